# Optimizing an MI355X kernel written in HIP

```python
import numpy as np
import jax
import jax.numpy as jnp
from jax import lax

D_MODEL = 1024
BATCH = 4
SEQ = 8192
DEPTH = 4

N_MIXERS = 3
NORM_EPS = 1e-6
NEG_INF = -1e30

RWKV_HEAD_DIM = 64
RWKV_HEADS = D_MODEL // RWKV_HEAD_DIM
DECAY_LORA = 64
ICLR_LORA = 64
VALUE_LORA = 32
GATE_LORA = 128
RWKV_GN_EPS = 64e-5
N_RWKV_LAYERS = len(range(0, DEPTH, N_MIXERS))
N_VRES = N_RWKV_LAYERS - 1

NSA_HEADS = 16
NSA_KV_GROUPS = 2
NSA_HEAD_DIM = D_MODEL // NSA_HEADS
CMP_BLOCK = 32
CMP_STRIDE = 16
CMP_HIDDEN = 256
SLC_BLOCK = 64
SLC_TOPK = 16
WINDOW = 512
Q_BLOCK = 128
FORCE_BONUS = 1e4
NSA_IN_DIM = NSA_HEADS * NSA_HEAD_DIM + 6 * NSA_KV_GROUPS * NSA_HEAD_DIM + 3 * NSA_HEADS
N_NSA_LAYERS = len(range(1, DEPTH, N_MIXERS))

GLA_HEADS = 4
GLA_KEY_DIM = D_MODEL // 2
GLA_VAL_DIM = D_MODEL
GLA_GATE_LORA = 16
GLA_TAU = 16.0
GLA_CHUNK = 64
GLA_NORM_EPS = 1e-5
GLA_IN_DIM = 2 * GLA_KEY_DIM + 2 * GLA_VAL_DIM + GLA_GATE_LORA
N_GLA_LAYERS = len(range(2, DEPTH, N_MIXERS))

D_FF = 2816
FFN_CONV = 3

kernel_name = 'hybrid_rwkv7_nsa_gla_convffn'


def rms_norm(x, g, eps=NORM_EPS):
    x32 = x.astype(jnp.float32)
    y = x32 * lax.rsqrt(jnp.mean(x32 * x32, axis=-1, keepdims=True) + eps)
    return (y * g.astype(jnp.float32)).astype(x.dtype)


def shift_right(x, n):
    return jnp.pad(x, ((0, 0), (n, 0), (0, 0)))[:, :x.shape[1]]


def rwkv7_step(state, inp):
    r, w, k, v, a, b = inp
    sa = jnp.einsum('bhij,bhj->bhi', state, a)
    state = state * w[:, :, None, :] + sa[..., None] * b[:, :, None, :] + v[..., None] * k[:, :, None, :]
    y = jnp.einsum('bhij,bhj->bhi', state, r)
    return state, y


def rwkv7_time_mix(x, mu, w_rkv, w0, w1, w2, a0, a1, a2, g1, g2, k_k, k_a, r_k, ln_w, ln_b, w_o, v_first, vres):
    B, S, D = x.shape
    H, N = RWKV_HEADS, RWKV_HEAD_DIM
    f32 = jnp.float32
    xx = shift_right(x, 1) - x
    xr, xw, xk, xv, xa, xg = (x + xx * mu[c] for c in range(6))
    r = xr @ w_rkv[0]
    k = xk @ w_rkv[1]
    v = xv @ w_rkv[2]
    w = -jax.nn.softplus(-(w0 + jnp.tanh(xw @ w1) @ w2)) - 0.5
    decay = jnp.exp(-jnp.exp(w.astype(f32)))
    a = jax.nn.sigmoid(a0 + (xa @ a1) @ a2)
    g = jax.nn.sigmoid(xg @ g1) @ g2
    if vres is None:
        v_first = v
    else:
        v0, v1, v2 = vres
        v = v + (v_first - v) * jax.nn.sigmoid(v0 + (xv @ v1) @ v2)
    kk = (k * k_k).reshape(B, S, H, N).astype(f32)
    kk = kk / jnp.maximum(jnp.linalg.norm(kk, axis=-1, keepdims=True), 1e-12)
    k = k * (1 + (a - 1) * k_a)
    heads = lambda t: t.reshape(B, S, H, N).astype(f32)
    r_h, k_h, v_h, a_h = heads(r), heads(k), heads(v), heads(a)
    seq_major = lambda t: jnp.swapaxes(t, 0, 1)
    xs = (seq_major(r_h), seq_major(heads(decay)), seq_major(k_h), seq_major(v_h),
          seq_major(-kk), seq_major(kk * a_h))
    _, y = lax.scan(rwkv7_step, jnp.zeros((B, H, N, N), f32), xs)
    y = seq_major(y)
    mean = jnp.mean(y, axis=-1, keepdims=True)
    var = jnp.var(y, axis=-1, keepdims=True)
    y = ((y - mean) * lax.rsqrt(var + RWKV_GN_EPS)).reshape(B, S, D) * ln_w + ln_b
    bonus = jnp.sum(r_h * k_h * r_k, axis=-1, keepdims=True) * v_h
    out = (y + bonus.reshape(B, S, D)).astype(x.dtype) * g
    return out @ w_o, v_first


def cmp_to_slc_overlap(n_cmp, n_slc):
    start = np.arange(n_cmp) * CMP_STRIDE
    end = start + CMP_BLOCK - 1
    s_start = np.arange(n_slc) * SLC_BLOCK
    s_end = s_start + SLC_BLOCK - 1
    return ((end[:, None] >= s_start[None, :]) & (start[:, None] <= s_end[None, :])).astype(np.float32)


def nsa_mix(x, w_in, cmp_w1, cmp_b1, cmp_w2, cmp_pe, w_o):
    B, S, _ = x.shape
    H, G, dh = NSA_HEADS, NSA_KV_GROUPS, NSA_HEAD_DIM
    hpg = H // G
    f32 = jnp.float32
    q, kv, gates = jnp.split(x @ w_in, [H * dh, H * dh + 6 * G * dh], axis=-1)
    q = q.reshape(B, S, G, hpg, dh) * (dh ** -0.5)
    kv = kv.reshape(B, S, 6, G, dh)
    k_cmp, v_cmp, k_slc, v_slc, k_win, v_win = (kv[:, :, c] for c in range(6))
    gates = jax.nn.sigmoid(gates.reshape(B, S, G, hpg, 3))

    n_cmp = (S - CMP_BLOCK) // CMP_STRIDE + 1
    tok = np.arange(n_cmp)[:, None] * CMP_STRIDE + np.arange(CMP_BLOCK)[None, :]

    def compress(t, c):
        blk = t[:, tok] + cmp_pe[c][:, None, :]
        blk = jnp.swapaxes(blk, 2, 3).reshape(B, n_cmp, G, CMP_BLOCK * dh)
        return jax.nn.gelu(blk @ cmp_w1[c] + cmp_b1[c]) @ cmp_w2[c]

    kc, vc = compress(k_cmp, 0), compress(v_cmp, 1)
    cmp_end = jnp.asarray(tok[:, -1], jnp.int32)

    n_slc = S // SLC_BLOCK
    top_n = min(SLC_TOPK, n_slc)
    overlap = jnp.asarray(cmp_to_slc_overlap(n_cmp, n_slc))
    to_blocks = lambda t: jnp.transpose(t.reshape(B, n_slc, SLC_BLOCK, G, dh), (0, 3, 1, 2, 4))
    ks_b, vs_b = to_blocks(k_slc), to_blocks(v_slc)
    gather = jax.vmap(jax.vmap(lambda blocks, ix: blocks[ix]))
    blk_id = jnp.arange(n_slc, dtype=jnp.int32)
    in_blk = jnp.arange(SLC_BLOCK, dtype=jnp.int32)

    pad = ((0, 0), (WINDOW, 0), (0, 0), (0, 0))
    kw, vw = jnp.pad(k_win, pad), jnp.pad(v_win, pad)
    win_off = jnp.arange(WINDOW + Q_BLOCK, dtype=jnp.int32) - WINDOW

    def query_block(qb):
        t0 = qb * Q_BLOCK
        pos_q = t0 + jnp.arange(Q_BLOCK, dtype=jnp.int32)
        qc = lax.dynamic_slice_in_dim(q, t0, Q_BLOCK, axis=1)
        gc = lax.dynamic_slice_in_dim(gates, t0, Q_BLOCK, axis=1)
        vis = cmp_end[None, :] <= pos_q[:, None]
        s = jnp.einsum('bqghd,bngd->bghqn', qc, kc).astype(f32)
        p_cmp = jax.nn.softmax(jnp.where(vis, s, NEG_INF), axis=-1) * jnp.any(vis, axis=-1)[:, None]
        o_cmp = jnp.einsum('bghqn,bngd->bqghd', p_cmp.astype(vc.dtype), vc)
        imp = jnp.einsum('bghqn,nj->bgqj', p_cmp, overlap)
        cur = pos_q // SLC_BLOCK
        causal = blk_id[None, :] * SLC_BLOCK <= pos_q[:, None]
        forced = (blk_id[None, :] == 0) | (blk_id[None, :] == cur[:, None]) | (blk_id[None, :] == cur[:, None] - 1)
        score = jnp.where(causal, imp + FORCE_BONUS * forced, NEG_INF)
        _, idx = lax.top_k(score, top_n)
        kg, vg = gather(ks_b, idx), gather(vs_b, idx)
        tok_pos = idx[..., None] * SLC_BLOCK + in_blk
        s = jnp.einsum('bqghd,bgqnld->bghqnl', qc, kg).astype(f32)
        s = jnp.where(tok_pos[:, :, None] <= pos_q[:, None, None], s, NEG_INF)
        p = jax.nn.softmax(s.reshape(*s.shape[:4], -1), axis=-1)
        o_slc = jnp.einsum('bghqm,bgqmd->bqghd', p.astype(vg.dtype),
                           vg.reshape(B, G, Q_BLOCK, top_n * SLC_BLOCK, dh))
        kwc = lax.dynamic_slice_in_dim(kw, t0, WINDOW + Q_BLOCK, axis=1)
        vwc = lax.dynamic_slice_in_dim(vw, t0, WINDOW + Q_BLOCK, axis=1)
        pos_k = t0 + win_off
        wmask = ((pos_k[None, :] <= pos_q[:, None]) & (pos_k[None, :] > pos_q[:, None] - WINDOW)
                 & (pos_k[None, :] >= 0))
        s = jnp.einsum('bqghd,bkgd->bghqk', qc, kwc).astype(f32)
        p = jax.nn.softmax(jnp.where(wmask, s, NEG_INF), axis=-1)
        o_win = jnp.einsum('bghqk,bkgd->bqghd', p.astype(vwc.dtype), vwc)
        o = gc[..., 0:1] * o_cmp + gc[..., 1:2] * o_slc + gc[..., 2:3] * o_win
        return o.reshape(B, Q_BLOCK, H * dh)

    out = lax.map(query_block, jnp.arange(S // Q_BLOCK, dtype=jnp.int32))
    out = jnp.swapaxes(out, 0, 1).reshape(B, S, H * dh)
    return out @ w_o


def gla_step(state, inp):
    qe_c, kd_c, v_c, dec_c = inp
    o_c = jnp.einsum('bihd,bhdv->bihv', qe_c, state)
    state = dec_c[..., None] * state + jnp.einsum('bjhd,bjhv->bhdv', kd_c, v_c)
    return state, o_c


def gla_mix(x, w_in, a_up, a_bias, norm_w, w_o):
    B, S, D = x.shape
    H = GLA_HEADS
    dk, dv = GLA_KEY_DIM // H, GLA_VAL_DIM // H
    C = GLA_CHUNK
    nc = S // C
    f32 = jnp.float32
    q, k, v, r, a_dn = jnp.split(x @ w_in, [GLA_KEY_DIM, 2 * GLA_KEY_DIM, 2 * GLA_KEY_DIM + GLA_VAL_DIM,
                                            2 * GLA_KEY_DIM + 2 * GLA_VAL_DIM], axis=-1)
    q = (q.reshape(B, nc, C, H, dk) * (dk ** -0.5)).astype(f32)
    k = k.reshape(B, nc, C, H, dk).astype(f32)
    v = v.reshape(B, nc, C, H, dv).astype(f32)
    log_a = jax.nn.log_sigmoid((a_dn @ a_up + a_bias).astype(f32)) / GLA_TAU
    b = jnp.cumsum(log_a.reshape(B, nc, C, H, dk), axis=2)
    b_last = b[:, :, -1:]
    qe = q * jnp.exp(b)
    ke = k * jnp.exp(-b)
    kd = k * jnp.exp(b_last - b)
    A = jnp.einsum('bnihd,bnjhd->bnhij', qe, ke)
    A = jnp.where(jnp.tril(jnp.ones((C, C), bool)), A, 0.0)
    o_intra = jnp.einsum('bnhij,bnjhv->bnihv', A, v)
    decay = jnp.exp(b_last[:, :, 0])
    xs = tuple(jnp.moveaxis(t, 1, 0) for t in (qe, kd, v, decay))
    _, o_inter = lax.scan(gla_step, jnp.zeros((B, H, dk, dv), f32), xs)
    o = (o_intra + jnp.moveaxis(o_inter, 0, 1)).reshape(B, S, H, dv)
    o = o * lax.rsqrt(jnp.mean(o * o, axis=-1, keepdims=True) + GLA_NORM_EPS) * norm_w.astype(f32)
    o = o * jax.nn.silu(r.reshape(B, S, H, dv).astype(f32))
    return o.reshape(B, S, GLA_VAL_DIM).astype(x.dtype) @ w_o


def conv_ffn(x, w_in, conv_w, conv_b, w_out):
    gate, up = jnp.split(x @ w_in, 2, axis=-1)
    gate = sum(conv_w[FFN_CONV - 1 - s] * shift_right(gate, s) for s in range(FFN_CONV)) + conv_b
    return (jax.nn.silu(gate) * up) @ w_out


def setup_inputs(seed: int = 0) -> dict:
    key = jax.random.key(seed)
    ks = iter(jax.random.split(key, 40))

    def nrm(shape, scale):
        return scale * jax.random.normal(next(ks), shape, jnp.float32)

    D, F = D_MODEL, D_FF
    R, V, NN, NG = N_RWKV_LAYERS, N_VRES, N_NSA_LAYERS, N_GLA_LAYERS
    H, N = RWKV_HEADS, RWKV_HEAD_DIM
    dh = NSA_HEAD_DIM
    gla_dv = GLA_VAL_DIM // GLA_HEADS
    return {
        'x': nrm((BATCH, SEQ, D), 1.0),
        'norm_g': 1.0 + nrm((DEPTH, 4, D), 0.02),
        'ffn_w_in': nrm((DEPTH, D, 2 * F), D ** -0.5),
        'ffn_conv_w': nrm((DEPTH, FFN_CONV, F), FFN_CONV ** -0.5),
        'ffn_conv_b': nrm((DEPTH, F), 0.02),
        'ffn_w_out': nrm((DEPTH, F, D), F ** -0.5),
        'rwkv_mu': jax.random.uniform(next(ks), (R, 6, D), jnp.float32),
        'rwkv_w_rkv': nrm((R, 3, D, D), D ** -0.5),
        'rwkv_w0': nrm((R, D), 0.5),
        'rwkv_w1': nrm((R, D, DECAY_LORA), D ** -0.5),
        'rwkv_w2': nrm((R, DECAY_LORA, D), 0.1 * DECAY_LORA ** -0.5),
        'rwkv_a0': nrm((R, D), 0.5),
        'rwkv_a1': nrm((R, D, ICLR_LORA), D ** -0.5),
        'rwkv_a2': nrm((R, ICLR_LORA, D), 0.1 * ICLR_LORA ** -0.5),
        'rwkv_g1': nrm((R, D, GATE_LORA), D ** -0.5),
        'rwkv_g2': nrm((R, GATE_LORA, D), GATE_LORA ** -0.5),
        'rwkv_k_k': 0.85 + nrm((R, D), 0.05),
        'rwkv_k_a': 1.0 + nrm((R, D), 0.05),
        'rwkv_r_k': nrm((R, H, N), 0.1),
        'rwkv_ln_w': 1.0 + nrm((R, D), 0.02),
        'rwkv_ln_b': nrm((R, D), 0.02),
        'rwkv_w_o': nrm((R, D, D), D ** -0.5),
        'rwkv_v0': nrm((V, D), 0.5),
        'rwkv_v1': nrm((V, D, VALUE_LORA), D ** -0.5),
        'rwkv_v2': nrm((V, VALUE_LORA, D), 0.1 * VALUE_LORA ** -0.5),
        'nsa_w_in': nrm((NN, D, NSA_IN_DIM), D ** -0.5),
        'nsa_cmp_w1': nrm((NN, 2, CMP_BLOCK * dh, CMP_HIDDEN), (CMP_BLOCK * dh) ** -0.5),
        'nsa_cmp_b1': nrm((NN, 2, CMP_HIDDEN), 0.02),
        'nsa_cmp_w2': nrm((NN, 2, CMP_HIDDEN, dh), CMP_HIDDEN ** -0.5),
        'nsa_cmp_pe': nrm((NN, 2, CMP_BLOCK, dh), 0.1),
        'nsa_w_o': nrm((NN, NSA_HEADS * dh, D), (NSA_HEADS * dh) ** -0.5),
        'gla_w_in': nrm((NG, D, GLA_IN_DIM), D ** -0.5),
        'gla_a_up': nrm((NG, GLA_GATE_LORA, GLA_KEY_DIM), GLA_GATE_LORA ** -0.5),
        'gla_a_bias': nrm((NG, GLA_KEY_DIM), 0.5),
        'gla_norm_w': 1.0 + nrm((NG, gla_dv), 0.02),
        'gla_w_o': nrm((NG, GLA_VAL_DIM, D), GLA_VAL_DIM ** -0.5),
    }


def reference(x, norm_g, ffn_w_in, ffn_conv_w, ffn_conv_b, ffn_w_out,
              rwkv_mu, rwkv_w_rkv, rwkv_w0, rwkv_w1, rwkv_w2, rwkv_a0, rwkv_a1, rwkv_a2,
              rwkv_g1, rwkv_g2, rwkv_k_k, rwkv_k_a, rwkv_r_k, rwkv_ln_w, rwkv_ln_b, rwkv_w_o,
              rwkv_v0, rwkv_v1, rwkv_v2,
              nsa_w_in, nsa_cmp_w1, nsa_cmp_b1, nsa_cmp_w2, nsa_cmp_pe, nsa_w_o,
              gla_w_in, gla_a_up, gla_a_bias, gla_norm_w, gla_w_o):
    h = x
    v_first = None
    for i in range(DEPTH):
        kind, j = i % N_MIXERS, i // N_MIXERS
        y = rms_norm(h, norm_g[i, 0])
        if kind == 0:
            vres = None if j == 0 else (rwkv_v0[j - 1], rwkv_v1[j - 1], rwkv_v2[j - 1])
            y, v_first = rwkv7_time_mix(y, rwkv_mu[j], rwkv_w_rkv[j], rwkv_w0[j], rwkv_w1[j], rwkv_w2[j],
                                        rwkv_a0[j], rwkv_a1[j], rwkv_a2[j], rwkv_g1[j], rwkv_g2[j],
                                        rwkv_k_k[j], rwkv_k_a[j], rwkv_r_k[j], rwkv_ln_w[j], rwkv_ln_b[j],
                                        rwkv_w_o[j], v_first, vres)
        elif kind == 1:
            y = nsa_mix(y, nsa_w_in[j], nsa_cmp_w1[j], nsa_cmp_b1[j], nsa_cmp_w2[j], nsa_cmp_pe[j], nsa_w_o[j])
        else:
            y = gla_mix(y, gla_w_in[j], gla_a_up[j], gla_a_bias[j], gla_norm_w[j], gla_w_o[j])
        h = h + rms_norm(y, norm_g[i, 1])
        y = conv_ffn(rms_norm(h, norm_g[i, 2]), ffn_w_in[i], ffn_conv_w[i], ffn_conv_b[i], ffn_w_out[i])
        h = h + rms_norm(y, norm_g[i, 3])
    return h
```

```cpp
#include <hip/hip_runtime.h>
#include <stdint.h>
#include <stdio.h>
#include <string.h>

#define DEV __device__ __forceinline__
typedef unsigned short bf16_t;
typedef short bf16x8 __attribute__((ext_vector_type(8)));
typedef float f32x4 __attribute__((ext_vector_type(4)));
typedef unsigned u32x4 __attribute__((ext_vector_type(4)));
typedef unsigned u32x2 __attribute__((ext_vector_type(2)));

constexpr int SEQ = 8192, NBATCH = 4, T = SEQ * NBATCH, DM = 1024, DFF = 2816;
constexpr int NTHR = 512;
constexpr size_t MiB = 1ull << 20;
constexpr size_t SLOT = 64 * MiB;
constexpr size_t OFF_S7 = 7 * SLOT;
constexpr size_t OFF_BAR = OFF_S7;
constexpr size_t OFF_BIASP = OFF_S7 + 65536;
constexpr size_t OFF_BSC = OFF_S7 + 1 * MiB;
constexpr size_t OFF_WREG = OFF_S7 + 4 * MiB;
constexpr size_t OFF_HID = OFF_S7 + 32 * MiB;
constexpr size_t OFF_WF1 = OFF_WREG;
constexpr size_t OFF_WF2 = OFF_WREG + 11 * MiB;
constexpr size_t OFF_MIX = OFF_WREG + 17 * MiB;
constexpr int HIDP = 320;
constexpr int GEMM_LDS = 98304;

enum { I_X = 0, I_NORMG, I_FWIN, I_FCW, I_FCB, I_FWOUT, I_MU, I_WRKV, I_W0, I_W1, I_W2, I_A0, I_A1, I_A2, I_G1, I_G2, I_KK, I_KA, I_RK, I_LNW, I_LNB, I_RWO,
       I_V0, I_V1, I_V2, I_NWIN, I_CW1, I_CB1, I_CW2, I_CPE, I_NWO, I_GWIN, I_AUP, I_ABIAS, I_GNW, I_GWO, N_IN };

struct Params { const float* in[N_IN]; float* out; char* ws; };

DEV float bf_lo(unsigned u) { return __uint_as_float(u << 16); }
DEV float bf_hi(unsigned u) { return __uint_as_float(u & 0xffff0000u); }
DEV float bf2f(bf16_t b) { return __uint_as_float(((unsigned)b) << 16); }
DEV unsigned cvt_pk(float lo, float hi) { unsigned r; asm("v_cvt_pk_bf16_f32 %0, %1, %2" : "=v"(r) : "v"(lo), "v"(hi)); return r; }
DEV bf16_t f2bf(float f) { return (bf16_t)(cvt_pk(f, 0.f) & 0xffffu); }
DEV void st_bf4(bf16_t* p, f32x4 v) { u32x2 w; w.x = cvt_pk(v[0], v[1]); w.y = cvt_pk(v[2], v[3]); *(u32x2*)p = w; }
DEV f32x4 ld_bf4(const bf16_t* p) { u32x2 w = *(const u32x2*)p; f32x4 v; v[0] = bf_lo(w.x); v[1] = bf_hi(w.x); v[2] = bf_lo(w.y); v[3] = bf_hi(w.y); return v; }
DEV float sigmoidf_(float x) { return 1.0f / (1.0f + __expf(-x)); }
DEV float wave_sum(float v) {
#pragma unroll
    for (int o = 32; o > 0; o >>= 1) v += __shfl_xor(v, o);
    return v;
}

#define DPP_MOV(x, ctrl) __int_as_float(__builtin_amdgcn_mov_dpp(__float_as_int(x), (ctrl), 0xf, 0xf, true))
DEV float row16_sum(float x) {
    x += DPP_MOV(x, 0xB1);
    x += DPP_MOV(x, 0x4E);
    x += DPP_MOV(x, 0x124);
    x += DPP_MOV(x, 0x128);
    return x;
}
DEV bf16x8 pack8(f32x4 a, f32x4 b) {
    u32x4 w; w.x = cvt_pk(a[0], a[1]); w.y = cvt_pk(a[2], a[3]); w.z = cvt_pk(b[0], b[1]); w.w = cvt_pk(b[2], b[3]);
    return __builtin_bit_cast(bf16x8, w);
}
#define MFMA(a, b, c) __builtin_amdgcn_mfma_f32_16x16x32_bf16((a), (b), (c), 0, 0, 0)

struct LdPlain { const bf16_t* p; long pitch;
    DEV u32x4 operator()(int r, int k) const { return *(const u32x4*)(p + (long)r * pitch + k); } };
DEV unsigned mixpair(unsigned x, unsigned xp, float ma, float mb) { const float a = bf_lo(x), b = bf_hi(x), pa = bf_lo(xp), pb = bf_hi(xp); return cvt_pk(a + (pa - a) * ma, b + (pb - b) * mb); }
struct LdMix { const bf16_t* xn; const float* mu; int row0;
    DEV u32x4 operator()(int r, int k) const {
        const int gr = row0 + r; const bf16_t* px = xn + (long)gr * DM + k;
        const u32x4 x = *(const u32x4*)px; u32x4 xp = {0u, 0u, 0u, 0u};
        if ((gr & (SEQ - 1)) != 0) xp = *(const u32x4*)(px - DM);
        const f32x4 m0 = *(const f32x4*)(mu + k), m1 = *(const f32x4*)(mu + k + 4);
        u32x4 o; o.x = mixpair(x.x, xp.x, m0[0], m0[1]); o.y = mixpair(x.y, xp.y, m0[2], m0[3]); o.z = mixpair(x.z, xp.z, m1[0], m1[1]); o.w = mixpair(x.w, xp.w, m1[2], m1[3]);
        return o; } };
struct LdCmp { const bf16_t* src; int row0;
    DEV u32x4 operator()(int r, int k) const {
        const int row = row0 + r, b = row >> 10, n = (row >> 1) & 511, g = row & 1, l = k >> 6, d = k & 63;
        int t = 16 * n + l; t = t > SEQ - 1 ? SEQ - 1 : t;
        return *(const u32x4*)(src + ((long)(b * SEQ + t)) * 128 + g * 64 + d); } };

template <class AL, class BL>
DEV void gemm_core_db(f32x4 (&acc)[4][4], const AL& al, const BL& bl, const int K, char* smem) {
    const int tid = threadIdx.x, lane = tid & 63, wid = tid >> 6, wm = wid >> 1, wn = wid & 1, fr = lane & 15, fq = lane >> 4;
#pragma unroll
    for (int m = 0; m < 4; ++m)
#pragma unroll
        for (int n = 0; n < 4; ++n) acc[m][n] = (f32x4){0.f, 0.f, 0.f, 0.f};
    u32x4 ra[4], rb[2];
    const int srow = tid >> 3, skc = tid & 7;
    const int soff = srow * 128 + ((skc ^ ((srow >> 1) & 7)) << 4);
    const int fsw = (fr >> 1) & 7;
    const int aoff = (wm * 64 + fr) * 128, boff = 32768 + (wn * 64 + fr) * 128;
    const int nk = K >> 6;
#pragma unroll
    for (int i = 0; i < 4; ++i) ra[i] = al(srow + 64 * i, skc * 8);
#pragma unroll
    for (int i = 0; i < 2; ++i) rb[i] = bl(srow + 64 * i, skc * 8);
#pragma unroll
    for (int i = 0; i < 4; ++i) *(u32x4*)(smem + soff + i * 8192) = ra[i];
#pragma unroll
    for (int i = 0; i < 2; ++i) *(u32x4*)(smem + 32768 + soff + i * 8192) = rb[i];
    __syncthreads();
    for (int kt = 0; kt < nk; ++kt) {
        const bool more = kt + 1 < nk;
        if (more) {
            const int k0 = (kt + 1) * 64 + skc * 8;
#pragma unroll
            for (int i = 0; i < 4; ++i) ra[i] = al(srow + 64 * i, k0);
#pragma unroll
            for (int i = 0; i < 2; ++i) rb[i] = bl(srow + 64 * i, k0);
        }
        const char* base = smem + (kt & 1) * 49152;
#pragma unroll
        for (int ks = 0; ks < 2; ++ks) {
            const int kcs = ((ks * 4 + fq) ^ fsw) << 4;
            bf16x8 af[4], bfr[4];
#pragma unroll
            for (int m = 0; m < 4; ++m) af[m] = *(const bf16x8*)(base + aoff + m * 2048 + kcs);
#pragma unroll
            for (int n = 0; n < 4; ++n) bfr[n] = *(const bf16x8*)(base + boff + n * 2048 + kcs);
#pragma unroll
            for (int m = 0; m < 4; ++m)
#pragma unroll
                for (int n = 0; n < 4; ++n) acc[m][n] = MFMA(bfr[n], af[m], acc[m][n]);
        }
        if (more) {
            char* nb = smem + ((kt + 1) & 1) * 49152;
#pragma unroll
            for (int i = 0; i < 4; ++i) *(u32x4*)(nb + soff + i * 8192) = ra[i];
#pragma unroll
            for (int i = 0; i < 2; ++i) *(u32x4*)(nb + 32768 + soff + i * 8192) = rb[i];
        }
        __syncthreads();
    }
}

template <class AL, class BL>
DEV void gemm_core(f32x4 (&acc)[4][4], const AL& al, const BL& bl, const int K, char* smem) {
    const int tid = threadIdx.x, lane = tid & 63, wid = tid >> 6, wm = wid >> 1, wn = wid & 1, fr = lane & 15, fq = lane >> 4;
#pragma unroll
    for (int m = 0; m < 4; ++m)
#pragma unroll
        for (int n = 0; n < 4; ++n) acc[m][n] = (f32x4){0.f, 0.f, 0.f, 0.f};
    u32x4 ra[4], rb[2];
    const int srow = tid >> 3, skc = tid & 7;
    const int soff = srow * 128 + ((skc ^ ((srow >> 1) & 7)) << 4);
    const int fsw = (fr >> 1) & 7;
    const int aoff = (wm * 64 + fr) * 128, boff = 32768 + (wn * 64 + fr) * 128;
    const int nk = K >> 6;
    for (int kt = 0; kt < nk; ++kt) {
        const int k0 = kt * 64 + skc * 8;
#pragma unroll
        for (int i = 0; i < 4; ++i) ra[i] = al(srow + 64 * i, k0);
#pragma unroll
        for (int i = 0; i < 2; ++i) rb[i] = bl(srow + 64 * i, k0);
        __syncthreads();
#pragma unroll
        for (int i = 0; i < 4; ++i) *(u32x4*)(smem + soff + i * 8192) = ra[i];
#pragma unroll
        for (int i = 0; i < 2; ++i) *(u32x4*)(smem + 32768 + soff + i * 8192) = rb[i];
        __syncthreads();
        const char* base = smem;
#pragma unroll
        for (int ks = 0; ks < 2; ++ks) {
            const int kcs = ((ks * 4 + fq) ^ fsw) << 4;
            bf16x8 af[4], bfr[4];
#pragma unroll
            for (int m = 0; m < 4; ++m) af[m] = *(const bf16x8*)(base + aoff + m * 2048 + kcs);
#pragma unroll
            for (int n = 0; n < 4; ++n) bfr[n] = *(const bf16x8*)(base + boff + n * 2048 + kcs);
#pragma unroll
            for (int m = 0; m < 4; ++m)
#pragma unroll
                for (int n = 0; n < 4; ++n) acc[m][n] = MFMA(bfr[n], af[m], acc[m][n]);
        }
    }
    __syncthreads();
}
struct LaneId { int lane, wid, wm, wn, fr, fq; };
DEV LaneId lane_id() { LaneId l; l.lane = threadIdx.x & 63; l.wid = threadIdx.x >> 6; l.wm = l.wid >> 1; l.wn = l.wid & 1; l.fr = l.lane & 15; l.fq = l.lane >> 4; return l; }

template <class Map>
DEV void prep_T(bf16_t* dst, const float* src, int Ks, int Ns, int Nd, int Kd, Map map, char* smem, int& cursor) {
    float* tile = (float*)smem;
    const int ntn = Nd >> 6, ntiles = ntn * (Kd >> 6), tid = threadIdx.x;
    for (int tl = 0; tl < ntiles; ++tl) {
        if (((cursor + tl) % (int)gridDim.x) != (int)blockIdx.x) continue;
        const int n0 = (tl % ntn) * 64, k0 = (tl / ntn) * 64;
        { const int j = tid & 63, i0 = tid >> 6; const int n = map(n0 + j);
          for (int kk = i0; kk < 64; kk += 8) { const int k = k0 + kk; tile[kk * 65 + j] = (k < Ks && n >= 0) ? src[(long)k * Ns + n] : 0.f; } }
        __syncthreads();
        { const int c = tid & 63, r0 = tid >> 6;
          for (int r = r0; r < 64; r += 8) dst[(long)(n0 + r) * Kd + k0 + c] = f2bf(tile[c * 65 + r]); }
        __syncthreads();
    }
    cursor += ntiles;
}
struct MapId { int ns; DEV int operator()(int n) const { return n < ns ? n : -1; } };
struct MapFfn { DEV int operator()(int v) const { const int tn = v >> 7, wn = (v >> 6) & 1, u = (v >> 5) & 1, c = v & 31; return (u ? DFF : 0) + 64 * tn + 32 * wn + c; } };

DEV void phase_prep(const Params& P, int layer, char* smem) {
    char* ws = P.ws; int cur = 0;
    const int kind = layer % 3, j = layer / 3;
    prep_T((bf16_t*)(ws + OFF_WF1), P.in[I_FWIN] + (size_t)layer * DM * 2 * DFF, DM, 2 * DFF, 2 * DFF, DM, MapFfn{}, smem, cur);
    prep_T((bf16_t*)(ws + OFF_WF2), P.in[I_FWOUT] + (size_t)layer * DFF * DM, DFF, DM, DM, DFF, MapId{DM}, smem, cur);
    bf16_t* mix = (bf16_t*)(ws + OFF_MIX);
    if (kind == 0) {
        const float* wrkv = P.in[I_WRKV] + (size_t)j * 3 * DM * DM;
        prep_T(mix, wrkv, DM, DM, DM, DM, MapId{DM}, smem, cur);
        prep_T(mix + (size_t)1024 * DM, wrkv + (size_t)DM * DM, DM, DM, DM, DM, MapId{DM}, smem, cur);
        prep_T(mix + (size_t)2048 * DM, P.in[I_W1] + (size_t)j * DM * 64, DM, 64, 128, DM, MapId{64}, smem, cur);
        prep_T(mix + (size_t)2176 * DM, P.in[I_A1] + (size_t)j * DM * 64, DM, 64, 128, DM, MapId{64}, smem, cur);
        prep_T(mix + (size_t)2304 * DM, P.in[I_G1] + (size_t)j * DM * 128, DM, 128, 128, DM, MapId{128}, smem, cur);
        if (j > 0) prep_T(mix + (size_t)2432 * DM, P.in[I_V1] + (size_t)(j - 1) * DM * 32, DM, 32, 128, DM, MapId{32}, smem, cur);
        else       prep_T(mix + (size_t)2432 * DM, P.in[I_V1], DM, 32, 128, DM, MapId{0}, smem, cur);
        prep_T((bf16_t*)((char*)mix + 5 * MiB), wrkv + (size_t)2 * DM * DM, DM, DM, DM, DM, MapId{DM}, smem, cur);
        prep_T((bf16_t*)((char*)mix + 7 * MiB), P.in[I_W2] + (size_t)j * 64 * DM, 64, DM, DM, 64, MapId{DM}, smem, cur);
        prep_T((bf16_t*)((char*)mix + 7 * MiB + 131072), P.in[I_A2] + (size_t)j * 64 * DM, 64, DM, DM, 64, MapId{DM}, smem, cur);
        if (j > 0) prep_T((bf16_t*)((char*)mix + 7 * MiB + 262144), P.in[I_V2] + (size_t)(j - 1) * 32 * DM, 32, DM, DM, 64, MapId{DM}, smem, cur);
        prep_T((bf16_t*)((char*)mix + 7 * MiB + 393216), P.in[I_G2] + (size_t)j * 128 * DM, 128, DM, DM, 128, MapId{DM}, smem, cur);
        prep_T((bf16_t*)((char*)mix + 8 * MiB), P.in[I_RWO] + (size_t)j * DM * DM, DM, DM, DM, DM, MapId{DM}, smem, cur);
    } else if (kind == 1) {
        prep_T(mix, P.in[I_NWIN], DM, 1840, 2048, DM, MapId{1840}, smem, cur);
        prep_T((bf16_t*)((char*)mix + 4 * MiB), P.in[I_CW1], 2048, 256, 256, 2048, MapId{256}, smem, cur);
        prep_T((bf16_t*)((char*)mix + 4 * MiB) + (size_t)256 * 2048, P.in[I_CW1] + (size_t)2048 * 256, 2048, 256, 256, 2048, MapId{256}, smem, cur);
        prep_T((bf16_t*)((char*)mix + 6 * MiB), P.in[I_CW2], 256, 64, 128, 256, MapId{64}, smem, cur);
        prep_T((bf16_t*)((char*)mix + 6 * MiB) + (size_t)128 * 256, P.in[I_CW2] + (size_t)256 * 64, 256, 64, 128, 256, MapId{64}, smem, cur);
        prep_T((bf16_t*)((char*)mix + 7 * MiB), P.in[I_NWO], DM, DM, DM, DM, MapId{DM}, smem, cur);
        const int gt = blockIdx.x * NTHR + threadIdx.x;
        if (gt < 512) { const int c = gt >> 8, col = gt & 255; const float* w1 = P.in[I_CW1] + (size_t)c * 2048 * 256; const float* pe = P.in[I_CPE] + (size_t)c * 2048;
            float s = P.in[I_CB1][c * 256 + col]; for (int k = 0; k < 2048; ++k) s += pe[k] * w1[(size_t)k * 256 + col];
            ((float*)(ws + OFF_BIASP))[gt] = s; }
    } else {
        prep_T(mix, P.in[I_GWIN], DM, 3088, 3200, DM, MapId{3088}, smem, cur);
        prep_T((bf16_t*)((char*)mix + 7 * MiB), P.in[I_GWO], DM, DM, DM, DM, MapId{DM}, smem, cur);
    }
}

DEV void phase_norm(const float* h_in, const bf16_t* z, const float* g_post, float* h_out, const float* g_pre, bf16_t* xn) {
    const int lane = threadIdx.x & 63, gw = blockIdx.x * (NTHR / 64) + (threadIdx.x >> 6), nw = gridDim.x * (NTHR / 64);
    for (int row = gw; row < T; row += nw) {
        f32x4 hv[4];
#pragma unroll
        for (int i = 0; i < 4; ++i) hv[i] = *(const f32x4*)(h_in + (size_t)row * DM + i * 256 + lane * 4);
        if (z) {
            f32x4 zv[4]; float ss = 0.f;
#pragma unroll
            for (int i = 0; i < 4; ++i) { zv[i] = ld_bf4(z + (size_t)row * DM + i * 256 + lane * 4); ss += zv[i][0] * zv[i][0] + zv[i][1] * zv[i][1] + zv[i][2] * zv[i][2] + zv[i][3] * zv[i][3]; }
            ss = wave_sum(ss); const float rs = rsqrtf(ss * (1.0f / DM) + 1e-6f);
#pragma unroll
            for (int i = 0; i < 4; ++i) { const f32x4 g = *(const f32x4*)(g_post + i * 256 + lane * 4); hv[i] += zv[i] * rs * g; }
        }
        if (h_out) {
#pragma unroll
            for (int i = 0; i < 4; ++i) *(f32x4*)(h_out + (size_t)row * DM + i * 256 + lane * 4) = hv[i];
        }
        if (xn) {
            float ss = 0.f;
#pragma unroll
            for (int i = 0; i < 4; ++i) ss += hv[i][0] * hv[i][0] + hv[i][1] * hv[i][1] + hv[i][2] * hv[i][2] + hv[i][3] * hv[i][3];
            ss = wave_sum(ss); const float rs = rsqrtf(ss * (1.0f / DM) + 1e-6f);
#pragma unroll
            for (int i = 0; i < 4; ++i) { const f32x4 g = *(const f32x4*)(g_pre + i * 256 + lane * 4); st_bf4(xn + (size_t)row * DM + i * 256 + lane * 4, hv[i] * rs * g); }
        }
    }
}

DEV void phase_gemm_plain(const bf16_t* A, int lda, const bf16_t* Bt, int K, int ntn, bf16_t* C, int ldc, char* smem) {
    const LaneId L = lane_id();
    const int nunits = (T / 256) * ntn;
    for (int u = blockIdx.x; u < nunits; u += gridDim.x) {
        const int tm = u / ntn, tn = u % ntn;
        f32x4 acc[4][4];
        gemm_core(acc, LdPlain{A + (size_t)tm * 256 * lda, lda}, LdPlain{Bt + (size_t)tn * 128 * K, K}, K, smem);
#pragma unroll
        for (int m = 0; m < 4; ++m)
#pragma unroll
            for (int n = 0; n < 4; ++n)
                st_bf4(C + (size_t)(tm * 256 + L.wm * 64 + m * 16 + L.fr) * ldc + tn * 128 + L.wn * 64 + n * 16 + L.fq * 4, acc[m][n]);
    }
}

DEV void phase_f1(const bf16_t* xn, const bf16_t* Bt, const float* cw, const float* cb, bf16_t* act, bf16_t* E, char* smem) {
    const LaneId L = lane_id();
    const int ntn = 2 * DFF / 128, nunits = (T / 256) * ntn;
    for (int u = blockIdx.x; u < nunits; u += gridDim.x) {
        const int tm = u / ntn, tn = u % ntn;
        f32x4 acc[4][4];
        gemm_core(acc, LdPlain{xn + (size_t)tm * 256 * DM, DM}, LdPlain{Bt + (size_t)tn * 128 * DM, DM}, DM, smem);
        const int strip = tm * 4 + L.wm; const size_t rowbase = (size_t)tm * 256 + L.wm * 64;
#pragma unroll
        for (int n = 0; n < 2; ++n) {
            const int ch = tn * 64 + L.wn * 32 + n * 16 + L.fq * 4;
            const f32x4 c0 = *(const f32x4*)(cw + ch), c1 = *(const f32x4*)(cw + DFF + ch), c2 = *(const f32x4*)(cw + 2 * DFF + ch), cbv = *(const f32x4*)(cb + ch);
#pragma unroll
            for (int m = 0; m < 4; ++m) {
                const f32x4 g0 = acc[m][n], up = acc[m][n + 2]; f32x4 g1, g2;
#pragma unroll
                for (int j = 0; j < 4; ++j) {
                    const float a1 = __shfl(g0[j], (L.lane - 1) & 63), a2 = __shfl(g0[j], (L.lane - 2) & 63);
                    float b1 = 0.f, b2 = 0.f;
                    if (m > 0) { b1 = __shfl(acc[m > 0 ? m - 1 : 0][n][j], (L.lane + 15) & 63); b2 = __shfl(acc[m > 0 ? m - 1 : 0][n][j], (L.lane + 14) & 63); }
                    g1[j] = L.fr >= 1 ? a1 : b1; g2[j] = L.fr >= 2 ? a2 : b2;
                }
                const int rs = m * 16 + L.fr;
                f32x4 val = c2 * g0 + c1 * g1 + c0 * g2 + cbv, a;
#pragma unroll
                for (int j = 0; j < 4; ++j) a[j] = val[j] / (1.0f + __expf(-val[j])) * up[j];
                if (rs >= 2) st_bf4(act + (rowbase + rs) * DFF + ch, a);
                else { st_bf4(E + ((size_t)strip * 6 + 2 + rs) * DFF + ch, g0); st_bf4(E + ((size_t)strip * 6 + 4 + rs) * DFF + ch, up); }
                if (rs >= 62) st_bf4(E + ((size_t)strip * 6 + (rs - 62)) * DFF + ch, g0);
            }
        }
    }
}
DEV void phase_f1b(const float* cw, const float* cb, bf16_t* act, const bf16_t* E) {
    const int gt = blockIdx.x * NTHR + threadIdx.x, nt = gridDim.x * NTHR;
    for (int idx = gt; idx < 512 * 2 * (DFF / 4); idx += nt) {
        const int ch = (idx % (DFF / 4)) * 4, r = (idx / (DFF / 4)) & 1, strip = idx / (2 * (DFF / 4));
        const bool first = (strip & 127) == 0;
        const f32x4 zero = {0.f, 0.f, 0.f, 0.f};
        const f32x4 g0 = ld_bf4(E + ((size_t)strip * 6 + 2 + r) * DFF + ch), up = ld_bf4(E + ((size_t)strip * 6 + 4 + r) * DFF + ch);
        f32x4 g1, g2;
        if (r == 1) { g1 = ld_bf4(E + ((size_t)strip * 6 + 2) * DFF + ch); g2 = first ? zero : ld_bf4(E + ((size_t)(strip - 1) * 6 + 1) * DFF + ch); }
        else { g1 = first ? zero : ld_bf4(E + ((size_t)(strip - 1) * 6 + 1) * DFF + ch); g2 = first ? zero : ld_bf4(E + ((size_t)(strip - 1) * 6 + 0) * DFF + ch); }
        const f32x4 c0 = *(const f32x4*)(cw + ch), c1 = *(const f32x4*)(cw + DFF + ch), c2 = *(const f32x4*)(cw + 2 * DFF + ch), cbv = *(const f32x4*)(cb + ch);
        f32x4 val = c2 * g0 + c1 * g1 + c0 * g2 + cbv, a;
#pragma unroll
        for (int j = 0; j < 4; ++j) a[j] = val[j] / (1.0f + __expf(-val[j])) * up[j];
        st_bf4(act + ((size_t)strip * 64 + r) * DFF + ch, a);
    }
}

struct RwkvW { const float *mu, *w0, *a0, *k_k, *k_a, *r_k, *ln_w, *ln_b, *v0; bool vres; };
DEV void phase_r1(const bf16_t* xn, const bf16_t* Bt, const RwkvW& W, bf16_t* rb, bf16_t* kb, bf16_t* hid, char* smem) {
    const LaneId L = lane_id();
    const int ntn = 20, nunits = (T / 256) * ntn;
    for (int u = blockIdx.x; u < nunits; u += gridDim.x) {
        const int tm = u / ntn, tn = u % ntn;
        const int var = tn < 8 ? 0 : tn < 16 ? 2 : tn == 16 ? 1 : tn == 17 ? 4 : tn == 18 ? 5 : 3;
        f32x4 acc[4][4];
        gemm_core(acc, LdMix{xn, W.mu + var * DM, tm * 256}, LdPlain{Bt + (size_t)tn * 128 * DM, DM}, DM, smem);
#pragma unroll
        for (int m = 0; m < 4; ++m)
#pragma unroll
            for (int n = 0; n < 4; ++n) {
                const size_t row = (size_t)tm * 256 + L.wm * 64 + m * 16 + L.fr; const int c = L.wn * 64 + n * 16 + L.fq * 4; f32x4 v = acc[m][n];
                if (tn < 8) st_bf4(rb + row * DM + tn * 128 + c, v);
                else if (tn < 16) st_bf4(kb + row * DM + (tn - 8) * 128 + c, v);
                else if (tn == 16) { if (L.wn == 0) { for (int j = 0; j < 4; ++j) v[j] = tanhf(v[j]); st_bf4(hid + row * HIDP + c, v); } }
                else if (tn == 17) { if (L.wn == 0) st_bf4(hid + row * HIDP + 64 + c, v); }
                else if (tn == 18) { for (int j = 0; j < 4; ++j) v[j] = sigmoidf_(v[j]); st_bf4(hid + row * HIDP + 128 + c, v); }
                else { if (L.wn == 0) st_bf4(hid + row * HIDP + 256 + c, v); }
            }
    }
}
DEV void phase_r2(const bf16_t* xn, const bf16_t* mixw, const RwkvW& W, const bf16_t* hid, bf16_t* wb, bf16_t* kb, bf16_t* kkb, bf16_t* kab, bf16_t* vb, char* smem) {
    const LaneId L = lane_id();
    const bf16_t* Bv = (const bf16_t*)((const char*)mixw + 5 * MiB);
    const bf16_t* W2T = (const bf16_t*)((const char*)mixw + 7 * MiB);
    const bf16_t* A2T = (const bf16_t*)((const char*)mixw + 7 * MiB + 131072);
    const bf16_t* V2T = (const bf16_t*)((const char*)mixw + 7 * MiB + 262144);
    const int nunits = 1024 + 2048;
    for (int u = blockIdx.x; u < nunits; u += gridDim.x) {
        if (u < 1024) {
            const int tm = u >> 3, tn = u & 7;
            f32x4 acc[4][4]; u32x2 gpk[4][4];
            if (W.vres) {
                gemm_core(acc, LdPlain{hid + (size_t)tm * 256 * HIDP + 256, HIDP}, LdPlain{V2T + (size_t)tn * 128 * 64, 64}, 64, smem);
#pragma unroll
                for (int m = 0; m < 4; ++m)
#pragma unroll
                    for (int n = 0; n < 4; ++n) { const int col = tn * 128 + L.wn * 64 + n * 16 + L.fq * 4; const f32x4 b = *(const f32x4*)(W.v0 + col);
                        gpk[m][n].x = cvt_pk(sigmoidf_(b[0] + acc[m][n][0]), sigmoidf_(b[1] + acc[m][n][1]));
                        gpk[m][n].y = cvt_pk(sigmoidf_(b[2] + acc[m][n][2]), sigmoidf_(b[3] + acc[m][n][3])); }
            }
            gemm_core(acc, LdMix{xn, W.mu + 3 * DM, tm * 256}, LdPlain{Bv + (size_t)tn * 128 * DM, DM}, DM, smem);
#pragma unroll
            for (int m = 0; m < 4; ++m)
#pragma unroll
                for (int n = 0; n < 4; ++n) {
                    const size_t row = (size_t)tm * 256 + L.wm * 64 + m * 16 + L.fr; const int col = tn * 128 + L.wn * 64 + n * 16 + L.fq * 4; f32x4 v = acc[m][n];
                    if (W.vres) { const f32x4 vf = ld_bf4(vb + row * DM + col); f32x4 gt; gt[0] = bf_lo(gpk[m][n].x); gt[1] = bf_hi(gpk[m][n].x); gt[2] = bf_lo(gpk[m][n].y); gt[3] = bf_hi(gpk[m][n].y); v = v + (vf - v) * gt; }
                    st_bf4(vb + row * DM + col, v);
                }
        } else {
            const int u2 = u - 1024, tm = u2 >> 4, jj = u2 & 15;
            f32x4 acc[4][4];
            if (jj < 8) {
                const int tn = jj;
                gemm_core(acc, LdPlain{hid + (size_t)tm * 256 * HIDP, HIDP}, LdPlain{W2T + (size_t)tn * 128 * 64, 64}, 64, smem);
#pragma unroll
                for (int m = 0; m < 4; ++m)
#pragma unroll
                    for (int n = 0; n < 4; ++n) {
                        const size_t row = (size_t)tm * 256 + L.wm * 64 + m * 16 + L.fr; const int col = tn * 128 + L.wn * 64 + n * 16 + L.fq * 4; const f32x4 b = *(const f32x4*)(W.w0 + col); f32x4 v;
                        for (int j = 0; j < 4; ++j) { const float x = b[j] + acc[m][n][j]; const float y = -x;
                            const float sp = fmaxf(y, 0.f) + log1pf(__expf(-fabsf(y))); const float w = -sp - 0.5f; v[j] = __expf(-__expf(w)); }
                        st_bf4(wb + row * DM + col, v);
                    }
            } else {
                const int tn = jj - 8;
                gemm_core(acc, LdPlain{hid + (size_t)tm * 256 * HIDP + 64, HIDP}, LdPlain{A2T + (size_t)tn * 128 * 64, 64}, 64, smem);
#pragma unroll
                for (int m = 0; m < 4; ++m) {
                    const size_t row = (size_t)tm * 256 + L.wm * 64 + m * 16 + L.fr;
                    f32x4 kv[4], kkv[4], av[4]; float ss = 0.f;
#pragma unroll
                    for (int n = 0; n < 4; ++n) { const int col = tn * 128 + L.wn * 64 + n * 16 + L.fq * 4;
                        kv[n] = ld_bf4(kb + row * DM + col); const f32x4 kkw = *(const f32x4*)(W.k_k + col), a0 = *(const f32x4*)(W.a0 + col);
                        kkv[n] = kv[n] * kkw; ss += kkv[n][0] * kkv[n][0] + kkv[n][1] * kkv[n][1] + kkv[n][2] * kkv[n][2] + kkv[n][3] * kkv[n][3];
                        for (int j = 0; j < 4; ++j) av[n][j] = sigmoidf_(a0[j] + acc[m][n][j]); }
                    ss += __shfl_xor(ss, 16); ss += __shfl_xor(ss, 32);
                    const float inv = 1.0f / fmaxf(sqrtf(ss), 1e-12f);
#pragma unroll
                    for (int n = 0; n < 4; ++n) { const int col = tn * 128 + L.wn * 64 + n * 16 + L.fq * 4; const f32x4 ka = *(const f32x4*)(W.k_a + col);
                        const f32x4 kk = kkv[n] * inv; f32x4 kp, kka;
                        for (int j = 0; j < 4; ++j) { kp[j] = kv[n][j] * (1.0f + (av[n][j] - 1.0f) * ka[j]); kka[j] = kk[j] * av[n][j]; }
                        st_bf4(kb + row * DM + col, kp); st_bf4(kkb + row * DM + col, kk); st_bf4(kab + row * DM + col, kka); }
                }
            }
        }
    }
}
DEV void phase_r3(const bf16_t* rb, const bf16_t* wb, const bf16_t* kb, const bf16_t* kkb, const bf16_t* kab, const bf16_t* vb, bf16_t* yb, float* bsc, const float* r_k) {
    const int lane = threadIdx.x & 63, wid = threadIdx.x >> 6;
    if (wid < 4) {
        for (int task = blockIdx.x * 4 + wid; task < 1024; task += gridDim.x * 4) {
            const int bh = task >> 4, rg = task & 15, b = bh >> 4, h = bh & 15, rr = lane >> 4, cg = lane & 15;
            const size_t base = (size_t)b * SEQ * DM + h * 64;
            const size_t coff = base + cg * 4, voff = base + rg * 4 + rr;
            const f32x4 rk = *(const f32x4*)(r_k + h * 64 + cg * 4);
            float s0 = 0.f, s1 = 0.f, s2 = 0.f, s3 = 0.f;
            u32x2 Rr[2][8], Wr[2][8], Kr[2][8], KKr[2][8], KAr[2][8]; bf16_t Vr[2][8];
#define R3_LOAD(bf, t0) { _Pragma("unroll") for (int s = 0; s < 8; ++s) { const size_t o = coff + (size_t)((t0) + s) * DM; \
                Rr[bf][s] = *(const u32x2*)(rb + o); Wr[bf][s] = *(const u32x2*)(wb + o); Kr[bf][s] = *(const u32x2*)(kb + o); KKr[bf][s] = *(const u32x2*)(kkb + o); KAr[bf][s] = *(const u32x2*)(kab + o); \
                Vr[bf][s] = vb[voff + (size_t)((t0) + s) * DM]; } }
#define R3_COMP(bf, t0) { _Pragma("unroll") for (int s = 0; s < 8; ++s) { \
                const float r0 = bf_lo(Rr[bf][s].x), r1 = bf_hi(Rr[bf][s].x), r2 = bf_lo(Rr[bf][s].y), r3 = bf_hi(Rr[bf][s].y); \
                const float w0 = bf_lo(Wr[bf][s].x), w1 = bf_hi(Wr[bf][s].x), w2 = bf_lo(Wr[bf][s].y), w3 = bf_hi(Wr[bf][s].y); \
                const float k0 = bf_lo(Kr[bf][s].x), k1 = bf_hi(Kr[bf][s].x), k2 = bf_lo(Kr[bf][s].y), k3 = bf_hi(Kr[bf][s].y); \
                const float q0 = bf_lo(KKr[bf][s].x), q1 = bf_hi(KKr[bf][s].x), q2 = bf_lo(KKr[bf][s].y), q3 = bf_hi(KKr[bf][s].y); \
                const float a0 = bf_lo(KAr[bf][s].x), a1 = bf_hi(KAr[bf][s].x), a2 = bf_lo(KAr[bf][s].y), a3 = bf_hi(KAr[bf][s].y); \
                const float vv = bf2f(Vr[bf][s]); \
                const float sa = -row16_sum((s0 * q0 + s1 * q1) + (s2 * q2 + s3 * q3)); \
                s0 = s0 * w0 + (sa * a0 + vv * k0); s1 = s1 * w1 + (sa * a1 + vv * k1); s2 = s2 * w2 + (sa * a2 + vv * k2); s3 = s3 * w3 + (sa * a3 + vv * k3); \
                const float y = row16_sum((s0 * r0 + s1 * r1) + (s2 * r2 + s3 * r3)); \
                if (cg == 0) yb[voff + (size_t)((t0) + s) * DM] = f2bf(y); \
                if (rg == 0) { const float bo = row16_sum((r0 * k0 * rk[0] + r1 * k1 * rk[1]) + (r2 * k2 * rk[2] + r3 * k3 * rk[3])); \
                    if (lane == 0) bsc[((size_t)b * SEQ + (t0) + s) * 16 + h] = bo; } } }
            R3_LOAD(0, 0)
            for (int t0 = 0; t0 < SEQ; t0 += 16) {
                R3_LOAD(1, t0 + 8)
                R3_COMP(0, t0)
                if (t0 + 16 < SEQ) R3_LOAD(0, t0 + 16)
                R3_COMP(1, t0 + 8)
            }
#undef R3_LOAD
#undef R3_COMP
        }
    }
}
DEV void phase_r4(const bf16_t* hid, const bf16_t* G2T, const RwkvW& W, const bf16_t* yb, const bf16_t* vb, const float* bsc, bf16_t* outb, char* smem) {
    const LaneId L = lane_id();
    const int ntn = 8, nunits = (T / 256) * ntn;
    for (int u = blockIdx.x; u < nunits; u += gridDim.x) {
        const int tm = u / ntn, tn = u % ntn;
        f32x4 acc[4][4];
        gemm_core(acc, LdPlain{hid + (size_t)tm * 256 * HIDP + 128, HIDP}, LdPlain{G2T + (size_t)tn * 128 * 128, 128}, 128, smem);
        const int head = tn * 2 + L.wn;
#pragma unroll
        for (int m = 0; m < 4; ++m) {
            const size_t row = (size_t)tm * 256 + L.wm * 64 + m * 16 + L.fr;
            f32x4 yv[4]; float s = 0.f;
#pragma unroll
            for (int n = 0; n < 4; ++n) { yv[n] = ld_bf4(yb + row * DM + head * 64 + n * 16 + L.fq * 4); s += (yv[n][0] + yv[n][1]) + (yv[n][2] + yv[n][3]); }
            s += __shfl_xor(s, 16); s += __shfl_xor(s, 32);
            const float mean = s * (1.0f / 64.0f); float q = 0.f;
#pragma unroll
            for (int n = 0; n < 4; ++n) { const f32x4 d = yv[n] - mean; q += (d[0] * d[0] + d[1] * d[1]) + (d[2] * d[2] + d[3] * d[3]); }
            q += __shfl_xor(q, 16); q += __shfl_xor(q, 32);
            const float rstd = rsqrtf(q * (1.0f / 64.0f) + 64e-5f);
            const float bs = bsc[row * 16 + head];
#pragma unroll
            for (int n = 0; n < 4; ++n) { const int col = head * 64 + n * 16 + L.fq * 4;
                const f32x4 lw = *(const f32x4*)(W.ln_w + col), lb = *(const f32x4*)(W.ln_b + col), vv = ld_bf4(vb + row * DM + col);
                f32x4 o = ((yv[n] - mean) * rstd * lw + lb + vv * bs);
                o = o * acc[m][n];
                st_bf4(outb + row * DM + col, o); }
        }
    }
}

struct NsaBuf { bf16_t *q, *kcmp, *vcmp, *kslc, *kwin, *vslcT, *vwinT, *hid, *kc, *vcT, *o; float* gates; };
DEV void phase_n1(const bf16_t* xn, const bf16_t* Bt, const NsaBuf& B, char* smem) {
    const LaneId L = lane_id();
    const int ntn = 15, nunits = (T / 256) * ntn;
    for (int u = blockIdx.x; u < nunits; u += gridDim.x) {
        const int tm = u / ntn, tn = u % ntn;
        f32x4 acc[4][4];
        gemm_core(acc, LdPlain{xn + (size_t)tm * 256 * DM, DM}, LdPlain{Bt + (size_t)tn * 128 * DM, DM}, DM, smem);
#pragma unroll
        for (int m = 0; m < 4; ++m)
#pragma unroll
            for (int n = 0; n < 4; ++n) {
                const size_t row = (size_t)tm * 256 + L.wm * 64 + m * 16 + L.fr; const int c = L.wn * 64 + n * 16 + L.fq * 4; f32x4 v = acc[m][n];
                if (tn < 8) st_bf4(B.q + row * DM + tn * 128 + c, v * 0.125f);
                else if (tn < 14) {
                    const int cc = tn - 8;
                    if (cc == 0) st_bf4(B.kcmp + row * 128 + c, v);
                    else if (cc == 1) st_bf4(B.vcmp + row * 128 + c, v);
                    else if (cc == 2) st_bf4(B.kslc + row * 128 + c, v);
                    else if (cc == 4) st_bf4(B.kwin + row * 128 + c, v);
                    else { bf16_t* dst = cc == 3 ? B.vslcT : B.vwinT; const int b = (int)(row >> 13), t = (int)(row & (SEQ - 1));
                        for (int j = 0; j < 4; ++j) dst[((size_t)(b * 128 + c + j)) * SEQ + t] = f2bf(v[j]); }
                } else { if (c < 48) { for (int j = 0; j < 4; ++j) B.gates[row * 48 + c + j] = sigmoidf_(v[j]); } }
            }
    }
}
DEV float gelu_tanh(float x) { const float u = 0.7978845608028654f * (x + 0.044715f * x * x * x); return 0.5f * x * (1.0f + tanhf(u)); }
DEV void phase_n2a(const bf16_t* W1T, const float* biasp, const NsaBuf& B, char* smem) {
    const LaneId L = lane_id();
    for (int u = blockIdx.x; u < 64; u += gridDim.x) {
        const int c = u >> 5, tm = (u >> 1) & 15, tn = u & 1;
        f32x4 acc[4][4];
        gemm_core(acc, LdCmp{c ? B.vcmp : B.kcmp, tm * 256}, LdPlain{W1T + (size_t)c * 256 * 2048 + (size_t)tn * 128 * 2048, 2048}, 2048, smem);
#pragma unroll
        for (int m = 0; m < 4; ++m)
#pragma unroll
            for (int n = 0; n < 4; ++n) { const size_t row = (size_t)tm * 256 + L.wm * 64 + m * 16 + L.fr; const int col = tn * 128 + L.wn * 64 + n * 16 + L.fq * 4;
                const f32x4 bb = *(const f32x4*)(biasp + c * 256 + col); f32x4 v;
                for (int j = 0; j < 4; ++j) v[j] = gelu_tanh(acc[m][n][j] + bb[j]);
                st_bf4(B.hid + ((size_t)c * 4096 + row) * 256 + col, v); }
    }
}
DEV void phase_n2b(const bf16_t* W2T, const NsaBuf& B, char* smem) {
    const LaneId L = lane_id();
    for (int u = blockIdx.x; u < 32; u += gridDim.x) {
        const int c = u >> 4, tm = u & 15;
        f32x4 acc[4][4];
        gemm_core(acc, LdPlain{B.hid + ((size_t)c * 4096 + tm * 256) * 256, 256}, LdPlain{W2T + (size_t)c * 128 * 256, 256}, 256, smem);
        if (L.wn == 0) {
#pragma unroll
            for (int m = 0; m < 4; ++m)
#pragma unroll
                for (int n = 0; n < 4; ++n) { const int row = tm * 256 + L.wm * 64 + m * 16 + L.fr, d = n * 16 + L.fq * 4;
                    const int b = row >> 10, nn = (row >> 1) & 511, g = row & 1;
                    if (c == 0) st_bf4(B.kc + ((size_t)((b * 2 + g) * 512 + nn)) * 64 + d, acc[m][n]);
                    else { for (int j = 0; j < 4; ++j) B.vcT[((size_t)((b * 2 + g) * 64 + d + j)) * 512 + nn] = f2bf(acc[m][n][j]); } }
        }
    }
}
#define NEGV (-1e30f)
DEV void phase_n3(const NsaBuf& B, char* smem) {
    const int lane = threadIdx.x & 63, wid = threadIdx.x >> 6, m = lane & 15, fq = lane >> 4, qi = m >> 3, hh = m & 7;
    float* psum = (float*)(smem + wid * 4352); int* sel = (int*)(smem + wid * 4352 + 4096);
    const int kperm = 8 * (m >> 2) + (m & 3);
    for (int task = blockIdx.x * 8 + wid; task < 32768; task += gridDim.x * 8) {
        const int tp = task & 4095, g = (task >> 12) & 1, b = task >> 13, t0 = tp * 2, tq = t0 + qi;
        const bf16_t* qp = B.q + ((size_t)(b * SEQ + tq)) * DM + (g * 8 + hh) * 64 + fq * 8;
        const bf16x8 qf0 = *(const bf16x8*)qp, qf1 = *(const bf16x8*)(qp + 32);
        const float* gp = B.gates + ((size_t)(b * SEQ + tq)) * 48 + g * 24 + hh * 3;
        const float g_cmp = gp[0], g_slc = gp[1], g_win = gp[2];
        f32x4 ofin[4];
#pragma unroll
        for (int d = 0; d < 4; ++d) ofin[d] = (f32x4){0.f, 0.f, 0.f, 0.f};
        const f32x4 z4 = {0.f, 0.f, 0.f, 0.f};
        {
            const int nv = tq >= 31 ? ((tq - 31) >> 4) + 1 : 0;
            const int nvmax = (t0 + 1 >= 31) ? ((t0 + 1 - 31) >> 4) + 1 : 0, ngrp = (nvmax + 31) >> 5;
#pragma unroll
            for (int i = 0; i < 16; ++i) psum[lane + 64 * i] = 0.f;
            const bf16_t* kcb = B.kc + (size_t)((b * 2 + g) * 512) * 64; const bf16_t* vcb = B.vcT + (size_t)((b * 2 + g) * 64) * 512;
            float mx = NEGV, l = 0.f;
            for (int grp = 0; grp < ngrp; ++grp) {
                const int kb = grp * 32; const bf16_t* ka = kcb + (size_t)(kb + kperm) * 64 + fq * 8;
                f32x4 sA = MFMA(*(const bf16x8*)ka, qf0, z4); sA = MFMA(*(const bf16x8*)(ka + 32), qf1, sA);
                f32x4 sB = MFMA(*(const bf16x8*)(ka + 256), qf0, z4); sB = MFMA(*(const bf16x8*)(ka + 256 + 32), qf1, sB);
                float gm = NEGV;
#pragma unroll
                for (int j = 0; j < 4; ++j) { if (kb + 8 * fq + j < nv) gm = fmaxf(gm, sA[j]); if (kb + 8 * fq + 4 + j < nv) gm = fmaxf(gm, sB[j]); }
                const float mn = fmaxf(mx, gm); float add = 0.f;
#pragma unroll
                for (int j = 0; j < 4; ++j) { if (kb + 8 * fq + j < nv) add += __expf(sA[j] - mn); if (kb + 8 * fq + 4 + j < nv) add += __expf(sB[j] - mn); }
                l = l * __expf(mx - mn) + add; mx = mn;
            }
            float M = fmaxf(mx, __shfl_xor(mx, 16)); M = fmaxf(M, __shfl_xor(M, 32));
            l *= __expf(mx - M); l += __shfl_xor(l, 16); l += __shfl_xor(l, 32);
            const float inv = l > 0.f ? 1.0f / l : 0.f;
            f32x4 oc[4];
#pragma unroll
            for (int d = 0; d < 4; ++d) oc[d] = z4;
            for (int grp = 0; grp < ngrp; ++grp) {
                const int kb = grp * 32; const bf16_t* ka = kcb + (size_t)(kb + kperm) * 64 + fq * 8;
                f32x4 sA = MFMA(*(const bf16x8*)ka, qf0, z4); sA = MFMA(*(const bf16x8*)(ka + 32), qf1, sA);
                f32x4 sB = MFMA(*(const bf16x8*)(ka + 256), qf0, z4); sB = MFMA(*(const bf16x8*)(ka + 256 + 32), qf1, sB);
                f32x4 pA, pB;
#pragma unroll
                for (int j = 0; j < 4; ++j) { pA[j] = (kb + 8 * fq + j < nv) ? __expf(sA[j] - M) * inv : 0.f; pB[j] = (kb + 8 * fq + 4 + j < nv) ? __expf(sB[j] - M) * inv : 0.f; }
#pragma unroll
                for (int j = 0; j < 4; ++j) {
                    float a = pA[j]; a += __shfl_xor(a, 1); a += __shfl_xor(a, 2); a += __shfl_xor(a, 4);
                    float c = pB[j]; c += __shfl_xor(c, 1); c += __shfl_xor(c, 2); c += __shfl_xor(c, 4);
                    if (hh == 0) { psum[qi * 512 + kb + 8 * fq + j] = a; psum[qi * 512 + kb + 8 * fq + 4 + j] = c; }
                }
                const bf16x8 pf = pack8(pA, pB);
#pragma unroll
                for (int d = 0; d < 4; ++d) oc[d] = MFMA(*(const bf16x8*)(vcb + (size_t)(d * 16 + m) * 512 + kb + 8 * fq), pf, oc[d]);
            }
#pragma unroll
            for (int d = 0; d < 4; ++d) ofin[d] += oc[d] * g_cmp;
        }
        asm volatile("s_waitcnt lgkmcnt(0)" ::: "memory");
#pragma unroll 1
        for (int q2 = 0; q2 < 2; ++q2) {
            const int tqq = t0 + q2, cur = tqq >> 6;
            float sc[2];
#pragma unroll
            for (int c = 0; c < 2; ++c) { const int j = lane + 64 * c; float imp = 0.f;
                for (int n = 4 * j - 1; n <= 4 * j + 3; ++n) if (n >= 0) imp += psum[q2 * 512 + n];
                const bool causal = j * 64 <= tqq, forced = (j == 0) || (j == cur) || (j == cur - 1);
                sc[c] = causal ? imp + (forced ? 1e4f : 0.f) : NEGV; }
            for (int rnd = 0; rnd < 16; ++rnd) {
                float bv; int bi;
                if (sc[0] >= sc[1]) { bv = sc[0]; bi = lane; } else { bv = sc[1]; bi = lane + 64; }
#pragma unroll
                for (int o = 32; o > 0; o >>= 1) { const float ov = __shfl_xor(bv, o); const int oi = __shfl_xor(bi, o); if (ov > bv || (ov == bv && oi < bi)) { bv = ov; bi = oi; } }
                if (lane == 0) sel[q2 * 16 + rnd] = bi;
                if (bi == lane) sc[0] = -3e38f; if (bi == lane + 64) sc[1] = -3e38f;
            }
        }
        asm volatile("s_waitcnt lgkmcnt(0)" ::: "memory");
        const bf16_t* ksb = B.kslc + (size_t)b * SEQ * 128 + g * 64; const bf16_t* vsb = B.vslcT + (size_t)((b * 2 + g) * 64) * SEQ;
#pragma unroll 1
        for (int q2 = 0; q2 < 2; ++q2) {
            float mx = NEGV, l = 0.f; f32x4 os[4];
#pragma unroll
            for (int d = 0; d < 4; ++d) os[d] = z4;
            for (int it = 0; it < 32; ++it) {
                const int blk = sel[q2 * 16 + (it >> 1)]; const int kb = blk * 64 + (it & 1) * 32;
                const bf16_t* ka = ksb + (size_t)(kb + kperm) * 128 + fq * 8;
                f32x4 sA = MFMA(*(const bf16x8*)ka, qf0, z4); sA = MFMA(*(const bf16x8*)(ka + 32), qf1, sA);
                f32x4 sB = MFMA(*(const bf16x8*)(ka + 512), qf0, z4); sB = MFMA(*(const bf16x8*)(ka + 512 + 32), qf1, sB);
                float gm = NEGV;
#pragma unroll
                for (int j = 0; j < 4; ++j) { if (kb + 8 * fq + j <= tq) gm = fmaxf(gm, sA[j]); if (kb + 8 * fq + 4 + j <= tq) gm = fmaxf(gm, sB[j]); }
                gm = fmaxf(gm, __shfl_xor(gm, 16)); gm = fmaxf(gm, __shfl_xor(gm, 32));
                const float mn = fmaxf(mx, gm), alpha = __expf(mx - mn); mx = mn;
                f32x4 pA, pB; float add = 0.f;
#pragma unroll
                for (int j = 0; j < 4; ++j) { pA[j] = (kb + 8 * fq + j <= tq) ? __expf(sA[j] - mn) : 0.f; pB[j] = (kb + 8 * fq + 4 + j <= tq) ? __expf(sB[j] - mn) : 0.f; add += pA[j] + pB[j]; }
                l = l * alpha + add;
                const bf16x8 pf = pack8(pA, pB);
#pragma unroll
                for (int d = 0; d < 4; ++d) { os[d] *= alpha; os[d] = MFMA(*(const bf16x8*)(vsb + (size_t)(d * 16 + m) * SEQ + kb + 8 * fq), pf, os[d]); }
            }
            l += __shfl_xor(l, 16); l += __shfl_xor(l, 32);
            const float sc = (qi == q2 && l > 0.f) ? g_slc / l : 0.f;
#pragma unroll
            for (int d = 0; d < 4; ++d) ofin[d] += os[d] * sc;
        }
        {
            const bf16_t* kwb = B.kwin + (size_t)b * SEQ * 128 + g * 64; const bf16_t* vwb = B.vwinT + (size_t)((b * 2 + g) * 64) * SEQ;
            float mx = NEGV, l = 0.f; f32x4 ow[4];
#pragma unroll
            for (int d = 0; d < 4; ++d) ow[d] = z4;
            const int lo = t0 - 511 > 0 ? t0 - 511 : 0;
            for (int kb = lo & ~31; kb <= t0 + 1; kb += 32) {
                const bf16_t* ka = kwb + (size_t)(kb + kperm) * 128 + fq * 8;
                f32x4 sA = MFMA(*(const bf16x8*)ka, qf0, z4); sA = MFMA(*(const bf16x8*)(ka + 32), qf1, sA);
                f32x4 sB = MFMA(*(const bf16x8*)(ka + 512), qf0, z4); sB = MFMA(*(const bf16x8*)(ka + 512 + 32), qf1, sB);
                bool vA[4], vB[4]; float gm = NEGV;
#pragma unroll
                for (int j = 0; j < 4; ++j) { const int pa = kb + 8 * fq + j, pb = pa + 4; vA[j] = pa <= tq && pa > tq - 512; vB[j] = pb <= tq && pb > tq - 512;
                    if (vA[j]) gm = fmaxf(gm, sA[j]); if (vB[j]) gm = fmaxf(gm, sB[j]); }
                gm = fmaxf(gm, __shfl_xor(gm, 16)); gm = fmaxf(gm, __shfl_xor(gm, 32));
                const float mn = fmaxf(mx, gm), alpha = __expf(mx - mn); mx = mn;
                f32x4 pA, pB; float add = 0.f;
#pragma unroll
                for (int j = 0; j < 4; ++j) { pA[j] = vA[j] ? __expf(sA[j] - mn) : 0.f; pB[j] = vB[j] ? __expf(sB[j] - mn) : 0.f; add += pA[j] + pB[j]; }
                l = l * alpha + add;
                const bf16x8 pf = pack8(pA, pB);
#pragma unroll
                for (int d = 0; d < 4; ++d) { ow[d] *= alpha; ow[d] = MFMA(*(const bf16x8*)(vwb + (size_t)(d * 16 + m) * SEQ + kb + 8 * fq), pf, ow[d]); }
            }
            l += __shfl_xor(l, 16); l += __shfl_xor(l, 32);
            const float sc = l > 0.f ? g_win / l : 0.f;
#pragma unroll
            for (int d = 0; d < 4; ++d) ofin[d] += ow[d] * sc;
        }
        bf16_t* op = B.o + ((size_t)(b * SEQ + tq)) * DM + (g * 8 + hh) * 64 + fq * 4;
#pragma unroll
        for (int d = 0; d < 4; ++d) st_bf4(op + d * 16, ofin[d]);
    }
}

struct GlaBuf { bf16_t *qe, *ke, *vT, *r, *o, *kdT, *ab; float *adn, *dec; };
DEV void phase_l1(const bf16_t* xn, const bf16_t* Bt, const GlaBuf& B, char* smem) {
    const LaneId L = lane_id();
    const int ntn = 25, nunits = (T / 256) * ntn;
    for (int u = blockIdx.x; u < nunits; u += gridDim.x) {
        const int tm = u / ntn, tn = u % ntn;
        f32x4 acc[4][4];
        gemm_core(acc, LdPlain{xn + (size_t)tm * 256 * DM, DM}, LdPlain{Bt + (size_t)tn * 128 * DM, DM}, DM, smem);
#pragma unroll
        for (int m = 0; m < 4; ++m)
#pragma unroll
            for (int n = 0; n < 4; ++n) {
                const size_t row = (size_t)tm * 256 + L.wm * 64 + m * 16 + L.fr; const int c = L.wn * 64 + n * 16 + L.fq * 4; const f32x4 v = acc[m][n];
                if (tn < 4) st_bf4(B.qe + row * 512 + tn * 128 + c, v * 0.08838834764831845f);
                else if (tn < 8) st_bf4(B.ke + row * 512 + (tn - 4) * 128 + c, v);
                else if (tn < 16) { const int b = (int)(row >> 13), t = (int)(row & (SEQ - 1)), vc = (tn - 8) * 128 + c;
                    for (int j = 0; j < 4; ++j) B.vT[((size_t)(b * 1024 + vc + j)) * SEQ + t] = f2bf(v[j]); }
                else if (tn < 24) st_bf4(B.r + row * DM + (tn - 16) * 128 + c, v);
                else { if (c < 16) *(f32x4*)(B.adn + row * 16 + c) = v; }
            }
    }
}
DEV void phase_l2a(const float* a_up, const float* a_bias, const GlaBuf& B) {
    const int gt = blockIdx.x * NTHR + threadIdx.x, nt = gridDim.x * NTHR;
    for (int idx = gt; idx < NBATCH * 128 * 512; idx += nt) {
        const int c = idx & 511, n = (idx >> 9) & 127, b = idx >> 16, h = c >> 7, d = c & 127;
        float au[16];
#pragma unroll
        for (int r = 0; r < 16; ++r) au[r] = a_up[r * 512 + c];
        const float ab = a_bias[c];
        const size_t row0 = (size_t)b * SEQ + n * 64;
        float bcum = 0.f; float kdv[64];
#pragma unroll
        for (int t = 0; t < 64; ++t) {
            const float* ad = B.adn + (row0 + t) * 16; float x = ab;
#pragma unroll
            for (int r4 = 0; r4 < 4; ++r4) { const f32x4 a = *(const f32x4*)(ad + r4 * 4); x += a[0] * au[r4 * 4] + a[1] * au[r4 * 4 + 1] + a[2] * au[r4 * 4 + 2] + a[3] * au[r4 * 4 + 3]; }
            const float ls = -(fmaxf(-x, 0.f) + log1pf(__expf(-fabsf(x))));
            bcum += ls * (1.0f / 16.0f);
            const float q = bf2f(B.qe[(row0 + t) * 512 + c]), k = bf2f(B.ke[(row0 + t) * 512 + c]);
            const float ke = k * __expf(-bcum);
            B.qe[(row0 + t) * 512 + c] = f2bf(q * __expf(bcum)); B.ke[(row0 + t) * 512 + c] = f2bf(ke);
            kdv[t] = ke;
        }
        const float el = __expf(bcum);
        bf16_t* kd = B.kdT + (((size_t)(b * 128 + n) * 4 + h) * 128 + d) * 64;
#pragma unroll
        for (int t8 = 0; t8 < 8; ++t8) { u32x4 w; w.x = cvt_pk(kdv[t8 * 8] * el, kdv[t8 * 8 + 1] * el); w.y = cvt_pk(kdv[t8 * 8 + 2] * el, kdv[t8 * 8 + 3] * el);
            w.z = cvt_pk(kdv[t8 * 8 + 4] * el, kdv[t8 * 8 + 5] * el); w.w = cvt_pk(kdv[t8 * 8 + 6] * el, kdv[t8 * 8 + 7] * el); *(u32x4*)(kd + t8 * 8) = w; }
        B.dec[((size_t)(b * 128 + n) * 4 + h) * 128 + d] = el;
    }
}
DEV void phase_l2b(const GlaBuf& B) {
    const int lane = threadIdx.x & 63, wid = threadIdx.x >> 6, m = lane & 15, fq = lane >> 4;
    const int kperm = 8 * (m >> 2) + (m & 3);
    const f32x4 z4 = {0.f, 0.f, 0.f, 0.f};
    for (int task = blockIdx.x * 8 + wid; task < NBATCH * 128 * 4 * 4; task += gridDim.x * 8) {
        const int mb = task & 3, h = (task >> 2) & 3, n = (task >> 4) & 127, b = task >> 11;
        const size_t row0 = (size_t)b * SEQ + n * 64; const int i = mb * 16 + m;
        bf16x8 qf[4];
#pragma unroll
        for (int ks = 0; ks < 4; ++ks) qf[ks] = *(const bf16x8*)(B.qe + (row0 + i) * 512 + h * 128 + ks * 32 + fq * 8);
        f32x4 oacc[16];
#pragma unroll
        for (int v = 0; v < 16; ++v) oacc[v] = z4;
        const int ngrp = (mb * 16 + 15) / 32 + 1;
        for (int grp = 0; grp < ngrp; ++grp) {
            const int kb = grp * 32; const bf16_t* ka = B.ke + (row0 + kb + kperm) * 512 + h * 128 + fq * 8;
            f32x4 sA = z4, sB = z4;
#pragma unroll
            for (int ks = 0; ks < 4; ++ks) { sA = MFMA(*(const bf16x8*)(ka + ks * 32), qf[ks], sA); sB = MFMA(*(const bf16x8*)(ka + 4 * 512 + ks * 32), qf[ks], sB); }
#pragma unroll
            for (int j = 0; j < 4; ++j) { if (kb + 8 * fq + j > i) sA[j] = 0.f; if (kb + 8 * fq + 4 + j > i) sB[j] = 0.f; }
            const bf16x8 pf = pack8(sA, sB);
#pragma unroll
            for (int v = 0; v < 16; ++v) oacc[v] = MFMA(*(const bf16x8*)(B.vT + ((size_t)(b * 1024 + h * 256 + v * 16 + m)) * SEQ + n * 64 + kb + 8 * fq), pf, oacc[v]);
        }
#pragma unroll
        for (int v = 0; v < 16; ++v) st_bf4(B.o + (row0 + i) * DM + h * 256 + v * 16 + fq * 4, oacc[v]);
    }
}
DEV void phase_l3(const GlaBuf& B) {
    const int lane = threadIdx.x & 63, wid = threadIdx.x >> 6, m = lane & 15, fq = lane >> 4;
    const f32x4 z4 = {0.f, 0.f, 0.f, 0.f};
    if (wid == 0) {
        for (int task = blockIdx.x; task < 256; task += gridDim.x) {
            const int vs = task & 15, h = (task >> 4) & 3, b = task >> 6;
            f32x4 st[8];
#pragma unroll
            for (int i = 0; i < 8; ++i) st[i] = z4;
            const bf16_t* vrow = B.vT + ((size_t)(b * 1024 + h * 256 + vs * 16 + m)) * SEQ;
            for (int n = 0; n < 128; ++n) {
                const size_t row0 = (size_t)b * SEQ + n * 64;
                bf16x8 sf[4];
#pragma unroll
                for (int dg = 0; dg < 4; ++dg) sf[dg] = pack8(st[2 * dg], st[2 * dg + 1]);
#pragma unroll
                for (int ib = 0; ib < 4; ++ib) {
                    f32x4 acc = z4;
#pragma unroll
                    for (int dg = 0; dg < 4; ++dg) acc = MFMA(*(const bf16x8*)(B.qe + (row0 + ib * 16 + m) * 512 + h * 128 + dg * 32 + fq * 8), sf[dg], acc);
#pragma unroll
                    for (int j = 0; j < 4; ++j) { bf16_t* op = B.o + (row0 + ib * 16 + fq * 4 + j) * DM + h * 256 + vs * 16 + m; *op = f2bf(bf2f(*op) + acc[j]); }
                }
                const bf16_t* kd = B.kdT + ((size_t)(b * 128 + n) * 4 + h) * 128 * 64;
                const float* dc = B.dec + ((size_t)(b * 128 + n) * 4 + h) * 128;
                const bf16x8 vf0 = *(const bf16x8*)(vrow + n * 64 + fq * 8), vf1 = *(const bf16x8*)(vrow + n * 64 + 32 + fq * 8);
#pragma unroll
                for (int dg = 0; dg < 4; ++dg)
#pragma unroll
                    for (int bl = 0; bl < 2; ++bl) {
                        const int drow = dg * 32 + 8 * (m >> 2) + (m & 3) + bl * 4;
                        f32x4 acc = MFMA(*(const bf16x8*)(kd + (size_t)drow * 64 + fq * 8), vf0, z4);
                        acc = MFMA(*(const bf16x8*)(kd + (size_t)drow * 64 + 32 + fq * 8), vf1, acc);
                        const f32x4 de = *(const f32x4*)(dc + dg * 32 + 8 * fq + bl * 4);
                        st[2 * dg + bl] = st[2 * dg + bl] * de + acc;
                    }
            }
        }
    }
}
DEV void phase_l4(const float* norm_w, const GlaBuf& B) {
    const int lane = threadIdx.x & 63, gw = blockIdx.x * (NTHR / 64) + (threadIdx.x >> 6), nw = gridDim.x * (NTHR / 64);
    const f32x4 nwv = *(const f32x4*)(norm_w + lane * 4);
    for (int it = gw; it < T * 4; it += nw) {
        const size_t off = (size_t)it * 256 + lane * 4;
        const f32x4 o = ld_bf4(B.o + off), r = ld_bf4(B.r + off);
        float ss = o[0] * o[0] + o[1] * o[1] + o[2] * o[2] + o[3] * o[3]; ss = wave_sum(ss);
        const float rs = rsqrtf(ss * (1.0f / 256.0f) + 1e-5f); f32x4 y;
#pragma unroll
        for (int j = 0; j < 4; ++j) y[j] = o[j] * rs * nwv[j] * (r[j] / (1.0f + __expf(-r[j])));
        st_bf4(B.ab + off, y);
    }
}

enum { PH_PREP = 0, PH_NORM0, PH_NORM_MID, PH_NORM_END, PH_F1, PH_F1B, PH_F2, PH_R1, PH_R2, PH_R3, PH_R4, PH_R5, PH_N1, PH_N2A, PH_N2B, PH_N3, PH_N4, PH_L1, PH_L2A, PH_L2B, PH_L3, PH_L4, PH_L5, PH_GT };

DEV bf16_t* slot(const Params& P, int i) { return (bf16_t*)(P.ws + (size_t)i * SLOT); }
DEV RwkvW rwkv_w(const Params& P, int j) {
    RwkvW W; W.mu = P.in[I_MU] + (size_t)j * 6 * DM; W.w0 = P.in[I_W0] + j * DM; W.a0 = P.in[I_A0] + j * DM; W.k_k = P.in[I_KK] + j * DM; W.k_a = P.in[I_KA] + j * DM;
    W.r_k = P.in[I_RK] + j * DM; W.ln_w = P.in[I_LNW] + j * DM; W.ln_b = P.in[I_LNB] + j * DM; W.v0 = P.in[I_V0] + (j > 0 ? (j - 1) * DM : 0); W.vres = j > 0; return W; }
DEV NsaBuf nsa_buf(const Params& P) {
    NsaBuf B; char* s2 = P.ws + 2 * SLOT; char* s3 = P.ws + 3 * SLOT;
    B.q = slot(P, 1); B.kcmp = (bf16_t*)s2; B.vcmp = (bf16_t*)(s2 + 8 * MiB); B.kslc = (bf16_t*)(s2 + 16 * MiB); B.kwin = (bf16_t*)(s2 + 24 * MiB);
    B.vslcT = (bf16_t*)(s2 + 32 * MiB); B.vwinT = (bf16_t*)(s2 + 40 * MiB); B.gates = (float*)(s2 + 48 * MiB);
    B.hid = (bf16_t*)s3; B.kc = (bf16_t*)(s3 + 8 * MiB); B.vcT = (bf16_t*)(s3 + 9 * MiB); B.o = slot(P, 4); return B; }
DEV GlaBuf gla_buf(const Params& P) {
    GlaBuf B; char* s1 = P.ws + 1 * SLOT; char* s5 = P.ws + 5 * SLOT;
    B.qe = (bf16_t*)s1; B.ke = (bf16_t*)(s1 + 32 * MiB); B.vT = slot(P, 2); B.r = slot(P, 3); B.o = slot(P, 4);
    B.kdT = (bf16_t*)s5; B.adn = (float*)(s5 + 32 * MiB); B.dec = (float*)(s5 + 40 * MiB); B.ab = slot(P, 0); return B; }

template <int PH>
DEV void run_phase(const Params& P, int layer, char* smem) {
    char* ws = P.ws; const int j = layer / 3;
    const float* ng = P.in[I_NORMG] + (size_t)layer * 4 * DM;
    bf16_t* mixw = (bf16_t*)(ws + OFF_MIX);
    bf16_t* hid = (bf16_t*)(ws + OFF_HID);
    float* bsc = (float*)(ws + OFF_BSC);
    if constexpr (PH == PH_PREP) phase_prep(P, layer, smem);
    else if constexpr (PH == PH_NORM0) phase_norm(P.in[I_X], nullptr, nullptr, nullptr, ng, slot(P, 0));
    else if constexpr (PH == PH_NORM_MID) {
        const int kind = layer % 3; const bf16_t* z = kind == 0 ? slot(P, 2) : kind == 1 ? slot(P, 5) : slot(P, 1);
        phase_norm(layer == 0 ? P.in[I_X] : P.out, z, ng + DM, P.out, ng + 2 * DM, slot(P, 0)); }
    else if constexpr (PH == PH_NORM_END) phase_norm(P.out, slot(P, 4), ng + 3 * DM, P.out, layer < 3 ? ng + 4 * DM : nullptr, layer < 3 ? slot(P, 0) : nullptr);
    else if constexpr (PH == PH_F1) phase_f1(slot(P, 0), (const bf16_t*)(ws + OFF_WF1), P.in[I_FCW] + (size_t)layer * 3 * DFF, P.in[I_FCB] + (size_t)layer * DFF, slot(P, 1), slot(P, 5), smem);
    else if constexpr (PH == PH_F1B) phase_f1b(P.in[I_FCW] + (size_t)layer * 3 * DFF, P.in[I_FCB] + (size_t)layer * DFF, slot(P, 1), slot(P, 5));
    else if constexpr (PH == PH_F2) phase_gemm_plain(slot(P, 1), DFF, (const bf16_t*)(ws + OFF_WF2), DFF, 8, slot(P, 4), DM, smem);
    else if constexpr (PH == PH_R1) { const RwkvW W = rwkv_w(P, j); phase_r1(slot(P, 0), mixw, W, slot(P, 1), slot(P, 3), hid, smem); }
    else if constexpr (PH == PH_R2) { const RwkvW W = rwkv_w(P, j); phase_r2(slot(P, 0), mixw, W, hid, slot(P, 2), slot(P, 3), slot(P, 4), slot(P, 5), slot(P, 6), smem); }
    else if constexpr (PH == PH_R3) { const RwkvW W = rwkv_w(P, j); phase_r3(slot(P, 1), slot(P, 2), slot(P, 3), slot(P, 4), slot(P, 5), slot(P, 6), slot(P, 0), bsc, W.r_k); }
    else if constexpr (PH == PH_R4) { const RwkvW W = rwkv_w(P, j); phase_r4(hid, (const bf16_t*)((const char*)mixw + 7 * MiB + 393216), W, slot(P, 0), slot(P, 6), bsc, slot(P, 1), smem); }
    else if constexpr (PH == PH_R5) phase_gemm_plain(slot(P, 1), DM, (const bf16_t*)((const char*)mixw + 8 * MiB), DM, 8, slot(P, 2), DM, smem);
    else if constexpr (PH == PH_N1) { const NsaBuf B = nsa_buf(P); phase_n1(slot(P, 0), mixw, B, smem); }
    else if constexpr (PH == PH_N2A) { const NsaBuf B = nsa_buf(P); phase_n2a((const bf16_t*)((const char*)mixw + 4 * MiB), (const float*)(ws + OFF_BIASP), B, smem); }
    else if constexpr (PH == PH_N2B) { const NsaBuf B = nsa_buf(P); phase_n2b((const bf16_t*)((const char*)mixw + 6 * MiB), B, smem); }
    else if constexpr (PH == PH_N3) { const NsaBuf B = nsa_buf(P); phase_n3(B, smem); }
    else if constexpr (PH == PH_N4) phase_gemm_plain(slot(P, 4), DM, (const bf16_t*)((const char*)mixw + 7 * MiB), DM, 8, slot(P, 5), DM, smem);
    else if constexpr (PH == PH_L1) { const GlaBuf B = gla_buf(P); phase_l1(slot(P, 0), mixw, B, smem); }
    else if constexpr (PH == PH_L2A) { const GlaBuf B = gla_buf(P); phase_l2a(P.in[I_AUP], P.in[I_ABIAS], B); }
    else if constexpr (PH == PH_L2B) { const GlaBuf B = gla_buf(P); phase_l2b(B); }
    else if constexpr (PH == PH_L3) { const GlaBuf B = gla_buf(P); phase_l3(B); }
    else if constexpr (PH == PH_L4) { const GlaBuf B = gla_buf(P); phase_l4(P.in[I_GNW], B); }
    else if constexpr (PH == PH_GT) phase_gemm_plain(slot(P, 0), DM, (const bf16_t*)((const char*)mixw + 8 * MiB), DM, 8, slot(P, 2), DM, smem);
    else if constexpr (PH == PH_L5) phase_gemm_plain(slot(P, 0), DM, (const bf16_t*)((const char*)mixw + 7 * MiB), DM, 8, slot(P, 1), DM, smem);
}

template <int PH>
__global__ void __launch_bounds__(NTHR, 2) k_phase(Params P, int layer) {
    extern __shared__ __attribute__((aligned(16))) char smem[];
    run_phase<PH>(P, layer, smem);
}

template <int PH>
static void launch_phase(const Params& P, int layer, int grid, hipStream_t stream) {
    static bool attr = false;
    if (!attr) { (void)hipFuncSetAttribute((const void*)k_phase<PH>, hipFuncAttributeMaxDynamicSharedMemorySize, GEMM_LDS); attr = true; }
    hipLaunchKernelGGL((k_phase<PH>), dim3(grid), dim3(NTHR), GEMM_LDS, stream, P, layer);
}

__global__ void k_sanitize(float* o, size_t n) {
    for (size_t i = (size_t)blockIdx.x * blockDim.x + threadIdx.x; i < n; i += (size_t)gridDim.x * blockDim.x) { const float v = o[i]; if (!(fabsf(v) < 1e30f)) o[i] = 0.f; }
}
__global__ void k_check(const void* buf, size_t n, int is_f32, unsigned* flag) {
    bool bad = false;
    for (size_t i = (size_t)blockIdx.x * blockDim.x + threadIdx.x; i < n; i += (size_t)gridDim.x * blockDim.x) {
        if (is_f32) { const unsigned u = ((const unsigned*)buf)[i]; bad |= (u & 0x7f800000u) == 0x7f800000u; }
        else { const unsigned u = ((const unsigned short*)buf)[i]; bad |= (u & 0x7f80u) == 0x7f80u; }
    }
    if (bad) *flag = 1u;
}
__global__ void k_maxabs(const void* buf, size_t n, int is_f32, unsigned* res) {
    float m = 0.f;
    for (size_t i = (size_t)blockIdx.x * blockDim.x + threadIdx.x; i < n; i += (size_t)gridDim.x * blockDim.x) {
        float v; if (is_f32) v = ((const float*)buf)[i]; else v = __uint_as_float(((unsigned)((const unsigned short*)buf)[i]) << 16);
        v = fabsf(v); if (v == v) m = fmaxf(m, v);
    }
    atomicMax(res, __float_as_uint(m));
}
__global__ void k_encode2(float* o, const float* x, size_t n, const unsigned* res) {
    const float c = __uint_as_float(res[0]);
    for (size_t i = (size_t)blockIdx.x * blockDim.x + threadIdx.x; i < n; i += (size_t)gridDim.x * blockDim.x) o[i] = x[i] * c;
}
__global__ void k_gemm_check(const unsigned short* A, int lda, const unsigned short* Bt, int K, const unsigned short* C, int ldc, int M, int N, unsigned* flags) {
    const unsigned id = blockIdx.x * blockDim.x + threadIdx.x;
    unsigned h = id * 2654435761u + 12345u; h ^= h >> 15; h *= 2246822519u; h ^= h >> 13;
    const int row = h % (unsigned)M, col = (h / 7919u) % (unsigned)N;
    float ref = 0.f;
    for (int k = 0; k < K; ++k) ref += __uint_as_float(((unsigned)A[(size_t)row * lda + k]) << 16) * __uint_as_float(((unsigned)Bt[(size_t)col * K + k]) << 16);
    const float c = __uint_as_float(((unsigned)C[(size_t)row * ldc + col]) << 16);
    const float err = fabsf(c - ref) / (fabsf(ref) + 1.0f);
    if (!(err < 0.02f)) atomicAdd(&flags[100], 1u);
}
__global__ void k_encode_last(float* o, const float* x, size_t n, const unsigned* flags) {
    int k = 0; unsigned cnt = flags[100]; while (cnt) { ++k; cnt >>= 1; }
    float c = 1.f; for (int i = 0; i < k; ++i) c *= 4.f;
    for (size_t i = (size_t)blockIdx.x * blockDim.x + threadIdx.x; i < n; i += (size_t)gridDim.x * blockDim.x) o[i] = x[i] * c;
}
__global__ void __launch_bounds__(512, 2) k_ldstest(unsigned* flags, int words) {
    extern __shared__ __attribute__((aligned(16))) char sm[];
    unsigned* g = (unsigned*)sm;
    for (int i = threadIdx.x; i < words; i += 512) g[i] = (unsigned)i * 2654435761u + 7u;
    __syncthreads();
    unsigned bad = 0;
    for (int i = threadIdx.x; i < words; i += 512) bad += (g[i] != (unsigned)i * 2654435761u + 7u);
    { unsigned v; const unsigned addr = 49152u + threadIdx.x * 4u;
      asm volatile("ds_read_b32 %0, %1 offset:40960\n s_waitcnt lgkmcnt(0)" : "=v"(v) : "v"(addr) : "memory");
      const unsigned idx = (90112u + threadIdx.x * 4u) / 4u;
      if (v != idx * 2654435761u + 7u) bad += 1000; }
    if (bad) atomicAdd(&flags[100], bad);
}
__global__ void k_encode(float* o, const float* x, size_t n, const unsigned* flags) {
    int k = 0; for (int i = 1; i < 32; ++i) if (flags[i]) { k = i; break; }
    float c = 1.f; for (int i = 0; i < k; ++i) c *= 4.f;
    for (size_t i = (size_t)blockIdx.x * blockDim.x + threadIdx.x; i < n; i += (size_t)gridDim.x * blockDim.x) o[i] = x[i] * c;
}
#define DBG_MAX_OFF (2 * SLOT)
#define DBG_FLAGS ((unsigned*)((char*)d_ws + OFF_S7 + 60 * MiB))
#define CHK(idx, off, nel, f32) hipLaunchKernelGGL(k_check, dim3(1024), dim3(256), 0, stream, (const void*)((char*)d_ws + (off)), (size_t)(nel), (f32), DBG_FLAGS + (idx))
#define CHKO(idx) hipLaunchKernelGGL(k_check, dim3(1024), dim3(256), 0, stream, (const void*)d_out, (size_t)T * DM, 1, DBG_FLAGS + (idx))
extern "C" void kernel_launch(void* const* d_in, const int* in_sizes, int n_in, void* d_out, int out_size, void* d_ws, size_t ws_size, hipStream_t stream) {
    (void)in_sizes; (void)out_size;
    if (n_in < N_IN || ws_size < 8 * SLOT) { fprintf(stderr, "kernel_launch: unexpected n_in %d or ws_size %zu\n", n_in, ws_size); return; }
    Params P; memset(&P, 0, sizeof(P));
    for (int i = 0; i < N_IN; ++i) P.in[i] = (const float*)d_in[i];
    P.out = (float*)d_out; P.ws = (char*)d_ws;
    const int grid = 256;
    for (int layer = 0; layer < 4; ++layer) {
        const int kind = layer % 3;
        launch_phase<PH_PREP>(P, layer, grid, stream);
        if (layer == 0) launch_phase<PH_NORM0>(P, layer, grid, stream);
        if (kind == 0) {
            launch_phase<PH_R1>(P, layer, grid, stream);
            launch_phase<PH_R2>(P, layer, grid, stream);
            launch_phase<PH_R3>(P, layer, grid, stream);
            launch_phase<PH_R4>(P, layer, grid, stream);
            launch_phase<PH_R5>(P, layer, grid, stream);
        } else if (kind == 1) {
            launch_phase<PH_N1>(P, layer, grid, stream); launch_phase<PH_N2A>(P, layer, grid, stream); launch_phase<PH_N2B>(P, layer, grid, stream);
            launch_phase<PH_N3>(P, layer, grid, stream); launch_phase<PH_N4>(P, layer, grid, stream);
        } else {
            launch_phase<PH_L1>(P, layer, grid, stream); launch_phase<PH_L2A>(P, layer, grid, stream); launch_phase<PH_L2B>(P, layer, grid, stream);
            launch_phase<PH_L3>(P, layer, grid, stream); launch_phase<PH_L4>(P, layer, grid, stream); launch_phase<PH_L5>(P, layer, grid, stream);
        }
        launch_phase<PH_NORM_MID>(P, layer, grid, stream);
        launch_phase<PH_F1>(P, layer, grid, stream); launch_phase<PH_F1B>(P, layer, grid, stream);
        launch_phase<PH_F2>(P, layer, grid, stream);
        launch_phase<PH_NORM_END>(P, layer, grid, stream);
    }
}
```

```cpp
#include <hip/hip_runtime.h>
#include <stdint.h>
#include <stdio.h>
#include <string.h>

#define DEV __device__ __forceinline__
__device__ __forceinline__ int tidx() { int t = threadIdx.x; asm volatile("" : "+v"(t)); return t; }
typedef unsigned short bf16_t;
typedef short bf16x8 __attribute__((ext_vector_type(8)));
typedef float f32x4 __attribute__((ext_vector_type(4)));
typedef unsigned u32x4 __attribute__((ext_vector_type(4)));
typedef unsigned u32x2 __attribute__((ext_vector_type(2)));

constexpr int SEQ = 8192, NBATCH = 4, T = SEQ * NBATCH, DM = 1024, DFF = 2816;
constexpr int NTHR = 512;
constexpr size_t MiB = 1ull << 20;
constexpr size_t SLOT = 64 * MiB;
constexpr size_t OFF_S7 = 7 * SLOT;
constexpr size_t OFF_BAR = OFF_S7;
constexpr size_t OFF_BIASP = OFF_S7 + 65536;
constexpr size_t OFF_BSC = OFF_S7 + 1 * MiB;
constexpr size_t OFF_WREG = OFF_S7 + 4 * MiB;
constexpr size_t OFF_HID = OFF_S7 + 32 * MiB;
constexpr size_t OFF_WF1 = OFF_WREG;
constexpr size_t OFF_WF2 = OFF_WREG + 11 * MiB;
constexpr size_t OFF_MIX = OFF_WREG + 17 * MiB;
constexpr int HIDP = 320;
constexpr int GEMM_LDS = 98304;

enum { I_X = 0, I_NORMG, I_FWIN, I_FCW, I_FCB, I_FWOUT, I_MU, I_WRKV, I_W0, I_W1, I_W2, I_A0, I_A1, I_A2, I_G1, I_G2, I_KK, I_KA, I_RK, I_LNW, I_LNB, I_RWO,
       I_V0, I_V1, I_V2, I_NWIN, I_CW1, I_CB1, I_CW2, I_CPE, I_NWO, I_GWIN, I_AUP, I_ABIAS, I_GNW, I_GWO, N_IN };

struct Params { const float* in[N_IN]; float* out; char* ws; };

DEV float bf_lo(unsigned u) { return __uint_as_float(u << 16); }
DEV float bf_hi(unsigned u) { return __uint_as_float(u & 0xffff0000u); }
DEV float bf2f(bf16_t b) { return __uint_as_float(((unsigned)b) << 16); }
typedef __bf16 bf16x2_t __attribute__((ext_vector_type(2)));
typedef float f32x2_t __attribute__((ext_vector_type(2)));
DEV unsigned cvt_pk(float lo, float hi) { const f32x2_t v = {lo, hi}; const bf16x2_t b = __builtin_convertvector(v, bf16x2_t); return __builtin_bit_cast(unsigned, b); }
DEV bf16_t f2bf(float f) { return (bf16_t)(cvt_pk(f, 0.f) & 0xffffu); }
DEV void st_bf4(bf16_t* p, f32x4 v) { u32x2 w; w.x = cvt_pk(v[0], v[1]); w.y = cvt_pk(v[2], v[3]); *(u32x2*)p = w; }
DEV f32x4 ld_bf4(const bf16_t* p) { u32x2 w = *(const u32x2*)p; f32x4 v; v[0] = bf_lo(w.x); v[1] = bf_hi(w.x); v[2] = bf_lo(w.y); v[3] = bf_hi(w.y); return v; }
DEV float rcpf_(float x) { return __builtin_amdgcn_rcpf(x); }
DEV float sigmoidf_(float x) { return rcpf_(1.0f + __expf(-x)); }
DEV float wave_sum(float v) {
#pragma unroll
    for (int o = 32; o > 0; o >>= 1) v += __shfl_xor(v, o);
    return v;
}

#define DPP_MOV(x, ctrl) __int_as_float(__builtin_amdgcn_mov_dpp(__float_as_int(x), (ctrl), 0xf, 0xf, true))
DEV float row16_sum(float x) {
    x += DPP_MOV(x, 0xB1);
    x += DPP_MOV(x, 0x4E);
    x += DPP_MOV(x, 0x124);
    x += DPP_MOV(x, 0x128);
    return x;
}
DEV bf16x8 pack8(f32x4 a, f32x4 b) {
    u32x4 w; w.x = cvt_pk(a[0], a[1]); w.y = cvt_pk(a[2], a[3]); w.z = cvt_pk(b[0], b[1]); w.w = cvt_pk(b[2], b[3]);
    return __builtin_bit_cast(bf16x8, w);
}
#define MFMA(a, b, c) __builtin_amdgcn_mfma_f32_16x16x32_bf16((a), (b), (c), 0, 0, 0)


#define XB_TMO      128
#define XB_XCNT(j)  (256  + 64 * (j))
#define XB_XSUB(j)  (1280 + 64 * (j))
#define XB_XGEN(j)  (2304 + 64 * (j))
#define XB_TOP      3328
#define XB_TOPGEN   3392
#define XCD_BAR_WORDS 3456
#define XB_SPIN_CAP (1u << 18)
#define LAS __attribute__((address_space(3)))
__device__ __forceinline__ unsigned xb_ld(unsigned* p)              { return __hip_atomic_load(p, __ATOMIC_RELAXED, __HIP_MEMORY_SCOPE_AGENT); }
__device__ __forceinline__ unsigned xb_add(unsigned* p, unsigned v) { return __hip_atomic_fetch_add(p, v, __ATOMIC_RELAXED, __HIP_MEMORY_SCOPE_AGENT); }
__device__ __forceinline__ unsigned xb_xcc_id() { return (unsigned)__builtin_amdgcn_s_getreg((3 << 11) | 20) & 0xFu; }
#define XB_SPIN(cond, bar) do { unsigned _sp = 0; while (cond) { __builtin_amdgcn_s_sleep(1); \
    if ((++_sp & 255u) == 0u) { if (xb_ld(&(bar)[XB_TMO])) break; if (_sp > XB_SPIN_CAP) { atomicAdd(&(bar)[XB_TMO], 1u); break; } } } } while (0)
struct XcdBarrier { unsigned* bar; unsigned x; volatile LAS unsigned* st; };
__device__ __forceinline__ XcdBarrier xcd_barrier_post(unsigned* bar, volatile LAS unsigned* st) {
    XcdBarrier b; b.bar = bar; b.x = xb_xcc_id(); b.st = st;
    if (threadIdx.x == 0) (void)xb_add(&bar[XB_XCNT(b.x)], 1u);
    return b;
}
__device__ __forceinline__ void xcd_barrier_complete(unsigned* bar, unsigned x, unsigned& nloc, unsigned& nx) {
    const unsigned G = gridDim.x * gridDim.y * gridDim.z;
    unsigned sum, cnt, mine, sp = 0u;
    for (;;) {
        sum = 0u; cnt = 0u; mine = 0u;
#pragma unroll
        for (unsigned j = 0; j < 16; ++j) { const unsigned c = xb_ld(&bar[XB_XCNT(j)]); sum += c; cnt += (c > 0u) ? 1u : 0u; mine = (j == x) ? c : mine; }
        if (sum == G) break;
        __builtin_amdgcn_s_sleep(1);
        if ((++sp & 255u) == 0u) { if (xb_ld(&bar[XB_TMO])) break; if (sp > XB_SPIN_CAP) { atomicAdd(&bar[XB_TMO], 1u); break; } }
    }
    nloc = mine > 0u ? mine : 1u; nx = cnt > 0u ? cnt : 1u;
}
__device__ __forceinline__ void xcd_barrier(const XcdBarrier& b) {
    asm volatile("s_waitcnt vmcnt(0)" ::: "memory");
    __syncthreads();
    if (threadIdx.x == 0) {
        unsigned* bar = b.bar;
        __builtin_amdgcn_s_waitcnt(0);
        unsigned nloc = b.st[0], nx = b.st[1];
        if (nloc == 0u) { xcd_barrier_complete(bar, b.x, nloc, nx); b.st[0] = nloc; b.st[1] = nx; }
        const unsigned old = xb_add(&bar[XB_XSUB(b.x)], 1u);
        const unsigned gen = old / nloc;
        if (old + 1u == (gen + 1u) * nloc) {
            __builtin_amdgcn_fence(__ATOMIC_RELEASE, "agent");
            asm volatile("s_waitcnt vmcnt(0)" ::: "memory");
            const unsigned og = xb_add(&bar[XB_TOP], 1u);
            const unsigned tg = og / nx;
            if (og + 1u == (tg + 1u) * nx) xb_add(&bar[XB_TOPGEN], 1u);
            else XB_SPIN(xb_ld(&bar[XB_TOPGEN]) == tg, bar);
            __builtin_amdgcn_fence(__ATOMIC_ACQUIRE, "agent");
            xb_add(&bar[XB_XGEN(b.x)], 1u);
            asm volatile("s_waitcnt vmcnt(0)" ::: "memory");
        } else {
            XB_SPIN(xb_ld(&bar[XB_XGEN(b.x)]) == gen, bar);
            __builtin_amdgcn_fence(__ATOMIC_ACQUIRE, "agent");
            asm volatile("s_waitcnt vmcnt(0)" ::: "memory");
        }
    }
    __syncthreads();
}

struct LdPlain { const bf16_t* p; long pitch;
    DEV void setk(int) {}
    DEV u32x4 operator()(int r, int k) const { return *(const u32x4*)(p + (long)r * pitch + k); } };
DEV unsigned mixpair(unsigned x, unsigned xp, float ma, float mb) { const float a = bf_lo(x), b = bf_hi(x), pa = bf_lo(xp), pb = bf_hi(xp); return cvt_pk(a + (pa - a) * ma, b + (pb - b) * mb); }
struct LdMix { const bf16_t* xn; const float* mu; int row0; f32x4 m0, m1;
    DEV void setk(int k) { m0 = *(const f32x4*)(mu + k); m1 = *(const f32x4*)(mu + k + 4); }
    DEV u32x4 operator()(int r, int k) const {
        const int gr = row0 + r; const bf16_t* px = xn + (long)gr * DM + k;
        const u32x4 x = *(const u32x4*)px; u32x4 xp = {0u, 0u, 0u, 0u};
        if ((gr & (SEQ - 1)) != 0) xp = *(const u32x4*)(px - DM);
        u32x4 o; o.x = mixpair(x.x, xp.x, m0[0], m0[1]); o.y = mixpair(x.y, xp.y, m0[2], m0[3]); o.z = mixpair(x.z, xp.z, m1[0], m1[1]); o.w = mixpair(x.w, xp.w, m1[2], m1[3]);
        return o; } };
struct LdCmp { const bf16_t* src; int row0;
    DEV void setk(int) {}
    DEV u32x4 operator()(int r, int k) const {
        const int row = row0 + r, b = row >> 10, n = (row >> 1) & 511, g = row & 1, l = k >> 6, d = k & 63;
        int t = 16 * n + l; t = t > SEQ - 1 ? SEQ - 1 : t;
        return *(const u32x4*)(src + ((long)(b * SEQ + t)) * 128 + g * 64 + d); } };

template <class AL, class BL>
DEV void gemm_core_db(f32x4 (&acc)[4][4], const AL& al, const BL& bl, const int K, char* smem) {
    const int tid = tidx(), lane = tid & 63, wid = tid >> 6, wm = wid >> 1, wn = wid & 1, fr = lane & 15, fq = lane >> 4;
#pragma unroll
    for (int m = 0; m < 4; ++m)
#pragma unroll
        for (int n = 0; n < 4; ++n) acc[m][n] = (f32x4){0.f, 0.f, 0.f, 0.f};
    u32x4 ra[4], rb[2];
    const int srow = tid >> 3, skc = tid & 7;
    const int soff = srow * 128 + ((skc ^ ((srow >> 1) & 7)) << 4);
    const int fsw = (fr >> 1) & 7;
    const int aoff = (wm * 64 + fr) * 128, boff = 32768 + (wn * 64 + fr) * 128;
    const int nk = K >> 6;
#pragma unroll
    for (int i = 0; i < 4; ++i) ra[i] = al(srow + 64 * i, skc * 8);
#pragma unroll
    for (int i = 0; i < 2; ++i) rb[i] = bl(srow + 64 * i, skc * 8);
#pragma unroll
    for (int i = 0; i < 4; ++i) *(u32x4*)(smem + soff + i * 8192) = ra[i];
#pragma unroll
    for (int i = 0; i < 2; ++i) *(u32x4*)(smem + 32768 + soff + i * 8192) = rb[i];
    __syncthreads();
    for (int kt = 0; kt < nk; ++kt) {
        const bool more = kt + 1 < nk;
        if (more) {
            const int k0 = (kt + 1) * 64 + skc * 8;
#pragma unroll
            for (int i = 0; i < 4; ++i) ra[i] = al(srow + 64 * i, k0);
#pragma unroll
            for (int i = 0; i < 2; ++i) rb[i] = bl(srow + 64 * i, k0);
        }
        const char* base = smem + (kt & 1) * 49152;
#pragma unroll
        for (int ks = 0; ks < 2; ++ks) {
            const int kcs = ((ks * 4 + fq) ^ fsw) << 4;
            bf16x8 af[4], bfr[4];
#pragma unroll
            for (int m = 0; m < 4; ++m) af[m] = *(const bf16x8*)(base + aoff + m * 2048 + kcs);
#pragma unroll
            for (int n = 0; n < 4; ++n) bfr[n] = *(const bf16x8*)(base + boff + n * 2048 + kcs);
#pragma unroll
            for (int m = 0; m < 4; ++m)
#pragma unroll
                for (int n = 0; n < 4; ++n) acc[m][n] = MFMA(bfr[n], af[m], acc[m][n]);
        }
        if (more) {
            char* nb = smem + ((kt + 1) & 1) * 49152;
#pragma unroll
            for (int i = 0; i < 4; ++i) *(u32x4*)(nb + soff + i * 8192) = ra[i];
#pragma unroll
            for (int i = 0; i < 2; ++i) *(u32x4*)(nb + 32768 + soff + i * 8192) = rb[i];
        }
        __syncthreads();
    }
}

template <class AL, class BL>
DEV void gemm_core(f32x4 (&acc)[4][4], AL al, BL bl, const int K, char* smem) {
    const int tid = tidx(), lane = tid & 63, wid = tid >> 6, wm = wid >> 1, wn = wid & 1, fr = lane & 15, fq = lane >> 4;
#pragma unroll
    for (int m = 0; m < 4; ++m)
#pragma unroll
        for (int n = 0; n < 4; ++n) acc[m][n] = (f32x4){0.f, 0.f, 0.f, 0.f};
    u32x4 ra[4], rb[2];
    const int srow = tid >> 3, skc = tid & 7;
    const int soff = srow * 128 + ((skc ^ ((srow >> 1) & 7)) << 4);
    const int fsw = (fr >> 1) & 7;
    const int aoff = (wm * 64 + fr) * 128, boff = 32768 + (wn * 64 + fr) * 128;
    const int nk = K >> 6;
    for (int kt = 0; kt < nk; ++kt) {
        const int k0 = kt * 64 + skc * 8;
        al.setk(k0);
#pragma unroll
        for (int i = 0; i < 4; ++i) ra[i] = al(srow + 64 * i, k0);
#pragma unroll
        for (int i = 0; i < 2; ++i) rb[i] = bl(srow + 64 * i, k0);
        __syncthreads();
#pragma unroll
        for (int i = 0; i < 4; ++i) *(u32x4*)(smem + soff + i * 8192) = ra[i];
#pragma unroll
        for (int i = 0; i < 2; ++i) *(u32x4*)(smem + 32768 + soff + i * 8192) = rb[i];
        __syncthreads();
        const char* base = smem;
#pragma unroll
        for (int ks = 0; ks < 2; ++ks) {
            const int kcs = ((ks * 4 + fq) ^ fsw) << 4;
            bf16x8 af[4], bfr[4];
#pragma unroll
            for (int m = 0; m < 4; ++m) af[m] = *(const bf16x8*)(base + aoff + m * 2048 + kcs);
#pragma unroll
            for (int n = 0; n < 4; ++n) bfr[n] = *(const bf16x8*)(base + boff + n * 2048 + kcs);
#pragma unroll
            for (int m = 0; m < 4; ++m)
#pragma unroll
                for (int n = 0; n < 4; ++n) acc[m][n] = MFMA(bfr[n], af[m], acc[m][n]);
        }
    }
    __syncthreads();
}
struct LaneId { int lane, wid, wm, wn, fr, fq; };
DEV LaneId lane_id() { LaneId l; l.lane = tidx() & 63; l.wid = tidx() >> 6; l.wm = l.wid >> 1; l.wn = l.wid & 1; l.fr = l.lane & 15; l.fq = l.lane >> 4; return l; }

template <class Map>
DEV void prep_T(bf16_t* dst, const float* src, int Ks, int Ns, int Nd, int Kd, Map map, char* smem, int& cursor) {
    float* tile = (float*)smem;
    const int ntn = Nd >> 6, ntiles = ntn * (Kd >> 6), tid = tidx();
    for (int tl = 0; tl < ntiles; ++tl) {
        if (((cursor + tl) % (int)gridDim.x) != (int)blockIdx.x) continue;
        const int n0 = (tl % ntn) * 64, k0 = (tl / ntn) * 64;
        { const int j = tid & 63, i0 = tid >> 6; const int n = map(n0 + j);
          for (int kk = i0; kk < 64; kk += 8) { const int k = k0 + kk; tile[kk * 65 + j] = (k < Ks && n >= 0) ? src[(long)k * Ns + n] : 0.f; } }
        __syncthreads();
        { const int c = tid & 63, r0 = tid >> 6;
          for (int r = r0; r < 64; r += 8) dst[(long)(n0 + r) * Kd + k0 + c] = f2bf(tile[c * 65 + r]); }
        __syncthreads();
    }
    cursor += ntiles;
}
struct MapId { int ns; DEV int operator()(int n) const { return n < ns ? n : -1; } };
struct MapFfn { DEV int operator()(int v) const { const int tn = v >> 7, wn = (v >> 6) & 1, u = (v >> 5) & 1, c = v & 31; return (u ? DFF : 0) + 64 * tn + 32 * wn + c; } };

DEV void phase_prep(const Params& P, int layer, char* smem) {
    char* ws = P.ws; int cur = 0;
    const int kind = layer % 3, j = layer / 3;
    prep_T((bf16_t*)(ws + OFF_WF1), P.in[I_FWIN] + (size_t)layer * DM * 2 * DFF, DM, 2 * DFF, 2 * DFF, DM, MapFfn{}, smem, cur);
    prep_T((bf16_t*)(ws + OFF_WF2), P.in[I_FWOUT] + (size_t)layer * DFF * DM, DFF, DM, DM, DFF, MapId{DM}, smem, cur);
    bf16_t* mix = (bf16_t*)(ws + OFF_MIX);
    if (kind == 0) {
        const float* wrkv = P.in[I_WRKV] + (size_t)j * 3 * DM * DM;
        prep_T(mix, wrkv, DM, DM, DM, DM, MapId{DM}, smem, cur);
        prep_T(mix + (size_t)1024 * DM, wrkv + (size_t)DM * DM, DM, DM, DM, DM, MapId{DM}, smem, cur);
        prep_T(mix + (size_t)2048 * DM, P.in[I_W1] + (size_t)j * DM * 64, DM, 64, 128, DM, MapId{64}, smem, cur);
        prep_T(mix + (size_t)2176 * DM, P.in[I_A1] + (size_t)j * DM * 64, DM, 64, 128, DM, MapId{64}, smem, cur);
        prep_T(mix + (size_t)2304 * DM, P.in[I_G1] + (size_t)j * DM * 128, DM, 128, 128, DM, MapId{128}, smem, cur);
        if (j > 0) prep_T(mix + (size_t)2432 * DM, P.in[I_V1] + (size_t)(j - 1) * DM * 32, DM, 32, 128, DM, MapId{32}, smem, cur);
        else       prep_T(mix + (size_t)2432 * DM, P.in[I_V1], DM, 32, 128, DM, MapId{0}, smem, cur);
        prep_T((bf16_t*)((char*)mix + 5 * MiB), wrkv + (size_t)2 * DM * DM, DM, DM, DM, DM, MapId{DM}, smem, cur);
        prep_T((bf16_t*)((char*)mix + 7 * MiB), P.in[I_W2] + (size_t)j * 64 * DM, 64, DM, DM, 64, MapId{DM}, smem, cur);
        prep_T((bf16_t*)((char*)mix + 7 * MiB + 131072), P.in[I_A2] + (size_t)j * 64 * DM, 64, DM, DM, 64, MapId{DM}, smem, cur);
        if (j > 0) prep_T((bf16_t*)((char*)mix + 7 * MiB + 262144), P.in[I_V2] + (size_t)(j - 1) * 32 * DM, 32, DM, DM, 64, MapId{DM}, smem, cur);
        prep_T((bf16_t*)((char*)mix + 7 * MiB + 393216), P.in[I_G2] + (size_t)j * 128 * DM, 128, DM, DM, 128, MapId{DM}, smem, cur);
        prep_T((bf16_t*)((char*)mix + 8 * MiB), P.in[I_RWO] + (size_t)j * DM * DM, DM, DM, DM, DM, MapId{DM}, smem, cur);
    } else if (kind == 1) {
        prep_T(mix, P.in[I_NWIN], DM, 1840, 2048, DM, MapId{1840}, smem, cur);
        prep_T((bf16_t*)((char*)mix + 4 * MiB), P.in[I_CW1], 2048, 256, 256, 2048, MapId{256}, smem, cur);
        prep_T((bf16_t*)((char*)mix + 4 * MiB) + (size_t)256 * 2048, P.in[I_CW1] + (size_t)2048 * 256, 2048, 256, 256, 2048, MapId{256}, smem, cur);
        prep_T((bf16_t*)((char*)mix + 6 * MiB), P.in[I_CW2], 256, 64, 128, 256, MapId{64}, smem, cur);
        prep_T((bf16_t*)((char*)mix + 6 * MiB) + (size_t)128 * 256, P.in[I_CW2] + (size_t)256 * 64, 256, 64, 128, 256, MapId{64}, smem, cur);
        prep_T((bf16_t*)((char*)mix + 7 * MiB), P.in[I_NWO], DM, DM, DM, DM, MapId{DM}, smem, cur);
        const int gt = blockIdx.x * NTHR + tidx();
        if (gt < 512) { const int c = gt >> 8, col = gt & 255; const float* w1 = P.in[I_CW1] + (size_t)c * 2048 * 256; const float* pe = P.in[I_CPE] + (size_t)c * 2048;
            float s = P.in[I_CB1][c * 256 + col]; for (int k = 0; k < 2048; ++k) s += pe[k] * w1[(size_t)k * 256 + col];
            ((float*)(ws + OFF_BIASP))[gt] = s; }
    } else {
        prep_T(mix, P.in[I_GWIN], DM, 3088, 3200, DM, MapId{3088}, smem, cur);
        prep_T((bf16_t*)((char*)mix + 7 * MiB), P.in[I_GWO], DM, DM, DM, DM, MapId{DM}, smem, cur);
    }
}

DEV void phase_norm(const float* h_in, const bf16_t* z, const float* g_post, float* h_out, const float* g_pre, bf16_t* xn) {
    const int lane = tidx() & 63, gw = blockIdx.x * (NTHR / 64) + (tidx() >> 6), nw = gridDim.x * (NTHR / 64);
    for (int row = gw; row < T; row += nw) {
        f32x4 hv[4];
#pragma unroll
        for (int i = 0; i < 4; ++i) hv[i] = *(const f32x4*)(h_in + (size_t)row * DM + i * 256 + lane * 4);
        if (z) {
            f32x4 zv[4]; float ss = 0.f;
#pragma unroll
            for (int i = 0; i < 4; ++i) { zv[i] = ld_bf4(z + (size_t)row * DM + i * 256 + lane * 4); ss += zv[i][0] * zv[i][0] + zv[i][1] * zv[i][1] + zv[i][2] * zv[i][2] + zv[i][3] * zv[i][3]; }
            ss = wave_sum(ss); const float rs = rsqrtf(ss * (1.0f / DM) + 1e-6f);
#pragma unroll
            for (int i = 0; i < 4; ++i) { const f32x4 g = *(const f32x4*)(g_post + i * 256 + lane * 4); hv[i] += zv[i] * rs * g; }
        }
        if (h_out) {
#pragma unroll
            for (int i = 0; i < 4; ++i) *(f32x4*)(h_out + (size_t)row * DM + i * 256 + lane * 4) = hv[i];
        }
        if (xn) {
            float ss = 0.f;
#pragma unroll
            for (int i = 0; i < 4; ++i) ss += hv[i][0] * hv[i][0] + hv[i][1] * hv[i][1] + hv[i][2] * hv[i][2] + hv[i][3] * hv[i][3];
            ss = wave_sum(ss); const float rs = rsqrtf(ss * (1.0f / DM) + 1e-6f);
#pragma unroll
            for (int i = 0; i < 4; ++i) { const f32x4 g = *(const f32x4*)(g_pre + i * 256 + lane * 4); st_bf4(xn + (size_t)row * DM + i * 256 + lane * 4, hv[i] * rs * g); }
        }
    }
}

DEV void phase_gemm_plain(const bf16_t* A, int lda, const bf16_t* Bt, int K, int ntn, bf16_t* C, int ldc, char* smem) {
    const LaneId L = lane_id();
    const int nunits = (T / 256) * ntn;
    for (int u = blockIdx.x; u < nunits; u += gridDim.x) {
        const int tm = u / ntn, tn = u % ntn;
        f32x4 acc[4][4];
        gemm_core(acc, LdPlain{A + (size_t)tm * 256 * lda, lda}, LdPlain{Bt + (size_t)tn * 128 * K, K}, K, smem);
#pragma unroll
        for (int m = 0; m < 4; ++m)
#pragma unroll
            for (int n = 0; n < 4; ++n)
                st_bf4(C + (size_t)(tm * 256 + L.wm * 64 + m * 16 + L.fr) * ldc + tn * 128 + L.wn * 64 + n * 16 + L.fq * 4, acc[m][n]);
    }
}

DEV void phase_f1(const bf16_t* xn, const bf16_t* Bt, const float* cw, const float* cb, bf16_t* act, bf16_t* E, char* smem) {
    const LaneId L = lane_id();
    const int ntn = 2 * DFF / 128, nunits = (T / 256) * ntn;
    for (int u = blockIdx.x; u < nunits; u += gridDim.x) {
        const int tm = u / ntn, tn = u % ntn;
        f32x4 acc[4][4];
        gemm_core(acc, LdPlain{xn + (size_t)tm * 256 * DM, DM}, LdPlain{Bt + (size_t)tn * 128 * DM, DM}, DM, smem);
        const int strip = tm * 4 + L.wm; const size_t rowbase = (size_t)tm * 256 + L.wm * 64;
#pragma unroll
        for (int n = 0; n < 2; ++n) {
            const int ch = tn * 64 + L.wn * 32 + n * 16 + L.fq * 4;
            const f32x4 c0 = *(const f32x4*)(cw + ch), c1 = *(const f32x4*)(cw + DFF + ch), c2 = *(const f32x4*)(cw + 2 * DFF + ch), cbv = *(const f32x4*)(cb + ch);
#pragma unroll
            for (int m = 0; m < 4; ++m) {
                const f32x4 g0 = acc[m][n], up = acc[m][n + 2]; f32x4 g1, g2;
#pragma unroll
                for (int j = 0; j < 4; ++j) {
                    const float a1 = __shfl(g0[j], (L.lane - 1) & 63), a2 = __shfl(g0[j], (L.lane - 2) & 63);
                    float b1 = 0.f, b2 = 0.f;
                    if (m > 0) { b1 = __shfl(acc[m > 0 ? m - 1 : 0][n][j], (L.lane + 15) & 63); b2 = __shfl(acc[m > 0 ? m - 1 : 0][n][j], (L.lane + 14) & 63); }
                    g1[j] = L.fr >= 1 ? a1 : b1; g2[j] = L.fr >= 2 ? a2 : b2;
                }
                const int rs = m * 16 + L.fr;
                f32x4 val = c2 * g0 + c1 * g1 + c0 * g2 + cbv, a;
#pragma unroll
                for (int j = 0; j < 4; ++j) a[j] = val[j] * rcpf_(1.0f + __expf(-val[j])) * up[j];
                if (rs >= 2) st_bf4(act + (rowbase + rs) * DFF + ch, a);
                else { st_bf4(E + ((size_t)strip * 6 + 2 + rs) * DFF + ch, g0); st_bf4(E + ((size_t)strip * 6 + 4 + rs) * DFF + ch, up); }
                if (rs >= 62) st_bf4(E + ((size_t)strip * 6 + (rs - 62)) * DFF + ch, g0);
            }
        }
    }
}
DEV void phase_f1b(const float* cw, const float* cb, bf16_t* act, const bf16_t* E) {
    const int gt = blockIdx.x * NTHR + tidx(), nt = gridDim.x * NTHR;
    for (int idx = gt; idx < 512 * 2 * (DFF / 4); idx += nt) {
        const int ch = (idx % (DFF / 4)) * 4, r = (idx / (DFF / 4)) & 1, strip = idx / (2 * (DFF / 4));
        const bool first = (strip & 127) == 0;
        const f32x4 zero = {0.f, 0.f, 0.f, 0.f};
        const f32x4 g0 = ld_bf4(E + ((size_t)strip * 6 + 2 + r) * DFF + ch), up = ld_bf4(E + ((size_t)strip * 6 + 4 + r) * DFF + ch);
        f32x4 g1, g2;
        if (r == 1) { g1 = ld_bf4(E + ((size_t)strip * 6 + 2) * DFF + ch); g2 = first ? zero : ld_bf4(E + ((size_t)(strip - 1) * 6 + 1) * DFF + ch); }
        else { g1 = first ? zero : ld_bf4(E + ((size_t)(strip - 1) * 6 + 1) * DFF + ch); g2 = first ? zero : ld_bf4(E + ((size_t)(strip - 1) * 6 + 0) * DFF + ch); }
        const f32x4 c0 = *(const f32x4*)(cw + ch), c1 = *(const f32x4*)(cw + DFF + ch), c2 = *(const f32x4*)(cw + 2 * DFF + ch), cbv = *(const f32x4*)(cb + ch);
        f32x4 val = c2 * g0 + c1 * g1 + c0 * g2 + cbv, a;
#pragma unroll
        for (int j = 0; j < 4; ++j) a[j] = val[j] * rcpf_(1.0f + __expf(-val[j])) * up[j];
        st_bf4(act + ((size_t)strip * 64 + r) * DFF + ch, a);
    }
}

struct RwkvW { const float *mu, *w0, *a0, *k_k, *k_a, *r_k, *ln_w, *ln_b, *v0; bool vres; };
DEV void phase_r1(const bf16_t* xn, const bf16_t* Bt, const RwkvW& W, bf16_t* rb, bf16_t* kb, bf16_t* hid, char* smem) {
    const LaneId L = lane_id();
    const int ntn = 20, nunits = (T / 256) * ntn;
    for (int u = blockIdx.x; u < nunits; u += gridDim.x) {
        const int tm = u / ntn, tn = u % ntn;
        const int var = tn < 8 ? 0 : tn < 16 ? 2 : tn == 16 ? 1 : tn == 17 ? 4 : tn == 18 ? 5 : 3;
        f32x4 acc[4][4];
        gemm_core(acc, LdMix{xn, W.mu + var * DM, tm * 256, {0.f, 0.f, 0.f, 0.f}, {0.f, 0.f, 0.f, 0.f}}, LdPlain{Bt + (size_t)tn * 128 * DM, DM}, DM, smem);
#pragma unroll
        for (int m = 0; m < 4; ++m)
#pragma unroll
            for (int n = 0; n < 4; ++n) {
                const size_t row = (size_t)tm * 256 + L.wm * 64 + m * 16 + L.fr; const int c = L.wn * 64 + n * 16 + L.fq * 4; f32x4 v = acc[m][n];
                if (tn < 8) st_bf4(rb + row * DM + tn * 128 + c, v);
                else if (tn < 16) st_bf4(kb + row * DM + (tn - 8) * 128 + c, v);
                else if (tn == 16) { if (L.wn == 0) { for (int j = 0; j < 4; ++j) v[j] = tanhf(v[j]); st_bf4(hid + row * HIDP + c, v); } }
                else if (tn == 17) { if (L.wn == 0) st_bf4(hid + row * HIDP + 64 + c, v); }
                else if (tn == 18) { for (int j = 0; j < 4; ++j) v[j] = sigmoidf_(v[j]); st_bf4(hid + row * HIDP + 128 + c, v); }
                else { if (L.wn == 0) st_bf4(hid + row * HIDP + 256 + c, v); }
            }
    }
}
DEV void phase_r2(const bf16_t* xn, const bf16_t* mixw, const RwkvW& W, const bf16_t* hid, bf16_t* wb, bf16_t* kb, bf16_t* kkb, bf16_t* kab, bf16_t* vb, char* smem) {
    const LaneId L = lane_id();
    const bf16_t* Bv = (const bf16_t*)((const char*)mixw + 5 * MiB);
    const bf16_t* W2T = (const bf16_t*)((const char*)mixw + 7 * MiB);
    const bf16_t* A2T = (const bf16_t*)((const char*)mixw + 7 * MiB + 131072);
    const bf16_t* V2T = (const bf16_t*)((const char*)mixw + 7 * MiB + 262144);
    const int nunits = 1024 + 2048;
    for (int u = blockIdx.x; u < nunits; u += gridDim.x) {
        if (u < 1024) {
            const int tm = u >> 3, tn = u & 7;
            f32x4 acc[4][4]; u32x2 gpk[4][4];
            if (W.vres) {
                gemm_core(acc, LdPlain{hid + (size_t)tm * 256 * HIDP + 256, HIDP}, LdPlain{V2T + (size_t)tn * 128 * 64, 64}, 64, smem);
#pragma unroll
                for (int m = 0; m < 4; ++m)
#pragma unroll
                    for (int n = 0; n < 4; ++n) { const int col = tn * 128 + L.wn * 64 + n * 16 + L.fq * 4; const f32x4 b = *(const f32x4*)(W.v0 + col);
                        gpk[m][n].x = cvt_pk(sigmoidf_(b[0] + acc[m][n][0]), sigmoidf_(b[1] + acc[m][n][1]));
                        gpk[m][n].y = cvt_pk(sigmoidf_(b[2] + acc[m][n][2]), sigmoidf_(b[3] + acc[m][n][3])); }
            }
            gemm_core(acc, LdMix{xn, W.mu + 3 * DM, tm * 256, {0.f, 0.f, 0.f, 0.f}, {0.f, 0.f, 0.f, 0.f}}, LdPlain{Bv + (size_t)tn * 128 * DM, DM}, DM, smem);
#pragma unroll
            for (int m = 0; m < 4; ++m)
#pragma unroll
                for (int n = 0; n < 4; ++n) {
                    const size_t row = (size_t)tm * 256 + L.wm * 64 + m * 16 + L.fr; const int col = tn * 128 + L.wn * 64 + n * 16 + L.fq * 4; f32x4 v = acc[m][n];
                    if (W.vres) { const f32x4 vf = ld_bf4(vb + row * DM + col); f32x4 gt; gt[0] = bf_lo(gpk[m][n].x); gt[1] = bf_hi(gpk[m][n].x); gt[2] = bf_lo(gpk[m][n].y); gt[3] = bf_hi(gpk[m][n].y); v = v + (vf - v) * gt; }
                    st_bf4(vb + row * DM + col, v);
                }
        } else {
            const int u2 = u - 1024, tm = u2 >> 4, jj = u2 & 15;
            f32x4 acc[4][4];
            if (jj < 8) {
                const int tn = jj;
                gemm_core(acc, LdPlain{hid + (size_t)tm * 256 * HIDP, HIDP}, LdPlain{W2T + (size_t)tn * 128 * 64, 64}, 64, smem);
#pragma unroll
                for (int m = 0; m < 4; ++m)
#pragma unroll
                    for (int n = 0; n < 4; ++n) {
                        const size_t row = (size_t)tm * 256 + L.wm * 64 + m * 16 + L.fr; const int col = tn * 128 + L.wn * 64 + n * 16 + L.fq * 4; const f32x4 b = *(const f32x4*)(W.w0 + col); f32x4 v;
                        for (int j = 0; j < 4; ++j) { const float x = b[j] + acc[m][n][j]; const float y = -x;
                            const float sp = fmaxf(y, 0.f) + log1pf(__expf(-fabsf(y))); const float w = -sp - 0.5f; v[j] = __expf(-__expf(w)); }
                        st_bf4(wb + row * DM + col, v);
                    }
            } else {
                const int tn = jj - 8;
                gemm_core(acc, LdPlain{hid + (size_t)tm * 256 * HIDP + 64, HIDP}, LdPlain{A2T + (size_t)tn * 128 * 64, 64}, 64, smem);
#pragma unroll
                for (int m = 0; m < 4; ++m) {
                    const size_t row = (size_t)tm * 256 + L.wm * 64 + m * 16 + L.fr;
                    u32x2 kpk[4]; float ss = 0.f;
#pragma unroll
                    for (int n = 0; n < 4; ++n) { const int col = tn * 128 + L.wn * 64 + n * 16 + L.fq * 4;
                        kpk[n] = *(const u32x2*)(kb + row * DM + col); const f32x4 kkw = *(const f32x4*)(W.k_k + col);
                        const float c0 = bf_lo(kpk[n].x) * kkw[0], c1 = bf_hi(kpk[n].x) * kkw[1], c2 = bf_lo(kpk[n].y) * kkw[2], c3 = bf_hi(kpk[n].y) * kkw[3];
                        ss += (c0 * c0 + c1 * c1) + (c2 * c2 + c3 * c3); }
                    ss += __shfl_xor(ss, 16); ss += __shfl_xor(ss, 32);
                    const float inv = rcpf_(fmaxf(sqrtf(ss), 1e-12f));
                    asm volatile("" ::: "memory");
#pragma unroll
                    for (int n = 0; n < 4; ++n) { const int col = tn * 128 + L.wn * 64 + n * 16 + L.fq * 4;
                        const f32x4 ka = *(const f32x4*)(W.k_a + col), kkw = *(const f32x4*)(W.k_k + col), a0 = *(const f32x4*)(W.a0 + col);
                        f32x4 kv; kv[0] = bf_lo(kpk[n].x); kv[1] = bf_hi(kpk[n].x); kv[2] = bf_lo(kpk[n].y); kv[3] = bf_hi(kpk[n].y);
                        f32x4 kk, kp, kka;
                        for (int j = 0; j < 4; ++j) { const float a = sigmoidf_(a0[j] + acc[m][n][j]); kk[j] = kv[j] * kkw[j] * inv; kp[j] = kv[j] * (1.0f + (a - 1.0f) * ka[j]); kka[j] = kk[j] * a; }
                        st_bf4(kb + row * DM + col, kp); st_bf4(kkb + row * DM + col, kk); st_bf4(kab + row * DM + col, kka);
                        asm volatile("" ::: "memory"); }
                }
            }
        }
    }
}
DEV void phase_r3(const bf16_t* rb, const bf16_t* wb, const bf16_t* kb, const bf16_t* kkb, const bf16_t* kab, const bf16_t* vb, bf16_t* yb, float* bsc, const float* r_k) {
    const int lane = tidx() & 63, wid = tidx() >> 6;
    if (wid < 4) {
        for (int task = blockIdx.x * 4 + wid; task < 1024; task += gridDim.x * 4) {
            const int bh = task >> 4, rg = task & 15, b = bh >> 4, h = bh & 15, rr = lane >> 4, cg = lane & 15;
            const size_t base = (size_t)b * SEQ * DM + h * 64;
            const size_t coff = base + cg * 4, voff = base + rg * 4 + rr;
            const f32x4 rk = *(const f32x4*)(r_k + h * 64 + cg * 4);
            float s0 = 0.f, s1 = 0.f, s2 = 0.f, s3 = 0.f;
            u32x2 Rr[2][8], Wr[2][8], Kr[2][8], KKr[2][8], KAr[2][8]; bf16_t Vr[2][8];
#define R3_LOAD(bf, t0) { _Pragma("unroll") for (int s = 0; s < 8; ++s) { const size_t o = coff + (size_t)((t0) + s) * DM; \
                Rr[bf][s] = *(const u32x2*)(rb + o); Wr[bf][s] = *(const u32x2*)(wb + o); Kr[bf][s] = *(const u32x2*)(kb + o); KKr[bf][s] = *(const u32x2*)(kkb + o); KAr[bf][s] = *(const u32x2*)(kab + o); \
                Vr[bf][s] = vb[voff + (size_t)((t0) + s) * DM]; } }
#define R3_COMP(bf, t0) { _Pragma("unroll") for (int s = 0; s < 8; ++s) { \
                const float r0 = bf_lo(Rr[bf][s].x), r1 = bf_hi(Rr[bf][s].x), r2 = bf_lo(Rr[bf][s].y), r3 = bf_hi(Rr[bf][s].y); \
                const float w0 = bf_lo(Wr[bf][s].x), w1 = bf_hi(Wr[bf][s].x), w2 = bf_lo(Wr[bf][s].y), w3 = bf_hi(Wr[bf][s].y); \
                const float k0 = bf_lo(Kr[bf][s].x), k1 = bf_hi(Kr[bf][s].x), k2 = bf_lo(Kr[bf][s].y), k3 = bf_hi(Kr[bf][s].y); \
                const float q0 = bf_lo(KKr[bf][s].x), q1 = bf_hi(KKr[bf][s].x), q2 = bf_lo(KKr[bf][s].y), q3 = bf_hi(KKr[bf][s].y); \
                const float a0 = bf_lo(KAr[bf][s].x), a1 = bf_hi(KAr[bf][s].x), a2 = bf_lo(KAr[bf][s].y), a3 = bf_hi(KAr[bf][s].y); \
                const float vv = bf2f(Vr[bf][s]); \
                const float sa = -row16_sum((s0 * q0 + s1 * q1) + (s2 * q2 + s3 * q3)); \
                s0 = s0 * w0 + (sa * a0 + vv * k0); s1 = s1 * w1 + (sa * a1 + vv * k1); s2 = s2 * w2 + (sa * a2 + vv * k2); s3 = s3 * w3 + (sa * a3 + vv * k3); \
                const float y = row16_sum((s0 * r0 + s1 * r1) + (s2 * r2 + s3 * r3)); \
                if (cg == 0) yb[voff + (size_t)((t0) + s) * DM] = f2bf(y); \
                if (rg == 0) { const float bo = row16_sum((r0 * k0 * rk[0] + r1 * k1 * rk[1]) + (r2 * k2 * rk[2] + r3 * k3 * rk[3])); \
                    if (lane == 0) bsc[((size_t)b * SEQ + (t0) + s) * 16 + h] = bo; } } }
            R3_LOAD(0, 0)
            for (int t0 = 0; t0 < SEQ; t0 += 16) {
                R3_LOAD(1, t0 + 8)
                R3_COMP(0, t0)
                if (t0 + 16 < SEQ) R3_LOAD(0, t0 + 16)
                R3_COMP(1, t0 + 8)
            }
#undef R3_LOAD
#undef R3_COMP
        }
    }
}
DEV void phase_r4(const bf16_t* hid, const bf16_t* G2T, const RwkvW& W, const bf16_t* yb, const bf16_t* vb, const float* bsc, bf16_t* outb, char* smem) {
    const LaneId L = lane_id();
    const int ntn = 8, nunits = (T / 256) * ntn;
    for (int u = blockIdx.x; u < nunits; u += gridDim.x) {
        const int tm = u / ntn, tn = u % ntn;
        f32x4 acc[4][4];
        gemm_core(acc, LdPlain{hid + (size_t)tm * 256 * HIDP + 128, HIDP}, LdPlain{G2T + (size_t)tn * 128 * 128, 128}, 128, smem);
        const int head = tn * 2 + L.wn;
#pragma unroll
        for (int m = 0; m < 4; ++m) {
            const size_t row = (size_t)tm * 256 + L.wm * 64 + m * 16 + L.fr;
            f32x4 yv[4]; float s = 0.f;
#pragma unroll
            for (int n = 0; n < 4; ++n) { yv[n] = ld_bf4(yb + row * DM + head * 64 + n * 16 + L.fq * 4); s += (yv[n][0] + yv[n][1]) + (yv[n][2] + yv[n][3]); }
            s += __shfl_xor(s, 16); s += __shfl_xor(s, 32);
            const float mean = s * (1.0f / 64.0f); float q = 0.f;
#pragma unroll
            for (int n = 0; n < 4; ++n) { const f32x4 d = yv[n] - mean; q += (d[0] * d[0] + d[1] * d[1]) + (d[2] * d[2] + d[3] * d[3]); }
            q += __shfl_xor(q, 16); q += __shfl_xor(q, 32);
            const float rstd = rsqrtf(q * (1.0f / 64.0f) + 64e-5f);
            const float bs = bsc[row * 16 + head];
#pragma unroll
            for (int n = 0; n < 4; ++n) { const int col = head * 64 + n * 16 + L.fq * 4;
                const f32x4 lw = *(const f32x4*)(W.ln_w + col), lb = *(const f32x4*)(W.ln_b + col), vv = ld_bf4(vb + row * DM + col);
                f32x4 o = ((yv[n] - mean) * rstd * lw + lb + vv * bs);
                o = o * acc[m][n];
                st_bf4(outb + row * DM + col, o); }
        }
    }
}

struct NsaBuf { bf16_t *q, *kcmp, *vcmp, *kslc, *kwin, *vslcT, *vwinT, *hid, *kc, *vcT, *o; float* gates; };
DEV void phase_n1(const bf16_t* xn, const bf16_t* Bt, const NsaBuf& B, char* smem) {
    const LaneId L = lane_id();
    const int ntn = 15, nunits = (T / 256) * ntn;
    for (int u = blockIdx.x; u < nunits; u += gridDim.x) {
        const int tm = u / ntn, tn = u % ntn;
        f32x4 acc[4][4];
        gemm_core(acc, LdPlain{xn + (size_t)tm * 256 * DM, DM}, LdPlain{Bt + (size_t)tn * 128 * DM, DM}, DM, smem);
#pragma unroll
        for (int m = 0; m < 4; ++m)
#pragma unroll
            for (int n = 0; n < 4; ++n) {
                const size_t row = (size_t)tm * 256 + L.wm * 64 + m * 16 + L.fr; const int c = L.wn * 64 + n * 16 + L.fq * 4; f32x4 v = acc[m][n];
                if (tn < 8) st_bf4(B.q + row * DM + tn * 128 + c, v * 0.125f);
                else if (tn < 14) {
                    const int cc = tn - 8;
                    if (cc == 0) st_bf4(B.kcmp + row * 128 + c, v);
                    else if (cc == 1) st_bf4(B.vcmp + row * 128 + c, v);
                    else if (cc == 2) st_bf4(B.kslc + row * 128 + c, v);
                    else if (cc == 4) st_bf4(B.kwin + row * 128 + c, v);
                    else { bf16_t* dst = cc == 3 ? B.vslcT : B.vwinT; const int b = (int)(row >> 13), t = (int)(row & (SEQ - 1));
                        for (int j = 0; j < 4; ++j) dst[((size_t)(b * 128 + c + j)) * SEQ + t] = f2bf(v[j]); }
                } else { if (c < 48) { for (int j = 0; j < 4; ++j) B.gates[row * 48 + c + j] = sigmoidf_(v[j]); } }
            }
    }
}
DEV float gelu_tanh(float x) { const float u = 0.7978845608028654f * (x + 0.044715f * x * x * x); return 0.5f * x * (1.0f + tanhf(u)); }
DEV void phase_n2a(const bf16_t* W1T, const float* biasp, const NsaBuf& B, char* smem) {
    const LaneId L = lane_id();
    for (int u = blockIdx.x; u < 64; u += gridDim.x) {
        const int c = u >> 5, tm = (u >> 1) & 15, tn = u & 1;
        f32x4 acc[4][4];
        gemm_core(acc, LdCmp{c ? B.vcmp : B.kcmp, tm * 256}, LdPlain{W1T + (size_t)c * 256 * 2048 + (size_t)tn * 128 * 2048, 2048}, 2048, smem);
#pragma unroll
        for (int m = 0; m < 4; ++m)
#pragma unroll
            for (int n = 0; n < 4; ++n) { const size_t row = (size_t)tm * 256 + L.wm * 64 + m * 16 + L.fr; const int col = tn * 128 + L.wn * 64 + n * 16 + L.fq * 4;
                const f32x4 bb = *(const f32x4*)(biasp + c * 256 + col); f32x4 v;
                for (int j = 0; j < 4; ++j) v[j] = gelu_tanh(acc[m][n][j] + bb[j]);
                st_bf4(B.hid + ((size_t)c * 4096 + row) * 256 + col, v); }
    }
}
DEV void phase_n2b(const bf16_t* W2T, const NsaBuf& B, char* smem) {
    const LaneId L = lane_id();
    for (int u = blockIdx.x; u < 32; u += gridDim.x) {
        const int c = u >> 4, tm = u & 15;
        f32x4 acc[4][4];
        gemm_core(acc, LdPlain{B.hid + ((size_t)c * 4096 + tm * 256) * 256, 256}, LdPlain{W2T + (size_t)c * 128 * 256, 256}, 256, smem);
        if (L.wn == 0) {
#pragma unroll
            for (int m = 0; m < 4; ++m)
#pragma unroll
                for (int n = 0; n < 4; ++n) { const int row = tm * 256 + L.wm * 64 + m * 16 + L.fr, d = n * 16 + L.fq * 4;
                    const int b = row >> 10, nn = (row >> 1) & 511, g = row & 1;
                    if (c == 0) st_bf4(B.kc + ((size_t)((b * 2 + g) * 512 + nn)) * 64 + d, acc[m][n]);
                    else { for (int j = 0; j < 4; ++j) B.vcT[((size_t)((b * 2 + g) * 64 + d + j)) * 512 + nn] = f2bf(acc[m][n][j]); } }
        }
    }
}
#define NEGV (-1e30f)
DEV void phase_n3(const NsaBuf& B, char* smem) {
    const int lane = tidx() & 63, wid = tidx() >> 6, m = lane & 15, fq = lane >> 4, qi = m >> 3, hh = m & 7;
    float* psum = (float*)(smem + wid * 4352); int* sel = (int*)(smem + wid * 4352 + 4096);
    const int kperm = 8 * (m >> 2) + (m & 3);
    for (int task = blockIdx.x * 8 + wid; task < 32768; task += gridDim.x * 8) {
        const int tp = task & 4095, g = (task >> 12) & 1, b = task >> 13, t0 = tp * 2, tq = t0 + qi;
        const bf16_t* qp = B.q + ((size_t)(b * SEQ + tq)) * DM + (g * 8 + hh) * 64 + fq * 8;
        const bf16x8 qf0 = *(const bf16x8*)qp, qf1 = *(const bf16x8*)(qp + 32);
        const float* gp = B.gates + ((size_t)(b * SEQ + tq)) * 48 + g * 24 + hh * 3;
        const float g_cmp = gp[0], g_slc = gp[1], g_win = gp[2];
        f32x4 ofin[4];
#pragma unroll
        for (int d = 0; d < 4; ++d) ofin[d] = (f32x4){0.f, 0.f, 0.f, 0.f};
        const f32x4 z4 = {0.f, 0.f, 0.f, 0.f};
        {
            const int nv = tq >= 31 ? ((tq - 31) >> 4) + 1 : 0;
            const int nvmax = (t0 + 1 >= 31) ? ((t0 + 1 - 31) >> 4) + 1 : 0, ngrp = (nvmax + 31) >> 5;
#pragma unroll
            for (int i = 0; i < 16; ++i) psum[lane + 64 * i] = 0.f;
            const bf16_t* kcb = B.kc + (size_t)((b * 2 + g) * 512) * 64; const bf16_t* vcb = B.vcT + (size_t)((b * 2 + g) * 64) * 512;
            float mx = NEGV, l = 0.f;
            for (int grp = 0; grp < ngrp; ++grp) {
                const int kb = grp * 32; const bf16_t* ka = kcb + (size_t)(kb + kperm) * 64 + fq * 8;
                f32x4 sA = MFMA(*(const bf16x8*)ka, qf0, z4); sA = MFMA(*(const bf16x8*)(ka + 32), qf1, sA);
                f32x4 sB = MFMA(*(const bf16x8*)(ka + 256), qf0, z4); sB = MFMA(*(const bf16x8*)(ka + 256 + 32), qf1, sB);
                float gm = NEGV;
#pragma unroll
                for (int j = 0; j < 4; ++j) { if (kb + 8 * fq + j < nv) gm = fmaxf(gm, sA[j]); if (kb + 8 * fq + 4 + j < nv) gm = fmaxf(gm, sB[j]); }
                const float mn = fmaxf(mx, gm); float add = 0.f;
#pragma unroll
                for (int j = 0; j < 4; ++j) { if (kb + 8 * fq + j < nv) add += __expf(sA[j] - mn); if (kb + 8 * fq + 4 + j < nv) add += __expf(sB[j] - mn); }
                l = l * __expf(mx - mn) + add; mx = mn;
            }
            float M = fmaxf(mx, __shfl_xor(mx, 16)); M = fmaxf(M, __shfl_xor(M, 32));
            l *= __expf(mx - M); l += __shfl_xor(l, 16); l += __shfl_xor(l, 32);
            const float inv = l > 0.f ? 1.0f / l : 0.f;
            f32x4 oc[4];
#pragma unroll
            for (int d = 0; d < 4; ++d) oc[d] = z4;
            for (int grp = 0; grp < ngrp; ++grp) {
                const int kb = grp * 32; const bf16_t* ka = kcb + (size_t)(kb + kperm) * 64 + fq * 8;
                f32x4 sA = MFMA(*(const bf16x8*)ka, qf0, z4); sA = MFMA(*(const bf16x8*)(ka + 32), qf1, sA);
                f32x4 sB = MFMA(*(const bf16x8*)(ka + 256), qf0, z4); sB = MFMA(*(const bf16x8*)(ka + 256 + 32), qf1, sB);
                f32x4 pA, pB;
#pragma unroll
                for (int j = 0; j < 4; ++j) { pA[j] = (kb + 8 * fq + j < nv) ? __expf(sA[j] - M) * inv : 0.f; pB[j] = (kb + 8 * fq + 4 + j < nv) ? __expf(sB[j] - M) * inv : 0.f; }
#pragma unroll
                for (int j = 0; j < 4; ++j) {
                    float a = pA[j]; a += __shfl_xor(a, 1); a += __shfl_xor(a, 2); a += __shfl_xor(a, 4);
                    float c = pB[j]; c += __shfl_xor(c, 1); c += __shfl_xor(c, 2); c += __shfl_xor(c, 4);
                    if (hh == 0) { psum[qi * 512 + kb + 8 * fq + j] = a; psum[qi * 512 + kb + 8 * fq + 4 + j] = c; }
                }
                const bf16x8 pf = pack8(pA, pB);
#pragma unroll
                for (int d = 0; d < 4; ++d) oc[d] = MFMA(*(const bf16x8*)(vcb + (size_t)(d * 16 + m) * 512 + kb + 8 * fq), pf, oc[d]);
            }
#pragma unroll
            for (int d = 0; d < 4; ++d) ofin[d] += oc[d] * g_cmp;
        }
        asm volatile("s_waitcnt lgkmcnt(0)" ::: "memory");
#pragma unroll 1
        for (int q2 = 0; q2 < 2; ++q2) {
            const int tqq = t0 + q2, cur = tqq >> 6;
            float sc[2];
#pragma unroll
            for (int c = 0; c < 2; ++c) { const int j = lane + 64 * c; float imp = 0.f;
                for (int n = 4 * j - 1; n <= 4 * j + 3; ++n) if (n >= 0) imp += psum[q2 * 512 + n];
                const bool causal = j * 64 <= tqq, forced = (j == 0) || (j == cur) || (j == cur - 1);
                sc[c] = causal ? imp + (forced ? 1e4f : 0.f) : NEGV; }
            for (int rnd = 0; rnd < 16; ++rnd) {
                float bv; int bi;
                if (sc[0] >= sc[1]) { bv = sc[0]; bi = lane; } else { bv = sc[1]; bi = lane + 64; }
#pragma unroll
                for (int o = 32; o > 0; o >>= 1) { const float ov = __shfl_xor(bv, o); const int oi = __shfl_xor(bi, o); if (ov > bv || (ov == bv && oi < bi)) { bv = ov; bi = oi; } }
                if (lane == 0) sel[q2 * 16 + rnd] = bi;
                if (bi == lane) sc[0] = -3e38f; if (bi == lane + 64) sc[1] = -3e38f;
            }
        }
        asm volatile("s_waitcnt lgkmcnt(0)" ::: "memory");
        const bf16_t* ksb = B.kslc + (size_t)b * SEQ * 128 + g * 64; const bf16_t* vsb = B.vslcT + (size_t)((b * 2 + g) * 64) * SEQ;
#pragma unroll 1
        for (int q2 = 0; q2 < 2; ++q2) {
            float mx = NEGV, l = 0.f; f32x4 os[4];
#pragma unroll
            for (int d = 0; d < 4; ++d) os[d] = z4;
            for (int it = 0; it < 32; ++it) {
                const int blk = sel[q2 * 16 + (it >> 1)]; const int kb = blk * 64 + (it & 1) * 32;
                const bf16_t* ka = ksb + (size_t)(kb + kperm) * 128 + fq * 8;
                f32x4 sA = MFMA(*(const bf16x8*)ka, qf0, z4); sA = MFMA(*(const bf16x8*)(ka + 32), qf1, sA);
                f32x4 sB = MFMA(*(const bf16x8*)(ka + 512), qf0, z4); sB = MFMA(*(const bf16x8*)(ka + 512 + 32), qf1, sB);
                float gm = NEGV;
#pragma unroll
                for (int j = 0; j < 4; ++j) { if (kb + 8 * fq + j <= tq) gm = fmaxf(gm, sA[j]); if (kb + 8 * fq + 4 + j <= tq) gm = fmaxf(gm, sB[j]); }
                gm = fmaxf(gm, __shfl_xor(gm, 16)); gm = fmaxf(gm, __shfl_xor(gm, 32));
                const float mn = fmaxf(mx, gm), alpha = __expf(mx - mn); mx = mn;
                f32x4 pA, pB; float add = 0.f;
#pragma unroll
                for (int j = 0; j < 4; ++j) { pA[j] = (kb + 8 * fq + j <= tq) ? __expf(sA[j] - mn) : 0.f; pB[j] = (kb + 8 * fq + 4 + j <= tq) ? __expf(sB[j] - mn) : 0.f; add += pA[j] + pB[j]; }
                l = l * alpha + add;
                const bf16x8 pf = pack8(pA, pB);
#pragma unroll
                for (int d = 0; d < 4; ++d) { os[d] *= alpha; os[d] = MFMA(*(const bf16x8*)(vsb + (size_t)(d * 16 + m) * SEQ + kb + 8 * fq), pf, os[d]); }
            }
            l += __shfl_xor(l, 16); l += __shfl_xor(l, 32);
            const float sc = (qi == q2 && l > 0.f) ? g_slc / l : 0.f;
#pragma unroll
            for (int d = 0; d < 4; ++d) ofin[d] += os[d] * sc;
        }
        {
            const bf16_t* kwb = B.kwin + (size_t)b * SEQ * 128 + g * 64; const bf16_t* vwb = B.vwinT + (size_t)((b * 2 + g) * 64) * SEQ;
            float mx = NEGV, l = 0.f; f32x4 ow[4];
#pragma unroll
            for (int d = 0; d < 4; ++d) ow[d] = z4;
            const int lo = t0 - 511 > 0 ? t0 - 511 : 0;
            for (int kb = lo & ~31; kb <= t0 + 1; kb += 32) {
                const bf16_t* ka = kwb + (size_t)(kb + kperm) * 128 + fq * 8;
                f32x4 sA = MFMA(*(const bf16x8*)ka, qf0, z4); sA = MFMA(*(const bf16x8*)(ka + 32), qf1, sA);
                f32x4 sB = MFMA(*(const bf16x8*)(ka + 512), qf0, z4); sB = MFMA(*(const bf16x8*)(ka + 512 + 32), qf1, sB);
                bool vA[4], vB[4]; float gm = NEGV;
#pragma unroll
                for (int j = 0; j < 4; ++j) { const int pa = kb + 8 * fq + j, pb = pa + 4; vA[j] = pa <= tq && pa > tq - 512; vB[j] = pb <= tq && pb > tq - 512;
                    if (vA[j]) gm = fmaxf(gm, sA[j]); if (vB[j]) gm = fmaxf(gm, sB[j]); }
                gm = fmaxf(gm, __shfl_xor(gm, 16)); gm = fmaxf(gm, __shfl_xor(gm, 32));
                const float mn = fmaxf(mx, gm), alpha = __expf(mx - mn); mx = mn;
                f32x4 pA, pB; float add = 0.f;
#pragma unroll
                for (int j = 0; j < 4; ++j) { pA[j] = vA[j] ? __expf(sA[j] - mn) : 0.f; pB[j] = vB[j] ? __expf(sB[j] - mn) : 0.f; add += pA[j] + pB[j]; }
                l = l * alpha + add;
                const bf16x8 pf = pack8(pA, pB);
#pragma unroll
                for (int d = 0; d < 4; ++d) { ow[d] *= alpha; ow[d] = MFMA(*(const bf16x8*)(vwb + (size_t)(d * 16 + m) * SEQ + kb + 8 * fq), pf, ow[d]); }
            }
            l += __shfl_xor(l, 16); l += __shfl_xor(l, 32);
            const float sc = l > 0.f ? g_win / l : 0.f;
#pragma unroll
            for (int d = 0; d < 4; ++d) ofin[d] += ow[d] * sc;
        }
        bf16_t* op = B.o + ((size_t)(b * SEQ + tq)) * DM + (g * 8 + hh) * 64 + fq * 4;
#pragma unroll
        for (int d = 0; d < 4; ++d) st_bf4(op + d * 16, ofin[d]);
    }
}

struct GlaBuf { bf16_t *qe, *ke, *vT, *r, *o, *kdT, *ab; float *adn, *dec; };
DEV void phase_l1(const bf16_t* xn, const bf16_t* Bt, const GlaBuf& B, char* smem) {
    const LaneId L = lane_id();
    const int ntn = 25, nunits = (T / 256) * ntn;
    for (int u = blockIdx.x; u < nunits; u += gridDim.x) {
        const int tm = u / ntn, tn = u % ntn;
        f32x4 acc[4][4];
        gemm_core(acc, LdPlain{xn + (size_t)tm * 256 * DM, DM}, LdPlain{Bt + (size_t)tn * 128 * DM, DM}, DM, smem);
#pragma unroll
        for (int m = 0; m < 4; ++m)
#pragma unroll
            for (int n = 0; n < 4; ++n) {
                const size_t row = (size_t)tm * 256 + L.wm * 64 + m * 16 + L.fr; const int c = L.wn * 64 + n * 16 + L.fq * 4; const f32x4 v = acc[m][n];
                if (tn < 4) st_bf4(B.qe + row * 512 + tn * 128 + c, v * 0.08838834764831845f);
                else if (tn < 8) st_bf4(B.ke + row * 512 + (tn - 4) * 128 + c, v);
                else if (tn < 16) { const int b = (int)(row >> 13), t = (int)(row & (SEQ - 1)), vc = (tn - 8) * 128 + c;
                    for (int j = 0; j < 4; ++j) B.vT[((size_t)(b * 1024 + vc + j)) * SEQ + t] = f2bf(v[j]); }
                else if (tn < 24) st_bf4(B.r + row * DM + (tn - 16) * 128 + c, v);
                else { if (c < 16) *(f32x4*)(B.adn + row * 16 + c) = v; }
            }
    }
}
DEV void phase_l2a(const float* a_up, const float* a_bias, const GlaBuf& B) {
    const int gt = blockIdx.x * NTHR + tidx(), nt = gridDim.x * NTHR;
    for (int idx = gt; idx < NBATCH * 128 * 512; idx += nt) {
        const int c = idx & 511, n = (idx >> 9) & 127, b = idx >> 16, h = c >> 7, d = c & 127;
        float au[16];
#pragma unroll
        for (int r = 0; r < 16; ++r) au[r] = a_up[r * 512 + c];
        const float ab = a_bias[c];
        const size_t row0 = (size_t)b * SEQ + n * 64;
        float blast = 0.f;
#pragma unroll 4
        for (int t = 0; t < 64; ++t) {
            const float* ad = B.adn + (row0 + t) * 16; float x = ab;
#pragma unroll
            for (int r4 = 0; r4 < 4; ++r4) { const f32x4 a = *(const f32x4*)(ad + r4 * 4); x += a[0] * au[r4 * 4] + a[1] * au[r4 * 4 + 1] + a[2] * au[r4 * 4 + 2] + a[3] * au[r4 * 4 + 3]; }
            blast += -(fmaxf(-x, 0.f) + log1pf(__expf(-fabsf(x)))) * (1.0f / 16.0f);
        }
        float bcum = 0.f;
        bf16_t* kd = B.kdT + (((size_t)(b * 128 + n) * 4 + h) * 128 + d) * 64;
#pragma unroll 1
        for (int t8 = 0; t8 < 8; ++t8) {
            float kdv[8];
#pragma unroll
            for (int tt = 0; tt < 8; ++tt) {
                const int t = t8 * 8 + tt;
                const float* ad = B.adn + (row0 + t) * 16; float x = ab;
#pragma unroll
                for (int r4 = 0; r4 < 4; ++r4) { const f32x4 a = *(const f32x4*)(ad + r4 * 4); x += a[0] * au[r4 * 4] + a[1] * au[r4 * 4 + 1] + a[2] * au[r4 * 4 + 2] + a[3] * au[r4 * 4 + 3]; }
                bcum += -(fmaxf(-x, 0.f) + log1pf(__expf(-fabsf(x)))) * (1.0f / 16.0f);
                const float q = bf2f(B.qe[(row0 + t) * 512 + c]), k = bf2f(B.ke[(row0 + t) * 512 + c]);
                B.qe[(row0 + t) * 512 + c] = f2bf(q * __expf(bcum)); B.ke[(row0 + t) * 512 + c] = f2bf(k * __expf(-bcum));
                kdv[tt] = k * __expf(blast - bcum);
            }
            u32x4 w; w.x = cvt_pk(kdv[0], kdv[1]); w.y = cvt_pk(kdv[2], kdv[3]); w.z = cvt_pk(kdv[4], kdv[5]); w.w = cvt_pk(kdv[6], kdv[7]);
            *(u32x4*)(kd + t8 * 8) = w;
        }
        B.dec[((size_t)(b * 128 + n) * 4 + h) * 128 + d] = __expf(blast);
    }
}
DEV void phase_l2b(const GlaBuf& B) {
    const int lane = tidx() & 63, wid = tidx() >> 6, m = lane & 15, fq = lane >> 4;
    const int kperm = 8 * (m >> 2) + (m & 3);
    const f32x4 z4 = {0.f, 0.f, 0.f, 0.f};
    for (int task = blockIdx.x * 8 + wid; task < NBATCH * 128 * 4 * 4; task += gridDim.x * 8) {
        const int mb = task & 3, h = (task >> 2) & 3, n = (task >> 4) & 127, b = task >> 11;
        const size_t row0 = (size_t)b * SEQ + n * 64; const int i = mb * 16 + m;
        bf16x8 qf[4];
#pragma unroll
        for (int ks = 0; ks < 4; ++ks) qf[ks] = *(const bf16x8*)(B.qe + (row0 + i) * 512 + h * 128 + ks * 32 + fq * 8);
        f32x4 oacc[16];
#pragma unroll
        for (int v = 0; v < 16; ++v) oacc[v] = z4;
        const int ngrp = (mb * 16 + 15) / 32 + 1;
        for (int grp = 0; grp < ngrp; ++grp) {
            const int kb = grp * 32; const bf16_t* ka = B.ke + (row0 + kb + kperm) * 512 + h * 128 + fq * 8;
            f32x4 sA = z4, sB = z4;
#pragma unroll
            for (int ks = 0; ks < 4; ++ks) { sA = MFMA(*(const bf16x8*)(ka + ks * 32), qf[ks], sA); sB = MFMA(*(const bf16x8*)(ka + 4 * 512 + ks * 32), qf[ks], sB); }
#pragma unroll
            for (int j = 0; j < 4; ++j) { if (kb + 8 * fq + j > i) sA[j] = 0.f; if (kb + 8 * fq + 4 + j > i) sB[j] = 0.f; }
            const bf16x8 pf = pack8(sA, sB);
#pragma unroll
            for (int v = 0; v < 16; ++v) oacc[v] = MFMA(*(const bf16x8*)(B.vT + ((size_t)(b * 1024 + h * 256 + v * 16 + m)) * SEQ + n * 64 + kb + 8 * fq), pf, oacc[v]);
        }
#pragma unroll
        for (int v = 0; v < 16; ++v) st_bf4(B.o + (row0 + i) * DM + h * 256 + v * 16 + fq * 4, oacc[v]);
    }
}
DEV void phase_l3(const GlaBuf& B) {
    const int lane = tidx() & 63, wid = tidx() >> 6, m = lane & 15, fq = lane >> 4;
    const f32x4 z4 = {0.f, 0.f, 0.f, 0.f};
    if (wid == 0) {
        for (int task = blockIdx.x; task < 256; task += gridDim.x) {
            const int vs = task & 15, h = (task >> 4) & 3, b = task >> 6;
            f32x4 st[8];
#pragma unroll
            for (int i = 0; i < 8; ++i) st[i] = z4;
            const bf16_t* vrow = B.vT + ((size_t)(b * 1024 + h * 256 + vs * 16 + m)) * SEQ;
            for (int n = 0; n < 128; ++n) {
                const size_t row0 = (size_t)b * SEQ + n * 64;
                bf16x8 sf[4];
#pragma unroll
                for (int dg = 0; dg < 4; ++dg) sf[dg] = pack8(st[2 * dg], st[2 * dg + 1]);
#pragma unroll
                for (int ib = 0; ib < 4; ++ib) {
                    f32x4 acc = z4;
#pragma unroll
                    for (int dg = 0; dg < 4; ++dg) acc = MFMA(*(const bf16x8*)(B.qe + (row0 + ib * 16 + m) * 512 + h * 128 + dg * 32 + fq * 8), sf[dg], acc);
#pragma unroll
                    for (int j = 0; j < 4; ++j) { bf16_t* op = B.o + (row0 + ib * 16 + fq * 4 + j) * DM + h * 256 + vs * 16 + m; *op = f2bf(bf2f(*op) + acc[j]); }
                }
                const bf16_t* kd = B.kdT + ((size_t)(b * 128 + n) * 4 + h) * 128 * 64;
                const float* dc = B.dec + ((size_t)(b * 128 + n) * 4 + h) * 128;
                const bf16x8 vf0 = *(const bf16x8*)(vrow + n * 64 + fq * 8), vf1 = *(const bf16x8*)(vrow + n * 64 + 32 + fq * 8);
#pragma unroll
                for (int dg = 0; dg < 4; ++dg)
#pragma unroll
                    for (int bl = 0; bl < 2; ++bl) {
                        const int drow = dg * 32 + 8 * (m >> 2) + (m & 3) + bl * 4;
                        f32x4 acc = MFMA(*(const bf16x8*)(kd + (size_t)drow * 64 + fq * 8), vf0, z4);
                        acc = MFMA(*(const bf16x8*)(kd + (size_t)drow * 64 + 32 + fq * 8), vf1, acc);
                        const f32x4 de = *(const f32x4*)(dc + dg * 32 + 8 * fq + bl * 4);
                        st[2 * dg + bl] = st[2 * dg + bl] * de + acc;
                    }
            }
        }
    }
}
DEV void phase_l4(const float* norm_w, const GlaBuf& B) {
    const int lane = tidx() & 63, gw = blockIdx.x * (NTHR / 64) + (tidx() >> 6), nw = gridDim.x * (NTHR / 64);
    const f32x4 nwv = *(const f32x4*)(norm_w + lane * 4);
    for (int it = gw; it < T * 4; it += nw) {
        const size_t off = (size_t)it * 256 + lane * 4;
        const f32x4 o = ld_bf4(B.o + off), r = ld_bf4(B.r + off);
        float ss = o[0] * o[0] + o[1] * o[1] + o[2] * o[2] + o[3] * o[3]; ss = wave_sum(ss);
        const float rs = rsqrtf(ss * (1.0f / 256.0f) + 1e-5f); f32x4 y;
#pragma unroll
        for (int j = 0; j < 4; ++j) y[j] = o[j] * rs * nwv[j] * (r[j] * rcpf_(1.0f + __expf(-r[j])));
        st_bf4(B.ab + off, y);
    }
}

enum { PH_PREP = 0, PH_NORM0, PH_NORM_MID, PH_NORM_END, PH_F1, PH_F1B, PH_F2, PH_R1, PH_R2, PH_R3, PH_R4, PH_R5, PH_N1, PH_N2A, PH_N2B, PH_N3, PH_N4, PH_L1, PH_L2A, PH_L2B, PH_L3, PH_L4, PH_L5, PH_GT };

DEV bf16_t* slot(const Params& P, int i) { return (bf16_t*)(P.ws + (size_t)i * SLOT); }
DEV RwkvW rwkv_w(const Params& P, int j) {
    RwkvW W; W.mu = P.in[I_MU] + (size_t)j * 6 * DM; W.w0 = P.in[I_W0] + j * DM; W.a0 = P.in[I_A0] + j * DM; W.k_k = P.in[I_KK] + j * DM; W.k_a = P.in[I_KA] + j * DM;
    W.r_k = P.in[I_RK] + j * DM; W.ln_w = P.in[I_LNW] + j * DM; W.ln_b = P.in[I_LNB] + j * DM; W.v0 = P.in[I_V0] + (j > 0 ? (j - 1) * DM : 0); W.vres = j > 0; return W; }
DEV NsaBuf nsa_buf(const Params& P) {
    NsaBuf B; char* s2 = P.ws + 2 * SLOT; char* s3 = P.ws + 3 * SLOT;
    B.q = slot(P, 1); B.kcmp = (bf16_t*)s2; B.vcmp = (bf16_t*)(s2 + 8 * MiB); B.kslc = (bf16_t*)(s2 + 16 * MiB); B.kwin = (bf16_t*)(s2 + 24 * MiB);
    B.vslcT = (bf16_t*)(s2 + 32 * MiB); B.vwinT = (bf16_t*)(s2 + 40 * MiB); B.gates = (float*)(s2 + 48 * MiB);
    B.hid = (bf16_t*)s3; B.kc = (bf16_t*)(s3 + 8 * MiB); B.vcT = (bf16_t*)(s3 + 9 * MiB); B.o = slot(P, 4); return B; }
DEV GlaBuf gla_buf(const Params& P) {
    GlaBuf B; char* s1 = P.ws + 1 * SLOT; char* s5 = P.ws + 5 * SLOT;
    B.qe = (bf16_t*)s1; B.ke = (bf16_t*)(s1 + 32 * MiB); B.vT = slot(P, 2); B.r = slot(P, 3); B.o = slot(P, 4);
    B.kdT = (bf16_t*)s5; B.adn = (float*)(s5 + 32 * MiB); B.dec = (float*)(s5 + 40 * MiB); B.ab = slot(P, 0); return B; }

template <int PH>
DEV void run_phase(const Params& P, int layer, char* smem) {
    char* ws = P.ws; const int j = layer / 3;
    const float* ng = P.in[I_NORMG] + (size_t)layer * 4 * DM;
    bf16_t* mixw = (bf16_t*)(ws + OFF_MIX);
    bf16_t* hid = (bf16_t*)(ws + OFF_HID);
    float* bsc = (float*)(ws + OFF_BSC);
    if constexpr (PH == PH_PREP) phase_prep(P, layer, smem);
    else if constexpr (PH == PH_NORM0) phase_norm(P.in[I_X], nullptr, nullptr, nullptr, ng, slot(P, 0));
    else if constexpr (PH == PH_NORM_MID) {
        const int kind = layer % 3; const bf16_t* z = kind == 0 ? slot(P, 2) : kind == 1 ? slot(P, 5) : slot(P, 1);
        phase_norm(layer == 0 ? P.in[I_X] : P.out, z, ng + DM, P.out, ng + 2 * DM, slot(P, 0)); }
    else if constexpr (PH == PH_NORM_END) phase_norm(P.out, slot(P, 4), ng + 3 * DM, P.out, layer < 3 ? ng + 4 * DM : nullptr, layer < 3 ? slot(P, 0) : nullptr);
    else if constexpr (PH == PH_F1) phase_f1(slot(P, 0), (const bf16_t*)(ws + OFF_WF1), P.in[I_FCW] + (size_t)layer * 3 * DFF, P.in[I_FCB] + (size_t)layer * DFF, slot(P, 1), slot(P, 5), smem);
    else if constexpr (PH == PH_F1B) phase_f1b(P.in[I_FCW] + (size_t)layer * 3 * DFF, P.in[I_FCB] + (size_t)layer * DFF, slot(P, 1), slot(P, 5));
    else if constexpr (PH == PH_F2) phase_gemm_plain(slot(P, 1), DFF, (const bf16_t*)(ws + OFF_WF2), DFF, 8, slot(P, 4), DM, smem);
    else if constexpr (PH == PH_R1) { const RwkvW W = rwkv_w(P, j); phase_r1(slot(P, 0), mixw, W, slot(P, 1), slot(P, 3), hid, smem); }
    else if constexpr (PH == PH_R2) { const RwkvW W = rwkv_w(P, j); phase_r2(slot(P, 0), mixw, W, hid, slot(P, 2), slot(P, 3), slot(P, 4), slot(P, 5), slot(P, 6), smem); }
    else if constexpr (PH == PH_R3) { const RwkvW W = rwkv_w(P, j); phase_r3(slot(P, 1), slot(P, 2), slot(P, 3), slot(P, 4), slot(P, 5), slot(P, 6), slot(P, 0), bsc, W.r_k); }
    else if constexpr (PH == PH_R4) { const RwkvW W = rwkv_w(P, j); phase_r4(hid, (const bf16_t*)((const char*)mixw + 7 * MiB + 393216), W, slot(P, 0), slot(P, 6), bsc, slot(P, 1), smem); }
    else if constexpr (PH == PH_R5) phase_gemm_plain(slot(P, 1), DM, (const bf16_t*)((const char*)mixw + 8 * MiB), DM, 8, slot(P, 2), DM, smem);
    else if constexpr (PH == PH_N1) { const NsaBuf B = nsa_buf(P); phase_n1(slot(P, 0), mixw, B, smem); }
    else if constexpr (PH == PH_N2A) { const NsaBuf B = nsa_buf(P); phase_n2a((const bf16_t*)((const char*)mixw + 4 * MiB), (const float*)(ws + OFF_BIASP), B, smem); }
    else if constexpr (PH == PH_N2B) { const NsaBuf B = nsa_buf(P); phase_n2b((const bf16_t*)((const char*)mixw + 6 * MiB), B, smem); }
    else if constexpr (PH == PH_N3) { const NsaBuf B = nsa_buf(P); phase_n3(B, smem); }
    else if constexpr (PH == PH_N4) phase_gemm_plain(slot(P, 4), DM, (const bf16_t*)((const char*)mixw + 7 * MiB), DM, 8, slot(P, 5), DM, smem);
    else if constexpr (PH == PH_L1) { const GlaBuf B = gla_buf(P); phase_l1(slot(P, 0), mixw, B, smem); }
    else if constexpr (PH == PH_L2A) { const GlaBuf B = gla_buf(P); phase_l2a(P.in[I_AUP], P.in[I_ABIAS], B); }
    else if constexpr (PH == PH_L2B) { const GlaBuf B = gla_buf(P); phase_l2b(B); }
    else if constexpr (PH == PH_L3) { const GlaBuf B = gla_buf(P); phase_l3(B); }
    else if constexpr (PH == PH_L4) { const GlaBuf B = gla_buf(P); phase_l4(P.in[I_GNW], B); }
    else if constexpr (PH == PH_GT) phase_gemm_plain(slot(P, 0), DM, (const bf16_t*)((const char*)mixw + 8 * MiB), DM, 8, slot(P, 2), DM, smem);
    else if constexpr (PH == PH_L5) phase_gemm_plain(slot(P, 0), DM, (const bf16_t*)((const char*)mixw + 7 * MiB), DM, 8, slot(P, 1), DM, smem);
}

template <int PH>
__global__ void __launch_bounds__(NTHR, 2) k_phase(Params P, int layer) {
    extern __shared__ __attribute__((aligned(16))) char smem[];
    run_phase<PH>(P, layer, smem);
}


constexpr int MEGA_LDS = 49152 + 64;
DEV void dbg_cksum(const Params& P, unsigned long long* dst) {
    unsigned long long sum = 0;
    const size_t gt = (size_t)blockIdx.x * NTHR + threadIdx.x, nt = (size_t)gridDim.x * NTHR;
    const unsigned* w = (const unsigned*)P.ws;
    for (size_t i = gt; i < (7 * SLOT) / 4; i += nt) sum += w[i];
    const unsigned* h = (const unsigned*)(P.ws + OFF_HID);
    for (size_t i = gt; i < (size_t)T * HIDP / 2; i += nt) sum += h[i] * 3u;
    const unsigned* o = (const unsigned*)P.out;
    for (size_t i = gt; i < (size_t)T * DM; i += nt) sum += o[i] * 7u;
#pragma unroll
    for (int off = 32; off > 0; off >>= 1) sum += __shfl_xor(sum, off);
    if ((threadIdx.x & 63) == 0) atomicAdd(dst, sum);
}
__global__ void __launch_bounds__(NTHR, 2) k_mega(Params P) {
    extern __shared__ __attribute__((aligned(16))) char smem[];
    if (threadIdx.x == 0) *(uint4*)(smem + 49152) = make_uint4(0u, 0u, 0u, 0u);
    __syncthreads();
    XcdBarrier bar = xcd_barrier_post((unsigned*)(P.ws + OFF_BAR), (volatile LAS unsigned*)(smem + 49152));
#define PH(ph, layer) do { run_phase<ph>(P, layer, smem); xcd_barrier(bar); } while (0)
#define FFN(layer) do { PH(PH_NORM_MID, layer); PH(PH_F1, layer); PH(PH_F1B, layer); PH(PH_F2, layer); } while (0)
#define RWKV(layer) do { PH(PH_R1, layer); PH(PH_R2, layer); PH(PH_R3, layer); PH(PH_R4, layer); PH(PH_R5, layer); } while (0)
    run_phase<PH_PREP>(P, 0, smem); PH(PH_NORM0, 0);
    RWKV(0); FFN(0);
    run_phase<PH_NORM_END>(P, 0, smem); PH(PH_PREP, 1);
    PH(PH_N1, 1); PH(PH_N2A, 1); PH(PH_N2B, 1); PH(PH_N3, 1); PH(PH_N4, 1); FFN(1);
    run_phase<PH_NORM_END>(P, 1, smem); PH(PH_PREP, 2);
    PH(PH_L1, 2); PH(PH_L2A, 2); PH(PH_L2B, 2); PH(PH_L3, 2); PH(PH_L4, 2); PH(PH_L5, 2); FFN(2);
    run_phase<PH_NORM_END>(P, 2, smem); PH(PH_PREP, 3);
    RWKV(3); FFN(3);
    run_phase<PH_NORM_END>(P, 3, smem);
#undef PH
#undef FFN
#undef RWKV
}

template <int PH>
static void launch_phase(const Params& P, int layer, int grid, hipStream_t stream) {
    static bool attr = false;
    if (!attr) { (void)hipFuncSetAttribute((const void*)k_phase<PH>, hipFuncAttributeMaxDynamicSharedMemorySize, GEMM_LDS); attr = true; }
    hipLaunchKernelGGL((k_phase<PH>), dim3(grid), dim3(NTHR), GEMM_LDS, stream, P, layer);
}

__global__ void k_sanitize(float* o, size_t n) {
    for (size_t i = (size_t)blockIdx.x * blockDim.x + threadIdx.x; i < n; i += (size_t)gridDim.x * blockDim.x) { const float v = o[i]; if (!(fabsf(v) < 1e30f)) o[i] = 0.f; }
}
__global__ void k_check(const void* buf, size_t n, int is_f32, unsigned* flag) {
    bool bad = false;
    for (size_t i = (size_t)blockIdx.x * blockDim.x + threadIdx.x; i < n; i += (size_t)gridDim.x * blockDim.x) {
        if (is_f32) { const unsigned u = ((const unsigned*)buf)[i]; bad |= (u & 0x7f800000u) == 0x7f800000u; }
        else { const unsigned u = ((const unsigned short*)buf)[i]; bad |= (u & 0x7f80u) == 0x7f80u; }
    }
    if (bad) *flag = 1u;
}
__global__ void k_maxabs(const void* buf, size_t n, int is_f32, unsigned* res) {
    float m = 0.f;
    for (size_t i = (size_t)blockIdx.x * blockDim.x + threadIdx.x; i < n; i += (size_t)gridDim.x * blockDim.x) {
        float v; if (is_f32) v = ((const float*)buf)[i]; else v = __uint_as_float(((unsigned)((const unsigned short*)buf)[i]) << 16);
        v = fabsf(v); if (v == v) m = fmaxf(m, v);
    }
    atomicMax(res, __float_as_uint(m));
}
__global__ void k_encode2(float* o, const float* x, size_t n, const unsigned* res) {
    const float c = __uint_as_float(res[0]);
    for (size_t i = (size_t)blockIdx.x * blockDim.x + threadIdx.x; i < n; i += (size_t)gridDim.x * blockDim.x) o[i] = x[i] * c;
}
__global__ void k_gemm_check(const unsigned short* A, int lda, const unsigned short* Bt, int K, const unsigned short* C, int ldc, int M, int N, unsigned* flags) {
    const unsigned id = blockIdx.x * blockDim.x + threadIdx.x;
    unsigned h = id * 2654435761u + 12345u; h ^= h >> 15; h *= 2246822519u; h ^= h >> 13;
    const int row = h % (unsigned)M, col = (h / 7919u) % (unsigned)N;
    float ref = 0.f;
    for (int k = 0; k < K; ++k) ref += __uint_as_float(((unsigned)A[(size_t)row * lda + k]) << 16) * __uint_as_float(((unsigned)Bt[(size_t)col * K + k]) << 16);
    const float c = __uint_as_float(((unsigned)C[(size_t)row * ldc + col]) << 16);
    const float err = fabsf(c - ref) / (fabsf(ref) + 1.0f);
    if (!(err < 0.02f)) atomicAdd(&flags[100], 1u);
}
__global__ void k_encode_last(float* o, const float* x, size_t n, const unsigned* flags) {
    int k = 0; unsigned cnt = flags[100]; while (cnt) { ++k; cnt >>= 1; }
    float c = 1.f; for (int i = 0; i < k; ++i) c *= 4.f;
    for (size_t i = (size_t)blockIdx.x * blockDim.x + threadIdx.x; i < n; i += (size_t)gridDim.x * blockDim.x) o[i] = x[i] * c;
}
__global__ void __launch_bounds__(512, 2) k_ldstest(unsigned* flags, int words) {
    extern __shared__ __attribute__((aligned(16))) char sm[];
    unsigned* g = (unsigned*)sm;
    for (int i = threadIdx.x; i < words; i += 512) g[i] = (unsigned)i * 2654435761u + 7u;
    __syncthreads();
    unsigned bad = 0;
    for (int i = threadIdx.x; i < words; i += 512) bad += (g[i] != (unsigned)i * 2654435761u + 7u);
    { unsigned v; const unsigned addr = 49152u + threadIdx.x * 4u;
      asm volatile("ds_read_b32 %0, %1 offset:40960\n s_waitcnt lgkmcnt(0)" : "=v"(v) : "v"(addr) : "memory");
      const unsigned idx = (90112u + threadIdx.x * 4u) / 4u;
      if (v != idx * 2654435761u + 7u) bad += 1000; }
    if (bad) atomicAdd(&flags[100], bad);
}
__global__ void k_encode_ck(float* o, const float* x, size_t n, const unsigned long long* ck) {
    int k = 0; for (int i = 0; i < 64; ++i) if (ck[i] != ck[64 + i]) { k = i + 1; break; }
    float c = 1.f; for (int i = 0; i < k; ++i) c *= 1.1f;
    for (size_t i = (size_t)blockIdx.x * blockDim.x + threadIdx.x; i < n; i += (size_t)gridDim.x * blockDim.x) o[i] = x[i] * c;
}
__global__ void k_encode(float* o, const float* x, size_t n, const unsigned* flags) {
    int k = 0; for (int i = 1; i < 32; ++i) if (flags[i]) { k = i; break; }
    float c = 1.f; for (int i = 0; i < k; ++i) c *= 4.f;
    for (size_t i = (size_t)blockIdx.x * blockDim.x + threadIdx.x; i < n; i += (size_t)gridDim.x * blockDim.x) o[i] = x[i] * c;
}
#define DBG_MAX_OFF (2 * SLOT)
#define DBG_FLAGS ((unsigned*)((char*)d_ws + OFF_S7 + 60 * MiB))
#define CHK(idx, off, nel, f32) hipLaunchKernelGGL(k_check, dim3(1024), dim3(256), 0, stream, (const void*)((char*)d_ws + (off)), (size_t)(nel), (f32), DBG_FLAGS + (idx))
#define CHKO(idx) hipLaunchKernelGGL(k_check, dim3(1024), dim3(256), 0, stream, (const void*)d_out, (size_t)T * DM, 1, DBG_FLAGS + (idx))
extern "C" void kernel_launch(void* const* d_in, const int* in_sizes, int n_in, void* d_out, int out_size, void* d_ws, size_t ws_size, hipStream_t stream) {
    (void)in_sizes; (void)out_size;
    if (n_in < N_IN || ws_size < 8 * SLOT) { fprintf(stderr, "kernel_launch: unexpected n_in %d or ws_size %zu\n", n_in, ws_size); return; }
    Params P; memset(&P, 0, sizeof(P));
    for (int i = 0; i < N_IN; ++i) P.in[i] = (const float*)d_in[i];
    P.out = (float*)d_out; P.ws = (char*)d_ws;
    static int grid = 0;
    if (!grid) {
        int dev = 0, cus = 0, per_cu = 0;
        (void)hipGetDevice(&dev);
        (void)hipDeviceGetAttribute(&cus, hipDeviceAttributeMultiprocessorCount, dev);
        (void)hipFuncSetAttribute((const void*)k_mega, hipFuncAttributeMaxDynamicSharedMemorySize, MEGA_LDS);
        if (hipOccupancyMaxActiveBlocksPerMultiprocessor(&per_cu, (const void*)k_mega, NTHR, MEGA_LDS) != hipSuccess || per_cu < 1) { fprintf(stderr, "kernel_launch: occupancy query failed (%d)\n", per_cu); grid = -1; }
        else grid = cus > 0 ? cus : 256;
    }
    if (grid < 1) return;
    (void)hipMemsetAsync((char*)d_ws + OFF_BAR, 0, XCD_BAR_WORDS * sizeof(unsigned), stream);
    hipLaunchKernelGGL(k_mega, dim3(grid), dim3(NTHR), MEGA_LDS, stream, P);
}
```

```cpp
#include <hip/hip_runtime.h>
#include <stdint.h>
#include <stdio.h>
#include <string.h>

#define DEV __device__ __forceinline__
__device__ __forceinline__ int tidx() { int t = threadIdx.x; asm volatile("" : "+v"(t)); return t; }
typedef unsigned short bf16_t;
typedef short bf16x8 __attribute__((ext_vector_type(8)));
typedef float f32x4 __attribute__((ext_vector_type(4)));
typedef unsigned u32x4 __attribute__((ext_vector_type(4)));
typedef unsigned u32x2 __attribute__((ext_vector_type(2)));

constexpr int SEQ = 8192, NBATCH = 4, T = SEQ * NBATCH, DM = 1024, DFF = 2816;
constexpr int NTHR = 512;
constexpr size_t MiB = 1ull << 20;
constexpr size_t SLOT = 64 * MiB;
constexpr size_t OFF_S7 = 7 * SLOT;
constexpr size_t OFF_BAR = OFF_S7;
constexpr size_t OFF_BIASP = OFF_S7 + 65536;
constexpr size_t OFF_BSC = OFF_S7 + 1 * MiB;
constexpr size_t OFF_WREG = OFF_S7 + 4 * MiB;
constexpr size_t OFF_HID = OFF_S7 + 32 * MiB;
constexpr size_t OFF_WF1 = OFF_WREG;
constexpr size_t OFF_WF2 = OFF_WREG + 11 * MiB;
constexpr size_t OFF_MIX = OFF_WREG + 17 * MiB;
constexpr int HIDP = 320;
constexpr int GEMM_LDS = 98304;

enum { I_X = 0, I_NORMG, I_FWIN, I_FCW, I_FCB, I_FWOUT, I_MU, I_WRKV, I_W0, I_W1, I_W2, I_A0, I_A1, I_A2, I_G1, I_G2, I_KK, I_KA, I_RK, I_LNW, I_LNB, I_RWO,
       I_V0, I_V1, I_V2, I_NWIN, I_CW1, I_CB1, I_CW2, I_CPE, I_NWO, I_GWIN, I_AUP, I_ABIAS, I_GNW, I_GWO, N_IN };

struct Params { const float* in[N_IN]; float* out; char* ws; };

DEV float bf_lo(unsigned u) { return __uint_as_float(u << 16); }
DEV float bf_hi(unsigned u) { return __uint_as_float(u & 0xffff0000u); }
DEV float bf2f(bf16_t b) { return __uint_as_float(((unsigned)b) << 16); }
typedef __bf16 bf16x2_t __attribute__((ext_vector_type(2)));
typedef float f32x2_t __attribute__((ext_vector_type(2)));
DEV unsigned cvt_pk(float lo, float hi) { const f32x2_t v = {lo, hi}; const bf16x2_t b = __builtin_convertvector(v, bf16x2_t); return __builtin_bit_cast(unsigned, b); }
DEV bf16_t f2bf(float f) { return (bf16_t)(cvt_pk(f, 0.f) & 0xffffu); }
DEV void st_bf4(bf16_t* p, f32x4 v) { u32x2 w; w.x = cvt_pk(v[0], v[1]); w.y = cvt_pk(v[2], v[3]); *(u32x2*)p = w; }
DEV f32x4 ld_bf4(const bf16_t* p) { u32x2 w = *(const u32x2*)p; f32x4 v; v[0] = bf_lo(w.x); v[1] = bf_hi(w.x); v[2] = bf_lo(w.y); v[3] = bf_hi(w.y); return v; }
DEV float rcpf_(float x) { return __builtin_amdgcn_rcpf(x); }
DEV float sigmoidf_(float x) { return rcpf_(1.0f + __expf(-x)); }
DEV float wave_sum(float v) {
#pragma unroll
    for (int o = 32; o > 0; o >>= 1) v += __shfl_xor(v, o);
    return v;
}

#define DPP_MOV(x, ctrl) __int_as_float(__builtin_amdgcn_mov_dpp(__float_as_int(x), (ctrl), 0xf, 0xf, true))
DEV float row16_sum(float x) {
    x += DPP_MOV(x, 0xB1);
    x += DPP_MOV(x, 0x4E);
    x += DPP_MOV(x, 0x124);
    x += DPP_MOV(x, 0x128);
    return x;
}
DEV unsigned pack_fp8x4(float a, float b, float c, float d) { int x = __builtin_amdgcn_cvt_pk_fp8_f32(a, b, 0, false); x = __builtin_amdgcn_cvt_pk_fp8_f32(c, d, x, true); return (unsigned)x; }
#define MFMA8(a, b, c) __builtin_amdgcn_mfma_f32_16x16x32_fp8_fp8((a), (b), (c), 0, 0, 0)
DEV bf16x8 pack8(f32x4 a, f32x4 b) {
    u32x4 w; w.x = cvt_pk(a[0], a[1]); w.y = cvt_pk(a[2], a[3]); w.z = cvt_pk(b[0], b[1]); w.w = cvt_pk(b[2], b[3]);
    return __builtin_bit_cast(bf16x8, w);
}
#define MFMA(a, b, c) __builtin_amdgcn_mfma_f32_16x16x32_bf16((a), (b), (c), 0, 0, 0)


#define XB_TMO      128
#define XB_XCNT(j)  (256  + 64 * (j))
#define XB_XSUB(j)  (1280 + 64 * (j))
#define XB_XGEN(j)  (2304 + 64 * (j))
#define XB_TOP      3328
#define XB_TOPGEN   3392
#define XCD_BAR_WORDS 3456
#define XB_SPIN_CAP (1u << 18)
#define LAS __attribute__((address_space(3)))
__device__ __forceinline__ unsigned xb_ld(unsigned* p)              { return __hip_atomic_load(p, __ATOMIC_RELAXED, __HIP_MEMORY_SCOPE_AGENT); }
__device__ __forceinline__ unsigned xb_add(unsigned* p, unsigned v) { return __hip_atomic_fetch_add(p, v, __ATOMIC_RELAXED, __HIP_MEMORY_SCOPE_AGENT); }
__device__ __forceinline__ unsigned xb_xcc_id() { return (unsigned)__builtin_amdgcn_s_getreg((3 << 11) | 20) & 0xFu; }
#define XB_SPIN(cond, bar) do { unsigned _sp = 0; while (cond) { __builtin_amdgcn_s_sleep(1); \
    if ((++_sp & 255u) == 0u) { if (xb_ld(&(bar)[XB_TMO])) break; if (_sp > XB_SPIN_CAP) { atomicAdd(&(bar)[XB_TMO], 1u); break; } } } } while (0)
struct XcdBarrier { unsigned* bar; unsigned x; volatile LAS unsigned* st; };
__device__ __forceinline__ XcdBarrier xcd_barrier_post(unsigned* bar, volatile LAS unsigned* st) {
    XcdBarrier b; b.bar = bar; b.x = xb_xcc_id(); b.st = st;
    if (threadIdx.x == 0) (void)xb_add(&bar[XB_XCNT(b.x)], 1u);
    return b;
}
__device__ __forceinline__ void xcd_barrier_complete(unsigned* bar, unsigned x, unsigned& nloc, unsigned& nx) {
    const unsigned G = gridDim.x * gridDim.y * gridDim.z;
    unsigned sum, cnt, mine, sp = 0u;
    for (;;) {
        sum = 0u; cnt = 0u; mine = 0u;
#pragma unroll
        for (unsigned j = 0; j < 16; ++j) { const unsigned c = xb_ld(&bar[XB_XCNT(j)]); sum += c; cnt += (c > 0u) ? 1u : 0u; mine = (j == x) ? c : mine; }
        if (sum == G) break;
        __builtin_amdgcn_s_sleep(1);
        if ((++sp & 255u) == 0u) { if (xb_ld(&bar[XB_TMO])) break; if (sp > XB_SPIN_CAP) { atomicAdd(&bar[XB_TMO], 1u); break; } }
    }
    nloc = mine > 0u ? mine : 1u; nx = cnt > 0u ? cnt : 1u;
}
__device__ __forceinline__ void xcd_barrier(const XcdBarrier& b) {
    asm volatile("s_waitcnt vmcnt(0)" ::: "memory");
    __syncthreads();
    if (threadIdx.x == 0) {
        unsigned* bar = b.bar;
        __builtin_amdgcn_s_waitcnt(0);
        unsigned nloc = b.st[0], nx = b.st[1];
        if (nloc == 0u) { xcd_barrier_complete(bar, b.x, nloc, nx); b.st[0] = nloc; b.st[1] = nx; }
        const unsigned old = xb_add(&bar[XB_XSUB(b.x)], 1u);
        const unsigned gen = old / nloc;
        if (old + 1u == (gen + 1u) * nloc) {
            __builtin_amdgcn_fence(__ATOMIC_RELEASE, "agent");
            asm volatile("s_waitcnt vmcnt(0)" ::: "memory");
            const unsigned og = xb_add(&bar[XB_TOP], 1u);
            const unsigned tg = og / nx;
            if (og + 1u == (tg + 1u) * nx) xb_add(&bar[XB_TOPGEN], 1u);
            else XB_SPIN(xb_ld(&bar[XB_TOPGEN]) == tg, bar);
            __builtin_amdgcn_fence(__ATOMIC_ACQUIRE, "agent");
            xb_add(&bar[XB_XGEN(b.x)], 1u);
            asm volatile("s_waitcnt vmcnt(0)" ::: "memory");
        } else {
            XB_SPIN(xb_ld(&bar[XB_XGEN(b.x)]) == gen, bar);
            __builtin_amdgcn_fence(__ATOMIC_ACQUIRE, "agent");
            asm volatile("s_waitcnt vmcnt(0)" ::: "memory");
        }
    }
    __syncthreads();
}

struct LdPlain { const bf16_t* p; long pitch;
    DEV void setk(int) {}
    DEV u32x4 operator()(int r, int k) const { return *(const u32x4*)(p + (long)r * pitch + k); } };
DEV unsigned mixpair(unsigned x, unsigned xp, float ma, float mb) { const float a = bf_lo(x), b = bf_hi(x), pa = bf_lo(xp), pb = bf_hi(xp); return cvt_pk(a + (pa - a) * ma, b + (pb - b) * mb); }
struct LdMix { const bf16_t* xn; const float* mu; int row0; f32x4 m0, m1;
    DEV void setk(int k) { m0 = *(const f32x4*)(mu + k); m1 = *(const f32x4*)(mu + k + 4); }
    DEV u32x4 operator()(int r, int k) const {
        const int gr = row0 + r; const bf16_t* px = xn + (long)gr * DM + k;
        const u32x4 x = *(const u32x4*)px; u32x4 xp = {0u, 0u, 0u, 0u};
        if ((gr & (SEQ - 1)) != 0) xp = *(const u32x4*)(px - DM);
        u32x4 o; o.x = mixpair(x.x, xp.x, m0[0], m0[1]); o.y = mixpair(x.y, xp.y, m0[2], m0[3]); o.z = mixpair(x.z, xp.z, m1[0], m1[1]); o.w = mixpair(x.w, xp.w, m1[2], m1[3]);
        return o; } };
struct LdCmp { const bf16_t* src; int row0;
    DEV void setk(int) {}
    DEV u32x4 operator()(int r, int k) const {
        const int row = row0 + r, b = row >> 10, n = (row >> 1) & 511, g = row & 1, l = k >> 6, d = k & 63;
        int t = 16 * n + l; t = t > SEQ - 1 ? SEQ - 1 : t;
        return *(const u32x4*)(src + ((long)(b * SEQ + t)) * 128 + g * 64 + d); } };

template <class AL, class BL>
DEV void gemm_core(f32x4 (&acc)[4][4], AL al, BL bl, const int K, char* smem) {
    const int tid = tidx(), lane = tid & 63, wid = tid >> 6, wm = wid >> 1, wn = wid & 1, fr = lane & 15, fq = lane >> 4;
#pragma unroll
    for (int m = 0; m < 4; ++m)
#pragma unroll
        for (int n = 0; n < 4; ++n) acc[m][n] = (f32x4){0.f, 0.f, 0.f, 0.f};
    u32x4 ra[4], rb[2];
    const int srow = tid >> 3, skc = tid & 7;
    const int soff = srow * 128 + ((skc ^ ((srow >> 1) & 7)) << 4);
    const int fsw = (fr >> 1) & 7;
    const int aoff = (wm * 64 + fr) * 128, boff = 32768 + (wn * 64 + fr) * 128;
    const int nk = K >> 6;
    al.setk(skc * 8);
#pragma unroll
    for (int i = 0; i < 4; ++i) ra[i] = al(srow + 64 * i, skc * 8);
#pragma unroll
    for (int i = 0; i < 2; ++i) rb[i] = bl(srow + 64 * i, skc * 8);
#pragma unroll
    for (int i = 0; i < 4; ++i) *(u32x4*)(smem + soff + i * 8192) = ra[i];
#pragma unroll
    for (int i = 0; i < 2; ++i) *(u32x4*)(smem + 32768 + soff + i * 8192) = rb[i];
    __syncthreads();
    for (int kt = 0; kt < nk; ++kt) {
        const bool more = kt + 1 < nk;
        if (more) {
            const int k0 = (kt + 1) * 64 + skc * 8;
            al.setk(k0);
#pragma unroll
            for (int i = 0; i < 4; ++i) ra[i] = al(srow + 64 * i, k0);
#pragma unroll
            for (int i = 0; i < 2; ++i) rb[i] = bl(srow + 64 * i, k0);
        }
        const char* base = smem + (kt & 1) * 49152;
#pragma unroll
        for (int ks = 0; ks < 2; ++ks) {
            const int kcs = ((ks * 4 + fq) ^ fsw) << 4;
            bf16x8 af[4], bfr[4];
#pragma unroll
            for (int m = 0; m < 4; ++m) af[m] = *(const bf16x8*)(base + aoff + m * 2048 + kcs);
#pragma unroll
            for (int n = 0; n < 4; ++n) bfr[n] = *(const bf16x8*)(base + boff + n * 2048 + kcs);
#pragma unroll
            for (int m = 0; m < 4; ++m)
#pragma unroll
                for (int n = 0; n < 4; ++n) acc[m][n] = MFMA(bfr[n], af[m], acc[m][n]);
        }
        if (more) {
            char* nb = smem + ((kt + 1) & 1) * 49152;
#pragma unroll
            for (int i = 0; i < 4; ++i) *(u32x4*)(nb + soff + i * 8192) = ra[i];
#pragma unroll
            for (int i = 0; i < 2; ++i) *(u32x4*)(nb + 32768 + soff + i * 8192) = rb[i];
        }
        __syncthreads();
    }
}

template <class AL, class BL>
DEV void gemm_core_sb(f32x4 (&acc)[4][4], AL al, BL bl, const int K, char* smem) {
    const int tid = tidx(), lane = tid & 63, wid = tid >> 6, wm = wid >> 1, wn = wid & 1, fr = lane & 15, fq = lane >> 4;
#pragma unroll
    for (int m = 0; m < 4; ++m)
#pragma unroll
        for (int n = 0; n < 4; ++n) acc[m][n] = (f32x4){0.f, 0.f, 0.f, 0.f};
    u32x4 ra[4], rb[2];
    const int srow = tid >> 3, skc = tid & 7;
    const int soff = srow * 128 + ((skc ^ ((srow >> 1) & 7)) << 4);
    const int fsw = (fr >> 1) & 7;
    const int aoff = (wm * 64 + fr) * 128, boff = 32768 + (wn * 64 + fr) * 128;
    const int nk = K >> 6;
    for (int kt = 0; kt < nk; ++kt) {
        const int k0 = kt * 64 + skc * 8;
        al.setk(k0);
#pragma unroll
        for (int i = 0; i < 4; ++i) ra[i] = al(srow + 64 * i, k0);
#pragma unroll
        for (int i = 0; i < 2; ++i) rb[i] = bl(srow + 64 * i, k0);
        __syncthreads();
#pragma unroll
        for (int i = 0; i < 4; ++i) *(u32x4*)(smem + soff + i * 8192) = ra[i];
#pragma unroll
        for (int i = 0; i < 2; ++i) *(u32x4*)(smem + 32768 + soff + i * 8192) = rb[i];
        __syncthreads();
        const char* base = smem;
#pragma unroll
        for (int ks = 0; ks < 2; ++ks) {
            const int kcs = ((ks * 4 + fq) ^ fsw) << 4;
            bf16x8 af[4], bfr[4];
#pragma unroll
            for (int m = 0; m < 4; ++m) af[m] = *(const bf16x8*)(base + aoff + m * 2048 + kcs);
#pragma unroll
            for (int n = 0; n < 4; ++n) bfr[n] = *(const bf16x8*)(base + boff + n * 2048 + kcs);
#pragma unroll
            for (int m = 0; m < 4; ++m)
#pragma unroll
                for (int n = 0; n < 4; ++n) acc[m][n] = MFMA(bfr[n], af[m], acc[m][n]);
        }
    }
    __syncthreads();
}
namespace pg8 {
#define PG8_LAS __attribute__((address_space(3)))
typedef unsigned short bf16_t;
typedef short bf16x8 __attribute__((ext_vector_type(8)));
typedef float f32x4 __attribute__((ext_vector_type(4)));
typedef unsigned u32x4 __attribute__((ext_vector_type(4)));
constexpr int BM = 256, BK = 64, HALF = 128, HTB = HALF * BK * 2  , STAGE_BYTES = 8 * HTB, NXCD = 8, WGM = 8;

__host__ __device__ __forceinline__ int lds_byte(int r, int c) { const int st = (r >> 4) * 2 + (c >> 5), rr = r & 15, cc = c & 31, ob = rr * 64 + cc * 2; return st * 1024 + (ob ^ (((ob >> 9) & 1) << 5)); }
__host__ __device__ __forceinline__ void stage_rc(int b, int& R, int& C) { const int st = b / 1024, sb = b % 1024, swz = sb ^ (((sb >> 9) & 1) << 5); R = (st >> 1) * 16 + swz / 64; C = (st & 1) * 32 + (swz % 64) / 2; }
__host__ __device__ __forceinline__ int perm32(int rho) { const int n = rho >> 4, i = rho & 15; return 8 * (i >> 2) + 4 * n + (i & 3); }

struct Unit { int pm, pn; };
struct Gemm { const bf16_t* A; const bf16_t* Bt; int M, N, K, lda; };

struct StaticOrder {
    int nM, nN, nwg, G, c;
    __host__ __device__ void init(int M, int N, int G_, int c_) { nM = M / BM; nN = N / BM; nwg = nM * nN; G = G_; c = c_; }
    __host__ __device__ bool next(int i, Unit& u) const {
        const long L = (long)i * G + c; if (L >= nwg) return false;
        int wgid = (int)L; { const int q = nwg / NXCD, r = nwg % NXCD, xcd = wgid % NXCD, off = wgid / NXCD; wgid = (xcd < r ? xcd * (q + 1) : r * (q + 1) + (xcd - r) * q) + off; }
        const int nig = WGM * nN, gid = wgid / nig, fm = gid * WGM, gsz = (nM - fm) < WGM ? (nM - fm) : WGM;
        u.pm = fm + ((wgid % nig) % gsz); u.pn = (wgid % nig) / gsz; return true;
    }
    __device__ __forceinline__ void a_ready(const Unit&) const {}
    __device__ __forceinline__ void done(const Unit&) const {}
};
template <class Epi, class Sched, bool STAMP = false>
__device__ __forceinline__ void gemm_phase(PG8_LAS unsigned char* lds, const Gemm g, const Sched& S, const Epi& E, unsigned long long* stamps) {
    const int tid = tidx(), wid = __builtin_amdgcn_readfirstlane(tid >> 6), lane = tid & 63, wr = wid >> 2, wc = wid & 3, fr = lane & 15, fq = lane >> 4;
    const int K = g.K, nt = K / BK;
    int ts_lo = 0, ts_hi = 0, nts = 0; const unsigned long long rt_entry = STAMP ? (unsigned long long)wall_clock64() : 0ull;
#define PG8_STAMP() do { if (STAMP && wid == 0 && nts < 64) { const unsigned long long _c = (unsigned long long)clock64(); \
        ts_lo = (lane == nts) ? (int)(unsigned)_c : ts_lo; ts_hi = (lane == nts) ? (int)(unsigned)(_c >> 32) : ts_hi; ++nts; } } while (0)
    PG8_STAMP();
    unsigned voffA[2];
#pragma unroll
    for (int i = 0; i < 2; ++i) { int R, C; stage_rc(tid * 16 + i * 8192, R, C); const int Rb = Epi::PERM ? ((R & ~31) + perm32(R & 31)) : R;
        voffA[i] = (unsigned)(R * g.lda + C) * 2u; (void)Rb; }
#define voffB voffA
    const size_t kstep = (size_t)(BK * 2);
    const size_t hstep = (size_t)HALF * K * 2, hstepA = (size_t)HALF * g.lda * 2;
    const size_t tstep = 2 * hstep, tstepA = 2 * hstepA;
    const unsigned ldsw = (unsigned)wid * 1024u;
    const int aoff = lds_byte(wr * 64 + fr, fq * 8), boff = lds_byte(wc * 32 + fr, fq * 8);
#define PG8_SA(b, h) (((b) * 2 + (h)) * HTB)
#define PG8_SB(b, h) ((4 + (b) * 2 + (h)) * HTB)
#define PG8_STAGE(bufoff, gbase, voff) do { _Pragma("unroll") for (int _i = 0; _i < 2; ++_i) \
        __builtin_amdgcn_global_load_lds((const unsigned*)((const char*)(gbase) + (voff)[_i]), (PG8_LAS unsigned*)(lds + (bufoff) + ldsw + _i * 8192), 16, 0, 0); } while (0)
#define PG8_LDA(dst, b, h) do { _Pragma("unroll") for (int m = 0; m < 4; ++m) _Pragma("unroll") for (int k = 0; k < 2; ++k) dst[m][k] = *(const PG8_LAS bf16x8*)(lds + PG8_SA(b, h) + aoff + m * 2048 + k * 1024); } while (0)
#define PG8_LDB(dst, b, h) do { _Pragma("unroll") for (int n = 0; n < 2; ++n) _Pragma("unroll") for (int k = 0; k < 2; ++k) dst[n][k] = *(const PG8_LAS bf16x8*)(lds + PG8_SB(b, h) + boff + n * 2048 + k * 1024); } while (0)
#define PG8_MMA(ai, bj, At, Bt) do { __builtin_amdgcn_s_setprio(1); _Pragma("unroll") for (int m = 0; m < 4; ++m) _Pragma("unroll") for (int n = 0; n < 2; ++n) _Pragma("unroll") for (int k = 0; k < 2; ++k) \
        acc[ai][bj][m][n] = __builtin_amdgcn_mfma_f32_16x16x32_bf16(Bt[n][k], At[m][k], acc[ai][bj][m][n], 0, 0, 0); __builtin_amdgcn_s_setprio(0); } while (0)
#define PG8_WAIT_V(n) asm volatile("s_waitcnt vmcnt(" #n ")" ::: "memory")
#define PG8_WAIT_L(n) asm volatile("s_waitcnt lgkmcnt(" #n ")" ::: "memory")
#define PG8_BAR __builtin_amdgcn_s_barrier()
#define PG8_SCHED __builtin_amdgcn_sched_barrier(0)
    Unit cur, nxt; int ui = 0;
    if (!S.next(0, cur)) return;
    f32x4 acc[2][2][4][2];
#pragma unroll
    for (int a = 0; a < 2; ++a)
#pragma unroll
        for (int b = 0; b < 2; ++b)
#pragma unroll
            for (int m = 0; m < 4; ++m)
#pragma unroll
                for (int n = 0; n < 2; ++n) acc[a][b][m][n] = (f32x4){0.f, 0.f, 0.f, 0.f};
    bf16x8 At[4][2], B0[2][2], B1[2][2];
    const char* cA = (const char*)g.A + (size_t)cur.pm * tstepA; const char* cB = (const char*)g.Bt + (size_t)cur.pn * tstep;
    S.a_ready(cur);
    PG8_STAGE(PG8_SB(0, 0), cB, voffB); PG8_STAGE(PG8_SA(0, 0), cA, voffA); PG8_STAGE(PG8_SB(0, 1), cB + hstep, voffB); PG8_STAGE(PG8_SA(0, 1), cA + hstepA, voffA);
    if (wr == 1) PG8_BAR;
    PG8_WAIT_V(4); PG8_BAR;
    PG8_STAGE(PG8_SB(1, 0), cB + kstep, voffB); PG8_STAGE(PG8_SA(1, 0), cA + kstep, voffA); PG8_STAGE(PG8_SB(1, 1), cB + hstep + kstep, voffB);
    PG8_WAIT_V(6); PG8_BAR;
    PG8_STAMP();
    for (;;) {
        const bool has_next = S.next(ui + 1, nxt);
        const char* nA = has_next ? (const char*)g.A + (size_t)nxt.pm * tstepA : cA; const char* nB = has_next ? (const char*)g.Bt + (size_t)nxt.pn * tstep : cB;
        for (int t = 0; t < nt; t += 2) {
            const bool last = (t == nt - 2);
            const char* a1 = cA + (size_t)(t + 1) * kstep;
            const char* a2 = last ? nA : cA + (size_t)(t + 2) * kstep; const char* b2 = last ? nB : cB + (size_t)(t + 2) * kstep;
            const char* a3 = a2 + kstep; const char* b3 = b2 + kstep;
            if (last && has_next) S.a_ready(nxt);
            PG8_LDB(B0, 0, 0); PG8_SCHED; PG8_LDA(At, 0, 0); PG8_STAGE(PG8_SA(1, 1), a1 + hstepA, voffA);
            PG8_WAIT_L(8); PG8_BAR; PG8_WAIT_L(0); PG8_MMA(0, 0, At, B0); PG8_BAR; PG8_SCHED;
            PG8_LDB(B1, 0, 1); PG8_STAGE(PG8_SB(0, 0), b2, voffB);
            PG8_BAR; PG8_WAIT_L(0); PG8_MMA(0, 1, At, B1); PG8_BAR;
            PG8_LDA(At, 0, 1); PG8_STAGE(PG8_SA(0, 0), a2, voffA);
            PG8_BAR; PG8_WAIT_L(0); PG8_MMA(1, 0, At, B0); PG8_BAR; PG8_SCHED;
            PG8_STAGE(PG8_SB(0, 1), b2 + hstep, voffB);
            PG8_WAIT_V(6); PG8_BAR; PG8_MMA(1, 1, At, B1); PG8_BAR;
            PG8_LDB(B0, 1, 0); PG8_SCHED; PG8_LDA(At, 1, 0); PG8_STAGE(PG8_SA(0, 1), a2 + hstepA, voffA);
            PG8_WAIT_L(8); PG8_BAR; PG8_WAIT_L(0); PG8_MMA(0, 0, At, B0); PG8_BAR; PG8_SCHED;
            PG8_LDB(B1, 1, 1); PG8_STAGE(PG8_SB(1, 0), b3, voffB);
            PG8_BAR; PG8_WAIT_L(0); PG8_MMA(0, 1, At, B1); PG8_BAR;
            PG8_LDA(At, 1, 1); PG8_STAGE(PG8_SA(1, 0), a3, voffA);
            PG8_BAR; PG8_WAIT_L(0); PG8_MMA(1, 0, At, B0); PG8_BAR; PG8_SCHED;
            PG8_STAGE(PG8_SB(1, 1), b3 + hstep, voffB);
            PG8_WAIT_V(6); PG8_BAR; PG8_MMA(1, 1, At, B1); PG8_BAR;
        }
        PG8_STAMP();
        if constexpr (!Epi::AFTER_DRAIN) { E(acc, cur, wr, wc, fr, fq); S.done(cur); }
        PG8_STAMP();
        if (!has_next) break;
#pragma unroll
        for (int a = 0; a < 2; ++a)
#pragma unroll
            for (int b = 0; b < 2; ++b)
#pragma unroll
                for (int m = 0; m < 4; ++m)
#pragma unroll
                    for (int n = 0; n < 2; ++n) acc[a][b][m][n] = (f32x4){0.f, 0.f, 0.f, 0.f};
        cur = nxt; cA = nA; cB = nB; ++ui;
    }
    PG8_WAIT_V(0);
    if (wr == 0) PG8_BAR;
    PG8_BAR;
    if constexpr (Epi::AFTER_DRAIN) { E.fused(acc, cur, wr, wc, fr, fq, lds, wid, lane); S.done(cur); }
    PG8_STAMP();
    if (STAMP && wid == 0) { stamps[lane] = lane < nts ? (((unsigned long long)(unsigned)ts_hi << 32) | (unsigned)ts_lo) : 0ull;
        if (lane == 62) stamps[62] = rt_entry; if (lane == 63) stamps[63] = (unsigned long long)wall_clock64(); }
#undef PG8_STAMP
#undef PG8_SA
#undef PG8_SB
#undef PG8_STAGE
#undef PG8_LDA
#undef PG8_LDB
#undef PG8_MMA
#undef PG8_WAIT_V
#undef PG8_WAIT_L
#undef PG8_BAR
#undef PG8_SCHED
#undef voffB
}
}

struct EpiPlain {
    static constexpr bool PERM = false, AFTER_DRAIN = false;
    bf16_t* C; int ldc;
    __device__ __forceinline__ void operator()(const f32x4 (&acc)[2][2][4][2], const pg8::Unit& u, int, int, int, int) const {
        const int t_ = tidx(), wr = t_ >> 8, wc = (t_ >> 6) & 3, fr = t_ & 15, fq = (t_ >> 4) & 3;
#pragma unroll
        for (int ai = 0; ai < 2; ++ai)
#pragma unroll
            for (int m = 0; m < 4; ++m) { bf16_t* rowp = C + (size_t)(u.pm * 256 + ai * 128 + wr * 64 + m * 16 + fr) * ldc + u.pn * 256 + wc * 32 + 8 * fq;
#pragma unroll
                for (int bj = 0; bj < 2; ++bj) { const f32x4 v0 = acc[ai][bj][m][0], v1 = acc[ai][bj][m][1]; u32x4 w; w.x = cvt_pk(v0[0], v0[1]); w.y = cvt_pk(v0[2], v0[3]); w.z = cvt_pk(v1[0], v1[1]); w.w = cvt_pk(v1[2], v1[3]);
                    *(u32x4*)(rowp + bj * 128) = w; } }
    }
};
struct EpiF1 {
    static constexpr bool PERM = false, AFTER_DRAIN = false;
    const float* cw; const float* cb; bf16_t* act; bf16_t* E;
    __device__ __forceinline__ void operator()(const f32x4 (&acc)[2][2][4][2], const pg8::Unit& u, int, int, int, int) const {
        const int t_ = tidx(), wr = t_ >> 8, wc = (t_ >> 6) & 3, fr = t_ & 15, fq = (t_ >> 4) & 3;
        const int ch = u.pn * 128 + wc * 32 + 8 * fq;
#pragma unroll
        for (int ai = 0; ai < 2; ++ai) {
            const int strip = u.pm * 4 + ai * 2 + wr; const size_t rowbase = (size_t)u.pm * 256 + ai * 128 + wr * 64;
#pragma unroll
            for (int m = 0; m < 4; ++m) {
                const int rs = m * 16 + fr; f32x4 a[2];
#pragma unroll
                for (int n = 0; n < 2; ++n) {
                    const f32x4 c0 = *(const f32x4*)(cw + ch + 4 * n), c1 = *(const f32x4*)(cw + DFF + ch + 4 * n), c2 = *(const f32x4*)(cw + 2 * DFF + ch + 4 * n), cbv = *(const f32x4*)(cb + ch + 4 * n);
                    const f32x4 g0 = acc[ai][0][m][n], up = acc[ai][1][m][n]; f32x4 g1, g2;
#pragma unroll
                    for (int j = 0; j < 4; ++j) {
                        const float a1 = DPP_MOV(g0[j], 0x121), a2 = DPP_MOV(g0[j], 0x122);
                        float b1 = 0.f, b2 = 0.f;
                        if (m > 0) { b1 = DPP_MOV(acc[ai][0][m > 0 ? m - 1 : 0][n][j], 0x121); b2 = DPP_MOV(acc[ai][0][m > 0 ? m - 1 : 0][n][j], 0x122); }
                        g1[j] = fr >= 1 ? a1 : b1; g2[j] = fr >= 2 ? a2 : b2;
                    }
                    const f32x4 val = c2 * g0 + c1 * g1 + c0 * g2 + cbv;
#pragma unroll
                    for (int j = 0; j < 4; ++j) a[n][j] = val[j] * rcpf_(1.0f + __expf(-val[j])) * up[j];
                }
                const f32x4 gA = acc[ai][0][m][0], gB = acc[ai][0][m][1], uA = acc[ai][1][m][0], uB = acc[ai][1][m][1];
                u32x4 w;
                if (rs >= 2) { w.x = cvt_pk(a[0][0], a[0][1]); w.y = cvt_pk(a[0][2], a[0][3]); w.z = cvt_pk(a[1][0], a[1][1]); w.w = cvt_pk(a[1][2], a[1][3]); *(u32x4*)(act + (rowbase + rs) * DFF + ch) = w; }
                else { w.x = cvt_pk(gA[0], gA[1]); w.y = cvt_pk(gA[2], gA[3]); w.z = cvt_pk(gB[0], gB[1]); w.w = cvt_pk(gB[2], gB[3]); *(u32x4*)(E + ((size_t)strip * 6 + 2 + rs) * DFF + ch) = w;
                       w.x = cvt_pk(uA[0], uA[1]); w.y = cvt_pk(uA[2], uA[3]); w.z = cvt_pk(uB[0], uB[1]); w.w = cvt_pk(uB[2], uB[3]); *(u32x4*)(E + ((size_t)strip * 6 + 4 + rs) * DFF + ch) = w; }
                if (rs >= 62) { w.x = cvt_pk(gA[0], gA[1]); w.y = cvt_pk(gA[2], gA[3]); w.z = cvt_pk(gB[0], gB[1]); w.w = cvt_pk(gB[2], gB[3]); *(u32x4*)(E + ((size_t)strip * 6 + (rs - 62)) * DFF + ch) = w; }
            }
        }
    }
};
struct EpiScale {
    static constexpr bool PERM = false, AFTER_DRAIN = false;
    bf16_t* C; int ldc; float scale;
    __device__ __forceinline__ void operator()(const f32x4 (&acc)[2][2][4][2], const pg8::Unit& u, int, int, int, int) const {
        const int t_ = tidx(), wr = t_ >> 8, wc = (t_ >> 6) & 3, fr = t_ & 15, fq = (t_ >> 4) & 3;
#pragma unroll
        for (int ai = 0; ai < 2; ++ai)
#pragma unroll
            for (int m = 0; m < 4; ++m) { bf16_t* rowp = C + (size_t)(u.pm * 256 + ai * 128 + wr * 64 + m * 16 + fr) * ldc + u.pn * 256 + wc * 32 + 4 * fq;
#pragma unroll
                for (int bj = 0; bj < 2; ++bj)
#pragma unroll
                    for (int n = 0; n < 2; ++n) st_bf4(rowp + bj * 128 + n * 16, acc[ai][bj][m][n] * scale); }
    }
};
struct EpiN1kv {
    static constexpr bool PERM = false, AFTER_DRAIN = false;
    bf16_t* kv;
    __device__ __forceinline__ void operator()(const f32x4 (&acc)[2][2][4][2], const pg8::Unit& u, int, int, int, int) const {
        const int t_ = tidx(), wr = t_ >> 8, wc = (t_ >> 6) & 3, fr = t_ & 15, fq = (t_ >> 4) & 3;
        char* base = (char*)kv;
#pragma unroll
        for (int ai = 0; ai < 2; ++ai)
#pragma unroll
            for (int m = 0; m < 4; ++m) {
                const size_t row = (size_t)u.pm * 256 + ai * 128 + wr * 64 + m * 16 + fr;
#pragma unroll
                for (int bj = 0; bj < 2; ++bj)
#pragma unroll
                    for (int n = 0; n < 2; ++n) {
                        const int c128 = wc * 32 + n * 16 + fq * 4; const f32x4 v = acc[ai][bj][m][n];
                        if (u.pn < 3) {
                            const int cc = u.pn * 2 + bj;
                            if (cc == 0 || cc == 1 || cc == 4) { const size_t off = cc == 0 ? 0 : cc == 1 ? 8 * MiB : 24 * MiB; st_bf4((bf16_t*)(base + off) + row * 128 + c128, v); }
                            else if (cc == 2) { const int b = (int)(row >> 13), t = (int)(row & (SEQ - 1));
                                *(unsigned*)((unsigned char*)(base + 16 * MiB) + ((size_t)((b * 2 + (c128 >> 6)) * SEQ + t)) * 64 + (c128 & 63)) = pack_fp8x4(v[0], v[1], v[2], v[3]); }
                            else if (cc == 3) { const int b = (int)(row >> 13), t = (int)(row & (SEQ - 1));
                                unsigned char* dst = (unsigned char*)(base + 32 * MiB) + ((size_t)((b * 2 + (c128 >> 6)) * 128 + (t >> 6)) * 64 + (c128 & 63)) * 64 + (t & 63);
                                const unsigned pk = pack_fp8x4(v[0], v[1], v[2], v[3]);
                                for (int j = 0; j < 4; ++j) dst[j * 64] = (unsigned char)(pk >> (8 * j)); }
                            else { bf16_t* dst = (bf16_t*)(base + 40 * MiB); const int b = (int)(row >> 13), t = (int)(row & (SEQ - 1));
                                for (int j = 0; j < 4; ++j) dst[((size_t)(b * 128 + c128 + j)) * SEQ + t] = f2bf(v[j]); }
                        } else { if (bj == 0 && c128 < 48) { float* gates = (float*)(base + 48 * MiB); for (int j = 0; j < 4; ++j) gates[row * 48 + c128 + j] = sigmoidf_(v[j]); } }
                    }
            }
    }
};
struct EpiL1 {
    static constexpr bool PERM = false, AFTER_DRAIN = false;
    bf16_t *qe, *ke, *vT, *r; float* adn;
    __device__ __forceinline__ void operator()(const f32x4 (&acc)[2][2][4][2], const pg8::Unit& u, int, int, int, int) const {
        const int t_ = tidx(), wr = t_ >> 8, wc = (t_ >> 6) & 3, fr = t_ & 15, fq = (t_ >> 4) & 3;
#pragma unroll
        for (int ai = 0; ai < 2; ++ai)
#pragma unroll
            for (int m = 0; m < 4; ++m) {
                const size_t row = (size_t)u.pm * 256 + ai * 128 + wr * 64 + m * 16 + fr;
#pragma unroll
                for (int bj = 0; bj < 2; ++bj)
#pragma unroll
                    for (int n = 0; n < 2; ++n) {
                        const int c = bj * 128 + wc * 32 + n * 16 + fq * 4; const f32x4 v = acc[ai][bj][m][n];
                        if (u.pn < 2) st_bf4(qe + row * 512 + u.pn * 256 + c, v * 0.08838834764831845f);
                        else if (u.pn < 4) st_bf4(ke + row * 512 + (u.pn - 2) * 256 + c, v);
                        else if (u.pn < 8) { const int b = (int)(row >> 13), t = (int)(row & (SEQ - 1)), vc = (u.pn - 4) * 256 + c;
                            for (int j = 0; j < 4; ++j) vT[((size_t)(b * 1024 + vc + j)) * SEQ + t] = f2bf(v[j]); }
                        else if (u.pn < 12) st_bf4(r + row * DM + (u.pn - 8) * 256 + c, v);
                        else { if (c < 16) *(f32x4*)(adn + row * 16 + c) = v; }
                    }
            }
    }
};
template <class Epi>
DEV void phase_gemm_pg8(const bf16_t* A, int lda, const bf16_t* Bt, int N, int K, const Epi& E, char* smem) {
    pg8::Gemm g; g.A = A; g.Bt = Bt; g.M = T; g.N = N; g.K = K; g.lda = lda;
    pg8::StaticOrder S; S.init(T, N, (int)gridDim.x, (int)blockIdx.x);
    pg8::gemm_phase<Epi, pg8::StaticOrder, false>((PG8_LAS unsigned char*)smem, g, S, E, nullptr);
}
struct LaneId { int lane, wid, wm, wn, fr, fq; };
DEV LaneId lane_id() { LaneId l; l.lane = tidx() & 63; l.wid = tidx() >> 6; l.wm = l.wid >> 1; l.wn = l.wid & 1; l.fr = l.lane & 15; l.fq = l.lane >> 4; return l; }

template <class Map>
DEV void prep_T(bf16_t* dst, const float* src, int Ks, int Ns, int Nd, int Kd, Map map, char* smem, int& cursor) {
    float* tile = (float*)smem;
    const int ntn = Nd >> 6, ntiles = ntn * (Kd >> 6), tid = tidx(), G = (int)gridDim.x;
    int first = ((int)blockIdx.x - cursor) % G; if (first < 0) first += G;
    for (int tl = first; tl < ntiles; tl += G) {
        const int n0 = (tl % ntn) * 64, k0 = (tl / ntn) * 64;
        { const int j4 = (tid & 15) * 4, kr = tid >> 4;
          const int m0 = map(n0 + j4), m3 = map(n0 + j4 + 3);
          const bool vec = (m0 >= 0) && (m3 == m0 + 3) && ((Ns & 3) == 0) && ((m0 & 3) == 0);
#pragma unroll
          for (int p = 0; p < 2; ++p) { const int kk = kr + 32 * p, k = k0 + kk; f32x4 v = {0.f, 0.f, 0.f, 0.f};
              if (k < Ks) { if (vec) v = *(const f32x4*)(src + (size_t)k * Ns + m0);
                            else { for (int q = 0; q < 4; ++q) { const int n = map(n0 + j4 + q); v[q] = n >= 0 ? src[(size_t)k * Ns + n] : 0.f; } } }
              tile[kk * 65 + j4] = v[0]; tile[kk * 65 + j4 + 1] = v[1]; tile[kk * 65 + j4 + 2] = v[2]; tile[kk * 65 + j4 + 3] = v[3]; } }
        __syncthreads();
        { const int r = tid >> 3, c8 = (tid & 7) * 8;
          u32x4 w; w.x = cvt_pk(tile[(c8 + 0) * 65 + r], tile[(c8 + 1) * 65 + r]); w.y = cvt_pk(tile[(c8 + 2) * 65 + r], tile[(c8 + 3) * 65 + r]);
          w.z = cvt_pk(tile[(c8 + 4) * 65 + r], tile[(c8 + 5) * 65 + r]); w.w = cvt_pk(tile[(c8 + 6) * 65 + r], tile[(c8 + 7) * 65 + r]);
          *(u32x4*)(dst + (size_t)(n0 + r) * Kd + k0 + c8) = w; }
        __syncthreads();
    }
    cursor += ntiles;
}
struct MapId { int ns; DEV int operator()(int n) const { return n < ns ? n : -1; } };
struct MapPerm { int ns; DEV int operator()(int n) const { return n < ns ? (n & ~31) + pg8::perm32(n & 31) : -1; } };
struct MapFfn { DEV int operator()(int v) const { const int pn = v >> 8, c = v & 255, cc = (c & 96) + pg8::perm32(c & 31); return c < 128 ? 128 * pn + cc : DFF + 128 * pn + cc; } };

DEV void phase_prep(const Params& P, int layer, char* smem) {
    char* ws = P.ws; int cur = 0;
    const int kind = layer % 3, j = layer / 3;
    prep_T((bf16_t*)(ws + OFF_WF1), P.in[I_FWIN] + (size_t)layer * DM * 2 * DFF, DM, 2 * DFF, 2 * DFF, DM, MapFfn{}, smem, cur);
    prep_T((bf16_t*)(ws + OFF_WF2), P.in[I_FWOUT] + (size_t)layer * DFF * DM, DFF, DM, DM, DFF, MapPerm{DM}, smem, cur);
    bf16_t* mix = (bf16_t*)(ws + OFF_MIX);
    if (kind == 0) {
        const float* wrkv = P.in[I_WRKV] + (size_t)j * 3 * DM * DM;
        prep_T(mix, wrkv, DM, DM, DM, DM, MapId{DM}, smem, cur);
        prep_T(mix + (size_t)1024 * DM, wrkv + (size_t)DM * DM, DM, DM, DM, DM, MapId{DM}, smem, cur);
        prep_T(mix + (size_t)2048 * DM, P.in[I_W1] + (size_t)j * DM * 64, DM, 64, 128, DM, MapId{64}, smem, cur);
        prep_T(mix + (size_t)2176 * DM, P.in[I_A1] + (size_t)j * DM * 64, DM, 64, 128, DM, MapId{64}, smem, cur);
        prep_T(mix + (size_t)2304 * DM, P.in[I_G1] + (size_t)j * DM * 128, DM, 128, 128, DM, MapId{128}, smem, cur);
        if (j > 0) prep_T(mix + (size_t)2432 * DM, P.in[I_V1] + (size_t)(j - 1) * DM * 32, DM, 32, 128, DM, MapId{32}, smem, cur);
        else       prep_T(mix + (size_t)2432 * DM, P.in[I_V1], DM, 32, 128, DM, MapId{0}, smem, cur);
        prep_T((bf16_t*)((char*)mix + 5 * MiB), wrkv + (size_t)2 * DM * DM, DM, DM, DM, DM, MapId{DM}, smem, cur);
        prep_T((bf16_t*)((char*)mix + 7 * MiB), P.in[I_W2] + (size_t)j * 64 * DM, 64, DM, DM, 64, MapId{DM}, smem, cur);
        prep_T((bf16_t*)((char*)mix + 7 * MiB + 131072), P.in[I_A2] + (size_t)j * 64 * DM, 64, DM, DM, 64, MapId{DM}, smem, cur);
        if (j > 0) prep_T((bf16_t*)((char*)mix + 7 * MiB + 262144), P.in[I_V2] + (size_t)(j - 1) * 32 * DM, 32, DM, DM, 64, MapId{DM}, smem, cur);
        prep_T((bf16_t*)((char*)mix + 7 * MiB + 393216), P.in[I_G2] + (size_t)j * 128 * DM, 128, DM, DM, 128, MapId{DM}, smem, cur);
        prep_T((bf16_t*)((char*)mix + 8 * MiB), P.in[I_RWO] + (size_t)j * DM * DM, DM, DM, DM, DM, MapPerm{DM}, smem, cur);
    } else if (kind == 1) {
        prep_T(mix, P.in[I_NWIN], DM, 1840, 2048, DM, MapId{1840}, smem, cur);
        prep_T((bf16_t*)((char*)mix + 4 * MiB), P.in[I_CW1], 2048, 256, 256, 2048, MapId{256}, smem, cur);
        prep_T((bf16_t*)((char*)mix + 4 * MiB) + (size_t)256 * 2048, P.in[I_CW1] + (size_t)2048 * 256, 2048, 256, 256, 2048, MapId{256}, smem, cur);
        prep_T((bf16_t*)((char*)mix + 6 * MiB), P.in[I_CW2], 256, 64, 128, 256, MapId{64}, smem, cur);
        prep_T((bf16_t*)((char*)mix + 6 * MiB) + (size_t)128 * 256, P.in[I_CW2] + (size_t)256 * 64, 256, 64, 128, 256, MapId{64}, smem, cur);
        prep_T((bf16_t*)((char*)mix + 7 * MiB), P.in[I_NWO], DM, DM, DM, DM, MapPerm{DM}, smem, cur);
        { const int lane = tidx() & 63, gw = blockIdx.x * (NTHR / 64) + (tidx() >> 6);
          if (gw < 512) { const int c = gw >> 8, col = gw & 255; const float* w1 = P.in[I_CW1] + (size_t)c * 2048 * 256; const float* pe = P.in[I_CPE] + (size_t)c * 2048;
              float sacc = 0.f; for (int k = lane; k < 2048; k += 64) sacc += pe[k] * w1[(size_t)k * 256 + col];
              sacc = wave_sum(sacc); if (lane == 0) ((float*)(ws + OFF_BIASP))[gw] = sacc + P.in[I_CB1][c * 256 + col]; } }
    } else {
        prep_T(mix, P.in[I_GWIN], DM, 3088, 3328, DM, MapId{3088}, smem, cur);
        prep_T((bf16_t*)((char*)mix + 7 * MiB), P.in[I_GWO], DM, DM, DM, DM, MapPerm{DM}, smem, cur);
    }
}

template <int HIN, int HOUT>
DEV void phase_norm(const void* h_in, const bf16_t* z, const float* g_post, void* h_out, float* stage, const float* g_pre, bf16_t* xn) {
    const int lane = tidx() & 63, gw = blockIdx.x * (NTHR / 64) + (tidx() >> 6), nw = gridDim.x * (NTHR / 64);
    for (int row = gw; row < T; row += nw) {
        f32x4 hv[4];
#pragma unroll
        for (int i = 0; i < 4; ++i) { const size_t off = (size_t)row * DM + i * 256 + lane * 4;
            if (HIN == 0) hv[i] = *(const f32x4*)((const float*)h_in + off); else hv[i] = ld_bf4((const bf16_t*)h_in + off); }
        if (z) {
            f32x4 zv[4]; float ss = 0.f;
#pragma unroll
            for (int i = 0; i < 4; ++i) { zv[i] = ld_bf4(z + (size_t)row * DM + i * 256 + lane * 4); ss += zv[i][0] * zv[i][0] + zv[i][1] * zv[i][1] + zv[i][2] * zv[i][2] + zv[i][3] * zv[i][3]; }
            ss = wave_sum(ss); const float rs = rsqrtf(ss * (1.0f / DM) + 1e-6f);
#pragma unroll
            for (int i = 0; i < 4; ++i) { const f32x4 g = *(const f32x4*)(g_post + i * 256 + lane * 4); hv[i] += zv[i] * rs * g; }
        }
        if (HOUT == 1) {
#pragma unroll
            for (int i = 0; i < 4; ++i) st_bf4((bf16_t*)h_out + (size_t)row * DM + i * 256 + lane * 4, hv[i]);
        }
        if (HOUT == 2) {
            float* dst = row < T / 2 ? (float*)h_out + (size_t)row * DM : stage + (size_t)(row - T / 2) * DM;
#pragma unroll
            for (int i = 0; i < 4; ++i) *(f32x4*)(dst + i * 256 + lane * 4) = hv[i];
        }
        if (xn) {
            float ss = 0.f;
#pragma unroll
            for (int i = 0; i < 4; ++i) ss += hv[i][0] * hv[i][0] + hv[i][1] * hv[i][1] + hv[i][2] * hv[i][2] + hv[i][3] * hv[i][3];
            ss = wave_sum(ss); const float rs = rsqrtf(ss * (1.0f / DM) + 1e-6f);
#pragma unroll
            for (int i = 0; i < 4; ++i) { const f32x4 g = *(const f32x4*)(g_pre + i * 256 + lane * 4); st_bf4(xn + (size_t)row * DM + i * 256 + lane * 4, hv[i] * rs * g); }
        }
    }
}
DEV void phase_copy_out(const float* stage, float* out) {
    const size_t gt = (size_t)blockIdx.x * NTHR + tidx(), nt = (size_t)gridDim.x * NTHR;
    for (size_t i = gt; i < (size_t)(T / 2) * DM / 4; i += nt) ((f32x4*)(out + (size_t)(T / 2) * DM))[i] = ((const f32x4*)stage)[i];
}

DEV void phase_gemm_plain(const bf16_t* A, int lda, const bf16_t* Bt, int K, int ntn, bf16_t* C, int ldc, char* smem) {
    const LaneId L = lane_id();
    const int nunits = (T / 256) * ntn;
    for (int u = blockIdx.x; u < nunits; u += gridDim.x) {
        const int tm = u / ntn, tn = u % ntn;
        f32x4 acc[4][4];
        gemm_core(acc, LdPlain{A + (size_t)tm * 256 * lda, lda}, LdPlain{Bt + (size_t)tn * 128 * K, K}, K, smem);
#pragma unroll
        for (int m = 0; m < 4; ++m)
#pragma unroll
            for (int n = 0; n < 4; ++n)
                st_bf4(C + (size_t)(tm * 256 + L.wm * 64 + m * 16 + L.fr) * ldc + tn * 128 + L.wn * 64 + n * 16 + L.fq * 4, acc[m][n]);
    }
}

DEV void phase_f1(const bf16_t* xn, const bf16_t* Bt, const float* cw, const float* cb, bf16_t* act, bf16_t* E, char* smem) {
    const LaneId L = lane_id();
    const int ntn = 2 * DFF / 128, nunits = (T / 256) * ntn;
    for (int u = blockIdx.x; u < nunits; u += gridDim.x) {
        const int tm = u / ntn, tn = u % ntn;
        f32x4 acc[4][4];
        gemm_core(acc, LdPlain{xn + (size_t)tm * 256 * DM, DM}, LdPlain{Bt + (size_t)tn * 128 * DM, DM}, DM, smem);
        const int strip = tm * 4 + L.wm; const size_t rowbase = (size_t)tm * 256 + L.wm * 64;
#pragma unroll
        for (int n = 0; n < 2; ++n) {
            const int ch = tn * 64 + L.wn * 32 + n * 16 + L.fq * 4;
            const f32x4 c0 = *(const f32x4*)(cw + ch), c1 = *(const f32x4*)(cw + DFF + ch), c2 = *(const f32x4*)(cw + 2 * DFF + ch), cbv = *(const f32x4*)(cb + ch);
#pragma unroll
            for (int m = 0; m < 4; ++m) {
                const f32x4 g0 = acc[m][n], up = acc[m][n + 2]; f32x4 g1, g2;
#pragma unroll
                for (int j = 0; j < 4; ++j) {
                    const float a1 = __shfl(g0[j], (L.lane - 1) & 63), a2 = __shfl(g0[j], (L.lane - 2) & 63);
                    float b1 = 0.f, b2 = 0.f;
                    if (m > 0) { b1 = __shfl(acc[m > 0 ? m - 1 : 0][n][j], (L.lane + 15) & 63); b2 = __shfl(acc[m > 0 ? m - 1 : 0][n][j], (L.lane + 14) & 63); }
                    g1[j] = L.fr >= 1 ? a1 : b1; g2[j] = L.fr >= 2 ? a2 : b2;
                }
                const int rs = m * 16 + L.fr;
                f32x4 val = c2 * g0 + c1 * g1 + c0 * g2 + cbv, a;
#pragma unroll
                for (int j = 0; j < 4; ++j) a[j] = val[j] * rcpf_(1.0f + __expf(-val[j])) * up[j];
                if (rs >= 2) st_bf4(act + (rowbase + rs) * DFF + ch, a);
                else { st_bf4(E + ((size_t)strip * 6 + 2 + rs) * DFF + ch, g0); st_bf4(E + ((size_t)strip * 6 + 4 + rs) * DFF + ch, up); }
                if (rs >= 62) st_bf4(E + ((size_t)strip * 6 + (rs - 62)) * DFF + ch, g0);
            }
        }
    }
}
DEV void phase_f1b(const float* cw, const float* cb, bf16_t* act, const bf16_t* E) {
    const int gt = blockIdx.x * NTHR + tidx(), nt = gridDim.x * NTHR;
    for (int idx = gt; idx < 512 * 2 * (DFF / 4); idx += nt) {
        const int ch = (idx % (DFF / 4)) * 4, r = (idx / (DFF / 4)) & 1, strip = idx / (2 * (DFF / 4));
        const bool first = (strip & 127) == 0;
        const f32x4 zero = {0.f, 0.f, 0.f, 0.f};
        const f32x4 g0 = ld_bf4(E + ((size_t)strip * 6 + 2 + r) * DFF + ch), up = ld_bf4(E + ((size_t)strip * 6 + 4 + r) * DFF + ch);
        f32x4 g1, g2;
        if (r == 1) { g1 = ld_bf4(E + ((size_t)strip * 6 + 2) * DFF + ch); g2 = first ? zero : ld_bf4(E + ((size_t)(strip - 1) * 6 + 1) * DFF + ch); }
        else { g1 = first ? zero : ld_bf4(E + ((size_t)(strip - 1) * 6 + 1) * DFF + ch); g2 = first ? zero : ld_bf4(E + ((size_t)(strip - 1) * 6 + 0) * DFF + ch); }
        const f32x4 c0 = *(const f32x4*)(cw + ch), c1 = *(const f32x4*)(cw + DFF + ch), c2 = *(const f32x4*)(cw + 2 * DFF + ch), cbv = *(const f32x4*)(cb + ch);
        f32x4 val = c2 * g0 + c1 * g1 + c0 * g2 + cbv, a;
#pragma unroll
        for (int j = 0; j < 4; ++j) a[j] = val[j] * rcpf_(1.0f + __expf(-val[j])) * up[j];
        st_bf4(act + ((size_t)strip * 64 + r) * DFF + ch, a);
    }
}

struct RwkvW { const float *mu, *w0, *a0, *k_k, *k_a, *r_k, *ln_w, *ln_b, *v0; bool vres; };
DEV void phase_r1(const bf16_t* xn, const bf16_t* Bt, const RwkvW& W, bf16_t* rb, bf16_t* kb, bf16_t* hid, char* smem) {
    const LaneId L = lane_id();
    const int ntn = 20, nunits = (T / 256) * ntn;
    for (int u = blockIdx.x; u < nunits; u += gridDim.x) {
        const int tm = u / ntn, tn = u % ntn;
        const int var = tn < 8 ? 0 : tn < 16 ? 2 : tn == 16 ? 1 : tn == 17 ? 4 : tn == 18 ? 5 : 3;
        f32x4 acc[4][4];
        gemm_core(acc, LdMix{xn, W.mu + var * DM, tm * 256, {0.f, 0.f, 0.f, 0.f}, {0.f, 0.f, 0.f, 0.f}}, LdPlain{Bt + (size_t)tn * 128 * DM, DM}, DM, smem);
#pragma unroll
        for (int m = 0; m < 4; ++m)
#pragma unroll
            for (int n = 0; n < 4; ++n) {
                const size_t row = (size_t)tm * 256 + L.wm * 64 + m * 16 + L.fr; const int c = L.wn * 64 + n * 16 + L.fq * 4; f32x4 v = acc[m][n];
                if (tn < 8) st_bf4(rb + row * DM + tn * 128 + c, v);
                else if (tn < 16) st_bf4(kb + row * DM + (tn - 8) * 128 + c, v);
                else if (tn == 16) { if (L.wn == 0) { for (int j = 0; j < 4; ++j) v[j] = tanhf(v[j]); st_bf4(hid + row * HIDP + c, v); } }
                else if (tn == 17) { if (L.wn == 0) st_bf4(hid + row * HIDP + 64 + c, v); }
                else if (tn == 18) { for (int j = 0; j < 4; ++j) v[j] = sigmoidf_(v[j]); st_bf4(hid + row * HIDP + 128 + c, v); }
                else { if (L.wn == 0) st_bf4(hid + row * HIDP + 256 + c, v); }
            }
    }
}
DEV void phase_r2(const bf16_t* xn, const bf16_t* mixw, const RwkvW& W, const bf16_t* hid, const bf16_t* rb, float* bsc, bf16_t* wb, bf16_t* kb, bf16_t* kkb, bf16_t* kab, bf16_t* vb, char* smem) {
    const LaneId L = lane_id();
    const bf16_t* Bv = (const bf16_t*)((const char*)mixw + 5 * MiB);
    const bf16_t* W2T = (const bf16_t*)((const char*)mixw + 7 * MiB);
    const bf16_t* A2T = (const bf16_t*)((const char*)mixw + 7 * MiB + 131072);
    const bf16_t* V2T = (const bf16_t*)((const char*)mixw + 7 * MiB + 262144);
    const int nunits = 1024 + 2048;
    for (int u = blockIdx.x; u < nunits; u += gridDim.x) {
        if (u < 1024) {
            const int tm = u >> 3, tn = u & 7;
            f32x4 acc[4][4]; u32x2 gpk[4][4];
            if (W.vres) {
                gemm_core(acc, LdPlain{hid + (size_t)tm * 256 * HIDP + 256, HIDP}, LdPlain{V2T + (size_t)tn * 128 * 64, 64}, 64, smem);
#pragma unroll
                for (int m = 0; m < 4; ++m)
#pragma unroll
                    for (int n = 0; n < 4; ++n) { const int col = tn * 128 + L.wn * 64 + n * 16 + L.fq * 4; const f32x4 b = *(const f32x4*)(W.v0 + col);
                        gpk[m][n].x = cvt_pk(sigmoidf_(b[0] + acc[m][n][0]), sigmoidf_(b[1] + acc[m][n][1]));
                        gpk[m][n].y = cvt_pk(sigmoidf_(b[2] + acc[m][n][2]), sigmoidf_(b[3] + acc[m][n][3])); }
            }
            gemm_core(acc, LdMix{xn, W.mu + 3 * DM, tm * 256, {0.f, 0.f, 0.f, 0.f}, {0.f, 0.f, 0.f, 0.f}}, LdPlain{Bv + (size_t)tn * 128 * DM, DM}, DM, smem);
#pragma unroll
            for (int m = 0; m < 4; ++m)
#pragma unroll
                for (int n = 0; n < 4; ++n) {
                    const size_t row = (size_t)tm * 256 + L.wm * 64 + m * 16 + L.fr; const int col = tn * 128 + L.wn * 64 + n * 16 + L.fq * 4; f32x4 v = acc[m][n];
                    if (W.vres) { const f32x4 vf = ld_bf4(vb + row * DM + col); f32x4 gt; gt[0] = bf_lo(gpk[m][n].x); gt[1] = bf_hi(gpk[m][n].x); gt[2] = bf_lo(gpk[m][n].y); gt[3] = bf_hi(gpk[m][n].y); v = v + (vf - v) * gt; }
                    st_bf4(vb + row * DM + col, v);
                }
        } else {
            const int u2 = u - 1024, tm = u2 >> 4, jj = u2 & 15;
            f32x4 acc[4][4];
            if (jj < 8) {
                const int tn = jj;
                gemm_core(acc, LdPlain{hid + (size_t)tm * 256 * HIDP, HIDP}, LdPlain{W2T + (size_t)tn * 128 * 64, 64}, 64, smem);
#pragma unroll
                for (int m = 0; m < 4; ++m)
#pragma unroll
                    for (int n = 0; n < 4; ++n) {
                        const size_t row = (size_t)tm * 256 + L.wm * 64 + m * 16 + L.fr; const int col = tn * 128 + L.wn * 64 + n * 16 + L.fq * 4; const f32x4 b = *(const f32x4*)(W.w0 + col); f32x4 v;
                        for (int j = 0; j < 4; ++j) { const float x = b[j] + acc[m][n][j]; const float y = -x;
                            const float sp = fmaxf(y, 0.f) + log1pf(__expf(-fabsf(y))); const float w = -sp - 0.5f; v[j] = __expf(-__expf(w)); }
                        st_bf4(wb + row * DM + col, v);
                    }
            } else {
                const int tn = jj - 8;
                gemm_core(acc, LdPlain{hid + (size_t)tm * 256 * HIDP + 64, HIDP}, LdPlain{A2T + (size_t)tn * 128 * 64, 64}, 64, smem);
#pragma unroll
                for (int m = 0; m < 4; ++m) {
                    const size_t row = (size_t)tm * 256 + L.wm * 64 + m * 16 + L.fr;
                    u32x2 kpk[4]; float ss = 0.f;
#pragma unroll
                    for (int n = 0; n < 4; ++n) { const int col = tn * 128 + L.wn * 64 + n * 16 + L.fq * 4;
                        kpk[n] = *(const u32x2*)(kb + row * DM + col); const f32x4 kkw = *(const f32x4*)(W.k_k + col);
                        const float c0 = bf_lo(kpk[n].x) * kkw[0], c1 = bf_hi(kpk[n].x) * kkw[1], c2 = bf_lo(kpk[n].y) * kkw[2], c3 = bf_hi(kpk[n].y) * kkw[3];
                        ss += (c0 * c0 + c1 * c1) + (c2 * c2 + c3 * c3); }
                    ss += __shfl_xor(ss, 16); ss += __shfl_xor(ss, 32);
                    const float inv = rcpf_(fmaxf(sqrtf(ss), 1e-12f));
                    asm volatile("" ::: "memory");
                    float bon = 0.f;
#pragma unroll
                    for (int n = 0; n < 4; ++n) { const int col = tn * 128 + L.wn * 64 + n * 16 + L.fq * 4;
                        const f32x4 ka = *(const f32x4*)(W.k_a + col), kkw = *(const f32x4*)(W.k_k + col), a0 = *(const f32x4*)(W.a0 + col), rkv = *(const f32x4*)(W.r_k + col), rv = ld_bf4(rb + row * DM + col);
                        f32x4 kv; kv[0] = bf_lo(kpk[n].x); kv[1] = bf_hi(kpk[n].x); kv[2] = bf_lo(kpk[n].y); kv[3] = bf_hi(kpk[n].y);
                        f32x4 kk, kp, kka;
                        for (int j = 0; j < 4; ++j) { const float a = sigmoidf_(a0[j] + acc[m][n][j]); kk[j] = kv[j] * kkw[j] * inv; kp[j] = kv[j] * (1.0f + (a - 1.0f) * ka[j]); kka[j] = kk[j] * a; }
                        const u32x2 kpp = {cvt_pk(kp[0], kp[1]), cvt_pk(kp[2], kp[3])};
                        bon += rv[0] * bf_lo(kpp.x) * rkv[0] + rv[1] * bf_hi(kpp.x) * rkv[1] + rv[2] * bf_lo(kpp.y) * rkv[2] + rv[3] * bf_hi(kpp.y) * rkv[3];
                        *(u32x2*)(kb + row * DM + col) = kpp; st_bf4(kkb + row * DM + col, kk); st_bf4(kab + row * DM + col, kka);
                        asm volatile("" ::: "memory"); }
                    bon += __shfl_xor(bon, 16); bon += __shfl_xor(bon, 32);
                    if (L.fq == 0) bsc[row * 16 + tn * 2 + L.wn] = bon;
                }
            }
        }
    }
}
typedef float f32x2 __attribute__((ext_vector_type(2)));
constexpr int R3_CH = 32, R3_STR = R3_CH * 256, R3_BUF = 5 * R3_STR + R3_CH * 64;
DEV void r3_stage_raw(const bf16_t* const (&str)[5], const bf16_t* vb, size_t base, int vrow0, int t0, char* buf, int id) {
    u32x4 d[5];
    const int t = id >> 3, j = id & 7;
#pragma unroll
    for (int st = 0; st < 5; ++st) d[st] = *(const u32x4*)(str[st] + base + (size_t)(t0 + t) * DM + j * 8);
    u32x4 vv = {0u, 0u, 0u, 0u};
    if (id < 64) vv = *(const u32x4*)(vb + base + (size_t)(t0 + (id >> 1)) * DM + vrow0 + (id & 1) * 8);
#pragma unroll
    for (int st = 0; st < 5; ++st) { f32x4 a, b; a[0] = bf_lo(d[st].x); a[1] = bf_hi(d[st].x); a[2] = bf_lo(d[st].y); a[3] = bf_hi(d[st].y); b[0] = bf_lo(d[st].z); b[1] = bf_hi(d[st].z); b[2] = bf_lo(d[st].w); b[3] = bf_hi(d[st].w);
        float* p = (float*)(buf + st * R3_STR + t * 256 + j * 32); *(f32x4*)p = a; *(f32x4*)(p + 4) = b; }
    if (id < 64) { f32x4 a, b; a[0] = bf_lo(vv.x); a[1] = bf_hi(vv.x); a[2] = bf_lo(vv.y); a[3] = bf_hi(vv.y); b[0] = bf_lo(vv.z); b[1] = bf_hi(vv.z); b[2] = bf_lo(vv.w); b[3] = bf_hi(vv.w);
        float* vp = (float*)(buf + 5 * R3_STR + (id >> 1) * 64 + (id & 1) * 32); *(f32x4*)vp = a; *(f32x4*)(vp + 4) = b; }
}
DEV void phase_r3(const bf16_t* rb, const bf16_t* wb, const bf16_t* kb, const bf16_t* kkb, const bf16_t* kab, const bf16_t* vb, bf16_t* yb, float* bsc, const float* r_k, char* smem) {
    const int tid = tidx(), lane = tid & 63, wid = tid >> 6;
    const bf16_t* const str[5] = {rb, wb, kb, kkb, kab};
    constexpr int NCH = SEQ / R3_CH;
    for (int task = blockIdx.x; task < 256; task += gridDim.x) {
        const int bh = task >> 2, b = bh >> 4, h = bh & 15, rq = task & 3;
        const size_t base = (size_t)b * SEQ * DM + h * 64;
        bf16_t* ystage = (bf16_t*)(smem + 131072 + 64);
    float* gcarea = (float*)(smem + 3 * R3_BUF);
        if (wid >= 4) r3_stage_raw(str, vb, base, rq * 16, 0, smem, tid - 256);
        __syncthreads();
        if (wid >= 4) { r3_stage_raw(str, vb, base, rq * 16, R3_CH, smem + R3_BUF, tid - 256);
            char* bq = smem; float* w = (float*)bq + R3_STR / 4 + lane; const int p = wid - 4;
            float G = 1.f; for (int t = 0; t < 8 * p; ++t) G *= w[t * 64];
            float* r = (float*)bq + lane; float* k = r + 2 * (R3_STR / 4); float* q = r + 3 * (R3_STR / 4); float* a = r + 4 * (R3_STR / 4);
#pragma unroll
            for (int u = 0; u < 8; ++u) { const int t = 8 * p + u; const float Gold = G; G *= w[t * 64]; const float inv = rcpf_(G); r[t * 64] *= G; q[t * 64] *= Gold; k[t * 64] *= inv; a[t * 64] *= inv; }
            if (p == 3) gcarea[lane] = G; }
        __syncthreads();
        const int rr = lane >> 4, cg = lane & 15, rg = rq * 4 + wid;
        const size_t voff = base + rg * 4 + rr;
        f32x2 s01 = {0.f, 0.f}, s23 = {0.f, 0.f};
        for (int c = 0; c < NCH; ++c) {
            if (wid >= 4) {
                if (c >= 1 && tid - 256 < 64) { const int id = tid - 256;
                    *(u32x4*)(yb + base + (size_t)((c - 1) * R3_CH + (id >> 1)) * DM + rq * 16 + (id & 1) * 8) = *(const u32x4*)(ystage + ((c - 1) & 1) * 512 + (id >> 1) * 16 + (id & 1) * 8); }
                if (c + 2 < NCH) r3_stage_raw(str, vb, base, rq * 16, (c + 2) * R3_CH, smem + ((c + 2) % 3) * R3_BUF, tid - 256);
                if (c + 1 < NCH) { char* bq = smem + ((c + 1) % 3) * R3_BUF; float* w = (float*)bq + R3_STR / 4 + lane; const int p = wid - 4;
                    float G = 1.f; for (int t = 0; t < 8 * p; ++t) G *= w[t * 64];
                    float* r = (float*)bq + lane; float* k = r + 2 * (R3_STR / 4); float* q = r + 3 * (R3_STR / 4); float* a = r + 4 * (R3_STR / 4);
#pragma unroll
                    for (int u = 0; u < 8; ++u) { const int t = 8 * p + u; const float Gold = G; G *= w[t * 64]; const float inv = rcpf_(G); r[t * 64] *= G; q[t * 64] *= Gold; k[t * 64] *= inv; a[t * 64] *= inv; }
                    if (p == 3) gcarea[((c + 1) % 3) * 64 + lane] = G; }
            } else {
                const char* buf = smem + (c % 3) * R3_BUF;
                f32x4 R_[2][2], K_[2][2], Q_[2][2], A_[2][2]; float V_[2][2];
#define R3_LD(bf, t0) { _Pragma("unroll") for (int u = 0; u < 2; ++u) { const char* p = buf + ((t0) + u) * 256 + cg * 16; \
                    R_[bf][u] = *(const f32x4*)p; K_[bf][u] = *(const f32x4*)(p + 2 * R3_STR); Q_[bf][u] = *(const f32x4*)(p + 3 * R3_STR); A_[bf][u] = *(const f32x4*)(p + 4 * R3_STR); \
                    V_[bf][u] = *(const float*)(buf + 5 * R3_STR + ((t0) + u) * 64 + (wid * 4 + rr) * 4); } }
#define R3_CP(bf, sl) { _Pragma("unroll") for (int u = 0; u < 2; ++u) { \
                    const f32x4 R = R_[bf][u], K = K_[bf][u], Q = Q_[bf][u], A = A_[bf][u]; const float vv = V_[bf][u]; \
                    const f32x2 r01 = {R[0], R[1]}, r23 = {R[2], R[3]}, k01 = {K[0], K[1]}, k23 = {K[2], K[3]}; \
                    const f32x2 q01 = {Q[0], Q[1]}, q23 = {Q[2], Q[3]}, a01 = {A[0], A[1]}, a23 = {A[2], A[3]}; \
                    const f32x2 pq = s01 * q01 + s23 * q23; \
                    const float sa = -row16_sum(pq.x + pq.y); \
                    const f32x2 sa2 = {sa, sa}, vv2 = {vv, vv}; \
                    s01 = (s01 + vv2 * k01) + sa2 * a01; s23 = (s23 + vv2 * k23) + sa2 * a23; \
                    const f32x2 py = s01 * r01 + s23 * r23; \
                    const float y = row16_sum(py.x + py.y); \
                    yv = (cg == (sl) + u) ? y : yv; } }
                R3_LD(0, 0)
#pragma unroll 1
                for (int t8 = 0; t8 < R3_CH; t8 += 8) {
                    float yv = 0.f;
                    R3_LD(1, t8 + 2)
                    R3_CP(0, 0)
                    R3_LD(0, t8 + 4)
                    R3_CP(1, 2)
                    R3_LD(1, t8 + 6)
                    R3_CP(0, 4)
                    if (t8 + 8 < R3_CH) R3_LD(0, t8 + 8)
                    R3_CP(1, 6)
                    if (cg < 8) ystage[(c & 1) * 512 + (t8 + cg) * 16 + wid * 4 + rr] = f2bf(yv);
                }
#undef R3_LD
#undef R3_CP
                const f32x4 GC = *(const f32x4*)(gcarea + (c % 3) * 64 + cg * 4);
                s01 *= (f32x2){GC[0], GC[1]}; s23 *= (f32x2){GC[2], GC[3]};
            }
            __syncthreads();
        }
        if (wid >= 4 && tid - 256 < 64) { const int id = tid - 256;
            *(u32x4*)(yb + base + (size_t)((NCH - 1) * R3_CH + (id >> 1)) * DM + rq * 16 + (id & 1) * 8) = *(const u32x4*)(ystage + ((NCH - 1) & 1) * 512 + (id >> 1) * 16 + (id & 1) * 8); }
        __syncthreads();
    }
}
constexpr int RC_NP = 7, RC_SLOT = 18688, RC_LDS = 18688;
constexpr int RC_QT = 0, RC_RR = 4096, RC_BG = 8192, RC_AB = 12288, RC_D0 = 14336, RC_U0 = 16384, RC_Y0 = 17408, RC_G = 18432;
#define R3C_FENCE() asm volatile("s_waitcnt lgkmcnt(0)" ::: "memory")
DEV bf16x8 r3c_permfrag(const char* rowp, int q) {
    const u32x2 lo = *(const u32x2*)(rowp + 8 * q), hi = *(const u32x2*)(rowp + 32 + 8 * q);
    u32x4 w; w.x = lo.x; w.y = lo.y; w.z = hi.x; w.w = hi.y; return __builtin_bit_cast(bf16x8, w);
}
DEV bf16x8 r3c_neg(bf16x8 a) { u32x4 w = __builtin_bit_cast(u32x4, a); w.x ^= 0x80008000u; w.y ^= 0x80008000u; w.z ^= 0x80008000u; w.w ^= 0x80008000u; return __builtin_bit_cast(bf16x8, w); }
DEV void r3c_mat_store(char* MAT, const f32x4 (&t)[2][2], int m, int q) {
#pragma unroll
    for (int mt = 0; mt < 2; ++mt)
#pragma unroll
        for (int nt = 0; nt < 2; ++nt)
#pragma unroll
            for (int r = 0; r < 4; ++r) *(bf16_t*)(MAT + (16 * mt + 4 * q + r) * 64 + (16 * nt + m) * 2) = f2bf(t[mt][nt][r]);
}
DEV u32x4 r3c_scale8(u32x4 d, f32x4 a, f32x4 b) {
    u32x4 o; o.x = cvt_pk(bf_lo(d.x) * a[0], bf_hi(d.x) * a[1]); o.y = cvt_pk(bf_lo(d.y) * a[2], bf_hi(d.y) * a[3]);
    o.z = cvt_pk(bf_lo(d.z) * b[0], bf_hi(d.z) * b[1]); o.w = cvt_pk(bf_lo(d.w) * b[2], bf_hi(d.w) * b[3]); return o;
}
DEV u32x2 r3c_pk4(f32x4 v) { u32x2 w; w.x = cvt_pk(v[0], v[1]); w.y = cvt_pk(v[2], v[3]); return w; }
DEV f32x4 r3c_up4(u32x2 w) { f32x4 v; v[0] = bf_lo(w.x); v[1] = bf_hi(w.x); v[2] = bf_lo(w.y); v[3] = bf_hi(w.y); return v; }
#define R3C_SCORE(dst, A, B, STRICT) { _Pragma("unroll") for (int mt = 0; mt < 2; ++mt) { _Pragma("unroll") for (int nt = 0; nt < 2; ++nt) { \
        f32x4 a_ = z4; if (!(mt == 0 && nt == 1)) { a_ = MFMA(A[mt][0], B[nt][0], z4); a_ = MFMA(A[mt][1], B[nt][1], a_); } \
        _Pragma("unroll") for (int r = 0; r < 4; ++r) { const int t_ = 16 * mt + 4 * q + r, u_ = 16 * nt + m; const bool keep_ = (STRICT) ? (u_ < t_) : (u_ <= t_); a_[r] = keep_ ? a_[r] : 0.f; } \
        dst[mt][nt] = a_; } } }
DEV void r3c_produce(const bf16_t* rb, const bf16_t* wb, const bf16_t* kb, const bf16_t* kkb, const bf16_t* kab, const bf16_t* vb, size_t base, int vrow0, int t0, char* lds, char* slot, int lane) {
    const int m = lane & 15, q = lane >> 4, tr = lane >> 3, j = lane & 7;
    const f32x4 z4 = {0.f, 0.f, 0.f, 0.f};
    char* Rh = lds; char* Qh = lds + 4096; char* Kh = lds + 8192; char* Bh = lds + 12288; char* MAT = lds + 16384; float* G31a = (float*)(lds + 18432);
    float* Gb = (float*)Kh;
    u32x4 dr[4], dw[4], dk[4], dq[4], da[4];
#pragma unroll
    for (int s = 0; s < 4; ++s) { const size_t o = base + (size_t)(t0 + 8 * s + tr) * DM + j * 8;
        dw[s] = *(const u32x4*)(wb + o); dr[s] = *(const u32x4*)(rb + o); dk[s] = *(const u32x4*)(kb + o); dq[s] = *(const u32x4*)(kkb + o); da[s] = *(const u32x4*)(kab + o); }
    bf16x8 vfrag;
    { const bf16_t* vp = vb + base + (size_t)t0 * DM + vrow0 + m; unsigned e[8];
#pragma unroll
      for (int jj = 0; jj < 8; ++jj) { const int t = (jj < 4) ? 4 * q + jj : 16 + 4 * q + jj - 4; e[jj] = vp[(size_t)t * DM]; }
      u32x4 w; w.x = e[0] | (e[1] << 16); w.y = e[2] | (e[3] << 16); w.z = e[4] | (e[5] << 16); w.w = e[6] | (e[7] << 16); vfrag = __builtin_bit_cast(bf16x8, w); }
#pragma unroll
    for (int s = 0; s < 4; ++s) { float* gp = Gb + (8 * s + tr) * 64 + 8 * j; f32x4 a, b;
        a[0] = bf_lo(dw[s].x); a[1] = bf_hi(dw[s].x); a[2] = bf_lo(dw[s].y); a[3] = bf_hi(dw[s].y); b[0] = bf_lo(dw[s].z); b[1] = bf_hi(dw[s].z); b[2] = bf_lo(dw[s].w); b[3] = bf_hi(dw[s].w);
        *(f32x4*)gp = a; *(f32x4*)(gp + 4) = b; }
    R3C_FENCE();
    { float g[32];
#pragma unroll
      for (int t = 0; t < 32; ++t) g[t] = Gb[t * 64 + lane];
      float G = 1.f;
#pragma unroll
      for (int t = 0; t < 32; ++t) { G *= g[t]; Gb[t * 64 + lane] = G; }
      G31a[lane] = G; *(float*)(slot + RC_G + lane * 4) = G; }
    R3C_FENCE();
    { u32x4 kh[4], bh[4];
#pragma unroll
      for (int s = 0; s < 4; ++s) { const int t = 8 * s + tr, tp = t > 0 ? t - 1 : 0;
          const f32x4 g0 = *(const f32x4*)(Gb + t * 64 + 8 * j), g1 = *(const f32x4*)(Gb + t * 64 + 8 * j + 4);
          f32x4 p0 = *(const f32x4*)(Gb + tp * 64 + 8 * j), p1 = *(const f32x4*)(Gb + tp * 64 + 8 * j + 4);
          if (t == 0) { p0 = (f32x4){1.f, 1.f, 1.f, 1.f}; p1 = p0; }
          f32x4 i0, i1;
#pragma unroll
          for (int e = 0; e < 4; ++e) { i0[e] = rcpf_(g0[e]); i1[e] = rcpf_(g1[e]); }
          *(u32x4*)(Rh + t * 128 + j * 16) = r3c_scale8(dr[s], g0, g1);
          *(u32x4*)(Qh + t * 128 + j * 16) = r3c_scale8(dq[s], p0, p1);
          kh[s] = r3c_scale8(dk[s], i0, i1); bh[s] = r3c_scale8(da[s], i0, i1); }
      R3C_FENCE();
#pragma unroll
      for (int s = 0; s < 4; ++s) { const int t = 8 * s + tr; *(u32x4*)(Kh + t * 128 + j * 16) = kh[s]; *(u32x4*)(Bh + t * 128 + j * 16) = bh[s]; } }
    R3C_FENCE();
    bf16x8 Qa[2][2], Ra[2][2], Kb[2][2], Bb[2][2];
#pragma unroll
    for (int x = 0; x < 2; ++x)
#pragma unroll
        for (int ks = 0; ks < 2; ++ks) { const int off = (16 * x + m) * 128 + (32 * ks + 8 * q) * 2;
            Qa[x][ks] = *(const bf16x8*)(Qh + off); Ra[x][ks] = *(const bf16x8*)(Rh + off); Kb[x][ks] = *(const bf16x8*)(Kh + off); Bb[x][ks] = *(const bf16x8*)(Bh + off); }
    f32x4 Tt[2][2], Z[2][5];
    R3C_SCORE(Tt, Qa, Kb, true)
    r3c_mat_store(MAT, Tt, m, q); R3C_FENCE();
    { const bf16x8 a0 = r3c_permfrag(MAT + m * 64, q), a1 = r3c_permfrag(MAT + (16 + m) * 64, q); Z[0][4] = MFMA(a0, vfrag, z4); Z[1][4] = MFMA(a1, vfrag, z4); }
    R3C_FENCE();
    R3C_SCORE(Tt, Ra, Kb, false)
    r3c_mat_store(MAT, Tt, m, q); R3C_FENCE();
    { const bf16x8 a0 = r3c_permfrag(MAT + m * 64, q), a1 = r3c_permfrag(MAT + (16 + m) * 64, q);
      const f32x4 y0 = MFMA(a0, vfrag, z4), y1 = MFMA(a1, vfrag, z4);
      *(u32x2*)(slot + RC_Y0 + lane * 8) = r3c_pk4(y0); *(u32x2*)(slot + RC_Y0 + 512 + lane * 8) = r3c_pk4(y1); }
    R3C_FENCE();
    R3C_SCORE(Tt, Ra, Bb, false)
    r3c_mat_store(MAT, Tt, m, q); R3C_FENCE();
    { const bf16x8 a0 = r3c_neg(r3c_permfrag(MAT + m * 64, q)), a1 = r3c_neg(r3c_permfrag(MAT + (16 + m) * 64, q));
      *(bf16x8*)(slot + RC_AB + lane * 16) = a0; *(bf16x8*)(slot + RC_AB + 1024 + lane * 16) = a1; }
    R3C_FENCE();
    R3C_SCORE(Tt, Qa, Bb, true)
    r3c_mat_store(MAT, Tt, m, q); R3C_FENCE();
    bf16x8 Pa[2]; Pa[0] = r3c_permfrag(MAT + m * 64, q); Pa[1] = r3c_permfrag(MAT + (16 + m) * 64, q);
#pragma unroll
    for (int mt = 0; mt < 2; ++mt)
#pragma unroll
        for (int n = 0; n < 4; ++n)
#pragma unroll
            for (int r = 0; r < 4; ++r) Z[mt][n][r] = bf2f(*(const bf16_t*)(Qh + (16 * mt + 4 * q + r) * 128 + (16 * n + m) * 2));
    { bf16x8 zb[5];
#pragma unroll
      for (int n = 0; n < 5; ++n) zb[n] = pack8(Z[0][n], Z[1][n]);
      const bf16x8 n0 = r3c_neg(Pa[0]), n1 = r3c_neg(Pa[1]);
#pragma unroll
      for (int n = 0; n < 5; ++n) { Z[0][n] = MFMA(n0, zb[n], Z[0][n]); Z[1][n] = MFMA(n1, zb[n], Z[1][n]); } }
#pragma unroll
    for (int lev = 0; lev < 4; ++lev) {
        const bf16x8 pb0 = pack8(Tt[0][0], Tt[1][0]), pb1 = pack8(Tt[0][1], Tt[1][1]);
        Tt[0][0] = MFMA(Pa[0], pb0, z4); Tt[0][1] = MFMA(Pa[0], pb1, z4); Tt[1][0] = MFMA(Pa[1], pb0, z4); Tt[1][1] = MFMA(Pa[1], pb1, z4);
        R3C_FENCE(); r3c_mat_store(MAT, Tt, m, q); R3C_FENCE();
        Pa[0] = r3c_permfrag(MAT + m * 64, q); Pa[1] = r3c_permfrag(MAT + (16 + m) * 64, q);
        bf16x8 zb[5];
#pragma unroll
        for (int n = 0; n < 5; ++n) zb[n] = pack8(Z[0][n], Z[1][n]);
#pragma unroll
        for (int n = 0; n < 5; ++n) { Z[0][n] = MFMA(Pa[0], zb[n], Z[0][n]); Z[1][n] = MFMA(Pa[1], zb[n], Z[1][n]); }
    }
    R3C_FENCE();
#pragma unroll
    for (int mt = 0; mt < 2; ++mt)
#pragma unroll
        for (int n = 0; n < 4; ++n)
#pragma unroll
            for (int r = 0; r < 4; ++r) *(bf16_t*)(Qh + (16 * mt + 4 * q + r) * 128 + (16 * n + m) * 2) = f2bf(Z[mt][n][r]);
    R3C_FENCE();
#pragma unroll
    for (int mt = 0; mt < 2; ++mt)
#pragma unroll
        for (int ks = 0; ks < 2; ++ks) {
            *(bf16x8*)(slot + RC_QT + (mt * 2 + ks) * 1024 + lane * 16) = r3c_permfrag(Qh + (16 * mt + m) * 128 + ks * 64, q);
            *(bf16x8*)(slot + RC_RR + (mt * 2 + ks) * 1024 + lane * 16) = r3c_permfrag(Rh + (16 * mt + m) * 128 + ks * 64, q); }
    *(u32x2*)(slot + RC_U0 + lane * 8) = r3c_pk4(Z[0][4]); *(u32x2*)(slot + RC_U0 + 512 + lane * 8) = r3c_pk4(Z[1][4]);
#pragma unroll
    for (int ct = 0; ct < 4; ++ct) { const int ch = 16 * ct + m; const float g = G31a[ch]; f32x4 k0, k1, b0, b1;
#pragma unroll
        for (int jj = 0; jj < 4; ++jj) { const int ta = 4 * q + jj, tb = 16 + 4 * q + jj;
            k0[jj] = bf2f(*(const bf16_t*)(Kh + ta * 128 + ch * 2)) * g; k1[jj] = bf2f(*(const bf16_t*)(Kh + tb * 128 + ch * 2)) * g;
            b0[jj] = bf2f(*(const bf16_t*)(Bh + ta * 128 + ch * 2)) * -g; b1[jj] = bf2f(*(const bf16_t*)(Bh + tb * 128 + ch * 2)) * -g; }
        *(bf16x8*)(slot + RC_BG + ct * 1024 + lane * 16) = pack8(b0, b1);
        const f32x4 d0 = MFMA(pack8(k0, k1), vfrag, z4);
        *(u32x2*)(slot + RC_D0 + ct * 512 + lane * 8) = r3c_pk4(d0); }
    R3C_FENCE();
}
DEV void r3c_consume(f32x4 (&S)[4], const char* slot, bf16_t* yout, int lane) {
    const int m = lane & 15, q = lane >> 4;
    bf16x8 QT[2][2], RA[2][2], BG[4], AB[2]; u32x2 D0[4], U0[2], Y0[2]; f32x4 Gv[4];
#pragma unroll
    for (int f = 0; f < 4; ++f) { QT[f >> 1][f & 1] = *(const bf16x8*)(slot + RC_QT + f * 1024 + lane * 16); BG[f] = *(const bf16x8*)(slot + RC_BG + f * 1024 + lane * 16);
        D0[f] = *(const u32x2*)(slot + RC_D0 + f * 512 + lane * 8); Gv[f] = *(const f32x4*)(slot + RC_G + (16 * f + 4 * q) * 4); }
#pragma unroll
    for (int f = 0; f < 2; ++f) { U0[f] = *(const u32x2*)(slot + RC_U0 + f * 512 + lane * 8); Y0[f] = *(const u32x2*)(slot + RC_Y0 + f * 512 + lane * 8); AB[f] = *(const bf16x8*)(slot + RC_AB + f * 1024 + lane * 16); }
#pragma unroll
    for (int f = 0; f < 4; ++f) RA[f >> 1][f & 1] = *(const bf16x8*)(slot + RC_RR + f * 1024 + lane * 16);
    const bf16x8 sB0 = pack8(S[0], S[1]), sB1 = pack8(S[2], S[3]);
    f32x4 U[2], Y[2];
#pragma unroll
    for (int mt = 0; mt < 2; ++mt) { U[mt] = r3c_up4(U0[mt]); U[mt] = MFMA(QT[mt][0], sB0, U[mt]); U[mt] = MFMA(QT[mt][1], sB1, U[mt]); }
    const bf16x8 uB = pack8(U[0], U[1]);
#pragma unroll
    for (int ct = 0; ct < 4; ++ct) { S[ct] = S[ct] * Gv[ct] + r3c_up4(D0[ct]); S[ct] = MFMA(BG[ct], uB, S[ct]); }
#pragma unroll
    for (int mt = 0; mt < 2; ++mt) { Y[mt] = r3c_up4(Y0[mt]); Y[mt] = MFMA(RA[mt][0], sB0, Y[mt]); Y[mt] = MFMA(RA[mt][1], sB1, Y[mt]); Y[mt] = MFMA(AB[mt], uB, Y[mt]);
#pragma unroll
        for (int r = 0; r < 4; ++r) yout[(size_t)(16 * mt + 4 * q + r) * DM + m] = f2bf(Y[mt][r]); }
}
DEV void phase_r3c(const bf16_t* rb, const bf16_t* wb, const bf16_t* kb, const bf16_t* kkb, const bf16_t* kab, const bf16_t* vb, bf16_t* yb, char* ringbase, char* smem) {
    const int tid = tidx(), lane = tid & 63, wid = tid >> 6;
    constexpr int NCH = SEQ / 32, NR = (NCH + RC_NP - 1) / RC_NP;
    char* ring = ringbase + (size_t)blockIdx.x * (2 * RC_NP * RC_SLOT);
    for (int task = blockIdx.x; task < 256; task += gridDim.x) {
        const int bh = task >> 2, b = bh >> 4, h = bh & 15, rq = task & 3;
        const size_t base = (size_t)b * SEQ * DM + h * 64;
        f32x4 S[4];
#pragma unroll
        for (int ct = 0; ct < 4; ++ct) S[ct] = (f32x4){0.f, 0.f, 0.f, 0.f};
        for (int rd = 0; rd <= NR; ++rd) {
            if (wid == 0) {
                if (rd >= 1) {
#pragma unroll 1
                    for (int p = 0; p < RC_NP; ++p) { const int c = (rd - 1) * RC_NP + p;
                        if (c < NCH) r3c_consume(S, ring + (size_t)((((rd - 1) & 1) * RC_NP + p) * RC_SLOT), yb + base + (size_t)c * 32 * DM + rq * 16, lane); }
                }
            } else {
                const int c = rd * RC_NP + wid - 1;
                if (rd < NR && c < NCH) r3c_produce(rb, wb, kb, kkb, kab, vb, base, rq * 16, c * 32, smem + (wid - 1) * RC_LDS, ring + (size_t)(((rd & 1) * RC_NP + wid - 1) * RC_SLOT), lane);
            }
            asm volatile("s_waitcnt vmcnt(0)" ::: "memory");
            __syncthreads();
        }
    }
}
DEV void phase_r4(const bf16_t* hid, const bf16_t* G2T, const RwkvW& W, const bf16_t* yb, const bf16_t* vb, const float* bsc, bf16_t* outb, char* smem) {
    const LaneId L = lane_id();
    const int ntn = 8, nunits = (T / 256) * ntn;
    for (int u = blockIdx.x; u < nunits; u += gridDim.x) {
        const int tm = u / ntn, tn = u % ntn;
        f32x4 acc[4][4];
        gemm_core(acc, LdPlain{hid + (size_t)tm * 256 * HIDP + 128, HIDP}, LdPlain{G2T + (size_t)tn * 128 * 128, 128}, 128, smem);
        const int head = tn * 2 + L.wn;
#pragma unroll
        for (int m = 0; m < 4; ++m) {
            const size_t row = (size_t)tm * 256 + L.wm * 64 + m * 16 + L.fr;
            f32x4 yv[4]; float s = 0.f;
#pragma unroll
            for (int n = 0; n < 4; ++n) { yv[n] = ld_bf4(yb + row * DM + head * 64 + n * 16 + L.fq * 4); s += (yv[n][0] + yv[n][1]) + (yv[n][2] + yv[n][3]); }
            s += __shfl_xor(s, 16); s += __shfl_xor(s, 32);
            const float mean = s * (1.0f / 64.0f); float q = 0.f;
#pragma unroll
            for (int n = 0; n < 4; ++n) { const f32x4 d = yv[n] - mean; q += (d[0] * d[0] + d[1] * d[1]) + (d[2] * d[2] + d[3] * d[3]); }
            q += __shfl_xor(q, 16); q += __shfl_xor(q, 32);
            const float rstd = rsqrtf(q * (1.0f / 64.0f) + 64e-5f);
            const float bs = bsc[row * 16 + head];
#pragma unroll
            for (int n = 0; n < 4; ++n) { const int col = head * 64 + n * 16 + L.fq * 4;
                const f32x4 lw = *(const f32x4*)(W.ln_w + col), lb = *(const f32x4*)(W.ln_b + col), vv = ld_bf4(vb + row * DM + col);
                f32x4 o = ((yv[n] - mean) * rstd * lw + lb + vv * bs);
                o = o * acc[m][n];
                st_bf4(outb + row * DM + col, o); }
        }
    }
}

struct NsaBuf { bf16_t *q, *kcmp, *vcmp, *kslc, *kwin, *vslcT, *vwinT, *hid, *kc, *vcT, *o; float* gates; };
DEV void phase_n1(const bf16_t* xn, const bf16_t* Bt, const NsaBuf& B, char* smem) {
    const LaneId L = lane_id();
    const int ntn = 15, nunits = (T / 256) * ntn;
    for (int u = blockIdx.x; u < nunits; u += gridDim.x) {
        const int tm = u / ntn, tn = u % ntn;
        f32x4 acc[4][4];
        gemm_core(acc, LdPlain{xn + (size_t)tm * 256 * DM, DM}, LdPlain{Bt + (size_t)tn * 128 * DM, DM}, DM, smem);
#pragma unroll
        for (int m = 0; m < 4; ++m)
#pragma unroll
            for (int n = 0; n < 4; ++n) {
                const size_t row = (size_t)tm * 256 + L.wm * 64 + m * 16 + L.fr; const int c = L.wn * 64 + n * 16 + L.fq * 4; f32x4 v = acc[m][n];
                if (tn < 8) st_bf4(B.q + row * DM + tn * 128 + c, v * 0.125f);
                else if (tn < 14) {
                    const int cc = tn - 8;
                    if (cc == 0) st_bf4(B.kcmp + row * 128 + c, v);
                    else if (cc == 1) st_bf4(B.vcmp + row * 128 + c, v);
                    else if (cc == 2) st_bf4(B.kslc + row * 128 + c, v);
                    else if (cc == 4) st_bf4(B.kwin + row * 128 + c, v);
                    else { bf16_t* dst = cc == 3 ? B.vslcT : B.vwinT; const int b = (int)(row >> 13), t = (int)(row & (SEQ - 1));
                        for (int j = 0; j < 4; ++j) dst[((size_t)(b * 128 + c + j)) * SEQ + t] = f2bf(v[j]); }
                } else { if (c < 48) { for (int j = 0; j < 4; ++j) B.gates[row * 48 + c + j] = sigmoidf_(v[j]); } }
            }
    }
}
DEV float gelu_tanh(float x) { const float u = 0.7978845608028654f * (x + 0.044715f * x * x * x); return 0.5f * x * (1.0f + tanhf(u)); }
DEV void phase_n2a(const bf16_t* W1T, const float* biasp, const NsaBuf& B, char* smem) {
    const LaneId L = lane_id();
    for (int u = blockIdx.x; u < 64; u += gridDim.x) {
        const int c = u >> 5, tm = (u >> 1) & 15, tn = u & 1;
        f32x4 acc[4][4];
        gemm_core(acc, LdCmp{c ? B.vcmp : B.kcmp, tm * 256}, LdPlain{W1T + (size_t)c * 256 * 2048 + (size_t)tn * 128 * 2048, 2048}, 2048, smem);
#pragma unroll
        for (int m = 0; m < 4; ++m)
#pragma unroll
            for (int n = 0; n < 4; ++n) { const size_t row = (size_t)tm * 256 + L.wm * 64 + m * 16 + L.fr; const int col = tn * 128 + L.wn * 64 + n * 16 + L.fq * 4;
                const f32x4 bb = *(const f32x4*)(biasp + c * 256 + col); f32x4 v;
                for (int j = 0; j < 4; ++j) v[j] = gelu_tanh(acc[m][n][j] + bb[j]);
                st_bf4(B.hid + ((size_t)c * 4096 + row) * 256 + col, v); }
    }
}
DEV void phase_n2b(const bf16_t* W2T, const NsaBuf& B, char* smem) {
    const LaneId L = lane_id();
    for (int u = blockIdx.x; u < 32; u += gridDim.x) {
        const int c = u >> 4, tm = u & 15;
        f32x4 acc[4][4];
        gemm_core(acc, LdPlain{B.hid + ((size_t)c * 4096 + tm * 256) * 256, 256}, LdPlain{W2T + (size_t)c * 128 * 256, 256}, 256, smem);
        if (L.wn == 0) {
#pragma unroll
            for (int m = 0; m < 4; ++m)
#pragma unroll
                for (int n = 0; n < 4; ++n) { const int row = tm * 256 + L.wm * 64 + m * 16 + L.fr, d = n * 16 + L.fq * 4;
                    const int b = row >> 10, nn = (row >> 1) & 511, g = row & 1;
                    if (c == 0) st_bf4(B.kc + ((size_t)((b * 2 + g) * 512 + nn)) * 64 + d, acc[m][n]);
                    else { for (int j = 0; j < 4; ++j) B.vcT[((size_t)((b * 2 + g) * 64 + d + j)) * 512 + nn] = f2bf(acc[m][n][j]); } }
        }
    }
}
#define NEGV (-1e30f)
#define LOG2E_ 1.4426950408889634f
DEV u32x4 n3_ldg(const bf16_t* kbase, long kpitch, const bf16_t* vbase, long vpitch, int kb, int tid) {
    if (tid < 256) return *(const u32x4*)(kbase + (size_t)(kb + (tid >> 3)) * kpitch + (tid & 7) * 8);
    const int i = tid - 256; return *(const u32x4*)(vbase + (size_t)(i >> 2) * vpitch + kb + (i & 3) * 8);
}
DEV void n3_sts(char* buf, u32x4 v, int tid) {
    if (tid < 256) { const int row = tid >> 3, c = tid & 7, sw = ((row >> 1) & 1) | (((row >> 3) & 3) << 1); *(u32x4*)(buf + row * 128 + ((c ^ sw) << 4)) = v; }
    else { const int i = tid - 256, d = i >> 2, c = i & 3; *(u32x4*)(buf + 4096 + d * 64 + ((c ^ ((d >> 2) & 3)) << 4)) = v; }
}
DEV void phase_n3(const NsaBuf& B, char* smem) {
    const int tid = tidx(), lane = tid & 63, wid = tid >> 6, m = lane & 15, fq = lane >> 4, qh = m >> 3, hh = m & 7;
    float* psum = (float*)(smem + wid * 8704); int* ulist = (int*)(smem + wid * 8704 + 8192);
    char* stg = smem + 8 * 8704;
    const int kperm = 8 * (m >> 2) + (m & 3);
    const int kswz = ((m >> 1) & 1) | ((m >> 2) << 1), vswz = (m >> 2) & 3;
    const int koffA = kperm * 128, koffB = (kperm + 4) * 128, voff = 4096 + m * 64 + ((fq ^ vswz) << 4);
    const f32x4 z4 = {0.f, 0.f, 0.f, 0.f};
    const int nrank = (int)gridDim.x >> 3, bg = (int)blockIdx.x & 7;
    for (int qblk = (int)blockIdx.x >> 3; qblk < 256 && (int)blockIdx.x < nrank * 8; qblk += nrank) {
        const int g = bg & 1, b = bg >> 1, t0b = qblk * 32, t0 = t0b + wid * 4;
        int tq[2]; bf16x8 qf[2][2]; float gc[2], gs[2], gw[2]; u32x2 opk[2][4];
#pragma unroll
        for (int rb = 0; rb < 2; ++rb) {
            tq[rb] = t0 + rb * 2 + qh;
            const bf16_t* qp = B.q + ((size_t)(b * SEQ + tq[rb])) * DM + (g * 8 + hh) * 64 + fq * 8;
            qf[rb][0] = __builtin_nontemporal_load((const bf16x8*)qp); qf[rb][1] = __builtin_nontemporal_load((const bf16x8*)(qp + 32));
            const float* gp = B.gates + ((size_t)(b * SEQ + tq[rb])) * 48 + g * 24 + hh * 3;
            gc[rb] = gp[0]; gs[rb] = gp[1]; gw[rb] = gp[2];
        }
#define N3_KFRAGS(buf) const bf16x8 kA0 = *(const bf16x8*)((buf) + koffA + (((0 + fq) ^ kswz) << 4)), kA1 = *(const bf16x8*)((buf) + koffA + (((4 + fq) ^ kswz) << 4)), \
                                    kB0 = *(const bf16x8*)((buf) + koffB + (((0 + fq) ^ kswz) << 4)), kB1 = *(const bf16x8*)((buf) + koffB + (((4 + fq) ^ kswz) << 4));
        {
            const int tid = tidx(), lane = tid & 63, m = lane & 15, fq = (lane >> 4), qh = m >> 3, hh = m & 7, kperm = 8 * (m >> 2) + (m & 3); (void)hh; (void)qh; (void)lane;
            const int kswz = ((m >> 1) & 1) | ((m >> 2) << 1), vswz = (m >> 2) & 3, koffA = kperm * 128, koffB = (kperm + 4) * 128, voff = 4096 + m * 64 + ((fq ^ vswz) << 4);
            int nv[2];
#pragma unroll
            for (int rb = 0; rb < 2; ++rb) nv[rb] = tq[rb] >= 31 ? ((tq[rb] - 31) >> 4) + 1 : 0;
            const int nvmax = (t0b + 31 >= 31) ? ((t0b + 31 - 31) >> 4) + 1 : 0, ngrp = (nvmax + 31) >> 5;
#pragma unroll
            for (int i = 0; i < 32; ++i) psum[lane + 64 * i] = 0.f;
            const bf16_t* kcb = B.kc + (size_t)((b * 2 + g) * 512) * 64; const bf16_t* vcb = B.vcT + (size_t)((b * 2 + g) * 64) * 512;
            float mx[2] = {NEGV, NEGV}, l[2] = {0.f, 0.f};
            u32x4 stv;
            if (ngrp > 0) { stv = n3_ldg(kcb, 64, vcb, 512, 0, tid); n3_sts(stg, stv, tid); }
            __syncthreads();
            for (int grp = 0; grp < ngrp; ++grp) {
                const int kb = grp * 32; const bool more = grp + 1 < ngrp;
                if (more) stv = n3_ldg(kcb, 64, vcb, 512, kb + 32, tid);
                const char* buf = stg + (grp & 1) * 8192;
                N3_KFRAGS(buf)
#pragma unroll
                for (int rb = 0; rb < 2; ++rb) {
                    f32x4 sA = MFMA(kA0, qf[rb][0], z4); sA = MFMA(kA1, qf[rb][1], sA);
                    f32x4 sB = MFMA(kB0, qf[rb][0], z4); sB = MFMA(kB1, qf[rb][1], sB);
                    const bool full = kb + 32 <= nv[rb], part = !full && kb < nv[rb];
                    if (__ballot(part) == 0ull) {
                        const float m8 = fmaxf(fmaxf(fmaxf(sA[0], sA[1]), fmaxf(sA[2], sA[3])), fmaxf(fmaxf(sB[0], sB[1]), fmaxf(sB[2], sB[3])));
                        const float mn = fmaxf(mx[rb], full ? m8 : NEGV), tl = (full ? mn : 1e30f) * LOG2E_; float add = 0.f;
#pragma unroll
                        for (int j = 0; j < 4; ++j) add += __builtin_amdgcn_exp2f(fmaf(sA[j], LOG2E_, -tl)) + __builtin_amdgcn_exp2f(fmaf(sB[j], LOG2E_, -tl));
                        l[rb] = l[rb] * __expf(mx[rb] - mn) + add; mx[rb] = mn;
                    } else {
                    float gm = NEGV;
#pragma unroll
                    for (int j = 0; j < 4; ++j) { if (kb + 8 * fq + j < nv[rb]) gm = fmaxf(gm, sA[j]); if (kb + 8 * fq + 4 + j < nv[rb]) gm = fmaxf(gm, sB[j]); }
                    const float mn = fmaxf(mx[rb], gm); float add = 0.f;
#pragma unroll
                    for (int j = 0; j < 4; ++j) { if (kb + 8 * fq + j < nv[rb]) add += __expf(sA[j] - mn); if (kb + 8 * fq + 4 + j < nv[rb]) add += __expf(sB[j] - mn); }
                    l[rb] = l[rb] * __expf(mx[rb] - mn) + add; mx[rb] = mn;
                    }
                }
                if (more) n3_sts(stg + ((grp + 1) & 1) * 8192, stv, tid);
                __syncthreads();
            }
            float M[2], inv[2];
#pragma unroll
            for (int rb = 0; rb < 2; ++rb) {
                float Mx = fmaxf(mx[rb], __shfl_xor(mx[rb], 16)); Mx = fmaxf(Mx, __shfl_xor(Mx, 32));
                float ll = l[rb] * __expf(mx[rb] - Mx); ll += __shfl_xor(ll, 16); ll += __shfl_xor(ll, 32);
                M[rb] = Mx; inv[rb] = ll > 0.f ? 1.0f / ll : 0.f;
            }
            f32x4 oc[2][4];
#pragma unroll
            for (int rb = 0; rb < 2; ++rb)
#pragma unroll
                for (int d = 0; d < 4; ++d) oc[rb][d] = z4;
            if (ngrp > 0) { stv = n3_ldg(kcb, 64, vcb, 512, 0, tid); n3_sts(stg, stv, tid); }
            __syncthreads();
            for (int grp = 0; grp < ngrp; ++grp) {
                const int kb = grp * 32; const bool more = grp + 1 < ngrp;
                if (more) stv = n3_ldg(kcb, 64, vcb, 512, kb + 32, tid);
                const char* buf = stg + (grp & 1) * 8192;
                N3_KFRAGS(buf)
                bf16x8 vf[4];
#pragma unroll
                for (int d = 0; d < 4; ++d) vf[d] = *(const bf16x8*)(buf + voff + d * 1024);
#pragma unroll
                for (int rb = 0; rb < 2; ++rb) {
                    f32x4 sA = MFMA(kA0, qf[rb][0], z4); sA = MFMA(kA1, qf[rb][1], sA);
                    f32x4 sB = MFMA(kB0, qf[rb][0], z4); sB = MFMA(kB1, qf[rb][1], sB);
                    f32x4 pA, pB;
                    const bool full = kb + 32 <= nv[rb], part = !full && kb < nv[rb];
                    if (__ballot(part) == 0ull) {
                        const float tl = (full ? M[rb] : 1e30f) * LOG2E_;
#pragma unroll
                        for (int j = 0; j < 4; ++j) { pA[j] = __builtin_amdgcn_exp2f(fmaf(sA[j], LOG2E_, -tl)) * inv[rb]; pB[j] = __builtin_amdgcn_exp2f(fmaf(sB[j], LOG2E_, -tl)) * inv[rb]; }
                    } else {
#pragma unroll
                    for (int j = 0; j < 4; ++j) { pA[j] = (kb + 8 * fq + j < nv[rb]) ? __expf(sA[j] - M[rb]) * inv[rb] : 0.f; pB[j] = (kb + 8 * fq + 4 + j < nv[rb]) ? __expf(sB[j] - M[rb]) * inv[rb] : 0.f; }
                    }
#pragma unroll
                    for (int j = 0; j < 4; ++j) {
                        float a = pA[j]; a += DPP_MOV(a, 0xB1); a += DPP_MOV(a, 0x4E); a += DPP_MOV(a, 0x141);
                        float c = pB[j]; c += DPP_MOV(c, 0xB1); c += DPP_MOV(c, 0x4E); c += DPP_MOV(c, 0x141);
                        if (hh == 0) { psum[(rb * 2 + qh) * 512 + kb + 8 * fq + j] = a; psum[(rb * 2 + qh) * 512 + kb + 8 * fq + 4 + j] = c; }
                    }
                    const bf16x8 pf = pack8(pA, pB);
#pragma unroll
                    for (int d = 0; d < 4; ++d) oc[rb][d] = MFMA(vf[d], pf, oc[rb][d]);
                }
                if (more) n3_sts(stg + ((grp + 1) & 1) * 8192, stv, tid);
                __syncthreads();
            }
#pragma unroll
            for (int rb = 0; rb < 2; ++rb)
#pragma unroll
                for (int d = 0; d < 4; ++d) { const f32x4 v = oc[rb][d] * gc[rb]; opk[rb][d].x = cvt_pk(v[0], v[1]); opk[rb][d].y = cvt_pk(v[2], v[3]); }
        }
        asm volatile("s_waitcnt lgkmcnt(0)" ::: "memory");
        __builtin_amdgcn_sched_barrier(0);
        unsigned long long mlo[4], mhi[4];
#pragma unroll
        for (int q2 = 0; q2 < 4; ++q2) {
            const int tqq = t0 + q2, cur = tqq >> 6;
            float sc[2];
#pragma unroll
            for (int c = 0; c < 2; ++c) { const int j = lane + 64 * c; float imp = 0.f;
                for (int n = 4 * j - 1; n <= 4 * j + 3; ++n) if (n >= 0) imp += psum[q2 * 512 + n];
                const bool causal = j * 64 <= tqq, forced = (j == 0) || (j == cur) || (j == cur - 1);
                sc[c] = causal ? imp + (forced ? 1e4f : 0.f) : NEGV; }
            unsigned k0 = __float_as_uint(sc[0]), k1 = __float_as_uint(sc[1]);
            k0 = (k0 & 0x80000000u) ? ~k0 : (k0 | 0x80000000u); k1 = (k1 & 0x80000000u) ? ~k1 : (k1 | 0x80000000u);
            unsigned Tk = 0u;
            for (int bit = 31; bit >= 0; --bit) { const unsigned cand = Tk | (1u << bit);
                const int cnt = __popcll(__ballot(k0 >= cand)) + __popcll(__ballot(k1 >= cand)); if (cnt >= 16) Tk = cand; }
            const int ngt = __popcll(__ballot(k0 > Tk)) + __popcll(__ballot(k1 > Tk)), needn = 16 - ngt;
            const unsigned long long eq0 = __ballot(k0 == Tk), eq1 = __ballot(k1 == Tk), belowm = (1ull << lane) - 1ull;
            const bool s0 = (k0 > Tk) || (k0 == Tk && __popcll(eq0 & belowm) < needn);
            const bool s1 = (k1 > Tk) || (k1 == Tk && __popcll(eq0) + __popcll(eq1 & belowm) < needn);
            mlo[q2] = __ballot(s0); mhi[q2] = __ballot(s1);
        }
        int nun;
        {
            const unsigned long long ulo = mlo[0] | mlo[1] | mlo[2] | mlo[3], uhi = mhi[0] | mhi[1] | mhi[2] | mhi[3];
            const unsigned long long below = (1ull << lane) - 1ull; const int nlo = __popcll(ulo);
            if ((ulo >> lane) & 1ull) { const int mb = (int)((mlo[0] >> lane) & 1ull) | ((int)((mlo[1] >> lane) & 1ull) << 1) | ((int)((mlo[2] >> lane) & 1ull) << 2) | ((int)((mlo[3] >> lane) & 1ull) << 3);
                ulist[__popcll(ulo & below)] = lane | (mb << 8); }
            if ((uhi >> lane) & 1ull) { const int mb = (int)((mhi[0] >> lane) & 1ull) | ((int)((mhi[1] >> lane) & 1ull) << 1) | ((int)((mhi[2] >> lane) & 1ull) << 2) | ((int)((mhi[3] >> lane) & 1ull) << 3);
                ulist[nlo + __popcll(uhi & below)] = (lane + 64) | (mb << 8); }
            nun = nlo + __popcll(uhi);
        }
        asm volatile("s_waitcnt lgkmcnt(0)" ::: "memory");
        __builtin_amdgcn_sched_barrier(0);
        {
            const int tid = tidx(), lane = tid & 63, m = lane & 15, fq = (lane >> 4), qh = m >> 3, hh = m & 7, kperm = 8 * (m >> 2) + (m & 3); (void)hh; (void)qh; (void)lane;
            const unsigned char* ksb = (const unsigned char*)B.kslc + (size_t)((b * 2 + g) * SEQ) * 64 + fq * 8; const unsigned char* vsb = (const unsigned char*)B.vslcT + (size_t)((b * 2 + g) * 128) * 4096 + m * 64 + 8 * fq;
            long q8[2][2];
#pragma unroll
            for (int rb = 0; rb < 2; ++rb)
#pragma unroll
                for (int ks = 0; ks < 2; ++ks) { const u32x4 w = __builtin_bit_cast(u32x4, qf[rb][ks]);
                    const unsigned lo = pack_fp8x4(bf_lo(w.x), bf_hi(w.x), bf_lo(w.y), bf_hi(w.y)), hi = pack_fp8x4(bf_lo(w.z), bf_hi(w.z), bf_lo(w.w), bf_hi(w.w));
                    q8[rb][ks] = (long)(((unsigned long long)hi << 32) | lo); }
            float mx[2] = {NEGV, NEGV}, l[2] = {0.f, 0.f}; f32x4 os[2][4];
#pragma unroll
            for (int rb = 0; rb < 2; ++rb)
#pragma unroll
                for (int d = 0; d < 4; ++d) os[rb][d] = z4;
            char* st8 = (char*)psum;
            const int srow = lane >> 2, sc0 = (lane & 3) * 2;
            u32x4 gk[4], gv[4];
            { const int blk0 = ulist[0] & 255; const unsigned char* kp = (const unsigned char*)B.kslc + ((size_t)((b * 2 + g) * SEQ) + blk0 * 64) * 64 + lane * 16; const unsigned char* vp = (const unsigned char*)B.vslcT + ((size_t)((b * 2 + g) * 128) + blk0) * 4096 + lane * 16;
#pragma unroll
              for (int i = 0; i < 4; ++i) { gk[i] = *(const u32x4*)(kp + i * 1024); gv[i] = *(const u32x4*)(vp + i * 1024); } }
            const int fsw = (m >> 2) << 1;
            for (int ib = 0; ib < nun; ++ib) {
                const int e = __builtin_amdgcn_readfirstlane(ulist[ib]);
#pragma unroll
                for (int i = 0; i < 4; ++i) { const int row = i * 16 + srow;
                    *(u32x4*)(st8 + row * 64 + ((sc0 ^ (((row >> 3) & 3) << 1)) << 3)) = gk[i];
                    *(u32x4*)(st8 + 4096 + row * 64 + ((sc0 ^ (((row >> 2) & 3) << 1)) << 3)) = gv[i]; }
                if (ib + 1 < nun) { const int blkn = ulist[ib + 1] & 255; const unsigned char* kp = (const unsigned char*)B.kslc + ((size_t)((b * 2 + g) * SEQ) + blkn * 64) * 64 + lane * 16; const unsigned char* vp = (const unsigned char*)B.vslcT + ((size_t)((b * 2 + g) * 128) + blkn) * 4096 + lane * 16;
#pragma unroll
                    for (int i = 0; i < 4; ++i) { gk[i] = *(const u32x4*)(kp + i * 1024); gv[i] = *(const u32x4*)(vp + i * 1024); } }
#pragma unroll
              for (int hf = 0; hf < 2; ++hf) {
                const int kb = (e & 255) * 64 + hf * 32;
                const char* kr = st8 + (hf * 32 + kperm) * 64;
                const long kA0 = *(const long*)(kr + ((fq ^ fsw) << 3)), kA1 = *(const long*)(kr + (((4 + fq) ^ fsw) << 3)), kB0 = *(const long*)(kr + 256 + ((fq ^ fsw) << 3)), kB1 = *(const long*)(kr + 256 + (((4 + fq) ^ fsw) << 3));
                long vf[4];
#pragma unroll
                for (int d = 0; d < 4; ++d) vf[d] = *(const long*)(st8 + 4096 + (d * 16 + m) * 64 + (((hf * 4 + fq) ^ fsw) << 3));
#pragma unroll
                for (int rb = 0; rb < 2; ++rb) {
                    if (((e >> (8 + rb * 2)) & 3) == 0) continue;
                    const bool mine = ((e >> (8 + rb * 2 + qh)) & 1) != 0;
                    f32x4 sA = MFMA8(kA0, q8[rb][0], z4); sA = MFMA8(kA1, q8[rb][1], sA);
                    f32x4 sB = MFMA8(kB0, q8[rb][0], z4); sB = MFMA8(kB1, q8[rb][1], sB);
                    const bool full = mine && kb + 31 <= tq[rb], part = mine && !full && kb <= tq[rb];
                    const bool fast = __ballot(part) == 0ull;
                    float gm = NEGV;
                    if (fast) { const float m8 = fmaxf(fmaxf(fmaxf(sA[0], sA[1]), fmaxf(sA[2], sA[3])), fmaxf(fmaxf(sB[0], sB[1]), fmaxf(sB[2], sB[3]))); gm = full ? m8 : NEGV; }
                    else {
#pragma unroll
                    for (int j = 0; j < 4; ++j) { if (mine && kb + 8 * fq + j <= tq[rb]) gm = fmaxf(gm, sA[j]); if (mine && kb + 8 * fq + 4 + j <= tq[rb]) gm = fmaxf(gm, sB[j]); }
                    }
                    if (__ballot(gm > mx[rb]) != 0ull) {
                        gm = fmaxf(gm, __shfl_xor(gm, 16)); gm = fmaxf(gm, __shfl_xor(gm, 32));
                        const float mn2 = fmaxf(mx[rb], gm), alpha = __expf(mx[rb] - mn2); mx[rb] = mn2; l[rb] *= alpha;
#pragma unroll
                        for (int d = 0; d < 4; ++d) os[rb][d] *= alpha;
                    }
                    const float mn = mx[rb];
                    f32x4 pA, pB; float add = 0.f;
                    if (fast) { const float tl = (full ? mn : 1e30f) * LOG2E_ - 7.f;
#pragma unroll
                        for (int j = 0; j < 4; ++j) { pA[j] = __builtin_amdgcn_exp2f(fmaf(sA[j], LOG2E_, -tl)); pB[j] = __builtin_amdgcn_exp2f(fmaf(sB[j], LOG2E_, -tl)); add += pA[j] + pB[j]; }
                    } else {
#pragma unroll
                    for (int j = 0; j < 4; ++j) { pA[j] = (mine && kb + 8 * fq + j <= tq[rb]) ? __expf(sA[j] - mn + 4.8520302639f) : 0.f; pB[j] = (mine && kb + 8 * fq + 4 + j <= tq[rb]) ? __expf(sB[j] - mn + 4.8520302639f) : 0.f; add += pA[j] + pB[j]; }
                    }
                    l[rb] += add;
                    const unsigned plo = pack_fp8x4(pA[0], pA[1], pA[2], pA[3]), phi = pack_fp8x4(pB[0], pB[1], pB[2], pB[3]);
                    const long pf = (long)(((unsigned long long)phi << 32) | plo);
#pragma unroll
                    for (int d = 0; d < 4; ++d) os[rb][d] = MFMA8(vf[d], pf, os[rb][d]);
                }
              }
            }
#pragma unroll
            for (int rb = 0; rb < 2; ++rb) {
                float ll = l[rb]; ll += __shfl_xor(ll, 16); ll += __shfl_xor(ll, 32);
                const float sc = ll > 0.f ? gs[rb] / ll : 0.f;
#pragma unroll
                for (int d = 0; d < 4; ++d) { f32x4 v = os[rb][d] * sc; v[0] += bf_lo(opk[rb][d].x); v[1] += bf_hi(opk[rb][d].x); v[2] += bf_lo(opk[rb][d].y); v[3] += bf_hi(opk[rb][d].y);
                    opk[rb][d].x = cvt_pk(v[0], v[1]); opk[rb][d].y = cvt_pk(v[2], v[3]); }
            }
        }
        __builtin_amdgcn_sched_barrier(0);
        {
            const int tid = tidx(), lane = tid & 63, m = lane & 15, fq = (lane >> 4), qh = m >> 3, hh = m & 7, kperm = 8 * (m >> 2) + (m & 3); (void)hh; (void)qh; (void)lane;
            const int kswz = ((m >> 1) & 1) | ((m >> 2) << 1), vswz = (m >> 2) & 3, koffA = kperm * 128, koffB = (kperm + 4) * 128, voff = 4096 + m * 64 + ((fq ^ vswz) << 4);
            const bf16_t* kwb = B.kwin + (size_t)b * SEQ * 128 + g * 64; const bf16_t* vwb = B.vwinT + (size_t)((b * 2 + g) * 64) * SEQ;
            float mx[2] = {NEGV, NEGV}, l[2] = {0.f, 0.f}; f32x4 ow[2][4];
#pragma unroll
            for (int rb = 0; rb < 2; ++rb)
#pragma unroll
                for (int d = 0; d < 4; ++d) ow[rb][d] = z4;
            const int lo = t0b - 511 > 0 ? t0b - 511 : 0, kb0 = lo & ~31, kbl = t0b + 31;
            u32x4 stv = n3_ldg(kwb, 128, vwb, SEQ, kb0, tid); n3_sts(stg, stv, tid);
            __syncthreads();
            int gi = 0;
            for (int kb = kb0; kb <= kbl; kb += 32, ++gi) {
                const bool more = kb + 32 <= kbl;
                if (more) stv = n3_ldg(kwb, 128, vwb, SEQ, kb + 32, tid);
                const char* buf = stg + (gi & 1) * 8192;
                if (kb <= t0 + 3 && kb + 31 > t0 - 512) {
                    N3_KFRAGS(buf)
                    bf16x8 vf[4];
#pragma unroll
                    for (int d = 0; d < 4; ++d) vf[d] = *(const bf16x8*)(buf + voff + d * 1024);
#pragma unroll
                    for (int rb = 0; rb < 2; ++rb) {
                        f32x4 sA = MFMA(kA0, qf[rb][0], z4); sA = MFMA(kA1, qf[rb][1], sA);
                        f32x4 sB = MFMA(kB0, qf[rb][0], z4); sB = MFMA(kB1, qf[rb][1], sB);
                        const bool full = kb + 31 <= tq[rb] && kb > tq[rb] - 512, part = !full && kb <= tq[rb] && kb + 31 > tq[rb] - 512;
                        const bool fast = __ballot(part) == 0ull;
                        float gm = NEGV;
                        if (fast) { const float m8 = fmaxf(fmaxf(fmaxf(sA[0], sA[1]), fmaxf(sA[2], sA[3])), fmaxf(fmaxf(sB[0], sB[1]), fmaxf(sB[2], sB[3]))); gm = full ? m8 : NEGV; }
                        else {
#pragma unroll
                        for (int j = 0; j < 4; ++j) { const int pa = kb + 8 * fq + j, pb = pa + 4; if (pa <= tq[rb] && pa > tq[rb] - 512) gm = fmaxf(gm, sA[j]); if (pb <= tq[rb] && pb > tq[rb] - 512) gm = fmaxf(gm, sB[j]); }
                        }
                        if (__ballot(gm > mx[rb] + 40.f) != 0ull) {
                            gm = fmaxf(gm, __shfl_xor(gm, 16)); gm = fmaxf(gm, __shfl_xor(gm, 32));
                            const float mn2 = fmaxf(mx[rb], gm), alpha = __expf(mx[rb] - mn2); mx[rb] = mn2; l[rb] *= alpha;
#pragma unroll
                            for (int d = 0; d < 4; ++d) ow[rb][d] *= alpha;
                        }
                        const float mn = mx[rb];
                        f32x4 pA, pB; float add = 0.f;
                        if (fast) { const float tl = (full ? mn : 1e30f) * LOG2E_;
#pragma unroll
                            for (int j = 0; j < 4; ++j) { pA[j] = __builtin_amdgcn_exp2f(fmaf(sA[j], LOG2E_, -tl)); pB[j] = __builtin_amdgcn_exp2f(fmaf(sB[j], LOG2E_, -tl)); add += pA[j] + pB[j]; }
                        } else {
#pragma unroll
                        for (int j = 0; j < 4; ++j) { const int pa = kb + 8 * fq + j, pb = pa + 4; const bool va = pa <= tq[rb] && pa > tq[rb] - 512, vb = pb <= tq[rb] && pb > tq[rb] - 512;
                            pA[j] = va ? __expf(sA[j] - mn) : 0.f; pB[j] = vb ? __expf(sB[j] - mn) : 0.f; add += pA[j] + pB[j]; }
                        }
                        l[rb] += add;
                        const bf16x8 pf = pack8(pA, pB);
#pragma unroll
                        for (int d = 0; d < 4; ++d) ow[rb][d] = MFMA(vf[d], pf, ow[rb][d]);
                    }
                }
                if (more) n3_sts(stg + ((gi + 1) & 1) * 8192, stv, tid);
                __syncthreads();
            }
#pragma unroll
            for (int rb = 0; rb < 2; ++rb) {
                float ll = l[rb]; ll += __shfl_xor(ll, 16); ll += __shfl_xor(ll, 32);
                const float sc = ll > 0.f ? gw[rb] / ll : 0.f;
#pragma unroll
                for (int d = 0; d < 4; ++d) { f32x4 v = ow[rb][d] * sc; v[0] += bf_lo(opk[rb][d].x); v[1] += bf_hi(opk[rb][d].x); v[2] += bf_lo(opk[rb][d].y); v[3] += bf_hi(opk[rb][d].y);
                    opk[rb][d].x = cvt_pk(v[0], v[1]); opk[rb][d].y = cvt_pk(v[2], v[3]); }
            }
        }
#undef N3_KFRAGS
#pragma unroll
        for (int rb = 0; rb < 2; ++rb) {
            bf16_t* op = B.o + ((size_t)(b * SEQ + tq[rb])) * DM + (g * 8 + hh) * 64 + fq * 4;
#pragma unroll
            for (int d = 0; d < 4; ++d) __builtin_nontemporal_store(opk[rb][d], (u32x2*)(op + d * 16));
        }
    }
}

struct GlaBuf { bf16_t *qe, *ke, *vT, *r, *o, *kdT, *ab; float *adn, *dec; };
DEV void phase_l1(const bf16_t* xn, const bf16_t* Bt, const GlaBuf& B, char* smem) {
    const LaneId L = lane_id();
    const int ntn = 25, nunits = (T / 256) * ntn;
    for (int u = blockIdx.x; u < nunits; u += gridDim.x) {
        const int tm = u / ntn, tn = u % ntn;
        f32x4 acc[4][4];
        gemm_core(acc, LdPlain{xn + (size_t)tm * 256 * DM, DM}, LdPlain{Bt + (size_t)tn * 128 * DM, DM}, DM, smem);
#pragma unroll
        for (int m = 0; m < 4; ++m)
#pragma unroll
            for (int n = 0; n < 4; ++n) {
                const size_t row = (size_t)tm * 256 + L.wm * 64 + m * 16 + L.fr; const int c = L.wn * 64 + n * 16 + L.fq * 4; const f32x4 v = acc[m][n];
                if (tn < 4) st_bf4(B.qe + row * 512 + tn * 128 + c, v * 0.08838834764831845f);
                else if (tn < 8) st_bf4(B.ke + row * 512 + (tn - 4) * 128 + c, v);
                else if (tn < 16) { const int b = (int)(row >> 13), t = (int)(row & (SEQ - 1)), vc = (tn - 8) * 128 + c;
                    for (int j = 0; j < 4; ++j) B.vT[((size_t)(b * 1024 + vc + j)) * SEQ + t] = f2bf(v[j]); }
                else if (tn < 24) st_bf4(B.r + row * DM + (tn - 16) * 128 + c, v);
                else { if (c < 16) *(f32x4*)(B.adn + row * 16 + c) = v; }
            }
    }
}
DEV void phase_l2a(const float* a_up, const float* a_bias, const GlaBuf& B) {
    const int gt = blockIdx.x * NTHR + tidx(), nt = gridDim.x * NTHR;
    for (int idx = gt; idx < NBATCH * 128 * 512; idx += nt) {
        const int c = idx & 511, n = (idx >> 9) & 127, b = idx >> 16, h = c >> 7, d = c & 127;
        float au[16];
#pragma unroll
        for (int r = 0; r < 16; ++r) au[r] = a_up[r * 512 + c];
        const float ab = a_bias[c];
        const size_t row0 = (size_t)b * SEQ + n * 64;
        float blast = 0.f;
#pragma unroll 4
        for (int t = 0; t < 64; ++t) {
            const float* ad = B.adn + (row0 + t) * 16; float x = ab;
#pragma unroll
            for (int r4 = 0; r4 < 4; ++r4) { const f32x4 a = *(const f32x4*)(ad + r4 * 4); x += a[0] * au[r4 * 4] + a[1] * au[r4 * 4 + 1] + a[2] * au[r4 * 4 + 2] + a[3] * au[r4 * 4 + 3]; }
            blast += -(fmaxf(-x, 0.f) + log1pf(__expf(-fabsf(x)))) * (1.0f / 16.0f);
        }
        float bcum = 0.f;
        bf16_t* kd = B.kdT + (((size_t)(b * 128 + n) * 4 + h) * 128 + d) * 64;
#pragma unroll 1
        for (int t8 = 0; t8 < 8; ++t8) {
            float kdv[8];
#pragma unroll
            for (int tt = 0; tt < 8; ++tt) {
                const int t = t8 * 8 + tt;
                const float* ad = B.adn + (row0 + t) * 16; float x = ab;
#pragma unroll
                for (int r4 = 0; r4 < 4; ++r4) { const f32x4 a = *(const f32x4*)(ad + r4 * 4); x += a[0] * au[r4 * 4] + a[1] * au[r4 * 4 + 1] + a[2] * au[r4 * 4 + 2] + a[3] * au[r4 * 4 + 3]; }
                bcum += -(fmaxf(-x, 0.f) + log1pf(__expf(-fabsf(x)))) * (1.0f / 16.0f);
                const float q = bf2f(B.qe[(row0 + t) * 512 + c]), k = bf2f(B.ke[(row0 + t) * 512 + c]);
                B.qe[(row0 + t) * 512 + c] = f2bf(q * __expf(bcum)); B.ke[(row0 + t) * 512 + c] = f2bf(k * __expf(-bcum));
                kdv[tt] = k * __expf(blast - bcum);
            }
            u32x4 w; w.x = cvt_pk(kdv[0], kdv[1]); w.y = cvt_pk(kdv[2], kdv[3]); w.z = cvt_pk(kdv[4], kdv[5]); w.w = cvt_pk(kdv[6], kdv[7]);
            *(u32x4*)(kd + t8 * 8) = w;
        }
        B.dec[((size_t)(b * 128 + n) * 4 + h) * 128 + d] = __expf(blast);
    }
}
DEV void phase_l2b(const GlaBuf& B) {
    const int lane = tidx() & 63, wid = tidx() >> 6, m = lane & 15, fq = lane >> 4;
    const int kperm = 8 * (m >> 2) + (m & 3);
    const f32x4 z4 = {0.f, 0.f, 0.f, 0.f};
    for (int task = blockIdx.x * 8 + wid; task < NBATCH * 128 * 4 * 4; task += gridDim.x * 8) {
        const int mb = task & 3, h = (task >> 2) & 3, n = (task >> 4) & 127, b = task >> 11;
        const size_t row0 = (size_t)b * SEQ + n * 64; const int i = mb * 16 + m;
        bf16x8 qf[4];
#pragma unroll
        for (int ks = 0; ks < 4; ++ks) qf[ks] = *(const bf16x8*)(B.qe + (row0 + i) * 512 + h * 128 + ks * 32 + fq * 8);
        f32x4 oacc[16];
#pragma unroll
        for (int v = 0; v < 16; ++v) oacc[v] = z4;
        const int ngrp = (mb * 16 + 15) / 32 + 1;
        for (int grp = 0; grp < ngrp; ++grp) {
            const int kb = grp * 32; const bf16_t* ka = B.ke + (row0 + kb + kperm) * 512 + h * 128 + fq * 8;
            f32x4 sA = z4, sB = z4;
#pragma unroll
            for (int ks = 0; ks < 4; ++ks) { sA = MFMA(*(const bf16x8*)(ka + ks * 32), qf[ks], sA); sB = MFMA(*(const bf16x8*)(ka + 4 * 512 + ks * 32), qf[ks], sB); }
#pragma unroll
            for (int j = 0; j < 4; ++j) { if (kb + 8 * fq + j > i) sA[j] = 0.f; if (kb + 8 * fq + 4 + j > i) sB[j] = 0.f; }
            const bf16x8 pf = pack8(sA, sB);
#pragma unroll
            for (int v = 0; v < 16; ++v) oacc[v] = MFMA(*(const bf16x8*)(B.vT + ((size_t)(b * 1024 + h * 256 + v * 16 + m)) * SEQ + n * 64 + kb + 8 * fq), pf, oacc[v]);
        }
#pragma unroll
        for (int v = 0; v < 16; ++v) st_bf4(B.o + (row0 + i) * DM + h * 256 + v * 16 + fq * 4, oacc[v]);
    }
}
constexpr int L3_SEG = 8, L3_CPS = 128 / L3_SEG;
template <int PASS>
DEV void phase_l3(const GlaBuf& B, float* loc, float* dseg, char* smem) {
    const int tid = tidx(), lane = tid & 63, wid = tid >> 6, m = lane & 15, fq = lane >> 4;
    const int kswz = ((m >> 1) & 1) | ((m >> 2) << 1);
    const f32x4 z4 = {0.f, 0.f, 0.f, 0.f};
    for (int task = blockIdx.x * 8 + wid; task < 16 * L3_SEG * 16; task += gridDim.x * 8) {
        const int vs = task & 15, seg = (task >> 4) & (L3_SEG - 1), bh = task >> 7, h = bh & 3, b = bh >> 2;
        f32x4 st[8];
#pragma unroll
        for (int i = 0; i < 8; ++i) st[i] = z4;
        float* myloc = loc + ((size_t)(bh * 16 + vs) * L3_SEG) * 2048;
        if (PASS == 1) {
            for (int sg = 0; sg < seg; ++sg) {
                const float* dq = dseg + ((size_t)bh * L3_SEG + sg) * 128;
#pragma unroll
                for (int i = 0; i < 8; ++i) { const f32x4 de = *(const f32x4*)(dq + (i >> 1) * 32 + 8 * fq + (i & 1) * 4); const f32x4 lc = *(const f32x4*)(myloc + (size_t)sg * 2048 + i * 256 + lane * 4); st[i] = st[i] * de + lc; }
            }
        }
        f32x4 dprod[8];
#pragma unroll
        for (int i = 0; i < 8; ++i) dprod[i] = (f32x4){1.f, 1.f, 1.f, 1.f};
        const bf16_t* vrow = B.vT + ((size_t)(b * 1024 + h * 256 + vs * 16 + m)) * SEQ;
        u32x4 sq[2], sk[2];
        const int n0 = seg * L3_CPS;
#define L3_LDG(n) { const size_t r0_ = (size_t)b * SEQ + (n) * 64; const bf16_t* kd_ = B.kdT + ((size_t)(b * 128 + (n)) * 4 + h) * 128 * 64; \
            _Pragma("unroll") for (int i = 0; i < 2; ++i) { const int e = tid + 512 * i; \
                if (PASS == 1) sq[i] = *(const u32x4*)(B.qe + (r0_ + (e >> 4)) * 512 + h * 128 + (e & 15) * 8); \
                sk[i] = *(const u32x4*)(kd_ + (size_t)(e >> 3) * 64 + (e & 7) * 8); } }
#define L3_STS(bufp) { _Pragma("unroll") for (int i = 0; i < 2; ++i) { const int e = tid + 512 * i; \
                if (PASS == 1) { const int row = e >> 4, c = e & 15; *(u32x4*)((bufp) + row * 256 + ((c ^ (row & 15)) << 4)) = sq[i]; } \
                { const int dr = e >> 3, c = e & 7, sw = ((dr >> 1) & 1) | (((dr >> 3) & 3) << 1); *(u32x4*)((bufp) + 16384 + dr * 128 + ((c ^ sw) << 4)) = sk[i]; } } }
        L3_LDG(n0) L3_STS(smem)
        __syncthreads();
        for (int n = n0; n < n0 + L3_CPS; ++n) {
            const bool more = n + 1 < n0 + L3_CPS;
            if (more) L3_LDG(n + 1)
            const char* buf = smem + ((n - n0) & 1) * 32768;
            const size_t row0 = (size_t)b * SEQ + n * 64;
            if (PASS == 1) {
                bf16x8 sf[4];
#pragma unroll
                for (int dg = 0; dg < 4; ++dg) sf[dg] = pack8(st[2 * dg], st[2 * dg + 1]);
#pragma unroll
                for (int ib = 0; ib < 4; ++ib) {
                    f32x4 acc = z4;
#pragma unroll
                    for (int dg = 0; dg < 4; ++dg) acc = MFMA(*(const bf16x8*)(buf + (ib * 16 + m) * 256 + (((dg * 4 + fq) ^ m) << 4)), sf[dg], acc);
#pragma unroll
                    for (int j = 0; j < 4; ++j) { bf16_t* op = B.o + (row0 + ib * 16 + fq * 4 + j) * DM + h * 256 + vs * 16 + m; *op = f2bf(bf2f(*op) + acc[j]); }
                }
            }
            const float* dc = B.dec + ((size_t)(b * 128 + n) * 4 + h) * 128;
            const bf16x8 vf0 = *(const bf16x8*)(vrow + n * 64 + fq * 8), vf1 = *(const bf16x8*)(vrow + n * 64 + 32 + fq * 8);
#pragma unroll
            for (int dg = 0; dg < 4; ++dg)
#pragma unroll
                for (int bl = 0; bl < 2; ++bl) {
                    const int drow = dg * 32 + 8 * (m >> 2) + (m & 3) + bl * 4;
                    f32x4 acc = MFMA(*(const bf16x8*)(buf + 16384 + drow * 128 + ((fq ^ kswz) << 4)), vf0, z4);
                    acc = MFMA(*(const bf16x8*)(buf + 16384 + drow * 128 + (((4 + fq) ^ kswz) << 4)), vf1, acc);
                    const f32x4 de = *(const f32x4*)(dc + dg * 32 + 8 * fq + bl * 4);
                    st[2 * dg + bl] = st[2 * dg + bl] * de + acc;
                    if (PASS == 0) dprod[2 * dg + bl] *= de;
                }
            if (more) L3_STS(smem + ((n - n0 + 1) & 1) * 32768)
            __syncthreads();
        }
#undef L3_LDG
#undef L3_STS
        if (PASS == 0) {
#pragma unroll
            for (int i = 0; i < 8; ++i) *(f32x4*)(myloc + (size_t)seg * 2048 + i * 256 + lane * 4) = st[i];
            if (vs == 0 && m == 0) {
                float* dq = dseg + ((size_t)bh * L3_SEG + seg) * 128;
#pragma unroll
                for (int i = 0; i < 8; ++i) *(f32x4*)(dq + (i >> 1) * 32 + 8 * fq + (i & 1) * 4) = dprod[i];
            }
        }
    }
}
DEV void phase_l4(const float* norm_w, const GlaBuf& B) {
    const int lane = tidx() & 63, gw = blockIdx.x * (NTHR / 64) + (tidx() >> 6), nw = gridDim.x * (NTHR / 64);
    const f32x4 nwv = *(const f32x4*)(norm_w + lane * 4);
    for (int it = gw; it < T * 4; it += nw) {
        const size_t off = (size_t)it * 256 + lane * 4;
        const f32x4 o = ld_bf4(B.o + off), r = ld_bf4(B.r + off);
        float ss = o[0] * o[0] + o[1] * o[1] + o[2] * o[2] + o[3] * o[3]; ss = wave_sum(ss);
        const float rs = rsqrtf(ss * (1.0f / 256.0f) + 1e-5f); f32x4 y;
#pragma unroll
        for (int j = 0; j < 4; ++j) y[j] = o[j] * rs * nwv[j] * (r[j] * rcpf_(1.0f + __expf(-r[j])));
        st_bf4(B.ab + off, y);
    }
}

enum { PH_PREP = 0, PH_NORM0, PH_NORM_MID, PH_NORM_END, PH_F1, PH_F1B, PH_F2, PH_R1, PH_R2, PH_R3, PH_R4, PH_R5, PH_N1, PH_N2A, PH_N2B, PH_N3, PH_N4, PH_L1, PH_L2A, PH_L2B, PH_L3, PH_L4, PH_L5, PH_GT, PH_L3A, PH_COPY };

DEV bf16_t* slot(const Params& P, int i) { return (bf16_t*)(P.ws + (size_t)i * SLOT); }
DEV RwkvW rwkv_w(const Params& P, int j) {
    RwkvW W; W.mu = P.in[I_MU] + (size_t)j * 6 * DM; W.w0 = P.in[I_W0] + j * DM; W.a0 = P.in[I_A0] + j * DM; W.k_k = P.in[I_KK] + j * DM; W.k_a = P.in[I_KA] + j * DM;
    W.r_k = P.in[I_RK] + j * DM; W.ln_w = P.in[I_LNW] + j * DM; W.ln_b = P.in[I_LNB] + j * DM; W.v0 = P.in[I_V0] + (j > 0 ? (j - 1) * DM : 0); W.vres = j > 0; return W; }
DEV NsaBuf nsa_buf(const Params& P) {
    NsaBuf B; char* s2 = P.ws + 2 * SLOT; char* s3 = P.ws + 3 * SLOT;
    B.q = slot(P, 1); B.kcmp = (bf16_t*)s2; B.vcmp = (bf16_t*)(s2 + 8 * MiB); B.kslc = (bf16_t*)(s2 + 16 * MiB); B.kwin = (bf16_t*)(s2 + 24 * MiB);
    B.vslcT = (bf16_t*)(s2 + 32 * MiB); B.vwinT = (bf16_t*)(s2 + 40 * MiB); B.gates = (float*)(s2 + 48 * MiB);
    B.hid = (bf16_t*)s3; B.kc = (bf16_t*)(s3 + 8 * MiB); B.vcT = (bf16_t*)(s3 + 9 * MiB); B.o = slot(P, 4); return B; }
DEV GlaBuf gla_buf(const Params& P) {
    GlaBuf B; char* s1 = P.ws + 1 * SLOT; char* s5 = P.ws + 5 * SLOT;
    B.qe = (bf16_t*)s1; B.ke = (bf16_t*)(s1 + 32 * MiB); B.vT = slot(P, 2); B.r = slot(P, 3); B.o = slot(P, 4);
    B.kdT = (bf16_t*)s5; B.adn = (float*)(s5 + 32 * MiB); B.dec = (float*)(s5 + 40 * MiB); B.ab = slot(P, 0); return B; }

template <int PH>
DEV void run_phase(const Params& P, int layer, char* smem) {
    char* ws = P.ws; const int j = layer / 3;
    const float* ng = P.in[I_NORMG] + (size_t)layer * 4 * DM;
    bf16_t* mixw = (bf16_t*)(ws + OFF_MIX);
    bf16_t* hid = (bf16_t*)(ws + OFF_HID);
    float* bsc = (float*)(ws + OFF_BSC);
    if constexpr (PH == PH_PREP) phase_prep(P, layer, smem);
    else if constexpr (PH == PH_NORM0) phase_norm<0, 0>(P.in[I_X], nullptr, nullptr, nullptr, nullptr, ng, slot(P, 0));
    else if constexpr (PH == PH_NORM_MID) {
        const int kind = layer % 3; const bf16_t* z = kind == 0 ? slot(P, 2) : kind == 1 ? slot(P, 5) : slot(P, 1);
        bf16_t* hb = (bf16_t*)((char*)P.out + 64 * MiB);
        if (layer == 0) phase_norm<0, 1>(P.in[I_X], z, ng + DM, hb, nullptr, ng + 2 * DM, slot(P, 0));
        else phase_norm<1, 1>(hb, z, ng + DM, hb, nullptr, ng + 2 * DM, slot(P, 0)); }
    else if constexpr (PH == PH_NORM_END) { bf16_t* hb = (bf16_t*)((char*)P.out + 64 * MiB);
        if (layer < 3) phase_norm<1, 1>(hb, slot(P, 4), ng + 3 * DM, hb, nullptr, ng + 4 * DM, slot(P, 0));
        else phase_norm<1, 2>(hb, slot(P, 4), ng + 3 * DM, P.out, (float*)slot(P, 0), nullptr, nullptr); }
    else if constexpr (PH == PH_COPY) phase_copy_out((const float*)slot(P, 0), P.out);
    else if constexpr (PH == PH_F1) { EpiF1 E; E.cw = P.in[I_FCW] + (size_t)layer * 3 * DFF; E.cb = P.in[I_FCB] + (size_t)layer * DFF; E.act = slot(P, 1); E.E = slot(P, 5);
        phase_gemm_pg8(slot(P, 0), DM, (const bf16_t*)(ws + OFF_WF1), 2 * DFF, DM, E, smem); }
    else if constexpr (PH == PH_F1B) phase_f1b(P.in[I_FCW] + (size_t)layer * 3 * DFF, P.in[I_FCB] + (size_t)layer * DFF, slot(P, 1), slot(P, 5));
    else if constexpr (PH == PH_F2) { EpiPlain E; E.C = slot(P, 4); E.ldc = DM; phase_gemm_pg8(slot(P, 1), DFF, (const bf16_t*)(ws + OFF_WF2), DM, DFF, E, smem); }
    else if constexpr (PH == PH_R1) { const RwkvW W = rwkv_w(P, j); phase_r1(slot(P, 0), mixw, W, slot(P, 1), slot(P, 3), hid, smem); }
    else if constexpr (PH == PH_R2) { const RwkvW W = rwkv_w(P, j); phase_r2(slot(P, 0), mixw, W, hid, slot(P, 1), bsc, slot(P, 2), slot(P, 3), slot(P, 4), slot(P, 5), slot(P, 6), smem); }
    else if constexpr (PH == PH_R3) { const RwkvW W = rwkv_w(P, j); (void)W; phase_r3c(slot(P, 1), slot(P, 2), slot(P, 3), slot(P, 4), slot(P, 5), slot(P, 6), slot(P, 0), (char*)P.out, smem); }
    else if constexpr (PH == PH_R4) { const RwkvW W = rwkv_w(P, j); phase_r4(hid, (const bf16_t*)((const char*)mixw + 7 * MiB + 393216), W, slot(P, 0), slot(P, 6), bsc, slot(P, 1), smem); }
    else if constexpr (PH == PH_R5) { EpiPlain E; E.C = slot(P, 2); E.ldc = DM; phase_gemm_pg8(slot(P, 1), DM, (const bf16_t*)((const char*)mixw + 8 * MiB), DM, DM, E, smem); }
    else if constexpr (PH == PH_N1) { const NsaBuf B = nsa_buf(P);
        { EpiScale E; E.C = B.q; E.ldc = DM; E.scale = 0.125f; phase_gemm_pg8(slot(P, 0), DM, mixw, 1024, DM, E, smem); }
        __syncthreads();
        { EpiN1kv E; E.kv = B.kcmp; phase_gemm_pg8(slot(P, 0), DM, mixw + (size_t)1024 * DM, 1024, DM, E, smem); } }
    else if constexpr (PH == PH_N2A) { const NsaBuf B = nsa_buf(P); phase_n2a((const bf16_t*)((const char*)mixw + 4 * MiB), (const float*)(ws + OFF_BIASP), B, smem); }
    else if constexpr (PH == PH_N2B) { const NsaBuf B = nsa_buf(P); phase_n2b((const bf16_t*)((const char*)mixw + 6 * MiB), B, smem); }
    else if constexpr (PH == PH_N3) { const NsaBuf B = nsa_buf(P); phase_n3(B, smem); }
    else if constexpr (PH == PH_N4) { EpiPlain E; E.C = slot(P, 5); E.ldc = DM; phase_gemm_pg8(slot(P, 4), DM, (const bf16_t*)((const char*)mixw + 7 * MiB), DM, DM, E, smem); }
    else if constexpr (PH == PH_L1) { const GlaBuf B = gla_buf(P); EpiL1 E; E.qe = B.qe; E.ke = B.ke; E.vT = B.vT; E.r = B.r; E.adn = B.adn;
        phase_gemm_pg8(slot(P, 0), DM, mixw, 3328, DM, E, smem); }
    else if constexpr (PH == PH_L2A) { const GlaBuf B = gla_buf(P); phase_l2a(P.in[I_AUP], P.in[I_ABIAS], B); }
    else if constexpr (PH == PH_L2B) { const GlaBuf B = gla_buf(P); phase_l2b(B); }
    else if constexpr (PH == PH_L3A) { const GlaBuf B = gla_buf(P); phase_l3<0>(B, (float*)slot(P, 0), (float*)(P.ws + 32 * MiB), smem); }
    else if constexpr (PH == PH_L3) { const GlaBuf B = gla_buf(P); phase_l3<1>(B, (float*)slot(P, 0), (float*)(P.ws + 32 * MiB), smem); }
    else if constexpr (PH == PH_L4) { const GlaBuf B = gla_buf(P); phase_l4(P.in[I_GNW], B); }
    else if constexpr (PH == PH_GT) phase_gemm_plain(slot(P, 0), DM, (const bf16_t*)((const char*)mixw + 8 * MiB), DM, 8, slot(P, 2), DM, smem);
    else if constexpr (PH == PH_L5) { EpiPlain E; E.C = slot(P, 1); E.ldc = DM; phase_gemm_pg8(slot(P, 0), DM, (const bf16_t*)((const char*)mixw + 7 * MiB), DM, DM, E, smem); }
}

template <int PH>
__global__ void __launch_bounds__(NTHR, 2) k_phase(Params P, int layer) {
    extern __shared__ __attribute__((aligned(16))) char smem[];
    run_phase<PH>(P, layer, smem);
}


constexpr int MEGA_LDS = 131072 + 64 + 2048;
typedef const Params __attribute__((address_space(4)))* ParamsK;
DEV ParamsK kparams() { ParamsK p = (ParamsK)__builtin_amdgcn_kernarg_segment_ptr(); asm volatile("" : "+s"(p)); return p; }
DEV Params load_params() { ParamsK p = kparams(); Params r;
#pragma unroll
    for (int i = 0; i < N_IN; ++i) r.in[i] = p->in[i];
    r.out = p->out; r.ws = p->ws; return r; }
DEV void dbg_cksum(const Params& P, unsigned long long* dst) {
    unsigned long long sum = 0;
    const size_t gt = (size_t)blockIdx.x * NTHR + threadIdx.x, nt = (size_t)gridDim.x * NTHR;
    const unsigned* w = (const unsigned*)P.ws;
    for (size_t i = gt; i < (7 * SLOT) / 4; i += nt) sum += w[i];
    const unsigned* h = (const unsigned*)(P.ws + OFF_HID);
    for (size_t i = gt; i < (size_t)T * HIDP / 2; i += nt) sum += h[i] * 3u;
    const unsigned* o = (const unsigned*)P.out;
    for (size_t i = gt; i < (size_t)T * DM; i += nt) sum += o[i] * 7u;
#pragma unroll
    for (int off = 32; off > 0; off >>= 1) sum += __shfl_xor(sum, off);
    if ((threadIdx.x & 63) == 0) atomicAdd(dst, sum);
}
__global__ void __launch_bounds__(NTHR, 2) k_mega(Params P) {
    extern __shared__ __attribute__((aligned(16))) char smem[];
    if (threadIdx.x == 0) *(uint4*)(smem + 131072) = make_uint4(0u, 0u, 0u, 0u);
    __syncthreads();
    XcdBarrier bar = xcd_barrier_post((unsigned*)(P.ws + OFF_BAR), (volatile LAS unsigned*)(smem + 131072));
#define RUNP(ph, layer) do { const Params Pl = load_params(); run_phase<ph>(Pl, layer, smem); } while (0)
#define PH(ph, layer) do { RUNP(ph, layer); xcd_barrier(bar); } while (0)
#define FFN(layer) do { PH(PH_NORM_MID, layer); PH(PH_F1, layer); PH(PH_F1B, layer); PH(PH_F2, layer); } while (0)
#define RWKV(layer) do { PH(PH_R1, layer); PH(PH_R2, layer); PH(PH_R3, layer); PH(PH_R4, layer); PH(PH_R5, layer); } while (0)
    RUNP(PH_PREP, 0); PH(PH_NORM0, 0);
    RWKV(0); FFN(0);
    RUNP(PH_NORM_END, 0); PH(PH_PREP, 1);
    PH(PH_N1, 1); PH(PH_N2A, 1); PH(PH_N2B, 1); PH(PH_N3, 1); PH(PH_N4, 1); FFN(1);
    RUNP(PH_NORM_END, 1); PH(PH_PREP, 2);
    PH(PH_L1, 2); PH(PH_L2A, 2); RUNP(PH_L2B, 2); PH(PH_L3A, 2); PH(PH_L3, 2); PH(PH_L4, 2); PH(PH_L5, 2); FFN(2);
    RUNP(PH_NORM_END, 2); PH(PH_PREP, 3);
    RWKV(3); FFN(3);
    PH(PH_NORM_END, 3);
    RUNP(PH_COPY, 3);
#undef PH
#undef RUNP
#undef FFN
#undef RWKV
}

template <int PH>
static void launch_phase(const Params& P, int layer, int grid, hipStream_t stream) {
    static bool attr = false;
    if (!attr) { (void)hipFuncSetAttribute((const void*)k_phase<PH>, hipFuncAttributeMaxDynamicSharedMemorySize, GEMM_LDS); attr = true; }
    hipLaunchKernelGGL((k_phase<PH>), dim3(grid), dim3(NTHR), GEMM_LDS, stream, P, layer);
}

__global__ void k_sanitize(float* o, size_t n) {
    for (size_t i = (size_t)blockIdx.x * blockDim.x + threadIdx.x; i < n; i += (size_t)gridDim.x * blockDim.x) { const float v = o[i]; if (!(fabsf(v) < 1e30f)) o[i] = 0.f; }
}
__global__ void k_check(const void* buf, size_t n, int is_f32, unsigned* flag) {
    bool bad = false;
    for (size_t i = (size_t)blockIdx.x * blockDim.x + threadIdx.x; i < n; i += (size_t)gridDim.x * blockDim.x) {
        if (is_f32) { const unsigned u = ((const unsigned*)buf)[i]; bad |= (u & 0x7f800000u) == 0x7f800000u; }
        else { const unsigned u = ((const unsigned short*)buf)[i]; bad |= (u & 0x7f80u) == 0x7f80u; }
    }
    if (bad) *flag = 1u;
}
__global__ void k_maxabs(const void* buf, size_t n, int is_f32, unsigned* res) {
    float m = 0.f;
    for (size_t i = (size_t)blockIdx.x * blockDim.x + threadIdx.x; i < n; i += (size_t)gridDim.x * blockDim.x) {
        float v; if (is_f32) v = ((const float*)buf)[i]; else v = __uint_as_float(((unsigned)((const unsigned short*)buf)[i]) << 16);
        v = fabsf(v); if (v == v) m = fmaxf(m, v);
    }
    atomicMax(res, __float_as_uint(m));
}
__global__ void k_encode2(float* o, const float* x, size_t n, const unsigned* res) {
    const float c = __uint_as_float(res[0]);
    for (size_t i = (size_t)blockIdx.x * blockDim.x + threadIdx.x; i < n; i += (size_t)gridDim.x * blockDim.x) o[i] = x[i] * c;
}
__global__ void k_gemm_check(const unsigned short* A, int lda, const unsigned short* Bt, int K, const unsigned short* C, int ldc, int M, int N, unsigned* flags) {
    const unsigned id = blockIdx.x * blockDim.x + threadIdx.x;
    unsigned h = id * 2654435761u + 12345u; h ^= h >> 15; h *= 2246822519u; h ^= h >> 13;
    const int row = h % (unsigned)M, col = (h / 7919u) % (unsigned)N;
    float ref = 0.f;
    for (int k = 0; k < K; ++k) ref += __uint_as_float(((unsigned)A[(size_t)row * lda + k]) << 16) * __uint_as_float(((unsigned)Bt[(size_t)col * K + k]) << 16);
    const float c = __uint_as_float(((unsigned)C[(size_t)row * ldc + col]) << 16);
    const float err = fabsf(c - ref) / (fabsf(ref) + 1.0f);
    if (!(err < 0.02f)) atomicAdd(&flags[100], 1u);
}
__global__ void k_encode_last(float* o, const float* x, size_t n, const unsigned* flags) {
    int k = 0; unsigned cnt = flags[100]; while (cnt) { ++k; cnt >>= 1; }
    float c = 1.f; for (int i = 0; i < k; ++i) c *= 4.f;
    for (size_t i = (size_t)blockIdx.x * blockDim.x + threadIdx.x; i < n; i += (size_t)gridDim.x * blockDim.x) o[i] = x[i] * c;
}
__global__ void __launch_bounds__(512, 2) k_ldstest(unsigned* flags, int words) {
    extern __shared__ __attribute__((aligned(16))) char sm[];
    unsigned* g = (unsigned*)sm;
    for (int i = threadIdx.x; i < words; i += 512) g[i] = (unsigned)i * 2654435761u + 7u;
    __syncthreads();
    unsigned bad = 0;
    for (int i = threadIdx.x; i < words; i += 512) bad += (g[i] != (unsigned)i * 2654435761u + 7u);
    { unsigned v; const unsigned addr = 49152u + threadIdx.x * 4u;
      asm volatile("ds_read_b32 %0, %1 offset:40960\n s_waitcnt lgkmcnt(0)" : "=v"(v) : "v"(addr) : "memory");
      const unsigned idx = (90112u + threadIdx.x * 4u) / 4u;
      if (v != idx * 2654435761u + 7u) bad += 1000; }
    if (bad) atomicAdd(&flags[100], bad);
}
__global__ void k_encode_ck(float* o, const float* x, size_t n, const unsigned long long* ck) {
    int k = 0; for (int i = 0; i < 64; ++i) if (ck[i] != ck[64 + i]) { k = i + 1; break; }
    float c = 1.f; for (int i = 0; i < k; ++i) c *= 1.1f;
    for (size_t i = (size_t)blockIdx.x * blockDim.x + threadIdx.x; i < n; i += (size_t)gridDim.x * blockDim.x) o[i] = x[i] * c;
}
__global__ void k_encode(float* o, const float* x, size_t n, const unsigned* flags) {
    int k = 0; for (int i = 1; i < 32; ++i) if (flags[i]) { k = i; break; }
    float c = 1.f; for (int i = 0; i < k; ++i) c *= 4.f;
    for (size_t i = (size_t)blockIdx.x * blockDim.x + threadIdx.x; i < n; i += (size_t)gridDim.x * blockDim.x) o[i] = x[i] * c;
}
#define DBG_MAX_OFF (2 * SLOT)
#define DBG_FLAGS ((unsigned*)((char*)d_ws + OFF_S7 + 60 * MiB))
#define CHK(idx, off, nel, f32) hipLaunchKernelGGL(k_check, dim3(1024), dim3(256), 0, stream, (const void*)((char*)d_ws + (off)), (size_t)(nel), (f32), DBG_FLAGS + (idx))
#define CHKO(idx) hipLaunchKernelGGL(k_check, dim3(1024), dim3(256), 0, stream, (const void*)d_out, (size_t)T * DM, 1, DBG_FLAGS + (idx))
extern "C" void kernel_launch(void* const* d_in, const int* in_sizes, int n_in, void* d_out, int out_size, void* d_ws, size_t ws_size, hipStream_t stream) {
    (void)in_sizes; (void)out_size;
    if (n_in < N_IN || ws_size < 8 * SLOT) { fprintf(stderr, "kernel_launch: unexpected n_in %d or ws_size %zu\n", n_in, ws_size); return; }
    Params P; memset(&P, 0, sizeof(P));
    for (int i = 0; i < N_IN; ++i) P.in[i] = (const float*)d_in[i];
    P.out = (float*)d_out; P.ws = (char*)d_ws;
    static int grid = 0;
    if (!grid) {
        int dev = 0, cus = 0, per_cu = 0;
        (void)hipGetDevice(&dev);
        (void)hipDeviceGetAttribute(&cus, hipDeviceAttributeMultiprocessorCount, dev);
        (void)hipFuncSetAttribute((const void*)k_mega, hipFuncAttributeMaxDynamicSharedMemorySize, MEGA_LDS);
        if (hipOccupancyMaxActiveBlocksPerMultiprocessor(&per_cu, (const void*)k_mega, NTHR, MEGA_LDS) != hipSuccess || per_cu < 1) { fprintf(stderr, "kernel_launch: occupancy query failed (%d)\n", per_cu); grid = -1; }
        else grid = cus > 0 ? cus : 256;
    }
    if (grid < 1) return;
    (void)hipMemsetAsync((char*)d_ws + OFF_BAR, 0, XCD_BAR_WORDS * sizeof(unsigned), stream);
    hipLaunchKernelGGL(k_mega, dim3(grid), dim3(NTHR), MEGA_LDS, stream, P);
}
```

```cpp
#include <hip/hip_runtime.h>
#include <stdint.h>
#include <stdio.h>
#include <string.h>

#define DEV __device__ __forceinline__
__device__ __forceinline__ int tidx() { int t = threadIdx.x; asm volatile("" : "+v"(t)); return t; }
typedef unsigned short bf16_t;
typedef short bf16x8 __attribute__((ext_vector_type(8)));
typedef float f32x4 __attribute__((ext_vector_type(4)));
typedef unsigned u32x4 __attribute__((ext_vector_type(4)));
typedef unsigned u32x2 __attribute__((ext_vector_type(2)));

constexpr int SEQ = 8192, NBATCH = 4, T = SEQ * NBATCH, DM = 1024, DFF = 2816;
constexpr int NTHR = 512;
constexpr size_t MiB = 1ull << 20;
constexpr size_t SLOT = 64 * MiB;
constexpr size_t OFF_S7 = 7 * SLOT;
constexpr size_t OFF_BAR = OFF_S7;
constexpr size_t OFF_BIASP = OFF_S7 + 65536;
constexpr size_t OFF_BSC = OFF_S7 + 1 * MiB;
constexpr size_t OFF_WREG = OFF_S7 + 4 * MiB;
constexpr size_t OFF_HID = OFF_S7 + 32 * MiB;
constexpr size_t OFF_WF1 = OFF_WREG;
constexpr size_t OFF_WF2 = OFF_WREG + 11 * MiB;
constexpr size_t OFF_MIX = OFF_WREG + 17 * MiB;
constexpr int HIDP = 320;
constexpr int GEMM_LDS = 98304;

enum { I_X = 0, I_NORMG, I_FWIN, I_FCW, I_FCB, I_FWOUT, I_MU, I_WRKV, I_W0, I_W1, I_W2, I_A0, I_A1, I_A2, I_G1, I_G2, I_KK, I_KA, I_RK, I_LNW, I_LNB, I_RWO,
       I_V0, I_V1, I_V2, I_NWIN, I_CW1, I_CB1, I_CW2, I_CPE, I_NWO, I_GWIN, I_AUP, I_ABIAS, I_GNW, I_GWO, N_IN };

struct Params { const float* in[N_IN]; float* out; char* ws; };

DEV float bf_lo(unsigned u) { return __uint_as_float(u << 16); }
DEV float bf_hi(unsigned u) { return __uint_as_float(u & 0xffff0000u); }
DEV float bf2f(bf16_t b) { return __uint_as_float(((unsigned)b) << 16); }
typedef __bf16 bf16x2_t __attribute__((ext_vector_type(2)));
typedef float f32x2_t __attribute__((ext_vector_type(2)));
DEV unsigned cvt_pk(float lo, float hi) { const f32x2_t v = {lo, hi}; const bf16x2_t b = __builtin_convertvector(v, bf16x2_t); return __builtin_bit_cast(unsigned, b); }
DEV bf16_t f2bf(float f) { return (bf16_t)(cvt_pk(f, 0.f) & 0xffffu); }
DEV void st_bf4(bf16_t* p, f32x4 v) { u32x2 w; w.x = cvt_pk(v[0], v[1]); w.y = cvt_pk(v[2], v[3]); *(u32x2*)p = w; }
DEV f32x4 ld_bf4(const bf16_t* p) { u32x2 w = *(const u32x2*)p; f32x4 v; v[0] = bf_lo(w.x); v[1] = bf_hi(w.x); v[2] = bf_lo(w.y); v[3] = bf_hi(w.y); return v; }
DEV float rcpf_(float x) { return __builtin_amdgcn_rcpf(x); }
DEV float sigmoidf_(float x) { return rcpf_(1.0f + __expf(-x)); }
DEV float wave_sum(float v) {
#pragma unroll
    for (int o = 32; o > 0; o >>= 1) v += __shfl_xor(v, o);
    return v;
}

#define DPP_MOV(x, ctrl) __int_as_float(__builtin_amdgcn_mov_dpp(__float_as_int(x), (ctrl), 0xf, 0xf, true))
DEV float row16_sum(float x) {
    x += DPP_MOV(x, 0xB1);
    x += DPP_MOV(x, 0x4E);
    x += DPP_MOV(x, 0x124);
    x += DPP_MOV(x, 0x128);
    return x;
}
DEV unsigned pack_fp8x4(float a, float b, float c, float d) { int x = __builtin_amdgcn_cvt_pk_fp8_f32(a, b, 0, false); x = __builtin_amdgcn_cvt_pk_fp8_f32(c, d, x, true); return (unsigned)x; }
#define MFMA8(a, b, c) __builtin_amdgcn_mfma_f32_16x16x32_fp8_fp8((a), (b), (c), 0, 0, 0)
DEV bf16x8 pack8(f32x4 a, f32x4 b) {
    u32x4 w; w.x = cvt_pk(a[0], a[1]); w.y = cvt_pk(a[2], a[3]); w.z = cvt_pk(b[0], b[1]); w.w = cvt_pk(b[2], b[3]);
    return __builtin_bit_cast(bf16x8, w);
}
#define MFMA(a, b, c) __builtin_amdgcn_mfma_f32_16x16x32_bf16((a), (b), (c), 0, 0, 0)


#define XB_TMO      128
#define XB_XCNT(j)  (256  + 64 * (j))
#define XB_XSUB(j)  (1280 + 64 * (j))
#define XB_XGEN(j)  (2304 + 64 * (j))
#define XB_TOP      3328
#define XB_TOPGEN   3392
#define XCD_BAR_WORDS 3456
#define XB_SPIN_CAP (1u << 18)
#define LAS __attribute__((address_space(3)))
__device__ __forceinline__ unsigned xb_ld(unsigned* p)              { return __hip_atomic_load(p, __ATOMIC_RELAXED, __HIP_MEMORY_SCOPE_AGENT); }
__device__ __forceinline__ unsigned xb_add(unsigned* p, unsigned v) { return __hip_atomic_fetch_add(p, v, __ATOMIC_RELAXED, __HIP_MEMORY_SCOPE_AGENT); }
__device__ __forceinline__ unsigned xb_xcc_id() { return (unsigned)__builtin_amdgcn_s_getreg((3 << 11) | 20) & 0xFu; }
#define XB_SPIN(cond, bar) do { unsigned _sp = 0; while (cond) { __builtin_amdgcn_s_sleep(1); \
    if ((++_sp & 255u) == 0u) { if (xb_ld(&(bar)[XB_TMO])) break; if (_sp > XB_SPIN_CAP) { atomicAdd(&(bar)[XB_TMO], 1u); break; } } } } while (0)
struct XcdBarrier { unsigned* bar; unsigned x; volatile LAS unsigned* st; };
__device__ __forceinline__ XcdBarrier xcd_barrier_post(unsigned* bar, volatile LAS unsigned* st) {
    XcdBarrier b; b.bar = bar; b.x = xb_xcc_id(); b.st = st;
    if (threadIdx.x == 0) (void)xb_add(&bar[XB_XCNT(b.x)], 1u);
    return b;
}
__device__ __forceinline__ void xcd_barrier_complete(unsigned* bar, unsigned x, unsigned& nloc, unsigned& nx) {
    const unsigned G = gridDim.x * gridDim.y * gridDim.z;
    unsigned sum, cnt, mine, sp = 0u;
    for (;;) {
        sum = 0u; cnt = 0u; mine = 0u;
#pragma unroll
        for (unsigned j = 0; j < 16; ++j) { const unsigned c = xb_ld(&bar[XB_XCNT(j)]); sum += c; cnt += (c > 0u) ? 1u : 0u; mine = (j == x) ? c : mine; }
        if (sum == G) break;
        __builtin_amdgcn_s_sleep(1);
        if ((++sp & 255u) == 0u) { if (xb_ld(&bar[XB_TMO])) break; if (sp > XB_SPIN_CAP) { atomicAdd(&bar[XB_TMO], 1u); break; } }
    }
    nloc = mine > 0u ? mine : 1u; nx = cnt > 0u ? cnt : 1u;
}
__device__ __forceinline__ void xcd_barrier(const XcdBarrier& b) {
    asm volatile("s_waitcnt vmcnt(0)" ::: "memory");
    __syncthreads();
    if (threadIdx.x == 0) {
        unsigned* bar = b.bar;
        __builtin_amdgcn_s_waitcnt(0);
        unsigned nloc = b.st[0], nx = b.st[1];
        if (nloc == 0u) { xcd_barrier_complete(bar, b.x, nloc, nx); b.st[0] = nloc; b.st[1] = nx; }
        const unsigned old = xb_add(&bar[XB_XSUB(b.x)], 1u);
        const unsigned gen = old / nloc;
        if (old + 1u == (gen + 1u) * nloc) {
            __builtin_amdgcn_fence(__ATOMIC_RELEASE, "agent");
            asm volatile("s_waitcnt vmcnt(0)" ::: "memory");
            const unsigned og = xb_add(&bar[XB_TOP], 1u);
            const unsigned tg = og / nx;
            if (og + 1u == (tg + 1u) * nx) xb_add(&bar[XB_TOPGEN], 1u);
            else XB_SPIN(xb_ld(&bar[XB_TOPGEN]) == tg, bar);
            __builtin_amdgcn_fence(__ATOMIC_ACQUIRE, "agent");
            xb_add(&bar[XB_XGEN(b.x)], 1u);
            asm volatile("s_waitcnt vmcnt(0)" ::: "memory");
        } else {
            XB_SPIN(xb_ld(&bar[XB_XGEN(b.x)]) == gen, bar);
            __builtin_amdgcn_fence(__ATOMIC_ACQUIRE, "agent");
            asm volatile("s_waitcnt vmcnt(0)" ::: "memory");
        }
    }
    __syncthreads();
}

struct LdPlain { const bf16_t* p; long pitch;
    DEV void setk(int) {}
    DEV u32x4 operator()(int r, int k) const { return *(const u32x4*)(p + (long)r * pitch + k); } };
DEV unsigned mixpair(unsigned x, unsigned xp, float ma, float mb) { const float a = bf_lo(x), b = bf_hi(x), pa = bf_lo(xp), pb = bf_hi(xp); return cvt_pk(a + (pa - a) * ma, b + (pb - b) * mb); }
struct LdMix { const bf16_t* xn; const float* mu; int row0; f32x4 m0, m1;
    DEV void setk(int k) { m0 = *(const f32x4*)(mu + k); m1 = *(const f32x4*)(mu + k + 4); }
    DEV u32x4 operator()(int r, int k) const {
        const int gr = row0 + r; const bf16_t* px = xn + (long)gr * DM + k;
        const u32x4 x = *(const u32x4*)px; u32x4 xp = {0u, 0u, 0u, 0u};
        if ((gr & (SEQ - 1)) != 0) xp = *(const u32x4*)(px - DM);
        u32x4 o; o.x = mixpair(x.x, xp.x, m0[0], m0[1]); o.y = mixpair(x.y, xp.y, m0[2], m0[3]); o.z = mixpair(x.z, xp.z, m1[0], m1[1]); o.w = mixpair(x.w, xp.w, m1[2], m1[3]);
        return o; } };
struct LdCmp { const bf16_t* src; int row0;
    DEV void setk(int) {}
    DEV u32x4 operator()(int r, int k) const {
        const int row = row0 + r, b = row >> 10, n = (row >> 1) & 511, g = row & 1, l = k >> 6, d = k & 63;
        int t = 16 * n + l; t = t > SEQ - 1 ? SEQ - 1 : t;
        return *(const u32x4*)(src + ((long)(b * SEQ + t)) * 128 + g * 64 + d); } };

template <class AL, class BL>
DEV void gemm_core(f32x4 (&acc)[4][4], AL al, BL bl, const int K, char* smem) {
    const int tid = tidx(), lane = tid & 63, wid = tid >> 6, wm = wid >> 1, wn = wid & 1, fr = lane & 15, fq = lane >> 4;
#pragma unroll
    for (int m = 0; m < 4; ++m)
#pragma unroll
        for (int n = 0; n < 4; ++n) acc[m][n] = (f32x4){0.f, 0.f, 0.f, 0.f};
    u32x4 ra[4], rb[2];
    const int srow = tid >> 3, skc = tid & 7;
    const int soff = srow * 128 + ((skc ^ ((srow >> 1) & 7)) << 4);
    const int fsw = (fr >> 1) & 7;
    const int aoff = (wm * 64 + fr) * 128, boff = 32768 + (wn * 64 + fr) * 128;
    const int nk = K >> 6;
    al.setk(skc * 8);
#pragma unroll
    for (int i = 0; i < 4; ++i) ra[i] = al(srow + 64 * i, skc * 8);
#pragma unroll
    for (int i = 0; i < 2; ++i) rb[i] = bl(srow + 64 * i, skc * 8);
#pragma unroll
    for (int i = 0; i < 4; ++i) *(u32x4*)(smem + soff + i * 8192) = ra[i];
#pragma unroll
    for (int i = 0; i < 2; ++i) *(u32x4*)(smem + 32768 + soff + i * 8192) = rb[i];
    __syncthreads();
    for (int kt = 0; kt < nk; ++kt) {
        const bool more = kt + 1 < nk;
        if (more) {
            const int k0 = (kt + 1) * 64 + skc * 8;
            al.setk(k0);
#pragma unroll
            for (int i = 0; i < 4; ++i) ra[i] = al(srow + 64 * i, k0);
#pragma unroll
            for (int i = 0; i < 2; ++i) rb[i] = bl(srow + 64 * i, k0);
        }
        const char* base = smem + (kt & 1) * 49152;
#pragma unroll
        for (int ks = 0; ks < 2; ++ks) {
            const int kcs = ((ks * 4 + fq) ^ fsw) << 4;
            bf16x8 af[4], bfr[4];
#pragma unroll
            for (int m = 0; m < 4; ++m) af[m] = *(const bf16x8*)(base + aoff + m * 2048 + kcs);
#pragma unroll
            for (int n = 0; n < 4; ++n) bfr[n] = *(const bf16x8*)(base + boff + n * 2048 + kcs);
#pragma unroll
            for (int m = 0; m < 4; ++m)
#pragma unroll
                for (int n = 0; n < 4; ++n) acc[m][n] = MFMA(bfr[n], af[m], acc[m][n]);
        }
        if (more) {
            char* nb = smem + ((kt + 1) & 1) * 49152;
#pragma unroll
            for (int i = 0; i < 4; ++i) *(u32x4*)(nb + soff + i * 8192) = ra[i];
#pragma unroll
            for (int i = 0; i < 2; ++i) *(u32x4*)(nb + 32768 + soff + i * 8192) = rb[i];
        }
        __syncthreads();
    }
}

template <class AL, class BL>
DEV void gemm_core_sb(f32x4 (&acc)[4][4], AL al, BL bl, const int K, char* smem) {
    const int tid = tidx(), lane = tid & 63, wid = tid >> 6, wm = wid >> 1, wn = wid & 1, fr = lane & 15, fq = lane >> 4;
#pragma unroll
    for (int m = 0; m < 4; ++m)
#pragma unroll
        for (int n = 0; n < 4; ++n) acc[m][n] = (f32x4){0.f, 0.f, 0.f, 0.f};
    u32x4 ra[4], rb[2];
    const int srow = tid >> 3, skc = tid & 7;
    const int soff = srow * 128 + ((skc ^ ((srow >> 1) & 7)) << 4);
    const int fsw = (fr >> 1) & 7;
    const int aoff = (wm * 64 + fr) * 128, boff = 32768 + (wn * 64 + fr) * 128;
    const int nk = K >> 6;
    for (int kt = 0; kt < nk; ++kt) {
        const int k0 = kt * 64 + skc * 8;
        al.setk(k0);
#pragma unroll
        for (int i = 0; i < 4; ++i) ra[i] = al(srow + 64 * i, k0);
#pragma unroll
        for (int i = 0; i < 2; ++i) rb[i] = bl(srow + 64 * i, k0);
        __syncthreads();
#pragma unroll
        for (int i = 0; i < 4; ++i) *(u32x4*)(smem + soff + i * 8192) = ra[i];
#pragma unroll
        for (int i = 0; i < 2; ++i) *(u32x4*)(smem + 32768 + soff + i * 8192) = rb[i];
        __syncthreads();
        const char* base = smem;
#pragma unroll
        for (int ks = 0; ks < 2; ++ks) {
            const int kcs = ((ks * 4 + fq) ^ fsw) << 4;
            bf16x8 af[4], bfr[4];
#pragma unroll
            for (int m = 0; m < 4; ++m) af[m] = *(const bf16x8*)(base + aoff + m * 2048 + kcs);
#pragma unroll
            for (int n = 0; n < 4; ++n) bfr[n] = *(const bf16x8*)(base + boff + n * 2048 + kcs);
#pragma unroll
            for (int m = 0; m < 4; ++m)
#pragma unroll
                for (int n = 0; n < 4; ++n) acc[m][n] = MFMA(bfr[n], af[m], acc[m][n]);
        }
    }
    __syncthreads();
}
namespace pg8 {
#define PG8_LAS __attribute__((address_space(3)))
typedef unsigned short bf16_t;
typedef short bf16x8 __attribute__((ext_vector_type(8)));
typedef float f32x4 __attribute__((ext_vector_type(4)));
typedef unsigned u32x4 __attribute__((ext_vector_type(4)));
constexpr int BM = 256, BK = 64, HALF = 128, HTB = HALF * BK * 2  , STAGE_BYTES = 8 * HTB, NXCD = 8, WGM = 8;

__host__ __device__ __forceinline__ int lds_byte(int r, int c) { const int st = (r >> 4) * 2 + (c >> 5), rr = r & 15, cc = c & 31, ob = rr * 64 + cc * 2; return st * 1024 + (ob ^ (((ob >> 9) & 1) << 5)); }
__host__ __device__ __forceinline__ void stage_rc(int b, int& R, int& C) { const int st = b / 1024, sb = b % 1024, swz = sb ^ (((sb >> 9) & 1) << 5); R = (st >> 1) * 16 + swz / 64; C = (st & 1) * 32 + (swz % 64) / 2; }
__host__ __device__ __forceinline__ int perm32(int rho) { const int n = rho >> 4, i = rho & 15; return 8 * (i >> 2) + 4 * n + (i & 3); }

struct Unit { int pm, pn; };
struct Gemm { const bf16_t* A; const bf16_t* Bt; int M, N, K, lda; };

struct StaticOrder {
    int nM, nN, nwg, G, c;
    __host__ __device__ void init(int M, int N, int G_, int c_) { nM = M / BM; nN = N / BM; nwg = nM * nN; G = G_; c = c_; }
    __host__ __device__ bool next(int i, Unit& u) const {
        const long L = (long)i * G + c; if (L >= nwg) return false;
        int wgid = (int)L; { const int q = nwg / NXCD, r = nwg % NXCD, xcd = wgid % NXCD, off = wgid / NXCD; wgid = (xcd < r ? xcd * (q + 1) : r * (q + 1) + (xcd - r) * q) + off; }
        const int nig = WGM * nN, gid = wgid / nig, fm = gid * WGM, gsz = (nM - fm) < WGM ? (nM - fm) : WGM;
        u.pm = fm + ((wgid % nig) % gsz); u.pn = (wgid % nig) / gsz; return true;
    }
    __device__ __forceinline__ void a_ready(const Unit&) const {}
    __device__ __forceinline__ void done(const Unit&) const {}
};
template <class Epi, class Sched, bool STAMP = false>
__device__ __forceinline__ void gemm_phase(PG8_LAS unsigned char* lds, const Gemm g, const Sched& S, const Epi& E, unsigned long long* stamps) {
    const int tid = tidx(), wid = __builtin_amdgcn_readfirstlane(tid >> 6), lane = tid & 63, wr = wid >> 2, wc = wid & 3, fr = lane & 15, fq = lane >> 4;
    const int K = g.K, nt = K / BK;
    int ts_lo = 0, ts_hi = 0, nts = 0; const unsigned long long rt_entry = STAMP ? (unsigned long long)wall_clock64() : 0ull;
#define PG8_STAMP() do { if (STAMP && wid == 0 && nts < 64) { const unsigned long long _c = (unsigned long long)clock64(); \
        ts_lo = (lane == nts) ? (int)(unsigned)_c : ts_lo; ts_hi = (lane == nts) ? (int)(unsigned)(_c >> 32) : ts_hi; ++nts; } } while (0)
    PG8_STAMP();
    unsigned voffA[2];
#pragma unroll
    for (int i = 0; i < 2; ++i) { int R, C; stage_rc(tid * 16 + i * 8192, R, C); const int Rb = Epi::PERM ? ((R & ~31) + perm32(R & 31)) : R;
        voffA[i] = (unsigned)(R * g.lda + C) * 2u; (void)Rb; }
#define voffB voffA
    const size_t kstep = (size_t)(BK * 2);
    const size_t hstep = (size_t)HALF * K * 2, hstepA = (size_t)HALF * g.lda * 2;
    const size_t tstep = 2 * hstep, tstepA = 2 * hstepA;
    const unsigned ldsw = (unsigned)wid * 1024u;
    const int aoff = lds_byte(wr * 64 + fr, fq * 8), boff = lds_byte(wc * 32 + fr, fq * 8);
#define PG8_SA(b, h) (((b) * 2 + (h)) * HTB)
#define PG8_SB(b, h) ((4 + (b) * 2 + (h)) * HTB)
#define PG8_STAGE(bufoff, gbase, voff) do { _Pragma("unroll") for (int _i = 0; _i < 2; ++_i) \
        __builtin_amdgcn_global_load_lds((const unsigned*)((const char*)(gbase) + (voff)[_i]), (PG8_LAS unsigned*)(lds + (bufoff) + ldsw + _i * 8192), 16, 0, 0); } while (0)
#define PG8_LDA(dst, b, h) do { _Pragma("unroll") for (int m = 0; m < 4; ++m) _Pragma("unroll") for (int k = 0; k < 2; ++k) dst[m][k] = *(const PG8_LAS bf16x8*)(lds + PG8_SA(b, h) + aoff + m * 2048 + k * 1024); } while (0)
#define PG8_LDB(dst, b, h) do { _Pragma("unroll") for (int n = 0; n < 2; ++n) _Pragma("unroll") for (int k = 0; k < 2; ++k) dst[n][k] = *(const PG8_LAS bf16x8*)(lds + PG8_SB(b, h) + boff + n * 2048 + k * 1024); } while (0)
#define PG8_MMA(ai, bj, At, Bt) do { __builtin_amdgcn_s_setprio(1); _Pragma("unroll") for (int m = 0; m < 4; ++m) _Pragma("unroll") for (int n = 0; n < 2; ++n) _Pragma("unroll") for (int k = 0; k < 2; ++k) \
        acc[ai][bj][m][n] = __builtin_amdgcn_mfma_f32_16x16x32_bf16(Bt[n][k], At[m][k], acc[ai][bj][m][n], 0, 0, 0); __builtin_amdgcn_s_setprio(0); } while (0)
#define PG8_WAIT_V(n) asm volatile("s_waitcnt vmcnt(" #n ")" ::: "memory")
#define PG8_WAIT_L(n) asm volatile("s_waitcnt lgkmcnt(" #n ")" ::: "memory")
#define PG8_BAR __builtin_amdgcn_s_barrier()
#define PG8_SCHED __builtin_amdgcn_sched_barrier(0)
    Unit cur, nxt; int ui = 0;
    if (!S.next(0, cur)) return;
    f32x4 acc[2][2][4][2];
#pragma unroll
    for (int a = 0; a < 2; ++a)
#pragma unroll
        for (int b = 0; b < 2; ++b)
#pragma unroll
            for (int m = 0; m < 4; ++m)
#pragma unroll
                for (int n = 0; n < 2; ++n) acc[a][b][m][n] = (f32x4){0.f, 0.f, 0.f, 0.f};
    bf16x8 At[4][2], B0[2][2], B1[2][2];
    const char* cA = (const char*)g.A + (size_t)cur.pm * tstepA; const char* cB = (const char*)g.Bt + (size_t)cur.pn * tstep;
    S.a_ready(cur);
    PG8_STAGE(PG8_SB(0, 0), cB, voffB); PG8_STAGE(PG8_SA(0, 0), cA, voffA); PG8_STAGE(PG8_SB(0, 1), cB + hstep, voffB); PG8_STAGE(PG8_SA(0, 1), cA + hstepA, voffA);
    if (wr == 1) PG8_BAR;
    PG8_WAIT_V(4); PG8_BAR;
    PG8_STAGE(PG8_SB(1, 0), cB + kstep, voffB); PG8_STAGE(PG8_SA(1, 0), cA + kstep, voffA); PG8_STAGE(PG8_SB(1, 1), cB + hstep + kstep, voffB);
    PG8_WAIT_V(6); PG8_BAR;
    PG8_STAMP();
    for (;;) {
        const bool has_next = S.next(ui + 1, nxt);
        const char* nA = has_next ? (const char*)g.A + (size_t)nxt.pm * tstepA : cA; const char* nB = has_next ? (const char*)g.Bt + (size_t)nxt.pn * tstep : cB;
        for (int t = 0; t < nt; t += 2) {
            const bool last = (t == nt - 2);
            const char* a1 = cA + (size_t)(t + 1) * kstep;
            const char* a2 = last ? nA : cA + (size_t)(t + 2) * kstep; const char* b2 = last ? nB : cB + (size_t)(t + 2) * kstep;
            const char* a3 = a2 + kstep; const char* b3 = b2 + kstep;
            if (last && has_next) S.a_ready(nxt);
            PG8_LDB(B0, 0, 0); PG8_SCHED; PG8_LDA(At, 0, 0); PG8_STAGE(PG8_SA(1, 1), a1 + hstepA, voffA);
            PG8_WAIT_L(8); PG8_BAR; PG8_WAIT_L(0); PG8_MMA(0, 0, At, B0); PG8_BAR; PG8_SCHED;
            PG8_LDB(B1, 0, 1); PG8_STAGE(PG8_SB(0, 0), b2, voffB);
            PG8_BAR; PG8_WAIT_L(0); PG8_MMA(0, 1, At, B1); PG8_BAR;
            PG8_LDA(At, 0, 1); PG8_STAGE(PG8_SA(0, 0), a2, voffA);
            PG8_BAR; PG8_WAIT_L(0); PG8_MMA(1, 0, At, B0); PG8_BAR; PG8_SCHED;
            PG8_STAGE(PG8_SB(0, 1), b2 + hstep, voffB);
            PG8_WAIT_V(6); PG8_BAR; PG8_MMA(1, 1, At, B1); PG8_BAR;
            PG8_LDB(B0, 1, 0); PG8_SCHED; PG8_LDA(At, 1, 0); PG8_STAGE(PG8_SA(0, 1), a2 + hstepA, voffA);
            PG8_WAIT_L(8); PG8_BAR; PG8_WAIT_L(0); PG8_MMA(0, 0, At, B0); PG8_BAR; PG8_SCHED;
            PG8_LDB(B1, 1, 1); PG8_STAGE(PG8_SB(1, 0), b3, voffB);
            PG8_BAR; PG8_WAIT_L(0); PG8_MMA(0, 1, At, B1); PG8_BAR;
            PG8_LDA(At, 1, 1); PG8_STAGE(PG8_SA(1, 0), a3, voffA);
            PG8_BAR; PG8_WAIT_L(0); PG8_MMA(1, 0, At, B0); PG8_BAR; PG8_SCHED;
            PG8_STAGE(PG8_SB(1, 1), b3 + hstep, voffB);
            PG8_WAIT_V(6); PG8_BAR; PG8_MMA(1, 1, At, B1); PG8_BAR;
        }
        PG8_STAMP();
        if constexpr (!Epi::AFTER_DRAIN) { E(acc, cur, wr, wc, fr, fq); S.done(cur); }
        PG8_STAMP();
        if (!has_next) break;
#pragma unroll
        for (int a = 0; a < 2; ++a)
#pragma unroll
            for (int b = 0; b < 2; ++b)
#pragma unroll
                for (int m = 0; m < 4; ++m)
#pragma unroll
                    for (int n = 0; n < 2; ++n) acc[a][b][m][n] = (f32x4){0.f, 0.f, 0.f, 0.f};
        cur = nxt; cA = nA; cB = nB; ++ui;
    }
    PG8_WAIT_V(0);
    if (wr == 0) PG8_BAR;
    PG8_BAR;
    if constexpr (Epi::AFTER_DRAIN) { E.fused(acc, cur, wr, wc, fr, fq, lds, wid, lane); S.done(cur); }
    PG8_STAMP();
    if (STAMP && wid == 0) { stamps[lane] = lane < nts ? (((unsigned long long)(unsigned)ts_hi << 32) | (unsigned)ts_lo) : 0ull;
        if (lane == 62) stamps[62] = rt_entry; if (lane == 63) stamps[63] = (unsigned long long)wall_clock64(); }
#undef PG8_STAMP
#undef PG8_SA
#undef PG8_SB
#undef PG8_STAGE
#undef PG8_LDA
#undef PG8_LDB
#undef PG8_MMA
#undef PG8_WAIT_V
#undef PG8_WAIT_L
#undef PG8_BAR
#undef PG8_SCHED
#undef voffB
}
}

struct EpiPlain {
    static constexpr bool PERM = false, AFTER_DRAIN = false;
    bf16_t* C; int ldc;
    __device__ __forceinline__ void operator()(const f32x4 (&acc)[2][2][4][2], const pg8::Unit& u, int, int, int, int) const {
        const int t_ = tidx(), wr = t_ >> 8, wc = (t_ >> 6) & 3, fr = t_ & 15, fq = (t_ >> 4) & 3;
#pragma unroll
        for (int ai = 0; ai < 2; ++ai)
#pragma unroll
            for (int m = 0; m < 4; ++m) { bf16_t* rowp = C + (size_t)(u.pm * 256 + ai * 128 + wr * 64 + m * 16 + fr) * ldc + u.pn * 256 + wc * 32 + 8 * fq;
#pragma unroll
                for (int bj = 0; bj < 2; ++bj) { const f32x4 v0 = acc[ai][bj][m][0], v1 = acc[ai][bj][m][1]; u32x4 w; w.x = cvt_pk(v0[0], v0[1]); w.y = cvt_pk(v0[2], v0[3]); w.z = cvt_pk(v1[0], v1[1]); w.w = cvt_pk(v1[2], v1[3]);
                    *(u32x4*)(rowp + bj * 128) = w; } }
    }
};
struct EpiF1 {
    static constexpr bool PERM = false, AFTER_DRAIN = false;
    const float* cw; const float* cb; bf16_t* act; bf16_t* E;
    __device__ __forceinline__ void operator()(const f32x4 (&acc)[2][2][4][2], const pg8::Unit& u, int, int, int, int) const {
        const int t_ = tidx(), wr = t_ >> 8, wc = (t_ >> 6) & 3, fr = t_ & 15, fq = (t_ >> 4) & 3;
        const int ch = u.pn * 128 + wc * 32 + 8 * fq;
#pragma unroll
        for (int ai = 0; ai < 2; ++ai) {
            const int strip = u.pm * 4 + ai * 2 + wr; const size_t rowbase = (size_t)u.pm * 256 + ai * 128 + wr * 64;
#pragma unroll
            for (int m = 0; m < 4; ++m) {
                const int rs = m * 16 + fr; f32x4 a[2];
#pragma unroll
                for (int n = 0; n < 2; ++n) {
                    const f32x4 c0 = *(const f32x4*)(cw + ch + 4 * n), c1 = *(const f32x4*)(cw + DFF + ch + 4 * n), c2 = *(const f32x4*)(cw + 2 * DFF + ch + 4 * n), cbv = *(const f32x4*)(cb + ch + 4 * n);
                    const f32x4 g0 = acc[ai][0][m][n], up = acc[ai][1][m][n]; f32x4 g1, g2;
#pragma unroll
                    for (int j = 0; j < 4; ++j) {
                        const float a1 = DPP_MOV(g0[j], 0x121), a2 = DPP_MOV(g0[j], 0x122);
                        float b1 = 0.f, b2 = 0.f;
                        if (m > 0) { b1 = DPP_MOV(acc[ai][0][m > 0 ? m - 1 : 0][n][j], 0x121); b2 = DPP_MOV(acc[ai][0][m > 0 ? m - 1 : 0][n][j], 0x122); }
                        g1[j] = fr >= 1 ? a1 : b1; g2[j] = fr >= 2 ? a2 : b2;
                    }
                    const f32x4 val = c2 * g0 + c1 * g1 + c0 * g2 + cbv;
#pragma unroll
                    for (int j = 0; j < 4; ++j) a[n][j] = val[j] * rcpf_(1.0f + __expf(-val[j])) * up[j];
                }
                const f32x4 gA = acc[ai][0][m][0], gB = acc[ai][0][m][1], uA = acc[ai][1][m][0], uB = acc[ai][1][m][1];
                u32x4 w;
                if (rs >= 2) { w.x = cvt_pk(a[0][0], a[0][1]); w.y = cvt_pk(a[0][2], a[0][3]); w.z = cvt_pk(a[1][0], a[1][1]); w.w = cvt_pk(a[1][2], a[1][3]); *(u32x4*)(act + (rowbase + rs) * DFF + ch) = w; }
                else { w.x = cvt_pk(gA[0], gA[1]); w.y = cvt_pk(gA[2], gA[3]); w.z = cvt_pk(gB[0], gB[1]); w.w = cvt_pk(gB[2], gB[3]); *(u32x4*)(E + ((size_t)strip * 6 + 2 + rs) * DFF + ch) = w;
                       w.x = cvt_pk(uA[0], uA[1]); w.y = cvt_pk(uA[2], uA[3]); w.z = cvt_pk(uB[0], uB[1]); w.w = cvt_pk(uB[2], uB[3]); *(u32x4*)(E + ((size_t)strip * 6 + 4 + rs) * DFF + ch) = w; }
                if (rs >= 62) { w.x = cvt_pk(gA[0], gA[1]); w.y = cvt_pk(gA[2], gA[3]); w.z = cvt_pk(gB[0], gB[1]); w.w = cvt_pk(gB[2], gB[3]); *(u32x4*)(E + ((size_t)strip * 6 + (rs - 62)) * DFF + ch) = w; }
            }
        }
    }
};
struct EpiScale {
    static constexpr bool PERM = false, AFTER_DRAIN = false;
    bf16_t* C; int ldc; float scale;
    __device__ __forceinline__ void operator()(const f32x4 (&acc)[2][2][4][2], const pg8::Unit& u, int, int, int, int) const {
        const int t_ = tidx(), wr = t_ >> 8, wc = (t_ >> 6) & 3, fr = t_ & 15, fq = (t_ >> 4) & 3;
#pragma unroll
        for (int ai = 0; ai < 2; ++ai)
#pragma unroll
            for (int m = 0; m < 4; ++m) { bf16_t* rowp = C + (size_t)(u.pm * 256 + ai * 128 + wr * 64 + m * 16 + fr) * ldc + u.pn * 256 + wc * 32 + 4 * fq;
#pragma unroll
                for (int bj = 0; bj < 2; ++bj)
#pragma unroll
                    for (int n = 0; n < 2; ++n) st_bf4(rowp + bj * 128 + n * 16, acc[ai][bj][m][n] * scale); }
    }
};
struct EpiN1kv {
    static constexpr bool PERM = false, AFTER_DRAIN = false;
    bf16_t* kv;
    __device__ __forceinline__ void operator()(const f32x4 (&acc)[2][2][4][2], const pg8::Unit& u, int, int, int, int) const {
        const int t_ = tidx(), wr = t_ >> 8, wc = (t_ >> 6) & 3, fr = t_ & 15, fq = (t_ >> 4) & 3;
        char* base = (char*)kv;
#pragma unroll
        for (int ai = 0; ai < 2; ++ai)
#pragma unroll
            for (int m = 0; m < 4; ++m) {
                const size_t row = (size_t)u.pm * 256 + ai * 128 + wr * 64 + m * 16 + fr;
#pragma unroll
                for (int bj = 0; bj < 2; ++bj)
#pragma unroll
                    for (int n = 0; n < 2; ++n) {
                        const int c128 = wc * 32 + n * 16 + fq * 4; const f32x4 v = acc[ai][bj][m][n];
                        if (u.pn < 3) {
                            const int cc = u.pn * 2 + bj;
                            if (cc == 0 || cc == 1 || cc == 4) { const size_t off = cc == 0 ? 0 : cc == 1 ? 8 * MiB : 24 * MiB; st_bf4((bf16_t*)(base + off) + row * 128 + c128, v); }
                            else if (cc == 2) { const int b = (int)(row >> 13), t = (int)(row & (SEQ - 1));
                                *(unsigned*)((unsigned char*)(base + 16 * MiB) + ((size_t)((b * 2 + (c128 >> 6)) * SEQ + t)) * 64 + (c128 & 63)) = pack_fp8x4(v[0], v[1], v[2], v[3]); }
                            else if (cc == 3) { const int b = (int)(row >> 13), t = (int)(row & (SEQ - 1));
                                unsigned char* dst = (unsigned char*)(base + 32 * MiB) + ((size_t)((b * 2 + (c128 >> 6)) * 128 + (t >> 6)) * 64 + (c128 & 63)) * 64 + (t & 63);
                                const unsigned pk = pack_fp8x4(v[0], v[1], v[2], v[3]);
                                for (int j = 0; j < 4; ++j) dst[j * 64] = (unsigned char)(pk >> (8 * j)); }
                            else { bf16_t* dst = (bf16_t*)(base + 40 * MiB); const int b = (int)(row >> 13), t = (int)(row & (SEQ - 1));
                                for (int j = 0; j < 4; ++j) dst[((size_t)(b * 128 + c128 + j)) * SEQ + t] = f2bf(v[j]); }
                        } else { if (bj == 0 && c128 < 48) { float* gates = (float*)(base + 48 * MiB); for (int j = 0; j < 4; ++j) gates[row * 48 + c128 + j] = sigmoidf_(v[j]); } }
                    }
            }
    }
};
struct EpiL1 {
    static constexpr bool PERM = false, AFTER_DRAIN = false;
    bf16_t *qe, *ke, *vT, *r; float* adn;
    __device__ __forceinline__ void operator()(const f32x4 (&acc)[2][2][4][2], const pg8::Unit& u, int, int, int, int) const {
        const int t_ = tidx(), wr = t_ >> 8, wc = (t_ >> 6) & 3, fr = t_ & 15, fq = (t_ >> 4) & 3;
#pragma unroll
        for (int ai = 0; ai < 2; ++ai)
#pragma unroll
            for (int m = 0; m < 4; ++m) {
                const size_t row = (size_t)u.pm * 256 + ai * 128 + wr * 64 + m * 16 + fr;
#pragma unroll
                for (int bj = 0; bj < 2; ++bj)
#pragma unroll
                    for (int n = 0; n < 2; ++n) {
                        const int c = bj * 128 + wc * 32 + n * 16 + fq * 4; const f32x4 v = acc[ai][bj][m][n];
                        if (u.pn < 2) st_bf4(qe + row * 512 + u.pn * 256 + c, v * 0.08838834764831845f);
                        else if (u.pn < 4) st_bf4(ke + row * 512 + (u.pn - 2) * 256 + c, v);
                        else if (u.pn < 8) { const int b = (int)(row >> 13), t = (int)(row & (SEQ - 1)), vc = (u.pn - 4) * 256 + c;
                            for (int j = 0; j < 4; ++j) vT[((size_t)(b * 1024 + vc + j)) * SEQ + t] = f2bf(v[j]); }
                        else if (u.pn < 12) st_bf4(r + row * DM + (u.pn - 8) * 256 + c, v);
                        else { if (c < 16) *(f32x4*)(adn + row * 16 + c) = v; }
                    }
            }
    }
};
template <class Epi>
DEV void phase_gemm_pg8(const bf16_t* A, int lda, const bf16_t* Bt, int N, int K, const Epi& E, char* smem) {
    pg8::Gemm g; g.A = A; g.Bt = Bt; g.M = T; g.N = N; g.K = K; g.lda = lda;
    pg8::StaticOrder S; S.init(T, N, (int)gridDim.x, (int)blockIdx.x);
    pg8::gemm_phase<Epi, pg8::StaticOrder, false>((PG8_LAS unsigned char*)smem, g, S, E, nullptr);
}
struct LaneId { int lane, wid, wm, wn, fr, fq; };
DEV LaneId lane_id() { LaneId l; l.lane = tidx() & 63; l.wid = tidx() >> 6; l.wm = l.wid >> 1; l.wn = l.wid & 1; l.fr = l.lane & 15; l.fq = l.lane >> 4; return l; }

template <class Map>
DEV void prep_T(bf16_t* dst, const float* src, int Ks, int Ns, int Nd, int Kd, Map map, char* smem, int& cursor) {
    float* tile = (float*)smem;
    const int ntn = Nd >> 6, ntiles = ntn * (Kd >> 6), tid = tidx(), G = (int)gridDim.x;
    int first = ((int)blockIdx.x - cursor) % G; if (first < 0) first += G;
    for (int tl = first; tl < ntiles; tl += G) {
        const int n0 = (tl % ntn) * 64, k0 = (tl / ntn) * 64;
        { const int j4 = (tid & 15) * 4, kr = tid >> 4;
          const int m0 = map(n0 + j4), m3 = map(n0 + j4 + 3);
          const bool vec = (m0 >= 0) && (m3 == m0 + 3) && ((Ns & 3) == 0) && ((m0 & 3) == 0);
#pragma unroll
          for (int p = 0; p < 2; ++p) { const int kk = kr + 32 * p, k = k0 + kk; f32x4 v = {0.f, 0.f, 0.f, 0.f};
              if (k < Ks) { if (vec) v = *(const f32x4*)(src + (size_t)k * Ns + m0);
                            else { for (int q = 0; q < 4; ++q) { const int n = map(n0 + j4 + q); v[q] = n >= 0 ? src[(size_t)k * Ns + n] : 0.f; } } }
              tile[kk * 65 + j4] = v[0]; tile[kk * 65 + j4 + 1] = v[1]; tile[kk * 65 + j4 + 2] = v[2]; tile[kk * 65 + j4 + 3] = v[3]; } }
        __syncthreads();
        { const int r = tid >> 3, c8 = (tid & 7) * 8;
          u32x4 w; w.x = cvt_pk(tile[(c8 + 0) * 65 + r], tile[(c8 + 1) * 65 + r]); w.y = cvt_pk(tile[(c8 + 2) * 65 + r], tile[(c8 + 3) * 65 + r]);
          w.z = cvt_pk(tile[(c8 + 4) * 65 + r], tile[(c8 + 5) * 65 + r]); w.w = cvt_pk(tile[(c8 + 6) * 65 + r], tile[(c8 + 7) * 65 + r]);
          *(u32x4*)(dst + (size_t)(n0 + r) * Kd + k0 + c8) = w; }
        __syncthreads();
    }
    cursor += ntiles;
}
struct MapId { int ns; DEV int operator()(int n) const { return n < ns ? n : -1; } };
struct MapPerm { int ns; DEV int operator()(int n) const { return n < ns ? (n & ~31) + pg8::perm32(n & 31) : -1; } };
struct MapFfn { DEV int operator()(int v) const { const int pn = v >> 8, c = v & 255, cc = (c & 96) + pg8::perm32(c & 31); return c < 128 ? 128 * pn + cc : DFF + 128 * pn + cc; } };

DEV void phase_prep(const Params& P, int layer, char* smem) {
    char* ws = P.ws; int cur = 0;
    const int kind = layer % 3, j = layer / 3;
    prep_T((bf16_t*)(ws + OFF_WF1), P.in[I_FWIN] + (size_t)layer * DM * 2 * DFF, DM, 2 * DFF, 2 * DFF, DM, MapFfn{}, smem, cur);
    prep_T((bf16_t*)(ws + OFF_WF2), P.in[I_FWOUT] + (size_t)layer * DFF * DM, DFF, DM, DM, DFF, MapPerm{DM}, smem, cur);
    bf16_t* mix = (bf16_t*)(ws + OFF_MIX);
    if (kind == 0) {
        const float* wrkv = P.in[I_WRKV] + (size_t)j * 3 * DM * DM;
        prep_T(mix, wrkv, DM, DM, DM, DM, MapId{DM}, smem, cur);
        prep_T(mix + (size_t)1024 * DM, wrkv + (size_t)DM * DM, DM, DM, DM, DM, MapId{DM}, smem, cur);
        prep_T(mix + (size_t)2048 * DM, P.in[I_W1] + (size_t)j * DM * 64, DM, 64, 128, DM, MapId{64}, smem, cur);
        prep_T(mix + (size_t)2176 * DM, P.in[I_A1] + (size_t)j * DM * 64, DM, 64, 128, DM, MapId{64}, smem, cur);
        prep_T(mix + (size_t)2304 * DM, P.in[I_G1] + (size_t)j * DM * 128, DM, 128, 128, DM, MapId{128}, smem, cur);
        if (j > 0) prep_T(mix + (size_t)2432 * DM, P.in[I_V1] + (size_t)(j - 1) * DM * 32, DM, 32, 128, DM, MapId{32}, smem, cur);
        else       prep_T(mix + (size_t)2432 * DM, P.in[I_V1], DM, 32, 128, DM, MapId{0}, smem, cur);
        prep_T((bf16_t*)((char*)mix + 5 * MiB), wrkv + (size_t)2 * DM * DM, DM, DM, DM, DM, MapId{DM}, smem, cur);
        prep_T((bf16_t*)((char*)mix + 7 * MiB), P.in[I_W2] + (size_t)j * 64 * DM, 64, DM, DM, 64, MapId{DM}, smem, cur);
        prep_T((bf16_t*)((char*)mix + 7 * MiB + 131072), P.in[I_A2] + (size_t)j * 64 * DM, 64, DM, DM, 64, MapId{DM}, smem, cur);
        if (j > 0) prep_T((bf16_t*)((char*)mix + 7 * MiB + 262144), P.in[I_V2] + (size_t)(j - 1) * 32 * DM, 32, DM, DM, 64, MapId{DM}, smem, cur);
        prep_T((bf16_t*)((char*)mix + 7 * MiB + 393216), P.in[I_G2] + (size_t)j * 128 * DM, 128, DM, DM, 128, MapId{DM}, smem, cur);
        prep_T((bf16_t*)((char*)mix + 8 * MiB), P.in[I_RWO] + (size_t)j * DM * DM, DM, DM, DM, DM, MapPerm{DM}, smem, cur);
    } else if (kind == 1) {
        prep_T(mix, P.in[I_NWIN], DM, 1840, 2048, DM, MapId{1840}, smem, cur);
        prep_T((bf16_t*)((char*)mix + 4 * MiB), P.in[I_CW1], 2048, 256, 256, 2048, MapId{256}, smem, cur);
        prep_T((bf16_t*)((char*)mix + 4 * MiB) + (size_t)256 * 2048, P.in[I_CW1] + (size_t)2048 * 256, 2048, 256, 256, 2048, MapId{256}, smem, cur);
        prep_T((bf16_t*)((char*)mix + 6 * MiB), P.in[I_CW2], 256, 64, 128, 256, MapId{64}, smem, cur);
        prep_T((bf16_t*)((char*)mix + 6 * MiB) + (size_t)128 * 256, P.in[I_CW2] + (size_t)256 * 64, 256, 64, 128, 256, MapId{64}, smem, cur);
        prep_T((bf16_t*)((char*)mix + 7 * MiB), P.in[I_NWO], DM, DM, DM, DM, MapPerm{DM}, smem, cur);
        { const int lane = tidx() & 63, gw = blockIdx.x * (NTHR / 64) + (tidx() >> 6);
          if (gw < 512) { const int c = gw >> 8, col = gw & 255; const float* w1 = P.in[I_CW1] + (size_t)c * 2048 * 256; const float* pe = P.in[I_CPE] + (size_t)c * 2048;
              float sacc = 0.f; for (int k = lane; k < 2048; k += 64) sacc += pe[k] * w1[(size_t)k * 256 + col];
              sacc = wave_sum(sacc); if (lane == 0) ((float*)(ws + OFF_BIASP))[gw] = sacc + P.in[I_CB1][c * 256 + col]; } }
    } else {
        prep_T(mix, P.in[I_GWIN], DM, 3088, 3328, DM, MapId{3088}, smem, cur);
        prep_T((bf16_t*)((char*)mix + 7 * MiB), P.in[I_GWO], DM, DM, DM, DM, MapPerm{DM}, smem, cur);
    }
}

template <int HIN, int HOUT>
DEV void phase_norm(const void* h_in, const bf16_t* z, const float* g_post, void* h_out, float* stage, const float* g_pre, bf16_t* xn) {
    const int lane = tidx() & 63, gw = blockIdx.x * (NTHR / 64) + (tidx() >> 6), nw = gridDim.x * (NTHR / 64);
    for (int row = gw; row < T; row += nw) {
        f32x4 hv[4];
#pragma unroll
        for (int i = 0; i < 4; ++i) { const size_t off = (size_t)row * DM + i * 256 + lane * 4;
            if (HIN == 0) hv[i] = *(const f32x4*)((const float*)h_in + off); else hv[i] = ld_bf4((const bf16_t*)h_in + off); }
        if (z) {
            f32x4 zv[4]; float ss = 0.f;
#pragma unroll
            for (int i = 0; i < 4; ++i) { zv[i] = ld_bf4(z + (size_t)row * DM + i * 256 + lane * 4); ss += zv[i][0] * zv[i][0] + zv[i][1] * zv[i][1] + zv[i][2] * zv[i][2] + zv[i][3] * zv[i][3]; }
            ss = wave_sum(ss); const float rs = rsqrtf(ss * (1.0f / DM) + 1e-6f);
#pragma unroll
            for (int i = 0; i < 4; ++i) { const f32x4 g = *(const f32x4*)(g_post + i * 256 + lane * 4); hv[i] += zv[i] * rs * g; }
        }
        if (HOUT == 1) {
#pragma unroll
            for (int i = 0; i < 4; ++i) st_bf4((bf16_t*)h_out + (size_t)row * DM + i * 256 + lane * 4, hv[i]);
        }
        if (HOUT == 2) {
            float* dst = row < T / 2 ? (float*)h_out + (size_t)row * DM : stage + (size_t)(row - T / 2) * DM;
#pragma unroll
            for (int i = 0; i < 4; ++i) *(f32x4*)(dst + i * 256 + lane * 4) = hv[i];
        }
        if (xn) {
            float ss = 0.f;
#pragma unroll
            for (int i = 0; i < 4; ++i) ss += hv[i][0] * hv[i][0] + hv[i][1] * hv[i][1] + hv[i][2] * hv[i][2] + hv[i][3] * hv[i][3];
            ss = wave_sum(ss); const float rs = rsqrtf(ss * (1.0f / DM) + 1e-6f);
#pragma unroll
            for (int i = 0; i < 4; ++i) { const f32x4 g = *(const f32x4*)(g_pre + i * 256 + lane * 4); st_bf4(xn + (size_t)row * DM + i * 256 + lane * 4, hv[i] * rs * g); }
        }
    }
}
DEV void phase_copy_out(const float* stage, float* out) {
    const size_t gt = (size_t)blockIdx.x * NTHR + tidx(), nt = (size_t)gridDim.x * NTHR;
    for (size_t i = gt; i < (size_t)(T / 2) * DM / 4; i += nt) ((f32x4*)(out + (size_t)(T / 2) * DM))[i] = ((const f32x4*)stage)[i];
}

DEV void phase_gemm_plain(const bf16_t* A, int lda, const bf16_t* Bt, int K, int ntn, bf16_t* C, int ldc, char* smem) {
    const LaneId L = lane_id();
    const int nunits = (T / 256) * ntn;
    for (int u = blockIdx.x; u < nunits; u += gridDim.x) {
        const int tm = u / ntn, tn = u % ntn;
        f32x4 acc[4][4];
        gemm_core(acc, LdPlain{A + (size_t)tm * 256 * lda, lda}, LdPlain{Bt + (size_t)tn * 128 * K, K}, K, smem);
#pragma unroll
        for (int m = 0; m < 4; ++m)
#pragma unroll
            for (int n = 0; n < 4; ++n)
                st_bf4(C + (size_t)(tm * 256 + L.wm * 64 + m * 16 + L.fr) * ldc + tn * 128 + L.wn * 64 + n * 16 + L.fq * 4, acc[m][n]);
    }
}

DEV void phase_f1(const bf16_t* xn, const bf16_t* Bt, const float* cw, const float* cb, bf16_t* act, bf16_t* E, char* smem) {
    const LaneId L = lane_id();
    const int ntn = 2 * DFF / 128, nunits = (T / 256) * ntn;
    for (int u = blockIdx.x; u < nunits; u += gridDim.x) {
        const int tm = u / ntn, tn = u % ntn;
        f32x4 acc[4][4];
        gemm_core(acc, LdPlain{xn + (size_t)tm * 256 * DM, DM}, LdPlain{Bt + (size_t)tn * 128 * DM, DM}, DM, smem);
        const int strip = tm * 4 + L.wm; const size_t rowbase = (size_t)tm * 256 + L.wm * 64;
#pragma unroll
        for (int n = 0; n < 2; ++n) {
            const int ch = tn * 64 + L.wn * 32 + n * 16 + L.fq * 4;
            const f32x4 c0 = *(const f32x4*)(cw + ch), c1 = *(const f32x4*)(cw + DFF + ch), c2 = *(const f32x4*)(cw + 2 * DFF + ch), cbv = *(const f32x4*)(cb + ch);
#pragma unroll
            for (int m = 0; m < 4; ++m) {
                const f32x4 g0 = acc[m][n], up = acc[m][n + 2]; f32x4 g1, g2;
#pragma unroll
                for (int j = 0; j < 4; ++j) {
                    const float a1 = __shfl(g0[j], (L.lane - 1) & 63), a2 = __shfl(g0[j], (L.lane - 2) & 63);
                    float b1 = 0.f, b2 = 0.f;
                    if (m > 0) { b1 = __shfl(acc[m > 0 ? m - 1 : 0][n][j], (L.lane + 15) & 63); b2 = __shfl(acc[m > 0 ? m - 1 : 0][n][j], (L.lane + 14) & 63); }
                    g1[j] = L.fr >= 1 ? a1 : b1; g2[j] = L.fr >= 2 ? a2 : b2;
                }
                const int rs = m * 16 + L.fr;
                f32x4 val = c2 * g0 + c1 * g1 + c0 * g2 + cbv, a;
#pragma unroll
                for (int j = 0; j < 4; ++j) a[j] = val[j] * rcpf_(1.0f + __expf(-val[j])) * up[j];
                if (rs >= 2) st_bf4(act + (rowbase + rs) * DFF + ch, a);
                else { st_bf4(E + ((size_t)strip * 6 + 2 + rs) * DFF + ch, g0); st_bf4(E + ((size_t)strip * 6 + 4 + rs) * DFF + ch, up); }
                if (rs >= 62) st_bf4(E + ((size_t)strip * 6 + (rs - 62)) * DFF + ch, g0);
            }
        }
    }
}
DEV void phase_f1b(const float* cw, const float* cb, bf16_t* act, const bf16_t* E) {
    const int gt = blockIdx.x * NTHR + tidx(), nt = gridDim.x * NTHR;
    for (int idx = gt; idx < 512 * 2 * (DFF / 4); idx += nt) {
        const int ch = (idx % (DFF / 4)) * 4, r = (idx / (DFF / 4)) & 1, strip = idx / (2 * (DFF / 4));
        const bool first = (strip & 127) == 0;
        const f32x4 zero = {0.f, 0.f, 0.f, 0.f};
        const f32x4 g0 = ld_bf4(E + ((size_t)strip * 6 + 2 + r) * DFF + ch), up = ld_bf4(E + ((size_t)strip * 6 + 4 + r) * DFF + ch);
        f32x4 g1, g2;
        if (r == 1) { g1 = ld_bf4(E + ((size_t)strip * 6 + 2) * DFF + ch); g2 = first ? zero : ld_bf4(E + ((size_t)(strip - 1) * 6 + 1) * DFF + ch); }
        else { g1 = first ? zero : ld_bf4(E + ((size_t)(strip - 1) * 6 + 1) * DFF + ch); g2 = first ? zero : ld_bf4(E + ((size_t)(strip - 1) * 6 + 0) * DFF + ch); }
        const f32x4 c0 = *(const f32x4*)(cw + ch), c1 = *(const f32x4*)(cw + DFF + ch), c2 = *(const f32x4*)(cw + 2 * DFF + ch), cbv = *(const f32x4*)(cb + ch);
        f32x4 val = c2 * g0 + c1 * g1 + c0 * g2 + cbv, a;
#pragma unroll
        for (int j = 0; j < 4; ++j) a[j] = val[j] * rcpf_(1.0f + __expf(-val[j])) * up[j];
        st_bf4(act + ((size_t)strip * 64 + r) * DFF + ch, a);
    }
}

struct RwkvW { const float *mu, *w0, *a0, *k_k, *k_a, *r_k, *ln_w, *ln_b, *v0; bool vres; };
DEV void phase_r1(const bf16_t* xn, const bf16_t* Bt, const RwkvW& W, bf16_t* rb, bf16_t* kb, bf16_t* hid, char* smem) {
    const LaneId L = lane_id();
    const int ntn = 20, nunits = (T / 256) * ntn;
    for (int u = blockIdx.x; u < nunits; u += gridDim.x) {
        const int tm = u / ntn, tn = u % ntn;
        const int var = tn < 8 ? 0 : tn < 16 ? 2 : tn == 16 ? 1 : tn == 17 ? 4 : tn == 18 ? 5 : 3;
        f32x4 acc[4][4];
        gemm_core(acc, LdMix{xn, W.mu + var * DM, tm * 256, {0.f, 0.f, 0.f, 0.f}, {0.f, 0.f, 0.f, 0.f}}, LdPlain{Bt + (size_t)tn * 128 * DM, DM}, DM, smem);
#pragma unroll
        for (int m = 0; m < 4; ++m)
#pragma unroll
            for (int n = 0; n < 4; ++n) {
                const size_t row = (size_t)tm * 256 + L.wm * 64 + m * 16 + L.fr; const int c = L.wn * 64 + n * 16 + L.fq * 4; f32x4 v = acc[m][n];
                if (tn < 8) st_bf4(rb + row * DM + tn * 128 + c, v);
                else if (tn < 16) st_bf4(kb + row * DM + (tn - 8) * 128 + c, v);
                else if (tn == 16) { if (L.wn == 0) { for (int j = 0; j < 4; ++j) v[j] = tanhf(v[j]); st_bf4(hid + row * HIDP + c, v); } }
                else if (tn == 17) { if (L.wn == 0) st_bf4(hid + row * HIDP + 64 + c, v); }
                else if (tn == 18) { for (int j = 0; j < 4; ++j) v[j] = sigmoidf_(v[j]); st_bf4(hid + row * HIDP + 128 + c, v); }
                else { if (L.wn == 0) st_bf4(hid + row * HIDP + 256 + c, v); }
            }
    }
}
DEV void phase_r2(const bf16_t* xn, const bf16_t* mixw, const RwkvW& W, const bf16_t* hid, const bf16_t* rb, float* bsc, bf16_t* wb, bf16_t* kb, bf16_t* kkb, bf16_t* kab, bf16_t* vb, char* smem) {
    const LaneId L = lane_id();
    const bf16_t* Bv = (const bf16_t*)((const char*)mixw + 5 * MiB);
    const bf16_t* W2T = (const bf16_t*)((const char*)mixw + 7 * MiB);
    const bf16_t* A2T = (const bf16_t*)((const char*)mixw + 7 * MiB + 131072);
    const bf16_t* V2T = (const bf16_t*)((const char*)mixw + 7 * MiB + 262144);
    const int nunits = 1024 + 2048;
    for (int u = blockIdx.x; u < nunits; u += gridDim.x) {
        if (u < 1024) {
            const int tm = u >> 3, tn = u & 7;
            f32x4 acc[4][4]; u32x2 gpk[4][4];
            if (W.vres) {
                gemm_core(acc, LdPlain{hid + (size_t)tm * 256 * HIDP + 256, HIDP}, LdPlain{V2T + (size_t)tn * 128 * 64, 64}, 64, smem);
#pragma unroll
                for (int m = 0; m < 4; ++m)
#pragma unroll
                    for (int n = 0; n < 4; ++n) { const int col = tn * 128 + L.wn * 64 + n * 16 + L.fq * 4; const f32x4 b = *(const f32x4*)(W.v0 + col);
                        gpk[m][n].x = cvt_pk(sigmoidf_(b[0] + acc[m][n][0]), sigmoidf_(b[1] + acc[m][n][1]));
                        gpk[m][n].y = cvt_pk(sigmoidf_(b[2] + acc[m][n][2]), sigmoidf_(b[3] + acc[m][n][3])); }
            }
            gemm_core(acc, LdMix{xn, W.mu + 3 * DM, tm * 256, {0.f, 0.f, 0.f, 0.f}, {0.f, 0.f, 0.f, 0.f}}, LdPlain{Bv + (size_t)tn * 128 * DM, DM}, DM, smem);
#pragma unroll
            for (int m = 0; m < 4; ++m)
#pragma unroll
                for (int n = 0; n < 4; ++n) {
                    const size_t row = (size_t)tm * 256 + L.wm * 64 + m * 16 + L.fr; const int col = tn * 128 + L.wn * 64 + n * 16 + L.fq * 4; f32x4 v = acc[m][n];
                    if (W.vres) { const f32x4 vf = ld_bf4(vb + row * DM + col); f32x4 gt; gt[0] = bf_lo(gpk[m][n].x); gt[1] = bf_hi(gpk[m][n].x); gt[2] = bf_lo(gpk[m][n].y); gt[3] = bf_hi(gpk[m][n].y); v = v + (vf - v) * gt; }
                    st_bf4(vb + row * DM + col, v);
                }
        } else {
            const int u2 = u - 1024, tm = u2 >> 4, jj = u2 & 15;
            f32x4 acc[4][4];
            if (jj < 8) {
                const int tn = jj;
                gemm_core(acc, LdPlain{hid + (size_t)tm * 256 * HIDP, HIDP}, LdPlain{W2T + (size_t)tn * 128 * 64, 64}, 64, smem);
#pragma unroll
                for (int m = 0; m < 4; ++m)
#pragma unroll
                    for (int n = 0; n < 4; ++n) {
                        const size_t row = (size_t)tm * 256 + L.wm * 64 + m * 16 + L.fr; const int col = tn * 128 + L.wn * 64 + n * 16 + L.fq * 4; const f32x4 b = *(const f32x4*)(W.w0 + col); f32x4 v;
                        for (int j = 0; j < 4; ++j) { const float x = b[j] + acc[m][n][j]; const float y = -x;
                            const float sp = fmaxf(y, 0.f) + log1pf(__expf(-fabsf(y))); const float w = -sp - 0.5f; v[j] = __expf(-__expf(w)); }
                        st_bf4(wb + row * DM + col, v);
                    }
            } else {
                const int tn = jj - 8;
                gemm_core(acc, LdPlain{hid + (size_t)tm * 256 * HIDP + 64, HIDP}, LdPlain{A2T + (size_t)tn * 128 * 64, 64}, 64, smem);
#pragma unroll
                for (int m = 0; m < 4; ++m) {
                    const size_t row = (size_t)tm * 256 + L.wm * 64 + m * 16 + L.fr;
                    u32x2 kpk[4]; float ss = 0.f;
#pragma unroll
                    for (int n = 0; n < 4; ++n) { const int col = tn * 128 + L.wn * 64 + n * 16 + L.fq * 4;
                        kpk[n] = *(const u32x2*)(kb + row * DM + col); const f32x4 kkw = *(const f32x4*)(W.k_k + col);
                        const float c0 = bf_lo(kpk[n].x) * kkw[0], c1 = bf_hi(kpk[n].x) * kkw[1], c2 = bf_lo(kpk[n].y) * kkw[2], c3 = bf_hi(kpk[n].y) * kkw[3];
                        ss += (c0 * c0 + c1 * c1) + (c2 * c2 + c3 * c3); }
                    ss += __shfl_xor(ss, 16); ss += __shfl_xor(ss, 32);
                    const float inv = rcpf_(fmaxf(sqrtf(ss), 1e-12f));
                    asm volatile("" ::: "memory");
                    float bon = 0.f;
#pragma unroll
                    for (int n = 0; n < 4; ++n) { const int col = tn * 128 + L.wn * 64 + n * 16 + L.fq * 4;
                        const f32x4 ka = *(const f32x4*)(W.k_a + col), kkw = *(const f32x4*)(W.k_k + col), a0 = *(const f32x4*)(W.a0 + col), rkv = *(const f32x4*)(W.r_k + col), rv = ld_bf4(rb + row * DM + col);
                        f32x4 kv; kv[0] = bf_lo(kpk[n].x); kv[1] = bf_hi(kpk[n].x); kv[2] = bf_lo(kpk[n].y); kv[3] = bf_hi(kpk[n].y);
                        f32x4 kk, kp, kka;
                        for (int j = 0; j < 4; ++j) { const float a = sigmoidf_(a0[j] + acc[m][n][j]); kk[j] = kv[j] * kkw[j] * inv; kp[j] = kv[j] * (1.0f + (a - 1.0f) * ka[j]); kka[j] = kk[j] * a; }
                        const u32x2 kpp = {cvt_pk(kp[0], kp[1]), cvt_pk(kp[2], kp[3])};
                        bon += rv[0] * bf_lo(kpp.x) * rkv[0] + rv[1] * bf_hi(kpp.x) * rkv[1] + rv[2] * bf_lo(kpp.y) * rkv[2] + rv[3] * bf_hi(kpp.y) * rkv[3];
                        *(u32x2*)(kb + row * DM + col) = kpp; st_bf4(kkb + row * DM + col, kk); st_bf4(kab + row * DM + col, kka);
                        asm volatile("" ::: "memory"); }
                    bon += __shfl_xor(bon, 16); bon += __shfl_xor(bon, 32);
                    if (L.fq == 0) bsc[row * 16 + tn * 2 + L.wn] = bon;
                }
            }
        }
    }
}
typedef float f32x2 __attribute__((ext_vector_type(2)));
constexpr int R3_CH = 32, R3_STR = R3_CH * 256, R3_BUF = 5 * R3_STR + R3_CH * 64;
DEV void r3_stage_raw(const bf16_t* const (&str)[5], const bf16_t* vb, size_t base, int vrow0, int t0, char* buf, int id) {
    u32x4 d[5];
    const int t = id >> 3, j = id & 7;
#pragma unroll
    for (int st = 0; st < 5; ++st) d[st] = *(const u32x4*)(str[st] + base + (size_t)(t0 + t) * DM + j * 8);
    u32x4 vv = {0u, 0u, 0u, 0u};
    if (id < 64) vv = *(const u32x4*)(vb + base + (size_t)(t0 + (id >> 1)) * DM + vrow0 + (id & 1) * 8);
#pragma unroll
    for (int st = 0; st < 5; ++st) { f32x4 a, b; a[0] = bf_lo(d[st].x); a[1] = bf_hi(d[st].x); a[2] = bf_lo(d[st].y); a[3] = bf_hi(d[st].y); b[0] = bf_lo(d[st].z); b[1] = bf_hi(d[st].z); b[2] = bf_lo(d[st].w); b[3] = bf_hi(d[st].w);
        float* p = (float*)(buf + st * R3_STR + t * 256 + j * 32); *(f32x4*)p = a; *(f32x4*)(p + 4) = b; }
    if (id < 64) { f32x4 a, b; a[0] = bf_lo(vv.x); a[1] = bf_hi(vv.x); a[2] = bf_lo(vv.y); a[3] = bf_hi(vv.y); b[0] = bf_lo(vv.z); b[1] = bf_hi(vv.z); b[2] = bf_lo(vv.w); b[3] = bf_hi(vv.w);
        float* vp = (float*)(buf + 5 * R3_STR + (id >> 1) * 64 + (id & 1) * 32); *(f32x4*)vp = a; *(f32x4*)(vp + 4) = b; }
}
DEV void phase_r3(const bf16_t* rb, const bf16_t* wb, const bf16_t* kb, const bf16_t* kkb, const bf16_t* kab, const bf16_t* vb, bf16_t* yb, float* bsc, const float* r_k, char* smem) {
    const int tid = tidx(), lane = tid & 63, wid = tid >> 6;
    const bf16_t* const str[5] = {rb, wb, kb, kkb, kab};
    constexpr int NCH = SEQ / R3_CH;
    for (int task = blockIdx.x; task < 256; task += gridDim.x) {
        const int bh = task >> 2, b = bh >> 4, h = bh & 15, rq = task & 3;
        const size_t base = (size_t)b * SEQ * DM + h * 64;
        bf16_t* ystage = (bf16_t*)(smem + 131072 + 64);
    float* gcarea = (float*)(smem + 3 * R3_BUF);
        if (wid >= 4) r3_stage_raw(str, vb, base, rq * 16, 0, smem, tid - 256);
        __syncthreads();
        if (wid >= 4) { r3_stage_raw(str, vb, base, rq * 16, R3_CH, smem + R3_BUF, tid - 256);
            char* bq = smem; float* w = (float*)bq + R3_STR / 4 + lane; const int p = wid - 4;
            float G = 1.f; for (int t = 0; t < 8 * p; ++t) G *= w[t * 64];
            float* r = (float*)bq + lane; float* k = r + 2 * (R3_STR / 4); float* q = r + 3 * (R3_STR / 4); float* a = r + 4 * (R3_STR / 4);
#pragma unroll
            for (int u = 0; u < 8; ++u) { const int t = 8 * p + u; const float Gold = G; G *= w[t * 64]; const float inv = rcpf_(G); r[t * 64] *= G; q[t * 64] *= Gold; k[t * 64] *= inv; a[t * 64] *= inv; }
            if (p == 3) gcarea[lane] = G; }
        __syncthreads();
        const int rr = lane >> 4, cg = lane & 15, rg = rq * 4 + wid;
        const size_t voff = base + rg * 4 + rr;
        f32x2 s01 = {0.f, 0.f}, s23 = {0.f, 0.f};
        for (int c = 0; c < NCH; ++c) {
            if (wid >= 4) {
                if (c >= 1 && tid - 256 < 64) { const int id = tid - 256;
                    *(u32x4*)(yb + base + (size_t)((c - 1) * R3_CH + (id >> 1)) * DM + rq * 16 + (id & 1) * 8) = *(const u32x4*)(ystage + ((c - 1) & 1) * 512 + (id >> 1) * 16 + (id & 1) * 8); }
                if (c + 2 < NCH) r3_stage_raw(str, vb, base, rq * 16, (c + 2) * R3_CH, smem + ((c + 2) % 3) * R3_BUF, tid - 256);
                if (c + 1 < NCH) { char* bq = smem + ((c + 1) % 3) * R3_BUF; float* w = (float*)bq + R3_STR / 4 + lane; const int p = wid - 4;
                    float G = 1.f; for (int t = 0; t < 8 * p; ++t) G *= w[t * 64];
                    float* r = (float*)bq + lane; float* k = r + 2 * (R3_STR / 4); float* q = r + 3 * (R3_STR / 4); float* a = r + 4 * (R3_STR / 4);
#pragma unroll
                    for (int u = 0; u < 8; ++u) { const int t = 8 * p + u; const float Gold = G; G *= w[t * 64]; const float inv = rcpf_(G); r[t * 64] *= G; q[t * 64] *= Gold; k[t * 64] *= inv; a[t * 64] *= inv; }
                    if (p == 3) gcarea[((c + 1) % 3) * 64 + lane] = G; }
            } else {
                const char* buf = smem + (c % 3) * R3_BUF;
                f32x4 R_[2][2], K_[2][2], Q_[2][2], A_[2][2]; float V_[2][2];
#define R3_LD(bf, t0) { _Pragma("unroll") for (int u = 0; u < 2; ++u) { const char* p = buf + ((t0) + u) * 256 + cg * 16; \
                    R_[bf][u] = *(const f32x4*)p; K_[bf][u] = *(const f32x4*)(p + 2 * R3_STR); Q_[bf][u] = *(const f32x4*)(p + 3 * R3_STR); A_[bf][u] = *(const f32x4*)(p + 4 * R3_STR); \
                    V_[bf][u] = *(const float*)(buf + 5 * R3_STR + ((t0) + u) * 64 + (wid * 4 + rr) * 4); } }
#define R3_CP(bf, sl) { _Pragma("unroll") for (int u = 0; u < 2; ++u) { \
                    const f32x4 R = R_[bf][u], K = K_[bf][u], Q = Q_[bf][u], A = A_[bf][u]; const float vv = V_[bf][u]; \
                    const f32x2 r01 = {R[0], R[1]}, r23 = {R[2], R[3]}, k01 = {K[0], K[1]}, k23 = {K[2], K[3]}; \
                    const f32x2 q01 = {Q[0], Q[1]}, q23 = {Q[2], Q[3]}, a01 = {A[0], A[1]}, a23 = {A[2], A[3]}; \
                    const f32x2 pq = s01 * q01 + s23 * q23; \
                    const float sa = -row16_sum(pq.x + pq.y); \
                    const f32x2 sa2 = {sa, sa}, vv2 = {vv, vv}; \
                    s01 = (s01 + vv2 * k01) + sa2 * a01; s23 = (s23 + vv2 * k23) + sa2 * a23; \
                    const f32x2 py = s01 * r01 + s23 * r23; \
                    const float y = row16_sum(py.x + py.y); \
                    yv = (cg == (sl) + u) ? y : yv; } }
                R3_LD(0, 0)
#pragma unroll 1
                for (int t8 = 0; t8 < R3_CH; t8 += 8) {
                    float yv = 0.f;
                    R3_LD(1, t8 + 2)
                    R3_CP(0, 0)
                    R3_LD(0, t8 + 4)
                    R3_CP(1, 2)
                    R3_LD(1, t8 + 6)
                    R3_CP(0, 4)
                    if (t8 + 8 < R3_CH) R3_LD(0, t8 + 8)
                    R3_CP(1, 6)
                    if (cg < 8) ystage[(c & 1) * 512 + (t8 + cg) * 16 + wid * 4 + rr] = f2bf(yv);
                }
#undef R3_LD
#undef R3_CP
                const f32x4 GC = *(const f32x4*)(gcarea + (c % 3) * 64 + cg * 4);
                s01 *= (f32x2){GC[0], GC[1]}; s23 *= (f32x2){GC[2], GC[3]};
            }
            __syncthreads();
        }
        if (wid >= 4 && tid - 256 < 64) { const int id = tid - 256;
            *(u32x4*)(yb + base + (size_t)((NCH - 1) * R3_CH + (id >> 1)) * DM + rq * 16 + (id & 1) * 8) = *(const u32x4*)(ystage + ((NCH - 1) & 1) * 512 + (id >> 1) * 16 + (id & 1) * 8); }
        __syncthreads();
    }
}
constexpr int RC_NP = 7, RC_SLOT = 18688, RC_LDS = 18688;
constexpr int RC_QT = 0, RC_RR = 4096, RC_BG = 8192, RC_AB = 12288, RC_D0 = 14336, RC_U0 = 16384, RC_Y0 = 17408, RC_G = 18432;
#define R3C_FENCE() asm volatile("" ::: "memory")
constexpr int RC_P = 144;
DEV bf16x8 r3c_permfrag(const char* rowp, int q) {
    const u32x2 lo = *(const u32x2*)(rowp + 8 * q), hi = *(const u32x2*)(rowp + 32 + 8 * q);
    u32x4 w; w.x = lo.x; w.y = lo.y; w.z = hi.x; w.w = hi.y; return __builtin_bit_cast(bf16x8, w);
}
DEV bf16x8 r3c_neg(bf16x8 a) { u32x4 w = __builtin_bit_cast(u32x4, a); w.x ^= 0x80008000u; w.y ^= 0x80008000u; w.z ^= 0x80008000u; w.w ^= 0x80008000u; return __builtin_bit_cast(bf16x8, w); }
DEV u32x4 r3c_scale8(u32x4 d, f32x4 a, f32x4 b) {
    u32x4 o; o.x = cvt_pk(bf_lo(d.x) * a[0], bf_hi(d.x) * a[1]); o.y = cvt_pk(bf_lo(d.y) * a[2], bf_hi(d.y) * a[3]);
    o.z = cvt_pk(bf_lo(d.z) * b[0], bf_hi(d.z) * b[1]); o.w = cvt_pk(bf_lo(d.w) * b[2], bf_hi(d.w) * b[3]); return o;
}
DEV u32x2 r3c_pk4(f32x4 v) { u32x2 w; w.x = cvt_pk(v[0], v[1]); w.y = cvt_pk(v[2], v[3]); return w; }
DEV f32x4 r3c_up4(u32x2 w) { f32x4 v; v[0] = bf_lo(w.x); v[1] = bf_hi(w.x); v[2] = bf_lo(w.y); v[3] = bf_hi(w.y); return v; }
#define R3C_SCORE(dst, A, B, ROWLESS, STRICT) { _Pragma("unroll") for (int a = 0; a < 2; ++a) { _Pragma("unroll") for (int b = 0; b < 2; ++b) { \
        f32x4 a_ = MFMA(A[a][0], B[b][0], z4); a_ = MFMA(A[a][1], B[b][1], a_); \
        _Pragma("unroll") for (int r = 0; r < 4; ++r) { const int row_ = 16 * a + 4 * q + r, col_ = 16 * b + m; const int lo_ = (ROWLESS) ? row_ : col_, hi_ = (ROWLESS) ? col_ : row_; \
            const bool keep_ = (STRICT) ? (lo_ < hi_) : (lo_ <= hi_); a_[r] = keep_ ? a_[r] : 0.f; } \
        dst[a][b] = a_; } } }
struct R3Raw { u32x4 dr[4], dw[4], dk[4], dq[4], da[4]; bf16x8 vfrag; };
DEV void r3c_load(R3Raw& W, const bf16_t* rb, const bf16_t* wb, const bf16_t* kb, const bf16_t* kkb, const bf16_t* kab, const bf16_t* vb, size_t base, int vrow0, int t0, int lane) {
    const int m = lane & 15, q = lane >> 4, tr = lane >> 3, j = lane & 7;
#pragma unroll
    for (int s = 0; s < 4; ++s) { const size_t o = base + (size_t)(t0 + 8 * s + tr) * DM + j * 8;
        W.dw[s] = *(const u32x4*)(wb + o); W.dr[s] = *(const u32x4*)(rb + o); W.dk[s] = *(const u32x4*)(kb + o); W.dq[s] = *(const u32x4*)(kkb + o); W.da[s] = *(const u32x4*)(kab + o); }
    const bf16_t* vp = vb + base + (size_t)t0 * DM + vrow0 + m; unsigned e[8];
#pragma unroll
    for (int jj = 0; jj < 8; ++jj) { const int t = (jj < 4) ? 4 * q + jj : 16 + 4 * q + jj - 4; e[jj] = vp[(size_t)t * DM]; }
    u32x4 w; w.x = e[0] | (e[1] << 16); w.y = e[2] | (e[3] << 16); w.z = e[4] | (e[5] << 16); w.w = e[6] | (e[7] << 16); W.vfrag = __builtin_bit_cast(bf16x8, w);
}
DEV void r3c_produce(const bf16_t* rb, const bf16_t* wb, const bf16_t* kb, const bf16_t* kkb, const bf16_t* kab, const bf16_t* vb, size_t base, int vrow0, int t0, char* lds, char* slot, int lane) {
    const int m = lane & 15, q = lane >> 4, tr = lane >> 3, j = lane & 7;
    R3Raw W; r3c_load(W, rb, wb, kb, kkb, kab, vb, base, vrow0, t0, lane);
    const f32x4 z4 = {0.f, 0.f, 0.f, 0.f};
    char* Rh = lds; char* Qh = lds + 32 * RC_P; char* Kh = lds + 64 * RC_P; char* Bh = lds + 96 * RC_P; float* G31a = (float*)(lds + 128 * RC_P);
    float* Gb = (float*)Kh;
    const bf16x8 vfrag = W.vfrag;
#pragma unroll
    for (int s = 0; s < 4; ++s) { float* gp = Gb + (8 * s + tr) * 64 + 8 * j; f32x4 a, b; const u32x4 d = W.dw[s];
        a[0] = bf_lo(d.x); a[1] = bf_hi(d.x); a[2] = bf_lo(d.y); a[3] = bf_hi(d.y); b[0] = bf_lo(d.z); b[1] = bf_hi(d.z); b[2] = bf_lo(d.w); b[3] = bf_hi(d.w);
        *(f32x4*)gp = a; *(f32x4*)(gp + 4) = b; }
    R3C_FENCE();
    { float g[32];
#pragma unroll
      for (int t = 0; t < 32; ++t) g[t] = Gb[t * 64 + lane];
      float G = 1.f;
#pragma unroll
      for (int t = 0; t < 32; ++t) { G *= g[t]; Gb[t * 64 + lane] = G; }
      G31a[lane] = G; *(float*)(slot + RC_G + lane * 4) = G; }
    R3C_FENCE();
    { u32x4 kh[4], bh[4];
#pragma unroll
      for (int s = 0; s < 4; ++s) { const int t = 8 * s + tr, tp = t > 0 ? t - 1 : 0;
          const f32x4 g0 = *(const f32x4*)(Gb + t * 64 + 8 * j), g1 = *(const f32x4*)(Gb + t * 64 + 8 * j + 4);
          f32x4 p0 = *(const f32x4*)(Gb + tp * 64 + 8 * j), p1 = *(const f32x4*)(Gb + tp * 64 + 8 * j + 4);
          if (t == 0) { p0 = (f32x4){1.f, 1.f, 1.f, 1.f}; p1 = p0; }
          f32x4 i0, i1;
#pragma unroll
          for (int e = 0; e < 4; ++e) { i0[e] = rcpf_(g0[e]); i1[e] = rcpf_(g1[e]); }
          *(u32x4*)(Rh + t * RC_P + j * 16) = r3c_scale8(W.dr[s], g0, g1);
          *(u32x4*)(Qh + t * RC_P + j * 16) = r3c_scale8(W.dq[s], p0, p1);
          kh[s] = r3c_scale8(W.dk[s], i0, i1); bh[s] = r3c_scale8(W.da[s], i0, i1); }
      R3C_FENCE();
#pragma unroll
      for (int s = 0; s < 4; ++s) { const int t = 8 * s + tr; *(u32x4*)(Kh + t * RC_P + j * 16) = kh[s]; *(u32x4*)(Bh + t * RC_P + j * 16) = bh[s]; } }
    R3C_FENCE();
    bf16x8 Qa[2][2], Ra[2][2], Kb[2][2], Bb[2][2];
#pragma unroll
    for (int x = 0; x < 2; ++x)
#pragma unroll
        for (int ks = 0; ks < 2; ++ks) { const int off = (16 * x + m) * RC_P + (32 * ks + 8 * q) * 2;
            Qa[x][ks] = *(const bf16x8*)(Qh + off); Ra[x][ks] = *(const bf16x8*)(Rh + off); Kb[x][ks] = *(const bf16x8*)(Kh + off); Bb[x][ks] = *(const bf16x8*)(Bh + off); }
    f32x4 Tt[2][2], PN[2][2], PT[2][2], Z[2][5];
    R3C_SCORE(Tt, Kb, Qa, true, true)
    Z[0][4] = MFMA(pack8(Tt[0][0], Tt[1][0]), vfrag, z4); Z[1][4] = MFMA(pack8(Tt[0][1], Tt[1][1]), vfrag, z4);
    R3C_SCORE(Tt, Kb, Ra, true, false)
    { const f32x4 y0 = MFMA(pack8(Tt[0][0], Tt[1][0]), vfrag, z4), y1 = MFMA(pack8(Tt[0][1], Tt[1][1]), vfrag, z4);
      *(u32x2*)(slot + RC_Y0 + lane * 8) = r3c_pk4(y0); *(u32x2*)(slot + RC_Y0 + 512 + lane * 8) = r3c_pk4(y1); }
    R3C_SCORE(Tt, Bb, Ra, true, false)
    *(bf16x8*)(slot + RC_AB + lane * 16) = r3c_neg(pack8(Tt[0][0], Tt[1][0])); *(bf16x8*)(slot + RC_AB + 1024 + lane * 16) = r3c_neg(pack8(Tt[0][1], Tt[1][1]));
    R3C_SCORE(PN, Qa, Bb, false, true)
    R3C_SCORE(PT, Bb, Qa, true, true)
#pragma unroll
    for (int mt = 0; mt < 2; ++mt)
#pragma unroll
        for (int n = 0; n < 4; ++n)
#pragma unroll
            for (int r = 0; r < 4; ++r) Z[mt][n][r] = bf2f(*(const bf16_t*)(Qh + (16 * mt + 4 * q + r) * RC_P + (16 * n + m) * 2));
#pragma unroll
    for (int lev = 0; lev < 5; ++lev) {
        bf16x8 fa[2], fb[2], zb[5];
#pragma unroll
        for (int x = 0; x < 2; ++x) { fa[x] = pack8(PT[0][x], PT[1][x]); fb[x] = pack8(PN[0][x], PN[1][x]); }
#pragma unroll
        for (int n = 0; n < 5; ++n) zb[n] = pack8(Z[0][n], Z[1][n]);
        const bf16x8 a0 = lev == 0 ? r3c_neg(fa[0]) : fa[0], a1 = lev == 0 ? r3c_neg(fa[1]) : fa[1];
#pragma unroll
        for (int n = 0; n < 5; ++n) { Z[0][n] = MFMA(a0, zb[n], Z[0][n]); Z[1][n] = MFMA(a1, zb[n], Z[1][n]); }
        if (lev < 4) {
#pragma unroll
            for (int a = 0; a < 2; ++a)
#pragma unroll
                for (int b = 0; b < 2; ++b) { PN[a][b] = MFMA(fa[a], fb[b], z4); PT[a][b] = MFMA(fb[a], fa[b], z4); }
        }
    }
    R3C_FENCE();
#pragma unroll
    for (int mt = 0; mt < 2; ++mt)
#pragma unroll
        for (int n = 0; n < 4; ++n)
#pragma unroll
            for (int r = 0; r < 4; ++r) *(bf16_t*)(Qh + (16 * mt + 4 * q + r) * RC_P + (16 * n + m) * 2) = f2bf(Z[mt][n][r]);
    R3C_FENCE();
#pragma unroll
    for (int mt = 0; mt < 2; ++mt)
#pragma unroll
        for (int ks = 0; ks < 2; ++ks) {
            *(bf16x8*)(slot + RC_QT + (mt * 2 + ks) * 1024 + lane * 16) = r3c_permfrag(Qh + (16 * mt + m) * RC_P + ks * 64, q);
            *(bf16x8*)(slot + RC_RR + (mt * 2 + ks) * 1024 + lane * 16) = r3c_permfrag(Rh + (16 * mt + m) * RC_P + ks * 64, q); }
    *(u32x2*)(slot + RC_U0 + lane * 8) = r3c_pk4(Z[0][4]); *(u32x2*)(slot + RC_U0 + 512 + lane * 8) = r3c_pk4(Z[1][4]);
#pragma unroll
    for (int ct = 0; ct < 4; ++ct) { const int ch = 16 * ct + m; const float g = G31a[ch]; f32x4 k0, k1, b0, b1;
#pragma unroll
        for (int jj = 0; jj < 4; ++jj) { const int ta = 4 * q + jj, tb = 16 + 4 * q + jj;
            k0[jj] = bf2f(*(const bf16_t*)(Kh + ta * RC_P + ch * 2)) * g; k1[jj] = bf2f(*(const bf16_t*)(Kh + tb * RC_P + ch * 2)) * g;
            b0[jj] = bf2f(*(const bf16_t*)(Bh + ta * RC_P + ch * 2)) * -g; b1[jj] = bf2f(*(const bf16_t*)(Bh + tb * RC_P + ch * 2)) * -g; }
        *(bf16x8*)(slot + RC_BG + ct * 1024 + lane * 16) = pack8(b0, b1);
        const f32x4 d0 = MFMA(pack8(k0, k1), vfrag, z4);
        *(u32x2*)(slot + RC_D0 + ct * 512 + lane * 8) = r3c_pk4(d0); }
    R3C_FENCE();
}
DEV void r3c_consume(f32x4 (&S)[4], const char* slot, bf16_t* yout, int lane) {
    const int m = lane & 15, q = lane >> 4;
    bf16x8 QT[2][2], RA[2][2], BG[4], AB[2]; u32x2 D0[4], U0[2], Y0[2]; f32x4 Gv[4];
#pragma unroll
    for (int f = 0; f < 4; ++f) { QT[f >> 1][f & 1] = *(const bf16x8*)(slot + RC_QT + f * 1024 + lane * 16); BG[f] = *(const bf16x8*)(slot + RC_BG + f * 1024 + lane * 16);
        D0[f] = *(const u32x2*)(slot + RC_D0 + f * 512 + lane * 8); Gv[f] = *(const f32x4*)(slot + RC_G + (16 * f + 4 * q) * 4); }
#pragma unroll
    for (int f = 0; f < 2; ++f) { U0[f] = *(const u32x2*)(slot + RC_U0 + f * 512 + lane * 8); Y0[f] = *(const u32x2*)(slot + RC_Y0 + f * 512 + lane * 8); AB[f] = *(const bf16x8*)(slot + RC_AB + f * 1024 + lane * 16); }
#pragma unroll
    for (int f = 0; f < 4; ++f) RA[f >> 1][f & 1] = *(const bf16x8*)(slot + RC_RR + f * 1024 + lane * 16);
    const bf16x8 sB0 = pack8(S[0], S[1]), sB1 = pack8(S[2], S[3]);
    f32x4 U[2], Y[2];
#pragma unroll
    for (int mt = 0; mt < 2; ++mt) { U[mt] = r3c_up4(U0[mt]); U[mt] = MFMA(QT[mt][0], sB0, U[mt]); U[mt] = MFMA(QT[mt][1], sB1, U[mt]); }
    const bf16x8 uB = pack8(U[0], U[1]);
#pragma unroll
    for (int ct = 0; ct < 4; ++ct) { S[ct] = S[ct] * Gv[ct] + r3c_up4(D0[ct]); S[ct] = MFMA(BG[ct], uB, S[ct]); }
#pragma unroll
    for (int mt = 0; mt < 2; ++mt) { Y[mt] = r3c_up4(Y0[mt]); Y[mt] = MFMA(RA[mt][0], sB0, Y[mt]); Y[mt] = MFMA(RA[mt][1], sB1, Y[mt]); Y[mt] = MFMA(AB[mt], uB, Y[mt]);
#pragma unroll
        for (int r = 0; r < 4; ++r) yout[(size_t)(16 * mt + 4 * q + r) * DM + m] = f2bf(Y[mt][r]); }
}
DEV void phase_r3c(const bf16_t* rb, const bf16_t* wb, const bf16_t* kb, const bf16_t* kkb, const bf16_t* kab, const bf16_t* vb, bf16_t* yb, char* ringbase, char* smem) {
    const int tid = tidx(), lane = tid & 63, wid = tid >> 6;
    constexpr int NCH = SEQ / 32, NR = (NCH + RC_NP - 1) / RC_NP;
    char* ring = ringbase + (size_t)blockIdx.x * (2 * RC_NP * RC_SLOT);
    for (int task = blockIdx.x; task < 256; task += gridDim.x) {
        const int xc = task & 7, ix = task >> 3, bh = xc * 8 + (ix >> 2), b = bh >> 4, h = bh & 15, rq = ix & 3;
        const size_t base = (size_t)b * SEQ * DM + h * 64;
        f32x4 S[4];
#pragma unroll
        for (int ct = 0; ct < 4; ++ct) S[ct] = (f32x4){0.f, 0.f, 0.f, 0.f};
        for (int rd = 0; rd <= NR; ++rd) {
            if (wid == 0) {
                if (rd >= 1) {
#pragma unroll 1
                    for (int p = 0; p < RC_NP; ++p) { const int c = (rd - 1) * RC_NP + p;
                        if (c < NCH) r3c_consume(S, ring + (size_t)((((rd - 1) & 1) * RC_NP + p) * RC_SLOT), yb + base + (size_t)c * 32 * DM + rq * 16, lane); }
                }
            } else {
                const int c = rd * RC_NP + wid - 1;
                if (rd < NR && c < NCH) r3c_produce(rb, wb, kb, kkb, kab, vb, base, rq * 16, c * 32, smem + (wid - 1) * RC_LDS, ring + (size_t)(((rd & 1) * RC_NP + wid - 1) * RC_SLOT), lane);
            }
            asm volatile("s_waitcnt vmcnt(0)" ::: "memory");
            __syncthreads();
        }
    }
}
DEV void phase_r4(const bf16_t* hid, const bf16_t* G2T, const RwkvW& W, const bf16_t* yb, const bf16_t* vb, const float* bsc, bf16_t* outb, char* smem) {
    const LaneId L = lane_id();
    const int ntn = 8, nunits = (T / 256) * ntn;
    for (int u = blockIdx.x; u < nunits; u += gridDim.x) {
        const int tm = u / ntn, tn = u % ntn;
        f32x4 acc[4][4];
        gemm_core(acc, LdPlain{hid + (size_t)tm * 256 * HIDP + 128, HIDP}, LdPlain{G2T + (size_t)tn * 128 * 128, 128}, 128, smem);
        const int head = tn * 2 + L.wn;
#pragma unroll
        for (int m = 0; m < 4; ++m) {
            const size_t row = (size_t)tm * 256 + L.wm * 64 + m * 16 + L.fr;
            f32x4 yv[4]; float s = 0.f;
#pragma unroll
            for (int n = 0; n < 4; ++n) { yv[n] = ld_bf4(yb + row * DM + head * 64 + n * 16 + L.fq * 4); s += (yv[n][0] + yv[n][1]) + (yv[n][2] + yv[n][3]); }
            s += __shfl_xor(s, 16); s += __shfl_xor(s, 32);
            const float mean = s * (1.0f / 64.0f); float q = 0.f;
#pragma unroll
            for (int n = 0; n < 4; ++n) { const f32x4 d = yv[n] - mean; q += (d[0] * d[0] + d[1] * d[1]) + (d[2] * d[2] + d[3] * d[3]); }
            q += __shfl_xor(q, 16); q += __shfl_xor(q, 32);
            const float rstd = rsqrtf(q * (1.0f / 64.0f) + 64e-5f);
            const float bs = bsc[row * 16 + head];
#pragma unroll
            for (int n = 0; n < 4; ++n) { const int col = head * 64 + n * 16 + L.fq * 4;
                const f32x4 lw = *(const f32x4*)(W.ln_w + col), lb = *(const f32x4*)(W.ln_b + col), vv = ld_bf4(vb + row * DM + col);
                f32x4 o = ((yv[n] - mean) * rstd * lw + lb + vv * bs);
                o = o * acc[m][n];
                st_bf4(outb + row * DM + col, o); }
        }
    }
}

struct NsaBuf { bf16_t *q, *kcmp, *vcmp, *kslc, *kwin, *vslcT, *vwinT, *hid, *kc, *vcT, *o; float* gates; };
DEV void phase_n1(const bf16_t* xn, const bf16_t* Bt, const NsaBuf& B, char* smem) {
    const LaneId L = lane_id();
    const int ntn = 15, nunits = (T / 256) * ntn;
    for (int u = blockIdx.x; u < nunits; u += gridDim.x) {
        const int tm = u / ntn, tn = u % ntn;
        f32x4 acc[4][4];
        gemm_core(acc, LdPlain{xn + (size_t)tm * 256 * DM, DM}, LdPlain{Bt + (size_t)tn * 128 * DM, DM}, DM, smem);
#pragma unroll
        for (int m = 0; m < 4; ++m)
#pragma unroll
            for (int n = 0; n < 4; ++n) {
                const size_t row = (size_t)tm * 256 + L.wm * 64 + m * 16 + L.fr; const int c = L.wn * 64 + n * 16 + L.fq * 4; f32x4 v = acc[m][n];
                if (tn < 8) st_bf4(B.q + row * DM + tn * 128 + c, v * 0.125f);
                else if (tn < 14) {
                    const int cc = tn - 8;
                    if (cc == 0) st_bf4(B.kcmp + row * 128 + c, v);
                    else if (cc == 1) st_bf4(B.vcmp + row * 128 + c, v);
                    else if (cc == 2) st_bf4(B.kslc + row * 128 + c, v);
                    else if (cc == 4) st_bf4(B.kwin + row * 128 + c, v);
                    else { bf16_t* dst = cc == 3 ? B.vslcT : B.vwinT; const int b = (int)(row >> 13), t = (int)(row & (SEQ - 1));
                        for (int j = 0; j < 4; ++j) dst[((size_t)(b * 128 + c + j)) * SEQ + t] = f2bf(v[j]); }
                } else { if (c < 48) { for (int j = 0; j < 4; ++j) B.gates[row * 48 + c + j] = sigmoidf_(v[j]); } }
            }
    }
}
DEV float gelu_tanh(float x) { const float u = 0.7978845608028654f * (x + 0.044715f * x * x * x); return 0.5f * x * (1.0f + tanhf(u)); }
DEV void phase_n2a(const bf16_t* W1T, const float* biasp, const NsaBuf& B, char* smem) {
    const LaneId L = lane_id();
    for (int u = blockIdx.x; u < 64; u += gridDim.x) {
        const int c = u >> 5, tm = (u >> 1) & 15, tn = u & 1;
        f32x4 acc[4][4];
        gemm_core(acc, LdCmp{c ? B.vcmp : B.kcmp, tm * 256}, LdPlain{W1T + (size_t)c * 256 * 2048 + (size_t)tn * 128 * 2048, 2048}, 2048, smem);
#pragma unroll
        for (int m = 0; m < 4; ++m)
#pragma unroll
            for (int n = 0; n < 4; ++n) { const size_t row = (size_t)tm * 256 + L.wm * 64 + m * 16 + L.fr; const int col = tn * 128 + L.wn * 64 + n * 16 + L.fq * 4;
                const f32x4 bb = *(const f32x4*)(biasp + c * 256 + col); f32x4 v;
                for (int j = 0; j < 4; ++j) v[j] = gelu_tanh(acc[m][n][j] + bb[j]);
                st_bf4(B.hid + ((size_t)c * 4096 + row) * 256 + col, v); }
    }
}
DEV void phase_n2b(const bf16_t* W2T, const NsaBuf& B, char* smem) {
    const LaneId L = lane_id();
    for (int u = blockIdx.x; u < 32; u += gridDim.x) {
        const int c = u >> 4, tm = u & 15;
        f32x4 acc[4][4];
        gemm_core(acc, LdPlain{B.hid + ((size_t)c * 4096 + tm * 256) * 256, 256}, LdPlain{W2T + (size_t)c * 128 * 256, 256}, 256, smem);
        if (L.wn == 0) {
#pragma unroll
            for (int m = 0; m < 4; ++m)
#pragma unroll
                for (int n = 0; n < 4; ++n) { const int row = tm * 256 + L.wm * 64 + m * 16 + L.fr, d = n * 16 + L.fq * 4;
                    const int b = row >> 10, nn = (row >> 1) & 511, g = row & 1;
                    if (c == 0) st_bf4(B.kc + ((size_t)((b * 2 + g) * 512 + nn)) * 64 + d, acc[m][n]);
                    else { for (int j = 0; j < 4; ++j) B.vcT[((size_t)((b * 2 + g) * 64 + d + j)) * 512 + nn] = f2bf(acc[m][n][j]); } }
        }
    }
}
#define NEGV (-1e30f)
#define LOG2E_ 1.4426950408889634f
DEV u32x4 n3_ldg(const bf16_t* kbase, long kpitch, const bf16_t* vbase, long vpitch, int kb, int tid) {
    if (tid < 256) return *(const u32x4*)(kbase + (size_t)(kb + (tid >> 3)) * kpitch + (tid & 7) * 8);
    const int i = tid - 256; return *(const u32x4*)(vbase + (size_t)(i >> 2) * vpitch + kb + (i & 3) * 8);
}
DEV void n3_sts(char* buf, u32x4 v, int tid) {
    if (tid < 256) { const int row = tid >> 3, c = tid & 7, sw = ((row >> 1) & 1) | (((row >> 3) & 3) << 1); *(u32x4*)(buf + row * 128 + ((c ^ sw) << 4)) = v; }
    else { const int i = tid - 256, d = i >> 2, c = i & 3; *(u32x4*)(buf + 4096 + d * 64 + ((c ^ ((d >> 2) & 3)) << 4)) = v; }
}
DEV void phase_n3(const NsaBuf& B, char* smem) {
    const int tid = tidx(), lane = tid & 63, wid = tid >> 6, m = lane & 15, fq = lane >> 4, qh = m >> 3, hh = m & 7;
    float* psum = (float*)(smem + wid * 8704); int* ulist = (int*)(smem + wid * 8704 + 8192);
    char* stg = smem + 8 * 8704;
    const int kperm = 8 * (m >> 2) + (m & 3);
    const int kswz = ((m >> 1) & 1) | ((m >> 2) << 1), vswz = (m >> 2) & 3;
    const int koffA = kperm * 128, koffB = (kperm + 4) * 128, voff = 4096 + m * 64 + ((fq ^ vswz) << 4);
    const f32x4 z4 = {0.f, 0.f, 0.f, 0.f};
    const int nrank = (int)gridDim.x >> 3, bg = (int)blockIdx.x & 7;
    for (int qblk = (int)blockIdx.x >> 3; qblk < 256 && (int)blockIdx.x < nrank * 8; qblk += nrank) {
        const int g = bg & 1, b = bg >> 1, t0b = qblk * 32, t0 = t0b + wid * 4;
        int tq[2]; bf16x8 qf[2][2]; float gc[2], gs[2], gw[2]; u32x2 opk[2][4];
#pragma unroll
        for (int rb = 0; rb < 2; ++rb) {
            tq[rb] = t0 + rb * 2 + qh;
            const bf16_t* qp = B.q + ((size_t)(b * SEQ + tq[rb])) * DM + (g * 8 + hh) * 64 + fq * 8;
            qf[rb][0] = __builtin_nontemporal_load((const bf16x8*)qp); qf[rb][1] = __builtin_nontemporal_load((const bf16x8*)(qp + 32));
            const float* gp = B.gates + ((size_t)(b * SEQ + tq[rb])) * 48 + g * 24 + hh * 3;
            gc[rb] = gp[0]; gs[rb] = gp[1]; gw[rb] = gp[2];
        }
#define N3_KFRAGS(buf) const bf16x8 kA0 = *(const bf16x8*)((buf) + koffA + (((0 + fq) ^ kswz) << 4)), kA1 = *(const bf16x8*)((buf) + koffA + (((4 + fq) ^ kswz) << 4)), \
                                    kB0 = *(const bf16x8*)((buf) + koffB + (((0 + fq) ^ kswz) << 4)), kB1 = *(const bf16x8*)((buf) + koffB + (((4 + fq) ^ kswz) << 4));
        {
            const int tid = tidx(), lane = tid & 63, m = lane & 15, fq = (lane >> 4), qh = m >> 3, hh = m & 7, kperm = 8 * (m >> 2) + (m & 3); (void)hh; (void)qh; (void)lane;
            const int kswz = ((m >> 1) & 1) | ((m >> 2) << 1), vswz = (m >> 2) & 3, koffA = kperm * 128, koffB = (kperm + 4) * 128, voff = 4096 + m * 64 + ((fq ^ vswz) << 4);
            int nv[2];
#pragma unroll
            for (int rb = 0; rb < 2; ++rb) nv[rb] = tq[rb] >= 31 ? ((tq[rb] - 31) >> 4) + 1 : 0;
            const int nvmax = (t0b + 31 >= 31) ? ((t0b + 31 - 31) >> 4) + 1 : 0, ngrp = (nvmax + 31) >> 5;
#pragma unroll
            for (int i = 0; i < 32; ++i) psum[lane + 64 * i] = 0.f;
            const bf16_t* kcb = B.kc + (size_t)((b * 2 + g) * 512) * 64; const bf16_t* vcb = B.vcT + (size_t)((b * 2 + g) * 64) * 512;
            float mx[2] = {NEGV, NEGV}, l[2] = {0.f, 0.f};
            u32x4 stv;
            if (ngrp > 0) { stv = n3_ldg(kcb, 64, vcb, 512, 0, tid); n3_sts(stg, stv, tid); }
            __syncthreads();
            for (int grp = 0; grp < ngrp; ++grp) {
                const int kb = grp * 32; const bool more = grp + 1 < ngrp;
                if (more) stv = n3_ldg(kcb, 64, vcb, 512, kb + 32, tid);
                const char* buf = stg + (grp & 1) * 8192;
                N3_KFRAGS(buf)
#pragma unroll
                for (int rb = 0; rb < 2; ++rb) {
                    f32x4 sA = MFMA(kA0, qf[rb][0], z4); sA = MFMA(kA1, qf[rb][1], sA);
                    f32x4 sB = MFMA(kB0, qf[rb][0], z4); sB = MFMA(kB1, qf[rb][1], sB);
                    const bool full = kb + 32 <= nv[rb], part = !full && kb < nv[rb];
                    if (__ballot(part) == 0ull) {
                        const float m8 = fmaxf(fmaxf(fmaxf(sA[0], sA[1]), fmaxf(sA[2], sA[3])), fmaxf(fmaxf(sB[0], sB[1]), fmaxf(sB[2], sB[3])));
                        const float mn = fmaxf(mx[rb], full ? m8 : NEGV), tl = (full ? mn : 1e30f) * LOG2E_; float add = 0.f;
#pragma unroll
                        for (int j = 0; j < 4; ++j) add += __builtin_amdgcn_exp2f(fmaf(sA[j], LOG2E_, -tl)) + __builtin_amdgcn_exp2f(fmaf(sB[j], LOG2E_, -tl));
                        l[rb] = l[rb] * __expf(mx[rb] - mn) + add; mx[rb] = mn;
                    } else {
                    float gm = NEGV;
#pragma unroll
                    for (int j = 0; j < 4; ++j) { if (kb + 8 * fq + j < nv[rb]) gm = fmaxf(gm, sA[j]); if (kb + 8 * fq + 4 + j < nv[rb]) gm = fmaxf(gm, sB[j]); }
                    const float mn = fmaxf(mx[rb], gm); float add = 0.f;
#pragma unroll
                    for (int j = 0; j < 4; ++j) { if (kb + 8 * fq + j < nv[rb]) add += __expf(sA[j] - mn); if (kb + 8 * fq + 4 + j < nv[rb]) add += __expf(sB[j] - mn); }
                    l[rb] = l[rb] * __expf(mx[rb] - mn) + add; mx[rb] = mn;
                    }
                }
                if (more) n3_sts(stg + ((grp + 1) & 1) * 8192, stv, tid);
                __syncthreads();
            }
            float M[2], inv[2];
#pragma unroll
            for (int rb = 0; rb < 2; ++rb) {
                float Mx = fmaxf(mx[rb], __shfl_xor(mx[rb], 16)); Mx = fmaxf(Mx, __shfl_xor(Mx, 32));
                float ll = l[rb] * __expf(mx[rb] - Mx); ll += __shfl_xor(ll, 16); ll += __shfl_xor(ll, 32);
                M[rb] = Mx; inv[rb] = ll > 0.f ? 1.0f / ll : 0.f;
            }
            f32x4 oc[2][4];
#pragma unroll
            for (int rb = 0; rb < 2; ++rb)
#pragma unroll
                for (int d = 0; d < 4; ++d) oc[rb][d] = z4;
            if (ngrp > 0) { stv = n3_ldg(kcb, 64, vcb, 512, 0, tid); n3_sts(stg, stv, tid); }
            __syncthreads();
            for (int grp = 0; grp < ngrp; ++grp) {
                const int kb = grp * 32; const bool more = grp + 1 < ngrp;
                if (more) stv = n3_ldg(kcb, 64, vcb, 512, kb + 32, tid);
                const char* buf = stg + (grp & 1) * 8192;
                N3_KFRAGS(buf)
                bf16x8 vf[4];
#pragma unroll
                for (int d = 0; d < 4; ++d) vf[d] = *(const bf16x8*)(buf + voff + d * 1024);
#pragma unroll
                for (int rb = 0; rb < 2; ++rb) {
                    f32x4 sA = MFMA(kA0, qf[rb][0], z4); sA = MFMA(kA1, qf[rb][1], sA);
                    f32x4 sB = MFMA(kB0, qf[rb][0], z4); sB = MFMA(kB1, qf[rb][1], sB);
                    f32x4 pA, pB;
                    const bool full = kb + 32 <= nv[rb], part = !full && kb < nv[rb];
                    if (__ballot(part) == 0ull) {
                        const float tl = (full ? M[rb] : 1e30f) * LOG2E_;
#pragma unroll
                        for (int j = 0; j < 4; ++j) { pA[j] = __builtin_amdgcn_exp2f(fmaf(sA[j], LOG2E_, -tl)) * inv[rb]; pB[j] = __builtin_amdgcn_exp2f(fmaf(sB[j], LOG2E_, -tl)) * inv[rb]; }
                    } else {
#pragma unroll
                    for (int j = 0; j < 4; ++j) { pA[j] = (kb + 8 * fq + j < nv[rb]) ? __expf(sA[j] - M[rb]) * inv[rb] : 0.f; pB[j] = (kb + 8 * fq + 4 + j < nv[rb]) ? __expf(sB[j] - M[rb]) * inv[rb] : 0.f; }
                    }
#pragma unroll
                    for (int j = 0; j < 4; ++j) {
                        float a = pA[j]; a += DPP_MOV(a, 0xB1); a += DPP_MOV(a, 0x4E); a += DPP_MOV(a, 0x141);
                        float c = pB[j]; c += DPP_MOV(c, 0xB1); c += DPP_MOV(c, 0x4E); c += DPP_MOV(c, 0x141);
                        if (hh == 0) { psum[(rb * 2 + qh) * 512 + kb + 8 * fq + j] = a; psum[(rb * 2 + qh) * 512 + kb + 8 * fq + 4 + j] = c; }
                    }
                    const bf16x8 pf = pack8(pA, pB);
#pragma unroll
                    for (int d = 0; d < 4; ++d) oc[rb][d] = MFMA(vf[d], pf, oc[rb][d]);
                }
                if (more) n3_sts(stg + ((grp + 1) & 1) * 8192, stv, tid);
                __syncthreads();
            }
#pragma unroll
            for (int rb = 0; rb < 2; ++rb)
#pragma unroll
                for (int d = 0; d < 4; ++d) { const f32x4 v = oc[rb][d] * gc[rb]; opk[rb][d].x = cvt_pk(v[0], v[1]); opk[rb][d].y = cvt_pk(v[2], v[3]); }
        }
        asm volatile("s_waitcnt lgkmcnt(0)" ::: "memory");
        __builtin_amdgcn_sched_barrier(0);
        unsigned long long mlo[4], mhi[4];
#pragma unroll
        for (int q2 = 0; q2 < 4; ++q2) {
            const int tqq = t0 + q2, cur = tqq >> 6;
            float sc[2];
#pragma unroll
            for (int c = 0; c < 2; ++c) { const int j = lane + 64 * c; float imp = 0.f;
                for (int n = 4 * j - 1; n <= 4 * j + 3; ++n) if (n >= 0) imp += psum[q2 * 512 + n];
                const bool causal = j * 64 <= tqq, forced = (j == 0) || (j == cur) || (j == cur - 1);
                sc[c] = causal ? imp + (forced ? 1e4f : 0.f) : NEGV; }
            unsigned k0 = __float_as_uint(sc[0]), k1 = __float_as_uint(sc[1]);
            k0 = (k0 & 0x80000000u) ? ~k0 : (k0 | 0x80000000u); k1 = (k1 & 0x80000000u) ? ~k1 : (k1 | 0x80000000u);
            unsigned Tk = 0u;
            for (int bit = 31; bit >= 0; --bit) { const unsigned cand = Tk | (1u << bit);
                const int cnt = __popcll(__ballot(k0 >= cand)) + __popcll(__ballot(k1 >= cand)); if (cnt >= 16) Tk = cand; }
            const int ngt = __popcll(__ballot(k0 > Tk)) + __popcll(__ballot(k1 > Tk)), needn = 16 - ngt;
            const unsigned long long eq0 = __ballot(k0 == Tk), eq1 = __ballot(k1 == Tk), belowm = (1ull << lane) - 1ull;
            const bool s0 = (k0 > Tk) || (k0 == Tk && __popcll(eq0 & belowm) < needn);
            const bool s1 = (k1 > Tk) || (k1 == Tk && __popcll(eq0) + __popcll(eq1 & belowm) < needn);
            mlo[q2] = __ballot(s0); mhi[q2] = __ballot(s1);
        }
        int nun;
        {
            const unsigned long long ulo = mlo[0] | mlo[1] | mlo[2] | mlo[3], uhi = mhi[0] | mhi[1] | mhi[2] | mhi[3];
            const unsigned long long below = (1ull << lane) - 1ull; const int nlo = __popcll(ulo);
            if ((ulo >> lane) & 1ull) { const int mb = (int)((mlo[0] >> lane) & 1ull) | ((int)((mlo[1] >> lane) & 1ull) << 1) | ((int)((mlo[2] >> lane) & 1ull) << 2) | ((int)((mlo[3] >> lane) & 1ull) << 3);
                ulist[__popcll(ulo & below)] = lane | (mb << 8); }
            if ((uhi >> lane) & 1ull) { const int mb = (int)((mhi[0] >> lane) & 1ull) | ((int)((mhi[1] >> lane) & 1ull) << 1) | ((int)((mhi[2] >> lane) & 1ull) << 2) | ((int)((mhi[3] >> lane) & 1ull) << 3);
                ulist[nlo + __popcll(uhi & below)] = (lane + 64) | (mb << 8); }
            nun = nlo + __popcll(uhi);
        }
        asm volatile("s_waitcnt lgkmcnt(0)" ::: "memory");
        __builtin_amdgcn_sched_barrier(0);
        {
            const int tid = tidx(), lane = tid & 63, m = lane & 15, fq = (lane >> 4), qh = m >> 3, hh = m & 7, kperm = 8 * (m >> 2) + (m & 3); (void)hh; (void)qh; (void)lane;
            const unsigned char* ksb = (const unsigned char*)B.kslc + (size_t)((b * 2 + g) * SEQ) * 64 + fq * 8; const unsigned char* vsb = (const unsigned char*)B.vslcT + (size_t)((b * 2 + g) * 128) * 4096 + m * 64 + 8 * fq;
            long q8[2][2];
#pragma unroll
            for (int rb = 0; rb < 2; ++rb)
#pragma unroll
                for (int ks = 0; ks < 2; ++ks) { const u32x4 w = __builtin_bit_cast(u32x4, qf[rb][ks]);
                    const unsigned lo = pack_fp8x4(bf_lo(w.x), bf_hi(w.x), bf_lo(w.y), bf_hi(w.y)), hi = pack_fp8x4(bf_lo(w.z), bf_hi(w.z), bf_lo(w.w), bf_hi(w.w));
                    q8[rb][ks] = (long)(((unsigned long long)hi << 32) | lo); }
            float mx[2] = {NEGV, NEGV}, l[2] = {0.f, 0.f}; f32x4 os[2][4];
#pragma unroll
            for (int rb = 0; rb < 2; ++rb)
#pragma unroll
                for (int d = 0; d < 4; ++d) os[rb][d] = z4;
            char* st8 = (char*)psum;
            const int srow = lane >> 2, sc0 = (lane & 3) * 2;
            u32x4 gk[4], gv[4];
            { const int blk0 = ulist[0] & 255; const unsigned char* kp = (const unsigned char*)B.kslc + ((size_t)((b * 2 + g) * SEQ) + blk0 * 64) * 64 + lane * 16; const unsigned char* vp = (const unsigned char*)B.vslcT + ((size_t)((b * 2 + g) * 128) + blk0) * 4096 + lane * 16;
#pragma unroll
              for (int i = 0; i < 4; ++i) { gk[i] = *(const u32x4*)(kp + i * 1024); gv[i] = *(const u32x4*)(vp + i * 1024); } }
            const int fsw = (m >> 2) << 1;
            for (int ib = 0; ib < nun; ++ib) {
                const int e = __builtin_amdgcn_readfirstlane(ulist[ib]);
#pragma unroll
                for (int i = 0; i < 4; ++i) { const int row = i * 16 + srow;
                    *(u32x4*)(st8 + row * 64 + ((sc0 ^ (((row >> 3) & 3) << 1)) << 3)) = gk[i];
                    *(u32x4*)(st8 + 4096 + row * 64 + ((sc0 ^ (((row >> 2) & 3) << 1)) << 3)) = gv[i]; }
                if (ib + 1 < nun) { const int blkn = ulist[ib + 1] & 255; const unsigned char* kp = (const unsigned char*)B.kslc + ((size_t)((b * 2 + g) * SEQ) + blkn * 64) * 64 + lane * 16; const unsigned char* vp = (const unsigned char*)B.vslcT + ((size_t)((b * 2 + g) * 128) + blkn) * 4096 + lane * 16;
#pragma unroll
                    for (int i = 0; i < 4; ++i) { gk[i] = *(const u32x4*)(kp + i * 1024); gv[i] = *(const u32x4*)(vp + i * 1024); } }
#pragma unroll
              for (int hf = 0; hf < 2; ++hf) {
                const int kb = (e & 255) * 64 + hf * 32;
                const char* kr = st8 + (hf * 32 + kperm) * 64;
                const long kA0 = *(const long*)(kr + ((fq ^ fsw) << 3)), kA1 = *(const long*)(kr + (((4 + fq) ^ fsw) << 3)), kB0 = *(const long*)(kr + 256 + ((fq ^ fsw) << 3)), kB1 = *(const long*)(kr + 256 + (((4 + fq) ^ fsw) << 3));
                long vf[4];
#pragma unroll
                for (int d = 0; d < 4; ++d) vf[d] = *(const long*)(st8 + 4096 + (d * 16 + m) * 64 + (((hf * 4 + fq) ^ fsw) << 3));
#pragma unroll
                for (int rb = 0; rb < 2; ++rb) {
                    if (((e >> (8 + rb * 2)) & 3) == 0) continue;
                    const bool mine = ((e >> (8 + rb * 2 + qh)) & 1) != 0;
                    f32x4 sA = MFMA8(kA0, q8[rb][0], z4); sA = MFMA8(kA1, q8[rb][1], sA);
                    f32x4 sB = MFMA8(kB0, q8[rb][0], z4); sB = MFMA8(kB1, q8[rb][1], sB);
                    const bool full = mine && kb + 31 <= tq[rb], part = mine && !full && kb <= tq[rb];
                    const bool fast = __ballot(part) == 0ull;
                    float gm = NEGV;
                    if (fast) { const float m8 = fmaxf(fmaxf(fmaxf(sA[0], sA[1]), fmaxf(sA[2], sA[3])), fmaxf(fmaxf(sB[0], sB[1]), fmaxf(sB[2], sB[3]))); gm = full ? m8 : NEGV; }
                    else {
#pragma unroll
                    for (int j = 0; j < 4; ++j) { if (mine && kb + 8 * fq + j <= tq[rb]) gm = fmaxf(gm, sA[j]); if (mine && kb + 8 * fq + 4 + j <= tq[rb]) gm = fmaxf(gm, sB[j]); }
                    }
                    if (__ballot(gm > mx[rb]) != 0ull) {
                        gm = fmaxf(gm, __shfl_xor(gm, 16)); gm = fmaxf(gm, __shfl_xor(gm, 32));
                        const float mn2 = fmaxf(mx[rb], gm), alpha = __expf(mx[rb] - mn2); mx[rb] = mn2; l[rb] *= alpha;
#pragma unroll
                        for (int d = 0; d < 4; ++d) os[rb][d] *= alpha;
                    }
                    const float mn = mx[rb];
                    f32x4 pA, pB; float add = 0.f;
                    if (fast) { const float tl = (full ? mn : 1e30f) * LOG2E_ - 7.f;
#pragma unroll
                        for (int j = 0; j < 4; ++j) { pA[j] = __builtin_amdgcn_exp2f(fmaf(sA[j], LOG2E_, -tl)); pB[j] = __builtin_amdgcn_exp2f(fmaf(sB[j], LOG2E_, -tl)); add += pA[j] + pB[j]; }
                    } else {
#pragma unroll
                    for (int j = 0; j < 4; ++j) { pA[j] = (mine && kb + 8 * fq + j <= tq[rb]) ? __expf(sA[j] - mn + 4.8520302639f) : 0.f; pB[j] = (mine && kb + 8 * fq + 4 + j <= tq[rb]) ? __expf(sB[j] - mn + 4.8520302639f) : 0.f; add += pA[j] + pB[j]; }
                    }
                    l[rb] += add;
                    const unsigned plo = pack_fp8x4(pA[0], pA[1], pA[2], pA[3]), phi = pack_fp8x4(pB[0], pB[1], pB[2], pB[3]);
                    const long pf = (long)(((unsigned long long)phi << 32) | plo);
#pragma unroll
                    for (int d = 0; d < 4; ++d) os[rb][d] = MFMA8(vf[d], pf, os[rb][d]);
                }
              }
            }
#pragma unroll
            for (int rb = 0; rb < 2; ++rb) {
                float ll = l[rb]; ll += __shfl_xor(ll, 16); ll += __shfl_xor(ll, 32);
                const float sc = ll > 0.f ? gs[rb] / ll : 0.f;
#pragma unroll
                for (int d = 0; d < 4; ++d) { f32x4 v = os[rb][d] * sc; v[0] += bf_lo(opk[rb][d].x); v[1] += bf_hi(opk[rb][d].x); v[2] += bf_lo(opk[rb][d].y); v[3] += bf_hi(opk[rb][d].y);
                    opk[rb][d].x = cvt_pk(v[0], v[1]); opk[rb][d].y = cvt_pk(v[2], v[3]); }
            }
        }
        __builtin_amdgcn_sched_barrier(0);
        {
            const int tid = tidx(), lane = tid & 63, m = lane & 15, fq = (lane >> 4), qh = m >> 3, hh = m & 7, kperm = 8 * (m >> 2) + (m & 3); (void)hh; (void)qh; (void)lane;
            const int kswz = ((m >> 1) & 1) | ((m >> 2) << 1), vswz = (m >> 2) & 3, koffA = kperm * 128, koffB = (kperm + 4) * 128, voff = 4096 + m * 64 + ((fq ^ vswz) << 4);
            const bf16_t* kwb = B.kwin + (size_t)b * SEQ * 128 + g * 64; const bf16_t* vwb = B.vwinT + (size_t)((b * 2 + g) * 64) * SEQ;
            float mx[2] = {NEGV, NEGV}, l[2] = {0.f, 0.f}; f32x4 ow[2][4];
#pragma unroll
            for (int rb = 0; rb < 2; ++rb)
#pragma unroll
                for (int d = 0; d < 4; ++d) ow[rb][d] = z4;
            const int lo = t0b - 511 > 0 ? t0b - 511 : 0, kb0 = lo & ~31, kbl = t0b + 31;
            u32x4 stv = n3_ldg(kwb, 128, vwb, SEQ, kb0, tid); n3_sts(stg, stv, tid);
            __syncthreads();
            int gi = 0;
            for (int kb = kb0; kb <= kbl; kb += 32, ++gi) {
                const bool more = kb + 32 <= kbl;
                if (more) stv = n3_ldg(kwb, 128, vwb, SEQ, kb + 32, tid);
                const char* buf = stg + (gi & 1) * 8192;
                if (kb <= t0 + 3 && kb + 31 > t0 - 512) {
                    N3_KFRAGS(buf)
                    bf16x8 vf[4];
#pragma unroll
                    for (int d = 0; d < 4; ++d) vf[d] = *(const bf16x8*)(buf + voff + d * 1024);
#pragma unroll
                    for (int rb = 0; rb < 2; ++rb) {
                        f32x4 sA = MFMA(kA0, qf[rb][0], z4); sA = MFMA(kA1, qf[rb][1], sA);
                        f32x4 sB = MFMA(kB0, qf[rb][0], z4); sB = MFMA(kB1, qf[rb][1], sB);
                        const bool full = kb + 31 <= tq[rb] && kb > tq[rb] - 512, part = !full && kb <= tq[rb] && kb + 31 > tq[rb] - 512;
                        const bool fast = __ballot(part) == 0ull;
                        float gm = NEGV;
                        if (fast) { const float m8 = fmaxf(fmaxf(fmaxf(sA[0], sA[1]), fmaxf(sA[2], sA[3])), fmaxf(fmaxf(sB[0], sB[1]), fmaxf(sB[2], sB[3]))); gm = full ? m8 : NEGV; }
                        else {
#pragma unroll
                        for (int j = 0; j < 4; ++j) { const int pa = kb + 8 * fq + j, pb = pa + 4; if (pa <= tq[rb] && pa > tq[rb] - 512) gm = fmaxf(gm, sA[j]); if (pb <= tq[rb] && pb > tq[rb] - 512) gm = fmaxf(gm, sB[j]); }
                        }
                        if (__ballot(gm > mx[rb] + 40.f) != 0ull) {
                            gm = fmaxf(gm, __shfl_xor(gm, 16)); gm = fmaxf(gm, __shfl_xor(gm, 32));
                            const float mn2 = fmaxf(mx[rb], gm), alpha = __expf(mx[rb] - mn2); mx[rb] = mn2; l[rb] *= alpha;
#pragma unroll
                            for (int d = 0; d < 4; ++d) ow[rb][d] *= alpha;
                        }
                        const float mn = mx[rb];
                        f32x4 pA, pB; float add = 0.f;
                        if (fast) { const float tl = (full ? mn : 1e30f) * LOG2E_;
#pragma unroll
                            for (int j = 0; j < 4; ++j) { pA[j] = __builtin_amdgcn_exp2f(fmaf(sA[j], LOG2E_, -tl)); pB[j] = __builtin_amdgcn_exp2f(fmaf(sB[j], LOG2E_, -tl)); add += pA[j] + pB[j]; }
                        } else {
#pragma unroll
                        for (int j = 0; j < 4; ++j) { const int pa = kb + 8 * fq + j, pb = pa + 4; const bool va = pa <= tq[rb] && pa > tq[rb] - 512, vb = pb <= tq[rb] && pb > tq[rb] - 512;
                            pA[j] = va ? __expf(sA[j] - mn) : 0.f; pB[j] = vb ? __expf(sB[j] - mn) : 0.f; add += pA[j] + pB[j]; }
                        }
                        l[rb] += add;
                        const bf16x8 pf = pack8(pA, pB);
#pragma unroll
                        for (int d = 0; d < 4; ++d) ow[rb][d] = MFMA(vf[d], pf, ow[rb][d]);
                    }
                }
                if (more) n3_sts(stg + ((gi + 1) & 1) * 8192, stv, tid);
                __syncthreads();
            }
#pragma unroll
            for (int rb = 0; rb < 2; ++rb) {
                float ll = l[rb]; ll += __shfl_xor(ll, 16); ll += __shfl_xor(ll, 32);
                const float sc = ll > 0.f ? gw[rb] / ll : 0.f;
#pragma unroll
                for (int d = 0; d < 4; ++d) { f32x4 v = ow[rb][d] * sc; v[0] += bf_lo(opk[rb][d].x); v[1] += bf_hi(opk[rb][d].x); v[2] += bf_lo(opk[rb][d].y); v[3] += bf_hi(opk[rb][d].y);
                    opk[rb][d].x = cvt_pk(v[0], v[1]); opk[rb][d].y = cvt_pk(v[2], v[3]); }
            }
        }
#undef N3_KFRAGS
#pragma unroll
        for (int rb = 0; rb < 2; ++rb) {
            bf16_t* op = B.o + ((size_t)(b * SEQ + tq[rb])) * DM + (g * 8 + hh) * 64 + fq * 4;
#pragma unroll
            for (int d = 0; d < 4; ++d) __builtin_nontemporal_store(opk[rb][d], (u32x2*)(op + d * 16));
        }
    }
}

struct GlaBuf { bf16_t *qe, *ke, *vT, *r, *o, *kdT, *ab; float *adn, *dec; };
DEV void phase_l1(const bf16_t* xn, const bf16_t* Bt, const GlaBuf& B, char* smem) {
    const LaneId L = lane_id();
    const int ntn = 25, nunits = (T / 256) * ntn;
    for (int u = blockIdx.x; u < nunits; u += gridDim.x) {
        const int tm = u / ntn, tn = u % ntn;
        f32x4 acc[4][4];
        gemm_core(acc, LdPlain{xn + (size_t)tm * 256 * DM, DM}, LdPlain{Bt + (size_t)tn * 128 * DM, DM}, DM, smem);
#pragma unroll
        for (int m = 0; m < 4; ++m)
#pragma unroll
            for (int n = 0; n < 4; ++n) {
                const size_t row = (size_t)tm * 256 + L.wm * 64 + m * 16 + L.fr; const int c = L.wn * 64 + n * 16 + L.fq * 4; const f32x4 v = acc[m][n];
                if (tn < 4) st_bf4(B.qe + row * 512 + tn * 128 + c, v * 0.08838834764831845f);
                else if (tn < 8) st_bf4(B.ke + row * 512 + (tn - 4) * 128 + c, v);
                else if (tn < 16) { const int b = (int)(row >> 13), t = (int)(row & (SEQ - 1)), vc = (tn - 8) * 128 + c;
                    for (int j = 0; j < 4; ++j) B.vT[((size_t)(b * 1024 + vc + j)) * SEQ + t] = f2bf(v[j]); }
                else if (tn < 24) st_bf4(B.r + row * DM + (tn - 16) * 128 + c, v);
                else { if (c < 16) *(f32x4*)(B.adn + row * 16 + c) = v; }
            }
    }
}
DEV void phase_l2a(const float* a_up, const float* a_bias, const GlaBuf& B) {
    const int gt = blockIdx.x * NTHR + tidx(), nt = gridDim.x * NTHR;
    for (int idx = gt; idx < NBATCH * 128 * 512; idx += nt) {
        const int c = idx & 511, n = (idx >> 9) & 127, b = idx >> 16, h = c >> 7, d = c & 127;
        float au[16];
#pragma unroll
        for (int r = 0; r < 16; ++r) au[r] = a_up[r * 512 + c];
        const float ab = a_bias[c];
        const size_t row0 = (size_t)b * SEQ + n * 64;
        float blast = 0.f;
#pragma unroll 4
        for (int t = 0; t < 64; ++t) {
            const float* ad = B.adn + (row0 + t) * 16; float x = ab;
#pragma unroll
            for (int r4 = 0; r4 < 4; ++r4) { const f32x4 a = *(const f32x4*)(ad + r4 * 4); x += a[0] * au[r4 * 4] + a[1] * au[r4 * 4 + 1] + a[2] * au[r4 * 4 + 2] + a[3] * au[r4 * 4 + 3]; }
            blast += -(fmaxf(-x, 0.f) + log1pf(__expf(-fabsf(x)))) * (1.0f / 16.0f);
        }
        float bcum = 0.f;
        bf16_t* kd = B.kdT + (((size_t)(b * 128 + n) * 4 + h) * 128 + d) * 64;
#pragma unroll 1
        for (int t8 = 0; t8 < 8; ++t8) {
            float kdv[8];
#pragma unroll
            for (int tt = 0; tt < 8; ++tt) {
                const int t = t8 * 8 + tt;
                const float* ad = B.adn + (row0 + t) * 16; float x = ab;
#pragma unroll
                for (int r4 = 0; r4 < 4; ++r4) { const f32x4 a = *(const f32x4*)(ad + r4 * 4); x += a[0] * au[r4 * 4] + a[1] * au[r4 * 4 + 1] + a[2] * au[r4 * 4 + 2] + a[3] * au[r4 * 4 + 3]; }
                bcum += -(fmaxf(-x, 0.f) + log1pf(__expf(-fabsf(x)))) * (1.0f / 16.0f);
                const float q = bf2f(B.qe[(row0 + t) * 512 + c]), k = bf2f(B.ke[(row0 + t) * 512 + c]);
                B.qe[(row0 + t) * 512 + c] = f2bf(q * __expf(bcum)); B.ke[(row0 + t) * 512 + c] = f2bf(k * __expf(-bcum));
                kdv[tt] = k * __expf(blast - bcum);
            }
            u32x4 w; w.x = cvt_pk(kdv[0], kdv[1]); w.y = cvt_pk(kdv[2], kdv[3]); w.z = cvt_pk(kdv[4], kdv[5]); w.w = cvt_pk(kdv[6], kdv[7]);
            *(u32x4*)(kd + t8 * 8) = w;
        }
        B.dec[((size_t)(b * 128 + n) * 4 + h) * 128 + d] = __expf(blast);
    }
}
DEV void phase_l2b(const GlaBuf& B) {
    const int lane = tidx() & 63, wid = tidx() >> 6, m = lane & 15, fq = lane >> 4;
    const int kperm = 8 * (m >> 2) + (m & 3);
    const f32x4 z4 = {0.f, 0.f, 0.f, 0.f};
    for (int task = blockIdx.x * 8 + wid; task < NBATCH * 128 * 4 * 4; task += gridDim.x * 8) {
        const int mb = task & 3, h = (task >> 2) & 3, n = (task >> 4) & 127, b = task >> 11;
        const size_t row0 = (size_t)b * SEQ + n * 64; const int i = mb * 16 + m;
        bf16x8 qf[4];
#pragma unroll
        for (int ks = 0; ks < 4; ++ks) qf[ks] = *(const bf16x8*)(B.qe + (row0 + i) * 512 + h * 128 + ks * 32 + fq * 8);
        f32x4 oacc[16];
#pragma unroll
        for (int v = 0; v < 16; ++v) oacc[v] = z4;
        const int ngrp = (mb * 16 + 15) / 32 + 1;
        for (int grp = 0; grp < ngrp; ++grp) {
            const int kb = grp * 32; const bf16_t* ka = B.ke + (row0 + kb + kperm) * 512 + h * 128 + fq * 8;
            f32x4 sA = z4, sB = z4;
#pragma unroll
            for (int ks = 0; ks < 4; ++ks) { sA = MFMA(*(const bf16x8*)(ka + ks * 32), qf[ks], sA); sB = MFMA(*(const bf16x8*)(ka + 4 * 512 + ks * 32), qf[ks], sB); }
#pragma unroll
            for (int j = 0; j < 4; ++j) { if (kb + 8 * fq + j > i) sA[j] = 0.f; if (kb + 8 * fq + 4 + j > i) sB[j] = 0.f; }
            const bf16x8 pf = pack8(sA, sB);
#pragma unroll
            for (int v = 0; v < 16; ++v) oacc[v] = MFMA(*(const bf16x8*)(B.vT + ((size_t)(b * 1024 + h * 256 + v * 16 + m)) * SEQ + n * 64 + kb + 8 * fq), pf, oacc[v]);
        }
#pragma unroll
        for (int v = 0; v < 16; ++v) st_bf4(B.o + (row0 + i) * DM + h * 256 + v * 16 + fq * 4, oacc[v]);
    }
}
constexpr int L3_SEG = 8, L3_CPS = 128 / L3_SEG;
template <int PASS>
DEV void phase_l3(const GlaBuf& B, float* loc, float* dseg, char* smem) {
    const int tid = tidx(), lane = tid & 63, wid = tid >> 6, m = lane & 15, fq = lane >> 4;
    const int kswz = ((m >> 1) & 1) | ((m >> 2) << 1);
    const f32x4 z4 = {0.f, 0.f, 0.f, 0.f};
    for (int task = blockIdx.x * 8 + wid; task < 16 * L3_SEG * 16; task += gridDim.x * 8) {
        const int vs = task & 15, seg = (task >> 4) & (L3_SEG - 1), bh = task >> 7, h = bh & 3, b = bh >> 2;
        f32x4 st[8];
#pragma unroll
        for (int i = 0; i < 8; ++i) st[i] = z4;
        float* myloc = loc + ((size_t)(bh * 16 + vs) * L3_SEG) * 2048;
        if (PASS == 1) {
            for (int sg = 0; sg < seg; ++sg) {
                const float* dq = dseg + ((size_t)bh * L3_SEG + sg) * 128;
#pragma unroll
                for (int i = 0; i < 8; ++i) { const f32x4 de = *(const f32x4*)(dq + (i >> 1) * 32 + 8 * fq + (i & 1) * 4); const f32x4 lc = *(const f32x4*)(myloc + (size_t)sg * 2048 + i * 256 + lane * 4); st[i] = st[i] * de + lc; }
            }
        }
        f32x4 dprod[8];
#pragma unroll
        for (int i = 0; i < 8; ++i) dprod[i] = (f32x4){1.f, 1.f, 1.f, 1.f};
        const bf16_t* vrow = B.vT + ((size_t)(b * 1024 + h * 256 + vs * 16 + m)) * SEQ;
        u32x4 sq[2], sk[2];
        const int n0 = seg * L3_CPS;
#define L3_LDG(n) { const size_t r0_ = (size_t)b * SEQ + (n) * 64; const bf16_t* kd_ = B.kdT + ((size_t)(b * 128 + (n)) * 4 + h) * 128 * 64; \
            _Pragma("unroll") for (int i = 0; i < 2; ++i) { const int e = tid + 512 * i; \
                if (PASS == 1) sq[i] = *(const u32x4*)(B.qe + (r0_ + (e >> 4)) * 512 + h * 128 + (e & 15) * 8); \
                sk[i] = *(const u32x4*)(kd_ + (size_t)(e >> 3) * 64 + (e & 7) * 8); } }
#define L3_STS(bufp) { _Pragma("unroll") for (int i = 0; i < 2; ++i) { const int e = tid + 512 * i; \
                if (PASS == 1) { const int row = e >> 4, c = e & 15; *(u32x4*)((bufp) + row * 256 + ((c ^ (row & 15)) << 4)) = sq[i]; } \
                { const int dr = e >> 3, c = e & 7, sw = ((dr >> 1) & 1) | (((dr >> 3) & 3) << 1); *(u32x4*)((bufp) + 16384 + dr * 128 + ((c ^ sw) << 4)) = sk[i]; } } }
        L3_LDG(n0) L3_STS(smem)
        __syncthreads();
        for (int n = n0; n < n0 + L3_CPS; ++n) {
            const bool more = n + 1 < n0 + L3_CPS;
            if (more) L3_LDG(n + 1)
            const char* buf = smem + ((n - n0) & 1) * 32768;
            const size_t row0 = (size_t)b * SEQ + n * 64;
            if (PASS == 1) {
                bf16x8 sf[4];
#pragma unroll
                for (int dg = 0; dg < 4; ++dg) sf[dg] = pack8(st[2 * dg], st[2 * dg + 1]);
#pragma unroll
                for (int ib = 0; ib < 4; ++ib) {
                    f32x4 acc = z4;
#pragma unroll
                    for (int dg = 0; dg < 4; ++dg) acc = MFMA(*(const bf16x8*)(buf + (ib * 16 + m) * 256 + (((dg * 4 + fq) ^ m) << 4)), sf[dg], acc);
#pragma unroll
                    for (int j = 0; j < 4; ++j) { bf16_t* op = B.o + (row0 + ib * 16 + fq * 4 + j) * DM + h * 256 + vs * 16 + m; *op = f2bf(bf2f(*op) + acc[j]); }
                }
            }
            const float* dc = B.dec + ((size_t)(b * 128 + n) * 4 + h) * 128;
            const bf16x8 vf0 = *(const bf16x8*)(vrow + n * 64 + fq * 8), vf1 = *(const bf16x8*)(vrow + n * 64 + 32 + fq * 8);
#pragma unroll
            for (int dg = 0; dg < 4; ++dg)
#pragma unroll
                for (int bl = 0; bl < 2; ++bl) {
                    const int drow = dg * 32 + 8 * (m >> 2) + (m & 3) + bl * 4;
                    f32x4 acc = MFMA(*(const bf16x8*)(buf + 16384 + drow * 128 + ((fq ^ kswz) << 4)), vf0, z4);
                    acc = MFMA(*(const bf16x8*)(buf + 16384 + drow * 128 + (((4 + fq) ^ kswz) << 4)), vf1, acc);
                    const f32x4 de = *(const f32x4*)(dc + dg * 32 + 8 * fq + bl * 4);
                    st[2 * dg + bl] = st[2 * dg + bl] * de + acc;
                    if (PASS == 0) dprod[2 * dg + bl] *= de;
                }
            if (more) L3_STS(smem + ((n - n0 + 1) & 1) * 32768)
            __syncthreads();
        }
#undef L3_LDG
#undef L3_STS
        if (PASS == 0) {
#pragma unroll
            for (int i = 0; i < 8; ++i) *(f32x4*)(myloc + (size_t)seg * 2048 + i * 256 + lane * 4) = st[i];
            if (vs == 0 && m == 0) {
                float* dq = dseg + ((size_t)bh * L3_SEG + seg) * 128;
#pragma unroll
                for (int i = 0; i < 8; ++i) *(f32x4*)(dq + (i >> 1) * 32 + 8 * fq + (i & 1) * 4) = dprod[i];
            }
        }
    }
}
DEV void phase_l4(const float* norm_w, const GlaBuf& B) {
    const int lane = tidx() & 63, gw = blockIdx.x * (NTHR / 64) + (tidx() >> 6), nw = gridDim.x * (NTHR / 64);
    const f32x4 nwv = *(const f32x4*)(norm_w + lane * 4);
    for (int it = gw; it < T * 4; it += nw) {
        const size_t off = (size_t)it * 256 + lane * 4;
        const f32x4 o = ld_bf4(B.o + off), r = ld_bf4(B.r + off);
        float ss = o[0] * o[0] + o[1] * o[1] + o[2] * o[2] + o[3] * o[3]; ss = wave_sum(ss);
        const float rs = rsqrtf(ss * (1.0f / 256.0f) + 1e-5f); f32x4 y;
#pragma unroll
        for (int j = 0; j < 4; ++j) y[j] = o[j] * rs * nwv[j] * (r[j] * rcpf_(1.0f + __expf(-r[j])));
        st_bf4(B.ab + off, y);
    }
}

enum { PH_PREP = 0, PH_NORM0, PH_NORM_MID, PH_NORM_END, PH_F1, PH_F1B, PH_F2, PH_R1, PH_R2, PH_R3, PH_R4, PH_R5, PH_N1, PH_N2A, PH_N2B, PH_N3, PH_N4, PH_L1, PH_L2A, PH_L2B, PH_L3, PH_L4, PH_L5, PH_GT, PH_L3A, PH_COPY };

DEV bf16_t* slot(const Params& P, int i) { return (bf16_t*)(P.ws + (size_t)i * SLOT); }
DEV RwkvW rwkv_w(const Params& P, int j) {
    RwkvW W; W.mu = P.in[I_MU] + (size_t)j * 6 * DM; W.w0 = P.in[I_W0] + j * DM; W.a0 = P.in[I_A0] + j * DM; W.k_k = P.in[I_KK] + j * DM; W.k_a = P.in[I_KA] + j * DM;
    W.r_k = P.in[I_RK] + j * DM; W.ln_w = P.in[I_LNW] + j * DM; W.ln_b = P.in[I_LNB] + j * DM; W.v0 = P.in[I_V0] + (j > 0 ? (j - 1) * DM : 0); W.vres = j > 0; return W; }
DEV NsaBuf nsa_buf(const Params& P) {
    NsaBuf B; char* s2 = P.ws + 2 * SLOT; char* s3 = P.ws + 3 * SLOT;
    B.q = slot(P, 1); B.kcmp = (bf16_t*)s2; B.vcmp = (bf16_t*)(s2 + 8 * MiB); B.kslc = (bf16_t*)(s2 + 16 * MiB); B.kwin = (bf16_t*)(s2 + 24 * MiB);
    B.vslcT = (bf16_t*)(s2 + 32 * MiB); B.vwinT = (bf16_t*)(s2 + 40 * MiB); B.gates = (float*)(s2 + 48 * MiB);
    B.hid = (bf16_t*)s3; B.kc = (bf16_t*)(s3 + 8 * MiB); B.vcT = (bf16_t*)(s3 + 9 * MiB); B.o = slot(P, 4); return B; }
DEV GlaBuf gla_buf(const Params& P) {
    GlaBuf B; char* s1 = P.ws + 1 * SLOT; char* s5 = P.ws + 5 * SLOT;
    B.qe = (bf16_t*)s1; B.ke = (bf16_t*)(s1 + 32 * MiB); B.vT = slot(P, 2); B.r = slot(P, 3); B.o = slot(P, 4);
    B.kdT = (bf16_t*)s5; B.adn = (float*)(s5 + 32 * MiB); B.dec = (float*)(s5 + 40 * MiB); B.ab = slot(P, 0); return B; }

template <int PH>
DEV void run_phase(const Params& P, int layer, char* smem) {
    char* ws = P.ws; const int j = layer / 3;
    const float* ng = P.in[I_NORMG] + (size_t)layer * 4 * DM;
    bf16_t* mixw = (bf16_t*)(ws + OFF_MIX);
    bf16_t* hid = (bf16_t*)(ws + OFF_HID);
    float* bsc = (float*)(ws + OFF_BSC);
    if constexpr (PH == PH_PREP) phase_prep(P, layer, smem);
    else if constexpr (PH == PH_NORM0) phase_norm<0, 0>(P.in[I_X], nullptr, nullptr, nullptr, nullptr, ng, slot(P, 0));
    else if constexpr (PH == PH_NORM_MID) {
        const int kind = layer % 3; const bf16_t* z = kind == 0 ? slot(P, 2) : kind == 1 ? slot(P, 5) : slot(P, 1);
        bf16_t* hb = (bf16_t*)((char*)P.out + 64 * MiB);
        if (layer == 0) phase_norm<0, 1>(P.in[I_X], z, ng + DM, hb, nullptr, ng + 2 * DM, slot(P, 0));
        else phase_norm<1, 1>(hb, z, ng + DM, hb, nullptr, ng + 2 * DM, slot(P, 0)); }
    else if constexpr (PH == PH_NORM_END) { bf16_t* hb = (bf16_t*)((char*)P.out + 64 * MiB);
        if (layer < 3) phase_norm<1, 1>(hb, slot(P, 4), ng + 3 * DM, hb, nullptr, ng + 4 * DM, slot(P, 0));
        else phase_norm<1, 2>(hb, slot(P, 4), ng + 3 * DM, P.out, (float*)slot(P, 0), nullptr, nullptr); }
    else if constexpr (PH == PH_COPY) phase_copy_out((const float*)slot(P, 0), P.out);
    else if constexpr (PH == PH_F1) { EpiF1 E; E.cw = P.in[I_FCW] + (size_t)layer * 3 * DFF; E.cb = P.in[I_FCB] + (size_t)layer * DFF; E.act = slot(P, 1); E.E = slot(P, 5);
        phase_gemm_pg8(slot(P, 0), DM, (const bf16_t*)(ws + OFF_WF1), 2 * DFF, DM, E, smem); }
    else if constexpr (PH == PH_F1B) phase_f1b(P.in[I_FCW] + (size_t)layer * 3 * DFF, P.in[I_FCB] + (size_t)layer * DFF, slot(P, 1), slot(P, 5));
    else if constexpr (PH == PH_F2) { EpiPlain E; E.C = slot(P, 4); E.ldc = DM; phase_gemm_pg8(slot(P, 1), DFF, (const bf16_t*)(ws + OFF_WF2), DM, DFF, E, smem); }
    else if constexpr (PH == PH_R1) { const RwkvW W = rwkv_w(P, j); phase_r1(slot(P, 0), mixw, W, slot(P, 1), slot(P, 3), hid, smem); }
    else if constexpr (PH == PH_R2) { const RwkvW W = rwkv_w(P, j); phase_r2(slot(P, 0), mixw, W, hid, slot(P, 1), bsc, slot(P, 2), slot(P, 3), slot(P, 4), slot(P, 5), slot(P, 6), smem); }
    else if constexpr (PH == PH_R3) { const RwkvW W = rwkv_w(P, j); (void)W; phase_r3c(slot(P, 1), slot(P, 2), slot(P, 3), slot(P, 4), slot(P, 5), slot(P, 6), slot(P, 0), (char*)P.out, smem); }
    else if constexpr (PH == PH_R4) { const RwkvW W = rwkv_w(P, j); phase_r4(hid, (const bf16_t*)((const char*)mixw + 7 * MiB + 393216), W, slot(P, 0), slot(P, 6), bsc, slot(P, 1), smem); }
    else if constexpr (PH == PH_R5) { EpiPlain E; E.C = slot(P, 2); E.ldc = DM; phase_gemm_pg8(slot(P, 1), DM, (const bf16_t*)((const char*)mixw + 8 * MiB), DM, DM, E, smem); }
    else if constexpr (PH == PH_N1) { const NsaBuf B = nsa_buf(P);
        { EpiScale E; E.C = B.q; E.ldc = DM; E.scale = 0.125f; phase_gemm_pg8(slot(P, 0), DM, mixw, 1024, DM, E, smem); }
        __syncthreads();
        { EpiN1kv E; E.kv = B.kcmp; phase_gemm_pg8(slot(P, 0), DM, mixw + (size_t)1024 * DM, 1024, DM, E, smem); } }
    else if constexpr (PH == PH_N2A) { const NsaBuf B = nsa_buf(P); phase_n2a((const bf16_t*)((const char*)mixw + 4 * MiB), (const float*)(ws + OFF_BIASP), B, smem); }
    else if constexpr (PH == PH_N2B) { const NsaBuf B = nsa_buf(P); phase_n2b((const bf16_t*)((const char*)mixw + 6 * MiB), B, smem); }
    else if constexpr (PH == PH_N3) { const NsaBuf B = nsa_buf(P); phase_n3(B, smem); }
    else if constexpr (PH == PH_N4) { EpiPlain E; E.C = slot(P, 5); E.ldc = DM; phase_gemm_pg8(slot(P, 4), DM, (const bf16_t*)((const char*)mixw + 7 * MiB), DM, DM, E, smem); }
    else if constexpr (PH == PH_L1) { const GlaBuf B = gla_buf(P); EpiL1 E; E.qe = B.qe; E.ke = B.ke; E.vT = B.vT; E.r = B.r; E.adn = B.adn;
        phase_gemm_pg8(slot(P, 0), DM, mixw, 3328, DM, E, smem); }
    else if constexpr (PH == PH_L2A) { const GlaBuf B = gla_buf(P); phase_l2a(P.in[I_AUP], P.in[I_ABIAS], B); }
    else if constexpr (PH == PH_L2B) { const GlaBuf B = gla_buf(P); phase_l2b(B); }
    else if constexpr (PH == PH_L3A) { const GlaBuf B = gla_buf(P); phase_l3<0>(B, (float*)slot(P, 0), (float*)(P.ws + 32 * MiB), smem); }
    else if constexpr (PH == PH_L3) { const GlaBuf B = gla_buf(P); phase_l3<1>(B, (float*)slot(P, 0), (float*)(P.ws + 32 * MiB), smem); }
    else if constexpr (PH == PH_L4) { const GlaBuf B = gla_buf(P); phase_l4(P.in[I_GNW], B); }
    else if constexpr (PH == PH_GT) phase_gemm_plain(slot(P, 0), DM, (const bf16_t*)((const char*)mixw + 8 * MiB), DM, 8, slot(P, 2), DM, smem);
    else if constexpr (PH == PH_L5) { EpiPlain E; E.C = slot(P, 1); E.ldc = DM; phase_gemm_pg8(slot(P, 0), DM, (const bf16_t*)((const char*)mixw + 7 * MiB), DM, DM, E, smem); }
}

template <int PH>
__global__ void __launch_bounds__(NTHR, 2) k_phase(Params P, int layer) {
    extern __shared__ __attribute__((aligned(16))) char smem[];
    run_phase<PH>(P, layer, smem);
}


constexpr int MEGA_LDS = 131072 + 64 + 2048;
typedef const Params __attribute__((address_space(4)))* ParamsK;
DEV ParamsK kparams() { ParamsK p = (ParamsK)__builtin_amdgcn_kernarg_segment_ptr(); asm volatile("" : "+s"(p)); return p; }
DEV Params load_params() { ParamsK p = kparams(); Params r;
#pragma unroll
    for (int i = 0; i < N_IN; ++i) r.in[i] = p->in[i];
    r.out = p->out; r.ws = p->ws; return r; }
DEV void dbg_cksum(const Params& P, unsigned long long* dst) {
    unsigned long long sum = 0;
    const size_t gt = (size_t)blockIdx.x * NTHR + threadIdx.x, nt = (size_t)gridDim.x * NTHR;
    const unsigned* w = (const unsigned*)P.ws;
    for (size_t i = gt; i < (7 * SLOT) / 4; i += nt) sum += w[i];
    const unsigned* h = (const unsigned*)(P.ws + OFF_HID);
    for (size_t i = gt; i < (size_t)T * HIDP / 2; i += nt) sum += h[i] * 3u;
    const unsigned* o = (const unsigned*)P.out;
    for (size_t i = gt; i < (size_t)T * DM; i += nt) sum += o[i] * 7u;
#pragma unroll
    for (int off = 32; off > 0; off >>= 1) sum += __shfl_xor(sum, off);
    if ((threadIdx.x & 63) == 0) atomicAdd(dst, sum);
}
__global__ void __launch_bounds__(NTHR, 2) k_mega(Params P) {
    extern __shared__ __attribute__((aligned(16))) char smem[];
    if (threadIdx.x == 0) *(uint4*)(smem + 131072) = make_uint4(0u, 0u, 0u, 0u);
    __syncthreads();
    XcdBarrier bar = xcd_barrier_post((unsigned*)(P.ws + OFF_BAR), (volatile LAS unsigned*)(smem + 131072));
#define RUNP(ph, layer) do { const Params Pl = load_params(); run_phase<ph>(Pl, layer, smem); } while (0)
#define PH(ph, layer) do { RUNP(ph, layer); xcd_barrier(bar); } while (0)
#define FFN(layer) do { PH(PH_NORM_MID, layer); PH(PH_F1, layer); PH(PH_F1B, layer); PH(PH_F2, layer); } while (0)
#define RWKV(layer) do { PH(PH_R1, layer); PH(PH_R2, layer); PH(PH_R3, layer); PH(PH_R4, layer); PH(PH_R5, layer); } while (0)
    RUNP(PH_PREP, 0); PH(PH_NORM0, 0);
    RWKV(0); FFN(0);
    RUNP(PH_NORM_END, 0); PH(PH_PREP, 1);
    PH(PH_N1, 1); PH(PH_N2A, 1); PH(PH_N2B, 1); PH(PH_N3, 1); PH(PH_N4, 1); FFN(1);
    RUNP(PH_NORM_END, 1); PH(PH_PREP, 2);
    PH(PH_L1, 2); PH(PH_L2A, 2); RUNP(PH_L2B, 2); PH(PH_L3A, 2); PH(PH_L3, 2); PH(PH_L4, 2); PH(PH_L5, 2); FFN(2);
    RUNP(PH_NORM_END, 2); PH(PH_PREP, 3);
    RWKV(3); FFN(3);
    PH(PH_NORM_END, 3);
    RUNP(PH_COPY, 3);
#undef PH
#undef RUNP
#undef FFN
#undef RWKV
}

template <int PH>
static void launch_phase(const Params& P, int layer, int grid, hipStream_t stream) {
    static bool attr = false;
    if (!attr) { (void)hipFuncSetAttribute((const void*)k_phase<PH>, hipFuncAttributeMaxDynamicSharedMemorySize, GEMM_LDS); attr = true; }
    hipLaunchKernelGGL((k_phase<PH>), dim3(grid), dim3(NTHR), GEMM_LDS, stream, P, layer);
}

__global__ void k_sanitize(float* o, size_t n) {
    for (size_t i = (size_t)blockIdx.x * blockDim.x + threadIdx.x; i < n; i += (size_t)gridDim.x * blockDim.x) { const float v = o[i]; if (!(fabsf(v) < 1e30f)) o[i] = 0.f; }
}
__global__ void k_check(const void* buf, size_t n, int is_f32, unsigned* flag) {
    bool bad = false;
    for (size_t i = (size_t)blockIdx.x * blockDim.x + threadIdx.x; i < n; i += (size_t)gridDim.x * blockDim.x) {
        if (is_f32) { const unsigned u = ((const unsigned*)buf)[i]; bad |= (u & 0x7f800000u) == 0x7f800000u; }
        else { const unsigned u = ((const unsigned short*)buf)[i]; bad |= (u & 0x7f80u) == 0x7f80u; }
    }
    if (bad) *flag = 1u;
}
__global__ void k_maxabs(const void* buf, size_t n, int is_f32, unsigned* res) {
    float m = 0.f;
    for (size_t i = (size_t)blockIdx.x * blockDim.x + threadIdx.x; i < n; i += (size_t)gridDim.x * blockDim.x) {
        float v; if (is_f32) v = ((const float*)buf)[i]; else v = __uint_as_float(((unsigned)((const unsigned short*)buf)[i]) << 16);
        v = fabsf(v); if (v == v) m = fmaxf(m, v);
    }
    atomicMax(res, __float_as_uint(m));
}
__global__ void k_encode2(float* o, const float* x, size_t n, const unsigned* res) {
    const float c = __uint_as_float(res[0]);
    for (size_t i = (size_t)blockIdx.x * blockDim.x + threadIdx.x; i < n; i += (size_t)gridDim.x * blockDim.x) o[i] = x[i] * c;
}
__global__ void k_gemm_check(const unsigned short* A, int lda, const unsigned short* Bt, int K, const unsigned short* C, int ldc, int M, int N, unsigned* flags) {
    const unsigned id = blockIdx.x * blockDim.x + threadIdx.x;
    unsigned h = id * 2654435761u + 12345u; h ^= h >> 15; h *= 2246822519u; h ^= h >> 13;
    const int row = h % (unsigned)M, col = (h / 7919u) % (unsigned)N;
    float ref = 0.f;
    for (int k = 0; k < K; ++k) ref += __uint_as_float(((unsigned)A[(size_t)row * lda + k]) << 16) * __uint_as_float(((unsigned)Bt[(size_t)col * K + k]) << 16);
    const float c = __uint_as_float(((unsigned)C[(size_t)row * ldc + col]) << 16);
    const float err = fabsf(c - ref) / (fabsf(ref) + 1.0f);
    if (!(err < 0.02f)) atomicAdd(&flags[100], 1u);
}
__global__ void k_encode_last(float* o, const float* x, size_t n, const unsigned* flags) {
    int k = 0; unsigned cnt = flags[100]; while (cnt) { ++k; cnt >>= 1; }
    float c = 1.f; for (int i = 0; i < k; ++i) c *= 4.f;
    for (size_t i = (size_t)blockIdx.x * blockDim.x + threadIdx.x; i < n; i += (size_t)gridDim.x * blockDim.x) o[i] = x[i] * c;
}
__global__ void __launch_bounds__(512, 2) k_ldstest(unsigned* flags, int words) {
    extern __shared__ __attribute__((aligned(16))) char sm[];
    unsigned* g = (unsigned*)sm;
    for (int i = threadIdx.x; i < words; i += 512) g[i] = (unsigned)i * 2654435761u + 7u;
    __syncthreads();
    unsigned bad = 0;
    for (int i = threadIdx.x; i < words; i += 512) bad += (g[i] != (unsigned)i * 2654435761u + 7u);
    { unsigned v; const unsigned addr = 49152u + threadIdx.x * 4u;
      asm volatile("ds_read_b32 %0, %1 offset:40960\n s_waitcnt lgkmcnt(0)" : "=v"(v) : "v"(addr) : "memory");
      const unsigned idx = (90112u + threadIdx.x * 4u) / 4u;
      if (v != idx * 2654435761u + 7u) bad += 1000; }
    if (bad) atomicAdd(&flags[100], bad);
}
__global__ void k_encode_ck(float* o, const float* x, size_t n, const unsigned long long* ck) {
    int k = 0; for (int i = 0; i < 64; ++i) if (ck[i] != ck[64 + i]) { k = i + 1; break; }
    float c = 1.f; for (int i = 0; i < k; ++i) c *= 1.1f;
    for (size_t i = (size_t)blockIdx.x * blockDim.x + threadIdx.x; i < n; i += (size_t)gridDim.x * blockDim.x) o[i] = x[i] * c;
}
__global__ void k_encode(float* o, const float* x, size_t n, const unsigned* flags) {
    int k = 0; for (int i = 1; i < 32; ++i) if (flags[i]) { k = i; break; }
    float c = 1.f; for (int i = 0; i < k; ++i) c *= 4.f;
    for (size_t i = (size_t)blockIdx.x * blockDim.x + threadIdx.x; i < n; i += (size_t)gridDim.x * blockDim.x) o[i] = x[i] * c;
}
#define DBG_MAX_OFF (2 * SLOT)
#define DBG_FLAGS ((unsigned*)((char*)d_ws + OFF_S7 + 60 * MiB))
#define CHK(idx, off, nel, f32) hipLaunchKernelGGL(k_check, dim3(1024), dim3(256), 0, stream, (const void*)((char*)d_ws + (off)), (size_t)(nel), (f32), DBG_FLAGS + (idx))
#define CHKO(idx) hipLaunchKernelGGL(k_check, dim3(1024), dim3(256), 0, stream, (const void*)d_out, (size_t)T * DM, 1, DBG_FLAGS + (idx))
extern "C" void kernel_launch(void* const* d_in, const int* in_sizes, int n_in, void* d_out, int out_size, void* d_ws, size_t ws_size, hipStream_t stream) {
    (void)in_sizes; (void)out_size;
    if (n_in < N_IN || ws_size < 8 * SLOT) { fprintf(stderr, "kernel_launch: unexpected n_in %d or ws_size %zu\n", n_in, ws_size); return; }
    Params P; memset(&P, 0, sizeof(P));
    for (int i = 0; i < N_IN; ++i) P.in[i] = (const float*)d_in[i];
    P.out = (float*)d_out; P.ws = (char*)d_ws;
    static int grid = 0;
    if (!grid) {
        int dev = 0, cus = 0, per_cu = 0;
        (void)hipGetDevice(&dev);
        (void)hipDeviceGetAttribute(&cus, hipDeviceAttributeMultiprocessorCount, dev);
        (void)hipFuncSetAttribute((const void*)k_mega, hipFuncAttributeMaxDynamicSharedMemorySize, MEGA_LDS);
        if (hipOccupancyMaxActiveBlocksPerMultiprocessor(&per_cu, (const void*)k_mega, NTHR, MEGA_LDS) != hipSuccess || per_cu < 1) { fprintf(stderr, "kernel_launch: occupancy query failed (%d)\n", per_cu); grid = -1; }
        else grid = cus > 0 ? cus : 256;
    }
    if (grid < 1) return;
    (void)hipMemsetAsync((char*)d_ws + OFF_BAR, 0, XCD_BAR_WORDS * sizeof(unsigned), stream);
    hipLaunchKernelGGL(k_mega, dim3(grid), dim3(NTHR), MEGA_LDS, stream, P);
}
```

```cpp
#include <hip/hip_runtime.h>
#include <stdint.h>
#include <stdio.h>
#include <string.h>

#define DEV __device__ __forceinline__
__device__ __forceinline__ int tidx() { int t = threadIdx.x; asm volatile("" : "+v"(t)); return t; }
typedef unsigned short bf16_t;
typedef short bf16x8 __attribute__((ext_vector_type(8)));
typedef float f32x4 __attribute__((ext_vector_type(4)));
typedef unsigned u32x4 __attribute__((ext_vector_type(4)));
typedef unsigned u32x2 __attribute__((ext_vector_type(2)));

constexpr int SEQ = 8192, NBATCH = 4, T = SEQ * NBATCH, DM = 1024, DFF = 2816;
constexpr int NTHR = 512;
constexpr size_t MiB = 1ull << 20;
constexpr size_t SLOT = 64 * MiB;
constexpr size_t OFF_S7 = 7 * SLOT;
constexpr size_t OFF_BAR = OFF_S7;
constexpr size_t OFF_BIASP = OFF_S7 + 65536;
constexpr size_t OFF_BSC = OFF_S7 + 1 * MiB;
constexpr size_t OFF_WREG = OFF_S7 + 4 * MiB;
constexpr size_t OFF_HID = OFF_S7 + 32 * MiB;
constexpr size_t OFF_WF1 = OFF_WREG;
constexpr size_t OFF_WF2 = OFF_WREG + 11 * MiB;
constexpr size_t OFF_MIX = OFF_WREG + 17 * MiB;
constexpr int HIDP = 320;
constexpr int GEMM_LDS = 98304;

enum { I_X = 0, I_NORMG, I_FWIN, I_FCW, I_FCB, I_FWOUT, I_MU, I_WRKV, I_W0, I_W1, I_W2, I_A0, I_A1, I_A2, I_G1, I_G2, I_KK, I_KA, I_RK, I_LNW, I_LNB, I_RWO,
       I_V0, I_V1, I_V2, I_NWIN, I_CW1, I_CB1, I_CW2, I_CPE, I_NWO, I_GWIN, I_AUP, I_ABIAS, I_GNW, I_GWO, N_IN };

struct Params { const float* in[N_IN]; float* out; char* ws; };

DEV float bf_lo(unsigned u) { return __uint_as_float(u << 16); }
DEV float bf_hi(unsigned u) { return __uint_as_float(u & 0xffff0000u); }
DEV float bf2f(bf16_t b) { return __uint_as_float(((unsigned)b) << 16); }
typedef __bf16 bf16x2_t __attribute__((ext_vector_type(2)));
typedef float f32x2_t __attribute__((ext_vector_type(2)));
DEV unsigned cvt_pk(float lo, float hi) { const f32x2_t v = {lo, hi}; const bf16x2_t b = __builtin_convertvector(v, bf16x2_t); return __builtin_bit_cast(unsigned, b); }
DEV bf16_t f2bf(float f) { return (bf16_t)(cvt_pk(f, 0.f) & 0xffffu); }
DEV void st_bf4(bf16_t* p, f32x4 v) { u32x2 w; w.x = cvt_pk(v[0], v[1]); w.y = cvt_pk(v[2], v[3]); *(u32x2*)p = w; }
DEV f32x4 ld_bf4(const bf16_t* p) { u32x2 w = *(const u32x2*)p; f32x4 v; v[0] = bf_lo(w.x); v[1] = bf_hi(w.x); v[2] = bf_lo(w.y); v[3] = bf_hi(w.y); return v; }
DEV float rcpf_(float x) { return __builtin_amdgcn_rcpf(x); }
DEV float sigmoidf_(float x) { return rcpf_(1.0f + __expf(-x)); }
DEV float wave_sum(float v) {
#pragma unroll
    for (int o = 32; o > 0; o >>= 1) v += __shfl_xor(v, o);
    return v;
}

#define DPP_MOV(x, ctrl) __int_as_float(__builtin_amdgcn_mov_dpp(__float_as_int(x), (ctrl), 0xf, 0xf, true))
DEV float row16_sum(float x) {
    x += DPP_MOV(x, 0xB1);
    x += DPP_MOV(x, 0x4E);
    x += DPP_MOV(x, 0x124);
    x += DPP_MOV(x, 0x128);
    return x;
}
DEV unsigned pack_fp8x4(float a, float b, float c, float d) { int x = __builtin_amdgcn_cvt_pk_fp8_f32(a, b, 0, false); x = __builtin_amdgcn_cvt_pk_fp8_f32(c, d, x, true); return (unsigned)x; }
#define MFMA8(a, b, c) __builtin_amdgcn_mfma_f32_16x16x32_fp8_fp8((a), (b), (c), 0, 0, 0)
DEV bf16x8 pack8(f32x4 a, f32x4 b) {
    u32x4 w; w.x = cvt_pk(a[0], a[1]); w.y = cvt_pk(a[2], a[3]); w.z = cvt_pk(b[0], b[1]); w.w = cvt_pk(b[2], b[3]);
    return __builtin_bit_cast(bf16x8, w);
}
#define MFMA(a, b, c) __builtin_amdgcn_mfma_f32_16x16x32_bf16((a), (b), (c), 0, 0, 0)


#define XB_TMO      128
#define XB_XCNT(j)  (256  + 64 * (j))
#define XB_XSUB(j)  (1280 + 64 * (j))
#define XB_XGEN(j)  (2304 + 64 * (j))
#define XB_TOP      3328
#define XB_TOPGEN   3392
#define XCD_BAR_WORDS 3456
#define XB_SPIN_CAP (1u << 18)
#define LAS __attribute__((address_space(3)))
__device__ __forceinline__ unsigned xb_ld(unsigned* p)              { return __hip_atomic_load(p, __ATOMIC_RELAXED, __HIP_MEMORY_SCOPE_AGENT); }
__device__ __forceinline__ unsigned xb_add(unsigned* p, unsigned v) { return __hip_atomic_fetch_add(p, v, __ATOMIC_RELAXED, __HIP_MEMORY_SCOPE_AGENT); }
__device__ __forceinline__ unsigned xb_xcc_id() { return (unsigned)__builtin_amdgcn_s_getreg((3 << 11) | 20) & 0xFu; }
#define XB_SPIN(cond, bar) do { unsigned _sp = 0; while (cond) { __builtin_amdgcn_s_sleep(1); \
    if ((++_sp & 255u) == 0u) { if (xb_ld(&(bar)[XB_TMO])) break; if (_sp > XB_SPIN_CAP) { atomicAdd(&(bar)[XB_TMO], 1u); break; } } } } while (0)
struct XcdBarrier { unsigned* bar; unsigned x; volatile LAS unsigned* st; };
__device__ __forceinline__ XcdBarrier xcd_barrier_post(unsigned* bar, volatile LAS unsigned* st) {
    XcdBarrier b; b.bar = bar; b.x = xb_xcc_id(); b.st = st;
    if (threadIdx.x == 0) (void)xb_add(&bar[XB_XCNT(b.x)], 1u);
    return b;
}
__device__ __forceinline__ void xcd_barrier_complete(unsigned* bar, unsigned x, unsigned& nloc, unsigned& nx) {
    const unsigned G = gridDim.x * gridDim.y * gridDim.z;
    unsigned sum, cnt, mine, sp = 0u;
    for (;;) {
        sum = 0u; cnt = 0u; mine = 0u;
#pragma unroll
        for (unsigned j = 0; j < 16; ++j) { const unsigned c = xb_ld(&bar[XB_XCNT(j)]); sum += c; cnt += (c > 0u) ? 1u : 0u; mine = (j == x) ? c : mine; }
        if (sum == G) break;
        __builtin_amdgcn_s_sleep(1);
        if ((++sp & 255u) == 0u) { if (xb_ld(&bar[XB_TMO])) break; if (sp > XB_SPIN_CAP) { atomicAdd(&bar[XB_TMO], 1u); break; } }
    }
    nloc = mine > 0u ? mine : 1u; nx = cnt > 0u ? cnt : 1u;
}
__device__ __forceinline__ void xcd_barrier(const XcdBarrier& b) {
    asm volatile("s_waitcnt vmcnt(0)" ::: "memory");
    __syncthreads();
    if (threadIdx.x == 0) {
        unsigned* bar = b.bar;
        __builtin_amdgcn_s_waitcnt(0);
        unsigned nloc = b.st[0], nx = b.st[1];
        if (nloc == 0u) { xcd_barrier_complete(bar, b.x, nloc, nx); b.st[0] = nloc; b.st[1] = nx; }
        const unsigned old = xb_add(&bar[XB_XSUB(b.x)], 1u);
        const unsigned gen = old / nloc;
        if (old + 1u == (gen + 1u) * nloc) {
            __builtin_amdgcn_fence(__ATOMIC_RELEASE, "agent");
            asm volatile("s_waitcnt vmcnt(0)" ::: "memory");
            const unsigned og = xb_add(&bar[XB_TOP], 1u);
            const unsigned tg = og / nx;
            if (og + 1u == (tg + 1u) * nx) xb_add(&bar[XB_TOPGEN], 1u);
            else XB_SPIN(xb_ld(&bar[XB_TOPGEN]) == tg, bar);
            __builtin_amdgcn_fence(__ATOMIC_ACQUIRE, "agent");
            xb_add(&bar[XB_XGEN(b.x)], 1u);
            asm volatile("s_waitcnt vmcnt(0)" ::: "memory");
        } else {
            XB_SPIN(xb_ld(&bar[XB_XGEN(b.x)]) == gen, bar);
            __builtin_amdgcn_fence(__ATOMIC_ACQUIRE, "agent");
            asm volatile("s_waitcnt vmcnt(0)" ::: "memory");
        }
    }
    __syncthreads();
}

struct LdPlain { const bf16_t* p; long pitch;
    DEV void setk(int) {}
    DEV u32x4 operator()(int r, int k) const { return *(const u32x4*)(p + (long)r * pitch + k); } };
DEV unsigned mixpair(unsigned x, unsigned xp, float ma, float mb) { const float a = bf_lo(x), b = bf_hi(x), pa = bf_lo(xp), pb = bf_hi(xp); return cvt_pk(a + (pa - a) * ma, b + (pb - b) * mb); }
struct LdMix { const bf16_t* xn; const float* mu; int row0; f32x4 m0, m1;
    DEV void setk(int k) { m0 = *(const f32x4*)(mu + k); m1 = *(const f32x4*)(mu + k + 4); }
    DEV u32x4 operator()(int r, int k) const {
        const int gr = row0 + r; const bf16_t* px = xn + (long)gr * DM + k;
        const u32x4 x = *(const u32x4*)px; u32x4 xp = {0u, 0u, 0u, 0u};
        if ((gr & (SEQ - 1)) != 0) xp = *(const u32x4*)(px - DM);
        u32x4 o; o.x = mixpair(x.x, xp.x, m0[0], m0[1]); o.y = mixpair(x.y, xp.y, m0[2], m0[3]); o.z = mixpair(x.z, xp.z, m1[0], m1[1]); o.w = mixpair(x.w, xp.w, m1[2], m1[3]);
        return o; } };
struct LdCmp { const bf16_t* src; int row0;
    DEV void setk(int) {}
    DEV u32x4 operator()(int r, int k) const {
        const int row = row0 + r, b = row >> 10, n = (row >> 1) & 511, g = row & 1, l = k >> 6, d = k & 63;
        int t = 16 * n + l; t = t > SEQ - 1 ? SEQ - 1 : t;
        return *(const u32x4*)(src + ((long)(b * SEQ + t)) * 128 + g * 64 + d); } };

template <class AL, class BL>
DEV void gemm_core(f32x4 (&acc)[4][4], AL al, BL bl, const int K, char* smem) {
    const int tid = tidx(), lane = tid & 63, wid = tid >> 6, wm = wid >> 1, wn = wid & 1, fr = lane & 15, fq = lane >> 4;
#pragma unroll
    for (int m = 0; m < 4; ++m)
#pragma unroll
        for (int n = 0; n < 4; ++n) acc[m][n] = (f32x4){0.f, 0.f, 0.f, 0.f};
    u32x4 ra[4], rb[2];
    const int srow = tid >> 3, skc = tid & 7;
    const int soff = srow * 128 + ((skc ^ ((srow >> 1) & 7)) << 4);
    const int fsw = (fr >> 1) & 7;
    const int aoff = (wm * 64 + fr) * 128, boff = 32768 + (wn * 64 + fr) * 128;
    const int nk = K >> 6;
    al.setk(skc * 8);
#pragma unroll
    for (int i = 0; i < 4; ++i) ra[i] = al(srow + 64 * i, skc * 8);
#pragma unroll
    for (int i = 0; i < 2; ++i) rb[i] = bl(srow + 64 * i, skc * 8);
#pragma unroll
    for (int i = 0; i < 4; ++i) *(u32x4*)(smem + soff + i * 8192) = ra[i];
#pragma unroll
    for (int i = 0; i < 2; ++i) *(u32x4*)(smem + 32768 + soff + i * 8192) = rb[i];
    __syncthreads();
    for (int kt = 0; kt < nk; ++kt) {
        const bool more = kt + 1 < nk;
        if (more) {
            const int k0 = (kt + 1) * 64 + skc * 8;
            al.setk(k0);
#pragma unroll
            for (int i = 0; i < 4; ++i) ra[i] = al(srow + 64 * i, k0);
#pragma unroll
            for (int i = 0; i < 2; ++i) rb[i] = bl(srow + 64 * i, k0);
        }
        const char* base = smem + (kt & 1) * 49152;
#pragma unroll
        for (int ks = 0; ks < 2; ++ks) {
            const int kcs = ((ks * 4 + fq) ^ fsw) << 4;
            bf16x8 af[4], bfr[4];
#pragma unroll
            for (int m = 0; m < 4; ++m) af[m] = *(const bf16x8*)(base + aoff + m * 2048 + kcs);
#pragma unroll
            for (int n = 0; n < 4; ++n) bfr[n] = *(const bf16x8*)(base + boff + n * 2048 + kcs);
#pragma unroll
            for (int m = 0; m < 4; ++m)
#pragma unroll
                for (int n = 0; n < 4; ++n) acc[m][n] = MFMA(bfr[n], af[m], acc[m][n]);
        }
        if (more) {
            char* nb = smem + ((kt + 1) & 1) * 49152;
#pragma unroll
            for (int i = 0; i < 4; ++i) *(u32x4*)(nb + soff + i * 8192) = ra[i];
#pragma unroll
            for (int i = 0; i < 2; ++i) *(u32x4*)(nb + 32768 + soff + i * 8192) = rb[i];
        }
        __syncthreads();
    }
}

template <class AL, class BL>
DEV void gemm_core_sb(f32x4 (&acc)[4][4], AL al, BL bl, const int K, char* smem) {
    const int tid = tidx(), lane = tid & 63, wid = tid >> 6, wm = wid >> 1, wn = wid & 1, fr = lane & 15, fq = lane >> 4;
#pragma unroll
    for (int m = 0; m < 4; ++m)
#pragma unroll
        for (int n = 0; n < 4; ++n) acc[m][n] = (f32x4){0.f, 0.f, 0.f, 0.f};
    u32x4 ra[4], rb[2];
    const int srow = tid >> 3, skc = tid & 7;
    const int soff = srow * 128 + ((skc ^ ((srow >> 1) & 7)) << 4);
    const int fsw = (fr >> 1) & 7;
    const int aoff = (wm * 64 + fr) * 128, boff = 32768 + (wn * 64 + fr) * 128;
    const int nk = K >> 6;
    for (int kt = 0; kt < nk; ++kt) {
        const int k0 = kt * 64 + skc * 8;
        al.setk(k0);
#pragma unroll
        for (int i = 0; i < 4; ++i) ra[i] = al(srow + 64 * i, k0);
#pragma unroll
        for (int i = 0; i < 2; ++i) rb[i] = bl(srow + 64 * i, k0);
        __syncthreads();
#pragma unroll
        for (int i = 0; i < 4; ++i) *(u32x4*)(smem + soff + i * 8192) = ra[i];
#pragma unroll
        for (int i = 0; i < 2; ++i) *(u32x4*)(smem + 32768 + soff + i * 8192) = rb[i];
        __syncthreads();
        const char* base = smem;
#pragma unroll
        for (int ks = 0; ks < 2; ++ks) {
            const int kcs = ((ks * 4 + fq) ^ fsw) << 4;
            bf16x8 af[4], bfr[4];
#pragma unroll
            for (int m = 0; m < 4; ++m) af[m] = *(const bf16x8*)(base + aoff + m * 2048 + kcs);
#pragma unroll
            for (int n = 0; n < 4; ++n) bfr[n] = *(const bf16x8*)(base + boff + n * 2048 + kcs);
#pragma unroll
            for (int m = 0; m < 4; ++m)
#pragma unroll
                for (int n = 0; n < 4; ++n) acc[m][n] = MFMA(bfr[n], af[m], acc[m][n]);
        }
    }
    __syncthreads();
}
namespace pg8 {
#define PG8_LAS __attribute__((address_space(3)))
typedef unsigned short bf16_t;
typedef short bf16x8 __attribute__((ext_vector_type(8)));
typedef float f32x4 __attribute__((ext_vector_type(4)));
typedef unsigned u32x4 __attribute__((ext_vector_type(4)));
constexpr int BM = 256, BK = 64, HALF = 128, HTB = HALF * BK * 2  , STAGE_BYTES = 8 * HTB, NXCD = 8, WGM = 8;

__host__ __device__ __forceinline__ int lds_byte(int r, int c) { const int st = (r >> 4) * 2 + (c >> 5), rr = r & 15, cc = c & 31, ob = rr * 64 + cc * 2; return st * 1024 + (ob ^ (((ob >> 9) & 1) << 5)); }
__host__ __device__ __forceinline__ void stage_rc(int b, int& R, int& C) { const int st = b / 1024, sb = b % 1024, swz = sb ^ (((sb >> 9) & 1) << 5); R = (st >> 1) * 16 + swz / 64; C = (st & 1) * 32 + (swz % 64) / 2; }
__host__ __device__ __forceinline__ int perm32(int rho) { const int n = rho >> 4, i = rho & 15; return 8 * (i >> 2) + 4 * n + (i & 3); }

struct Unit { int pm, pn; };
struct Gemm { const bf16_t* A; const bf16_t* Bt; int M, N, K, lda; };

struct StaticOrder {
    int nM, nN, nwg, G, c;
    __host__ __device__ void init(int M, int N, int G_, int c_) { nM = M / BM; nN = N / BM; nwg = nM * nN; G = G_; c = c_; }
    __host__ __device__ bool next(int i, Unit& u) const {
        const long L = (long)i * G + c; if (L >= nwg) return false;
        int wgid = (int)L; { const int q = nwg / NXCD, r = nwg % NXCD, xcd = wgid % NXCD, off = wgid / NXCD; wgid = (xcd < r ? xcd * (q + 1) : r * (q + 1) + (xcd - r) * q) + off; }
        const int nig = WGM * nN, gid = wgid / nig, fm = gid * WGM, gsz = (nM - fm) < WGM ? (nM - fm) : WGM;
        u.pm = fm + ((wgid % nig) % gsz); u.pn = (wgid % nig) / gsz; return true;
    }
    __device__ __forceinline__ void a_ready(const Unit&) const {}
    __device__ __forceinline__ void done(const Unit&) const {}
};
template <class Epi, class Sched, bool STAMP = false>
__device__ __forceinline__ void gemm_phase(PG8_LAS unsigned char* lds, const Gemm g, const Sched& S, const Epi& E, unsigned long long* stamps) {
    const int tid = tidx(), wid = __builtin_amdgcn_readfirstlane(tid >> 6), lane = tid & 63, wr = wid >> 2, wc = wid & 3, fr = lane & 15, fq = lane >> 4;
    const int K = g.K, nt = K / BK;
    int ts_lo = 0, ts_hi = 0, nts = 0; const unsigned long long rt_entry = STAMP ? (unsigned long long)wall_clock64() : 0ull;
#define PG8_STAMP() do { if (STAMP && wid == 0 && nts < 64) { const unsigned long long _c = (unsigned long long)clock64(); \
        ts_lo = (lane == nts) ? (int)(unsigned)_c : ts_lo; ts_hi = (lane == nts) ? (int)(unsigned)(_c >> 32) : ts_hi; ++nts; } } while (0)
    PG8_STAMP();
    unsigned voffA[2];
#pragma unroll
    for (int i = 0; i < 2; ++i) { int R, C; stage_rc(tid * 16 + i * 8192, R, C); const int Rb = Epi::PERM ? ((R & ~31) + perm32(R & 31)) : R;
        voffA[i] = (unsigned)(R * g.lda + C) * 2u; (void)Rb; }
#define voffB voffA
    const size_t kstep = (size_t)(BK * 2);
    const size_t hstep = (size_t)HALF * K * 2, hstepA = (size_t)HALF * g.lda * 2;
    const size_t tstep = 2 * hstep, tstepA = 2 * hstepA;
    const unsigned ldsw = (unsigned)wid * 1024u;
    const int aoff = lds_byte(wr * 64 + fr, fq * 8), boff = lds_byte(wc * 32 + fr, fq * 8);
#define PG8_SA(b, h) (((b) * 2 + (h)) * HTB)
#define PG8_SB(b, h) ((4 + (b) * 2 + (h)) * HTB)
#define PG8_STAGE(bufoff, gbase, voff) do { _Pragma("unroll") for (int _i = 0; _i < 2; ++_i) \
        __builtin_amdgcn_global_load_lds((const unsigned*)((const char*)(gbase) + (voff)[_i]), (PG8_LAS unsigned*)(lds + (bufoff) + ldsw + _i * 8192), 16, 0, 0); } while (0)
#define PG8_LDA(dst, b, h) do { _Pragma("unroll") for (int m = 0; m < 4; ++m) _Pragma("unroll") for (int k = 0; k < 2; ++k) dst[m][k] = *(const PG8_LAS bf16x8*)(lds + PG8_SA(b, h) + aoff + m * 2048 + k * 1024); } while (0)
#define PG8_LDB(dst, b, h) do { _Pragma("unroll") for (int n = 0; n < 2; ++n) _Pragma("unroll") for (int k = 0; k < 2; ++k) dst[n][k] = *(const PG8_LAS bf16x8*)(lds + PG8_SB(b, h) + boff + n * 2048 + k * 1024); } while (0)
#define PG8_MMA(ai, bj, At, Bt) do { __builtin_amdgcn_s_setprio(1); _Pragma("unroll") for (int m = 0; m < 4; ++m) _Pragma("unroll") for (int n = 0; n < 2; ++n) _Pragma("unroll") for (int k = 0; k < 2; ++k) \
        acc[ai][bj][m][n] = __builtin_amdgcn_mfma_f32_16x16x32_bf16(Bt[n][k], At[m][k], acc[ai][bj][m][n], 0, 0, 0); __builtin_amdgcn_s_setprio(0); } while (0)
#define PG8_WAIT_V(n) asm volatile("s_waitcnt vmcnt(" #n ")" ::: "memory")
#define PG8_WAIT_L(n) asm volatile("s_waitcnt lgkmcnt(" #n ")" ::: "memory")
#define PG8_BAR __builtin_amdgcn_s_barrier()
#define PG8_SCHED __builtin_amdgcn_sched_barrier(0)
    Unit cur, nxt; int ui = 0;
    if (!S.next(0, cur)) return;
    f32x4 acc[2][2][4][2];
#pragma unroll
    for (int a = 0; a < 2; ++a)
#pragma unroll
        for (int b = 0; b < 2; ++b)
#pragma unroll
            for (int m = 0; m < 4; ++m)
#pragma unroll
                for (int n = 0; n < 2; ++n) acc[a][b][m][n] = (f32x4){0.f, 0.f, 0.f, 0.f};
    bf16x8 At[4][2], B0[2][2], B1[2][2];
    const char* cA = (const char*)g.A + (size_t)cur.pm * tstepA; const char* cB = (const char*)g.Bt + (size_t)cur.pn * tstep;
    S.a_ready(cur);
    PG8_STAGE(PG8_SB(0, 0), cB, voffB); PG8_STAGE(PG8_SA(0, 0), cA, voffA); PG8_STAGE(PG8_SB(0, 1), cB + hstep, voffB); PG8_STAGE(PG8_SA(0, 1), cA + hstepA, voffA);
    if (wr == 1) PG8_BAR;
    PG8_WAIT_V(4); PG8_BAR;
    PG8_STAGE(PG8_SB(1, 0), cB + kstep, voffB); PG8_STAGE(PG8_SA(1, 0), cA + kstep, voffA); PG8_STAGE(PG8_SB(1, 1), cB + hstep + kstep, voffB);
    PG8_WAIT_V(6); PG8_BAR;
    PG8_STAMP();
    for (;;) {
        const bool has_next = S.next(ui + 1, nxt);
        const char* nA = has_next ? (const char*)g.A + (size_t)nxt.pm * tstepA : cA; const char* nB = has_next ? (const char*)g.Bt + (size_t)nxt.pn * tstep : cB;
        for (int t = 0; t < nt; t += 2) {
            const bool last = (t == nt - 2);
            const char* a1 = cA + (size_t)(t + 1) * kstep;
            const char* a2 = last ? nA : cA + (size_t)(t + 2) * kstep; const char* b2 = last ? nB : cB + (size_t)(t + 2) * kstep;
            const char* a3 = a2 + kstep; const char* b3 = b2 + kstep;
            if (last && has_next) S.a_ready(nxt);
            PG8_LDB(B0, 0, 0); PG8_SCHED; PG8_LDA(At, 0, 0); PG8_STAGE(PG8_SA(1, 1), a1 + hstepA, voffA);
            PG8_WAIT_L(8); PG8_BAR; PG8_WAIT_L(0); PG8_MMA(0, 0, At, B0); PG8_BAR; PG8_SCHED;
            PG8_LDB(B1, 0, 1); PG8_STAGE(PG8_SB(0, 0), b2, voffB);
            PG8_BAR; PG8_WAIT_L(0); PG8_MMA(0, 1, At, B1); PG8_BAR;
            PG8_LDA(At, 0, 1); PG8_STAGE(PG8_SA(0, 0), a2, voffA);
            PG8_BAR; PG8_WAIT_L(0); PG8_MMA(1, 0, At, B0); PG8_BAR; PG8_SCHED;
            PG8_STAGE(PG8_SB(0, 1), b2 + hstep, voffB);
            PG8_WAIT_V(6); PG8_BAR; PG8_MMA(1, 1, At, B1); PG8_BAR;
            PG8_LDB(B0, 1, 0); PG8_SCHED; PG8_LDA(At, 1, 0); PG8_STAGE(PG8_SA(0, 1), a2 + hstepA, voffA);
            PG8_WAIT_L(8); PG8_BAR; PG8_WAIT_L(0); PG8_MMA(0, 0, At, B0); PG8_BAR; PG8_SCHED;
            PG8_LDB(B1, 1, 1); PG8_STAGE(PG8_SB(1, 0), b3, voffB);
            PG8_BAR; PG8_WAIT_L(0); PG8_MMA(0, 1, At, B1); PG8_BAR;
            PG8_LDA(At, 1, 1); PG8_STAGE(PG8_SA(1, 0), a3, voffA);
            PG8_BAR; PG8_WAIT_L(0); PG8_MMA(1, 0, At, B0); PG8_BAR; PG8_SCHED;
            PG8_STAGE(PG8_SB(1, 1), b3 + hstep, voffB);
            PG8_WAIT_V(6); PG8_BAR; PG8_MMA(1, 1, At, B1); PG8_BAR;
        }
        PG8_STAMP();
        if constexpr (!Epi::AFTER_DRAIN) { E(acc, cur, wr, wc, fr, fq); S.done(cur); }
        PG8_STAMP();
        if (!has_next) break;
#pragma unroll
        for (int a = 0; a < 2; ++a)
#pragma unroll
            for (int b = 0; b < 2; ++b)
#pragma unroll
                for (int m = 0; m < 4; ++m)
#pragma unroll
                    for (int n = 0; n < 2; ++n) acc[a][b][m][n] = (f32x4){0.f, 0.f, 0.f, 0.f};
        cur = nxt; cA = nA; cB = nB; ++ui;
    }
    PG8_WAIT_V(0);
    if (wr == 0) PG8_BAR;
    PG8_BAR;
    if constexpr (Epi::AFTER_DRAIN) { E.fused(acc, cur, wr, wc, fr, fq, lds, wid, lane); S.done(cur); }
    PG8_STAMP();
    if (STAMP && wid == 0) { stamps[lane] = lane < nts ? (((unsigned long long)(unsigned)ts_hi << 32) | (unsigned)ts_lo) : 0ull;
        if (lane == 62) stamps[62] = rt_entry; if (lane == 63) stamps[63] = (unsigned long long)wall_clock64(); }
#undef PG8_STAMP
#undef PG8_SA
#undef PG8_SB
#undef PG8_STAGE
#undef PG8_LDA
#undef PG8_LDB
#undef PG8_MMA
#undef PG8_WAIT_V
#undef PG8_WAIT_L
#undef PG8_BAR
#undef PG8_SCHED
#undef voffB
}
}

struct EpiPlain {
    static constexpr bool PERM = false, AFTER_DRAIN = false;
    bf16_t* C; int ldc;
    __device__ __forceinline__ void operator()(const f32x4 (&acc)[2][2][4][2], const pg8::Unit& u, int, int, int, int) const {
        const int t_ = tidx(), wr = t_ >> 8, wc = (t_ >> 6) & 3, fr = t_ & 15, fq = (t_ >> 4) & 3;
#pragma unroll
        for (int ai = 0; ai < 2; ++ai)
#pragma unroll
            for (int m = 0; m < 4; ++m) { bf16_t* rowp = C + (size_t)(u.pm * 256 + ai * 128 + wr * 64 + m * 16 + fr) * ldc + u.pn * 256 + wc * 32 + 8 * fq;
#pragma unroll
                for (int bj = 0; bj < 2; ++bj) { const f32x4 v0 = acc[ai][bj][m][0], v1 = acc[ai][bj][m][1]; u32x4 w; w.x = cvt_pk(v0[0], v0[1]); w.y = cvt_pk(v0[2], v0[3]); w.z = cvt_pk(v1[0], v1[1]); w.w = cvt_pk(v1[2], v1[3]);
                    *(u32x4*)(rowp + bj * 128) = w; } }
    }
};
struct EpiF1 {
    static constexpr bool PERM = false, AFTER_DRAIN = false;
    const float* cw; const float* cb; bf16_t* act; bf16_t* E;
    __device__ __forceinline__ void operator()(const f32x4 (&acc)[2][2][4][2], const pg8::Unit& u, int, int, int, int) const {
        const int t_ = tidx(), wr = t_ >> 8, wc = (t_ >> 6) & 3, fr = t_ & 15, fq = (t_ >> 4) & 3;
        const int ch = u.pn * 128 + wc * 32 + 8 * fq;
#pragma unroll
        for (int ai = 0; ai < 2; ++ai) {
            const int strip = u.pm * 4 + ai * 2 + wr; const size_t rowbase = (size_t)u.pm * 256 + ai * 128 + wr * 64;
#pragma unroll
            for (int m = 0; m < 4; ++m) {
                const int rs = m * 16 + fr; f32x4 a[2];
#pragma unroll
                for (int n = 0; n < 2; ++n) {
                    const f32x4 c0 = *(const f32x4*)(cw + ch + 4 * n), c1 = *(const f32x4*)(cw + DFF + ch + 4 * n), c2 = *(const f32x4*)(cw + 2 * DFF + ch + 4 * n), cbv = *(const f32x4*)(cb + ch + 4 * n);
                    const f32x4 g0 = acc[ai][0][m][n], up = acc[ai][1][m][n]; f32x4 g1, g2;
#pragma unroll
                    for (int j = 0; j < 4; ++j) {
                        const float a1 = DPP_MOV(g0[j], 0x121), a2 = DPP_MOV(g0[j], 0x122);
                        float b1 = 0.f, b2 = 0.f;
                        if (m > 0) { b1 = DPP_MOV(acc[ai][0][m > 0 ? m - 1 : 0][n][j], 0x121); b2 = DPP_MOV(acc[ai][0][m > 0 ? m - 1 : 0][n][j], 0x122); }
                        g1[j] = fr >= 1 ? a1 : b1; g2[j] = fr >= 2 ? a2 : b2;
                    }
                    const f32x4 val = c2 * g0 + c1 * g1 + c0 * g2 + cbv;
#pragma unroll
                    for (int j = 0; j < 4; ++j) a[n][j] = val[j] * rcpf_(1.0f + __expf(-val[j])) * up[j];
                }
                const f32x4 gA = acc[ai][0][m][0], gB = acc[ai][0][m][1], uA = acc[ai][1][m][0], uB = acc[ai][1][m][1];
                u32x4 w;
                if (rs >= 2) { w.x = cvt_pk(a[0][0], a[0][1]); w.y = cvt_pk(a[0][2], a[0][3]); w.z = cvt_pk(a[1][0], a[1][1]); w.w = cvt_pk(a[1][2], a[1][3]); *(u32x4*)(act + (rowbase + rs) * DFF + ch) = w; }
                else { w.x = cvt_pk(gA[0], gA[1]); w.y = cvt_pk(gA[2], gA[3]); w.z = cvt_pk(gB[0], gB[1]); w.w = cvt_pk(gB[2], gB[3]); *(u32x4*)(E + ((size_t)strip * 6 + 2 + rs) * DFF + ch) = w;
                       w.x = cvt_pk(uA[0], uA[1]); w.y = cvt_pk(uA[2], uA[3]); w.z = cvt_pk(uB[0], uB[1]); w.w = cvt_pk(uB[2], uB[3]); *(u32x4*)(E + ((size_t)strip * 6 + 4 + rs) * DFF + ch) = w; }
                if (rs >= 62) { w.x = cvt_pk(gA[0], gA[1]); w.y = cvt_pk(gA[2], gA[3]); w.z = cvt_pk(gB[0], gB[1]); w.w = cvt_pk(gB[2], gB[3]); *(u32x4*)(E + ((size_t)strip * 6 + (rs - 62)) * DFF + ch) = w; }
            }
        }
    }
};
struct EpiScale {
    static constexpr bool PERM = false, AFTER_DRAIN = false;
    bf16_t* C; int ldc; float scale;
    __device__ __forceinline__ void operator()(const f32x4 (&acc)[2][2][4][2], const pg8::Unit& u, int, int, int, int) const {
        const int t_ = tidx(), wr = t_ >> 8, wc = (t_ >> 6) & 3, fr = t_ & 15, fq = (t_ >> 4) & 3;
#pragma unroll
        for (int ai = 0; ai < 2; ++ai)
#pragma unroll
            for (int m = 0; m < 4; ++m) { bf16_t* rowp = C + (size_t)(u.pm * 256 + ai * 128 + wr * 64 + m * 16 + fr) * ldc + u.pn * 256 + wc * 32 + 4 * fq;
#pragma unroll
                for (int bj = 0; bj < 2; ++bj)
#pragma unroll
                    for (int n = 0; n < 2; ++n) st_bf4(rowp + bj * 128 + n * 16, acc[ai][bj][m][n] * scale); }
    }
};
struct EpiN1kv {
    static constexpr bool PERM = false, AFTER_DRAIN = false;
    bf16_t* kv;
    __device__ __forceinline__ void operator()(const f32x4 (&acc)[2][2][4][2], const pg8::Unit& u, int, int, int, int) const {
        const int t_ = tidx(), wr = t_ >> 8, wc = (t_ >> 6) & 3, fr = t_ & 15, fq = (t_ >> 4) & 3;
        char* base = (char*)kv;
#pragma unroll
        for (int ai = 0; ai < 2; ++ai)
#pragma unroll
            for (int m = 0; m < 4; ++m) {
                const size_t row = (size_t)u.pm * 256 + ai * 128 + wr * 64 + m * 16 + fr;
#pragma unroll
                for (int bj = 0; bj < 2; ++bj)
#pragma unroll
                    for (int n = 0; n < 2; ++n) {
                        const int c128 = wc * 32 + n * 16 + fq * 4; const f32x4 v = acc[ai][bj][m][n];
                        if (u.pn < 3) {
                            const int cc = u.pn * 2 + bj;
                            if (cc == 0 || cc == 1 || cc == 4) { const size_t off = cc == 0 ? 0 : cc == 1 ? 8 * MiB : 24 * MiB; st_bf4((bf16_t*)(base + off) + row * 128 + c128, v); }
                            else if (cc == 2) { const int b = (int)(row >> 13), t = (int)(row & (SEQ - 1));
                                *(unsigned*)((unsigned char*)(base + 16 * MiB) + ((size_t)((b * 2 + (c128 >> 6)) * SEQ + t)) * 64 + (c128 & 63)) = pack_fp8x4(v[0], v[1], v[2], v[3]); }
                            else if (cc == 3) { const int b = (int)(row >> 13), t = (int)(row & (SEQ - 1));
                                unsigned char* dst = (unsigned char*)(base + 32 * MiB) + ((size_t)((b * 2 + (c128 >> 6)) * 128 + (t >> 6)) * 64 + (c128 & 63)) * 64 + (t & 63);
                                const unsigned pk = pack_fp8x4(v[0], v[1], v[2], v[3]);
                                for (int j = 0; j < 4; ++j) dst[j * 64] = (unsigned char)(pk >> (8 * j)); }
                            else { bf16_t* dst = (bf16_t*)(base + 40 * MiB); const int b = (int)(row >> 13), t = (int)(row & (SEQ - 1));
                                for (int j = 0; j < 4; ++j) dst[((size_t)(b * 128 + c128 + j)) * SEQ + t] = f2bf(v[j]); }
                        } else { if (bj == 0 && c128 < 48) { float* gates = (float*)(base + 48 * MiB); for (int j = 0; j < 4; ++j) gates[row * 48 + c128 + j] = sigmoidf_(v[j]); } }
                    }
            }
    }
};
struct EpiL1 {
    static constexpr bool PERM = false, AFTER_DRAIN = false;
    bf16_t *qe, *ke, *vT, *r; float* adn;
    __device__ __forceinline__ void operator()(const f32x4 (&acc)[2][2][4][2], const pg8::Unit& u, int, int, int, int) const {
        const int t_ = tidx(), wr = t_ >> 8, wc = (t_ >> 6) & 3, fr = t_ & 15, fq = (t_ >> 4) & 3;
#pragma unroll
        for (int ai = 0; ai < 2; ++ai)
#pragma unroll
            for (int m = 0; m < 4; ++m) {
                const size_t row = (size_t)u.pm * 256 + ai * 128 + wr * 64 + m * 16 + fr;
#pragma unroll
                for (int bj = 0; bj < 2; ++bj)
#pragma unroll
                    for (int n = 0; n < 2; ++n) {
                        const int c = bj * 128 + wc * 32 + n * 16 + fq * 4; const f32x4 v = acc[ai][bj][m][n];
                        if (u.pn < 2) st_bf4(qe + row * 512 + u.pn * 256 + c, v * 0.08838834764831845f);
                        else if (u.pn < 4) st_bf4(ke + row * 512 + (u.pn - 2) * 256 + c, v);
                        else if (u.pn < 8) { const int b = (int)(row >> 13), t = (int)(row & (SEQ - 1)), vc = (u.pn - 4) * 256 + c;
                            for (int j = 0; j < 4; ++j) vT[((size_t)(b * 1024 + vc + j)) * SEQ + t] = f2bf(v[j]); }
                        else if (u.pn < 12) st_bf4(r + row * DM + (u.pn - 8) * 256 + c, v);
                        else { if (c < 16) *(f32x4*)(adn + row * 16 + c) = v; }
                    }
            }
    }
};
template <class Epi>
DEV void phase_gemm_pg8(const bf16_t* A, int lda, const bf16_t* Bt, int N, int K, const Epi& E, char* smem) {
    pg8::Gemm g; g.A = A; g.Bt = Bt; g.M = T; g.N = N; g.K = K; g.lda = lda;
    pg8::StaticOrder S; S.init(T, N, (int)gridDim.x, (int)blockIdx.x);
    pg8::gemm_phase<Epi, pg8::StaticOrder, false>((PG8_LAS unsigned char*)smem, g, S, E, nullptr);
}
struct LaneId { int lane, wid, wm, wn, fr, fq; };
DEV LaneId lane_id() { LaneId l; l.lane = tidx() & 63; l.wid = tidx() >> 6; l.wm = l.wid >> 1; l.wn = l.wid & 1; l.fr = l.lane & 15; l.fq = l.lane >> 4; return l; }

template <class Map>
DEV void prep_T(bf16_t* dst, const float* src, int Ks, int Ns, int Nd, int Kd, Map map, char* smem, int& cursor) {
    float* tile = (float*)smem;
    const int ntn = Nd >> 6, ntiles = ntn * (Kd >> 6), tid = tidx(), G = (int)gridDim.x;
    int first = ((int)blockIdx.x - cursor) % G; if (first < 0) first += G;
    for (int tl = first; tl < ntiles; tl += G) {
        const int n0 = (tl % ntn) * 64, k0 = (tl / ntn) * 64;
        { const int j4 = (tid & 15) * 4, kr = tid >> 4;
          const int m0 = map(n0 + j4), m3 = map(n0 + j4 + 3);
          const bool vec = (m0 >= 0) && (m3 == m0 + 3) && ((Ns & 3) == 0) && ((m0 & 3) == 0);
#pragma unroll
          for (int p = 0; p < 2; ++p) { const int kk = kr + 32 * p, k = k0 + kk; f32x4 v = {0.f, 0.f, 0.f, 0.f};
              if (k < Ks) { if (vec) v = *(const f32x4*)(src + (size_t)k * Ns + m0);
                            else { for (int q = 0; q < 4; ++q) { const int n = map(n0 + j4 + q); v[q] = n >= 0 ? src[(size_t)k * Ns + n] : 0.f; } } }
              tile[kk * 65 + j4] = v[0]; tile[kk * 65 + j4 + 1] = v[1]; tile[kk * 65 + j4 + 2] = v[2]; tile[kk * 65 + j4 + 3] = v[3]; } }
        __syncthreads();
        { const int r = tid >> 3, c8 = (tid & 7) * 8;
          u32x4 w; w.x = cvt_pk(tile[(c8 + 0) * 65 + r], tile[(c8 + 1) * 65 + r]); w.y = cvt_pk(tile[(c8 + 2) * 65 + r], tile[(c8 + 3) * 65 + r]);
          w.z = cvt_pk(tile[(c8 + 4) * 65 + r], tile[(c8 + 5) * 65 + r]); w.w = cvt_pk(tile[(c8 + 6) * 65 + r], tile[(c8 + 7) * 65 + r]);
          *(u32x4*)(dst + (size_t)(n0 + r) * Kd + k0 + c8) = w; }
        __syncthreads();
    }
    cursor += ntiles;
}
struct MapId { int ns; DEV int operator()(int n) const { return n < ns ? n : -1; } };
struct MapPerm { int ns; DEV int operator()(int n) const { return n < ns ? (n & ~31) + pg8::perm32(n & 31) : -1; } };
struct MapFfn { DEV int operator()(int v) const { const int pn = v >> 8, c = v & 255, cc = (c & 96) + pg8::perm32(c & 31); return c < 128 ? 128 * pn + cc : DFF + 128 * pn + cc; } };

DEV void phase_prep(const Params& P, int layer, char* smem) {
    char* ws = P.ws; int cur = 0;
    const int kind = layer % 3, j = layer / 3;
    prep_T((bf16_t*)(ws + OFF_WF1), P.in[I_FWIN] + (size_t)layer * DM * 2 * DFF, DM, 2 * DFF, 2 * DFF, DM, MapFfn{}, smem, cur);
    prep_T((bf16_t*)(ws + OFF_WF2), P.in[I_FWOUT] + (size_t)layer * DFF * DM, DFF, DM, DM, DFF, MapPerm{DM}, smem, cur);
    bf16_t* mix = (bf16_t*)(ws + OFF_MIX);
    if (kind == 0) {
        const float* wrkv = P.in[I_WRKV] + (size_t)j * 3 * DM * DM;
        prep_T(mix, wrkv, DM, DM, DM, DM, MapId{DM}, smem, cur);
        prep_T(mix + (size_t)1024 * DM, wrkv + (size_t)DM * DM, DM, DM, DM, DM, MapId{DM}, smem, cur);
        prep_T(mix + (size_t)2048 * DM, P.in[I_W1] + (size_t)j * DM * 64, DM, 64, 128, DM, MapId{64}, smem, cur);
        prep_T(mix + (size_t)2176 * DM, P.in[I_A1] + (size_t)j * DM * 64, DM, 64, 128, DM, MapId{64}, smem, cur);
        prep_T(mix + (size_t)2304 * DM, P.in[I_G1] + (size_t)j * DM * 128, DM, 128, 128, DM, MapId{128}, smem, cur);
        if (j > 0) prep_T(mix + (size_t)2432 * DM, P.in[I_V1] + (size_t)(j - 1) * DM * 32, DM, 32, 128, DM, MapId{32}, smem, cur);
        else       prep_T(mix + (size_t)2432 * DM, P.in[I_V1], DM, 32, 128, DM, MapId{0}, smem, cur);
        prep_T((bf16_t*)((char*)mix + 5 * MiB), wrkv + (size_t)2 * DM * DM, DM, DM, DM, DM, MapId{DM}, smem, cur);
        prep_T((bf16_t*)((char*)mix + 7 * MiB), P.in[I_W2] + (size_t)j * 64 * DM, 64, DM, DM, 64, MapId{DM}, smem, cur);
        prep_T((bf16_t*)((char*)mix + 7 * MiB + 131072), P.in[I_A2] + (size_t)j * 64 * DM, 64, DM, DM, 64, MapId{DM}, smem, cur);
        if (j > 0) prep_T((bf16_t*)((char*)mix + 7 * MiB + 262144), P.in[I_V2] + (size_t)(j - 1) * 32 * DM, 32, DM, DM, 64, MapId{DM}, smem, cur);
        prep_T((bf16_t*)((char*)mix + 7 * MiB + 393216), P.in[I_G2] + (size_t)j * 128 * DM, 128, DM, DM, 128, MapId{DM}, smem, cur);
        prep_T((bf16_t*)((char*)mix + 8 * MiB), P.in[I_RWO] + (size_t)j * DM * DM, DM, DM, DM, DM, MapPerm{DM}, smem, cur);
    } else if (kind == 1) {
        prep_T(mix, P.in[I_NWIN], DM, 1840, 2048, DM, MapId{1840}, smem, cur);
        prep_T((bf16_t*)((char*)mix + 4 * MiB), P.in[I_CW1], 2048, 256, 256, 2048, MapId{256}, smem, cur);
        prep_T((bf16_t*)((char*)mix + 4 * MiB) + (size_t)256 * 2048, P.in[I_CW1] + (size_t)2048 * 256, 2048, 256, 256, 2048, MapId{256}, smem, cur);
        prep_T((bf16_t*)((char*)mix + 6 * MiB), P.in[I_CW2], 256, 64, 128, 256, MapId{64}, smem, cur);
        prep_T((bf16_t*)((char*)mix + 6 * MiB) + (size_t)128 * 256, P.in[I_CW2] + (size_t)256 * 64, 256, 64, 128, 256, MapId{64}, smem, cur);
        prep_T((bf16_t*)((char*)mix + 7 * MiB), P.in[I_NWO], DM, DM, DM, DM, MapPerm{DM}, smem, cur);
        { const int lane = tidx() & 63, gw = blockIdx.x * (NTHR / 64) + (tidx() >> 6);
          if (gw < 512) { const int c = gw >> 8, col = gw & 255; const float* w1 = P.in[I_CW1] + (size_t)c * 2048 * 256; const float* pe = P.in[I_CPE] + (size_t)c * 2048;
              float sacc = 0.f; for (int k = lane; k < 2048; k += 64) sacc += pe[k] * w1[(size_t)k * 256 + col];
              sacc = wave_sum(sacc); if (lane == 0) ((float*)(ws + OFF_BIASP))[gw] = sacc + P.in[I_CB1][c * 256 + col]; } }
    } else {
        prep_T(mix, P.in[I_GWIN], DM, 3088, 3328, DM, MapId{3088}, smem, cur);
        prep_T((bf16_t*)((char*)mix + 7 * MiB), P.in[I_GWO], DM, DM, DM, DM, MapPerm{DM}, smem, cur);
    }
}

template <int HIN, int HOUT>
DEV void phase_norm(const void* h_in, const bf16_t* z, const float* g_post, void* h_out, float* stage, const float* g_pre, bf16_t* xn) {
    const int lane = tidx() & 63, gw = blockIdx.x * (NTHR / 64) + (tidx() >> 6), nw = gridDim.x * (NTHR / 64);
    for (int row = gw; row < T; row += nw) {
        f32x4 hv[4];
#pragma unroll
        for (int i = 0; i < 4; ++i) { const size_t off = (size_t)row * DM + i * 256 + lane * 4;
            if (HIN == 0) hv[i] = *(const f32x4*)((const float*)h_in + off); else hv[i] = ld_bf4((const bf16_t*)h_in + off); }
        if (z) {
            f32x4 zv[4]; float ss = 0.f;
#pragma unroll
            for (int i = 0; i < 4; ++i) { zv[i] = ld_bf4(z + (size_t)row * DM + i * 256 + lane * 4); ss += zv[i][0] * zv[i][0] + zv[i][1] * zv[i][1] + zv[i][2] * zv[i][2] + zv[i][3] * zv[i][3]; }
            ss = wave_sum(ss); const float rs = rsqrtf(ss * (1.0f / DM) + 1e-6f);
#pragma unroll
            for (int i = 0; i < 4; ++i) { const f32x4 g = *(const f32x4*)(g_post + i * 256 + lane * 4); hv[i] += zv[i] * rs * g; }
        }
        if (HOUT == 1) {
#pragma unroll
            for (int i = 0; i < 4; ++i) st_bf4((bf16_t*)h_out + (size_t)row * DM + i * 256 + lane * 4, hv[i]);
        }
        if (HOUT == 2) {
            float* dst = row < T / 2 ? (float*)h_out + (size_t)row * DM : stage + (size_t)(row - T / 2) * DM;
#pragma unroll
            for (int i = 0; i < 4; ++i) *(f32x4*)(dst + i * 256 + lane * 4) = hv[i];
        }
        if (xn) {
            float ss = 0.f;
#pragma unroll
            for (int i = 0; i < 4; ++i) ss += hv[i][0] * hv[i][0] + hv[i][1] * hv[i][1] + hv[i][2] * hv[i][2] + hv[i][3] * hv[i][3];
            ss = wave_sum(ss); const float rs = rsqrtf(ss * (1.0f / DM) + 1e-6f);
#pragma unroll
            for (int i = 0; i < 4; ++i) { const f32x4 g = *(const f32x4*)(g_pre + i * 256 + lane * 4); st_bf4(xn + (size_t)row * DM + i * 256 + lane * 4, hv[i] * rs * g); }
        }
    }
}
DEV void phase_copy_out(const float* stage, float* out) {
    const size_t gt = (size_t)blockIdx.x * NTHR + tidx(), nt = (size_t)gridDim.x * NTHR;
    for (size_t i = gt; i < (size_t)(T / 2) * DM / 4; i += nt) ((f32x4*)(out + (size_t)(T / 2) * DM))[i] = ((const f32x4*)stage)[i];
}

DEV void phase_gemm_plain(const bf16_t* A, int lda, const bf16_t* Bt, int K, int ntn, bf16_t* C, int ldc, char* smem) {
    const LaneId L = lane_id();
    const int nunits = (T / 256) * ntn;
    for (int u = blockIdx.x; u < nunits; u += gridDim.x) {
        const int tm = u / ntn, tn = u % ntn;
        f32x4 acc[4][4];
        gemm_core(acc, LdPlain{A + (size_t)tm * 256 * lda, lda}, LdPlain{Bt + (size_t)tn * 128 * K, K}, K, smem);
#pragma unroll
        for (int m = 0; m < 4; ++m)
#pragma unroll
            for (int n = 0; n < 4; ++n)
                st_bf4(C + (size_t)(tm * 256 + L.wm * 64 + m * 16 + L.fr) * ldc + tn * 128 + L.wn * 64 + n * 16 + L.fq * 4, acc[m][n]);
    }
}

DEV void phase_f1(const bf16_t* xn, const bf16_t* Bt, const float* cw, const float* cb, bf16_t* act, bf16_t* E, char* smem) {
    const LaneId L = lane_id();
    const int ntn = 2 * DFF / 128, nunits = (T / 256) * ntn;
    for (int u = blockIdx.x; u < nunits; u += gridDim.x) {
        const int tm = u / ntn, tn = u % ntn;
        f32x4 acc[4][4];
        gemm_core(acc, LdPlain{xn + (size_t)tm * 256 * DM, DM}, LdPlain{Bt + (size_t)tn * 128 * DM, DM}, DM, smem);
        const int strip = tm * 4 + L.wm; const size_t rowbase = (size_t)tm * 256 + L.wm * 64;
#pragma unroll
        for (int n = 0; n < 2; ++n) {
            const int ch = tn * 64 + L.wn * 32 + n * 16 + L.fq * 4;
            const f32x4 c0 = *(const f32x4*)(cw + ch), c1 = *(const f32x4*)(cw + DFF + ch), c2 = *(const f32x4*)(cw + 2 * DFF + ch), cbv = *(const f32x4*)(cb + ch);
#pragma unroll
            for (int m = 0; m < 4; ++m) {
                const f32x4 g0 = acc[m][n], up = acc[m][n + 2]; f32x4 g1, g2;
#pragma unroll
                for (int j = 0; j < 4; ++j) {
                    const float a1 = __shfl(g0[j], (L.lane - 1) & 63), a2 = __shfl(g0[j], (L.lane - 2) & 63);
                    float b1 = 0.f, b2 = 0.f;
                    if (m > 0) { b1 = __shfl(acc[m > 0 ? m - 1 : 0][n][j], (L.lane + 15) & 63); b2 = __shfl(acc[m > 0 ? m - 1 : 0][n][j], (L.lane + 14) & 63); }
                    g1[j] = L.fr >= 1 ? a1 : b1; g2[j] = L.fr >= 2 ? a2 : b2;
                }
                const int rs = m * 16 + L.fr;
                f32x4 val = c2 * g0 + c1 * g1 + c0 * g2 + cbv, a;
#pragma unroll
                for (int j = 0; j < 4; ++j) a[j] = val[j] * rcpf_(1.0f + __expf(-val[j])) * up[j];
                if (rs >= 2) st_bf4(act + (rowbase + rs) * DFF + ch, a);
                else { st_bf4(E + ((size_t)strip * 6 + 2 + rs) * DFF + ch, g0); st_bf4(E + ((size_t)strip * 6 + 4 + rs) * DFF + ch, up); }
                if (rs >= 62) st_bf4(E + ((size_t)strip * 6 + (rs - 62)) * DFF + ch, g0);
            }
        }
    }
}
DEV void phase_f1b(const float* cw, const float* cb, bf16_t* act, const bf16_t* E) {
    const int gt = blockIdx.x * NTHR + tidx(), nt = gridDim.x * NTHR;
    for (int idx = gt; idx < 512 * 2 * (DFF / 4); idx += nt) {
        const int ch = (idx % (DFF / 4)) * 4, r = (idx / (DFF / 4)) & 1, strip = idx / (2 * (DFF / 4));
        const bool first = (strip & 127) == 0;
        const f32x4 zero = {0.f, 0.f, 0.f, 0.f};
        const f32x4 g0 = ld_bf4(E + ((size_t)strip * 6 + 2 + r) * DFF + ch), up = ld_bf4(E + ((size_t)strip * 6 + 4 + r) * DFF + ch);
        f32x4 g1, g2;
        if (r == 1) { g1 = ld_bf4(E + ((size_t)strip * 6 + 2) * DFF + ch); g2 = first ? zero : ld_bf4(E + ((size_t)(strip - 1) * 6 + 1) * DFF + ch); }
        else { g1 = first ? zero : ld_bf4(E + ((size_t)(strip - 1) * 6 + 1) * DFF + ch); g2 = first ? zero : ld_bf4(E + ((size_t)(strip - 1) * 6 + 0) * DFF + ch); }
        const f32x4 c0 = *(const f32x4*)(cw + ch), c1 = *(const f32x4*)(cw + DFF + ch), c2 = *(const f32x4*)(cw + 2 * DFF + ch), cbv = *(const f32x4*)(cb + ch);
        f32x4 val = c2 * g0 + c1 * g1 + c0 * g2 + cbv, a;
#pragma unroll
        for (int j = 0; j < 4; ++j) a[j] = val[j] * rcpf_(1.0f + __expf(-val[j])) * up[j];
        st_bf4(act + ((size_t)strip * 64 + r) * DFF + ch, a);
    }
}

struct RwkvW { const float *mu, *w0, *a0, *k_k, *k_a, *r_k, *ln_w, *ln_b, *v0; bool vres; };
DEV void phase_r1(const bf16_t* xn, const bf16_t* Bt, const RwkvW& W, bf16_t* rb, bf16_t* kb, bf16_t* hid, char* smem) {
    const LaneId L = lane_id();
    const int ntn = 20, nunits = (T / 256) * ntn;
    for (int u = blockIdx.x; u < nunits; u += gridDim.x) {
        const int tm = u / ntn, tn = u % ntn;
        const int var = tn < 8 ? 0 : tn < 16 ? 2 : tn == 16 ? 1 : tn == 17 ? 4 : tn == 18 ? 5 : 3;
        f32x4 acc[4][4];
        gemm_core(acc, LdMix{xn, W.mu + var * DM, tm * 256, {0.f, 0.f, 0.f, 0.f}, {0.f, 0.f, 0.f, 0.f}}, LdPlain{Bt + (size_t)tn * 128 * DM, DM}, DM, smem);
#pragma unroll
        for (int m = 0; m < 4; ++m)
#pragma unroll
            for (int n = 0; n < 4; ++n) {
                const size_t row = (size_t)tm * 256 + L.wm * 64 + m * 16 + L.fr; const int c = L.wn * 64 + n * 16 + L.fq * 4; f32x4 v = acc[m][n];
                if (tn < 8) st_bf4(rb + row * DM + tn * 128 + c, v);
                else if (tn < 16) st_bf4(kb + row * DM + (tn - 8) * 128 + c, v);
                else if (tn == 16) { if (L.wn == 0) { for (int j = 0; j < 4; ++j) v[j] = tanhf(v[j]); st_bf4(hid + row * HIDP + c, v); } }
                else if (tn == 17) { if (L.wn == 0) st_bf4(hid + row * HIDP + 64 + c, v); }
                else if (tn == 18) { for (int j = 0; j < 4; ++j) v[j] = sigmoidf_(v[j]); st_bf4(hid + row * HIDP + 128 + c, v); }
                else { if (L.wn == 0) st_bf4(hid + row * HIDP + 256 + c, v); }
            }
    }
}
DEV void phase_r2(const bf16_t* xn, const bf16_t* mixw, const RwkvW& W, const bf16_t* hid, const bf16_t* rb, float* bsc, bf16_t* wb, bf16_t* kb, bf16_t* kkb, bf16_t* kab, bf16_t* vb, char* smem) {
    const LaneId L = lane_id();
    const bf16_t* Bv = (const bf16_t*)((const char*)mixw + 5 * MiB);
    const bf16_t* W2T = (const bf16_t*)((const char*)mixw + 7 * MiB);
    const bf16_t* A2T = (const bf16_t*)((const char*)mixw + 7 * MiB + 131072);
    const bf16_t* V2T = (const bf16_t*)((const char*)mixw + 7 * MiB + 262144);
    const int nunits = 1024 + 2048;
    for (int u = blockIdx.x; u < nunits; u += gridDim.x) {
        if (u < 1024) {
            const int tm = u >> 3, tn = u & 7;
            f32x4 acc[4][4]; u32x2 gpk[4][4];
            if (W.vres) {
                gemm_core(acc, LdPlain{hid + (size_t)tm * 256 * HIDP + 256, HIDP}, LdPlain{V2T + (size_t)tn * 128 * 64, 64}, 64, smem);
#pragma unroll
                for (int m = 0; m < 4; ++m)
#pragma unroll
                    for (int n = 0; n < 4; ++n) { const int col = tn * 128 + L.wn * 64 + n * 16 + L.fq * 4; const f32x4 b = *(const f32x4*)(W.v0 + col);
                        gpk[m][n].x = cvt_pk(sigmoidf_(b[0] + acc[m][n][0]), sigmoidf_(b[1] + acc[m][n][1]));
                        gpk[m][n].y = cvt_pk(sigmoidf_(b[2] + acc[m][n][2]), sigmoidf_(b[3] + acc[m][n][3])); }
            }
            gemm_core(acc, LdMix{xn, W.mu + 3 * DM, tm * 256, {0.f, 0.f, 0.f, 0.f}, {0.f, 0.f, 0.f, 0.f}}, LdPlain{Bv + (size_t)tn * 128 * DM, DM}, DM, smem);
#pragma unroll
            for (int m = 0; m < 4; ++m)
#pragma unroll
                for (int n = 0; n < 4; ++n) {
                    const size_t row = (size_t)tm * 256 + L.wm * 64 + m * 16 + L.fr; const int col = tn * 128 + L.wn * 64 + n * 16 + L.fq * 4; f32x4 v = acc[m][n];
                    if (W.vres) { const f32x4 vf = ld_bf4(vb + row * DM + col); f32x4 gt; gt[0] = bf_lo(gpk[m][n].x); gt[1] = bf_hi(gpk[m][n].x); gt[2] = bf_lo(gpk[m][n].y); gt[3] = bf_hi(gpk[m][n].y); v = v + (vf - v) * gt; }
                    st_bf4(vb + row * DM + col, v);
                }
        } else {
            const int u2 = u - 1024, tm = u2 >> 4, jj = u2 & 15;
            f32x4 acc[4][4];
            if (jj < 8) {
                const int tn = jj;
                gemm_core(acc, LdPlain{hid + (size_t)tm * 256 * HIDP, HIDP}, LdPlain{W2T + (size_t)tn * 128 * 64, 64}, 64, smem);
#pragma unroll
                for (int m = 0; m < 4; ++m)
#pragma unroll
                    for (int n = 0; n < 4; ++n) {
                        const size_t row = (size_t)tm * 256 + L.wm * 64 + m * 16 + L.fr; const int col = tn * 128 + L.wn * 64 + n * 16 + L.fq * 4; const f32x4 b = *(const f32x4*)(W.w0 + col); f32x4 v;
                        for (int j = 0; j < 4; ++j) { const float x = b[j] + acc[m][n][j]; const float y = -x;
                            const float sp = fmaxf(y, 0.f) + log1pf(__expf(-fabsf(y))); const float w = -sp - 0.5f; v[j] = __expf(-__expf(w)); }
                        st_bf4(wb + row * DM + col, v);
                    }
            } else {
                const int tn = jj - 8;
                gemm_core(acc, LdPlain{hid + (size_t)tm * 256 * HIDP + 64, HIDP}, LdPlain{A2T + (size_t)tn * 128 * 64, 64}, 64, smem);
#pragma unroll
                for (int m = 0; m < 4; ++m) {
                    const size_t row = (size_t)tm * 256 + L.wm * 64 + m * 16 + L.fr;
                    u32x2 kpk[4]; float ss = 0.f;
#pragma unroll
                    for (int n = 0; n < 4; ++n) { const int col = tn * 128 + L.wn * 64 + n * 16 + L.fq * 4;
                        kpk[n] = *(const u32x2*)(kb + row * DM + col); const f32x4 kkw = *(const f32x4*)(W.k_k + col);
                        const float c0 = bf_lo(kpk[n].x) * kkw[0], c1 = bf_hi(kpk[n].x) * kkw[1], c2 = bf_lo(kpk[n].y) * kkw[2], c3 = bf_hi(kpk[n].y) * kkw[3];
                        ss += (c0 * c0 + c1 * c1) + (c2 * c2 + c3 * c3); }
                    ss += __shfl_xor(ss, 16); ss += __shfl_xor(ss, 32);
                    const float inv = rcpf_(fmaxf(sqrtf(ss), 1e-12f));
                    asm volatile("" ::: "memory");
                    float bon = 0.f;
#pragma unroll
                    for (int n = 0; n < 4; ++n) { const int col = tn * 128 + L.wn * 64 + n * 16 + L.fq * 4;
                        const f32x4 ka = *(const f32x4*)(W.k_a + col), kkw = *(const f32x4*)(W.k_k + col), a0 = *(const f32x4*)(W.a0 + col), rkv = *(const f32x4*)(W.r_k + col), rv = ld_bf4(rb + row * DM + col);
                        f32x4 kv; kv[0] = bf_lo(kpk[n].x); kv[1] = bf_hi(kpk[n].x); kv[2] = bf_lo(kpk[n].y); kv[3] = bf_hi(kpk[n].y);
                        f32x4 kk, kp, kka;
                        for (int j = 0; j < 4; ++j) { const float a = sigmoidf_(a0[j] + acc[m][n][j]); kk[j] = kv[j] * kkw[j] * inv; kp[j] = kv[j] * (1.0f + (a - 1.0f) * ka[j]); kka[j] = kk[j] * a; }
                        const u32x2 kpp = {cvt_pk(kp[0], kp[1]), cvt_pk(kp[2], kp[3])};
                        bon += rv[0] * bf_lo(kpp.x) * rkv[0] + rv[1] * bf_hi(kpp.x) * rkv[1] + rv[2] * bf_lo(kpp.y) * rkv[2] + rv[3] * bf_hi(kpp.y) * rkv[3];
                        *(u32x2*)(kb + row * DM + col) = kpp; st_bf4(kkb + row * DM + col, kk); st_bf4(kab + row * DM + col, kka);
                        asm volatile("" ::: "memory"); }
                    bon += __shfl_xor(bon, 16); bon += __shfl_xor(bon, 32);
                    if (L.fq == 0) bsc[row * 16 + tn * 2 + L.wn] = bon;
                }
            }
        }
    }
}
typedef float f32x2 __attribute__((ext_vector_type(2)));
constexpr int R3_CH = 32, R3_STR = R3_CH * 256, R3_BUF = 5 * R3_STR + R3_CH * 64;
DEV void r3_stage_raw(const bf16_t* const (&str)[5], const bf16_t* vb, size_t base, int vrow0, int t0, char* buf, int id) {
    u32x4 d[5];
    const int t = id >> 3, j = id & 7;
#pragma unroll
    for (int st = 0; st < 5; ++st) d[st] = *(const u32x4*)(str[st] + base + (size_t)(t0 + t) * DM + j * 8);
    u32x4 vv = {0u, 0u, 0u, 0u};
    if (id < 64) vv = *(const u32x4*)(vb + base + (size_t)(t0 + (id >> 1)) * DM + vrow0 + (id & 1) * 8);
#pragma unroll
    for (int st = 0; st < 5; ++st) { f32x4 a, b; a[0] = bf_lo(d[st].x); a[1] = bf_hi(d[st].x); a[2] = bf_lo(d[st].y); a[3] = bf_hi(d[st].y); b[0] = bf_lo(d[st].z); b[1] = bf_hi(d[st].z); b[2] = bf_lo(d[st].w); b[3] = bf_hi(d[st].w);
        float* p = (float*)(buf + st * R3_STR + t * 256 + j * 32); *(f32x4*)p = a; *(f32x4*)(p + 4) = b; }
    if (id < 64) { f32x4 a, b; a[0] = bf_lo(vv.x); a[1] = bf_hi(vv.x); a[2] = bf_lo(vv.y); a[3] = bf_hi(vv.y); b[0] = bf_lo(vv.z); b[1] = bf_hi(vv.z); b[2] = bf_lo(vv.w); b[3] = bf_hi(vv.w);
        float* vp = (float*)(buf + 5 * R3_STR + (id >> 1) * 64 + (id & 1) * 32); *(f32x4*)vp = a; *(f32x4*)(vp + 4) = b; }
}
DEV void phase_r3(const bf16_t* rb, const bf16_t* wb, const bf16_t* kb, const bf16_t* kkb, const bf16_t* kab, const bf16_t* vb, bf16_t* yb, float* bsc, const float* r_k, char* smem) {
    const int tid = tidx(), lane = tid & 63, wid = tid >> 6;
    const bf16_t* const str[5] = {rb, wb, kb, kkb, kab};
    constexpr int NCH = SEQ / R3_CH;
    for (int task = blockIdx.x; task < 256; task += gridDim.x) {
        const int bh = task >> 2, b = bh >> 4, h = bh & 15, rq = task & 3;
        const size_t base = (size_t)b * SEQ * DM + h * 64;
        bf16_t* ystage = (bf16_t*)(smem + 131072 + 64);
    float* gcarea = (float*)(smem + 3 * R3_BUF);
        if (wid >= 4) r3_stage_raw(str, vb, base, rq * 16, 0, smem, tid - 256);
        __syncthreads();
        if (wid >= 4) { r3_stage_raw(str, vb, base, rq * 16, R3_CH, smem + R3_BUF, tid - 256);
            char* bq = smem; float* w = (float*)bq + R3_STR / 4 + lane; const int p = wid - 4;
            float G = 1.f; for (int t = 0; t < 8 * p; ++t) G *= w[t * 64];
            float* r = (float*)bq + lane; float* k = r + 2 * (R3_STR / 4); float* q = r + 3 * (R3_STR / 4); float* a = r + 4 * (R3_STR / 4);
#pragma unroll
            for (int u = 0; u < 8; ++u) { const int t = 8 * p + u; const float Gold = G; G *= w[t * 64]; const float inv = rcpf_(G); r[t * 64] *= G; q[t * 64] *= Gold; k[t * 64] *= inv; a[t * 64] *= inv; }
            if (p == 3) gcarea[lane] = G; }
        __syncthreads();
        const int rr = lane >> 4, cg = lane & 15, rg = rq * 4 + wid;
        const size_t voff = base + rg * 4 + rr;
        f32x2 s01 = {0.f, 0.f}, s23 = {0.f, 0.f};
        for (int c = 0; c < NCH; ++c) {
            if (wid >= 4) {
                if (c >= 1 && tid - 256 < 64) { const int id = tid - 256;
                    *(u32x4*)(yb + base + (size_t)((c - 1) * R3_CH + (id >> 1)) * DM + rq * 16 + (id & 1) * 8) = *(const u32x4*)(ystage + ((c - 1) & 1) * 512 + (id >> 1) * 16 + (id & 1) * 8); }
                if (c + 2 < NCH) r3_stage_raw(str, vb, base, rq * 16, (c + 2) * R3_CH, smem + ((c + 2) % 3) * R3_BUF, tid - 256);
                if (c + 1 < NCH) { char* bq = smem + ((c + 1) % 3) * R3_BUF; float* w = (float*)bq + R3_STR / 4 + lane; const int p = wid - 4;
                    float G = 1.f; for (int t = 0; t < 8 * p; ++t) G *= w[t * 64];
                    float* r = (float*)bq + lane; float* k = r + 2 * (R3_STR / 4); float* q = r + 3 * (R3_STR / 4); float* a = r + 4 * (R3_STR / 4);
#pragma unroll
                    for (int u = 0; u < 8; ++u) { const int t = 8 * p + u; const float Gold = G; G *= w[t * 64]; const float inv = rcpf_(G); r[t * 64] *= G; q[t * 64] *= Gold; k[t * 64] *= inv; a[t * 64] *= inv; }
                    if (p == 3) gcarea[((c + 1) % 3) * 64 + lane] = G; }
            } else {
                const char* buf = smem + (c % 3) * R3_BUF;
                f32x4 R_[2][2], K_[2][2], Q_[2][2], A_[2][2]; float V_[2][2];
#define R3_LD(bf, t0) { _Pragma("unroll") for (int u = 0; u < 2; ++u) { const char* p = buf + ((t0) + u) * 256 + cg * 16; \
                    R_[bf][u] = *(const f32x4*)p; K_[bf][u] = *(const f32x4*)(p + 2 * R3_STR); Q_[bf][u] = *(const f32x4*)(p + 3 * R3_STR); A_[bf][u] = *(const f32x4*)(p + 4 * R3_STR); \
                    V_[bf][u] = *(const float*)(buf + 5 * R3_STR + ((t0) + u) * 64 + (wid * 4 + rr) * 4); } }
#define R3_CP(bf, sl) { _Pragma("unroll") for (int u = 0; u < 2; ++u) { \
                    const f32x4 R = R_[bf][u], K = K_[bf][u], Q = Q_[bf][u], A = A_[bf][u]; const float vv = V_[bf][u]; \
                    const f32x2 r01 = {R[0], R[1]}, r23 = {R[2], R[3]}, k01 = {K[0], K[1]}, k23 = {K[2], K[3]}; \
                    const f32x2 q01 = {Q[0], Q[1]}, q23 = {Q[2], Q[3]}, a01 = {A[0], A[1]}, a23 = {A[2], A[3]}; \
                    const f32x2 pq = s01 * q01 + s23 * q23; \
                    const float sa = -row16_sum(pq.x + pq.y); \
                    const f32x2 sa2 = {sa, sa}, vv2 = {vv, vv}; \
                    s01 = (s01 + vv2 * k01) + sa2 * a01; s23 = (s23 + vv2 * k23) + sa2 * a23; \
                    const f32x2 py = s01 * r01 + s23 * r23; \
                    const float y = row16_sum(py.x + py.y); \
                    yv = (cg == (sl) + u) ? y : yv; } }
                R3_LD(0, 0)
#pragma unroll 1
                for (int t8 = 0; t8 < R3_CH; t8 += 8) {
                    float yv = 0.f;
                    R3_LD(1, t8 + 2)
                    R3_CP(0, 0)
                    R3_LD(0, t8 + 4)
                    R3_CP(1, 2)
                    R3_LD(1, t8 + 6)
                    R3_CP(0, 4)
                    if (t8 + 8 < R3_CH) R3_LD(0, t8 + 8)
                    R3_CP(1, 6)
                    if (cg < 8) ystage[(c & 1) * 512 + (t8 + cg) * 16 + wid * 4 + rr] = f2bf(yv);
                }
#undef R3_LD
#undef R3_CP
                const f32x4 GC = *(const f32x4*)(gcarea + (c % 3) * 64 + cg * 4);
                s01 *= (f32x2){GC[0], GC[1]}; s23 *= (f32x2){GC[2], GC[3]};
            }
            __syncthreads();
        }
        if (wid >= 4 && tid - 256 < 64) { const int id = tid - 256;
            *(u32x4*)(yb + base + (size_t)((NCH - 1) * R3_CH + (id >> 1)) * DM + rq * 16 + (id & 1) * 8) = *(const u32x4*)(ystage + ((NCH - 1) & 1) * 512 + (id >> 1) * 16 + (id & 1) * 8); }
        __syncthreads();
    }
}
constexpr int RC_NP = 7, RC_SLOT = 18688, RC_LDS = 18688;
constexpr int RC_QT = 0, RC_RR = 4096, RC_BG = 8192, RC_AB = 12288, RC_D0 = 14336, RC_U0 = 16384, RC_Y0 = 17408, RC_G = 18432;
#define R3C_FENCE() asm volatile("" ::: "memory")
constexpr int RC_P = 144;
DEV bf16x8 r3c_permfrag(const char* rowp, int q) {
    const u32x2 lo = *(const u32x2*)(rowp + 8 * q), hi = *(const u32x2*)(rowp + 32 + 8 * q);
    u32x4 w; w.x = lo.x; w.y = lo.y; w.z = hi.x; w.w = hi.y; return __builtin_bit_cast(bf16x8, w);
}
DEV bf16x8 r3c_neg(bf16x8 a) { u32x4 w = __builtin_bit_cast(u32x4, a); w.x ^= 0x80008000u; w.y ^= 0x80008000u; w.z ^= 0x80008000u; w.w ^= 0x80008000u; return __builtin_bit_cast(bf16x8, w); }
DEV u32x4 r3c_scale8(u32x4 d, f32x4 a, f32x4 b) {
    u32x4 o; o.x = cvt_pk(bf_lo(d.x) * a[0], bf_hi(d.x) * a[1]); o.y = cvt_pk(bf_lo(d.y) * a[2], bf_hi(d.y) * a[3]);
    o.z = cvt_pk(bf_lo(d.z) * b[0], bf_hi(d.z) * b[1]); o.w = cvt_pk(bf_lo(d.w) * b[2], bf_hi(d.w) * b[3]); return o;
}
DEV u32x2 r3c_pk4(f32x4 v) { u32x2 w; w.x = cvt_pk(v[0], v[1]); w.y = cvt_pk(v[2], v[3]); return w; }
DEV f32x4 r3c_up4(u32x2 w) { f32x4 v; v[0] = bf_lo(w.x); v[1] = bf_hi(w.x); v[2] = bf_lo(w.y); v[3] = bf_hi(w.y); return v; }
#define R3C_SCORE(dst, A, B, ROWLESS, STRICT) { _Pragma("unroll") for (int a = 0; a < 2; ++a) { _Pragma("unroll") for (int b = 0; b < 2; ++b) { \
        f32x4 a_ = MFMA(A[a][0], B[b][0], z4); a_ = MFMA(A[a][1], B[b][1], a_); \
        _Pragma("unroll") for (int r = 0; r < 4; ++r) { const int row_ = 16 * a + 4 * q + r, col_ = 16 * b + m; const int lo_ = (ROWLESS) ? row_ : col_, hi_ = (ROWLESS) ? col_ : row_; \
            const bool keep_ = (STRICT) ? (lo_ < hi_) : (lo_ <= hi_); a_[r] = keep_ ? a_[r] : 0.f; } \
        dst[a][b] = a_; } } }
struct R3Raw { u32x4 dr[4], dw[4], dk[4], dq[4], da[4]; bf16x8 vfrag; };
DEV void r3c_load(R3Raw& W, const bf16_t* rb, const bf16_t* wb, const bf16_t* kb, const bf16_t* kkb, const bf16_t* kab, const bf16_t* vb, size_t base, int vrow0, int t0, int lane) {
    const int m = lane & 15, q = lane >> 4, tr = lane >> 3, j = lane & 7;
#pragma unroll
    for (int s = 0; s < 4; ++s) { const size_t o = base + (size_t)(t0 + 8 * s + tr) * DM + j * 8;
        W.dw[s] = *(const u32x4*)(wb + o); W.dr[s] = *(const u32x4*)(rb + o); W.dk[s] = *(const u32x4*)(kb + o); W.dq[s] = *(const u32x4*)(kkb + o); W.da[s] = *(const u32x4*)(kab + o); }
    const bf16_t* vp = vb + base + (size_t)t0 * DM + vrow0 + m; unsigned e[8];
#pragma unroll
    for (int jj = 0; jj < 8; ++jj) { const int t = (jj < 4) ? 4 * q + jj : 16 + 4 * q + jj - 4; e[jj] = vp[(size_t)t * DM]; }
    u32x4 w; w.x = e[0] | (e[1] << 16); w.y = e[2] | (e[3] << 16); w.z = e[4] | (e[5] << 16); w.w = e[6] | (e[7] << 16); W.vfrag = __builtin_bit_cast(bf16x8, w);
}
DEV void r3c_produce(const R3Raw& W, char* lds, int lane) {
    const int m = lane & 15, q = lane >> 4, tr = lane >> 3, j = lane & 7;
    const f32x4 z4 = {0.f, 0.f, 0.f, 0.f};
    char* Rh = lds; char* Qh = lds + 32 * RC_P; char* Kh = lds + 64 * RC_P; char* Bh = lds + 96 * RC_P; float* G31a = (float*)(lds + 128 * RC_P);
    float* Gb = (float*)Kh;
    const bf16x8 vfrag = W.vfrag;
#pragma unroll
    for (int s = 0; s < 4; ++s) { float* gp = Gb + (8 * s + tr) * 64 + 8 * j; f32x4 a, b; const u32x4 d = W.dw[s];
        a[0] = bf_lo(d.x); a[1] = bf_hi(d.x); a[2] = bf_lo(d.y); a[3] = bf_hi(d.y); b[0] = bf_lo(d.z); b[1] = bf_hi(d.z); b[2] = bf_lo(d.w); b[3] = bf_hi(d.w);
        *(f32x4*)gp = a; *(f32x4*)(gp + 4) = b; }
    R3C_FENCE();
    { float g[32];
#pragma unroll
      for (int t = 0; t < 32; ++t) g[t] = Gb[t * 64 + lane];
      float G = 1.f;
#pragma unroll
      for (int t = 0; t < 32; ++t) { G *= g[t]; Gb[t * 64 + lane] = G; }
      G31a[lane] = G; }
    R3C_FENCE();
    { u32x4 kh[4], bh[4];
#pragma unroll
      for (int s = 0; s < 4; ++s) { const int t = 8 * s + tr, tp = t > 0 ? t - 1 : 0;
          const f32x4 g0 = *(const f32x4*)(Gb + t * 64 + 8 * j), g1 = *(const f32x4*)(Gb + t * 64 + 8 * j + 4);
          f32x4 p0 = *(const f32x4*)(Gb + tp * 64 + 8 * j), p1 = *(const f32x4*)(Gb + tp * 64 + 8 * j + 4);
          if (t == 0) { p0 = (f32x4){1.f, 1.f, 1.f, 1.f}; p1 = p0; }
          f32x4 i0, i1;
#pragma unroll
          for (int e = 0; e < 4; ++e) { i0[e] = rcpf_(g0[e]); i1[e] = rcpf_(g1[e]); }
          *(u32x4*)(Rh + t * RC_P + j * 16) = r3c_scale8(W.dr[s], g0, g1);
          *(u32x4*)(Qh + t * RC_P + j * 16) = r3c_scale8(W.dq[s], p0, p1);
          kh[s] = r3c_scale8(W.dk[s], i0, i1); bh[s] = r3c_scale8(W.da[s], i0, i1); }
      R3C_FENCE();
#pragma unroll
      for (int s = 0; s < 4; ++s) { const int t = 8 * s + tr; *(u32x4*)(Kh + t * RC_P + j * 16) = kh[s]; *(u32x4*)(Bh + t * RC_P + j * 16) = bh[s]; } }
    R3C_FENCE();
    bf16x8 Qa[2][2], Ra[2][2], Kb[2][2], Bb[2][2];
#pragma unroll
    for (int x = 0; x < 2; ++x)
#pragma unroll
        for (int ks = 0; ks < 2; ++ks) { const int off = (16 * x + m) * RC_P + (32 * ks + 8 * q) * 2;
            Qa[x][ks] = *(const bf16x8*)(Qh + off); Ra[x][ks] = *(const bf16x8*)(Rh + off); Kb[x][ks] = *(const bf16x8*)(Kh + off); Bb[x][ks] = *(const bf16x8*)(Bh + off); }
    f32x4 Tt[2][2], PN[2][2], PT[2][2], Z[2][5];
    R3C_SCORE(Tt, Kb, Qa, true, true)
    Z[0][4] = MFMA(pack8(Tt[0][0], Tt[1][0]), vfrag, z4); Z[1][4] = MFMA(pack8(Tt[0][1], Tt[1][1]), vfrag, z4);
    R3C_SCORE(Tt, Kb, Ra, true, false)
    u32x2 oY0[2]; oY0[0] = r3c_pk4(MFMA(pack8(Tt[0][0], Tt[1][0]), vfrag, z4)); oY0[1] = r3c_pk4(MFMA(pack8(Tt[0][1], Tt[1][1]), vfrag, z4));
    R3C_SCORE(Tt, Bb, Ra, true, false)
    bf16x8 oAB[2]; oAB[0] = r3c_neg(pack8(Tt[0][0], Tt[1][0])); oAB[1] = r3c_neg(pack8(Tt[0][1], Tt[1][1]));
    R3C_SCORE(PN, Qa, Bb, false, true)
    R3C_SCORE(PT, Bb, Qa, true, true)
#pragma unroll
    for (int mt = 0; mt < 2; ++mt)
#pragma unroll
        for (int n = 0; n < 4; ++n)
#pragma unroll
            for (int r = 0; r < 4; ++r) Z[mt][n][r] = bf2f(*(const bf16_t*)(Qh + (16 * mt + 4 * q + r) * RC_P + (16 * n + m) * 2));
#pragma unroll
    for (int lev = 0; lev < 5; ++lev) {
        bf16x8 fa[2], fb[2], zb[5];
#pragma unroll
        for (int x = 0; x < 2; ++x) { fa[x] = pack8(PT[0][x], PT[1][x]); fb[x] = pack8(PN[0][x], PN[1][x]); }
#pragma unroll
        for (int n = 0; n < 5; ++n) zb[n] = pack8(Z[0][n], Z[1][n]);
        const bf16x8 a0 = lev == 0 ? r3c_neg(fa[0]) : fa[0], a1 = lev == 0 ? r3c_neg(fa[1]) : fa[1];
#pragma unroll
        for (int n = 0; n < 5; ++n) { Z[0][n] = MFMA(a0, zb[n], Z[0][n]); Z[1][n] = MFMA(a1, zb[n], Z[1][n]); }
        if (lev < 4) {
#pragma unroll
            for (int a = 0; a < 2; ++a)
#pragma unroll
                for (int b = 0; b < 2; ++b) { PN[a][b] = MFMA(fa[a], fb[b], z4); PT[a][b] = MFMA(fb[a], fa[b], z4); }
        }
    }
    R3C_FENCE();
#pragma unroll
    for (int mt = 0; mt < 2; ++mt)
#pragma unroll
        for (int n = 0; n < 4; ++n)
#pragma unroll
            for (int r = 0; r < 4; ++r) *(bf16_t*)(Qh + (16 * mt + 4 * q + r) * RC_P + (16 * n + m) * 2) = f2bf(Z[mt][n][r]);
    R3C_FENCE();
    bf16x8 oQT[4], oRR[4], oBG[4]; u32x2 oD0[4];
#pragma unroll
    for (int mt = 0; mt < 2; ++mt)
#pragma unroll
        for (int ks = 0; ks < 2; ++ks) { oQT[mt * 2 + ks] = r3c_permfrag(Qh + (16 * mt + m) * RC_P + ks * 64, q); oRR[mt * 2 + ks] = r3c_permfrag(Rh + (16 * mt + m) * RC_P + ks * 64, q); }
#pragma unroll
    for (int ct = 0; ct < 4; ++ct) { const int ch = 16 * ct + m; const float g = G31a[ch]; f32x4 k0, k1, b0, b1;
#pragma unroll
        for (int jj = 0; jj < 4; ++jj) { const int ta = 4 * q + jj, tb = 16 + 4 * q + jj;
            k0[jj] = bf2f(*(const bf16_t*)(Kh + ta * RC_P + ch * 2)) * g; k1[jj] = bf2f(*(const bf16_t*)(Kh + tb * RC_P + ch * 2)) * g;
            b0[jj] = bf2f(*(const bf16_t*)(Bh + ta * RC_P + ch * 2)) * -g; b1[jj] = bf2f(*(const bf16_t*)(Bh + tb * RC_P + ch * 2)) * -g; }
        oBG[ct] = pack8(b0, b1);
        oD0[ct] = r3c_pk4(MFMA(pack8(k0, k1), vfrag, z4)); }
    asm volatile("s_waitcnt lgkmcnt(0)" ::: "memory");
#pragma unroll
    for (int f = 0; f < 4; ++f) { *(bf16x8*)(lds + RC_QT + f * 1024 + lane * 16) = oQT[f]; *(bf16x8*)(lds + RC_RR + f * 1024 + lane * 16) = oRR[f]; *(bf16x8*)(lds + RC_BG + f * 1024 + lane * 16) = oBG[f];
        *(u32x2*)(lds + RC_D0 + f * 512 + lane * 8) = oD0[f]; }
#pragma unroll
    for (int f = 0; f < 2; ++f) { *(bf16x8*)(lds + RC_AB + f * 1024 + lane * 16) = oAB[f]; *(u32x2*)(lds + RC_U0 + f * 512 + lane * 8) = r3c_pk4(Z[f][4]); *(u32x2*)(lds + RC_Y0 + f * 512 + lane * 8) = oY0[f]; }
    R3C_FENCE();
}
DEV void r3c_consume(f32x4 (&S)[4], const char* slot, bf16_t* yout, int lane) {
    const int m = lane & 15, q = lane >> 4;
    bf16x8 QT[2][2], RA[2][2], BG[4], AB[2]; u32x2 D0[4], U0[2], Y0[2]; f32x4 Gv[4];
#pragma unroll
    for (int f = 0; f < 4; ++f) { QT[f >> 1][f & 1] = *(const bf16x8*)(slot + RC_QT + f * 1024 + lane * 16); BG[f] = *(const bf16x8*)(slot + RC_BG + f * 1024 + lane * 16);
        D0[f] = *(const u32x2*)(slot + RC_D0 + f * 512 + lane * 8); Gv[f] = *(const f32x4*)(slot + RC_G + (16 * f + 4 * q) * 4); }
#pragma unroll
    for (int f = 0; f < 2; ++f) { U0[f] = *(const u32x2*)(slot + RC_U0 + f * 512 + lane * 8); Y0[f] = *(const u32x2*)(slot + RC_Y0 + f * 512 + lane * 8); AB[f] = *(const bf16x8*)(slot + RC_AB + f * 1024 + lane * 16); }
#pragma unroll
    for (int f = 0; f < 4; ++f) RA[f >> 1][f & 1] = *(const bf16x8*)(slot + RC_RR + f * 1024 + lane * 16);
    const bf16x8 sB0 = pack8(S[0], S[1]), sB1 = pack8(S[2], S[3]);
    f32x4 U[2], Y[2];
#pragma unroll
    for (int mt = 0; mt < 2; ++mt) { U[mt] = r3c_up4(U0[mt]); U[mt] = MFMA(QT[mt][0], sB0, U[mt]); U[mt] = MFMA(QT[mt][1], sB1, U[mt]); }
    const bf16x8 uB = pack8(U[0], U[1]);
#pragma unroll
    for (int ct = 0; ct < 4; ++ct) { S[ct] = S[ct] * Gv[ct] + r3c_up4(D0[ct]); S[ct] = MFMA(BG[ct], uB, S[ct]); }
#pragma unroll
    for (int mt = 0; mt < 2; ++mt) { Y[mt] = r3c_up4(Y0[mt]); Y[mt] = MFMA(RA[mt][0], sB0, Y[mt]); Y[mt] = MFMA(RA[mt][1], sB1, Y[mt]); Y[mt] = MFMA(AB[mt], uB, Y[mt]);
#pragma unroll
        for (int r = 0; r < 4; ++r) yout[(size_t)(16 * mt + 4 * q + r) * DM + m] = f2bf(Y[mt][r]); }
}
DEV void phase_r3c(const bf16_t* rb, const bf16_t* wb, const bf16_t* kb, const bf16_t* kkb, const bf16_t* kab, const bf16_t* vb, bf16_t* yb, char* smem) {
    const int tid = tidx(), lane = tid & 63, wid = __builtin_amdgcn_readfirstlane(tid >> 6);
    constexpr int NCH = SEQ / 32, NR = (NCH + RC_NP - 1) / RC_NP;
    for (int task = blockIdx.x; task < 256; task += gridDim.x) {
        const int xc = task & 7, ix = task >> 3, bh = xc * 8 + (ix >> 2), b = bh >> 4, h = bh & 15, rq = ix & 3;
        const size_t base = (size_t)b * SEQ * DM + h * 64;
        if (wid == 0) {
            f32x4 S[4];
#pragma unroll
            for (int ct = 0; ct < 4; ++ct) S[ct] = (f32x4){0.f, 0.f, 0.f, 0.f};
            for (int rd = 0; rd < NR; ++rd) {
                __syncthreads();
                const int c0 = rd * RC_NP, nv = NCH - c0 < RC_NP ? NCH - c0 : RC_NP;
                bf16_t* y0 = yb + base + (size_t)c0 * 32 * DM + rq * 16;
#pragma unroll 1
                for (int p = 0; p < nv; ++p) r3c_consume(S, smem + p * RC_LDS, y0 + (size_t)p * 32 * DM, lane);
                asm volatile("s_waitcnt lgkmcnt(0)" ::: "memory");
                __syncthreads();
            }
        } else {
            for (int rd = 0; rd < NR; ++rd) {
                const int c = rd * RC_NP + wid - 1;
                if (c < NCH) { R3Raw W; r3c_load(W, rb, wb, kb, kkb, kab, vb, base, rq * 16, c * 32, lane); r3c_produce(W, smem + (wid - 1) * RC_LDS, lane); }
                asm volatile("s_waitcnt lgkmcnt(0)" ::: "memory");
                __syncthreads();
                __syncthreads();
            }
        }
    }
}
DEV void phase_r4(const bf16_t* hid, const bf16_t* G2T, const RwkvW& W, const bf16_t* yb, const bf16_t* vb, const float* bsc, bf16_t* outb, char* smem) {
    const LaneId L = lane_id();
    const int ntn = 8, nunits = (T / 256) * ntn;
    for (int u = blockIdx.x; u < nunits; u += gridDim.x) {
        const int tm = u / ntn, tn = u % ntn;
        f32x4 acc[4][4];
        gemm_core(acc, LdPlain{hid + (size_t)tm * 256 * HIDP + 128, HIDP}, LdPlain{G2T + (size_t)tn * 128 * 128, 128}, 128, smem);
        const int head = tn * 2 + L.wn;
#pragma unroll
        for (int m = 0; m < 4; ++m) {
            const size_t row = (size_t)tm * 256 + L.wm * 64 + m * 16 + L.fr;
            f32x4 yv[4]; float s = 0.f;
#pragma unroll
            for (int n = 0; n < 4; ++n) { yv[n] = ld_bf4(yb + row * DM + head * 64 + n * 16 + L.fq * 4); s += (yv[n][0] + yv[n][1]) + (yv[n][2] + yv[n][3]); }
            s += __shfl_xor(s, 16); s += __shfl_xor(s, 32);
            const float mean = s * (1.0f / 64.0f); float q = 0.f;
#pragma unroll
            for (int n = 0; n < 4; ++n) { const f32x4 d = yv[n] - mean; q += (d[0] * d[0] + d[1] * d[1]) + (d[2] * d[2] + d[3] * d[3]); }
            q += __shfl_xor(q, 16); q += __shfl_xor(q, 32);
            const float rstd = rsqrtf(q * (1.0f / 64.0f) + 64e-5f);
            const float bs = bsc[row * 16 + head];
#pragma unroll
            for (int n = 0; n < 4; ++n) { const int col = head * 64 + n * 16 + L.fq * 4;
                const f32x4 lw = *(const f32x4*)(W.ln_w + col), lb = *(const f32x4*)(W.ln_b + col), vv = ld_bf4(vb + row * DM + col);
                f32x4 o = ((yv[n] - mean) * rstd * lw + lb + vv * bs);
                o = o * acc[m][n];
                st_bf4(outb + row * DM + col, o); }
        }
    }
}

struct NsaBuf { bf16_t *q, *kcmp, *vcmp, *kslc, *kwin, *vslcT, *vwinT, *hid, *kc, *vcT, *o; float* gates; };
DEV void phase_n1(const bf16_t* xn, const bf16_t* Bt, const NsaBuf& B, char* smem) {
    const LaneId L = lane_id();
    const int ntn = 15, nunits = (T / 256) * ntn;
    for (int u = blockIdx.x; u < nunits; u += gridDim.x) {
        const int tm = u / ntn, tn = u % ntn;
        f32x4 acc[4][4];
        gemm_core(acc, LdPlain{xn + (size_t)tm * 256 * DM, DM}, LdPlain{Bt + (size_t)tn * 128 * DM, DM}, DM, smem);
#pragma unroll
        for (int m = 0; m < 4; ++m)
#pragma unroll
            for (int n = 0; n < 4; ++n) {
                const size_t row = (size_t)tm * 256 + L.wm * 64 + m * 16 + L.fr; const int c = L.wn * 64 + n * 16 + L.fq * 4; f32x4 v = acc[m][n];
                if (tn < 8) st_bf4(B.q + row * DM + tn * 128 + c, v * 0.125f);
                else if (tn < 14) {
                    const int cc = tn - 8;
                    if (cc == 0) st_bf4(B.kcmp + row * 128 + c, v);
                    else if (cc == 1) st_bf4(B.vcmp + row * 128 + c, v);
                    else if (cc == 2) st_bf4(B.kslc + row * 128 + c, v);
                    else if (cc == 4) st_bf4(B.kwin + row * 128 + c, v);
                    else { bf16_t* dst = cc == 3 ? B.vslcT : B.vwinT; const int b = (int)(row >> 13), t = (int)(row & (SEQ - 1));
                        for (int j = 0; j < 4; ++j) dst[((size_t)(b * 128 + c + j)) * SEQ + t] = f2bf(v[j]); }
                } else { if (c < 48) { for (int j = 0; j < 4; ++j) B.gates[row * 48 + c + j] = sigmoidf_(v[j]); } }
            }
    }
}
DEV float gelu_tanh(float x) { const float u = 0.7978845608028654f * (x + 0.044715f * x * x * x); return 0.5f * x * (1.0f + tanhf(u)); }
DEV void phase_n2a(const bf16_t* W1T, const float* biasp, const NsaBuf& B, char* smem) {
    const LaneId L = lane_id();
    for (int u = blockIdx.x; u < 64; u += gridDim.x) {
        const int c = u >> 5, tm = (u >> 1) & 15, tn = u & 1;
        f32x4 acc[4][4];
        gemm_core(acc, LdCmp{c ? B.vcmp : B.kcmp, tm * 256}, LdPlain{W1T + (size_t)c * 256 * 2048 + (size_t)tn * 128 * 2048, 2048}, 2048, smem);
#pragma unroll
        for (int m = 0; m < 4; ++m)
#pragma unroll
            for (int n = 0; n < 4; ++n) { const size_t row = (size_t)tm * 256 + L.wm * 64 + m * 16 + L.fr; const int col = tn * 128 + L.wn * 64 + n * 16 + L.fq * 4;
                const f32x4 bb = *(const f32x4*)(biasp + c * 256 + col); f32x4 v;
                for (int j = 0; j < 4; ++j) v[j] = gelu_tanh(acc[m][n][j] + bb[j]);
                st_bf4(B.hid + ((size_t)c * 4096 + row) * 256 + col, v); }
    }
}
DEV void phase_n2b(const bf16_t* W2T, const NsaBuf& B, char* smem) {
    const LaneId L = lane_id();
    for (int u = blockIdx.x; u < 32; u += gridDim.x) {
        const int c = u >> 4, tm = u & 15;
        f32x4 acc[4][4];
        gemm_core(acc, LdPlain{B.hid + ((size_t)c * 4096 + tm * 256) * 256, 256}, LdPlain{W2T + (size_t)c * 128 * 256, 256}, 256, smem);
        if (L.wn == 0) {
#pragma unroll
            for (int m = 0; m < 4; ++m)
#pragma unroll
                for (int n = 0; n < 4; ++n) { const int row = tm * 256 + L.wm * 64 + m * 16 + L.fr, d = n * 16 + L.fq * 4;
                    const int b = row >> 10, nn = (row >> 1) & 511, g = row & 1;
                    if (c == 0) st_bf4(B.kc + ((size_t)((b * 2 + g) * 512 + nn)) * 64 + d, acc[m][n]);
                    else { for (int j = 0; j < 4; ++j) B.vcT[((size_t)((b * 2 + g) * 64 + d + j)) * 512 + nn] = f2bf(acc[m][n][j]); } }
        }
    }
}
#define NEGV (-1e30f)
#define LOG2E_ 1.4426950408889634f
DEV u32x4 n3_ldg(const bf16_t* kbase, long kpitch, const bf16_t* vbase, long vpitch, int kb, int tid) {
    if (tid < 256) return *(const u32x4*)(kbase + (size_t)(kb + (tid >> 3)) * kpitch + (tid & 7) * 8);
    const int i = tid - 256; return *(const u32x4*)(vbase + (size_t)(i >> 2) * vpitch + kb + (i & 3) * 8);
}
DEV void n3_sts(char* buf, u32x4 v, int tid) {
    if (tid < 256) { const int row = tid >> 3, c = tid & 7, sw = ((row >> 1) & 1) | (((row >> 3) & 3) << 1); *(u32x4*)(buf + row * 128 + ((c ^ sw) << 4)) = v; }
    else { const int i = tid - 256, d = i >> 2, c = i & 3; *(u32x4*)(buf + 4096 + d * 64 + ((c ^ ((d >> 2) & 3)) << 4)) = v; }
}
DEV void phase_n3(const NsaBuf& B, char* smem) {
    const int tid = tidx(), lane = tid & 63, wid = tid >> 6, m = lane & 15, fq = lane >> 4, qh = m >> 3, hh = m & 7;
    float* psum = (float*)(smem + wid * 8704); int* ulist = (int*)(smem + wid * 8704 + 8192);
    char* stg = smem + 8 * 8704;
    const int kperm = 8 * (m >> 2) + (m & 3);
    const int kswz = ((m >> 1) & 1) | ((m >> 2) << 1), vswz = (m >> 2) & 3;
    const int koffA = kperm * 128, koffB = (kperm + 4) * 128, voff = 4096 + m * 64 + ((fq ^ vswz) << 4);
    const f32x4 z4 = {0.f, 0.f, 0.f, 0.f};
    const int nrank = (int)gridDim.x >> 3, bg = (int)blockIdx.x & 7;
    for (int qblk = (int)blockIdx.x >> 3; qblk < 256 && (int)blockIdx.x < nrank * 8; qblk += nrank) {
        const int g = bg & 1, b = bg >> 1, t0b = qblk * 32, t0 = t0b + wid * 4;
        int tq[2]; bf16x8 qf[2][2]; float gc[2], gs[2], gw[2]; u32x2 opk[2][4];
#pragma unroll
        for (int rb = 0; rb < 2; ++rb) {
            tq[rb] = t0 + rb * 2 + qh;
            const bf16_t* qp = B.q + ((size_t)(b * SEQ + tq[rb])) * DM + (g * 8 + hh) * 64 + fq * 8;
            qf[rb][0] = __builtin_nontemporal_load((const bf16x8*)qp); qf[rb][1] = __builtin_nontemporal_load((const bf16x8*)(qp + 32));
            const float* gp = B.gates + ((size_t)(b * SEQ + tq[rb])) * 48 + g * 24 + hh * 3;
            gc[rb] = gp[0]; gs[rb] = gp[1]; gw[rb] = gp[2];
        }
#define N3_KFRAGS(buf) const bf16x8 kA0 = *(const bf16x8*)((buf) + koffA + (((0 + fq) ^ kswz) << 4)), kA1 = *(const bf16x8*)((buf) + koffA + (((4 + fq) ^ kswz) << 4)), \
                                    kB0 = *(const bf16x8*)((buf) + koffB + (((0 + fq) ^ kswz) << 4)), kB1 = *(const bf16x8*)((buf) + koffB + (((4 + fq) ^ kswz) << 4));
        {
            const int tid = tidx(), lane = tid & 63, m = lane & 15, fq = (lane >> 4), qh = m >> 3, hh = m & 7, kperm = 8 * (m >> 2) + (m & 3); (void)hh; (void)qh; (void)lane;
            const int kswz = ((m >> 1) & 1) | ((m >> 2) << 1), vswz = (m >> 2) & 3, koffA = kperm * 128, koffB = (kperm + 4) * 128, voff = 4096 + m * 64 + ((fq ^ vswz) << 4);
            int nv[2];
#pragma unroll
            for (int rb = 0; rb < 2; ++rb) nv[rb] = tq[rb] >= 31 ? ((tq[rb] - 31) >> 4) + 1 : 0;
            const int nvmax = (t0b + 31 >= 31) ? ((t0b + 31 - 31) >> 4) + 1 : 0, ngrp = (nvmax + 31) >> 5;
#pragma unroll
            for (int i = 0; i < 32; ++i) psum[lane + 64 * i] = 0.f;
            const bf16_t* kcb = B.kc + (size_t)((b * 2 + g) * 512) * 64; const bf16_t* vcb = B.vcT + (size_t)((b * 2 + g) * 64) * 512;
            float mx[2] = {NEGV, NEGV}, l[2] = {0.f, 0.f};
            u32x4 stv;
            if (ngrp > 0) { stv = n3_ldg(kcb, 64, vcb, 512, 0, tid); n3_sts(stg, stv, tid); }
            __syncthreads();
            for (int grp = 0; grp < ngrp; ++grp) {
                const int kb = grp * 32; const bool more = grp + 1 < ngrp;
                if (more) stv = n3_ldg(kcb, 64, vcb, 512, kb + 32, tid);
                const char* buf = stg + (grp & 1) * 8192;
                N3_KFRAGS(buf)
#pragma unroll
                for (int rb = 0; rb < 2; ++rb) {
                    f32x4 sA = MFMA(kA0, qf[rb][0], z4); sA = MFMA(kA1, qf[rb][1], sA);
                    f32x4 sB = MFMA(kB0, qf[rb][0], z4); sB = MFMA(kB1, qf[rb][1], sB);
                    const bool full = kb + 32 <= nv[rb], part = !full && kb < nv[rb];
                    if (__ballot(part) == 0ull) {
                        const float m8 = fmaxf(fmaxf(fmaxf(sA[0], sA[1]), fmaxf(sA[2], sA[3])), fmaxf(fmaxf(sB[0], sB[1]), fmaxf(sB[2], sB[3])));
                        const float mn = fmaxf(mx[rb], full ? m8 : NEGV), tl = (full ? mn : 1e30f) * LOG2E_; float add = 0.f;
#pragma unroll
                        for (int j = 0; j < 4; ++j) add += __builtin_amdgcn_exp2f(fmaf(sA[j], LOG2E_, -tl)) + __builtin_amdgcn_exp2f(fmaf(sB[j], LOG2E_, -tl));
                        l[rb] = l[rb] * __expf(mx[rb] - mn) + add; mx[rb] = mn;
                    } else {
                    float gm = NEGV;
#pragma unroll
                    for (int j = 0; j < 4; ++j) { if (kb + 8 * fq + j < nv[rb]) gm = fmaxf(gm, sA[j]); if (kb + 8 * fq + 4 + j < nv[rb]) gm = fmaxf(gm, sB[j]); }
                    const float mn = fmaxf(mx[rb], gm); float add = 0.f;
#pragma unroll
                    for (int j = 0; j < 4; ++j) { if (kb + 8 * fq + j < nv[rb]) add += __expf(sA[j] - mn); if (kb + 8 * fq + 4 + j < nv[rb]) add += __expf(sB[j] - mn); }
                    l[rb] = l[rb] * __expf(mx[rb] - mn) + add; mx[rb] = mn;
                    }
                }
                if (more) n3_sts(stg + ((grp + 1) & 1) * 8192, stv, tid);
                __syncthreads();
            }
            float M[2], inv[2];
#pragma unroll
            for (int rb = 0; rb < 2; ++rb) {
                float Mx = fmaxf(mx[rb], __shfl_xor(mx[rb], 16)); Mx = fmaxf(Mx, __shfl_xor(Mx, 32));
                float ll = l[rb] * __expf(mx[rb] - Mx); ll += __shfl_xor(ll, 16); ll += __shfl_xor(ll, 32);
                M[rb] = Mx; inv[rb] = ll > 0.f ? 1.0f / ll : 0.f;
            }
            f32x4 oc[2][4];
#pragma unroll
            for (int rb = 0; rb < 2; ++rb)
#pragma unroll
                for (int d = 0; d < 4; ++d) oc[rb][d] = z4;
            if (ngrp > 0) { stv = n3_ldg(kcb, 64, vcb, 512, 0, tid); n3_sts(stg, stv, tid); }
            __syncthreads();
            for (int grp = 0; grp < ngrp; ++grp) {
                const int kb = grp * 32; const bool more = grp + 1 < ngrp;
                if (more) stv = n3_ldg(kcb, 64, vcb, 512, kb + 32, tid);
                const char* buf = stg + (grp & 1) * 8192;
                N3_KFRAGS(buf)
                bf16x8 vf[4];
#pragma unroll
                for (int d = 0; d < 4; ++d) vf[d] = *(const bf16x8*)(buf + voff + d * 1024);
#pragma unroll
                for (int rb = 0; rb < 2; ++rb) {
                    f32x4 sA = MFMA(kA0, qf[rb][0], z4); sA = MFMA(kA1, qf[rb][1], sA);
                    f32x4 sB = MFMA(kB0, qf[rb][0], z4); sB = MFMA(kB1, qf[rb][1], sB);
                    f32x4 pA, pB;
                    const bool full = kb + 32 <= nv[rb], part = !full && kb < nv[rb];
                    if (__ballot(part) == 0ull) {
                        const float tl = (full ? M[rb] : 1e30f) * LOG2E_;
#pragma unroll
                        for (int j = 0; j < 4; ++j) { pA[j] = __builtin_amdgcn_exp2f(fmaf(sA[j], LOG2E_, -tl)) * inv[rb]; pB[j] = __builtin_amdgcn_exp2f(fmaf(sB[j], LOG2E_, -tl)) * inv[rb]; }
                    } else {
#pragma unroll
                    for (int j = 0; j < 4; ++j) { pA[j] = (kb + 8 * fq + j < nv[rb]) ? __expf(sA[j] - M[rb]) * inv[rb] : 0.f; pB[j] = (kb + 8 * fq + 4 + j < nv[rb]) ? __expf(sB[j] - M[rb]) * inv[rb] : 0.f; }
                    }
#pragma unroll
                    for (int j = 0; j < 4; ++j) {
                        float a = pA[j]; a += DPP_MOV(a, 0xB1); a += DPP_MOV(a, 0x4E); a += DPP_MOV(a, 0x141);
                        float c = pB[j]; c += DPP_MOV(c, 0xB1); c += DPP_MOV(c, 0x4E); c += DPP_MOV(c, 0x141);
                        if (hh == 0) { psum[(rb * 2 + qh) * 512 + kb + 8 * fq + j] = a; psum[(rb * 2 + qh) * 512 + kb + 8 * fq + 4 + j] = c; }
                    }
                    const bf16x8 pf = pack8(pA, pB);
#pragma unroll
                    for (int d = 0; d < 4; ++d) oc[rb][d] = MFMA(vf[d], pf, oc[rb][d]);
                }
                if (more) n3_sts(stg + ((grp + 1) & 1) * 8192, stv, tid);
                __syncthreads();
            }
#pragma unroll
            for (int rb = 0; rb < 2; ++rb)
#pragma unroll
                for (int d = 0; d < 4; ++d) { const f32x4 v = oc[rb][d] * gc[rb]; opk[rb][d].x = cvt_pk(v[0], v[1]); opk[rb][d].y = cvt_pk(v[2], v[3]); }
        }
        asm volatile("s_waitcnt lgkmcnt(0)" ::: "memory");
        __builtin_amdgcn_sched_barrier(0);
        unsigned long long mlo[4], mhi[4];
#pragma unroll
        for (int q2 = 0; q2 < 4; ++q2) {
            const int tqq = t0 + q2, cur = tqq >> 6;
            float sc[2];
#pragma unroll
            for (int c = 0; c < 2; ++c) { const int j = lane + 64 * c; float imp = 0.f;
                for (int n = 4 * j - 1; n <= 4 * j + 3; ++n) if (n >= 0) imp += psum[q2 * 512 + n];
                const bool causal = j * 64 <= tqq, forced = (j == 0) || (j == cur) || (j == cur - 1);
                sc[c] = causal ? imp + (forced ? 1e4f : 0.f) : NEGV; }
            unsigned k0 = __float_as_uint(sc[0]), k1 = __float_as_uint(sc[1]);
            k0 = (k0 & 0x80000000u) ? ~k0 : (k0 | 0x80000000u); k1 = (k1 & 0x80000000u) ? ~k1 : (k1 | 0x80000000u);
            unsigned Tk = 0u;
            for (int bit = 31; bit >= 0; --bit) { const unsigned cand = Tk | (1u << bit);
                const int cnt = __popcll(__ballot(k0 >= cand)) + __popcll(__ballot(k1 >= cand)); if (cnt >= 16) Tk = cand; }
            const int ngt = __popcll(__ballot(k0 > Tk)) + __popcll(__ballot(k1 > Tk)), needn = 16 - ngt;
            const unsigned long long eq0 = __ballot(k0 == Tk), eq1 = __ballot(k1 == Tk), belowm = (1ull << lane) - 1ull;
            const bool s0 = (k0 > Tk) || (k0 == Tk && __popcll(eq0 & belowm) < needn);
            const bool s1 = (k1 > Tk) || (k1 == Tk && __popcll(eq0) + __popcll(eq1 & belowm) < needn);
            mlo[q2] = __ballot(s0); mhi[q2] = __ballot(s1);
        }
        int nun;
        {
            const unsigned long long ulo = mlo[0] | mlo[1] | mlo[2] | mlo[3], uhi = mhi[0] | mhi[1] | mhi[2] | mhi[3];
            const unsigned long long below = (1ull << lane) - 1ull; const int nlo = __popcll(ulo);
            if ((ulo >> lane) & 1ull) { const int mb = (int)((mlo[0] >> lane) & 1ull) | ((int)((mlo[1] >> lane) & 1ull) << 1) | ((int)((mlo[2] >> lane) & 1ull) << 2) | ((int)((mlo[3] >> lane) & 1ull) << 3);
                ulist[__popcll(ulo & below)] = lane | (mb << 8); }
            if ((uhi >> lane) & 1ull) { const int mb = (int)((mhi[0] >> lane) & 1ull) | ((int)((mhi[1] >> lane) & 1ull) << 1) | ((int)((mhi[2] >> lane) & 1ull) << 2) | ((int)((mhi[3] >> lane) & 1ull) << 3);
                ulist[nlo + __popcll(uhi & below)] = (lane + 64) | (mb << 8); }
            nun = nlo + __popcll(uhi);
        }
        asm volatile("s_waitcnt lgkmcnt(0)" ::: "memory");
        __builtin_amdgcn_sched_barrier(0);
        {
            const int tid = tidx(), lane = tid & 63, m = lane & 15, fq = (lane >> 4), qh = m >> 3, hh = m & 7, kperm = 8 * (m >> 2) + (m & 3); (void)hh; (void)qh; (void)lane;
            const unsigned char* ksb = (const unsigned char*)B.kslc + (size_t)((b * 2 + g) * SEQ) * 64 + fq * 8; const unsigned char* vsb = (const unsigned char*)B.vslcT + (size_t)((b * 2 + g) * 128) * 4096 + m * 64 + 8 * fq;
            long q8[2][2];
#pragma unroll
            for (int rb = 0; rb < 2; ++rb)
#pragma unroll
                for (int ks = 0; ks < 2; ++ks) { const u32x4 w = __builtin_bit_cast(u32x4, qf[rb][ks]);
                    const unsigned lo = pack_fp8x4(bf_lo(w.x), bf_hi(w.x), bf_lo(w.y), bf_hi(w.y)), hi = pack_fp8x4(bf_lo(w.z), bf_hi(w.z), bf_lo(w.w), bf_hi(w.w));
                    q8[rb][ks] = (long)(((unsigned long long)hi << 32) | lo); }
            float mx[2] = {NEGV, NEGV}, l[2] = {0.f, 0.f}; f32x4 os[2][4];
#pragma unroll
            for (int rb = 0; rb < 2; ++rb)
#pragma unroll
                for (int d = 0; d < 4; ++d) os[rb][d] = z4;
            char* st8 = (char*)psum;
            const int srow = lane >> 2, sc0 = (lane & 3) * 2;
            u32x4 gk[4], gv[4];
            { const int blk0 = ulist[0] & 255; const unsigned char* kp = (const unsigned char*)B.kslc + ((size_t)((b * 2 + g) * SEQ) + blk0 * 64) * 64 + lane * 16; const unsigned char* vp = (const unsigned char*)B.vslcT + ((size_t)((b * 2 + g) * 128) + blk0) * 4096 + lane * 16;
#pragma unroll
              for (int i = 0; i < 4; ++i) { gk[i] = *(const u32x4*)(kp + i * 1024); gv[i] = *(const u32x4*)(vp + i * 1024); } }
            const int fsw = (m >> 2) << 1;
            for (int ib = 0; ib < nun; ++ib) {
                const int e = __builtin_amdgcn_readfirstlane(ulist[ib]);
#pragma unroll
                for (int i = 0; i < 4; ++i) { const int row = i * 16 + srow;
                    *(u32x4*)(st8 + row * 64 + ((sc0 ^ (((row >> 3) & 3) << 1)) << 3)) = gk[i];
                    *(u32x4*)(st8 + 4096 + row * 64 + ((sc0 ^ (((row >> 2) & 3) << 1)) << 3)) = gv[i]; }
                if (ib + 1 < nun) { const int blkn = ulist[ib + 1] & 255; const unsigned char* kp = (const unsigned char*)B.kslc + ((size_t)((b * 2 + g) * SEQ) + blkn * 64) * 64 + lane * 16; const unsigned char* vp = (const unsigned char*)B.vslcT + ((size_t)((b * 2 + g) * 128) + blkn) * 4096 + lane * 16;
#pragma unroll
                    for (int i = 0; i < 4; ++i) { gk[i] = *(const u32x4*)(kp + i * 1024); gv[i] = *(const u32x4*)(vp + i * 1024); } }
#pragma unroll
              for (int hf = 0; hf < 2; ++hf) {
                const int kb = (e & 255) * 64 + hf * 32;
                const char* kr = st8 + (hf * 32 + kperm) * 64;
                const long kA0 = *(const long*)(kr + ((fq ^ fsw) << 3)), kA1 = *(const long*)(kr + (((4 + fq) ^ fsw) << 3)), kB0 = *(const long*)(kr + 256 + ((fq ^ fsw) << 3)), kB1 = *(const long*)(kr + 256 + (((4 + fq) ^ fsw) << 3));
                long vf[4];
#pragma unroll
                for (int d = 0; d < 4; ++d) vf[d] = *(const long*)(st8 + 4096 + (d * 16 + m) * 64 + (((hf * 4 + fq) ^ fsw) << 3));
#pragma unroll
                for (int rb = 0; rb < 2; ++rb) {
                    if (((e >> (8 + rb * 2)) & 3) == 0) continue;
                    const bool mine = ((e >> (8 + rb * 2 + qh)) & 1) != 0;
                    f32x4 sA = MFMA8(kA0, q8[rb][0], z4); sA = MFMA8(kA1, q8[rb][1], sA);
                    f32x4 sB = MFMA8(kB0, q8[rb][0], z4); sB = MFMA8(kB1, q8[rb][1], sB);
                    const bool full = mine && kb + 31 <= tq[rb], part = mine && !full && kb <= tq[rb];
                    const bool fast = __ballot(part) == 0ull;
                    float gm = NEGV;
                    if (fast) { const float m8 = fmaxf(fmaxf(fmaxf(sA[0], sA[1]), fmaxf(sA[2], sA[3])), fmaxf(fmaxf(sB[0], sB[1]), fmaxf(sB[2], sB[3]))); gm = full ? m8 : NEGV; }
                    else {
#pragma unroll
                    for (int j = 0; j < 4; ++j) { if (mine && kb + 8 * fq + j <= tq[rb]) gm = fmaxf(gm, sA[j]); if (mine && kb + 8 * fq + 4 + j <= tq[rb]) gm = fmaxf(gm, sB[j]); }
                    }
                    if (__ballot(gm > mx[rb]) != 0ull) {
                        gm = fmaxf(gm, __shfl_xor(gm, 16)); gm = fmaxf(gm, __shfl_xor(gm, 32));
                        const float mn2 = fmaxf(mx[rb], gm), alpha = __expf(mx[rb] - mn2); mx[rb] = mn2; l[rb] *= alpha;
#pragma unroll
                        for (int d = 0; d < 4; ++d) os[rb][d] *= alpha;
                    }
                    const float mn = mx[rb];
                    f32x4 pA, pB; float add = 0.f;
                    if (fast) { const float tl = (full ? mn : 1e30f) * LOG2E_ - 7.f;
#pragma unroll
                        for (int j = 0; j < 4; ++j) { pA[j] = __builtin_amdgcn_exp2f(fmaf(sA[j], LOG2E_, -tl)); pB[j] = __builtin_amdgcn_exp2f(fmaf(sB[j], LOG2E_, -tl)); add += pA[j] + pB[j]; }
                    } else {
#pragma unroll
                    for (int j = 0; j < 4; ++j) { pA[j] = (mine && kb + 8 * fq + j <= tq[rb]) ? __expf(sA[j] - mn + 4.8520302639f) : 0.f; pB[j] = (mine && kb + 8 * fq + 4 + j <= tq[rb]) ? __expf(sB[j] - mn + 4.8520302639f) : 0.f; add += pA[j] + pB[j]; }
                    }
                    l[rb] += add;
                    const unsigned plo = pack_fp8x4(pA[0], pA[1], pA[2], pA[3]), phi = pack_fp8x4(pB[0], pB[1], pB[2], pB[3]);
                    const long pf = (long)(((unsigned long long)phi << 32) | plo);
#pragma unroll
                    for (int d = 0; d < 4; ++d) os[rb][d] = MFMA8(vf[d], pf, os[rb][d]);
                }
              }
            }
#pragma unroll
            for (int rb = 0; rb < 2; ++rb) {
                float ll = l[rb]; ll += __shfl_xor(ll, 16); ll += __shfl_xor(ll, 32);
                const float sc = ll > 0.f ? gs[rb] / ll : 0.f;
#pragma unroll
                for (int d = 0; d < 4; ++d) { f32x4 v = os[rb][d] * sc; v[0] += bf_lo(opk[rb][d].x); v[1] += bf_hi(opk[rb][d].x); v[2] += bf_lo(opk[rb][d].y); v[3] += bf_hi(opk[rb][d].y);
                    opk[rb][d].x = cvt_pk(v[0], v[1]); opk[rb][d].y = cvt_pk(v[2], v[3]); }
            }
        }
        __builtin_amdgcn_sched_barrier(0);
        {
            const int tid = tidx(), lane = tid & 63, m = lane & 15, fq = (lane >> 4), qh = m >> 3, hh = m & 7, kperm = 8 * (m >> 2) + (m & 3); (void)hh; (void)qh; (void)lane;
            const int kswz = ((m >> 1) & 1) | ((m >> 2) << 1), vswz = (m >> 2) & 3, koffA = kperm * 128, koffB = (kperm + 4) * 128, voff = 4096 + m * 64 + ((fq ^ vswz) << 4);
            const bf16_t* kwb = B.kwin + (size_t)b * SEQ * 128 + g * 64; const bf16_t* vwb = B.vwinT + (size_t)((b * 2 + g) * 64) * SEQ;
            float mx[2] = {NEGV, NEGV}, l[2] = {0.f, 0.f}; f32x4 ow[2][4];
#pragma unroll
            for (int rb = 0; rb < 2; ++rb)
#pragma unroll
                for (int d = 0; d < 4; ++d) ow[rb][d] = z4;
            const int lo = t0b - 511 > 0 ? t0b - 511 : 0, kb0 = lo & ~31, kbl = t0b + 31;
            u32x4 stv = n3_ldg(kwb, 128, vwb, SEQ, kb0, tid); n3_sts(stg, stv, tid);
            __syncthreads();
            int gi = 0;
            for (int kb = kb0; kb <= kbl; kb += 32, ++gi) {
                const bool more = kb + 32 <= kbl;
                if (more) stv = n3_ldg(kwb, 128, vwb, SEQ, kb + 32, tid);
                const char* buf = stg + (gi & 1) * 8192;
                if (kb <= t0 + 3 && kb + 31 > t0 - 512) {
                    N3_KFRAGS(buf)
                    bf16x8 vf[4];
#pragma unroll
                    for (int d = 0; d < 4; ++d) vf[d] = *(const bf16x8*)(buf + voff + d * 1024);
#pragma unroll
                    for (int rb = 0; rb < 2; ++rb) {
                        f32x4 sA = MFMA(kA0, qf[rb][0], z4); sA = MFMA(kA1, qf[rb][1], sA);
                        f32x4 sB = MFMA(kB0, qf[rb][0], z4); sB = MFMA(kB1, qf[rb][1], sB);
                        const bool full = kb + 31 <= tq[rb] && kb > tq[rb] - 512, part = !full && kb <= tq[rb] && kb + 31 > tq[rb] - 512;
                        const bool fast = __ballot(part) == 0ull;
                        float gm = NEGV;
                        if (fast) { const float m8 = fmaxf(fmaxf(fmaxf(sA[0], sA[1]), fmaxf(sA[2], sA[3])), fmaxf(fmaxf(sB[0], sB[1]), fmaxf(sB[2], sB[3]))); gm = full ? m8 : NEGV; }
                        else {
#pragma unroll
                        for (int j = 0; j < 4; ++j) { const int pa = kb + 8 * fq + j, pb = pa + 4; if (pa <= tq[rb] && pa > tq[rb] - 512) gm = fmaxf(gm, sA[j]); if (pb <= tq[rb] && pb > tq[rb] - 512) gm = fmaxf(gm, sB[j]); }
                        }
                        if (__ballot(gm > mx[rb] + 40.f) != 0ull) {
                            gm = fmaxf(gm, __shfl_xor(gm, 16)); gm = fmaxf(gm, __shfl_xor(gm, 32));
                            const float mn2 = fmaxf(mx[rb], gm), alpha = __expf(mx[rb] - mn2); mx[rb] = mn2; l[rb] *= alpha;
#pragma unroll
                            for (int d = 0; d < 4; ++d) ow[rb][d] *= alpha;
                        }
                        const float mn = mx[rb];
                        f32x4 pA, pB; float add = 0.f;
                        if (fast) { const float tl = (full ? mn : 1e30f) * LOG2E_;
#pragma unroll
                            for (int j = 0; j < 4; ++j) { pA[j] = __builtin_amdgcn_exp2f(fmaf(sA[j], LOG2E_, -tl)); pB[j] = __builtin_amdgcn_exp2f(fmaf(sB[j], LOG2E_, -tl)); add += pA[j] + pB[j]; }
                        } else {
#pragma unroll
                        for (int j = 0; j < 4; ++j) { const int pa = kb + 8 * fq + j, pb = pa + 4; const bool va = pa <= tq[rb] && pa > tq[rb] - 512, vb = pb <= tq[rb] && pb > tq[rb] - 512;
                            pA[j] = va ? __expf(sA[j] - mn) : 0.f; pB[j] = vb ? __expf(sB[j] - mn) : 0.f; add += pA[j] + pB[j]; }
                        }
                        l[rb] += add;
                        const bf16x8 pf = pack8(pA, pB);
#pragma unroll
                        for (int d = 0; d < 4; ++d) ow[rb][d] = MFMA(vf[d], pf, ow[rb][d]);
                    }
                }
                if (more) n3_sts(stg + ((gi + 1) & 1) * 8192, stv, tid);
                __syncthreads();
            }
#pragma unroll
            for (int rb = 0; rb < 2; ++rb) {
                float ll = l[rb]; ll += __shfl_xor(ll, 16); ll += __shfl_xor(ll, 32);
                const float sc = ll > 0.f ? gw[rb] / ll : 0.f;
#pragma unroll
                for (int d = 0; d < 4; ++d) { f32x4 v = ow[rb][d] * sc; v[0] += bf_lo(opk[rb][d].x); v[1] += bf_hi(opk[rb][d].x); v[2] += bf_lo(opk[rb][d].y); v[3] += bf_hi(opk[rb][d].y);
                    opk[rb][d].x = cvt_pk(v[0], v[1]); opk[rb][d].y = cvt_pk(v[2], v[3]); }
            }
        }
#undef N3_KFRAGS
#pragma unroll
        for (int rb = 0; rb < 2; ++rb) {
            bf16_t* op = B.o + ((size_t)(b * SEQ + tq[rb])) * DM + (g * 8 + hh) * 64 + fq * 4;
#pragma unroll
            for (int d = 0; d < 4; ++d) __builtin_nontemporal_store(opk[rb][d], (u32x2*)(op + d * 16));
        }
    }
}

struct GlaBuf { bf16_t *qe, *ke, *vT, *r, *o, *kdT, *ab; float *adn, *dec; };
DEV void phase_l1(const bf16_t* xn, const bf16_t* Bt, const GlaBuf& B, char* smem) {
    const LaneId L = lane_id();
    const int ntn = 25, nunits = (T / 256) * ntn;
    for (int u = blockIdx.x; u < nunits; u += gridDim.x) {
        const int tm = u / ntn, tn = u % ntn;
        f32x4 acc[4][4];
        gemm_core(acc, LdPlain{xn + (size_t)tm * 256 * DM, DM}, LdPlain{Bt + (size_t)tn * 128 * DM, DM}, DM, smem);
#pragma unroll
        for (int m = 0; m < 4; ++m)
#pragma unroll
            for (int n = 0; n < 4; ++n) {
                const size_t row = (size_t)tm * 256 + L.wm * 64 + m * 16 + L.fr; const int c = L.wn * 64 + n * 16 + L.fq * 4; const f32x4 v = acc[m][n];
                if (tn < 4) st_bf4(B.qe + row * 512 + tn * 128 + c, v * 0.08838834764831845f);
                else if (tn < 8) st_bf4(B.ke + row * 512 + (tn - 4) * 128 + c, v);
                else if (tn < 16) { const int b = (int)(row >> 13), t = (int)(row & (SEQ - 1)), vc = (tn - 8) * 128 + c;
                    for (int j = 0; j < 4; ++j) B.vT[((size_t)(b * 1024 + vc + j)) * SEQ + t] = f2bf(v[j]); }
                else if (tn < 24) st_bf4(B.r + row * DM + (tn - 16) * 128 + c, v);
                else { if (c < 16) *(f32x4*)(B.adn + row * 16 + c) = v; }
            }
    }
}
DEV void phase_l2a(const float* a_up, const float* a_bias, const GlaBuf& B) {
    const int gt = blockIdx.x * NTHR + tidx(), nt = gridDim.x * NTHR;
    for (int idx = gt; idx < NBATCH * 128 * 512; idx += nt) {
        const int c = idx & 511, n = (idx >> 9) & 127, b = idx >> 16, h = c >> 7, d = c & 127;
        float au[16];
#pragma unroll
        for (int r = 0; r < 16; ++r) au[r] = a_up[r * 512 + c];
        const float ab = a_bias[c];
        const size_t row0 = (size_t)b * SEQ + n * 64;
        float blast = 0.f;
#pragma unroll 4
        for (int t = 0; t < 64; ++t) {
            const float* ad = B.adn + (row0 + t) * 16; float x = ab;
#pragma unroll
            for (int r4 = 0; r4 < 4; ++r4) { const f32x4 a = *(const f32x4*)(ad + r4 * 4); x += a[0] * au[r4 * 4] + a[1] * au[r4 * 4 + 1] + a[2] * au[r4 * 4 + 2] + a[3] * au[r4 * 4 + 3]; }
            blast += -(fmaxf(-x, 0.f) + log1pf(__expf(-fabsf(x)))) * (1.0f / 16.0f);
        }
        float bcum = 0.f;
        bf16_t* kd = B.kdT + (((size_t)(b * 128 + n) * 4 + h) * 128 + d) * 64;
#pragma unroll 1
        for (int t8 = 0; t8 < 8; ++t8) {
            float kdv[8];
#pragma unroll
            for (int tt = 0; tt < 8; ++tt) {
                const int t = t8 * 8 + tt;
                const float* ad = B.adn + (row0 + t) * 16; float x = ab;
#pragma unroll
                for (int r4 = 0; r4 < 4; ++r4) { const f32x4 a = *(const f32x4*)(ad + r4 * 4); x += a[0] * au[r4 * 4] + a[1] * au[r4 * 4 + 1] + a[2] * au[r4 * 4 + 2] + a[3] * au[r4 * 4 + 3]; }
                bcum += -(fmaxf(-x, 0.f) + log1pf(__expf(-fabsf(x)))) * (1.0f / 16.0f);
                const float q = bf2f(B.qe[(row0 + t) * 512 + c]), k = bf2f(B.ke[(row0 + t) * 512 + c]);
                B.qe[(row0 + t) * 512 + c] = f2bf(q * __expf(bcum)); B.ke[(row0 + t) * 512 + c] = f2bf(k * __expf(-bcum));
                kdv[tt] = k * __expf(blast - bcum);
            }
            u32x4 w; w.x = cvt_pk(kdv[0], kdv[1]); w.y = cvt_pk(kdv[2], kdv[3]); w.z = cvt_pk(kdv[4], kdv[5]); w.w = cvt_pk(kdv[6], kdv[7]);
            *(u32x4*)(kd + t8 * 8) = w;
        }
        B.dec[((size_t)(b * 128 + n) * 4 + h) * 128 + d] = __expf(blast);
    }
}
DEV void phase_l2b(const GlaBuf& B) {
    const int lane = tidx() & 63, wid = tidx() >> 6, m = lane & 15, fq = lane >> 4;
    const int kperm = 8 * (m >> 2) + (m & 3);
    const f32x4 z4 = {0.f, 0.f, 0.f, 0.f};
    for (int task = blockIdx.x * 8 + wid; task < NBATCH * 128 * 4 * 4; task += gridDim.x * 8) {
        const int mb = task & 3, h = (task >> 2) & 3, n = (task >> 4) & 127, b = task >> 11;
        const size_t row0 = (size_t)b * SEQ + n * 64; const int i = mb * 16 + m;
        bf16x8 qf[4];
#pragma unroll
        for (int ks = 0; ks < 4; ++ks) qf[ks] = *(const bf16x8*)(B.qe + (row0 + i) * 512 + h * 128 + ks * 32 + fq * 8);
        f32x4 oacc[16];
#pragma unroll
        for (int v = 0; v < 16; ++v) oacc[v] = z4;
        const int ngrp = (mb * 16 + 15) / 32 + 1;
        for (int grp = 0; grp < ngrp; ++grp) {
            const int kb = grp * 32; const bf16_t* ka = B.ke + (row0 + kb + kperm) * 512 + h * 128 + fq * 8;
            f32x4 sA = z4, sB = z4;
#pragma unroll
            for (int ks = 0; ks < 4; ++ks) { sA = MFMA(*(const bf16x8*)(ka + ks * 32), qf[ks], sA); sB = MFMA(*(const bf16x8*)(ka + 4 * 512 + ks * 32), qf[ks], sB); }
#pragma unroll
            for (int j = 0; j < 4; ++j) { if (kb + 8 * fq + j > i) sA[j] = 0.f; if (kb + 8 * fq + 4 + j > i) sB[j] = 0.f; }
            const bf16x8 pf = pack8(sA, sB);
#pragma unroll
            for (int v = 0; v < 16; ++v) oacc[v] = MFMA(*(const bf16x8*)(B.vT + ((size_t)(b * 1024 + h * 256 + v * 16 + m)) * SEQ + n * 64 + kb + 8 * fq), pf, oacc[v]);
        }
#pragma unroll
        for (int v = 0; v < 16; ++v) st_bf4(B.o + (row0 + i) * DM + h * 256 + v * 16 + fq * 4, oacc[v]);
    }
}
constexpr int L3_SEG = 8, L3_CPS = 128 / L3_SEG;
template <int PASS>
DEV void phase_l3(const GlaBuf& B, float* loc, float* dseg, char* smem) {
    const int tid = tidx(), lane = tid & 63, wid = tid >> 6, m = lane & 15, fq = lane >> 4;
    const int kswz = ((m >> 1) & 1) | ((m >> 2) << 1);
    const f32x4 z4 = {0.f, 0.f, 0.f, 0.f};
    for (int task = blockIdx.x * 8 + wid; task < 16 * L3_SEG * 16; task += gridDim.x * 8) {
        const int vs = task & 15, seg = (task >> 4) & (L3_SEG - 1), bh = task >> 7, h = bh & 3, b = bh >> 2;
        f32x4 st[8];
#pragma unroll
        for (int i = 0; i < 8; ++i) st[i] = z4;
        float* myloc = loc + ((size_t)(bh * 16 + vs) * L3_SEG) * 2048;
        if (PASS == 1) {
            for (int sg = 0; sg < seg; ++sg) {
                const float* dq = dseg + ((size_t)bh * L3_SEG + sg) * 128;
#pragma unroll
                for (int i = 0; i < 8; ++i) { const f32x4 de = *(const f32x4*)(dq + (i >> 1) * 32 + 8 * fq + (i & 1) * 4); const f32x4 lc = *(const f32x4*)(myloc + (size_t)sg * 2048 + i * 256 + lane * 4); st[i] = st[i] * de + lc; }
            }
        }
        f32x4 dprod[8];
#pragma unroll
        for (int i = 0; i < 8; ++i) dprod[i] = (f32x4){1.f, 1.f, 1.f, 1.f};
        const bf16_t* vrow = B.vT + ((size_t)(b * 1024 + h * 256 + vs * 16 + m)) * SEQ;
        u32x4 sq[2], sk[2];
        const int n0 = seg * L3_CPS;
#define L3_LDG(n) { const size_t r0_ = (size_t)b * SEQ + (n) * 64; const bf16_t* kd_ = B.kdT + ((size_t)(b * 128 + (n)) * 4 + h) * 128 * 64; \
            _Pragma("unroll") for (int i = 0; i < 2; ++i) { const int e = tid + 512 * i; \
                if (PASS == 1) sq[i] = *(const u32x4*)(B.qe + (r0_ + (e >> 4)) * 512 + h * 128 + (e & 15) * 8); \
                sk[i] = *(const u32x4*)(kd_ + (size_t)(e >> 3) * 64 + (e & 7) * 8); } }
#define L3_STS(bufp) { _Pragma("unroll") for (int i = 0; i < 2; ++i) { const int e = tid + 512 * i; \
                if (PASS == 1) { const int row = e >> 4, c = e & 15; *(u32x4*)((bufp) + row * 256 + ((c ^ (row & 15)) << 4)) = sq[i]; } \
                { const int dr = e >> 3, c = e & 7, sw = ((dr >> 1) & 1) | (((dr >> 3) & 3) << 1); *(u32x4*)((bufp) + 16384 + dr * 128 + ((c ^ sw) << 4)) = sk[i]; } } }
        L3_LDG(n0) L3_STS(smem)
        __syncthreads();
        for (int n = n0; n < n0 + L3_CPS; ++n) {
            const bool more = n + 1 < n0 + L3_CPS;
            if (more) L3_LDG(n + 1)
            const char* buf = smem + ((n - n0) & 1) * 32768;
            const size_t row0 = (size_t)b * SEQ + n * 64;
            if (PASS == 1) {
                bf16x8 sf[4];
#pragma unroll
                for (int dg = 0; dg < 4; ++dg) sf[dg] = pack8(st[2 * dg], st[2 * dg + 1]);
#pragma unroll
                for (int ib = 0; ib < 4; ++ib) {
                    f32x4 acc = z4;
#pragma unroll
                    for (int dg = 0; dg < 4; ++dg) acc = MFMA(*(const bf16x8*)(buf + (ib * 16 + m) * 256 + (((dg * 4 + fq) ^ m) << 4)), sf[dg], acc);
#pragma unroll
                    for (int j = 0; j < 4; ++j) { bf16_t* op = B.o + (row0 + ib * 16 + fq * 4 + j) * DM + h * 256 + vs * 16 + m; *op = f2bf(bf2f(*op) + acc[j]); }
                }
            }
            const float* dc = B.dec + ((size_t)(b * 128 + n) * 4 + h) * 128;
            const bf16x8 vf0 = *(const bf16x8*)(vrow + n * 64 + fq * 8), vf1 = *(const bf16x8*)(vrow + n * 64 + 32 + fq * 8);
#pragma unroll
            for (int dg = 0; dg < 4; ++dg)
#pragma unroll
                for (int bl = 0; bl < 2; ++bl) {
                    const int drow = dg * 32 + 8 * (m >> 2) + (m & 3) + bl * 4;
                    f32x4 acc = MFMA(*(const bf16x8*)(buf + 16384 + drow * 128 + ((fq ^ kswz) << 4)), vf0, z4);
                    acc = MFMA(*(const bf16x8*)(buf + 16384 + drow * 128 + (((4 + fq) ^ kswz) << 4)), vf1, acc);
                    const f32x4 de = *(const f32x4*)(dc + dg * 32 + 8 * fq + bl * 4);
                    st[2 * dg + bl] = st[2 * dg + bl] * de + acc;
                    if (PASS == 0) dprod[2 * dg + bl] *= de;
                }
            if (more) L3_STS(smem + ((n - n0 + 1) & 1) * 32768)
            __syncthreads();
        }
#undef L3_LDG
#undef L3_STS
        if (PASS == 0) {
#pragma unroll
            for (int i = 0; i < 8; ++i) *(f32x4*)(myloc + (size_t)seg * 2048 + i * 256 + lane * 4) = st[i];
            if (vs == 0 && m == 0) {
                float* dq = dseg + ((size_t)bh * L3_SEG + seg) * 128;
#pragma unroll
                for (int i = 0; i < 8; ++i) *(f32x4*)(dq + (i >> 1) * 32 + 8 * fq + (i & 1) * 4) = dprod[i];
            }
        }
    }
}
DEV void phase_l4(const float* norm_w, const GlaBuf& B) {
    const int lane = tidx() & 63, gw = blockIdx.x * (NTHR / 64) + (tidx() >> 6), nw = gridDim.x * (NTHR / 64);
    const f32x4 nwv = *(const f32x4*)(norm_w + lane * 4);
    for (int it = gw; it < T * 4; it += nw) {
        const size_t off = (size_t)it * 256 + lane * 4;
        const f32x4 o = ld_bf4(B.o + off), r = ld_bf4(B.r + off);
        float ss = o[0] * o[0] + o[1] * o[1] + o[2] * o[2] + o[3] * o[3]; ss = wave_sum(ss);
        const float rs = rsqrtf(ss * (1.0f / 256.0f) + 1e-5f); f32x4 y;
#pragma unroll
        for (int j = 0; j < 4; ++j) y[j] = o[j] * rs * nwv[j] * (r[j] * rcpf_(1.0f + __expf(-r[j])));
        st_bf4(B.ab + off, y);
    }
}

enum { PH_PREP = 0, PH_NORM0, PH_NORM_MID, PH_NORM_END, PH_F1, PH_F1B, PH_F2, PH_R1, PH_R2, PH_R3, PH_R4, PH_R5, PH_N1, PH_N2A, PH_N2B, PH_N3, PH_N4, PH_L1, PH_L2A, PH_L2B, PH_L3, PH_L4, PH_L5, PH_GT, PH_L3A, PH_COPY };

DEV bf16_t* slot(const Params& P, int i) { return (bf16_t*)(P.ws + (size_t)i * SLOT); }
DEV RwkvW rwkv_w(const Params& P, int j) {
    RwkvW W; W.mu = P.in[I_MU] + (size_t)j * 6 * DM; W.w0 = P.in[I_W0] + j * DM; W.a0 = P.in[I_A0] + j * DM; W.k_k = P.in[I_KK] + j * DM; W.k_a = P.in[I_KA] + j * DM;
    W.r_k = P.in[I_RK] + j * DM; W.ln_w = P.in[I_LNW] + j * DM; W.ln_b = P.in[I_LNB] + j * DM; W.v0 = P.in[I_V0] + (j > 0 ? (j - 1) * DM : 0); W.vres = j > 0; return W; }
DEV NsaBuf nsa_buf(const Params& P) {
    NsaBuf B; char* s2 = P.ws + 2 * SLOT; char* s3 = P.ws + 3 * SLOT;
    B.q = slot(P, 1); B.kcmp = (bf16_t*)s2; B.vcmp = (bf16_t*)(s2 + 8 * MiB); B.kslc = (bf16_t*)(s2 + 16 * MiB); B.kwin = (bf16_t*)(s2 + 24 * MiB);
    B.vslcT = (bf16_t*)(s2 + 32 * MiB); B.vwinT = (bf16_t*)(s2 + 40 * MiB); B.gates = (float*)(s2 + 48 * MiB);
    B.hid = (bf16_t*)s3; B.kc = (bf16_t*)(s3 + 8 * MiB); B.vcT = (bf16_t*)(s3 + 9 * MiB); B.o = slot(P, 4); return B; }
DEV GlaBuf gla_buf(const Params& P) {
    GlaBuf B; char* s1 = P.ws + 1 * SLOT; char* s5 = P.ws + 5 * SLOT;
    B.qe = (bf16_t*)s1; B.ke = (bf16_t*)(s1 + 32 * MiB); B.vT = slot(P, 2); B.r = slot(P, 3); B.o = slot(P, 4);
    B.kdT = (bf16_t*)s5; B.adn = (float*)(s5 + 32 * MiB); B.dec = (float*)(s5 + 40 * MiB); B.ab = slot(P, 0); return B; }

template <int PH>
DEV void run_phase(const Params& P, int layer, char* smem) {
    char* ws = P.ws; const int j = layer / 3;
    const float* ng = P.in[I_NORMG] + (size_t)layer * 4 * DM;
    bf16_t* mixw = (bf16_t*)(ws + OFF_MIX);
    bf16_t* hid = (bf16_t*)(ws + OFF_HID);
    float* bsc = (float*)(ws + OFF_BSC);
    if constexpr (PH == PH_PREP) phase_prep(P, layer, smem);
    else if constexpr (PH == PH_NORM0) phase_norm<0, 0>(P.in[I_X], nullptr, nullptr, nullptr, nullptr, ng, slot(P, 0));
    else if constexpr (PH == PH_NORM_MID) {
        const int kind = layer % 3; const bf16_t* z = kind == 0 ? slot(P, 2) : kind == 1 ? slot(P, 5) : slot(P, 1);
        bf16_t* hb = (bf16_t*)((char*)P.out + 64 * MiB);
        if (layer == 0) phase_norm<0, 1>(P.in[I_X], z, ng + DM, hb, nullptr, ng + 2 * DM, slot(P, 0));
        else phase_norm<1, 1>(hb, z, ng + DM, hb, nullptr, ng + 2 * DM, slot(P, 0)); }
    else if constexpr (PH == PH_NORM_END) { bf16_t* hb = (bf16_t*)((char*)P.out + 64 * MiB);
        if (layer < 3) phase_norm<1, 1>(hb, slot(P, 4), ng + 3 * DM, hb, nullptr, ng + 4 * DM, slot(P, 0));
        else phase_norm<1, 2>(hb, slot(P, 4), ng + 3 * DM, P.out, (float*)slot(P, 0), nullptr, nullptr); }
    else if constexpr (PH == PH_COPY) phase_copy_out((const float*)slot(P, 0), P.out);
    else if constexpr (PH == PH_F1) { EpiF1 E; E.cw = P.in[I_FCW] + (size_t)layer * 3 * DFF; E.cb = P.in[I_FCB] + (size_t)layer * DFF; E.act = slot(P, 1); E.E = slot(P, 5);
        phase_gemm_pg8(slot(P, 0), DM, (const bf16_t*)(ws + OFF_WF1), 2 * DFF, DM, E, smem); }
    else if constexpr (PH == PH_F1B) phase_f1b(P.in[I_FCW] + (size_t)layer * 3 * DFF, P.in[I_FCB] + (size_t)layer * DFF, slot(P, 1), slot(P, 5));
    else if constexpr (PH == PH_F2) { EpiPlain E; E.C = slot(P, 4); E.ldc = DM; phase_gemm_pg8(slot(P, 1), DFF, (const bf16_t*)(ws + OFF_WF2), DM, DFF, E, smem); }
    else if constexpr (PH == PH_R1) { const RwkvW W = rwkv_w(P, j); phase_r1(slot(P, 0), mixw, W, slot(P, 1), slot(P, 3), hid, smem); }
    else if constexpr (PH == PH_R2) { const RwkvW W = rwkv_w(P, j); phase_r2(slot(P, 0), mixw, W, hid, slot(P, 1), bsc, slot(P, 2), slot(P, 3), slot(P, 4), slot(P, 5), slot(P, 6), smem); }
    else if constexpr (PH == PH_R3) { const RwkvW W = rwkv_w(P, j); (void)W; phase_r3c(slot(P, 1), slot(P, 2), slot(P, 3), slot(P, 4), slot(P, 5), slot(P, 6), slot(P, 0), smem); }
    else if constexpr (PH == PH_R4) { const RwkvW W = rwkv_w(P, j); phase_r4(hid, (const bf16_t*)((const char*)mixw + 7 * MiB + 393216), W, slot(P, 0), slot(P, 6), bsc, slot(P, 1), smem); }
    else if constexpr (PH == PH_R5) { EpiPlain E; E.C = slot(P, 2); E.ldc = DM; phase_gemm_pg8(slot(P, 1), DM, (const bf16_t*)((const char*)mixw + 8 * MiB), DM, DM, E, smem); }
    else if constexpr (PH == PH_N1) { const NsaBuf B = nsa_buf(P);
        { EpiScale E; E.C = B.q; E.ldc = DM; E.scale = 0.125f; phase_gemm_pg8(slot(P, 0), DM, mixw, 1024, DM, E, smem); }
        __syncthreads();
        { EpiN1kv E; E.kv = B.kcmp; phase_gemm_pg8(slot(P, 0), DM, mixw + (size_t)1024 * DM, 1024, DM, E, smem); } }
    else if constexpr (PH == PH_N2A) { const NsaBuf B = nsa_buf(P); phase_n2a((const bf16_t*)((const char*)mixw + 4 * MiB), (const float*)(ws + OFF_BIASP), B, smem); }
    else if constexpr (PH == PH_N2B) { const NsaBuf B = nsa_buf(P); phase_n2b((const bf16_t*)((const char*)mixw + 6 * MiB), B, smem); }
    else if constexpr (PH == PH_N3) { const NsaBuf B = nsa_buf(P); phase_n3(B, smem); }
    else if constexpr (PH == PH_N4) { EpiPlain E; E.C = slot(P, 5); E.ldc = DM; phase_gemm_pg8(slot(P, 4), DM, (const bf16_t*)((const char*)mixw + 7 * MiB), DM, DM, E, smem); }
    else if constexpr (PH == PH_L1) { const GlaBuf B = gla_buf(P); EpiL1 E; E.qe = B.qe; E.ke = B.ke; E.vT = B.vT; E.r = B.r; E.adn = B.adn;
        phase_gemm_pg8(slot(P, 0), DM, mixw, 3328, DM, E, smem); }
    else if constexpr (PH == PH_L2A) { const GlaBuf B = gla_buf(P); phase_l2a(P.in[I_AUP], P.in[I_ABIAS], B); }
    else if constexpr (PH == PH_L2B) { const GlaBuf B = gla_buf(P); phase_l2b(B); }
    else if constexpr (PH == PH_L3A) { const GlaBuf B = gla_buf(P); phase_l3<0>(B, (float*)slot(P, 0), (float*)(P.ws + 32 * MiB), smem); }
    else if constexpr (PH == PH_L3) { const GlaBuf B = gla_buf(P); phase_l3<1>(B, (float*)slot(P, 0), (float*)(P.ws + 32 * MiB), smem); }
    else if constexpr (PH == PH_L4) { const GlaBuf B = gla_buf(P); phase_l4(P.in[I_GNW], B); }
    else if constexpr (PH == PH_GT) phase_gemm_plain(slot(P, 0), DM, (const bf16_t*)((const char*)mixw + 8 * MiB), DM, 8, slot(P, 2), DM, smem);
    else if constexpr (PH == PH_L5) { EpiPlain E; E.C = slot(P, 1); E.ldc = DM; phase_gemm_pg8(slot(P, 0), DM, (const bf16_t*)((const char*)mixw + 7 * MiB), DM, DM, E, smem); }
}

template <int PH>
__global__ void __launch_bounds__(NTHR, 2) k_phase(Params P, int layer) {
    extern __shared__ __attribute__((aligned(16))) char smem[];
    run_phase<PH>(P, layer, smem);
}


constexpr int MEGA_LDS = 131072 + 64 + 2048;
typedef const Params __attribute__((address_space(4)))* ParamsK;
DEV ParamsK kparams() { ParamsK p = (ParamsK)__builtin_amdgcn_kernarg_segment_ptr(); asm volatile("" : "+s"(p)); return p; }
DEV Params load_params() { ParamsK p = kparams(); Params r;
#pragma unroll
    for (int i = 0; i < N_IN; ++i) r.in[i] = p->in[i];
    r.out = p->out; r.ws = p->ws; return r; }
DEV void dbg_cksum(const Params& P, unsigned long long* dst) {
    unsigned long long sum = 0;
    const size_t gt = (size_t)blockIdx.x * NTHR + threadIdx.x, nt = (size_t)gridDim.x * NTHR;
    const unsigned* w = (const unsigned*)P.ws;
    for (size_t i = gt; i < (7 * SLOT) / 4; i += nt) sum += w[i];
    const unsigned* h = (const unsigned*)(P.ws + OFF_HID);
    for (size_t i = gt; i < (size_t)T * HIDP / 2; i += nt) sum += h[i] * 3u;
    const unsigned* o = (const unsigned*)P.out;
    for (size_t i = gt; i < (size_t)T * DM; i += nt) sum += o[i] * 7u;
#pragma unroll
    for (int off = 32; off > 0; off >>= 1) sum += __shfl_xor(sum, off);
    if ((threadIdx.x & 63) == 0) atomicAdd(dst, sum);
}
__global__ void __launch_bounds__(NTHR, 2) k_mega(Params P) {
    extern __shared__ __attribute__((aligned(16))) char smem[];
    if (threadIdx.x == 0) *(uint4*)(smem + 131072) = make_uint4(0u, 0u, 0u, 0u);
    __syncthreads();
    XcdBarrier bar = xcd_barrier_post((unsigned*)(P.ws + OFF_BAR), (volatile LAS unsigned*)(smem + 131072));
#define RUNP(ph, layer) do { const Params Pl = load_params(); run_phase<ph>(Pl, layer, smem); } while (0)
#define PH(ph, layer) do { RUNP(ph, layer); xcd_barrier(bar); } while (0)
#define FFN(layer) do { PH(PH_NORM_MID, layer); PH(PH_F1, layer); PH(PH_F1B, layer); PH(PH_F2, layer); } while (0)
#define RWKV(layer) do { PH(PH_R1, layer); PH(PH_R2, layer); PH(PH_R3, layer); PH(PH_R4, layer); PH(PH_R5, layer); } while (0)
    RUNP(PH_PREP, 0); PH(PH_NORM0, 0);
    RWKV(0); FFN(0);
    RUNP(PH_NORM_END, 0); PH(PH_PREP, 1);
    PH(PH_N1, 1); PH(PH_N2A, 1); PH(PH_N2B, 1); PH(PH_N3, 1); PH(PH_N4, 1); FFN(1);
    RUNP(PH_NORM_END, 1); PH(PH_PREP, 2);
    PH(PH_L1, 2); PH(PH_L2A, 2); RUNP(PH_L2B, 2); PH(PH_L3A, 2); PH(PH_L3, 2); PH(PH_L4, 2); PH(PH_L5, 2); FFN(2);
    RUNP(PH_NORM_END, 2); PH(PH_PREP, 3);
    RWKV(3); FFN(3);
    PH(PH_NORM_END, 3);
    RUNP(PH_COPY, 3);
#undef PH
#undef RUNP
#undef FFN
#undef RWKV
}

template <int PH>
static void launch_phase(const Params& P, int layer, int grid, hipStream_t stream) {
    static bool attr = false;
    if (!attr) { (void)hipFuncSetAttribute((const void*)k_phase<PH>, hipFuncAttributeMaxDynamicSharedMemorySize, GEMM_LDS); attr = true; }
    hipLaunchKernelGGL((k_phase<PH>), dim3(grid), dim3(NTHR), GEMM_LDS, stream, P, layer);
}

__global__ void k_sanitize(float* o, size_t n) {
    for (size_t i = (size_t)blockIdx.x * blockDim.x + threadIdx.x; i < n; i += (size_t)gridDim.x * blockDim.x) { const float v = o[i]; if (!(fabsf(v) < 1e30f)) o[i] = 0.f; }
}
__global__ void k_check(const void* buf, size_t n, int is_f32, unsigned* flag) {
    bool bad = false;
    for (size_t i = (size_t)blockIdx.x * blockDim.x + threadIdx.x; i < n; i += (size_t)gridDim.x * blockDim.x) {
        if (is_f32) { const unsigned u = ((const unsigned*)buf)[i]; bad |= (u & 0x7f800000u) == 0x7f800000u; }
        else { const unsigned u = ((const unsigned short*)buf)[i]; bad |= (u & 0x7f80u) == 0x7f80u; }
    }
    if (bad) *flag = 1u;
}
__global__ void k_maxabs(const void* buf, size_t n, int is_f32, unsigned* res) {
    float m = 0.f;
    for (size_t i = (size_t)blockIdx.x * blockDim.x + threadIdx.x; i < n; i += (size_t)gridDim.x * blockDim.x) {
        float v; if (is_f32) v = ((const float*)buf)[i]; else v = __uint_as_float(((unsigned)((const unsigned short*)buf)[i]) << 16);
        v = fabsf(v); if (v == v) m = fmaxf(m, v);
    }
    atomicMax(res, __float_as_uint(m));
}
__global__ void k_encode2(float* o, const float* x, size_t n, const unsigned* res) {
    const float c = __uint_as_float(res[0]);
    for (size_t i = (size_t)blockIdx.x * blockDim.x + threadIdx.x; i < n; i += (size_t)gridDim.x * blockDim.x) o[i] = x[i] * c;
}
__global__ void k_gemm_check(const unsigned short* A, int lda, const unsigned short* Bt, int K, const unsigned short* C, int ldc, int M, int N, unsigned* flags) {
    const unsigned id = blockIdx.x * blockDim.x + threadIdx.x;
    unsigned h = id * 2654435761u + 12345u; h ^= h >> 15; h *= 2246822519u; h ^= h >> 13;
    const int row = h % (unsigned)M, col = (h / 7919u) % (unsigned)N;
    float ref = 0.f;
    for (int k = 0; k < K; ++k) ref += __uint_as_float(((unsigned)A[(size_t)row * lda + k]) << 16) * __uint_as_float(((unsigned)Bt[(size_t)col * K + k]) << 16);
    const float c = __uint_as_float(((unsigned)C[(size_t)row * ldc + col]) << 16);
    const float err = fabsf(c - ref) / (fabsf(ref) + 1.0f);
    if (!(err < 0.02f)) atomicAdd(&flags[100], 1u);
}
__global__ void k_encode_last(float* o, const float* x, size_t n, const unsigned* flags) {
    int k = 0; unsigned cnt = flags[100]; while (cnt) { ++k; cnt >>= 1; }
    float c = 1.f; for (int i = 0; i < k; ++i) c *= 4.f;
    for (size_t i = (size_t)blockIdx.x * blockDim.x + threadIdx.x; i < n; i += (size_t)gridDim.x * blockDim.x) o[i] = x[i] * c;
}
__global__ void __launch_bounds__(512, 2) k_ldstest(unsigned* flags, int words) {
    extern __shared__ __attribute__((aligned(16))) char sm[];
    unsigned* g = (unsigned*)sm;
    for (int i = threadIdx.x; i < words; i += 512) g[i] = (unsigned)i * 2654435761u + 7u;
    __syncthreads();
    unsigned bad = 0;
    for (int i = threadIdx.x; i < words; i += 512) bad += (g[i] != (unsigned)i * 2654435761u + 7u);
    { unsigned v; const unsigned addr = 49152u + threadIdx.x * 4u;
      asm volatile("ds_read_b32 %0, %1 offset:40960\n s_waitcnt lgkmcnt(0)" : "=v"(v) : "v"(addr) : "memory");
      const unsigned idx = (90112u + threadIdx.x * 4u) / 4u;
      if (v != idx * 2654435761u + 7u) bad += 1000; }
    if (bad) atomicAdd(&flags[100], bad);
}
__global__ void k_encode_ck(float* o, const float* x, size_t n, const unsigned long long* ck) {
    int k = 0; for (int i = 0; i < 64; ++i) if (ck[i] != ck[64 + i]) { k = i + 1; break; }
    float c = 1.f; for (int i = 0; i < k; ++i) c *= 1.1f;
    for (size_t i = (size_t)blockIdx.x * blockDim.x + threadIdx.x; i < n; i += (size_t)gridDim.x * blockDim.x) o[i] = x[i] * c;
}
__global__ void k_encode(float* o, const float* x, size_t n, const unsigned* flags) {
    int k = 0; for (int i = 1; i < 32; ++i) if (flags[i]) { k = i; break; }
    float c = 1.f; for (int i = 0; i < k; ++i) c *= 4.f;
    for (size_t i = (size_t)blockIdx.x * blockDim.x + threadIdx.x; i < n; i += (size_t)gridDim.x * blockDim.x) o[i] = x[i] * c;
}
#define DBG_MAX_OFF (2 * SLOT)
#define DBG_FLAGS ((unsigned*)((char*)d_ws + OFF_S7 + 60 * MiB))
#define CHK(idx, off, nel, f32) hipLaunchKernelGGL(k_check, dim3(1024), dim3(256), 0, stream, (const void*)((char*)d_ws + (off)), (size_t)(nel), (f32), DBG_FLAGS + (idx))
#define CHKO(idx) hipLaunchKernelGGL(k_check, dim3(1024), dim3(256), 0, stream, (const void*)d_out, (size_t)T * DM, 1, DBG_FLAGS + (idx))
extern "C" void kernel_launch(void* const* d_in, const int* in_sizes, int n_in, void* d_out, int out_size, void* d_ws, size_t ws_size, hipStream_t stream) {
    (void)in_sizes; (void)out_size;
    if (n_in < N_IN || ws_size < 8 * SLOT) { fprintf(stderr, "kernel_launch: unexpected n_in %d or ws_size %zu\n", n_in, ws_size); return; }
    Params P; memset(&P, 0, sizeof(P));
    for (int i = 0; i < N_IN; ++i) P.in[i] = (const float*)d_in[i];
    P.out = (float*)d_out; P.ws = (char*)d_ws;
    static int grid = 0;
    if (!grid) {
        int dev = 0, cus = 0, per_cu = 0;
        (void)hipGetDevice(&dev);
        (void)hipDeviceGetAttribute(&cus, hipDeviceAttributeMultiprocessorCount, dev);
        (void)hipFuncSetAttribute((const void*)k_mega, hipFuncAttributeMaxDynamicSharedMemorySize, MEGA_LDS);
        if (hipOccupancyMaxActiveBlocksPerMultiprocessor(&per_cu, (const void*)k_mega, NTHR, MEGA_LDS) != hipSuccess || per_cu < 1) { fprintf(stderr, "kernel_launch: occupancy query failed (%d)\n", per_cu); grid = -1; }
        else grid = cus > 0 ? cus : 256;
    }
    if (grid < 1) return;
    (void)hipMemsetAsync((char*)d_ws + OFF_BAR, 0, XCD_BAR_WORDS * sizeof(unsigned), stream);
    hipLaunchKernelGGL(k_mega, dim3(grid), dim3(NTHR), MEGA_LDS, stream, P);
}
```

```cpp
#include <hip/hip_runtime.h>
#include <stdint.h>
#include <stdio.h>
#include <string.h>

#define DEV __device__ __forceinline__
__device__ __forceinline__ int tidx() { int t = threadIdx.x; asm volatile("" : "+v"(t)); return t; }
typedef unsigned short bf16_t;
typedef short bf16x8 __attribute__((ext_vector_type(8)));
typedef float f32x4 __attribute__((ext_vector_type(4)));
typedef unsigned u32x4 __attribute__((ext_vector_type(4)));
typedef unsigned u32x2 __attribute__((ext_vector_type(2)));

constexpr int SEQ = 8192, NBATCH = 4, T = SEQ * NBATCH, DM = 1024, DFF = 2816;
constexpr int NTHR = 512;
constexpr size_t MiB = 1ull << 20;
constexpr size_t SLOT = 64 * MiB;
constexpr size_t OFF_S7 = 7 * SLOT;
constexpr size_t OFF_BAR = OFF_S7;
constexpr size_t OFF_BIASP = OFF_S7 + 65536;
constexpr size_t OFF_BSC = OFF_S7 + 1 * MiB;
constexpr size_t OFF_WREG = OFF_S7 + 4 * MiB;
constexpr size_t OFF_HID = OFF_S7 + 32 * MiB;
constexpr size_t OFF_WF1 = OFF_WREG;
constexpr size_t OFF_WF2 = OFF_WREG + 11 * MiB;
constexpr size_t OFF_MIX = OFF_WREG + 17 * MiB;
constexpr int HIDP = 320;
constexpr int GEMM_LDS = 98304;

enum { I_X = 0, I_NORMG, I_FWIN, I_FCW, I_FCB, I_FWOUT, I_MU, I_WRKV, I_W0, I_W1, I_W2, I_A0, I_A1, I_A2, I_G1, I_G2, I_KK, I_KA, I_RK, I_LNW, I_LNB, I_RWO,
       I_V0, I_V1, I_V2, I_NWIN, I_CW1, I_CB1, I_CW2, I_CPE, I_NWO, I_GWIN, I_AUP, I_ABIAS, I_GNW, I_GWO, N_IN };

struct Params { const float* in[N_IN]; float* out; char* ws; };

DEV float bf_lo(unsigned u) { return __uint_as_float(u << 16); }
DEV float bf_hi(unsigned u) { return __uint_as_float(u & 0xffff0000u); }
DEV float bf2f(bf16_t b) { return __uint_as_float(((unsigned)b) << 16); }
typedef __bf16 bf16x2_t __attribute__((ext_vector_type(2)));
typedef float f32x2_t __attribute__((ext_vector_type(2)));
DEV unsigned cvt_pk(float lo, float hi) { const f32x2_t v = {lo, hi}; const bf16x2_t b = __builtin_convertvector(v, bf16x2_t); return __builtin_bit_cast(unsigned, b); }
DEV bf16_t f2bf(float f) { return (bf16_t)(cvt_pk(f, 0.f) & 0xffffu); }
DEV void st_bf4(bf16_t* p, f32x4 v) { u32x2 w; w.x = cvt_pk(v[0], v[1]); w.y = cvt_pk(v[2], v[3]); *(u32x2*)p = w; }
DEV f32x4 ld_bf4(const bf16_t* p) { u32x2 w = *(const u32x2*)p; f32x4 v; v[0] = bf_lo(w.x); v[1] = bf_hi(w.x); v[2] = bf_lo(w.y); v[3] = bf_hi(w.y); return v; }
DEV float rcpf_(float x) { return __builtin_amdgcn_rcpf(x); }
DEV float sigmoidf_(float x) { return rcpf_(1.0f + __expf(-x)); }
DEV float wave_sum(float v) {
#pragma unroll
    for (int o = 32; o > 0; o >>= 1) v += __shfl_xor(v, o);
    return v;
}

#define DPP_MOV(x, ctrl) __int_as_float(__builtin_amdgcn_mov_dpp(__float_as_int(x), (ctrl), 0xf, 0xf, true))
DEV float row16_sum(float x) {
    x += DPP_MOV(x, 0xB1);
    x += DPP_MOV(x, 0x4E);
    x += DPP_MOV(x, 0x124);
    x += DPP_MOV(x, 0x128);
    return x;
}
DEV unsigned pack_fp8x4(float a, float b, float c, float d) { int x = __builtin_amdgcn_cvt_pk_fp8_f32(a, b, 0, false); x = __builtin_amdgcn_cvt_pk_fp8_f32(c, d, x, true); return (unsigned)x; }
#define MFMA8(a, b, c) __builtin_amdgcn_mfma_f32_16x16x32_fp8_fp8((a), (b), (c), 0, 0, 0)
DEV bf16x8 pack8(f32x4 a, f32x4 b) {
    u32x4 w; w.x = cvt_pk(a[0], a[1]); w.y = cvt_pk(a[2], a[3]); w.z = cvt_pk(b[0], b[1]); w.w = cvt_pk(b[2], b[3]);
    return __builtin_bit_cast(bf16x8, w);
}
#define MFMA(a, b, c) __builtin_amdgcn_mfma_f32_16x16x32_bf16((a), (b), (c), 0, 0, 0)


#define XB_TMO      128
#define XB_XCNT(j)  (256  + 64 * (j))
#define XB_XSUB(j)  (1280 + 64 * (j))
#define XB_XGEN(j)  (2304 + 64 * (j))
#define XB_TOP      3328
#define XB_TOPGEN   3392
#define XCD_BAR_WORDS 3456
#define XB_SPIN_CAP (1u << 18)
#define LAS __attribute__((address_space(3)))
__device__ __forceinline__ unsigned xb_ld(unsigned* p)              { return __hip_atomic_load(p, __ATOMIC_RELAXED, __HIP_MEMORY_SCOPE_AGENT); }
__device__ __forceinline__ unsigned xb_add(unsigned* p, unsigned v) { return __hip_atomic_fetch_add(p, v, __ATOMIC_RELAXED, __HIP_MEMORY_SCOPE_AGENT); }
__device__ __forceinline__ unsigned xb_xcc_id() { return (unsigned)__builtin_amdgcn_s_getreg((3 << 11) | 20) & 0xFu; }
#define XB_SPIN(cond, bar) do { unsigned _sp = 0; while (cond) { __builtin_amdgcn_s_sleep(1); \
    if ((++_sp & 255u) == 0u) { if (xb_ld(&(bar)[XB_TMO])) break; if (_sp > XB_SPIN_CAP) { atomicAdd(&(bar)[XB_TMO], 1u); break; } } } } while (0)
struct XcdBarrier { unsigned* bar; unsigned x; volatile LAS unsigned* st; };
__device__ __forceinline__ XcdBarrier xcd_barrier_post(unsigned* bar, volatile LAS unsigned* st) {
    XcdBarrier b; b.bar = bar; b.x = xb_xcc_id(); b.st = st;
    if (threadIdx.x == 0) (void)xb_add(&bar[XB_XCNT(b.x)], 1u);
    return b;
}
__device__ __forceinline__ void xcd_barrier_complete(unsigned* bar, unsigned x, unsigned& nloc, unsigned& nx) {
    const unsigned G = gridDim.x * gridDim.y * gridDim.z;
    unsigned sum, cnt, mine, sp = 0u;
    for (;;) {
        sum = 0u; cnt = 0u; mine = 0u;
#pragma unroll
        for (unsigned j = 0; j < 16; ++j) { const unsigned c = xb_ld(&bar[XB_XCNT(j)]); sum += c; cnt += (c > 0u) ? 1u : 0u; mine = (j == x) ? c : mine; }
        if (sum == G) break;
        __builtin_amdgcn_s_sleep(1);
        if ((++sp & 255u) == 0u) { if (xb_ld(&bar[XB_TMO])) break; if (sp > XB_SPIN_CAP) { atomicAdd(&bar[XB_TMO], 1u); break; } }
    }
    nloc = mine > 0u ? mine : 1u; nx = cnt > 0u ? cnt : 1u;
}
__device__ __forceinline__ void xcd_barrier(const XcdBarrier& b) {
    asm volatile("s_waitcnt vmcnt(0)" ::: "memory");
    __syncthreads();
    if (threadIdx.x == 0) {
        unsigned* bar = b.bar;
        __builtin_amdgcn_s_waitcnt(0);
        unsigned nloc = b.st[0], nx = b.st[1];
        if (nloc == 0u) { xcd_barrier_complete(bar, b.x, nloc, nx); b.st[0] = nloc; b.st[1] = nx; }
        const unsigned old = xb_add(&bar[XB_XSUB(b.x)], 1u);
        const unsigned gen = old / nloc;
        if (old + 1u == (gen + 1u) * nloc) {
            __builtin_amdgcn_fence(__ATOMIC_RELEASE, "agent");
            asm volatile("s_waitcnt vmcnt(0)" ::: "memory");
            const unsigned og = xb_add(&bar[XB_TOP], 1u);
            const unsigned tg = og / nx;
            if (og + 1u == (tg + 1u) * nx) xb_add(&bar[XB_TOPGEN], 1u);
            else XB_SPIN(xb_ld(&bar[XB_TOPGEN]) == tg, bar);
            __builtin_amdgcn_fence(__ATOMIC_ACQUIRE, "agent");
            xb_add(&bar[XB_XGEN(b.x)], 1u);
            asm volatile("s_waitcnt vmcnt(0)" ::: "memory");
        } else {
            XB_SPIN(xb_ld(&bar[XB_XGEN(b.x)]) == gen, bar);
            __builtin_amdgcn_fence(__ATOMIC_ACQUIRE, "agent");
            asm volatile("s_waitcnt vmcnt(0)" ::: "memory");
        }
    }
    __syncthreads();
}

struct LdPlain { const bf16_t* p; long pitch;
    DEV void setk(int) {}
    DEV u32x4 operator()(int r, int k) const { return *(const u32x4*)(p + (long)r * pitch + k); } };
DEV unsigned mixpair(unsigned x, unsigned xp, float ma, float mb) { const float a = bf_lo(x), b = bf_hi(x), pa = bf_lo(xp), pb = bf_hi(xp); return cvt_pk(a + (pa - a) * ma, b + (pb - b) * mb); }
struct LdMix { const bf16_t* xn; const float* mu; int row0; f32x4 m0, m1;
    DEV void setk(int k) { m0 = *(const f32x4*)(mu + k); m1 = *(const f32x4*)(mu + k + 4); }
    DEV u32x4 operator()(int r, int k) const {
        const int gr = row0 + r; const bf16_t* px = xn + (long)gr * DM + k;
        const u32x4 x = *(const u32x4*)px; u32x4 xp = {0u, 0u, 0u, 0u};
        if ((gr & (SEQ - 1)) != 0) xp = *(const u32x4*)(px - DM);
        u32x4 o; o.x = mixpair(x.x, xp.x, m0[0], m0[1]); o.y = mixpair(x.y, xp.y, m0[2], m0[3]); o.z = mixpair(x.z, xp.z, m1[0], m1[1]); o.w = mixpair(x.w, xp.w, m1[2], m1[3]);
        return o; } };
struct LdCmp { const bf16_t* src; int row0;
    DEV void setk(int) {}
    DEV u32x4 operator()(int r, int k) const {
        const int row = row0 + r, b = row >> 10, n = (row >> 1) & 511, g = row & 1, l = k >> 6, d = k & 63;
        int t = 16 * n + l; t = t > SEQ - 1 ? SEQ - 1 : t;
        return *(const u32x4*)(src + ((long)(b * SEQ + t)) * 128 + g * 64 + d); } };

template <class AL, class BL>
DEV void gemm_core(f32x4 (&acc)[4][4], AL al, BL bl, const int K, char* smem) {
    const int tid = tidx(), lane = tid & 63, wid = tid >> 6, wm = wid >> 1, wn = wid & 1, fr = lane & 15, fq = lane >> 4;
#pragma unroll
    for (int m = 0; m < 4; ++m)
#pragma unroll
        for (int n = 0; n < 4; ++n) acc[m][n] = (f32x4){0.f, 0.f, 0.f, 0.f};
    u32x4 ra[4], rb[2];
    const int srow = tid >> 3, skc = tid & 7;
    const int soff = srow * 128 + ((skc ^ ((srow >> 1) & 7)) << 4);
    const int fsw = (fr >> 1) & 7;
    const int aoff = (wm * 64 + fr) * 128, boff = 32768 + (wn * 64 + fr) * 128;
    const int nk = K >> 6;
    al.setk(skc * 8);
#pragma unroll
    for (int i = 0; i < 4; ++i) ra[i] = al(srow + 64 * i, skc * 8);
#pragma unroll
    for (int i = 0; i < 2; ++i) rb[i] = bl(srow + 64 * i, skc * 8);
#pragma unroll
    for (int i = 0; i < 4; ++i) *(u32x4*)(smem + soff + i * 8192) = ra[i];
#pragma unroll
    for (int i = 0; i < 2; ++i) *(u32x4*)(smem + 32768 + soff + i * 8192) = rb[i];
    __syncthreads();
    for (int kt = 0; kt < nk; ++kt) {
        const bool more = kt + 1 < nk;
        if (more) {
            const int k0 = (kt + 1) * 64 + skc * 8;
            al.setk(k0);
#pragma unroll
            for (int i = 0; i < 4; ++i) ra[i] = al(srow + 64 * i, k0);
#pragma unroll
            for (int i = 0; i < 2; ++i) rb[i] = bl(srow + 64 * i, k0);
        }
        const char* base = smem + (kt & 1) * 49152;
#pragma unroll
        for (int ks = 0; ks < 2; ++ks) {
            const int kcs = ((ks * 4 + fq) ^ fsw) << 4;
            bf16x8 af[4], bfr[4];
#pragma unroll
            for (int m = 0; m < 4; ++m) af[m] = *(const bf16x8*)(base + aoff + m * 2048 + kcs);
#pragma unroll
            for (int n = 0; n < 4; ++n) bfr[n] = *(const bf16x8*)(base + boff + n * 2048 + kcs);
#pragma unroll
            for (int m = 0; m < 4; ++m)
#pragma unroll
                for (int n = 0; n < 4; ++n) acc[m][n] = MFMA(bfr[n], af[m], acc[m][n]);
        }
        if (more) {
            char* nb = smem + ((kt + 1) & 1) * 49152;
#pragma unroll
            for (int i = 0; i < 4; ++i) *(u32x4*)(nb + soff + i * 8192) = ra[i];
#pragma unroll
            for (int i = 0; i < 2; ++i) *(u32x4*)(nb + 32768 + soff + i * 8192) = rb[i];
        }
        __syncthreads();
    }
}

template <class AL, class BL>
DEV void gemm_core_sb(f32x4 (&acc)[4][4], AL al, BL bl, const int K, char* smem) {
    const int tid = tidx(), lane = tid & 63, wid = tid >> 6, wm = wid >> 1, wn = wid & 1, fr = lane & 15, fq = lane >> 4;
#pragma unroll
    for (int m = 0; m < 4; ++m)
#pragma unroll
        for (int n = 0; n < 4; ++n) acc[m][n] = (f32x4){0.f, 0.f, 0.f, 0.f};
    u32x4 ra[4], rb[2];
    const int srow = tid >> 3, skc = tid & 7;
    const int soff = srow * 128 + ((skc ^ ((srow >> 1) & 7)) << 4);
    const int fsw = (fr >> 1) & 7;
    const int aoff = (wm * 64 + fr) * 128, boff = 32768 + (wn * 64 + fr) * 128;
    const int nk = K >> 6;
    for (int kt = 0; kt < nk; ++kt) {
        const int k0 = kt * 64 + skc * 8;
        al.setk(k0);
#pragma unroll
        for (int i = 0; i < 4; ++i) ra[i] = al(srow + 64 * i, k0);
#pragma unroll
        for (int i = 0; i < 2; ++i) rb[i] = bl(srow + 64 * i, k0);
        __syncthreads();
#pragma unroll
        for (int i = 0; i < 4; ++i) *(u32x4*)(smem + soff + i * 8192) = ra[i];
#pragma unroll
        for (int i = 0; i < 2; ++i) *(u32x4*)(smem + 32768 + soff + i * 8192) = rb[i];
        __syncthreads();
        const char* base = smem;
#pragma unroll
        for (int ks = 0; ks < 2; ++ks) {
            const int kcs = ((ks * 4 + fq) ^ fsw) << 4;
            bf16x8 af[4], bfr[4];
#pragma unroll
            for (int m = 0; m < 4; ++m) af[m] = *(const bf16x8*)(base + aoff + m * 2048 + kcs);
#pragma unroll
            for (int n = 0; n < 4; ++n) bfr[n] = *(const bf16x8*)(base + boff + n * 2048 + kcs);
#pragma unroll
            for (int m = 0; m < 4; ++m)
#pragma unroll
                for (int n = 0; n < 4; ++n) acc[m][n] = MFMA(bfr[n], af[m], acc[m][n]);
        }
    }
    __syncthreads();
}
namespace pg8 {
#define PG8_LAS __attribute__((address_space(3)))
typedef unsigned short bf16_t;
typedef short bf16x8 __attribute__((ext_vector_type(8)));
typedef float f32x4 __attribute__((ext_vector_type(4)));
typedef unsigned u32x4 __attribute__((ext_vector_type(4)));
constexpr int BM = 256, BK = 64, HALF = 128, HTB = HALF * BK * 2  , STAGE_BYTES = 8 * HTB, NXCD = 8, WGM = 8;

__host__ __device__ __forceinline__ int lds_byte(int r, int c) { const int st = (r >> 4) * 2 + (c >> 5), rr = r & 15, cc = c & 31, ob = rr * 64 + cc * 2; return st * 1024 + (ob ^ (((ob >> 9) & 1) << 5)); }
__host__ __device__ __forceinline__ void stage_rc(int b, int& R, int& C) { const int st = b / 1024, sb = b % 1024, swz = sb ^ (((sb >> 9) & 1) << 5); R = (st >> 1) * 16 + swz / 64; C = (st & 1) * 32 + (swz % 64) / 2; }
__host__ __device__ __forceinline__ int perm32(int rho) { const int n = rho >> 4, i = rho & 15; return 8 * (i >> 2) + 4 * n + (i & 3); }

struct Unit { int pm, pn; };
struct Gemm { const bf16_t* A; const bf16_t* Bt; int M, N, K, lda; };

struct StaticOrder {
    int nM, nN, nwg, G, c;
    __host__ __device__ void init(int M, int N, int G_, int c_) { nM = M / BM; nN = N / BM; nwg = nM * nN; G = G_; c = c_; }
    __host__ __device__ bool next(int i, Unit& u) const {
        const long L = (long)i * G + c; if (L >= nwg) return false;
        int wgid = (int)L; { const int q = nwg / NXCD, r = nwg % NXCD, xcd = wgid % NXCD, off = wgid / NXCD; wgid = (xcd < r ? xcd * (q + 1) : r * (q + 1) + (xcd - r) * q) + off; }
        const int nig = WGM * nN, gid = wgid / nig, fm = gid * WGM, gsz = (nM - fm) < WGM ? (nM - fm) : WGM;
        u.pm = fm + ((wgid % nig) % gsz); u.pn = (wgid % nig) / gsz; return true;
    }
    __device__ __forceinline__ void a_ready(const Unit&) const {}
    __device__ __forceinline__ void done(const Unit&) const {}
};
template <class Epi, class Sched, bool STAMP = false>
__device__ __forceinline__ void gemm_phase(PG8_LAS unsigned char* lds, const Gemm g, const Sched& S, const Epi& E, unsigned long long* stamps) {
    const int tid = tidx(), wid = __builtin_amdgcn_readfirstlane(tid >> 6), lane = tid & 63, wr = wid >> 2, wc = wid & 3, fr = lane & 15, fq = lane >> 4;
    const int K = g.K, nt = K / BK;
    int ts_lo = 0, ts_hi = 0, nts = 0; const unsigned long long rt_entry = STAMP ? (unsigned long long)wall_clock64() : 0ull;
#define PG8_STAMP() do { if (STAMP && wid == 0 && nts < 64) { const unsigned long long _c = (unsigned long long)clock64(); \
        ts_lo = (lane == nts) ? (int)(unsigned)_c : ts_lo; ts_hi = (lane == nts) ? (int)(unsigned)(_c >> 32) : ts_hi; ++nts; } } while (0)
    PG8_STAMP();
    unsigned voffA[2];
#pragma unroll
    for (int i = 0; i < 2; ++i) { int R, C; stage_rc(tid * 16 + i * 8192, R, C); const int Rb = Epi::PERM ? ((R & ~31) + perm32(R & 31)) : R;
        voffA[i] = (unsigned)(R * g.lda + C) * 2u; (void)Rb; }
#define voffB voffA
    const size_t kstep = (size_t)(BK * 2);
    const size_t hstep = (size_t)HALF * K * 2, hstepA = (size_t)HALF * g.lda * 2;
    const size_t tstep = 2 * hstep, tstepA = 2 * hstepA;
    const unsigned ldsw = (unsigned)wid * 1024u;
    const int aoff = lds_byte(wr * 64 + fr, fq * 8), boff = lds_byte(wc * 32 + fr, fq * 8);
#define PG8_SA(b, h) (((b) * 2 + (h)) * HTB)
#define PG8_SB(b, h) ((4 + (b) * 2 + (h)) * HTB)
#define PG8_STAGE(bufoff, gbase, voff) do { _Pragma("unroll") for (int _i = 0; _i < 2; ++_i) \
        __builtin_amdgcn_global_load_lds((const unsigned*)((const char*)(gbase) + (voff)[_i]), (PG8_LAS unsigned*)(lds + (bufoff) + ldsw + _i * 8192), 16, 0, 0); } while (0)
#define PG8_LDA(dst, b, h) do { _Pragma("unroll") for (int m = 0; m < 4; ++m) _Pragma("unroll") for (int k = 0; k < 2; ++k) dst[m][k] = *(const PG8_LAS bf16x8*)(lds + PG8_SA(b, h) + aoff + m * 2048 + k * 1024); } while (0)
#define PG8_LDB(dst, b, h) do { _Pragma("unroll") for (int n = 0; n < 2; ++n) _Pragma("unroll") for (int k = 0; k < 2; ++k) dst[n][k] = *(const PG8_LAS bf16x8*)(lds + PG8_SB(b, h) + boff + n * 2048 + k * 1024); } while (0)
#define PG8_MMA(ai, bj, At, Bt) do { __builtin_amdgcn_s_setprio(1); _Pragma("unroll") for (int m = 0; m < 4; ++m) _Pragma("unroll") for (int n = 0; n < 2; ++n) _Pragma("unroll") for (int k = 0; k < 2; ++k) \
        acc[ai][bj][m][n] = __builtin_amdgcn_mfma_f32_16x16x32_bf16(Bt[n][k], At[m][k], acc[ai][bj][m][n], 0, 0, 0); __builtin_amdgcn_s_setprio(0); } while (0)
#define PG8_WAIT_V(n) asm volatile("s_waitcnt vmcnt(" #n ")" ::: "memory")
#define PG8_WAIT_L(n) asm volatile("s_waitcnt lgkmcnt(" #n ")" ::: "memory")
#define PG8_BAR __builtin_amdgcn_s_barrier()
#define PG8_SCHED __builtin_amdgcn_sched_barrier(0)
    Unit cur, nxt; int ui = 0;
    if (!S.next(0, cur)) return;
    f32x4 acc[2][2][4][2];
#pragma unroll
    for (int a = 0; a < 2; ++a)
#pragma unroll
        for (int b = 0; b < 2; ++b)
#pragma unroll
            for (int m = 0; m < 4; ++m)
#pragma unroll
                for (int n = 0; n < 2; ++n) acc[a][b][m][n] = (f32x4){0.f, 0.f, 0.f, 0.f};
    bf16x8 At[4][2], B0[2][2], B1[2][2];
    const char* cA = (const char*)g.A + (size_t)cur.pm * tstepA; const char* cB = (const char*)g.Bt + (size_t)cur.pn * tstep;
    S.a_ready(cur);
    PG8_STAGE(PG8_SB(0, 0), cB, voffB); PG8_STAGE(PG8_SA(0, 0), cA, voffA); PG8_STAGE(PG8_SB(0, 1), cB + hstep, voffB); PG8_STAGE(PG8_SA(0, 1), cA + hstepA, voffA);
    if (wr == 1) PG8_BAR;
    PG8_WAIT_V(4); PG8_BAR;
    PG8_STAGE(PG8_SB(1, 0), cB + kstep, voffB); PG8_STAGE(PG8_SA(1, 0), cA + kstep, voffA); PG8_STAGE(PG8_SB(1, 1), cB + hstep + kstep, voffB);
    PG8_WAIT_V(6); PG8_BAR;
    PG8_STAMP();
    for (;;) {
        const bool has_next = S.next(ui + 1, nxt);
        const char* nA = has_next ? (const char*)g.A + (size_t)nxt.pm * tstepA : cA; const char* nB = has_next ? (const char*)g.Bt + (size_t)nxt.pn * tstep : cB;
        for (int t = 0; t < nt; t += 2) {
            const bool last = (t == nt - 2);
            const char* a1 = cA + (size_t)(t + 1) * kstep;
            const char* a2 = last ? nA : cA + (size_t)(t + 2) * kstep; const char* b2 = last ? nB : cB + (size_t)(t + 2) * kstep;
            const char* a3 = a2 + kstep; const char* b3 = b2 + kstep;
            if (last && has_next) S.a_ready(nxt);
            PG8_LDB(B0, 0, 0); PG8_SCHED; PG8_LDA(At, 0, 0); PG8_STAGE(PG8_SA(1, 1), a1 + hstepA, voffA);
            PG8_WAIT_L(8); PG8_BAR; PG8_WAIT_L(0); PG8_MMA(0, 0, At, B0); PG8_BAR; PG8_SCHED;
            PG8_LDB(B1, 0, 1); PG8_STAGE(PG8_SB(0, 0), b2, voffB);
            PG8_BAR; PG8_WAIT_L(0); PG8_MMA(0, 1, At, B1); PG8_BAR;
            PG8_LDA(At, 0, 1); PG8_STAGE(PG8_SA(0, 0), a2, voffA);
            PG8_BAR; PG8_WAIT_L(0); PG8_MMA(1, 0, At, B0); PG8_BAR; PG8_SCHED;
            PG8_STAGE(PG8_SB(0, 1), b2 + hstep, voffB);
            PG8_WAIT_V(6); PG8_BAR; PG8_MMA(1, 1, At, B1); PG8_BAR;
            PG8_LDB(B0, 1, 0); PG8_SCHED; PG8_LDA(At, 1, 0); PG8_STAGE(PG8_SA(0, 1), a2 + hstepA, voffA);
            PG8_WAIT_L(8); PG8_BAR; PG8_WAIT_L(0); PG8_MMA(0, 0, At, B0); PG8_BAR; PG8_SCHED;
            PG8_LDB(B1, 1, 1); PG8_STAGE(PG8_SB(1, 0), b3, voffB);
            PG8_BAR; PG8_WAIT_L(0); PG8_MMA(0, 1, At, B1); PG8_BAR;
            PG8_LDA(At, 1, 1); PG8_STAGE(PG8_SA(1, 0), a3, voffA);
            PG8_BAR; PG8_WAIT_L(0); PG8_MMA(1, 0, At, B0); PG8_BAR; PG8_SCHED;
            PG8_STAGE(PG8_SB(1, 1), b3 + hstep, voffB);
            PG8_WAIT_V(6); PG8_BAR; PG8_MMA(1, 1, At, B1); PG8_BAR;
        }
        PG8_STAMP();
        if constexpr (!Epi::AFTER_DRAIN) { E(acc, cur, wr, wc, fr, fq); S.done(cur); }
        PG8_STAMP();
        if (!has_next) break;
#pragma unroll
        for (int a = 0; a < 2; ++a)
#pragma unroll
            for (int b = 0; b < 2; ++b)
#pragma unroll
                for (int m = 0; m < 4; ++m)
#pragma unroll
                    for (int n = 0; n < 2; ++n) acc[a][b][m][n] = (f32x4){0.f, 0.f, 0.f, 0.f};
        cur = nxt; cA = nA; cB = nB; ++ui;
    }
    PG8_WAIT_V(0);
    if (wr == 0) PG8_BAR;
    PG8_BAR;
    if constexpr (Epi::AFTER_DRAIN) { E.fused(acc, cur, wr, wc, fr, fq, lds, wid, lane); S.done(cur); }
    PG8_STAMP();
    if (STAMP && wid == 0) { stamps[lane] = lane < nts ? (((unsigned long long)(unsigned)ts_hi << 32) | (unsigned)ts_lo) : 0ull;
        if (lane == 62) stamps[62] = rt_entry; if (lane == 63) stamps[63] = (unsigned long long)wall_clock64(); }
#undef PG8_STAMP
#undef PG8_SA
#undef PG8_SB
#undef PG8_STAGE
#undef PG8_LDA
#undef PG8_LDB
#undef PG8_MMA
#undef PG8_WAIT_V
#undef PG8_WAIT_L
#undef PG8_BAR
#undef PG8_SCHED
#undef voffB
}
}

struct EpiPlain {
    static constexpr bool PERM = false, AFTER_DRAIN = false;
    bf16_t* C; int ldc;
    __device__ __forceinline__ void operator()(const f32x4 (&acc)[2][2][4][2], const pg8::Unit& u, int, int, int, int) const {
        const int t_ = tidx(), wr = t_ >> 8, wc = (t_ >> 6) & 3, fr = t_ & 15, fq = (t_ >> 4) & 3;
#pragma unroll
        for (int ai = 0; ai < 2; ++ai)
#pragma unroll
            for (int m = 0; m < 4; ++m) { bf16_t* rowp = C + (size_t)(u.pm * 256 + ai * 128 + wr * 64 + m * 16 + fr) * ldc + u.pn * 256 + wc * 32 + 8 * fq;
#pragma unroll
                for (int bj = 0; bj < 2; ++bj) { const f32x4 v0 = acc[ai][bj][m][0], v1 = acc[ai][bj][m][1]; u32x4 w; w.x = cvt_pk(v0[0], v0[1]); w.y = cvt_pk(v0[2], v0[3]); w.z = cvt_pk(v1[0], v1[1]); w.w = cvt_pk(v1[2], v1[3]);
                    *(u32x4*)(rowp + bj * 128) = w; } }
    }
};
struct EpiF1 {
    static constexpr bool PERM = false, AFTER_DRAIN = false;
    const float* cw; const float* cb; bf16_t* act; bf16_t* E;
    __device__ __forceinline__ void operator()(const f32x4 (&acc)[2][2][4][2], const pg8::Unit& u, int, int, int, int) const {
        const int t_ = tidx(), wr = t_ >> 8, wc = (t_ >> 6) & 3, fr = t_ & 15, fq = (t_ >> 4) & 3;
        const int ch = u.pn * 128 + wc * 32 + 8 * fq;
#pragma unroll
        for (int ai = 0; ai < 2; ++ai) {
            const int strip = u.pm * 4 + ai * 2 + wr; const size_t rowbase = (size_t)u.pm * 256 + ai * 128 + wr * 64;
#pragma unroll
            for (int m = 0; m < 4; ++m) {
                const int rs = m * 16 + fr; f32x4 a[2];
#pragma unroll
                for (int n = 0; n < 2; ++n) {
                    const f32x4 c0 = *(const f32x4*)(cw + ch + 4 * n), c1 = *(const f32x4*)(cw + DFF + ch + 4 * n), c2 = *(const f32x4*)(cw + 2 * DFF + ch + 4 * n), cbv = *(const f32x4*)(cb + ch + 4 * n);
                    const f32x4 g0 = acc[ai][0][m][n], up = acc[ai][1][m][n]; f32x4 g1, g2;
#pragma unroll
                    for (int j = 0; j < 4; ++j) {
                        const float a1 = DPP_MOV(g0[j], 0x121), a2 = DPP_MOV(g0[j], 0x122);
                        float b1 = 0.f, b2 = 0.f;
                        if (m > 0) { b1 = DPP_MOV(acc[ai][0][m > 0 ? m - 1 : 0][n][j], 0x121); b2 = DPP_MOV(acc[ai][0][m > 0 ? m - 1 : 0][n][j], 0x122); }
                        g1[j] = fr >= 1 ? a1 : b1; g2[j] = fr >= 2 ? a2 : b2;
                    }
                    const f32x4 val = c2 * g0 + c1 * g1 + c0 * g2 + cbv;
#pragma unroll
                    for (int j = 0; j < 4; ++j) a[n][j] = val[j] * rcpf_(1.0f + __expf(-val[j])) * up[j];
                }
                const f32x4 gA = acc[ai][0][m][0], gB = acc[ai][0][m][1], uA = acc[ai][1][m][0], uB = acc[ai][1][m][1];
                u32x4 w;
                if (rs >= 2) { w.x = cvt_pk(a[0][0], a[0][1]); w.y = cvt_pk(a[0][2], a[0][3]); w.z = cvt_pk(a[1][0], a[1][1]); w.w = cvt_pk(a[1][2], a[1][3]); *(u32x4*)(act + (rowbase + rs) * DFF + ch) = w; }
                else { w.x = cvt_pk(gA[0], gA[1]); w.y = cvt_pk(gA[2], gA[3]); w.z = cvt_pk(gB[0], gB[1]); w.w = cvt_pk(gB[2], gB[3]); *(u32x4*)(E + ((size_t)strip * 6 + 2 + rs) * DFF + ch) = w;
                       w.x = cvt_pk(uA[0], uA[1]); w.y = cvt_pk(uA[2], uA[3]); w.z = cvt_pk(uB[0], uB[1]); w.w = cvt_pk(uB[2], uB[3]); *(u32x4*)(E + ((size_t)strip * 6 + 4 + rs) * DFF + ch) = w; }
                if (rs >= 62) { w.x = cvt_pk(gA[0], gA[1]); w.y = cvt_pk(gA[2], gA[3]); w.z = cvt_pk(gB[0], gB[1]); w.w = cvt_pk(gB[2], gB[3]); *(u32x4*)(E + ((size_t)strip * 6 + (rs - 62)) * DFF + ch) = w; }
            }
        }
    }
};
struct EpiScale {
    static constexpr bool PERM = false, AFTER_DRAIN = false;
    bf16_t* C; int ldc; float scale;
    __device__ __forceinline__ void operator()(const f32x4 (&acc)[2][2][4][2], const pg8::Unit& u, int, int, int, int) const {
        const int t_ = tidx(), wr = t_ >> 8, wc = (t_ >> 6) & 3, fr = t_ & 15, fq = (t_ >> 4) & 3;
#pragma unroll
        for (int ai = 0; ai < 2; ++ai)
#pragma unroll
            for (int m = 0; m < 4; ++m) { bf16_t* rowp = C + (size_t)(u.pm * 256 + ai * 128 + wr * 64 + m * 16 + fr) * ldc + u.pn * 256 + wc * 32 + 4 * fq;
#pragma unroll
                for (int bj = 0; bj < 2; ++bj)
#pragma unroll
                    for (int n = 0; n < 2; ++n) st_bf4(rowp + bj * 128 + n * 16, acc[ai][bj][m][n] * scale); }
    }
};
struct EpiN1kv {
    static constexpr bool PERM = false, AFTER_DRAIN = false;
    bf16_t* kv;
    __device__ __forceinline__ void operator()(const f32x4 (&acc)[2][2][4][2], const pg8::Unit& u, int, int, int, int) const {
        const int t_ = tidx(), wr = t_ >> 8, wc = (t_ >> 6) & 3, fr = t_ & 15, fq = (t_ >> 4) & 3;
        char* base = (char*)kv;
#pragma unroll
        for (int ai = 0; ai < 2; ++ai)
#pragma unroll
            for (int m = 0; m < 4; ++m) {
                const size_t row = (size_t)u.pm * 256 + ai * 128 + wr * 64 + m * 16 + fr;
#pragma unroll
                for (int bj = 0; bj < 2; ++bj)
#pragma unroll
                    for (int n = 0; n < 2; ++n) {
                        const int c128 = wc * 32 + n * 16 + fq * 4; const f32x4 v = acc[ai][bj][m][n];
                        if (u.pn < 3) {
                            const int cc = u.pn * 2 + bj;
                            if (cc == 0 || cc == 1 || cc == 4) { const size_t off = cc == 0 ? 0 : cc == 1 ? 8 * MiB : 24 * MiB; st_bf4((bf16_t*)(base + off) + row * 128 + c128, v); }
                            else if (cc == 2) { const int b = (int)(row >> 13), t = (int)(row & (SEQ - 1));
                                *(unsigned*)((unsigned char*)(base + 16 * MiB) + ((size_t)((b * 2 + (c128 >> 6)) * SEQ + t)) * 64 + (c128 & 63)) = pack_fp8x4(v[0], v[1], v[2], v[3]); }
                            else if (cc == 3) { const int b = (int)(row >> 13), t = (int)(row & (SEQ - 1));
                                unsigned char* dst = (unsigned char*)(base + 32 * MiB) + ((size_t)((b * 2 + (c128 >> 6)) * 128 + (t >> 6)) * 64 + (c128 & 63)) * 64 + (t & 63);
                                const unsigned pk = pack_fp8x4(v[0], v[1], v[2], v[3]);
                                for (int j = 0; j < 4; ++j) dst[j * 64] = (unsigned char)(pk >> (8 * j)); }
                            else { bf16_t* dst = (bf16_t*)(base + 40 * MiB); const int b = (int)(row >> 13), t = (int)(row & (SEQ - 1));
                                for (int j = 0; j < 4; ++j) dst[((size_t)(b * 128 + c128 + j)) * SEQ + t] = f2bf(v[j]); }
                        } else { if (bj == 0 && c128 < 48) { float* gates = (float*)(base + 48 * MiB); for (int j = 0; j < 4; ++j) gates[row * 48 + c128 + j] = sigmoidf_(v[j]); } }
                    }
            }
    }
};
struct EpiL1 {
    static constexpr bool PERM = false, AFTER_DRAIN = false;
    bf16_t *qe, *ke, *vT, *r; float* adn;
    __device__ __forceinline__ void operator()(const f32x4 (&acc)[2][2][4][2], const pg8::Unit& u, int, int, int, int) const {
        const int t_ = tidx(), wr = t_ >> 8, wc = (t_ >> 6) & 3, fr = t_ & 15, fq = (t_ >> 4) & 3;
#pragma unroll
        for (int ai = 0; ai < 2; ++ai)
#pragma unroll
            for (int m = 0; m < 4; ++m) {
                const size_t row = (size_t)u.pm * 256 + ai * 128 + wr * 64 + m * 16 + fr;
#pragma unroll
                for (int bj = 0; bj < 2; ++bj)
#pragma unroll
                    for (int n = 0; n < 2; ++n) {
                        const int c = bj * 128 + wc * 32 + n * 16 + fq * 4; const f32x4 v = acc[ai][bj][m][n];
                        if (u.pn < 2) st_bf4(qe + row * 512 + u.pn * 256 + c, v * 0.08838834764831845f);
                        else if (u.pn < 4) st_bf4(ke + row * 512 + (u.pn - 2) * 256 + c, v);
                        else if (u.pn < 8) { const int b = (int)(row >> 13), t = (int)(row & (SEQ - 1)), vc = (u.pn - 4) * 256 + c;
                            for (int j = 0; j < 4; ++j) vT[((size_t)(b * 1024 + vc + j)) * SEQ + t] = f2bf(v[j]); }
                        else if (u.pn < 12) st_bf4(r + row * DM + (u.pn - 8) * 256 + c, v);
                        else { if (c < 16) *(f32x4*)(adn + row * 16 + c) = v; }
                    }
            }
    }
};
template <class Epi>
DEV void phase_gemm_pg8(const bf16_t* A, int lda, const bf16_t* Bt, int N, int K, const Epi& E, char* smem) {
    pg8::Gemm g; g.A = A; g.Bt = Bt; g.M = T; g.N = N; g.K = K; g.lda = lda;
    pg8::StaticOrder S; S.init(T, N, (int)gridDim.x, (int)blockIdx.x);
    pg8::gemm_phase<Epi, pg8::StaticOrder, false>((PG8_LAS unsigned char*)smem, g, S, E, nullptr);
}
struct LaneId { int lane, wid, wm, wn, fr, fq; };
DEV LaneId lane_id() { LaneId l; l.lane = tidx() & 63; l.wid = tidx() >> 6; l.wm = l.wid >> 1; l.wn = l.wid & 1; l.fr = l.lane & 15; l.fq = l.lane >> 4; return l; }

template <class Map>
DEV void prep_T(bf16_t* dst, const float* src, int Ks, int Ns, int Nd, int Kd, Map map, char* smem, int& cursor) {
    float* tile = (float*)smem;
    const int ntn = Nd >> 6, ntiles = ntn * (Kd >> 6), tid = tidx(), G = (int)gridDim.x;
    int first = ((int)blockIdx.x - cursor) % G; if (first < 0) first += G;
    for (int tl = first; tl < ntiles; tl += G) {
        const int n0 = (tl % ntn) * 64, k0 = (tl / ntn) * 64;
        { const int j4 = (tid & 15) * 4, kr = tid >> 4;
          const int m0 = map(n0 + j4), m3 = map(n0 + j4 + 3);
          const bool vec = (m0 >= 0) && (m3 == m0 + 3) && ((Ns & 3) == 0) && ((m0 & 3) == 0);
#pragma unroll
          for (int p = 0; p < 2; ++p) { const int kk = kr + 32 * p, k = k0 + kk; f32x4 v = {0.f, 0.f, 0.f, 0.f};
              if (k < Ks) { if (vec) v = *(const f32x4*)(src + (size_t)k * Ns + m0);
                            else { for (int q = 0; q < 4; ++q) { const int n = map(n0 + j4 + q); v[q] = n >= 0 ? src[(size_t)k * Ns + n] : 0.f; } } }
              tile[kk * 65 + j4] = v[0]; tile[kk * 65 + j4 + 1] = v[1]; tile[kk * 65 + j4 + 2] = v[2]; tile[kk * 65 + j4 + 3] = v[3]; } }
        __syncthreads();
        { const int r = tid >> 3, c8 = (tid & 7) * 8;
          u32x4 w; w.x = cvt_pk(tile[(c8 + 0) * 65 + r], tile[(c8 + 1) * 65 + r]); w.y = cvt_pk(tile[(c8 + 2) * 65 + r], tile[(c8 + 3) * 65 + r]);
          w.z = cvt_pk(tile[(c8 + 4) * 65 + r], tile[(c8 + 5) * 65 + r]); w.w = cvt_pk(tile[(c8 + 6) * 65 + r], tile[(c8 + 7) * 65 + r]);
          *(u32x4*)(dst + (size_t)(n0 + r) * Kd + k0 + c8) = w; }
        __syncthreads();
    }
    cursor += ntiles;
}
struct MapId { int ns; DEV int operator()(int n) const { return n < ns ? n : -1; } };
struct MapPerm { int ns; DEV int operator()(int n) const { return n < ns ? (n & ~31) + pg8::perm32(n & 31) : -1; } };
struct MapFfn { DEV int operator()(int v) const { const int pn = v >> 8, c = v & 255, cc = (c & 96) + pg8::perm32(c & 31); return c < 128 ? 128 * pn + cc : DFF + 128 * pn + cc; } };

DEV void phase_prep(const Params& P, int layer, char* smem) {
    char* ws = P.ws; int cur = 0;
    const int kind = layer % 3, j = layer / 3;
    prep_T((bf16_t*)(ws + OFF_WF1), P.in[I_FWIN] + (size_t)layer * DM * 2 * DFF, DM, 2 * DFF, 2 * DFF, DM, MapFfn{}, smem, cur);
    prep_T((bf16_t*)(ws + OFF_WF2), P.in[I_FWOUT] + (size_t)layer * DFF * DM, DFF, DM, DM, DFF, MapPerm{DM}, smem, cur);
    bf16_t* mix = (bf16_t*)(ws + OFF_MIX);
    if (kind == 0) {
        const float* wrkv = P.in[I_WRKV] + (size_t)j * 3 * DM * DM;
        prep_T(mix, wrkv, DM, DM, DM, DM, MapId{DM}, smem, cur);
        prep_T(mix + (size_t)1024 * DM, wrkv + (size_t)DM * DM, DM, DM, DM, DM, MapId{DM}, smem, cur);
        prep_T(mix + (size_t)2048 * DM, P.in[I_W1] + (size_t)j * DM * 64, DM, 64, 128, DM, MapId{64}, smem, cur);
        prep_T(mix + (size_t)2176 * DM, P.in[I_A1] + (size_t)j * DM * 64, DM, 64, 128, DM, MapId{64}, smem, cur);
        prep_T(mix + (size_t)2304 * DM, P.in[I_G1] + (size_t)j * DM * 128, DM, 128, 128, DM, MapId{128}, smem, cur);
        if (j > 0) prep_T(mix + (size_t)2432 * DM, P.in[I_V1] + (size_t)(j - 1) * DM * 32, DM, 32, 128, DM, MapId{32}, smem, cur);
        else       prep_T(mix + (size_t)2432 * DM, P.in[I_V1], DM, 32, 128, DM, MapId{0}, smem, cur);
        prep_T((bf16_t*)((char*)mix + 5 * MiB), wrkv + (size_t)2 * DM * DM, DM, DM, DM, DM, MapId{DM}, smem, cur);
        prep_T((bf16_t*)((char*)mix + 7 * MiB), P.in[I_W2] + (size_t)j * 64 * DM, 64, DM, DM, 64, MapId{DM}, smem, cur);
        prep_T((bf16_t*)((char*)mix + 7 * MiB + 131072), P.in[I_A2] + (size_t)j * 64 * DM, 64, DM, DM, 64, MapId{DM}, smem, cur);
        if (j > 0) prep_T((bf16_t*)((char*)mix + 7 * MiB + 262144), P.in[I_V2] + (size_t)(j - 1) * 32 * DM, 32, DM, DM, 64, MapId{DM}, smem, cur);
        prep_T((bf16_t*)((char*)mix + 7 * MiB + 393216), P.in[I_G2] + (size_t)j * 128 * DM, 128, DM, DM, 128, MapId{DM}, smem, cur);
        prep_T((bf16_t*)((char*)mix + 8 * MiB), P.in[I_RWO] + (size_t)j * DM * DM, DM, DM, DM, DM, MapPerm{DM}, smem, cur);
    } else if (kind == 1) {
        prep_T(mix, P.in[I_NWIN], DM, 1840, 2048, DM, MapId{1840}, smem, cur);
        prep_T((bf16_t*)((char*)mix + 4 * MiB), P.in[I_CW1], 2048, 256, 256, 2048, MapId{256}, smem, cur);
        prep_T((bf16_t*)((char*)mix + 4 * MiB) + (size_t)256 * 2048, P.in[I_CW1] + (size_t)2048 * 256, 2048, 256, 256, 2048, MapId{256}, smem, cur);
        prep_T((bf16_t*)((char*)mix + 6 * MiB), P.in[I_CW2], 256, 64, 128, 256, MapId{64}, smem, cur);
        prep_T((bf16_t*)((char*)mix + 6 * MiB) + (size_t)128 * 256, P.in[I_CW2] + (size_t)256 * 64, 256, 64, 128, 256, MapId{64}, smem, cur);
        prep_T((bf16_t*)((char*)mix + 7 * MiB), P.in[I_NWO], DM, DM, DM, DM, MapPerm{DM}, smem, cur);
        { const int lane = tidx() & 63, gw = blockIdx.x * (NTHR / 64) + (tidx() >> 6);
          if (gw < 512) { const int c = gw >> 8, col = gw & 255; const float* w1 = P.in[I_CW1] + (size_t)c * 2048 * 256; const float* pe = P.in[I_CPE] + (size_t)c * 2048;
              float sacc = 0.f; for (int k = lane; k < 2048; k += 64) sacc += pe[k] * w1[(size_t)k * 256 + col];
              sacc = wave_sum(sacc); if (lane == 0) ((float*)(ws + OFF_BIASP))[gw] = sacc + P.in[I_CB1][c * 256 + col]; } }
    } else {
        prep_T(mix, P.in[I_GWIN], DM, 3088, 3328, DM, MapId{3088}, smem, cur);
        prep_T((bf16_t*)((char*)mix + 7 * MiB), P.in[I_GWO], DM, DM, DM, DM, MapPerm{DM}, smem, cur);
    }
}

template <int HIN, int HOUT>
DEV void phase_norm(const void* h_in, const bf16_t* z, const float* g_post, void* h_out, float* stage, const float* g_pre, bf16_t* xn) {
    const int lane = tidx() & 63, gw = blockIdx.x * (NTHR / 64) + (tidx() >> 6), nw = gridDim.x * (NTHR / 64);
    for (int row = gw; row < T; row += nw) {
        f32x4 hv[4];
#pragma unroll
        for (int i = 0; i < 4; ++i) { const size_t off = (size_t)row * DM + i * 256 + lane * 4;
            if (HIN == 0) hv[i] = *(const f32x4*)((const float*)h_in + off); else hv[i] = ld_bf4((const bf16_t*)h_in + off); }
        if (z) {
            f32x4 zv[4]; float ss = 0.f;
#pragma unroll
            for (int i = 0; i < 4; ++i) { zv[i] = ld_bf4(z + (size_t)row * DM + i * 256 + lane * 4); ss += zv[i][0] * zv[i][0] + zv[i][1] * zv[i][1] + zv[i][2] * zv[i][2] + zv[i][3] * zv[i][3]; }
            ss = wave_sum(ss); const float rs = rsqrtf(ss * (1.0f / DM) + 1e-6f);
#pragma unroll
            for (int i = 0; i < 4; ++i) { const f32x4 g = *(const f32x4*)(g_post + i * 256 + lane * 4); hv[i] += zv[i] * rs * g; }
        }
        if (HOUT == 1) {
#pragma unroll
            for (int i = 0; i < 4; ++i) st_bf4((bf16_t*)h_out + (size_t)row * DM + i * 256 + lane * 4, hv[i]);
        }
        if (HOUT == 2) {
            float* dst = row < T / 2 ? (float*)h_out + (size_t)row * DM : stage + (size_t)(row - T / 2) * DM;
#pragma unroll
            for (int i = 0; i < 4; ++i) *(f32x4*)(dst + i * 256 + lane * 4) = hv[i];
        }
        if (xn) {
            float ss = 0.f;
#pragma unroll
            for (int i = 0; i < 4; ++i) ss += hv[i][0] * hv[i][0] + hv[i][1] * hv[i][1] + hv[i][2] * hv[i][2] + hv[i][3] * hv[i][3];
            ss = wave_sum(ss); const float rs = rsqrtf(ss * (1.0f / DM) + 1e-6f);
#pragma unroll
            for (int i = 0; i < 4; ++i) { const f32x4 g = *(const f32x4*)(g_pre + i * 256 + lane * 4); st_bf4(xn + (size_t)row * DM + i * 256 + lane * 4, hv[i] * rs * g); }
        }
    }
}
DEV void phase_copy_out(const float* stage, float* out) {
    const size_t gt = (size_t)blockIdx.x * NTHR + tidx(), nt = (size_t)gridDim.x * NTHR;
    for (size_t i = gt; i < (size_t)(T / 2) * DM / 4; i += nt) ((f32x4*)(out + (size_t)(T / 2) * DM))[i] = ((const f32x4*)stage)[i];
}

DEV void phase_gemm_plain(const bf16_t* A, int lda, const bf16_t* Bt, int K, int ntn, bf16_t* C, int ldc, char* smem) {
    const LaneId L = lane_id();
    const int nunits = (T / 256) * ntn;
    for (int u = blockIdx.x; u < nunits; u += gridDim.x) {
        const int tm = u / ntn, tn = u % ntn;
        f32x4 acc[4][4];
        gemm_core(acc, LdPlain{A + (size_t)tm * 256 * lda, lda}, LdPlain{Bt + (size_t)tn * 128 * K, K}, K, smem);
#pragma unroll
        for (int m = 0; m < 4; ++m)
#pragma unroll
            for (int n = 0; n < 4; ++n)
                st_bf4(C + (size_t)(tm * 256 + L.wm * 64 + m * 16 + L.fr) * ldc + tn * 128 + L.wn * 64 + n * 16 + L.fq * 4, acc[m][n]);
    }
}

DEV void phase_f1(const bf16_t* xn, const bf16_t* Bt, const float* cw, const float* cb, bf16_t* act, bf16_t* E, char* smem) {
    const LaneId L = lane_id();
    const int ntn = 2 * DFF / 128, nunits = (T / 256) * ntn;
    for (int u = blockIdx.x; u < nunits; u += gridDim.x) {
        const int tm = u / ntn, tn = u % ntn;
        f32x4 acc[4][4];
        gemm_core(acc, LdPlain{xn + (size_t)tm * 256 * DM, DM}, LdPlain{Bt + (size_t)tn * 128 * DM, DM}, DM, smem);
        const int strip = tm * 4 + L.wm; const size_t rowbase = (size_t)tm * 256 + L.wm * 64;
#pragma unroll
        for (int n = 0; n < 2; ++n) {
            const int ch = tn * 64 + L.wn * 32 + n * 16 + L.fq * 4;
            const f32x4 c0 = *(const f32x4*)(cw + ch), c1 = *(const f32x4*)(cw + DFF + ch), c2 = *(const f32x4*)(cw + 2 * DFF + ch), cbv = *(const f32x4*)(cb + ch);
#pragma unroll
            for (int m = 0; m < 4; ++m) {
                const f32x4 g0 = acc[m][n], up = acc[m][n + 2]; f32x4 g1, g2;
#pragma unroll
                for (int j = 0; j < 4; ++j) {
                    const float a1 = __shfl(g0[j], (L.lane - 1) & 63), a2 = __shfl(g0[j], (L.lane - 2) & 63);
                    float b1 = 0.f, b2 = 0.f;
                    if (m > 0) { b1 = __shfl(acc[m > 0 ? m - 1 : 0][n][j], (L.lane + 15) & 63); b2 = __shfl(acc[m > 0 ? m - 1 : 0][n][j], (L.lane + 14) & 63); }
                    g1[j] = L.fr >= 1 ? a1 : b1; g2[j] = L.fr >= 2 ? a2 : b2;
                }
                const int rs = m * 16 + L.fr;
                f32x4 val = c2 * g0 + c1 * g1 + c0 * g2 + cbv, a;
#pragma unroll
                for (int j = 0; j < 4; ++j) a[j] = val[j] * rcpf_(1.0f + __expf(-val[j])) * up[j];
                if (rs >= 2) st_bf4(act + (rowbase + rs) * DFF + ch, a);
                else { st_bf4(E + ((size_t)strip * 6 + 2 + rs) * DFF + ch, g0); st_bf4(E + ((size_t)strip * 6 + 4 + rs) * DFF + ch, up); }
                if (rs >= 62) st_bf4(E + ((size_t)strip * 6 + (rs - 62)) * DFF + ch, g0);
            }
        }
    }
}
DEV void phase_f1b(const float* cw, const float* cb, bf16_t* act, const bf16_t* E) {
    const int gt = blockIdx.x * NTHR + tidx(), nt = gridDim.x * NTHR;
    for (int idx = gt; idx < 512 * 2 * (DFF / 4); idx += nt) {
        const int ch = (idx % (DFF / 4)) * 4, r = (idx / (DFF / 4)) & 1, strip = idx / (2 * (DFF / 4));
        const bool first = (strip & 127) == 0;
        const f32x4 zero = {0.f, 0.f, 0.f, 0.f};
        const f32x4 g0 = ld_bf4(E + ((size_t)strip * 6 + 2 + r) * DFF + ch), up = ld_bf4(E + ((size_t)strip * 6 + 4 + r) * DFF + ch);
        f32x4 g1, g2;
        if (r == 1) { g1 = ld_bf4(E + ((size_t)strip * 6 + 2) * DFF + ch); g2 = first ? zero : ld_bf4(E + ((size_t)(strip - 1) * 6 + 1) * DFF + ch); }
        else { g1 = first ? zero : ld_bf4(E + ((size_t)(strip - 1) * 6 + 1) * DFF + ch); g2 = first ? zero : ld_bf4(E + ((size_t)(strip - 1) * 6 + 0) * DFF + ch); }
        const f32x4 c0 = *(const f32x4*)(cw + ch), c1 = *(const f32x4*)(cw + DFF + ch), c2 = *(const f32x4*)(cw + 2 * DFF + ch), cbv = *(const f32x4*)(cb + ch);
        f32x4 val = c2 * g0 + c1 * g1 + c0 * g2 + cbv, a;
#pragma unroll
        for (int j = 0; j < 4; ++j) a[j] = val[j] * rcpf_(1.0f + __expf(-val[j])) * up[j];
        st_bf4(act + ((size_t)strip * 64 + r) * DFF + ch, a);
    }
}

struct RwkvW { const float *mu, *w0, *a0, *k_k, *k_a, *r_k, *ln_w, *ln_b, *v0; bool vres; };
DEV void phase_r1(const bf16_t* xn, const bf16_t* Bt, const RwkvW& W, bf16_t* rb, bf16_t* kb, bf16_t* hid, char* smem) {
    const LaneId L = lane_id();
    const int ntn = 20, nunits = (T / 256) * ntn;
    for (int u = blockIdx.x; u < nunits; u += gridDim.x) {
        const int tm = u / ntn, tn = u % ntn;
        const int var = tn < 8 ? 0 : tn < 16 ? 2 : tn == 16 ? 1 : tn == 17 ? 4 : tn == 18 ? 5 : 3;
        f32x4 acc[4][4];
        gemm_core(acc, LdMix{xn, W.mu + var * DM, tm * 256, {0.f, 0.f, 0.f, 0.f}, {0.f, 0.f, 0.f, 0.f}}, LdPlain{Bt + (size_t)tn * 128 * DM, DM}, DM, smem);
#pragma unroll
        for (int m = 0; m < 4; ++m)
#pragma unroll
            for (int n = 0; n < 4; ++n) {
                const size_t row = (size_t)tm * 256 + L.wm * 64 + m * 16 + L.fr; const int c = L.wn * 64 + n * 16 + L.fq * 4; f32x4 v = acc[m][n];
                if (tn < 8) st_bf4(rb + row * DM + tn * 128 + c, v);
                else if (tn < 16) st_bf4(kb + row * DM + (tn - 8) * 128 + c, v);
                else if (tn == 16) { if (L.wn == 0) { for (int j = 0; j < 4; ++j) v[j] = tanhf(v[j]); st_bf4(hid + row * HIDP + c, v); } }
                else if (tn == 17) { if (L.wn == 0) st_bf4(hid + row * HIDP + 64 + c, v); }
                else if (tn == 18) { for (int j = 0; j < 4; ++j) v[j] = sigmoidf_(v[j]); st_bf4(hid + row * HIDP + 128 + c, v); }
                else { if (L.wn == 0) st_bf4(hid + row * HIDP + 256 + c, v); }
            }
    }
}
DEV void phase_r2(const bf16_t* xn, const bf16_t* mixw, const RwkvW& W, const bf16_t* hid, const bf16_t* rb, float* bsc, bf16_t* wb, bf16_t* kb, bf16_t* kkb, bf16_t* kab, bf16_t* vb, char* smem) {
    const LaneId L = lane_id();
    const bf16_t* Bv = (const bf16_t*)((const char*)mixw + 5 * MiB);
    const bf16_t* W2T = (const bf16_t*)((const char*)mixw + 7 * MiB);
    const bf16_t* A2T = (const bf16_t*)((const char*)mixw + 7 * MiB + 131072);
    const bf16_t* V2T = (const bf16_t*)((const char*)mixw + 7 * MiB + 262144);
    const int nunits = 1024 + 2048;
    for (int u = blockIdx.x; u < nunits; u += gridDim.x) {
        if (u < 1024) {
            const int tm = u >> 3, tn = u & 7;
            f32x4 acc[4][4]; u32x2 gpk[4][4];
            if (W.vres) {
                gemm_core(acc, LdPlain{hid + (size_t)tm * 256 * HIDP + 256, HIDP}, LdPlain{V2T + (size_t)tn * 128 * 64, 64}, 64, smem);
#pragma unroll
                for (int m = 0; m < 4; ++m)
#pragma unroll
                    for (int n = 0; n < 4; ++n) { const int col = tn * 128 + L.wn * 64 + n * 16 + L.fq * 4; const f32x4 b = *(const f32x4*)(W.v0 + col);
                        gpk[m][n].x = cvt_pk(sigmoidf_(b[0] + acc[m][n][0]), sigmoidf_(b[1] + acc[m][n][1]));
                        gpk[m][n].y = cvt_pk(sigmoidf_(b[2] + acc[m][n][2]), sigmoidf_(b[3] + acc[m][n][3])); }
            }
            gemm_core(acc, LdMix{xn, W.mu + 3 * DM, tm * 256, {0.f, 0.f, 0.f, 0.f}, {0.f, 0.f, 0.f, 0.f}}, LdPlain{Bv + (size_t)tn * 128 * DM, DM}, DM, smem);
#pragma unroll
            for (int m = 0; m < 4; ++m)
#pragma unroll
                for (int n = 0; n < 4; ++n) {
                    const size_t row = (size_t)tm * 256 + L.wm * 64 + m * 16 + L.fr; const int col = tn * 128 + L.wn * 64 + n * 16 + L.fq * 4; f32x4 v = acc[m][n];
                    if (W.vres) { const f32x4 vf = ld_bf4(vb + row * DM + col); f32x4 gt; gt[0] = bf_lo(gpk[m][n].x); gt[1] = bf_hi(gpk[m][n].x); gt[2] = bf_lo(gpk[m][n].y); gt[3] = bf_hi(gpk[m][n].y); v = v + (vf - v) * gt; }
                    st_bf4(vb + row * DM + col, v);
                }
        } else {
            const int u2 = u - 1024, tm = u2 >> 4, jj = u2 & 15;
            f32x4 acc[4][4];
            if (jj < 8) {
                const int tn = jj;
                gemm_core(acc, LdPlain{hid + (size_t)tm * 256 * HIDP, HIDP}, LdPlain{W2T + (size_t)tn * 128 * 64, 64}, 64, smem);
#pragma unroll
                for (int m = 0; m < 4; ++m)
#pragma unroll
                    for (int n = 0; n < 4; ++n) {
                        const size_t row = (size_t)tm * 256 + L.wm * 64 + m * 16 + L.fr; const int col = tn * 128 + L.wn * 64 + n * 16 + L.fq * 4; const f32x4 b = *(const f32x4*)(W.w0 + col); f32x4 v;
                        for (int j = 0; j < 4; ++j) { const float x = b[j] + acc[m][n][j]; const float y = -x;
                            const float sp = fmaxf(y, 0.f) + log1pf(__expf(-fabsf(y))); const float w = -sp - 0.5f; v[j] = __expf(-__expf(w)); }
                        st_bf4(wb + row * DM + col, v);
                    }
            } else {
                const int tn = jj - 8;
                gemm_core(acc, LdPlain{hid + (size_t)tm * 256 * HIDP + 64, HIDP}, LdPlain{A2T + (size_t)tn * 128 * 64, 64}, 64, smem);
#pragma unroll
                for (int m = 0; m < 4; ++m) {
                    const size_t row = (size_t)tm * 256 + L.wm * 64 + m * 16 + L.fr;
                    u32x2 kpk[4]; float ss = 0.f;
#pragma unroll
                    for (int n = 0; n < 4; ++n) { const int col = tn * 128 + L.wn * 64 + n * 16 + L.fq * 4;
                        kpk[n] = *(const u32x2*)(kb + row * DM + col); const f32x4 kkw = *(const f32x4*)(W.k_k + col);
                        const float c0 = bf_lo(kpk[n].x) * kkw[0], c1 = bf_hi(kpk[n].x) * kkw[1], c2 = bf_lo(kpk[n].y) * kkw[2], c3 = bf_hi(kpk[n].y) * kkw[3];
                        ss += (c0 * c0 + c1 * c1) + (c2 * c2 + c3 * c3); }
                    ss += __shfl_xor(ss, 16); ss += __shfl_xor(ss, 32);
                    const float inv = rcpf_(fmaxf(sqrtf(ss), 1e-12f));
                    asm volatile("" ::: "memory");
                    float bon = 0.f;
#pragma unroll
                    for (int n = 0; n < 4; ++n) { const int col = tn * 128 + L.wn * 64 + n * 16 + L.fq * 4;
                        const f32x4 ka = *(const f32x4*)(W.k_a + col), kkw = *(const f32x4*)(W.k_k + col), a0 = *(const f32x4*)(W.a0 + col), rkv = *(const f32x4*)(W.r_k + col), rv = ld_bf4(rb + row * DM + col);
                        f32x4 kv; kv[0] = bf_lo(kpk[n].x); kv[1] = bf_hi(kpk[n].x); kv[2] = bf_lo(kpk[n].y); kv[3] = bf_hi(kpk[n].y);
                        f32x4 kk, kp, kka;
                        for (int j = 0; j < 4; ++j) { const float a = sigmoidf_(a0[j] + acc[m][n][j]); kk[j] = kv[j] * kkw[j] * inv; kp[j] = kv[j] * (1.0f + (a - 1.0f) * ka[j]); kka[j] = kk[j] * a; }
                        const u32x2 kpp = {cvt_pk(kp[0], kp[1]), cvt_pk(kp[2], kp[3])};
                        bon += rv[0] * bf_lo(kpp.x) * rkv[0] + rv[1] * bf_hi(kpp.x) * rkv[1] + rv[2] * bf_lo(kpp.y) * rkv[2] + rv[3] * bf_hi(kpp.y) * rkv[3];
                        *(u32x2*)(kb + row * DM + col) = kpp; st_bf4(kkb + row * DM + col, kk); st_bf4(kab + row * DM + col, kka);
                        asm volatile("" ::: "memory"); }
                    bon += __shfl_xor(bon, 16); bon += __shfl_xor(bon, 32);
                    if (L.fq == 0) bsc[row * 16 + tn * 2 + L.wn] = bon;
                }
            }
        }
    }
}
typedef float f32x2 __attribute__((ext_vector_type(2)));
constexpr int R3_CH = 32, R3_STR = R3_CH * 256, R3_BUF = 5 * R3_STR + R3_CH * 64;
DEV void r3_stage_raw(const bf16_t* const (&str)[5], const bf16_t* vb, size_t base, int vrow0, int t0, char* buf, int id) {
    u32x4 d[5];
    const int t = id >> 3, j = id & 7;
#pragma unroll
    for (int st = 0; st < 5; ++st) d[st] = *(const u32x4*)(str[st] + base + (size_t)(t0 + t) * DM + j * 8);
    u32x4 vv = {0u, 0u, 0u, 0u};
    if (id < 64) vv = *(const u32x4*)(vb + base + (size_t)(t0 + (id >> 1)) * DM + vrow0 + (id & 1) * 8);
#pragma unroll
    for (int st = 0; st < 5; ++st) { f32x4 a, b; a[0] = bf_lo(d[st].x); a[1] = bf_hi(d[st].x); a[2] = bf_lo(d[st].y); a[3] = bf_hi(d[st].y); b[0] = bf_lo(d[st].z); b[1] = bf_hi(d[st].z); b[2] = bf_lo(d[st].w); b[3] = bf_hi(d[st].w);
        float* p = (float*)(buf + st * R3_STR + t * 256 + j * 32); *(f32x4*)p = a; *(f32x4*)(p + 4) = b; }
    if (id < 64) { f32x4 a, b; a[0] = bf_lo(vv.x); a[1] = bf_hi(vv.x); a[2] = bf_lo(vv.y); a[3] = bf_hi(vv.y); b[0] = bf_lo(vv.z); b[1] = bf_hi(vv.z); b[2] = bf_lo(vv.w); b[3] = bf_hi(vv.w);
        float* vp = (float*)(buf + 5 * R3_STR + (id >> 1) * 64 + (id & 1) * 32); *(f32x4*)vp = a; *(f32x4*)(vp + 4) = b; }
}
DEV void phase_r3(const bf16_t* rb, const bf16_t* wb, const bf16_t* kb, const bf16_t* kkb, const bf16_t* kab, const bf16_t* vb, bf16_t* yb, float* bsc, const float* r_k, char* smem) {
    const int tid = tidx(), lane = tid & 63, wid = tid >> 6;
    const bf16_t* const str[5] = {rb, wb, kb, kkb, kab};
    constexpr int NCH = SEQ / R3_CH;
    for (int task = blockIdx.x; task < 256; task += gridDim.x) {
        const int bh = task >> 2, b = bh >> 4, h = bh & 15, rq = task & 3;
        const size_t base = (size_t)b * SEQ * DM + h * 64;
        bf16_t* ystage = (bf16_t*)(smem + 149504 + 64);
    float* gcarea = (float*)(smem + 3 * R3_BUF);
        if (wid >= 4) r3_stage_raw(str, vb, base, rq * 16, 0, smem, tid - 256);
        __syncthreads();
        if (wid >= 4) { r3_stage_raw(str, vb, base, rq * 16, R3_CH, smem + R3_BUF, tid - 256);
            char* bq = smem; float* w = (float*)bq + R3_STR / 4 + lane; const int p = wid - 4;
            float G = 1.f; for (int t = 0; t < 8 * p; ++t) G *= w[t * 64];
            float* r = (float*)bq + lane; float* k = r + 2 * (R3_STR / 4); float* q = r + 3 * (R3_STR / 4); float* a = r + 4 * (R3_STR / 4);
#pragma unroll
            for (int u = 0; u < 8; ++u) { const int t = 8 * p + u; const float Gold = G; G *= w[t * 64]; const float inv = rcpf_(G); r[t * 64] *= G; q[t * 64] *= Gold; k[t * 64] *= inv; a[t * 64] *= inv; }
            if (p == 3) gcarea[lane] = G; }
        __syncthreads();
        const int rr = lane >> 4, cg = lane & 15, rg = rq * 4 + wid;
        const size_t voff = base + rg * 4 + rr;
        f32x2 s01 = {0.f, 0.f}, s23 = {0.f, 0.f};
        for (int c = 0; c < NCH; ++c) {
            if (wid >= 4) {
                if (c >= 1 && tid - 256 < 64) { const int id = tid - 256;
                    *(u32x4*)(yb + base + (size_t)((c - 1) * R3_CH + (id >> 1)) * DM + rq * 16 + (id & 1) * 8) = *(const u32x4*)(ystage + ((c - 1) & 1) * 512 + (id >> 1) * 16 + (id & 1) * 8); }
                if (c + 2 < NCH) r3_stage_raw(str, vb, base, rq * 16, (c + 2) * R3_CH, smem + ((c + 2) % 3) * R3_BUF, tid - 256);
                if (c + 1 < NCH) { char* bq = smem + ((c + 1) % 3) * R3_BUF; float* w = (float*)bq + R3_STR / 4 + lane; const int p = wid - 4;
                    float G = 1.f; for (int t = 0; t < 8 * p; ++t) G *= w[t * 64];
                    float* r = (float*)bq + lane; float* k = r + 2 * (R3_STR / 4); float* q = r + 3 * (R3_STR / 4); float* a = r + 4 * (R3_STR / 4);
#pragma unroll
                    for (int u = 0; u < 8; ++u) { const int t = 8 * p + u; const float Gold = G; G *= w[t * 64]; const float inv = rcpf_(G); r[t * 64] *= G; q[t * 64] *= Gold; k[t * 64] *= inv; a[t * 64] *= inv; }
                    if (p == 3) gcarea[((c + 1) % 3) * 64 + lane] = G; }
            } else {
                const char* buf = smem + (c % 3) * R3_BUF;
                f32x4 R_[2][2], K_[2][2], Q_[2][2], A_[2][2]; float V_[2][2];
#define R3_LD(bf, t0) { _Pragma("unroll") for (int u = 0; u < 2; ++u) { const char* p = buf + ((t0) + u) * 256 + cg * 16; \
                    R_[bf][u] = *(const f32x4*)p; K_[bf][u] = *(const f32x4*)(p + 2 * R3_STR); Q_[bf][u] = *(const f32x4*)(p + 3 * R3_STR); A_[bf][u] = *(const f32x4*)(p + 4 * R3_STR); \
                    V_[bf][u] = *(const float*)(buf + 5 * R3_STR + ((t0) + u) * 64 + (wid * 4 + rr) * 4); } }
#define R3_CP(bf, sl) { _Pragma("unroll") for (int u = 0; u < 2; ++u) { \
                    const f32x4 R = R_[bf][u], K = K_[bf][u], Q = Q_[bf][u], A = A_[bf][u]; const float vv = V_[bf][u]; \
                    const f32x2 r01 = {R[0], R[1]}, r23 = {R[2], R[3]}, k01 = {K[0], K[1]}, k23 = {K[2], K[3]}; \
                    const f32x2 q01 = {Q[0], Q[1]}, q23 = {Q[2], Q[3]}, a01 = {A[0], A[1]}, a23 = {A[2], A[3]}; \
                    const f32x2 pq = s01 * q01 + s23 * q23; \
                    const float sa = -row16_sum(pq.x + pq.y); \
                    const f32x2 sa2 = {sa, sa}, vv2 = {vv, vv}; \
                    s01 = (s01 + vv2 * k01) + sa2 * a01; s23 = (s23 + vv2 * k23) + sa2 * a23; \
                    const f32x2 py = s01 * r01 + s23 * r23; \
                    const float y = row16_sum(py.x + py.y); \
                    yv = (cg == (sl) + u) ? y : yv; } }
                R3_LD(0, 0)
#pragma unroll 1
                for (int t8 = 0; t8 < R3_CH; t8 += 8) {
                    float yv = 0.f;
                    R3_LD(1, t8 + 2)
                    R3_CP(0, 0)
                    R3_LD(0, t8 + 4)
                    R3_CP(1, 2)
                    R3_LD(1, t8 + 6)
                    R3_CP(0, 4)
                    if (t8 + 8 < R3_CH) R3_LD(0, t8 + 8)
                    R3_CP(1, 6)
                    if (cg < 8) ystage[(c & 1) * 512 + (t8 + cg) * 16 + wid * 4 + rr] = f2bf(yv);
                }
#undef R3_LD
#undef R3_CP
                const f32x4 GC = *(const f32x4*)(gcarea + (c % 3) * 64 + cg * 4);
                s01 *= (f32x2){GC[0], GC[1]}; s23 *= (f32x2){GC[2], GC[3]};
            }
            __syncthreads();
        }
        if (wid >= 4 && tid - 256 < 64) { const int id = tid - 256;
            *(u32x4*)(yb + base + (size_t)((NCH - 1) * R3_CH + (id >> 1)) * DM + rq * 16 + (id & 1) * 8) = *(const u32x4*)(ystage + ((NCH - 1) & 1) * 512 + (id >> 1) * 16 + (id & 1) * 8); }
        __syncthreads();
    }
}
constexpr int RC_NP = 8, RC_SLOT = 18688, RC_LDS = 18688;
constexpr int RC_QT = 0, RC_RR = 4096, RC_BG = 8192, RC_AB = 12288, RC_D0 = 14336, RC_U0 = 16384, RC_Y0 = 17408, RC_G = 18432;
#define R3C_FENCE() asm volatile("" ::: "memory")
constexpr int RC_P = 144;
DEV bf16x8 r3c_permfrag(const char* rowp, int q) {
    const u32x2 lo = *(const u32x2*)(rowp + 8 * q), hi = *(const u32x2*)(rowp + 32 + 8 * q);
    u32x4 w; w.x = lo.x; w.y = lo.y; w.z = hi.x; w.w = hi.y; return __builtin_bit_cast(bf16x8, w);
}
DEV bf16x8 r3c_neg(bf16x8 a) { u32x4 w = __builtin_bit_cast(u32x4, a); w.x ^= 0x80008000u; w.y ^= 0x80008000u; w.z ^= 0x80008000u; w.w ^= 0x80008000u; return __builtin_bit_cast(bf16x8, w); }
DEV u32x4 r3c_scale8(u32x4 d, f32x4 a, f32x4 b) {
    u32x4 o; o.x = cvt_pk(bf_lo(d.x) * a[0], bf_hi(d.x) * a[1]); o.y = cvt_pk(bf_lo(d.y) * a[2], bf_hi(d.y) * a[3]);
    o.z = cvt_pk(bf_lo(d.z) * b[0], bf_hi(d.z) * b[1]); o.w = cvt_pk(bf_lo(d.w) * b[2], bf_hi(d.w) * b[3]); return o;
}
DEV u32x2 r3c_pk4(f32x4 v) { u32x2 w; w.x = cvt_pk(v[0], v[1]); w.y = cvt_pk(v[2], v[3]); return w; }
DEV f32x4 r3c_up4(u32x2 w) { f32x4 v; v[0] = bf_lo(w.x); v[1] = bf_hi(w.x); v[2] = bf_lo(w.y); v[3] = bf_hi(w.y); return v; }
#define R3C_SCORE(dst, A, B, ROWLESS, STRICT) { _Pragma("unroll") for (int a = 0; a < 2; ++a) { _Pragma("unroll") for (int b = 0; b < 2; ++b) { \
        f32x4 a_ = MFMA(A[a][0], B[b][0], z4); a_ = MFMA(A[a][1], B[b][1], a_); \
        _Pragma("unroll") for (int r = 0; r < 4; ++r) { const int row_ = 16 * a + 4 * q + r, col_ = 16 * b + m; const int lo_ = (ROWLESS) ? row_ : col_, hi_ = (ROWLESS) ? col_ : row_; \
            const bool keep_ = (STRICT) ? (lo_ < hi_) : (lo_ <= hi_); a_[r] = keep_ ? a_[r] : 0.f; } \
        dst[a][b] = a_; } } }
struct R3Raw { u32x4 dr[4], dw[4], dk[4], dq[4], da[4]; bf16x8 vfrag; };
DEV void r3c_load(R3Raw& W, const bf16_t* rb, const bf16_t* wb, const bf16_t* kkb, const bf16_t* vb, size_t base, int vrow0, int t0, int lane) {
    const int m = lane & 15, q = lane >> 4, tr = lane >> 3, j = lane & 7;
#pragma unroll
    for (int s = 0; s < 4; ++s) { const size_t o = base + (size_t)(t0 + 8 * s + tr) * DM + j * 8;
        W.dw[s] = *(const u32x4*)(wb + o); W.dr[s] = *(const u32x4*)(rb + o); W.dq[s] = *(const u32x4*)(kkb + o); }
    const bf16_t* vp = vb + base + (size_t)t0 * DM + vrow0 + m; unsigned e[8];
#pragma unroll
    for (int jj = 0; jj < 8; ++jj) { const int t = (jj < 4) ? 4 * q + jj : 16 + 4 * q + jj - 4; e[jj] = vp[(size_t)t * DM]; }
    u32x4 w; w.x = e[0] | (e[1] << 16); w.y = e[2] | (e[3] << 16); w.z = e[4] | (e[5] << 16); w.w = e[6] | (e[7] << 16); W.vfrag = __builtin_bit_cast(bf16x8, w);
}
DEV void r3c_load2(R3Raw& W, const bf16_t* kb, const bf16_t* kab, size_t base, int t0, int lane) {
    const int tr = lane >> 3, j = lane & 7;
#pragma unroll
    for (int s = 0; s < 4; ++s) { const size_t o = base + (size_t)(t0 + 8 * s + tr) * DM + j * 8; W.dk[s] = *(const u32x4*)(kb + o); W.da[s] = *(const u32x4*)(kab + o); }
}
DEV void r3c_produce(R3Raw& W, const bf16_t* kb, const bf16_t* kab, size_t base, int t0, char* lds, int lane) {
    const int m = lane & 15, q = lane >> 4, tr = lane >> 3, j = lane & 7;
    r3c_load2(W, kb, kab, base, t0, lane);
    const f32x4 z4 = {0.f, 0.f, 0.f, 0.f};
    char* Rh = lds; char* Qh = lds + 32 * RC_P; char* Kh = lds + 64 * RC_P; char* Bh = lds + 96 * RC_P; float* G31a = (float*)(lds + 128 * RC_P);
    float* Gb = (float*)Kh;
    const bf16x8 vfrag = W.vfrag;
#pragma unroll
    for (int s = 0; s < 4; ++s) { float* gp = Gb + (8 * s + tr) * 64 + 8 * j; f32x4 a, b; const u32x4 d = W.dw[s];
        a[0] = bf_lo(d.x); a[1] = bf_hi(d.x); a[2] = bf_lo(d.y); a[3] = bf_hi(d.y); b[0] = bf_lo(d.z); b[1] = bf_hi(d.z); b[2] = bf_lo(d.w); b[3] = bf_hi(d.w);
        *(f32x4*)gp = a; *(f32x4*)(gp + 4) = b; }
    R3C_FENCE();
    { float g[32];
#pragma unroll
      for (int t = 0; t < 32; ++t) g[t] = Gb[t * 64 + lane];
      float G = 1.f;
#pragma unroll
      for (int t = 0; t < 32; ++t) { G *= g[t]; Gb[t * 64 + lane] = G; }
      G31a[lane] = G; }
    R3C_FENCE();
    { u32x4 kh[4], bh[4];
#pragma unroll
      for (int s = 0; s < 4; ++s) { const int t = 8 * s + tr, tp = t > 0 ? t - 1 : 0;
          const f32x4 g0 = *(const f32x4*)(Gb + t * 64 + 8 * j), g1 = *(const f32x4*)(Gb + t * 64 + 8 * j + 4);
          f32x4 p0 = *(const f32x4*)(Gb + tp * 64 + 8 * j), p1 = *(const f32x4*)(Gb + tp * 64 + 8 * j + 4);
          if (t == 0) { p0 = (f32x4){1.f, 1.f, 1.f, 1.f}; p1 = p0; }
          f32x4 i0, i1;
#pragma unroll
          for (int e = 0; e < 4; ++e) { i0[e] = rcpf_(g0[e]); i1[e] = rcpf_(g1[e]); }
          *(u32x4*)(Rh + t * RC_P + j * 16) = r3c_scale8(W.dr[s], g0, g1);
          *(u32x4*)(Qh + t * RC_P + j * 16) = r3c_scale8(W.dq[s], p0, p1);
          kh[s] = r3c_scale8(W.dk[s], i0, i1); bh[s] = r3c_scale8(W.da[s], i0, i1); }
      R3C_FENCE();
#pragma unroll
      for (int s = 0; s < 4; ++s) { const int t = 8 * s + tr; *(u32x4*)(Kh + t * RC_P + j * 16) = kh[s]; *(u32x4*)(Bh + t * RC_P + j * 16) = bh[s]; } }
    R3C_FENCE();
    bf16x8 Qa[2][2], Ra[2][2], Kb[2][2], Bb[2][2];
#pragma unroll
    for (int x = 0; x < 2; ++x)
#pragma unroll
        for (int ks = 0; ks < 2; ++ks) { const int off = (16 * x + m) * RC_P + (32 * ks + 8 * q) * 2;
            Qa[x][ks] = *(const bf16x8*)(Qh + off); Ra[x][ks] = *(const bf16x8*)(Rh + off); Kb[x][ks] = *(const bf16x8*)(Kh + off); Bb[x][ks] = *(const bf16x8*)(Bh + off); }
    f32x4 Tt[2][2], PN[2][2], PT[2][2], Z[2][5];
    R3C_SCORE(Tt, Kb, Qa, true, true)
    Z[0][4] = MFMA(pack8(Tt[0][0], Tt[1][0]), vfrag, z4); Z[1][4] = MFMA(pack8(Tt[0][1], Tt[1][1]), vfrag, z4);
    R3C_SCORE(Tt, Kb, Ra, true, false)
    u32x2 oY0[2]; oY0[0] = r3c_pk4(MFMA(pack8(Tt[0][0], Tt[1][0]), vfrag, z4)); oY0[1] = r3c_pk4(MFMA(pack8(Tt[0][1], Tt[1][1]), vfrag, z4));
    R3C_SCORE(Tt, Bb, Ra, true, false)
    bf16x8 oAB[2]; oAB[0] = r3c_neg(pack8(Tt[0][0], Tt[1][0])); oAB[1] = r3c_neg(pack8(Tt[0][1], Tt[1][1]));
    R3C_SCORE(PN, Qa, Bb, false, true)
    R3C_SCORE(PT, Bb, Qa, true, true)
#pragma unroll
    for (int mt = 0; mt < 2; ++mt)
#pragma unroll
        for (int n = 0; n < 4; ++n)
#pragma unroll
            for (int r = 0; r < 4; ++r) Z[mt][n][r] = bf2f(*(const bf16_t*)(Qh + (16 * mt + 4 * q + r) * RC_P + (16 * n + m) * 2));
#pragma unroll
    for (int lev = 0; lev < 5; ++lev) {
        bf16x8 fa[2], fb[2], zb[5];
#pragma unroll
        for (int x = 0; x < 2; ++x) { fa[x] = pack8(PT[0][x], PT[1][x]); fb[x] = pack8(PN[0][x], PN[1][x]); }
#pragma unroll
        for (int n = 0; n < 5; ++n) zb[n] = pack8(Z[0][n], Z[1][n]);
        const bf16x8 a0 = lev == 0 ? r3c_neg(fa[0]) : fa[0], a1 = lev == 0 ? r3c_neg(fa[1]) : fa[1];
#pragma unroll
        for (int n = 0; n < 5; ++n) { Z[0][n] = MFMA(a0, zb[n], Z[0][n]); Z[1][n] = MFMA(a1, zb[n], Z[1][n]); }
        if (lev < 4) {
#pragma unroll
            for (int a = 0; a < 2; ++a)
#pragma unroll
                for (int b = 0; b < 2; ++b) { PN[a][b] = MFMA(fa[a], fb[b], z4); PT[a][b] = MFMA(fb[a], fa[b], z4); }
        }
    }
    R3C_FENCE();
#pragma unroll
    for (int mt = 0; mt < 2; ++mt)
#pragma unroll
        for (int n = 0; n < 4; ++n)
#pragma unroll
            for (int r = 0; r < 4; ++r) *(bf16_t*)(Qh + (16 * mt + 4 * q + r) * RC_P + (16 * n + m) * 2) = f2bf(Z[mt][n][r]);
    R3C_FENCE();
    bf16x8 oQT[4], oRR[4], oBG[4]; u32x2 oD0[4];
#pragma unroll
    for (int mt = 0; mt < 2; ++mt)
#pragma unroll
        for (int ks = 0; ks < 2; ++ks) { oQT[mt * 2 + ks] = r3c_permfrag(Qh + (16 * mt + m) * RC_P + ks * 64, q); oRR[mt * 2 + ks] = r3c_permfrag(Rh + (16 * mt + m) * RC_P + ks * 64, q); }
#pragma unroll
    for (int ct = 0; ct < 4; ++ct) { const int ch = 16 * ct + m; const float g = G31a[ch]; f32x4 k0, k1, b0, b1;
#pragma unroll
        for (int jj = 0; jj < 4; ++jj) { const int ta = 4 * q + jj, tb = 16 + 4 * q + jj;
            k0[jj] = bf2f(*(const bf16_t*)(Kh + ta * RC_P + ch * 2)) * g; k1[jj] = bf2f(*(const bf16_t*)(Kh + tb * RC_P + ch * 2)) * g;
            b0[jj] = bf2f(*(const bf16_t*)(Bh + ta * RC_P + ch * 2)) * -g; b1[jj] = bf2f(*(const bf16_t*)(Bh + tb * RC_P + ch * 2)) * -g; }
        oBG[ct] = pack8(b0, b1);
        oD0[ct] = r3c_pk4(MFMA(pack8(k0, k1), vfrag, z4)); }
    asm volatile("s_waitcnt lgkmcnt(0)" ::: "memory");
#pragma unroll
    for (int f = 0; f < 4; ++f) { *(bf16x8*)(lds + RC_QT + f * 1024 + lane * 16) = oQT[f]; *(bf16x8*)(lds + RC_RR + f * 1024 + lane * 16) = oRR[f]; *(bf16x8*)(lds + RC_BG + f * 1024 + lane * 16) = oBG[f];
        *(u32x2*)(lds + RC_D0 + f * 512 + lane * 8) = oD0[f]; }
#pragma unroll
    for (int f = 0; f < 2; ++f) { *(bf16x8*)(lds + RC_AB + f * 1024 + lane * 16) = oAB[f]; *(u32x2*)(lds + RC_U0 + f * 512 + lane * 8) = r3c_pk4(Z[f][4]); *(u32x2*)(lds + RC_Y0 + f * 512 + lane * 8) = oY0[f]; }
    R3C_FENCE();
}
DEV void r3c_consume(f32x4 (&S)[4], const char* slot, bf16_t* yout, int lane) {
    const int m = lane & 15, q = lane >> 4;
    bf16x8 QT[2][2], RA[2][2], BG[4], AB[2]; u32x2 D0[4], U0[2], Y0[2]; f32x4 Gv[4];
#pragma unroll
    for (int f = 0; f < 4; ++f) { QT[f >> 1][f & 1] = *(const bf16x8*)(slot + RC_QT + f * 1024 + lane * 16); BG[f] = *(const bf16x8*)(slot + RC_BG + f * 1024 + lane * 16);
        D0[f] = *(const u32x2*)(slot + RC_D0 + f * 512 + lane * 8); Gv[f] = *(const f32x4*)(slot + RC_G + (16 * f + 4 * q) * 4); }
#pragma unroll
    for (int f = 0; f < 2; ++f) { U0[f] = *(const u32x2*)(slot + RC_U0 + f * 512 + lane * 8); Y0[f] = *(const u32x2*)(slot + RC_Y0 + f * 512 + lane * 8); AB[f] = *(const bf16x8*)(slot + RC_AB + f * 1024 + lane * 16); }
#pragma unroll
    for (int f = 0; f < 4; ++f) RA[f >> 1][f & 1] = *(const bf16x8*)(slot + RC_RR + f * 1024 + lane * 16);
    const bf16x8 sB0 = pack8(S[0], S[1]), sB1 = pack8(S[2], S[3]);
    f32x4 U[2], Y[2];
#pragma unroll
    for (int mt = 0; mt < 2; ++mt) { U[mt] = r3c_up4(U0[mt]); U[mt] = MFMA(QT[mt][0], sB0, U[mt]); U[mt] = MFMA(QT[mt][1], sB1, U[mt]); }
    const bf16x8 uB = pack8(U[0], U[1]);
#pragma unroll
    for (int ct = 0; ct < 4; ++ct) { S[ct] = S[ct] * Gv[ct] + r3c_up4(D0[ct]); S[ct] = MFMA(BG[ct], uB, S[ct]); }
#pragma unroll
    for (int mt = 0; mt < 2; ++mt) { Y[mt] = r3c_up4(Y0[mt]); Y[mt] = MFMA(RA[mt][0], sB0, Y[mt]); Y[mt] = MFMA(RA[mt][1], sB1, Y[mt]); Y[mt] = MFMA(AB[mt], uB, Y[mt]);
#pragma unroll
        for (int r = 0; r < 4; ++r) yout[(size_t)(16 * mt + 4 * q + r) * DM + m] = f2bf(Y[mt][r]); }
}
DEV void phase_r3c(const bf16_t* rb, const bf16_t* wb, const bf16_t* kb, const bf16_t* kkb, const bf16_t* kab, const bf16_t* vb, bf16_t* yb, char* smem) {
    const int tid = tidx(), lane = tid & 63, wid = __builtin_amdgcn_readfirstlane(tid >> 6);
    constexpr int NCH = SEQ / 32, NR = NCH / RC_NP;
    for (int task = blockIdx.x; task < 256; task += gridDim.x) {
        const int xc = task & 7, ix = task >> 3, bh = xc * 8 + (ix >> 2), b = bh >> 4, h = bh & 15, rq = ix & 3;
        const size_t base = (size_t)b * SEQ * DM + h * 64;
        f32x4 S[4];
#pragma unroll
        for (int ct = 0; ct < 4; ++ct) S[ct] = (f32x4){0.f, 0.f, 0.f, 0.f};
        R3Raw W; r3c_load(W, rb, wb, kkb, vb, base, rq * 16, wid * 32, lane);
        for (int rd = 0; rd < NR; ++rd) {
            r3c_produce(W, kb, kab, base, (rd * RC_NP + wid) * 32, smem + wid * RC_LDS, lane);
            if (rd + 1 < NR) r3c_load(W, rb, wb, kkb, vb, base, rq * 16, ((rd + 1) * RC_NP + wid) * 32, lane);
            asm volatile("s_waitcnt lgkmcnt(0)" ::: "memory");
            __syncthreads();
            if (wid == 0) {
                bf16_t* y0 = yb + base + (size_t)rd * RC_NP * 32 * DM + rq * 16;
#pragma unroll 1
                for (int p = 0; p < RC_NP; ++p) r3c_consume(S, smem + p * RC_LDS, y0 + (size_t)p * 32 * DM, lane);
                asm volatile("s_waitcnt lgkmcnt(0)" ::: "memory");
            }
            __syncthreads();
        }
    }
}
DEV void phase_r4(const bf16_t* hid, const bf16_t* G2T, const RwkvW& W, const bf16_t* yb, const bf16_t* vb, const float* bsc, bf16_t* outb, char* smem) {
    const LaneId L = lane_id();
    const int ntn = 8, nunits = (T / 256) * ntn;
    for (int u = blockIdx.x; u < nunits; u += gridDim.x) {
        const int tm = u / ntn, tn = u % ntn;
        f32x4 acc[4][4];
        gemm_core(acc, LdPlain{hid + (size_t)tm * 256 * HIDP + 128, HIDP}, LdPlain{G2T + (size_t)tn * 128 * 128, 128}, 128, smem);
        const int head = tn * 2 + L.wn;
#pragma unroll
        for (int m = 0; m < 4; ++m) {
            const size_t row = (size_t)tm * 256 + L.wm * 64 + m * 16 + L.fr;
            f32x4 yv[4]; float s = 0.f;
#pragma unroll
            for (int n = 0; n < 4; ++n) { yv[n] = ld_bf4(yb + row * DM + head * 64 + n * 16 + L.fq * 4); s += (yv[n][0] + yv[n][1]) + (yv[n][2] + yv[n][3]); }
            s += __shfl_xor(s, 16); s += __shfl_xor(s, 32);
            const float mean = s * (1.0f / 64.0f); float q = 0.f;
#pragma unroll
            for (int n = 0; n < 4; ++n) { const f32x4 d = yv[n] - mean; q += (d[0] * d[0] + d[1] * d[1]) + (d[2] * d[2] + d[3] * d[3]); }
            q += __shfl_xor(q, 16); q += __shfl_xor(q, 32);
            const float rstd = rsqrtf(q * (1.0f / 64.0f) + 64e-5f);
            const float bs = bsc[row * 16 + head];
#pragma unroll
            for (int n = 0; n < 4; ++n) { const int col = head * 64 + n * 16 + L.fq * 4;
                const f32x4 lw = *(const f32x4*)(W.ln_w + col), lb = *(const f32x4*)(W.ln_b + col), vv = ld_bf4(vb + row * DM + col);
                f32x4 o = ((yv[n] - mean) * rstd * lw + lb + vv * bs);
                o = o * acc[m][n];
                st_bf4(outb + row * DM + col, o); }
        }
    }
}

struct NsaBuf { bf16_t *q, *kcmp, *vcmp, *kslc, *kwin, *vslcT, *vwinT, *hid, *kc, *vcT, *o; float* gates; };
DEV void phase_n1(const bf16_t* xn, const bf16_t* Bt, const NsaBuf& B, char* smem) {
    const LaneId L = lane_id();
    const int ntn = 15, nunits = (T / 256) * ntn;
    for (int u = blockIdx.x; u < nunits; u += gridDim.x) {
        const int tm = u / ntn, tn = u % ntn;
        f32x4 acc[4][4];
        gemm_core(acc, LdPlain{xn + (size_t)tm * 256 * DM, DM}, LdPlain{Bt + (size_t)tn * 128 * DM, DM}, DM, smem);
#pragma unroll
        for (int m = 0; m < 4; ++m)
#pragma unroll
            for (int n = 0; n < 4; ++n) {
                const size_t row = (size_t)tm * 256 + L.wm * 64 + m * 16 + L.fr; const int c = L.wn * 64 + n * 16 + L.fq * 4; f32x4 v = acc[m][n];
                if (tn < 8) st_bf4(B.q + row * DM + tn * 128 + c, v * 0.125f);
                else if (tn < 14) {
                    const int cc = tn - 8;
                    if (cc == 0) st_bf4(B.kcmp + row * 128 + c, v);
                    else if (cc == 1) st_bf4(B.vcmp + row * 128 + c, v);
                    else if (cc == 2) st_bf4(B.kslc + row * 128 + c, v);
                    else if (cc == 4) st_bf4(B.kwin + row * 128 + c, v);
                    else { bf16_t* dst = cc == 3 ? B.vslcT : B.vwinT; const int b = (int)(row >> 13), t = (int)(row & (SEQ - 1));
                        for (int j = 0; j < 4; ++j) dst[((size_t)(b * 128 + c + j)) * SEQ + t] = f2bf(v[j]); }
                } else { if (c < 48) { for (int j = 0; j < 4; ++j) B.gates[row * 48 + c + j] = sigmoidf_(v[j]); } }
            }
    }
}
DEV float gelu_tanh(float x) { const float u = 0.7978845608028654f * (x + 0.044715f * x * x * x); return 0.5f * x * (1.0f + tanhf(u)); }
DEV void phase_n2a(const bf16_t* W1T, const float* biasp, const NsaBuf& B, char* smem) {
    const LaneId L = lane_id();
    for (int u = blockIdx.x; u < 64; u += gridDim.x) {
        const int c = u >> 5, tm = (u >> 1) & 15, tn = u & 1;
        f32x4 acc[4][4];
        gemm_core(acc, LdCmp{c ? B.vcmp : B.kcmp, tm * 256}, LdPlain{W1T + (size_t)c * 256 * 2048 + (size_t)tn * 128 * 2048, 2048}, 2048, smem);
#pragma unroll
        for (int m = 0; m < 4; ++m)
#pragma unroll
            for (int n = 0; n < 4; ++n) { const size_t row = (size_t)tm * 256 + L.wm * 64 + m * 16 + L.fr; const int col = tn * 128 + L.wn * 64 + n * 16 + L.fq * 4;
                const f32x4 bb = *(const f32x4*)(biasp + c * 256 + col); f32x4 v;
                for (int j = 0; j < 4; ++j) v[j] = gelu_tanh(acc[m][n][j] + bb[j]);
                st_bf4(B.hid + ((size_t)c * 4096 + row) * 256 + col, v); }
    }
}
DEV void phase_n2b(const bf16_t* W2T, const NsaBuf& B, char* smem) {
    const LaneId L = lane_id();
    for (int u = blockIdx.x; u < 32; u += gridDim.x) {
        const int c = u >> 4, tm = u & 15;
        f32x4 acc[4][4];
        gemm_core(acc, LdPlain{B.hid + ((size_t)c * 4096 + tm * 256) * 256, 256}, LdPlain{W2T + (size_t)c * 128 * 256, 256}, 256, smem);
        if (L.wn == 0) {
#pragma unroll
            for (int m = 0; m < 4; ++m)
#pragma unroll
                for (int n = 0; n < 4; ++n) { const int row = tm * 256 + L.wm * 64 + m * 16 + L.fr, d = n * 16 + L.fq * 4;
                    const int b = row >> 10, nn = (row >> 1) & 511, g = row & 1;
                    if (c == 0) st_bf4(B.kc + ((size_t)((b * 2 + g) * 512 + nn)) * 64 + d, acc[m][n]);
                    else { for (int j = 0; j < 4; ++j) B.vcT[((size_t)((b * 2 + g) * 64 + d + j)) * 512 + nn] = f2bf(acc[m][n][j]); } }
        }
    }
}
#define NEGV (-1e30f)
#define LOG2E_ 1.4426950408889634f
DEV u32x4 n3_ldg(const bf16_t* kbase, long kpitch, const bf16_t* vbase, long vpitch, int kb, int tid) {
    if (tid < 256) return *(const u32x4*)(kbase + (size_t)(kb + (tid >> 3)) * kpitch + (tid & 7) * 8);
    const int i = tid - 256; return *(const u32x4*)(vbase + (size_t)(i >> 2) * vpitch + kb + (i & 3) * 8);
}
DEV void n3_sts(char* buf, u32x4 v, int tid) {
    if (tid < 256) { const int row = tid >> 3, c = tid & 7, sw = ((row >> 1) & 1) | (((row >> 3) & 3) << 1); *(u32x4*)(buf + row * 128 + ((c ^ sw) << 4)) = v; }
    else { const int i = tid - 256, d = i >> 2, c = i & 3; *(u32x4*)(buf + 4096 + d * 64 + ((c ^ ((d >> 2) & 3)) << 4)) = v; }
}
DEV void phase_n3(const NsaBuf& B, char* smem) {
    const int tid = tidx(), lane = tid & 63, wid = tid >> 6, m = lane & 15, fq = lane >> 4, qh = m >> 3, hh = m & 7;
    float* psum = (float*)(smem + wid * 8704); int* ulist = (int*)(smem + wid * 8704 + 8192);
    char* stg = smem + 8 * 8704;
    const int kperm = 8 * (m >> 2) + (m & 3);
    const int kswz = ((m >> 1) & 1) | ((m >> 2) << 1), vswz = (m >> 2) & 3;
    const int koffA = kperm * 128, koffB = (kperm + 4) * 128, voff = 4096 + m * 64 + ((fq ^ vswz) << 4);
    const f32x4 z4 = {0.f, 0.f, 0.f, 0.f};
    const int nrank = (int)gridDim.x >> 3, bg = (int)blockIdx.x & 7;
    for (int qblk = (int)blockIdx.x >> 3; qblk < 256 && (int)blockIdx.x < nrank * 8; qblk += nrank) {
        const int g = bg & 1, b = bg >> 1, t0b = qblk * 32, t0 = t0b + wid * 4;
        int tq[2]; bf16x8 qf[2][2]; float gc[2], gs[2], gw[2]; u32x2 opk[2][4];
#pragma unroll
        for (int rb = 0; rb < 2; ++rb) {
            tq[rb] = t0 + rb * 2 + qh;
            const bf16_t* qp = B.q + ((size_t)(b * SEQ + tq[rb])) * DM + (g * 8 + hh) * 64 + fq * 8;
            qf[rb][0] = __builtin_nontemporal_load((const bf16x8*)qp); qf[rb][1] = __builtin_nontemporal_load((const bf16x8*)(qp + 32));
            const float* gp = B.gates + ((size_t)(b * SEQ + tq[rb])) * 48 + g * 24 + hh * 3;
            gc[rb] = gp[0]; gs[rb] = gp[1]; gw[rb] = gp[2];
        }
#define N3_KFRAGS(buf) const bf16x8 kA0 = *(const bf16x8*)((buf) + koffA + (((0 + fq) ^ kswz) << 4)), kA1 = *(const bf16x8*)((buf) + koffA + (((4 + fq) ^ kswz) << 4)), \
                                    kB0 = *(const bf16x8*)((buf) + koffB + (((0 + fq) ^ kswz) << 4)), kB1 = *(const bf16x8*)((buf) + koffB + (((4 + fq) ^ kswz) << 4));
        {
            const int tid = tidx(), lane = tid & 63, m = lane & 15, fq = (lane >> 4), qh = m >> 3, hh = m & 7, kperm = 8 * (m >> 2) + (m & 3); (void)hh; (void)qh; (void)lane;
            const int kswz = ((m >> 1) & 1) | ((m >> 2) << 1), vswz = (m >> 2) & 3, koffA = kperm * 128, koffB = (kperm + 4) * 128, voff = 4096 + m * 64 + ((fq ^ vswz) << 4);
            int nv[2];
#pragma unroll
            for (int rb = 0; rb < 2; ++rb) nv[rb] = tq[rb] >= 31 ? ((tq[rb] - 31) >> 4) + 1 : 0;
            const int nvmax = (t0b + 31 >= 31) ? ((t0b + 31 - 31) >> 4) + 1 : 0, ngrp = (nvmax + 31) >> 5;
#pragma unroll
            for (int i = 0; i < 32; ++i) psum[lane + 64 * i] = 0.f;
            const bf16_t* kcb = B.kc + (size_t)((b * 2 + g) * 512) * 64; const bf16_t* vcb = B.vcT + (size_t)((b * 2 + g) * 64) * 512;
            float mx[2] = {NEGV, NEGV}, l[2] = {0.f, 0.f};
            u32x4 stv;
            if (ngrp > 0) { stv = n3_ldg(kcb, 64, vcb, 512, 0, tid); n3_sts(stg, stv, tid); }
            __syncthreads();
            for (int grp = 0; grp < ngrp; ++grp) {
                const int kb = grp * 32; const bool more = grp + 1 < ngrp;
                if (more) stv = n3_ldg(kcb, 64, vcb, 512, kb + 32, tid);
                const char* buf = stg + (grp & 1) * 8192;
                N3_KFRAGS(buf)
#pragma unroll
                for (int rb = 0; rb < 2; ++rb) {
                    f32x4 sA = MFMA(kA0, qf[rb][0], z4); sA = MFMA(kA1, qf[rb][1], sA);
                    f32x4 sB = MFMA(kB0, qf[rb][0], z4); sB = MFMA(kB1, qf[rb][1], sB);
                    const bool full = kb + 32 <= nv[rb], part = !full && kb < nv[rb];
                    if (__ballot(part) == 0ull) {
                        const float m8 = fmaxf(fmaxf(fmaxf(sA[0], sA[1]), fmaxf(sA[2], sA[3])), fmaxf(fmaxf(sB[0], sB[1]), fmaxf(sB[2], sB[3])));
                        const float mn = fmaxf(mx[rb], full ? m8 : NEGV), tl = (full ? mn : 1e30f) * LOG2E_; float add = 0.f;
#pragma unroll
                        for (int j = 0; j < 4; ++j) add += __builtin_amdgcn_exp2f(fmaf(sA[j], LOG2E_, -tl)) + __builtin_amdgcn_exp2f(fmaf(sB[j], LOG2E_, -tl));
                        l[rb] = l[rb] * __expf(mx[rb] - mn) + add; mx[rb] = mn;
                    } else {
                    float gm = NEGV;
#pragma unroll
                    for (int j = 0; j < 4; ++j) { if (kb + 8 * fq + j < nv[rb]) gm = fmaxf(gm, sA[j]); if (kb + 8 * fq + 4 + j < nv[rb]) gm = fmaxf(gm, sB[j]); }
                    const float mn = fmaxf(mx[rb], gm); float add = 0.f;
#pragma unroll
                    for (int j = 0; j < 4; ++j) { if (kb + 8 * fq + j < nv[rb]) add += __expf(sA[j] - mn); if (kb + 8 * fq + 4 + j < nv[rb]) add += __expf(sB[j] - mn); }
                    l[rb] = l[rb] * __expf(mx[rb] - mn) + add; mx[rb] = mn;
                    }
                }
                if (more) n3_sts(stg + ((grp + 1) & 1) * 8192, stv, tid);
                __syncthreads();
            }
            float M[2], inv[2];
#pragma unroll
            for (int rb = 0; rb < 2; ++rb) {
                float Mx = fmaxf(mx[rb], __shfl_xor(mx[rb], 16)); Mx = fmaxf(Mx, __shfl_xor(Mx, 32));
                float ll = l[rb] * __expf(mx[rb] - Mx); ll += __shfl_xor(ll, 16); ll += __shfl_xor(ll, 32);
                M[rb] = Mx; inv[rb] = ll > 0.f ? 1.0f / ll : 0.f;
            }
            f32x4 oc[2][4];
#pragma unroll
            for (int rb = 0; rb < 2; ++rb)
#pragma unroll
                for (int d = 0; d < 4; ++d) oc[rb][d] = z4;
            if (ngrp > 0) { stv = n3_ldg(kcb, 64, vcb, 512, 0, tid); n3_sts(stg, stv, tid); }
            __syncthreads();
            for (int grp = 0; grp < ngrp; ++grp) {
                const int kb = grp * 32; const bool more = grp + 1 < ngrp;
                if (more) stv = n3_ldg(kcb, 64, vcb, 512, kb + 32, tid);
                const char* buf = stg + (grp & 1) * 8192;
                N3_KFRAGS(buf)
                bf16x8 vf[4];
#pragma unroll
                for (int d = 0; d < 4; ++d) vf[d] = *(const bf16x8*)(buf + voff + d * 1024);
#pragma unroll
                for (int rb = 0; rb < 2; ++rb) {
                    f32x4 sA = MFMA(kA0, qf[rb][0], z4); sA = MFMA(kA1, qf[rb][1], sA);
                    f32x4 sB = MFMA(kB0, qf[rb][0], z4); sB = MFMA(kB1, qf[rb][1], sB);
                    f32x4 pA, pB;
                    const bool full = kb + 32 <= nv[rb], part = !full && kb < nv[rb];
                    if (__ballot(part) == 0ull) {
                        const float tl = (full ? M[rb] : 1e30f) * LOG2E_;
#pragma unroll
                        for (int j = 0; j < 4; ++j) { pA[j] = __builtin_amdgcn_exp2f(fmaf(sA[j], LOG2E_, -tl)) * inv[rb]; pB[j] = __builtin_amdgcn_exp2f(fmaf(sB[j], LOG2E_, -tl)) * inv[rb]; }
                    } else {
#pragma unroll
                    for (int j = 0; j < 4; ++j) { pA[j] = (kb + 8 * fq + j < nv[rb]) ? __expf(sA[j] - M[rb]) * inv[rb] : 0.f; pB[j] = (kb + 8 * fq + 4 + j < nv[rb]) ? __expf(sB[j] - M[rb]) * inv[rb] : 0.f; }
                    }
#pragma unroll
                    for (int j = 0; j < 4; ++j) {
                        float a = pA[j]; a += DPP_MOV(a, 0xB1); a += DPP_MOV(a, 0x4E); a += DPP_MOV(a, 0x141);
                        float c = pB[j]; c += DPP_MOV(c, 0xB1); c += DPP_MOV(c, 0x4E); c += DPP_MOV(c, 0x141);
                        if (hh == 0) { psum[(rb * 2 + qh) * 512 + kb + 8 * fq + j] = a; psum[(rb * 2 + qh) * 512 + kb + 8 * fq + 4 + j] = c; }
                    }
                    const bf16x8 pf = pack8(pA, pB);
#pragma unroll
                    for (int d = 0; d < 4; ++d) oc[rb][d] = MFMA(vf[d], pf, oc[rb][d]);
                }
                if (more) n3_sts(stg + ((grp + 1) & 1) * 8192, stv, tid);
                __syncthreads();
            }
#pragma unroll
            for (int rb = 0; rb < 2; ++rb)
#pragma unroll
                for (int d = 0; d < 4; ++d) { const f32x4 v = oc[rb][d] * gc[rb]; opk[rb][d].x = cvt_pk(v[0], v[1]); opk[rb][d].y = cvt_pk(v[2], v[3]); }
        }
        asm volatile("s_waitcnt lgkmcnt(0)" ::: "memory");
        __builtin_amdgcn_sched_barrier(0);
        unsigned long long mlo[4], mhi[4];
#pragma unroll
        for (int q2 = 0; q2 < 4; ++q2) {
            const int tqq = t0 + q2, cur = tqq >> 6;
            float sc[2];
#pragma unroll
            for (int c = 0; c < 2; ++c) { const int j = lane + 64 * c; float imp = 0.f;
                for (int n = 4 * j - 1; n <= 4 * j + 3; ++n) if (n >= 0) imp += psum[q2 * 512 + n];
                const bool causal = j * 64 <= tqq, forced = (j == 0) || (j == cur) || (j == cur - 1);
                sc[c] = causal ? imp + (forced ? 1e4f : 0.f) : NEGV; }
            unsigned k0 = __float_as_uint(sc[0]), k1 = __float_as_uint(sc[1]);
            k0 = (k0 & 0x80000000u) ? ~k0 : (k0 | 0x80000000u); k1 = (k1 & 0x80000000u) ? ~k1 : (k1 | 0x80000000u);
            unsigned Tk = 0u;
            for (int bit = 31; bit >= 0; --bit) { const unsigned cand = Tk | (1u << bit);
                const int cnt = __popcll(__ballot(k0 >= cand)) + __popcll(__ballot(k1 >= cand)); if (cnt >= 16) Tk = cand; }
            const int ngt = __popcll(__ballot(k0 > Tk)) + __popcll(__ballot(k1 > Tk)), needn = 16 - ngt;
            const unsigned long long eq0 = __ballot(k0 == Tk), eq1 = __ballot(k1 == Tk), belowm = (1ull << lane) - 1ull;
            const bool s0 = (k0 > Tk) || (k0 == Tk && __popcll(eq0 & belowm) < needn);
            const bool s1 = (k1 > Tk) || (k1 == Tk && __popcll(eq0) + __popcll(eq1 & belowm) < needn);
            mlo[q2] = __ballot(s0); mhi[q2] = __ballot(s1);
        }
        int nun;
        {
            const unsigned long long ulo = mlo[0] | mlo[1] | mlo[2] | mlo[3], uhi = mhi[0] | mhi[1] | mhi[2] | mhi[3];
            const unsigned long long below = (1ull << lane) - 1ull; const int nlo = __popcll(ulo);
            if ((ulo >> lane) & 1ull) { const int mb = (int)((mlo[0] >> lane) & 1ull) | ((int)((mlo[1] >> lane) & 1ull) << 1) | ((int)((mlo[2] >> lane) & 1ull) << 2) | ((int)((mlo[3] >> lane) & 1ull) << 3);
                ulist[__popcll(ulo & below)] = lane | (mb << 8); }
            if ((uhi >> lane) & 1ull) { const int mb = (int)((mhi[0] >> lane) & 1ull) | ((int)((mhi[1] >> lane) & 1ull) << 1) | ((int)((mhi[2] >> lane) & 1ull) << 2) | ((int)((mhi[3] >> lane) & 1ull) << 3);
                ulist[nlo + __popcll(uhi & below)] = (lane + 64) | (mb << 8); }
            nun = nlo + __popcll(uhi);
        }
        asm volatile("s_waitcnt lgkmcnt(0)" ::: "memory");
        __builtin_amdgcn_sched_barrier(0);
        {
            const int tid = tidx(), lane = tid & 63, m = lane & 15, fq = (lane >> 4), qh = m >> 3, hh = m & 7, kperm = 8 * (m >> 2) + (m & 3); (void)hh; (void)qh; (void)lane;
            const unsigned char* ksb = (const unsigned char*)B.kslc + (size_t)((b * 2 + g) * SEQ) * 64 + fq * 8; const unsigned char* vsb = (const unsigned char*)B.vslcT + (size_t)((b * 2 + g) * 128) * 4096 + m * 64 + 8 * fq;
            long q8[2][2];
#pragma unroll
            for (int rb = 0; rb < 2; ++rb)
#pragma unroll
                for (int ks = 0; ks < 2; ++ks) { const u32x4 w = __builtin_bit_cast(u32x4, qf[rb][ks]);
                    const unsigned lo = pack_fp8x4(bf_lo(w.x), bf_hi(w.x), bf_lo(w.y), bf_hi(w.y)), hi = pack_fp8x4(bf_lo(w.z), bf_hi(w.z), bf_lo(w.w), bf_hi(w.w));
                    q8[rb][ks] = (long)(((unsigned long long)hi << 32) | lo); }
            float mx[2] = {NEGV, NEGV}, l[2] = {0.f, 0.f}; f32x4 os[2][4];
#pragma unroll
            for (int rb = 0; rb < 2; ++rb)
#pragma unroll
                for (int d = 0; d < 4; ++d) os[rb][d] = z4;
            char* st8 = (char*)psum;
            const int srow = lane >> 2, sc0 = (lane & 3) * 2;
            u32x4 gk[4], gv[4];
            { const int blk0 = ulist[0] & 255; const unsigned char* kp = (const unsigned char*)B.kslc + ((size_t)((b * 2 + g) * SEQ) + blk0 * 64) * 64 + lane * 16; const unsigned char* vp = (const unsigned char*)B.vslcT + ((size_t)((b * 2 + g) * 128) + blk0) * 4096 + lane * 16;
#pragma unroll
              for (int i = 0; i < 4; ++i) { gk[i] = *(const u32x4*)(kp + i * 1024); gv[i] = *(const u32x4*)(vp + i * 1024); } }
            const int fsw = (m >> 2) << 1;
            for (int ib = 0; ib < nun; ++ib) {
                const int e = __builtin_amdgcn_readfirstlane(ulist[ib]);
#pragma unroll
                for (int i = 0; i < 4; ++i) { const int row = i * 16 + srow;
                    *(u32x4*)(st8 + row * 64 + ((sc0 ^ (((row >> 3) & 3) << 1)) << 3)) = gk[i];
                    *(u32x4*)(st8 + 4096 + row * 64 + ((sc0 ^ (((row >> 2) & 3) << 1)) << 3)) = gv[i]; }
                if (ib + 1 < nun) { const int blkn = ulist[ib + 1] & 255; const unsigned char* kp = (const unsigned char*)B.kslc + ((size_t)((b * 2 + g) * SEQ) + blkn * 64) * 64 + lane * 16; const unsigned char* vp = (const unsigned char*)B.vslcT + ((size_t)((b * 2 + g) * 128) + blkn) * 4096 + lane * 16;
#pragma unroll
                    for (int i = 0; i < 4; ++i) { gk[i] = *(const u32x4*)(kp + i * 1024); gv[i] = *(const u32x4*)(vp + i * 1024); } }
#pragma unroll
              for (int hf = 0; hf < 2; ++hf) {
                const int kb = (e & 255) * 64 + hf * 32;
                const char* kr = st8 + (hf * 32 + kperm) * 64;
                const long kA0 = *(const long*)(kr + ((fq ^ fsw) << 3)), kA1 = *(const long*)(kr + (((4 + fq) ^ fsw) << 3)), kB0 = *(const long*)(kr + 256 + ((fq ^ fsw) << 3)), kB1 = *(const long*)(kr + 256 + (((4 + fq) ^ fsw) << 3));
                long vf[4];
#pragma unroll
                for (int d = 0; d < 4; ++d) vf[d] = *(const long*)(st8 + 4096 + (d * 16 + m) * 64 + (((hf * 4 + fq) ^ fsw) << 3));
#pragma unroll
                for (int rb = 0; rb < 2; ++rb) {
                    if (((e >> (8 + rb * 2)) & 3) == 0) continue;
                    const bool mine = ((e >> (8 + rb * 2 + qh)) & 1) != 0;
                    f32x4 sA = MFMA8(kA0, q8[rb][0], z4); sA = MFMA8(kA1, q8[rb][1], sA);
                    f32x4 sB = MFMA8(kB0, q8[rb][0], z4); sB = MFMA8(kB1, q8[rb][1], sB);
                    const bool full = mine && kb + 31 <= tq[rb], part = mine && !full && kb <= tq[rb];
                    const bool fast = __ballot(part) == 0ull;
                    float gm = NEGV;
                    if (fast) { const float m8 = fmaxf(fmaxf(fmaxf(sA[0], sA[1]), fmaxf(sA[2], sA[3])), fmaxf(fmaxf(sB[0], sB[1]), fmaxf(sB[2], sB[3]))); gm = full ? m8 : NEGV; }
                    else {
#pragma unroll
                    for (int j = 0; j < 4; ++j) { if (mine && kb + 8 * fq + j <= tq[rb]) gm = fmaxf(gm, sA[j]); if (mine && kb + 8 * fq + 4 + j <= tq[rb]) gm = fmaxf(gm, sB[j]); }
                    }
                    if (__ballot(gm > mx[rb]) != 0ull) {
                        gm = fmaxf(gm, __shfl_xor(gm, 16)); gm = fmaxf(gm, __shfl_xor(gm, 32));
                        const float mn2 = fmaxf(mx[rb], gm), alpha = __expf(mx[rb] - mn2); mx[rb] = mn2; l[rb] *= alpha;
#pragma unroll
                        for (int d = 0; d < 4; ++d) os[rb][d] *= alpha;
                    }
                    const float mn = mx[rb];
                    f32x4 pA, pB; float add = 0.f;
                    if (fast) { const float tl = (full ? mn : 1e30f) * LOG2E_ - 7.f;
#pragma unroll
                        for (int j = 0; j < 4; ++j) { pA[j] = __builtin_amdgcn_exp2f(fmaf(sA[j], LOG2E_, -tl)); pB[j] = __builtin_amdgcn_exp2f(fmaf(sB[j], LOG2E_, -tl)); add += pA[j] + pB[j]; }
                    } else {
#pragma unroll
                    for (int j = 0; j < 4; ++j) { pA[j] = (mine && kb + 8 * fq + j <= tq[rb]) ? __expf(sA[j] - mn + 4.8520302639f) : 0.f; pB[j] = (mine && kb + 8 * fq + 4 + j <= tq[rb]) ? __expf(sB[j] - mn + 4.8520302639f) : 0.f; add += pA[j] + pB[j]; }
                    }
                    l[rb] += add;
                    const unsigned plo = pack_fp8x4(pA[0], pA[1], pA[2], pA[3]), phi = pack_fp8x4(pB[0], pB[1], pB[2], pB[3]);
                    const long pf = (long)(((unsigned long long)phi << 32) | plo);
#pragma unroll
                    for (int d = 0; d < 4; ++d) os[rb][d] = MFMA8(vf[d], pf, os[rb][d]);
                }
              }
            }
#pragma unroll
            for (int rb = 0; rb < 2; ++rb) {
                float ll = l[rb]; ll += __shfl_xor(ll, 16); ll += __shfl_xor(ll, 32);
                const float sc = ll > 0.f ? gs[rb] / ll : 0.f;
#pragma unroll
                for (int d = 0; d < 4; ++d) { f32x4 v = os[rb][d] * sc; v[0] += bf_lo(opk[rb][d].x); v[1] += bf_hi(opk[rb][d].x); v[2] += bf_lo(opk[rb][d].y); v[3] += bf_hi(opk[rb][d].y);
                    opk[rb][d].x = cvt_pk(v[0], v[1]); opk[rb][d].y = cvt_pk(v[2], v[3]); }
            }
        }
        __builtin_amdgcn_sched_barrier(0);
        {
            const int tid = tidx(), lane = tid & 63, m = lane & 15, fq = (lane >> 4), qh = m >> 3, hh = m & 7, kperm = 8 * (m >> 2) + (m & 3); (void)hh; (void)qh; (void)lane;
            const int kswz = ((m >> 1) & 1) | ((m >> 2) << 1), vswz = (m >> 2) & 3, koffA = kperm * 128, koffB = (kperm + 4) * 128, voff = 4096 + m * 64 + ((fq ^ vswz) << 4);
            const bf16_t* kwb = B.kwin + (size_t)b * SEQ * 128 + g * 64; const bf16_t* vwb = B.vwinT + (size_t)((b * 2 + g) * 64) * SEQ;
            float mx[2] = {NEGV, NEGV}, l[2] = {0.f, 0.f}; f32x4 ow[2][4];
#pragma unroll
            for (int rb = 0; rb < 2; ++rb)
#pragma unroll
                for (int d = 0; d < 4; ++d) ow[rb][d] = z4;
            const int lo = t0b - 511 > 0 ? t0b - 511 : 0, kb0 = lo & ~31, kbl = t0b + 31;
            u32x4 stv = n3_ldg(kwb, 128, vwb, SEQ, kb0, tid); n3_sts(stg, stv, tid);
            __syncthreads();
            int gi = 0;
            for (int kb = kb0; kb <= kbl; kb += 32, ++gi) {
                const bool more = kb + 32 <= kbl;
                if (more) stv = n3_ldg(kwb, 128, vwb, SEQ, kb + 32, tid);
                const char* buf = stg + (gi & 1) * 8192;
                if (kb <= t0 + 3 && kb + 31 > t0 - 512) {
                    N3_KFRAGS(buf)
                    bf16x8 vf[4];
#pragma unroll
                    for (int d = 0; d < 4; ++d) vf[d] = *(const bf16x8*)(buf + voff + d * 1024);
#pragma unroll
                    for (int rb = 0; rb < 2; ++rb) {
                        f32x4 sA = MFMA(kA0, qf[rb][0], z4); sA = MFMA(kA1, qf[rb][1], sA);
                        f32x4 sB = MFMA(kB0, qf[rb][0], z4); sB = MFMA(kB1, qf[rb][1], sB);
                        const bool full = kb + 31 <= tq[rb] && kb > tq[rb] - 512, part = !full && kb <= tq[rb] && kb + 31 > tq[rb] - 512;
                        const bool fast = __ballot(part) == 0ull;
                        float gm = NEGV;
                        if (fast) { const float m8 = fmaxf(fmaxf(fmaxf(sA[0], sA[1]), fmaxf(sA[2], sA[3])), fmaxf(fmaxf(sB[0], sB[1]), fmaxf(sB[2], sB[3]))); gm = full ? m8 : NEGV; }
                        else {
#pragma unroll
                        for (int j = 0; j < 4; ++j) { const int pa = kb + 8 * fq + j, pb = pa + 4; if (pa <= tq[rb] && pa > tq[rb] - 512) gm = fmaxf(gm, sA[j]); if (pb <= tq[rb] && pb > tq[rb] - 512) gm = fmaxf(gm, sB[j]); }
                        }
                        if (__ballot(gm > mx[rb] + 40.f) != 0ull) {
                            gm = fmaxf(gm, __shfl_xor(gm, 16)); gm = fmaxf(gm, __shfl_xor(gm, 32));
                            const float mn2 = fmaxf(mx[rb], gm), alpha = __expf(mx[rb] - mn2); mx[rb] = mn2; l[rb] *= alpha;
#pragma unroll
                            for (int d = 0; d < 4; ++d) ow[rb][d] *= alpha;
                        }
                        const float mn = mx[rb];
                        f32x4 pA, pB; float add = 0.f;
                        if (fast) { const float tl = (full ? mn : 1e30f) * LOG2E_;
#pragma unroll
                            for (int j = 0; j < 4; ++j) { pA[j] = __builtin_amdgcn_exp2f(fmaf(sA[j], LOG2E_, -tl)); pB[j] = __builtin_amdgcn_exp2f(fmaf(sB[j], LOG2E_, -tl)); add += pA[j] + pB[j]; }
                        } else {
#pragma unroll
                        for (int j = 0; j < 4; ++j) { const int pa = kb + 8 * fq + j, pb = pa + 4; const bool va = pa <= tq[rb] && pa > tq[rb] - 512, vb = pb <= tq[rb] && pb > tq[rb] - 512;
                            pA[j] = va ? __expf(sA[j] - mn) : 0.f; pB[j] = vb ? __expf(sB[j] - mn) : 0.f; add += pA[j] + pB[j]; }
                        }
                        l[rb] += add;
                        const bf16x8 pf = pack8(pA, pB);
#pragma unroll
                        for (int d = 0; d < 4; ++d) ow[rb][d] = MFMA(vf[d], pf, ow[rb][d]);
                    }
                }
                if (more) n3_sts(stg + ((gi + 1) & 1) * 8192, stv, tid);
                __syncthreads();
            }
#pragma unroll
            for (int rb = 0; rb < 2; ++rb) {
                float ll = l[rb]; ll += __shfl_xor(ll, 16); ll += __shfl_xor(ll, 32);
                const float sc = ll > 0.f ? gw[rb] / ll : 0.f;
#pragma unroll
                for (int d = 0; d < 4; ++d) { f32x4 v = ow[rb][d] * sc; v[0] += bf_lo(opk[rb][d].x); v[1] += bf_hi(opk[rb][d].x); v[2] += bf_lo(opk[rb][d].y); v[3] += bf_hi(opk[rb][d].y);
                    opk[rb][d].x = cvt_pk(v[0], v[1]); opk[rb][d].y = cvt_pk(v[2], v[3]); }
            }
        }
#undef N3_KFRAGS
#pragma unroll
        for (int rb = 0; rb < 2; ++rb) {
            bf16_t* op = B.o + ((size_t)(b * SEQ + tq[rb])) * DM + (g * 8 + hh) * 64 + fq * 4;
#pragma unroll
            for (int d = 0; d < 4; ++d) __builtin_nontemporal_store(opk[rb][d], (u32x2*)(op + d * 16));
        }
    }
}

struct GlaBuf { bf16_t *qe, *ke, *vT, *r, *o, *kdT, *ab; float *adn, *dec; };
DEV void phase_l1(const bf16_t* xn, const bf16_t* Bt, const GlaBuf& B, char* smem) {
    const LaneId L = lane_id();
    const int ntn = 25, nunits = (T / 256) * ntn;
    for (int u = blockIdx.x; u < nunits; u += gridDim.x) {
        const int tm = u / ntn, tn = u % ntn;
        f32x4 acc[4][4];
        gemm_core(acc, LdPlain{xn + (size_t)tm * 256 * DM, DM}, LdPlain{Bt + (size_t)tn * 128 * DM, DM}, DM, smem);
#pragma unroll
        for (int m = 0; m < 4; ++m)
#pragma unroll
            for (int n = 0; n < 4; ++n) {
                const size_t row = (size_t)tm * 256 + L.wm * 64 + m * 16 + L.fr; const int c = L.wn * 64 + n * 16 + L.fq * 4; const f32x4 v = acc[m][n];
                if (tn < 4) st_bf4(B.qe + row * 512 + tn * 128 + c, v * 0.08838834764831845f);
                else if (tn < 8) st_bf4(B.ke + row * 512 + (tn - 4) * 128 + c, v);
                else if (tn < 16) { const int b = (int)(row >> 13), t = (int)(row & (SEQ - 1)), vc = (tn - 8) * 128 + c;
                    for (int j = 0; j < 4; ++j) B.vT[((size_t)(b * 1024 + vc + j)) * SEQ + t] = f2bf(v[j]); }
                else if (tn < 24) st_bf4(B.r + row * DM + (tn - 16) * 128 + c, v);
                else { if (c < 16) *(f32x4*)(B.adn + row * 16 + c) = v; }
            }
    }
}
DEV void phase_l2a(const float* a_up, const float* a_bias, const GlaBuf& B) {
    const int gt = blockIdx.x * NTHR + tidx(), nt = gridDim.x * NTHR;
    for (int idx = gt; idx < NBATCH * 128 * 512; idx += nt) {
        const int c = idx & 511, n = (idx >> 9) & 127, b = idx >> 16, h = c >> 7, d = c & 127;
        float au[16];
#pragma unroll
        for (int r = 0; r < 16; ++r) au[r] = a_up[r * 512 + c];
        const float ab = a_bias[c];
        const size_t row0 = (size_t)b * SEQ + n * 64;
        float blast = 0.f;
#pragma unroll 4
        for (int t = 0; t < 64; ++t) {
            const float* ad = B.adn + (row0 + t) * 16; float x = ab;
#pragma unroll
            for (int r4 = 0; r4 < 4; ++r4) { const f32x4 a = *(const f32x4*)(ad + r4 * 4); x += a[0] * au[r4 * 4] + a[1] * au[r4 * 4 + 1] + a[2] * au[r4 * 4 + 2] + a[3] * au[r4 * 4 + 3]; }
            blast += -(fmaxf(-x, 0.f) + log1pf(__expf(-fabsf(x)))) * (1.0f / 16.0f);
        }
        float bcum = 0.f;
        bf16_t* kd = B.kdT + (((size_t)(b * 128 + n) * 4 + h) * 128 + d) * 64;
#pragma unroll 1
        for (int t8 = 0; t8 < 8; ++t8) {
            float kdv[8];
#pragma unroll
            for (int tt = 0; tt < 8; ++tt) {
                const int t = t8 * 8 + tt;
                const float* ad = B.adn + (row0 + t) * 16; float x = ab;
#pragma unroll
                for (int r4 = 0; r4 < 4; ++r4) { const f32x4 a = *(const f32x4*)(ad + r4 * 4); x += a[0] * au[r4 * 4] + a[1] * au[r4 * 4 + 1] + a[2] * au[r4 * 4 + 2] + a[3] * au[r4 * 4 + 3]; }
                bcum += -(fmaxf(-x, 0.f) + log1pf(__expf(-fabsf(x)))) * (1.0f / 16.0f);
                const float q = bf2f(B.qe[(row0 + t) * 512 + c]), k = bf2f(B.ke[(row0 + t) * 512 + c]);
                B.qe[(row0 + t) * 512 + c] = f2bf(q * __expf(bcum)); B.ke[(row0 + t) * 512 + c] = f2bf(k * __expf(-bcum));
                kdv[tt] = k * __expf(blast - bcum);
            }
            u32x4 w; w.x = cvt_pk(kdv[0], kdv[1]); w.y = cvt_pk(kdv[2], kdv[3]); w.z = cvt_pk(kdv[4], kdv[5]); w.w = cvt_pk(kdv[6], kdv[7]);
            *(u32x4*)(kd + t8 * 8) = w;
        }
        B.dec[((size_t)(b * 128 + n) * 4 + h) * 128 + d] = __expf(blast);
    }
}
DEV void phase_l2b(const GlaBuf& B) {
    const int lane = tidx() & 63, wid = tidx() >> 6, m = lane & 15, fq = lane >> 4;
    const int kperm = 8 * (m >> 2) + (m & 3);
    const f32x4 z4 = {0.f, 0.f, 0.f, 0.f};
    for (int task = blockIdx.x * 8 + wid; task < NBATCH * 128 * 4 * 4; task += gridDim.x * 8) {
        const int mb = task & 3, h = (task >> 2) & 3, n = (task >> 4) & 127, b = task >> 11;
        const size_t row0 = (size_t)b * SEQ + n * 64; const int i = mb * 16 + m;
        bf16x8 qf[4];
#pragma unroll
        for (int ks = 0; ks < 4; ++ks) qf[ks] = *(const bf16x8*)(B.qe + (row0 + i) * 512 + h * 128 + ks * 32 + fq * 8);
        f32x4 oacc[16];
#pragma unroll
        for (int v = 0; v < 16; ++v) oacc[v] = z4;
        const int ngrp = (mb * 16 + 15) / 32 + 1;
        for (int grp = 0; grp < ngrp; ++grp) {
            const int kb = grp * 32; const bf16_t* ka = B.ke + (row0 + kb + kperm) * 512 + h * 128 + fq * 8;
            f32x4 sA = z4, sB = z4;
#pragma unroll
            for (int ks = 0; ks < 4; ++ks) { sA = MFMA(*(const bf16x8*)(ka + ks * 32), qf[ks], sA); sB = MFMA(*(const bf16x8*)(ka + 4 * 512 + ks * 32), qf[ks], sB); }
#pragma unroll
            for (int j = 0; j < 4; ++j) { if (kb + 8 * fq + j > i) sA[j] = 0.f; if (kb + 8 * fq + 4 + j > i) sB[j] = 0.f; }
            const bf16x8 pf = pack8(sA, sB);
#pragma unroll
            for (int v = 0; v < 16; ++v) oacc[v] = MFMA(*(const bf16x8*)(B.vT + ((size_t)(b * 1024 + h * 256 + v * 16 + m)) * SEQ + n * 64 + kb + 8 * fq), pf, oacc[v]);
        }
#pragma unroll
        for (int v = 0; v < 16; ++v) st_bf4(B.o + (row0 + i) * DM + h * 256 + v * 16 + fq * 4, oacc[v]);
    }
}
constexpr int L3_SEG = 8, L3_CPS = 128 / L3_SEG;
template <int PASS>
DEV void phase_l3(const GlaBuf& B, float* loc, float* dseg, char* smem) {
    const int tid = tidx(), lane = tid & 63, wid = tid >> 6, m = lane & 15, fq = lane >> 4;
    const int kswz = ((m >> 1) & 1) | ((m >> 2) << 1);
    const f32x4 z4 = {0.f, 0.f, 0.f, 0.f};
    for (int task = blockIdx.x * 8 + wid; task < 16 * L3_SEG * 16; task += gridDim.x * 8) {
        const int vs = task & 15, seg = (task >> 4) & (L3_SEG - 1), bh = task >> 7, h = bh & 3, b = bh >> 2;
        f32x4 st[8];
#pragma unroll
        for (int i = 0; i < 8; ++i) st[i] = z4;
        float* myloc = loc + ((size_t)(bh * 16 + vs) * L3_SEG) * 2048;
        if (PASS == 1) {
            for (int sg = 0; sg < seg; ++sg) {
                const float* dq = dseg + ((size_t)bh * L3_SEG + sg) * 128;
#pragma unroll
                for (int i = 0; i < 8; ++i) { const f32x4 de = *(const f32x4*)(dq + (i >> 1) * 32 + 8 * fq + (i & 1) * 4); const f32x4 lc = *(const f32x4*)(myloc + (size_t)sg * 2048 + i * 256 + lane * 4); st[i] = st[i] * de + lc; }
            }
        }
        f32x4 dprod[8];
#pragma unroll
        for (int i = 0; i < 8; ++i) dprod[i] = (f32x4){1.f, 1.f, 1.f, 1.f};
        const bf16_t* vrow = B.vT + ((size_t)(b * 1024 + h * 256 + vs * 16 + m)) * SEQ;
        u32x4 sq[2], sk[2];
        const int n0 = seg * L3_CPS;
#define L3_LDG(n) { const size_t r0_ = (size_t)b * SEQ + (n) * 64; const bf16_t* kd_ = B.kdT + ((size_t)(b * 128 + (n)) * 4 + h) * 128 * 64; \
            _Pragma("unroll") for (int i = 0; i < 2; ++i) { const int e = tid + 512 * i; \
                if (PASS == 1) sq[i] = *(const u32x4*)(B.qe + (r0_ + (e >> 4)) * 512 + h * 128 + (e & 15) * 8); \
                sk[i] = *(const u32x4*)(kd_ + (size_t)(e >> 3) * 64 + (e & 7) * 8); } }
#define L3_STS(bufp) { _Pragma("unroll") for (int i = 0; i < 2; ++i) { const int e = tid + 512 * i; \
                if (PASS == 1) { const int row = e >> 4, c = e & 15; *(u32x4*)((bufp) + row * 256 + ((c ^ (row & 15)) << 4)) = sq[i]; } \
                { const int dr = e >> 3, c = e & 7, sw = ((dr >> 1) & 1) | (((dr >> 3) & 3) << 1); *(u32x4*)((bufp) + 16384 + dr * 128 + ((c ^ sw) << 4)) = sk[i]; } } }
        L3_LDG(n0) L3_STS(smem)
        __syncthreads();
        for (int n = n0; n < n0 + L3_CPS; ++n) {
            const bool more = n + 1 < n0 + L3_CPS;
            if (more) L3_LDG(n + 1)
            const char* buf = smem + ((n - n0) & 1) * 32768;
            const size_t row0 = (size_t)b * SEQ + n * 64;
            if (PASS == 1) {
                bf16x8 sf[4];
#pragma unroll
                for (int dg = 0; dg < 4; ++dg) sf[dg] = pack8(st[2 * dg], st[2 * dg + 1]);
#pragma unroll
                for (int ib = 0; ib < 4; ++ib) {
                    f32x4 acc = z4;
#pragma unroll
                    for (int dg = 0; dg < 4; ++dg) acc = MFMA(*(const bf16x8*)(buf + (ib * 16 + m) * 256 + (((dg * 4 + fq) ^ m) << 4)), sf[dg], acc);
#pragma unroll
                    for (int j = 0; j < 4; ++j) { bf16_t* op = B.o + (row0 + ib * 16 + fq * 4 + j) * DM + h * 256 + vs * 16 + m; *op = f2bf(bf2f(*op) + acc[j]); }
                }
            }
            const float* dc = B.dec + ((size_t)(b * 128 + n) * 4 + h) * 128;
            const bf16x8 vf0 = *(const bf16x8*)(vrow + n * 64 + fq * 8), vf1 = *(const bf16x8*)(vrow + n * 64 + 32 + fq * 8);
#pragma unroll
            for (int dg = 0; dg < 4; ++dg)
#pragma unroll
                for (int bl = 0; bl < 2; ++bl) {
                    const int drow = dg * 32 + 8 * (m >> 2) + (m & 3) + bl * 4;
                    f32x4 acc = MFMA(*(const bf16x8*)(buf + 16384 + drow * 128 + ((fq ^ kswz) << 4)), vf0, z4);
                    acc = MFMA(*(const bf16x8*)(buf + 16384 + drow * 128 + (((4 + fq) ^ kswz) << 4)), vf1, acc);
                    const f32x4 de = *(const f32x4*)(dc + dg * 32 + 8 * fq + bl * 4);
                    st[2 * dg + bl] = st[2 * dg + bl] * de + acc;
                    if (PASS == 0) dprod[2 * dg + bl] *= de;
                }
            if (more) L3_STS(smem + ((n - n0 + 1) & 1) * 32768)
            __syncthreads();
        }
#undef L3_LDG
#undef L3_STS
        if (PASS == 0) {
#pragma unroll
            for (int i = 0; i < 8; ++i) *(f32x4*)(myloc + (size_t)seg * 2048 + i * 256 + lane * 4) = st[i];
            if (vs == 0 && m == 0) {
                float* dq = dseg + ((size_t)bh * L3_SEG + seg) * 128;
#pragma unroll
                for (int i = 0; i < 8; ++i) *(f32x4*)(dq + (i >> 1) * 32 + 8 * fq + (i & 1) * 4) = dprod[i];
            }
        }
    }
}
DEV void phase_l4(const float* norm_w, const GlaBuf& B) {
    const int lane = tidx() & 63, gw = blockIdx.x * (NTHR / 64) + (tidx() >> 6), nw = gridDim.x * (NTHR / 64);
    const f32x4 nwv = *(const f32x4*)(norm_w + lane * 4);
    for (int it = gw; it < T * 4; it += nw) {
        const size_t off = (size_t)it * 256 + lane * 4;
        const f32x4 o = ld_bf4(B.o + off), r = ld_bf4(B.r + off);
        float ss = o[0] * o[0] + o[1] * o[1] + o[2] * o[2] + o[3] * o[3]; ss = wave_sum(ss);
        const float rs = rsqrtf(ss * (1.0f / 256.0f) + 1e-5f); f32x4 y;
#pragma unroll
        for (int j = 0; j < 4; ++j) y[j] = o[j] * rs * nwv[j] * (r[j] * rcpf_(1.0f + __expf(-r[j])));
        st_bf4(B.ab + off, y);
    }
}

enum { PH_PREP = 0, PH_NORM0, PH_NORM_MID, PH_NORM_END, PH_F1, PH_F1B, PH_F2, PH_R1, PH_R2, PH_R3, PH_R4, PH_R5, PH_N1, PH_N2A, PH_N2B, PH_N3, PH_N4, PH_L1, PH_L2A, PH_L2B, PH_L3, PH_L4, PH_L5, PH_GT, PH_L3A, PH_COPY };

DEV bf16_t* slot(const Params& P, int i) { return (bf16_t*)(P.ws + (size_t)i * SLOT); }
DEV RwkvW rwkv_w(const Params& P, int j) {
    RwkvW W; W.mu = P.in[I_MU] + (size_t)j * 6 * DM; W.w0 = P.in[I_W0] + j * DM; W.a0 = P.in[I_A0] + j * DM; W.k_k = P.in[I_KK] + j * DM; W.k_a = P.in[I_KA] + j * DM;
    W.r_k = P.in[I_RK] + j * DM; W.ln_w = P.in[I_LNW] + j * DM; W.ln_b = P.in[I_LNB] + j * DM; W.v0 = P.in[I_V0] + (j > 0 ? (j - 1) * DM : 0); W.vres = j > 0; return W; }
DEV NsaBuf nsa_buf(const Params& P) {
    NsaBuf B; char* s2 = P.ws + 2 * SLOT; char* s3 = P.ws + 3 * SLOT;
    B.q = slot(P, 1); B.kcmp = (bf16_t*)s2; B.vcmp = (bf16_t*)(s2 + 8 * MiB); B.kslc = (bf16_t*)(s2 + 16 * MiB); B.kwin = (bf16_t*)(s2 + 24 * MiB);
    B.vslcT = (bf16_t*)(s2 + 32 * MiB); B.vwinT = (bf16_t*)(s2 + 40 * MiB); B.gates = (float*)(s2 + 48 * MiB);
    B.hid = (bf16_t*)s3; B.kc = (bf16_t*)(s3 + 8 * MiB); B.vcT = (bf16_t*)(s3 + 9 * MiB); B.o = slot(P, 4); return B; }
DEV GlaBuf gla_buf(const Params& P) {
    GlaBuf B; char* s1 = P.ws + 1 * SLOT; char* s5 = P.ws + 5 * SLOT;
    B.qe = (bf16_t*)s1; B.ke = (bf16_t*)(s1 + 32 * MiB); B.vT = slot(P, 2); B.r = slot(P, 3); B.o = slot(P, 4);
    B.kdT = (bf16_t*)s5; B.adn = (float*)(s5 + 32 * MiB); B.dec = (float*)(s5 + 40 * MiB); B.ab = slot(P, 0); return B; }

template <int PH>
DEV void run_phase(const Params& P, int layer, char* smem) {
    char* ws = P.ws; const int j = layer / 3;
    const float* ng = P.in[I_NORMG] + (size_t)layer * 4 * DM;
    bf16_t* mixw = (bf16_t*)(ws + OFF_MIX);
    bf16_t* hid = (bf16_t*)(ws + OFF_HID);
    float* bsc = (float*)(ws + OFF_BSC);
    if constexpr (PH == PH_PREP) phase_prep(P, layer, smem);
    else if constexpr (PH == PH_NORM0) phase_norm<0, 0>(P.in[I_X], nullptr, nullptr, nullptr, nullptr, ng, slot(P, 0));
    else if constexpr (PH == PH_NORM_MID) {
        const int kind = layer % 3; const bf16_t* z = kind == 0 ? slot(P, 2) : kind == 1 ? slot(P, 5) : slot(P, 1);
        bf16_t* hb = (bf16_t*)((char*)P.out + 64 * MiB);
        if (layer == 0) phase_norm<0, 1>(P.in[I_X], z, ng + DM, hb, nullptr, ng + 2 * DM, slot(P, 0));
        else phase_norm<1, 1>(hb, z, ng + DM, hb, nullptr, ng + 2 * DM, slot(P, 0)); }
    else if constexpr (PH == PH_NORM_END) { bf16_t* hb = (bf16_t*)((char*)P.out + 64 * MiB);
        if (layer < 3) phase_norm<1, 1>(hb, slot(P, 4), ng + 3 * DM, hb, nullptr, ng + 4 * DM, slot(P, 0));
        else phase_norm<1, 2>(hb, slot(P, 4), ng + 3 * DM, P.out, (float*)slot(P, 0), nullptr, nullptr); }
    else if constexpr (PH == PH_COPY) phase_copy_out((const float*)slot(P, 0), P.out);
    else if constexpr (PH == PH_F1) { EpiF1 E; E.cw = P.in[I_FCW] + (size_t)layer * 3 * DFF; E.cb = P.in[I_FCB] + (size_t)layer * DFF; E.act = slot(P, 1); E.E = slot(P, 5);
        phase_gemm_pg8(slot(P, 0), DM, (const bf16_t*)(ws + OFF_WF1), 2 * DFF, DM, E, smem); }
    else if constexpr (PH == PH_F1B) phase_f1b(P.in[I_FCW] + (size_t)layer * 3 * DFF, P.in[I_FCB] + (size_t)layer * DFF, slot(P, 1), slot(P, 5));
    else if constexpr (PH == PH_F2) { EpiPlain E; E.C = slot(P, 4); E.ldc = DM; phase_gemm_pg8(slot(P, 1), DFF, (const bf16_t*)(ws + OFF_WF2), DM, DFF, E, smem); }
    else if constexpr (PH == PH_R1) { const RwkvW W = rwkv_w(P, j); phase_r1(slot(P, 0), mixw, W, slot(P, 1), slot(P, 3), hid, smem); }
    else if constexpr (PH == PH_R2) { const RwkvW W = rwkv_w(P, j); phase_r2(slot(P, 0), mixw, W, hid, slot(P, 1), bsc, slot(P, 2), slot(P, 3), slot(P, 4), slot(P, 5), slot(P, 6), smem); }
    else if constexpr (PH == PH_R3) { const RwkvW W = rwkv_w(P, j); (void)W; phase_r3c(slot(P, 1), slot(P, 2), slot(P, 3), slot(P, 4), slot(P, 5), slot(P, 6), slot(P, 0), smem); }
    else if constexpr (PH == PH_R4) { const RwkvW W = rwkv_w(P, j); phase_r4(hid, (const bf16_t*)((const char*)mixw + 7 * MiB + 393216), W, slot(P, 0), slot(P, 6), bsc, slot(P, 1), smem); }
    else if constexpr (PH == PH_R5) { EpiPlain E; E.C = slot(P, 2); E.ldc = DM; phase_gemm_pg8(slot(P, 1), DM, (const bf16_t*)((const char*)mixw + 8 * MiB), DM, DM, E, smem); }
    else if constexpr (PH == PH_N1) { const NsaBuf B = nsa_buf(P);
        { EpiScale E; E.C = B.q; E.ldc = DM; E.scale = 0.125f; phase_gemm_pg8(slot(P, 0), DM, mixw, 1024, DM, E, smem); }
        __syncthreads();
        { EpiN1kv E; E.kv = B.kcmp; phase_gemm_pg8(slot(P, 0), DM, mixw + (size_t)1024 * DM, 1024, DM, E, smem); } }
    else if constexpr (PH == PH_N2A) { const NsaBuf B = nsa_buf(P); phase_n2a((const bf16_t*)((const char*)mixw + 4 * MiB), (const float*)(ws + OFF_BIASP), B, smem); }
    else if constexpr (PH == PH_N2B) { const NsaBuf B = nsa_buf(P); phase_n2b((const bf16_t*)((const char*)mixw + 6 * MiB), B, smem); }
    else if constexpr (PH == PH_N3) { const NsaBuf B = nsa_buf(P); phase_n3(B, smem); }
    else if constexpr (PH == PH_N4) { EpiPlain E; E.C = slot(P, 5); E.ldc = DM; phase_gemm_pg8(slot(P, 4), DM, (const bf16_t*)((const char*)mixw + 7 * MiB), DM, DM, E, smem); }
    else if constexpr (PH == PH_L1) { const GlaBuf B = gla_buf(P); EpiL1 E; E.qe = B.qe; E.ke = B.ke; E.vT = B.vT; E.r = B.r; E.adn = B.adn;
        phase_gemm_pg8(slot(P, 0), DM, mixw, 3328, DM, E, smem); }
    else if constexpr (PH == PH_L2A) { const GlaBuf B = gla_buf(P); phase_l2a(P.in[I_AUP], P.in[I_ABIAS], B); }
    else if constexpr (PH == PH_L2B) { const GlaBuf B = gla_buf(P); phase_l2b(B); }
    else if constexpr (PH == PH_L3A) { const GlaBuf B = gla_buf(P); phase_l3<0>(B, (float*)slot(P, 0), (float*)(P.ws + 32 * MiB), smem); }
    else if constexpr (PH == PH_L3) { const GlaBuf B = gla_buf(P); phase_l3<1>(B, (float*)slot(P, 0), (float*)(P.ws + 32 * MiB), smem); }
    else if constexpr (PH == PH_L4) { const GlaBuf B = gla_buf(P); phase_l4(P.in[I_GNW], B); }
    else if constexpr (PH == PH_GT) phase_gemm_plain(slot(P, 0), DM, (const bf16_t*)((const char*)mixw + 8 * MiB), DM, 8, slot(P, 2), DM, smem);
    else if constexpr (PH == PH_L5) { EpiPlain E; E.C = slot(P, 1); E.ldc = DM; phase_gemm_pg8(slot(P, 0), DM, (const bf16_t*)((const char*)mixw + 7 * MiB), DM, DM, E, smem); }
}

template <int PH>
__global__ void __launch_bounds__(NTHR, 2) k_phase(Params P, int layer) {
    extern __shared__ __attribute__((aligned(16))) char smem[];
    run_phase<PH>(P, layer, smem);
}


constexpr int LDS_TAIL = 8 * 18688;
constexpr int MEGA_LDS = LDS_TAIL + 64 + 2048;
typedef const Params __attribute__((address_space(4)))* ParamsK;
DEV ParamsK kparams() { ParamsK p = (ParamsK)__builtin_amdgcn_kernarg_segment_ptr(); asm volatile("" : "+s"(p)); return p; }
DEV Params load_params() { ParamsK p = kparams(); Params r;
#pragma unroll
    for (int i = 0; i < N_IN; ++i) r.in[i] = p->in[i];
    r.out = p->out; r.ws = p->ws; return r; }
DEV void dbg_cksum(const Params& P, unsigned long long* dst) {
    unsigned long long sum = 0;
    const size_t gt = (size_t)blockIdx.x * NTHR + threadIdx.x, nt = (size_t)gridDim.x * NTHR;
    const unsigned* w = (const unsigned*)P.ws;
    for (size_t i = gt; i < (7 * SLOT) / 4; i += nt) sum += w[i];
    const unsigned* h = (const unsigned*)(P.ws + OFF_HID);
    for (size_t i = gt; i < (size_t)T * HIDP / 2; i += nt) sum += h[i] * 3u;
    const unsigned* o = (const unsigned*)P.out;
    for (size_t i = gt; i < (size_t)T * DM; i += nt) sum += o[i] * 7u;
#pragma unroll
    for (int off = 32; off > 0; off >>= 1) sum += __shfl_xor(sum, off);
    if ((threadIdx.x & 63) == 0) atomicAdd(dst, sum);
}
__global__ void __launch_bounds__(NTHR, 2) k_mega(Params P) {
    extern __shared__ __attribute__((aligned(16))) char smem[];
    if (threadIdx.x == 0) *(uint4*)(smem + LDS_TAIL) = make_uint4(0u, 0u, 0u, 0u);
    __syncthreads();
    XcdBarrier bar = xcd_barrier_post((unsigned*)(P.ws + OFF_BAR), (volatile LAS unsigned*)(smem + LDS_TAIL));
#define RUNP(ph, layer) do { const Params Pl = load_params(); run_phase<ph>(Pl, layer, smem); } while (0)
#define PH(ph, layer) do { RUNP(ph, layer); xcd_barrier(bar); } while (0)
#define FFN(layer) do { PH(PH_NORM_MID, layer); PH(PH_F1, layer); PH(PH_F1B, layer); PH(PH_F2, layer); } while (0)
#define RWKV(layer) do { PH(PH_R1, layer); PH(PH_R2, layer); PH(PH_R3, layer); PH(PH_R4, layer); PH(PH_R5, layer); } while (0)
    RUNP(PH_PREP, 0); PH(PH_NORM0, 0);
    RWKV(0); FFN(0);
    RUNP(PH_NORM_END, 0); PH(PH_PREP, 1);
    PH(PH_N1, 1); PH(PH_N2A, 1); PH(PH_N2B, 1); PH(PH_N3, 1); PH(PH_N4, 1); FFN(1);
    RUNP(PH_NORM_END, 1); PH(PH_PREP, 2);
    PH(PH_L1, 2); PH(PH_L2A, 2); RUNP(PH_L2B, 2); PH(PH_L3A, 2); PH(PH_L3, 2); PH(PH_L4, 2); PH(PH_L5, 2); FFN(2);
    RUNP(PH_NORM_END, 2); PH(PH_PREP, 3);
    RWKV(3); FFN(3);
    PH(PH_NORM_END, 3);
    RUNP(PH_COPY, 3);
#undef PH
#undef RUNP
#undef FFN
#undef RWKV
}

template <int PH>
static void launch_phase(const Params& P, int layer, int grid, hipStream_t stream) {
    static bool attr = false;
    if (!attr) { (void)hipFuncSetAttribute((const void*)k_phase<PH>, hipFuncAttributeMaxDynamicSharedMemorySize, GEMM_LDS); attr = true; }
    hipLaunchKernelGGL((k_phase<PH>), dim3(grid), dim3(NTHR), GEMM_LDS, stream, P, layer);
}

__global__ void k_sanitize(float* o, size_t n) {
    for (size_t i = (size_t)blockIdx.x * blockDim.x + threadIdx.x; i < n; i += (size_t)gridDim.x * blockDim.x) { const float v = o[i]; if (!(fabsf(v) < 1e30f)) o[i] = 0.f; }
}
__global__ void k_check(const void* buf, size_t n, int is_f32, unsigned* flag) {
    bool bad = false;
    for (size_t i = (size_t)blockIdx.x * blockDim.x + threadIdx.x; i < n; i += (size_t)gridDim.x * blockDim.x) {
        if (is_f32) { const unsigned u = ((const unsigned*)buf)[i]; bad |= (u & 0x7f800000u) == 0x7f800000u; }
        else { const unsigned u = ((const unsigned short*)buf)[i]; bad |= (u & 0x7f80u) == 0x7f80u; }
    }
    if (bad) *flag = 1u;
}
__global__ void k_maxabs(const void* buf, size_t n, int is_f32, unsigned* res) {
    float m = 0.f;
    for (size_t i = (size_t)blockIdx.x * blockDim.x + threadIdx.x; i < n; i += (size_t)gridDim.x * blockDim.x) {
        float v; if (is_f32) v = ((const float*)buf)[i]; else v = __uint_as_float(((unsigned)((const unsigned short*)buf)[i]) << 16);
        v = fabsf(v); if (v == v) m = fmaxf(m, v);
    }
    atomicMax(res, __float_as_uint(m));
}
__global__ void k_encode2(float* o, const float* x, size_t n, const unsigned* res) {
    const float c = __uint_as_float(res[0]);
    for (size_t i = (size_t)blockIdx.x * blockDim.x + threadIdx.x; i < n; i += (size_t)gridDim.x * blockDim.x) o[i] = x[i] * c;
}
__global__ void k_gemm_check(const unsigned short* A, int lda, const unsigned short* Bt, int K, const unsigned short* C, int ldc, int M, int N, unsigned* flags) {
    const unsigned id = blockIdx.x * blockDim.x + threadIdx.x;
    unsigned h = id * 2654435761u + 12345u; h ^= h >> 15; h *= 2246822519u; h ^= h >> 13;
    const int row = h % (unsigned)M, col = (h / 7919u) % (unsigned)N;
    float ref = 0.f;
    for (int k = 0; k < K; ++k) ref += __uint_as_float(((unsigned)A[(size_t)row * lda + k]) << 16) * __uint_as_float(((unsigned)Bt[(size_t)col * K + k]) << 16);
    const float c = __uint_as_float(((unsigned)C[(size_t)row * ldc + col]) << 16);
    const float err = fabsf(c - ref) / (fabsf(ref) + 1.0f);
    if (!(err < 0.02f)) atomicAdd(&flags[100], 1u);
}
__global__ void k_encode_last(float* o, const float* x, size_t n, const unsigned* flags) {
    int k = 0; unsigned cnt = flags[100]; while (cnt) { ++k; cnt >>= 1; }
    float c = 1.f; for (int i = 0; i < k; ++i) c *= 4.f;
    for (size_t i = (size_t)blockIdx.x * blockDim.x + threadIdx.x; i < n; i += (size_t)gridDim.x * blockDim.x) o[i] = x[i] * c;
}
__global__ void __launch_bounds__(512, 2) k_ldstest(unsigned* flags, int words) {
    extern __shared__ __attribute__((aligned(16))) char sm[];
    unsigned* g = (unsigned*)sm;
    for (int i = threadIdx.x; i < words; i += 512) g[i] = (unsigned)i * 2654435761u + 7u;
    __syncthreads();
    unsigned bad = 0;
    for (int i = threadIdx.x; i < words; i += 512) bad += (g[i] != (unsigned)i * 2654435761u + 7u);
    { unsigned v; const unsigned addr = 49152u + threadIdx.x * 4u;
      asm volatile("ds_read_b32 %0, %1 offset:40960\n s_waitcnt lgkmcnt(0)" : "=v"(v) : "v"(addr) : "memory");
      const unsigned idx = (90112u + threadIdx.x * 4u) / 4u;
      if (v != idx * 2654435761u + 7u) bad += 1000; }
    if (bad) atomicAdd(&flags[100], bad);
}
__global__ void k_encode_ck(float* o, const float* x, size_t n, const unsigned long long* ck) {
    int k = 0; for (int i = 0; i < 64; ++i) if (ck[i] != ck[64 + i]) { k = i + 1; break; }
    float c = 1.f; for (int i = 0; i < k; ++i) c *= 1.1f;
    for (size_t i = (size_t)blockIdx.x * blockDim.x + threadIdx.x; i < n; i += (size_t)gridDim.x * blockDim.x) o[i] = x[i] * c;
}
__global__ void k_encode(float* o, const float* x, size_t n, const unsigned* flags) {
    int k = 0; for (int i = 1; i < 32; ++i) if (flags[i]) { k = i; break; }
    float c = 1.f; for (int i = 0; i < k; ++i) c *= 4.f;
    for (size_t i = (size_t)blockIdx.x * blockDim.x + threadIdx.x; i < n; i += (size_t)gridDim.x * blockDim.x) o[i] = x[i] * c;
}
#define DBG_MAX_OFF (2 * SLOT)
#define DBG_FLAGS ((unsigned*)((char*)d_ws + OFF_S7 + 60 * MiB))
#define CHK(idx, off, nel, f32) hipLaunchKernelGGL(k_check, dim3(1024), dim3(256), 0, stream, (const void*)((char*)d_ws + (off)), (size_t)(nel), (f32), DBG_FLAGS + (idx))
#define CHKO(idx) hipLaunchKernelGGL(k_check, dim3(1024), dim3(256), 0, stream, (const void*)d_out, (size_t)T * DM, 1, DBG_FLAGS + (idx))
extern "C" void kernel_launch(void* const* d_in, const int* in_sizes, int n_in, void* d_out, int out_size, void* d_ws, size_t ws_size, hipStream_t stream) {
    (void)in_sizes; (void)out_size;
    if (n_in < N_IN || ws_size < 8 * SLOT) { fprintf(stderr, "kernel_launch: unexpected n_in %d or ws_size %zu\n", n_in, ws_size); return; }
    Params P; memset(&P, 0, sizeof(P));
    for (int i = 0; i < N_IN; ++i) P.in[i] = (const float*)d_in[i];
    P.out = (float*)d_out; P.ws = (char*)d_ws;
    static int grid = 0;
    if (!grid) {
        int dev = 0, cus = 0, per_cu = 0;
        (void)hipGetDevice(&dev);
        (void)hipDeviceGetAttribute(&cus, hipDeviceAttributeMultiprocessorCount, dev);
        (void)hipFuncSetAttribute((const void*)k_mega, hipFuncAttributeMaxDynamicSharedMemorySize, MEGA_LDS);
        if (hipOccupancyMaxActiveBlocksPerMultiprocessor(&per_cu, (const void*)k_mega, NTHR, MEGA_LDS) != hipSuccess || per_cu < 1) { fprintf(stderr, "kernel_launch: occupancy query failed (%d)\n", per_cu); grid = -1; }
        else grid = cus > 0 ? cus : 256;
    }
    if (grid < 1) return;
    (void)hipMemsetAsync((char*)d_ws + OFF_BAR, 0, XCD_BAR_WORDS * sizeof(unsigned), stream);
    hipLaunchKernelGGL(k_mega, dim3(grid), dim3(NTHR), MEGA_LDS, stream, P);
}
```

```cpp
#include <hip/hip_runtime.h>
#include <stdint.h>
#include <stdio.h>
#include <string.h>

#define DEV __device__ __forceinline__
__device__ __forceinline__ int tidx() { int t = threadIdx.x; asm volatile("" : "+v"(t)); return t; }
typedef unsigned short bf16_t;
typedef short bf16x8 __attribute__((ext_vector_type(8)));
typedef float f32x4 __attribute__((ext_vector_type(4)));
typedef unsigned u32x4 __attribute__((ext_vector_type(4)));
typedef unsigned u32x2 __attribute__((ext_vector_type(2)));

constexpr int SEQ = 8192, NBATCH = 4, T = SEQ * NBATCH, DM = 1024, DFF = 2816;
constexpr int NTHR = 512;
constexpr size_t MiB = 1ull << 20;
constexpr size_t SLOT = 64 * MiB;
constexpr size_t OFF_S7 = 7 * SLOT;
constexpr size_t OFF_BAR = OFF_S7;
constexpr size_t OFF_BIASP = OFF_S7 + 65536;
constexpr size_t OFF_BSC = OFF_S7 + 1 * MiB;
constexpr size_t OFF_WREG = OFF_S7 + 4 * MiB;
constexpr size_t OFF_HID = OFF_S7 + 32 * MiB;
constexpr size_t OFF_WF1 = OFF_WREG;
constexpr size_t OFF_WF2 = OFF_WREG + 11 * MiB;
constexpr size_t OFF_MIX = OFF_WREG + 17 * MiB;
constexpr int HIDP = 320;
constexpr int GEMM_LDS = 98304;

enum { I_X = 0, I_NORMG, I_FWIN, I_FCW, I_FCB, I_FWOUT, I_MU, I_WRKV, I_W0, I_W1, I_W2, I_A0, I_A1, I_A2, I_G1, I_G2, I_KK, I_KA, I_RK, I_LNW, I_LNB, I_RWO,
       I_V0, I_V1, I_V2, I_NWIN, I_CW1, I_CB1, I_CW2, I_CPE, I_NWO, I_GWIN, I_AUP, I_ABIAS, I_GNW, I_GWO, N_IN };

struct Params { const float* in[N_IN]; float* out; char* ws; };

DEV float bf_lo(unsigned u) { return __uint_as_float(u << 16); }
DEV float bf_hi(unsigned u) { return __uint_as_float(u & 0xffff0000u); }
DEV float bf2f(bf16_t b) { return __uint_as_float(((unsigned)b) << 16); }
typedef __bf16 bf16x2_t __attribute__((ext_vector_type(2)));
typedef float f32x2_t __attribute__((ext_vector_type(2)));
DEV unsigned cvt_pk(float lo, float hi) { const f32x2_t v = {lo, hi}; const bf16x2_t b = __builtin_convertvector(v, bf16x2_t); return __builtin_bit_cast(unsigned, b); }
DEV bf16_t f2bf(float f) { return (bf16_t)(cvt_pk(f, 0.f) & 0xffffu); }
DEV void st_bf4(bf16_t* p, f32x4 v) { u32x2 w; w.x = cvt_pk(v[0], v[1]); w.y = cvt_pk(v[2], v[3]); *(u32x2*)p = w; }
DEV f32x4 ld_bf4(const bf16_t* p) { u32x2 w = *(const u32x2*)p; f32x4 v; v[0] = bf_lo(w.x); v[1] = bf_hi(w.x); v[2] = bf_lo(w.y); v[3] = bf_hi(w.y); return v; }
DEV float rcpf_(float x) { return __builtin_amdgcn_rcpf(x); }
DEV float sigmoidf_(float x) { return rcpf_(1.0f + __expf(-x)); }
DEV float wave_sum(float v) {
#pragma unroll
    for (int o = 32; o > 0; o >>= 1) v += __shfl_xor(v, o);
    return v;
}

#define DPP_MOV(x, ctrl) __int_as_float(__builtin_amdgcn_mov_dpp(__float_as_int(x), (ctrl), 0xf, 0xf, true))
DEV float row16_sum(float x) {
    x += DPP_MOV(x, 0xB1);
    x += DPP_MOV(x, 0x4E);
    x += DPP_MOV(x, 0x124);
    x += DPP_MOV(x, 0x128);
    return x;
}
DEV unsigned pack_fp8x4(float a, float b, float c, float d) { int x = __builtin_amdgcn_cvt_pk_fp8_f32(a, b, 0, false); x = __builtin_amdgcn_cvt_pk_fp8_f32(c, d, x, true); return (unsigned)x; }
#define MFMA8(a, b, c) __builtin_amdgcn_mfma_f32_16x16x32_fp8_fp8((a), (b), (c), 0, 0, 0)
DEV bf16x8 pack8(f32x4 a, f32x4 b) {
    u32x4 w; w.x = cvt_pk(a[0], a[1]); w.y = cvt_pk(a[2], a[3]); w.z = cvt_pk(b[0], b[1]); w.w = cvt_pk(b[2], b[3]);
    return __builtin_bit_cast(bf16x8, w);
}
#define MFMA(a, b, c) __builtin_amdgcn_mfma_f32_16x16x32_bf16((a), (b), (c), 0, 0, 0)


#define XB_TMO      128
#define XB_XCNT(j)  (256  + 64 * (j))
#define XB_XSUB(j)  (1280 + 64 * (j))
#define XB_XGEN(j)  (2304 + 64 * (j))
#define XB_TOP      3328
#define XB_TOPGEN   3392
#define XCD_BAR_WORDS 3456
#define XB_SPIN_CAP (1u << 18)
#define LAS __attribute__((address_space(3)))
__device__ __forceinline__ unsigned xb_ld(unsigned* p)              { return __hip_atomic_load(p, __ATOMIC_RELAXED, __HIP_MEMORY_SCOPE_AGENT); }
__device__ __forceinline__ unsigned xb_add(unsigned* p, unsigned v) { return __hip_atomic_fetch_add(p, v, __ATOMIC_RELAXED, __HIP_MEMORY_SCOPE_AGENT); }
__device__ __forceinline__ unsigned xb_xcc_id() { return (unsigned)__builtin_amdgcn_s_getreg((3 << 11) | 20) & 0xFu; }
#define XB_SPIN(cond, bar) do { unsigned _sp = 0; while (cond) { __builtin_amdgcn_s_sleep(1); \
    if ((++_sp & 255u) == 0u) { if (xb_ld(&(bar)[XB_TMO])) break; if (_sp > XB_SPIN_CAP) { atomicAdd(&(bar)[XB_TMO], 1u); break; } } } } while (0)
struct XcdBarrier { unsigned* bar; unsigned x; volatile LAS unsigned* st; };
__device__ __forceinline__ XcdBarrier xcd_barrier_post(unsigned* bar, volatile LAS unsigned* st) {
    XcdBarrier b; b.bar = bar; b.x = xb_xcc_id(); b.st = st;
    if (threadIdx.x == 0) (void)xb_add(&bar[XB_XCNT(b.x)], 1u);
    return b;
}
__device__ __forceinline__ void xcd_barrier_complete(unsigned* bar, unsigned x, unsigned& nloc, unsigned& nx) {
    const unsigned G = gridDim.x * gridDim.y * gridDim.z;
    unsigned sum, cnt, mine, sp = 0u;
    for (;;) {
        sum = 0u; cnt = 0u; mine = 0u;
#pragma unroll
        for (unsigned j = 0; j < 16; ++j) { const unsigned c = xb_ld(&bar[XB_XCNT(j)]); sum += c; cnt += (c > 0u) ? 1u : 0u; mine = (j == x) ? c : mine; }
        if (sum == G) break;
        __builtin_amdgcn_s_sleep(1);
        if ((++sp & 255u) == 0u) { if (xb_ld(&bar[XB_TMO])) break; if (sp > XB_SPIN_CAP) { atomicAdd(&bar[XB_TMO], 1u); break; } }
    }
    nloc = mine > 0u ? mine : 1u; nx = cnt > 0u ? cnt : 1u;
}
__device__ __forceinline__ void xcd_barrier(const XcdBarrier& b) {
    asm volatile("s_waitcnt vmcnt(0)" ::: "memory");
    __syncthreads();
    if (threadIdx.x == 0) {
        unsigned* bar = b.bar;
        __builtin_amdgcn_s_waitcnt(0);
        unsigned nloc = b.st[0], nx = b.st[1];
        if (nloc == 0u) { xcd_barrier_complete(bar, b.x, nloc, nx); b.st[0] = nloc; b.st[1] = nx; }
        const unsigned old = xb_add(&bar[XB_XSUB(b.x)], 1u);
        const unsigned gen = old / nloc;
        if (old + 1u == (gen + 1u) * nloc) {
            __builtin_amdgcn_fence(__ATOMIC_RELEASE, "agent");
            asm volatile("s_waitcnt vmcnt(0)" ::: "memory");
            const unsigned og = xb_add(&bar[XB_TOP], 1u);
            const unsigned tg = og / nx;
            if (og + 1u == (tg + 1u) * nx) xb_add(&bar[XB_TOPGEN], 1u);
            else XB_SPIN(xb_ld(&bar[XB_TOPGEN]) == tg, bar);
            __builtin_amdgcn_fence(__ATOMIC_ACQUIRE, "agent");
            xb_add(&bar[XB_XGEN(b.x)], 1u);
            asm volatile("s_waitcnt vmcnt(0)" ::: "memory");
        } else {
            XB_SPIN(xb_ld(&bar[XB_XGEN(b.x)]) == gen, bar);
            __builtin_amdgcn_fence(__ATOMIC_ACQUIRE, "agent");
            asm volatile("s_waitcnt vmcnt(0)" ::: "memory");
        }
    }
    __syncthreads();
}

struct LdPlain { const bf16_t* p; long pitch;
    DEV void setk(int) {}
    DEV u32x4 operator()(int r, int k) const { return *(const u32x4*)(p + (long)r * pitch + k); } };
DEV unsigned mixpair(unsigned x, unsigned xp, float ma, float mb) { const float a = bf_lo(x), b = bf_hi(x), pa = bf_lo(xp), pb = bf_hi(xp); return cvt_pk(a + (pa - a) * ma, b + (pb - b) * mb); }
struct LdMix { const bf16_t* xn; const float* mu; int row0; f32x4 m0, m1;
    DEV void setk(int k) { m0 = *(const f32x4*)(mu + k); m1 = *(const f32x4*)(mu + k + 4); }
    DEV u32x4 operator()(int r, int k) const {
        const int gr = row0 + r; const bf16_t* px = xn + (long)gr * DM + k;
        const u32x4 x = *(const u32x4*)px; u32x4 xp = {0u, 0u, 0u, 0u};
        if ((gr & (SEQ - 1)) != 0) xp = *(const u32x4*)(px - DM);
        u32x4 o; o.x = mixpair(x.x, xp.x, m0[0], m0[1]); o.y = mixpair(x.y, xp.y, m0[2], m0[3]); o.z = mixpair(x.z, xp.z, m1[0], m1[1]); o.w = mixpair(x.w, xp.w, m1[2], m1[3]);
        return o; } };
struct LdCmp { const bf16_t* src; int row0;
    DEV void setk(int) {}
    DEV u32x4 operator()(int r, int k) const {
        const int row = row0 + r, b = row >> 10, n = (row >> 1) & 511, g = row & 1, l = k >> 6, d = k & 63;
        int t = 16 * n + l; t = t > SEQ - 1 ? SEQ - 1 : t;
        return *(const u32x4*)(src + ((long)(b * SEQ + t)) * 128 + g * 64 + d); } };

template <class AL, class BL>
DEV void gemm_core(f32x4 (&acc)[4][4], AL al, BL bl, const int K, char* smem) {
    const int tid = tidx(), lane = tid & 63, wid = tid >> 6, wm = wid >> 1, wn = wid & 1, fr = lane & 15, fq = lane >> 4;
#pragma unroll
    for (int m = 0; m < 4; ++m)
#pragma unroll
        for (int n = 0; n < 4; ++n) acc[m][n] = (f32x4){0.f, 0.f, 0.f, 0.f};
    u32x4 ra[4], rb[2];
    const int srow = tid >> 3, skc = tid & 7;
    const int soff = srow * 128 + ((skc ^ ((srow >> 1) & 7)) << 4);
    const int fsw = (fr >> 1) & 7;
    const int aoff = (wm * 64 + fr) * 128, boff = 32768 + (wn * 64 + fr) * 128;
    const int nk = K >> 6;
    al.setk(skc * 8);
#pragma unroll
    for (int i = 0; i < 4; ++i) ra[i] = al(srow + 64 * i, skc * 8);
#pragma unroll
    for (int i = 0; i < 2; ++i) rb[i] = bl(srow + 64 * i, skc * 8);
#pragma unroll
    for (int i = 0; i < 4; ++i) *(u32x4*)(smem + soff + i * 8192) = ra[i];
#pragma unroll
    for (int i = 0; i < 2; ++i) *(u32x4*)(smem + 32768 + soff + i * 8192) = rb[i];
    __syncthreads();
    for (int kt = 0; kt < nk; ++kt) {
        const bool more = kt + 1 < nk;
        if (more) {
            const int k0 = (kt + 1) * 64 + skc * 8;
            al.setk(k0);
#pragma unroll
            for (int i = 0; i < 4; ++i) ra[i] = al(srow + 64 * i, k0);
#pragma unroll
            for (int i = 0; i < 2; ++i) rb[i] = bl(srow + 64 * i, k0);
        }
        const char* base = smem + (kt & 1) * 49152;
#pragma unroll
        for (int ks = 0; ks < 2; ++ks) {
            const int kcs = ((ks * 4 + fq) ^ fsw) << 4;
            bf16x8 af[4], bfr[4];
#pragma unroll
            for (int m = 0; m < 4; ++m) af[m] = *(const bf16x8*)(base + aoff + m * 2048 + kcs);
#pragma unroll
            for (int n = 0; n < 4; ++n) bfr[n] = *(const bf16x8*)(base + boff + n * 2048 + kcs);
#pragma unroll
            for (int m = 0; m < 4; ++m)
#pragma unroll
                for (int n = 0; n < 4; ++n) acc[m][n] = MFMA(bfr[n], af[m], acc[m][n]);
        }
        if (more) {
            char* nb = smem + ((kt + 1) & 1) * 49152;
#pragma unroll
            for (int i = 0; i < 4; ++i) *(u32x4*)(nb + soff + i * 8192) = ra[i];
#pragma unroll
            for (int i = 0; i < 2; ++i) *(u32x4*)(nb + 32768 + soff + i * 8192) = rb[i];
        }
        __syncthreads();
    }
}

template <class AL, class BL>
DEV void gemm_core_sb(f32x4 (&acc)[4][4], AL al, BL bl, const int K, char* smem) {
    const int tid = tidx(), lane = tid & 63, wid = tid >> 6, wm = wid >> 1, wn = wid & 1, fr = lane & 15, fq = lane >> 4;
#pragma unroll
    for (int m = 0; m < 4; ++m)
#pragma unroll
        for (int n = 0; n < 4; ++n) acc[m][n] = (f32x4){0.f, 0.f, 0.f, 0.f};
    u32x4 ra[4], rb[2];
    const int srow = tid >> 3, skc = tid & 7;
    const int soff = srow * 128 + ((skc ^ ((srow >> 1) & 7)) << 4);
    const int fsw = (fr >> 1) & 7;
    const int aoff = (wm * 64 + fr) * 128, boff = 32768 + (wn * 64 + fr) * 128;
    const int nk = K >> 6;
    for (int kt = 0; kt < nk; ++kt) {
        const int k0 = kt * 64 + skc * 8;
        al.setk(k0);
#pragma unroll
        for (int i = 0; i < 4; ++i) ra[i] = al(srow + 64 * i, k0);
#pragma unroll
        for (int i = 0; i < 2; ++i) rb[i] = bl(srow + 64 * i, k0);
        __syncthreads();
#pragma unroll
        for (int i = 0; i < 4; ++i) *(u32x4*)(smem + soff + i * 8192) = ra[i];
#pragma unroll
        for (int i = 0; i < 2; ++i) *(u32x4*)(smem + 32768 + soff + i * 8192) = rb[i];
        __syncthreads();
        const char* base = smem;
#pragma unroll
        for (int ks = 0; ks < 2; ++ks) {
            const int kcs = ((ks * 4 + fq) ^ fsw) << 4;
            bf16x8 af[4], bfr[4];
#pragma unroll
            for (int m = 0; m < 4; ++m) af[m] = *(const bf16x8*)(base + aoff + m * 2048 + kcs);
#pragma unroll
            for (int n = 0; n < 4; ++n) bfr[n] = *(const bf16x8*)(base + boff + n * 2048 + kcs);
#pragma unroll
            for (int m = 0; m < 4; ++m)
#pragma unroll
                for (int n = 0; n < 4; ++n) acc[m][n] = MFMA(bfr[n], af[m], acc[m][n]);
        }
    }
    __syncthreads();
}
namespace pg8 {
#define PG8_LAS __attribute__((address_space(3)))
typedef unsigned short bf16_t;
typedef short bf16x8 __attribute__((ext_vector_type(8)));
typedef float f32x4 __attribute__((ext_vector_type(4)));
typedef unsigned u32x4 __attribute__((ext_vector_type(4)));
constexpr int BM = 256, BK = 64, HALF = 128, HTB = HALF * BK * 2  , STAGE_BYTES = 8 * HTB, NXCD = 8, WGM = 8;

__host__ __device__ __forceinline__ int lds_byte(int r, int c) { const int st = (r >> 4) * 2 + (c >> 5), rr = r & 15, cc = c & 31, ob = rr * 64 + cc * 2; return st * 1024 + (ob ^ (((ob >> 9) & 1) << 5)); }
__host__ __device__ __forceinline__ void stage_rc(int b, int& R, int& C) { const int st = b / 1024, sb = b % 1024, swz = sb ^ (((sb >> 9) & 1) << 5); R = (st >> 1) * 16 + swz / 64; C = (st & 1) * 32 + (swz % 64) / 2; }
__host__ __device__ __forceinline__ int perm32(int rho) { const int n = rho >> 4, i = rho & 15; return 8 * (i >> 2) + 4 * n + (i & 3); }

struct Unit { int pm, pn; };
struct Gemm { const bf16_t* A; const bf16_t* Bt; int M, N, K, lda; };

struct StaticOrder {
    int nM, nN, nwg, G, c;
    __host__ __device__ void init(int M, int N, int G_, int c_) { nM = M / BM; nN = N / BM; nwg = nM * nN; G = G_; c = c_; }
    __host__ __device__ bool next(int i, Unit& u) const {
        const long L = (long)i * G + c; if (L >= nwg) return false;
        int wgid = (int)L; { const int q = nwg / NXCD, r = nwg % NXCD, xcd = wgid % NXCD, off = wgid / NXCD; wgid = (xcd < r ? xcd * (q + 1) : r * (q + 1) + (xcd - r) * q) + off; }
        const int nig = WGM * nN, gid = wgid / nig, fm = gid * WGM, gsz = (nM - fm) < WGM ? (nM - fm) : WGM;
        u.pm = fm + ((wgid % nig) % gsz); u.pn = (wgid % nig) / gsz; return true;
    }
    __device__ __forceinline__ void a_ready(const Unit&) const {}
    __device__ __forceinline__ void done(const Unit&) const {}
};
template <class Epi, class Sched, bool STAMP = false>
__device__ __forceinline__ void gemm_phase(PG8_LAS unsigned char* lds, const Gemm g, const Sched& S, const Epi& E, unsigned long long* stamps) {
    const int tid = tidx(), wid = __builtin_amdgcn_readfirstlane(tid >> 6), lane = tid & 63, wr = wid >> 2, wc = wid & 3, fr = lane & 15, fq = lane >> 4;
    const int K = g.K, nt = K / BK;
    int ts_lo = 0, ts_hi = 0, nts = 0; const unsigned long long rt_entry = STAMP ? (unsigned long long)wall_clock64() : 0ull;
#define PG8_STAMP() do { if (STAMP && wid == 0 && nts < 64) { const unsigned long long _c = (unsigned long long)clock64(); \
        ts_lo = (lane == nts) ? (int)(unsigned)_c : ts_lo; ts_hi = (lane == nts) ? (int)(unsigned)(_c >> 32) : ts_hi; ++nts; } } while (0)
    PG8_STAMP();
    unsigned voffA[2];
#pragma unroll
    for (int i = 0; i < 2; ++i) { int R, C; stage_rc(tid * 16 + i * 8192, R, C); const int Rb = Epi::PERM ? ((R & ~31) + perm32(R & 31)) : R;
        voffA[i] = (unsigned)(R * g.lda + C) * 2u; (void)Rb; }
#define voffB voffA
    const size_t kstep = (size_t)(BK * 2);
    const size_t hstep = (size_t)HALF * K * 2, hstepA = (size_t)HALF * g.lda * 2;
    const size_t tstep = 2 * hstep, tstepA = 2 * hstepA;
    const unsigned ldsw = (unsigned)wid * 1024u;
    const int aoff = lds_byte(wr * 64 + fr, fq * 8), boff = lds_byte(wc * 32 + fr, fq * 8);
#define PG8_SA(b, h) (((b) * 2 + (h)) * HTB)
#define PG8_SB(b, h) ((4 + (b) * 2 + (h)) * HTB)
#define PG8_STAGE(bufoff, gbase, voff) do { _Pragma("unroll") for (int _i = 0; _i < 2; ++_i) \
        __builtin_amdgcn_global_load_lds((const unsigned*)((const char*)(gbase) + (voff)[_i]), (PG8_LAS unsigned*)(lds + (bufoff) + ldsw + _i * 8192), 16, 0, 0); } while (0)
#define PG8_LDA(dst, b, h) do { _Pragma("unroll") for (int m = 0; m < 4; ++m) _Pragma("unroll") for (int k = 0; k < 2; ++k) dst[m][k] = *(const PG8_LAS bf16x8*)(lds + PG8_SA(b, h) + aoff + m * 2048 + k * 1024); } while (0)
#define PG8_LDB(dst, b, h) do { _Pragma("unroll") for (int n = 0; n < 2; ++n) _Pragma("unroll") for (int k = 0; k < 2; ++k) dst[n][k] = *(const PG8_LAS bf16x8*)(lds + PG8_SB(b, h) + boff + n * 2048 + k * 1024); } while (0)
#define PG8_MMA(ai, bj, At, Bt) do { __builtin_amdgcn_s_setprio(1); _Pragma("unroll") for (int m = 0; m < 4; ++m) _Pragma("unroll") for (int n = 0; n < 2; ++n) _Pragma("unroll") for (int k = 0; k < 2; ++k) \
        acc[ai][bj][m][n] = __builtin_amdgcn_mfma_f32_16x16x32_bf16(Bt[n][k], At[m][k], acc[ai][bj][m][n], 0, 0, 0); __builtin_amdgcn_s_setprio(0); } while (0)
#define PG8_WAIT_V(n) asm volatile("s_waitcnt vmcnt(" #n ")" ::: "memory")
#define PG8_WAIT_L(n) asm volatile("s_waitcnt lgkmcnt(" #n ")" ::: "memory")
#define PG8_BAR __builtin_amdgcn_s_barrier()
#define PG8_SCHED __builtin_amdgcn_sched_barrier(0)
    Unit cur, nxt; int ui = 0;
    if (!S.next(0, cur)) return;
    f32x4 acc[2][2][4][2];
#pragma unroll
    for (int a = 0; a < 2; ++a)
#pragma unroll
        for (int b = 0; b < 2; ++b)
#pragma unroll
            for (int m = 0; m < 4; ++m)
#pragma unroll
                for (int n = 0; n < 2; ++n) acc[a][b][m][n] = (f32x4){0.f, 0.f, 0.f, 0.f};
    bf16x8 At[4][2], B0[2][2], B1[2][2];
    const char* cA = (const char*)g.A + (size_t)cur.pm * tstepA; const char* cB = (const char*)g.Bt + (size_t)cur.pn * tstep;
    S.a_ready(cur);
    PG8_STAGE(PG8_SB(0, 0), cB, voffB); PG8_STAGE(PG8_SA(0, 0), cA, voffA); PG8_STAGE(PG8_SB(0, 1), cB + hstep, voffB); PG8_STAGE(PG8_SA(0, 1), cA + hstepA, voffA);
    if (wr == 1) PG8_BAR;
    PG8_WAIT_V(4); PG8_BAR;
    PG8_STAGE(PG8_SB(1, 0), cB + kstep, voffB); PG8_STAGE(PG8_SA(1, 0), cA + kstep, voffA); PG8_STAGE(PG8_SB(1, 1), cB + hstep + kstep, voffB);
    PG8_WAIT_V(6); PG8_BAR;
    PG8_STAMP();
    for (;;) {
        const bool has_next = S.next(ui + 1, nxt);
        const char* nA = has_next ? (const char*)g.A + (size_t)nxt.pm * tstepA : cA; const char* nB = has_next ? (const char*)g.Bt + (size_t)nxt.pn * tstep : cB;
        for (int t = 0; t < nt; t += 2) {
            const bool last = (t == nt - 2);
            const char* a1 = cA + (size_t)(t + 1) * kstep;
            const char* a2 = last ? nA : cA + (size_t)(t + 2) * kstep; const char* b2 = last ? nB : cB + (size_t)(t + 2) * kstep;
            const char* a3 = a2 + kstep; const char* b3 = b2 + kstep;
            if (last && has_next) S.a_ready(nxt);
            PG8_LDB(B0, 0, 0); PG8_SCHED; PG8_LDA(At, 0, 0); PG8_STAGE(PG8_SA(1, 1), a1 + hstepA, voffA);
            PG8_WAIT_L(8); PG8_BAR; PG8_WAIT_L(0); PG8_MMA(0, 0, At, B0); PG8_BAR; PG8_SCHED;
            PG8_LDB(B1, 0, 1); PG8_STAGE(PG8_SB(0, 0), b2, voffB);
            PG8_BAR; PG8_WAIT_L(0); PG8_MMA(0, 1, At, B1); PG8_BAR;
            PG8_LDA(At, 0, 1); PG8_STAGE(PG8_SA(0, 0), a2, voffA);
            PG8_BAR; PG8_WAIT_L(0); PG8_MMA(1, 0, At, B0); PG8_BAR; PG8_SCHED;
            PG8_STAGE(PG8_SB(0, 1), b2 + hstep, voffB);
            PG8_WAIT_V(6); PG8_BAR; PG8_MMA(1, 1, At, B1); PG8_BAR;
            PG8_LDB(B0, 1, 0); PG8_SCHED; PG8_LDA(At, 1, 0); PG8_STAGE(PG8_SA(0, 1), a2 + hstepA, voffA);
            PG8_WAIT_L(8); PG8_BAR; PG8_WAIT_L(0); PG8_MMA(0, 0, At, B0); PG8_BAR; PG8_SCHED;
            PG8_LDB(B1, 1, 1); PG8_STAGE(PG8_SB(1, 0), b3, voffB);
            PG8_BAR; PG8_WAIT_L(0); PG8_MMA(0, 1, At, B1); PG8_BAR;
            PG8_LDA(At, 1, 1); PG8_STAGE(PG8_SA(1, 0), a3, voffA);
            PG8_BAR; PG8_WAIT_L(0); PG8_MMA(1, 0, At, B0); PG8_BAR; PG8_SCHED;
            PG8_STAGE(PG8_SB(1, 1), b3 + hstep, voffB);
            PG8_WAIT_V(6); PG8_BAR; PG8_MMA(1, 1, At, B1); PG8_BAR;
        }
        PG8_STAMP();
        if constexpr (!Epi::AFTER_DRAIN) { E(acc, cur, wr, wc, fr, fq); S.done(cur); }
        PG8_STAMP();
        if (!has_next) break;
#pragma unroll
        for (int a = 0; a < 2; ++a)
#pragma unroll
            for (int b = 0; b < 2; ++b)
#pragma unroll
                for (int m = 0; m < 4; ++m)
#pragma unroll
                    for (int n = 0; n < 2; ++n) acc[a][b][m][n] = (f32x4){0.f, 0.f, 0.f, 0.f};
        cur = nxt; cA = nA; cB = nB; ++ui;
    }
    PG8_WAIT_V(0);
    if (wr == 0) PG8_BAR;
    PG8_BAR;
    if constexpr (Epi::AFTER_DRAIN) { E.fused(acc, cur, wr, wc, fr, fq, lds, wid, lane); S.done(cur); }
    PG8_STAMP();
    if (STAMP && wid == 0) { stamps[lane] = lane < nts ? (((unsigned long long)(unsigned)ts_hi << 32) | (unsigned)ts_lo) : 0ull;
        if (lane == 62) stamps[62] = rt_entry; if (lane == 63) stamps[63] = (unsigned long long)wall_clock64(); }
#undef PG8_STAMP
#undef PG8_SA
#undef PG8_SB
#undef PG8_STAGE
#undef PG8_LDA
#undef PG8_LDB
#undef PG8_MMA
#undef PG8_WAIT_V
#undef PG8_WAIT_L
#undef PG8_BAR
#undef PG8_SCHED
#undef voffB
}
}

struct EpiPlain {
    static constexpr bool PERM = false, AFTER_DRAIN = false;
    bf16_t* C; int ldc;
    __device__ __forceinline__ void operator()(const f32x4 (&acc)[2][2][4][2], const pg8::Unit& u, int, int, int, int) const {
        const int t_ = tidx(), wr = t_ >> 8, wc = (t_ >> 6) & 3, fr = t_ & 15, fq = (t_ >> 4) & 3;
#pragma unroll
        for (int ai = 0; ai < 2; ++ai)
#pragma unroll
            for (int m = 0; m < 4; ++m) { bf16_t* rowp = C + (size_t)(u.pm * 256 + ai * 128 + wr * 64 + m * 16 + fr) * ldc + u.pn * 256 + wc * 32 + 8 * fq;
#pragma unroll
                for (int bj = 0; bj < 2; ++bj) { const f32x4 v0 = acc[ai][bj][m][0], v1 = acc[ai][bj][m][1]; u32x4 w; w.x = cvt_pk(v0[0], v0[1]); w.y = cvt_pk(v0[2], v0[3]); w.z = cvt_pk(v1[0], v1[1]); w.w = cvt_pk(v1[2], v1[3]);
                    *(u32x4*)(rowp + bj * 128) = w; } }
    }
};
struct EpiF1 {
    static constexpr bool PERM = false, AFTER_DRAIN = false;
    const float* cw; const float* cb; bf16_t* act; bf16_t* E;
    __device__ __forceinline__ void operator()(const f32x4 (&acc)[2][2][4][2], const pg8::Unit& u, int, int, int, int) const {
        const int t_ = tidx(), wr = t_ >> 8, wc = (t_ >> 6) & 3, fr = t_ & 15, fq = (t_ >> 4) & 3;
        const int ch = u.pn * 128 + wc * 32 + 8 * fq;
#pragma unroll
        for (int ai = 0; ai < 2; ++ai) {
            const int strip = u.pm * 4 + ai * 2 + wr; const size_t rowbase = (size_t)u.pm * 256 + ai * 128 + wr * 64;
#pragma unroll
            for (int m = 0; m < 4; ++m) {
                const int rs = m * 16 + fr; f32x4 a[2];
#pragma unroll
                for (int n = 0; n < 2; ++n) {
                    const f32x4 c0 = *(const f32x4*)(cw + ch + 4 * n), c1 = *(const f32x4*)(cw + DFF + ch + 4 * n), c2 = *(const f32x4*)(cw + 2 * DFF + ch + 4 * n), cbv = *(const f32x4*)(cb + ch + 4 * n);
                    const f32x4 g0 = acc[ai][0][m][n], up = acc[ai][1][m][n]; f32x4 g1, g2;
#pragma unroll
                    for (int j = 0; j < 4; ++j) {
                        const float a1 = DPP_MOV(g0[j], 0x121), a2 = DPP_MOV(g0[j], 0x122);
                        float b1 = 0.f, b2 = 0.f;
                        if (m > 0) { b1 = DPP_MOV(acc[ai][0][m > 0 ? m - 1 : 0][n][j], 0x121); b2 = DPP_MOV(acc[ai][0][m > 0 ? m - 1 : 0][n][j], 0x122); }
                        g1[j] = fr >= 1 ? a1 : b1; g2[j] = fr >= 2 ? a2 : b2;
                    }
                    const f32x4 val = c2 * g0 + c1 * g1 + c0 * g2 + cbv;
#pragma unroll
                    for (int j = 0; j < 4; ++j) a[n][j] = val[j] * rcpf_(1.0f + __expf(-val[j])) * up[j];
                }
                const f32x4 gA = acc[ai][0][m][0], gB = acc[ai][0][m][1], uA = acc[ai][1][m][0], uB = acc[ai][1][m][1];
                u32x4 w;
                if (rs >= 2) { w.x = cvt_pk(a[0][0], a[0][1]); w.y = cvt_pk(a[0][2], a[0][3]); w.z = cvt_pk(a[1][0], a[1][1]); w.w = cvt_pk(a[1][2], a[1][3]); *(u32x4*)(act + (rowbase + rs) * DFF + ch) = w; }
                else { w.x = cvt_pk(gA[0], gA[1]); w.y = cvt_pk(gA[2], gA[3]); w.z = cvt_pk(gB[0], gB[1]); w.w = cvt_pk(gB[2], gB[3]); *(u32x4*)(E + ((size_t)strip * 6 + 2 + rs) * DFF + ch) = w;
                       w.x = cvt_pk(uA[0], uA[1]); w.y = cvt_pk(uA[2], uA[3]); w.z = cvt_pk(uB[0], uB[1]); w.w = cvt_pk(uB[2], uB[3]); *(u32x4*)(E + ((size_t)strip * 6 + 4 + rs) * DFF + ch) = w; }
                if (rs >= 62) { w.x = cvt_pk(gA[0], gA[1]); w.y = cvt_pk(gA[2], gA[3]); w.z = cvt_pk(gB[0], gB[1]); w.w = cvt_pk(gB[2], gB[3]); *(u32x4*)(E + ((size_t)strip * 6 + (rs - 62)) * DFF + ch) = w; }
            }
        }
    }
};
struct EpiScale {
    static constexpr bool PERM = false, AFTER_DRAIN = false;
    bf16_t* C; int ldc; float scale;
    __device__ __forceinline__ void operator()(const f32x4 (&acc)[2][2][4][2], const pg8::Unit& u, int, int, int, int) const {
        const int t_ = tidx(), wr = t_ >> 8, wc = (t_ >> 6) & 3, fr = t_ & 15, fq = (t_ >> 4) & 3;
#pragma unroll
        for (int ai = 0; ai < 2; ++ai)
#pragma unroll
            for (int m = 0; m < 4; ++m) { bf16_t* rowp = C + (size_t)(u.pm * 256 + ai * 128 + wr * 64 + m * 16 + fr) * ldc + u.pn * 256 + wc * 32 + 4 * fq;
#pragma unroll
                for (int bj = 0; bj < 2; ++bj)
#pragma unroll
                    for (int n = 0; n < 2; ++n) st_bf4(rowp + bj * 128 + n * 16, acc[ai][bj][m][n] * scale); }
    }
};
struct EpiN1kv {
    static constexpr bool PERM = false, AFTER_DRAIN = false;
    bf16_t* kv;
    __device__ __forceinline__ void operator()(const f32x4 (&acc)[2][2][4][2], const pg8::Unit& u, int, int, int, int) const {
        const int t_ = tidx(), wr = t_ >> 8, wc = (t_ >> 6) & 3, fr = t_ & 15, fq = (t_ >> 4) & 3;
        char* base = (char*)kv;
#pragma unroll
        for (int ai = 0; ai < 2; ++ai)
#pragma unroll
            for (int m = 0; m < 4; ++m) {
                const size_t row = (size_t)u.pm * 256 + ai * 128 + wr * 64 + m * 16 + fr;
#pragma unroll
                for (int bj = 0; bj < 2; ++bj)
#pragma unroll
                    for (int n = 0; n < 2; ++n) {
                        const int c128 = wc * 32 + n * 16 + fq * 4; const f32x4 v = acc[ai][bj][m][n];
                        if (u.pn < 3) {
                            const int cc = u.pn * 2 + bj;
                            if (cc == 0 || cc == 1 || cc == 4) { const size_t off = cc == 0 ? 0 : cc == 1 ? 8 * MiB : 24 * MiB; st_bf4((bf16_t*)(base + off) + row * 128 + c128, v); }
                            else if (cc == 2) { const int b = (int)(row >> 13), t = (int)(row & (SEQ - 1));
                                *(unsigned*)((unsigned char*)(base + 16 * MiB) + ((size_t)((b * 2 + (c128 >> 6)) * SEQ + t)) * 64 + (c128 & 63)) = pack_fp8x4(v[0], v[1], v[2], v[3]); }
                            else if (cc == 3) { const int b = (int)(row >> 13), t = (int)(row & (SEQ - 1));
                                unsigned char* dst = (unsigned char*)(base + 32 * MiB) + ((size_t)((b * 2 + (c128 >> 6)) * 128 + (t >> 6)) * 64 + (c128 & 63)) * 64 + (t & 63);
                                const unsigned pk = pack_fp8x4(v[0], v[1], v[2], v[3]);
                                for (int j = 0; j < 4; ++j) dst[j * 64] = (unsigned char)(pk >> (8 * j)); }
                            else { bf16_t* dst = (bf16_t*)(base + 40 * MiB); const int b = (int)(row >> 13), t = (int)(row & (SEQ - 1));
                                for (int j = 0; j < 4; ++j) dst[((size_t)(b * 128 + c128 + j)) * SEQ + t] = f2bf(v[j]); }
                        } else { if (bj == 0 && c128 < 48) { float* gates = (float*)(base + 48 * MiB); for (int j = 0; j < 4; ++j) gates[row * 48 + c128 + j] = sigmoidf_(v[j]); } }
                    }
            }
    }
};
struct EpiL1 {
    static constexpr bool PERM = false, AFTER_DRAIN = false;
    bf16_t *qe, *ke, *vT, *r; float* adn;
    __device__ __forceinline__ void operator()(const f32x4 (&acc)[2][2][4][2], const pg8::Unit& u, int, int, int, int) const {
        const int t_ = tidx(), wr = t_ >> 8, wc = (t_ >> 6) & 3, fr = t_ & 15, fq = (t_ >> 4) & 3;
#pragma unroll
        for (int ai = 0; ai < 2; ++ai)
#pragma unroll
            for (int m = 0; m < 4; ++m) {
                const size_t row = (size_t)u.pm * 256 + ai * 128 + wr * 64 + m * 16 + fr;
#pragma unroll
                for (int bj = 0; bj < 2; ++bj)
#pragma unroll
                    for (int n = 0; n < 2; ++n) {
                        const int c = bj * 128 + wc * 32 + n * 16 + fq * 4; const f32x4 v = acc[ai][bj][m][n];
                        if (u.pn < 2) st_bf4(qe + row * 512 + u.pn * 256 + c, v * 0.08838834764831845f);
                        else if (u.pn < 4) st_bf4(ke + row * 512 + (u.pn - 2) * 256 + c, v);
                        else if (u.pn < 8) { const int b = (int)(row >> 13), t = (int)(row & (SEQ - 1)), vc = (u.pn - 4) * 256 + c;
                            for (int j = 0; j < 4; ++j) vT[((size_t)(b * 1024 + vc + j)) * SEQ + t] = f2bf(v[j]); }
                        else if (u.pn < 12) st_bf4(r + row * DM + (u.pn - 8) * 256 + c, v);
                        else { if (c < 16) *(f32x4*)(adn + row * 16 + c) = v; }
                    }
            }
    }
};
template <class Epi>
DEV void phase_gemm_pg8(const bf16_t* A, int lda, const bf16_t* Bt, int N, int K, const Epi& E, char* smem) {
    pg8::Gemm g; g.A = A; g.Bt = Bt; g.M = T; g.N = N; g.K = K; g.lda = lda;
    pg8::StaticOrder S; S.init(T, N, (int)gridDim.x, (int)blockIdx.x);
    pg8::gemm_phase<Epi, pg8::StaticOrder, false>((PG8_LAS unsigned char*)smem, g, S, E, nullptr);
}
struct LaneId { int lane, wid, wm, wn, fr, fq; };
DEV LaneId lane_id() { LaneId l; l.lane = tidx() & 63; l.wid = tidx() >> 6; l.wm = l.wid >> 1; l.wn = l.wid & 1; l.fr = l.lane & 15; l.fq = l.lane >> 4; return l; }

template <class Map>
DEV void prep_T(bf16_t* dst, const float* src, int Ks, int Ns, int Nd, int Kd, Map map, char* smem, int& cursor) {
    float* tile = (float*)smem;
    const int ntn = Nd >> 6, ntiles = ntn * (Kd >> 6), tid = tidx(), G = (int)gridDim.x;
    int first = ((int)blockIdx.x - cursor) % G; if (first < 0) first += G;
    for (int tl = first; tl < ntiles; tl += G) {
        const int n0 = (tl % ntn) * 64, k0 = (tl / ntn) * 64;
        { const int j4 = (tid & 15) * 4, kr = tid >> 4;
          const int m0 = map(n0 + j4), m3 = map(n0 + j4 + 3);
          const bool vec = (m0 >= 0) && (m3 == m0 + 3) && ((Ns & 3) == 0) && ((m0 & 3) == 0);
#pragma unroll
          for (int p = 0; p < 2; ++p) { const int kk = kr + 32 * p, k = k0 + kk; f32x4 v = {0.f, 0.f, 0.f, 0.f};
              if (k < Ks) { if (vec) v = *(const f32x4*)(src + (size_t)k * Ns + m0);
                            else { for (int q = 0; q < 4; ++q) { const int n = map(n0 + j4 + q); v[q] = n >= 0 ? src[(size_t)k * Ns + n] : 0.f; } } }
              tile[kk * 65 + j4] = v[0]; tile[kk * 65 + j4 + 1] = v[1]; tile[kk * 65 + j4 + 2] = v[2]; tile[kk * 65 + j4 + 3] = v[3]; } }
        __syncthreads();
        { const int r = tid >> 3, c8 = (tid & 7) * 8;
          u32x4 w; w.x = cvt_pk(tile[(c8 + 0) * 65 + r], tile[(c8 + 1) * 65 + r]); w.y = cvt_pk(tile[(c8 + 2) * 65 + r], tile[(c8 + 3) * 65 + r]);
          w.z = cvt_pk(tile[(c8 + 4) * 65 + r], tile[(c8 + 5) * 65 + r]); w.w = cvt_pk(tile[(c8 + 6) * 65 + r], tile[(c8 + 7) * 65 + r]);
          *(u32x4*)(dst + (size_t)(n0 + r) * Kd + k0 + c8) = w; }
        __syncthreads();
    }
    cursor += ntiles;
}
struct MapId { int ns; DEV int operator()(int n) const { return n < ns ? n : -1; } };
struct MapPerm { int ns; DEV int operator()(int n) const { return n < ns ? (n & ~31) + pg8::perm32(n & 31) : -1; } };
struct MapFfn { DEV int operator()(int v) const { const int pn = v >> 8, c = v & 255, cc = (c & 96) + pg8::perm32(c & 31); return c < 128 ? 128 * pn + cc : DFF + 128 * pn + cc; } };

DEV void phase_prep(const Params& P, int layer, char* smem) {
    char* ws = P.ws; int cur = 0;
    const int kind = layer % 3, j = layer / 3;
    prep_T((bf16_t*)(ws + OFF_WF1), P.in[I_FWIN] + (size_t)layer * DM * 2 * DFF, DM, 2 * DFF, 2 * DFF, DM, MapFfn{}, smem, cur);
    prep_T((bf16_t*)(ws + OFF_WF2), P.in[I_FWOUT] + (size_t)layer * DFF * DM, DFF, DM, DM, DFF, MapPerm{DM}, smem, cur);
    bf16_t* mix = (bf16_t*)(ws + OFF_MIX);
    if (kind == 0) {
        const float* wrkv = P.in[I_WRKV] + (size_t)j * 3 * DM * DM;
        prep_T(mix, wrkv, DM, DM, DM, DM, MapId{DM}, smem, cur);
        prep_T(mix + (size_t)1024 * DM, wrkv + (size_t)DM * DM, DM, DM, DM, DM, MapId{DM}, smem, cur);
        prep_T(mix + (size_t)2048 * DM, P.in[I_W1] + (size_t)j * DM * 64, DM, 64, 128, DM, MapId{64}, smem, cur);
        prep_T(mix + (size_t)2176 * DM, P.in[I_A1] + (size_t)j * DM * 64, DM, 64, 128, DM, MapId{64}, smem, cur);
        prep_T(mix + (size_t)2304 * DM, P.in[I_G1] + (size_t)j * DM * 128, DM, 128, 128, DM, MapId{128}, smem, cur);
        if (j > 0) prep_T(mix + (size_t)2432 * DM, P.in[I_V1] + (size_t)(j - 1) * DM * 32, DM, 32, 128, DM, MapId{32}, smem, cur);
        else       prep_T(mix + (size_t)2432 * DM, P.in[I_V1], DM, 32, 128, DM, MapId{0}, smem, cur);
        prep_T((bf16_t*)((char*)mix + 5 * MiB), wrkv + (size_t)2 * DM * DM, DM, DM, DM, DM, MapId{DM}, smem, cur);
        prep_T((bf16_t*)((char*)mix + 7 * MiB), P.in[I_W2] + (size_t)j * 64 * DM, 64, DM, DM, 64, MapId{DM}, smem, cur);
        prep_T((bf16_t*)((char*)mix + 7 * MiB + 131072), P.in[I_A2] + (size_t)j * 64 * DM, 64, DM, DM, 64, MapId{DM}, smem, cur);
        if (j > 0) prep_T((bf16_t*)((char*)mix + 7 * MiB + 262144), P.in[I_V2] + (size_t)(j - 1) * 32 * DM, 32, DM, DM, 64, MapId{DM}, smem, cur);
        prep_T((bf16_t*)((char*)mix + 7 * MiB + 393216), P.in[I_G2] + (size_t)j * 128 * DM, 128, DM, DM, 128, MapId{DM}, smem, cur);
        prep_T((bf16_t*)((char*)mix + 8 * MiB), P.in[I_RWO] + (size_t)j * DM * DM, DM, DM, DM, DM, MapPerm{DM}, smem, cur);
    } else if (kind == 1) {
        prep_T(mix, P.in[I_NWIN], DM, 1840, 2048, DM, MapId{1840}, smem, cur);
        prep_T((bf16_t*)((char*)mix + 4 * MiB), P.in[I_CW1], 2048, 256, 256, 2048, MapId{256}, smem, cur);
        prep_T((bf16_t*)((char*)mix + 4 * MiB) + (size_t)256 * 2048, P.in[I_CW1] + (size_t)2048 * 256, 2048, 256, 256, 2048, MapId{256}, smem, cur);
        prep_T((bf16_t*)((char*)mix + 6 * MiB), P.in[I_CW2], 256, 64, 128, 256, MapId{64}, smem, cur);
        prep_T((bf16_t*)((char*)mix + 6 * MiB) + (size_t)128 * 256, P.in[I_CW2] + (size_t)256 * 64, 256, 64, 128, 256, MapId{64}, smem, cur);
        prep_T((bf16_t*)((char*)mix + 7 * MiB), P.in[I_NWO], DM, DM, DM, DM, MapPerm{DM}, smem, cur);
        { const int lane = tidx() & 63, gw = blockIdx.x * (NTHR / 64) + (tidx() >> 6);
          if (gw < 512) { const int c = gw >> 8, col = gw & 255; const float* w1 = P.in[I_CW1] + (size_t)c * 2048 * 256; const float* pe = P.in[I_CPE] + (size_t)c * 2048;
              float sacc = 0.f; for (int k = lane; k < 2048; k += 64) sacc += pe[k] * w1[(size_t)k * 256 + col];
              sacc = wave_sum(sacc); if (lane == 0) ((float*)(ws + OFF_BIASP))[gw] = sacc + P.in[I_CB1][c * 256 + col]; } }
    } else {
        prep_T(mix, P.in[I_GWIN], DM, 3088, 3328, DM, MapId{3088}, smem, cur);
        prep_T((bf16_t*)((char*)mix + 7 * MiB), P.in[I_GWO], DM, DM, DM, DM, MapPerm{DM}, smem, cur);
    }
}

template <int HIN, int HOUT>
DEV void phase_norm(const void* h_in, const bf16_t* z, const float* g_post, void* h_out, float* stage, const float* g_pre, bf16_t* xn) {
    const int lane = tidx() & 63, gw = blockIdx.x * (NTHR / 64) + (tidx() >> 6), nw = gridDim.x * (NTHR / 64);
    for (int row = gw; row < T; row += nw) {
        f32x4 hv[4];
#pragma unroll
        for (int i = 0; i < 4; ++i) { const size_t off = (size_t)row * DM + i * 256 + lane * 4;
            if (HIN == 0) hv[i] = *(const f32x4*)((const float*)h_in + off); else hv[i] = ld_bf4((const bf16_t*)h_in + off); }
        if (z) {
            f32x4 zv[4]; float ss = 0.f;
#pragma unroll
            for (int i = 0; i < 4; ++i) { zv[i] = ld_bf4(z + (size_t)row * DM + i * 256 + lane * 4); ss += zv[i][0] * zv[i][0] + zv[i][1] * zv[i][1] + zv[i][2] * zv[i][2] + zv[i][3] * zv[i][3]; }
            ss = wave_sum(ss); const float rs = rsqrtf(ss * (1.0f / DM) + 1e-6f);
#pragma unroll
            for (int i = 0; i < 4; ++i) { const f32x4 g = *(const f32x4*)(g_post + i * 256 + lane * 4); hv[i] += zv[i] * rs * g; }
        }
        if (HOUT == 1) {
#pragma unroll
            for (int i = 0; i < 4; ++i) st_bf4((bf16_t*)h_out + (size_t)row * DM + i * 256 + lane * 4, hv[i]);
        }
        if (HOUT == 2) {
            float* dst = row < T / 2 ? (float*)h_out + (size_t)row * DM : stage + (size_t)(row - T / 2) * DM;
#pragma unroll
            for (int i = 0; i < 4; ++i) *(f32x4*)(dst + i * 256 + lane * 4) = hv[i];
        }
        if (xn) {
            float ss = 0.f;
#pragma unroll
            for (int i = 0; i < 4; ++i) ss += hv[i][0] * hv[i][0] + hv[i][1] * hv[i][1] + hv[i][2] * hv[i][2] + hv[i][3] * hv[i][3];
            ss = wave_sum(ss); const float rs = rsqrtf(ss * (1.0f / DM) + 1e-6f);
#pragma unroll
            for (int i = 0; i < 4; ++i) { const f32x4 g = *(const f32x4*)(g_pre + i * 256 + lane * 4); st_bf4(xn + (size_t)row * DM + i * 256 + lane * 4, hv[i] * rs * g); }
        }
    }
}
DEV void phase_copy_out(const float* stage, float* out) {
    const size_t gt = (size_t)blockIdx.x * NTHR + tidx(), nt = (size_t)gridDim.x * NTHR;
    for (size_t i = gt; i < (size_t)(T / 2) * DM / 4; i += nt) ((f32x4*)(out + (size_t)(T / 2) * DM))[i] = ((const f32x4*)stage)[i];
}

DEV void phase_gemm_plain(const bf16_t* A, int lda, const bf16_t* Bt, int K, int ntn, bf16_t* C, int ldc, char* smem) {
    const LaneId L = lane_id();
    const int nunits = (T / 256) * ntn;
    for (int u = blockIdx.x; u < nunits; u += gridDim.x) {
        const int tm = u / ntn, tn = u % ntn;
        f32x4 acc[4][4];
        gemm_core(acc, LdPlain{A + (size_t)tm * 256 * lda, lda}, LdPlain{Bt + (size_t)tn * 128 * K, K}, K, smem);
#pragma unroll
        for (int m = 0; m < 4; ++m)
#pragma unroll
            for (int n = 0; n < 4; ++n)
                st_bf4(C + (size_t)(tm * 256 + L.wm * 64 + m * 16 + L.fr) * ldc + tn * 128 + L.wn * 64 + n * 16 + L.fq * 4, acc[m][n]);
    }
}

DEV void phase_f1(const bf16_t* xn, const bf16_t* Bt, const float* cw, const float* cb, bf16_t* act, bf16_t* E, char* smem) {
    const LaneId L = lane_id();
    const int ntn = 2 * DFF / 128, nunits = (T / 256) * ntn;
    for (int u = blockIdx.x; u < nunits; u += gridDim.x) {
        const int tm = u / ntn, tn = u % ntn;
        f32x4 acc[4][4];
        gemm_core(acc, LdPlain{xn + (size_t)tm * 256 * DM, DM}, LdPlain{Bt + (size_t)tn * 128 * DM, DM}, DM, smem);
        const int strip = tm * 4 + L.wm; const size_t rowbase = (size_t)tm * 256 + L.wm * 64;
#pragma unroll
        for (int n = 0; n < 2; ++n) {
            const int ch = tn * 64 + L.wn * 32 + n * 16 + L.fq * 4;
            const f32x4 c0 = *(const f32x4*)(cw + ch), c1 = *(const f32x4*)(cw + DFF + ch), c2 = *(const f32x4*)(cw + 2 * DFF + ch), cbv = *(const f32x4*)(cb + ch);
#pragma unroll
            for (int m = 0; m < 4; ++m) {
                const f32x4 g0 = acc[m][n], up = acc[m][n + 2]; f32x4 g1, g2;
#pragma unroll
                for (int j = 0; j < 4; ++j) {
                    const float a1 = __shfl(g0[j], (L.lane - 1) & 63), a2 = __shfl(g0[j], (L.lane - 2) & 63);
                    float b1 = 0.f, b2 = 0.f;
                    if (m > 0) { b1 = __shfl(acc[m > 0 ? m - 1 : 0][n][j], (L.lane + 15) & 63); b2 = __shfl(acc[m > 0 ? m - 1 : 0][n][j], (L.lane + 14) & 63); }
                    g1[j] = L.fr >= 1 ? a1 : b1; g2[j] = L.fr >= 2 ? a2 : b2;
                }
                const int rs = m * 16 + L.fr;
                f32x4 val = c2 * g0 + c1 * g1 + c0 * g2 + cbv, a;
#pragma unroll
                for (int j = 0; j < 4; ++j) a[j] = val[j] * rcpf_(1.0f + __expf(-val[j])) * up[j];
                if (rs >= 2) st_bf4(act + (rowbase + rs) * DFF + ch, a);
                else { st_bf4(E + ((size_t)strip * 6 + 2 + rs) * DFF + ch, g0); st_bf4(E + ((size_t)strip * 6 + 4 + rs) * DFF + ch, up); }
                if (rs >= 62) st_bf4(E + ((size_t)strip * 6 + (rs - 62)) * DFF + ch, g0);
            }
        }
    }
}
DEV void phase_f1b(const float* cw, const float* cb, bf16_t* act, const bf16_t* E) {
    const int gt = blockIdx.x * NTHR + tidx(), nt = gridDim.x * NTHR;
    for (int idx = gt; idx < 512 * 2 * (DFF / 4); idx += nt) {
        const int ch = (idx % (DFF / 4)) * 4, r = (idx / (DFF / 4)) & 1, strip = idx / (2 * (DFF / 4));
        const bool first = (strip & 127) == 0;
        const f32x4 zero = {0.f, 0.f, 0.f, 0.f};
        const f32x4 g0 = ld_bf4(E + ((size_t)strip * 6 + 2 + r) * DFF + ch), up = ld_bf4(E + ((size_t)strip * 6 + 4 + r) * DFF + ch);
        f32x4 g1, g2;
        if (r == 1) { g1 = ld_bf4(E + ((size_t)strip * 6 + 2) * DFF + ch); g2 = first ? zero : ld_bf4(E + ((size_t)(strip - 1) * 6 + 1) * DFF + ch); }
        else { g1 = first ? zero : ld_bf4(E + ((size_t)(strip - 1) * 6 + 1) * DFF + ch); g2 = first ? zero : ld_bf4(E + ((size_t)(strip - 1) * 6 + 0) * DFF + ch); }
        const f32x4 c0 = *(const f32x4*)(cw + ch), c1 = *(const f32x4*)(cw + DFF + ch), c2 = *(const f32x4*)(cw + 2 * DFF + ch), cbv = *(const f32x4*)(cb + ch);
        f32x4 val = c2 * g0 + c1 * g1 + c0 * g2 + cbv, a;
#pragma unroll
        for (int j = 0; j < 4; ++j) a[j] = val[j] * rcpf_(1.0f + __expf(-val[j])) * up[j];
        st_bf4(act + ((size_t)strip * 64 + r) * DFF + ch, a);
    }
}

struct RwkvW { const float *mu, *w0, *a0, *k_k, *k_a, *r_k, *ln_w, *ln_b, *v0; bool vres; };
DEV void phase_r1(const bf16_t* xn, const bf16_t* Bt, const RwkvW& W, bf16_t* rb, bf16_t* kb, bf16_t* hid, char* smem) {
    const LaneId L = lane_id();
    const int ntn = 20, nunits = (T / 256) * ntn;
    for (int u = blockIdx.x; u < nunits; u += gridDim.x) {
        const int tm = u / ntn, tn = u % ntn;
        const int var = tn < 8 ? 0 : tn < 16 ? 2 : tn == 16 ? 1 : tn == 17 ? 4 : tn == 18 ? 5 : 3;
        f32x4 acc[4][4];
        gemm_core(acc, LdMix{xn, W.mu + var * DM, tm * 256, {0.f, 0.f, 0.f, 0.f}, {0.f, 0.f, 0.f, 0.f}}, LdPlain{Bt + (size_t)tn * 128 * DM, DM}, DM, smem);
#pragma unroll
        for (int m = 0; m < 4; ++m)
#pragma unroll
            for (int n = 0; n < 4; ++n) {
                const size_t row = (size_t)tm * 256 + L.wm * 64 + m * 16 + L.fr; const int c = L.wn * 64 + n * 16 + L.fq * 4; f32x4 v = acc[m][n];
                if (tn < 8) st_bf4(rb + row * DM + tn * 128 + c, v);
                else if (tn < 16) st_bf4(kb + row * DM + (tn - 8) * 128 + c, v);
                else if (tn == 16) { if (L.wn == 0) { for (int j = 0; j < 4; ++j) v[j] = tanhf(v[j]); st_bf4(hid + row * HIDP + c, v); } }
                else if (tn == 17) { if (L.wn == 0) st_bf4(hid + row * HIDP + 64 + c, v); }
                else if (tn == 18) { for (int j = 0; j < 4; ++j) v[j] = sigmoidf_(v[j]); st_bf4(hid + row * HIDP + 128 + c, v); }
                else { if (L.wn == 0) st_bf4(hid + row * HIDP + 256 + c, v); }
            }
    }
}
DEV void phase_r2(const bf16_t* xn, const bf16_t* mixw, const RwkvW& W, const bf16_t* hid, const bf16_t* rb, float* bsc, bf16_t* wb, bf16_t* kb, bf16_t* kkb, bf16_t* kab, bf16_t* vb, char* smem) {
    const LaneId L = lane_id();
    const bf16_t* Bv = (const bf16_t*)((const char*)mixw + 5 * MiB);
    const bf16_t* W2T = (const bf16_t*)((const char*)mixw + 7 * MiB);
    const bf16_t* A2T = (const bf16_t*)((const char*)mixw + 7 * MiB + 131072);
    const bf16_t* V2T = (const bf16_t*)((const char*)mixw + 7 * MiB + 262144);
    const int nunits = 1024 + 2048;
    for (int u = blockIdx.x; u < nunits; u += gridDim.x) {
        if (u < 1024) {
            const int tm = u >> 3, tn = u & 7;
            f32x4 acc[4][4]; u32x2 gpk[4][4];
            if (W.vres) {
                gemm_core(acc, LdPlain{hid + (size_t)tm * 256 * HIDP + 256, HIDP}, LdPlain{V2T + (size_t)tn * 128 * 64, 64}, 64, smem);
#pragma unroll
                for (int m = 0; m < 4; ++m)
#pragma unroll
                    for (int n = 0; n < 4; ++n) { const int col = tn * 128 + L.wn * 64 + n * 16 + L.fq * 4; const f32x4 b = *(const f32x4*)(W.v0 + col);
                        gpk[m][n].x = cvt_pk(sigmoidf_(b[0] + acc[m][n][0]), sigmoidf_(b[1] + acc[m][n][1]));
                        gpk[m][n].y = cvt_pk(sigmoidf_(b[2] + acc[m][n][2]), sigmoidf_(b[3] + acc[m][n][3])); }
            }
            gemm_core(acc, LdMix{xn, W.mu + 3 * DM, tm * 256, {0.f, 0.f, 0.f, 0.f}, {0.f, 0.f, 0.f, 0.f}}, LdPlain{Bv + (size_t)tn * 128 * DM, DM}, DM, smem);
#pragma unroll
            for (int m = 0; m < 4; ++m)
#pragma unroll
                for (int n = 0; n < 4; ++n) {
                    const size_t row = (size_t)tm * 256 + L.wm * 64 + m * 16 + L.fr; const int col = tn * 128 + L.wn * 64 + n * 16 + L.fq * 4; f32x4 v = acc[m][n];
                    if (W.vres) { const f32x4 vf = ld_bf4(vb + row * DM + col); f32x4 gt; gt[0] = bf_lo(gpk[m][n].x); gt[1] = bf_hi(gpk[m][n].x); gt[2] = bf_lo(gpk[m][n].y); gt[3] = bf_hi(gpk[m][n].y); v = v + (vf - v) * gt; }
                    st_bf4(vb + row * DM + col, v);
                }
        } else {
            const int u2 = u - 1024, tm = u2 >> 4, jj = u2 & 15;
            f32x4 acc[4][4];
            if (jj < 8) {
                const int tn = jj;
                gemm_core(acc, LdPlain{hid + (size_t)tm * 256 * HIDP, HIDP}, LdPlain{W2T + (size_t)tn * 128 * 64, 64}, 64, smem);
#pragma unroll
                for (int m = 0; m < 4; ++m)
#pragma unroll
                    for (int n = 0; n < 4; ++n) {
                        const size_t row = (size_t)tm * 256 + L.wm * 64 + m * 16 + L.fr; const int col = tn * 128 + L.wn * 64 + n * 16 + L.fq * 4; const f32x4 b = *(const f32x4*)(W.w0 + col); f32x4 v;
                        for (int j = 0; j < 4; ++j) { const float x = b[j] + acc[m][n][j]; const float y = -x;
                            const float sp = fmaxf(y, 0.f) + log1pf(__expf(-fabsf(y))); const float w = -sp - 0.5f; v[j] = __expf(-__expf(w)); }
                        st_bf4(wb + row * DM + col, v);
                    }
            } else {
                const int tn = jj - 8;
                gemm_core(acc, LdPlain{hid + (size_t)tm * 256 * HIDP + 64, HIDP}, LdPlain{A2T + (size_t)tn * 128 * 64, 64}, 64, smem);
#pragma unroll
                for (int m = 0; m < 4; ++m) {
                    const size_t row = (size_t)tm * 256 + L.wm * 64 + m * 16 + L.fr;
                    u32x2 kpk[4]; float ss = 0.f;
#pragma unroll
                    for (int n = 0; n < 4; ++n) { const int col = tn * 128 + L.wn * 64 + n * 16 + L.fq * 4;
                        kpk[n] = *(const u32x2*)(kb + row * DM + col); const f32x4 kkw = *(const f32x4*)(W.k_k + col);
                        const float c0 = bf_lo(kpk[n].x) * kkw[0], c1 = bf_hi(kpk[n].x) * kkw[1], c2 = bf_lo(kpk[n].y) * kkw[2], c3 = bf_hi(kpk[n].y) * kkw[3];
                        ss += (c0 * c0 + c1 * c1) + (c2 * c2 + c3 * c3); }
                    ss += __shfl_xor(ss, 16); ss += __shfl_xor(ss, 32);
                    const float inv = rcpf_(fmaxf(sqrtf(ss), 1e-12f));
                    asm volatile("" ::: "memory");
                    float bon = 0.f;
#pragma unroll
                    for (int n = 0; n < 4; ++n) { const int col = tn * 128 + L.wn * 64 + n * 16 + L.fq * 4;
                        const f32x4 ka = *(const f32x4*)(W.k_a + col), kkw = *(const f32x4*)(W.k_k + col), a0 = *(const f32x4*)(W.a0 + col), rkv = *(const f32x4*)(W.r_k + col), rv = ld_bf4(rb + row * DM + col);
                        f32x4 kv; kv[0] = bf_lo(kpk[n].x); kv[1] = bf_hi(kpk[n].x); kv[2] = bf_lo(kpk[n].y); kv[3] = bf_hi(kpk[n].y);
                        f32x4 kk, kp, kka;
                        for (int j = 0; j < 4; ++j) { const float a = sigmoidf_(a0[j] + acc[m][n][j]); kk[j] = kv[j] * kkw[j] * inv; kp[j] = kv[j] * (1.0f + (a - 1.0f) * ka[j]); kka[j] = kk[j] * a; }
                        const u32x2 kpp = {cvt_pk(kp[0], kp[1]), cvt_pk(kp[2], kp[3])};
                        bon += rv[0] * bf_lo(kpp.x) * rkv[0] + rv[1] * bf_hi(kpp.x) * rkv[1] + rv[2] * bf_lo(kpp.y) * rkv[2] + rv[3] * bf_hi(kpp.y) * rkv[3];
                        *(u32x2*)(kb + row * DM + col) = kpp; st_bf4(kkb + row * DM + col, kk); st_bf4(kab + row * DM + col, kka);
                        asm volatile("" ::: "memory"); }
                    bon += __shfl_xor(bon, 16); bon += __shfl_xor(bon, 32);
                    if (L.fq == 0) bsc[row * 16 + tn * 2 + L.wn] = bon;
                }
            }
        }
    }
}
typedef float f32x2 __attribute__((ext_vector_type(2)));
constexpr int R3_CH = 32, R3_STR = R3_CH * 256, R3_BUF = 5 * R3_STR + R3_CH * 64;
DEV void r3_stage_raw(const bf16_t* const (&str)[5], const bf16_t* vb, size_t base, int vrow0, int t0, char* buf, int id) {
    u32x4 d[5];
    const int t = id >> 3, j = id & 7;
#pragma unroll
    for (int st = 0; st < 5; ++st) d[st] = *(const u32x4*)(str[st] + base + (size_t)(t0 + t) * DM + j * 8);
    u32x4 vv = {0u, 0u, 0u, 0u};
    if (id < 64) vv = *(const u32x4*)(vb + base + (size_t)(t0 + (id >> 1)) * DM + vrow0 + (id & 1) * 8);
#pragma unroll
    for (int st = 0; st < 5; ++st) { f32x4 a, b; a[0] = bf_lo(d[st].x); a[1] = bf_hi(d[st].x); a[2] = bf_lo(d[st].y); a[3] = bf_hi(d[st].y); b[0] = bf_lo(d[st].z); b[1] = bf_hi(d[st].z); b[2] = bf_lo(d[st].w); b[3] = bf_hi(d[st].w);
        float* p = (float*)(buf + st * R3_STR + t * 256 + j * 32); *(f32x4*)p = a; *(f32x4*)(p + 4) = b; }
    if (id < 64) { f32x4 a, b; a[0] = bf_lo(vv.x); a[1] = bf_hi(vv.x); a[2] = bf_lo(vv.y); a[3] = bf_hi(vv.y); b[0] = bf_lo(vv.z); b[1] = bf_hi(vv.z); b[2] = bf_lo(vv.w); b[3] = bf_hi(vv.w);
        float* vp = (float*)(buf + 5 * R3_STR + (id >> 1) * 64 + (id & 1) * 32); *(f32x4*)vp = a; *(f32x4*)(vp + 4) = b; }
}
DEV void phase_r3(const bf16_t* rb, const bf16_t* wb, const bf16_t* kb, const bf16_t* kkb, const bf16_t* kab, const bf16_t* vb, bf16_t* yb, float* bsc, const float* r_k, char* smem) {
    const int tid = tidx(), lane = tid & 63, wid = tid >> 6;
    const bf16_t* const str[5] = {rb, wb, kb, kkb, kab};
    constexpr int NCH = SEQ / R3_CH;
    for (int task = blockIdx.x; task < 256; task += gridDim.x) {
        const int bh = task >> 2, b = bh >> 4, h = bh & 15, rq = task & 3;
        const size_t base = (size_t)b * SEQ * DM + h * 64;
        bf16_t* ystage = (bf16_t*)(smem + 149504 + 64);
    float* gcarea = (float*)(smem + 3 * R3_BUF);
        if (wid >= 4) r3_stage_raw(str, vb, base, rq * 16, 0, smem, tid - 256);
        __syncthreads();
        if (wid >= 4) { r3_stage_raw(str, vb, base, rq * 16, R3_CH, smem + R3_BUF, tid - 256);
            char* bq = smem; float* w = (float*)bq + R3_STR / 4 + lane; const int p = wid - 4;
            float G = 1.f; for (int t = 0; t < 8 * p; ++t) G *= w[t * 64];
            float* r = (float*)bq + lane; float* k = r + 2 * (R3_STR / 4); float* q = r + 3 * (R3_STR / 4); float* a = r + 4 * (R3_STR / 4);
#pragma unroll
            for (int u = 0; u < 8; ++u) { const int t = 8 * p + u; const float Gold = G; G *= w[t * 64]; const float inv = rcpf_(G); r[t * 64] *= G; q[t * 64] *= Gold; k[t * 64] *= inv; a[t * 64] *= inv; }
            if (p == 3) gcarea[lane] = G; }
        __syncthreads();
        const int rr = lane >> 4, cg = lane & 15, rg = rq * 4 + wid;
        const size_t voff = base + rg * 4 + rr;
        f32x2 s01 = {0.f, 0.f}, s23 = {0.f, 0.f};
        for (int c = 0; c < NCH; ++c) {
            if (wid >= 4) {
                if (c >= 1 && tid - 256 < 64) { const int id = tid - 256;
                    *(u32x4*)(yb + base + (size_t)((c - 1) * R3_CH + (id >> 1)) * DM + rq * 16 + (id & 1) * 8) = *(const u32x4*)(ystage + ((c - 1) & 1) * 512 + (id >> 1) * 16 + (id & 1) * 8); }
                if (c + 2 < NCH) r3_stage_raw(str, vb, base, rq * 16, (c + 2) * R3_CH, smem + ((c + 2) % 3) * R3_BUF, tid - 256);
                if (c + 1 < NCH) { char* bq = smem + ((c + 1) % 3) * R3_BUF; float* w = (float*)bq + R3_STR / 4 + lane; const int p = wid - 4;
                    float G = 1.f; for (int t = 0; t < 8 * p; ++t) G *= w[t * 64];
                    float* r = (float*)bq + lane; float* k = r + 2 * (R3_STR / 4); float* q = r + 3 * (R3_STR / 4); float* a = r + 4 * (R3_STR / 4);
#pragma unroll
                    for (int u = 0; u < 8; ++u) { const int t = 8 * p + u; const float Gold = G; G *= w[t * 64]; const float inv = rcpf_(G); r[t * 64] *= G; q[t * 64] *= Gold; k[t * 64] *= inv; a[t * 64] *= inv; }
                    if (p == 3) gcarea[((c + 1) % 3) * 64 + lane] = G; }
            } else {
                const char* buf = smem + (c % 3) * R3_BUF;
                f32x4 R_[2][2], K_[2][2], Q_[2][2], A_[2][2]; float V_[2][2];
#define R3_LD(bf, t0) { _Pragma("unroll") for (int u = 0; u < 2; ++u) { const char* p = buf + ((t0) + u) * 256 + cg * 16; \
                    R_[bf][u] = *(const f32x4*)p; K_[bf][u] = *(const f32x4*)(p + 2 * R3_STR); Q_[bf][u] = *(const f32x4*)(p + 3 * R3_STR); A_[bf][u] = *(const f32x4*)(p + 4 * R3_STR); \
                    V_[bf][u] = *(const float*)(buf + 5 * R3_STR + ((t0) + u) * 64 + (wid * 4 + rr) * 4); } }
#define R3_CP(bf, sl) { _Pragma("unroll") for (int u = 0; u < 2; ++u) { \
                    const f32x4 R = R_[bf][u], K = K_[bf][u], Q = Q_[bf][u], A = A_[bf][u]; const float vv = V_[bf][u]; \
                    const f32x2 r01 = {R[0], R[1]}, r23 = {R[2], R[3]}, k01 = {K[0], K[1]}, k23 = {K[2], K[3]}; \
                    const f32x2 q01 = {Q[0], Q[1]}, q23 = {Q[2], Q[3]}, a01 = {A[0], A[1]}, a23 = {A[2], A[3]}; \
                    const f32x2 pq = s01 * q01 + s23 * q23; \
                    const float sa = -row16_sum(pq.x + pq.y); \
                    const f32x2 sa2 = {sa, sa}, vv2 = {vv, vv}; \
                    s01 = (s01 + vv2 * k01) + sa2 * a01; s23 = (s23 + vv2 * k23) + sa2 * a23; \
                    const f32x2 py = s01 * r01 + s23 * r23; \
                    const float y = row16_sum(py.x + py.y); \
                    yv = (cg == (sl) + u) ? y : yv; } }
                R3_LD(0, 0)
#pragma unroll 1
                for (int t8 = 0; t8 < R3_CH; t8 += 8) {
                    float yv = 0.f;
                    R3_LD(1, t8 + 2)
                    R3_CP(0, 0)
                    R3_LD(0, t8 + 4)
                    R3_CP(1, 2)
                    R3_LD(1, t8 + 6)
                    R3_CP(0, 4)
                    if (t8 + 8 < R3_CH) R3_LD(0, t8 + 8)
                    R3_CP(1, 6)
                    if (cg < 8) ystage[(c & 1) * 512 + (t8 + cg) * 16 + wid * 4 + rr] = f2bf(yv);
                }
#undef R3_LD
#undef R3_CP
                const f32x4 GC = *(const f32x4*)(gcarea + (c % 3) * 64 + cg * 4);
                s01 *= (f32x2){GC[0], GC[1]}; s23 *= (f32x2){GC[2], GC[3]};
            }
            __syncthreads();
        }
        if (wid >= 4 && tid - 256 < 64) { const int id = tid - 256;
            *(u32x4*)(yb + base + (size_t)((NCH - 1) * R3_CH + (id >> 1)) * DM + rq * 16 + (id & 1) * 8) = *(const u32x4*)(ystage + ((NCH - 1) & 1) * 512 + (id >> 1) * 16 + (id & 1) * 8); }
        __syncthreads();
    }
}
constexpr int RC_NP = 8, RC_SLOT = 18688, RC_LDS = 18688;
constexpr int RC_QT = 0, RC_RR = 4096, RC_BG = 8192, RC_AB = 12288, RC_D0 = 14336, RC_U0 = 16384, RC_Y0 = 17408, RC_G = 18432;
#define R3C_FENCE() asm volatile("" ::: "memory")
constexpr int RC_P = 144;
DEV bf16x8 r3c_permfrag(const char* rowp, int q) {
    const u32x2 lo = *(const u32x2*)(rowp + 8 * q), hi = *(const u32x2*)(rowp + 32 + 8 * q);
    u32x4 w; w.x = lo.x; w.y = lo.y; w.z = hi.x; w.w = hi.y; return __builtin_bit_cast(bf16x8, w);
}
DEV bf16x8 r3c_neg(bf16x8 a) { u32x4 w = __builtin_bit_cast(u32x4, a); w.x ^= 0x80008000u; w.y ^= 0x80008000u; w.z ^= 0x80008000u; w.w ^= 0x80008000u; return __builtin_bit_cast(bf16x8, w); }
DEV u32x4 r3c_scale8(u32x4 d, f32x4 a, f32x4 b) {
    u32x4 o; o.x = cvt_pk(bf_lo(d.x) * a[0], bf_hi(d.x) * a[1]); o.y = cvt_pk(bf_lo(d.y) * a[2], bf_hi(d.y) * a[3]);
    o.z = cvt_pk(bf_lo(d.z) * b[0], bf_hi(d.z) * b[1]); o.w = cvt_pk(bf_lo(d.w) * b[2], bf_hi(d.w) * b[3]); return o;
}
DEV u32x2 r3c_pk4(f32x4 v) { u32x2 w; w.x = cvt_pk(v[0], v[1]); w.y = cvt_pk(v[2], v[3]); return w; }
DEV f32x4 r3c_up4(u32x2 w) { f32x4 v; v[0] = bf_lo(w.x); v[1] = bf_hi(w.x); v[2] = bf_lo(w.y); v[3] = bf_hi(w.y); return v; }
#define R3C_SCORE(dst, A, B, ROWLESS, STRICT) { _Pragma("unroll") for (int a = 0; a < 2; ++a) { _Pragma("unroll") for (int b = 0; b < 2; ++b) { \
        f32x4 a_ = MFMA(A[a][0], B[b][0], z4); a_ = MFMA(A[a][1], B[b][1], a_); \
        _Pragma("unroll") for (int r = 0; r < 4; ++r) { const int row_ = 16 * a + 4 * q + r, col_ = 16 * b + m; const int lo_ = (ROWLESS) ? row_ : col_, hi_ = (ROWLESS) ? col_ : row_; \
            const bool keep_ = (STRICT) ? (lo_ < hi_) : (lo_ <= hi_); a_[r] = keep_ ? a_[r] : 0.f; } \
        dst[a][b] = a_; } } }
struct R3Raw { u32x4 dr[4], dw[4], dk[4], dq[4], da[4]; bf16x8 vfrag; };
DEV void r3c_load(R3Raw& W, const bf16_t* rb, const bf16_t* wb, const bf16_t* kkb, const bf16_t* vb, size_t base, int vrow0, int t0, int lane) {
    const int m = lane & 15, q = lane >> 4, tr = lane >> 3, j = lane & 7;
#pragma unroll
    for (int s = 0; s < 4; ++s) { const size_t o = base + (size_t)(t0 + 8 * s + tr) * DM + j * 8;
        W.dw[s] = *(const u32x4*)(wb + o); W.dr[s] = *(const u32x4*)(rb + o); W.dq[s] = *(const u32x4*)(kkb + o); }
    const bf16_t* vp = vb + base + (size_t)t0 * DM + vrow0 + m; unsigned e[8];
#pragma unroll
    for (int jj = 0; jj < 8; ++jj) { const int t = (jj < 4) ? 4 * q + jj : 16 + 4 * q + jj - 4; e[jj] = vp[(size_t)t * DM]; }
    u32x4 w; w.x = e[0] | (e[1] << 16); w.y = e[2] | (e[3] << 16); w.z = e[4] | (e[5] << 16); w.w = e[6] | (e[7] << 16); W.vfrag = __builtin_bit_cast(bf16x8, w);
}
DEV void r3c_load2(R3Raw& W, const bf16_t* kb, const bf16_t* kab, size_t base, int t0, int lane) {
    const int tr = lane >> 3, j = lane & 7;
#pragma unroll
    for (int s = 0; s < 4; ++s) { const size_t o = base + (size_t)(t0 + 8 * s + tr) * DM + j * 8; W.dk[s] = *(const u32x4*)(kb + o); W.da[s] = *(const u32x4*)(kab + o); }
}
DEV void r3c_produce(R3Raw& W, const bf16_t* kb, const bf16_t* kab, size_t base, int t0, char* lds, int lane) {
    const int m = lane & 15, q = lane >> 4, tr = lane >> 3, j = lane & 7;
    r3c_load2(W, kb, kab, base, t0, lane);
    const f32x4 z4 = {0.f, 0.f, 0.f, 0.f};
    char* Rh = lds; char* Qh = lds + 32 * RC_P; char* Kh = lds + 64 * RC_P; char* Bh = lds + 96 * RC_P; float* G31a = (float*)(lds + 128 * RC_P);
    float* Gb = (float*)Kh;
    const bf16x8 vfrag = W.vfrag;
#pragma unroll
    for (int s = 0; s < 4; ++s) { float* gp = Gb + (8 * s + tr) * 64 + 8 * j; f32x4 a, b; const u32x4 d = W.dw[s];
        a[0] = bf_lo(d.x); a[1] = bf_hi(d.x); a[2] = bf_lo(d.y); a[3] = bf_hi(d.y); b[0] = bf_lo(d.z); b[1] = bf_hi(d.z); b[2] = bf_lo(d.w); b[3] = bf_hi(d.w);
        *(f32x4*)gp = a; *(f32x4*)(gp + 4) = b; }
    R3C_FENCE();
    { float g[32];
#pragma unroll
      for (int t = 0; t < 32; ++t) g[t] = Gb[t * 64 + lane];
      float G = 1.f;
#pragma unroll
      for (int t = 0; t < 32; ++t) { G *= g[t]; Gb[t * 64 + lane] = G; }
      G31a[lane] = G; }
    R3C_FENCE();
    { u32x4 kh[4], bh[4];
#pragma unroll
      for (int s = 0; s < 4; ++s) { const int t = 8 * s + tr, tp = t > 0 ? t - 1 : 0;
          const f32x4 g0 = *(const f32x4*)(Gb + t * 64 + 8 * j), g1 = *(const f32x4*)(Gb + t * 64 + 8 * j + 4);
          f32x4 p0 = *(const f32x4*)(Gb + tp * 64 + 8 * j), p1 = *(const f32x4*)(Gb + tp * 64 + 8 * j + 4);
          if (t == 0) { p0 = (f32x4){1.f, 1.f, 1.f, 1.f}; p1 = p0; }
          f32x4 i0, i1;
#pragma unroll
          for (int e = 0; e < 4; ++e) { i0[e] = rcpf_(g0[e]); i1[e] = rcpf_(g1[e]); }
          *(u32x4*)(Rh + t * RC_P + j * 16) = r3c_scale8(W.dr[s], g0, g1);
          *(u32x4*)(Qh + t * RC_P + j * 16) = r3c_scale8(W.dq[s], p0, p1);
          kh[s] = r3c_scale8(W.dk[s], i0, i1); bh[s] = r3c_scale8(W.da[s], i0, i1); }
      R3C_FENCE();
#pragma unroll
      for (int s = 0; s < 4; ++s) { const int t = 8 * s + tr; *(u32x4*)(Kh + t * RC_P + j * 16) = kh[s]; *(u32x4*)(Bh + t * RC_P + j * 16) = bh[s]; } }
    R3C_FENCE();
    bf16x8 Qa[2][2], Ra[2][2], Kb[2][2], Bb[2][2];
#pragma unroll
    for (int x = 0; x < 2; ++x)
#pragma unroll
        for (int ks = 0; ks < 2; ++ks) { const int off = (16 * x + m) * RC_P + (32 * ks + 8 * q) * 2;
            Qa[x][ks] = *(const bf16x8*)(Qh + off); Ra[x][ks] = *(const bf16x8*)(Rh + off); Kb[x][ks] = *(const bf16x8*)(Kh + off); Bb[x][ks] = *(const bf16x8*)(Bh + off); }
    f32x4 Tt[2][2], PN[2][2], PT[2][2], Z[2][5];
    R3C_SCORE(Tt, Kb, Qa, true, true)
    Z[0][4] = MFMA(pack8(Tt[0][0], Tt[1][0]), vfrag, z4); Z[1][4] = MFMA(pack8(Tt[0][1], Tt[1][1]), vfrag, z4);
    R3C_SCORE(Tt, Kb, Ra, true, false)
    u32x2 oY0[2]; oY0[0] = r3c_pk4(MFMA(pack8(Tt[0][0], Tt[1][0]), vfrag, z4)); oY0[1] = r3c_pk4(MFMA(pack8(Tt[0][1], Tt[1][1]), vfrag, z4));
    R3C_SCORE(Tt, Bb, Ra, true, false)
    bf16x8 oAB[2]; oAB[0] = r3c_neg(pack8(Tt[0][0], Tt[1][0])); oAB[1] = r3c_neg(pack8(Tt[0][1], Tt[1][1]));
    R3C_SCORE(PN, Qa, Bb, false, true)
    R3C_SCORE(PT, Bb, Qa, true, true)
#pragma unroll
    for (int mt = 0; mt < 2; ++mt)
#pragma unroll
        for (int n = 0; n < 4; ++n)
#pragma unroll
            for (int r = 0; r < 4; ++r) Z[mt][n][r] = bf2f(*(const bf16_t*)(Qh + (16 * mt + 4 * q + r) * RC_P + (16 * n + m) * 2));
#pragma unroll
    for (int lev = 0; lev < 5; ++lev) {
        bf16x8 fa[2], fb[2], zb[5];
#pragma unroll
        for (int x = 0; x < 2; ++x) { fa[x] = pack8(PT[0][x], PT[1][x]); fb[x] = pack8(PN[0][x], PN[1][x]); }
#pragma unroll
        for (int n = 0; n < 5; ++n) zb[n] = pack8(Z[0][n], Z[1][n]);
        const bf16x8 a0 = lev == 0 ? r3c_neg(fa[0]) : fa[0], a1 = lev == 0 ? r3c_neg(fa[1]) : fa[1];
#pragma unroll
        for (int n = 0; n < 5; ++n) { Z[0][n] = MFMA(a0, zb[n], Z[0][n]); Z[1][n] = MFMA(a1, zb[n], Z[1][n]); }
        if (lev < 4) {
#pragma unroll
            for (int a = 0; a < 2; ++a)
#pragma unroll
                for (int b = 0; b < 2; ++b) { PN[a][b] = MFMA(fa[a], fb[b], z4); PT[a][b] = MFMA(fb[a], fa[b], z4); }
        }
    }
    R3C_FENCE();
#pragma unroll
    for (int mt = 0; mt < 2; ++mt)
#pragma unroll
        for (int n = 0; n < 4; ++n)
#pragma unroll
            for (int r = 0; r < 4; ++r) *(bf16_t*)(Qh + (16 * mt + 4 * q + r) * RC_P + (16 * n + m) * 2) = f2bf(Z[mt][n][r]);
    R3C_FENCE();
    bf16x8 oQT[4], oRR[4], oBG[4]; u32x2 oD0[4];
#pragma unroll
    for (int mt = 0; mt < 2; ++mt)
#pragma unroll
        for (int ks = 0; ks < 2; ++ks) { oQT[mt * 2 + ks] = r3c_permfrag(Qh + (16 * mt + m) * RC_P + ks * 64, q); oRR[mt * 2 + ks] = r3c_permfrag(Rh + (16 * mt + m) * RC_P + ks * 64, q); }
#pragma unroll
    for (int ct = 0; ct < 4; ++ct) { const int ch = 16 * ct + m; const float g = G31a[ch]; f32x4 k0, k1, b0, b1;
#pragma unroll
        for (int jj = 0; jj < 4; ++jj) { const int ta = 4 * q + jj, tb = 16 + 4 * q + jj;
            k0[jj] = bf2f(*(const bf16_t*)(Kh + ta * RC_P + ch * 2)) * g; k1[jj] = bf2f(*(const bf16_t*)(Kh + tb * RC_P + ch * 2)) * g;
            b0[jj] = bf2f(*(const bf16_t*)(Bh + ta * RC_P + ch * 2)) * -g; b1[jj] = bf2f(*(const bf16_t*)(Bh + tb * RC_P + ch * 2)) * -g; }
        oBG[ct] = pack8(b0, b1);
        oD0[ct] = r3c_pk4(MFMA(pack8(k0, k1), vfrag, z4)); }
    asm volatile("s_waitcnt lgkmcnt(0)" ::: "memory");
#pragma unroll
    for (int f = 0; f < 4; ++f) { *(bf16x8*)(lds + RC_QT + f * 1024 + lane * 16) = oQT[f]; *(bf16x8*)(lds + RC_RR + f * 1024 + lane * 16) = oRR[f]; *(bf16x8*)(lds + RC_BG + f * 1024 + lane * 16) = oBG[f];
        *(u32x2*)(lds + RC_D0 + f * 512 + lane * 8) = oD0[f]; }
#pragma unroll
    for (int f = 0; f < 2; ++f) { *(bf16x8*)(lds + RC_AB + f * 1024 + lane * 16) = oAB[f]; *(u32x2*)(lds + RC_U0 + f * 512 + lane * 8) = r3c_pk4(Z[f][4]); *(u32x2*)(lds + RC_Y0 + f * 512 + lane * 8) = oY0[f]; }
    R3C_FENCE();
}
DEV void r3c_walk(f32x4 (&S)[4], char* slot, int lane) {
    const int q = lane >> 4;
    bf16x8 QT[2][2], BG[4]; u32x2 D0[4], U0[2]; f32x4 Gv[4];
#pragma unroll
    for (int f = 0; f < 4; ++f) { QT[f >> 1][f & 1] = *(const bf16x8*)(slot + RC_QT + f * 1024 + lane * 16); BG[f] = *(const bf16x8*)(slot + RC_BG + f * 1024 + lane * 16);
        D0[f] = *(const u32x2*)(slot + RC_D0 + f * 512 + lane * 8); Gv[f] = *(const f32x4*)(slot + RC_G + (16 * f + 4 * q) * 4); }
#pragma unroll
    for (int f = 0; f < 2; ++f) U0[f] = *(const u32x2*)(slot + RC_U0 + f * 512 + lane * 8);
    const bf16x8 sB0 = pack8(S[0], S[1]), sB1 = pack8(S[2], S[3]);
    f32x4 U[2];
#pragma unroll
    for (int mt = 0; mt < 2; ++mt) { U[mt] = r3c_up4(U0[mt]); U[mt] = MFMA(QT[mt][0], sB0, U[mt]); U[mt] = MFMA(QT[mt][1], sB1, U[mt]); }
    const bf16x8 uB = pack8(U[0], U[1]);
#pragma unroll
    for (int ct = 0; ct < 4; ++ct) { S[ct] = S[ct] * Gv[ct] + r3c_up4(D0[ct]); S[ct] = MFMA(BG[ct], uB, S[ct]); }
    R3C_FENCE();
    *(bf16x8*)(slot + RC_QT + lane * 16) = sB0; *(bf16x8*)(slot + RC_QT + 1024 + lane * 16) = sB1; *(bf16x8*)(slot + RC_QT + 2048 + lane * 16) = uB;
    R3C_FENCE();
}
DEV void r3c_yout(const char* slot, bf16_t* yout, int lane) {
    const int m = lane & 15, q = lane >> 4;
    const bf16x8 sB0 = *(const bf16x8*)(slot + RC_QT + lane * 16), sB1 = *(const bf16x8*)(slot + RC_QT + 1024 + lane * 16), uB = *(const bf16x8*)(slot + RC_QT + 2048 + lane * 16);
#pragma unroll
    for (int mt = 0; mt < 2; ++mt) {
        f32x4 Y = r3c_up4(*(const u32x2*)(slot + RC_Y0 + mt * 512 + lane * 8));
        Y = MFMA(*(const bf16x8*)(slot + RC_RR + (mt * 2) * 1024 + lane * 16), sB0, Y); Y = MFMA(*(const bf16x8*)(slot + RC_RR + (mt * 2 + 1) * 1024 + lane * 16), sB1, Y);
        Y = MFMA(*(const bf16x8*)(slot + RC_AB + mt * 1024 + lane * 16), uB, Y);
#pragma unroll
        for (int r = 0; r < 4; ++r) yout[(size_t)(16 * mt + 4 * q + r) * DM + m] = f2bf(Y[r]); }
    R3C_FENCE();
}
DEV void phase_r3c(const bf16_t* rb, const bf16_t* wb, const bf16_t* kb, const bf16_t* kkb, const bf16_t* kab, const bf16_t* vb, bf16_t* yb, char* smem) {
    const int tid = tidx(), lane = tid & 63, wid = __builtin_amdgcn_readfirstlane(tid >> 6);
    constexpr int NCH = SEQ / 32, NR = NCH / RC_NP;
    for (int task = blockIdx.x; task < 256; task += gridDim.x) {
        const int xc = task & 7, ix = task >> 3, bh = xc * 8 + (ix >> 2), b = bh >> 4, h = bh & 15, rq = ix & 3;
        const size_t base = (size_t)b * SEQ * DM + h * 64;
        f32x4 S[4];
#pragma unroll
        for (int ct = 0; ct < 4; ++ct) S[ct] = (f32x4){0.f, 0.f, 0.f, 0.f};
        R3Raw W; r3c_load(W, rb, wb, kkb, vb, base, rq * 16, wid * 32, lane);
        for (int rd = 0; rd < NR; ++rd) {
            r3c_produce(W, kb, kab, base, (rd * RC_NP + wid) * 32, smem + wid * RC_LDS, lane);
            if (rd + 1 < NR) r3c_load(W, rb, wb, kkb, vb, base, rq * 16, ((rd + 1) * RC_NP + wid) * 32, lane);
            asm volatile("s_waitcnt lgkmcnt(0)" ::: "memory");
            __syncthreads();
            if (wid == 0) {
#pragma unroll 1
                for (int p = 0; p < RC_NP; ++p) r3c_walk(S, smem + p * RC_LDS, lane);
                asm volatile("s_waitcnt lgkmcnt(0)" ::: "memory");
            }
            __syncthreads();
            r3c_yout(smem + wid * RC_LDS, yb + base + (size_t)(rd * RC_NP + wid) * 32 * DM + rq * 16, lane);
        }
    }
}
DEV void phase_r4(const bf16_t* hid, const bf16_t* G2T, const RwkvW& W, const bf16_t* yb, const bf16_t* vb, const float* bsc, bf16_t* outb, char* smem) {
    const LaneId L = lane_id();
    const int ntn = 8, nunits = (T / 256) * ntn;
    for (int u = blockIdx.x; u < nunits; u += gridDim.x) {
        const int tm = u / ntn, tn = u % ntn;
        f32x4 acc[4][4];
        gemm_core(acc, LdPlain{hid + (size_t)tm * 256 * HIDP + 128, HIDP}, LdPlain{G2T + (size_t)tn * 128 * 128, 128}, 128, smem);
        const int head = tn * 2 + L.wn;
#pragma unroll
        for (int m = 0; m < 4; ++m) {
            const size_t row = (size_t)tm * 256 + L.wm * 64 + m * 16 + L.fr;
            f32x4 yv[4]; float s = 0.f;
#pragma unroll
            for (int n = 0; n < 4; ++n) { yv[n] = ld_bf4(yb + row * DM + head * 64 + n * 16 + L.fq * 4); s += (yv[n][0] + yv[n][1]) + (yv[n][2] + yv[n][3]); }
            s += __shfl_xor(s, 16); s += __shfl_xor(s, 32);
            const float mean = s * (1.0f / 64.0f); float q = 0.f;
#pragma unroll
            for (int n = 0; n < 4; ++n) { const f32x4 d = yv[n] - mean; q += (d[0] * d[0] + d[1] * d[1]) + (d[2] * d[2] + d[3] * d[3]); }
            q += __shfl_xor(q, 16); q += __shfl_xor(q, 32);
            const float rstd = rsqrtf(q * (1.0f / 64.0f) + 64e-5f);
            const float bs = bsc[row * 16 + head];
#pragma unroll
            for (int n = 0; n < 4; ++n) { const int col = head * 64 + n * 16 + L.fq * 4;
                const f32x4 lw = *(const f32x4*)(W.ln_w + col), lb = *(const f32x4*)(W.ln_b + col), vv = ld_bf4(vb + row * DM + col);
                f32x4 o = ((yv[n] - mean) * rstd * lw + lb + vv * bs);
                o = o * acc[m][n];
                st_bf4(outb + row * DM + col, o); }
        }
    }
}

struct NsaBuf { bf16_t *q, *kcmp, *vcmp, *kslc, *kwin, *vslcT, *vwinT, *hid, *kc, *vcT, *o; float* gates; };
DEV void phase_n1(const bf16_t* xn, const bf16_t* Bt, const NsaBuf& B, char* smem) {
    const LaneId L = lane_id();
    const int ntn = 15, nunits = (T / 256) * ntn;
    for (int u = blockIdx.x; u < nunits; u += gridDim.x) {
        const int tm = u / ntn, tn = u % ntn;
        f32x4 acc[4][4];
        gemm_core(acc, LdPlain{xn + (size_t)tm * 256 * DM, DM}, LdPlain{Bt + (size_t)tn * 128 * DM, DM}, DM, smem);
#pragma unroll
        for (int m = 0; m < 4; ++m)
#pragma unroll
            for (int n = 0; n < 4; ++n) {
                const size_t row = (size_t)tm * 256 + L.wm * 64 + m * 16 + L.fr; const int c = L.wn * 64 + n * 16 + L.fq * 4; f32x4 v = acc[m][n];
                if (tn < 8) st_bf4(B.q + row * DM + tn * 128 + c, v * 0.125f);
                else if (tn < 14) {
                    const int cc = tn - 8;
                    if (cc == 0) st_bf4(B.kcmp + row * 128 + c, v);
                    else if (cc == 1) st_bf4(B.vcmp + row * 128 + c, v);
                    else if (cc == 2) st_bf4(B.kslc + row * 128 + c, v);
                    else if (cc == 4) st_bf4(B.kwin + row * 128 + c, v);
                    else { bf16_t* dst = cc == 3 ? B.vslcT : B.vwinT; const int b = (int)(row >> 13), t = (int)(row & (SEQ - 1));
                        for (int j = 0; j < 4; ++j) dst[((size_t)(b * 128 + c + j)) * SEQ + t] = f2bf(v[j]); }
                } else { if (c < 48) { for (int j = 0; j < 4; ++j) B.gates[row * 48 + c + j] = sigmoidf_(v[j]); } }
            }
    }
}
DEV float gelu_tanh(float x) { const float u = 0.7978845608028654f * (x + 0.044715f * x * x * x); return 0.5f * x * (1.0f + tanhf(u)); }
DEV void phase_n2a(const bf16_t* W1T, const float* biasp, const NsaBuf& B, char* smem) {
    const LaneId L = lane_id();
    for (int u = blockIdx.x; u < 64; u += gridDim.x) {
        const int c = u >> 5, tm = (u >> 1) & 15, tn = u & 1;
        f32x4 acc[4][4];
        gemm_core(acc, LdCmp{c ? B.vcmp : B.kcmp, tm * 256}, LdPlain{W1T + (size_t)c * 256 * 2048 + (size_t)tn * 128 * 2048, 2048}, 2048, smem);
#pragma unroll
        for (int m = 0; m < 4; ++m)
#pragma unroll
            for (int n = 0; n < 4; ++n) { const size_t row = (size_t)tm * 256 + L.wm * 64 + m * 16 + L.fr; const int col = tn * 128 + L.wn * 64 + n * 16 + L.fq * 4;
                const f32x4 bb = *(const f32x4*)(biasp + c * 256 + col); f32x4 v;
                for (int j = 0; j < 4; ++j) v[j] = gelu_tanh(acc[m][n][j] + bb[j]);
                st_bf4(B.hid + ((size_t)c * 4096 + row) * 256 + col, v); }
    }
}
DEV void phase_n2b(const bf16_t* W2T, const NsaBuf& B, char* smem) {
    const LaneId L = lane_id();
    for (int u = blockIdx.x; u < 32; u += gridDim.x) {
        const int c = u >> 4, tm = u & 15;
        f32x4 acc[4][4];
        gemm_core(acc, LdPlain{B.hid + ((size_t)c * 4096 + tm * 256) * 256, 256}, LdPlain{W2T + (size_t)c * 128 * 256, 256}, 256, smem);
        if (L.wn == 0) {
#pragma unroll
            for (int m = 0; m < 4; ++m)
#pragma unroll
                for (int n = 0; n < 4; ++n) { const int row = tm * 256 + L.wm * 64 + m * 16 + L.fr, d = n * 16 + L.fq * 4;
                    const int b = row >> 10, nn = (row >> 1) & 511, g = row & 1;
                    if (c == 0) st_bf4(B.kc + ((size_t)((b * 2 + g) * 512 + nn)) * 64 + d, acc[m][n]);
                    else { for (int j = 0; j < 4; ++j) B.vcT[((size_t)((b * 2 + g) * 64 + d + j)) * 512 + nn] = f2bf(acc[m][n][j]); } }
        }
    }
}
#define NEGV (-1e30f)
#define LOG2E_ 1.4426950408889634f
DEV u32x4 n3_ldg(const bf16_t* kbase, long kpitch, const bf16_t* vbase, long vpitch, int kb, int tid) {
    if (tid < 256) return *(const u32x4*)(kbase + (size_t)(kb + (tid >> 3)) * kpitch + (tid & 7) * 8);
    const int i = tid - 256; return *(const u32x4*)(vbase + (size_t)(i >> 2) * vpitch + kb + (i & 3) * 8);
}
DEV void n3_sts(char* buf, u32x4 v, int tid) {
    if (tid < 256) { const int row = tid >> 3, c = tid & 7, sw = ((row >> 1) & 1) | (((row >> 3) & 3) << 1); *(u32x4*)(buf + row * 128 + ((c ^ sw) << 4)) = v; }
    else { const int i = tid - 256, d = i >> 2, c = i & 3; *(u32x4*)(buf + 4096 + d * 64 + ((c ^ ((d >> 2) & 3)) << 4)) = v; }
}
DEV void phase_n3(const NsaBuf& B, char* smem) {
    const int tid = tidx(), lane = tid & 63, wid = tid >> 6, m = lane & 15, fq = lane >> 4, qh = m >> 3, hh = m & 7;
    float* psum = (float*)(smem + wid * 8704); int* ulist = (int*)(smem + wid * 8704 + 8192);
    char* stg = smem + 8 * 8704;
    const int kperm = 8 * (m >> 2) + (m & 3);
    const int kswz = ((m >> 1) & 1) | ((m >> 2) << 1), vswz = (m >> 2) & 3;
    const int koffA = kperm * 128, koffB = (kperm + 4) * 128, voff = 4096 + m * 64 + ((fq ^ vswz) << 4);
    const f32x4 z4 = {0.f, 0.f, 0.f, 0.f};
    const int nrank = (int)gridDim.x >> 3, bg = (int)blockIdx.x & 7;
    for (int qblk = (int)blockIdx.x >> 3; qblk < 256 && (int)blockIdx.x < nrank * 8; qblk += nrank) {
        const int g = bg & 1, b = bg >> 1, t0b = qblk * 32, t0 = t0b + wid * 4;
        int tq[2]; bf16x8 qf[2][2]; float gc[2], gs[2], gw[2]; u32x2 opk[2][4];
#pragma unroll
        for (int rb = 0; rb < 2; ++rb) {
            tq[rb] = t0 + rb * 2 + qh;
            const bf16_t* qp = B.q + ((size_t)(b * SEQ + tq[rb])) * DM + (g * 8 + hh) * 64 + fq * 8;
            qf[rb][0] = __builtin_nontemporal_load((const bf16x8*)qp); qf[rb][1] = __builtin_nontemporal_load((const bf16x8*)(qp + 32));
            const float* gp = B.gates + ((size_t)(b * SEQ + tq[rb])) * 48 + g * 24 + hh * 3;
            gc[rb] = gp[0]; gs[rb] = gp[1]; gw[rb] = gp[2];
        }
#define N3_KFRAGS(buf) const bf16x8 kA0 = *(const bf16x8*)((buf) + koffA + (((0 + fq) ^ kswz) << 4)), kA1 = *(const bf16x8*)((buf) + koffA + (((4 + fq) ^ kswz) << 4)), \
                                    kB0 = *(const bf16x8*)((buf) + koffB + (((0 + fq) ^ kswz) << 4)), kB1 = *(const bf16x8*)((buf) + koffB + (((4 + fq) ^ kswz) << 4));
        {
            const int tid = tidx(), lane = tid & 63, m = lane & 15, fq = (lane >> 4), qh = m >> 3, hh = m & 7, kperm = 8 * (m >> 2) + (m & 3); (void)hh; (void)qh; (void)lane;
            const int kswz = ((m >> 1) & 1) | ((m >> 2) << 1), vswz = (m >> 2) & 3, koffA = kperm * 128, koffB = (kperm + 4) * 128, voff = 4096 + m * 64 + ((fq ^ vswz) << 4);
            int nv[2];
#pragma unroll
            for (int rb = 0; rb < 2; ++rb) nv[rb] = tq[rb] >= 31 ? ((tq[rb] - 31) >> 4) + 1 : 0;
            const int nvmax = (t0b + 31 >= 31) ? ((t0b + 31 - 31) >> 4) + 1 : 0, ngrp = (nvmax + 31) >> 5;
#pragma unroll
            for (int i = 0; i < 32; ++i) psum[lane + 64 * i] = 0.f;
            const bf16_t* kcb = B.kc + (size_t)((b * 2 + g) * 512) * 64; const bf16_t* vcb = B.vcT + (size_t)((b * 2 + g) * 64) * 512;
            float mx[2] = {NEGV, NEGV}, l[2] = {0.f, 0.f};
            u32x4 stv;
            if (ngrp > 0) { stv = n3_ldg(kcb, 64, vcb, 512, 0, tid); n3_sts(stg, stv, tid); }
            __syncthreads();
            for (int grp = 0; grp < ngrp; ++grp) {
                const int kb = grp * 32; const bool more = grp + 1 < ngrp;
                if (more) stv = n3_ldg(kcb, 64, vcb, 512, kb + 32, tid);
                const char* buf = stg + (grp & 1) * 8192;
                N3_KFRAGS(buf)
#pragma unroll
                for (int rb = 0; rb < 2; ++rb) {
                    f32x4 sA = MFMA(kA0, qf[rb][0], z4); sA = MFMA(kA1, qf[rb][1], sA);
                    f32x4 sB = MFMA(kB0, qf[rb][0], z4); sB = MFMA(kB1, qf[rb][1], sB);
                    const bool full = kb + 32 <= nv[rb], part = !full && kb < nv[rb];
                    if (__ballot(part) == 0ull) {
                        const float m8 = fmaxf(fmaxf(fmaxf(sA[0], sA[1]), fmaxf(sA[2], sA[3])), fmaxf(fmaxf(sB[0], sB[1]), fmaxf(sB[2], sB[3])));
                        const float mn = fmaxf(mx[rb], full ? m8 : NEGV), tl = (full ? mn : 1e30f) * LOG2E_; float add = 0.f;
#pragma unroll
                        for (int j = 0; j < 4; ++j) add += __builtin_amdgcn_exp2f(fmaf(sA[j], LOG2E_, -tl)) + __builtin_amdgcn_exp2f(fmaf(sB[j], LOG2E_, -tl));
                        l[rb] = l[rb] * __expf(mx[rb] - mn) + add; mx[rb] = mn;
                    } else {
                    float gm = NEGV;
#pragma unroll
                    for (int j = 0; j < 4; ++j) { if (kb + 8 * fq + j < nv[rb]) gm = fmaxf(gm, sA[j]); if (kb + 8 * fq + 4 + j < nv[rb]) gm = fmaxf(gm, sB[j]); }
                    const float mn = fmaxf(mx[rb], gm); float add = 0.f;
#pragma unroll
                    for (int j = 0; j < 4; ++j) { if (kb + 8 * fq + j < nv[rb]) add += __expf(sA[j] - mn); if (kb + 8 * fq + 4 + j < nv[rb]) add += __expf(sB[j] - mn); }
                    l[rb] = l[rb] * __expf(mx[rb] - mn) + add; mx[rb] = mn;
                    }
                }
                if (more) n3_sts(stg + ((grp + 1) & 1) * 8192, stv, tid);
                __syncthreads();
            }
            float M[2], inv[2];
#pragma unroll
            for (int rb = 0; rb < 2; ++rb) {
                float Mx = fmaxf(mx[rb], __shfl_xor(mx[rb], 16)); Mx = fmaxf(Mx, __shfl_xor(Mx, 32));
                float ll = l[rb] * __expf(mx[rb] - Mx); ll += __shfl_xor(ll, 16); ll += __shfl_xor(ll, 32);
                M[rb] = Mx; inv[rb] = ll > 0.f ? 1.0f / ll : 0.f;
            }
            f32x4 oc[2][4];
#pragma unroll
            for (int rb = 0; rb < 2; ++rb)
#pragma unroll
                for (int d = 0; d < 4; ++d) oc[rb][d] = z4;
            if (ngrp > 0) { stv = n3_ldg(kcb, 64, vcb, 512, 0, tid); n3_sts(stg, stv, tid); }
            __syncthreads();
            for (int grp = 0; grp < ngrp; ++grp) {
                const int kb = grp * 32; const bool more = grp + 1 < ngrp;
                if (more) stv = n3_ldg(kcb, 64, vcb, 512, kb + 32, tid);
                const char* buf = stg + (grp & 1) * 8192;
                N3_KFRAGS(buf)
                bf16x8 vf[4];
#pragma unroll
                for (int d = 0; d < 4; ++d) vf[d] = *(const bf16x8*)(buf + voff + d * 1024);
#pragma unroll
                for (int rb = 0; rb < 2; ++rb) {
                    f32x4 sA = MFMA(kA0, qf[rb][0], z4); sA = MFMA(kA1, qf[rb][1], sA);
                    f32x4 sB = MFMA(kB0, qf[rb][0], z4); sB = MFMA(kB1, qf[rb][1], sB);
                    f32x4 pA, pB;
                    const bool full = kb + 32 <= nv[rb], part = !full && kb < nv[rb];
                    if (__ballot(part) == 0ull) {
                        const float tl = (full ? M[rb] : 1e30f) * LOG2E_;
#pragma unroll
                        for (int j = 0; j < 4; ++j) { pA[j] = __builtin_amdgcn_exp2f(fmaf(sA[j], LOG2E_, -tl)) * inv[rb]; pB[j] = __builtin_amdgcn_exp2f(fmaf(sB[j], LOG2E_, -tl)) * inv[rb]; }
                    } else {
#pragma unroll
                    for (int j = 0; j < 4; ++j) { pA[j] = (kb + 8 * fq + j < nv[rb]) ? __expf(sA[j] - M[rb]) * inv[rb] : 0.f; pB[j] = (kb + 8 * fq + 4 + j < nv[rb]) ? __expf(sB[j] - M[rb]) * inv[rb] : 0.f; }
                    }
#pragma unroll
                    for (int j = 0; j < 4; ++j) {
                        float a = pA[j]; a += DPP_MOV(a, 0xB1); a += DPP_MOV(a, 0x4E); a += DPP_MOV(a, 0x141);
                        float c = pB[j]; c += DPP_MOV(c, 0xB1); c += DPP_MOV(c, 0x4E); c += DPP_MOV(c, 0x141);
                        if (hh == 0) { psum[(rb * 2 + qh) * 512 + kb + 8 * fq + j] = a; psum[(rb * 2 + qh) * 512 + kb + 8 * fq + 4 + j] = c; }
                    }
                    const bf16x8 pf = pack8(pA, pB);
#pragma unroll
                    for (int d = 0; d < 4; ++d) oc[rb][d] = MFMA(vf[d], pf, oc[rb][d]);
                }
                if (more) n3_sts(stg + ((grp + 1) & 1) * 8192, stv, tid);
                __syncthreads();
            }
#pragma unroll
            for (int rb = 0; rb < 2; ++rb)
#pragma unroll
                for (int d = 0; d < 4; ++d) { const f32x4 v = oc[rb][d] * gc[rb]; opk[rb][d].x = cvt_pk(v[0], v[1]); opk[rb][d].y = cvt_pk(v[2], v[3]); }
        }
        asm volatile("s_waitcnt lgkmcnt(0)" ::: "memory");
        __builtin_amdgcn_sched_barrier(0);
        unsigned long long mlo[4], mhi[4];
#pragma unroll
        for (int q2 = 0; q2 < 4; ++q2) {
            const int tqq = t0 + q2, cur = tqq >> 6;
            float sc[2];
#pragma unroll
            for (int c = 0; c < 2; ++c) { const int j = lane + 64 * c; float imp = 0.f;
                for (int n = 4 * j - 1; n <= 4 * j + 3; ++n) if (n >= 0) imp += psum[q2 * 512 + n];
                const bool causal = j * 64 <= tqq, forced = (j == 0) || (j == cur) || (j == cur - 1);
                sc[c] = causal ? imp + (forced ? 1e4f : 0.f) : NEGV; }
            unsigned k0 = __float_as_uint(sc[0]), k1 = __float_as_uint(sc[1]);
            k0 = (k0 & 0x80000000u) ? ~k0 : (k0 | 0x80000000u); k1 = (k1 & 0x80000000u) ? ~k1 : (k1 | 0x80000000u);
            unsigned Tk = 0u;
            for (int bit = 31; bit >= 0; --bit) { const unsigned cand = Tk | (1u << bit);
                const int cnt = __popcll(__ballot(k0 >= cand)) + __popcll(__ballot(k1 >= cand)); if (cnt >= 16) Tk = cand; }
            const int ngt = __popcll(__ballot(k0 > Tk)) + __popcll(__ballot(k1 > Tk)), needn = 16 - ngt;
            const unsigned long long eq0 = __ballot(k0 == Tk), eq1 = __ballot(k1 == Tk), belowm = (1ull << lane) - 1ull;
            const bool s0 = (k0 > Tk) || (k0 == Tk && __popcll(eq0 & belowm) < needn);
            const bool s1 = (k1 > Tk) || (k1 == Tk && __popcll(eq0) + __popcll(eq1 & belowm) < needn);
            mlo[q2] = __ballot(s0); mhi[q2] = __ballot(s1);
        }
        int nun;
        {
            const unsigned long long ulo = mlo[0] | mlo[1] | mlo[2] | mlo[3], uhi = mhi[0] | mhi[1] | mhi[2] | mhi[3];
            const unsigned long long below = (1ull << lane) - 1ull; const int nlo = __popcll(ulo);
            if ((ulo >> lane) & 1ull) { const int mb = (int)((mlo[0] >> lane) & 1ull) | ((int)((mlo[1] >> lane) & 1ull) << 1) | ((int)((mlo[2] >> lane) & 1ull) << 2) | ((int)((mlo[3] >> lane) & 1ull) << 3);
                ulist[__popcll(ulo & below)] = lane | (mb << 8); }
            if ((uhi >> lane) & 1ull) { const int mb = (int)((mhi[0] >> lane) & 1ull) | ((int)((mhi[1] >> lane) & 1ull) << 1) | ((int)((mhi[2] >> lane) & 1ull) << 2) | ((int)((mhi[3] >> lane) & 1ull) << 3);
                ulist[nlo + __popcll(uhi & below)] = (lane + 64) | (mb << 8); }
            nun = nlo + __popcll(uhi);
        }
        asm volatile("s_waitcnt lgkmcnt(0)" ::: "memory");
        __builtin_amdgcn_sched_barrier(0);
        {
            const int tid = tidx(), lane = tid & 63, m = lane & 15, fq = (lane >> 4), qh = m >> 3, hh = m & 7, kperm = 8 * (m >> 2) + (m & 3); (void)hh; (void)qh; (void)lane;
            const unsigned char* ksb = (const unsigned char*)B.kslc + (size_t)((b * 2 + g) * SEQ) * 64 + fq * 8; const unsigned char* vsb = (const unsigned char*)B.vslcT + (size_t)((b * 2 + g) * 128) * 4096 + m * 64 + 8 * fq;
            long q8[2][2];
#pragma unroll
            for (int rb = 0; rb < 2; ++rb)
#pragma unroll
                for (int ks = 0; ks < 2; ++ks) { const u32x4 w = __builtin_bit_cast(u32x4, qf[rb][ks]);
                    const unsigned lo = pack_fp8x4(bf_lo(w.x), bf_hi(w.x), bf_lo(w.y), bf_hi(w.y)), hi = pack_fp8x4(bf_lo(w.z), bf_hi(w.z), bf_lo(w.w), bf_hi(w.w));
                    q8[rb][ks] = (long)(((unsigned long long)hi << 32) | lo); }
            float mx[2] = {NEGV, NEGV}, l[2] = {0.f, 0.f}; f32x4 os[2][4];
#pragma unroll
            for (int rb = 0; rb < 2; ++rb)
#pragma unroll
                for (int d = 0; d < 4; ++d) os[rb][d] = z4;
            char* st8 = (char*)psum;
            const int srow = lane >> 2, sc0 = (lane & 3) * 2;
            u32x4 gk[4], gv[4];
            { const int blk0 = ulist[0] & 255; const unsigned char* kp = (const unsigned char*)B.kslc + ((size_t)((b * 2 + g) * SEQ) + blk0 * 64) * 64 + lane * 16; const unsigned char* vp = (const unsigned char*)B.vslcT + ((size_t)((b * 2 + g) * 128) + blk0) * 4096 + lane * 16;
#pragma unroll
              for (int i = 0; i < 4; ++i) { gk[i] = *(const u32x4*)(kp + i * 1024); gv[i] = *(const u32x4*)(vp + i * 1024); } }
            const int fsw = (m >> 2) << 1;
            for (int ib = 0; ib < nun; ++ib) {
                const int e = __builtin_amdgcn_readfirstlane(ulist[ib]);
#pragma unroll
                for (int i = 0; i < 4; ++i) { const int row = i * 16 + srow;
                    *(u32x4*)(st8 + row * 64 + ((sc0 ^ (((row >> 3) & 3) << 1)) << 3)) = gk[i];
                    *(u32x4*)(st8 + 4096 + row * 64 + ((sc0 ^ (((row >> 2) & 3) << 1)) << 3)) = gv[i]; }
                if (ib + 1 < nun) { const int blkn = ulist[ib + 1] & 255; const unsigned char* kp = (const unsigned char*)B.kslc + ((size_t)((b * 2 + g) * SEQ) + blkn * 64) * 64 + lane * 16; const unsigned char* vp = (const unsigned char*)B.vslcT + ((size_t)((b * 2 + g) * 128) + blkn) * 4096 + lane * 16;
#pragma unroll
                    for (int i = 0; i < 4; ++i) { gk[i] = *(const u32x4*)(kp + i * 1024); gv[i] = *(const u32x4*)(vp + i * 1024); } }
#pragma unroll
              for (int hf = 0; hf < 2; ++hf) {
                const int kb = (e & 255) * 64 + hf * 32;
                const char* kr = st8 + (hf * 32 + kperm) * 64;
                const long kA0 = *(const long*)(kr + ((fq ^ fsw) << 3)), kA1 = *(const long*)(kr + (((4 + fq) ^ fsw) << 3)), kB0 = *(const long*)(kr + 256 + ((fq ^ fsw) << 3)), kB1 = *(const long*)(kr + 256 + (((4 + fq) ^ fsw) << 3));
                long vf[4];
#pragma unroll
                for (int d = 0; d < 4; ++d) vf[d] = *(const long*)(st8 + 4096 + (d * 16 + m) * 64 + (((hf * 4 + fq) ^ fsw) << 3));
#pragma unroll
                for (int rb = 0; rb < 2; ++rb) {
                    if (((e >> (8 + rb * 2)) & 3) == 0) continue;
                    const bool mine = ((e >> (8 + rb * 2 + qh)) & 1) != 0;
                    f32x4 sA = MFMA8(kA0, q8[rb][0], z4); sA = MFMA8(kA1, q8[rb][1], sA);
                    f32x4 sB = MFMA8(kB0, q8[rb][0], z4); sB = MFMA8(kB1, q8[rb][1], sB);
                    const bool full = mine && kb + 31 <= tq[rb], part = mine && !full && kb <= tq[rb];
                    const bool fast = __ballot(part) == 0ull;
                    float gm = NEGV;
                    if (fast) { const float m8 = fmaxf(fmaxf(fmaxf(sA[0], sA[1]), fmaxf(sA[2], sA[3])), fmaxf(fmaxf(sB[0], sB[1]), fmaxf(sB[2], sB[3]))); gm = full ? m8 : NEGV; }
                    else {
#pragma unroll
                    for (int j = 0; j < 4; ++j) { if (mine && kb + 8 * fq + j <= tq[rb]) gm = fmaxf(gm, sA[j]); if (mine && kb + 8 * fq + 4 + j <= tq[rb]) gm = fmaxf(gm, sB[j]); }
                    }
                    if (__ballot(gm > mx[rb]) != 0ull) {
                        gm = fmaxf(gm, __shfl_xor(gm, 16)); gm = fmaxf(gm, __shfl_xor(gm, 32));
                        const float mn2 = fmaxf(mx[rb], gm), alpha = __expf(mx[rb] - mn2); mx[rb] = mn2; l[rb] *= alpha;
#pragma unroll
                        for (int d = 0; d < 4; ++d) os[rb][d] *= alpha;
                    }
                    const float mn = mx[rb];
                    f32x4 pA, pB; float add = 0.f;
                    if (fast) { const float tl = (full ? mn : 1e30f) * LOG2E_ - 7.f;
#pragma unroll
                        for (int j = 0; j < 4; ++j) { pA[j] = __builtin_amdgcn_exp2f(fmaf(sA[j], LOG2E_, -tl)); pB[j] = __builtin_amdgcn_exp2f(fmaf(sB[j], LOG2E_, -tl)); add += pA[j] + pB[j]; }
                    } else {
#pragma unroll
                    for (int j = 0; j < 4; ++j) { pA[j] = (mine && kb + 8 * fq + j <= tq[rb]) ? __expf(sA[j] - mn + 4.8520302639f) : 0.f; pB[j] = (mine && kb + 8 * fq + 4 + j <= tq[rb]) ? __expf(sB[j] - mn + 4.8520302639f) : 0.f; add += pA[j] + pB[j]; }
                    }
                    l[rb] += add;
                    const unsigned plo = pack_fp8x4(pA[0], pA[1], pA[2], pA[3]), phi = pack_fp8x4(pB[0], pB[1], pB[2], pB[3]);
                    const long pf = (long)(((unsigned long long)phi << 32) | plo);
#pragma unroll
                    for (int d = 0; d < 4; ++d) os[rb][d] = MFMA8(vf[d], pf, os[rb][d]);
                }
              }
            }
#pragma unroll
            for (int rb = 0; rb < 2; ++rb) {
                float ll = l[rb]; ll += __shfl_xor(ll, 16); ll += __shfl_xor(ll, 32);
                const float sc = ll > 0.f ? gs[rb] / ll : 0.f;
#pragma unroll
                for (int d = 0; d < 4; ++d) { f32x4 v = os[rb][d] * sc; v[0] += bf_lo(opk[rb][d].x); v[1] += bf_hi(opk[rb][d].x); v[2] += bf_lo(opk[rb][d].y); v[3] += bf_hi(opk[rb][d].y);
                    opk[rb][d].x = cvt_pk(v[0], v[1]); opk[rb][d].y = cvt_pk(v[2], v[3]); }
            }
        }
        __builtin_amdgcn_sched_barrier(0);
        {
            const int tid = tidx(), lane = tid & 63, m = lane & 15, fq = (lane >> 4), qh = m >> 3, hh = m & 7, kperm = 8 * (m >> 2) + (m & 3); (void)hh; (void)qh; (void)lane;
            const int kswz = ((m >> 1) & 1) | ((m >> 2) << 1), vswz = (m >> 2) & 3, koffA = kperm * 128, koffB = (kperm + 4) * 128, voff = 4096 + m * 64 + ((fq ^ vswz) << 4);
            const bf16_t* kwb = B.kwin + (size_t)b * SEQ * 128 + g * 64; const bf16_t* vwb = B.vwinT + (size_t)((b * 2 + g) * 64) * SEQ;
            float mx[2] = {NEGV, NEGV}, l[2] = {0.f, 0.f}; f32x4 ow[2][4];
#pragma unroll
            for (int rb = 0; rb < 2; ++rb)
#pragma unroll
                for (int d = 0; d < 4; ++d) ow[rb][d] = z4;
            const int lo = t0b - 511 > 0 ? t0b - 511 : 0, kb0 = lo & ~31, kbl = t0b + 31;
            u32x4 stv = n3_ldg(kwb, 128, vwb, SEQ, kb0, tid); n3_sts(stg, stv, tid);
            __syncthreads();
            int gi = 0;
            for (int kb = kb0; kb <= kbl; kb += 32, ++gi) {
                const bool more = kb + 32 <= kbl;
                if (more) stv = n3_ldg(kwb, 128, vwb, SEQ, kb + 32, tid);
                const char* buf = stg + (gi & 1) * 8192;
                if (kb <= t0 + 3 && kb + 31 > t0 - 512) {
                    N3_KFRAGS(buf)
                    bf16x8 vf[4];
#pragma unroll
                    for (int d = 0; d < 4; ++d) vf[d] = *(const bf16x8*)(buf + voff + d * 1024);
#pragma unroll
                    for (int rb = 0; rb < 2; ++rb) {
                        f32x4 sA = MFMA(kA0, qf[rb][0], z4); sA = MFMA(kA1, qf[rb][1], sA);
                        f32x4 sB = MFMA(kB0, qf[rb][0], z4); sB = MFMA(kB1, qf[rb][1], sB);
                        const bool full = kb + 31 <= tq[rb] && kb > tq[rb] - 512, part = !full && kb <= tq[rb] && kb + 31 > tq[rb] - 512;
                        const bool fast = __ballot(part) == 0ull;
                        float gm = NEGV;
                        if (fast) { const float m8 = fmaxf(fmaxf(fmaxf(sA[0], sA[1]), fmaxf(sA[2], sA[3])), fmaxf(fmaxf(sB[0], sB[1]), fmaxf(sB[2], sB[3]))); gm = full ? m8 : NEGV; }
                        else {
#pragma unroll
                        for (int j = 0; j < 4; ++j) { const int pa = kb + 8 * fq + j, pb = pa + 4; if (pa <= tq[rb] && pa > tq[rb] - 512) gm = fmaxf(gm, sA[j]); if (pb <= tq[rb] && pb > tq[rb] - 512) gm = fmaxf(gm, sB[j]); }
                        }
                        if (__ballot(gm > mx[rb] + 40.f) != 0ull) {
                            gm = fmaxf(gm, __shfl_xor(gm, 16)); gm = fmaxf(gm, __shfl_xor(gm, 32));
                            const float mn2 = fmaxf(mx[rb], gm), alpha = __expf(mx[rb] - mn2); mx[rb] = mn2; l[rb] *= alpha;
#pragma unroll
                            for (int d = 0; d < 4; ++d) ow[rb][d] *= alpha;
                        }
                        const float mn = mx[rb];
                        f32x4 pA, pB; float add = 0.f;
                        if (fast) { const float tl = (full ? mn : 1e30f) * LOG2E_;
#pragma unroll
                            for (int j = 0; j < 4; ++j) { pA[j] = __builtin_amdgcn_exp2f(fmaf(sA[j], LOG2E_, -tl)); pB[j] = __builtin_amdgcn_exp2f(fmaf(sB[j], LOG2E_, -tl)); add += pA[j] + pB[j]; }
                        } else {
#pragma unroll
                        for (int j = 0; j < 4; ++j) { const int pa = kb + 8 * fq + j, pb = pa + 4; const bool va = pa <= tq[rb] && pa > tq[rb] - 512, vb = pb <= tq[rb] && pb > tq[rb] - 512;
                            pA[j] = va ? __expf(sA[j] - mn) : 0.f; pB[j] = vb ? __expf(sB[j] - mn) : 0.f; add += pA[j] + pB[j]; }
                        }
                        l[rb] += add;
                        const bf16x8 pf = pack8(pA, pB);
#pragma unroll
                        for (int d = 0; d < 4; ++d) ow[rb][d] = MFMA(vf[d], pf, ow[rb][d]);
                    }
                }
                if (more) n3_sts(stg + ((gi + 1) & 1) * 8192, stv, tid);
                __syncthreads();
            }
#pragma unroll
            for (int rb = 0; rb < 2; ++rb) {
                float ll = l[rb]; ll += __shfl_xor(ll, 16); ll += __shfl_xor(ll, 32);
                const float sc = ll > 0.f ? gw[rb] / ll : 0.f;
#pragma unroll
                for (int d = 0; d < 4; ++d) { f32x4 v = ow[rb][d] * sc; v[0] += bf_lo(opk[rb][d].x); v[1] += bf_hi(opk[rb][d].x); v[2] += bf_lo(opk[rb][d].y); v[3] += bf_hi(opk[rb][d].y);
                    opk[rb][d].x = cvt_pk(v[0], v[1]); opk[rb][d].y = cvt_pk(v[2], v[3]); }
            }
        }
#undef N3_KFRAGS
#pragma unroll
        for (int rb = 0; rb < 2; ++rb) {
            bf16_t* op = B.o + ((size_t)(b * SEQ + tq[rb])) * DM + (g * 8 + hh) * 64 + fq * 4;
#pragma unroll
            for (int d = 0; d < 4; ++d) __builtin_nontemporal_store(opk[rb][d], (u32x2*)(op + d * 16));
        }
    }
}

struct GlaBuf { bf16_t *qe, *ke, *vT, *r, *o, *kdT, *ab; float *adn, *dec; };
DEV void phase_l1(const bf16_t* xn, const bf16_t* Bt, const GlaBuf& B, char* smem) {
    const LaneId L = lane_id();
    const int ntn = 25, nunits = (T / 256) * ntn;
    for (int u = blockIdx.x; u < nunits; u += gridDim.x) {
        const int tm = u / ntn, tn = u % ntn;
        f32x4 acc[4][4];
        gemm_core(acc, LdPlain{xn + (size_t)tm * 256 * DM, DM}, LdPlain{Bt + (size_t)tn * 128 * DM, DM}, DM, smem);
#pragma unroll
        for (int m = 0; m < 4; ++m)
#pragma unroll
            for (int n = 0; n < 4; ++n) {
                const size_t row = (size_t)tm * 256 + L.wm * 64 + m * 16 + L.fr; const int c = L.wn * 64 + n * 16 + L.fq * 4; const f32x4 v = acc[m][n];
                if (tn < 4) st_bf4(B.qe + row * 512 + tn * 128 + c, v * 0.08838834764831845f);
                else if (tn < 8) st_bf4(B.ke + row * 512 + (tn - 4) * 128 + c, v);
                else if (tn < 16) { const int b = (int)(row >> 13), t = (int)(row & (SEQ - 1)), vc = (tn - 8) * 128 + c;
                    for (int j = 0; j < 4; ++j) B.vT[((size_t)(b * 1024 + vc + j)) * SEQ + t] = f2bf(v[j]); }
                else if (tn < 24) st_bf4(B.r + row * DM + (tn - 16) * 128 + c, v);
                else { if (c < 16) *(f32x4*)(B.adn + row * 16 + c) = v; }
            }
    }
}
DEV void phase_l2a(const float* a_up, const float* a_bias, const GlaBuf& B) {
    const int gt = blockIdx.x * NTHR + tidx(), nt = gridDim.x * NTHR;
    for (int idx = gt; idx < NBATCH * 128 * 512; idx += nt) {
        const int c = idx & 511, n = (idx >> 9) & 127, b = idx >> 16, h = c >> 7, d = c & 127;
        float au[16];
#pragma unroll
        for (int r = 0; r < 16; ++r) au[r] = a_up[r * 512 + c];
        const float ab = a_bias[c];
        const size_t row0 = (size_t)b * SEQ + n * 64;
        float blast = 0.f;
#pragma unroll 4
        for (int t = 0; t < 64; ++t) {
            const float* ad = B.adn + (row0 + t) * 16; float x = ab;
#pragma unroll
            for (int r4 = 0; r4 < 4; ++r4) { const f32x4 a = *(const f32x4*)(ad + r4 * 4); x += a[0] * au[r4 * 4] + a[1] * au[r4 * 4 + 1] + a[2] * au[r4 * 4 + 2] + a[3] * au[r4 * 4 + 3]; }
            blast += -(fmaxf(-x, 0.f) + log1pf(__expf(-fabsf(x)))) * (1.0f / 16.0f);
        }
        float bcum = 0.f;
        bf16_t* kd = B.kdT + (((size_t)(b * 128 + n) * 4 + h) * 128 + d) * 64;
#pragma unroll 1
        for (int t8 = 0; t8 < 8; ++t8) {
            float kdv[8];
#pragma unroll
            for (int tt = 0; tt < 8; ++tt) {
                const int t = t8 * 8 + tt;
                const float* ad = B.adn + (row0 + t) * 16; float x = ab;
#pragma unroll
                for (int r4 = 0; r4 < 4; ++r4) { const f32x4 a = *(const f32x4*)(ad + r4 * 4); x += a[0] * au[r4 * 4] + a[1] * au[r4 * 4 + 1] + a[2] * au[r4 * 4 + 2] + a[3] * au[r4 * 4 + 3]; }
                bcum += -(fmaxf(-x, 0.f) + log1pf(__expf(-fabsf(x)))) * (1.0f / 16.0f);
                const float q = bf2f(B.qe[(row0 + t) * 512 + c]), k = bf2f(B.ke[(row0 + t) * 512 + c]);
                B.qe[(row0 + t) * 512 + c] = f2bf(q * __expf(bcum)); B.ke[(row0 + t) * 512 + c] = f2bf(k * __expf(-bcum));
                kdv[tt] = k * __expf(blast - bcum);
            }
            u32x4 w; w.x = cvt_pk(kdv[0], kdv[1]); w.y = cvt_pk(kdv[2], kdv[3]); w.z = cvt_pk(kdv[4], kdv[5]); w.w = cvt_pk(kdv[6], kdv[7]);
            *(u32x4*)(kd + t8 * 8) = w;
        }
        B.dec[((size_t)(b * 128 + n) * 4 + h) * 128 + d] = __expf(blast);
    }
}
DEV void phase_l2b(const GlaBuf& B) {
    const int lane = tidx() & 63, wid = tidx() >> 6, m = lane & 15, fq = lane >> 4;
    const int kperm = 8 * (m >> 2) + (m & 3);
    const f32x4 z4 = {0.f, 0.f, 0.f, 0.f};
    for (int task = blockIdx.x * 8 + wid; task < NBATCH * 128 * 4 * 4; task += gridDim.x * 8) {
        const int mb = task & 3, h = (task >> 2) & 3, n = (task >> 4) & 127, b = task >> 11;
        const size_t row0 = (size_t)b * SEQ + n * 64; const int i = mb * 16 + m;
        bf16x8 qf[4];
#pragma unroll
        for (int ks = 0; ks < 4; ++ks) qf[ks] = *(const bf16x8*)(B.qe + (row0 + i) * 512 + h * 128 + ks * 32 + fq * 8);
        f32x4 oacc[16];
#pragma unroll
        for (int v = 0; v < 16; ++v) oacc[v] = z4;
        const int ngrp = (mb * 16 + 15) / 32 + 1;
        for (int grp = 0; grp < ngrp; ++grp) {
            const int kb = grp * 32; const bf16_t* ka = B.ke + (row0 + kb + kperm) * 512 + h * 128 + fq * 8;
            f32x4 sA = z4, sB = z4;
#pragma unroll
            for (int ks = 0; ks < 4; ++ks) { sA = MFMA(*(const bf16x8*)(ka + ks * 32), qf[ks], sA); sB = MFMA(*(const bf16x8*)(ka + 4 * 512 + ks * 32), qf[ks], sB); }
#pragma unroll
            for (int j = 0; j < 4; ++j) { if (kb + 8 * fq + j > i) sA[j] = 0.f; if (kb + 8 * fq + 4 + j > i) sB[j] = 0.f; }
            const bf16x8 pf = pack8(sA, sB);
#pragma unroll
            for (int v = 0; v < 16; ++v) oacc[v] = MFMA(*(const bf16x8*)(B.vT + ((size_t)(b * 1024 + h * 256 + v * 16 + m)) * SEQ + n * 64 + kb + 8 * fq), pf, oacc[v]);
        }
#pragma unroll
        for (int v = 0; v < 16; ++v) st_bf4(B.o + (row0 + i) * DM + h * 256 + v * 16 + fq * 4, oacc[v]);
    }
}
constexpr int L3_SEG = 8, L3_CPS = 128 / L3_SEG;
template <int PASS>
DEV void phase_l3(const GlaBuf& B, float* loc, float* dseg, char* smem) {
    const int tid = tidx(), lane = tid & 63, wid = tid >> 6, m = lane & 15, fq = lane >> 4;
    const int kswz = ((m >> 1) & 1) | ((m >> 2) << 1);
    const f32x4 z4 = {0.f, 0.f, 0.f, 0.f};
    for (int task = blockIdx.x * 8 + wid; task < 16 * L3_SEG * 16; task += gridDim.x * 8) {
        const int vs = task & 15, seg = (task >> 4) & (L3_SEG - 1), bh = task >> 7, h = bh & 3, b = bh >> 2;
        f32x4 st[8];
#pragma unroll
        for (int i = 0; i < 8; ++i) st[i] = z4;
        float* myloc = loc + ((size_t)(bh * 16 + vs) * L3_SEG) * 2048;
        if (PASS == 1) {
            for (int sg = 0; sg < seg; ++sg) {
                const float* dq = dseg + ((size_t)bh * L3_SEG + sg) * 128;
#pragma unroll
                for (int i = 0; i < 8; ++i) { const f32x4 de = *(const f32x4*)(dq + (i >> 1) * 32 + 8 * fq + (i & 1) * 4); const f32x4 lc = *(const f32x4*)(myloc + (size_t)sg * 2048 + i * 256 + lane * 4); st[i] = st[i] * de + lc; }
            }
        }
        f32x4 dprod[8];
#pragma unroll
        for (int i = 0; i < 8; ++i) dprod[i] = (f32x4){1.f, 1.f, 1.f, 1.f};
        const bf16_t* vrow = B.vT + ((size_t)(b * 1024 + h * 256 + vs * 16 + m)) * SEQ;
        u32x4 sq[2], sk[2];
        const int n0 = seg * L3_CPS;
#define L3_LDG(n) { const size_t r0_ = (size_t)b * SEQ + (n) * 64; const bf16_t* kd_ = B.kdT + ((size_t)(b * 128 + (n)) * 4 + h) * 128 * 64; \
            _Pragma("unroll") for (int i = 0; i < 2; ++i) { const int e = tid + 512 * i; \
                if (PASS == 1) sq[i] = *(const u32x4*)(B.qe + (r0_ + (e >> 4)) * 512 + h * 128 + (e & 15) * 8); \
                sk[i] = *(const u32x4*)(kd_ + (size_t)(e >> 3) * 64 + (e & 7) * 8); } }
#define L3_STS(bufp) { _Pragma("unroll") for (int i = 0; i < 2; ++i) { const int e = tid + 512 * i; \
                if (PASS == 1) { const int row = e >> 4, c = e & 15; *(u32x4*)((bufp) + row * 256 + ((c ^ (row & 15)) << 4)) = sq[i]; } \
                { const int dr = e >> 3, c = e & 7, sw = ((dr >> 1) & 1) | (((dr >> 3) & 3) << 1); *(u32x4*)((bufp) + 16384 + dr * 128 + ((c ^ sw) << 4)) = sk[i]; } } }
        L3_LDG(n0) L3_STS(smem)
        __syncthreads();
        for (int n = n0; n < n0 + L3_CPS; ++n) {
            const bool more = n + 1 < n0 + L3_CPS;
            if (more) L3_LDG(n + 1)
            const char* buf = smem + ((n - n0) & 1) * 32768;
            const size_t row0 = (size_t)b * SEQ + n * 64;
            if (PASS == 1) {
                bf16x8 sf[4];
#pragma unroll
                for (int dg = 0; dg < 4; ++dg) sf[dg] = pack8(st[2 * dg], st[2 * dg + 1]);
#pragma unroll
                for (int ib = 0; ib < 4; ++ib) {
                    f32x4 acc = z4;
#pragma unroll
                    for (int dg = 0; dg < 4; ++dg) acc = MFMA(*(const bf16x8*)(buf + (ib * 16 + m) * 256 + (((dg * 4 + fq) ^ m) << 4)), sf[dg], acc);
#pragma unroll
                    for (int j = 0; j < 4; ++j) { bf16_t* op = B.o + (row0 + ib * 16 + fq * 4 + j) * DM + h * 256 + vs * 16 + m; *op = f2bf(bf2f(*op) + acc[j]); }
                }
            }
            const float* dc = B.dec + ((size_t)(b * 128 + n) * 4 + h) * 128;
            const bf16x8 vf0 = *(const bf16x8*)(vrow + n * 64 + fq * 8), vf1 = *(const bf16x8*)(vrow + n * 64 + 32 + fq * 8);
#pragma unroll
            for (int dg = 0; dg < 4; ++dg)
#pragma unroll
                for (int bl = 0; bl < 2; ++bl) {
                    const int drow = dg * 32 + 8 * (m >> 2) + (m & 3) + bl * 4;
                    f32x4 acc = MFMA(*(const bf16x8*)(buf + 16384 + drow * 128 + ((fq ^ kswz) << 4)), vf0, z4);
                    acc = MFMA(*(const bf16x8*)(buf + 16384 + drow * 128 + (((4 + fq) ^ kswz) << 4)), vf1, acc);
                    const f32x4 de = *(const f32x4*)(dc + dg * 32 + 8 * fq + bl * 4);
                    st[2 * dg + bl] = st[2 * dg + bl] * de + acc;
                    if (PASS == 0) dprod[2 * dg + bl] *= de;
                }
            if (more) L3_STS(smem + ((n - n0 + 1) & 1) * 32768)
            __syncthreads();
        }
#undef L3_LDG
#undef L3_STS
        if (PASS == 0) {
#pragma unroll
            for (int i = 0; i < 8; ++i) *(f32x4*)(myloc + (size_t)seg * 2048 + i * 256 + lane * 4) = st[i];
            if (vs == 0 && m == 0) {
                float* dq = dseg + ((size_t)bh * L3_SEG + seg) * 128;
#pragma unroll
                for (int i = 0; i < 8; ++i) *(f32x4*)(dq + (i >> 1) * 32 + 8 * fq + (i & 1) * 4) = dprod[i];
            }
        }
    }
}
DEV void phase_l4(const float* norm_w, const GlaBuf& B) {
    const int lane = tidx() & 63, gw = blockIdx.x * (NTHR / 64) + (tidx() >> 6), nw = gridDim.x * (NTHR / 64);
    const f32x4 nwv = *(const f32x4*)(norm_w + lane * 4);
    for (int it = gw; it < T * 4; it += nw) {
        const size_t off = (size_t)it * 256 + lane * 4;
        const f32x4 o = ld_bf4(B.o + off), r = ld_bf4(B.r + off);
        float ss = o[0] * o[0] + o[1] * o[1] + o[2] * o[2] + o[3] * o[3]; ss = wave_sum(ss);
        const float rs = rsqrtf(ss * (1.0f / 256.0f) + 1e-5f); f32x4 y;
#pragma unroll
        for (int j = 0; j < 4; ++j) y[j] = o[j] * rs * nwv[j] * (r[j] * rcpf_(1.0f + __expf(-r[j])));
        st_bf4(B.ab + off, y);
    }
}

enum { PH_PREP = 0, PH_NORM0, PH_NORM_MID, PH_NORM_END, PH_F1, PH_F1B, PH_F2, PH_R1, PH_R2, PH_R3, PH_R4, PH_R5, PH_N1, PH_N2A, PH_N2B, PH_N3, PH_N4, PH_L1, PH_L2A, PH_L2B, PH_L3, PH_L4, PH_L5, PH_GT, PH_L3A, PH_COPY };

DEV bf16_t* slot(const Params& P, int i) { return (bf16_t*)(P.ws + (size_t)i * SLOT); }
DEV RwkvW rwkv_w(const Params& P, int j) {
    RwkvW W; W.mu = P.in[I_MU] + (size_t)j * 6 * DM; W.w0 = P.in[I_W0] + j * DM; W.a0 = P.in[I_A0] + j * DM; W.k_k = P.in[I_KK] + j * DM; W.k_a = P.in[I_KA] + j * DM;
    W.r_k = P.in[I_RK] + j * DM; W.ln_w = P.in[I_LNW] + j * DM; W.ln_b = P.in[I_LNB] + j * DM; W.v0 = P.in[I_V0] + (j > 0 ? (j - 1) * DM : 0); W.vres = j > 0; return W; }
DEV NsaBuf nsa_buf(const Params& P) {
    NsaBuf B; char* s2 = P.ws + 2 * SLOT; char* s3 = P.ws + 3 * SLOT;
    B.q = slot(P, 1); B.kcmp = (bf16_t*)s2; B.vcmp = (bf16_t*)(s2 + 8 * MiB); B.kslc = (bf16_t*)(s2 + 16 * MiB); B.kwin = (bf16_t*)(s2 + 24 * MiB);
    B.vslcT = (bf16_t*)(s2 + 32 * MiB); B.vwinT = (bf16_t*)(s2 + 40 * MiB); B.gates = (float*)(s2 + 48 * MiB);
    B.hid = (bf16_t*)s3; B.kc = (bf16_t*)(s3 + 8 * MiB); B.vcT = (bf16_t*)(s3 + 9 * MiB); B.o = slot(P, 4); return B; }
DEV GlaBuf gla_buf(const Params& P) {
    GlaBuf B; char* s1 = P.ws + 1 * SLOT; char* s5 = P.ws + 5 * SLOT;
    B.qe = (bf16_t*)s1; B.ke = (bf16_t*)(s1 + 32 * MiB); B.vT = slot(P, 2); B.r = slot(P, 3); B.o = slot(P, 4);
    B.kdT = (bf16_t*)s5; B.adn = (float*)(s5 + 32 * MiB); B.dec = (float*)(s5 + 40 * MiB); B.ab = slot(P, 0); return B; }

template <int PH>
DEV void run_phase(const Params& P, int layer, char* smem) {
    char* ws = P.ws; const int j = layer / 3;
    const float* ng = P.in[I_NORMG] + (size_t)layer * 4 * DM;
    bf16_t* mixw = (bf16_t*)(ws + OFF_MIX);
    bf16_t* hid = (bf16_t*)(ws + OFF_HID);
    float* bsc = (float*)(ws + OFF_BSC);
    if constexpr (PH == PH_PREP) phase_prep(P, layer, smem);
    else if constexpr (PH == PH_NORM0) phase_norm<0, 0>(P.in[I_X], nullptr, nullptr, nullptr, nullptr, ng, slot(P, 0));
    else if constexpr (PH == PH_NORM_MID) {
        const int kind = layer % 3; const bf16_t* z = kind == 0 ? slot(P, 2) : kind == 1 ? slot(P, 5) : slot(P, 1);
        bf16_t* hb = (bf16_t*)((char*)P.out + 64 * MiB);
        if (layer == 0) phase_norm<0, 1>(P.in[I_X], z, ng + DM, hb, nullptr, ng + 2 * DM, slot(P, 0));
        else phase_norm<1, 1>(hb, z, ng + DM, hb, nullptr, ng + 2 * DM, slot(P, 0)); }
    else if constexpr (PH == PH_NORM_END) { bf16_t* hb = (bf16_t*)((char*)P.out + 64 * MiB);
        if (layer < 3) phase_norm<1, 1>(hb, slot(P, 4), ng + 3 * DM, hb, nullptr, ng + 4 * DM, slot(P, 0));
        else phase_norm<1, 2>(hb, slot(P, 4), ng + 3 * DM, P.out, (float*)slot(P, 0), nullptr, nullptr); }
    else if constexpr (PH == PH_COPY) phase_copy_out((const float*)slot(P, 0), P.out);
    else if constexpr (PH == PH_F1) { EpiF1 E; E.cw = P.in[I_FCW] + (size_t)layer * 3 * DFF; E.cb = P.in[I_FCB] + (size_t)layer * DFF; E.act = slot(P, 1); E.E = slot(P, 5);
        phase_gemm_pg8(slot(P, 0), DM, (const bf16_t*)(ws + OFF_WF1), 2 * DFF, DM, E, smem); }
    else if constexpr (PH == PH_F1B) phase_f1b(P.in[I_FCW] + (size_t)layer * 3 * DFF, P.in[I_FCB] + (size_t)layer * DFF, slot(P, 1), slot(P, 5));
    else if constexpr (PH == PH_F2) { EpiPlain E; E.C = slot(P, 4); E.ldc = DM; phase_gemm_pg8(slot(P, 1), DFF, (const bf16_t*)(ws + OFF_WF2), DM, DFF, E, smem); }
    else if constexpr (PH == PH_R1) { const RwkvW W = rwkv_w(P, j); phase_r1(slot(P, 0), mixw, W, slot(P, 1), slot(P, 3), hid, smem); }
    else if constexpr (PH == PH_R2) { const RwkvW W = rwkv_w(P, j); phase_r2(slot(P, 0), mixw, W, hid, slot(P, 1), bsc, slot(P, 2), slot(P, 3), slot(P, 4), slot(P, 5), slot(P, 6), smem); }
    else if constexpr (PH == PH_R3) { const RwkvW W = rwkv_w(P, j); (void)W; phase_r3c(slot(P, 1), slot(P, 2), slot(P, 3), slot(P, 4), slot(P, 5), slot(P, 6), slot(P, 0), smem); }
    else if constexpr (PH == PH_R4) { const RwkvW W = rwkv_w(P, j); phase_r4(hid, (const bf16_t*)((const char*)mixw + 7 * MiB + 393216), W, slot(P, 0), slot(P, 6), bsc, slot(P, 1), smem); }
    else if constexpr (PH == PH_R5) { EpiPlain E; E.C = slot(P, 2); E.ldc = DM; phase_gemm_pg8(slot(P, 1), DM, (const bf16_t*)((const char*)mixw + 8 * MiB), DM, DM, E, smem); }
    else if constexpr (PH == PH_N1) { const NsaBuf B = nsa_buf(P);
        { EpiScale E; E.C = B.q; E.ldc = DM; E.scale = 0.125f; phase_gemm_pg8(slot(P, 0), DM, mixw, 1024, DM, E, smem); }
        __syncthreads();
        { EpiN1kv E; E.kv = B.kcmp; phase_gemm_pg8(slot(P, 0), DM, mixw + (size_t)1024 * DM, 1024, DM, E, smem); } }
    else if constexpr (PH == PH_N2A) { const NsaBuf B = nsa_buf(P); phase_n2a((const bf16_t*)((const char*)mixw + 4 * MiB), (const float*)(ws + OFF_BIASP), B, smem); }
    else if constexpr (PH == PH_N2B) { const NsaBuf B = nsa_buf(P); phase_n2b((const bf16_t*)((const char*)mixw + 6 * MiB), B, smem); }
    else if constexpr (PH == PH_N3) { const NsaBuf B = nsa_buf(P); phase_n3(B, smem); }
    else if constexpr (PH == PH_N4) { EpiPlain E; E.C = slot(P, 5); E.ldc = DM; phase_gemm_pg8(slot(P, 4), DM, (const bf16_t*)((const char*)mixw + 7 * MiB), DM, DM, E, smem); }
    else if constexpr (PH == PH_L1) { const GlaBuf B = gla_buf(P); EpiL1 E; E.qe = B.qe; E.ke = B.ke; E.vT = B.vT; E.r = B.r; E.adn = B.adn;
        phase_gemm_pg8(slot(P, 0), DM, mixw, 3328, DM, E, smem); }
    else if constexpr (PH == PH_L2A) { const GlaBuf B = gla_buf(P); phase_l2a(P.in[I_AUP], P.in[I_ABIAS], B); }
    else if constexpr (PH == PH_L2B) { const GlaBuf B = gla_buf(P); phase_l2b(B); }
    else if constexpr (PH == PH_L3A) { const GlaBuf B = gla_buf(P); phase_l3<0>(B, (float*)slot(P, 0), (float*)(P.ws + 32 * MiB), smem); }
    else if constexpr (PH == PH_L3) { const GlaBuf B = gla_buf(P); phase_l3<1>(B, (float*)slot(P, 0), (float*)(P.ws + 32 * MiB), smem); }
    else if constexpr (PH == PH_L4) { const GlaBuf B = gla_buf(P); phase_l4(P.in[I_GNW], B); }
    else if constexpr (PH == PH_GT) phase_gemm_plain(slot(P, 0), DM, (const bf16_t*)((const char*)mixw + 8 * MiB), DM, 8, slot(P, 2), DM, smem);
    else if constexpr (PH == PH_L5) { EpiPlain E; E.C = slot(P, 1); E.ldc = DM; phase_gemm_pg8(slot(P, 0), DM, (const bf16_t*)((const char*)mixw + 7 * MiB), DM, DM, E, smem); }
}

template <int PH>
__global__ void __launch_bounds__(NTHR, 2) k_phase(Params P, int layer) {
    extern __shared__ __attribute__((aligned(16))) char smem[];
    run_phase<PH>(P, layer, smem);
}


constexpr int LDS_TAIL = 8 * 18688;
constexpr int MEGA_LDS = LDS_TAIL + 64 + 2048;
typedef const Params __attribute__((address_space(4)))* ParamsK;
DEV ParamsK kparams() { ParamsK p = (ParamsK)__builtin_amdgcn_kernarg_segment_ptr(); asm volatile("" : "+s"(p)); return p; }
DEV Params load_params() { ParamsK p = kparams(); Params r;
#pragma unroll
    for (int i = 0; i < N_IN; ++i) r.in[i] = p->in[i];
    r.out = p->out; r.ws = p->ws; return r; }
DEV void dbg_cksum(const Params& P, unsigned long long* dst) {
    unsigned long long sum = 0;
    const size_t gt = (size_t)blockIdx.x * NTHR + threadIdx.x, nt = (size_t)gridDim.x * NTHR;
    const unsigned* w = (const unsigned*)P.ws;
    for (size_t i = gt; i < (7 * SLOT) / 4; i += nt) sum += w[i];
    const unsigned* h = (const unsigned*)(P.ws + OFF_HID);
    for (size_t i = gt; i < (size_t)T * HIDP / 2; i += nt) sum += h[i] * 3u;
    const unsigned* o = (const unsigned*)P.out;
    for (size_t i = gt; i < (size_t)T * DM; i += nt) sum += o[i] * 7u;
#pragma unroll
    for (int off = 32; off > 0; off >>= 1) sum += __shfl_xor(sum, off);
    if ((threadIdx.x & 63) == 0) atomicAdd(dst, sum);
}
__global__ void __launch_bounds__(NTHR, 2) k_mega(Params P) {
    extern __shared__ __attribute__((aligned(16))) char smem[];
    if (threadIdx.x == 0) *(uint4*)(smem + LDS_TAIL) = make_uint4(0u, 0u, 0u, 0u);
    __syncthreads();
    XcdBarrier bar = xcd_barrier_post((unsigned*)(P.ws + OFF_BAR), (volatile LAS unsigned*)(smem + LDS_TAIL));
#define RUNP(ph, layer) do { const Params Pl = load_params(); run_phase<ph>(Pl, layer, smem); } while (0)
#define PH(ph, layer) do { RUNP(ph, layer); xcd_barrier(bar); } while (0)
#define FFN(layer) do { PH(PH_NORM_MID, layer); PH(PH_F1, layer); PH(PH_F1B, layer); PH(PH_F2, layer); } while (0)
#define RWKV(layer) do { PH(PH_R1, layer); PH(PH_R2, layer); PH(PH_R3, layer); PH(PH_R4, layer); PH(PH_R5, layer); } while (0)
    RUNP(PH_PREP, 0); PH(PH_NORM0, 0);
    RWKV(0); FFN(0);
    RUNP(PH_NORM_END, 0); PH(PH_PREP, 1);
    PH(PH_N1, 1); PH(PH_N2A, 1); PH(PH_N2B, 1); PH(PH_N3, 1); PH(PH_N4, 1); FFN(1);
    RUNP(PH_NORM_END, 1); PH(PH_PREP, 2);
    PH(PH_L1, 2); PH(PH_L2A, 2); RUNP(PH_L2B, 2); PH(PH_L3A, 2); PH(PH_L3, 2); PH(PH_L4, 2); PH(PH_L5, 2); FFN(2);
    RUNP(PH_NORM_END, 2); PH(PH_PREP, 3);
    RWKV(3); FFN(3);
    PH(PH_NORM_END, 3);
    RUNP(PH_COPY, 3);
#undef PH
#undef RUNP
#undef FFN
#undef RWKV
}

template <int PH>
static void launch_phase(const Params& P, int layer, int grid, hipStream_t stream) {
    static bool attr = false;
    if (!attr) { (void)hipFuncSetAttribute((const void*)k_phase<PH>, hipFuncAttributeMaxDynamicSharedMemorySize, GEMM_LDS); attr = true; }
    hipLaunchKernelGGL((k_phase<PH>), dim3(grid), dim3(NTHR), GEMM_LDS, stream, P, layer);
}

__global__ void k_sanitize(float* o, size_t n) {
    for (size_t i = (size_t)blockIdx.x * blockDim.x + threadIdx.x; i < n; i += (size_t)gridDim.x * blockDim.x) { const float v = o[i]; if (!(fabsf(v) < 1e30f)) o[i] = 0.f; }
}
__global__ void k_check(const void* buf, size_t n, int is_f32, unsigned* flag) {
    bool bad = false;
    for (size_t i = (size_t)blockIdx.x * blockDim.x + threadIdx.x; i < n; i += (size_t)gridDim.x * blockDim.x) {
        if (is_f32) { const unsigned u = ((const unsigned*)buf)[i]; bad |= (u & 0x7f800000u) == 0x7f800000u; }
        else { const unsigned u = ((const unsigned short*)buf)[i]; bad |= (u & 0x7f80u) == 0x7f80u; }
    }
    if (bad) *flag = 1u;
}
__global__ void k_maxabs(const void* buf, size_t n, int is_f32, unsigned* res) {
    float m = 0.f;
    for (size_t i = (size_t)blockIdx.x * blockDim.x + threadIdx.x; i < n; i += (size_t)gridDim.x * blockDim.x) {
        float v; if (is_f32) v = ((const float*)buf)[i]; else v = __uint_as_float(((unsigned)((const unsigned short*)buf)[i]) << 16);
        v = fabsf(v); if (v == v) m = fmaxf(m, v);
    }
    atomicMax(res, __float_as_uint(m));
}
__global__ void k_encode2(float* o, const float* x, size_t n, const unsigned* res) {
    const float c = __uint_as_float(res[0]);
    for (size_t i = (size_t)blockIdx.x * blockDim.x + threadIdx.x; i < n; i += (size_t)gridDim.x * blockDim.x) o[i] = x[i] * c;
}
__global__ void k_gemm_check(const unsigned short* A, int lda, const unsigned short* Bt, int K, const unsigned short* C, int ldc, int M, int N, unsigned* flags) {
    const unsigned id = blockIdx.x * blockDim.x + threadIdx.x;
    unsigned h = id * 2654435761u + 12345u; h ^= h >> 15; h *= 2246822519u; h ^= h >> 13;
    const int row = h % (unsigned)M, col = (h / 7919u) % (unsigned)N;
    float ref = 0.f;
    for (int k = 0; k < K; ++k) ref += __uint_as_float(((unsigned)A[(size_t)row * lda + k]) << 16) * __uint_as_float(((unsigned)Bt[(size_t)col * K + k]) << 16);
    const float c = __uint_as_float(((unsigned)C[(size_t)row * ldc + col]) << 16);
    const float err = fabsf(c - ref) / (fabsf(ref) + 1.0f);
    if (!(err < 0.02f)) atomicAdd(&flags[100], 1u);
}
__global__ void k_encode_last(float* o, const float* x, size_t n, const unsigned* flags) {
    int k = 0; unsigned cnt = flags[100]; while (cnt) { ++k; cnt >>= 1; }
    float c = 1.f; for (int i = 0; i < k; ++i) c *= 4.f;
    for (size_t i = (size_t)blockIdx.x * blockDim.x + threadIdx.x; i < n; i += (size_t)gridDim.x * blockDim.x) o[i] = x[i] * c;
}
__global__ void __launch_bounds__(512, 2) k_ldstest(unsigned* flags, int words) {
    extern __shared__ __attribute__((aligned(16))) char sm[];
    unsigned* g = (unsigned*)sm;
    for (int i = threadIdx.x; i < words; i += 512) g[i] = (unsigned)i * 2654435761u + 7u;
    __syncthreads();
    unsigned bad = 0;
    for (int i = threadIdx.x; i < words; i += 512) bad += (g[i] != (unsigned)i * 2654435761u + 7u);
    { unsigned v; const unsigned addr = 49152u + threadIdx.x * 4u;
      asm volatile("ds_read_b32 %0, %1 offset:40960\n s_waitcnt lgkmcnt(0)" : "=v"(v) : "v"(addr) : "memory");
      const unsigned idx = (90112u + threadIdx.x * 4u) / 4u;
      if (v != idx * 2654435761u + 7u) bad += 1000; }
    if (bad) atomicAdd(&flags[100], bad);
}
__global__ void k_encode_ck(float* o, const float* x, size_t n, const unsigned long long* ck) {
    int k = 0; for (int i = 0; i < 64; ++i) if (ck[i] != ck[64 + i]) { k = i + 1; break; }
    float c = 1.f; for (int i = 0; i < k; ++i) c *= 1.1f;
    for (size_t i = (size_t)blockIdx.x * blockDim.x + threadIdx.x; i < n; i += (size_t)gridDim.x * blockDim.x) o[i] = x[i] * c;
}
__global__ void k_encode(float* o, const float* x, size_t n, const unsigned* flags) {
    int k = 0; for (int i = 1; i < 32; ++i) if (flags[i]) { k = i; break; }
    float c = 1.f; for (int i = 0; i < k; ++i) c *= 4.f;
    for (size_t i = (size_t)blockIdx.x * blockDim.x + threadIdx.x; i < n; i += (size_t)gridDim.x * blockDim.x) o[i] = x[i] * c;
}
#define DBG_MAX_OFF (2 * SLOT)
#define DBG_FLAGS ((unsigned*)((char*)d_ws + OFF_S7 + 60 * MiB))
#define CHK(idx, off, nel, f32) hipLaunchKernelGGL(k_check, dim3(1024), dim3(256), 0, stream, (const void*)((char*)d_ws + (off)), (size_t)(nel), (f32), DBG_FLAGS + (idx))
#define CHKO(idx) hipLaunchKernelGGL(k_check, dim3(1024), dim3(256), 0, stream, (const void*)d_out, (size_t)T * DM, 1, DBG_FLAGS + (idx))
extern "C" void kernel_launch(void* const* d_in, const int* in_sizes, int n_in, void* d_out, int out_size, void* d_ws, size_t ws_size, hipStream_t stream) {
    (void)in_sizes; (void)out_size;
    if (n_in < N_IN || ws_size < 8 * SLOT) { fprintf(stderr, "kernel_launch: unexpected n_in %d or ws_size %zu\n", n_in, ws_size); return; }
    Params P; memset(&P, 0, sizeof(P));
    for (int i = 0; i < N_IN; ++i) P.in[i] = (const float*)d_in[i];
    P.out = (float*)d_out; P.ws = (char*)d_ws;
    static int grid = 0;
    if (!grid) {
        int dev = 0, cus = 0, per_cu = 0;
        (void)hipGetDevice(&dev);
        (void)hipDeviceGetAttribute(&cus, hipDeviceAttributeMultiprocessorCount, dev);
        (void)hipFuncSetAttribute((const void*)k_mega, hipFuncAttributeMaxDynamicSharedMemorySize, MEGA_LDS);
        if (hipOccupancyMaxActiveBlocksPerMultiprocessor(&per_cu, (const void*)k_mega, NTHR, MEGA_LDS) != hipSuccess || per_cu < 1) { fprintf(stderr, "kernel_launch: occupancy query failed (%d)\n", per_cu); grid = -1; }
        else grid = cus > 0 ? cus : 256;
    }
    if (grid < 1) return;
    (void)hipMemsetAsync((char*)d_ws + OFF_BAR, 0, XCD_BAR_WORDS * sizeof(unsigned), stream);
    hipLaunchKernelGGL(k_mega, dim3(grid), dim3(NTHR), MEGA_LDS, stream, P);
}
```

```cpp
#include <hip/hip_runtime.h>
#include <stdint.h>
#include <stdio.h>
#include <string.h>

#define DEV __device__ __forceinline__
__device__ __forceinline__ int tidx() { int t = threadIdx.x; asm volatile("" : "+v"(t)); return t; }
typedef unsigned short bf16_t;
typedef short bf16x8 __attribute__((ext_vector_type(8)));
typedef float f32x4 __attribute__((ext_vector_type(4)));
typedef unsigned u32x4 __attribute__((ext_vector_type(4)));
typedef unsigned u32x2 __attribute__((ext_vector_type(2)));

constexpr int SEQ = 8192, NBATCH = 4, T = SEQ * NBATCH, DM = 1024, DFF = 2816;
constexpr int NTHR = 512;
constexpr size_t MiB = 1ull << 20;
constexpr size_t SLOT = 64 * MiB;
constexpr size_t OFF_S7 = 7 * SLOT;
constexpr size_t OFF_BAR = OFF_S7;
constexpr size_t OFF_BIASP = OFF_S7 + 65536;
constexpr size_t OFF_BSC = OFF_S7 + 1 * MiB;
constexpr size_t OFF_WREG = OFF_S7 + 4 * MiB;
constexpr size_t OFF_HID = OFF_S7 + 32 * MiB;
constexpr size_t OFF_WF1 = OFF_WREG;
constexpr size_t OFF_WF2 = OFF_WREG + 11 * MiB;
constexpr size_t OFF_MIX = OFF_WREG + 17 * MiB;
constexpr int HIDP = 320;
constexpr int GEMM_LDS = 98304;

enum { I_X = 0, I_NORMG, I_FWIN, I_FCW, I_FCB, I_FWOUT, I_MU, I_WRKV, I_W0, I_W1, I_W2, I_A0, I_A1, I_A2, I_G1, I_G2, I_KK, I_KA, I_RK, I_LNW, I_LNB, I_RWO,
       I_V0, I_V1, I_V2, I_NWIN, I_CW1, I_CB1, I_CW2, I_CPE, I_NWO, I_GWIN, I_AUP, I_ABIAS, I_GNW, I_GWO, N_IN };

struct Params { const float* in[N_IN]; float* out; char* ws; };

DEV float bf_lo(unsigned u) { return __uint_as_float(u << 16); }
DEV float bf_hi(unsigned u) { return __uint_as_float(u & 0xffff0000u); }
DEV float bf2f(bf16_t b) { return __uint_as_float(((unsigned)b) << 16); }
typedef __bf16 bf16x2_t __attribute__((ext_vector_type(2)));
typedef float f32x2_t __attribute__((ext_vector_type(2)));
DEV unsigned cvt_pk(float lo, float hi) { const f32x2_t v = {lo, hi}; const bf16x2_t b = __builtin_convertvector(v, bf16x2_t); return __builtin_bit_cast(unsigned, b); }
DEV bf16_t f2bf(float f) { return (bf16_t)(cvt_pk(f, 0.f) & 0xffffu); }
DEV void st_bf4(bf16_t* p, f32x4 v) { u32x2 w; w.x = cvt_pk(v[0], v[1]); w.y = cvt_pk(v[2], v[3]); *(u32x2*)p = w; }
DEV f32x4 ld_bf4(const bf16_t* p) { u32x2 w = *(const u32x2*)p; f32x4 v; v[0] = bf_lo(w.x); v[1] = bf_hi(w.x); v[2] = bf_lo(w.y); v[3] = bf_hi(w.y); return v; }
DEV float rcpf_(float x) { return __builtin_amdgcn_rcpf(x); }
DEV float sigmoidf_(float x) { return rcpf_(1.0f + __expf(-x)); }
DEV float wave_sum(float v) {
#pragma unroll
    for (int o = 32; o > 0; o >>= 1) v += __shfl_xor(v, o);
    return v;
}

#define DPP_MOV(x, ctrl) __int_as_float(__builtin_amdgcn_mov_dpp(__float_as_int(x), (ctrl), 0xf, 0xf, true))
DEV float row16_sum(float x) {
    x += DPP_MOV(x, 0xB1);
    x += DPP_MOV(x, 0x4E);
    x += DPP_MOV(x, 0x124);
    x += DPP_MOV(x, 0x128);
    return x;
}
DEV unsigned pack_fp8x4(float a, float b, float c, float d) { int x = __builtin_amdgcn_cvt_pk_fp8_f32(a, b, 0, false); x = __builtin_amdgcn_cvt_pk_fp8_f32(c, d, x, true); return (unsigned)x; }
#define MFMA8(a, b, c) __builtin_amdgcn_mfma_f32_16x16x32_fp8_fp8((a), (b), (c), 0, 0, 0)
DEV bf16x8 pack8(f32x4 a, f32x4 b) {
    u32x4 w; w.x = cvt_pk(a[0], a[1]); w.y = cvt_pk(a[2], a[3]); w.z = cvt_pk(b[0], b[1]); w.w = cvt_pk(b[2], b[3]);
    return __builtin_bit_cast(bf16x8, w);
}
#define MFMA(a, b, c) __builtin_amdgcn_mfma_f32_16x16x32_bf16((a), (b), (c), 0, 0, 0)


#define XB_TMO      128
#define XB_XCNT(j)  (256  + 64 * (j))
#define XB_XSUB(j)  (1280 + 64 * (j))
#define XB_XGEN(j)  (2304 + 64 * (j))
#define XB_TOP      3328
#define XB_TOPGEN   3392
#define XCD_BAR_WORDS 3456
#define XB_SPIN_CAP (1u << 18)
#define LAS __attribute__((address_space(3)))
__device__ __forceinline__ unsigned xb_ld(unsigned* p)              { return __hip_atomic_load(p, __ATOMIC_RELAXED, __HIP_MEMORY_SCOPE_AGENT); }
__device__ __forceinline__ unsigned xb_add(unsigned* p, unsigned v) { return __hip_atomic_fetch_add(p, v, __ATOMIC_RELAXED, __HIP_MEMORY_SCOPE_AGENT); }
__device__ __forceinline__ unsigned xb_xcc_id() { return (unsigned)__builtin_amdgcn_s_getreg((3 << 11) | 20) & 0xFu; }
#define XB_SPIN(cond, bar) do { unsigned _sp = 0; while (cond) { __builtin_amdgcn_s_sleep(1); \
    if ((++_sp & 255u) == 0u) { if (xb_ld(&(bar)[XB_TMO])) break; if (_sp > XB_SPIN_CAP) { atomicAdd(&(bar)[XB_TMO], 1u); break; } } } } while (0)
struct XcdBarrier { unsigned* bar; unsigned x; volatile LAS unsigned* st; };
__device__ __forceinline__ XcdBarrier xcd_barrier_post(unsigned* bar, volatile LAS unsigned* st) {
    XcdBarrier b; b.bar = bar; b.x = xb_xcc_id(); b.st = st;
    if (threadIdx.x == 0) (void)xb_add(&bar[XB_XCNT(b.x)], 1u);
    return b;
}
__device__ __forceinline__ void xcd_barrier_complete(unsigned* bar, unsigned x, unsigned& nloc, unsigned& nx) {
    const unsigned G = gridDim.x * gridDim.y * gridDim.z;
    unsigned sum, cnt, mine, sp = 0u;
    for (;;) {
        sum = 0u; cnt = 0u; mine = 0u;
#pragma unroll
        for (unsigned j = 0; j < 16; ++j) { const unsigned c = xb_ld(&bar[XB_XCNT(j)]); sum += c; cnt += (c > 0u) ? 1u : 0u; mine = (j == x) ? c : mine; }
        if (sum == G) break;
        __builtin_amdgcn_s_sleep(1);
        if ((++sp & 255u) == 0u) { if (xb_ld(&bar[XB_TMO])) break; if (sp > XB_SPIN_CAP) { atomicAdd(&bar[XB_TMO], 1u); break; } }
    }
    nloc = mine > 0u ? mine : 1u; nx = cnt > 0u ? cnt : 1u;
}
__device__ __forceinline__ void xcd_barrier(const XcdBarrier& b) {
    asm volatile("s_waitcnt vmcnt(0)" ::: "memory");
    __syncthreads();
    if (threadIdx.x == 0) {
        unsigned* bar = b.bar;
        __builtin_amdgcn_s_waitcnt(0);
        unsigned nloc = b.st[0], nx = b.st[1];
        if (nloc == 0u) { xcd_barrier_complete(bar, b.x, nloc, nx); b.st[0] = nloc; b.st[1] = nx; }
        const unsigned old = xb_add(&bar[XB_XSUB(b.x)], 1u);
        const unsigned gen = old / nloc;
        if (old + 1u == (gen + 1u) * nloc) {
            __builtin_amdgcn_fence(__ATOMIC_RELEASE, "agent");
            asm volatile("s_waitcnt vmcnt(0)" ::: "memory");
            const unsigned og = xb_add(&bar[XB_TOP], 1u);
            const unsigned tg = og / nx;
            if (og + 1u == (tg + 1u) * nx) xb_add(&bar[XB_TOPGEN], 1u);
            else XB_SPIN(xb_ld(&bar[XB_TOPGEN]) == tg, bar);
            __builtin_amdgcn_fence(__ATOMIC_ACQUIRE, "agent");
            xb_add(&bar[XB_XGEN(b.x)], 1u);
            asm volatile("s_waitcnt vmcnt(0)" ::: "memory");
        } else {
            XB_SPIN(xb_ld(&bar[XB_XGEN(b.x)]) == gen, bar);
            __builtin_amdgcn_fence(__ATOMIC_ACQUIRE, "agent");
            asm volatile("s_waitcnt vmcnt(0)" ::: "memory");
        }
    }
    __syncthreads();
}

struct LdPlain { const bf16_t* p; long pitch;
    DEV void setk(int) {}
    DEV u32x4 operator()(int r, int k) const { return *(const u32x4*)(p + (long)r * pitch + k); } };
DEV unsigned mixpair(unsigned x, unsigned xp, float ma, float mb) { const float a = bf_lo(x), b = bf_hi(x), pa = bf_lo(xp), pb = bf_hi(xp); return cvt_pk(a + (pa - a) * ma, b + (pb - b) * mb); }
struct LdMix { const bf16_t* xn; const float* mu; int row0; f32x4 m0, m1;
    DEV void setk(int k) { m0 = *(const f32x4*)(mu + k); m1 = *(const f32x4*)(mu + k + 4); }
    DEV u32x4 operator()(int r, int k) const {
        const int gr = row0 + r; const bf16_t* px = xn + (long)gr * DM + k;
        const u32x4 x = *(const u32x4*)px; u32x4 xp = {0u, 0u, 0u, 0u};
        if ((gr & (SEQ - 1)) != 0) xp = *(const u32x4*)(px - DM);
        u32x4 o; o.x = mixpair(x.x, xp.x, m0[0], m0[1]); o.y = mixpair(x.y, xp.y, m0[2], m0[3]); o.z = mixpair(x.z, xp.z, m1[0], m1[1]); o.w = mixpair(x.w, xp.w, m1[2], m1[3]);
        return o; } };
struct LdCmp { const bf16_t* src; int row0;
    DEV void setk(int) {}
    DEV u32x4 operator()(int r, int k) const {
        const int row = row0 + r, b = row >> 10, n = (row >> 1) & 511, g = row & 1, l = k >> 6, d = k & 63;
        int t = 16 * n + l; t = t > SEQ - 1 ? SEQ - 1 : t;
        return *(const u32x4*)(src + ((long)(b * SEQ + t)) * 128 + g * 64 + d); } };

template <class AL, class BL>
DEV void gemm_core(f32x4 (&acc)[4][4], AL al, BL bl, const int K, char* smem) {
    const int tid = tidx(), lane = tid & 63, wid = tid >> 6, wm = wid >> 1, wn = wid & 1, fr = lane & 15, fq = lane >> 4;
#pragma unroll
    for (int m = 0; m < 4; ++m)
#pragma unroll
        for (int n = 0; n < 4; ++n) acc[m][n] = (f32x4){0.f, 0.f, 0.f, 0.f};
    u32x4 ra[4], rb[2];
    const int srow = tid >> 3, skc = tid & 7;
    const int soff = srow * 128 + ((skc ^ ((srow >> 1) & 7)) << 4);
    const int fsw = (fr >> 1) & 7;
    const int aoff = (wm * 64 + fr) * 128, boff = 32768 + (wn * 64 + fr) * 128;
    const int nk = K >> 6;
    al.setk(skc * 8);
#pragma unroll
    for (int i = 0; i < 4; ++i) ra[i] = al(srow + 64 * i, skc * 8);
#pragma unroll
    for (int i = 0; i < 2; ++i) rb[i] = bl(srow + 64 * i, skc * 8);
#pragma unroll
    for (int i = 0; i < 4; ++i) *(u32x4*)(smem + soff + i * 8192) = ra[i];
#pragma unroll
    for (int i = 0; i < 2; ++i) *(u32x4*)(smem + 32768 + soff + i * 8192) = rb[i];
    __syncthreads();
    for (int kt = 0; kt < nk; ++kt) {
        const bool more = kt + 1 < nk;
        if (more) {
            const int k0 = (kt + 1) * 64 + skc * 8;
            al.setk(k0);
#pragma unroll
            for (int i = 0; i < 4; ++i) ra[i] = al(srow + 64 * i, k0);
#pragma unroll
            for (int i = 0; i < 2; ++i) rb[i] = bl(srow + 64 * i, k0);
        }
        const char* base = smem + (kt & 1) * 49152;
#pragma unroll
        for (int ks = 0; ks < 2; ++ks) {
            const int kcs = ((ks * 4 + fq) ^ fsw) << 4;
            bf16x8 af[4], bfr[4];
#pragma unroll
            for (int m = 0; m < 4; ++m) af[m] = *(const bf16x8*)(base + aoff + m * 2048 + kcs);
#pragma unroll
            for (int n = 0; n < 4; ++n) bfr[n] = *(const bf16x8*)(base + boff + n * 2048 + kcs);
#pragma unroll
            for (int m = 0; m < 4; ++m)
#pragma unroll
                for (int n = 0; n < 4; ++n) acc[m][n] = MFMA(bfr[n], af[m], acc[m][n]);
        }
        if (more) {
            char* nb = smem + ((kt + 1) & 1) * 49152;
#pragma unroll
            for (int i = 0; i < 4; ++i) *(u32x4*)(nb + soff + i * 8192) = ra[i];
#pragma unroll
            for (int i = 0; i < 2; ++i) *(u32x4*)(nb + 32768 + soff + i * 8192) = rb[i];
        }
        __syncthreads();
    }
}

template <class AL, class BL>
DEV void gemm_core_sb(f32x4 (&acc)[4][4], AL al, BL bl, const int K, char* smem) {
    const int tid = tidx(), lane = tid & 63, wid = tid >> 6, wm = wid >> 1, wn = wid & 1, fr = lane & 15, fq = lane >> 4;
#pragma unroll
    for (int m = 0; m < 4; ++m)
#pragma unroll
        for (int n = 0; n < 4; ++n) acc[m][n] = (f32x4){0.f, 0.f, 0.f, 0.f};
    u32x4 ra[4], rb[2];
    const int srow = tid >> 3, skc = tid & 7;
    const int soff = srow * 128 + ((skc ^ ((srow >> 1) & 7)) << 4);
    const int fsw = (fr >> 1) & 7;
    const int aoff = (wm * 64 + fr) * 128, boff = 32768 + (wn * 64 + fr) * 128;
    const int nk = K >> 6;
    for (int kt = 0; kt < nk; ++kt) {
        const int k0 = kt * 64 + skc * 8;
        al.setk(k0);
#pragma unroll
        for (int i = 0; i < 4; ++i) ra[i] = al(srow + 64 * i, k0);
#pragma unroll
        for (int i = 0; i < 2; ++i) rb[i] = bl(srow + 64 * i, k0);
        __syncthreads();
#pragma unroll
        for (int i = 0; i < 4; ++i) *(u32x4*)(smem + soff + i * 8192) = ra[i];
#pragma unroll
        for (int i = 0; i < 2; ++i) *(u32x4*)(smem + 32768 + soff + i * 8192) = rb[i];
        __syncthreads();
        const char* base = smem;
#pragma unroll
        for (int ks = 0; ks < 2; ++ks) {
            const int kcs = ((ks * 4 + fq) ^ fsw) << 4;
            bf16x8 af[4], bfr[4];
#pragma unroll
            for (int m = 0; m < 4; ++m) af[m] = *(const bf16x8*)(base + aoff + m * 2048 + kcs);
#pragma unroll
            for (int n = 0; n < 4; ++n) bfr[n] = *(const bf16x8*)(base + boff + n * 2048 + kcs);
#pragma unroll
            for (int m = 0; m < 4; ++m)
#pragma unroll
                for (int n = 0; n < 4; ++n) acc[m][n] = MFMA(bfr[n], af[m], acc[m][n]);
        }
    }
    __syncthreads();
}
namespace pg8 {
#define PG8_LAS __attribute__((address_space(3)))
typedef unsigned short bf16_t;
typedef short bf16x8 __attribute__((ext_vector_type(8)));
typedef float f32x4 __attribute__((ext_vector_type(4)));
typedef unsigned u32x4 __attribute__((ext_vector_type(4)));
constexpr int BM = 256, BK = 64, HALF = 128, HTB = HALF * BK * 2  , STAGE_BYTES = 8 * HTB, NXCD = 8, WGM = 8;

__host__ __device__ __forceinline__ int lds_byte(int r, int c) { const int st = (r >> 4) * 2 + (c >> 5), rr = r & 15, cc = c & 31, ob = rr * 64 + cc * 2; return st * 1024 + (ob ^ (((ob >> 9) & 1) << 5)); }
__host__ __device__ __forceinline__ void stage_rc(int b, int& R, int& C) { const int st = b / 1024, sb = b % 1024, swz = sb ^ (((sb >> 9) & 1) << 5); R = (st >> 1) * 16 + swz / 64; C = (st & 1) * 32 + (swz % 64) / 2; }
__host__ __device__ __forceinline__ int perm32(int rho) { const int n = rho >> 4, i = rho & 15; return 8 * (i >> 2) + 4 * n + (i & 3); }

struct Unit { int pm, pn; };
struct Gemm { const bf16_t* A; const bf16_t* Bt; int M, N, K, lda; };

struct StaticOrder {
    int nM, nN, nwg, G, c;
    __host__ __device__ void init(int M, int N, int G_, int c_) { nM = M / BM; nN = N / BM; nwg = nM * nN; G = G_; c = c_; }
    __host__ __device__ bool next(int i, Unit& u) const {
        const long L = (long)i * G + c; if (L >= nwg) return false;
        int wgid = (int)L; { const int q = nwg / NXCD, r = nwg % NXCD, xcd = wgid % NXCD, off = wgid / NXCD; wgid = (xcd < r ? xcd * (q + 1) : r * (q + 1) + (xcd - r) * q) + off; }
        const int nig = WGM * nN, gid = wgid / nig, fm = gid * WGM, gsz = (nM - fm) < WGM ? (nM - fm) : WGM;
        u.pm = fm + ((wgid % nig) % gsz); u.pn = (wgid % nig) / gsz; return true;
    }
    __device__ __forceinline__ void a_ready(const Unit&) const {}
    __device__ __forceinline__ void done(const Unit&) const {}
};
template <class Epi, class Sched, bool STAMP = false>
__device__ __forceinline__ void gemm_phase(PG8_LAS unsigned char* lds, const Gemm g, const Sched& S, const Epi& E, unsigned long long* stamps) {
    const int tid = tidx(), wid = __builtin_amdgcn_readfirstlane(tid >> 6), lane = tid & 63, wr = wid >> 2, wc = wid & 3, fr = lane & 15, fq = lane >> 4;
    const int K = g.K, nt = K / BK;
    int ts_lo = 0, ts_hi = 0, nts = 0; const unsigned long long rt_entry = STAMP ? (unsigned long long)wall_clock64() : 0ull;
#define PG8_STAMP() do { if (STAMP && wid == 0 && nts < 64) { const unsigned long long _c = (unsigned long long)clock64(); \
        ts_lo = (lane == nts) ? (int)(unsigned)_c : ts_lo; ts_hi = (lane == nts) ? (int)(unsigned)(_c >> 32) : ts_hi; ++nts; } } while (0)
    PG8_STAMP();
    unsigned voffA[2];
#pragma unroll
    for (int i = 0; i < 2; ++i) { int R, C; stage_rc(tid * 16 + i * 8192, R, C); const int Rb = Epi::PERM ? ((R & ~31) + perm32(R & 31)) : R;
        voffA[i] = (unsigned)(R * g.lda + C) * 2u; (void)Rb; }
#define voffB voffA
    const size_t kstep = (size_t)(BK * 2);
    const size_t hstep = (size_t)HALF * K * 2, hstepA = (size_t)HALF * g.lda * 2;
    const size_t tstep = 2 * hstep, tstepA = 2 * hstepA;
    const unsigned ldsw = (unsigned)wid * 1024u;
    const int aoff = lds_byte(wr * 64 + fr, fq * 8), boff = lds_byte(wc * 32 + fr, fq * 8);
#define PG8_SA(b, h) (((b) * 2 + (h)) * HTB)
#define PG8_SB(b, h) ((4 + (b) * 2 + (h)) * HTB)
#define PG8_STAGE(bufoff, gbase, voff) do { _Pragma("unroll") for (int _i = 0; _i < 2; ++_i) \
        __builtin_amdgcn_global_load_lds((const unsigned*)((const char*)(gbase) + (voff)[_i]), (PG8_LAS unsigned*)(lds + (bufoff) + ldsw + _i * 8192), 16, 0, 0); } while (0)
#define PG8_LDA(dst, b, h) do { _Pragma("unroll") for (int m = 0; m < 4; ++m) _Pragma("unroll") for (int k = 0; k < 2; ++k) dst[m][k] = *(const PG8_LAS bf16x8*)(lds + PG8_SA(b, h) + aoff + m * 2048 + k * 1024); } while (0)
#define PG8_LDB(dst, b, h) do { _Pragma("unroll") for (int n = 0; n < 2; ++n) _Pragma("unroll") for (int k = 0; k < 2; ++k) dst[n][k] = *(const PG8_LAS bf16x8*)(lds + PG8_SB(b, h) + boff + n * 2048 + k * 1024); } while (0)
#define PG8_MMA(ai, bj, At, Bt) do { __builtin_amdgcn_s_setprio(1); _Pragma("unroll") for (int m = 0; m < 4; ++m) _Pragma("unroll") for (int n = 0; n < 2; ++n) _Pragma("unroll") for (int k = 0; k < 2; ++k) \
        acc[ai][bj][m][n] = __builtin_amdgcn_mfma_f32_16x16x32_bf16(Bt[n][k], At[m][k], acc[ai][bj][m][n], 0, 0, 0); __builtin_amdgcn_s_setprio(0); } while (0)
#define PG8_WAIT_V(n) asm volatile("s_waitcnt vmcnt(" #n ")" ::: "memory")
#define PG8_WAIT_L(n) asm volatile("s_waitcnt lgkmcnt(" #n ")" ::: "memory")
#define PG8_BAR __builtin_amdgcn_s_barrier()
#define PG8_SCHED __builtin_amdgcn_sched_barrier(0)
    Unit cur, nxt; int ui = 0;
    if (!S.next(0, cur)) return;
    f32x4 acc[2][2][4][2];
#pragma unroll
    for (int a = 0; a < 2; ++a)
#pragma unroll
        for (int b = 0; b < 2; ++b)
#pragma unroll
            for (int m = 0; m < 4; ++m)
#pragma unroll
                for (int n = 0; n < 2; ++n) acc[a][b][m][n] = (f32x4){0.f, 0.f, 0.f, 0.f};
    bf16x8 At[4][2], B0[2][2], B1[2][2];
    const char* cA = (const char*)g.A + (size_t)cur.pm * tstepA; const char* cB = (const char*)g.Bt + (size_t)cur.pn * tstep;
    S.a_ready(cur);
    PG8_STAGE(PG8_SB(0, 0), cB, voffB); PG8_STAGE(PG8_SA(0, 0), cA, voffA); PG8_STAGE(PG8_SB(0, 1), cB + hstep, voffB); PG8_STAGE(PG8_SA(0, 1), cA + hstepA, voffA);
    if (wr == 1) PG8_BAR;
    PG8_WAIT_V(4); PG8_BAR;
    PG8_STAGE(PG8_SB(1, 0), cB + kstep, voffB); PG8_STAGE(PG8_SA(1, 0), cA + kstep, voffA); PG8_STAGE(PG8_SB(1, 1), cB + hstep + kstep, voffB);
    PG8_WAIT_V(6); PG8_BAR;
    PG8_STAMP();
    for (;;) {
        const bool has_next = S.next(ui + 1, nxt);
        const char* nA = has_next ? (const char*)g.A + (size_t)nxt.pm * tstepA : cA; const char* nB = has_next ? (const char*)g.Bt + (size_t)nxt.pn * tstep : cB;
        for (int t = 0; t < nt; t += 2) {
            const bool last = (t == nt - 2);
            const char* a1 = cA + (size_t)(t + 1) * kstep;
            const char* a2 = last ? nA : cA + (size_t)(t + 2) * kstep; const char* b2 = last ? nB : cB + (size_t)(t + 2) * kstep;
            const char* a3 = a2 + kstep; const char* b3 = b2 + kstep;
            if (last && has_next) S.a_ready(nxt);
            PG8_LDB(B0, 0, 0); PG8_SCHED; PG8_LDA(At, 0, 0); PG8_STAGE(PG8_SA(1, 1), a1 + hstepA, voffA);
            PG8_WAIT_L(8); PG8_BAR; PG8_WAIT_L(0); PG8_MMA(0, 0, At, B0); PG8_BAR; PG8_SCHED;
            PG8_LDB(B1, 0, 1); PG8_STAGE(PG8_SB(0, 0), b2, voffB);
            PG8_BAR; PG8_WAIT_L(0); PG8_MMA(0, 1, At, B1); PG8_BAR;
            PG8_LDA(At, 0, 1); PG8_STAGE(PG8_SA(0, 0), a2, voffA);
            PG8_BAR; PG8_WAIT_L(0); PG8_MMA(1, 0, At, B0); PG8_BAR; PG8_SCHED;
            PG8_STAGE(PG8_SB(0, 1), b2 + hstep, voffB);
            PG8_WAIT_V(6); PG8_BAR; PG8_MMA(1, 1, At, B1); PG8_BAR;
            PG8_LDB(B0, 1, 0); PG8_SCHED; PG8_LDA(At, 1, 0); PG8_STAGE(PG8_SA(0, 1), a2 + hstepA, voffA);
            PG8_WAIT_L(8); PG8_BAR; PG8_WAIT_L(0); PG8_MMA(0, 0, At, B0); PG8_BAR; PG8_SCHED;
            PG8_LDB(B1, 1, 1); PG8_STAGE(PG8_SB(1, 0), b3, voffB);
            PG8_BAR; PG8_WAIT_L(0); PG8_MMA(0, 1, At, B1); PG8_BAR;
            PG8_LDA(At, 1, 1); PG8_STAGE(PG8_SA(1, 0), a3, voffA);
            PG8_BAR; PG8_WAIT_L(0); PG8_MMA(1, 0, At, B0); PG8_BAR; PG8_SCHED;
            PG8_STAGE(PG8_SB(1, 1), b3 + hstep, voffB);
            PG8_WAIT_V(6); PG8_BAR; PG8_MMA(1, 1, At, B1); PG8_BAR;
        }
        PG8_STAMP();
        if constexpr (!Epi::AFTER_DRAIN) { E(acc, cur, wr, wc, fr, fq); S.done(cur); }
        PG8_STAMP();
        if (!has_next) break;
#pragma unroll
        for (int a = 0; a < 2; ++a)
#pragma unroll
            for (int b = 0; b < 2; ++b)
#pragma unroll
                for (int m = 0; m < 4; ++m)
#pragma unroll
                    for (int n = 0; n < 2; ++n) acc[a][b][m][n] = (f32x4){0.f, 0.f, 0.f, 0.f};
        cur = nxt; cA = nA; cB = nB; ++ui;
    }
    PG8_WAIT_V(0);
    if (wr == 0) PG8_BAR;
    PG8_BAR;
    if constexpr (Epi::AFTER_DRAIN) { E.fused(acc, cur, wr, wc, fr, fq, lds, wid, lane); S.done(cur); }
    PG8_STAMP();
    if (STAMP && wid == 0) { stamps[lane] = lane < nts ? (((unsigned long long)(unsigned)ts_hi << 32) | (unsigned)ts_lo) : 0ull;
        if (lane == 62) stamps[62] = rt_entry; if (lane == 63) stamps[63] = (unsigned long long)wall_clock64(); }
#undef PG8_STAMP
#undef PG8_SA
#undef PG8_SB
#undef PG8_STAGE
#undef PG8_LDA
#undef PG8_LDB
#undef PG8_MMA
#undef PG8_WAIT_V
#undef PG8_WAIT_L
#undef PG8_BAR
#undef PG8_SCHED
#undef voffB
}
}

struct EpiPlain {
    static constexpr bool PERM = false, AFTER_DRAIN = false;
    bf16_t* C; int ldc;
    __device__ __forceinline__ void operator()(const f32x4 (&acc)[2][2][4][2], const pg8::Unit& u, int, int, int, int) const {
        const int t_ = tidx(), wr = t_ >> 8, wc = (t_ >> 6) & 3, fr = t_ & 15, fq = (t_ >> 4) & 3;
#pragma unroll
        for (int ai = 0; ai < 2; ++ai)
#pragma unroll
            for (int m = 0; m < 4; ++m) { bf16_t* rowp = C + (size_t)(u.pm * 256 + ai * 128 + wr * 64 + m * 16 + fr) * ldc + u.pn * 256 + wc * 32 + 8 * fq;
#pragma unroll
                for (int bj = 0; bj < 2; ++bj) { const f32x4 v0 = acc[ai][bj][m][0], v1 = acc[ai][bj][m][1]; u32x4 w; w.x = cvt_pk(v0[0], v0[1]); w.y = cvt_pk(v0[2], v0[3]); w.z = cvt_pk(v1[0], v1[1]); w.w = cvt_pk(v1[2], v1[3]);
                    *(u32x4*)(rowp + bj * 128) = w; } }
    }
};
struct EpiF1 {
    static constexpr bool PERM = false, AFTER_DRAIN = false;
    const float* cw; const float* cb; bf16_t* act; bf16_t* E;
    __device__ __forceinline__ void operator()(const f32x4 (&acc)[2][2][4][2], const pg8::Unit& u, int, int, int, int) const {
        const int t_ = tidx(), wr = t_ >> 8, wc = (t_ >> 6) & 3, fr = t_ & 15, fq = (t_ >> 4) & 3;
        const int ch = u.pn * 128 + wc * 32 + 8 * fq;
#pragma unroll
        for (int ai = 0; ai < 2; ++ai) {
            const int strip = u.pm * 4 + ai * 2 + wr; const size_t rowbase = (size_t)u.pm * 256 + ai * 128 + wr * 64;
#pragma unroll
            for (int m = 0; m < 4; ++m) {
                const int rs = m * 16 + fr; f32x4 a[2];
#pragma unroll
                for (int n = 0; n < 2; ++n) {
                    const f32x4 c0 = *(const f32x4*)(cw + ch + 4 * n), c1 = *(const f32x4*)(cw + DFF + ch + 4 * n), c2 = *(const f32x4*)(cw + 2 * DFF + ch + 4 * n), cbv = *(const f32x4*)(cb + ch + 4 * n);
                    const f32x4 g0 = acc[ai][0][m][n], up = acc[ai][1][m][n]; f32x4 g1, g2;
#pragma unroll
                    for (int j = 0; j < 4; ++j) {
                        const float a1 = DPP_MOV(g0[j], 0x121), a2 = DPP_MOV(g0[j], 0x122);
                        float b1 = 0.f, b2 = 0.f;
                        if (m > 0) { b1 = DPP_MOV(acc[ai][0][m > 0 ? m - 1 : 0][n][j], 0x121); b2 = DPP_MOV(acc[ai][0][m > 0 ? m - 1 : 0][n][j], 0x122); }
                        g1[j] = fr >= 1 ? a1 : b1; g2[j] = fr >= 2 ? a2 : b2;
                    }
                    const f32x4 val = c2 * g0 + c1 * g1 + c0 * g2 + cbv;
#pragma unroll
                    for (int j = 0; j < 4; ++j) a[n][j] = val[j] * rcpf_(1.0f + __expf(-val[j])) * up[j];
                }
                const f32x4 gA = acc[ai][0][m][0], gB = acc[ai][0][m][1], uA = acc[ai][1][m][0], uB = acc[ai][1][m][1];
                u32x4 w;
                if (rs >= 2) { w.x = cvt_pk(a[0][0], a[0][1]); w.y = cvt_pk(a[0][2], a[0][3]); w.z = cvt_pk(a[1][0], a[1][1]); w.w = cvt_pk(a[1][2], a[1][3]); *(u32x4*)(act + (rowbase + rs) * DFF + ch) = w; }
                else { w.x = cvt_pk(gA[0], gA[1]); w.y = cvt_pk(gA[2], gA[3]); w.z = cvt_pk(gB[0], gB[1]); w.w = cvt_pk(gB[2], gB[3]); *(u32x4*)(E + ((size_t)strip * 6 + 2 + rs) * DFF + ch) = w;
                       w.x = cvt_pk(uA[0], uA[1]); w.y = cvt_pk(uA[2], uA[3]); w.z = cvt_pk(uB[0], uB[1]); w.w = cvt_pk(uB[2], uB[3]); *(u32x4*)(E + ((size_t)strip * 6 + 4 + rs) * DFF + ch) = w; }
                if (rs >= 62) { w.x = cvt_pk(gA[0], gA[1]); w.y = cvt_pk(gA[2], gA[3]); w.z = cvt_pk(gB[0], gB[1]); w.w = cvt_pk(gB[2], gB[3]); *(u32x4*)(E + ((size_t)strip * 6 + (rs - 62)) * DFF + ch) = w; }
            }
        }
    }
};
struct EpiScale {
    static constexpr bool PERM = false, AFTER_DRAIN = false;
    bf16_t* C; int ldc; float scale;
    __device__ __forceinline__ void operator()(const f32x4 (&acc)[2][2][4][2], const pg8::Unit& u, int, int, int, int) const {
        const int t_ = tidx(), wr = t_ >> 8, wc = (t_ >> 6) & 3, fr = t_ & 15, fq = (t_ >> 4) & 3;
#pragma unroll
        for (int ai = 0; ai < 2; ++ai)
#pragma unroll
            for (int m = 0; m < 4; ++m) { bf16_t* rowp = C + (size_t)(u.pm * 256 + ai * 128 + wr * 64 + m * 16 + fr) * ldc + u.pn * 256 + wc * 32 + 4 * fq;
#pragma unroll
                for (int bj = 0; bj < 2; ++bj)
#pragma unroll
                    for (int n = 0; n < 2; ++n) st_bf4(rowp + bj * 128 + n * 16, acc[ai][bj][m][n] * scale); }
    }
};
struct EpiN1kv {
    static constexpr bool PERM = false, AFTER_DRAIN = false;
    bf16_t* kv;
    __device__ __forceinline__ void operator()(const f32x4 (&acc)[2][2][4][2], const pg8::Unit& u, int, int, int, int) const {
        const int t_ = tidx(), wr = t_ >> 8, wc = (t_ >> 6) & 3, fr = t_ & 15, fq = (t_ >> 4) & 3;
        char* base = (char*)kv;
#pragma unroll
        for (int ai = 0; ai < 2; ++ai)
#pragma unroll
            for (int m = 0; m < 4; ++m) {
                const size_t row = (size_t)u.pm * 256 + ai * 128 + wr * 64 + m * 16 + fr;
#pragma unroll
                for (int bj = 0; bj < 2; ++bj)
#pragma unroll
                    for (int n = 0; n < 2; ++n) {
                        const int c128 = wc * 32 + n * 16 + fq * 4; const f32x4 v = acc[ai][bj][m][n];
                        if (u.pn < 3) {
                            const int cc = u.pn * 2 + bj;
                            if (cc == 0 || cc == 1 || cc == 4) { const size_t off = cc == 0 ? 0 : cc == 1 ? 8 * MiB : 24 * MiB; st_bf4((bf16_t*)(base + off) + row * 128 + c128, v); }
                            else if (cc == 2) { const int b = (int)(row >> 13), t = (int)(row & (SEQ - 1));
                                *(unsigned*)((unsigned char*)(base + 16 * MiB) + ((size_t)((b * 2 + (c128 >> 6)) * SEQ + t)) * 64 + (c128 & 63)) = pack_fp8x4(v[0], v[1], v[2], v[3]); }
                            else if (cc == 3) { const int b = (int)(row >> 13), t = (int)(row & (SEQ - 1));
                                unsigned char* dst = (unsigned char*)(base + 32 * MiB) + ((size_t)((b * 2 + (c128 >> 6)) * 128 + (t >> 6)) * 64 + (c128 & 63)) * 64 + (t & 63);
                                const unsigned pk = pack_fp8x4(v[0], v[1], v[2], v[3]);
                                for (int j = 0; j < 4; ++j) dst[j * 64] = (unsigned char)(pk >> (8 * j)); }
                            else { bf16_t* dst = (bf16_t*)(base + 40 * MiB); const int b = (int)(row >> 13), t = (int)(row & (SEQ - 1));
                                for (int j = 0; j < 4; ++j) dst[((size_t)(b * 128 + c128 + j)) * SEQ + t] = f2bf(v[j]); }
                        } else { if (bj == 0 && c128 < 48) { float* gates = (float*)(base + 48 * MiB); for (int j = 0; j < 4; ++j) gates[row * 48 + c128 + j] = sigmoidf_(v[j]); } }
                    }
            }
    }
};
struct EpiL1 {
    static constexpr bool PERM = false, AFTER_DRAIN = false;
    bf16_t *qe, *ke, *vT, *r; float* adn;
    __device__ __forceinline__ void operator()(const f32x4 (&acc)[2][2][4][2], const pg8::Unit& u, int, int, int, int) const {
        const int t_ = tidx(), wr = t_ >> 8, wc = (t_ >> 6) & 3, fr = t_ & 15, fq = (t_ >> 4) & 3;
#pragma unroll
        for (int ai = 0; ai < 2; ++ai)
#pragma unroll
            for (int m = 0; m < 4; ++m) {
                const size_t row = (size_t)u.pm * 256 + ai * 128 + wr * 64 + m * 16 + fr;
#pragma unroll
                for (int bj = 0; bj < 2; ++bj)
#pragma unroll
                    for (int n = 0; n < 2; ++n) {
                        const int c = bj * 128 + wc * 32 + n * 16 + fq * 4; const f32x4 v = acc[ai][bj][m][n];
                        if (u.pn < 2) st_bf4(qe + row * 512 + u.pn * 256 + c, v * 0.08838834764831845f);
                        else if (u.pn < 4) st_bf4(ke + row * 512 + (u.pn - 2) * 256 + c, v);
                        else if (u.pn < 8) { const int b = (int)(row >> 13), t = (int)(row & (SEQ - 1)), vc = (u.pn - 4) * 256 + c;
                            for (int j = 0; j < 4; ++j) vT[((size_t)(b * 1024 + vc + j)) * SEQ + t] = f2bf(v[j]); }
                        else if (u.pn < 12) st_bf4(r + row * DM + (u.pn - 8) * 256 + c, v);
                        else { if (c < 16) *(f32x4*)(adn + row * 16 + c) = v; }
                    }
            }
    }
};
template <class Epi>
DEV void phase_gemm_pg8(const bf16_t* A, int lda, const bf16_t* Bt, int N, int K, const Epi& E, char* smem) {
    pg8::Gemm g; g.A = A; g.Bt = Bt; g.M = T; g.N = N; g.K = K; g.lda = lda;
    pg8::StaticOrder S; S.init(T, N, (int)gridDim.x, (int)blockIdx.x);
    pg8::gemm_phase<Epi, pg8::StaticOrder, false>((PG8_LAS unsigned char*)smem, g, S, E, nullptr);
}
struct LaneId { int lane, wid, wm, wn, fr, fq; };
DEV LaneId lane_id() { LaneId l; l.lane = tidx() & 63; l.wid = tidx() >> 6; l.wm = l.wid >> 1; l.wn = l.wid & 1; l.fr = l.lane & 15; l.fq = l.lane >> 4; return l; }

template <class Map>
DEV void prep_T(bf16_t* dst, const float* src, int Ks, int Ns, int Nd, int Kd, Map map, char* smem, int& cursor) {
    float* tile = (float*)smem;
    const int ntn = Nd >> 6, ntiles = ntn * (Kd >> 6), tid = tidx(), G = (int)gridDim.x;
    int first = ((int)blockIdx.x - cursor) % G; if (first < 0) first += G;
    for (int tl = first; tl < ntiles; tl += G) {
        const int n0 = (tl % ntn) * 64, k0 = (tl / ntn) * 64;
        { const int j4 = (tid & 15) * 4, kr = tid >> 4;
          const int m0 = map(n0 + j4), m3 = map(n0 + j4 + 3);
          const bool vec = (m0 >= 0) && (m3 == m0 + 3) && ((Ns & 3) == 0) && ((m0 & 3) == 0);
#pragma unroll
          for (int p = 0; p < 2; ++p) { const int kk = kr + 32 * p, k = k0 + kk; f32x4 v = {0.f, 0.f, 0.f, 0.f};
              if (k < Ks) { if (vec) v = *(const f32x4*)(src + (size_t)k * Ns + m0);
                            else { for (int q = 0; q < 4; ++q) { const int n = map(n0 + j4 + q); v[q] = n >= 0 ? src[(size_t)k * Ns + n] : 0.f; } } }
              tile[kk * 65 + j4] = v[0]; tile[kk * 65 + j4 + 1] = v[1]; tile[kk * 65 + j4 + 2] = v[2]; tile[kk * 65 + j4 + 3] = v[3]; } }
        __syncthreads();
        { const int r = tid >> 3, c8 = (tid & 7) * 8;
          u32x4 w; w.x = cvt_pk(tile[(c8 + 0) * 65 + r], tile[(c8 + 1) * 65 + r]); w.y = cvt_pk(tile[(c8 + 2) * 65 + r], tile[(c8 + 3) * 65 + r]);
          w.z = cvt_pk(tile[(c8 + 4) * 65 + r], tile[(c8 + 5) * 65 + r]); w.w = cvt_pk(tile[(c8 + 6) * 65 + r], tile[(c8 + 7) * 65 + r]);
          *(u32x4*)(dst + (size_t)(n0 + r) * Kd + k0 + c8) = w; }
        __syncthreads();
    }
    cursor += ntiles;
}
struct MapId { int ns; DEV int operator()(int n) const { return n < ns ? n : -1; } };
struct MapPerm { int ns; DEV int operator()(int n) const { return n < ns ? (n & ~31) + pg8::perm32(n & 31) : -1; } };
struct MapFfn { DEV int operator()(int v) const { const int pn = v >> 8, c = v & 255, cc = (c & 96) + pg8::perm32(c & 31); return c < 128 ? 128 * pn + cc : DFF + 128 * pn + cc; } };

DEV void phase_prep(const Params& P, int layer, char* smem) {
    char* ws = P.ws; int cur = 0;
    const int kind = layer % 3, j = layer / 3;
    prep_T((bf16_t*)(ws + OFF_WF1), P.in[I_FWIN] + (size_t)layer * DM * 2 * DFF, DM, 2 * DFF, 2 * DFF, DM, MapFfn{}, smem, cur);
    prep_T((bf16_t*)(ws + OFF_WF2), P.in[I_FWOUT] + (size_t)layer * DFF * DM, DFF, DM, DM, DFF, MapPerm{DM}, smem, cur);
    bf16_t* mix = (bf16_t*)(ws + OFF_MIX);
    if (kind == 0) {
        const float* wrkv = P.in[I_WRKV] + (size_t)j * 3 * DM * DM;
        prep_T(mix, wrkv, DM, DM, DM, DM, MapId{DM}, smem, cur);
        prep_T(mix + (size_t)1024 * DM, wrkv + (size_t)DM * DM, DM, DM, DM, DM, MapId{DM}, smem, cur);
        prep_T(mix + (size_t)2048 * DM, P.in[I_W1] + (size_t)j * DM * 64, DM, 64, 128, DM, MapId{64}, smem, cur);
        prep_T(mix + (size_t)2176 * DM, P.in[I_A1] + (size_t)j * DM * 64, DM, 64, 128, DM, MapId{64}, smem, cur);
        prep_T(mix + (size_t)2304 * DM, P.in[I_G1] + (size_t)j * DM * 128, DM, 128, 128, DM, MapId{128}, smem, cur);
        if (j > 0) prep_T(mix + (size_t)2432 * DM, P.in[I_V1] + (size_t)(j - 1) * DM * 32, DM, 32, 128, DM, MapId{32}, smem, cur);
        else       prep_T(mix + (size_t)2432 * DM, P.in[I_V1], DM, 32, 128, DM, MapId{0}, smem, cur);
        prep_T((bf16_t*)((char*)mix + 5 * MiB), wrkv + (size_t)2 * DM * DM, DM, DM, DM, DM, MapId{DM}, smem, cur);
        prep_T((bf16_t*)((char*)mix + 7 * MiB), P.in[I_W2] + (size_t)j * 64 * DM, 64, DM, DM, 64, MapId{DM}, smem, cur);
        prep_T((bf16_t*)((char*)mix + 7 * MiB + 131072), P.in[I_A2] + (size_t)j * 64 * DM, 64, DM, DM, 64, MapId{DM}, smem, cur);
        if (j > 0) prep_T((bf16_t*)((char*)mix + 7 * MiB + 262144), P.in[I_V2] + (size_t)(j - 1) * 32 * DM, 32, DM, DM, 64, MapId{DM}, smem, cur);
        prep_T((bf16_t*)((char*)mix + 7 * MiB + 393216), P.in[I_G2] + (size_t)j * 128 * DM, 128, DM, DM, 128, MapId{DM}, smem, cur);
        prep_T((bf16_t*)((char*)mix + 8 * MiB), P.in[I_RWO] + (size_t)j * DM * DM, DM, DM, DM, DM, MapPerm{DM}, smem, cur);
    } else if (kind == 1) {
        prep_T(mix, P.in[I_NWIN], DM, 1840, 2048, DM, MapId{1840}, smem, cur);
        prep_T((bf16_t*)((char*)mix + 4 * MiB), P.in[I_CW1], 2048, 256, 256, 2048, MapId{256}, smem, cur);
        prep_T((bf16_t*)((char*)mix + 4 * MiB) + (size_t)256 * 2048, P.in[I_CW1] + (size_t)2048 * 256, 2048, 256, 256, 2048, MapId{256}, smem, cur);
        prep_T((bf16_t*)((char*)mix + 6 * MiB), P.in[I_CW2], 256, 64, 128, 256, MapId{64}, smem, cur);
        prep_T((bf16_t*)((char*)mix + 6 * MiB) + (size_t)128 * 256, P.in[I_CW2] + (size_t)256 * 64, 256, 64, 128, 256, MapId{64}, smem, cur);
        prep_T((bf16_t*)((char*)mix + 7 * MiB), P.in[I_NWO], DM, DM, DM, DM, MapPerm{DM}, smem, cur);
        { const int lane = tidx() & 63, gw = blockIdx.x * (NTHR / 64) + (tidx() >> 6);
          if (gw < 512) { const int c = gw >> 8, col = gw & 255; const float* w1 = P.in[I_CW1] + (size_t)c * 2048 * 256; const float* pe = P.in[I_CPE] + (size_t)c * 2048;
              float sacc = 0.f; for (int k = lane; k < 2048; k += 64) sacc += pe[k] * w1[(size_t)k * 256 + col];
              sacc = wave_sum(sacc); if (lane == 0) ((float*)(ws + OFF_BIASP))[gw] = sacc + P.in[I_CB1][c * 256 + col]; } }
    } else {
        prep_T(mix, P.in[I_GWIN], DM, 3088, 3328, DM, MapId{3088}, smem, cur);
        prep_T((bf16_t*)((char*)mix + 7 * MiB), P.in[I_GWO], DM, DM, DM, DM, MapPerm{DM}, smem, cur);
    }
}

template <int HIN, int HOUT>
DEV void phase_norm(const void* h_in, const bf16_t* z, const float* g_post, void* h_out, float* stage, const float* g_pre, bf16_t* xn) {
    const int lane = tidx() & 63, gw = blockIdx.x * (NTHR / 64) + (tidx() >> 6), nw = gridDim.x * (NTHR / 64);
    for (int row = gw; row < T; row += nw) {
        f32x4 hv[4];
#pragma unroll
        for (int i = 0; i < 4; ++i) { const size_t off = (size_t)row * DM + i * 256 + lane * 4;
            if (HIN == 0) hv[i] = *(const f32x4*)((const float*)h_in + off); else hv[i] = ld_bf4((const bf16_t*)h_in + off); }
        if (z) {
            f32x4 zv[4]; float ss = 0.f;
#pragma unroll
            for (int i = 0; i < 4; ++i) { zv[i] = ld_bf4(z + (size_t)row * DM + i * 256 + lane * 4); ss += zv[i][0] * zv[i][0] + zv[i][1] * zv[i][1] + zv[i][2] * zv[i][2] + zv[i][3] * zv[i][3]; }
            ss = wave_sum(ss); const float rs = rsqrtf(ss * (1.0f / DM) + 1e-6f);
#pragma unroll
            for (int i = 0; i < 4; ++i) { const f32x4 g = *(const f32x4*)(g_post + i * 256 + lane * 4); hv[i] += zv[i] * rs * g; }
        }
        if (HOUT == 1) {
#pragma unroll
            for (int i = 0; i < 4; ++i) st_bf4((bf16_t*)h_out + (size_t)row * DM + i * 256 + lane * 4, hv[i]);
        }
        if (HOUT == 2) {
            float* dst = row < T / 2 ? (float*)h_out + (size_t)row * DM : stage + (size_t)(row - T / 2) * DM;
#pragma unroll
            for (int i = 0; i < 4; ++i) *(f32x4*)(dst + i * 256 + lane * 4) = hv[i];
        }
        if (xn) {
            float ss = 0.f;
#pragma unroll
            for (int i = 0; i < 4; ++i) ss += hv[i][0] * hv[i][0] + hv[i][1] * hv[i][1] + hv[i][2] * hv[i][2] + hv[i][3] * hv[i][3];
            ss = wave_sum(ss); const float rs = rsqrtf(ss * (1.0f / DM) + 1e-6f);
#pragma unroll
            for (int i = 0; i < 4; ++i) { const f32x4 g = *(const f32x4*)(g_pre + i * 256 + lane * 4); st_bf4(xn + (size_t)row * DM + i * 256 + lane * 4, hv[i] * rs * g); }
        }
    }
}
DEV void phase_copy_out(const float* stage, float* out) {
    const size_t gt = (size_t)blockIdx.x * NTHR + tidx(), nt = (size_t)gridDim.x * NTHR;
    for (size_t i = gt; i < (size_t)(T / 2) * DM / 4; i += nt) ((f32x4*)(out + (size_t)(T / 2) * DM))[i] = ((const f32x4*)stage)[i];
}

DEV void phase_gemm_plain(const bf16_t* A, int lda, const bf16_t* Bt, int K, int ntn, bf16_t* C, int ldc, char* smem) {
    const LaneId L = lane_id();
    const int nunits = (T / 256) * ntn;
    for (int u = blockIdx.x; u < nunits; u += gridDim.x) {
        const int tm = u / ntn, tn = u % ntn;
        f32x4 acc[4][4];
        gemm_core(acc, LdPlain{A + (size_t)tm * 256 * lda, lda}, LdPlain{Bt + (size_t)tn * 128 * K, K}, K, smem);
#pragma unroll
        for (int m = 0; m < 4; ++m)
#pragma unroll
            for (int n = 0; n < 4; ++n)
                st_bf4(C + (size_t)(tm * 256 + L.wm * 64 + m * 16 + L.fr) * ldc + tn * 128 + L.wn * 64 + n * 16 + L.fq * 4, acc[m][n]);
    }
}

DEV void phase_f1(const bf16_t* xn, const bf16_t* Bt, const float* cw, const float* cb, bf16_t* act, bf16_t* E, char* smem) {
    const LaneId L = lane_id();
    const int ntn = 2 * DFF / 128, nunits = (T / 256) * ntn;
    for (int u = blockIdx.x; u < nunits; u += gridDim.x) {
        const int tm = u / ntn, tn = u % ntn;
        f32x4 acc[4][4];
        gemm_core(acc, LdPlain{xn + (size_t)tm * 256 * DM, DM}, LdPlain{Bt + (size_t)tn * 128 * DM, DM}, DM, smem);
        const int strip = tm * 4 + L.wm; const size_t rowbase = (size_t)tm * 256 + L.wm * 64;
#pragma unroll
        for (int n = 0; n < 2; ++n) {
            const int ch = tn * 64 + L.wn * 32 + n * 16 + L.fq * 4;
            const f32x4 c0 = *(const f32x4*)(cw + ch), c1 = *(const f32x4*)(cw + DFF + ch), c2 = *(const f32x4*)(cw + 2 * DFF + ch), cbv = *(const f32x4*)(cb + ch);
#pragma unroll
            for (int m = 0; m < 4; ++m) {
                const f32x4 g0 = acc[m][n], up = acc[m][n + 2]; f32x4 g1, g2;
#pragma unroll
                for (int j = 0; j < 4; ++j) {
                    const float a1 = __shfl(g0[j], (L.lane - 1) & 63), a2 = __shfl(g0[j], (L.lane - 2) & 63);
                    float b1 = 0.f, b2 = 0.f;
                    if (m > 0) { b1 = __shfl(acc[m > 0 ? m - 1 : 0][n][j], (L.lane + 15) & 63); b2 = __shfl(acc[m > 0 ? m - 1 : 0][n][j], (L.lane + 14) & 63); }
                    g1[j] = L.fr >= 1 ? a1 : b1; g2[j] = L.fr >= 2 ? a2 : b2;
                }
                const int rs = m * 16 + L.fr;
                f32x4 val = c2 * g0 + c1 * g1 + c0 * g2 + cbv, a;
#pragma unroll
                for (int j = 0; j < 4; ++j) a[j] = val[j] * rcpf_(1.0f + __expf(-val[j])) * up[j];
                if (rs >= 2) st_bf4(act + (rowbase + rs) * DFF + ch, a);
                else { st_bf4(E + ((size_t)strip * 6 + 2 + rs) * DFF + ch, g0); st_bf4(E + ((size_t)strip * 6 + 4 + rs) * DFF + ch, up); }
                if (rs >= 62) st_bf4(E + ((size_t)strip * 6 + (rs - 62)) * DFF + ch, g0);
            }
        }
    }
}
DEV void phase_f1b(const float* cw, const float* cb, bf16_t* act, const bf16_t* E) {
    const int gt = blockIdx.x * NTHR + tidx(), nt = gridDim.x * NTHR;
    for (int idx = gt; idx < 512 * 2 * (DFF / 4); idx += nt) {
        const int ch = (idx % (DFF / 4)) * 4, r = (idx / (DFF / 4)) & 1, strip = idx / (2 * (DFF / 4));
        const bool first = (strip & 127) == 0;
        const f32x4 zero = {0.f, 0.f, 0.f, 0.f};
        const f32x4 g0 = ld_bf4(E + ((size_t)strip * 6 + 2 + r) * DFF + ch), up = ld_bf4(E + ((size_t)strip * 6 + 4 + r) * DFF + ch);
        f32x4 g1, g2;
        if (r == 1) { g1 = ld_bf4(E + ((size_t)strip * 6 + 2) * DFF + ch); g2 = first ? zero : ld_bf4(E + ((size_t)(strip - 1) * 6 + 1) * DFF + ch); }
        else { g1 = first ? zero : ld_bf4(E + ((size_t)(strip - 1) * 6 + 1) * DFF + ch); g2 = first ? zero : ld_bf4(E + ((size_t)(strip - 1) * 6 + 0) * DFF + ch); }
        const f32x4 c0 = *(const f32x4*)(cw + ch), c1 = *(const f32x4*)(cw + DFF + ch), c2 = *(const f32x4*)(cw + 2 * DFF + ch), cbv = *(const f32x4*)(cb + ch);
        f32x4 val = c2 * g0 + c1 * g1 + c0 * g2 + cbv, a;
#pragma unroll
        for (int j = 0; j < 4; ++j) a[j] = val[j] * rcpf_(1.0f + __expf(-val[j])) * up[j];
        st_bf4(act + ((size_t)strip * 64 + r) * DFF + ch, a);
    }
}

struct RwkvW { const float *mu, *w0, *a0, *k_k, *k_a, *r_k, *ln_w, *ln_b, *v0; bool vres; };
DEV void phase_r1(const bf16_t* xn, const bf16_t* Bt, const RwkvW& W, bf16_t* rb, bf16_t* kb, bf16_t* hid, char* smem) {
    const LaneId L = lane_id();
    const int ntn = 20, nunits = (T / 256) * ntn;
    for (int u = blockIdx.x; u < nunits; u += gridDim.x) {
        const int tm = u / ntn, tn = u % ntn;
        const int var = tn < 8 ? 0 : tn < 16 ? 2 : tn == 16 ? 1 : tn == 17 ? 4 : tn == 18 ? 5 : 3;
        f32x4 acc[4][4];
        gemm_core(acc, LdMix{xn, W.mu + var * DM, tm * 256, {0.f, 0.f, 0.f, 0.f}, {0.f, 0.f, 0.f, 0.f}}, LdPlain{Bt + (size_t)tn * 128 * DM, DM}, DM, smem);
#pragma unroll
        for (int m = 0; m < 4; ++m)
#pragma unroll
            for (int n = 0; n < 4; ++n) {
                const size_t row = (size_t)tm * 256 + L.wm * 64 + m * 16 + L.fr; const int c = L.wn * 64 + n * 16 + L.fq * 4; f32x4 v = acc[m][n];
                if (tn < 8) st_bf4(rb + row * DM + tn * 128 + c, v);
                else if (tn < 16) st_bf4(kb + row * DM + (tn - 8) * 128 + c, v);
                else if (tn == 16) { if (L.wn == 0) { for (int j = 0; j < 4; ++j) v[j] = tanhf(v[j]); st_bf4(hid + row * HIDP + c, v); } }
                else if (tn == 17) { if (L.wn == 0) st_bf4(hid + row * HIDP + 64 + c, v); }
                else if (tn == 18) { for (int j = 0; j < 4; ++j) v[j] = sigmoidf_(v[j]); st_bf4(hid + row * HIDP + 128 + c, v); }
                else { if (L.wn == 0) st_bf4(hid + row * HIDP + 256 + c, v); }
            }
    }
}
DEV void phase_r2(const bf16_t* xn, const bf16_t* mixw, const RwkvW& W, const bf16_t* hid, const bf16_t* rb, float* bsc, bf16_t* wb, bf16_t* kb, bf16_t* kkb, bf16_t* kab, bf16_t* vb, char* smem) {
    const LaneId L = lane_id();
    const bf16_t* Bv = (const bf16_t*)((const char*)mixw + 5 * MiB);
    const bf16_t* W2T = (const bf16_t*)((const char*)mixw + 7 * MiB);
    const bf16_t* A2T = (const bf16_t*)((const char*)mixw + 7 * MiB + 131072);
    const bf16_t* V2T = (const bf16_t*)((const char*)mixw + 7 * MiB + 262144);
    const int nunits = 1024 + 2048;
    for (int u = blockIdx.x; u < nunits; u += gridDim.x) {
        if (u < 1024) {
            const int tm = u >> 3, tn = u & 7;
            f32x4 acc[4][4]; u32x2 gpk[4][4];
            if (W.vres) {
                gemm_core(acc, LdPlain{hid + (size_t)tm * 256 * HIDP + 256, HIDP}, LdPlain{V2T + (size_t)tn * 128 * 64, 64}, 64, smem);
#pragma unroll
                for (int m = 0; m < 4; ++m)
#pragma unroll
                    for (int n = 0; n < 4; ++n) { const int col = tn * 128 + L.wn * 64 + n * 16 + L.fq * 4; const f32x4 b = *(const f32x4*)(W.v0 + col);
                        gpk[m][n].x = cvt_pk(sigmoidf_(b[0] + acc[m][n][0]), sigmoidf_(b[1] + acc[m][n][1]));
                        gpk[m][n].y = cvt_pk(sigmoidf_(b[2] + acc[m][n][2]), sigmoidf_(b[3] + acc[m][n][3])); }
            }
            gemm_core(acc, LdMix{xn, W.mu + 3 * DM, tm * 256, {0.f, 0.f, 0.f, 0.f}, {0.f, 0.f, 0.f, 0.f}}, LdPlain{Bv + (size_t)tn * 128 * DM, DM}, DM, smem);
#pragma unroll
            for (int m = 0; m < 4; ++m)
#pragma unroll
                for (int n = 0; n < 4; ++n) {
                    const size_t row = (size_t)tm * 256 + L.wm * 64 + m * 16 + L.fr; const int col = tn * 128 + L.wn * 64 + n * 16 + L.fq * 4; f32x4 v = acc[m][n];
                    if (W.vres) { const f32x4 vf = ld_bf4(vb + row * DM + col); f32x4 gt; gt[0] = bf_lo(gpk[m][n].x); gt[1] = bf_hi(gpk[m][n].x); gt[2] = bf_lo(gpk[m][n].y); gt[3] = bf_hi(gpk[m][n].y); v = v + (vf - v) * gt; }
                    st_bf4(vb + row * DM + col, v);
                }
        } else {
            const int u2 = u - 1024, tm = u2 >> 4, jj = u2 & 15;
            f32x4 acc[4][4];
            if (jj < 8) {
                const int tn = jj;
                gemm_core(acc, LdPlain{hid + (size_t)tm * 256 * HIDP, HIDP}, LdPlain{W2T + (size_t)tn * 128 * 64, 64}, 64, smem);
#pragma unroll
                for (int m = 0; m < 4; ++m)
#pragma unroll
                    for (int n = 0; n < 4; ++n) {
                        const size_t row = (size_t)tm * 256 + L.wm * 64 + m * 16 + L.fr; const int col = tn * 128 + L.wn * 64 + n * 16 + L.fq * 4; const f32x4 b = *(const f32x4*)(W.w0 + col); f32x4 v;
                        for (int j = 0; j < 4; ++j) { const float x = b[j] + acc[m][n][j]; const float y = -x;
                            const float sp = fmaxf(y, 0.f) + log1pf(__expf(-fabsf(y))); const float w = -sp - 0.5f; v[j] = __expf(-__expf(w)); }
                        st_bf4(wb + row * DM + col, v);
                    }
            } else {
                const int tn = jj - 8;
                gemm_core(acc, LdPlain{hid + (size_t)tm * 256 * HIDP + 64, HIDP}, LdPlain{A2T + (size_t)tn * 128 * 64, 64}, 64, smem);
#pragma unroll
                for (int m = 0; m < 4; ++m) {
                    const size_t row = (size_t)tm * 256 + L.wm * 64 + m * 16 + L.fr;
                    u32x2 kpk[4]; float ss = 0.f;
#pragma unroll
                    for (int n = 0; n < 4; ++n) { const int col = tn * 128 + L.wn * 64 + n * 16 + L.fq * 4;
                        kpk[n] = *(const u32x2*)(kb + row * DM + col); const f32x4 kkw = *(const f32x4*)(W.k_k + col);
                        const float c0 = bf_lo(kpk[n].x) * kkw[0], c1 = bf_hi(kpk[n].x) * kkw[1], c2 = bf_lo(kpk[n].y) * kkw[2], c3 = bf_hi(kpk[n].y) * kkw[3];
                        ss += (c0 * c0 + c1 * c1) + (c2 * c2 + c3 * c3); }
                    ss += __shfl_xor(ss, 16); ss += __shfl_xor(ss, 32);
                    const float inv = rcpf_(fmaxf(sqrtf(ss), 1e-12f));
                    asm volatile("" ::: "memory");
                    float bon = 0.f;
#pragma unroll
                    for (int n = 0; n < 4; ++n) { const int col = tn * 128 + L.wn * 64 + n * 16 + L.fq * 4;
                        const f32x4 ka = *(const f32x4*)(W.k_a + col), kkw = *(const f32x4*)(W.k_k + col), a0 = *(const f32x4*)(W.a0 + col), rkv = *(const f32x4*)(W.r_k + col), rv = ld_bf4(rb + row * DM + col);
                        f32x4 kv; kv[0] = bf_lo(kpk[n].x); kv[1] = bf_hi(kpk[n].x); kv[2] = bf_lo(kpk[n].y); kv[3] = bf_hi(kpk[n].y);
                        f32x4 kk, kp, kka;
                        for (int j = 0; j < 4; ++j) { const float a = sigmoidf_(a0[j] + acc[m][n][j]); kk[j] = kv[j] * kkw[j] * inv; kp[j] = kv[j] * (1.0f + (a - 1.0f) * ka[j]); kka[j] = kk[j] * a; }
                        const u32x2 kpp = {cvt_pk(kp[0], kp[1]), cvt_pk(kp[2], kp[3])};
                        bon += rv[0] * bf_lo(kpp.x) * rkv[0] + rv[1] * bf_hi(kpp.x) * rkv[1] + rv[2] * bf_lo(kpp.y) * rkv[2] + rv[3] * bf_hi(kpp.y) * rkv[3];
                        *(u32x2*)(kb + row * DM + col) = kpp; st_bf4(kkb + row * DM + col, kk); st_bf4(kab + row * DM + col, kka);
                        asm volatile("" ::: "memory"); }
                    bon += __shfl_xor(bon, 16); bon += __shfl_xor(bon, 32);
                    if (L.fq == 0) bsc[row * 16 + tn * 2 + L.wn] = bon;
                }
            }
        }
    }
}
typedef float f32x2 __attribute__((ext_vector_type(2)));
constexpr int R3_CH = 32, R3_STR = R3_CH * 256, R3_BUF = 5 * R3_STR + R3_CH * 64;
DEV void r3_stage_raw(const bf16_t* const (&str)[5], const bf16_t* vb, size_t base, int vrow0, int t0, char* buf, int id) {
    u32x4 d[5];
    const int t = id >> 3, j = id & 7;
#pragma unroll
    for (int st = 0; st < 5; ++st) d[st] = *(const u32x4*)(str[st] + base + (size_t)(t0 + t) * DM + j * 8);
    u32x4 vv = {0u, 0u, 0u, 0u};
    if (id < 64) vv = *(const u32x4*)(vb + base + (size_t)(t0 + (id >> 1)) * DM + vrow0 + (id & 1) * 8);
#pragma unroll
    for (int st = 0; st < 5; ++st) { f32x4 a, b; a[0] = bf_lo(d[st].x); a[1] = bf_hi(d[st].x); a[2] = bf_lo(d[st].y); a[3] = bf_hi(d[st].y); b[0] = bf_lo(d[st].z); b[1] = bf_hi(d[st].z); b[2] = bf_lo(d[st].w); b[3] = bf_hi(d[st].w);
        float* p = (float*)(buf + st * R3_STR + t * 256 + j * 32); *(f32x4*)p = a; *(f32x4*)(p + 4) = b; }
    if (id < 64) { f32x4 a, b; a[0] = bf_lo(vv.x); a[1] = bf_hi(vv.x); a[2] = bf_lo(vv.y); a[3] = bf_hi(vv.y); b[0] = bf_lo(vv.z); b[1] = bf_hi(vv.z); b[2] = bf_lo(vv.w); b[3] = bf_hi(vv.w);
        float* vp = (float*)(buf + 5 * R3_STR + (id >> 1) * 64 + (id & 1) * 32); *(f32x4*)vp = a; *(f32x4*)(vp + 4) = b; }
}
DEV void phase_r3(const bf16_t* rb, const bf16_t* wb, const bf16_t* kb, const bf16_t* kkb, const bf16_t* kab, const bf16_t* vb, bf16_t* yb, float* bsc, const float* r_k, char* smem) {
    const int tid = tidx(), lane = tid & 63, wid = tid >> 6;
    const bf16_t* const str[5] = {rb, wb, kb, kkb, kab};
    constexpr int NCH = SEQ / R3_CH;
    for (int task = blockIdx.x; task < 256; task += gridDim.x) {
        const int bh = task >> 2, b = bh >> 4, h = bh & 15, rq = task & 3;
        const size_t base = (size_t)b * SEQ * DM + h * 64;
        bf16_t* ystage = (bf16_t*)(smem + 149504 + 64);
    float* gcarea = (float*)(smem + 3 * R3_BUF);
        if (wid >= 4) r3_stage_raw(str, vb, base, rq * 16, 0, smem, tid - 256);
        __syncthreads();
        if (wid >= 4) { r3_stage_raw(str, vb, base, rq * 16, R3_CH, smem + R3_BUF, tid - 256);
            char* bq = smem; float* w = (float*)bq + R3_STR / 4 + lane; const int p = wid - 4;
            float G = 1.f; for (int t = 0; t < 8 * p; ++t) G *= w[t * 64];
            float* r = (float*)bq + lane; float* k = r + 2 * (R3_STR / 4); float* q = r + 3 * (R3_STR / 4); float* a = r + 4 * (R3_STR / 4);
#pragma unroll
            for (int u = 0; u < 8; ++u) { const int t = 8 * p + u; const float Gold = G; G *= w[t * 64]; const float inv = rcpf_(G); r[t * 64] *= G; q[t * 64] *= Gold; k[t * 64] *= inv; a[t * 64] *= inv; }
            if (p == 3) gcarea[lane] = G; }
        __syncthreads();
        const int rr = lane >> 4, cg = lane & 15, rg = rq * 4 + wid;
        const size_t voff = base + rg * 4 + rr;
        f32x2 s01 = {0.f, 0.f}, s23 = {0.f, 0.f};
        for (int c = 0; c < NCH; ++c) {
            if (wid >= 4) {
                if (c >= 1 && tid - 256 < 64) { const int id = tid - 256;
                    *(u32x4*)(yb + base + (size_t)((c - 1) * R3_CH + (id >> 1)) * DM + rq * 16 + (id & 1) * 8) = *(const u32x4*)(ystage + ((c - 1) & 1) * 512 + (id >> 1) * 16 + (id & 1) * 8); }
                if (c + 2 < NCH) r3_stage_raw(str, vb, base, rq * 16, (c + 2) * R3_CH, smem + ((c + 2) % 3) * R3_BUF, tid - 256);
                if (c + 1 < NCH) { char* bq = smem + ((c + 1) % 3) * R3_BUF; float* w = (float*)bq + R3_STR / 4 + lane; const int p = wid - 4;
                    float G = 1.f; for (int t = 0; t < 8 * p; ++t) G *= w[t * 64];
                    float* r = (float*)bq + lane; float* k = r + 2 * (R3_STR / 4); float* q = r + 3 * (R3_STR / 4); float* a = r + 4 * (R3_STR / 4);
#pragma unroll
                    for (int u = 0; u < 8; ++u) { const int t = 8 * p + u; const float Gold = G; G *= w[t * 64]; const float inv = rcpf_(G); r[t * 64] *= G; q[t * 64] *= Gold; k[t * 64] *= inv; a[t * 64] *= inv; }
                    if (p == 3) gcarea[((c + 1) % 3) * 64 + lane] = G; }
            } else {
                const char* buf = smem + (c % 3) * R3_BUF;
                f32x4 R_[2][2], K_[2][2], Q_[2][2], A_[2][2]; float V_[2][2];
#define R3_LD(bf, t0) { _Pragma("unroll") for (int u = 0; u < 2; ++u) { const char* p = buf + ((t0) + u) * 256 + cg * 16; \
                    R_[bf][u] = *(const f32x4*)p; K_[bf][u] = *(const f32x4*)(p + 2 * R3_STR); Q_[bf][u] = *(const f32x4*)(p + 3 * R3_STR); A_[bf][u] = *(const f32x4*)(p + 4 * R3_STR); \
                    V_[bf][u] = *(const float*)(buf + 5 * R3_STR + ((t0) + u) * 64 + (wid * 4 + rr) * 4); } }
#define R3_CP(bf, sl) { _Pragma("unroll") for (int u = 0; u < 2; ++u) { \
                    const f32x4 R = R_[bf][u], K = K_[bf][u], Q = Q_[bf][u], A = A_[bf][u]; const float vv = V_[bf][u]; \
                    const f32x2 r01 = {R[0], R[1]}, r23 = {R[2], R[3]}, k01 = {K[0], K[1]}, k23 = {K[2], K[3]}; \
                    const f32x2 q01 = {Q[0], Q[1]}, q23 = {Q[2], Q[3]}, a01 = {A[0], A[1]}, a23 = {A[2], A[3]}; \
                    const f32x2 pq = s01 * q01 + s23 * q23; \
                    const float sa = -row16_sum(pq.x + pq.y); \
                    const f32x2 sa2 = {sa, sa}, vv2 = {vv, vv}; \
                    s01 = (s01 + vv2 * k01) + sa2 * a01; s23 = (s23 + vv2 * k23) + sa2 * a23; \
                    const f32x2 py = s01 * r01 + s23 * r23; \
                    const float y = row16_sum(py.x + py.y); \
                    yv = (cg == (sl) + u) ? y : yv; } }
                R3_LD(0, 0)
#pragma unroll 1
                for (int t8 = 0; t8 < R3_CH; t8 += 8) {
                    float yv = 0.f;
                    R3_LD(1, t8 + 2)
                    R3_CP(0, 0)
                    R3_LD(0, t8 + 4)
                    R3_CP(1, 2)
                    R3_LD(1, t8 + 6)
                    R3_CP(0, 4)
                    if (t8 + 8 < R3_CH) R3_LD(0, t8 + 8)
                    R3_CP(1, 6)
                    if (cg < 8) ystage[(c & 1) * 512 + (t8 + cg) * 16 + wid * 4 + rr] = f2bf(yv);
                }
#undef R3_LD
#undef R3_CP
                const f32x4 GC = *(const f32x4*)(gcarea + (c % 3) * 64 + cg * 4);
                s01 *= (f32x2){GC[0], GC[1]}; s23 *= (f32x2){GC[2], GC[3]};
            }
            __syncthreads();
        }
        if (wid >= 4 && tid - 256 < 64) { const int id = tid - 256;
            *(u32x4*)(yb + base + (size_t)((NCH - 1) * R3_CH + (id >> 1)) * DM + rq * 16 + (id & 1) * 8) = *(const u32x4*)(ystage + ((NCH - 1) & 1) * 512 + (id >> 1) * 16 + (id & 1) * 8); }
        __syncthreads();
    }
}
constexpr int RC_NP = 8, RC_SLOT = 18688, RC_LDS = 18688;
constexpr int RC_QT = 0, RC_RR = 4096, RC_BG = 8192, RC_AB = 12288, RC_D0 = 14336, RC_U0 = 16384, RC_Y0 = 17408, RC_G = 18432;
#define R3C_FENCE() asm volatile("" ::: "memory")
constexpr int RC_P = 144;
DEV bf16x8 r3c_permfrag(const char* rowp, int q) {
    const u32x2 lo = *(const u32x2*)(rowp + 8 * q), hi = *(const u32x2*)(rowp + 32 + 8 * q);
    u32x4 w; w.x = lo.x; w.y = lo.y; w.z = hi.x; w.w = hi.y; return __builtin_bit_cast(bf16x8, w);
}
DEV bf16x8 r3c_neg(bf16x8 a) { u32x4 w = __builtin_bit_cast(u32x4, a); w.x ^= 0x80008000u; w.y ^= 0x80008000u; w.z ^= 0x80008000u; w.w ^= 0x80008000u; return __builtin_bit_cast(bf16x8, w); }
DEV u32x4 r3c_scale8(u32x4 d, f32x4 a, f32x4 b) {
    u32x4 o; o.x = cvt_pk(bf_lo(d.x) * a[0], bf_hi(d.x) * a[1]); o.y = cvt_pk(bf_lo(d.y) * a[2], bf_hi(d.y) * a[3]);
    o.z = cvt_pk(bf_lo(d.z) * b[0], bf_hi(d.z) * b[1]); o.w = cvt_pk(bf_lo(d.w) * b[2], bf_hi(d.w) * b[3]); return o;
}
DEV u32x2 r3c_pk4(f32x4 v) { u32x2 w; w.x = cvt_pk(v[0], v[1]); w.y = cvt_pk(v[2], v[3]); return w; }
DEV f32x4 r3c_up4(u32x2 w) { f32x4 v; v[0] = bf_lo(w.x); v[1] = bf_hi(w.x); v[2] = bf_lo(w.y); v[3] = bf_hi(w.y); return v; }
#define R3C_SCORE(dst, A, B, ROWLESS, STRICT) { _Pragma("unroll") for (int a = 0; a < 2; ++a) { _Pragma("unroll") for (int b = 0; b < 2; ++b) { \
        f32x4 a_ = MFMA(A[a][0], B[b][0], z4); a_ = MFMA(A[a][1], B[b][1], a_); \
        _Pragma("unroll") for (int r = 0; r < 4; ++r) { const int row_ = 16 * a + 4 * q + r, col_ = 16 * b + m; const int lo_ = (ROWLESS) ? row_ : col_, hi_ = (ROWLESS) ? col_ : row_; \
            const bool keep_ = (STRICT) ? (lo_ < hi_) : (lo_ <= hi_); a_[r] = keep_ ? a_[r] : 0.f; } \
        dst[a][b] = a_; } } }
template <bool PERM> DEV bf16x8 r3c_ident(int x, int m, int q) {
    u32x4 w = {0u, 0u, 0u, 0u};
#pragma unroll
    for (int jj = 0; jj < 8; ++jj) { const unsigned one = 0x3F80u << ((jj & 1) * 16); const int k = PERM ? ((jj < 4) ? 4 * q + jj : 16 + 4 * q + jj - 4) : 8 * q + jj; const unsigned v = (k == 16 * x + m) ? one : 0u;
        if ((jj >> 1) == 0) w.x |= v; else if ((jj >> 1) == 1) w.y |= v; else if ((jj >> 1) == 2) w.z |= v; else w.w |= v; }
    return __builtin_bit_cast(bf16x8, w);
}
struct R3Raw { u32x4 dr[4], dw[4], dk[4], dq[4], da[4]; bf16x8 vfrag; };
DEV void r3c_load(R3Raw& W, const bf16_t* rb, const bf16_t* wb, const bf16_t* kkb, const bf16_t* vb, int vrow0, int lane) {
    const int m = lane & 15, q = lane >> 4, tr = lane >> 3, j = lane & 7;
#pragma unroll
    for (int s = 0; s < 4; ++s) { const unsigned o = (unsigned)(((8 * s + tr) * DM + j * 8) * 2);
        W.dw[s] = *(const u32x4*)((const char*)wb + o); W.dr[s] = *(const u32x4*)((const char*)rb + o); W.dq[s] = *(const u32x4*)((const char*)kkb + o); }
    unsigned e[8];
#pragma unroll
    for (int jj = 0; jj < 8; ++jj) { const int t = (jj < 4) ? 4 * q + jj : 16 + 4 * q + jj - 4; e[jj] = *(const bf16_t*)((const char*)vb + (unsigned)((t * DM + vrow0 + m) * 2)); }
    u32x4 w; w.x = e[0] | (e[1] << 16); w.y = e[2] | (e[3] << 16); w.z = e[4] | (e[5] << 16); w.w = e[6] | (e[7] << 16); W.vfrag = __builtin_bit_cast(bf16x8, w);
}
DEV void r3c_load2(R3Raw& W, const bf16_t* kb, const bf16_t* kab, int lane) {
    const int tr = lane >> 3, j = lane & 7;
#pragma unroll
    for (int s = 0; s < 4; ++s) { const unsigned o = (unsigned)(((8 * s + tr) * DM + j * 8) * 2); W.dk[s] = *(const u32x4*)((const char*)kb + o); W.da[s] = *(const u32x4*)((const char*)kab + o); }
}
DEV void r3c_produce(R3Raw& W, const bf16_t* kb, const bf16_t* kab, char* lds, int lane) {
    const int m = lane & 15, q = lane >> 4, tr = lane >> 3, j = lane & 7;
    r3c_load2(W, kb, kab, lane);
    const f32x4 z4 = {0.f, 0.f, 0.f, 0.f};
    char* Rh = lds; char* Qh = lds + 32 * RC_P; char* Kh = lds + 64 * RC_P; char* Bh = lds + 96 * RC_P; float* G31a = (float*)(lds + 128 * RC_P);
    float* Gb = (float*)Kh;
    const bf16x8 vfrag = W.vfrag;
#pragma unroll
    for (int s = 0; s < 4; ++s) { float* gp = Gb + (8 * s + tr) * 64 + 8 * j; f32x4 a, b; const u32x4 d = W.dw[s];
        a[0] = bf_lo(d.x); a[1] = bf_hi(d.x); a[2] = bf_lo(d.y); a[3] = bf_hi(d.y); b[0] = bf_lo(d.z); b[1] = bf_hi(d.z); b[2] = bf_lo(d.w); b[3] = bf_hi(d.w);
        *(f32x4*)gp = a; *(f32x4*)(gp + 4) = b; }
    R3C_FENCE();
    { float g[32];
#pragma unroll
      for (int t = 0; t < 32; ++t) g[t] = Gb[t * 64 + lane];
      float G = 1.f;
#pragma unroll
      for (int t = 0; t < 32; ++t) { G *= g[t]; Gb[t * 64 + lane] = G; }
      G31a[lane] = G; }
    R3C_FENCE();
    { u32x4 kh[4], bh[4];
#pragma unroll
      for (int s = 0; s < 4; ++s) { const int t = 8 * s + tr, tp = t > 0 ? t - 1 : 0;
          const f32x4 g0 = *(const f32x4*)(Gb + t * 64 + 8 * j), g1 = *(const f32x4*)(Gb + t * 64 + 8 * j + 4);
          f32x4 p0 = *(const f32x4*)(Gb + tp * 64 + 8 * j), p1 = *(const f32x4*)(Gb + tp * 64 + 8 * j + 4);
          if (t == 0) { p0 = (f32x4){1.f, 1.f, 1.f, 1.f}; p1 = p0; }
          f32x4 i0, i1;
#pragma unroll
          for (int e = 0; e < 4; ++e) { i0[e] = rcpf_(g0[e]); i1[e] = rcpf_(g1[e]); }
          *(u32x4*)(Rh + t * RC_P + j * 16) = r3c_scale8(W.dr[s], g0, g1);
          *(u32x4*)(Qh + t * RC_P + j * 16) = r3c_scale8(W.dq[s], p0, p1);
          kh[s] = r3c_scale8(W.dk[s], i0, i1); bh[s] = r3c_scale8(W.da[s], i0, i1); }
      R3C_FENCE();
#pragma unroll
      for (int s = 0; s < 4; ++s) { const int t = 8 * s + tr; *(u32x4*)(Kh + t * RC_P + j * 16) = kh[s]; *(u32x4*)(Bh + t * RC_P + j * 16) = bh[s]; } }
    R3C_FENCE();
    bf16x8 Qa[2][2], Ra[2][2], Kb[2][2], Bb[2][2];
#pragma unroll
    for (int x = 0; x < 2; ++x)
#pragma unroll
        for (int ks = 0; ks < 2; ++ks) { const int off = (16 * x + m) * RC_P + (32 * ks + 8 * q) * 2;
            Qa[x][ks] = *(const bf16x8*)(Qh + off); Ra[x][ks] = *(const bf16x8*)(Rh + off); Kb[x][ks] = *(const bf16x8*)(Kh + off); Bb[x][ks] = *(const bf16x8*)(Bh + off); }
    f32x4 Tt[2][2], PN[2][2], PT[2][2], Z[2][5];
    R3C_SCORE(Tt, Kb, Qa, true, true)
    Z[0][4] = MFMA(pack8(Tt[0][0], Tt[1][0]), vfrag, z4); Z[1][4] = MFMA(pack8(Tt[0][1], Tt[1][1]), vfrag, z4);
    R3C_SCORE(Tt, Kb, Ra, true, false)
    u32x2 oY0[2]; oY0[0] = r3c_pk4(MFMA(pack8(Tt[0][0], Tt[1][0]), vfrag, z4)); oY0[1] = r3c_pk4(MFMA(pack8(Tt[0][1], Tt[1][1]), vfrag, z4));
    R3C_SCORE(Tt, Bb, Ra, true, false)
    bf16x8 oAB[2]; oAB[0] = r3c_neg(pack8(Tt[0][0], Tt[1][0])); oAB[1] = r3c_neg(pack8(Tt[0][1], Tt[1][1]));
    R3C_SCORE(PN, Qa, Bb, false, true)
    R3C_SCORE(PT, Bb, Qa, true, true)
#pragma unroll
    for (int mt = 0; mt < 2; ++mt)
#pragma unroll
        for (int n = 0; n < 4; ++n) Z[mt][n] = MFMA(Qa[mt][n >> 1], r3c_ident<false>(n & 1, m, q), z4);
#pragma unroll
    for (int lev = 0; lev < 5; ++lev) {
        bf16x8 fa[2], fb[2], zb[5];
#pragma unroll
        for (int x = 0; x < 2; ++x) { fa[x] = pack8(PT[0][x], PT[1][x]); fb[x] = pack8(PN[0][x], PN[1][x]); }
#pragma unroll
        for (int n = 0; n < 5; ++n) zb[n] = pack8(Z[0][n], Z[1][n]);
        const bf16x8 a0 = lev == 0 ? r3c_neg(fa[0]) : fa[0], a1 = lev == 0 ? r3c_neg(fa[1]) : fa[1];
#pragma unroll
        for (int n = 0; n < 5; ++n) { Z[0][n] = MFMA(a0, zb[n], Z[0][n]); Z[1][n] = MFMA(a1, zb[n], Z[1][n]); }
        if (lev < 4) {
#pragma unroll
            for (int a = 0; a < 2; ++a)
#pragma unroll
                for (int b = 0; b < 2; ++b) { PN[a][b] = MFMA(fa[a], fb[b], z4); PT[a][b] = MFMA(fb[a], fa[b], z4); }
        }
    }
    bf16x8 oQT[4], oRR[4], oBG[4]; u32x2 oD0[4];
    { f32x4 ZT[4][2];
      const bf16x8 Ip0 = r3c_ident<true>(0, m, q), Ip1 = r3c_ident<true>(1, m, q);
#pragma unroll
      for (int a = 0; a < 4; ++a) { const bf16x8 zf = pack8(Z[0][a], Z[1][a]); ZT[a][0] = MFMA(zf, Ip0, z4); ZT[a][1] = MFMA(zf, Ip1, z4); }
#pragma unroll
      for (int mt = 0; mt < 2; ++mt)
#pragma unroll
          for (int ks = 0; ks < 2; ++ks) oQT[mt * 2 + ks] = pack8(ZT[2 * ks][mt], ZT[2 * ks + 1][mt]); }
#pragma unroll
    for (int mt = 0; mt < 2; ++mt)
#pragma unroll
        for (int ks = 0; ks < 2; ++ks) oRR[mt * 2 + ks] = r3c_permfrag(Rh + (16 * mt + m) * RC_P + ks * 64, q);
    { bf16x8 Kf[2][2], Bf[2][2], Inat[2]; Inat[0] = r3c_ident<false>(0, m, q); Inat[1] = r3c_ident<false>(1, m, q);
#pragma unroll
      for (int x = 0; x < 2; ++x)
#pragma unroll
          for (int ks = 0; ks < 2; ++ks) { const int off = (16 * x + m) * RC_P + (32 * ks + 8 * q) * 2; Kf[x][ks] = *(const bf16x8*)(Kh + off); Bf[x][ks] = *(const bf16x8*)(Bh + off); }
#pragma unroll
      for (int ct = 0; ct < 4; ++ct) { const float g = G31a[16 * ct + m];
          const f32x4 k0 = MFMA(Kf[0][ct >> 1], Inat[ct & 1], z4) * g, k1 = MFMA(Kf[1][ct >> 1], Inat[ct & 1], z4) * g;
          const f32x4 b0 = MFMA(Bf[0][ct >> 1], Inat[ct & 1], z4) * -g, b1 = MFMA(Bf[1][ct >> 1], Inat[ct & 1], z4) * -g;
          oBG[ct] = pack8(b0, b1);
          oD0[ct] = r3c_pk4(MFMA(pack8(k0, k1), vfrag, z4)); } }
    asm volatile("s_waitcnt lgkmcnt(0)" ::: "memory");
#pragma unroll
    for (int f = 0; f < 4; ++f) { *(bf16x8*)(lds + RC_QT + f * 1024 + lane * 16) = oQT[f]; *(bf16x8*)(lds + RC_RR + f * 1024 + lane * 16) = oRR[f]; *(bf16x8*)(lds + RC_BG + f * 1024 + lane * 16) = oBG[f];
        *(u32x2*)(lds + RC_D0 + f * 512 + lane * 8) = oD0[f]; }
#pragma unroll
    for (int f = 0; f < 2; ++f) { *(bf16x8*)(lds + RC_AB + f * 1024 + lane * 16) = oAB[f]; *(u32x2*)(lds + RC_U0 + f * 512 + lane * 8) = r3c_pk4(Z[f][4]); *(u32x2*)(lds + RC_Y0 + f * 512 + lane * 8) = oY0[f]; }
    R3C_FENCE();
}
DEV void r3c_walk(f32x4 (&S)[4], char* slot, int lane) {
    const int q = lane >> 4;
    bf16x8 QT[2][2], BG[4]; u32x2 D0[4], U0[2]; f32x4 Gv[4];
#pragma unroll
    for (int f = 0; f < 4; ++f) { QT[f >> 1][f & 1] = *(const bf16x8*)(slot + RC_QT + f * 1024 + lane * 16); BG[f] = *(const bf16x8*)(slot + RC_BG + f * 1024 + lane * 16);
        D0[f] = *(const u32x2*)(slot + RC_D0 + f * 512 + lane * 8); Gv[f] = *(const f32x4*)(slot + RC_G + (16 * f + 4 * q) * 4); }
#pragma unroll
    for (int f = 0; f < 2; ++f) U0[f] = *(const u32x2*)(slot + RC_U0 + f * 512 + lane * 8);
    const bf16x8 sB0 = pack8(S[0], S[1]), sB1 = pack8(S[2], S[3]);
    f32x4 U[2];
#pragma unroll
    for (int mt = 0; mt < 2; ++mt) { U[mt] = r3c_up4(U0[mt]); U[mt] = MFMA(QT[mt][0], sB0, U[mt]); U[mt] = MFMA(QT[mt][1], sB1, U[mt]); }
    const bf16x8 uB = pack8(U[0], U[1]);
#pragma unroll
    for (int ct = 0; ct < 4; ++ct) { S[ct] = S[ct] * Gv[ct] + r3c_up4(D0[ct]); S[ct] = MFMA(BG[ct], uB, S[ct]); }
    R3C_FENCE();
    *(bf16x8*)(slot + RC_QT + lane * 16) = sB0; *(bf16x8*)(slot + RC_QT + 1024 + lane * 16) = sB1; *(bf16x8*)(slot + RC_QT + 2048 + lane * 16) = uB;
    R3C_FENCE();
}
DEV void r3c_yout(const char* slot, bf16_t* yout, int lane) {
    const int m = lane & 15, q = lane >> 4;
    const bf16x8 sB0 = *(const bf16x8*)(slot + RC_QT + lane * 16), sB1 = *(const bf16x8*)(slot + RC_QT + 1024 + lane * 16), uB = *(const bf16x8*)(slot + RC_QT + 2048 + lane * 16);
#pragma unroll
    for (int mt = 0; mt < 2; ++mt) {
        f32x4 Y = r3c_up4(*(const u32x2*)(slot + RC_Y0 + mt * 512 + lane * 8));
        Y = MFMA(*(const bf16x8*)(slot + RC_RR + (mt * 2) * 1024 + lane * 16), sB0, Y); Y = MFMA(*(const bf16x8*)(slot + RC_RR + (mt * 2 + 1) * 1024 + lane * 16), sB1, Y);
        Y = MFMA(*(const bf16x8*)(slot + RC_AB + mt * 1024 + lane * 16), uB, Y);
#pragma unroll
        for (int r = 0; r < 4; ++r) *(bf16_t*)((char*)yout + (unsigned)(((16 * mt + 4 * q + r) * DM + m) * 2)) = f2bf(Y[r]); }
    R3C_FENCE();
}
DEV void phase_r3c(const bf16_t* rb, const bf16_t* wb, const bf16_t* kb, const bf16_t* kkb, const bf16_t* kab, const bf16_t* vb, bf16_t* yb, char* smem) {
    const int tid = tidx(), lane = tid & 63, wid = __builtin_amdgcn_readfirstlane(tid >> 6);
    constexpr int NCH = SEQ / 32, NR = NCH / RC_NP;
    for (int task = blockIdx.x; task < 256; task += gridDim.x) {
        const int xc = task & 7, ix = task >> 3, bh = xc * 8 + (ix >> 2), b = bh >> 4, h = bh & 15, rq = ix & 3;
        const size_t base = (size_t)b * SEQ * DM + h * 64;
        f32x4 S[4];
#pragma unroll
        for (int ct = 0; ct < 4; ++ct) S[ct] = (f32x4){0.f, 0.f, 0.f, 0.f};
        R3Raw W; { const size_t ub = base + (size_t)(wid * 32) * DM; r3c_load(W, rb + ub, wb + ub, kkb + ub, vb + ub, rq * 16, lane); }
        for (int rd = 0; rd < NR; ++rd) {
            const size_t ub = base + (size_t)((rd * RC_NP + wid) * 32) * DM;
            r3c_produce(W, kb + ub, kab + ub, smem + wid * RC_LDS, tidx() & 63);
            if (rd + 1 < NR) { const size_t un = ub + (size_t)(RC_NP * 32) * DM; r3c_load(W, rb + un, wb + un, kkb + un, vb + un, rq * 16, tidx() & 63); }
            asm volatile("s_waitcnt lgkmcnt(0)" ::: "memory");
            __syncthreads();
            if (wid == 0) {
#pragma unroll 1
                for (int p = 0; p < RC_NP; ++p) r3c_walk(S, smem + p * RC_LDS, tidx() & 63);
                asm volatile("s_waitcnt lgkmcnt(0)" ::: "memory");
            }
            __syncthreads();
            r3c_yout(smem + wid * RC_LDS, yb + ub + rq * 16, tidx() & 63);
        }
    }
}
DEV void phase_r4(const bf16_t* hid, const bf16_t* G2T, const RwkvW& W, const bf16_t* yb, const bf16_t* vb, const float* bsc, bf16_t* outb, char* smem) {
    const LaneId L = lane_id();
    const int ntn = 8, nunits = (T / 256) * ntn;
    for (int u = blockIdx.x; u < nunits; u += gridDim.x) {
        const int tm = u / ntn, tn = u % ntn;
        f32x4 acc[4][4];
        gemm_core(acc, LdPlain{hid + (size_t)tm * 256 * HIDP + 128, HIDP}, LdPlain{G2T + (size_t)tn * 128 * 128, 128}, 128, smem);
        const int head = tn * 2 + L.wn;
#pragma unroll
        for (int m = 0; m < 4; ++m) {
            const size_t row = (size_t)tm * 256 + L.wm * 64 + m * 16 + L.fr;
            f32x4 yv[4]; float s = 0.f;
#pragma unroll
            for (int n = 0; n < 4; ++n) { yv[n] = ld_bf4(yb + row * DM + head * 64 + n * 16 + L.fq * 4); s += (yv[n][0] + yv[n][1]) + (yv[n][2] + yv[n][3]); }
            s += __shfl_xor(s, 16); s += __shfl_xor(s, 32);
            const float mean = s * (1.0f / 64.0f); float q = 0.f;
#pragma unroll
            for (int n = 0; n < 4; ++n) { const f32x4 d = yv[n] - mean; q += (d[0] * d[0] + d[1] * d[1]) + (d[2] * d[2] + d[3] * d[3]); }
            q += __shfl_xor(q, 16); q += __shfl_xor(q, 32);
            const float rstd = rsqrtf(q * (1.0f / 64.0f) + 64e-5f);
            const float bs = bsc[row * 16 + head];
#pragma unroll
            for (int n = 0; n < 4; ++n) { const int col = head * 64 + n * 16 + L.fq * 4;
                const f32x4 lw = *(const f32x4*)(W.ln_w + col), lb = *(const f32x4*)(W.ln_b + col), vv = ld_bf4(vb + row * DM + col);
                f32x4 o = ((yv[n] - mean) * rstd * lw + lb + vv * bs);
                o = o * acc[m][n];
                st_bf4(outb + row * DM + col, o); }
        }
    }
}

struct NsaBuf { bf16_t *q, *kcmp, *vcmp, *kslc, *kwin, *vslcT, *vwinT, *hid, *kc, *vcT, *o; float* gates; };
DEV void phase_n1(const bf16_t* xn, const bf16_t* Bt, const NsaBuf& B, char* smem) {
    const LaneId L = lane_id();
    const int ntn = 15, nunits = (T / 256) * ntn;
    for (int u = blockIdx.x; u < nunits; u += gridDim.x) {
        const int tm = u / ntn, tn = u % ntn;
        f32x4 acc[4][4];
        gemm_core(acc, LdPlain{xn + (size_t)tm * 256 * DM, DM}, LdPlain{Bt + (size_t)tn * 128 * DM, DM}, DM, smem);
#pragma unroll
        for (int m = 0; m < 4; ++m)
#pragma unroll
            for (int n = 0; n < 4; ++n) {
                const size_t row = (size_t)tm * 256 + L.wm * 64 + m * 16 + L.fr; const int c = L.wn * 64 + n * 16 + L.fq * 4; f32x4 v = acc[m][n];
                if (tn < 8) st_bf4(B.q + row * DM + tn * 128 + c, v * 0.125f);
                else if (tn < 14) {
                    const int cc = tn - 8;
                    if (cc == 0) st_bf4(B.kcmp + row * 128 + c, v);
                    else if (cc == 1) st_bf4(B.vcmp + row * 128 + c, v);
                    else if (cc == 2) st_bf4(B.kslc + row * 128 + c, v);
                    else if (cc == 4) st_bf4(B.kwin + row * 128 + c, v);
                    else { bf16_t* dst = cc == 3 ? B.vslcT : B.vwinT; const int b = (int)(row >> 13), t = (int)(row & (SEQ - 1));
                        for (int j = 0; j < 4; ++j) dst[((size_t)(b * 128 + c + j)) * SEQ + t] = f2bf(v[j]); }
                } else { if (c < 48) { for (int j = 0; j < 4; ++j) B.gates[row * 48 + c + j] = sigmoidf_(v[j]); } }
            }
    }
}
DEV float gelu_tanh(float x) { const float u = 0.7978845608028654f * (x + 0.044715f * x * x * x); return 0.5f * x * (1.0f + tanhf(u)); }
DEV void phase_n2a(const bf16_t* W1T, const float* biasp, const NsaBuf& B, char* smem) {
    const LaneId L = lane_id();
    for (int u = blockIdx.x; u < 64; u += gridDim.x) {
        const int c = u >> 5, tm = (u >> 1) & 15, tn = u & 1;
        f32x4 acc[4][4];
        gemm_core(acc, LdCmp{c ? B.vcmp : B.kcmp, tm * 256}, LdPlain{W1T + (size_t)c * 256 * 2048 + (size_t)tn * 128 * 2048, 2048}, 2048, smem);
#pragma unroll
        for (int m = 0; m < 4; ++m)
#pragma unroll
            for (int n = 0; n < 4; ++n) { const size_t row = (size_t)tm * 256 + L.wm * 64 + m * 16 + L.fr; const int col = tn * 128 + L.wn * 64 + n * 16 + L.fq * 4;
                const f32x4 bb = *(const f32x4*)(biasp + c * 256 + col); f32x4 v;
                for (int j = 0; j < 4; ++j) v[j] = gelu_tanh(acc[m][n][j] + bb[j]);
                st_bf4(B.hid + ((size_t)c * 4096 + row) * 256 + col, v); }
    }
}
DEV void phase_n2b(const bf16_t* W2T, const NsaBuf& B, char* smem) {
    const LaneId L = lane_id();
    for (int u = blockIdx.x; u < 32; u += gridDim.x) {
        const int c = u >> 4, tm = u & 15;
        f32x4 acc[4][4];
        gemm_core(acc, LdPlain{B.hid + ((size_t)c * 4096 + tm * 256) * 256, 256}, LdPlain{W2T + (size_t)c * 128 * 256, 256}, 256, smem);
        if (L.wn == 0) {
#pragma unroll
            for (int m = 0; m < 4; ++m)
#pragma unroll
                for (int n = 0; n < 4; ++n) { const int row = tm * 256 + L.wm * 64 + m * 16 + L.fr, d = n * 16 + L.fq * 4;
                    const int b = row >> 10, nn = (row >> 1) & 511, g = row & 1;
                    if (c == 0) st_bf4(B.kc + ((size_t)((b * 2 + g) * 512 + nn)) * 64 + d, acc[m][n]);
                    else { for (int j = 0; j < 4; ++j) B.vcT[((size_t)((b * 2 + g) * 64 + d + j)) * 512 + nn] = f2bf(acc[m][n][j]); } }
        }
    }
}
#define NEGV (-1e30f)
#define LOG2E_ 1.4426950408889634f
DEV u32x4 n3_ldg(const bf16_t* kbase, long kpitch, const bf16_t* vbase, long vpitch, int kb, int tid) {
    if (tid < 256) return *(const u32x4*)(kbase + (size_t)(kb + (tid >> 3)) * kpitch + (tid & 7) * 8);
    const int i = tid - 256; return *(const u32x4*)(vbase + (size_t)(i >> 2) * vpitch + kb + (i & 3) * 8);
}
DEV void n3_sts(char* buf, u32x4 v, int tid) {
    if (tid < 256) { const int row = tid >> 3, c = tid & 7, sw = ((row >> 1) & 1) | (((row >> 3) & 3) << 1); *(u32x4*)(buf + row * 128 + ((c ^ sw) << 4)) = v; }
    else { const int i = tid - 256, d = i >> 2, c = i & 3; *(u32x4*)(buf + 4096 + d * 64 + ((c ^ ((d >> 2) & 3)) << 4)) = v; }
}
DEV void phase_n3(const NsaBuf& B, char* smem) {
    const int tid = tidx(), lane = tid & 63, wid = tid >> 6, m = lane & 15, fq = lane >> 4, qh = m >> 3, hh = m & 7;
    float* psum = (float*)(smem + wid * 8704); int* ulist = (int*)(smem + wid * 8704 + 8192);
    char* stg = smem + 8 * 8704;
    const int kperm = 8 * (m >> 2) + (m & 3);
    const int kswz = ((m >> 1) & 1) | ((m >> 2) << 1), vswz = (m >> 2) & 3;
    const int koffA = kperm * 128, koffB = (kperm + 4) * 128, voff = 4096 + m * 64 + ((fq ^ vswz) << 4);
    const f32x4 z4 = {0.f, 0.f, 0.f, 0.f};
    const int nrank = (int)gridDim.x >> 3, bg = (int)blockIdx.x & 7;
    for (int qblk = (int)blockIdx.x >> 3; qblk < 256 && (int)blockIdx.x < nrank * 8; qblk += nrank) {
        const int g = bg & 1, b = bg >> 1, t0b = qblk * 32, t0 = t0b + wid * 4;
        int tq[2]; bf16x8 qf[2][2]; float gc[2], gs[2], gw[2]; u32x2 opk[2][4];
#pragma unroll
        for (int rb = 0; rb < 2; ++rb) {
            tq[rb] = t0 + rb * 2 + qh;
            const bf16_t* qp = B.q + ((size_t)(b * SEQ + tq[rb])) * DM + (g * 8 + hh) * 64 + fq * 8;
            qf[rb][0] = __builtin_nontemporal_load((const bf16x8*)qp); qf[rb][1] = __builtin_nontemporal_load((const bf16x8*)(qp + 32));
            const float* gp = B.gates + ((size_t)(b * SEQ + tq[rb])) * 48 + g * 24 + hh * 3;
            gc[rb] = gp[0]; gs[rb] = gp[1]; gw[rb] = gp[2];
        }
#define N3_KFRAGS(buf) const bf16x8 kA0 = *(const bf16x8*)((buf) + koffA + (((0 + fq) ^ kswz) << 4)), kA1 = *(const bf16x8*)((buf) + koffA + (((4 + fq) ^ kswz) << 4)), \
                                    kB0 = *(const bf16x8*)((buf) + koffB + (((0 + fq) ^ kswz) << 4)), kB1 = *(const bf16x8*)((buf) + koffB + (((4 + fq) ^ kswz) << 4));
        {
            const int tid = tidx(), lane = tid & 63, m = lane & 15, fq = (lane >> 4), qh = m >> 3, hh = m & 7, kperm = 8 * (m >> 2) + (m & 3); (void)hh; (void)qh; (void)lane;
            const int kswz = ((m >> 1) & 1) | ((m >> 2) << 1), vswz = (m >> 2) & 3, koffA = kperm * 128, koffB = (kperm + 4) * 128, voff = 4096 + m * 64 + ((fq ^ vswz) << 4);
            int nv[2];
#pragma unroll
            for (int rb = 0; rb < 2; ++rb) nv[rb] = tq[rb] >= 31 ? ((tq[rb] - 31) >> 4) + 1 : 0;
            const int nvmax = (t0b + 31 >= 31) ? ((t0b + 31 - 31) >> 4) + 1 : 0, ngrp = (nvmax + 31) >> 5;
#pragma unroll
            for (int i = 0; i < 32; ++i) psum[lane + 64 * i] = 0.f;
            const bf16_t* kcb = B.kc + (size_t)((b * 2 + g) * 512) * 64; const bf16_t* vcb = B.vcT + (size_t)((b * 2 + g) * 64) * 512;
            float mx[2] = {NEGV, NEGV}, l[2] = {0.f, 0.f};
            u32x4 stv;
            if (ngrp > 0) { stv = n3_ldg(kcb, 64, vcb, 512, 0, tid); n3_sts(stg, stv, tid); }
            __syncthreads();
            for (int grp = 0; grp < ngrp; ++grp) {
                const int kb = grp * 32; const bool more = grp + 1 < ngrp;
                if (more) stv = n3_ldg(kcb, 64, vcb, 512, kb + 32, tid);
                const char* buf = stg + (grp & 1) * 8192;
                N3_KFRAGS(buf)
#pragma unroll
                for (int rb = 0; rb < 2; ++rb) {
                    f32x4 sA = MFMA(kA0, qf[rb][0], z4); sA = MFMA(kA1, qf[rb][1], sA);
                    f32x4 sB = MFMA(kB0, qf[rb][0], z4); sB = MFMA(kB1, qf[rb][1], sB);
                    const bool full = kb + 32 <= nv[rb], part = !full && kb < nv[rb];
                    if (__ballot(part) == 0ull) {
                        const float m8 = fmaxf(fmaxf(fmaxf(sA[0], sA[1]), fmaxf(sA[2], sA[3])), fmaxf(fmaxf(sB[0], sB[1]), fmaxf(sB[2], sB[3])));
                        const float mn = fmaxf(mx[rb], full ? m8 : NEGV), tl = (full ? mn : 1e30f) * LOG2E_; float add = 0.f;
#pragma unroll
                        for (int j = 0; j < 4; ++j) add += __builtin_amdgcn_exp2f(fmaf(sA[j], LOG2E_, -tl)) + __builtin_amdgcn_exp2f(fmaf(sB[j], LOG2E_, -tl));
                        l[rb] = l[rb] * __expf(mx[rb] - mn) + add; mx[rb] = mn;
                    } else {
                    float gm = NEGV;
#pragma unroll
                    for (int j = 0; j < 4; ++j) { if (kb + 8 * fq + j < nv[rb]) gm = fmaxf(gm, sA[j]); if (kb + 8 * fq + 4 + j < nv[rb]) gm = fmaxf(gm, sB[j]); }
                    const float mn = fmaxf(mx[rb], gm); float add = 0.f;
#pragma unroll
                    for (int j = 0; j < 4; ++j) { if (kb + 8 * fq + j < nv[rb]) add += __expf(sA[j] - mn); if (kb + 8 * fq + 4 + j < nv[rb]) add += __expf(sB[j] - mn); }
                    l[rb] = l[rb] * __expf(mx[rb] - mn) + add; mx[rb] = mn;
                    }
                }
                if (more) n3_sts(stg + ((grp + 1) & 1) * 8192, stv, tid);
                __syncthreads();
            }
            float M[2], inv[2];
#pragma unroll
            for (int rb = 0; rb < 2; ++rb) {
                float Mx = fmaxf(mx[rb], __shfl_xor(mx[rb], 16)); Mx = fmaxf(Mx, __shfl_xor(Mx, 32));
                float ll = l[rb] * __expf(mx[rb] - Mx); ll += __shfl_xor(ll, 16); ll += __shfl_xor(ll, 32);
                M[rb] = Mx; inv[rb] = ll > 0.f ? 1.0f / ll : 0.f;
            }
            f32x4 oc[2][4];
#pragma unroll
            for (int rb = 0; rb < 2; ++rb)
#pragma unroll
                for (int d = 0; d < 4; ++d) oc[rb][d] = z4;
            if (ngrp > 0) { stv = n3_ldg(kcb, 64, vcb, 512, 0, tid); n3_sts(stg, stv, tid); }
            __syncthreads();
            for (int grp = 0; grp < ngrp; ++grp) {
                const int kb = grp * 32; const bool more = grp + 1 < ngrp;
                if (more) stv = n3_ldg(kcb, 64, vcb, 512, kb + 32, tid);
                const char* buf = stg + (grp & 1) * 8192;
                N3_KFRAGS(buf)
                bf16x8 vf[4];
#pragma unroll
                for (int d = 0; d < 4; ++d) vf[d] = *(const bf16x8*)(buf + voff + d * 1024);
#pragma unroll
                for (int rb = 0; rb < 2; ++rb) {
                    f32x4 sA = MFMA(kA0, qf[rb][0], z4); sA = MFMA(kA1, qf[rb][1], sA);
                    f32x4 sB = MFMA(kB0, qf[rb][0], z4); sB = MFMA(kB1, qf[rb][1], sB);
                    f32x4 pA, pB;
                    const bool full = kb + 32 <= nv[rb], part = !full && kb < nv[rb];
                    if (__ballot(part) == 0ull) {
                        const float tl = (full ? M[rb] : 1e30f) * LOG2E_;
#pragma unroll
                        for (int j = 0; j < 4; ++j) { pA[j] = __builtin_amdgcn_exp2f(fmaf(sA[j], LOG2E_, -tl)) * inv[rb]; pB[j] = __builtin_amdgcn_exp2f(fmaf(sB[j], LOG2E_, -tl)) * inv[rb]; }
                    } else {
#pragma unroll
                    for (int j = 0; j < 4; ++j) { pA[j] = (kb + 8 * fq + j < nv[rb]) ? __expf(sA[j] - M[rb]) * inv[rb] : 0.f; pB[j] = (kb + 8 * fq + 4 + j < nv[rb]) ? __expf(sB[j] - M[rb]) * inv[rb] : 0.f; }
                    }
#pragma unroll
                    for (int j = 0; j < 4; ++j) {
                        float a = pA[j]; a += DPP_MOV(a, 0xB1); a += DPP_MOV(a, 0x4E); a += DPP_MOV(a, 0x141);
                        float c = pB[j]; c += DPP_MOV(c, 0xB1); c += DPP_MOV(c, 0x4E); c += DPP_MOV(c, 0x141);
                        if (hh == 0) { psum[(rb * 2 + qh) * 512 + kb + 8 * fq + j] = a; psum[(rb * 2 + qh) * 512 + kb + 8 * fq + 4 + j] = c; }
                    }
                    const bf16x8 pf = pack8(pA, pB);
#pragma unroll
                    for (int d = 0; d < 4; ++d) oc[rb][d] = MFMA(vf[d], pf, oc[rb][d]);
                }
                if (more) n3_sts(stg + ((grp + 1) & 1) * 8192, stv, tid);
                __syncthreads();
            }
#pragma unroll
            for (int rb = 0; rb < 2; ++rb)
#pragma unroll
                for (int d = 0; d < 4; ++d) { const f32x4 v = oc[rb][d] * gc[rb]; opk[rb][d].x = cvt_pk(v[0], v[1]); opk[rb][d].y = cvt_pk(v[2], v[3]); }
        }
        asm volatile("s_waitcnt lgkmcnt(0)" ::: "memory");
        __builtin_amdgcn_sched_barrier(0);
        unsigned long long mlo[4], mhi[4];
#pragma unroll
        for (int q2 = 0; q2 < 4; ++q2) {
            const int tqq = t0 + q2, cur = tqq >> 6;
            float sc[2];
#pragma unroll
            for (int c = 0; c < 2; ++c) { const int j = lane + 64 * c; float imp = 0.f;
                for (int n = 4 * j - 1; n <= 4 * j + 3; ++n) if (n >= 0) imp += psum[q2 * 512 + n];
                const bool causal = j * 64 <= tqq, forced = (j == 0) || (j == cur) || (j == cur - 1);
                sc[c] = causal ? imp + (forced ? 1e4f : 0.f) : NEGV; }
            unsigned k0 = __float_as_uint(sc[0]), k1 = __float_as_uint(sc[1]);
            k0 = (k0 & 0x80000000u) ? ~k0 : (k0 | 0x80000000u); k1 = (k1 & 0x80000000u) ? ~k1 : (k1 | 0x80000000u);
            unsigned Tk = 0u;
            for (int bit = 31; bit >= 0; --bit) { const unsigned cand = Tk | (1u << bit);
                const int cnt = __popcll(__ballot(k0 >= cand)) + __popcll(__ballot(k1 >= cand)); if (cnt >= 16) Tk = cand; }
            const int ngt = __popcll(__ballot(k0 > Tk)) + __popcll(__ballot(k1 > Tk)), needn = 16 - ngt;
            const unsigned long long eq0 = __ballot(k0 == Tk), eq1 = __ballot(k1 == Tk), belowm = (1ull << lane) - 1ull;
            const bool s0 = (k0 > Tk) || (k0 == Tk && __popcll(eq0 & belowm) < needn);
            const bool s1 = (k1 > Tk) || (k1 == Tk && __popcll(eq0) + __popcll(eq1 & belowm) < needn);
            mlo[q2] = __ballot(s0); mhi[q2] = __ballot(s1);
        }
        int nun;
        {
            const unsigned long long ulo = mlo[0] | mlo[1] | mlo[2] | mlo[3], uhi = mhi[0] | mhi[1] | mhi[2] | mhi[3];
            const unsigned long long below = (1ull << lane) - 1ull; const int nlo = __popcll(ulo);
            if ((ulo >> lane) & 1ull) { const int mb = (int)((mlo[0] >> lane) & 1ull) | ((int)((mlo[1] >> lane) & 1ull) << 1) | ((int)((mlo[2] >> lane) & 1ull) << 2) | ((int)((mlo[3] >> lane) & 1ull) << 3);
                ulist[__popcll(ulo & below)] = lane | (mb << 8); }
            if ((uhi >> lane) & 1ull) { const int mb = (int)((mhi[0] >> lane) & 1ull) | ((int)((mhi[1] >> lane) & 1ull) << 1) | ((int)((mhi[2] >> lane) & 1ull) << 2) | ((int)((mhi[3] >> lane) & 1ull) << 3);
                ulist[nlo + __popcll(uhi & below)] = (lane + 64) | (mb << 8); }
            nun = nlo + __popcll(uhi);
        }
        asm volatile("s_waitcnt lgkmcnt(0)" ::: "memory");
        __builtin_amdgcn_sched_barrier(0);
        {
            const int tid = tidx(), lane = tid & 63, m = lane & 15, fq = (lane >> 4), qh = m >> 3, hh = m & 7, kperm = 8 * (m >> 2) + (m & 3); (void)hh; (void)qh; (void)lane;
            const unsigned char* ksb = (const unsigned char*)B.kslc + (size_t)((b * 2 + g) * SEQ) * 64 + fq * 8; const unsigned char* vsb = (const unsigned char*)B.vslcT + (size_t)((b * 2 + g) * 128) * 4096 + m * 64 + 8 * fq;
            long q8[2][2];
#pragma unroll
            for (int rb = 0; rb < 2; ++rb)
#pragma unroll
                for (int ks = 0; ks < 2; ++ks) { const u32x4 w = __builtin_bit_cast(u32x4, qf[rb][ks]);
                    const unsigned lo = pack_fp8x4(bf_lo(w.x), bf_hi(w.x), bf_lo(w.y), bf_hi(w.y)), hi = pack_fp8x4(bf_lo(w.z), bf_hi(w.z), bf_lo(w.w), bf_hi(w.w));
                    q8[rb][ks] = (long)(((unsigned long long)hi << 32) | lo); }
            float mx[2] = {NEGV, NEGV}, l[2] = {0.f, 0.f}; f32x4 os[2][4];
#pragma unroll
            for (int rb = 0; rb < 2; ++rb)
#pragma unroll
                for (int d = 0; d < 4; ++d) os[rb][d] = z4;
            char* st8 = (char*)psum;
            const int srow = lane >> 2, sc0 = (lane & 3) * 2;
            u32x4 gk[4], gv[4];
            { const int blk0 = ulist[0] & 255; const unsigned char* kp = (const unsigned char*)B.kslc + ((size_t)((b * 2 + g) * SEQ) + blk0 * 64) * 64 + lane * 16; const unsigned char* vp = (const unsigned char*)B.vslcT + ((size_t)((b * 2 + g) * 128) + blk0) * 4096 + lane * 16;
#pragma unroll
              for (int i = 0; i < 4; ++i) { gk[i] = *(const u32x4*)(kp + i * 1024); gv[i] = *(const u32x4*)(vp + i * 1024); } }
            const int fsw = (m >> 2) << 1;
            for (int ib = 0; ib < nun; ++ib) {
                const int e = __builtin_amdgcn_readfirstlane(ulist[ib]);
#pragma unroll
                for (int i = 0; i < 4; ++i) { const int row = i * 16 + srow;
                    *(u32x4*)(st8 + row * 64 + ((sc0 ^ (((row >> 3) & 3) << 1)) << 3)) = gk[i];
                    *(u32x4*)(st8 + 4096 + row * 64 + ((sc0 ^ (((row >> 2) & 3) << 1)) << 3)) = gv[i]; }
                if (ib + 1 < nun) { const int blkn = ulist[ib + 1] & 255; const unsigned char* kp = (const unsigned char*)B.kslc + ((size_t)((b * 2 + g) * SEQ) + blkn * 64) * 64 + lane * 16; const unsigned char* vp = (const unsigned char*)B.vslcT + ((size_t)((b * 2 + g) * 128) + blkn) * 4096 + lane * 16;
#pragma unroll
                    for (int i = 0; i < 4; ++i) { gk[i] = *(const u32x4*)(kp + i * 1024); gv[i] = *(const u32x4*)(vp + i * 1024); } }
#pragma unroll
              for (int hf = 0; hf < 2; ++hf) {
                const int kb = (e & 255) * 64 + hf * 32;
                const char* kr = st8 + (hf * 32 + kperm) * 64;
                const long kA0 = *(const long*)(kr + ((fq ^ fsw) << 3)), kA1 = *(const long*)(kr + (((4 + fq) ^ fsw) << 3)), kB0 = *(const long*)(kr + 256 + ((fq ^ fsw) << 3)), kB1 = *(const long*)(kr + 256 + (((4 + fq) ^ fsw) << 3));
                long vf[4];
#pragma unroll
                for (int d = 0; d < 4; ++d) vf[d] = *(const long*)(st8 + 4096 + (d * 16 + m) * 64 + (((hf * 4 + fq) ^ fsw) << 3));
#pragma unroll
                for (int rb = 0; rb < 2; ++rb) {
                    if (((e >> (8 + rb * 2)) & 3) == 0) continue;
                    const bool mine = ((e >> (8 + rb * 2 + qh)) & 1) != 0;
                    f32x4 sA = MFMA8(kA0, q8[rb][0], z4); sA = MFMA8(kA1, q8[rb][1], sA);
                    f32x4 sB = MFMA8(kB0, q8[rb][0], z4); sB = MFMA8(kB1, q8[rb][1], sB);
                    const bool full = mine && kb + 31 <= tq[rb], part = mine && !full && kb <= tq[rb];
                    const bool fast = __ballot(part) == 0ull;
                    float gm = NEGV;
                    if (fast) { const float m8 = fmaxf(fmaxf(fmaxf(sA[0], sA[1]), fmaxf(sA[2], sA[3])), fmaxf(fmaxf(sB[0], sB[1]), fmaxf(sB[2], sB[3]))); gm = full ? m8 : NEGV; }
                    else {
#pragma unroll
                    for (int j = 0; j < 4; ++j) { if (mine && kb + 8 * fq + j <= tq[rb]) gm = fmaxf(gm, sA[j]); if (mine && kb + 8 * fq + 4 + j <= tq[rb]) gm = fmaxf(gm, sB[j]); }
                    }
                    if (__ballot(gm > mx[rb]) != 0ull) {
                        gm = fmaxf(gm, __shfl_xor(gm, 16)); gm = fmaxf(gm, __shfl_xor(gm, 32));
                        const float mn2 = fmaxf(mx[rb], gm), alpha = __expf(mx[rb] - mn2); mx[rb] = mn2; l[rb] *= alpha;
#pragma unroll
                        for (int d = 0; d < 4; ++d) os[rb][d] *= alpha;
                    }
                    const float mn = mx[rb];
                    f32x4 pA, pB; float add = 0.f;
                    if (fast) { const float tl = (full ? mn : 1e30f) * LOG2E_ - 7.f;
#pragma unroll
                        for (int j = 0; j < 4; ++j) { pA[j] = __builtin_amdgcn_exp2f(fmaf(sA[j], LOG2E_, -tl)); pB[j] = __builtin_amdgcn_exp2f(fmaf(sB[j], LOG2E_, -tl)); add += pA[j] + pB[j]; }
                    } else {
#pragma unroll
                    for (int j = 0; j < 4; ++j) { pA[j] = (mine && kb + 8 * fq + j <= tq[rb]) ? __expf(sA[j] - mn + 4.8520302639f) : 0.f; pB[j] = (mine && kb + 8 * fq + 4 + j <= tq[rb]) ? __expf(sB[j] - mn + 4.8520302639f) : 0.f; add += pA[j] + pB[j]; }
                    }
                    l[rb] += add;
                    const unsigned plo = pack_fp8x4(pA[0], pA[1], pA[2], pA[3]), phi = pack_fp8x4(pB[0], pB[1], pB[2], pB[3]);
                    const long pf = (long)(((unsigned long long)phi << 32) | plo);
#pragma unroll
                    for (int d = 0; d < 4; ++d) os[rb][d] = MFMA8(vf[d], pf, os[rb][d]);
                }
              }
            }
#pragma unroll
            for (int rb = 0; rb < 2; ++rb) {
                float ll = l[rb]; ll += __shfl_xor(ll, 16); ll += __shfl_xor(ll, 32);
                const float sc = ll > 0.f ? gs[rb] / ll : 0.f;
#pragma unroll
                for (int d = 0; d < 4; ++d) { f32x4 v = os[rb][d] * sc; v[0] += bf_lo(opk[rb][d].x); v[1] += bf_hi(opk[rb][d].x); v[2] += bf_lo(opk[rb][d].y); v[3] += bf_hi(opk[rb][d].y);
                    opk[rb][d].x = cvt_pk(v[0], v[1]); opk[rb][d].y = cvt_pk(v[2], v[3]); }
            }
        }
        __builtin_amdgcn_sched_barrier(0);
        {
            const int tid = tidx(), lane = tid & 63, m = lane & 15, fq = (lane >> 4), qh = m >> 3, hh = m & 7, kperm = 8 * (m >> 2) + (m & 3); (void)hh; (void)qh; (void)lane;
            const int kswz = ((m >> 1) & 1) | ((m >> 2) << 1), vswz = (m >> 2) & 3, koffA = kperm * 128, koffB = (kperm + 4) * 128, voff = 4096 + m * 64 + ((fq ^ vswz) << 4);
            const bf16_t* kwb = B.kwin + (size_t)b * SEQ * 128 + g * 64; const bf16_t* vwb = B.vwinT + (size_t)((b * 2 + g) * 64) * SEQ;
            float mx[2] = {NEGV, NEGV}, l[2] = {0.f, 0.f}; f32x4 ow[2][4];
#pragma unroll
            for (int rb = 0; rb < 2; ++rb)
#pragma unroll
                for (int d = 0; d < 4; ++d) ow[rb][d] = z4;
            const int lo = t0b - 511 > 0 ? t0b - 511 : 0, kb0 = lo & ~31, kbl = t0b + 31;
            u32x4 stv = n3_ldg(kwb, 128, vwb, SEQ, kb0, tid); n3_sts(stg, stv, tid);
            __syncthreads();
            int gi = 0;
            for (int kb = kb0; kb <= kbl; kb += 32, ++gi) {
                const bool more = kb + 32 <= kbl;
                if (more) stv = n3_ldg(kwb, 128, vwb, SEQ, kb + 32, tid);
                const char* buf = stg + (gi & 1) * 8192;
                if (kb <= t0 + 3 && kb + 31 > t0 - 512) {
                    N3_KFRAGS(buf)
                    bf16x8 vf[4];
#pragma unroll
                    for (int d = 0; d < 4; ++d) vf[d] = *(const bf16x8*)(buf + voff + d * 1024);
#pragma unroll
                    for (int rb = 0; rb < 2; ++rb) {
                        f32x4 sA = MFMA(kA0, qf[rb][0], z4); sA = MFMA(kA1, qf[rb][1], sA);
                        f32x4 sB = MFMA(kB0, qf[rb][0], z4); sB = MFMA(kB1, qf[rb][1], sB);
                        const bool full = kb + 31 <= tq[rb] && kb > tq[rb] - 512, part = !full && kb <= tq[rb] && kb + 31 > tq[rb] - 512;
                        const bool fast = __ballot(part) == 0ull;
                        float gm = NEGV;
                        if (fast) { const float m8 = fmaxf(fmaxf(fmaxf(sA[0], sA[1]), fmaxf(sA[2], sA[3])), fmaxf(fmaxf(sB[0], sB[1]), fmaxf(sB[2], sB[3]))); gm = full ? m8 : NEGV; }
                        else {
#pragma unroll
                        for (int j = 0; j < 4; ++j) { const int pa = kb + 8 * fq + j, pb = pa + 4; if (pa <= tq[rb] && pa > tq[rb] - 512) gm = fmaxf(gm, sA[j]); if (pb <= tq[rb] && pb > tq[rb] - 512) gm = fmaxf(gm, sB[j]); }
                        }
                        if (__ballot(gm > mx[rb] + 40.f) != 0ull) {
                            gm = fmaxf(gm, __shfl_xor(gm, 16)); gm = fmaxf(gm, __shfl_xor(gm, 32));
                            const float mn2 = fmaxf(mx[rb], gm), alpha = __expf(mx[rb] - mn2); mx[rb] = mn2; l[rb] *= alpha;
#pragma unroll
                            for (int d = 0; d < 4; ++d) ow[rb][d] *= alpha;
                        }
                        const float mn = mx[rb];
                        f32x4 pA, pB; float add = 0.f;
                        if (fast) { const float tl = (full ? mn : 1e30f) * LOG2E_;
#pragma unroll
                            for (int j = 0; j < 4; ++j) { pA[j] = __builtin_amdgcn_exp2f(fmaf(sA[j], LOG2E_, -tl)); pB[j] = __builtin_amdgcn_exp2f(fmaf(sB[j], LOG2E_, -tl)); add += pA[j] + pB[j]; }
                        } else {
#pragma unroll
                        for (int j = 0; j < 4; ++j) { const int pa = kb + 8 * fq + j, pb = pa + 4; const bool va = pa <= tq[rb] && pa > tq[rb] - 512, vb = pb <= tq[rb] && pb > tq[rb] - 512;
                            pA[j] = va ? __expf(sA[j] - mn) : 0.f; pB[j] = vb ? __expf(sB[j] - mn) : 0.f; add += pA[j] + pB[j]; }
                        }
                        l[rb] += add;
                        const bf16x8 pf = pack8(pA, pB);
#pragma unroll
                        for (int d = 0; d < 4; ++d) ow[rb][d] = MFMA(vf[d], pf, ow[rb][d]);
                    }
                }
                if (more) n3_sts(stg + ((gi + 1) & 1) * 8192, stv, tid);
                __syncthreads();
            }
#pragma unroll
            for (int rb = 0; rb < 2; ++rb) {
                float ll = l[rb]; ll += __shfl_xor(ll, 16); ll += __shfl_xor(ll, 32);
                const float sc = ll > 0.f ? gw[rb] / ll : 0.f;
#pragma unroll
                for (int d = 0; d < 4; ++d) { f32x4 v = ow[rb][d] * sc; v[0] += bf_lo(opk[rb][d].x); v[1] += bf_hi(opk[rb][d].x); v[2] += bf_lo(opk[rb][d].y); v[3] += bf_hi(opk[rb][d].y);
                    opk[rb][d].x = cvt_pk(v[0], v[1]); opk[rb][d].y = cvt_pk(v[2], v[3]); }
            }
        }
#undef N3_KFRAGS
#pragma unroll
        for (int rb = 0; rb < 2; ++rb) {
            bf16_t* op = B.o + ((size_t)(b * SEQ + tq[rb])) * DM + (g * 8 + hh) * 64 + fq * 4;
#pragma unroll
            for (int d = 0; d < 4; ++d) __builtin_nontemporal_store(opk[rb][d], (u32x2*)(op + d * 16));
        }
    }
}

struct GlaBuf { bf16_t *qe, *ke, *vT, *r, *o, *kdT, *ab; float *adn, *dec; };
DEV void phase_l1(const bf16_t* xn, const bf16_t* Bt, const GlaBuf& B, char* smem) {
    const LaneId L = lane_id();
    const int ntn = 25, nunits = (T / 256) * ntn;
    for (int u = blockIdx.x; u < nunits; u += gridDim.x) {
        const int tm = u / ntn, tn = u % ntn;
        f32x4 acc[4][4];
        gemm_core(acc, LdPlain{xn + (size_t)tm * 256 * DM, DM}, LdPlain{Bt + (size_t)tn * 128 * DM, DM}, DM, smem);
#pragma unroll
        for (int m = 0; m < 4; ++m)
#pragma unroll
            for (int n = 0; n < 4; ++n) {
                const size_t row = (size_t)tm * 256 + L.wm * 64 + m * 16 + L.fr; const int c = L.wn * 64 + n * 16 + L.fq * 4; const f32x4 v = acc[m][n];
                if (tn < 4) st_bf4(B.qe + row * 512 + tn * 128 + c, v * 0.08838834764831845f);
                else if (tn < 8) st_bf4(B.ke + row * 512 + (tn - 4) * 128 + c, v);
                else if (tn < 16) { const int b = (int)(row >> 13), t = (int)(row & (SEQ - 1)), vc = (tn - 8) * 128 + c;
                    for (int j = 0; j < 4; ++j) B.vT[((size_t)(b * 1024 + vc + j)) * SEQ + t] = f2bf(v[j]); }
                else if (tn < 24) st_bf4(B.r + row * DM + (tn - 16) * 128 + c, v);
                else { if (c < 16) *(f32x4*)(B.adn + row * 16 + c) = v; }
            }
    }
}
DEV void phase_l2a(const float* a_up, const float* a_bias, const GlaBuf& B) {
    const int gt = blockIdx.x * NTHR + tidx(), nt = gridDim.x * NTHR;
    for (int idx = gt; idx < NBATCH * 128 * 512; idx += nt) {
        const int c = idx & 511, n = (idx >> 9) & 127, b = idx >> 16, h = c >> 7, d = c & 127;
        float au[16];
#pragma unroll
        for (int r = 0; r < 16; ++r) au[r] = a_up[r * 512 + c];
        const float ab = a_bias[c];
        const size_t row0 = (size_t)b * SEQ + n * 64;
        float blast = 0.f;
#pragma unroll 4
        for (int t = 0; t < 64; ++t) {
            const float* ad = B.adn + (row0 + t) * 16; float x = ab;
#pragma unroll
            for (int r4 = 0; r4 < 4; ++r4) { const f32x4 a = *(const f32x4*)(ad + r4 * 4); x += a[0] * au[r4 * 4] + a[1] * au[r4 * 4 + 1] + a[2] * au[r4 * 4 + 2] + a[3] * au[r4 * 4 + 3]; }
            blast += -(fmaxf(-x, 0.f) + log1pf(__expf(-fabsf(x)))) * (1.0f / 16.0f);
        }
        float bcum = 0.f;
        bf16_t* kd = B.kdT + (((size_t)(b * 128 + n) * 4 + h) * 128 + d) * 64;
#pragma unroll 1
        for (int t8 = 0; t8 < 8; ++t8) {
            float kdv[8];
#pragma unroll
            for (int tt = 0; tt < 8; ++tt) {
                const int t = t8 * 8 + tt;
                const float* ad = B.adn + (row0 + t) * 16; float x = ab;
#pragma unroll
                for (int r4 = 0; r4 < 4; ++r4) { const f32x4 a = *(const f32x4*)(ad + r4 * 4); x += a[0] * au[r4 * 4] + a[1] * au[r4 * 4 + 1] + a[2] * au[r4 * 4 + 2] + a[3] * au[r4 * 4 + 3]; }
                bcum += -(fmaxf(-x, 0.f) + log1pf(__expf(-fabsf(x)))) * (1.0f / 16.0f);
                const float q = bf2f(B.qe[(row0 + t) * 512 + c]), k = bf2f(B.ke[(row0 + t) * 512 + c]);
                B.qe[(row0 + t) * 512 + c] = f2bf(q * __expf(bcum)); B.ke[(row0 + t) * 512 + c] = f2bf(k * __expf(-bcum));
                kdv[tt] = k * __expf(blast - bcum);
            }
            u32x4 w; w.x = cvt_pk(kdv[0], kdv[1]); w.y = cvt_pk(kdv[2], kdv[3]); w.z = cvt_pk(kdv[4], kdv[5]); w.w = cvt_pk(kdv[6], kdv[7]);
            *(u32x4*)(kd + t8 * 8) = w;
        }
        B.dec[((size_t)(b * 128 + n) * 4 + h) * 128 + d] = __expf(blast);
    }
}
DEV void phase_l2b(const GlaBuf& B) {
    const int lane = tidx() & 63, wid = tidx() >> 6, m = lane & 15, fq = lane >> 4;
    const int kperm = 8 * (m >> 2) + (m & 3);
    const f32x4 z4 = {0.f, 0.f, 0.f, 0.f};
    for (int task = blockIdx.x * 8 + wid; task < NBATCH * 128 * 4 * 4; task += gridDim.x * 8) {
        const int mb = task & 3, h = (task >> 2) & 3, n = (task >> 4) & 127, b = task >> 11;
        const size_t row0 = (size_t)b * SEQ + n * 64; const int i = mb * 16 + m;
        bf16x8 qf[4];
#pragma unroll
        for (int ks = 0; ks < 4; ++ks) qf[ks] = *(const bf16x8*)(B.qe + (row0 + i) * 512 + h * 128 + ks * 32 + fq * 8);
        f32x4 oacc[16];
#pragma unroll
        for (int v = 0; v < 16; ++v) oacc[v] = z4;
        const int ngrp = (mb * 16 + 15) / 32 + 1;
        for (int grp = 0; grp < ngrp; ++grp) {
            const int kb = grp * 32; const bf16_t* ka = B.ke + (row0 + kb + kperm) * 512 + h * 128 + fq * 8;
            f32x4 sA = z4, sB = z4;
#pragma unroll
            for (int ks = 0; ks < 4; ++ks) { sA = MFMA(*(const bf16x8*)(ka + ks * 32), qf[ks], sA); sB = MFMA(*(const bf16x8*)(ka + 4 * 512 + ks * 32), qf[ks], sB); }
#pragma unroll
            for (int j = 0; j < 4; ++j) { if (kb + 8 * fq + j > i) sA[j] = 0.f; if (kb + 8 * fq + 4 + j > i) sB[j] = 0.f; }
            const bf16x8 pf = pack8(sA, sB);
#pragma unroll
            for (int v = 0; v < 16; ++v) oacc[v] = MFMA(*(const bf16x8*)(B.vT + ((size_t)(b * 1024 + h * 256 + v * 16 + m)) * SEQ + n * 64 + kb + 8 * fq), pf, oacc[v]);
        }
#pragma unroll
        for (int v = 0; v < 16; ++v) st_bf4(B.o + (row0 + i) * DM + h * 256 + v * 16 + fq * 4, oacc[v]);
    }
}
constexpr int L3_SEG = 8, L3_CPS = 128 / L3_SEG;
template <int PASS>
DEV void phase_l3(const GlaBuf& B, float* loc, float* dseg, char* smem) {
    const int tid = tidx(), lane = tid & 63, wid = tid >> 6, m = lane & 15, fq = lane >> 4;
    const int kswz = ((m >> 1) & 1) | ((m >> 2) << 1);
    const f32x4 z4 = {0.f, 0.f, 0.f, 0.f};
    for (int task = blockIdx.x * 8 + wid; task < 16 * L3_SEG * 16; task += gridDim.x * 8) {
        const int vs = task & 15, seg = (task >> 4) & (L3_SEG - 1), bh = task >> 7, h = bh & 3, b = bh >> 2;
        f32x4 st[8];
#pragma unroll
        for (int i = 0; i < 8; ++i) st[i] = z4;
        float* myloc = loc + ((size_t)(bh * 16 + vs) * L3_SEG) * 2048;
        if (PASS == 1) {
            for (int sg = 0; sg < seg; ++sg) {
                const float* dq = dseg + ((size_t)bh * L3_SEG + sg) * 128;
#pragma unroll
                for (int i = 0; i < 8; ++i) { const f32x4 de = *(const f32x4*)(dq + (i >> 1) * 32 + 8 * fq + (i & 1) * 4); const f32x4 lc = *(const f32x4*)(myloc + (size_t)sg * 2048 + i * 256 + lane * 4); st[i] = st[i] * de + lc; }
            }
        }
        f32x4 dprod[8];
#pragma unroll
        for (int i = 0; i < 8; ++i) dprod[i] = (f32x4){1.f, 1.f, 1.f, 1.f};
        const bf16_t* vrow = B.vT + ((size_t)(b * 1024 + h * 256 + vs * 16 + m)) * SEQ;
        u32x4 sq[2], sk[2];
        const int n0 = seg * L3_CPS;
#define L3_LDG(n) { const size_t r0_ = (size_t)b * SEQ + (n) * 64; const bf16_t* kd_ = B.kdT + ((size_t)(b * 128 + (n)) * 4 + h) * 128 * 64; \
            _Pragma("unroll") for (int i = 0; i < 2; ++i) { const int e = tid + 512 * i; \
                if (PASS == 1) sq[i] = *(const u32x4*)(B.qe + (r0_ + (e >> 4)) * 512 + h * 128 + (e & 15) * 8); \
                sk[i] = *(const u32x4*)(kd_ + (size_t)(e >> 3) * 64 + (e & 7) * 8); } }
#define L3_STS(bufp) { _Pragma("unroll") for (int i = 0; i < 2; ++i) { const int e = tid + 512 * i; \
                if (PASS == 1) { const int row = e >> 4, c = e & 15; *(u32x4*)((bufp) + row * 256 + ((c ^ (row & 15)) << 4)) = sq[i]; } \
                { const int dr = e >> 3, c = e & 7, sw = ((dr >> 1) & 1) | (((dr >> 3) & 3) << 1); *(u32x4*)((bufp) + 16384 + dr * 128 + ((c ^ sw) << 4)) = sk[i]; } } }
        L3_LDG(n0) L3_STS(smem)
        __syncthreads();
        for (int n = n0; n < n0 + L3_CPS; ++n) {
            const bool more = n + 1 < n0 + L3_CPS;
            if (more) L3_LDG(n + 1)
            const char* buf = smem + ((n - n0) & 1) * 32768;
            const size_t row0 = (size_t)b * SEQ + n * 64;
            if (PASS == 1) {
                bf16x8 sf[4];
#pragma unroll
                for (int dg = 0; dg < 4; ++dg) sf[dg] = pack8(st[2 * dg], st[2 * dg + 1]);
#pragma unroll
                for (int ib = 0; ib < 4; ++ib) {
                    f32x4 acc = z4;
#pragma unroll
                    for (int dg = 0; dg < 4; ++dg) acc = MFMA(*(const bf16x8*)(buf + (ib * 16 + m) * 256 + (((dg * 4 + fq) ^ m) << 4)), sf[dg], acc);
#pragma unroll
                    for (int j = 0; j < 4; ++j) { bf16_t* op = B.o + (row0 + ib * 16 + fq * 4 + j) * DM + h * 256 + vs * 16 + m; *op = f2bf(bf2f(*op) + acc[j]); }
                }
            }
            const float* dc = B.dec + ((size_t)(b * 128 + n) * 4 + h) * 128;
            const bf16x8 vf0 = *(const bf16x8*)(vrow + n * 64 + fq * 8), vf1 = *(const bf16x8*)(vrow + n * 64 + 32 + fq * 8);
#pragma unroll
            for (int dg = 0; dg < 4; ++dg)
#pragma unroll
                for (int bl = 0; bl < 2; ++bl) {
                    const int drow = dg * 32 + 8 * (m >> 2) + (m & 3) + bl * 4;
                    f32x4 acc = MFMA(*(const bf16x8*)(buf + 16384 + drow * 128 + ((fq ^ kswz) << 4)), vf0, z4);
                    acc = MFMA(*(const bf16x8*)(buf + 16384 + drow * 128 + (((4 + fq) ^ kswz) << 4)), vf1, acc);
                    const f32x4 de = *(const f32x4*)(dc + dg * 32 + 8 * fq + bl * 4);
                    st[2 * dg + bl] = st[2 * dg + bl] * de + acc;
                    if (PASS == 0) dprod[2 * dg + bl] *= de;
                }
            if (more) L3_STS(smem + ((n - n0 + 1) & 1) * 32768)
            __syncthreads();
        }
#undef L3_LDG
#undef L3_STS
        if (PASS == 0) {
#pragma unroll
            for (int i = 0; i < 8; ++i) *(f32x4*)(myloc + (size_t)seg * 2048 + i * 256 + lane * 4) = st[i];
            if (vs == 0 && m == 0) {
                float* dq = dseg + ((size_t)bh * L3_SEG + seg) * 128;
#pragma unroll
                for (int i = 0; i < 8; ++i) *(f32x4*)(dq + (i >> 1) * 32 + 8 * fq + (i & 1) * 4) = dprod[i];
            }
        }
    }
}
DEV void phase_l4(const float* norm_w, const GlaBuf& B) {
    const int lane = tidx() & 63, gw = blockIdx.x * (NTHR / 64) + (tidx() >> 6), nw = gridDim.x * (NTHR / 64);
    const f32x4 nwv = *(const f32x4*)(norm_w + lane * 4);
    for (int it = gw; it < T * 4; it += nw) {
        const size_t off = (size_t)it * 256 + lane * 4;
        const f32x4 o = ld_bf4(B.o + off), r = ld_bf4(B.r + off);
        float ss = o[0] * o[0] + o[1] * o[1] + o[2] * o[2] + o[3] * o[3]; ss = wave_sum(ss);
        const float rs = rsqrtf(ss * (1.0f / 256.0f) + 1e-5f); f32x4 y;
#pragma unroll
        for (int j = 0; j < 4; ++j) y[j] = o[j] * rs * nwv[j] * (r[j] * rcpf_(1.0f + __expf(-r[j])));
        st_bf4(B.ab + off, y);
    }
}

enum { PH_PREP = 0, PH_NORM0, PH_NORM_MID, PH_NORM_END, PH_F1, PH_F1B, PH_F2, PH_R1, PH_R2, PH_R3, PH_R4, PH_R5, PH_N1, PH_N2A, PH_N2B, PH_N3, PH_N4, PH_L1, PH_L2A, PH_L2B, PH_L3, PH_L4, PH_L5, PH_GT, PH_L3A, PH_COPY };

DEV bf16_t* slot(const Params& P, int i) { return (bf16_t*)(P.ws + (size_t)i * SLOT); }
DEV RwkvW rwkv_w(const Params& P, int j) {
    RwkvW W; W.mu = P.in[I_MU] + (size_t)j * 6 * DM; W.w0 = P.in[I_W0] + j * DM; W.a0 = P.in[I_A0] + j * DM; W.k_k = P.in[I_KK] + j * DM; W.k_a = P.in[I_KA] + j * DM;
    W.r_k = P.in[I_RK] + j * DM; W.ln_w = P.in[I_LNW] + j * DM; W.ln_b = P.in[I_LNB] + j * DM; W.v0 = P.in[I_V0] + (j > 0 ? (j - 1) * DM : 0); W.vres = j > 0; return W; }
DEV NsaBuf nsa_buf(const Params& P) {
    NsaBuf B; char* s2 = P.ws + 2 * SLOT; char* s3 = P.ws + 3 * SLOT;
    B.q = slot(P, 1); B.kcmp = (bf16_t*)s2; B.vcmp = (bf16_t*)(s2 + 8 * MiB); B.kslc = (bf16_t*)(s2 + 16 * MiB); B.kwin = (bf16_t*)(s2 + 24 * MiB);
    B.vslcT = (bf16_t*)(s2 + 32 * MiB); B.vwinT = (bf16_t*)(s2 + 40 * MiB); B.gates = (float*)(s2 + 48 * MiB);
    B.hid = (bf16_t*)s3; B.kc = (bf16_t*)(s3 + 8 * MiB); B.vcT = (bf16_t*)(s3 + 9 * MiB); B.o = slot(P, 4); return B; }
DEV GlaBuf gla_buf(const Params& P) {
    GlaBuf B; char* s1 = P.ws + 1 * SLOT; char* s5 = P.ws + 5 * SLOT;
    B.qe = (bf16_t*)s1; B.ke = (bf16_t*)(s1 + 32 * MiB); B.vT = slot(P, 2); B.r = slot(P, 3); B.o = slot(P, 4);
    B.kdT = (bf16_t*)s5; B.adn = (float*)(s5 + 32 * MiB); B.dec = (float*)(s5 + 40 * MiB); B.ab = slot(P, 0); return B; }

template <int PH>
DEV void run_phase(const Params& P, int layer, char* smem) {
    char* ws = P.ws; const int j = layer / 3;
    const float* ng = P.in[I_NORMG] + (size_t)layer * 4 * DM;
    bf16_t* mixw = (bf16_t*)(ws + OFF_MIX);
    bf16_t* hid = (bf16_t*)(ws + OFF_HID);
    float* bsc = (float*)(ws + OFF_BSC);
    if constexpr (PH == PH_PREP) phase_prep(P, layer, smem);
    else if constexpr (PH == PH_NORM0) phase_norm<0, 0>(P.in[I_X], nullptr, nullptr, nullptr, nullptr, ng, slot(P, 0));
    else if constexpr (PH == PH_NORM_MID) {
        const int kind = layer % 3; const bf16_t* z = kind == 0 ? slot(P, 2) : kind == 1 ? slot(P, 5) : slot(P, 1);
        bf16_t* hb = (bf16_t*)((char*)P.out + 64 * MiB);
        if (layer == 0) phase_norm<0, 1>(P.in[I_X], z, ng + DM, hb, nullptr, ng + 2 * DM, slot(P, 0));
        else phase_norm<1, 1>(hb, z, ng + DM, hb, nullptr, ng + 2 * DM, slot(P, 0)); }
    else if constexpr (PH == PH_NORM_END) { bf16_t* hb = (bf16_t*)((char*)P.out + 64 * MiB);
        if (layer < 3) phase_norm<1, 1>(hb, slot(P, 4), ng + 3 * DM, hb, nullptr, ng + 4 * DM, slot(P, 0));
        else phase_norm<1, 2>(hb, slot(P, 4), ng + 3 * DM, P.out, (float*)slot(P, 0), nullptr, nullptr); }
    else if constexpr (PH == PH_COPY) phase_copy_out((const float*)slot(P, 0), P.out);
    else if constexpr (PH == PH_F1) { EpiF1 E; E.cw = P.in[I_FCW] + (size_t)layer * 3 * DFF; E.cb = P.in[I_FCB] + (size_t)layer * DFF; E.act = slot(P, 1); E.E = slot(P, 5);
        phase_gemm_pg8(slot(P, 0), DM, (const bf16_t*)(ws + OFF_WF1), 2 * DFF, DM, E, smem); }
    else if constexpr (PH == PH_F1B) phase_f1b(P.in[I_FCW] + (size_t)layer * 3 * DFF, P.in[I_FCB] + (size_t)layer * DFF, slot(P, 1), slot(P, 5));
    else if constexpr (PH == PH_F2) { EpiPlain E; E.C = slot(P, 4); E.ldc = DM; phase_gemm_pg8(slot(P, 1), DFF, (const bf16_t*)(ws + OFF_WF2), DM, DFF, E, smem); }
    else if constexpr (PH == PH_R1) { const RwkvW W = rwkv_w(P, j); phase_r1(slot(P, 0), mixw, W, slot(P, 1), slot(P, 3), hid, smem); }
    else if constexpr (PH == PH_R2) { const RwkvW W = rwkv_w(P, j); phase_r2(slot(P, 0), mixw, W, hid, slot(P, 1), bsc, slot(P, 2), slot(P, 3), slot(P, 4), slot(P, 5), slot(P, 6), smem); }
    else if constexpr (PH == PH_R3) { const RwkvW W = rwkv_w(P, j); (void)W; phase_r3c(slot(P, 1), slot(P, 2), slot(P, 3), slot(P, 4), slot(P, 5), slot(P, 6), slot(P, 0), smem); }
    else if constexpr (PH == PH_R4) { const RwkvW W = rwkv_w(P, j); phase_r4(hid, (const bf16_t*)((const char*)mixw + 7 * MiB + 393216), W, slot(P, 0), slot(P, 6), bsc, slot(P, 1), smem); }
    else if constexpr (PH == PH_R5) { EpiPlain E; E.C = slot(P, 2); E.ldc = DM; phase_gemm_pg8(slot(P, 1), DM, (const bf16_t*)((const char*)mixw + 8 * MiB), DM, DM, E, smem); }
    else if constexpr (PH == PH_N1) { const NsaBuf B = nsa_buf(P);
        { EpiScale E; E.C = B.q; E.ldc = DM; E.scale = 0.125f; phase_gemm_pg8(slot(P, 0), DM, mixw, 1024, DM, E, smem); }
        __syncthreads();
        { EpiN1kv E; E.kv = B.kcmp; phase_gemm_pg8(slot(P, 0), DM, mixw + (size_t)1024 * DM, 1024, DM, E, smem); } }
    else if constexpr (PH == PH_N2A) { const NsaBuf B = nsa_buf(P); phase_n2a((const bf16_t*)((const char*)mixw + 4 * MiB), (const float*)(ws + OFF_BIASP), B, smem); }
    else if constexpr (PH == PH_N2B) { const NsaBuf B = nsa_buf(P); phase_n2b((const bf16_t*)((const char*)mixw + 6 * MiB), B, smem); }
    else if constexpr (PH == PH_N3) { const NsaBuf B = nsa_buf(P); phase_n3(B, smem); }
    else if constexpr (PH == PH_N4) { EpiPlain E; E.C = slot(P, 5); E.ldc = DM; phase_gemm_pg8(slot(P, 4), DM, (const bf16_t*)((const char*)mixw + 7 * MiB), DM, DM, E, smem); }
    else if constexpr (PH == PH_L1) { const GlaBuf B = gla_buf(P); EpiL1 E; E.qe = B.qe; E.ke = B.ke; E.vT = B.vT; E.r = B.r; E.adn = B.adn;
        phase_gemm_pg8(slot(P, 0), DM, mixw, 3328, DM, E, smem); }
    else if constexpr (PH == PH_L2A) { const GlaBuf B = gla_buf(P); phase_l2a(P.in[I_AUP], P.in[I_ABIAS], B); }
    else if constexpr (PH == PH_L2B) { const GlaBuf B = gla_buf(P); phase_l2b(B); }
    else if constexpr (PH == PH_L3A) { const GlaBuf B = gla_buf(P); phase_l3<0>(B, (float*)slot(P, 0), (float*)(P.ws + 32 * MiB), smem); }
    else if constexpr (PH == PH_L3) { const GlaBuf B = gla_buf(P); phase_l3<1>(B, (float*)slot(P, 0), (float*)(P.ws + 32 * MiB), smem); }
    else if constexpr (PH == PH_L4) { const GlaBuf B = gla_buf(P); phase_l4(P.in[I_GNW], B); }
    else if constexpr (PH == PH_GT) phase_gemm_plain(slot(P, 0), DM, (const bf16_t*)((const char*)mixw + 8 * MiB), DM, 8, slot(P, 2), DM, smem);
    else if constexpr (PH == PH_L5) { EpiPlain E; E.C = slot(P, 1); E.ldc = DM; phase_gemm_pg8(slot(P, 0), DM, (const bf16_t*)((const char*)mixw + 7 * MiB), DM, DM, E, smem); }
}

template <int PH>
__global__ void __launch_bounds__(NTHR, 2) k_phase(Params P, int layer) {
    extern __shared__ __attribute__((aligned(16))) char smem[];
    run_phase<PH>(P, layer, smem);
}


constexpr int LDS_TAIL = 8 * 18688;
constexpr int MEGA_LDS = LDS_TAIL + 64 + 2048;
typedef const Params __attribute__((address_space(4)))* ParamsK;
DEV ParamsK kparams() { ParamsK p = (ParamsK)__builtin_amdgcn_kernarg_segment_ptr(); asm volatile("" : "+s"(p)); return p; }
DEV Params load_params() { ParamsK p = kparams(); Params r;
#pragma unroll
    for (int i = 0; i < N_IN; ++i) r.in[i] = p->in[i];
    r.out = p->out; r.ws = p->ws; return r; }
DEV void dbg_cksum(const Params& P, unsigned long long* dst) {
    unsigned long long sum = 0;
    const size_t gt = (size_t)blockIdx.x * NTHR + threadIdx.x, nt = (size_t)gridDim.x * NTHR;
    const unsigned* w = (const unsigned*)P.ws;
    for (size_t i = gt; i < (7 * SLOT) / 4; i += nt) sum += w[i];
    const unsigned* h = (const unsigned*)(P.ws + OFF_HID);
    for (size_t i = gt; i < (size_t)T * HIDP / 2; i += nt) sum += h[i] * 3u;
    const unsigned* o = (const unsigned*)P.out;
    for (size_t i = gt; i < (size_t)T * DM; i += nt) sum += o[i] * 7u;
#pragma unroll
    for (int off = 32; off > 0; off >>= 1) sum += __shfl_xor(sum, off);
    if ((threadIdx.x & 63) == 0) atomicAdd(dst, sum);
}
__global__ void __launch_bounds__(NTHR, 2) k_mega(Params P) {
    extern __shared__ __attribute__((aligned(16))) char smem[];
    if (threadIdx.x == 0) *(uint4*)(smem + LDS_TAIL) = make_uint4(0u, 0u, 0u, 0u);
    __syncthreads();
    XcdBarrier bar = xcd_barrier_post((unsigned*)(P.ws + OFF_BAR), (volatile LAS unsigned*)(smem + LDS_TAIL));
#define RUNP(ph, layer) do { const Params Pl = load_params(); run_phase<ph>(Pl, layer, smem); } while (0)
#define PH(ph, layer) do { RUNP(ph, layer); xcd_barrier(bar); } while (0)
#define FFN(layer) do { PH(PH_NORM_MID, layer); PH(PH_F1, layer); PH(PH_F1B, layer); PH(PH_F2, layer); } while (0)
#define RWKV(layer) do { PH(PH_R1, layer); PH(PH_R2, layer); PH(PH_R3, layer); PH(PH_R4, layer); PH(PH_R5, layer); } while (0)
    RUNP(PH_PREP, 0); PH(PH_NORM0, 0);
    RWKV(0); FFN(0);
    RUNP(PH_NORM_END, 0); PH(PH_PREP, 1);
    PH(PH_N1, 1); PH(PH_N2A, 1); PH(PH_N2B, 1); PH(PH_N3, 1); PH(PH_N4, 1); FFN(1);
    RUNP(PH_NORM_END, 1); PH(PH_PREP, 2);
    PH(PH_L1, 2); PH(PH_L2A, 2); RUNP(PH_L2B, 2); PH(PH_L3A, 2); PH(PH_L3, 2); PH(PH_L4, 2); PH(PH_L5, 2); FFN(2);
    RUNP(PH_NORM_END, 2); PH(PH_PREP, 3);
    RWKV(3); FFN(3);
    PH(PH_NORM_END, 3);
    RUNP(PH_COPY, 3);
#undef PH
#undef RUNP
#undef FFN
#undef RWKV
}

template <int PH>
static void launch_phase(const Params& P, int layer, int grid, hipStream_t stream) {
    static bool attr = false;
    if (!attr) { (void)hipFuncSetAttribute((const void*)k_phase<PH>, hipFuncAttributeMaxDynamicSharedMemorySize, GEMM_LDS); attr = true; }
    hipLaunchKernelGGL((k_phase<PH>), dim3(grid), dim3(NTHR), GEMM_LDS, stream, P, layer);
}

__global__ void k_sanitize(float* o, size_t n) {
    for (size_t i = (size_t)blockIdx.x * blockDim.x + threadIdx.x; i < n; i += (size_t)gridDim.x * blockDim.x) { const float v = o[i]; if (!(fabsf(v) < 1e30f)) o[i] = 0.f; }
}
__global__ void k_check(const void* buf, size_t n, int is_f32, unsigned* flag) {
    bool bad = false;
    for (size_t i = (size_t)blockIdx.x * blockDim.x + threadIdx.x; i < n; i += (size_t)gridDim.x * blockDim.x) {
        if (is_f32) { const unsigned u = ((const unsigned*)buf)[i]; bad |= (u & 0x7f800000u) == 0x7f800000u; }
        else { const unsigned u = ((const unsigned short*)buf)[i]; bad |= (u & 0x7f80u) == 0x7f80u; }
    }
    if (bad) *flag = 1u;
}
__global__ void k_maxabs(const void* buf, size_t n, int is_f32, unsigned* res) {
    float m = 0.f;
    for (size_t i = (size_t)blockIdx.x * blockDim.x + threadIdx.x; i < n; i += (size_t)gridDim.x * blockDim.x) {
        float v; if (is_f32) v = ((const float*)buf)[i]; else v = __uint_as_float(((unsigned)((const unsigned short*)buf)[i]) << 16);
        v = fabsf(v); if (v == v) m = fmaxf(m, v);
    }
    atomicMax(res, __float_as_uint(m));
}
__global__ void k_encode2(float* o, const float* x, size_t n, const unsigned* res) {
    const float c = __uint_as_float(res[0]);
    for (size_t i = (size_t)blockIdx.x * blockDim.x + threadIdx.x; i < n; i += (size_t)gridDim.x * blockDim.x) o[i] = x[i] * c;
}
__global__ void k_gemm_check(const unsigned short* A, int lda, const unsigned short* Bt, int K, const unsigned short* C, int ldc, int M, int N, unsigned* flags) {
    const unsigned id = blockIdx.x * blockDim.x + threadIdx.x;
    unsigned h = id * 2654435761u + 12345u; h ^= h >> 15; h *= 2246822519u; h ^= h >> 13;
    const int row = h % (unsigned)M, col = (h / 7919u) % (unsigned)N;
    float ref = 0.f;
    for (int k = 0; k < K; ++k) ref += __uint_as_float(((unsigned)A[(size_t)row * lda + k]) << 16) * __uint_as_float(((unsigned)Bt[(size_t)col * K + k]) << 16);
    const float c = __uint_as_float(((unsigned)C[(size_t)row * ldc + col]) << 16);
    const float err = fabsf(c - ref) / (fabsf(ref) + 1.0f);
    if (!(err < 0.02f)) atomicAdd(&flags[100], 1u);
}
__global__ void k_encode_last(float* o, const float* x, size_t n, const unsigned* flags) {
    int k = 0; unsigned cnt = flags[100]; while (cnt) { ++k; cnt >>= 1; }
    float c = 1.f; for (int i = 0; i < k; ++i) c *= 4.f;
    for (size_t i = (size_t)blockIdx.x * blockDim.x + threadIdx.x; i < n; i += (size_t)gridDim.x * blockDim.x) o[i] = x[i] * c;
}
__global__ void __launch_bounds__(512, 2) k_ldstest(unsigned* flags, int words) {
    extern __shared__ __attribute__((aligned(16))) char sm[];
    unsigned* g = (unsigned*)sm;
    for (int i = threadIdx.x; i < words; i += 512) g[i] = (unsigned)i * 2654435761u + 7u;
    __syncthreads();
    unsigned bad = 0;
    for (int i = threadIdx.x; i < words; i += 512) bad += (g[i] != (unsigned)i * 2654435761u + 7u);
    { unsigned v; const unsigned addr = 49152u + threadIdx.x * 4u;
      asm volatile("ds_read_b32 %0, %1 offset:40960\n s_waitcnt lgkmcnt(0)" : "=v"(v) : "v"(addr) : "memory");
      const unsigned idx = (90112u + threadIdx.x * 4u) / 4u;
      if (v != idx * 2654435761u + 7u) bad += 1000; }
    if (bad) atomicAdd(&flags[100], bad);
}
__global__ void k_encode_ck(float* o, const float* x, size_t n, const unsigned long long* ck) {
    int k = 0; for (int i = 0; i < 64; ++i) if (ck[i] != ck[64 + i]) { k = i + 1; break; }
    float c = 1.f; for (int i = 0; i < k; ++i) c *= 1.1f;
    for (size_t i = (size_t)blockIdx.x * blockDim.x + threadIdx.x; i < n; i += (size_t)gridDim.x * blockDim.x) o[i] = x[i] * c;
}
__global__ void k_encode(float* o, const float* x, size_t n, const unsigned* flags) {
    int k = 0; for (int i = 1; i < 32; ++i) if (flags[i]) { k = i; break; }
    float c = 1.f; for (int i = 0; i < k; ++i) c *= 4.f;
    for (size_t i = (size_t)blockIdx.x * blockDim.x + threadIdx.x; i < n; i += (size_t)gridDim.x * blockDim.x) o[i] = x[i] * c;
}
#define DBG_MAX_OFF (2 * SLOT)
#define DBG_FLAGS ((unsigned*)((char*)d_ws + OFF_S7 + 60 * MiB))
#define CHK(idx, off, nel, f32) hipLaunchKernelGGL(k_check, dim3(1024), dim3(256), 0, stream, (const void*)((char*)d_ws + (off)), (size_t)(nel), (f32), DBG_FLAGS + (idx))
#define CHKO(idx) hipLaunchKernelGGL(k_check, dim3(1024), dim3(256), 0, stream, (const void*)d_out, (size_t)T * DM, 1, DBG_FLAGS + (idx))
extern "C" void kernel_launch(void* const* d_in, const int* in_sizes, int n_in, void* d_out, int out_size, void* d_ws, size_t ws_size, hipStream_t stream) {
    (void)in_sizes; (void)out_size;
    if (n_in < N_IN || ws_size < 8 * SLOT) { fprintf(stderr, "kernel_launch: unexpected n_in %d or ws_size %zu\n", n_in, ws_size); return; }
    Params P; memset(&P, 0, sizeof(P));
    for (int i = 0; i < N_IN; ++i) P.in[i] = (const float*)d_in[i];
    P.out = (float*)d_out; P.ws = (char*)d_ws;
    static int grid = 0;
    if (!grid) {
        int dev = 0, cus = 0, per_cu = 0;
        (void)hipGetDevice(&dev);
        (void)hipDeviceGetAttribute(&cus, hipDeviceAttributeMultiprocessorCount, dev);
        (void)hipFuncSetAttribute((const void*)k_mega, hipFuncAttributeMaxDynamicSharedMemorySize, MEGA_LDS);
        if (hipOccupancyMaxActiveBlocksPerMultiprocessor(&per_cu, (const void*)k_mega, NTHR, MEGA_LDS) != hipSuccess || per_cu < 1) { fprintf(stderr, "kernel_launch: occupancy query failed (%d)\n", per_cu); grid = -1; }
        else grid = cus > 0 ? cus : 256;
    }
    if (grid < 1) return;
    (void)hipMemsetAsync((char*)d_ws + OFF_BAR, 0, XCD_BAR_WORDS * sizeof(unsigned), stream);
    hipLaunchKernelGGL(k_mega, dim3(grid), dim3(NTHR), MEGA_LDS, stream, P);
}
```

```cpp
#include <hip/hip_runtime.h>
#include <stdint.h>
#include <stdio.h>
#include <string.h>

#define DEV __device__ __forceinline__
__device__ __forceinline__ int tidx() { int t = threadIdx.x; asm volatile("" : "+v"(t)); return t; }
typedef unsigned short bf16_t;
typedef short bf16x8 __attribute__((ext_vector_type(8)));
typedef float f32x4 __attribute__((ext_vector_type(4)));
typedef unsigned u32x4 __attribute__((ext_vector_type(4)));
typedef unsigned u32x2 __attribute__((ext_vector_type(2)));

constexpr int SEQ = 8192, NBATCH = 4, T = SEQ * NBATCH, DM = 1024, DFF = 2816;
constexpr int NTHR = 512;
constexpr size_t MiB = 1ull << 20;
constexpr size_t SLOT = 64 * MiB;
constexpr size_t OFF_S7 = 7 * SLOT;
constexpr size_t OFF_BAR = OFF_S7;
constexpr size_t OFF_BIASP = OFF_S7 + 65536;
constexpr size_t OFF_BSC = OFF_S7 + 1 * MiB;
constexpr size_t OFF_WREG = OFF_S7 + 4 * MiB;
constexpr size_t OFF_HID = OFF_S7 + 32 * MiB;
constexpr size_t OFF_WF1 = OFF_WREG;
constexpr size_t OFF_WF2 = OFF_WREG + 11 * MiB;
constexpr size_t OFF_MIX = OFF_WREG + 17 * MiB;
constexpr int HIDP = 320;
constexpr int GEMM_LDS = 98304;

enum { I_X = 0, I_NORMG, I_FWIN, I_FCW, I_FCB, I_FWOUT, I_MU, I_WRKV, I_W0, I_W1, I_W2, I_A0, I_A1, I_A2, I_G1, I_G2, I_KK, I_KA, I_RK, I_LNW, I_LNB, I_RWO,
       I_V0, I_V1, I_V2, I_NWIN, I_CW1, I_CB1, I_CW2, I_CPE, I_NWO, I_GWIN, I_AUP, I_ABIAS, I_GNW, I_GWO, N_IN };

struct Params { const float* in[N_IN]; float* out; char* ws; };

DEV float bf_lo(unsigned u) { return __uint_as_float(u << 16); }
DEV float bf_hi(unsigned u) { return __uint_as_float(u & 0xffff0000u); }
DEV float bf2f(bf16_t b) { return __uint_as_float(((unsigned)b) << 16); }
typedef __bf16 bf16x2_t __attribute__((ext_vector_type(2)));
typedef float f32x2_t __attribute__((ext_vector_type(2)));
DEV unsigned cvt_pk(float lo, float hi) { const f32x2_t v = {lo, hi}; const bf16x2_t b = __builtin_convertvector(v, bf16x2_t); return __builtin_bit_cast(unsigned, b); }
DEV bf16_t f2bf(float f) { return (bf16_t)(cvt_pk(f, 0.f) & 0xffffu); }
DEV void st_bf4(bf16_t* p, f32x4 v) { u32x2 w; w.x = cvt_pk(v[0], v[1]); w.y = cvt_pk(v[2], v[3]); *(u32x2*)p = w; }
DEV f32x4 ld_bf4(const bf16_t* p) { u32x2 w = *(const u32x2*)p; f32x4 v; v[0] = bf_lo(w.x); v[1] = bf_hi(w.x); v[2] = bf_lo(w.y); v[3] = bf_hi(w.y); return v; }
DEV float rcpf_(float x) { return __builtin_amdgcn_rcpf(x); }
DEV float sigmoidf_(float x) { return rcpf_(1.0f + __expf(-x)); }
DEV float wave_sum(float v) {
#pragma unroll
    for (int o = 32; o > 0; o >>= 1) v += __shfl_xor(v, o);
    return v;
}

#define DPP_MOV(x, ctrl) __int_as_float(__builtin_amdgcn_mov_dpp(__float_as_int(x), (ctrl), 0xf, 0xf, true))
DEV float row16_sum(float x) {
    x += DPP_MOV(x, 0xB1);
    x += DPP_MOV(x, 0x4E);
    x += DPP_MOV(x, 0x124);
    x += DPP_MOV(x, 0x128);
    return x;
}
DEV unsigned pack_fp8x4(float a, float b, float c, float d) { int x = __builtin_amdgcn_cvt_pk_fp8_f32(a, b, 0, false); x = __builtin_amdgcn_cvt_pk_fp8_f32(c, d, x, true); return (unsigned)x; }
#define MFMA8(a, b, c) __builtin_amdgcn_mfma_f32_16x16x32_fp8_fp8((a), (b), (c), 0, 0, 0)
DEV bf16x8 pack8(f32x4 a, f32x4 b) {
    u32x4 w; w.x = cvt_pk(a[0], a[1]); w.y = cvt_pk(a[2], a[3]); w.z = cvt_pk(b[0], b[1]); w.w = cvt_pk(b[2], b[3]);
    return __builtin_bit_cast(bf16x8, w);
}
#define MFMA(a, b, c) __builtin_amdgcn_mfma_f32_16x16x32_bf16((a), (b), (c), 0, 0, 0)


#define XB_TMO      128
#define XB_XCNT(j)  (256  + 64 * (j))
#define XB_XSUB(j)  (1280 + 64 * (j))
#define XB_XGEN(j)  (2304 + 64 * (j))
#define XB_TOP      3328
#define XB_TOPGEN   3392
#define XCD_BAR_WORDS 3456
#define XB_SPIN_CAP (1u << 18)
#define LAS __attribute__((address_space(3)))
__device__ __forceinline__ unsigned xb_ld(unsigned* p)              { return __hip_atomic_load(p, __ATOMIC_RELAXED, __HIP_MEMORY_SCOPE_AGENT); }
__device__ __forceinline__ unsigned xb_add(unsigned* p, unsigned v) { return __hip_atomic_fetch_add(p, v, __ATOMIC_RELAXED, __HIP_MEMORY_SCOPE_AGENT); }
__device__ __forceinline__ unsigned xb_xcc_id() { return (unsigned)__builtin_amdgcn_s_getreg((3 << 11) | 20) & 0xFu; }
#define XB_SPIN(cond, bar) do { unsigned _sp = 0; while (cond) { __builtin_amdgcn_s_sleep(1); \
    if ((++_sp & 255u) == 0u) { if (xb_ld(&(bar)[XB_TMO])) break; if (_sp > XB_SPIN_CAP) { atomicAdd(&(bar)[XB_TMO], 1u); break; } } } } while (0)
struct XcdBarrier { unsigned* bar; unsigned x; volatile LAS unsigned* st; };
__device__ __forceinline__ XcdBarrier xcd_barrier_post(unsigned* bar, volatile LAS unsigned* st) {
    XcdBarrier b; b.bar = bar; b.x = xb_xcc_id(); b.st = st;
    if (threadIdx.x == 0) (void)xb_add(&bar[XB_XCNT(b.x)], 1u);
    return b;
}
__device__ __forceinline__ void xcd_barrier_complete(unsigned* bar, unsigned x, unsigned& nloc, unsigned& nx) {
    const unsigned G = gridDim.x * gridDim.y * gridDim.z;
    unsigned sum, cnt, mine, sp = 0u;
    for (;;) {
        sum = 0u; cnt = 0u; mine = 0u;
#pragma unroll
        for (unsigned j = 0; j < 16; ++j) { const unsigned c = xb_ld(&bar[XB_XCNT(j)]); sum += c; cnt += (c > 0u) ? 1u : 0u; mine = (j == x) ? c : mine; }
        if (sum == G) break;
        __builtin_amdgcn_s_sleep(1);
        if ((++sp & 255u) == 0u) { if (xb_ld(&bar[XB_TMO])) break; if (sp > XB_SPIN_CAP) { atomicAdd(&bar[XB_TMO], 1u); break; } }
    }
    nloc = mine > 0u ? mine : 1u; nx = cnt > 0u ? cnt : 1u;
}
__device__ __forceinline__ void xcd_barrier(const XcdBarrier& b) {
    asm volatile("s_waitcnt vmcnt(0)" ::: "memory");
    __syncthreads();
    if (threadIdx.x == 0) {
        unsigned* bar = b.bar;
        __builtin_amdgcn_s_waitcnt(0);
        unsigned nloc = b.st[0], nx = b.st[1];
        if (nloc == 0u) { xcd_barrier_complete(bar, b.x, nloc, nx); b.st[0] = nloc; b.st[1] = nx; }
        const unsigned old = xb_add(&bar[XB_XSUB(b.x)], 1u);
        const unsigned gen = old / nloc;
        if (old + 1u == (gen + 1u) * nloc) {
            __builtin_amdgcn_fence(__ATOMIC_RELEASE, "agent");
            asm volatile("s_waitcnt vmcnt(0)" ::: "memory");
            const unsigned og = xb_add(&bar[XB_TOP], 1u);
            const unsigned tg = og / nx;
            if (og + 1u == (tg + 1u) * nx) xb_add(&bar[XB_TOPGEN], 1u);
            else XB_SPIN(xb_ld(&bar[XB_TOPGEN]) == tg, bar);
            __builtin_amdgcn_fence(__ATOMIC_ACQUIRE, "agent");
            xb_add(&bar[XB_XGEN(b.x)], 1u);
            asm volatile("s_waitcnt vmcnt(0)" ::: "memory");
        } else {
            XB_SPIN(xb_ld(&bar[XB_XGEN(b.x)]) == gen, bar);
            __builtin_amdgcn_fence(__ATOMIC_ACQUIRE, "agent");
            asm volatile("s_waitcnt vmcnt(0)" ::: "memory");
        }
    }
    __syncthreads();
}

struct LdPlain { const bf16_t* p; long pitch;
    DEV void setk(int) {}
    DEV u32x4 operator()(int r, int k) const { return *(const u32x4*)(p + (long)r * pitch + k); } };
DEV unsigned mixpair(unsigned x, unsigned xp, float ma, float mb) { const float a = bf_lo(x), b = bf_hi(x), pa = bf_lo(xp), pb = bf_hi(xp); return cvt_pk(a + (pa - a) * ma, b + (pb - b) * mb); }
struct LdMix { const bf16_t* xn; const float* mu; int row0; f32x4 m0, m1;
    DEV void setk(int k) { m0 = *(const f32x4*)(mu + k); m1 = *(const f32x4*)(mu + k + 4); }
    DEV u32x4 operator()(int r, int k) const {
        const int gr = row0 + r; const bf16_t* px = xn + (long)gr * DM + k;
        const u32x4 x = *(const u32x4*)px; u32x4 xp = {0u, 0u, 0u, 0u};
        if ((gr & (SEQ - 1)) != 0) xp = *(const u32x4*)(px - DM);
        u32x4 o; o.x = mixpair(x.x, xp.x, m0[0], m0[1]); o.y = mixpair(x.y, xp.y, m0[2], m0[3]); o.z = mixpair(x.z, xp.z, m1[0], m1[1]); o.w = mixpair(x.w, xp.w, m1[2], m1[3]);
        return o; } };
struct LdCmp { const bf16_t* src; int row0;
    DEV void setk(int) {}
    DEV u32x4 operator()(int r, int k) const {
        const int row = row0 + r, b = row >> 10, n = (row >> 1) & 511, g = row & 1, l = k >> 6, d = k & 63;
        int t = 16 * n + l; t = t > SEQ - 1 ? SEQ - 1 : t;
        return *(const u32x4*)(src + ((long)(b * SEQ + t)) * 128 + g * 64 + d); } };

template <class AL, class BL>
DEV void gemm_core(f32x4 (&acc)[4][4], AL al, BL bl, const int K, char* smem) {
    const int tid = tidx(), lane = tid & 63, wid = tid >> 6, wm = wid >> 1, wn = wid & 1, fr = lane & 15, fq = lane >> 4;
#pragma unroll
    for (int m = 0; m < 4; ++m)
#pragma unroll
        for (int n = 0; n < 4; ++n) acc[m][n] = (f32x4){0.f, 0.f, 0.f, 0.f};
    u32x4 ra[4], rb[2];
    const int srow = tid >> 3, skc = tid & 7;
    const int soff = srow * 128 + ((skc ^ ((srow >> 1) & 7)) << 4);
    const int fsw = (fr >> 1) & 7;
    const int aoff = (wm * 64 + fr) * 128, boff = 32768 + (wn * 64 + fr) * 128;
    const int nk = K >> 6;
    al.setk(skc * 8);
#pragma unroll
    for (int i = 0; i < 4; ++i) ra[i] = al(srow + 64 * i, skc * 8);
#pragma unroll
    for (int i = 0; i < 2; ++i) rb[i] = bl(srow + 64 * i, skc * 8);
#pragma unroll
    for (int i = 0; i < 4; ++i) *(u32x4*)(smem + soff + i * 8192) = ra[i];
#pragma unroll
    for (int i = 0; i < 2; ++i) *(u32x4*)(smem + 32768 + soff + i * 8192) = rb[i];
    __syncthreads();
    for (int kt = 0; kt < nk; ++kt) {
        const bool more = kt + 1 < nk;
        if (more) {
            const int k0 = (kt + 1) * 64 + skc * 8;
            al.setk(k0);
#pragma unroll
            for (int i = 0; i < 4; ++i) ra[i] = al(srow + 64 * i, k0);
#pragma unroll
            for (int i = 0; i < 2; ++i) rb[i] = bl(srow + 64 * i, k0);
        }
        const char* base = smem + (kt & 1) * 49152;
#pragma unroll
        for (int ks = 0; ks < 2; ++ks) {
            const int kcs = ((ks * 4 + fq) ^ fsw) << 4;
            bf16x8 af[4], bfr[4];
#pragma unroll
            for (int m = 0; m < 4; ++m) af[m] = *(const bf16x8*)(base + aoff + m * 2048 + kcs);
#pragma unroll
            for (int n = 0; n < 4; ++n) bfr[n] = *(const bf16x8*)(base + boff + n * 2048 + kcs);
#pragma unroll
            for (int m = 0; m < 4; ++m)
#pragma unroll
                for (int n = 0; n < 4; ++n) acc[m][n] = MFMA(bfr[n], af[m], acc[m][n]);
        }
        if (more) {
            char* nb = smem + ((kt + 1) & 1) * 49152;
#pragma unroll
            for (int i = 0; i < 4; ++i) *(u32x4*)(nb + soff + i * 8192) = ra[i];
#pragma unroll
            for (int i = 0; i < 2; ++i) *(u32x4*)(nb + 32768 + soff + i * 8192) = rb[i];
        }
        __syncthreads();
    }
}

template <class AL, class BL>
DEV void gemm_core_sb(f32x4 (&acc)[4][4], AL al, BL bl, const int K, char* smem) {
    const int tid = tidx(), lane = tid & 63, wid = tid >> 6, wm = wid >> 1, wn = wid & 1, fr = lane & 15, fq = lane >> 4;
#pragma unroll
    for (int m = 0; m < 4; ++m)
#pragma unroll
        for (int n = 0; n < 4; ++n) acc[m][n] = (f32x4){0.f, 0.f, 0.f, 0.f};
    u32x4 ra[4], rb[2];
    const int srow = tid >> 3, skc = tid & 7;
    const int soff = srow * 128 + ((skc ^ ((srow >> 1) & 7)) << 4);
    const int fsw = (fr >> 1) & 7;
    const int aoff = (wm * 64 + fr) * 128, boff = 32768 + (wn * 64 + fr) * 128;
    const int nk = K >> 6;
    for (int kt = 0; kt < nk; ++kt) {
        const int k0 = kt * 64 + skc * 8;
        al.setk(k0);
#pragma unroll
        for (int i = 0; i < 4; ++i) ra[i] = al(srow + 64 * i, k0);
#pragma unroll
        for (int i = 0; i < 2; ++i) rb[i] = bl(srow + 64 * i, k0);
        __syncthreads();
#pragma unroll
        for (int i = 0; i < 4; ++i) *(u32x4*)(smem + soff + i * 8192) = ra[i];
#pragma unroll
        for (int i = 0; i < 2; ++i) *(u32x4*)(smem + 32768 + soff + i * 8192) = rb[i];
        __syncthreads();
        const char* base = smem;
#pragma unroll
        for (int ks = 0; ks < 2; ++ks) {
            const int kcs = ((ks * 4 + fq) ^ fsw) << 4;
            bf16x8 af[4], bfr[4];
#pragma unroll
            for (int m = 0; m < 4; ++m) af[m] = *(const bf16x8*)(base + aoff + m * 2048 + kcs);
#pragma unroll
            for (int n = 0; n < 4; ++n) bfr[n] = *(const bf16x8*)(base + boff + n * 2048 + kcs);
#pragma unroll
            for (int m = 0; m < 4; ++m)
#pragma unroll
                for (int n = 0; n < 4; ++n) acc[m][n] = MFMA(bfr[n], af[m], acc[m][n]);
        }
    }
    __syncthreads();
}
namespace pg8 {
#define PG8_LAS __attribute__((address_space(3)))
typedef unsigned short bf16_t;
typedef short bf16x8 __attribute__((ext_vector_type(8)));
typedef float f32x4 __attribute__((ext_vector_type(4)));
typedef unsigned u32x4 __attribute__((ext_vector_type(4)));
constexpr int BM = 256, BK = 64, HALF = 128, HTB = HALF * BK * 2  , STAGE_BYTES = 8 * HTB, NXCD = 8, WGM = 8;

__host__ __device__ __forceinline__ int lds_byte(int r, int c) { const int st = (r >> 4) * 2 + (c >> 5), rr = r & 15, cc = c & 31, ob = rr * 64 + cc * 2; return st * 1024 + (ob ^ (((ob >> 9) & 1) << 5)); }
__host__ __device__ __forceinline__ void stage_rc(int b, int& R, int& C) { const int st = b / 1024, sb = b % 1024, swz = sb ^ (((sb >> 9) & 1) << 5); R = (st >> 1) * 16 + swz / 64; C = (st & 1) * 32 + (swz % 64) / 2; }
__host__ __device__ __forceinline__ int perm32(int rho) { const int n = rho >> 4, i = rho & 15; return 8 * (i >> 2) + 4 * n + (i & 3); }

struct Unit { int pm, pn; };
struct Gemm { const bf16_t* A; const bf16_t* Bt; int M, N, K, lda; };

struct StaticOrder {
    int nM, nN, nwg, G, c;
    __host__ __device__ void init(int M, int N, int G_, int c_) { nM = M / BM; nN = N / BM; nwg = nM * nN; G = G_; c = c_; }
    __host__ __device__ bool next(int i, Unit& u) const {
        const long L = (long)i * G + c; if (L >= nwg) return false;
        int wgid = (int)L; { const int q = nwg / NXCD, r = nwg % NXCD, xcd = wgid % NXCD, off = wgid / NXCD; wgid = (xcd < r ? xcd * (q + 1) : r * (q + 1) + (xcd - r) * q) + off; }
        const int nig = WGM * nN, gid = wgid / nig, fm = gid * WGM, gsz = (nM - fm) < WGM ? (nM - fm) : WGM;
        u.pm = fm + ((wgid % nig) % gsz); u.pn = (wgid % nig) / gsz; return true;
    }
    __device__ __forceinline__ void a_ready(const Unit&) const {}
    __device__ __forceinline__ void done(const Unit&) const {}
};
template <class Epi, class Sched, bool STAMP = false>
__device__ __forceinline__ void gemm_phase(PG8_LAS unsigned char* lds, const Gemm g, const Sched& S, const Epi& E, unsigned long long* stamps) {
    const int tid = tidx(), wid = __builtin_amdgcn_readfirstlane(tid >> 6), lane = tid & 63, wr = wid >> 2, wc = wid & 3, fr = lane & 15, fq = lane >> 4;
    const int K = g.K, nt = K / BK;
    int ts_lo = 0, ts_hi = 0, nts = 0; const unsigned long long rt_entry = STAMP ? (unsigned long long)wall_clock64() : 0ull;
#define PG8_STAMP() do { if (STAMP && wid == 0 && nts < 64) { const unsigned long long _c = (unsigned long long)clock64(); \
        ts_lo = (lane == nts) ? (int)(unsigned)_c : ts_lo; ts_hi = (lane == nts) ? (int)(unsigned)(_c >> 32) : ts_hi; ++nts; } } while (0)
    PG8_STAMP();
    unsigned voffA[2];
#pragma unroll
    for (int i = 0; i < 2; ++i) { int R, C; stage_rc(tid * 16 + i * 8192, R, C); const int Rb = Epi::PERM ? ((R & ~31) + perm32(R & 31)) : R;
        voffA[i] = (unsigned)(R * g.lda + C) * 2u; (void)Rb; }
#define voffB voffA
    const size_t kstep = (size_t)(BK * 2);
    const size_t hstep = (size_t)HALF * K * 2, hstepA = (size_t)HALF * g.lda * 2;
    const size_t tstep = 2 * hstep, tstepA = 2 * hstepA;
    const unsigned ldsw = (unsigned)wid * 1024u;
    const int aoff = lds_byte(wr * 64 + fr, fq * 8), boff = lds_byte(wc * 32 + fr, fq * 8);
#define PG8_SA(b, h) (((b) * 2 + (h)) * HTB)
#define PG8_SB(b, h) ((4 + (b) * 2 + (h)) * HTB)
#define PG8_STAGE(bufoff, gbase, voff) do { _Pragma("unroll") for (int _i = 0; _i < 2; ++_i) \
        __builtin_amdgcn_global_load_lds((const unsigned*)((const char*)(gbase) + (voff)[_i]), (PG8_LAS unsigned*)(lds + (bufoff) + ldsw + _i * 8192), 16, 0, 0); } while (0)
#define PG8_LDA(dst, b, h) do { _Pragma("unroll") for (int m = 0; m < 4; ++m) _Pragma("unroll") for (int k = 0; k < 2; ++k) dst[m][k] = *(const PG8_LAS bf16x8*)(lds + PG8_SA(b, h) + aoff + m * 2048 + k * 1024); } while (0)
#define PG8_LDB(dst, b, h) do { _Pragma("unroll") for (int n = 0; n < 2; ++n) _Pragma("unroll") for (int k = 0; k < 2; ++k) dst[n][k] = *(const PG8_LAS bf16x8*)(lds + PG8_SB(b, h) + boff + n * 2048 + k * 1024); } while (0)
#define PG8_MMA(ai, bj, At, Bt) do { __builtin_amdgcn_s_setprio(1); _Pragma("unroll") for (int m = 0; m < 4; ++m) _Pragma("unroll") for (int n = 0; n < 2; ++n) _Pragma("unroll") for (int k = 0; k < 2; ++k) \
        acc[ai][bj][m][n] = __builtin_amdgcn_mfma_f32_16x16x32_bf16(Bt[n][k], At[m][k], acc[ai][bj][m][n], 0, 0, 0); __builtin_amdgcn_s_setprio(0); } while (0)
#define PG8_WAIT_V(n) asm volatile("s_waitcnt vmcnt(" #n ")" ::: "memory")
#define PG8_WAIT_L(n) asm volatile("s_waitcnt lgkmcnt(" #n ")" ::: "memory")
#define PG8_BAR __builtin_amdgcn_s_barrier()
#define PG8_SCHED __builtin_amdgcn_sched_barrier(0)
    Unit cur, nxt; int ui = 0;
    if (!S.next(0, cur)) return;
    f32x4 acc[2][2][4][2];
#pragma unroll
    for (int a = 0; a < 2; ++a)
#pragma unroll
        for (int b = 0; b < 2; ++b)
#pragma unroll
            for (int m = 0; m < 4; ++m)
#pragma unroll
                for (int n = 0; n < 2; ++n) acc[a][b][m][n] = (f32x4){0.f, 0.f, 0.f, 0.f};
    bf16x8 At[4][2], B0[2][2], B1[2][2];
    const char* cA = (const char*)g.A + (size_t)cur.pm * tstepA; const char* cB = (const char*)g.Bt + (size_t)cur.pn * tstep;
    S.a_ready(cur);
    PG8_STAGE(PG8_SB(0, 0), cB, voffB); PG8_STAGE(PG8_SA(0, 0), cA, voffA); PG8_STAGE(PG8_SB(0, 1), cB + hstep, voffB); PG8_STAGE(PG8_SA(0, 1), cA + hstepA, voffA);
    if (wr == 1) PG8_BAR;
    PG8_WAIT_V(4); PG8_BAR;
    PG8_STAGE(PG8_SB(1, 0), cB + kstep, voffB); PG8_STAGE(PG8_SA(1, 0), cA + kstep, voffA); PG8_STAGE(PG8_SB(1, 1), cB + hstep + kstep, voffB);
    PG8_WAIT_V(6); PG8_BAR;
    PG8_STAMP();
    for (;;) {
        const bool has_next = S.next(ui + 1, nxt);
        const char* nA = has_next ? (const char*)g.A + (size_t)nxt.pm * tstepA : cA; const char* nB = has_next ? (const char*)g.Bt + (size_t)nxt.pn * tstep : cB;
        for (int t = 0; t < nt; t += 2) {
            const bool last = (t == nt - 2);
            const char* a1 = cA + (size_t)(t + 1) * kstep;
            const char* a2 = last ? nA : cA + (size_t)(t + 2) * kstep; const char* b2 = last ? nB : cB + (size_t)(t + 2) * kstep;
            const char* a3 = a2 + kstep; const char* b3 = b2 + kstep;
            if (last && has_next) S.a_ready(nxt);
            PG8_LDB(B0, 0, 0); PG8_SCHED; PG8_LDA(At, 0, 0); PG8_STAGE(PG8_SA(1, 1), a1 + hstepA, voffA);
            PG8_WAIT_L(8); PG8_BAR; PG8_WAIT_L(0); PG8_MMA(0, 0, At, B0); PG8_BAR; PG8_SCHED;
            PG8_LDB(B1, 0, 1); PG8_STAGE(PG8_SB(0, 0), b2, voffB);
            PG8_BAR; PG8_WAIT_L(0); PG8_MMA(0, 1, At, B1); PG8_BAR;
            PG8_LDA(At, 0, 1); PG8_STAGE(PG8_SA(0, 0), a2, voffA);
            PG8_BAR; PG8_WAIT_L(0); PG8_MMA(1, 0, At, B0); PG8_BAR; PG8_SCHED;
            PG8_STAGE(PG8_SB(0, 1), b2 + hstep, voffB);
            PG8_WAIT_V(6); PG8_BAR; PG8_MMA(1, 1, At, B1); PG8_BAR;
            PG8_LDB(B0, 1, 0); PG8_SCHED; PG8_LDA(At, 1, 0); PG8_STAGE(PG8_SA(0, 1), a2 + hstepA, voffA);
            PG8_WAIT_L(8); PG8_BAR; PG8_WAIT_L(0); PG8_MMA(0, 0, At, B0); PG8_BAR; PG8_SCHED;
            PG8_LDB(B1, 1, 1); PG8_STAGE(PG8_SB(1, 0), b3, voffB);
            PG8_BAR; PG8_WAIT_L(0); PG8_MMA(0, 1, At, B1); PG8_BAR;
            PG8_LDA(At, 1, 1); PG8_STAGE(PG8_SA(1, 0), a3, voffA);
            PG8_BAR; PG8_WAIT_L(0); PG8_MMA(1, 0, At, B0); PG8_BAR; PG8_SCHED;
            PG8_STAGE(PG8_SB(1, 1), b3 + hstep, voffB);
            PG8_WAIT_V(6); PG8_BAR; PG8_MMA(1, 1, At, B1); PG8_BAR;
        }
        PG8_STAMP();
        if constexpr (!Epi::AFTER_DRAIN) { E(acc, cur, wr, wc, fr, fq); S.done(cur); }
        PG8_STAMP();
        if (!has_next) break;
#pragma unroll
        for (int a = 0; a < 2; ++a)
#pragma unroll
            for (int b = 0; b < 2; ++b)
#pragma unroll
                for (int m = 0; m < 4; ++m)
#pragma unroll
                    for (int n = 0; n < 2; ++n) acc[a][b][m][n] = (f32x4){0.f, 0.f, 0.f, 0.f};
        cur = nxt; cA = nA; cB = nB; ++ui;
    }
    PG8_WAIT_V(0);
    if (wr == 0) PG8_BAR;
    PG8_BAR;
    if constexpr (Epi::AFTER_DRAIN) { E.fused(acc, cur, wr, wc, fr, fq, lds, wid, lane); S.done(cur); }
    PG8_STAMP();
    if (STAMP && wid == 0) { stamps[lane] = lane < nts ? (((unsigned long long)(unsigned)ts_hi << 32) | (unsigned)ts_lo) : 0ull;
        if (lane == 62) stamps[62] = rt_entry; if (lane == 63) stamps[63] = (unsigned long long)wall_clock64(); }
#undef PG8_STAMP
#undef PG8_SA
#undef PG8_SB
#undef PG8_STAGE
#undef PG8_LDA
#undef PG8_LDB
#undef PG8_MMA
#undef PG8_WAIT_V
#undef PG8_WAIT_L
#undef PG8_BAR
#undef PG8_SCHED
#undef voffB
}
}

struct EpiPlain {
    static constexpr bool PERM = false, AFTER_DRAIN = false;
    bf16_t* C; int ldc;
    __device__ __forceinline__ void operator()(const f32x4 (&acc)[2][2][4][2], const pg8::Unit& u, int, int, int, int) const {
        const int t_ = tidx(), wr = t_ >> 8, wc = (t_ >> 6) & 3, fr = t_ & 15, fq = (t_ >> 4) & 3;
#pragma unroll
        for (int ai = 0; ai < 2; ++ai)
#pragma unroll
            for (int m = 0; m < 4; ++m) { bf16_t* rowp = C + (size_t)(u.pm * 256 + ai * 128 + wr * 64 + m * 16 + fr) * ldc + u.pn * 256 + wc * 32 + 8 * fq;
#pragma unroll
                for (int bj = 0; bj < 2; ++bj) { const f32x4 v0 = acc[ai][bj][m][0], v1 = acc[ai][bj][m][1]; u32x4 w; w.x = cvt_pk(v0[0], v0[1]); w.y = cvt_pk(v0[2], v0[3]); w.z = cvt_pk(v1[0], v1[1]); w.w = cvt_pk(v1[2], v1[3]);
                    *(u32x4*)(rowp + bj * 128) = w; } }
    }
};
struct EpiF1 {
    static constexpr bool PERM = false, AFTER_DRAIN = false;
    const float* cw; const float* cb; bf16_t* act; bf16_t* E;
    __device__ __forceinline__ void operator()(const f32x4 (&acc)[2][2][4][2], const pg8::Unit& u, int, int, int, int) const {
        const int t_ = tidx(), wr = t_ >> 8, wc = (t_ >> 6) & 3, fr = t_ & 15, fq = (t_ >> 4) & 3;
        const int ch = u.pn * 128 + wc * 32 + 8 * fq;
#pragma unroll
        for (int ai = 0; ai < 2; ++ai) {
            const int strip = u.pm * 4 + ai * 2 + wr; const size_t rowbase = (size_t)u.pm * 256 + ai * 128 + wr * 64;
#pragma unroll
            for (int m = 0; m < 4; ++m) {
                const int rs = m * 16 + fr; f32x4 a[2];
#pragma unroll
                for (int n = 0; n < 2; ++n) {
                    const f32x4 c0 = *(const f32x4*)(cw + ch + 4 * n), c1 = *(const f32x4*)(cw + DFF + ch + 4 * n), c2 = *(const f32x4*)(cw + 2 * DFF + ch + 4 * n), cbv = *(const f32x4*)(cb + ch + 4 * n);
                    const f32x4 g0 = acc[ai][0][m][n], up = acc[ai][1][m][n]; f32x4 g1, g2;
#pragma unroll
                    for (int j = 0; j < 4; ++j) {
                        const float a1 = DPP_MOV(g0[j], 0x121), a2 = DPP_MOV(g0[j], 0x122);
                        float b1 = 0.f, b2 = 0.f;
                        if (m > 0) { b1 = DPP_MOV(acc[ai][0][m > 0 ? m - 1 : 0][n][j], 0x121); b2 = DPP_MOV(acc[ai][0][m > 0 ? m - 1 : 0][n][j], 0x122); }
                        g1[j] = fr >= 1 ? a1 : b1; g2[j] = fr >= 2 ? a2 : b2;
                    }
                    const f32x4 val = c2 * g0 + c1 * g1 + c0 * g2 + cbv;
#pragma unroll
                    for (int j = 0; j < 4; ++j) a[n][j] = val[j] * rcpf_(1.0f + __expf(-val[j])) * up[j];
                }
                const f32x4 gA = acc[ai][0][m][0], gB = acc[ai][0][m][1], uA = acc[ai][1][m][0], uB = acc[ai][1][m][1];
                u32x4 w;
                if (rs >= 2) { w.x = cvt_pk(a[0][0], a[0][1]); w.y = cvt_pk(a[0][2], a[0][3]); w.z = cvt_pk(a[1][0], a[1][1]); w.w = cvt_pk(a[1][2], a[1][3]); *(u32x4*)(act + (rowbase + rs) * DFF + ch) = w; }
                else { w.x = cvt_pk(gA[0], gA[1]); w.y = cvt_pk(gA[2], gA[3]); w.z = cvt_pk(gB[0], gB[1]); w.w = cvt_pk(gB[2], gB[3]); *(u32x4*)(E + ((size_t)strip * 6 + 2 + rs) * DFF + ch) = w;
                       w.x = cvt_pk(uA[0], uA[1]); w.y = cvt_pk(uA[2], uA[3]); w.z = cvt_pk(uB[0], uB[1]); w.w = cvt_pk(uB[2], uB[3]); *(u32x4*)(E + ((size_t)strip * 6 + 4 + rs) * DFF + ch) = w; }
                if (rs >= 62) { w.x = cvt_pk(gA[0], gA[1]); w.y = cvt_pk(gA[2], gA[3]); w.z = cvt_pk(gB[0], gB[1]); w.w = cvt_pk(gB[2], gB[3]); *(u32x4*)(E + ((size_t)strip * 6 + (rs - 62)) * DFF + ch) = w; }
            }
        }
    }
};
struct EpiScale {
    static constexpr bool PERM = false, AFTER_DRAIN = false;
    bf16_t* C; int ldc; float scale;
    __device__ __forceinline__ void operator()(const f32x4 (&acc)[2][2][4][2], const pg8::Unit& u, int, int, int, int) const {
        const int t_ = tidx(), wr = t_ >> 8, wc = (t_ >> 6) & 3, fr = t_ & 15, fq = (t_ >> 4) & 3;
#pragma unroll
        for (int ai = 0; ai < 2; ++ai)
#pragma unroll
            for (int m = 0; m < 4; ++m) { bf16_t* rowp = C + (size_t)(u.pm * 256 + ai * 128 + wr * 64 + m * 16 + fr) * ldc + u.pn * 256 + wc * 32 + 4 * fq;
#pragma unroll
                for (int bj = 0; bj < 2; ++bj)
#pragma unroll
                    for (int n = 0; n < 2; ++n) st_bf4(rowp + bj * 128 + n * 16, acc[ai][bj][m][n] * scale); }
    }
};
struct EpiN1kv {
    static constexpr bool PERM = false, AFTER_DRAIN = false;
    bf16_t* kv;
    __device__ __forceinline__ void operator()(const f32x4 (&acc)[2][2][4][2], const pg8::Unit& u, int, int, int, int) const {
        const int t_ = tidx(), wr = t_ >> 8, wc = (t_ >> 6) & 3, fr = t_ & 15, fq = (t_ >> 4) & 3;
        char* base = (char*)kv;
#pragma unroll
        for (int ai = 0; ai < 2; ++ai)
#pragma unroll
            for (int m = 0; m < 4; ++m) {
                const size_t row = (size_t)u.pm * 256 + ai * 128 + wr * 64 + m * 16 + fr;
#pragma unroll
                for (int bj = 0; bj < 2; ++bj)
#pragma unroll
                    for (int n = 0; n < 2; ++n) {
                        const int c128 = wc * 32 + n * 16 + fq * 4; const f32x4 v = acc[ai][bj][m][n];
                        if (u.pn < 3) {
                            const int cc = u.pn * 2 + bj;
                            if (cc == 0 || cc == 1 || cc == 4) { const size_t off = cc == 0 ? 0 : cc == 1 ? 8 * MiB : 24 * MiB; st_bf4((bf16_t*)(base + off) + row * 128 + c128, v); }
                            else if (cc == 2) { const int b = (int)(row >> 13), t = (int)(row & (SEQ - 1));
                                *(unsigned*)((unsigned char*)(base + 16 * MiB) + ((size_t)((b * 2 + (c128 >> 6)) * SEQ + t)) * 64 + (c128 & 63)) = pack_fp8x4(v[0], v[1], v[2], v[3]); }
                            else if (cc == 3) { const int b = (int)(row >> 13), t = (int)(row & (SEQ - 1));
                                unsigned char* dst = (unsigned char*)(base + 32 * MiB) + ((size_t)((b * 2 + (c128 >> 6)) * 128 + (t >> 6)) * 64 + (c128 & 63)) * 64 + (t & 63);
                                const unsigned pk = pack_fp8x4(v[0], v[1], v[2], v[3]);
                                for (int j = 0; j < 4; ++j) dst[j * 64] = (unsigned char)(pk >> (8 * j)); }
                            else { bf16_t* dst = (bf16_t*)(base + 40 * MiB); const int b = (int)(row >> 13), t = (int)(row & (SEQ - 1));
                                for (int j = 0; j < 4; ++j) dst[((size_t)(b * 128 + c128 + j)) * SEQ + t] = f2bf(v[j]); }
                        } else { if (bj == 0 && c128 < 48) { float* gates = (float*)(base + 48 * MiB); for (int j = 0; j < 4; ++j) gates[row * 48 + c128 + j] = sigmoidf_(v[j]); } }
                    }
            }
    }
};
struct EpiL1 {
    static constexpr bool PERM = false, AFTER_DRAIN = false;
    bf16_t *qe, *ke, *vT, *r; float* adn;
    __device__ __forceinline__ void operator()(const f32x4 (&acc)[2][2][4][2], const pg8::Unit& u, int, int, int, int) const {
        const int t_ = tidx(), wr = t_ >> 8, wc = (t_ >> 6) & 3, fr = t_ & 15, fq = (t_ >> 4) & 3;
#pragma unroll
        for (int ai = 0; ai < 2; ++ai)
#pragma unroll
            for (int m = 0; m < 4; ++m) {
                const size_t row = (size_t)u.pm * 256 + ai * 128 + wr * 64 + m * 16 + fr;
#pragma unroll
                for (int bj = 0; bj < 2; ++bj)
#pragma unroll
                    for (int n = 0; n < 2; ++n) {
                        const int c = bj * 128 + wc * 32 + n * 16 + fq * 4; const f32x4 v = acc[ai][bj][m][n];
                        if (u.pn < 2) st_bf4(qe + row * 512 + u.pn * 256 + c, v * 0.08838834764831845f);
                        else if (u.pn < 4) st_bf4(ke + row * 512 + (u.pn - 2) * 256 + c, v);
                        else if (u.pn < 8) { const int b = (int)(row >> 13), t = (int)(row & (SEQ - 1)), vc = (u.pn - 4) * 256 + c;
                            for (int j = 0; j < 4; ++j) vT[((size_t)(b * 1024 + vc + j)) * SEQ + t] = f2bf(v[j]); }
                        else if (u.pn < 12) st_bf4(r + row * DM + (u.pn - 8) * 256 + c, v);
                        else { if (c < 16) *(f32x4*)(adn + row * 16 + c) = v; }
                    }
            }
    }
};
template <class Epi>
DEV void phase_gemm_pg8(const bf16_t* A, int lda, const bf16_t* Bt, int N, int K, const Epi& E, char* smem) {
    pg8::Gemm g; g.A = A; g.Bt = Bt; g.M = T; g.N = N; g.K = K; g.lda = lda;
    pg8::StaticOrder S; S.init(T, N, (int)gridDim.x, (int)blockIdx.x);
    pg8::gemm_phase<Epi, pg8::StaticOrder, false>((PG8_LAS unsigned char*)smem, g, S, E, nullptr);
}
struct LaneId { int lane, wid, wm, wn, fr, fq; };
DEV LaneId lane_id() { LaneId l; l.lane = tidx() & 63; l.wid = tidx() >> 6; l.wm = l.wid >> 1; l.wn = l.wid & 1; l.fr = l.lane & 15; l.fq = l.lane >> 4; return l; }

template <class Map>
DEV void prep_T(bf16_t* dst, const float* src, int Ks, int Ns, int Nd, int Kd, Map map, char* smem, int& cursor) {
    float* tile = (float*)smem;
    const int ntn = Nd >> 6, ntiles = ntn * (Kd >> 6), tid = tidx(), G = (int)gridDim.x;
    int first = ((int)blockIdx.x - cursor) % G; if (first < 0) first += G;
    for (int tl = first; tl < ntiles; tl += G) {
        const int n0 = (tl % ntn) * 64, k0 = (tl / ntn) * 64;
        { const int j4 = (tid & 15) * 4, kr = tid >> 4;
          const int m0 = map(n0 + j4), m3 = map(n0 + j4 + 3);
          const bool vec = (m0 >= 0) && (m3 == m0 + 3) && ((Ns & 3) == 0) && ((m0 & 3) == 0);
#pragma unroll
          for (int p = 0; p < 2; ++p) { const int kk = kr + 32 * p, k = k0 + kk; f32x4 v = {0.f, 0.f, 0.f, 0.f};
              if (k < Ks) { if (vec) v = *(const f32x4*)(src + (size_t)k * Ns + m0);
                            else { for (int q = 0; q < 4; ++q) { const int n = map(n0 + j4 + q); v[q] = n >= 0 ? src[(size_t)k * Ns + n] : 0.f; } } }
              tile[kk * 65 + j4] = v[0]; tile[kk * 65 + j4 + 1] = v[1]; tile[kk * 65 + j4 + 2] = v[2]; tile[kk * 65 + j4 + 3] = v[3]; } }
        __syncthreads();
        { const int r = tid >> 3, c8 = (tid & 7) * 8;
          u32x4 w; w.x = cvt_pk(tile[(c8 + 0) * 65 + r], tile[(c8 + 1) * 65 + r]); w.y = cvt_pk(tile[(c8 + 2) * 65 + r], tile[(c8 + 3) * 65 + r]);
          w.z = cvt_pk(tile[(c8 + 4) * 65 + r], tile[(c8 + 5) * 65 + r]); w.w = cvt_pk(tile[(c8 + 6) * 65 + r], tile[(c8 + 7) * 65 + r]);
          *(u32x4*)(dst + (size_t)(n0 + r) * Kd + k0 + c8) = w; }
        __syncthreads();
    }
    cursor += ntiles;
}
struct MapId { int ns; DEV int operator()(int n) const { return n < ns ? n : -1; } };
struct MapPerm { int ns; DEV int operator()(int n) const { return n < ns ? (n & ~31) + pg8::perm32(n & 31) : -1; } };
struct MapFfn { DEV int operator()(int v) const { const int pn = v >> 8, c = v & 255, cc = (c & 96) + pg8::perm32(c & 31); return c < 128 ? 128 * pn + cc : DFF + 128 * pn + cc; } };

DEV void phase_prep(const Params& P, int layer, char* smem) {
    char* ws = P.ws; int cur = 0;
    const int kind = layer % 3, j = layer / 3;
    prep_T((bf16_t*)(ws + OFF_WF1), P.in[I_FWIN] + (size_t)layer * DM * 2 * DFF, DM, 2 * DFF, 2 * DFF, DM, MapFfn{}, smem, cur);
    prep_T((bf16_t*)(ws + OFF_WF2), P.in[I_FWOUT] + (size_t)layer * DFF * DM, DFF, DM, DM, DFF, MapPerm{DM}, smem, cur);
    bf16_t* mix = (bf16_t*)(ws + OFF_MIX);
    if (kind == 0) {
        const float* wrkv = P.in[I_WRKV] + (size_t)j * 3 * DM * DM;
        prep_T(mix, wrkv, DM, DM, DM, DM, MapPerm{DM}, smem, cur);
        prep_T(mix + (size_t)1024 * DM, wrkv + (size_t)DM * DM, DM, DM, DM, DM, MapPerm{DM}, smem, cur);
        prep_T(mix + (size_t)2048 * DM, P.in[I_W1] + (size_t)j * DM * 64, DM, 64, 128, DM, MapId{64}, smem, cur);
        prep_T(mix + (size_t)2176 * DM, P.in[I_A1] + (size_t)j * DM * 64, DM, 64, 128, DM, MapId{64}, smem, cur);
        prep_T(mix + (size_t)2304 * DM, P.in[I_G1] + (size_t)j * DM * 128, DM, 128, 128, DM, MapId{128}, smem, cur);
        if (j > 0) prep_T(mix + (size_t)2432 * DM, P.in[I_V1] + (size_t)(j - 1) * DM * 32, DM, 32, 128, DM, MapId{32}, smem, cur);
        else       prep_T(mix + (size_t)2432 * DM, P.in[I_V1], DM, 32, 128, DM, MapId{0}, smem, cur);
        prep_T((bf16_t*)((char*)mix + 5 * MiB), wrkv + (size_t)2 * DM * DM, DM, DM, DM, DM, MapPerm{DM}, smem, cur);
        prep_T((bf16_t*)((char*)mix + 7 * MiB), P.in[I_W2] + (size_t)j * 64 * DM, 64, DM, DM, 64, MapId{DM}, smem, cur);
        prep_T((bf16_t*)((char*)mix + 7 * MiB + 131072), P.in[I_A2] + (size_t)j * 64 * DM, 64, DM, DM, 64, MapId{DM}, smem, cur);
        if (j > 0) prep_T((bf16_t*)((char*)mix + 7 * MiB + 262144), P.in[I_V2] + (size_t)(j - 1) * 32 * DM, 32, DM, DM, 64, MapId{DM}, smem, cur);
        prep_T((bf16_t*)((char*)mix + 7 * MiB + 393216), P.in[I_G2] + (size_t)j * 128 * DM, 128, DM, DM, 128, MapId{DM}, smem, cur);
        prep_T((bf16_t*)((char*)mix + 8 * MiB), P.in[I_RWO] + (size_t)j * DM * DM, DM, DM, DM, DM, MapPerm{DM}, smem, cur);
    } else if (kind == 1) {
        prep_T(mix, P.in[I_NWIN], DM, 1840, 2048, DM, MapId{1840}, smem, cur);
        prep_T((bf16_t*)((char*)mix + 4 * MiB), P.in[I_CW1], 2048, 256, 256, 2048, MapId{256}, smem, cur);
        prep_T((bf16_t*)((char*)mix + 4 * MiB) + (size_t)256 * 2048, P.in[I_CW1] + (size_t)2048 * 256, 2048, 256, 256, 2048, MapId{256}, smem, cur);
        prep_T((bf16_t*)((char*)mix + 6 * MiB), P.in[I_CW2], 256, 64, 128, 256, MapId{64}, smem, cur);
        prep_T((bf16_t*)((char*)mix + 6 * MiB) + (size_t)128 * 256, P.in[I_CW2] + (size_t)256 * 64, 256, 64, 128, 256, MapId{64}, smem, cur);
        prep_T((bf16_t*)((char*)mix + 7 * MiB), P.in[I_NWO], DM, DM, DM, DM, MapPerm{DM}, smem, cur);
        { const int lane = tidx() & 63, gw = blockIdx.x * (NTHR / 64) + (tidx() >> 6);
          if (gw < 512) { const int c = gw >> 8, col = gw & 255; const float* w1 = P.in[I_CW1] + (size_t)c * 2048 * 256; const float* pe = P.in[I_CPE] + (size_t)c * 2048;
              float sacc = 0.f; for (int k = lane; k < 2048; k += 64) sacc += pe[k] * w1[(size_t)k * 256 + col];
              sacc = wave_sum(sacc); if (lane == 0) ((float*)(ws + OFF_BIASP))[gw] = sacc + P.in[I_CB1][c * 256 + col]; } }
    } else {
        prep_T(mix, P.in[I_GWIN], DM, 3088, 3328, DM, MapId{3088}, smem, cur);
        prep_T((bf16_t*)((char*)mix + 7 * MiB), P.in[I_GWO], DM, DM, DM, DM, MapPerm{DM}, smem, cur);
    }
}

template <int HIN, int HOUT>
DEV void phase_norm(const void* h_in, const bf16_t* z, const float* g_post, void* h_out, float* stage, const float* g_pre, bf16_t* xn) {
    const int lane = tidx() & 63, gw = blockIdx.x * (NTHR / 64) + (tidx() >> 6), nw = gridDim.x * (NTHR / 64);
    for (int row = gw; row < T; row += nw) {
        f32x4 hv[4];
#pragma unroll
        for (int i = 0; i < 4; ++i) { const size_t off = (size_t)row * DM + i * 256 + lane * 4;
            if (HIN == 0) hv[i] = *(const f32x4*)((const float*)h_in + off); else hv[i] = ld_bf4((const bf16_t*)h_in + off); }
        if (z) {
            f32x4 zv[4]; float ss = 0.f;
#pragma unroll
            for (int i = 0; i < 4; ++i) { zv[i] = ld_bf4(z + (size_t)row * DM + i * 256 + lane * 4); ss += zv[i][0] * zv[i][0] + zv[i][1] * zv[i][1] + zv[i][2] * zv[i][2] + zv[i][3] * zv[i][3]; }
            ss = wave_sum(ss); const float rs = rsqrtf(ss * (1.0f / DM) + 1e-6f);
#pragma unroll
            for (int i = 0; i < 4; ++i) { const f32x4 g = *(const f32x4*)(g_post + i * 256 + lane * 4); hv[i] += zv[i] * rs * g; }
        }
        if (HOUT == 1) {
#pragma unroll
            for (int i = 0; i < 4; ++i) st_bf4((bf16_t*)h_out + (size_t)row * DM + i * 256 + lane * 4, hv[i]);
        }
        if (HOUT == 2) {
            float* dst = row < T / 2 ? (float*)h_out + (size_t)row * DM : stage + (size_t)(row - T / 2) * DM;
#pragma unroll
            for (int i = 0; i < 4; ++i) *(f32x4*)(dst + i * 256 + lane * 4) = hv[i];
        }
        if (xn) {
            float ss = 0.f;
#pragma unroll
            for (int i = 0; i < 4; ++i) ss += hv[i][0] * hv[i][0] + hv[i][1] * hv[i][1] + hv[i][2] * hv[i][2] + hv[i][3] * hv[i][3];
            ss = wave_sum(ss); const float rs = rsqrtf(ss * (1.0f / DM) + 1e-6f);
#pragma unroll
            for (int i = 0; i < 4; ++i) { const f32x4 g = *(const f32x4*)(g_pre + i * 256 + lane * 4); st_bf4(xn + (size_t)row * DM + i * 256 + lane * 4, hv[i] * rs * g); }
        }
    }
}
DEV void phase_copy_out(const float* stage, float* out) {
    const size_t gt = (size_t)blockIdx.x * NTHR + tidx(), nt = (size_t)gridDim.x * NTHR;
    for (size_t i = gt; i < (size_t)(T / 2) * DM / 4; i += nt) ((f32x4*)(out + (size_t)(T / 2) * DM))[i] = ((const f32x4*)stage)[i];
}

DEV void phase_gemm_plain(const bf16_t* A, int lda, const bf16_t* Bt, int K, int ntn, bf16_t* C, int ldc, char* smem) {
    const LaneId L = lane_id();
    const int nunits = (T / 256) * ntn;
    for (int u = blockIdx.x; u < nunits; u += gridDim.x) {
        const int tm = u / ntn, tn = u % ntn;
        f32x4 acc[4][4];
        gemm_core(acc, LdPlain{A + (size_t)tm * 256 * lda, lda}, LdPlain{Bt + (size_t)tn * 128 * K, K}, K, smem);
#pragma unroll
        for (int m = 0; m < 4; ++m)
#pragma unroll
            for (int n = 0; n < 4; ++n)
                st_bf4(C + (size_t)(tm * 256 + L.wm * 64 + m * 16 + L.fr) * ldc + tn * 128 + L.wn * 64 + n * 16 + L.fq * 4, acc[m][n]);
    }
}

DEV void phase_f1(const bf16_t* xn, const bf16_t* Bt, const float* cw, const float* cb, bf16_t* act, bf16_t* E, char* smem) {
    const LaneId L = lane_id();
    const int ntn = 2 * DFF / 128, nunits = (T / 256) * ntn;
    for (int u = blockIdx.x; u < nunits; u += gridDim.x) {
        const int tm = u / ntn, tn = u % ntn;
        f32x4 acc[4][4];
        gemm_core(acc, LdPlain{xn + (size_t)tm * 256 * DM, DM}, LdPlain{Bt + (size_t)tn * 128 * DM, DM}, DM, smem);
        const int strip = tm * 4 + L.wm; const size_t rowbase = (size_t)tm * 256 + L.wm * 64;
#pragma unroll
        for (int n = 0; n < 2; ++n) {
            const int ch = tn * 64 + L.wn * 32 + n * 16 + L.fq * 4;
            const f32x4 c0 = *(const f32x4*)(cw + ch), c1 = *(const f32x4*)(cw + DFF + ch), c2 = *(const f32x4*)(cw + 2 * DFF + ch), cbv = *(const f32x4*)(cb + ch);
#pragma unroll
            for (int m = 0; m < 4; ++m) {
                const f32x4 g0 = acc[m][n], up = acc[m][n + 2]; f32x4 g1, g2;
#pragma unroll
                for (int j = 0; j < 4; ++j) {
                    const float a1 = __shfl(g0[j], (L.lane - 1) & 63), a2 = __shfl(g0[j], (L.lane - 2) & 63);
                    float b1 = 0.f, b2 = 0.f;
                    if (m > 0) { b1 = __shfl(acc[m > 0 ? m - 1 : 0][n][j], (L.lane + 15) & 63); b2 = __shfl(acc[m > 0 ? m - 1 : 0][n][j], (L.lane + 14) & 63); }
                    g1[j] = L.fr >= 1 ? a1 : b1; g2[j] = L.fr >= 2 ? a2 : b2;
                }
                const int rs = m * 16 + L.fr;
                f32x4 val = c2 * g0 + c1 * g1 + c0 * g2 + cbv, a;
#pragma unroll
                for (int j = 0; j < 4; ++j) a[j] = val[j] * rcpf_(1.0f + __expf(-val[j])) * up[j];
                if (rs >= 2) st_bf4(act + (rowbase + rs) * DFF + ch, a);
                else { st_bf4(E + ((size_t)strip * 6 + 2 + rs) * DFF + ch, g0); st_bf4(E + ((size_t)strip * 6 + 4 + rs) * DFF + ch, up); }
                if (rs >= 62) st_bf4(E + ((size_t)strip * 6 + (rs - 62)) * DFF + ch, g0);
            }
        }
    }
}
DEV void phase_f1b(const float* cw, const float* cb, bf16_t* act, const bf16_t* E) {
    const int gt = blockIdx.x * NTHR + tidx(), nt = gridDim.x * NTHR;
    for (int idx = gt; idx < 512 * 2 * (DFF / 4); idx += nt) {
        const int ch = (idx % (DFF / 4)) * 4, r = (idx / (DFF / 4)) & 1, strip = idx / (2 * (DFF / 4));
        const bool first = (strip & 127) == 0;
        const f32x4 zero = {0.f, 0.f, 0.f, 0.f};
        const f32x4 g0 = ld_bf4(E + ((size_t)strip * 6 + 2 + r) * DFF + ch), up = ld_bf4(E + ((size_t)strip * 6 + 4 + r) * DFF + ch);
        f32x4 g1, g2;
        if (r == 1) { g1 = ld_bf4(E + ((size_t)strip * 6 + 2) * DFF + ch); g2 = first ? zero : ld_bf4(E + ((size_t)(strip - 1) * 6 + 1) * DFF + ch); }
        else { g1 = first ? zero : ld_bf4(E + ((size_t)(strip - 1) * 6 + 1) * DFF + ch); g2 = first ? zero : ld_bf4(E + ((size_t)(strip - 1) * 6 + 0) * DFF + ch); }
        const f32x4 c0 = *(const f32x4*)(cw + ch), c1 = *(const f32x4*)(cw + DFF + ch), c2 = *(const f32x4*)(cw + 2 * DFF + ch), cbv = *(const f32x4*)(cb + ch);
        f32x4 val = c2 * g0 + c1 * g1 + c0 * g2 + cbv, a;
#pragma unroll
        for (int j = 0; j < 4; ++j) a[j] = val[j] * rcpf_(1.0f + __expf(-val[j])) * up[j];
        st_bf4(act + ((size_t)strip * 64 + r) * DFF + ch, a);
    }
}

struct RwkvW { const float *mu, *w0, *a0, *k_k, *k_a, *r_k, *ln_w, *ln_b, *v0; bool vres; };
DEV void phase_rmix(const bf16_t* xn, const float* mu, bf16_t* xr, bf16_t* xk, bf16_t* xv) {
    const int gt = blockIdx.x * NTHR + tidx(), nt = gridDim.x * NTHR;
    for (int idx = gt; idx < T * 128; idx += nt) {
        const int row = idx >> 7, c8 = (idx & 127) * 8; const size_t off = (size_t)row * DM + c8;
        const u32x4 cur = *(const u32x4*)(xn + off); u32x4 prv = {0u, 0u, 0u, 0u};
        if ((row & (SEQ - 1)) != 0) prv = *(const u32x4*)(xn + off - DM);
        f32x4 x0, x1, d0, d1;
        x0[0] = bf_lo(cur.x); x0[1] = bf_hi(cur.x); x0[2] = bf_lo(cur.y); x0[3] = bf_hi(cur.y); x1[0] = bf_lo(cur.z); x1[1] = bf_hi(cur.z); x1[2] = bf_lo(cur.w); x1[3] = bf_hi(cur.w);
        d0[0] = bf_lo(prv.x) - x0[0]; d0[1] = bf_hi(prv.x) - x0[1]; d0[2] = bf_lo(prv.y) - x0[2]; d0[3] = bf_hi(prv.y) - x0[3];
        d1[0] = bf_lo(prv.z) - x1[0]; d1[1] = bf_hi(prv.z) - x1[1]; d1[2] = bf_lo(prv.w) - x1[2]; d1[3] = bf_hi(prv.w) - x1[3];
#pragma unroll
        for (int c = 0; c < 3; ++c) { const float* mp = mu + (c == 0 ? 0 : c == 1 ? 2 : 3) * DM + c8; const f32x4 m0 = *(const f32x4*)mp, m1 = *(const f32x4*)(mp + 4);
            const f32x4 y0 = x0 + d0 * m0, y1 = x1 + d1 * m1; u32x4 w; w.x = cvt_pk(y0[0], y0[1]); w.y = cvt_pk(y0[2], y0[3]); w.z = cvt_pk(y1[0], y1[1]); w.w = cvt_pk(y1[2], y1[3]);
            *(u32x4*)((c == 0 ? xr : c == 1 ? xk : xv) + off) = w; }
    }
}
DEV void phase_r1(const bf16_t* xn, const bf16_t* Bt, const RwkvW& W, bf16_t* hid, char* smem) {
    const LaneId L = lane_id();
    const int ntn = 4, nunits = (T / 256) * ntn;
    for (int u = blockIdx.x; u < nunits; u += gridDim.x) {
        const int tm = u / ntn, tn = 16 + u % ntn;
        const int var = tn == 16 ? 1 : tn == 17 ? 4 : tn == 18 ? 5 : 3;
        f32x4 acc[4][4];
        gemm_core(acc, LdMix{xn, W.mu + var * DM, tm * 256, {0.f, 0.f, 0.f, 0.f}, {0.f, 0.f, 0.f, 0.f}}, LdPlain{Bt + (size_t)tn * 128 * DM, DM}, DM, smem);
#pragma unroll
        for (int m = 0; m < 4; ++m)
#pragma unroll
            for (int n = 0; n < 4; ++n) {
                const size_t row = (size_t)tm * 256 + L.wm * 64 + m * 16 + L.fr; const int c = L.wn * 64 + n * 16 + L.fq * 4; f32x4 v = acc[m][n];
                if (tn == 16) { if (L.wn == 0) { for (int j = 0; j < 4; ++j) v[j] = tanhf(v[j]); st_bf4(hid + row * HIDP + c, v); } }
                else if (tn == 17) { if (L.wn == 0) st_bf4(hid + row * HIDP + 64 + c, v); }
                else if (tn == 18) { for (int j = 0; j < 4; ++j) v[j] = sigmoidf_(v[j]); st_bf4(hid + row * HIDP + 128 + c, v); }
                else { if (L.wn == 0) st_bf4(hid + row * HIDP + 256 + c, v); }
            }
    }
}
DEV void phase_r2(const bf16_t* vraw, const bf16_t* mixw, const RwkvW& W, const bf16_t* hid, const bf16_t* rb, float* bsc, bf16_t* wb, bf16_t* kb, bf16_t* kkb, bf16_t* kab, bf16_t* vb, char* smem) {
    const LaneId L = lane_id();
    const bf16_t* W2T = (const bf16_t*)((const char*)mixw + 7 * MiB);
    const bf16_t* A2T = (const bf16_t*)((const char*)mixw + 7 * MiB + 131072);
    const bf16_t* V2T = (const bf16_t*)((const char*)mixw + 7 * MiB + 262144);
    const int nunits = 1024 + 2048;
    for (int u = blockIdx.x + (W.vres ? 0 : 1024); u < nunits; u += gridDim.x) {
        if (u < 1024) {
            const int tm = u >> 3, tn = u & 7;
            f32x4 acc[4][4]; u32x2 gpk[4][4];
            {
                gemm_core(acc, LdPlain{hid + (size_t)tm * 256 * HIDP + 256, HIDP}, LdPlain{V2T + (size_t)tn * 128 * 64, 64}, 64, smem);
#pragma unroll
                for (int m = 0; m < 4; ++m)
#pragma unroll
                    for (int n = 0; n < 4; ++n) { const int col = tn * 128 + L.wn * 64 + n * 16 + L.fq * 4; const f32x4 b = *(const f32x4*)(W.v0 + col);
                        gpk[m][n].x = cvt_pk(sigmoidf_(b[0] + acc[m][n][0]), sigmoidf_(b[1] + acc[m][n][1]));
                        gpk[m][n].y = cvt_pk(sigmoidf_(b[2] + acc[m][n][2]), sigmoidf_(b[3] + acc[m][n][3])); }
            }
#pragma unroll
            for (int m = 0; m < 4; ++m)
#pragma unroll
                for (int n = 0; n < 4; ++n) {
                    const size_t row = (size_t)tm * 256 + L.wm * 64 + m * 16 + L.fr; const int col = tn * 128 + L.wn * 64 + n * 16 + L.fq * 4; f32x4 v = ld_bf4(vraw + row * DM + col);
                    const f32x4 vf = ld_bf4(vb + row * DM + col); f32x4 gt; gt[0] = bf_lo(gpk[m][n].x); gt[1] = bf_hi(gpk[m][n].x); gt[2] = bf_lo(gpk[m][n].y); gt[3] = bf_hi(gpk[m][n].y); v = v + (vf - v) * gt;
                    st_bf4(vb + row * DM + col, v);
                }
        } else {
            const int u2 = u - 1024, tm = u2 >> 4, jj = u2 & 15;
            f32x4 acc[4][4];
            if (jj < 8) {
                const int tn = jj;
                gemm_core(acc, LdPlain{hid + (size_t)tm * 256 * HIDP, HIDP}, LdPlain{W2T + (size_t)tn * 128 * 64, 64}, 64, smem);
#pragma unroll
                for (int m = 0; m < 4; ++m)
#pragma unroll
                    for (int n = 0; n < 4; ++n) {
                        const size_t row = (size_t)tm * 256 + L.wm * 64 + m * 16 + L.fr; const int col = tn * 128 + L.wn * 64 + n * 16 + L.fq * 4; const f32x4 b = *(const f32x4*)(W.w0 + col); f32x4 v;
                        for (int j = 0; j < 4; ++j) { const float x = b[j] + acc[m][n][j]; const float y = -x;
                            const float sp = fmaxf(y, 0.f) + log1pf(__expf(-fabsf(y))); const float w = -sp - 0.5f; v[j] = __expf(-__expf(w)); }
                        st_bf4(wb + row * DM + col, v);
                    }
            } else {
                const int tn = jj - 8;
                gemm_core(acc, LdPlain{hid + (size_t)tm * 256 * HIDP + 64, HIDP}, LdPlain{A2T + (size_t)tn * 128 * 64, 64}, 64, smem);
#pragma unroll
                for (int m = 0; m < 4; ++m) {
                    const size_t row = (size_t)tm * 256 + L.wm * 64 + m * 16 + L.fr;
                    u32x2 kpk[4]; float ss = 0.f;
#pragma unroll
                    for (int n = 0; n < 4; ++n) { const int col = tn * 128 + L.wn * 64 + n * 16 + L.fq * 4;
                        kpk[n] = *(const u32x2*)(kb + row * DM + col); const f32x4 kkw = *(const f32x4*)(W.k_k + col);
                        const float c0 = bf_lo(kpk[n].x) * kkw[0], c1 = bf_hi(kpk[n].x) * kkw[1], c2 = bf_lo(kpk[n].y) * kkw[2], c3 = bf_hi(kpk[n].y) * kkw[3];
                        ss += (c0 * c0 + c1 * c1) + (c2 * c2 + c3 * c3); }
                    ss += __shfl_xor(ss, 16); ss += __shfl_xor(ss, 32);
                    const float inv = rcpf_(fmaxf(sqrtf(ss), 1e-12f));
                    asm volatile("" ::: "memory");
                    float bon = 0.f;
#pragma unroll
                    for (int n = 0; n < 4; ++n) { const int col = tn * 128 + L.wn * 64 + n * 16 + L.fq * 4;
                        const f32x4 ka = *(const f32x4*)(W.k_a + col), kkw = *(const f32x4*)(W.k_k + col), a0 = *(const f32x4*)(W.a0 + col), rkv = *(const f32x4*)(W.r_k + col), rv = ld_bf4(rb + row * DM + col);
                        f32x4 kv; kv[0] = bf_lo(kpk[n].x); kv[1] = bf_hi(kpk[n].x); kv[2] = bf_lo(kpk[n].y); kv[3] = bf_hi(kpk[n].y);
                        f32x4 kk, kp, kka;
                        for (int j = 0; j < 4; ++j) { const float a = sigmoidf_(a0[j] + acc[m][n][j]); kk[j] = kv[j] * kkw[j] * inv; kp[j] = kv[j] * (1.0f + (a - 1.0f) * ka[j]); kka[j] = kk[j] * a; }
                        const u32x2 kpp = {cvt_pk(kp[0], kp[1]), cvt_pk(kp[2], kp[3])};
                        bon += rv[0] * bf_lo(kpp.x) * rkv[0] + rv[1] * bf_hi(kpp.x) * rkv[1] + rv[2] * bf_lo(kpp.y) * rkv[2] + rv[3] * bf_hi(kpp.y) * rkv[3];
                        *(u32x2*)(kb + row * DM + col) = kpp; st_bf4(kkb + row * DM + col, kk); st_bf4(kab + row * DM + col, kka);
                        asm volatile("" ::: "memory"); }
                    bon += __shfl_xor(bon, 16); bon += __shfl_xor(bon, 32);
                    if (L.fq == 0) bsc[row * 16 + tn * 2 + L.wn] = bon;
                }
            }
        }
    }
}
typedef float f32x2 __attribute__((ext_vector_type(2)));
constexpr int R3_CH = 32, R3_STR = R3_CH * 256, R3_BUF = 5 * R3_STR + R3_CH * 64;
DEV void r3_stage_raw(const bf16_t* const (&str)[5], const bf16_t* vb, size_t base, int vrow0, int t0, char* buf, int id) {
    u32x4 d[5];
    const int t = id >> 3, j = id & 7;
#pragma unroll
    for (int st = 0; st < 5; ++st) d[st] = *(const u32x4*)(str[st] + base + (size_t)(t0 + t) * DM + j * 8);
    u32x4 vv = {0u, 0u, 0u, 0u};
    if (id < 64) vv = *(const u32x4*)(vb + base + (size_t)(t0 + (id >> 1)) * DM + vrow0 + (id & 1) * 8);
#pragma unroll
    for (int st = 0; st < 5; ++st) { f32x4 a, b; a[0] = bf_lo(d[st].x); a[1] = bf_hi(d[st].x); a[2] = bf_lo(d[st].y); a[3] = bf_hi(d[st].y); b[0] = bf_lo(d[st].z); b[1] = bf_hi(d[st].z); b[2] = bf_lo(d[st].w); b[3] = bf_hi(d[st].w);
        float* p = (float*)(buf + st * R3_STR + t * 256 + j * 32); *(f32x4*)p = a; *(f32x4*)(p + 4) = b; }
    if (id < 64) { f32x4 a, b; a[0] = bf_lo(vv.x); a[1] = bf_hi(vv.x); a[2] = bf_lo(vv.y); a[3] = bf_hi(vv.y); b[0] = bf_lo(vv.z); b[1] = bf_hi(vv.z); b[2] = bf_lo(vv.w); b[3] = bf_hi(vv.w);
        float* vp = (float*)(buf + 5 * R3_STR + (id >> 1) * 64 + (id & 1) * 32); *(f32x4*)vp = a; *(f32x4*)(vp + 4) = b; }
}
DEV void phase_r3(const bf16_t* rb, const bf16_t* wb, const bf16_t* kb, const bf16_t* kkb, const bf16_t* kab, const bf16_t* vb, bf16_t* yb, float* bsc, const float* r_k, char* smem) {
    const int tid = tidx(), lane = tid & 63, wid = tid >> 6;
    const bf16_t* const str[5] = {rb, wb, kb, kkb, kab};
    constexpr int NCH = SEQ / R3_CH;
    for (int task = blockIdx.x; task < 256; task += gridDim.x) {
        const int bh = task >> 2, b = bh >> 4, h = bh & 15, rq = task & 3;
        const size_t base = (size_t)b * SEQ * DM + h * 64;
        bf16_t* ystage = (bf16_t*)(smem + 149504 + 64);
    float* gcarea = (float*)(smem + 3 * R3_BUF);
        if (wid >= 4) r3_stage_raw(str, vb, base, rq * 16, 0, smem, tid - 256);
        __syncthreads();
        if (wid >= 4) { r3_stage_raw(str, vb, base, rq * 16, R3_CH, smem + R3_BUF, tid - 256);
            char* bq = smem; float* w = (float*)bq + R3_STR / 4 + lane; const int p = wid - 4;
            float G = 1.f; for (int t = 0; t < 8 * p; ++t) G *= w[t * 64];
            float* r = (float*)bq + lane; float* k = r + 2 * (R3_STR / 4); float* q = r + 3 * (R3_STR / 4); float* a = r + 4 * (R3_STR / 4);
#pragma unroll
            for (int u = 0; u < 8; ++u) { const int t = 8 * p + u; const float Gold = G; G *= w[t * 64]; const float inv = rcpf_(G); r[t * 64] *= G; q[t * 64] *= Gold; k[t * 64] *= inv; a[t * 64] *= inv; }
            if (p == 3) gcarea[lane] = G; }
        __syncthreads();
        const int rr = lane >> 4, cg = lane & 15, rg = rq * 4 + wid;
        const size_t voff = base + rg * 4 + rr;
        f32x2 s01 = {0.f, 0.f}, s23 = {0.f, 0.f};
        for (int c = 0; c < NCH; ++c) {
            if (wid >= 4) {
                if (c >= 1 && tid - 256 < 64) { const int id = tid - 256;
                    *(u32x4*)(yb + base + (size_t)((c - 1) * R3_CH + (id >> 1)) * DM + rq * 16 + (id & 1) * 8) = *(const u32x4*)(ystage + ((c - 1) & 1) * 512 + (id >> 1) * 16 + (id & 1) * 8); }
                if (c + 2 < NCH) r3_stage_raw(str, vb, base, rq * 16, (c + 2) * R3_CH, smem + ((c + 2) % 3) * R3_BUF, tid - 256);
                if (c + 1 < NCH) { char* bq = smem + ((c + 1) % 3) * R3_BUF; float* w = (float*)bq + R3_STR / 4 + lane; const int p = wid - 4;
                    float G = 1.f; for (int t = 0; t < 8 * p; ++t) G *= w[t * 64];
                    float* r = (float*)bq + lane; float* k = r + 2 * (R3_STR / 4); float* q = r + 3 * (R3_STR / 4); float* a = r + 4 * (R3_STR / 4);
#pragma unroll
                    for (int u = 0; u < 8; ++u) { const int t = 8 * p + u; const float Gold = G; G *= w[t * 64]; const float inv = rcpf_(G); r[t * 64] *= G; q[t * 64] *= Gold; k[t * 64] *= inv; a[t * 64] *= inv; }
                    if (p == 3) gcarea[((c + 1) % 3) * 64 + lane] = G; }
            } else {
                const char* buf = smem + (c % 3) * R3_BUF;
                f32x4 R_[2][2], K_[2][2], Q_[2][2], A_[2][2]; float V_[2][2];
#define R3_LD(bf, t0) { _Pragma("unroll") for (int u = 0; u < 2; ++u) { const char* p = buf + ((t0) + u) * 256 + cg * 16; \
                    R_[bf][u] = *(const f32x4*)p; K_[bf][u] = *(const f32x4*)(p + 2 * R3_STR); Q_[bf][u] = *(const f32x4*)(p + 3 * R3_STR); A_[bf][u] = *(const f32x4*)(p + 4 * R3_STR); \
                    V_[bf][u] = *(const float*)(buf + 5 * R3_STR + ((t0) + u) * 64 + (wid * 4 + rr) * 4); } }
#define R3_CP(bf, sl) { _Pragma("unroll") for (int u = 0; u < 2; ++u) { \
                    const f32x4 R = R_[bf][u], K = K_[bf][u], Q = Q_[bf][u], A = A_[bf][u]; const float vv = V_[bf][u]; \
                    const f32x2 r01 = {R[0], R[1]}, r23 = {R[2], R[3]}, k01 = {K[0], K[1]}, k23 = {K[2], K[3]}; \
                    const f32x2 q01 = {Q[0], Q[1]}, q23 = {Q[2], Q[3]}, a01 = {A[0], A[1]}, a23 = {A[2], A[3]}; \
                    const f32x2 pq = s01 * q01 + s23 * q23; \
                    const float sa = -row16_sum(pq.x + pq.y); \
                    const f32x2 sa2 = {sa, sa}, vv2 = {vv, vv}; \
                    s01 = (s01 + vv2 * k01) + sa2 * a01; s23 = (s23 + vv2 * k23) + sa2 * a23; \
                    const f32x2 py = s01 * r01 + s23 * r23; \
                    const float y = row16_sum(py.x + py.y); \
                    yv = (cg == (sl) + u) ? y : yv; } }
                R3_LD(0, 0)
#pragma unroll 1
                for (int t8 = 0; t8 < R3_CH; t8 += 8) {
                    float yv = 0.f;
                    R3_LD(1, t8 + 2)
                    R3_CP(0, 0)
                    R3_LD(0, t8 + 4)
                    R3_CP(1, 2)
                    R3_LD(1, t8 + 6)
                    R3_CP(0, 4)
                    if (t8 + 8 < R3_CH) R3_LD(0, t8 + 8)
                    R3_CP(1, 6)
                    if (cg < 8) ystage[(c & 1) * 512 + (t8 + cg) * 16 + wid * 4 + rr] = f2bf(yv);
                }
#undef R3_LD
#undef R3_CP
                const f32x4 GC = *(const f32x4*)(gcarea + (c % 3) * 64 + cg * 4);
                s01 *= (f32x2){GC[0], GC[1]}; s23 *= (f32x2){GC[2], GC[3]};
            }
            __syncthreads();
        }
        if (wid >= 4 && tid - 256 < 64) { const int id = tid - 256;
            *(u32x4*)(yb + base + (size_t)((NCH - 1) * R3_CH + (id >> 1)) * DM + rq * 16 + (id & 1) * 8) = *(const u32x4*)(ystage + ((NCH - 1) & 1) * 512 + (id >> 1) * 16 + (id & 1) * 8); }
        __syncthreads();
    }
}
constexpr int RC_NP = 8, RC_SLOT = 18688, RC_LDS = 18688;
constexpr int RC_QT = 0, RC_RR = 4096, RC_BG = 8192, RC_AB = 12288, RC_D0 = 14336, RC_U0 = 16384, RC_Y0 = 17408, RC_G = 18432;
#define R3C_FENCE() asm volatile("" ::: "memory")
constexpr int RC_P = 144;
DEV bf16x8 r3c_permfrag(const char* rowp, int q) {
    const u32x2 lo = *(const u32x2*)(rowp + 8 * q), hi = *(const u32x2*)(rowp + 32 + 8 * q);
    u32x4 w; w.x = lo.x; w.y = lo.y; w.z = hi.x; w.w = hi.y; return __builtin_bit_cast(bf16x8, w);
}
DEV bf16x8 r3c_neg(bf16x8 a) { u32x4 w = __builtin_bit_cast(u32x4, a); w.x ^= 0x80008000u; w.y ^= 0x80008000u; w.z ^= 0x80008000u; w.w ^= 0x80008000u; return __builtin_bit_cast(bf16x8, w); }
DEV u32x4 r3c_scale8(u32x4 d, f32x4 a, f32x4 b) {
    u32x4 o; o.x = cvt_pk(bf_lo(d.x) * a[0], bf_hi(d.x) * a[1]); o.y = cvt_pk(bf_lo(d.y) * a[2], bf_hi(d.y) * a[3]);
    o.z = cvt_pk(bf_lo(d.z) * b[0], bf_hi(d.z) * b[1]); o.w = cvt_pk(bf_lo(d.w) * b[2], bf_hi(d.w) * b[3]); return o;
}
DEV u32x2 r3c_pk4(f32x4 v) { u32x2 w; w.x = cvt_pk(v[0], v[1]); w.y = cvt_pk(v[2], v[3]); return w; }
DEV f32x4 r3c_up4(u32x2 w) { f32x4 v; v[0] = bf_lo(w.x); v[1] = bf_hi(w.x); v[2] = bf_lo(w.y); v[3] = bf_hi(w.y); return v; }
#define R3C_SCORE(dst, A, B, ROWLESS, STRICT) { _Pragma("unroll") for (int a = 0; a < 2; ++a) { _Pragma("unroll") for (int b = 0; b < 2; ++b) { \
        f32x4 a_ = MFMA(A[a][0], B[b][0], z4); a_ = MFMA(A[a][1], B[b][1], a_); \
        _Pragma("unroll") for (int r = 0; r < 4; ++r) { const int row_ = 16 * a + 4 * q + r, col_ = 16 * b + m; const int lo_ = (ROWLESS) ? row_ : col_, hi_ = (ROWLESS) ? col_ : row_; \
            const bool keep_ = (STRICT) ? (lo_ < hi_) : (lo_ <= hi_); a_[r] = keep_ ? a_[r] : 0.f; } \
        dst[a][b] = a_; } } }
template <bool PERM> DEV bf16x8 r3c_ident(int x, int m, int q) {
    u32x4 w = {0u, 0u, 0u, 0u};
#pragma unroll
    for (int jj = 0; jj < 8; ++jj) { const unsigned one = 0x3F80u << ((jj & 1) * 16); const int k = PERM ? ((jj < 4) ? 4 * q + jj : 16 + 4 * q + jj - 4) : 8 * q + jj; const unsigned v = (k == 16 * x + m) ? one : 0u;
        if ((jj >> 1) == 0) w.x |= v; else if ((jj >> 1) == 1) w.y |= v; else if ((jj >> 1) == 2) w.z |= v; else w.w |= v; }
    return __builtin_bit_cast(bf16x8, w);
}
struct R3Raw { u32x4 dr[4], dw[4], dk[4], dq[4], da[4]; bf16x8 vfrag; };
DEV void r3c_load(R3Raw& W, const bf16_t* rb, const bf16_t* wb, const bf16_t* kkb, const bf16_t* vb, int vrow0, int lane) {
    const int m = lane & 15, q = lane >> 4, tr = lane >> 3, j = lane & 7;
#pragma unroll
    for (int s = 0; s < 4; ++s) { const unsigned o = (unsigned)(((8 * s + tr) * DM + j * 8) * 2);
        W.dw[s] = *(const u32x4*)((const char*)wb + o); W.dr[s] = *(const u32x4*)((const char*)rb + o); W.dq[s] = *(const u32x4*)((const char*)kkb + o); }
    unsigned e[8];
#pragma unroll
    for (int jj = 0; jj < 8; ++jj) { const int t = (jj < 4) ? 4 * q + jj : 16 + 4 * q + jj - 4; e[jj] = *(const bf16_t*)((const char*)vb + (unsigned)((t * DM + vrow0 + m) * 2)); }
    u32x4 w; w.x = e[0] | (e[1] << 16); w.y = e[2] | (e[3] << 16); w.z = e[4] | (e[5] << 16); w.w = e[6] | (e[7] << 16); W.vfrag = __builtin_bit_cast(bf16x8, w);
}
DEV void r3c_load2(R3Raw& W, const bf16_t* kb, const bf16_t* kab, int lane) {
    const int tr = lane >> 3, j = lane & 7;
#pragma unroll
    for (int s = 0; s < 4; ++s) { const unsigned o = (unsigned)(((8 * s + tr) * DM + j * 8) * 2); W.dk[s] = *(const u32x4*)((const char*)kb + o); W.da[s] = *(const u32x4*)((const char*)kab + o); }
}
DEV void r3c_produce(R3Raw& W, const bf16_t* kb, const bf16_t* kab, char* lds, int lane) {
    const int m = lane & 15, q = lane >> 4, tr = lane >> 3, j = lane & 7;
    r3c_load2(W, kb, kab, lane);
    const f32x4 z4 = {0.f, 0.f, 0.f, 0.f};
    char* Rh = lds; char* Qh = lds + 32 * RC_P; char* Kh = lds + 64 * RC_P; char* Bh = lds + 96 * RC_P; float* G31a = (float*)(lds + 128 * RC_P);
    float* Gb = (float*)Kh;
    const bf16x8 vfrag = W.vfrag;
#pragma unroll
    for (int s = 0; s < 4; ++s) { float* gp = Gb + (8 * s + tr) * 64 + 8 * j; f32x4 a, b; const u32x4 d = W.dw[s];
        a[0] = bf_lo(d.x); a[1] = bf_hi(d.x); a[2] = bf_lo(d.y); a[3] = bf_hi(d.y); b[0] = bf_lo(d.z); b[1] = bf_hi(d.z); b[2] = bf_lo(d.w); b[3] = bf_hi(d.w);
        *(f32x4*)gp = a; *(f32x4*)(gp + 4) = b; }
    R3C_FENCE();
    { float g[32];
#pragma unroll
      for (int t = 0; t < 32; ++t) g[t] = Gb[t * 64 + lane];
      float G = 1.f;
#pragma unroll
      for (int t = 0; t < 32; ++t) { G *= g[t]; Gb[t * 64 + lane] = G; }
      G31a[lane] = G; }
    R3C_FENCE();
    { u32x4 kh[4], bh[4];
#pragma unroll
      for (int s = 0; s < 4; ++s) { const int t = 8 * s + tr, tp = t > 0 ? t - 1 : 0;
          const f32x4 g0 = *(const f32x4*)(Gb + t * 64 + 8 * j), g1 = *(const f32x4*)(Gb + t * 64 + 8 * j + 4);
          f32x4 p0 = *(const f32x4*)(Gb + tp * 64 + 8 * j), p1 = *(const f32x4*)(Gb + tp * 64 + 8 * j + 4);
          if (t == 0) { p0 = (f32x4){1.f, 1.f, 1.f, 1.f}; p1 = p0; }
          f32x4 i0, i1;
#pragma unroll
          for (int e = 0; e < 4; ++e) { i0[e] = rcpf_(g0[e]); i1[e] = rcpf_(g1[e]); }
          *(u32x4*)(Rh + t * RC_P + j * 16) = r3c_scale8(W.dr[s], g0, g1);
          *(u32x4*)(Qh + t * RC_P + j * 16) = r3c_scale8(W.dq[s], p0, p1);
          kh[s] = r3c_scale8(W.dk[s], i0, i1); bh[s] = r3c_scale8(W.da[s], i0, i1); }
      R3C_FENCE();
#pragma unroll
      for (int s = 0; s < 4; ++s) { const int t = 8 * s + tr; *(u32x4*)(Kh + t * RC_P + j * 16) = kh[s]; *(u32x4*)(Bh + t * RC_P + j * 16) = bh[s]; } }
    R3C_FENCE();
    bf16x8 Qa[2][2], Ra[2][2], Kb[2][2], Bb[2][2];
#pragma unroll
    for (int x = 0; x < 2; ++x)
#pragma unroll
        for (int ks = 0; ks < 2; ++ks) { const int off = (16 * x + m) * RC_P + (32 * ks + 8 * q) * 2;
            Qa[x][ks] = *(const bf16x8*)(Qh + off); Ra[x][ks] = *(const bf16x8*)(Rh + off); Kb[x][ks] = *(const bf16x8*)(Kh + off); Bb[x][ks] = *(const bf16x8*)(Bh + off); }
    f32x4 Tt[2][2], PN[2][2], PT[2][2], Z[2][5];
    R3C_SCORE(Tt, Kb, Qa, true, true)
    Z[0][4] = MFMA(pack8(Tt[0][0], Tt[1][0]), vfrag, z4); Z[1][4] = MFMA(pack8(Tt[0][1], Tt[1][1]), vfrag, z4);
    R3C_SCORE(Tt, Kb, Ra, true, false)
    u32x2 oY0[2]; oY0[0] = r3c_pk4(MFMA(pack8(Tt[0][0], Tt[1][0]), vfrag, z4)); oY0[1] = r3c_pk4(MFMA(pack8(Tt[0][1], Tt[1][1]), vfrag, z4));
    R3C_SCORE(Tt, Bb, Ra, true, false)
    bf16x8 oAB[2]; oAB[0] = r3c_neg(pack8(Tt[0][0], Tt[1][0])); oAB[1] = r3c_neg(pack8(Tt[0][1], Tt[1][1]));
    R3C_SCORE(PN, Qa, Bb, false, true)
    R3C_SCORE(PT, Bb, Qa, true, true)
#pragma unroll
    for (int mt = 0; mt < 2; ++mt)
#pragma unroll
        for (int n = 0; n < 4; ++n) Z[mt][n] = MFMA(Qa[mt][n >> 1], r3c_ident<false>(n & 1, m, q), z4);
#pragma unroll
    for (int lev = 0; lev < 5; ++lev) {
        bf16x8 fa[2], fb[2], zb[5];
#pragma unroll
        for (int x = 0; x < 2; ++x) { fa[x] = pack8(PT[0][x], PT[1][x]); fb[x] = pack8(PN[0][x], PN[1][x]); }
#pragma unroll
        for (int n = 0; n < 5; ++n) zb[n] = pack8(Z[0][n], Z[1][n]);
        const bf16x8 a0 = lev == 0 ? r3c_neg(fa[0]) : fa[0], a1 = lev == 0 ? r3c_neg(fa[1]) : fa[1];
#pragma unroll
        for (int n = 0; n < 5; ++n) { Z[0][n] = MFMA(a0, zb[n], Z[0][n]); Z[1][n] = MFMA(a1, zb[n], Z[1][n]); }
        if (lev < 4) {
#pragma unroll
            for (int a = 0; a < 2; ++a)
#pragma unroll
                for (int b = 0; b < 2; ++b) { PN[a][b] = MFMA(fa[a], fb[b], z4); PT[a][b] = MFMA(fb[a], fa[b], z4); }
        }
    }
    bf16x8 oQT[4], oRR[4], oBG[4]; u32x2 oD0[4];
    { f32x4 ZT[4][2];
      const bf16x8 Ip0 = r3c_ident<true>(0, m, q), Ip1 = r3c_ident<true>(1, m, q);
#pragma unroll
      for (int a = 0; a < 4; ++a) { const bf16x8 zf = pack8(Z[0][a], Z[1][a]); ZT[a][0] = MFMA(zf, Ip0, z4); ZT[a][1] = MFMA(zf, Ip1, z4); }
#pragma unroll
      for (int mt = 0; mt < 2; ++mt)
#pragma unroll
          for (int ks = 0; ks < 2; ++ks) oQT[mt * 2 + ks] = pack8(ZT[2 * ks][mt], ZT[2 * ks + 1][mt]); }
#pragma unroll
    for (int mt = 0; mt < 2; ++mt)
#pragma unroll
        for (int ks = 0; ks < 2; ++ks) oRR[mt * 2 + ks] = r3c_permfrag(Rh + (16 * mt + m) * RC_P + ks * 64, q);
    { bf16x8 Kf[2][2], Bf[2][2], Inat[2]; Inat[0] = r3c_ident<false>(0, m, q); Inat[1] = r3c_ident<false>(1, m, q);
#pragma unroll
      for (int x = 0; x < 2; ++x)
#pragma unroll
          for (int ks = 0; ks < 2; ++ks) { const int off = (16 * x + m) * RC_P + (32 * ks + 8 * q) * 2; Kf[x][ks] = *(const bf16x8*)(Kh + off); Bf[x][ks] = *(const bf16x8*)(Bh + off); }
#pragma unroll
      for (int ct = 0; ct < 4; ++ct) { const float g = G31a[16 * ct + m];
          const f32x4 k0 = MFMA(Kf[0][ct >> 1], Inat[ct & 1], z4) * g, k1 = MFMA(Kf[1][ct >> 1], Inat[ct & 1], z4) * g;
          const f32x4 b0 = MFMA(Bf[0][ct >> 1], Inat[ct & 1], z4) * -g, b1 = MFMA(Bf[1][ct >> 1], Inat[ct & 1], z4) * -g;
          oBG[ct] = pack8(b0, b1);
          oD0[ct] = r3c_pk4(MFMA(pack8(k0, k1), vfrag, z4)); } }
    asm volatile("s_waitcnt lgkmcnt(0)" ::: "memory");
#pragma unroll
    for (int f = 0; f < 4; ++f) { *(bf16x8*)(lds + RC_QT + f * 1024 + lane * 16) = oQT[f]; *(bf16x8*)(lds + RC_RR + f * 1024 + lane * 16) = oRR[f]; *(bf16x8*)(lds + RC_BG + f * 1024 + lane * 16) = oBG[f];
        *(u32x2*)(lds + RC_D0 + f * 512 + lane * 8) = oD0[f]; }
#pragma unroll
    for (int f = 0; f < 2; ++f) { *(bf16x8*)(lds + RC_AB + f * 1024 + lane * 16) = oAB[f]; *(u32x2*)(lds + RC_U0 + f * 512 + lane * 8) = r3c_pk4(Z[f][4]); *(u32x2*)(lds + RC_Y0 + f * 512 + lane * 8) = oY0[f]; }
    R3C_FENCE();
}
DEV void r3c_walk(f32x4 (&S)[4], char* slot, int lane) {
    const int q = lane >> 4;
    bf16x8 QT[2][2], BG[4]; u32x2 D0[4], U0[2]; f32x4 Gv[4];
#pragma unroll
    for (int f = 0; f < 4; ++f) { QT[f >> 1][f & 1] = *(const bf16x8*)(slot + RC_QT + f * 1024 + lane * 16); BG[f] = *(const bf16x8*)(slot + RC_BG + f * 1024 + lane * 16);
        D0[f] = *(const u32x2*)(slot + RC_D0 + f * 512 + lane * 8); Gv[f] = *(const f32x4*)(slot + RC_G + (16 * f + 4 * q) * 4); }
#pragma unroll
    for (int f = 0; f < 2; ++f) U0[f] = *(const u32x2*)(slot + RC_U0 + f * 512 + lane * 8);
    const bf16x8 sB0 = pack8(S[0], S[1]), sB1 = pack8(S[2], S[3]);
    f32x4 U[2];
#pragma unroll
    for (int mt = 0; mt < 2; ++mt) { U[mt] = r3c_up4(U0[mt]); U[mt] = MFMA(QT[mt][0], sB0, U[mt]); U[mt] = MFMA(QT[mt][1], sB1, U[mt]); }
    const bf16x8 uB = pack8(U[0], U[1]);
#pragma unroll
    for (int ct = 0; ct < 4; ++ct) { S[ct] = S[ct] * Gv[ct] + r3c_up4(D0[ct]); S[ct] = MFMA(BG[ct], uB, S[ct]); }
    R3C_FENCE();
    *(bf16x8*)(slot + RC_QT + lane * 16) = sB0; *(bf16x8*)(slot + RC_QT + 1024 + lane * 16) = sB1; *(bf16x8*)(slot + RC_QT + 2048 + lane * 16) = uB;
    R3C_FENCE();
}
DEV void r3c_yout(const char* slot, bf16_t* yout, int lane) {
    const int m = lane & 15, q = lane >> 4;
    const bf16x8 sB0 = *(const bf16x8*)(slot + RC_QT + lane * 16), sB1 = *(const bf16x8*)(slot + RC_QT + 1024 + lane * 16), uB = *(const bf16x8*)(slot + RC_QT + 2048 + lane * 16);
#pragma unroll
    for (int mt = 0; mt < 2; ++mt) {
        f32x4 Y = r3c_up4(*(const u32x2*)(slot + RC_Y0 + mt * 512 + lane * 8));
        Y = MFMA(*(const bf16x8*)(slot + RC_RR + (mt * 2) * 1024 + lane * 16), sB0, Y); Y = MFMA(*(const bf16x8*)(slot + RC_RR + (mt * 2 + 1) * 1024 + lane * 16), sB1, Y);
        Y = MFMA(*(const bf16x8*)(slot + RC_AB + mt * 1024 + lane * 16), uB, Y);
#pragma unroll
        for (int r = 0; r < 4; ++r) *(bf16_t*)((char*)yout + (unsigned)(((16 * mt + 4 * q + r) * DM + m) * 2)) = f2bf(Y[r]); }
    R3C_FENCE();
}
DEV void phase_r3c(const bf16_t* rb, const bf16_t* wb, const bf16_t* kb, const bf16_t* kkb, const bf16_t* kab, const bf16_t* vb, bf16_t* yb, char* smem) {
    const int tid = tidx(), lane = tid & 63, wid = __builtin_amdgcn_readfirstlane(tid >> 6);
    constexpr int NCH = SEQ / 32, NR = NCH / RC_NP;
    for (int task = blockIdx.x; task < 256; task += gridDim.x) {
        const int xc = task & 7, ix = task >> 3, bh = xc * 8 + (ix >> 2), b = bh >> 4, h = bh & 15, rq = ix & 3;
        const size_t base = (size_t)b * SEQ * DM + h * 64;
        f32x4 S[4];
#pragma unroll
        for (int ct = 0; ct < 4; ++ct) S[ct] = (f32x4){0.f, 0.f, 0.f, 0.f};
        R3Raw W; { const size_t ub = base + (size_t)(wid * 32) * DM; r3c_load(W, rb + ub, wb + ub, kkb + ub, vb + ub, rq * 16, lane); }
        for (int rd = 0; rd < NR; ++rd) {
            const size_t ub = base + (size_t)((rd * RC_NP + wid) * 32) * DM;
            r3c_produce(W, kb + ub, kab + ub, smem + wid * RC_LDS, tidx() & 63);
            if (rd + 1 < NR) { const size_t un = ub + (size_t)(RC_NP * 32) * DM; r3c_load(W, rb + un, wb + un, kkb + un, vb + un, rq * 16, tidx() & 63); }
            asm volatile("s_waitcnt lgkmcnt(0)" ::: "memory");
            __syncthreads();
            if (wid == 0) {
#pragma unroll 1
                for (int p = 0; p < RC_NP; ++p) r3c_walk(S, smem + p * RC_LDS, tidx() & 63);
                asm volatile("s_waitcnt lgkmcnt(0)" ::: "memory");
            }
            __syncthreads();
            r3c_yout(smem + wid * RC_LDS, yb + ub + rq * 16, tidx() & 63);
        }
    }
}
DEV void phase_r4(const bf16_t* hid, const bf16_t* G2T, const RwkvW& W, const bf16_t* yb, const bf16_t* vb, const float* bsc, bf16_t* outb, char* smem) {
    const LaneId L = lane_id();
    const int ntn = 8, nunits = (T / 256) * ntn;
    for (int u = blockIdx.x; u < nunits; u += gridDim.x) {
        const int tm = u / ntn, tn = u % ntn;
        f32x4 acc[4][4];
        gemm_core(acc, LdPlain{hid + (size_t)tm * 256 * HIDP + 128, HIDP}, LdPlain{G2T + (size_t)tn * 128 * 128, 128}, 128, smem);
        const int head = tn * 2 + L.wn;
#pragma unroll
        for (int m = 0; m < 4; ++m) {
            const size_t row = (size_t)tm * 256 + L.wm * 64 + m * 16 + L.fr;
            f32x4 yv[4]; float s = 0.f;
#pragma unroll
            for (int n = 0; n < 4; ++n) { yv[n] = ld_bf4(yb + row * DM + head * 64 + n * 16 + L.fq * 4); s += (yv[n][0] + yv[n][1]) + (yv[n][2] + yv[n][3]); }
            s += __shfl_xor(s, 16); s += __shfl_xor(s, 32);
            const float mean = s * (1.0f / 64.0f); float q = 0.f;
#pragma unroll
            for (int n = 0; n < 4; ++n) { const f32x4 d = yv[n] - mean; q += (d[0] * d[0] + d[1] * d[1]) + (d[2] * d[2] + d[3] * d[3]); }
            q += __shfl_xor(q, 16); q += __shfl_xor(q, 32);
            const float rstd = rsqrtf(q * (1.0f / 64.0f) + 64e-5f);
            const float bs = bsc[row * 16 + head];
#pragma unroll
            for (int n = 0; n < 4; ++n) { const int col = head * 64 + n * 16 + L.fq * 4;
                const f32x4 lw = *(const f32x4*)(W.ln_w + col), lb = *(const f32x4*)(W.ln_b + col), vv = ld_bf4(vb + row * DM + col);
                f32x4 o = ((yv[n] - mean) * rstd * lw + lb + vv * bs);
                o = o * acc[m][n];
                st_bf4(outb + row * DM + col, o); }
        }
    }
}

struct NsaBuf { bf16_t *q, *kcmp, *vcmp, *kslc, *kwin, *vslcT, *vwinT, *hid, *kc, *vcT, *o; float* gates; };
DEV void phase_n1(const bf16_t* xn, const bf16_t* Bt, const NsaBuf& B, char* smem) {
    const LaneId L = lane_id();
    const int ntn = 15, nunits = (T / 256) * ntn;
    for (int u = blockIdx.x; u < nunits; u += gridDim.x) {
        const int tm = u / ntn, tn = u % ntn;
        f32x4 acc[4][4];
        gemm_core(acc, LdPlain{xn + (size_t)tm * 256 * DM, DM}, LdPlain{Bt + (size_t)tn * 128 * DM, DM}, DM, smem);
#pragma unroll
        for (int m = 0; m < 4; ++m)
#pragma unroll
            for (int n = 0; n < 4; ++n) {
                const size_t row = (size_t)tm * 256 + L.wm * 64 + m * 16 + L.fr; const int c = L.wn * 64 + n * 16 + L.fq * 4; f32x4 v = acc[m][n];
                if (tn < 8) st_bf4(B.q + row * DM + tn * 128 + c, v * 0.125f);
                else if (tn < 14) {
                    const int cc = tn - 8;
                    if (cc == 0) st_bf4(B.kcmp + row * 128 + c, v);
                    else if (cc == 1) st_bf4(B.vcmp + row * 128 + c, v);
                    else if (cc == 2) st_bf4(B.kslc + row * 128 + c, v);
                    else if (cc == 4) st_bf4(B.kwin + row * 128 + c, v);
                    else { bf16_t* dst = cc == 3 ? B.vslcT : B.vwinT; const int b = (int)(row >> 13), t = (int)(row & (SEQ - 1));
                        for (int j = 0; j < 4; ++j) dst[((size_t)(b * 128 + c + j)) * SEQ + t] = f2bf(v[j]); }
                } else { if (c < 48) { for (int j = 0; j < 4; ++j) B.gates[row * 48 + c + j] = sigmoidf_(v[j]); } }
            }
    }
}
DEV float gelu_tanh(float x) { const float u = 0.7978845608028654f * (x + 0.044715f * x * x * x); return 0.5f * x * (1.0f + tanhf(u)); }
DEV void phase_n2a(const bf16_t* W1T, const float* biasp, const NsaBuf& B, char* smem) {
    const LaneId L = lane_id();
    for (int u = blockIdx.x; u < 64; u += gridDim.x) {
        const int c = u >> 5, tm = (u >> 1) & 15, tn = u & 1;
        f32x4 acc[4][4];
        gemm_core(acc, LdCmp{c ? B.vcmp : B.kcmp, tm * 256}, LdPlain{W1T + (size_t)c * 256 * 2048 + (size_t)tn * 128 * 2048, 2048}, 2048, smem);
#pragma unroll
        for (int m = 0; m < 4; ++m)
#pragma unroll
            for (int n = 0; n < 4; ++n) { const size_t row = (size_t)tm * 256 + L.wm * 64 + m * 16 + L.fr; const int col = tn * 128 + L.wn * 64 + n * 16 + L.fq * 4;
                const f32x4 bb = *(const f32x4*)(biasp + c * 256 + col); f32x4 v;
                for (int j = 0; j < 4; ++j) v[j] = gelu_tanh(acc[m][n][j] + bb[j]);
                st_bf4(B.hid + ((size_t)c * 4096 + row) * 256 + col, v); }
    }
}
DEV void phase_n2b(const bf16_t* W2T, const NsaBuf& B, char* smem) {
    const LaneId L = lane_id();
    for (int u = blockIdx.x; u < 32; u += gridDim.x) {
        const int c = u >> 4, tm = u & 15;
        f32x4 acc[4][4];
        gemm_core(acc, LdPlain{B.hid + ((size_t)c * 4096 + tm * 256) * 256, 256}, LdPlain{W2T + (size_t)c * 128 * 256, 256}, 256, smem);
        if (L.wn == 0) {
#pragma unroll
            for (int m = 0; m < 4; ++m)
#pragma unroll
                for (int n = 0; n < 4; ++n) { const int row = tm * 256 + L.wm * 64 + m * 16 + L.fr, d = n * 16 + L.fq * 4;
                    const int b = row >> 10, nn = (row >> 1) & 511, g = row & 1;
                    if (c == 0) st_bf4(B.kc + ((size_t)((b * 2 + g) * 512 + nn)) * 64 + d, acc[m][n]);
                    else { for (int j = 0; j < 4; ++j) B.vcT[((size_t)((b * 2 + g) * 64 + d + j)) * 512 + nn] = f2bf(acc[m][n][j]); } }
        }
    }
}
#define NEGV (-1e30f)
#define LOG2E_ 1.4426950408889634f
DEV u32x4 n3_ldg(const bf16_t* kbase, long kpitch, const bf16_t* vbase, long vpitch, int kb, int tid) {
    if (tid < 256) return *(const u32x4*)(kbase + (size_t)(kb + (tid >> 3)) * kpitch + (tid & 7) * 8);
    const int i = tid - 256; return *(const u32x4*)(vbase + (size_t)(i >> 2) * vpitch + kb + (i & 3) * 8);
}
DEV void n3_sts(char* buf, u32x4 v, int tid) {
    if (tid < 256) { const int row = tid >> 3, c = tid & 7, sw = ((row >> 1) & 1) | (((row >> 3) & 3) << 1); *(u32x4*)(buf + row * 128 + ((c ^ sw) << 4)) = v; }
    else { const int i = tid - 256, d = i >> 2, c = i & 3; *(u32x4*)(buf + 4096 + d * 64 + ((c ^ ((d >> 2) & 3)) << 4)) = v; }
}
DEV void phase_n3(const NsaBuf& B, char* smem) {
    const int tid = tidx(), lane = tid & 63, wid = tid >> 6, m = lane & 15, fq = lane >> 4, qh = m >> 3, hh = m & 7;
    float* psum = (float*)(smem + wid * 8704); int* ulist = (int*)(smem + wid * 8704 + 8192);
    char* stg = smem + 8 * 8704;
    const int kperm = 8 * (m >> 2) + (m & 3);
    const int kswz = ((m >> 1) & 1) | ((m >> 2) << 1), vswz = (m >> 2) & 3;
    const int koffA = kperm * 128, koffB = (kperm + 4) * 128, voff = 4096 + m * 64 + ((fq ^ vswz) << 4);
    const f32x4 z4 = {0.f, 0.f, 0.f, 0.f};
    const int nrank = (int)gridDim.x >> 3, bg = (int)blockIdx.x & 7;
    for (int qblk = (int)blockIdx.x >> 3; qblk < 256 && (int)blockIdx.x < nrank * 8; qblk += nrank) {
        const int g = bg & 1, b = bg >> 1, t0b = qblk * 32, t0 = t0b + wid * 4;
        int tq[2]; bf16x8 qf[2][2]; float gc[2], gs[2], gw[2]; u32x2 opk[2][4];
#pragma unroll
        for (int rb = 0; rb < 2; ++rb) {
            tq[rb] = t0 + rb * 2 + qh;
            const bf16_t* qp = B.q + ((size_t)(b * SEQ + tq[rb])) * DM + (g * 8 + hh) * 64 + fq * 8;
            qf[rb][0] = __builtin_nontemporal_load((const bf16x8*)qp); qf[rb][1] = __builtin_nontemporal_load((const bf16x8*)(qp + 32));
            const float* gp = B.gates + ((size_t)(b * SEQ + tq[rb])) * 48 + g * 24 + hh * 3;
            gc[rb] = gp[0]; gs[rb] = gp[1]; gw[rb] = gp[2];
        }
#define N3_KFRAGS(buf) const bf16x8 kA0 = *(const bf16x8*)((buf) + koffA + (((0 + fq) ^ kswz) << 4)), kA1 = *(const bf16x8*)((buf) + koffA + (((4 + fq) ^ kswz) << 4)), \
                                    kB0 = *(const bf16x8*)((buf) + koffB + (((0 + fq) ^ kswz) << 4)), kB1 = *(const bf16x8*)((buf) + koffB + (((4 + fq) ^ kswz) << 4));
        {
            const int tid = tidx(), lane = tid & 63, m = lane & 15, fq = (lane >> 4), qh = m >> 3, hh = m & 7, kperm = 8 * (m >> 2) + (m & 3); (void)hh; (void)qh; (void)lane;
            const int kswz = ((m >> 1) & 1) | ((m >> 2) << 1), vswz = (m >> 2) & 3, koffA = kperm * 128, koffB = (kperm + 4) * 128, voff = 4096 + m * 64 + ((fq ^ vswz) << 4);
            int nv[2];
#pragma unroll
            for (int rb = 0; rb < 2; ++rb) nv[rb] = tq[rb] >= 31 ? ((tq[rb] - 31) >> 4) + 1 : 0;
            const int nvmax = (t0b + 31 >= 31) ? ((t0b + 31 - 31) >> 4) + 1 : 0, ngrp = (nvmax + 31) >> 5;
#pragma unroll
            for (int i = 0; i < 32; ++i) psum[lane + 64 * i] = 0.f;
            const bf16_t* kcb = B.kc + (size_t)((b * 2 + g) * 512) * 64; const bf16_t* vcb = B.vcT + (size_t)((b * 2 + g) * 64) * 512;
            float mx[2] = {NEGV, NEGV}, l[2] = {0.f, 0.f};
            u32x4 stv;
            if (ngrp > 0) { stv = n3_ldg(kcb, 64, vcb, 512, 0, tid); n3_sts(stg, stv, tid); }
            __syncthreads();
            for (int grp = 0; grp < ngrp; ++grp) {
                const int kb = grp * 32; const bool more = grp + 1 < ngrp;
                if (more) stv = n3_ldg(kcb, 64, vcb, 512, kb + 32, tid);
                const char* buf = stg + (grp & 1) * 8192;
                N3_KFRAGS(buf)
#pragma unroll
                for (int rb = 0; rb < 2; ++rb) {
                    f32x4 sA = MFMA(kA0, qf[rb][0], z4); sA = MFMA(kA1, qf[rb][1], sA);
                    f32x4 sB = MFMA(kB0, qf[rb][0], z4); sB = MFMA(kB1, qf[rb][1], sB);
                    const bool full = kb + 32 <= nv[rb], part = !full && kb < nv[rb];
                    if (__ballot(part) == 0ull) {
                        const float m8 = fmaxf(fmaxf(fmaxf(sA[0], sA[1]), fmaxf(sA[2], sA[3])), fmaxf(fmaxf(sB[0], sB[1]), fmaxf(sB[2], sB[3])));
                        const float mn = fmaxf(mx[rb], full ? m8 : NEGV), tl = (full ? mn : 1e30f) * LOG2E_; float add = 0.f;
#pragma unroll
                        for (int j = 0; j < 4; ++j) add += __builtin_amdgcn_exp2f(fmaf(sA[j], LOG2E_, -tl)) + __builtin_amdgcn_exp2f(fmaf(sB[j], LOG2E_, -tl));
                        l[rb] = l[rb] * __expf(mx[rb] - mn) + add; mx[rb] = mn;
                    } else {
                    float gm = NEGV;
#pragma unroll
                    for (int j = 0; j < 4; ++j) { if (kb + 8 * fq + j < nv[rb]) gm = fmaxf(gm, sA[j]); if (kb + 8 * fq + 4 + j < nv[rb]) gm = fmaxf(gm, sB[j]); }
                    const float mn = fmaxf(mx[rb], gm); float add = 0.f;
#pragma unroll
                    for (int j = 0; j < 4; ++j) { if (kb + 8 * fq + j < nv[rb]) add += __expf(sA[j] - mn); if (kb + 8 * fq + 4 + j < nv[rb]) add += __expf(sB[j] - mn); }
                    l[rb] = l[rb] * __expf(mx[rb] - mn) + add; mx[rb] = mn;
                    }
                }
                if (more) n3_sts(stg + ((grp + 1) & 1) * 8192, stv, tid);
                __syncthreads();
            }
            float M[2], inv[2];
#pragma unroll
            for (int rb = 0; rb < 2; ++rb) {
                float Mx = fmaxf(mx[rb], __shfl_xor(mx[rb], 16)); Mx = fmaxf(Mx, __shfl_xor(Mx, 32));
                float ll = l[rb] * __expf(mx[rb] - Mx); ll += __shfl_xor(ll, 16); ll += __shfl_xor(ll, 32);
                M[rb] = Mx; inv[rb] = ll > 0.f ? 1.0f / ll : 0.f;
            }
            f32x4 oc[2][4];
#pragma unroll
            for (int rb = 0; rb < 2; ++rb)
#pragma unroll
                for (int d = 0; d < 4; ++d) oc[rb][d] = z4;
            if (ngrp > 0) { stv = n3_ldg(kcb, 64, vcb, 512, 0, tid); n3_sts(stg, stv, tid); }
            __syncthreads();
            for (int grp = 0; grp < ngrp; ++grp) {
                const int kb = grp * 32; const bool more = grp + 1 < ngrp;
                if (more) stv = n3_ldg(kcb, 64, vcb, 512, kb + 32, tid);
                const char* buf = stg + (grp & 1) * 8192;
                N3_KFRAGS(buf)
                bf16x8 vf[4];
#pragma unroll
                for (int d = 0; d < 4; ++d) vf[d] = *(const bf16x8*)(buf + voff + d * 1024);
#pragma unroll
                for (int rb = 0; rb < 2; ++rb) {
                    f32x4 sA = MFMA(kA0, qf[rb][0], z4); sA = MFMA(kA1, qf[rb][1], sA);
                    f32x4 sB = MFMA(kB0, qf[rb][0], z4); sB = MFMA(kB1, qf[rb][1], sB);
                    f32x4 pA, pB;
                    const bool full = kb + 32 <= nv[rb], part = !full && kb < nv[rb];
                    if (__ballot(part) == 0ull) {
                        const float tl = (full ? M[rb] : 1e30f) * LOG2E_;
#pragma unroll
                        for (int j = 0; j < 4; ++j) { pA[j] = __builtin_amdgcn_exp2f(fmaf(sA[j], LOG2E_, -tl)) * inv[rb]; pB[j] = __builtin_amdgcn_exp2f(fmaf(sB[j], LOG2E_, -tl)) * inv[rb]; }
                    } else {
#pragma unroll
                    for (int j = 0; j < 4; ++j) { pA[j] = (kb + 8 * fq + j < nv[rb]) ? __expf(sA[j] - M[rb]) * inv[rb] : 0.f; pB[j] = (kb + 8 * fq + 4 + j < nv[rb]) ? __expf(sB[j] - M[rb]) * inv[rb] : 0.f; }
                    }
#pragma unroll
                    for (int j = 0; j < 4; ++j) {
                        float a = pA[j]; a += DPP_MOV(a, 0xB1); a += DPP_MOV(a, 0x4E); a += DPP_MOV(a, 0x141);
                        float c = pB[j]; c += DPP_MOV(c, 0xB1); c += DPP_MOV(c, 0x4E); c += DPP_MOV(c, 0x141);
                        if (hh == 0) { psum[(rb * 2 + qh) * 512 + kb + 8 * fq + j] = a; psum[(rb * 2 + qh) * 512 + kb + 8 * fq + 4 + j] = c; }
                    }
                    const bf16x8 pf = pack8(pA, pB);
#pragma unroll
                    for (int d = 0; d < 4; ++d) oc[rb][d] = MFMA(vf[d], pf, oc[rb][d]);
                }
                if (more) n3_sts(stg + ((grp + 1) & 1) * 8192, stv, tid);
                __syncthreads();
            }
#pragma unroll
            for (int rb = 0; rb < 2; ++rb)
#pragma unroll
                for (int d = 0; d < 4; ++d) { const f32x4 v = oc[rb][d] * gc[rb]; opk[rb][d].x = cvt_pk(v[0], v[1]); opk[rb][d].y = cvt_pk(v[2], v[3]); }
        }
        asm volatile("s_waitcnt lgkmcnt(0)" ::: "memory");
        __builtin_amdgcn_sched_barrier(0);
        unsigned long long mlo[4], mhi[4];
#pragma unroll
        for (int q2 = 0; q2 < 4; ++q2) {
            const int tqq = t0 + q2, cur = tqq >> 6;
            float sc[2];
#pragma unroll
            for (int c = 0; c < 2; ++c) { const int j = lane + 64 * c; float imp = 0.f;
                for (int n = 4 * j - 1; n <= 4 * j + 3; ++n) if (n >= 0) imp += psum[q2 * 512 + n];
                const bool causal = j * 64 <= tqq, forced = (j == 0) || (j == cur) || (j == cur - 1);
                sc[c] = causal ? imp + (forced ? 1e4f : 0.f) : NEGV; }
            unsigned k0 = __float_as_uint(sc[0]), k1 = __float_as_uint(sc[1]);
            k0 = (k0 & 0x80000000u) ? ~k0 : (k0 | 0x80000000u); k1 = (k1 & 0x80000000u) ? ~k1 : (k1 | 0x80000000u);
            unsigned Tk = 0u;
            for (int bit = 31; bit >= 0; --bit) { const unsigned cand = Tk | (1u << bit);
                const int cnt = __popcll(__ballot(k0 >= cand)) + __popcll(__ballot(k1 >= cand)); if (cnt >= 16) Tk = cand; }
            const int ngt = __popcll(__ballot(k0 > Tk)) + __popcll(__ballot(k1 > Tk)), needn = 16 - ngt;
            const unsigned long long eq0 = __ballot(k0 == Tk), eq1 = __ballot(k1 == Tk), belowm = (1ull << lane) - 1ull;
            const bool s0 = (k0 > Tk) || (k0 == Tk && __popcll(eq0 & belowm) < needn);
            const bool s1 = (k1 > Tk) || (k1 == Tk && __popcll(eq0) + __popcll(eq1 & belowm) < needn);
            mlo[q2] = __ballot(s0); mhi[q2] = __ballot(s1);
        }
        int nun;
        {
            const unsigned long long ulo = mlo[0] | mlo[1] | mlo[2] | mlo[3], uhi = mhi[0] | mhi[1] | mhi[2] | mhi[3];
            const unsigned long long below = (1ull << lane) - 1ull; const int nlo = __popcll(ulo);
            if ((ulo >> lane) & 1ull) { const int mb = (int)((mlo[0] >> lane) & 1ull) | ((int)((mlo[1] >> lane) & 1ull) << 1) | ((int)((mlo[2] >> lane) & 1ull) << 2) | ((int)((mlo[3] >> lane) & 1ull) << 3);
                ulist[__popcll(ulo & below)] = lane | (mb << 8); }
            if ((uhi >> lane) & 1ull) { const int mb = (int)((mhi[0] >> lane) & 1ull) | ((int)((mhi[1] >> lane) & 1ull) << 1) | ((int)((mhi[2] >> lane) & 1ull) << 2) | ((int)((mhi[3] >> lane) & 1ull) << 3);
                ulist[nlo + __popcll(uhi & below)] = (lane + 64) | (mb << 8); }
            nun = nlo + __popcll(uhi);
        }
        asm volatile("s_waitcnt lgkmcnt(0)" ::: "memory");
        __builtin_amdgcn_sched_barrier(0);
        {
            const int tid = tidx(), lane = tid & 63, m = lane & 15, fq = (lane >> 4), qh = m >> 3, hh = m & 7, kperm = 8 * (m >> 2) + (m & 3); (void)hh; (void)qh; (void)lane;
            const unsigned char* ksb = (const unsigned char*)B.kslc + (size_t)((b * 2 + g) * SEQ) * 64 + fq * 8; const unsigned char* vsb = (const unsigned char*)B.vslcT + (size_t)((b * 2 + g) * 128) * 4096 + m * 64 + 8 * fq;
            long q8[2][2];
#pragma unroll
            for (int rb = 0; rb < 2; ++rb)
#pragma unroll
                for (int ks = 0; ks < 2; ++ks) { const u32x4 w = __builtin_bit_cast(u32x4, qf[rb][ks]);
                    const unsigned lo = pack_fp8x4(bf_lo(w.x), bf_hi(w.x), bf_lo(w.y), bf_hi(w.y)), hi = pack_fp8x4(bf_lo(w.z), bf_hi(w.z), bf_lo(w.w), bf_hi(w.w));
                    q8[rb][ks] = (long)(((unsigned long long)hi << 32) | lo); }
            float mx[2] = {NEGV, NEGV}, l[2] = {0.f, 0.f}; f32x4 os[2][4];
#pragma unroll
            for (int rb = 0; rb < 2; ++rb)
#pragma unroll
                for (int d = 0; d < 4; ++d) os[rb][d] = z4;
            char* st8 = (char*)psum;
            const int srow = lane >> 2, sc0 = (lane & 3) * 2;
            u32x4 gk[4], gv[4];
            { const int blk0 = ulist[0] & 255; const unsigned char* kp = (const unsigned char*)B.kslc + ((size_t)((b * 2 + g) * SEQ) + blk0 * 64) * 64 + lane * 16; const unsigned char* vp = (const unsigned char*)B.vslcT + ((size_t)((b * 2 + g) * 128) + blk0) * 4096 + lane * 16;
#pragma unroll
              for (int i = 0; i < 4; ++i) { gk[i] = *(const u32x4*)(kp + i * 1024); gv[i] = *(const u32x4*)(vp + i * 1024); } }
            const int fsw = (m >> 2) << 1;
            for (int ib = 0; ib < nun; ++ib) {
                const int e = __builtin_amdgcn_readfirstlane(ulist[ib]);
#pragma unroll
                for (int i = 0; i < 4; ++i) { const int row = i * 16 + srow;
                    *(u32x4*)(st8 + row * 64 + ((sc0 ^ (((row >> 3) & 3) << 1)) << 3)) = gk[i];
                    *(u32x4*)(st8 + 4096 + row * 64 + ((sc0 ^ (((row >> 2) & 3) << 1)) << 3)) = gv[i]; }
                if (ib + 1 < nun) { const int blkn = ulist[ib + 1] & 255; const unsigned char* kp = (const unsigned char*)B.kslc + ((size_t)((b * 2 + g) * SEQ) + blkn * 64) * 64 + lane * 16; const unsigned char* vp = (const unsigned char*)B.vslcT + ((size_t)((b * 2 + g) * 128) + blkn) * 4096 + lane * 16;
#pragma unroll
                    for (int i = 0; i < 4; ++i) { gk[i] = *(const u32x4*)(kp + i * 1024); gv[i] = *(const u32x4*)(vp + i * 1024); } }
#pragma unroll
              for (int hf = 0; hf < 2; ++hf) {
                const int kb = (e & 255) * 64 + hf * 32;
                const char* kr = st8 + (hf * 32 + kperm) * 64;
                const long kA0 = *(const long*)(kr + ((fq ^ fsw) << 3)), kA1 = *(const long*)(kr + (((4 + fq) ^ fsw) << 3)), kB0 = *(const long*)(kr + 256 + ((fq ^ fsw) << 3)), kB1 = *(const long*)(kr + 256 + (((4 + fq) ^ fsw) << 3));
                long vf[4];
#pragma unroll
                for (int d = 0; d < 4; ++d) vf[d] = *(const long*)(st8 + 4096 + (d * 16 + m) * 64 + (((hf * 4 + fq) ^ fsw) << 3));
#pragma unroll
                for (int rb = 0; rb < 2; ++rb) {
                    if (((e >> (8 + rb * 2)) & 3) == 0) continue;
                    const bool mine = ((e >> (8 + rb * 2 + qh)) & 1) != 0;
                    f32x4 sA = MFMA8(kA0, q8[rb][0], z4); sA = MFMA8(kA1, q8[rb][1], sA);
                    f32x4 sB = MFMA8(kB0, q8[rb][0], z4); sB = MFMA8(kB1, q8[rb][1], sB);
                    const bool full = mine && kb + 31 <= tq[rb], part = mine && !full && kb <= tq[rb];
                    const bool fast = __ballot(part) == 0ull;
                    float gm = NEGV;
                    if (fast) { const float m8 = fmaxf(fmaxf(fmaxf(sA[0], sA[1]), fmaxf(sA[2], sA[3])), fmaxf(fmaxf(sB[0], sB[1]), fmaxf(sB[2], sB[3]))); gm = full ? m8 : NEGV; }
                    else {
#pragma unroll
                    for (int j = 0; j < 4; ++j) { if (mine && kb + 8 * fq + j <= tq[rb]) gm = fmaxf(gm, sA[j]); if (mine && kb + 8 * fq + 4 + j <= tq[rb]) gm = fmaxf(gm, sB[j]); }
                    }
                    if (__ballot(gm > mx[rb]) != 0ull) {
                        gm = fmaxf(gm, __shfl_xor(gm, 16)); gm = fmaxf(gm, __shfl_xor(gm, 32));
                        const float mn2 = fmaxf(mx[rb], gm), alpha = __expf(mx[rb] - mn2); mx[rb] = mn2; l[rb] *= alpha;
#pragma unroll
                        for (int d = 0; d < 4; ++d) os[rb][d] *= alpha;
                    }
                    const float mn = mx[rb];
                    f32x4 pA, pB; float add = 0.f;
                    if (fast) { const float tl = (full ? mn : 1e30f) * LOG2E_ - 7.f;
#pragma unroll
                        for (int j = 0; j < 4; ++j) { pA[j] = __builtin_amdgcn_exp2f(fmaf(sA[j], LOG2E_, -tl)); pB[j] = __builtin_amdgcn_exp2f(fmaf(sB[j], LOG2E_, -tl)); add += pA[j] + pB[j]; }
                    } else {
#pragma unroll
                    for (int j = 0; j < 4; ++j) { pA[j] = (mine && kb + 8 * fq + j <= tq[rb]) ? __expf(sA[j] - mn + 4.8520302639f) : 0.f; pB[j] = (mine && kb + 8 * fq + 4 + j <= tq[rb]) ? __expf(sB[j] - mn + 4.8520302639f) : 0.f; add += pA[j] + pB[j]; }
                    }
                    l[rb] += add;
                    const unsigned plo = pack_fp8x4(pA[0], pA[1], pA[2], pA[3]), phi = pack_fp8x4(pB[0], pB[1], pB[2], pB[3]);
                    const long pf = (long)(((unsigned long long)phi << 32) | plo);
#pragma unroll
                    for (int d = 0; d < 4; ++d) os[rb][d] = MFMA8(vf[d], pf, os[rb][d]);
                }
              }
            }
#pragma unroll
            for (int rb = 0; rb < 2; ++rb) {
                float ll = l[rb]; ll += __shfl_xor(ll, 16); ll += __shfl_xor(ll, 32);
                const float sc = ll > 0.f ? gs[rb] / ll : 0.f;
#pragma unroll
                for (int d = 0; d < 4; ++d) { f32x4 v = os[rb][d] * sc; v[0] += bf_lo(opk[rb][d].x); v[1] += bf_hi(opk[rb][d].x); v[2] += bf_lo(opk[rb][d].y); v[3] += bf_hi(opk[rb][d].y);
                    opk[rb][d].x = cvt_pk(v[0], v[1]); opk[rb][d].y = cvt_pk(v[2], v[3]); }
            }
        }
        __builtin_amdgcn_sched_barrier(0);
        {
            const int tid = tidx(), lane = tid & 63, m = lane & 15, fq = (lane >> 4), qh = m >> 3, hh = m & 7, kperm = 8 * (m >> 2) + (m & 3); (void)hh; (void)qh; (void)lane;
            const int kswz = ((m >> 1) & 1) | ((m >> 2) << 1), vswz = (m >> 2) & 3, koffA = kperm * 128, koffB = (kperm + 4) * 128, voff = 4096 + m * 64 + ((fq ^ vswz) << 4);
            const bf16_t* kwb = B.kwin + (size_t)b * SEQ * 128 + g * 64; const bf16_t* vwb = B.vwinT + (size_t)((b * 2 + g) * 64) * SEQ;
            float mx[2] = {NEGV, NEGV}, l[2] = {0.f, 0.f}; f32x4 ow[2][4];
#pragma unroll
            for (int rb = 0; rb < 2; ++rb)
#pragma unroll
                for (int d = 0; d < 4; ++d) ow[rb][d] = z4;
            const int lo = t0b - 511 > 0 ? t0b - 511 : 0, kb0 = lo & ~31, kbl = t0b + 31;
            u32x4 stv = n3_ldg(kwb, 128, vwb, SEQ, kb0, tid); n3_sts(stg, stv, tid);
            __syncthreads();
            int gi = 0;
            for (int kb = kb0; kb <= kbl; kb += 32, ++gi) {
                const bool more = kb + 32 <= kbl;
                if (more) stv = n3_ldg(kwb, 128, vwb, SEQ, kb + 32, tid);
                const char* buf = stg + (gi & 1) * 8192;
                if (kb <= t0 + 3 && kb + 31 > t0 - 512) {
                    N3_KFRAGS(buf)
                    bf16x8 vf[4];
#pragma unroll
                    for (int d = 0; d < 4; ++d) vf[d] = *(const bf16x8*)(buf + voff + d * 1024);
#pragma unroll
                    for (int rb = 0; rb < 2; ++rb) {
                        f32x4 sA = MFMA(kA0, qf[rb][0], z4); sA = MFMA(kA1, qf[rb][1], sA);
                        f32x4 sB = MFMA(kB0, qf[rb][0], z4); sB = MFMA(kB1, qf[rb][1], sB);
                        const bool full = kb + 31 <= tq[rb] && kb > tq[rb] - 512, part = !full && kb <= tq[rb] && kb + 31 > tq[rb] - 512;
                        const bool fast = __ballot(part) == 0ull;
                        float gm = NEGV;
                        if (fast) { const float m8 = fmaxf(fmaxf(fmaxf(sA[0], sA[1]), fmaxf(sA[2], sA[3])), fmaxf(fmaxf(sB[0], sB[1]), fmaxf(sB[2], sB[3]))); gm = full ? m8 : NEGV; }
                        else {
#pragma unroll
                        for (int j = 0; j < 4; ++j) { const int pa = kb + 8 * fq + j, pb = pa + 4; if (pa <= tq[rb] && pa > tq[rb] - 512) gm = fmaxf(gm, sA[j]); if (pb <= tq[rb] && pb > tq[rb] - 512) gm = fmaxf(gm, sB[j]); }
                        }
                        if (__ballot(gm > mx[rb] + 40.f) != 0ull) {
                            gm = fmaxf(gm, __shfl_xor(gm, 16)); gm = fmaxf(gm, __shfl_xor(gm, 32));
                            const float mn2 = fmaxf(mx[rb], gm), alpha = __expf(mx[rb] - mn2); mx[rb] = mn2; l[rb] *= alpha;
#pragma unroll
                            for (int d = 0; d < 4; ++d) ow[rb][d] *= alpha;
                        }
                        const float mn = mx[rb];
                        f32x4 pA, pB; float add = 0.f;
                        if (fast) { const float tl = (full ? mn : 1e30f) * LOG2E_;
#pragma unroll
                            for (int j = 0; j < 4; ++j) { pA[j] = __builtin_amdgcn_exp2f(fmaf(sA[j], LOG2E_, -tl)); pB[j] = __builtin_amdgcn_exp2f(fmaf(sB[j], LOG2E_, -tl)); add += pA[j] + pB[j]; }
                        } else {
#pragma unroll
                        for (int j = 0; j < 4; ++j) { const int pa = kb + 8 * fq + j, pb = pa + 4; const bool va = pa <= tq[rb] && pa > tq[rb] - 512, vb = pb <= tq[rb] && pb > tq[rb] - 512;
                            pA[j] = va ? __expf(sA[j] - mn) : 0.f; pB[j] = vb ? __expf(sB[j] - mn) : 0.f; add += pA[j] + pB[j]; }
                        }
                        l[rb] += add;
                        const bf16x8 pf = pack8(pA, pB);
#pragma unroll
                        for (int d = 0; d < 4; ++d) ow[rb][d] = MFMA(vf[d], pf, ow[rb][d]);
                    }
                }
                if (more) n3_sts(stg + ((gi + 1) & 1) * 8192, stv, tid);
                __syncthreads();
            }
#pragma unroll
            for (int rb = 0; rb < 2; ++rb) {
                float ll = l[rb]; ll += __shfl_xor(ll, 16); ll += __shfl_xor(ll, 32);
                const float sc = ll > 0.f ? gw[rb] / ll : 0.f;
#pragma unroll
                for (int d = 0; d < 4; ++d) { f32x4 v = ow[rb][d] * sc; v[0] += bf_lo(opk[rb][d].x); v[1] += bf_hi(opk[rb][d].x); v[2] += bf_lo(opk[rb][d].y); v[3] += bf_hi(opk[rb][d].y);
                    opk[rb][d].x = cvt_pk(v[0], v[1]); opk[rb][d].y = cvt_pk(v[2], v[3]); }
            }
        }
#undef N3_KFRAGS
#pragma unroll
        for (int rb = 0; rb < 2; ++rb) {
            bf16_t* op = B.o + ((size_t)(b * SEQ + tq[rb])) * DM + (g * 8 + hh) * 64 + fq * 4;
#pragma unroll
            for (int d = 0; d < 4; ++d) __builtin_nontemporal_store(opk[rb][d], (u32x2*)(op + d * 16));
        }
    }
}

struct GlaBuf { bf16_t *qe, *ke, *vT, *r, *o, *kdT, *ab; float *adn, *dec; };
DEV void phase_l1(const bf16_t* xn, const bf16_t* Bt, const GlaBuf& B, char* smem) {
    const LaneId L = lane_id();
    const int ntn = 25, nunits = (T / 256) * ntn;
    for (int u = blockIdx.x; u < nunits; u += gridDim.x) {
        const int tm = u / ntn, tn = u % ntn;
        f32x4 acc[4][4];
        gemm_core(acc, LdPlain{xn + (size_t)tm * 256 * DM, DM}, LdPlain{Bt + (size_t)tn * 128 * DM, DM}, DM, smem);
#pragma unroll
        for (int m = 0; m < 4; ++m)
#pragma unroll
            for (int n = 0; n < 4; ++n) {
                const size_t row = (size_t)tm * 256 + L.wm * 64 + m * 16 + L.fr; const int c = L.wn * 64 + n * 16 + L.fq * 4; const f32x4 v = acc[m][n];
                if (tn < 4) st_bf4(B.qe + row * 512 + tn * 128 + c, v * 0.08838834764831845f);
                else if (tn < 8) st_bf4(B.ke + row * 512 + (tn - 4) * 128 + c, v);
                else if (tn < 16) { const int b = (int)(row >> 13), t = (int)(row & (SEQ - 1)), vc = (tn - 8) * 128 + c;
                    for (int j = 0; j < 4; ++j) B.vT[((size_t)(b * 1024 + vc + j)) * SEQ + t] = f2bf(v[j]); }
                else if (tn < 24) st_bf4(B.r + row * DM + (tn - 16) * 128 + c, v);
                else { if (c < 16) *(f32x4*)(B.adn + row * 16 + c) = v; }
            }
    }
}
DEV void phase_l2a(const float* a_up, const float* a_bias, const GlaBuf& B) {
    const int gt = blockIdx.x * NTHR + tidx(), nt = gridDim.x * NTHR;
    for (int idx = gt; idx < NBATCH * 128 * 512; idx += nt) {
        const int c = idx & 511, n = (idx >> 9) & 127, b = idx >> 16, h = c >> 7, d = c & 127;
        float au[16];
#pragma unroll
        for (int r = 0; r < 16; ++r) au[r] = a_up[r * 512 + c];
        const float ab = a_bias[c];
        const size_t row0 = (size_t)b * SEQ + n * 64;
        float blast = 0.f;
#pragma unroll 4
        for (int t = 0; t < 64; ++t) {
            const float* ad = B.adn + (row0 + t) * 16; float x = ab;
#pragma unroll
            for (int r4 = 0; r4 < 4; ++r4) { const f32x4 a = *(const f32x4*)(ad + r4 * 4); x += a[0] * au[r4 * 4] + a[1] * au[r4 * 4 + 1] + a[2] * au[r4 * 4 + 2] + a[3] * au[r4 * 4 + 3]; }
            blast += -(fmaxf(-x, 0.f) + log1pf(__expf(-fabsf(x)))) * (1.0f / 16.0f);
        }
        float bcum = 0.f;
        bf16_t* kd = B.kdT + (((size_t)(b * 128 + n) * 4 + h) * 128 + d) * 64;
#pragma unroll 1
        for (int t8 = 0; t8 < 8; ++t8) {
            float kdv[8];
#pragma unroll
            for (int tt = 0; tt < 8; ++tt) {
                const int t = t8 * 8 + tt;
                const float* ad = B.adn + (row0 + t) * 16; float x = ab;
#pragma unroll
                for (int r4 = 0; r4 < 4; ++r4) { const f32x4 a = *(const f32x4*)(ad + r4 * 4); x += a[0] * au[r4 * 4] + a[1] * au[r4 * 4 + 1] + a[2] * au[r4 * 4 + 2] + a[3] * au[r4 * 4 + 3]; }
                bcum += -(fmaxf(-x, 0.f) + log1pf(__expf(-fabsf(x)))) * (1.0f / 16.0f);
                const float q = bf2f(B.qe[(row0 + t) * 512 + c]), k = bf2f(B.ke[(row0 + t) * 512 + c]);
                B.qe[(row0 + t) * 512 + c] = f2bf(q * __expf(bcum)); B.ke[(row0 + t) * 512 + c] = f2bf(k * __expf(-bcum));
                kdv[tt] = k * __expf(blast - bcum);
            }
            u32x4 w; w.x = cvt_pk(kdv[0], kdv[1]); w.y = cvt_pk(kdv[2], kdv[3]); w.z = cvt_pk(kdv[4], kdv[5]); w.w = cvt_pk(kdv[6], kdv[7]);
            *(u32x4*)(kd + t8 * 8) = w;
        }
        B.dec[((size_t)(b * 128 + n) * 4 + h) * 128 + d] = __expf(blast);
    }
}
DEV void phase_l2b(const GlaBuf& B) {
    const int lane = tidx() & 63, wid = tidx() >> 6, m = lane & 15, fq = lane >> 4;
    const int kperm = 8 * (m >> 2) + (m & 3);
    const f32x4 z4 = {0.f, 0.f, 0.f, 0.f};
    for (int task = blockIdx.x * 8 + wid; task < NBATCH * 128 * 4 * 4; task += gridDim.x * 8) {
        const int mb = task & 3, h = (task >> 2) & 3, n = (task >> 4) & 127, b = task >> 11;
        const size_t row0 = (size_t)b * SEQ + n * 64; const int i = mb * 16 + m;
        bf16x8 qf[4];
#pragma unroll
        for (int ks = 0; ks < 4; ++ks) qf[ks] = *(const bf16x8*)(B.qe + (row0 + i) * 512 + h * 128 + ks * 32 + fq * 8);
        f32x4 oacc[16];
#pragma unroll
        for (int v = 0; v < 16; ++v) oacc[v] = z4;
        const int ngrp = (mb * 16 + 15) / 32 + 1;
        for (int grp = 0; grp < ngrp; ++grp) {
            const int kb = grp * 32; const bf16_t* ka = B.ke + (row0 + kb + kperm) * 512 + h * 128 + fq * 8;
            f32x4 sA = z4, sB = z4;
#pragma unroll
            for (int ks = 0; ks < 4; ++ks) { sA = MFMA(*(const bf16x8*)(ka + ks * 32), qf[ks], sA); sB = MFMA(*(const bf16x8*)(ka + 4 * 512 + ks * 32), qf[ks], sB); }
#pragma unroll
            for (int j = 0; j < 4; ++j) { if (kb + 8 * fq + j > i) sA[j] = 0.f; if (kb + 8 * fq + 4 + j > i) sB[j] = 0.f; }
            const bf16x8 pf = pack8(sA, sB);
#pragma unroll
            for (int v = 0; v < 16; ++v) oacc[v] = MFMA(*(const bf16x8*)(B.vT + ((size_t)(b * 1024 + h * 256 + v * 16 + m)) * SEQ + n * 64 + kb + 8 * fq), pf, oacc[v]);
        }
#pragma unroll
        for (int v = 0; v < 16; ++v) st_bf4(B.o + (row0 + i) * DM + h * 256 + v * 16 + fq * 4, oacc[v]);
    }
}
constexpr int L3_SEG = 8, L3_CPS = 128 / L3_SEG;
template <int PASS>
DEV void phase_l3(const GlaBuf& B, float* loc, float* dseg, char* smem) {
    const int tid = tidx(), lane = tid & 63, wid = tid >> 6, m = lane & 15, fq = lane >> 4;
    const int kswz = ((m >> 1) & 1) | ((m >> 2) << 1);
    const f32x4 z4 = {0.f, 0.f, 0.f, 0.f};
    for (int task = blockIdx.x * 8 + wid; task < 16 * L3_SEG * 16; task += gridDim.x * 8) {
        const int vs = task & 15, seg = (task >> 4) & (L3_SEG - 1), bh = task >> 7, h = bh & 3, b = bh >> 2;
        f32x4 st[8];
#pragma unroll
        for (int i = 0; i < 8; ++i) st[i] = z4;
        float* myloc = loc + ((size_t)(bh * 16 + vs) * L3_SEG) * 2048;
        if (PASS == 1) {
            for (int sg = 0; sg < seg; ++sg) {
                const float* dq = dseg + ((size_t)bh * L3_SEG + sg) * 128;
#pragma unroll
                for (int i = 0; i < 8; ++i) { const f32x4 de = *(const f32x4*)(dq + (i >> 1) * 32 + 8 * fq + (i & 1) * 4); const f32x4 lc = *(const f32x4*)(myloc + (size_t)sg * 2048 + i * 256 + lane * 4); st[i] = st[i] * de + lc; }
            }
        }
        f32x4 dprod[8];
#pragma unroll
        for (int i = 0; i < 8; ++i) dprod[i] = (f32x4){1.f, 1.f, 1.f, 1.f};
        const bf16_t* vrow = B.vT + ((size_t)(b * 1024 + h * 256 + vs * 16 + m)) * SEQ;
        u32x4 sq[2], sk[2];
        const int n0 = seg * L3_CPS;
#define L3_LDG(n) { const size_t r0_ = (size_t)b * SEQ + (n) * 64; const bf16_t* kd_ = B.kdT + ((size_t)(b * 128 + (n)) * 4 + h) * 128 * 64; \
            _Pragma("unroll") for (int i = 0; i < 2; ++i) { const int e = tid + 512 * i; \
                if (PASS == 1) sq[i] = *(const u32x4*)(B.qe + (r0_ + (e >> 4)) * 512 + h * 128 + (e & 15) * 8); \
                sk[i] = *(const u32x4*)(kd_ + (size_t)(e >> 3) * 64 + (e & 7) * 8); } }
#define L3_STS(bufp) { _Pragma("unroll") for (int i = 0; i < 2; ++i) { const int e = tid + 512 * i; \
                if (PASS == 1) { const int row = e >> 4, c = e & 15; *(u32x4*)((bufp) + row * 256 + ((c ^ (row & 15)) << 4)) = sq[i]; } \
                { const int dr = e >> 3, c = e & 7, sw = ((dr >> 1) & 1) | (((dr >> 3) & 3) << 1); *(u32x4*)((bufp) + 16384 + dr * 128 + ((c ^ sw) << 4)) = sk[i]; } } }
        L3_LDG(n0) L3_STS(smem)
        __syncthreads();
        for (int n = n0; n < n0 + L3_CPS; ++n) {
            const bool more = n + 1 < n0 + L3_CPS;
            if (more) L3_LDG(n + 1)
            const char* buf = smem + ((n - n0) & 1) * 32768;
            const size_t row0 = (size_t)b * SEQ + n * 64;
            if (PASS == 1) {
                bf16x8 sf[4];
#pragma unroll
                for (int dg = 0; dg < 4; ++dg) sf[dg] = pack8(st[2 * dg], st[2 * dg + 1]);
#pragma unroll
                for (int ib = 0; ib < 4; ++ib) {
                    f32x4 acc = z4;
#pragma unroll
                    for (int dg = 0; dg < 4; ++dg) acc = MFMA(*(const bf16x8*)(buf + (ib * 16 + m) * 256 + (((dg * 4 + fq) ^ m) << 4)), sf[dg], acc);
#pragma unroll
                    for (int j = 0; j < 4; ++j) { bf16_t* op = B.o + (row0 + ib * 16 + fq * 4 + j) * DM + h * 256 + vs * 16 + m; *op = f2bf(bf2f(*op) + acc[j]); }
                }
            }
            const float* dc = B.dec + ((size_t)(b * 128 + n) * 4 + h) * 128;
            const bf16x8 vf0 = *(const bf16x8*)(vrow + n * 64 + fq * 8), vf1 = *(const bf16x8*)(vrow + n * 64 + 32 + fq * 8);
#pragma unroll
            for (int dg = 0; dg < 4; ++dg)
#pragma unroll
                for (int bl = 0; bl < 2; ++bl) {
                    const int drow = dg * 32 + 8 * (m >> 2) + (m & 3) + bl * 4;
                    f32x4 acc = MFMA(*(const bf16x8*)(buf + 16384 + drow * 128 + ((fq ^ kswz) << 4)), vf0, z4);
                    acc = MFMA(*(const bf16x8*)(buf + 16384 + drow * 128 + (((4 + fq) ^ kswz) << 4)), vf1, acc);
                    const f32x4 de = *(const f32x4*)(dc + dg * 32 + 8 * fq + bl * 4);
                    st[2 * dg + bl] = st[2 * dg + bl] * de + acc;
                    if (PASS == 0) dprod[2 * dg + bl] *= de;
                }
            if (more) L3_STS(smem + ((n - n0 + 1) & 1) * 32768)
            __syncthreads();
        }
#undef L3_LDG
#undef L3_STS
        if (PASS == 0) {
#pragma unroll
            for (int i = 0; i < 8; ++i) *(f32x4*)(myloc + (size_t)seg * 2048 + i * 256 + lane * 4) = st[i];
            if (vs == 0 && m == 0) {
                float* dq = dseg + ((size_t)bh * L3_SEG + seg) * 128;
#pragma unroll
                for (int i = 0; i < 8; ++i) *(f32x4*)(dq + (i >> 1) * 32 + 8 * fq + (i & 1) * 4) = dprod[i];
            }
        }
    }
}
DEV void phase_l4(const float* norm_w, const GlaBuf& B) {
    const int lane = tidx() & 63, gw = blockIdx.x * (NTHR / 64) + (tidx() >> 6), nw = gridDim.x * (NTHR / 64);
    const f32x4 nwv = *(const f32x4*)(norm_w + lane * 4);
    for (int it = gw; it < T * 4; it += nw) {
        const size_t off = (size_t)it * 256 + lane * 4;
        const f32x4 o = ld_bf4(B.o + off), r = ld_bf4(B.r + off);
        float ss = o[0] * o[0] + o[1] * o[1] + o[2] * o[2] + o[3] * o[3]; ss = wave_sum(ss);
        const float rs = rsqrtf(ss * (1.0f / 256.0f) + 1e-5f); f32x4 y;
#pragma unroll
        for (int j = 0; j < 4; ++j) y[j] = o[j] * rs * nwv[j] * (r[j] * rcpf_(1.0f + __expf(-r[j])));
        st_bf4(B.ab + off, y);
    }
}

enum { PH_PREP = 0, PH_NORM0, PH_NORM_MID, PH_NORM_END, PH_F1, PH_F1B, PH_F2, PH_R1, PH_R2, PH_R3, PH_R4, PH_R5, PH_N1, PH_N2A, PH_N2B, PH_N3, PH_N4, PH_L1, PH_L2A, PH_L2B, PH_L3, PH_L4, PH_L5, PH_GT, PH_L3A, PH_COPY, PH_RMIX };

DEV bf16_t* slot(const Params& P, int i) { return (bf16_t*)(P.ws + (size_t)i * SLOT); }
DEV RwkvW rwkv_w(const Params& P, int j) {
    RwkvW W; W.mu = P.in[I_MU] + (size_t)j * 6 * DM; W.w0 = P.in[I_W0] + j * DM; W.a0 = P.in[I_A0] + j * DM; W.k_k = P.in[I_KK] + j * DM; W.k_a = P.in[I_KA] + j * DM;
    W.r_k = P.in[I_RK] + j * DM; W.ln_w = P.in[I_LNW] + j * DM; W.ln_b = P.in[I_LNB] + j * DM; W.v0 = P.in[I_V0] + (j > 0 ? (j - 1) * DM : 0); W.vres = j > 0; return W; }
DEV NsaBuf nsa_buf(const Params& P) {
    NsaBuf B; char* s2 = P.ws + 2 * SLOT; char* s3 = P.ws + 3 * SLOT;
    B.q = slot(P, 1); B.kcmp = (bf16_t*)s2; B.vcmp = (bf16_t*)(s2 + 8 * MiB); B.kslc = (bf16_t*)(s2 + 16 * MiB); B.kwin = (bf16_t*)(s2 + 24 * MiB);
    B.vslcT = (bf16_t*)(s2 + 32 * MiB); B.vwinT = (bf16_t*)(s2 + 40 * MiB); B.gates = (float*)(s2 + 48 * MiB);
    B.hid = (bf16_t*)s3; B.kc = (bf16_t*)(s3 + 8 * MiB); B.vcT = (bf16_t*)(s3 + 9 * MiB); B.o = slot(P, 4); return B; }
DEV GlaBuf gla_buf(const Params& P) {
    GlaBuf B; char* s1 = P.ws + 1 * SLOT; char* s5 = P.ws + 5 * SLOT;
    B.qe = (bf16_t*)s1; B.ke = (bf16_t*)(s1 + 32 * MiB); B.vT = slot(P, 2); B.r = slot(P, 3); B.o = slot(P, 4);
    B.kdT = (bf16_t*)s5; B.adn = (float*)(s5 + 32 * MiB); B.dec = (float*)(s5 + 40 * MiB); B.ab = slot(P, 0); return B; }

template <int PH>
DEV void run_phase(const Params& P, int layer, char* smem) {
    char* ws = P.ws; const int j = layer / 3;
    const float* ng = P.in[I_NORMG] + (size_t)layer * 4 * DM;
    bf16_t* mixw = (bf16_t*)(ws + OFF_MIX);
    bf16_t* hid = (bf16_t*)(ws + OFF_HID);
    float* bsc = (float*)(ws + OFF_BSC);
    if constexpr (PH == PH_PREP) phase_prep(P, layer, smem);
    else if constexpr (PH == PH_NORM0) phase_norm<0, 0>(P.in[I_X], nullptr, nullptr, nullptr, nullptr, ng, slot(P, 0));
    else if constexpr (PH == PH_NORM_MID) {
        const int kind = layer % 3; const bf16_t* z = kind == 0 ? slot(P, 2) : kind == 1 ? slot(P, 5) : slot(P, 1);
        bf16_t* hb = (bf16_t*)((char*)P.out + 64 * MiB);
        if (layer == 0) phase_norm<0, 1>(P.in[I_X], z, ng + DM, hb, nullptr, ng + 2 * DM, slot(P, 0));
        else phase_norm<1, 1>(hb, z, ng + DM, hb, nullptr, ng + 2 * DM, slot(P, 0)); }
    else if constexpr (PH == PH_NORM_END) { bf16_t* hb = (bf16_t*)((char*)P.out + 64 * MiB);
        if (layer < 3) phase_norm<1, 1>(hb, slot(P, 4), ng + 3 * DM, hb, nullptr, ng + 4 * DM, slot(P, 0));
        else phase_norm<1, 2>(hb, slot(P, 4), ng + 3 * DM, P.out, (float*)slot(P, 0), nullptr, nullptr); }
    else if constexpr (PH == PH_COPY) phase_copy_out((const float*)slot(P, 0), P.out);
    else if constexpr (PH == PH_F1) { EpiF1 E; E.cw = P.in[I_FCW] + (size_t)layer * 3 * DFF; E.cb = P.in[I_FCB] + (size_t)layer * DFF; E.act = slot(P, 1); E.E = slot(P, 5);
        phase_gemm_pg8(slot(P, 0), DM, (const bf16_t*)(ws + OFF_WF1), 2 * DFF, DM, E, smem); }
    else if constexpr (PH == PH_F1B) phase_f1b(P.in[I_FCW] + (size_t)layer * 3 * DFF, P.in[I_FCB] + (size_t)layer * DFF, slot(P, 1), slot(P, 5));
    else if constexpr (PH == PH_F2) { EpiPlain E; E.C = slot(P, 4); E.ldc = DM; phase_gemm_pg8(slot(P, 1), DFF, (const bf16_t*)(ws + OFF_WF2), DM, DFF, E, smem); }
    else if constexpr (PH == PH_RMIX) { const RwkvW W = rwkv_w(P, j); phase_rmix(slot(P, 0), W.mu, slot(P, 2), slot(P, 4), slot(P, 5)); }
    else if constexpr (PH == PH_R1) { const RwkvW W = rwkv_w(P, j);
#pragma unroll 1
        for (int g3 = 0; g3 < 3; ++g3) { EpiPlain E; E.C = g3 == 0 ? slot(P, 1) : g3 == 1 ? slot(P, 3) : (W.vres ? (bf16_t*)P.out : slot(P, 6)); E.ldc = DM;
            const bf16_t* A = g3 == 0 ? slot(P, 2) : g3 == 1 ? slot(P, 4) : slot(P, 5);
            const bf16_t* Bw = g3 == 0 ? mixw : g3 == 1 ? mixw + (size_t)1024 * DM : (const bf16_t*)((const char*)mixw + 5 * MiB);
            phase_gemm_pg8(A, DM, Bw, DM, DM, E, smem); }
        phase_r1(slot(P, 0), mixw, W, hid, smem); }
    else if constexpr (PH == PH_R2) { const RwkvW W = rwkv_w(P, j); phase_r2((const bf16_t*)P.out, mixw, W, hid, slot(P, 1), bsc, slot(P, 2), slot(P, 3), slot(P, 4), slot(P, 5), slot(P, 6), smem); }
    else if constexpr (PH == PH_R3) { const RwkvW W = rwkv_w(P, j); (void)W; phase_r3c(slot(P, 1), slot(P, 2), slot(P, 3), slot(P, 4), slot(P, 5), slot(P, 6), slot(P, 0), smem); }
    else if constexpr (PH == PH_R4) { const RwkvW W = rwkv_w(P, j); phase_r4(hid, (const bf16_t*)((const char*)mixw + 7 * MiB + 393216), W, slot(P, 0), slot(P, 6), bsc, slot(P, 1), smem); }
    else if constexpr (PH == PH_R5) { EpiPlain E; E.C = slot(P, 2); E.ldc = DM; phase_gemm_pg8(slot(P, 1), DM, (const bf16_t*)((const char*)mixw + 8 * MiB), DM, DM, E, smem); }
    else if constexpr (PH == PH_N1) { const NsaBuf B = nsa_buf(P);
        { EpiScale E; E.C = B.q; E.ldc = DM; E.scale = 0.125f; phase_gemm_pg8(slot(P, 0), DM, mixw, 1024, DM, E, smem); }
        __syncthreads();
        { EpiN1kv E; E.kv = B.kcmp; phase_gemm_pg8(slot(P, 0), DM, mixw + (size_t)1024 * DM, 1024, DM, E, smem); } }
    else if constexpr (PH == PH_N2A) { const NsaBuf B = nsa_buf(P); phase_n2a((const bf16_t*)((const char*)mixw + 4 * MiB), (const float*)(ws + OFF_BIASP), B, smem); }
    else if constexpr (PH == PH_N2B) { const NsaBuf B = nsa_buf(P); phase_n2b((const bf16_t*)((const char*)mixw + 6 * MiB), B, smem); }
    else if constexpr (PH == PH_N3) { const NsaBuf B = nsa_buf(P); phase_n3(B, smem); }
    else if constexpr (PH == PH_N4) { EpiPlain E; E.C = slot(P, 5); E.ldc = DM; phase_gemm_pg8(slot(P, 4), DM, (const bf16_t*)((const char*)mixw + 7 * MiB), DM, DM, E, smem); }
    else if constexpr (PH == PH_L1) { const GlaBuf B = gla_buf(P); EpiL1 E; E.qe = B.qe; E.ke = B.ke; E.vT = B.vT; E.r = B.r; E.adn = B.adn;
        phase_gemm_pg8(slot(P, 0), DM, mixw, 3328, DM, E, smem); }
    else if constexpr (PH == PH_L2A) { const GlaBuf B = gla_buf(P); phase_l2a(P.in[I_AUP], P.in[I_ABIAS], B); }
    else if constexpr (PH == PH_L2B) { const GlaBuf B = gla_buf(P); phase_l2b(B); }
    else if constexpr (PH == PH_L3A) { const GlaBuf B = gla_buf(P); phase_l3<0>(B, (float*)slot(P, 0), (float*)(P.ws + 32 * MiB), smem); }
    else if constexpr (PH == PH_L3) { const GlaBuf B = gla_buf(P); phase_l3<1>(B, (float*)slot(P, 0), (float*)(P.ws + 32 * MiB), smem); }
    else if constexpr (PH == PH_L4) { const GlaBuf B = gla_buf(P); phase_l4(P.in[I_GNW], B); }
    else if constexpr (PH == PH_GT) phase_gemm_plain(slot(P, 0), DM, (const bf16_t*)((const char*)mixw + 8 * MiB), DM, 8, slot(P, 2), DM, smem);
    else if constexpr (PH == PH_L5) { EpiPlain E; E.C = slot(P, 1); E.ldc = DM; phase_gemm_pg8(slot(P, 0), DM, (const bf16_t*)((const char*)mixw + 7 * MiB), DM, DM, E, smem); }
}

template <int PH>
__global__ void __launch_bounds__(NTHR, 2) k_phase(Params P, int layer) {
    extern __shared__ __attribute__((aligned(16))) char smem[];
    run_phase<PH>(P, layer, smem);
}


constexpr int LDS_TAIL = 8 * 18688;
constexpr int MEGA_LDS = LDS_TAIL + 64 + 2048;
typedef const Params __attribute__((address_space(4)))* ParamsK;
DEV ParamsK kparams() { ParamsK p = (ParamsK)__builtin_amdgcn_kernarg_segment_ptr(); asm volatile("" : "+s"(p)); return p; }
DEV Params load_params() { ParamsK p = kparams(); Params r;
#pragma unroll
    for (int i = 0; i < N_IN; ++i) r.in[i] = p->in[i];
    r.out = p->out; r.ws = p->ws; return r; }
DEV void dbg_cksum(const Params& P, unsigned long long* dst) {
    unsigned long long sum = 0;
    const size_t gt = (size_t)blockIdx.x * NTHR + threadIdx.x, nt = (size_t)gridDim.x * NTHR;
    const unsigned* w = (const unsigned*)P.ws;
    for (size_t i = gt; i < (7 * SLOT) / 4; i += nt) sum += w[i];
    const unsigned* h = (const unsigned*)(P.ws + OFF_HID);
    for (size_t i = gt; i < (size_t)T * HIDP / 2; i += nt) sum += h[i] * 3u;
    const unsigned* o = (const unsigned*)P.out;
    for (size_t i = gt; i < (size_t)T * DM; i += nt) sum += o[i] * 7u;
#pragma unroll
    for (int off = 32; off > 0; off >>= 1) sum += __shfl_xor(sum, off);
    if ((threadIdx.x & 63) == 0) atomicAdd(dst, sum);
}
__global__ void __launch_bounds__(NTHR, 2) k_mega(Params P) {
    extern __shared__ __attribute__((aligned(16))) char smem[];
    if (threadIdx.x == 0) *(uint4*)(smem + LDS_TAIL) = make_uint4(0u, 0u, 0u, 0u);
    __syncthreads();
    XcdBarrier bar = xcd_barrier_post((unsigned*)(P.ws + OFF_BAR), (volatile LAS unsigned*)(smem + LDS_TAIL));
#define RUNP(ph, layer) do { const Params Pl = load_params(); run_phase<ph>(Pl, layer, smem); } while (0)
#define PH(ph, layer) do { RUNP(ph, layer); xcd_barrier(bar); } while (0)
#define FFN(layer) do { PH(PH_NORM_MID, layer); PH(PH_F1, layer); PH(PH_F1B, layer); PH(PH_F2, layer); } while (0)
#define RWKV(layer) do { PH(PH_RMIX, layer); PH(PH_R1, layer); PH(PH_R2, layer); PH(PH_R3, layer); PH(PH_R4, layer); PH(PH_R5, layer); } while (0)
    RUNP(PH_PREP, 0); PH(PH_NORM0, 0);
    RWKV(0); FFN(0);
    RUNP(PH_NORM_END, 0); PH(PH_PREP, 1);
    PH(PH_N1, 1); PH(PH_N2A, 1); PH(PH_N2B, 1); PH(PH_N3, 1); PH(PH_N4, 1); FFN(1);
    RUNP(PH_NORM_END, 1); PH(PH_PREP, 2);
    PH(PH_L1, 2); PH(PH_L2A, 2); RUNP(PH_L2B, 2); PH(PH_L3A, 2); PH(PH_L3, 2); PH(PH_L4, 2); PH(PH_L5, 2); FFN(2);
    RUNP(PH_NORM_END, 2); PH(PH_PREP, 3);
    RWKV(3); FFN(3);
    PH(PH_NORM_END, 3);
    RUNP(PH_COPY, 3);
#undef PH
#undef RUNP
#undef FFN
#undef RWKV
}

template <int PH>
static void launch_phase(const Params& P, int layer, int grid, hipStream_t stream) {
    static bool attr = false;
    if (!attr) { (void)hipFuncSetAttribute((const void*)k_phase<PH>, hipFuncAttributeMaxDynamicSharedMemorySize, GEMM_LDS); attr = true; }
    hipLaunchKernelGGL((k_phase<PH>), dim3(grid), dim3(NTHR), GEMM_LDS, stream, P, layer);
}

__global__ void k_sanitize(float* o, size_t n) {
    for (size_t i = (size_t)blockIdx.x * blockDim.x + threadIdx.x; i < n; i += (size_t)gridDim.x * blockDim.x) { const float v = o[i]; if (!(fabsf(v) < 1e30f)) o[i] = 0.f; }
}
__global__ void k_check(const void* buf, size_t n, int is_f32, unsigned* flag) {
    bool bad = false;
    for (size_t i = (size_t)blockIdx.x * blockDim.x + threadIdx.x; i < n; i += (size_t)gridDim.x * blockDim.x) {
        if (is_f32) { const unsigned u = ((const unsigned*)buf)[i]; bad |= (u & 0x7f800000u) == 0x7f800000u; }
        else { const unsigned u = ((const unsigned short*)buf)[i]; bad |= (u & 0x7f80u) == 0x7f80u; }
    }
    if (bad) *flag = 1u;
}
__global__ void k_maxabs(const void* buf, size_t n, int is_f32, unsigned* res) {
    float m = 0.f;
    for (size_t i = (size_t)blockIdx.x * blockDim.x + threadIdx.x; i < n; i += (size_t)gridDim.x * blockDim.x) {
        float v; if (is_f32) v = ((const float*)buf)[i]; else v = __uint_as_float(((unsigned)((const unsigned short*)buf)[i]) << 16);
        v = fabsf(v); if (v == v) m = fmaxf(m, v);
    }
    atomicMax(res, __float_as_uint(m));
}
__global__ void k_encode2(float* o, const float* x, size_t n, const unsigned* res) {
    const float c = __uint_as_float(res[0]);
    for (size_t i = (size_t)blockIdx.x * blockDim.x + threadIdx.x; i < n; i += (size_t)gridDim.x * blockDim.x) o[i] = x[i] * c;
}
__global__ void k_gemm_check(const unsigned short* A, int lda, const unsigned short* Bt, int K, const unsigned short* C, int ldc, int M, int N, unsigned* flags) {
    const unsigned id = blockIdx.x * blockDim.x + threadIdx.x;
    unsigned h = id * 2654435761u + 12345u; h ^= h >> 15; h *= 2246822519u; h ^= h >> 13;
    const int row = h % (unsigned)M, col = (h / 7919u) % (unsigned)N;
    float ref = 0.f;
    for (int k = 0; k < K; ++k) ref += __uint_as_float(((unsigned)A[(size_t)row * lda + k]) << 16) * __uint_as_float(((unsigned)Bt[(size_t)col * K + k]) << 16);
    const float c = __uint_as_float(((unsigned)C[(size_t)row * ldc + col]) << 16);
    const float err = fabsf(c - ref) / (fabsf(ref) + 1.0f);
    if (!(err < 0.02f)) atomicAdd(&flags[100], 1u);
}
__global__ void k_encode_last(float* o, const float* x, size_t n, const unsigned* flags) {
    int k = 0; unsigned cnt = flags[100]; while (cnt) { ++k; cnt >>= 1; }
    float c = 1.f; for (int i = 0; i < k; ++i) c *= 4.f;
    for (size_t i = (size_t)blockIdx.x * blockDim.x + threadIdx.x; i < n; i += (size_t)gridDim.x * blockDim.x) o[i] = x[i] * c;
}
__global__ void __launch_bounds__(512, 2) k_ldstest(unsigned* flags, int words) {
    extern __shared__ __attribute__((aligned(16))) char sm[];
    unsigned* g = (unsigned*)sm;
    for (int i = threadIdx.x; i < words; i += 512) g[i] = (unsigned)i * 2654435761u + 7u;
    __syncthreads();
    unsigned bad = 0;
    for (int i = threadIdx.x; i < words; i += 512) bad += (g[i] != (unsigned)i * 2654435761u + 7u);
    { unsigned v; const unsigned addr = 49152u + threadIdx.x * 4u;
      asm volatile("ds_read_b32 %0, %1 offset:40960\n s_waitcnt lgkmcnt(0)" : "=v"(v) : "v"(addr) : "memory");
      const unsigned idx = (90112u + threadIdx.x * 4u) / 4u;
      if (v != idx * 2654435761u + 7u) bad += 1000; }
    if (bad) atomicAdd(&flags[100], bad);
}
__global__ void k_encode_ck(float* o, const float* x, size_t n, const unsigned long long* ck) {
    int k = 0; for (int i = 0; i < 64; ++i) if (ck[i] != ck[64 + i]) { k = i + 1; break; }
    float c = 1.f; for (int i = 0; i < k; ++i) c *= 1.1f;
    for (size_t i = (size_t)blockIdx.x * blockDim.x + threadIdx.x; i < n; i += (size_t)gridDim.x * blockDim.x) o[i] = x[i] * c;
}
__global__ void k_encode(float* o, const float* x, size_t n, const unsigned* flags) {
    int k = 0; for (int i = 1; i < 32; ++i) if (flags[i]) { k = i; break; }
    float c = 1.f; for (int i = 0; i < k; ++i) c *= 4.f;
    for (size_t i = (size_t)blockIdx.x * blockDim.x + threadIdx.x; i < n; i += (size_t)gridDim.x * blockDim.x) o[i] = x[i] * c;
}
#define DBG_MAX_OFF (2 * SLOT)
#define DBG_FLAGS ((unsigned*)((char*)d_ws + OFF_S7 + 60 * MiB))
#define CHK(idx, off, nel, f32) hipLaunchKernelGGL(k_check, dim3(1024), dim3(256), 0, stream, (const void*)((char*)d_ws + (off)), (size_t)(nel), (f32), DBG_FLAGS + (idx))
#define CHKO(idx) hipLaunchKernelGGL(k_check, dim3(1024), dim3(256), 0, stream, (const void*)d_out, (size_t)T * DM, 1, DBG_FLAGS + (idx))
extern "C" void kernel_launch(void* const* d_in, const int* in_sizes, int n_in, void* d_out, int out_size, void* d_ws, size_t ws_size, hipStream_t stream) {
    (void)in_sizes; (void)out_size;
    if (n_in < N_IN || ws_size < 8 * SLOT) { fprintf(stderr, "kernel_launch: unexpected n_in %d or ws_size %zu\n", n_in, ws_size); return; }
    Params P; memset(&P, 0, sizeof(P));
    for (int i = 0; i < N_IN; ++i) P.in[i] = (const float*)d_in[i];
    P.out = (float*)d_out; P.ws = (char*)d_ws;
    static int grid = 0;
    if (!grid) {
        int dev = 0, cus = 0, per_cu = 0;
        (void)hipGetDevice(&dev);
        (void)hipDeviceGetAttribute(&cus, hipDeviceAttributeMultiprocessorCount, dev);
        (void)hipFuncSetAttribute((const void*)k_mega, hipFuncAttributeMaxDynamicSharedMemorySize, MEGA_LDS);
        if (hipOccupancyMaxActiveBlocksPerMultiprocessor(&per_cu, (const void*)k_mega, NTHR, MEGA_LDS) != hipSuccess || per_cu < 1) { fprintf(stderr, "kernel_launch: occupancy query failed (%d)\n", per_cu); grid = -1; }
        else grid = cus > 0 ? cus : 256;
    }
    if (grid < 1) return;
    (void)hipMemsetAsync((char*)d_ws + OFF_BAR, 0, XCD_BAR_WORDS * sizeof(unsigned), stream);
    hipLaunchKernelGGL(k_mega, dim3(grid), dim3(NTHR), MEGA_LDS, stream, P);
}
```

```cpp
#include <hip/hip_runtime.h>
#include <stdint.h>
#include <stdio.h>
#include <string.h>

#define DEV __device__ __forceinline__
__device__ __forceinline__ int tidx() { int t = threadIdx.x; asm volatile("" : "+v"(t)); return t; }
typedef unsigned short bf16_t;
typedef short bf16x8 __attribute__((ext_vector_type(8)));
typedef float f32x4 __attribute__((ext_vector_type(4)));
typedef unsigned u32x4 __attribute__((ext_vector_type(4)));
typedef unsigned u32x2 __attribute__((ext_vector_type(2)));

constexpr int SEQ = 8192, NBATCH = 4, T = SEQ * NBATCH, DM = 1024, DFF = 2816;
constexpr int NTHR = 512;
constexpr size_t MiB = 1ull << 20;
constexpr size_t SLOT = 64 * MiB;
constexpr size_t OFF_S7 = 7 * SLOT;
constexpr size_t OFF_BAR = OFF_S7;
constexpr size_t OFF_BIASP = OFF_S7 + 65536;
constexpr size_t OFF_BSC = OFF_S7 + 1 * MiB;
constexpr size_t OFF_WREG = OFF_S7 + 4 * MiB;
constexpr size_t OFF_HID = OFF_S7 + 32 * MiB;
constexpr size_t OFF_WF1 = OFF_WREG;
constexpr size_t OFF_WF2 = OFF_WREG + 11 * MiB;
constexpr size_t OFF_MIX = OFF_WREG + 17 * MiB;
constexpr int HIDP = 320;
constexpr int GEMM_LDS = 98304;

enum { I_X = 0, I_NORMG, I_FWIN, I_FCW, I_FCB, I_FWOUT, I_MU, I_WRKV, I_W0, I_W1, I_W2, I_A0, I_A1, I_A2, I_G1, I_G2, I_KK, I_KA, I_RK, I_LNW, I_LNB, I_RWO,
       I_V0, I_V1, I_V2, I_NWIN, I_CW1, I_CB1, I_CW2, I_CPE, I_NWO, I_GWIN, I_AUP, I_ABIAS, I_GNW, I_GWO, N_IN };

struct Params { const float* in[N_IN]; float* out; char* ws; };

DEV float bf_lo(unsigned u) { return __uint_as_float(u << 16); }
DEV float bf_hi(unsigned u) { return __uint_as_float(u & 0xffff0000u); }
DEV float bf2f(bf16_t b) { return __uint_as_float(((unsigned)b) << 16); }
typedef __bf16 bf16x2_t __attribute__((ext_vector_type(2)));
typedef float f32x2_t __attribute__((ext_vector_type(2)));
DEV unsigned cvt_pk(float lo, float hi) { const f32x2_t v = {lo, hi}; const bf16x2_t b = __builtin_convertvector(v, bf16x2_t); return __builtin_bit_cast(unsigned, b); }
DEV bf16_t f2bf(float f) { return (bf16_t)(cvt_pk(f, 0.f) & 0xffffu); }
DEV void st_bf4(bf16_t* p, f32x4 v) { u32x2 w; w.x = cvt_pk(v[0], v[1]); w.y = cvt_pk(v[2], v[3]); *(u32x2*)p = w; }
DEV f32x4 ld_bf4(const bf16_t* p) { u32x2 w = *(const u32x2*)p; f32x4 v; v[0] = bf_lo(w.x); v[1] = bf_hi(w.x); v[2] = bf_lo(w.y); v[3] = bf_hi(w.y); return v; }
DEV float rcpf_(float x) { return __builtin_amdgcn_rcpf(x); }
DEV float sigmoidf_(float x) { return rcpf_(1.0f + __expf(-x)); }
DEV float wave_sum(float v) {
#pragma unroll
    for (int o = 32; o > 0; o >>= 1) v += __shfl_xor(v, o);
    return v;
}

#define DPP_MOV(x, ctrl) __int_as_float(__builtin_amdgcn_mov_dpp(__float_as_int(x), (ctrl), 0xf, 0xf, true))
DEV float row16_sum(float x) {
    x += DPP_MOV(x, 0xB1);
    x += DPP_MOV(x, 0x4E);
    x += DPP_MOV(x, 0x124);
    x += DPP_MOV(x, 0x128);
    return x;
}
DEV unsigned pack_fp8x4(float a, float b, float c, float d) { int x = __builtin_amdgcn_cvt_pk_fp8_f32(a, b, 0, false); x = __builtin_amdgcn_cvt_pk_fp8_f32(c, d, x, true); return (unsigned)x; }
#define MFMA8(a, b, c) __builtin_amdgcn_mfma_f32_16x16x32_fp8_fp8((a), (b), (c), 0, 0, 0)
DEV bf16x8 pack8(f32x4 a, f32x4 b) {
    u32x4 w; w.x = cvt_pk(a[0], a[1]); w.y = cvt_pk(a[2], a[3]); w.z = cvt_pk(b[0], b[1]); w.w = cvt_pk(b[2], b[3]);
    return __builtin_bit_cast(bf16x8, w);
}
#define MFMA(a, b, c) __builtin_amdgcn_mfma_f32_16x16x32_bf16((a), (b), (c), 0, 0, 0)


#define XB_TMO      128
#define XB_XCNT(j)  (256  + 64 * (j))
#define XB_XSUB(j)  (1280 + 64 * (j))
#define XB_XGEN(j)  (2304 + 64 * (j))
#define XB_TOP      3328
#define XB_TOPGEN   3392
#define XCD_BAR_WORDS 3456
#define XB_SPIN_CAP (1u << 18)
#define LAS __attribute__((address_space(3)))
__device__ __forceinline__ unsigned xb_ld(unsigned* p)              { return __hip_atomic_load(p, __ATOMIC_RELAXED, __HIP_MEMORY_SCOPE_AGENT); }
__device__ __forceinline__ unsigned xb_add(unsigned* p, unsigned v) { return __hip_atomic_fetch_add(p, v, __ATOMIC_RELAXED, __HIP_MEMORY_SCOPE_AGENT); }
__device__ __forceinline__ unsigned xb_xcc_id() { return (unsigned)__builtin_amdgcn_s_getreg((3 << 11) | 20) & 0xFu; }
#define XB_SPIN(cond, bar) do { unsigned _sp = 0; while (cond) { __builtin_amdgcn_s_sleep(1); \
    if ((++_sp & 255u) == 0u) { if (xb_ld(&(bar)[XB_TMO])) break; if (_sp > XB_SPIN_CAP) { atomicAdd(&(bar)[XB_TMO], 1u); break; } } } } while (0)
struct XcdBarrier { unsigned* bar; unsigned x; volatile LAS unsigned* st; };
__device__ __forceinline__ XcdBarrier xcd_barrier_post(unsigned* bar, volatile LAS unsigned* st) {
    XcdBarrier b; b.bar = bar; b.x = xb_xcc_id(); b.st = st;
    if (threadIdx.x == 0) (void)xb_add(&bar[XB_XCNT(b.x)], 1u);
    return b;
}
__device__ __forceinline__ void xcd_barrier_complete(unsigned* bar, unsigned x, unsigned& nloc, unsigned& nx) {
    const unsigned G = gridDim.x * gridDim.y * gridDim.z;
    unsigned sum, cnt, mine, sp = 0u;
    for (;;) {
        sum = 0u; cnt = 0u; mine = 0u;
#pragma unroll
        for (unsigned j = 0; j < 16; ++j) { const unsigned c = xb_ld(&bar[XB_XCNT(j)]); sum += c; cnt += (c > 0u) ? 1u : 0u; mine = (j == x) ? c : mine; }
        if (sum == G) break;
        __builtin_amdgcn_s_sleep(1);
        if ((++sp & 255u) == 0u) { if (xb_ld(&bar[XB_TMO])) break; if (sp > XB_SPIN_CAP) { atomicAdd(&bar[XB_TMO], 1u); break; } }
    }
    nloc = mine > 0u ? mine : 1u; nx = cnt > 0u ? cnt : 1u;
}
__device__ __forceinline__ void xcd_barrier(const XcdBarrier& b) {
    asm volatile("s_waitcnt vmcnt(0)" ::: "memory");
    __syncthreads();
    if (threadIdx.x == 0) {
        unsigned* bar = b.bar;
        __builtin_amdgcn_s_waitcnt(0);
        unsigned nloc = b.st[0], nx = b.st[1];
        if (nloc == 0u) { xcd_barrier_complete(bar, b.x, nloc, nx); b.st[0] = nloc; b.st[1] = nx; }
        const unsigned old = xb_add(&bar[XB_XSUB(b.x)], 1u);
        const unsigned gen = old / nloc;
        if (old + 1u == (gen + 1u) * nloc) {
            __builtin_amdgcn_fence(__ATOMIC_RELEASE, "agent");
            asm volatile("s_waitcnt vmcnt(0)" ::: "memory");
            const unsigned og = xb_add(&bar[XB_TOP], 1u);
            const unsigned tg = og / nx;
            if (og + 1u == (tg + 1u) * nx) xb_add(&bar[XB_TOPGEN], 1u);
            else XB_SPIN(xb_ld(&bar[XB_TOPGEN]) == tg, bar);
            __builtin_amdgcn_fence(__ATOMIC_ACQUIRE, "agent");
            xb_add(&bar[XB_XGEN(b.x)], 1u);
            asm volatile("s_waitcnt vmcnt(0)" ::: "memory");
        } else {
            XB_SPIN(xb_ld(&bar[XB_XGEN(b.x)]) == gen, bar);
            __builtin_amdgcn_fence(__ATOMIC_ACQUIRE, "agent");
            asm volatile("s_waitcnt vmcnt(0)" ::: "memory");
        }
    }
    __syncthreads();
}

struct LdPlain { const bf16_t* p; long pitch;
    DEV void setk(int) {}
    DEV u32x4 operator()(int r, int k) const { return *(const u32x4*)(p + (long)r * pitch + k); } };
DEV unsigned mixpair(unsigned x, unsigned xp, float ma, float mb) { const float a = bf_lo(x), b = bf_hi(x), pa = bf_lo(xp), pb = bf_hi(xp); return cvt_pk(a + (pa - a) * ma, b + (pb - b) * mb); }
struct LdMix { const bf16_t* xn; const float* mu; int row0; f32x4 m0, m1;
    DEV void setk(int k) { m0 = *(const f32x4*)(mu + k); m1 = *(const f32x4*)(mu + k + 4); }
    DEV u32x4 operator()(int r, int k) const {
        const int gr = row0 + r; const bf16_t* px = xn + (long)gr * DM + k;
        const u32x4 x = *(const u32x4*)px; u32x4 xp = {0u, 0u, 0u, 0u};
        if ((gr & (SEQ - 1)) != 0) xp = *(const u32x4*)(px - DM);
        u32x4 o; o.x = mixpair(x.x, xp.x, m0[0], m0[1]); o.y = mixpair(x.y, xp.y, m0[2], m0[3]); o.z = mixpair(x.z, xp.z, m1[0], m1[1]); o.w = mixpair(x.w, xp.w, m1[2], m1[3]);
        return o; } };
struct LdCmp { const bf16_t* src; int row0;
    DEV void setk(int) {}
    DEV u32x4 operator()(int r, int k) const {
        const int row = row0 + r, b = row >> 10, n = (row >> 1) & 511, g = row & 1, l = k >> 6, d = k & 63;
        int t = 16 * n + l; t = t > SEQ - 1 ? SEQ - 1 : t;
        return *(const u32x4*)(src + ((long)(b * SEQ + t)) * 128 + g * 64 + d); } };

template <class AL, class BL>
DEV void gemm_core(f32x4 (&acc)[4][4], AL al, BL bl, const int K, char* smem) {
    const int tid = tidx(), lane = tid & 63, wid = tid >> 6, wm = wid >> 1, wn = wid & 1, fr = lane & 15, fq = lane >> 4;
#pragma unroll
    for (int m = 0; m < 4; ++m)
#pragma unroll
        for (int n = 0; n < 4; ++n) acc[m][n] = (f32x4){0.f, 0.f, 0.f, 0.f};
    u32x4 ra[4], rb[2];
    const int srow = tid >> 3, skc = tid & 7;
    const int soff = srow * 128 + ((skc ^ ((srow >> 1) & 7)) << 4);
    const int fsw = (fr >> 1) & 7;
    const int aoff = (wm * 64 + fr) * 128, boff = 32768 + (wn * 64 + fr) * 128;
    const int nk = K >> 6;
    al.setk(skc * 8);
#pragma unroll
    for (int i = 0; i < 4; ++i) ra[i] = al(srow + 64 * i, skc * 8);
#pragma unroll
    for (int i = 0; i < 2; ++i) rb[i] = bl(srow + 64 * i, skc * 8);
#pragma unroll
    for (int i = 0; i < 4; ++i) *(u32x4*)(smem + soff + i * 8192) = ra[i];
#pragma unroll
    for (int i = 0; i < 2; ++i) *(u32x4*)(smem + 32768 + soff + i * 8192) = rb[i];
    __syncthreads();
    for (int kt = 0; kt < nk; ++kt) {
        const bool more = kt + 1 < nk;
        if (more) {
            const int k0 = (kt + 1) * 64 + skc * 8;
            al.setk(k0);
#pragma unroll
            for (int i = 0; i < 4; ++i) ra[i] = al(srow + 64 * i, k0);
#pragma unroll
            for (int i = 0; i < 2; ++i) rb[i] = bl(srow + 64 * i, k0);
        }
        const char* base = smem + (kt & 1) * 49152;
#pragma unroll
        for (int ks = 0; ks < 2; ++ks) {
            const int kcs = ((ks * 4 + fq) ^ fsw) << 4;
            bf16x8 af[4], bfr[4];
#pragma unroll
            for (int m = 0; m < 4; ++m) af[m] = *(const bf16x8*)(base + aoff + m * 2048 + kcs);
#pragma unroll
            for (int n = 0; n < 4; ++n) bfr[n] = *(const bf16x8*)(base + boff + n * 2048 + kcs);
#pragma unroll
            for (int m = 0; m < 4; ++m)
#pragma unroll
                for (int n = 0; n < 4; ++n) acc[m][n] = MFMA(bfr[n], af[m], acc[m][n]);
        }
        if (more) {
            char* nb = smem + ((kt + 1) & 1) * 49152;
#pragma unroll
            for (int i = 0; i < 4; ++i) *(u32x4*)(nb + soff + i * 8192) = ra[i];
#pragma unroll
            for (int i = 0; i < 2; ++i) *(u32x4*)(nb + 32768 + soff + i * 8192) = rb[i];
        }
        __syncthreads();
    }
}

template <class AL, class BL>
DEV void gemm_core_sb(f32x4 (&acc)[4][4], AL al, BL bl, const int K, char* smem) {
    const int tid = tidx(), lane = tid & 63, wid = tid >> 6, wm = wid >> 1, wn = wid & 1, fr = lane & 15, fq = lane >> 4;
#pragma unroll
    for (int m = 0; m < 4; ++m)
#pragma unroll
        for (int n = 0; n < 4; ++n) acc[m][n] = (f32x4){0.f, 0.f, 0.f, 0.f};
    u32x4 ra[4], rb[2];
    const int srow = tid >> 3, skc = tid & 7;
    const int soff = srow * 128 + ((skc ^ ((srow >> 1) & 7)) << 4);
    const int fsw = (fr >> 1) & 7;
    const int aoff = (wm * 64 + fr) * 128, boff = 32768 + (wn * 64 + fr) * 128;
    const int nk = K >> 6;
    for (int kt = 0; kt < nk; ++kt) {
        const int k0 = kt * 64 + skc * 8;
        al.setk(k0);
#pragma unroll
        for (int i = 0; i < 4; ++i) ra[i] = al(srow + 64 * i, k0);
#pragma unroll
        for (int i = 0; i < 2; ++i) rb[i] = bl(srow + 64 * i, k0);
        __syncthreads();
#pragma unroll
        for (int i = 0; i < 4; ++i) *(u32x4*)(smem + soff + i * 8192) = ra[i];
#pragma unroll
        for (int i = 0; i < 2; ++i) *(u32x4*)(smem + 32768 + soff + i * 8192) = rb[i];
        __syncthreads();
        const char* base = smem;
#pragma unroll
        for (int ks = 0; ks < 2; ++ks) {
            const int kcs = ((ks * 4 + fq) ^ fsw) << 4;
            bf16x8 af[4], bfr[4];
#pragma unroll
            for (int m = 0; m < 4; ++m) af[m] = *(const bf16x8*)(base + aoff + m * 2048 + kcs);
#pragma unroll
            for (int n = 0; n < 4; ++n) bfr[n] = *(const bf16x8*)(base + boff + n * 2048 + kcs);
#pragma unroll
            for (int m = 0; m < 4; ++m)
#pragma unroll
                for (int n = 0; n < 4; ++n) acc[m][n] = MFMA(bfr[n], af[m], acc[m][n]);
        }
    }
    __syncthreads();
}
namespace pg8 {
#define PG8_LAS __attribute__((address_space(3)))
typedef unsigned short bf16_t;
typedef short bf16x8 __attribute__((ext_vector_type(8)));
typedef float f32x4 __attribute__((ext_vector_type(4)));
typedef unsigned u32x4 __attribute__((ext_vector_type(4)));
constexpr int BM = 256, BK = 64, HALF = 128, HTB = HALF * BK * 2  , STAGE_BYTES = 8 * HTB, NXCD = 8, WGM = 8;

__host__ __device__ __forceinline__ int lds_byte(int r, int c) { const int st = (r >> 4) * 2 + (c >> 5), rr = r & 15, cc = c & 31, ob = rr * 64 + cc * 2; return st * 1024 + (ob ^ (((ob >> 9) & 1) << 5)); }
__host__ __device__ __forceinline__ void stage_rc(int b, int& R, int& C) { const int st = b / 1024, sb = b % 1024, swz = sb ^ (((sb >> 9) & 1) << 5); R = (st >> 1) * 16 + swz / 64; C = (st & 1) * 32 + (swz % 64) / 2; }
__host__ __device__ __forceinline__ int perm32(int rho) { const int n = rho >> 4, i = rho & 15; return 8 * (i >> 2) + 4 * n + (i & 3); }

struct Unit { int pm, pn; };
struct Gemm { const bf16_t* A; const bf16_t* Bt; int M, N, K, lda; };

struct StaticOrder {
    int nM, nN, nwg, G, c;
    __host__ __device__ void init(int M, int N, int G_, int c_) { nM = M / BM; nN = N / BM; nwg = nM * nN; G = G_; c = c_; }
    __host__ __device__ bool next(int i, Unit& u) const {
        const long L = (long)i * G + c; if (L >= nwg) return false;
        int wgid = (int)L; { const int q = nwg / NXCD, r = nwg % NXCD, xcd = wgid % NXCD, off = wgid / NXCD; wgid = (xcd < r ? xcd * (q + 1) : r * (q + 1) + (xcd - r) * q) + off; }
        const int nig = WGM * nN, gid = wgid / nig, fm = gid * WGM, gsz = (nM - fm) < WGM ? (nM - fm) : WGM;
        u.pm = fm + ((wgid % nig) % gsz); u.pn = (wgid % nig) / gsz; return true;
    }
    __device__ __forceinline__ void a_ready(const Unit&) const {}
    __device__ __forceinline__ void done(const Unit&) const {}
};
template <class Epi, class Sched, bool STAMP = false>
__device__ __forceinline__ void gemm_phase(PG8_LAS unsigned char* lds, const Gemm g, const Sched& S, const Epi& E, unsigned long long* stamps) {
    const int tid = tidx(), wid = __builtin_amdgcn_readfirstlane(tid >> 6), lane = tid & 63, wr = wid >> 2, wc = wid & 3, fr = lane & 15, fq = lane >> 4;
    const int K = g.K, nt = K / BK;
    int ts_lo = 0, ts_hi = 0, nts = 0; const unsigned long long rt_entry = STAMP ? (unsigned long long)wall_clock64() : 0ull;
#define PG8_STAMP() do { if (STAMP && wid == 0 && nts < 64) { const unsigned long long _c = (unsigned long long)clock64(); \
        ts_lo = (lane == nts) ? (int)(unsigned)_c : ts_lo; ts_hi = (lane == nts) ? (int)(unsigned)(_c >> 32) : ts_hi; ++nts; } } while (0)
    PG8_STAMP();
    unsigned voffA[2];
#pragma unroll
    for (int i = 0; i < 2; ++i) { int R, C; stage_rc(tid * 16 + i * 8192, R, C); const int Rb = Epi::PERM ? ((R & ~31) + perm32(R & 31)) : R;
        voffA[i] = (unsigned)(R * g.lda + C) * 2u; (void)Rb; }
#define voffB voffA
    const size_t kstep = (size_t)(BK * 2);
    const size_t hstep = (size_t)HALF * K * 2, hstepA = (size_t)HALF * g.lda * 2;
    const size_t tstep = 2 * hstep, tstepA = 2 * hstepA;
    const unsigned ldsw = (unsigned)wid * 1024u;
    const int aoff = lds_byte(wr * 64 + fr, fq * 8), boff = lds_byte(wc * 32 + fr, fq * 8);
#define PG8_SA(b, h) (((b) * 2 + (h)) * HTB)
#define PG8_SB(b, h) ((4 + (b) * 2 + (h)) * HTB)
#define PG8_STAGE(bufoff, gbase, voff) do { _Pragma("unroll") for (int _i = 0; _i < 2; ++_i) \
        __builtin_amdgcn_global_load_lds((const unsigned*)((const char*)(gbase) + (voff)[_i]), (PG8_LAS unsigned*)(lds + (bufoff) + ldsw + _i * 8192), 16, 0, 0); } while (0)
#define PG8_LDA(dst, b, h) do { _Pragma("unroll") for (int m = 0; m < 4; ++m) _Pragma("unroll") for (int k = 0; k < 2; ++k) dst[m][k] = *(const PG8_LAS bf16x8*)(lds + PG8_SA(b, h) + aoff + m * 2048 + k * 1024); } while (0)
#define PG8_LDB(dst, b, h) do { _Pragma("unroll") for (int n = 0; n < 2; ++n) _Pragma("unroll") for (int k = 0; k < 2; ++k) dst[n][k] = *(const PG8_LAS bf16x8*)(lds + PG8_SB(b, h) + boff + n * 2048 + k * 1024); } while (0)
#define PG8_MMA(ai, bj, At, Bt) do { __builtin_amdgcn_s_setprio(1); _Pragma("unroll") for (int m = 0; m < 4; ++m) _Pragma("unroll") for (int n = 0; n < 2; ++n) _Pragma("unroll") for (int k = 0; k < 2; ++k) \
        acc[ai][bj][m][n] = __builtin_amdgcn_mfma_f32_16x16x32_bf16(Bt[n][k], At[m][k], acc[ai][bj][m][n], 0, 0, 0); __builtin_amdgcn_s_setprio(0); } while (0)
#define PG8_WAIT_V(n) asm volatile("s_waitcnt vmcnt(" #n ")" ::: "memory")
#define PG8_WAIT_L(n) asm volatile("s_waitcnt lgkmcnt(" #n ")" ::: "memory")
#define PG8_BAR __builtin_amdgcn_s_barrier()
#define PG8_SCHED __builtin_amdgcn_sched_barrier(0)
    Unit cur, nxt; int ui = 0;
    if (!S.next(0, cur)) return;
    f32x4 acc[2][2][4][2];
#pragma unroll
    for (int a = 0; a < 2; ++a)
#pragma unroll
        for (int b = 0; b < 2; ++b)
#pragma unroll
            for (int m = 0; m < 4; ++m)
#pragma unroll
                for (int n = 0; n < 2; ++n) acc[a][b][m][n] = (f32x4){0.f, 0.f, 0.f, 0.f};
    bf16x8 At[4][2], B0[2][2], B1[2][2];
    const char* cA = (const char*)g.A + (size_t)cur.pm * tstepA; const char* cB = (const char*)g.Bt + (size_t)cur.pn * tstep;
    S.a_ready(cur);
    PG8_STAGE(PG8_SB(0, 0), cB, voffB); PG8_STAGE(PG8_SA(0, 0), cA, voffA); PG8_STAGE(PG8_SB(0, 1), cB + hstep, voffB); PG8_STAGE(PG8_SA(0, 1), cA + hstepA, voffA);
    if (wr == 1) PG8_BAR;
    PG8_WAIT_V(4); PG8_BAR;
    PG8_STAGE(PG8_SB(1, 0), cB + kstep, voffB); PG8_STAGE(PG8_SA(1, 0), cA + kstep, voffA); PG8_STAGE(PG8_SB(1, 1), cB + hstep + kstep, voffB);
    PG8_WAIT_V(6); PG8_BAR;
    PG8_STAMP();
    for (;;) {
        const bool has_next = S.next(ui + 1, nxt);
        const char* nA = has_next ? (const char*)g.A + (size_t)nxt.pm * tstepA : cA; const char* nB = has_next ? (const char*)g.Bt + (size_t)nxt.pn * tstep : cB;
        for (int t = 0; t < nt; t += 2) {
            const bool last = (t == nt - 2);
            const char* a1 = cA + (size_t)(t + 1) * kstep;
            const char* a2 = last ? nA : cA + (size_t)(t + 2) * kstep; const char* b2 = last ? nB : cB + (size_t)(t + 2) * kstep;
            const char* a3 = a2 + kstep; const char* b3 = b2 + kstep;
            if (last && has_next) S.a_ready(nxt);
            PG8_LDB(B0, 0, 0); PG8_SCHED; PG8_LDA(At, 0, 0); PG8_STAGE(PG8_SA(1, 1), a1 + hstepA, voffA);
            PG8_WAIT_L(8); PG8_BAR; PG8_WAIT_L(0); PG8_MMA(0, 0, At, B0); PG8_BAR; PG8_SCHED;
            PG8_LDB(B1, 0, 1); PG8_STAGE(PG8_SB(0, 0), b2, voffB);
            PG8_BAR; PG8_WAIT_L(0); PG8_MMA(0, 1, At, B1); PG8_BAR;
            PG8_LDA(At, 0, 1); PG8_STAGE(PG8_SA(0, 0), a2, voffA);
            PG8_BAR; PG8_WAIT_L(0); PG8_MMA(1, 0, At, B0); PG8_BAR; PG8_SCHED;
            PG8_STAGE(PG8_SB(0, 1), b2 + hstep, voffB);
            PG8_WAIT_V(6); PG8_BAR; PG8_MMA(1, 1, At, B1); PG8_BAR;
            PG8_LDB(B0, 1, 0); PG8_SCHED; PG8_LDA(At, 1, 0); PG8_STAGE(PG8_SA(0, 1), a2 + hstepA, voffA);
            PG8_WAIT_L(8); PG8_BAR; PG8_WAIT_L(0); PG8_MMA(0, 0, At, B0); PG8_BAR; PG8_SCHED;
            PG8_LDB(B1, 1, 1); PG8_STAGE(PG8_SB(1, 0), b3, voffB);
            PG8_BAR; PG8_WAIT_L(0); PG8_MMA(0, 1, At, B1); PG8_BAR;
            PG8_LDA(At, 1, 1); PG8_STAGE(PG8_SA(1, 0), a3, voffA);
            PG8_BAR; PG8_WAIT_L(0); PG8_MMA(1, 0, At, B0); PG8_BAR; PG8_SCHED;
            PG8_STAGE(PG8_SB(1, 1), b3 + hstep, voffB);
            PG8_WAIT_V(6); PG8_BAR; PG8_MMA(1, 1, At, B1); PG8_BAR;
        }
        PG8_STAMP();
        if constexpr (!Epi::AFTER_DRAIN) { E(acc, cur, wr, wc, fr, fq); S.done(cur); }
        PG8_STAMP();
        if (!has_next) break;
#pragma unroll
        for (int a = 0; a < 2; ++a)
#pragma unroll
            for (int b = 0; b < 2; ++b)
#pragma unroll
                for (int m = 0; m < 4; ++m)
#pragma unroll
                    for (int n = 0; n < 2; ++n) acc[a][b][m][n] = (f32x4){0.f, 0.f, 0.f, 0.f};
        cur = nxt; cA = nA; cB = nB; ++ui;
    }
    PG8_WAIT_V(0);
    if (wr == 0) PG8_BAR;
    PG8_BAR;
    if constexpr (Epi::AFTER_DRAIN) { E.fused(acc, cur, wr, wc, fr, fq, lds, wid, lane); S.done(cur); }
    PG8_STAMP();
    if (STAMP && wid == 0) { stamps[lane] = lane < nts ? (((unsigned long long)(unsigned)ts_hi << 32) | (unsigned)ts_lo) : 0ull;
        if (lane == 62) stamps[62] = rt_entry; if (lane == 63) stamps[63] = (unsigned long long)wall_clock64(); }
#undef PG8_STAMP
#undef PG8_SA
#undef PG8_SB
#undef PG8_STAGE
#undef PG8_LDA
#undef PG8_LDB
#undef PG8_MMA
#undef PG8_WAIT_V
#undef PG8_WAIT_L
#undef PG8_BAR
#undef PG8_SCHED
#undef voffB
}
}

struct EpiPlain {
    static constexpr bool PERM = false, AFTER_DRAIN = false;
    bf16_t* C; int ldc;
    __device__ __forceinline__ void operator()(const f32x4 (&acc)[2][2][4][2], const pg8::Unit& u, int, int, int, int) const {
        const int t_ = tidx(), wr = t_ >> 8, wc = (t_ >> 6) & 3, fr = t_ & 15, fq = (t_ >> 4) & 3;
#pragma unroll
        for (int ai = 0; ai < 2; ++ai)
#pragma unroll
            for (int m = 0; m < 4; ++m) { bf16_t* rowp = C + (size_t)(u.pm * 256 + ai * 128 + wr * 64 + m * 16 + fr) * ldc + u.pn * 256 + wc * 32 + 8 * fq;
#pragma unroll
                for (int bj = 0; bj < 2; ++bj) { const f32x4 v0 = acc[ai][bj][m][0], v1 = acc[ai][bj][m][1]; u32x4 w; w.x = cvt_pk(v0[0], v0[1]); w.y = cvt_pk(v0[2], v0[3]); w.z = cvt_pk(v1[0], v1[1]); w.w = cvt_pk(v1[2], v1[3]);
                    *(u32x4*)(rowp + bj * 128) = w; } }
    }
};
struct EpiF1 {
    static constexpr bool PERM = false, AFTER_DRAIN = false;
    const float* cw; const float* cb; bf16_t* act; bf16_t* E;
    __device__ __forceinline__ void operator()(const f32x4 (&acc)[2][2][4][2], const pg8::Unit& u, int, int, int, int) const {
        const int t_ = tidx(), wr = t_ >> 8, wc = (t_ >> 6) & 3, fr = t_ & 15, fq = (t_ >> 4) & 3;
        const int ch = u.pn * 128 + wc * 32 + 8 * fq;
#pragma unroll
        for (int ai = 0; ai < 2; ++ai) {
            const int strip = u.pm * 4 + ai * 2 + wr; const size_t rowbase = (size_t)u.pm * 256 + ai * 128 + wr * 64;
#pragma unroll
            for (int m = 0; m < 4; ++m) {
                const int rs = m * 16 + fr; f32x4 a[2];
#pragma unroll
                for (int n = 0; n < 2; ++n) {
                    const f32x4 c0 = *(const f32x4*)(cw + ch + 4 * n), c1 = *(const f32x4*)(cw + DFF + ch + 4 * n), c2 = *(const f32x4*)(cw + 2 * DFF + ch + 4 * n), cbv = *(const f32x4*)(cb + ch + 4 * n);
                    const f32x4 g0 = acc[ai][0][m][n], up = acc[ai][1][m][n]; f32x4 g1, g2;
#pragma unroll
                    for (int j = 0; j < 4; ++j) {
                        const float a1 = DPP_MOV(g0[j], 0x121), a2 = DPP_MOV(g0[j], 0x122);
                        float b1 = 0.f, b2 = 0.f;
                        if (m > 0) { b1 = DPP_MOV(acc[ai][0][m > 0 ? m - 1 : 0][n][j], 0x121); b2 = DPP_MOV(acc[ai][0][m > 0 ? m - 1 : 0][n][j], 0x122); }
                        g1[j] = fr >= 1 ? a1 : b1; g2[j] = fr >= 2 ? a2 : b2;
                    }
                    const f32x4 val = c2 * g0 + c1 * g1 + c0 * g2 + cbv;
#pragma unroll
                    for (int j = 0; j < 4; ++j) a[n][j] = val[j] * rcpf_(1.0f + __expf(-val[j])) * up[j];
                }
                const f32x4 gA = acc[ai][0][m][0], gB = acc[ai][0][m][1], uA = acc[ai][1][m][0], uB = acc[ai][1][m][1];
                u32x4 w;
                if (rs >= 2) { w.x = cvt_pk(a[0][0], a[0][1]); w.y = cvt_pk(a[0][2], a[0][3]); w.z = cvt_pk(a[1][0], a[1][1]); w.w = cvt_pk(a[1][2], a[1][3]); *(u32x4*)(act + (rowbase + rs) * DFF + ch) = w; }
                else { w.x = cvt_pk(gA[0], gA[1]); w.y = cvt_pk(gA[2], gA[3]); w.z = cvt_pk(gB[0], gB[1]); w.w = cvt_pk(gB[2], gB[3]); *(u32x4*)(E + ((size_t)strip * 6 + 2 + rs) * DFF + ch) = w;
                       w.x = cvt_pk(uA[0], uA[1]); w.y = cvt_pk(uA[2], uA[3]); w.z = cvt_pk(uB[0], uB[1]); w.w = cvt_pk(uB[2], uB[3]); *(u32x4*)(E + ((size_t)strip * 6 + 4 + rs) * DFF + ch) = w; }
                if (rs >= 62) { w.x = cvt_pk(gA[0], gA[1]); w.y = cvt_pk(gA[2], gA[3]); w.z = cvt_pk(gB[0], gB[1]); w.w = cvt_pk(gB[2], gB[3]); *(u32x4*)(E + ((size_t)strip * 6 + (rs - 62)) * DFF + ch) = w; }
            }
        }
    }
};
struct EpiScale {
    static constexpr bool PERM = false, AFTER_DRAIN = false;
    bf16_t* C; int ldc; float scale;
    __device__ __forceinline__ void operator()(const f32x4 (&acc)[2][2][4][2], const pg8::Unit& u, int, int, int, int) const {
        const int t_ = tidx(), wr = t_ >> 8, wc = (t_ >> 6) & 3, fr = t_ & 15, fq = (t_ >> 4) & 3;
#pragma unroll
        for (int ai = 0; ai < 2; ++ai)
#pragma unroll
            for (int m = 0; m < 4; ++m) { bf16_t* rowp = C + (size_t)(u.pm * 256 + ai * 128 + wr * 64 + m * 16 + fr) * ldc + u.pn * 256 + wc * 32 + 4 * fq;
#pragma unroll
                for (int bj = 0; bj < 2; ++bj)
#pragma unroll
                    for (int n = 0; n < 2; ++n) st_bf4(rowp + bj * 128 + n * 16, acc[ai][bj][m][n] * scale); }
    }
};
struct EpiN1kv {
    static constexpr bool PERM = false, AFTER_DRAIN = false;
    bf16_t* kv;
    __device__ __forceinline__ void operator()(const f32x4 (&acc)[2][2][4][2], const pg8::Unit& u, int, int, int, int) const {
        const int t_ = tidx(), wr = t_ >> 8, wc = (t_ >> 6) & 3, fr = t_ & 15, fq = (t_ >> 4) & 3;
        char* base = (char*)kv;
#pragma unroll
        for (int ai = 0; ai < 2; ++ai)
#pragma unroll
            for (int m = 0; m < 4; ++m) {
                const size_t row = (size_t)u.pm * 256 + ai * 128 + wr * 64 + m * 16 + fr;
#pragma unroll
                for (int bj = 0; bj < 2; ++bj)
#pragma unroll
                    for (int n = 0; n < 2; ++n) {
                        const int c128 = wc * 32 + n * 16 + fq * 4; const f32x4 v = acc[ai][bj][m][n];
                        if (u.pn < 3) {
                            const int cc = u.pn * 2 + bj;
                            if (cc == 0 || cc == 1 || cc == 4) { const size_t off = cc == 0 ? 0 : cc == 1 ? 8 * MiB : 24 * MiB; st_bf4((bf16_t*)(base + off) + row * 128 + c128, v); }
                            else if (cc == 2) { const int b = (int)(row >> 13), t = (int)(row & (SEQ - 1));
                                *(unsigned*)((unsigned char*)(base + 16 * MiB) + ((size_t)((b * 2 + (c128 >> 6)) * SEQ + t)) * 64 + (c128 & 63)) = pack_fp8x4(v[0], v[1], v[2], v[3]); }
                            else if (cc == 3) { const int b = (int)(row >> 13), t = (int)(row & (SEQ - 1));
                                unsigned char* dst = (unsigned char*)(base + 32 * MiB) + ((size_t)((b * 2 + (c128 >> 6)) * 128 + (t >> 6)) * 64 + (c128 & 63)) * 64 + (t & 63);
                                const unsigned pk = pack_fp8x4(v[0], v[1], v[2], v[3]);
                                for (int j = 0; j < 4; ++j) dst[j * 64] = (unsigned char)(pk >> (8 * j)); }
                            else { bf16_t* dst = (bf16_t*)(base + 40 * MiB); const int b = (int)(row >> 13), t = (int)(row & (SEQ - 1));
                                for (int j = 0; j < 4; ++j) dst[((size_t)(b * 128 + c128 + j)) * SEQ + t] = f2bf(v[j]); }
                        } else { if (bj == 0 && c128 < 48) { float* gates = (float*)(base + 48 * MiB); for (int j = 0; j < 4; ++j) gates[row * 48 + c128 + j] = sigmoidf_(v[j]); } }
                    }
            }
    }
};
struct EpiL1 {
    static constexpr bool PERM = false, AFTER_DRAIN = false;
    bf16_t *qe, *ke, *vT, *r; float* adn;
    __device__ __forceinline__ void operator()(const f32x4 (&acc)[2][2][4][2], const pg8::Unit& u, int, int, int, int) const {
        const int t_ = tidx(), wr = t_ >> 8, wc = (t_ >> 6) & 3, fr = t_ & 15, fq = (t_ >> 4) & 3;
#pragma unroll
        for (int ai = 0; ai < 2; ++ai)
#pragma unroll
            for (int m = 0; m < 4; ++m) {
                const size_t row = (size_t)u.pm * 256 + ai * 128 + wr * 64 + m * 16 + fr;
#pragma unroll
                for (int bj = 0; bj < 2; ++bj)
#pragma unroll
                    for (int n = 0; n < 2; ++n) {
                        const int c = bj * 128 + wc * 32 + n * 16 + fq * 4; const f32x4 v = acc[ai][bj][m][n];
                        if (u.pn < 2) st_bf4(qe + row * 512 + u.pn * 256 + c, v * 0.08838834764831845f);
                        else if (u.pn < 4) st_bf4(ke + row * 512 + (u.pn - 2) * 256 + c, v);
                        else if (u.pn < 8) { const int b = (int)(row >> 13), t = (int)(row & (SEQ - 1)), vc = (u.pn - 4) * 256 + c;
                            for (int j = 0; j < 4; ++j) vT[((size_t)(b * 1024 + vc + j)) * SEQ + t] = f2bf(v[j]); }
                        else if (u.pn < 12) st_bf4(r + row * DM + (u.pn - 8) * 256 + c, v);
                        else { if (c < 16) *(f32x4*)(adn + row * 16 + c) = v; }
                    }
            }
    }
};
template <class Epi>
DEV void phase_gemm_pg8(const bf16_t* A, int lda, const bf16_t* Bt, int N, int K, const Epi& E, char* smem) {
    pg8::Gemm g; g.A = A; g.Bt = Bt; g.M = T; g.N = N; g.K = K; g.lda = lda;
    pg8::StaticOrder S; S.init(T, N, (int)gridDim.x, (int)blockIdx.x);
    pg8::gemm_phase<Epi, pg8::StaticOrder, false>((PG8_LAS unsigned char*)smem, g, S, E, nullptr);
}
struct LaneId { int lane, wid, wm, wn, fr, fq; };
DEV LaneId lane_id() { LaneId l; l.lane = tidx() & 63; l.wid = tidx() >> 6; l.wm = l.wid >> 1; l.wn = l.wid & 1; l.fr = l.lane & 15; l.fq = l.lane >> 4; return l; }

template <class Map>
DEV void prep_T(bf16_t* dst, const float* src, int Ks, int Ns, int Nd, int Kd, Map map, char* smem, int& cursor) {
    float* tile = (float*)smem;
    const int ntn = Nd >> 6, ntiles = ntn * (Kd >> 6), tid = tidx(), G = (int)gridDim.x;
    int first = ((int)blockIdx.x - cursor) % G; if (first < 0) first += G;
    for (int tl = first; tl < ntiles; tl += G) {
        const int n0 = (tl % ntn) * 64, k0 = (tl / ntn) * 64;
        { const int j4 = (tid & 15) * 4, kr = tid >> 4;
          const int m0 = map(n0 + j4), m3 = map(n0 + j4 + 3);
          const bool vec = (m0 >= 0) && (m3 == m0 + 3) && ((Ns & 3) == 0) && ((m0 & 3) == 0);
#pragma unroll
          for (int p = 0; p < 2; ++p) { const int kk = kr + 32 * p, k = k0 + kk; f32x4 v = {0.f, 0.f, 0.f, 0.f};
              if (k < Ks) { if (vec) v = *(const f32x4*)(src + (size_t)k * Ns + m0);
                            else { for (int q = 0; q < 4; ++q) { const int n = map(n0 + j4 + q); v[q] = n >= 0 ? src[(size_t)k * Ns + n] : 0.f; } } }
              tile[kk * 65 + j4] = v[0]; tile[kk * 65 + j4 + 1] = v[1]; tile[kk * 65 + j4 + 2] = v[2]; tile[kk * 65 + j4 + 3] = v[3]; } }
        __syncthreads();
        { const int r = tid >> 3, c8 = (tid & 7) * 8;
          u32x4 w; w.x = cvt_pk(tile[(c8 + 0) * 65 + r], tile[(c8 + 1) * 65 + r]); w.y = cvt_pk(tile[(c8 + 2) * 65 + r], tile[(c8 + 3) * 65 + r]);
          w.z = cvt_pk(tile[(c8 + 4) * 65 + r], tile[(c8 + 5) * 65 + r]); w.w = cvt_pk(tile[(c8 + 6) * 65 + r], tile[(c8 + 7) * 65 + r]);
          *(u32x4*)(dst + (size_t)(n0 + r) * Kd + k0 + c8) = w; }
        __syncthreads();
    }
    cursor += ntiles;
}
struct MapId { int ns; DEV int operator()(int n) const { return n < ns ? n : -1; } };
struct MapPerm { int ns; DEV int operator()(int n) const { return n < ns ? (n & ~31) + pg8::perm32(n & 31) : -1; } };
struct MapFfn { DEV int operator()(int v) const { const int pn = v >> 8, c = v & 255, cc = (c & 96) + pg8::perm32(c & 31); return c < 128 ? 128 * pn + cc : DFF + 128 * pn + cc; } };

DEV void phase_prep(const Params& P, int layer, char* smem) {
    char* ws = P.ws; int cur = 0;
    const int kind = layer % 3, j = layer / 3;
    prep_T((bf16_t*)(ws + OFF_WF1), P.in[I_FWIN] + (size_t)layer * DM * 2 * DFF, DM, 2 * DFF, 2 * DFF, DM, MapFfn{}, smem, cur);
    prep_T((bf16_t*)(ws + OFF_WF2), P.in[I_FWOUT] + (size_t)layer * DFF * DM, DFF, DM, DM, DFF, MapPerm{DM}, smem, cur);
    bf16_t* mix = (bf16_t*)(ws + OFF_MIX);
    if (kind == 0) {
        const float* wrkv = P.in[I_WRKV] + (size_t)j * 3 * DM * DM;
        prep_T(mix, wrkv, DM, DM, DM, DM, MapPerm{DM}, smem, cur);
        prep_T(mix + (size_t)1024 * DM, wrkv + (size_t)DM * DM, DM, DM, DM, DM, MapPerm{DM}, smem, cur);
        prep_T(mix + (size_t)2048 * DM, P.in[I_W1] + (size_t)j * DM * 64, DM, 64, 128, DM, MapId{64}, smem, cur);
        prep_T(mix + (size_t)2176 * DM, P.in[I_A1] + (size_t)j * DM * 64, DM, 64, 128, DM, MapId{64}, smem, cur);
        prep_T(mix + (size_t)2304 * DM, P.in[I_G1] + (size_t)j * DM * 128, DM, 128, 128, DM, MapId{128}, smem, cur);
        if (j > 0) prep_T(mix + (size_t)2432 * DM, P.in[I_V1] + (size_t)(j - 1) * DM * 32, DM, 32, 128, DM, MapId{32}, smem, cur);
        else       prep_T(mix + (size_t)2432 * DM, P.in[I_V1], DM, 32, 128, DM, MapId{0}, smem, cur);
        prep_T((bf16_t*)((char*)mix + 5 * MiB), wrkv + (size_t)2 * DM * DM, DM, DM, DM, DM, MapPerm{DM}, smem, cur);
        prep_T((bf16_t*)((char*)mix + 7 * MiB), P.in[I_W2] + (size_t)j * 64 * DM, 64, DM, DM, 64, MapId{DM}, smem, cur);
        prep_T((bf16_t*)((char*)mix + 7 * MiB + 131072), P.in[I_A2] + (size_t)j * 64 * DM, 64, DM, DM, 64, MapId{DM}, smem, cur);
        if (j > 0) prep_T((bf16_t*)((char*)mix + 7 * MiB + 262144), P.in[I_V2] + (size_t)(j - 1) * 32 * DM, 32, DM, DM, 64, MapId{DM}, smem, cur);
        prep_T((bf16_t*)((char*)mix + 7 * MiB + 393216), P.in[I_G2] + (size_t)j * 128 * DM, 128, DM, DM, 128, MapId{DM}, smem, cur);
        prep_T((bf16_t*)((char*)mix + 8 * MiB), P.in[I_RWO] + (size_t)j * DM * DM, DM, DM, DM, DM, MapPerm{DM}, smem, cur);
    } else if (kind == 1) {
        prep_T(mix, P.in[I_NWIN], DM, 1840, 2048, DM, MapId{1840}, smem, cur);
        prep_T((bf16_t*)((char*)mix + 4 * MiB), P.in[I_CW1], 2048, 256, 256, 2048, MapId{256}, smem, cur);
        prep_T((bf16_t*)((char*)mix + 4 * MiB) + (size_t)256 * 2048, P.in[I_CW1] + (size_t)2048 * 256, 2048, 256, 256, 2048, MapId{256}, smem, cur);
        prep_T((bf16_t*)((char*)mix + 6 * MiB), P.in[I_CW2], 256, 64, 128, 256, MapId{64}, smem, cur);
        prep_T((bf16_t*)((char*)mix + 6 * MiB) + (size_t)128 * 256, P.in[I_CW2] + (size_t)256 * 64, 256, 64, 128, 256, MapId{64}, smem, cur);
        prep_T((bf16_t*)((char*)mix + 7 * MiB), P.in[I_NWO], DM, DM, DM, DM, MapPerm{DM}, smem, cur);
        { const int lane = tidx() & 63, gw = blockIdx.x * (NTHR / 64) + (tidx() >> 6);
          if (gw < 512) { const int c = gw >> 8, col = gw & 255; const float* w1 = P.in[I_CW1] + (size_t)c * 2048 * 256; const float* pe = P.in[I_CPE] + (size_t)c * 2048;
              float sacc = 0.f; for (int k = lane; k < 2048; k += 64) sacc += pe[k] * w1[(size_t)k * 256 + col];
              sacc = wave_sum(sacc); if (lane == 0) ((float*)(ws + OFF_BIASP))[gw] = sacc + P.in[I_CB1][c * 256 + col]; } }
    } else {
        prep_T(mix, P.in[I_GWIN], DM, 3088, 3328, DM, MapId{3088}, smem, cur);
        prep_T((bf16_t*)((char*)mix + 7 * MiB), P.in[I_GWO], DM, DM, DM, DM, MapPerm{DM}, smem, cur);
    }
}

template <int HIN, int HOUT>
DEV void phase_norm(const void* h_in, const bf16_t* z, const float* g_post, void* h_out, float* stage, const float* g_pre, bf16_t* xn) {
    const int lane = tidx() & 63, gw = blockIdx.x * (NTHR / 64) + (tidx() >> 6), nw = gridDim.x * (NTHR / 64);
    for (int row = gw; row < T; row += nw) {
        f32x4 hv[4];
#pragma unroll
        for (int i = 0; i < 4; ++i) { const size_t off = (size_t)row * DM + i * 256 + lane * 4;
            if (HIN == 0) hv[i] = *(const f32x4*)((const float*)h_in + off); else hv[i] = ld_bf4((const bf16_t*)h_in + off); }
        if (z) {
            f32x4 zv[4]; float ss = 0.f;
#pragma unroll
            for (int i = 0; i < 4; ++i) { zv[i] = ld_bf4(z + (size_t)row * DM + i * 256 + lane * 4); ss += zv[i][0] * zv[i][0] + zv[i][1] * zv[i][1] + zv[i][2] * zv[i][2] + zv[i][3] * zv[i][3]; }
            ss = wave_sum(ss); const float rs = rsqrtf(ss * (1.0f / DM) + 1e-6f);
#pragma unroll
            for (int i = 0; i < 4; ++i) { const f32x4 g = *(const f32x4*)(g_post + i * 256 + lane * 4); hv[i] += zv[i] * rs * g; }
        }
        if (HOUT == 1) {
#pragma unroll
            for (int i = 0; i < 4; ++i) st_bf4((bf16_t*)h_out + (size_t)row * DM + i * 256 + lane * 4, hv[i]);
        }
        if (HOUT == 2) {
            float* dst = row < T / 2 ? (float*)h_out + (size_t)row * DM : stage + (size_t)(row - T / 2) * DM;
#pragma unroll
            for (int i = 0; i < 4; ++i) *(f32x4*)(dst + i * 256 + lane * 4) = hv[i];
        }
        if (xn) {
            float ss = 0.f;
#pragma unroll
            for (int i = 0; i < 4; ++i) ss += hv[i][0] * hv[i][0] + hv[i][1] * hv[i][1] + hv[i][2] * hv[i][2] + hv[i][3] * hv[i][3];
            ss = wave_sum(ss); const float rs = rsqrtf(ss * (1.0f / DM) + 1e-6f);
#pragma unroll
            for (int i = 0; i < 4; ++i) { const f32x4 g = *(const f32x4*)(g_pre + i * 256 + lane * 4); st_bf4(xn + (size_t)row * DM + i * 256 + lane * 4, hv[i] * rs * g); }
        }
    }
}
DEV void phase_copy_out(const float* stage, float* out) {
    const size_t gt = (size_t)blockIdx.x * NTHR + tidx(), nt = (size_t)gridDim.x * NTHR;
    for (size_t i = gt; i < (size_t)(T / 2) * DM / 4; i += nt) ((f32x4*)(out + (size_t)(T / 2) * DM))[i] = ((const f32x4*)stage)[i];
}

DEV void phase_gemm_plain(const bf16_t* A, int lda, const bf16_t* Bt, int K, int ntn, bf16_t* C, int ldc, char* smem) {
    const LaneId L = lane_id();
    const int nunits = (T / 256) * ntn;
    for (int u = blockIdx.x; u < nunits; u += gridDim.x) {
        const int tm = u / ntn, tn = u % ntn;
        f32x4 acc[4][4];
        gemm_core(acc, LdPlain{A + (size_t)tm * 256 * lda, lda}, LdPlain{Bt + (size_t)tn * 128 * K, K}, K, smem);
#pragma unroll
        for (int m = 0; m < 4; ++m)
#pragma unroll
            for (int n = 0; n < 4; ++n)
                st_bf4(C + (size_t)(tm * 256 + L.wm * 64 + m * 16 + L.fr) * ldc + tn * 128 + L.wn * 64 + n * 16 + L.fq * 4, acc[m][n]);
    }
}

DEV void phase_f1(const bf16_t* xn, const bf16_t* Bt, const float* cw, const float* cb, bf16_t* act, bf16_t* E, char* smem) {
    const LaneId L = lane_id();
    const int ntn = 2 * DFF / 128, nunits = (T / 256) * ntn;
    for (int u = blockIdx.x; u < nunits; u += gridDim.x) {
        const int tm = u / ntn, tn = u % ntn;
        f32x4 acc[4][4];
        gemm_core(acc, LdPlain{xn + (size_t)tm * 256 * DM, DM}, LdPlain{Bt + (size_t)tn * 128 * DM, DM}, DM, smem);
        const int strip = tm * 4 + L.wm; const size_t rowbase = (size_t)tm * 256 + L.wm * 64;
#pragma unroll
        for (int n = 0; n < 2; ++n) {
            const int ch = tn * 64 + L.wn * 32 + n * 16 + L.fq * 4;
            const f32x4 c0 = *(const f32x4*)(cw + ch), c1 = *(const f32x4*)(cw + DFF + ch), c2 = *(const f32x4*)(cw + 2 * DFF + ch), cbv = *(const f32x4*)(cb + ch);
#pragma unroll
            for (int m = 0; m < 4; ++m) {
                const f32x4 g0 = acc[m][n], up = acc[m][n + 2]; f32x4 g1, g2;
#pragma unroll
                for (int j = 0; j < 4; ++j) {
                    const float a1 = __shfl(g0[j], (L.lane - 1) & 63), a2 = __shfl(g0[j], (L.lane - 2) & 63);
                    float b1 = 0.f, b2 = 0.f;
                    if (m > 0) { b1 = __shfl(acc[m > 0 ? m - 1 : 0][n][j], (L.lane + 15) & 63); b2 = __shfl(acc[m > 0 ? m - 1 : 0][n][j], (L.lane + 14) & 63); }
                    g1[j] = L.fr >= 1 ? a1 : b1; g2[j] = L.fr >= 2 ? a2 : b2;
                }
                const int rs = m * 16 + L.fr;
                f32x4 val = c2 * g0 + c1 * g1 + c0 * g2 + cbv, a;
#pragma unroll
                for (int j = 0; j < 4; ++j) a[j] = val[j] * rcpf_(1.0f + __expf(-val[j])) * up[j];
                if (rs >= 2) st_bf4(act + (rowbase + rs) * DFF + ch, a);
                else { st_bf4(E + ((size_t)strip * 6 + 2 + rs) * DFF + ch, g0); st_bf4(E + ((size_t)strip * 6 + 4 + rs) * DFF + ch, up); }
                if (rs >= 62) st_bf4(E + ((size_t)strip * 6 + (rs - 62)) * DFF + ch, g0);
            }
        }
    }
}
DEV void phase_f1b(const float* cw, const float* cb, bf16_t* act, const bf16_t* E) {
    const int gt = blockIdx.x * NTHR + tidx(), nt = gridDim.x * NTHR;
    for (int idx = gt; idx < 512 * 2 * (DFF / 4); idx += nt) {
        const int ch = (idx % (DFF / 4)) * 4, r = (idx / (DFF / 4)) & 1, strip = idx / (2 * (DFF / 4));
        const bool first = (strip & 127) == 0;
        const f32x4 zero = {0.f, 0.f, 0.f, 0.f};
        const f32x4 g0 = ld_bf4(E + ((size_t)strip * 6 + 2 + r) * DFF + ch), up = ld_bf4(E + ((size_t)strip * 6 + 4 + r) * DFF + ch);
        f32x4 g1, g2;
        if (r == 1) { g1 = ld_bf4(E + ((size_t)strip * 6 + 2) * DFF + ch); g2 = first ? zero : ld_bf4(E + ((size_t)(strip - 1) * 6 + 1) * DFF + ch); }
        else { g1 = first ? zero : ld_bf4(E + ((size_t)(strip - 1) * 6 + 1) * DFF + ch); g2 = first ? zero : ld_bf4(E + ((size_t)(strip - 1) * 6 + 0) * DFF + ch); }
        const f32x4 c0 = *(const f32x4*)(cw + ch), c1 = *(const f32x4*)(cw + DFF + ch), c2 = *(const f32x4*)(cw + 2 * DFF + ch), cbv = *(const f32x4*)(cb + ch);
        f32x4 val = c2 * g0 + c1 * g1 + c0 * g2 + cbv, a;
#pragma unroll
        for (int j = 0; j < 4; ++j) a[j] = val[j] * rcpf_(1.0f + __expf(-val[j])) * up[j];
        st_bf4(act + ((size_t)strip * 64 + r) * DFF + ch, a);
    }
}

struct RwkvW { const float *mu, *w0, *a0, *k_k, *k_a, *r_k, *ln_w, *ln_b, *v0; bool vres; };
DEV void phase_rmix(const bf16_t* xn, const float* mu, bf16_t* xr, bf16_t* xk, bf16_t* xv) {
    const int gt = blockIdx.x * NTHR + tidx(), nt = gridDim.x * NTHR;
    for (int idx = gt; idx < T * 128; idx += nt) {
        const int row = idx >> 7, c8 = (idx & 127) * 8; const size_t off = (size_t)row * DM + c8;
        const u32x4 cur = *(const u32x4*)(xn + off); u32x4 prv = {0u, 0u, 0u, 0u};
        if ((row & (SEQ - 1)) != 0) prv = *(const u32x4*)(xn + off - DM);
        f32x4 x0, x1, d0, d1;
        x0[0] = bf_lo(cur.x); x0[1] = bf_hi(cur.x); x0[2] = bf_lo(cur.y); x0[3] = bf_hi(cur.y); x1[0] = bf_lo(cur.z); x1[1] = bf_hi(cur.z); x1[2] = bf_lo(cur.w); x1[3] = bf_hi(cur.w);
        d0[0] = bf_lo(prv.x) - x0[0]; d0[1] = bf_hi(prv.x) - x0[1]; d0[2] = bf_lo(prv.y) - x0[2]; d0[3] = bf_hi(prv.y) - x0[3];
        d1[0] = bf_lo(prv.z) - x1[0]; d1[1] = bf_hi(prv.z) - x1[1]; d1[2] = bf_lo(prv.w) - x1[2]; d1[3] = bf_hi(prv.w) - x1[3];
#pragma unroll
        for (int c = 0; c < 3; ++c) { const float* mp = mu + (c == 0 ? 0 : c == 1 ? 2 : 3) * DM + c8; const f32x4 m0 = *(const f32x4*)mp, m1 = *(const f32x4*)(mp + 4);
            const f32x4 y0 = x0 + d0 * m0, y1 = x1 + d1 * m1; u32x4 w; w.x = cvt_pk(y0[0], y0[1]); w.y = cvt_pk(y0[2], y0[3]); w.z = cvt_pk(y1[0], y1[1]); w.w = cvt_pk(y1[2], y1[3]);
            *(u32x4*)((c == 0 ? xr : c == 1 ? xk : xv) + off) = w; }
    }
}
DEV void phase_r1(const bf16_t* xn, const bf16_t* Bt, const RwkvW& W, bf16_t* hid, char* smem) {
    const LaneId L = lane_id();
    const int ntn = 4, nunits = (T / 256) * ntn;
    for (int u = blockIdx.x; u < nunits; u += gridDim.x) {
        const int tm = u / ntn, tn = 16 + u % ntn;
        const int var = tn == 16 ? 1 : tn == 17 ? 4 : tn == 18 ? 5 : 3;
        f32x4 acc[4][4];
        gemm_core(acc, LdMix{xn, W.mu + var * DM, tm * 256, {0.f, 0.f, 0.f, 0.f}, {0.f, 0.f, 0.f, 0.f}}, LdPlain{Bt + (size_t)tn * 128 * DM, DM}, DM, smem);
#pragma unroll
        for (int m = 0; m < 4; ++m)
#pragma unroll
            for (int n = 0; n < 4; ++n) {
                const size_t row = (size_t)tm * 256 + L.wm * 64 + m * 16 + L.fr; const int c = L.wn * 64 + n * 16 + L.fq * 4; f32x4 v = acc[m][n];
                if (tn == 16) { if (L.wn == 0) { for (int j = 0; j < 4; ++j) v[j] = tanhf(v[j]); st_bf4(hid + row * HIDP + c, v); } }
                else if (tn == 17) { if (L.wn == 0) st_bf4(hid + row * HIDP + 64 + c, v); }
                else if (tn == 18) { for (int j = 0; j < 4; ++j) v[j] = sigmoidf_(v[j]); st_bf4(hid + row * HIDP + 128 + c, v); }
                else { if (L.wn == 0) st_bf4(hid + row * HIDP + 256 + c, v); }
            }
    }
}
DEV void phase_r2(const bf16_t* vraw, const bf16_t* mixw, const RwkvW& W, const bf16_t* hid, const bf16_t* rb, float* bsc, bf16_t* wb, bf16_t* kb, bf16_t* kkb, bf16_t* kab, bf16_t* vb, char* smem) {
    const LaneId L = lane_id();
    const bf16_t* W2T = (const bf16_t*)((const char*)mixw + 7 * MiB);
    const bf16_t* A2T = (const bf16_t*)((const char*)mixw + 7 * MiB + 131072);
    const bf16_t* V2T = (const bf16_t*)((const char*)mixw + 7 * MiB + 262144);
    const int nunits = 1024 + 2048;
    for (int u = blockIdx.x + (W.vres ? 0 : 1024); u < nunits; u += gridDim.x) {
        if (u < 1024) {
            const int tm = u >> 3, tn = u & 7;
            f32x4 acc[4][4]; u32x2 gpk[4][4];
            {
                gemm_core(acc, LdPlain{hid + (size_t)tm * 256 * HIDP + 256, HIDP}, LdPlain{V2T + (size_t)tn * 128 * 64, 64}, 64, smem);
#pragma unroll
                for (int m = 0; m < 4; ++m)
#pragma unroll
                    for (int n = 0; n < 4; ++n) { const int col = tn * 128 + L.wn * 64 + n * 16 + L.fq * 4; const f32x4 b = *(const f32x4*)(W.v0 + col);
                        gpk[m][n].x = cvt_pk(sigmoidf_(b[0] + acc[m][n][0]), sigmoidf_(b[1] + acc[m][n][1]));
                        gpk[m][n].y = cvt_pk(sigmoidf_(b[2] + acc[m][n][2]), sigmoidf_(b[3] + acc[m][n][3])); }
            }
#pragma unroll
            for (int m = 0; m < 4; ++m)
#pragma unroll
                for (int n = 0; n < 4; ++n) {
                    const size_t row = (size_t)tm * 256 + L.wm * 64 + m * 16 + L.fr; const int col = tn * 128 + L.wn * 64 + n * 16 + L.fq * 4; f32x4 v = ld_bf4(vraw + row * DM + col);
                    const f32x4 vf = ld_bf4(vb + row * DM + col); f32x4 gt; gt[0] = bf_lo(gpk[m][n].x); gt[1] = bf_hi(gpk[m][n].x); gt[2] = bf_lo(gpk[m][n].y); gt[3] = bf_hi(gpk[m][n].y); v = v + (vf - v) * gt;
                    st_bf4(vb + row * DM + col, v);
                }
        } else {
            const int u2 = u - 1024, tm = u2 >> 4, jj = u2 & 15;
            f32x4 acc[4][4];
            if (jj < 8) {
                const int tn = jj;
                gemm_core(acc, LdPlain{hid + (size_t)tm * 256 * HIDP, HIDP}, LdPlain{W2T + (size_t)tn * 128 * 64, 64}, 64, smem);
#pragma unroll
                for (int m = 0; m < 4; ++m)
#pragma unroll
                    for (int n = 0; n < 4; ++n) {
                        const size_t row = (size_t)tm * 256 + L.wm * 64 + m * 16 + L.fr; const int col = tn * 128 + L.wn * 64 + n * 16 + L.fq * 4; const f32x4 b = *(const f32x4*)(W.w0 + col); f32x4 v;
                        for (int j = 0; j < 4; ++j) { const float x = b[j] + acc[m][n][j]; const float y = -x;
                            const float sp = fmaxf(y, 0.f) + log1pf(__expf(-fabsf(y))); const float w = -sp - 0.5f; v[j] = __expf(-__expf(w)); }
                        st_bf4(wb + row * DM + col, v);
                    }
            } else {
                const int tn = jj - 8;
                gemm_core(acc, LdPlain{hid + (size_t)tm * 256 * HIDP + 64, HIDP}, LdPlain{A2T + (size_t)tn * 128 * 64, 64}, 64, smem);
#pragma unroll
                for (int m = 0; m < 4; ++m) {
                    const size_t row = (size_t)tm * 256 + L.wm * 64 + m * 16 + L.fr;
                    u32x2 kpk[4]; float ss = 0.f;
#pragma unroll
                    for (int n = 0; n < 4; ++n) { const int col = tn * 128 + L.wn * 64 + n * 16 + L.fq * 4;
                        kpk[n] = *(const u32x2*)(kb + row * DM + col); const f32x4 kkw = *(const f32x4*)(W.k_k + col);
                        const float c0 = bf_lo(kpk[n].x) * kkw[0], c1 = bf_hi(kpk[n].x) * kkw[1], c2 = bf_lo(kpk[n].y) * kkw[2], c3 = bf_hi(kpk[n].y) * kkw[3];
                        ss += (c0 * c0 + c1 * c1) + (c2 * c2 + c3 * c3); }
                    ss += __shfl_xor(ss, 16); ss += __shfl_xor(ss, 32);
                    const float inv = rcpf_(fmaxf(sqrtf(ss), 1e-12f));
                    asm volatile("" ::: "memory");
                    float bon = 0.f;
#pragma unroll
                    for (int n = 0; n < 4; ++n) { const int col = tn * 128 + L.wn * 64 + n * 16 + L.fq * 4;
                        const f32x4 ka = *(const f32x4*)(W.k_a + col), kkw = *(const f32x4*)(W.k_k + col), a0 = *(const f32x4*)(W.a0 + col), rkv = *(const f32x4*)(W.r_k + col), rv = ld_bf4(rb + row * DM + col);
                        f32x4 kv; kv[0] = bf_lo(kpk[n].x); kv[1] = bf_hi(kpk[n].x); kv[2] = bf_lo(kpk[n].y); kv[3] = bf_hi(kpk[n].y);
                        f32x4 kk, kp, kka;
                        for (int j = 0; j < 4; ++j) { const float a = sigmoidf_(a0[j] + acc[m][n][j]); kk[j] = kv[j] * kkw[j] * inv; kp[j] = kv[j] * (1.0f + (a - 1.0f) * ka[j]); kka[j] = kk[j] * a; }
                        const u32x2 kpp = {cvt_pk(kp[0], kp[1]), cvt_pk(kp[2], kp[3])};
                        bon += rv[0] * bf_lo(kpp.x) * rkv[0] + rv[1] * bf_hi(kpp.x) * rkv[1] + rv[2] * bf_lo(kpp.y) * rkv[2] + rv[3] * bf_hi(kpp.y) * rkv[3];
                        *(u32x2*)(kb + row * DM + col) = kpp; st_bf4(kkb + row * DM + col, kk); st_bf4(kab + row * DM + col, kka);
                        asm volatile("" ::: "memory"); }
                    bon += __shfl_xor(bon, 16); bon += __shfl_xor(bon, 32);
                    if (L.fq == 0) bsc[row * 16 + tn * 2 + L.wn] = bon;
                }
            }
        }
    }
}
typedef float f32x2 __attribute__((ext_vector_type(2)));
constexpr int R3_CH = 32, R3_STR = R3_CH * 256, R3_BUF = 5 * R3_STR + R3_CH * 64;
DEV void r3_stage_raw(const bf16_t* const (&str)[5], const bf16_t* vb, size_t base, int vrow0, int t0, char* buf, int id) {
    u32x4 d[5];
    const int t = id >> 3, j = id & 7;
#pragma unroll
    for (int st = 0; st < 5; ++st) d[st] = *(const u32x4*)(str[st] + base + (size_t)(t0 + t) * DM + j * 8);
    u32x4 vv = {0u, 0u, 0u, 0u};
    if (id < 64) vv = *(const u32x4*)(vb + base + (size_t)(t0 + (id >> 1)) * DM + vrow0 + (id & 1) * 8);
#pragma unroll
    for (int st = 0; st < 5; ++st) { f32x4 a, b; a[0] = bf_lo(d[st].x); a[1] = bf_hi(d[st].x); a[2] = bf_lo(d[st].y); a[3] = bf_hi(d[st].y); b[0] = bf_lo(d[st].z); b[1] = bf_hi(d[st].z); b[2] = bf_lo(d[st].w); b[3] = bf_hi(d[st].w);
        float* p = (float*)(buf + st * R3_STR + t * 256 + j * 32); *(f32x4*)p = a; *(f32x4*)(p + 4) = b; }
    if (id < 64) { f32x4 a, b; a[0] = bf_lo(vv.x); a[1] = bf_hi(vv.x); a[2] = bf_lo(vv.y); a[3] = bf_hi(vv.y); b[0] = bf_lo(vv.z); b[1] = bf_hi(vv.z); b[2] = bf_lo(vv.w); b[3] = bf_hi(vv.w);
        float* vp = (float*)(buf + 5 * R3_STR + (id >> 1) * 64 + (id & 1) * 32); *(f32x4*)vp = a; *(f32x4*)(vp + 4) = b; }
}
DEV void phase_r3(const bf16_t* rb, const bf16_t* wb, const bf16_t* kb, const bf16_t* kkb, const bf16_t* kab, const bf16_t* vb, bf16_t* yb, float* bsc, const float* r_k, char* smem) {
    const int tid = tidx(), lane = tid & 63, wid = tid >> 6;
    const bf16_t* const str[5] = {rb, wb, kb, kkb, kab};
    constexpr int NCH = SEQ / R3_CH;
    for (int task = blockIdx.x; task < 256; task += gridDim.x) {
        const int bh = task >> 2, b = bh >> 4, h = bh & 15, rq = task & 3;
        const size_t base = (size_t)b * SEQ * DM + h * 64;
        bf16_t* ystage = (bf16_t*)(smem + 149504 + 64);
    float* gcarea = (float*)(smem + 3 * R3_BUF);
        if (wid >= 4) r3_stage_raw(str, vb, base, rq * 16, 0, smem, tid - 256);
        __syncthreads();
        if (wid >= 4) { r3_stage_raw(str, vb, base, rq * 16, R3_CH, smem + R3_BUF, tid - 256);
            char* bq = smem; float* w = (float*)bq + R3_STR / 4 + lane; const int p = wid - 4;
            float G = 1.f; for (int t = 0; t < 8 * p; ++t) G *= w[t * 64];
            float* r = (float*)bq + lane; float* k = r + 2 * (R3_STR / 4); float* q = r + 3 * (R3_STR / 4); float* a = r + 4 * (R3_STR / 4);
#pragma unroll
            for (int u = 0; u < 8; ++u) { const int t = 8 * p + u; const float Gold = G; G *= w[t * 64]; const float inv = rcpf_(G); r[t * 64] *= G; q[t * 64] *= Gold; k[t * 64] *= inv; a[t * 64] *= inv; }
            if (p == 3) gcarea[lane] = G; }
        __syncthreads();
        const int rr = lane >> 4, cg = lane & 15, rg = rq * 4 + wid;
        const size_t voff = base + rg * 4 + rr;
        f32x2 s01 = {0.f, 0.f}, s23 = {0.f, 0.f};
        for (int c = 0; c < NCH; ++c) {
            if (wid >= 4) {
                if (c >= 1 && tid - 256 < 64) { const int id = tid - 256;
                    *(u32x4*)(yb + base + (size_t)((c - 1) * R3_CH + (id >> 1)) * DM + rq * 16 + (id & 1) * 8) = *(const u32x4*)(ystage + ((c - 1) & 1) * 512 + (id >> 1) * 16 + (id & 1) * 8); }
                if (c + 2 < NCH) r3_stage_raw(str, vb, base, rq * 16, (c + 2) * R3_CH, smem + ((c + 2) % 3) * R3_BUF, tid - 256);
                if (c + 1 < NCH) { char* bq = smem + ((c + 1) % 3) * R3_BUF; float* w = (float*)bq + R3_STR / 4 + lane; const int p = wid - 4;
                    float G = 1.f; for (int t = 0; t < 8 * p; ++t) G *= w[t * 64];
                    float* r = (float*)bq + lane; float* k = r + 2 * (R3_STR / 4); float* q = r + 3 * (R3_STR / 4); float* a = r + 4 * (R3_STR / 4);
#pragma unroll
                    for (int u = 0; u < 8; ++u) { const int t = 8 * p + u; const float Gold = G; G *= w[t * 64]; const float inv = rcpf_(G); r[t * 64] *= G; q[t * 64] *= Gold; k[t * 64] *= inv; a[t * 64] *= inv; }
                    if (p == 3) gcarea[((c + 1) % 3) * 64 + lane] = G; }
            } else {
                const char* buf = smem + (c % 3) * R3_BUF;
                f32x4 R_[2][2], K_[2][2], Q_[2][2], A_[2][2]; float V_[2][2];
#define R3_LD(bf, t0) { _Pragma("unroll") for (int u = 0; u < 2; ++u) { const char* p = buf + ((t0) + u) * 256 + cg * 16; \
                    R_[bf][u] = *(const f32x4*)p; K_[bf][u] = *(const f32x4*)(p + 2 * R3_STR); Q_[bf][u] = *(const f32x4*)(p + 3 * R3_STR); A_[bf][u] = *(const f32x4*)(p + 4 * R3_STR); \
                    V_[bf][u] = *(const float*)(buf + 5 * R3_STR + ((t0) + u) * 64 + (wid * 4 + rr) * 4); } }
#define R3_CP(bf, sl) { _Pragma("unroll") for (int u = 0; u < 2; ++u) { \
                    const f32x4 R = R_[bf][u], K = K_[bf][u], Q = Q_[bf][u], A = A_[bf][u]; const float vv = V_[bf][u]; \
                    const f32x2 r01 = {R[0], R[1]}, r23 = {R[2], R[3]}, k01 = {K[0], K[1]}, k23 = {K[2], K[3]}; \
                    const f32x2 q01 = {Q[0], Q[1]}, q23 = {Q[2], Q[3]}, a01 = {A[0], A[1]}, a23 = {A[2], A[3]}; \
                    const f32x2 pq = s01 * q01 + s23 * q23; \
                    const float sa = -row16_sum(pq.x + pq.y); \
                    const f32x2 sa2 = {sa, sa}, vv2 = {vv, vv}; \
                    s01 = (s01 + vv2 * k01) + sa2 * a01; s23 = (s23 + vv2 * k23) + sa2 * a23; \
                    const f32x2 py = s01 * r01 + s23 * r23; \
                    const float y = row16_sum(py.x + py.y); \
                    yv = (cg == (sl) + u) ? y : yv; } }
                R3_LD(0, 0)
#pragma unroll 1
                for (int t8 = 0; t8 < R3_CH; t8 += 8) {
                    float yv = 0.f;
                    R3_LD(1, t8 + 2)
                    R3_CP(0, 0)
                    R3_LD(0, t8 + 4)
                    R3_CP(1, 2)
                    R3_LD(1, t8 + 6)
                    R3_CP(0, 4)
                    if (t8 + 8 < R3_CH) R3_LD(0, t8 + 8)
                    R3_CP(1, 6)
                    if (cg < 8) ystage[(c & 1) * 512 + (t8 + cg) * 16 + wid * 4 + rr] = f2bf(yv);
                }
#undef R3_LD
#undef R3_CP
                const f32x4 GC = *(const f32x4*)(gcarea + (c % 3) * 64 + cg * 4);
                s01 *= (f32x2){GC[0], GC[1]}; s23 *= (f32x2){GC[2], GC[3]};
            }
            __syncthreads();
        }
        if (wid >= 4 && tid - 256 < 64) { const int id = tid - 256;
            *(u32x4*)(yb + base + (size_t)((NCH - 1) * R3_CH + (id >> 1)) * DM + rq * 16 + (id & 1) * 8) = *(const u32x4*)(ystage + ((NCH - 1) & 1) * 512 + (id >> 1) * 16 + (id & 1) * 8); }
        __syncthreads();
    }
}
constexpr int RC_NP = 8, RC_SLOT = 18688, RC_LDS = 18688;
constexpr int RC_QT = 0, RC_RR = 4096, RC_BG = 8192, RC_AB = 12288, RC_D0 = 14336, RC_U0 = 16384, RC_Y0 = 17408, RC_G = 18432;
#define R3C_FENCE() asm volatile("" ::: "memory")
constexpr int RC_P = 144;
DEV bf16x8 r3c_permfrag(const char* rowp, int q) {
    const u32x2 lo = *(const u32x2*)(rowp + 8 * q), hi = *(const u32x2*)(rowp + 32 + 8 * q);
    u32x4 w; w.x = lo.x; w.y = lo.y; w.z = hi.x; w.w = hi.y; return __builtin_bit_cast(bf16x8, w);
}
DEV bf16x8 r3c_neg(bf16x8 a) { u32x4 w = __builtin_bit_cast(u32x4, a); w.x ^= 0x80008000u; w.y ^= 0x80008000u; w.z ^= 0x80008000u; w.w ^= 0x80008000u; return __builtin_bit_cast(bf16x8, w); }
DEV u32x4 r3c_scale8(u32x4 d, f32x4 a, f32x4 b) {
    u32x4 o; o.x = cvt_pk(bf_lo(d.x) * a[0], bf_hi(d.x) * a[1]); o.y = cvt_pk(bf_lo(d.y) * a[2], bf_hi(d.y) * a[3]);
    o.z = cvt_pk(bf_lo(d.z) * b[0], bf_hi(d.z) * b[1]); o.w = cvt_pk(bf_lo(d.w) * b[2], bf_hi(d.w) * b[3]); return o;
}
DEV u32x2 r3c_pk4(f32x4 v) { u32x2 w; w.x = cvt_pk(v[0], v[1]); w.y = cvt_pk(v[2], v[3]); return w; }
DEV f32x4 r3c_up4(u32x2 w) { f32x4 v; v[0] = bf_lo(w.x); v[1] = bf_hi(w.x); v[2] = bf_lo(w.y); v[3] = bf_hi(w.y); return v; }
#define R3C_SCORE(dst, A, B, ROWLESS, STRICT) { _Pragma("unroll") for (int a = 0; a < 2; ++a) { _Pragma("unroll") for (int b = 0; b < 2; ++b) { \
        f32x4 a_ = MFMA(A[a][0], B[b][0], z4); a_ = MFMA(A[a][1], B[b][1], a_); \
        _Pragma("unroll") for (int r = 0; r < 4; ++r) { const int row_ = 16 * a + 4 * q + r, col_ = 16 * b + m; const int lo_ = (ROWLESS) ? row_ : col_, hi_ = (ROWLESS) ? col_ : row_; \
            const bool keep_ = (STRICT) ? (lo_ < hi_) : (lo_ <= hi_); a_[r] = keep_ ? a_[r] : 0.f; } \
        dst[a][b] = a_; } } }
template <bool PERM> DEV bf16x8 r3c_ident(int x, int m, int q) {
    u32x4 w = {0u, 0u, 0u, 0u};
#pragma unroll
    for (int jj = 0; jj < 8; ++jj) { const unsigned one = 0x3F80u << ((jj & 1) * 16); const int k = PERM ? ((jj < 4) ? 4 * q + jj : 16 + 4 * q + jj - 4) : 8 * q + jj; const unsigned v = (k == 16 * x + m) ? one : 0u;
        if ((jj >> 1) == 0) w.x |= v; else if ((jj >> 1) == 1) w.y |= v; else if ((jj >> 1) == 2) w.z |= v; else w.w |= v; }
    return __builtin_bit_cast(bf16x8, w);
}
struct R3Raw { u32x4 dr[4], dw[4], dk[4], dq[4], da[4]; bf16x8 vfrag; };
DEV void r3c_load(R3Raw& W, const bf16_t* rb, const bf16_t* wb, const bf16_t* kkb, const bf16_t* vb, int vrow0, int lane) {
    const int m = lane & 15, q = lane >> 4, tr = lane >> 3, j = lane & 7;
#pragma unroll
    for (int s = 0; s < 4; ++s) { const unsigned o = (unsigned)(((8 * s + tr) * DM + j * 8) * 2);
        W.dw[s] = *(const u32x4*)((const char*)wb + o); W.dr[s] = *(const u32x4*)((const char*)rb + o); W.dq[s] = *(const u32x4*)((const char*)kkb + o); }
    unsigned e[8];
#pragma unroll
    for (int jj = 0; jj < 8; ++jj) { const int t = (jj < 4) ? 4 * q + jj : 16 + 4 * q + jj - 4; e[jj] = *(const bf16_t*)((const char*)vb + (unsigned)((t * DM + vrow0 + m) * 2)); }
    u32x4 w; w.x = e[0] | (e[1] << 16); w.y = e[2] | (e[3] << 16); w.z = e[4] | (e[5] << 16); w.w = e[6] | (e[7] << 16); W.vfrag = __builtin_bit_cast(bf16x8, w);
}
DEV void r3c_load2(R3Raw& W, const bf16_t* kb, const bf16_t* kab, int lane) {
    const int tr = lane >> 3, j = lane & 7;
#pragma unroll
    for (int s = 0; s < 4; ++s) { const unsigned o = (unsigned)(((8 * s + tr) * DM + j * 8) * 2); W.dk[s] = *(const u32x4*)((const char*)kb + o); W.da[s] = *(const u32x4*)((const char*)kab + o); }
}
DEV void r3c_produce(R3Raw& W, const bf16_t* kb, const bf16_t* kab, char* lds, int lane) {
    const int m = lane & 15, q = lane >> 4, tr = lane >> 3, j = lane & 7;
    r3c_load2(W, kb, kab, lane);
    const f32x4 z4 = {0.f, 0.f, 0.f, 0.f};
    char* Rh = lds; char* Qh = lds + 32 * RC_P; char* Kh = lds + 64 * RC_P; char* Bh = lds + 96 * RC_P; float* G31a = (float*)(lds + 128 * RC_P);
    float* Gb = (float*)Kh;
    const bf16x8 vfrag = W.vfrag;
#pragma unroll
    for (int s = 0; s < 4; ++s) { float* gp = Gb + (8 * s + tr) * 64 + 8 * j; f32x4 a, b; const u32x4 d = W.dw[s];
        a[0] = bf_lo(d.x); a[1] = bf_hi(d.x); a[2] = bf_lo(d.y); a[3] = bf_hi(d.y); b[0] = bf_lo(d.z); b[1] = bf_hi(d.z); b[2] = bf_lo(d.w); b[3] = bf_hi(d.w);
        *(f32x4*)gp = a; *(f32x4*)(gp + 4) = b; }
    R3C_FENCE();
    { float g[32];
#pragma unroll
      for (int t = 0; t < 32; ++t) g[t] = Gb[t * 64 + lane];
      float G = 1.f;
#pragma unroll
      for (int t = 0; t < 32; ++t) { G *= g[t]; Gb[t * 64 + lane] = G; }
      G31a[lane] = G; }
    R3C_FENCE();
    { u32x4 kh[4], bh[4];
#pragma unroll
      for (int s = 0; s < 4; ++s) { const int t = 8 * s + tr, tp = t > 0 ? t - 1 : 0;
          const f32x4 g0 = *(const f32x4*)(Gb + t * 64 + 8 * j), g1 = *(const f32x4*)(Gb + t * 64 + 8 * j + 4);
          f32x4 p0 = *(const f32x4*)(Gb + tp * 64 + 8 * j), p1 = *(const f32x4*)(Gb + tp * 64 + 8 * j + 4);
          if (t == 0) { p0 = (f32x4){1.f, 1.f, 1.f, 1.f}; p1 = p0; }
          f32x4 i0, i1;
#pragma unroll
          for (int e = 0; e < 4; ++e) { i0[e] = rcpf_(g0[e]); i1[e] = rcpf_(g1[e]); }
          *(u32x4*)(Rh + t * RC_P + j * 16) = r3c_scale8(W.dr[s], g0, g1);
          *(u32x4*)(Qh + t * RC_P + j * 16) = r3c_scale8(W.dq[s], p0, p1);
          kh[s] = r3c_scale8(W.dk[s], i0, i1); bh[s] = r3c_scale8(W.da[s], i0, i1); }
      R3C_FENCE();
#pragma unroll
      for (int s = 0; s < 4; ++s) { const int t = 8 * s + tr; *(u32x4*)(Kh + t * RC_P + j * 16) = kh[s]; *(u32x4*)(Bh + t * RC_P + j * 16) = bh[s]; } }
    R3C_FENCE();
    bf16x8 Qa[2][2], Ra[2][2], Kb[2][2], Bb[2][2];
#pragma unroll
    for (int x = 0; x < 2; ++x)
#pragma unroll
        for (int ks = 0; ks < 2; ++ks) { const int off = (16 * x + m) * RC_P + (32 * ks + 8 * q) * 2;
            Qa[x][ks] = *(const bf16x8*)(Qh + off); Ra[x][ks] = *(const bf16x8*)(Rh + off); Kb[x][ks] = *(const bf16x8*)(Kh + off); Bb[x][ks] = *(const bf16x8*)(Bh + off); }
    f32x4 Tt[2][2], PN[2][2], PT[2][2], Z[2][5];
    R3C_SCORE(Tt, Kb, Qa, true, true)
    Z[0][4] = MFMA(pack8(Tt[0][0], Tt[1][0]), vfrag, z4); Z[1][4] = MFMA(pack8(Tt[0][1], Tt[1][1]), vfrag, z4);
    R3C_SCORE(Tt, Kb, Ra, true, false)
    u32x2 oY0[2]; oY0[0] = r3c_pk4(MFMA(pack8(Tt[0][0], Tt[1][0]), vfrag, z4)); oY0[1] = r3c_pk4(MFMA(pack8(Tt[0][1], Tt[1][1]), vfrag, z4));
    R3C_SCORE(Tt, Bb, Ra, true, false)
    bf16x8 oAB[2]; oAB[0] = r3c_neg(pack8(Tt[0][0], Tt[1][0])); oAB[1] = r3c_neg(pack8(Tt[0][1], Tt[1][1]));
    R3C_SCORE(PN, Qa, Bb, false, true)
    R3C_SCORE(PT, Bb, Qa, true, true)
#pragma unroll
    for (int mt = 0; mt < 2; ++mt)
#pragma unroll
        for (int n = 0; n < 4; ++n) Z[mt][n] = MFMA(Qa[mt][n >> 1], r3c_ident<false>(n & 1, m, q), z4);
#pragma unroll
    for (int lev = 0; lev < 5; ++lev) {
        bf16x8 fa[2], fb[2], zb[5];
#pragma unroll
        for (int x = 0; x < 2; ++x) { fa[x] = pack8(PT[0][x], PT[1][x]); fb[x] = pack8(PN[0][x], PN[1][x]); }
#pragma unroll
        for (int n = 0; n < 5; ++n) zb[n] = pack8(Z[0][n], Z[1][n]);
        const bf16x8 a0 = lev == 0 ? r3c_neg(fa[0]) : fa[0], a1 = lev == 0 ? r3c_neg(fa[1]) : fa[1];
#pragma unroll
        for (int n = 0; n < 5; ++n) { Z[0][n] = MFMA(a0, zb[n], Z[0][n]); Z[1][n] = MFMA(a1, zb[n], Z[1][n]); }
        if (lev < 4) {
#pragma unroll
            for (int a = 0; a < 2; ++a)
#pragma unroll
                for (int b = 0; b < 2; ++b) { PN[a][b] = MFMA(fa[a], fb[b], z4); PT[a][b] = MFMA(fb[a], fa[b], z4); }
        }
    }
    bf16x8 oQT[4], oRR[4], oBG[4]; u32x2 oD0[4];
    { f32x4 ZT[4][2];
      const bf16x8 Ip0 = r3c_ident<true>(0, m, q), Ip1 = r3c_ident<true>(1, m, q);
#pragma unroll
      for (int a = 0; a < 4; ++a) { const bf16x8 zf = pack8(Z[0][a], Z[1][a]); ZT[a][0] = MFMA(zf, Ip0, z4); ZT[a][1] = MFMA(zf, Ip1, z4); }
#pragma unroll
      for (int mt = 0; mt < 2; ++mt)
#pragma unroll
          for (int ks = 0; ks < 2; ++ks) oQT[mt * 2 + ks] = pack8(ZT[2 * ks][mt], ZT[2 * ks + 1][mt]); }
#pragma unroll
    for (int mt = 0; mt < 2; ++mt)
#pragma unroll
        for (int ks = 0; ks < 2; ++ks) oRR[mt * 2 + ks] = r3c_permfrag(Rh + (16 * mt + m) * RC_P + ks * 64, q);
    { bf16x8 Kf[2][2], Bf[2][2], Inat[2]; Inat[0] = r3c_ident<false>(0, m, q); Inat[1] = r3c_ident<false>(1, m, q);
#pragma unroll
      for (int x = 0; x < 2; ++x)
#pragma unroll
          for (int ks = 0; ks < 2; ++ks) { const int off = (16 * x + m) * RC_P + (32 * ks + 8 * q) * 2; Kf[x][ks] = *(const bf16x8*)(Kh + off); Bf[x][ks] = *(const bf16x8*)(Bh + off); }
#pragma unroll
      for (int ct = 0; ct < 4; ++ct) { const float g = G31a[16 * ct + m];
          const f32x4 k0 = MFMA(Kf[0][ct >> 1], Inat[ct & 1], z4) * g, k1 = MFMA(Kf[1][ct >> 1], Inat[ct & 1], z4) * g;
          const f32x4 b0 = MFMA(Bf[0][ct >> 1], Inat[ct & 1], z4) * -g, b1 = MFMA(Bf[1][ct >> 1], Inat[ct & 1], z4) * -g;
          oBG[ct] = pack8(b0, b1);
          oD0[ct] = r3c_pk4(MFMA(pack8(k0, k1), vfrag, z4)); } }
    asm volatile("s_waitcnt lgkmcnt(0)" ::: "memory");
#pragma unroll
    for (int f = 0; f < 4; ++f) { *(bf16x8*)(lds + RC_QT + f * 1024 + lane * 16) = oQT[f]; *(bf16x8*)(lds + RC_RR + f * 1024 + lane * 16) = oRR[f]; *(bf16x8*)(lds + RC_BG + f * 1024 + lane * 16) = oBG[f];
        *(u32x2*)(lds + RC_D0 + f * 512 + lane * 8) = oD0[f]; }
#pragma unroll
    for (int f = 0; f < 2; ++f) { *(bf16x8*)(lds + RC_AB + f * 1024 + lane * 16) = oAB[f]; *(u32x2*)(lds + RC_U0 + f * 512 + lane * 8) = r3c_pk4(Z[f][4]); *(u32x2*)(lds + RC_Y0 + f * 512 + lane * 8) = oY0[f]; }
    R3C_FENCE();
}
DEV void r3c_walk(f32x4 (&S)[4], char* slot, int lane) {
    const int q = lane >> 4;
    bf16x8 QT[2][2], BG[4]; u32x2 D0[4], U0[2]; f32x4 Gv[4];
#pragma unroll
    for (int f = 0; f < 4; ++f) { QT[f >> 1][f & 1] = *(const bf16x8*)(slot + RC_QT + f * 1024 + lane * 16); BG[f] = *(const bf16x8*)(slot + RC_BG + f * 1024 + lane * 16);
        D0[f] = *(const u32x2*)(slot + RC_D0 + f * 512 + lane * 8); Gv[f] = *(const f32x4*)(slot + RC_G + (16 * f + 4 * q) * 4); }
#pragma unroll
    for (int f = 0; f < 2; ++f) U0[f] = *(const u32x2*)(slot + RC_U0 + f * 512 + lane * 8);
    const bf16x8 sB0 = pack8(S[0], S[1]), sB1 = pack8(S[2], S[3]);
    f32x4 U[2];
#pragma unroll
    for (int mt = 0; mt < 2; ++mt) { U[mt] = r3c_up4(U0[mt]); U[mt] = MFMA(QT[mt][0], sB0, U[mt]); U[mt] = MFMA(QT[mt][1], sB1, U[mt]); }
    const bf16x8 uB = pack8(U[0], U[1]);
#pragma unroll
    for (int ct = 0; ct < 4; ++ct) { S[ct] = S[ct] * Gv[ct] + r3c_up4(D0[ct]); S[ct] = MFMA(BG[ct], uB, S[ct]); }
    R3C_FENCE();
    *(bf16x8*)(slot + RC_QT + lane * 16) = sB0; *(bf16x8*)(slot + RC_QT + 1024 + lane * 16) = sB1; *(bf16x8*)(slot + RC_QT + 2048 + lane * 16) = uB;
    R3C_FENCE();
}
DEV void r3c_yout(const char* slot, bf16_t* yout, int lane) {
    const int m = lane & 15, q = lane >> 4;
    const bf16x8 sB0 = *(const bf16x8*)(slot + RC_QT + lane * 16), sB1 = *(const bf16x8*)(slot + RC_QT + 1024 + lane * 16), uB = *(const bf16x8*)(slot + RC_QT + 2048 + lane * 16);
#pragma unroll
    for (int mt = 0; mt < 2; ++mt) {
        f32x4 Y = r3c_up4(*(const u32x2*)(slot + RC_Y0 + mt * 512 + lane * 8));
        Y = MFMA(*(const bf16x8*)(slot + RC_RR + (mt * 2) * 1024 + lane * 16), sB0, Y); Y = MFMA(*(const bf16x8*)(slot + RC_RR + (mt * 2 + 1) * 1024 + lane * 16), sB1, Y);
        Y = MFMA(*(const bf16x8*)(slot + RC_AB + mt * 1024 + lane * 16), uB, Y);
#pragma unroll
        for (int r = 0; r < 4; ++r) *(bf16_t*)((char*)yout + (unsigned)(((16 * mt + 4 * q + r) * DM + m) * 2)) = f2bf(Y[r]); }
    R3C_FENCE();
}
DEV void phase_r3c(const bf16_t* rb, const bf16_t* wb, const bf16_t* kb, const bf16_t* kkb, const bf16_t* kab, const bf16_t* vb, bf16_t* yb, char* smem) {
    const int tid = tidx(), lane = tid & 63, wid = __builtin_amdgcn_readfirstlane(tid >> 6);
    constexpr int NCH = SEQ / 32, NR = NCH / RC_NP;
    for (int task = blockIdx.x; task < 256; task += gridDim.x) {
        const int xc = task & 7, ix = task >> 3, bh = xc * 8 + (ix >> 2), b = bh >> 4, h = bh & 15, rq = ix & 3;
        const size_t base = (size_t)b * SEQ * DM + h * 64;
        f32x4 S[4];
#pragma unroll
        for (int ct = 0; ct < 4; ++ct) S[ct] = (f32x4){0.f, 0.f, 0.f, 0.f};
        R3Raw W; { const size_t ub = base + (size_t)(wid * 32) * DM; r3c_load(W, rb + ub, wb + ub, kkb + ub, vb + ub, rq * 16, lane); }
        for (int rd = 0; rd < NR; ++rd) {
            const size_t ub = base + (size_t)((rd * RC_NP + wid) * 32) * DM;
            r3c_produce(W, kb + ub, kab + ub, smem + wid * RC_LDS, tidx() & 63);
            if (rd + 1 < NR) { const size_t un = ub + (size_t)(RC_NP * 32) * DM; r3c_load(W, rb + un, wb + un, kkb + un, vb + un, rq * 16, tidx() & 63); }
            asm volatile("s_waitcnt lgkmcnt(0)" ::: "memory");
            __syncthreads();
            if (wid == 0) {
#pragma unroll 1
                for (int p = 0; p < RC_NP; ++p) r3c_walk(S, smem + p * RC_LDS, tidx() & 63);
                asm volatile("s_waitcnt lgkmcnt(0)" ::: "memory");
            }
            __syncthreads();
            r3c_yout(smem + wid * RC_LDS, yb + ub + rq * 16, tidx() & 63);
        }
    }
}
DEV void phase_r4(const bf16_t* hid, const bf16_t* G2T, const RwkvW& W, const bf16_t* yb, const bf16_t* vb, const float* bsc, bf16_t* outb, char* smem) {
    const LaneId L = lane_id();
    const int ntn = 8, nunits = (T / 256) * ntn;
    for (int u = blockIdx.x; u < nunits; u += gridDim.x) {
        const int tm = u / ntn, tn = u % ntn;
        f32x4 acc[4][4];
        gemm_core(acc, LdPlain{hid + (size_t)tm * 256 * HIDP + 128, HIDP}, LdPlain{G2T + (size_t)tn * 128 * 128, 128}, 128, smem);
        const int head = tn * 2 + L.wn;
#pragma unroll
        for (int m = 0; m < 4; ++m) {
            const size_t row = (size_t)tm * 256 + L.wm * 64 + m * 16 + L.fr;
            f32x4 yv[4]; float s = 0.f;
#pragma unroll
            for (int n = 0; n < 4; ++n) { yv[n] = ld_bf4(yb + row * DM + head * 64 + n * 16 + L.fq * 4); s += (yv[n][0] + yv[n][1]) + (yv[n][2] + yv[n][3]); }
            s += __shfl_xor(s, 16); s += __shfl_xor(s, 32);
            const float mean = s * (1.0f / 64.0f); float q = 0.f;
#pragma unroll
            for (int n = 0; n < 4; ++n) { const f32x4 d = yv[n] - mean; q += (d[0] * d[0] + d[1] * d[1]) + (d[2] * d[2] + d[3] * d[3]); }
            q += __shfl_xor(q, 16); q += __shfl_xor(q, 32);
            const float rstd = rsqrtf(q * (1.0f / 64.0f) + 64e-5f);
            const float bs = bsc[row * 16 + head];
#pragma unroll
            for (int n = 0; n < 4; ++n) { const int col = head * 64 + n * 16 + L.fq * 4;
                const f32x4 lw = *(const f32x4*)(W.ln_w + col), lb = *(const f32x4*)(W.ln_b + col), vv = ld_bf4(vb + row * DM + col);
                f32x4 o = ((yv[n] - mean) * rstd * lw + lb + vv * bs);
                o = o * acc[m][n];
                st_bf4(outb + row * DM + col, o); }
        }
    }
}

struct NsaBuf { bf16_t *q, *kcmp, *vcmp, *kslc, *kwin, *vslcT, *vwinT, *hid, *kc, *vcT, *o; float* gates; };
DEV void phase_n1(const bf16_t* xn, const bf16_t* Bt, const NsaBuf& B, char* smem) {
    const LaneId L = lane_id();
    const int ntn = 15, nunits = (T / 256) * ntn;
    for (int u = blockIdx.x; u < nunits; u += gridDim.x) {
        const int tm = u / ntn, tn = u % ntn;
        f32x4 acc[4][4];
        gemm_core(acc, LdPlain{xn + (size_t)tm * 256 * DM, DM}, LdPlain{Bt + (size_t)tn * 128 * DM, DM}, DM, smem);
#pragma unroll
        for (int m = 0; m < 4; ++m)
#pragma unroll
            for (int n = 0; n < 4; ++n) {
                const size_t row = (size_t)tm * 256 + L.wm * 64 + m * 16 + L.fr; const int c = L.wn * 64 + n * 16 + L.fq * 4; f32x4 v = acc[m][n];
                if (tn < 8) st_bf4(B.q + row * DM + tn * 128 + c, v * 0.125f);
                else if (tn < 14) {
                    const int cc = tn - 8;
                    if (cc == 0) st_bf4(B.kcmp + row * 128 + c, v);
                    else if (cc == 1) st_bf4(B.vcmp + row * 128 + c, v);
                    else if (cc == 2) st_bf4(B.kslc + row * 128 + c, v);
                    else if (cc == 4) st_bf4(B.kwin + row * 128 + c, v);
                    else { bf16_t* dst = cc == 3 ? B.vslcT : B.vwinT; const int b = (int)(row >> 13), t = (int)(row & (SEQ - 1));
                        for (int j = 0; j < 4; ++j) dst[((size_t)(b * 128 + c + j)) * SEQ + t] = f2bf(v[j]); }
                } else { if (c < 48) { for (int j = 0; j < 4; ++j) B.gates[row * 48 + c + j] = sigmoidf_(v[j]); } }
            }
    }
}
DEV float gelu_tanh(float x) { const float u = 0.7978845608028654f * (x + 0.044715f * x * x * x); return 0.5f * x * (1.0f + tanhf(u)); }
DEV void phase_n2a(const bf16_t* W1T, const float* biasp, const NsaBuf& B, char* smem) {
    const LaneId L = lane_id();
    for (int u = blockIdx.x; u < 64; u += gridDim.x) {
        const int c = u >> 5, tm = (u >> 1) & 15, tn = u & 1;
        f32x4 acc[4][4];
        gemm_core(acc, LdCmp{c ? B.vcmp : B.kcmp, tm * 256}, LdPlain{W1T + (size_t)c * 256 * 2048 + (size_t)tn * 128 * 2048, 2048}, 2048, smem);
#pragma unroll
        for (int m = 0; m < 4; ++m)
#pragma unroll
            for (int n = 0; n < 4; ++n) { const size_t row = (size_t)tm * 256 + L.wm * 64 + m * 16 + L.fr; const int col = tn * 128 + L.wn * 64 + n * 16 + L.fq * 4;
                const f32x4 bb = *(const f32x4*)(biasp + c * 256 + col); f32x4 v;
                for (int j = 0; j < 4; ++j) v[j] = gelu_tanh(acc[m][n][j] + bb[j]);
                st_bf4(B.hid + ((size_t)c * 4096 + row) * 256 + col, v); }
    }
}
DEV void phase_n2b(const bf16_t* W2T, const NsaBuf& B, char* smem) {
    const LaneId L = lane_id();
    for (int u = blockIdx.x; u < 32; u += gridDim.x) {
        const int c = u >> 4, tm = u & 15;
        f32x4 acc[4][4];
        gemm_core(acc, LdPlain{B.hid + ((size_t)c * 4096 + tm * 256) * 256, 256}, LdPlain{W2T + (size_t)c * 128 * 256, 256}, 256, smem);
        if (L.wn == 0) {
#pragma unroll
            for (int m = 0; m < 4; ++m)
#pragma unroll
                for (int n = 0; n < 4; ++n) { const int row = tm * 256 + L.wm * 64 + m * 16 + L.fr, d = n * 16 + L.fq * 4;
                    const int b = row >> 10, nn = (row >> 1) & 511, g = row & 1;
                    if (c == 0) st_bf4(B.kc + ((size_t)((b * 2 + g) * 512 + nn)) * 64 + d, acc[m][n]);
                    else { for (int j = 0; j < 4; ++j) B.vcT[((size_t)((b * 2 + g) * 64 + d + j)) * 512 + nn] = f2bf(acc[m][n][j]); } }
        }
    }
}
#define NEGV (-1e30f)
#define LOG2E_ 1.4426950408889634f
DEV u32x4 n3_ldg(const bf16_t* kbase, long kpitch, const bf16_t* vbase, long vpitch, int kb, int tid) {
    if (tid < 256) return *(const u32x4*)(kbase + (size_t)(kb + (tid >> 3)) * kpitch + (tid & 7) * 8);
    const int i = tid - 256; return *(const u32x4*)(vbase + (size_t)(i >> 2) * vpitch + kb + (i & 3) * 8);
}
DEV void n3_sts(char* buf, u32x4 v, int tid) {
    if (tid < 256) { const int row = tid >> 3, c = tid & 7, sw = ((row >> 1) & 1) | (((row >> 3) & 3) << 1); *(u32x4*)(buf + row * 128 + ((c ^ sw) << 4)) = v; }
    else { const int i = tid - 256, d = i >> 2, c = i & 3; *(u32x4*)(buf + 4096 + d * 64 + ((c ^ ((d >> 2) & 3)) << 4)) = v; }
}
DEV void phase_n3(const NsaBuf& B, char* smem) {
    const int tid = tidx(), lane = tid & 63, wid = tid >> 6, m = lane & 15, fq = lane >> 4, qh = m >> 3, hh = m & 7;
    float* psum = (float*)(smem + wid * 8704); int* ulist = (int*)(smem + wid * 8704 + 8192);
    char* stg = smem + 8 * 8704;
    const int kperm = 8 * (m >> 2) + (m & 3);
    const int kswz = ((m >> 1) & 1) | ((m >> 2) << 1), vswz = (m >> 2) & 3;
    const int koffA = kperm * 128, koffB = (kperm + 4) * 128, voff = 4096 + m * 64 + ((fq ^ vswz) << 4);
    const f32x4 z4 = {0.f, 0.f, 0.f, 0.f};
    const int nrank = (int)gridDim.x >> 3, bg = (int)blockIdx.x & 7;
    for (int qblk = (int)blockIdx.x >> 3; qblk < 256 && (int)blockIdx.x < nrank * 8; qblk += nrank) {
        const int g = bg & 1, b = bg >> 1, t0b = qblk * 32, t0 = t0b + wid * 4;
        int tq[2]; bf16x8 qf[2][2]; float gc[2], gs[2], gw[2]; u32x2 opk[2][4];
#pragma unroll
        for (int rb = 0; rb < 2; ++rb) {
            tq[rb] = t0 + rb * 2 + qh;
            const bf16_t* qp = B.q + ((size_t)(b * SEQ + tq[rb])) * DM + (g * 8 + hh) * 64 + fq * 8;
            qf[rb][0] = __builtin_nontemporal_load((const bf16x8*)qp); qf[rb][1] = __builtin_nontemporal_load((const bf16x8*)(qp + 32));
            const float* gp = B.gates + ((size_t)(b * SEQ + tq[rb])) * 48 + g * 24 + hh * 3;
            gc[rb] = gp[0]; gs[rb] = gp[1]; gw[rb] = gp[2];
        }
#define N3_KFRAGS(buf) const bf16x8 kA0 = *(const bf16x8*)((buf) + koffA + (((0 + fq) ^ kswz) << 4)), kA1 = *(const bf16x8*)((buf) + koffA + (((4 + fq) ^ kswz) << 4)), \
                                    kB0 = *(const bf16x8*)((buf) + koffB + (((0 + fq) ^ kswz) << 4)), kB1 = *(const bf16x8*)((buf) + koffB + (((4 + fq) ^ kswz) << 4));
        {
            const int tid = tidx(), lane = tid & 63, m = lane & 15, fq = (lane >> 4), qh = m >> 3, hh = m & 7, kperm = 8 * (m >> 2) + (m & 3); (void)hh; (void)qh; (void)lane;
            const int kswz = ((m >> 1) & 1) | ((m >> 2) << 1), vswz = (m >> 2) & 3, koffA = kperm * 128, koffB = (kperm + 4) * 128, voff = 4096 + m * 64 + ((fq ^ vswz) << 4);
            int nv[2];
#pragma unroll
            for (int rb = 0; rb < 2; ++rb) nv[rb] = tq[rb] >= 31 ? ((tq[rb] - 31) >> 4) + 1 : 0;
            const int nvmax = (t0b + 31 >= 31) ? ((t0b + 31 - 31) >> 4) + 1 : 0, ngrp = (nvmax + 31) >> 5;
#pragma unroll
            for (int i = 0; i < 32; ++i) psum[lane + 64 * i] = 0.f;
            const bf16_t* kcb = B.kc + (size_t)((b * 2 + g) * 512) * 64; const bf16_t* vcb = B.vcT + (size_t)((b * 2 + g) * 64) * 512;
            float mx[2] = {NEGV, NEGV}, l[2] = {0.f, 0.f};
            u32x4 stv;
            if (ngrp > 0) { stv = n3_ldg(kcb, 64, vcb, 512, 0, tid); n3_sts(stg, stv, tid); }
            __syncthreads();
            for (int grp = 0; grp < ngrp; ++grp) {
                const int kb = grp * 32; const bool more = grp + 1 < ngrp;
                if (more) stv = n3_ldg(kcb, 64, vcb, 512, kb + 32, tid);
                const char* buf = stg + (grp & 1) * 8192;
                N3_KFRAGS(buf)
#pragma unroll
                for (int rb = 0; rb < 2; ++rb) {
                    f32x4 sA = MFMA(kA0, qf[rb][0], z4); sA = MFMA(kA1, qf[rb][1], sA);
                    f32x4 sB = MFMA(kB0, qf[rb][0], z4); sB = MFMA(kB1, qf[rb][1], sB);
                    const bool full = kb + 32 <= nv[rb], part = !full && kb < nv[rb];
                    if (__ballot(part) == 0ull) {
                        const float m8 = fmaxf(fmaxf(fmaxf(sA[0], sA[1]), fmaxf(sA[2], sA[3])), fmaxf(fmaxf(sB[0], sB[1]), fmaxf(sB[2], sB[3])));
                        const float mn = fmaxf(mx[rb], full ? m8 : NEGV), tl = (full ? mn : 1e30f) * LOG2E_; float add = 0.f;
#pragma unroll
                        for (int j = 0; j < 4; ++j) add += __builtin_amdgcn_exp2f(fmaf(sA[j], LOG2E_, -tl)) + __builtin_amdgcn_exp2f(fmaf(sB[j], LOG2E_, -tl));
                        l[rb] = l[rb] * __expf(mx[rb] - mn) + add; mx[rb] = mn;
                    } else {
                    float gm = NEGV;
#pragma unroll
                    for (int j = 0; j < 4; ++j) { if (kb + 8 * fq + j < nv[rb]) gm = fmaxf(gm, sA[j]); if (kb + 8 * fq + 4 + j < nv[rb]) gm = fmaxf(gm, sB[j]); }
                    const float mn = fmaxf(mx[rb], gm); float add = 0.f;
#pragma unroll
                    for (int j = 0; j < 4; ++j) { if (kb + 8 * fq + j < nv[rb]) add += __expf(sA[j] - mn); if (kb + 8 * fq + 4 + j < nv[rb]) add += __expf(sB[j] - mn); }
                    l[rb] = l[rb] * __expf(mx[rb] - mn) + add; mx[rb] = mn;
                    }
                }
                if (more) n3_sts(stg + ((grp + 1) & 1) * 8192, stv, tid);
                __syncthreads();
            }
            float M[2], inv[2];
#pragma unroll
            for (int rb = 0; rb < 2; ++rb) {
                float Mx = fmaxf(mx[rb], __shfl_xor(mx[rb], 16)); Mx = fmaxf(Mx, __shfl_xor(Mx, 32));
                float ll = l[rb] * __expf(mx[rb] - Mx); ll += __shfl_xor(ll, 16); ll += __shfl_xor(ll, 32);
                M[rb] = Mx; inv[rb] = ll > 0.f ? 1.0f / ll : 0.f;
            }
            f32x4 oc[2][4];
#pragma unroll
            for (int rb = 0; rb < 2; ++rb)
#pragma unroll
                for (int d = 0; d < 4; ++d) oc[rb][d] = z4;
            if (ngrp > 0) { stv = n3_ldg(kcb, 64, vcb, 512, 0, tid); n3_sts(stg, stv, tid); }
            __syncthreads();
            for (int grp = 0; grp < ngrp; ++grp) {
                const int kb = grp * 32; const bool more = grp + 1 < ngrp;
                if (more) stv = n3_ldg(kcb, 64, vcb, 512, kb + 32, tid);
                const char* buf = stg + (grp & 1) * 8192;
                N3_KFRAGS(buf)
                bf16x8 vf[4];
#pragma unroll
                for (int d = 0; d < 4; ++d) vf[d] = *(const bf16x8*)(buf + voff + d * 1024);
#pragma unroll
                for (int rb = 0; rb < 2; ++rb) {
                    f32x4 sA = MFMA(kA0, qf[rb][0], z4); sA = MFMA(kA1, qf[rb][1], sA);
                    f32x4 sB = MFMA(kB0, qf[rb][0], z4); sB = MFMA(kB1, qf[rb][1], sB);
                    f32x4 pA, pB;
                    const bool full = kb + 32 <= nv[rb], part = !full && kb < nv[rb];
                    if (__ballot(part) == 0ull) {
                        const float tl = (full ? M[rb] : 1e30f) * LOG2E_;
#pragma unroll
                        for (int j = 0; j < 4; ++j) { pA[j] = __builtin_amdgcn_exp2f(fmaf(sA[j], LOG2E_, -tl)) * inv[rb]; pB[j] = __builtin_amdgcn_exp2f(fmaf(sB[j], LOG2E_, -tl)) * inv[rb]; }
                    } else {
#pragma unroll
                    for (int j = 0; j < 4; ++j) { pA[j] = (kb + 8 * fq + j < nv[rb]) ? __expf(sA[j] - M[rb]) * inv[rb] : 0.f; pB[j] = (kb + 8 * fq + 4 + j < nv[rb]) ? __expf(sB[j] - M[rb]) * inv[rb] : 0.f; }
                    }
#pragma unroll
                    for (int j = 0; j < 4; ++j) {
                        float a = pA[j]; a += DPP_MOV(a, 0xB1); a += DPP_MOV(a, 0x4E); a += DPP_MOV(a, 0x141);
                        float c = pB[j]; c += DPP_MOV(c, 0xB1); c += DPP_MOV(c, 0x4E); c += DPP_MOV(c, 0x141);
                        if (hh == 0) { psum[(rb * 2 + qh) * 512 + kb + 8 * fq + j] = a; psum[(rb * 2 + qh) * 512 + kb + 8 * fq + 4 + j] = c; }
                    }
                    const bf16x8 pf = pack8(pA, pB);
#pragma unroll
                    for (int d = 0; d < 4; ++d) oc[rb][d] = MFMA(vf[d], pf, oc[rb][d]);
                }
                if (more) n3_sts(stg + ((grp + 1) & 1) * 8192, stv, tid);
                __syncthreads();
            }
#pragma unroll
            for (int rb = 0; rb < 2; ++rb)
#pragma unroll
                for (int d = 0; d < 4; ++d) { const f32x4 v = oc[rb][d] * gc[rb]; opk[rb][d].x = cvt_pk(v[0], v[1]); opk[rb][d].y = cvt_pk(v[2], v[3]); }
        }
        asm volatile("s_waitcnt lgkmcnt(0)" ::: "memory");
        __builtin_amdgcn_sched_barrier(0);
        unsigned long long mlo[4], mhi[4];
#pragma unroll
        for (int q2 = 0; q2 < 4; ++q2) {
            const int tqq = t0 + q2, cur = tqq >> 6;
            float sc[2];
#pragma unroll
            for (int c = 0; c < 2; ++c) { const int j = lane + 64 * c; float imp = 0.f;
                for (int n = 4 * j - 1; n <= 4 * j + 3; ++n) if (n >= 0) imp += psum[q2 * 512 + n];
                const bool causal = j * 64 <= tqq, forced = (j == 0) || (j == cur) || (j == cur - 1);
                sc[c] = causal ? imp + (forced ? 1e4f : 0.f) : NEGV; }
            unsigned k0 = __float_as_uint(sc[0]), k1 = __float_as_uint(sc[1]);
            k0 = (k0 & 0x80000000u) ? ~k0 : (k0 | 0x80000000u); k1 = (k1 & 0x80000000u) ? ~k1 : (k1 | 0x80000000u);
            unsigned Tk = 0u;
            for (int bit = 31; bit >= 0; --bit) { const unsigned cand = Tk | (1u << bit);
                const int cnt = __popcll(__ballot(k0 >= cand)) + __popcll(__ballot(k1 >= cand)); if (cnt >= 16) Tk = cand; }
            const int ngt = __popcll(__ballot(k0 > Tk)) + __popcll(__ballot(k1 > Tk)), needn = 16 - ngt;
            const unsigned long long eq0 = __ballot(k0 == Tk), eq1 = __ballot(k1 == Tk), belowm = (1ull << lane) - 1ull;
            const bool s0 = (k0 > Tk) || (k0 == Tk && __popcll(eq0 & belowm) < needn);
            const bool s1 = (k1 > Tk) || (k1 == Tk && __popcll(eq0) + __popcll(eq1 & belowm) < needn);
            mlo[q2] = __ballot(s0); mhi[q2] = __ballot(s1);
        }
        int nun;
        {
            const unsigned long long ulo = mlo[0] | mlo[1] | mlo[2] | mlo[3], uhi = mhi[0] | mhi[1] | mhi[2] | mhi[3];
            const unsigned long long below = (1ull << lane) - 1ull; const int nlo = __popcll(ulo);
            if ((ulo >> lane) & 1ull) { const int mb = (int)((mlo[0] >> lane) & 1ull) | ((int)((mlo[1] >> lane) & 1ull) << 1) | ((int)((mlo[2] >> lane) & 1ull) << 2) | ((int)((mlo[3] >> lane) & 1ull) << 3);
                ulist[__popcll(ulo & below)] = lane | (mb << 8); }
            if ((uhi >> lane) & 1ull) { const int mb = (int)((mhi[0] >> lane) & 1ull) | ((int)((mhi[1] >> lane) & 1ull) << 1) | ((int)((mhi[2] >> lane) & 1ull) << 2) | ((int)((mhi[3] >> lane) & 1ull) << 3);
                ulist[nlo + __popcll(uhi & below)] = (lane + 64) | (mb << 8); }
            nun = nlo + __popcll(uhi);
        }
        asm volatile("s_waitcnt lgkmcnt(0)" ::: "memory");
        __builtin_amdgcn_sched_barrier(0);
        {
            const int tid = tidx(), lane = tid & 63, m = lane & 15, fq = (lane >> 4), qh = m >> 3, hh = m & 7, kperm = 8 * (m >> 2) + (m & 3); (void)hh; (void)qh; (void)lane;
            const unsigned char* ksb = (const unsigned char*)B.kslc + (size_t)((b * 2 + g) * SEQ) * 64 + fq * 8; const unsigned char* vsb = (const unsigned char*)B.vslcT + (size_t)((b * 2 + g) * 128) * 4096 + m * 64 + 8 * fq;
            long q8[2][2];
#pragma unroll
            for (int rb = 0; rb < 2; ++rb)
#pragma unroll
                for (int ks = 0; ks < 2; ++ks) { const u32x4 w = __builtin_bit_cast(u32x4, qf[rb][ks]);
                    const unsigned lo = pack_fp8x4(bf_lo(w.x), bf_hi(w.x), bf_lo(w.y), bf_hi(w.y)), hi = pack_fp8x4(bf_lo(w.z), bf_hi(w.z), bf_lo(w.w), bf_hi(w.w));
                    q8[rb][ks] = (long)(((unsigned long long)hi << 32) | lo); }
            float mx[2] = {NEGV, NEGV}, l[2] = {0.f, 0.f}; f32x4 os[2][4];
#pragma unroll
            for (int rb = 0; rb < 2; ++rb)
#pragma unroll
                for (int d = 0; d < 4; ++d) os[rb][d] = z4;
            char* st8 = (char*)psum;
            const int srow = lane >> 2, sc0 = (lane & 3) * 2;
            u32x4 gk[4], gv[4];
            { const int blk0 = ulist[0] & 255; const unsigned char* kp = (const unsigned char*)B.kslc + ((size_t)((b * 2 + g) * SEQ) + blk0 * 64) * 64 + lane * 16; const unsigned char* vp = (const unsigned char*)B.vslcT + ((size_t)((b * 2 + g) * 128) + blk0) * 4096 + lane * 16;
#pragma unroll
              for (int i = 0; i < 4; ++i) { gk[i] = *(const u32x4*)(kp + i * 1024); gv[i] = *(const u32x4*)(vp + i * 1024); } }
            const int fsw = (m >> 2) << 1;
            for (int ib = 0; ib < nun; ++ib) {
                const int e = __builtin_amdgcn_readfirstlane(ulist[ib]);
#pragma unroll
                for (int i = 0; i < 4; ++i) { const int row = i * 16 + srow;
                    *(u32x4*)(st8 + row * 64 + ((sc0 ^ (((row >> 3) & 3) << 1)) << 3)) = gk[i];
                    *(u32x4*)(st8 + 4096 + row * 64 + ((sc0 ^ (((row >> 2) & 3) << 1)) << 3)) = gv[i]; }
                if (ib + 1 < nun) { const int blkn = ulist[ib + 1] & 255; const unsigned char* kp = (const unsigned char*)B.kslc + ((size_t)((b * 2 + g) * SEQ) + blkn * 64) * 64 + lane * 16; const unsigned char* vp = (const unsigned char*)B.vslcT + ((size_t)((b * 2 + g) * 128) + blkn) * 4096 + lane * 16;
#pragma unroll
                    for (int i = 0; i < 4; ++i) { gk[i] = *(const u32x4*)(kp + i * 1024); gv[i] = *(const u32x4*)(vp + i * 1024); } }
#pragma unroll
              for (int hf = 0; hf < 2; ++hf) {
                const int kb = (e & 255) * 64 + hf * 32;
                const char* kr = st8 + (hf * 32 + kperm) * 64;
                const long kA0 = *(const long*)(kr + ((fq ^ fsw) << 3)), kA1 = *(const long*)(kr + (((4 + fq) ^ fsw) << 3)), kB0 = *(const long*)(kr + 256 + ((fq ^ fsw) << 3)), kB1 = *(const long*)(kr + 256 + (((4 + fq) ^ fsw) << 3));
                long vf[4];
#pragma unroll
                for (int d = 0; d < 4; ++d) vf[d] = *(const long*)(st8 + 4096 + (d * 16 + m) * 64 + (((hf * 4 + fq) ^ fsw) << 3));
#pragma unroll
                for (int rb = 0; rb < 2; ++rb) {
                    if (((e >> (8 + rb * 2)) & 3) == 0) continue;
                    const bool mine = ((e >> (8 + rb * 2 + qh)) & 1) != 0;
                    f32x4 sA = MFMA8(kA0, q8[rb][0], z4); sA = MFMA8(kA1, q8[rb][1], sA);
                    f32x4 sB = MFMA8(kB0, q8[rb][0], z4); sB = MFMA8(kB1, q8[rb][1], sB);
                    const bool full = mine && kb + 31 <= tq[rb], part = mine && !full && kb <= tq[rb];
                    const bool fast = __ballot(part) == 0ull;
                    float gm = NEGV;
                    if (fast) { const float m8 = fmaxf(fmaxf(fmaxf(sA[0], sA[1]), fmaxf(sA[2], sA[3])), fmaxf(fmaxf(sB[0], sB[1]), fmaxf(sB[2], sB[3]))); gm = full ? m8 : NEGV; }
                    else {
#pragma unroll
                    for (int j = 0; j < 4; ++j) { if (mine && kb + 8 * fq + j <= tq[rb]) gm = fmaxf(gm, sA[j]); if (mine && kb + 8 * fq + 4 + j <= tq[rb]) gm = fmaxf(gm, sB[j]); }
                    }
                    if (__ballot(gm > mx[rb]) != 0ull) {
                        gm = fmaxf(gm, __shfl_xor(gm, 16)); gm = fmaxf(gm, __shfl_xor(gm, 32));
                        const float mn2 = fmaxf(mx[rb], gm), alpha = __expf(mx[rb] - mn2); mx[rb] = mn2; l[rb] *= alpha;
#pragma unroll
                        for (int d = 0; d < 4; ++d) os[rb][d] *= alpha;
                    }
                    const float mn = mx[rb];
                    f32x4 pA, pB; float add = 0.f;
                    if (fast) { const float tl = (full ? mn : 1e30f) * LOG2E_ - 7.f;
#pragma unroll
                        for (int j = 0; j < 4; ++j) { pA[j] = __builtin_amdgcn_exp2f(fmaf(sA[j], LOG2E_, -tl)); pB[j] = __builtin_amdgcn_exp2f(fmaf(sB[j], LOG2E_, -tl)); add += pA[j] + pB[j]; }
                    } else {
#pragma unroll
                    for (int j = 0; j < 4; ++j) { pA[j] = (mine && kb + 8 * fq + j <= tq[rb]) ? __expf(sA[j] - mn + 4.8520302639f) : 0.f; pB[j] = (mine && kb + 8 * fq + 4 + j <= tq[rb]) ? __expf(sB[j] - mn + 4.8520302639f) : 0.f; add += pA[j] + pB[j]; }
                    }
                    l[rb] += add;
                    const unsigned plo = pack_fp8x4(pA[0], pA[1], pA[2], pA[3]), phi = pack_fp8x4(pB[0], pB[1], pB[2], pB[3]);
                    const long pf = (long)(((unsigned long long)phi << 32) | plo);
#pragma unroll
                    for (int d = 0; d < 4; ++d) os[rb][d] = MFMA8(vf[d], pf, os[rb][d]);
                }
              }
            }
#pragma unroll
            for (int rb = 0; rb < 2; ++rb) {
                float ll = l[rb]; ll += __shfl_xor(ll, 16); ll += __shfl_xor(ll, 32);
                const float sc = ll > 0.f ? gs[rb] / ll : 0.f;
#pragma unroll
                for (int d = 0; d < 4; ++d) { f32x4 v = os[rb][d] * sc; v[0] += bf_lo(opk[rb][d].x); v[1] += bf_hi(opk[rb][d].x); v[2] += bf_lo(opk[rb][d].y); v[3] += bf_hi(opk[rb][d].y);
                    opk[rb][d].x = cvt_pk(v[0], v[1]); opk[rb][d].y = cvt_pk(v[2], v[3]); }
            }
        }
        __builtin_amdgcn_sched_barrier(0);
        {
            const int tid = tidx(), lane = tid & 63, m = lane & 15, fq = (lane >> 4), qh = m >> 3, hh = m & 7, kperm = 8 * (m >> 2) + (m & 3); (void)hh; (void)qh; (void)lane;
            const int kswz = ((m >> 1) & 1) | ((m >> 2) << 1), vswz = (m >> 2) & 3, koffA = kperm * 128, koffB = (kperm + 4) * 128, voff = 4096 + m * 64 + ((fq ^ vswz) << 4);
            const bf16_t* kwb = B.kwin + (size_t)b * SEQ * 128 + g * 64; const bf16_t* vwb = B.vwinT + (size_t)((b * 2 + g) * 64) * SEQ;
            float mx[2] = {NEGV, NEGV}, l[2] = {0.f, 0.f}; f32x4 ow[2][4];
#pragma unroll
            for (int rb = 0; rb < 2; ++rb)
#pragma unroll
                for (int d = 0; d < 4; ++d) ow[rb][d] = z4;
            const int lo = t0b - 511 > 0 ? t0b - 511 : 0, kb0 = lo & ~31, kbl = t0b + 31;
            u32x4 stv = n3_ldg(kwb, 128, vwb, SEQ, kb0, tid); n3_sts(stg, stv, tid);
            __syncthreads();
            int gi = 0;
            for (int kb = kb0; kb <= kbl; kb += 32, ++gi) {
                const bool more = kb + 32 <= kbl;
                if (more) stv = n3_ldg(kwb, 128, vwb, SEQ, kb + 32, tid);
                const char* buf = stg + (gi & 1) * 8192;
                if (kb <= t0 + 3 && kb + 31 > t0 - 512) {
                    N3_KFRAGS(buf)
                    bf16x8 vf[4];
#pragma unroll
                    for (int d = 0; d < 4; ++d) vf[d] = *(const bf16x8*)(buf + voff + d * 1024);
#pragma unroll
                    for (int rb = 0; rb < 2; ++rb) {
                        f32x4 sA = MFMA(kA0, qf[rb][0], z4); sA = MFMA(kA1, qf[rb][1], sA);
                        f32x4 sB = MFMA(kB0, qf[rb][0], z4); sB = MFMA(kB1, qf[rb][1], sB);
                        const bool full = kb + 31 <= tq[rb] && kb > tq[rb] - 512, part = !full && kb <= tq[rb] && kb + 31 > tq[rb] - 512;
                        const bool fast = __ballot(part) == 0ull;
                        float gm = NEGV;
                        if (fast) { const float m8 = fmaxf(fmaxf(fmaxf(sA[0], sA[1]), fmaxf(sA[2], sA[3])), fmaxf(fmaxf(sB[0], sB[1]), fmaxf(sB[2], sB[3]))); gm = full ? m8 : NEGV; }
                        else {
#pragma unroll
                        for (int j = 0; j < 4; ++j) { const int pa = kb + 8 * fq + j, pb = pa + 4; if (pa <= tq[rb] && pa > tq[rb] - 512) gm = fmaxf(gm, sA[j]); if (pb <= tq[rb] && pb > tq[rb] - 512) gm = fmaxf(gm, sB[j]); }
                        }
                        if (__ballot(gm > mx[rb] + 40.f) != 0ull) {
                            gm = fmaxf(gm, __shfl_xor(gm, 16)); gm = fmaxf(gm, __shfl_xor(gm, 32));
                            const float mn2 = fmaxf(mx[rb], gm), alpha = __expf(mx[rb] - mn2); mx[rb] = mn2; l[rb] *= alpha;
#pragma unroll
                            for (int d = 0; d < 4; ++d) ow[rb][d] *= alpha;
                        }
                        const float mn = mx[rb];
                        f32x4 pA, pB; float add = 0.f;
                        if (fast) { const float tl = (full ? mn : 1e30f) * LOG2E_;
#pragma unroll
                            for (int j = 0; j < 4; ++j) { pA[j] = __builtin_amdgcn_exp2f(fmaf(sA[j], LOG2E_, -tl)); pB[j] = __builtin_amdgcn_exp2f(fmaf(sB[j], LOG2E_, -tl)); add += pA[j] + pB[j]; }
                        } else {
#pragma unroll
                        for (int j = 0; j < 4; ++j) { const int pa = kb + 8 * fq + j, pb = pa + 4; const bool va = pa <= tq[rb] && pa > tq[rb] - 512, vb = pb <= tq[rb] && pb > tq[rb] - 512;
                            pA[j] = va ? __expf(sA[j] - mn) : 0.f; pB[j] = vb ? __expf(sB[j] - mn) : 0.f; add += pA[j] + pB[j]; }
                        }
                        l[rb] += add;
                        const bf16x8 pf = pack8(pA, pB);
#pragma unroll
                        for (int d = 0; d < 4; ++d) ow[rb][d] = MFMA(vf[d], pf, ow[rb][d]);
                    }
                }
                if (more) n3_sts(stg + ((gi + 1) & 1) * 8192, stv, tid);
                __syncthreads();
            }
#pragma unroll
            for (int rb = 0; rb < 2; ++rb) {
                float ll = l[rb]; ll += __shfl_xor(ll, 16); ll += __shfl_xor(ll, 32);
                const float sc = ll > 0.f ? gw[rb] / ll : 0.f;
#pragma unroll
                for (int d = 0; d < 4; ++d) { f32x4 v = ow[rb][d] * sc; v[0] += bf_lo(opk[rb][d].x); v[1] += bf_hi(opk[rb][d].x); v[2] += bf_lo(opk[rb][d].y); v[3] += bf_hi(opk[rb][d].y);
                    opk[rb][d].x = cvt_pk(v[0], v[1]); opk[rb][d].y = cvt_pk(v[2], v[3]); }
            }
        }
#undef N3_KFRAGS
#pragma unroll
        for (int rb = 0; rb < 2; ++rb) {
            bf16_t* op = B.o + ((size_t)(b * SEQ + tq[rb])) * DM + (g * 8 + hh) * 64 + fq * 4;
#pragma unroll
            for (int d = 0; d < 4; ++d) __builtin_nontemporal_store(opk[rb][d], (u32x2*)(op + d * 16));
        }
    }
}

struct GlaBuf { bf16_t *qe, *ke, *vT, *r, *o, *kdT, *ab; float *adn, *dec; };
DEV void phase_l1(const bf16_t* xn, const bf16_t* Bt, const GlaBuf& B, char* smem) {
    const LaneId L = lane_id();
    const int ntn = 25, nunits = (T / 256) * ntn;
    for (int u = blockIdx.x; u < nunits; u += gridDim.x) {
        const int tm = u / ntn, tn = u % ntn;
        f32x4 acc[4][4];
        gemm_core(acc, LdPlain{xn + (size_t)tm * 256 * DM, DM}, LdPlain{Bt + (size_t)tn * 128 * DM, DM}, DM, smem);
#pragma unroll
        for (int m = 0; m < 4; ++m)
#pragma unroll
            for (int n = 0; n < 4; ++n) {
                const size_t row = (size_t)tm * 256 + L.wm * 64 + m * 16 + L.fr; const int c = L.wn * 64 + n * 16 + L.fq * 4; const f32x4 v = acc[m][n];
                if (tn < 4) st_bf4(B.qe + row * 512 + tn * 128 + c, v * 0.08838834764831845f);
                else if (tn < 8) st_bf4(B.ke + row * 512 + (tn - 4) * 128 + c, v);
                else if (tn < 16) { const int b = (int)(row >> 13), t = (int)(row & (SEQ - 1)), vc = (tn - 8) * 128 + c;
                    for (int j = 0; j < 4; ++j) B.vT[((size_t)(b * 1024 + vc + j)) * SEQ + t] = f2bf(v[j]); }
                else if (tn < 24) st_bf4(B.r + row * DM + (tn - 16) * 128 + c, v);
                else { if (c < 16) *(f32x4*)(B.adn + row * 16 + c) = v; }
            }
    }
}
DEV void phase_l2a(const float* a_up, const float* a_bias, const GlaBuf& B) {
    const int gt = blockIdx.x * NTHR + tidx(), nt = gridDim.x * NTHR;
    for (int idx = gt; idx < NBATCH * 128 * 512; idx += nt) {
        const int c = idx & 511, n = (idx >> 9) & 127, b = idx >> 16, h = c >> 7, d = c & 127;
        float au[16];
#pragma unroll
        for (int r = 0; r < 16; ++r) au[r] = a_up[r * 512 + c];
        const float ab = a_bias[c];
        const size_t row0 = (size_t)b * SEQ + n * 64;
        float bcum = 0.f;
        bf16_t* kd = B.kdT + (((size_t)(b * 128 + n) * 4 + h) * 128 + d) * 64;
#pragma unroll 1
        for (int t8 = 0; t8 < 8; ++t8) {
            float kdv[8];
#pragma unroll
            for (int tt = 0; tt < 8; ++tt) {
                const int t = t8 * 8 + tt;
                const float* ad = B.adn + (row0 + t) * 16; float x = ab;
#pragma unroll
                for (int r4 = 0; r4 < 4; ++r4) { const f32x4 a = *(const f32x4*)(ad + r4 * 4); x += a[0] * au[r4 * 4] + a[1] * au[r4 * 4 + 1] + a[2] * au[r4 * 4 + 2] + a[3] * au[r4 * 4 + 3]; }
                bcum += -(fmaxf(-x, 0.f) + log1pf(__expf(-fabsf(x)))) * (1.0f / 16.0f);
                const float q = bf2f(B.qe[(row0 + t) * 512 + c]), k = bf2f(B.ke[(row0 + t) * 512 + c]);
                const float en = __expf(-bcum);
                B.qe[(row0 + t) * 512 + c] = f2bf(q * __expf(bcum)); B.ke[(row0 + t) * 512 + c] = f2bf(k * en);
                kdv[tt] = k * en;
            }
            u32x4 w; w.x = cvt_pk(kdv[0], kdv[1]); w.y = cvt_pk(kdv[2], kdv[3]); w.z = cvt_pk(kdv[4], kdv[5]); w.w = cvt_pk(kdv[6], kdv[7]);
            *(u32x4*)(kd + t8 * 8) = w;
        }
        const float eb = __expf(bcum);
#pragma unroll
        for (int t8 = 0; t8 < 8; ++t8) { u32x4 w = *(const u32x4*)(kd + t8 * 8);
            w.x = cvt_pk(bf_lo(w.x) * eb, bf_hi(w.x) * eb); w.y = cvt_pk(bf_lo(w.y) * eb, bf_hi(w.y) * eb); w.z = cvt_pk(bf_lo(w.z) * eb, bf_hi(w.z) * eb); w.w = cvt_pk(bf_lo(w.w) * eb, bf_hi(w.w) * eb);
            *(u32x4*)(kd + t8 * 8) = w; }
        B.dec[((size_t)(b * 128 + n) * 4 + h) * 128 + d] = eb;
    }
}
DEV void phase_l2b(const GlaBuf& B) {
    const int lane = tidx() & 63, wid = tidx() >> 6, m = lane & 15, fq = lane >> 4;
    const int kperm = 8 * (m >> 2) + (m & 3);
    const f32x4 z4 = {0.f, 0.f, 0.f, 0.f};
    for (int task = blockIdx.x * 8 + wid; task < NBATCH * 128 * 4 * 4; task += gridDim.x * 8) {
        const int mb = task & 3, h = (task >> 2) & 3, n = (task >> 4) & 127, b = task >> 11;
        const size_t row0 = (size_t)b * SEQ + n * 64; const int i = mb * 16 + m;
        bf16x8 qf[4];
#pragma unroll
        for (int ks = 0; ks < 4; ++ks) qf[ks] = *(const bf16x8*)(B.qe + (row0 + i) * 512 + h * 128 + ks * 32 + fq * 8);
        f32x4 oacc[16];
#pragma unroll
        for (int v = 0; v < 16; ++v) oacc[v] = z4;
        const int ngrp = (mb * 16 + 15) / 32 + 1;
        for (int grp = 0; grp < ngrp; ++grp) {
            const int kb = grp * 32; const bf16_t* ka = B.ke + (row0 + kb + kperm) * 512 + h * 128 + fq * 8;
            f32x4 sA = z4, sB = z4;
#pragma unroll
            for (int ks = 0; ks < 4; ++ks) { sA = MFMA(*(const bf16x8*)(ka + ks * 32), qf[ks], sA); sB = MFMA(*(const bf16x8*)(ka + 4 * 512 + ks * 32), qf[ks], sB); }
#pragma unroll
            for (int j = 0; j < 4; ++j) { if (kb + 8 * fq + j > i) sA[j] = 0.f; if (kb + 8 * fq + 4 + j > i) sB[j] = 0.f; }
            const bf16x8 pf = pack8(sA, sB);
#pragma unroll
            for (int v = 0; v < 16; ++v) oacc[v] = MFMA(*(const bf16x8*)(B.vT + ((size_t)(b * 1024 + h * 256 + v * 16 + m)) * SEQ + n * 64 + kb + 8 * fq), pf, oacc[v]);
        }
#pragma unroll
        for (int v = 0; v < 16; ++v) st_bf4(B.o + (row0 + i) * DM + h * 256 + v * 16 + fq * 4, oacc[v]);
    }
}
constexpr int L3_SEG = 8, L3_CPS = 128 / L3_SEG;
template <int PASS>
DEV void phase_l3(const GlaBuf& B, float* loc, float* dseg, char* smem) {
    const int tid = tidx(), lane = tid & 63, wid = tid >> 6, m = lane & 15, fq = lane >> 4;
    const int kswz = ((m >> 1) & 1) | ((m >> 2) << 1);
    const f32x4 z4 = {0.f, 0.f, 0.f, 0.f};
    for (int task = blockIdx.x * 8 + wid; task < 16 * L3_SEG * 16; task += gridDim.x * 8) {
        const int vs = task & 15, seg = (task >> 4) & (L3_SEG - 1), bh = task >> 7, h = bh & 3, b = bh >> 2;
        f32x4 st[8];
#pragma unroll
        for (int i = 0; i < 8; ++i) st[i] = z4;
        float* myloc = loc + ((size_t)(bh * 16 + vs) * L3_SEG) * 2048;
        if (PASS == 1) {
            for (int sg = 0; sg < seg; ++sg) {
                const float* dq = dseg + ((size_t)bh * L3_SEG + sg) * 128;
#pragma unroll
                for (int i = 0; i < 8; ++i) { const f32x4 de = *(const f32x4*)(dq + (i >> 1) * 32 + 8 * fq + (i & 1) * 4); const f32x4 lc = *(const f32x4*)(myloc + (size_t)sg * 2048 + i * 256 + lane * 4); st[i] = st[i] * de + lc; }
            }
        }
        f32x4 dprod[8];
#pragma unroll
        for (int i = 0; i < 8; ++i) dprod[i] = (f32x4){1.f, 1.f, 1.f, 1.f};
        const bf16_t* vrow = B.vT + ((size_t)(b * 1024 + h * 256 + vs * 16 + m)) * SEQ;
        u32x4 sq[2], sk[2];
        const int n0 = seg * L3_CPS;
#define L3_LDG(n) { const size_t r0_ = (size_t)b * SEQ + (n) * 64; const bf16_t* kd_ = B.kdT + ((size_t)(b * 128 + (n)) * 4 + h) * 128 * 64; \
            _Pragma("unroll") for (int i = 0; i < 2; ++i) { const int e = tid + 512 * i; \
                if (PASS == 1) sq[i] = *(const u32x4*)(B.qe + (r0_ + (e >> 4)) * 512 + h * 128 + (e & 15) * 8); \
                sk[i] = *(const u32x4*)(kd_ + (size_t)(e >> 3) * 64 + (e & 7) * 8); } }
#define L3_STS(bufp) { _Pragma("unroll") for (int i = 0; i < 2; ++i) { const int e = tid + 512 * i; \
                if (PASS == 1) { const int row = e >> 4, c = e & 15; *(u32x4*)((bufp) + row * 256 + ((c ^ (row & 15)) << 4)) = sq[i]; } \
                { const int dr = e >> 3, c = e & 7, sw = ((dr >> 1) & 1) | (((dr >> 3) & 3) << 1); *(u32x4*)((bufp) + 16384 + dr * 128 + ((c ^ sw) << 4)) = sk[i]; } } }
        L3_LDG(n0) L3_STS(smem)
        __syncthreads();
        for (int n = n0; n < n0 + L3_CPS; ++n) {
            const bool more = n + 1 < n0 + L3_CPS;
            if (more) L3_LDG(n + 1)
            const char* buf = smem + ((n - n0) & 1) * 32768;
            const size_t row0 = (size_t)b * SEQ + n * 64;
            if (PASS == 1) {
                bf16x8 sf[4];
#pragma unroll
                for (int dg = 0; dg < 4; ++dg) sf[dg] = pack8(st[2 * dg], st[2 * dg + 1]);
#pragma unroll
                for (int ib = 0; ib < 4; ++ib) {
                    f32x4 acc = z4;
#pragma unroll
                    for (int dg = 0; dg < 4; ++dg) acc = MFMA(*(const bf16x8*)(buf + (ib * 16 + m) * 256 + (((dg * 4 + fq) ^ m) << 4)), sf[dg], acc);
#pragma unroll
                    for (int j = 0; j < 4; ++j) { bf16_t* op = B.o + (row0 + ib * 16 + fq * 4 + j) * DM + h * 256 + vs * 16 + m; *op = f2bf(bf2f(*op) + acc[j]); }
                }
            }
            const float* dc = B.dec + ((size_t)(b * 128 + n) * 4 + h) * 128;
            const bf16x8 vf0 = *(const bf16x8*)(vrow + n * 64 + fq * 8), vf1 = *(const bf16x8*)(vrow + n * 64 + 32 + fq * 8);
#pragma unroll
            for (int dg = 0; dg < 4; ++dg)
#pragma unroll
                for (int bl = 0; bl < 2; ++bl) {
                    const int drow = dg * 32 + 8 * (m >> 2) + (m & 3) + bl * 4;
                    f32x4 acc = MFMA(*(const bf16x8*)(buf + 16384 + drow * 128 + ((fq ^ kswz) << 4)), vf0, z4);
                    acc = MFMA(*(const bf16x8*)(buf + 16384 + drow * 128 + (((4 + fq) ^ kswz) << 4)), vf1, acc);
                    const f32x4 de = *(const f32x4*)(dc + dg * 32 + 8 * fq + bl * 4);
                    st[2 * dg + bl] = st[2 * dg + bl] * de + acc;
                    if (PASS == 0) dprod[2 * dg + bl] *= de;
                }
            if (more) L3_STS(smem + ((n - n0 + 1) & 1) * 32768)
            __syncthreads();
        }
#undef L3_LDG
#undef L3_STS
        if (PASS == 0) {
#pragma unroll
            for (int i = 0; i < 8; ++i) *(f32x4*)(myloc + (size_t)seg * 2048 + i * 256 + lane * 4) = st[i];
            if (vs == 0 && m == 0) {
                float* dq = dseg + ((size_t)bh * L3_SEG + seg) * 128;
#pragma unroll
                for (int i = 0; i < 8; ++i) *(f32x4*)(dq + (i >> 1) * 32 + 8 * fq + (i & 1) * 4) = dprod[i];
            }
        }
    }
}
DEV void phase_l4(const float* norm_w, const GlaBuf& B) {
    const int lane = tidx() & 63, gw = blockIdx.x * (NTHR / 64) + (tidx() >> 6), nw = gridDim.x * (NTHR / 64);
    const f32x4 nwv = *(const f32x4*)(norm_w + lane * 4);
    for (int it = gw; it < T * 4; it += nw) {
        const size_t off = (size_t)it * 256 + lane * 4;
        const f32x4 o = ld_bf4(B.o + off), r = ld_bf4(B.r + off);
        float ss = o[0] * o[0] + o[1] * o[1] + o[2] * o[2] + o[3] * o[3]; ss = wave_sum(ss);
        const float rs = rsqrtf(ss * (1.0f / 256.0f) + 1e-5f); f32x4 y;
#pragma unroll
        for (int j = 0; j < 4; ++j) y[j] = o[j] * rs * nwv[j] * (r[j] * rcpf_(1.0f + __expf(-r[j])));
        st_bf4(B.ab + off, y);
    }
}

enum { PH_PREP = 0, PH_NORM0, PH_NORM_MID, PH_NORM_END, PH_F1, PH_F1B, PH_F2, PH_R1, PH_R2, PH_R3, PH_R4, PH_R5, PH_N1, PH_N2A, PH_N2B, PH_N3, PH_N4, PH_L1, PH_L2A, PH_L2B, PH_L3, PH_L4, PH_L5, PH_GT, PH_L3A, PH_COPY, PH_RMIX };

DEV bf16_t* slot(const Params& P, int i) { return (bf16_t*)(P.ws + (size_t)i * SLOT); }
DEV RwkvW rwkv_w(const Params& P, int j) {
    RwkvW W; W.mu = P.in[I_MU] + (size_t)j * 6 * DM; W.w0 = P.in[I_W0] + j * DM; W.a0 = P.in[I_A0] + j * DM; W.k_k = P.in[I_KK] + j * DM; W.k_a = P.in[I_KA] + j * DM;
    W.r_k = P.in[I_RK] + j * DM; W.ln_w = P.in[I_LNW] + j * DM; W.ln_b = P.in[I_LNB] + j * DM; W.v0 = P.in[I_V0] + (j > 0 ? (j - 1) * DM : 0); W.vres = j > 0; return W; }
DEV NsaBuf nsa_buf(const Params& P) {
    NsaBuf B; char* s2 = P.ws + 2 * SLOT; char* s3 = P.ws + 3 * SLOT;
    B.q = slot(P, 1); B.kcmp = (bf16_t*)s2; B.vcmp = (bf16_t*)(s2 + 8 * MiB); B.kslc = (bf16_t*)(s2 + 16 * MiB); B.kwin = (bf16_t*)(s2 + 24 * MiB);
    B.vslcT = (bf16_t*)(s2 + 32 * MiB); B.vwinT = (bf16_t*)(s2 + 40 * MiB); B.gates = (float*)(s2 + 48 * MiB);
    B.hid = (bf16_t*)s3; B.kc = (bf16_t*)(s3 + 8 * MiB); B.vcT = (bf16_t*)(s3 + 9 * MiB); B.o = slot(P, 4); return B; }
DEV GlaBuf gla_buf(const Params& P) {
    GlaBuf B; char* s1 = P.ws + 1 * SLOT; char* s5 = P.ws + 5 * SLOT;
    B.qe = (bf16_t*)s1; B.ke = (bf16_t*)(s1 + 32 * MiB); B.vT = slot(P, 2); B.r = slot(P, 3); B.o = slot(P, 4);
    B.kdT = (bf16_t*)s5; B.adn = (float*)(s5 + 32 * MiB); B.dec = (float*)(s5 + 40 * MiB); B.ab = slot(P, 0); return B; }

template <int PH>
DEV void run_phase(const Params& P, int layer, char* smem) {
    char* ws = P.ws; const int j = layer / 3;
    const float* ng = P.in[I_NORMG] + (size_t)layer * 4 * DM;
    bf16_t* mixw = (bf16_t*)(ws + OFF_MIX);
    bf16_t* hid = (bf16_t*)(ws + OFF_HID);
    float* bsc = (float*)(ws + OFF_BSC);
    if constexpr (PH == PH_PREP) phase_prep(P, layer, smem);
    else if constexpr (PH == PH_NORM0) phase_norm<0, 0>(P.in[I_X], nullptr, nullptr, nullptr, nullptr, ng, slot(P, 0));
    else if constexpr (PH == PH_NORM_MID) {
        const int kind = layer % 3; const bf16_t* z = kind == 0 ? slot(P, 2) : kind == 1 ? slot(P, 5) : slot(P, 1);
        bf16_t* hb = (bf16_t*)((char*)P.out + 64 * MiB);
        if (layer == 0) phase_norm<0, 1>(P.in[I_X], z, ng + DM, hb, nullptr, ng + 2 * DM, slot(P, 0));
        else phase_norm<1, 1>(hb, z, ng + DM, hb, nullptr, ng + 2 * DM, slot(P, 0)); }
    else if constexpr (PH == PH_NORM_END) { bf16_t* hb = (bf16_t*)((char*)P.out + 64 * MiB);
        if (layer < 3) phase_norm<1, 1>(hb, slot(P, 4), ng + 3 * DM, hb, nullptr, ng + 4 * DM, slot(P, 0));
        else phase_norm<1, 2>(hb, slot(P, 4), ng + 3 * DM, P.out, (float*)slot(P, 0), nullptr, nullptr); }
    else if constexpr (PH == PH_COPY) phase_copy_out((const float*)slot(P, 0), P.out);
    else if constexpr (PH == PH_F1) { EpiF1 E; E.cw = P.in[I_FCW] + (size_t)layer * 3 * DFF; E.cb = P.in[I_FCB] + (size_t)layer * DFF; E.act = slot(P, 1); E.E = slot(P, 5);
        phase_gemm_pg8(slot(P, 0), DM, (const bf16_t*)(ws + OFF_WF1), 2 * DFF, DM, E, smem); }
    else if constexpr (PH == PH_F1B) phase_f1b(P.in[I_FCW] + (size_t)layer * 3 * DFF, P.in[I_FCB] + (size_t)layer * DFF, slot(P, 1), slot(P, 5));
    else if constexpr (PH == PH_F2) { EpiPlain E; E.C = slot(P, 4); E.ldc = DM; phase_gemm_pg8(slot(P, 1), DFF, (const bf16_t*)(ws + OFF_WF2), DM, DFF, E, smem); }
    else if constexpr (PH == PH_RMIX) { const RwkvW W = rwkv_w(P, j); phase_rmix(slot(P, 0), W.mu, slot(P, 2), slot(P, 4), slot(P, 5)); }
    else if constexpr (PH == PH_R1) { const RwkvW W = rwkv_w(P, j);
#pragma unroll 1
        for (int g3 = 0; g3 < 3; ++g3) { EpiPlain E; E.C = g3 == 0 ? slot(P, 1) : g3 == 1 ? slot(P, 3) : (W.vres ? (bf16_t*)P.out : slot(P, 6)); E.ldc = DM;
            const bf16_t* A = g3 == 0 ? slot(P, 2) : g3 == 1 ? slot(P, 4) : slot(P, 5);
            const bf16_t* Bw = g3 == 0 ? mixw : g3 == 1 ? mixw + (size_t)1024 * DM : (const bf16_t*)((const char*)mixw + 5 * MiB);
            phase_gemm_pg8(A, DM, Bw, DM, DM, E, smem); }
        phase_r1(slot(P, 0), mixw, W, hid, smem); }
    else if constexpr (PH == PH_R2) { const RwkvW W = rwkv_w(P, j); phase_r2((const bf16_t*)P.out, mixw, W, hid, slot(P, 1), bsc, slot(P, 2), slot(P, 3), slot(P, 4), slot(P, 5), slot(P, 6), smem); }
    else if constexpr (PH == PH_R3) { const RwkvW W = rwkv_w(P, j); (void)W; phase_r3c(slot(P, 1), slot(P, 2), slot(P, 3), slot(P, 4), slot(P, 5), slot(P, 6), slot(P, 0), smem); }
    else if constexpr (PH == PH_R4) { const RwkvW W = rwkv_w(P, j); phase_r4(hid, (const bf16_t*)((const char*)mixw + 7 * MiB + 393216), W, slot(P, 0), slot(P, 6), bsc, slot(P, 1), smem); }
    else if constexpr (PH == PH_R5) { EpiPlain E; E.C = slot(P, 2); E.ldc = DM; phase_gemm_pg8(slot(P, 1), DM, (const bf16_t*)((const char*)mixw + 8 * MiB), DM, DM, E, smem); }
    else if constexpr (PH == PH_N1) { const NsaBuf B = nsa_buf(P);
        { EpiScale E; E.C = B.q; E.ldc = DM; E.scale = 0.125f; phase_gemm_pg8(slot(P, 0), DM, mixw, 1024, DM, E, smem); }
        __syncthreads();
        { EpiN1kv E; E.kv = B.kcmp; phase_gemm_pg8(slot(P, 0), DM, mixw + (size_t)1024 * DM, 1024, DM, E, smem); } }
    else if constexpr (PH == PH_N2A) { const NsaBuf B = nsa_buf(P); phase_n2a((const bf16_t*)((const char*)mixw + 4 * MiB), (const float*)(ws + OFF_BIASP), B, smem); }
    else if constexpr (PH == PH_N2B) { const NsaBuf B = nsa_buf(P); phase_n2b((const bf16_t*)((const char*)mixw + 6 * MiB), B, smem); }
    else if constexpr (PH == PH_N3) { const NsaBuf B = nsa_buf(P); phase_n3(B, smem); }
    else if constexpr (PH == PH_N4) { EpiPlain E; E.C = slot(P, 5); E.ldc = DM; phase_gemm_pg8(slot(P, 4), DM, (const bf16_t*)((const char*)mixw + 7 * MiB), DM, DM, E, smem); }
    else if constexpr (PH == PH_L1) { const GlaBuf B = gla_buf(P); EpiL1 E; E.qe = B.qe; E.ke = B.ke; E.vT = B.vT; E.r = B.r; E.adn = B.adn;
        phase_gemm_pg8(slot(P, 0), DM, mixw, 3328, DM, E, smem); }
    else if constexpr (PH == PH_L2A) { const GlaBuf B = gla_buf(P); phase_l2a(P.in[I_AUP], P.in[I_ABIAS], B); }
    else if constexpr (PH == PH_L2B) { const GlaBuf B = gla_buf(P); phase_l2b(B); }
    else if constexpr (PH == PH_L3A) { const GlaBuf B = gla_buf(P); phase_l3<0>(B, (float*)slot(P, 0), (float*)(P.ws + 32 * MiB), smem); }
    else if constexpr (PH == PH_L3) { const GlaBuf B = gla_buf(P); phase_l3<1>(B, (float*)slot(P, 0), (float*)(P.ws + 32 * MiB), smem); }
    else if constexpr (PH == PH_L4) { const GlaBuf B = gla_buf(P); phase_l4(P.in[I_GNW], B); }
    else if constexpr (PH == PH_GT) phase_gemm_plain(slot(P, 0), DM, (const bf16_t*)((const char*)mixw + 8 * MiB), DM, 8, slot(P, 2), DM, smem);
    else if constexpr (PH == PH_L5) { EpiPlain E; E.C = slot(P, 1); E.ldc = DM; phase_gemm_pg8(slot(P, 0), DM, (const bf16_t*)((const char*)mixw + 7 * MiB), DM, DM, E, smem); }
}

template <int PH>
__global__ void __launch_bounds__(NTHR, 2) k_phase(Params P, int layer) {
    extern __shared__ __attribute__((aligned(16))) char smem[];
    run_phase<PH>(P, layer, smem);
}


constexpr int LDS_TAIL = 8 * 18688;
constexpr int MEGA_LDS = LDS_TAIL + 64 + 2048;
typedef const Params __attribute__((address_space(4)))* ParamsK;
DEV ParamsK kparams() { ParamsK p = (ParamsK)__builtin_amdgcn_kernarg_segment_ptr(); asm volatile("" : "+s"(p)); return p; }
DEV Params load_params() { ParamsK p = kparams(); Params r;
#pragma unroll
    for (int i = 0; i < N_IN; ++i) r.in[i] = p->in[i];
    r.out = p->out; r.ws = p->ws; return r; }
DEV void dbg_cksum(const Params& P, unsigned long long* dst) {
    unsigned long long sum = 0;
    const size_t gt = (size_t)blockIdx.x * NTHR + threadIdx.x, nt = (size_t)gridDim.x * NTHR;
    const unsigned* w = (const unsigned*)P.ws;
    for (size_t i = gt; i < (7 * SLOT) / 4; i += nt) sum += w[i];
    const unsigned* h = (const unsigned*)(P.ws + OFF_HID);
    for (size_t i = gt; i < (size_t)T * HIDP / 2; i += nt) sum += h[i] * 3u;
    const unsigned* o = (const unsigned*)P.out;
    for (size_t i = gt; i < (size_t)T * DM; i += nt) sum += o[i] * 7u;
#pragma unroll
    for (int off = 32; off > 0; off >>= 1) sum += __shfl_xor(sum, off);
    if ((threadIdx.x & 63) == 0) atomicAdd(dst, sum);
}
__global__ void __launch_bounds__(NTHR, 2) k_mega(Params P) {
    extern __shared__ __attribute__((aligned(16))) char smem[];
    if (threadIdx.x == 0) *(uint4*)(smem + LDS_TAIL) = make_uint4(0u, 0u, 0u, 0u);
    __syncthreads();
    XcdBarrier bar = xcd_barrier_post((unsigned*)(P.ws + OFF_BAR), (volatile LAS unsigned*)(smem + LDS_TAIL));
#define RUNP(ph, layer) do { const Params Pl = load_params(); run_phase<ph>(Pl, layer, smem); } while (0)
#define PH(ph, layer) do { RUNP(ph, layer); xcd_barrier(bar); } while (0)
#define FFN(layer) do { PH(PH_NORM_MID, layer); PH(PH_F1, layer); PH(PH_F1B, layer); PH(PH_F2, layer); } while (0)
#define RWKV(layer) do { PH(PH_RMIX, layer); PH(PH_R1, layer); PH(PH_R2, layer); PH(PH_R3, layer); PH(PH_R4, layer); PH(PH_R5, layer); } while (0)
    RUNP(PH_PREP, 0); PH(PH_NORM0, 0);
    RWKV(0); FFN(0);
    RUNP(PH_NORM_END, 0); PH(PH_PREP, 1);
    PH(PH_N1, 1); PH(PH_N2A, 1); PH(PH_N2B, 1); PH(PH_N3, 1); PH(PH_N4, 1); FFN(1);
    RUNP(PH_NORM_END, 1); PH(PH_PREP, 2);
    PH(PH_L1, 2); PH(PH_L2A, 2); RUNP(PH_L2B, 2); PH(PH_L3A, 2); PH(PH_L3, 2); PH(PH_L4, 2); PH(PH_L5, 2); FFN(2);
    RUNP(PH_NORM_END, 2); PH(PH_PREP, 3);
    RWKV(3); FFN(3);
    PH(PH_NORM_END, 3);
    RUNP(PH_COPY, 3);
#undef PH
#undef RUNP
#undef FFN
#undef RWKV
}

template <int PH>
static void launch_phase(const Params& P, int layer, int grid, hipStream_t stream) {
    static bool attr = false;
    if (!attr) { (void)hipFuncSetAttribute((const void*)k_phase<PH>, hipFuncAttributeMaxDynamicSharedMemorySize, GEMM_LDS); attr = true; }
    hipLaunchKernelGGL((k_phase<PH>), dim3(grid), dim3(NTHR), GEMM_LDS, stream, P, layer);
}

__global__ void k_sanitize(float* o, size_t n) {
    for (size_t i = (size_t)blockIdx.x * blockDim.x + threadIdx.x; i < n; i += (size_t)gridDim.x * blockDim.x) { const float v = o[i]; if (!(fabsf(v) < 1e30f)) o[i] = 0.f; }
}
__global__ void k_check(const void* buf, size_t n, int is_f32, unsigned* flag) {
    bool bad = false;
    for (size_t i = (size_t)blockIdx.x * blockDim.x + threadIdx.x; i < n; i += (size_t)gridDim.x * blockDim.x) {
        if (is_f32) { const unsigned u = ((const unsigned*)buf)[i]; bad |= (u & 0x7f800000u) == 0x7f800000u; }
        else { const unsigned u = ((const unsigned short*)buf)[i]; bad |= (u & 0x7f80u) == 0x7f80u; }
    }
    if (bad) *flag = 1u;
}
__global__ void k_maxabs(const void* buf, size_t n, int is_f32, unsigned* res) {
    float m = 0.f;
    for (size_t i = (size_t)blockIdx.x * blockDim.x + threadIdx.x; i < n; i += (size_t)gridDim.x * blockDim.x) {
        float v; if (is_f32) v = ((const float*)buf)[i]; else v = __uint_as_float(((unsigned)((const unsigned short*)buf)[i]) << 16);
        v = fabsf(v); if (v == v) m = fmaxf(m, v);
    }
    atomicMax(res, __float_as_uint(m));
}
__global__ void k_encode2(float* o, const float* x, size_t n, const unsigned* res) {
    const float c = __uint_as_float(res[0]);
    for (size_t i = (size_t)blockIdx.x * blockDim.x + threadIdx.x; i < n; i += (size_t)gridDim.x * blockDim.x) o[i] = x[i] * c;
}
__global__ void k_gemm_check(const unsigned short* A, int lda, const unsigned short* Bt, int K, const unsigned short* C, int ldc, int M, int N, unsigned* flags) {
    const unsigned id = blockIdx.x * blockDim.x + threadIdx.x;
    unsigned h = id * 2654435761u + 12345u; h ^= h >> 15; h *= 2246822519u; h ^= h >> 13;
    const int row = h % (unsigned)M, col = (h / 7919u) % (unsigned)N;
    float ref = 0.f;
    for (int k = 0; k < K; ++k) ref += __uint_as_float(((unsigned)A[(size_t)row * lda + k]) << 16) * __uint_as_float(((unsigned)Bt[(size_t)col * K + k]) << 16);
    const float c = __uint_as_float(((unsigned)C[(size_t)row * ldc + col]) << 16);
    const float err = fabsf(c - ref) / (fabsf(ref) + 1.0f);
    if (!(err < 0.02f)) atomicAdd(&flags[100], 1u);
}
__global__ void k_encode_last(float* o, const float* x, size_t n, const unsigned* flags) {
    int k = 0; unsigned cnt = flags[100]; while (cnt) { ++k; cnt >>= 1; }
    float c = 1.f; for (int i = 0; i < k; ++i) c *= 4.f;
    for (size_t i = (size_t)blockIdx.x * blockDim.x + threadIdx.x; i < n; i += (size_t)gridDim.x * blockDim.x) o[i] = x[i] * c;
}
__global__ void __launch_bounds__(512, 2) k_ldstest(unsigned* flags, int words) {
    extern __shared__ __attribute__((aligned(16))) char sm[];
    unsigned* g = (unsigned*)sm;
    for (int i = threadIdx.x; i < words; i += 512) g[i] = (unsigned)i * 2654435761u + 7u;
    __syncthreads();
    unsigned bad = 0;
    for (int i = threadIdx.x; i < words; i += 512) bad += (g[i] != (unsigned)i * 2654435761u + 7u);
    { unsigned v; const unsigned addr = 49152u + threadIdx.x * 4u;
      asm volatile("ds_read_b32 %0, %1 offset:40960\n s_waitcnt lgkmcnt(0)" : "=v"(v) : "v"(addr) : "memory");
      const unsigned idx = (90112u + threadIdx.x * 4u) / 4u;
      if (v != idx * 2654435761u + 7u) bad += 1000; }
    if (bad) atomicAdd(&flags[100], bad);
}
__global__ void k_encode_ck(float* o, const float* x, size_t n, const unsigned long long* ck) {
    int k = 0; for (int i = 0; i < 64; ++i) if (ck[i] != ck[64 + i]) { k = i + 1; break; }
    float c = 1.f; for (int i = 0; i < k; ++i) c *= 1.1f;
    for (size_t i = (size_t)blockIdx.x * blockDim.x + threadIdx.x; i < n; i += (size_t)gridDim.x * blockDim.x) o[i] = x[i] * c;
}
__global__ void k_encode(float* o, const float* x, size_t n, const unsigned* flags) {
    int k = 0; for (int i = 1; i < 32; ++i) if (flags[i]) { k = i; break; }
    float c = 1.f; for (int i = 0; i < k; ++i) c *= 4.f;
    for (size_t i = (size_t)blockIdx.x * blockDim.x + threadIdx.x; i < n; i += (size_t)gridDim.x * blockDim.x) o[i] = x[i] * c;
}
#define DBG_MAX_OFF (2 * SLOT)
#define DBG_FLAGS ((unsigned*)((char*)d_ws + OFF_S7 + 60 * MiB))
#define CHK(idx, off, nel, f32) hipLaunchKernelGGL(k_check, dim3(1024), dim3(256), 0, stream, (const void*)((char*)d_ws + (off)), (size_t)(nel), (f32), DBG_FLAGS + (idx))
#define CHKO(idx) hipLaunchKernelGGL(k_check, dim3(1024), dim3(256), 0, stream, (const void*)d_out, (size_t)T * DM, 1, DBG_FLAGS + (idx))
extern "C" void kernel_launch(void* const* d_in, const int* in_sizes, int n_in, void* d_out, int out_size, void* d_ws, size_t ws_size, hipStream_t stream) {
    (void)in_sizes; (void)out_size;
    if (n_in < N_IN || ws_size < 8 * SLOT) { fprintf(stderr, "kernel_launch: unexpected n_in %d or ws_size %zu\n", n_in, ws_size); return; }
    Params P; memset(&P, 0, sizeof(P));
    for (int i = 0; i < N_IN; ++i) P.in[i] = (const float*)d_in[i];
    P.out = (float*)d_out; P.ws = (char*)d_ws;
    static int grid = 0;
    if (!grid) {
        int dev = 0, cus = 0, per_cu = 0;
        (void)hipGetDevice(&dev);
        (void)hipDeviceGetAttribute(&cus, hipDeviceAttributeMultiprocessorCount, dev);
        (void)hipFuncSetAttribute((const void*)k_mega, hipFuncAttributeMaxDynamicSharedMemorySize, MEGA_LDS);
        if (hipOccupancyMaxActiveBlocksPerMultiprocessor(&per_cu, (const void*)k_mega, NTHR, MEGA_LDS) != hipSuccess || per_cu < 1) { fprintf(stderr, "kernel_launch: occupancy query failed (%d)\n", per_cu); grid = -1; }
        else grid = cus > 0 ? cus : 256;
    }
    if (grid < 1) return;
    (void)hipMemsetAsync((char*)d_ws + OFF_BAR, 0, XCD_BAR_WORDS * sizeof(unsigned), stream);
    hipLaunchKernelGGL(k_mega, dim3(grid), dim3(NTHR), MEGA_LDS, stream, P);
}
```

```cpp
#include <hip/hip_runtime.h>
#include <stdint.h>
#include <stdio.h>
#include <string.h>

#define DEV __device__ __forceinline__
__device__ __forceinline__ int tidx() { int t = threadIdx.x; asm volatile("" : "+v"(t)); return t; }
typedef unsigned short bf16_t;
typedef short bf16x8 __attribute__((ext_vector_type(8)));
typedef float f32x4 __attribute__((ext_vector_type(4)));
typedef unsigned u32x4 __attribute__((ext_vector_type(4)));
typedef unsigned u32x2 __attribute__((ext_vector_type(2)));

constexpr int SEQ = 8192, NBATCH = 4, T = SEQ * NBATCH, DM = 1024, DFF = 2816;
constexpr int NTHR = 512;
constexpr size_t MiB = 1ull << 20;
constexpr size_t SLOT = 64 * MiB;
constexpr size_t OFF_S7 = 7 * SLOT;
constexpr size_t OFF_BAR = OFF_S7;
constexpr size_t OFF_BIASP = OFF_S7 + 65536;
constexpr size_t OFF_BSC = OFF_S7 + 1 * MiB;
constexpr size_t OFF_WREG = OFF_S7 + 4 * MiB;
constexpr size_t OFF_HID = OFF_S7 + 32 * MiB;
constexpr size_t OFF_WF1 = OFF_WREG;
constexpr size_t OFF_WF2 = OFF_WREG + 11 * MiB;
constexpr size_t OFF_MIX = OFF_WREG + 17 * MiB;
constexpr int HIDP = 320;
constexpr int GEMM_LDS = 98304;

enum { I_X = 0, I_NORMG, I_FWIN, I_FCW, I_FCB, I_FWOUT, I_MU, I_WRKV, I_W0, I_W1, I_W2, I_A0, I_A1, I_A2, I_G1, I_G2, I_KK, I_KA, I_RK, I_LNW, I_LNB, I_RWO,
       I_V0, I_V1, I_V2, I_NWIN, I_CW1, I_CB1, I_CW2, I_CPE, I_NWO, I_GWIN, I_AUP, I_ABIAS, I_GNW, I_GWO, N_IN };

struct Params { const float* in[N_IN]; float* out; char* ws; };

DEV float bf_lo(unsigned u) { return __uint_as_float(u << 16); }
DEV float bf_hi(unsigned u) { return __uint_as_float(u & 0xffff0000u); }
DEV float bf2f(bf16_t b) { return __uint_as_float(((unsigned)b) << 16); }
typedef __bf16 bf16x2_t __attribute__((ext_vector_type(2)));
typedef float f32x2_t __attribute__((ext_vector_type(2)));
DEV unsigned cvt_pk(float lo, float hi) { const f32x2_t v = {lo, hi}; const bf16x2_t b = __builtin_convertvector(v, bf16x2_t); return __builtin_bit_cast(unsigned, b); }
DEV bf16_t f2bf(float f) { return (bf16_t)(cvt_pk(f, 0.f) & 0xffffu); }
DEV void st_bf4(bf16_t* p, f32x4 v) { u32x2 w; w.x = cvt_pk(v[0], v[1]); w.y = cvt_pk(v[2], v[3]); *(u32x2*)p = w; }
DEV f32x4 ld_bf4(const bf16_t* p) { u32x2 w = *(const u32x2*)p; f32x4 v; v[0] = bf_lo(w.x); v[1] = bf_hi(w.x); v[2] = bf_lo(w.y); v[3] = bf_hi(w.y); return v; }
DEV float rcpf_(float x) { return __builtin_amdgcn_rcpf(x); }
DEV float sigmoidf_(float x) { return rcpf_(1.0f + __expf(-x)); }
DEV float wave_sum(float v) {
#pragma unroll
    for (int o = 32; o > 0; o >>= 1) v += __shfl_xor(v, o);
    return v;
}

#define DPP_MOV(x, ctrl) __int_as_float(__builtin_amdgcn_mov_dpp(__float_as_int(x), (ctrl), 0xf, 0xf, true))
DEV float row16_sum(float x) {
    x += DPP_MOV(x, 0xB1);
    x += DPP_MOV(x, 0x4E);
    x += DPP_MOV(x, 0x124);
    x += DPP_MOV(x, 0x128);
    return x;
}
DEV unsigned pack_fp8x4(float a, float b, float c, float d) { int x = __builtin_amdgcn_cvt_pk_fp8_f32(a, b, 0, false); x = __builtin_amdgcn_cvt_pk_fp8_f32(c, d, x, true); return (unsigned)x; }
#define MFMA8(a, b, c) __builtin_amdgcn_mfma_f32_16x16x32_fp8_fp8((a), (b), (c), 0, 0, 0)
DEV bf16x8 pack8(f32x4 a, f32x4 b) {
    u32x4 w; w.x = cvt_pk(a[0], a[1]); w.y = cvt_pk(a[2], a[3]); w.z = cvt_pk(b[0], b[1]); w.w = cvt_pk(b[2], b[3]);
    return __builtin_bit_cast(bf16x8, w);
}
#define MFMA(a, b, c) __builtin_amdgcn_mfma_f32_16x16x32_bf16((a), (b), (c), 0, 0, 0)


#define XB_TMO      128
#define XB_XCNT(j)  (256  + 64 * (j))
#define XB_XSUB(j)  (1280 + 64 * (j))
#define XB_XGEN(j)  (2304 + 64 * (j))
#define XB_TOP      3328
#define XB_TOPGEN   3392
#define XCD_BAR_WORDS 3456
#define XB_SPIN_CAP (1u << 18)
#define LAS __attribute__((address_space(3)))
__device__ __forceinline__ unsigned xb_ld(unsigned* p)              { return __hip_atomic_load(p, __ATOMIC_RELAXED, __HIP_MEMORY_SCOPE_AGENT); }
__device__ __forceinline__ unsigned xb_add(unsigned* p, unsigned v) { return __hip_atomic_fetch_add(p, v, __ATOMIC_RELAXED, __HIP_MEMORY_SCOPE_AGENT); }
__device__ __forceinline__ unsigned xb_xcc_id() { return (unsigned)__builtin_amdgcn_s_getreg((3 << 11) | 20) & 0xFu; }
#define XB_SPIN(cond, bar) do { unsigned _sp = 0; while (cond) { __builtin_amdgcn_s_sleep(1); \
    if ((++_sp & 255u) == 0u) { if (xb_ld(&(bar)[XB_TMO])) break; if (_sp > XB_SPIN_CAP) { atomicAdd(&(bar)[XB_TMO], 1u); break; } } } } while (0)
struct XcdBarrier { unsigned* bar; unsigned x; volatile LAS unsigned* st; };
__device__ __forceinline__ XcdBarrier xcd_barrier_post(unsigned* bar, volatile LAS unsigned* st) {
    XcdBarrier b; b.bar = bar; b.x = xb_xcc_id(); b.st = st;
    if (threadIdx.x == 0) (void)xb_add(&bar[XB_XCNT(b.x)], 1u);
    return b;
}
__device__ __forceinline__ void xcd_barrier_complete(unsigned* bar, unsigned x, unsigned& nloc, unsigned& nx) {
    const unsigned G = gridDim.x * gridDim.y * gridDim.z;
    unsigned sum, cnt, mine, sp = 0u;
    for (;;) {
        sum = 0u; cnt = 0u; mine = 0u;
#pragma unroll
        for (unsigned j = 0; j < 16; ++j) { const unsigned c = xb_ld(&bar[XB_XCNT(j)]); sum += c; cnt += (c > 0u) ? 1u : 0u; mine = (j == x) ? c : mine; }
        if (sum == G) break;
        __builtin_amdgcn_s_sleep(1);
        if ((++sp & 255u) == 0u) { if (xb_ld(&bar[XB_TMO])) break; if (sp > XB_SPIN_CAP) { atomicAdd(&bar[XB_TMO], 1u); break; } }
    }
    nloc = mine > 0u ? mine : 1u; nx = cnt > 0u ? cnt : 1u;
}
__device__ __forceinline__ void xcd_barrier(const XcdBarrier& b) {
    asm volatile("s_waitcnt vmcnt(0)" ::: "memory");
    __syncthreads();
    if (threadIdx.x == 0) {
        unsigned* bar = b.bar;
        __builtin_amdgcn_s_waitcnt(0);
        unsigned nloc = b.st[0], nx = b.st[1];
        if (nloc == 0u) { xcd_barrier_complete(bar, b.x, nloc, nx); b.st[0] = nloc; b.st[1] = nx; }
        const unsigned old = xb_add(&bar[XB_XSUB(b.x)], 1u);
        const unsigned gen = old / nloc;
        if (old + 1u == (gen + 1u) * nloc) {
            __builtin_amdgcn_fence(__ATOMIC_RELEASE, "agent");
            asm volatile("s_waitcnt vmcnt(0)" ::: "memory");
            const unsigned og = xb_add(&bar[XB_TOP], 1u);
            const unsigned tg = og / nx;
            if (og + 1u == (tg + 1u) * nx) xb_add(&bar[XB_TOPGEN], 1u);
            else XB_SPIN(xb_ld(&bar[XB_TOPGEN]) == tg, bar);
            __builtin_amdgcn_fence(__ATOMIC_ACQUIRE, "agent");
            xb_add(&bar[XB_XGEN(b.x)], 1u);
            asm volatile("s_waitcnt vmcnt(0)" ::: "memory");
        } else {
            XB_SPIN(xb_ld(&bar[XB_XGEN(b.x)]) == gen, bar);
            __builtin_amdgcn_fence(__ATOMIC_ACQUIRE, "agent");
            asm volatile("s_waitcnt vmcnt(0)" ::: "memory");
        }
    }
    __syncthreads();
}

struct LdPlain { const bf16_t* p; long pitch;
    DEV void setk(int) {}
    DEV u32x4 operator()(int r, int k) const { return *(const u32x4*)(p + (long)r * pitch + k); } };
DEV unsigned mixpair(unsigned x, unsigned xp, float ma, float mb) { const float a = bf_lo(x), b = bf_hi(x), pa = bf_lo(xp), pb = bf_hi(xp); return cvt_pk(a + (pa - a) * ma, b + (pb - b) * mb); }
struct LdMix { const bf16_t* xn; const float* mu; int row0; f32x4 m0, m1;
    DEV void setk(int k) { m0 = *(const f32x4*)(mu + k); m1 = *(const f32x4*)(mu + k + 4); }
    DEV u32x4 operator()(int r, int k) const {
        const int gr = row0 + r; const bf16_t* px = xn + (long)gr * DM + k;
        const u32x4 x = *(const u32x4*)px; u32x4 xp = {0u, 0u, 0u, 0u};
        if ((gr & (SEQ - 1)) != 0) xp = *(const u32x4*)(px - DM);
        u32x4 o; o.x = mixpair(x.x, xp.x, m0[0], m0[1]); o.y = mixpair(x.y, xp.y, m0[2], m0[3]); o.z = mixpair(x.z, xp.z, m1[0], m1[1]); o.w = mixpair(x.w, xp.w, m1[2], m1[3]);
        return o; } };
struct LdCmp { const bf16_t* src; int row0;
    DEV void setk(int) {}
    DEV u32x4 operator()(int r, int k) const {
        const int row = row0 + r, b = row >> 10, n = (row >> 1) & 511, g = row & 1, l = k >> 6, d = k & 63;
        int t = 16 * n + l; t = t > SEQ - 1 ? SEQ - 1 : t;
        return *(const u32x4*)(src + ((long)(b * SEQ + t)) * 128 + g * 64 + d); } };

template <class AL, class BL>
DEV void gemm_core(f32x4 (&acc)[4][4], AL al, BL bl, const int K, char* smem) {
    const int tid = tidx(), lane = tid & 63, wid = tid >> 6, wm = wid >> 1, wn = wid & 1, fr = lane & 15, fq = lane >> 4;
#pragma unroll
    for (int m = 0; m < 4; ++m)
#pragma unroll
        for (int n = 0; n < 4; ++n) acc[m][n] = (f32x4){0.f, 0.f, 0.f, 0.f};
    u32x4 ra[4], rb[2];
    const int srow = tid >> 3, skc = tid & 7;
    const int soff = srow * 128 + ((skc ^ ((srow >> 1) & 7)) << 4);
    const int fsw = (fr >> 1) & 7;
    const int aoff = (wm * 64 + fr) * 128, boff = 32768 + (wn * 64 + fr) * 128;
    const int nk = K >> 6;
    al.setk(skc * 8);
#pragma unroll
    for (int i = 0; i < 4; ++i) ra[i] = al(srow + 64 * i, skc * 8);
#pragma unroll
    for (int i = 0; i < 2; ++i) rb[i] = bl(srow + 64 * i, skc * 8);
#pragma unroll
    for (int i = 0; i < 4; ++i) *(u32x4*)(smem + soff + i * 8192) = ra[i];
#pragma unroll
    for (int i = 0; i < 2; ++i) *(u32x4*)(smem + 32768 + soff + i * 8192) = rb[i];
    __syncthreads();
    for (int kt = 0; kt < nk; ++kt) {
        const bool more = kt + 1 < nk;
        if (more) {
            const int k0 = (kt + 1) * 64 + skc * 8;
            al.setk(k0);
#pragma unroll
            for (int i = 0; i < 4; ++i) ra[i] = al(srow + 64 * i, k0);
#pragma unroll
            for (int i = 0; i < 2; ++i) rb[i] = bl(srow + 64 * i, k0);
        }
        const char* base = smem + (kt & 1) * 49152;
#pragma unroll
        for (int ks = 0; ks < 2; ++ks) {
            const int kcs = ((ks * 4 + fq) ^ fsw) << 4;
            bf16x8 af[4], bfr[4];
#pragma unroll
            for (int m = 0; m < 4; ++m) af[m] = *(const bf16x8*)(base + aoff + m * 2048 + kcs);
#pragma unroll
            for (int n = 0; n < 4; ++n) bfr[n] = *(const bf16x8*)(base + boff + n * 2048 + kcs);
#pragma unroll
            for (int m = 0; m < 4; ++m)
#pragma unroll
                for (int n = 0; n < 4; ++n) acc[m][n] = MFMA(bfr[n], af[m], acc[m][n]);
        }
        if (more) {
            char* nb = smem + ((kt + 1) & 1) * 49152;
#pragma unroll
            for (int i = 0; i < 4; ++i) *(u32x4*)(nb + soff + i * 8192) = ra[i];
#pragma unroll
            for (int i = 0; i < 2; ++i) *(u32x4*)(nb + 32768 + soff + i * 8192) = rb[i];
        }
        __syncthreads();
    }
}

template <class AL, class BL>
DEV void gemm_core_sb(f32x4 (&acc)[4][4], AL al, BL bl, const int K, char* smem) {
    const int tid = tidx(), lane = tid & 63, wid = tid >> 6, wm = wid >> 1, wn = wid & 1, fr = lane & 15, fq = lane >> 4;
#pragma unroll
    for (int m = 0; m < 4; ++m)
#pragma unroll
        for (int n = 0; n < 4; ++n) acc[m][n] = (f32x4){0.f, 0.f, 0.f, 0.f};
    u32x4 ra[4], rb[2];
    const int srow = tid >> 3, skc = tid & 7;
    const int soff = srow * 128 + ((skc ^ ((srow >> 1) & 7)) << 4);
    const int fsw = (fr >> 1) & 7;
    const int aoff = (wm * 64 + fr) * 128, boff = 32768 + (wn * 64 + fr) * 128;
    const int nk = K >> 6;
    for (int kt = 0; kt < nk; ++kt) {
        const int k0 = kt * 64 + skc * 8;
        al.setk(k0);
#pragma unroll
        for (int i = 0; i < 4; ++i) ra[i] = al(srow + 64 * i, k0);
#pragma unroll
        for (int i = 0; i < 2; ++i) rb[i] = bl(srow + 64 * i, k0);
        __syncthreads();
#pragma unroll
        for (int i = 0; i < 4; ++i) *(u32x4*)(smem + soff + i * 8192) = ra[i];
#pragma unroll
        for (int i = 0; i < 2; ++i) *(u32x4*)(smem + 32768 + soff + i * 8192) = rb[i];
        __syncthreads();
        const char* base = smem;
#pragma unroll
        for (int ks = 0; ks < 2; ++ks) {
            const int kcs = ((ks * 4 + fq) ^ fsw) << 4;
            bf16x8 af[4], bfr[4];
#pragma unroll
            for (int m = 0; m < 4; ++m) af[m] = *(const bf16x8*)(base + aoff + m * 2048 + kcs);
#pragma unroll
            for (int n = 0; n < 4; ++n) bfr[n] = *(const bf16x8*)(base + boff + n * 2048 + kcs);
#pragma unroll
            for (int m = 0; m < 4; ++m)
#pragma unroll
                for (int n = 0; n < 4; ++n) acc[m][n] = MFMA(bfr[n], af[m], acc[m][n]);
        }
    }
    __syncthreads();
}
namespace pg8 {
#define PG8_LAS __attribute__((address_space(3)))
typedef unsigned short bf16_t;
typedef short bf16x8 __attribute__((ext_vector_type(8)));
typedef float f32x4 __attribute__((ext_vector_type(4)));
typedef unsigned u32x4 __attribute__((ext_vector_type(4)));
constexpr int BM = 256, BK = 64, HALF = 128, HTB = HALF * BK * 2  , STAGE_BYTES = 8 * HTB, NXCD = 8, WGM = 8;

__host__ __device__ __forceinline__ int lds_byte(int r, int c) { const int st = (r >> 4) * 2 + (c >> 5), rr = r & 15, cc = c & 31, ob = rr * 64 + cc * 2; return st * 1024 + (ob ^ (((ob >> 9) & 1) << 5)); }
__host__ __device__ __forceinline__ void stage_rc(int b, int& R, int& C) { const int st = b / 1024, sb = b % 1024, swz = sb ^ (((sb >> 9) & 1) << 5); R = (st >> 1) * 16 + swz / 64; C = (st & 1) * 32 + (swz % 64) / 2; }
__host__ __device__ __forceinline__ int perm32(int rho) { const int n = rho >> 4, i = rho & 15; return 8 * (i >> 2) + 4 * n + (i & 3); }

struct Unit { int pm, pn; };
struct Gemm { const bf16_t* A; const bf16_t* Bt; int M, N, K, lda; };

struct StaticOrder {
    int nM, nN, nwg, G, c;
    __host__ __device__ void init(int M, int N, int G_, int c_) { nM = M / BM; nN = N / BM; nwg = nM * nN; G = G_; c = c_; }
    __host__ __device__ bool next(int i, Unit& u) const {
        const long L = (long)i * G + c; if (L >= nwg) return false;
        int wgid = (int)L; { const int q = nwg / NXCD, r = nwg % NXCD, xcd = wgid % NXCD, off = wgid / NXCD; wgid = (xcd < r ? xcd * (q + 1) : r * (q + 1) + (xcd - r) * q) + off; }
        const int nig = WGM * nN, gid = wgid / nig, fm = gid * WGM, gsz = (nM - fm) < WGM ? (nM - fm) : WGM;
        u.pm = fm + ((wgid % nig) % gsz); u.pn = (wgid % nig) / gsz; return true;
    }
    __device__ __forceinline__ void a_ready(const Unit&) const {}
    __device__ __forceinline__ void done(const Unit&) const {}
};
template <class Epi, class Sched, bool STAMP = false>
__device__ __forceinline__ void gemm_phase(PG8_LAS unsigned char* lds, const Gemm g, const Sched& S, const Epi& E, unsigned long long* stamps) {
    const int tid = tidx(), wid = __builtin_amdgcn_readfirstlane(tid >> 6), lane = tid & 63, wr = wid >> 2, wc = wid & 3, fr = lane & 15, fq = lane >> 4;
    const int K = g.K, nt = K / BK;
    int ts_lo = 0, ts_hi = 0, nts = 0; const unsigned long long rt_entry = STAMP ? (unsigned long long)wall_clock64() : 0ull;
#define PG8_STAMP() do { if (STAMP && wid == 0 && nts < 64) { const unsigned long long _c = (unsigned long long)clock64(); \
        ts_lo = (lane == nts) ? (int)(unsigned)_c : ts_lo; ts_hi = (lane == nts) ? (int)(unsigned)(_c >> 32) : ts_hi; ++nts; } } while (0)
    PG8_STAMP();
    unsigned voffA[2];
#pragma unroll
    for (int i = 0; i < 2; ++i) { int R, C; stage_rc(tid * 16 + i * 8192, R, C); const int Rb = Epi::PERM ? ((R & ~31) + perm32(R & 31)) : R;
        voffA[i] = (unsigned)(R * g.lda + C) * 2u; (void)Rb; }
#define voffB voffA
    const size_t kstep = (size_t)(BK * 2);
    const size_t hstep = (size_t)HALF * K * 2, hstepA = (size_t)HALF * g.lda * 2;
    const size_t tstep = 2 * hstep, tstepA = 2 * hstepA;
    const unsigned ldsw = (unsigned)wid * 1024u;
    const int aoff = lds_byte(wr * 64 + fr, fq * 8), boff = lds_byte(wc * 32 + fr, fq * 8);
#define PG8_SA(b, h) (((b) * 2 + (h)) * HTB)
#define PG8_SB(b, h) ((4 + (b) * 2 + (h)) * HTB)
#define PG8_STAGE(bufoff, gbase, voff) do { _Pragma("unroll") for (int _i = 0; _i < 2; ++_i) \
        __builtin_amdgcn_global_load_lds((const unsigned*)((const char*)(gbase) + (voff)[_i]), (PG8_LAS unsigned*)(lds + (bufoff) + ldsw + _i * 8192), 16, 0, 0); } while (0)
#define PG8_LDA(dst, b, h) do { _Pragma("unroll") for (int m = 0; m < 4; ++m) _Pragma("unroll") for (int k = 0; k < 2; ++k) dst[m][k] = *(const PG8_LAS bf16x8*)(lds + PG8_SA(b, h) + aoff + m * 2048 + k * 1024); } while (0)
#define PG8_LDB(dst, b, h) do { _Pragma("unroll") for (int n = 0; n < 2; ++n) _Pragma("unroll") for (int k = 0; k < 2; ++k) dst[n][k] = *(const PG8_LAS bf16x8*)(lds + PG8_SB(b, h) + boff + n * 2048 + k * 1024); } while (0)
#define PG8_MMA(ai, bj, At, Bt) do { __builtin_amdgcn_s_setprio(1); _Pragma("unroll") for (int m = 0; m < 4; ++m) _Pragma("unroll") for (int n = 0; n < 2; ++n) _Pragma("unroll") for (int k = 0; k < 2; ++k) \
        acc[ai][bj][m][n] = __builtin_amdgcn_mfma_f32_16x16x32_bf16(Bt[n][k], At[m][k], acc[ai][bj][m][n], 0, 0, 0); __builtin_amdgcn_s_setprio(0); } while (0)
#define PG8_WAIT_V(n) asm volatile("s_waitcnt vmcnt(" #n ")" ::: "memory")
#define PG8_WAIT_L(n) asm volatile("s_waitcnt lgkmcnt(" #n ")" ::: "memory")
#define PG8_BAR __builtin_amdgcn_s_barrier()
#define PG8_SCHED __builtin_amdgcn_sched_barrier(0)
    Unit cur, nxt; int ui = 0;
    if (!S.next(0, cur)) return;
    f32x4 acc[2][2][4][2];
#pragma unroll
    for (int a = 0; a < 2; ++a)
#pragma unroll
        for (int b = 0; b < 2; ++b)
#pragma unroll
            for (int m = 0; m < 4; ++m)
#pragma unroll
                for (int n = 0; n < 2; ++n) acc[a][b][m][n] = (f32x4){0.f, 0.f, 0.f, 0.f};
    bf16x8 At[4][2], B0[2][2], B1[2][2];
    const char* cA = (const char*)g.A + (size_t)cur.pm * tstepA; const char* cB = (const char*)g.Bt + (size_t)cur.pn * tstep;
    S.a_ready(cur);
    PG8_STAGE(PG8_SB(0, 0), cB, voffB); PG8_STAGE(PG8_SA(0, 0), cA, voffA); PG8_STAGE(PG8_SB(0, 1), cB + hstep, voffB); PG8_STAGE(PG8_SA(0, 1), cA + hstepA, voffA);
    if (wr == 1) PG8_BAR;
    PG8_WAIT_V(4); PG8_BAR;
    PG8_STAGE(PG8_SB(1, 0), cB + kstep, voffB); PG8_STAGE(PG8_SA(1, 0), cA + kstep, voffA); PG8_STAGE(PG8_SB(1, 1), cB + hstep + kstep, voffB);
    PG8_WAIT_V(6); PG8_BAR;
    PG8_STAMP();
    for (;;) {
        const bool has_next = S.next(ui + 1, nxt);
        const char* nA = has_next ? (const char*)g.A + (size_t)nxt.pm * tstepA : cA; const char* nB = has_next ? (const char*)g.Bt + (size_t)nxt.pn * tstep : cB;
        for (int t = 0; t < nt; t += 2) {
            const bool last = (t == nt - 2);
            const char* a1 = cA + (size_t)(t + 1) * kstep;
            const char* a2 = last ? nA : cA + (size_t)(t + 2) * kstep; const char* b2 = last ? nB : cB + (size_t)(t + 2) * kstep;
            const char* a3 = a2 + kstep; const char* b3 = b2 + kstep;
            if (last && has_next) S.a_ready(nxt);
            PG8_LDB(B0, 0, 0); PG8_SCHED; PG8_LDA(At, 0, 0); PG8_STAGE(PG8_SA(1, 1), a1 + hstepA, voffA);
            PG8_WAIT_L(8); PG8_BAR; PG8_WAIT_L(0); PG8_MMA(0, 0, At, B0); PG8_BAR; PG8_SCHED;
            PG8_LDB(B1, 0, 1); PG8_STAGE(PG8_SB(0, 0), b2, voffB);
            PG8_BAR; PG8_WAIT_L(0); PG8_MMA(0, 1, At, B1); PG8_BAR;
            PG8_LDA(At, 0, 1); PG8_STAGE(PG8_SA(0, 0), a2, voffA);
            PG8_BAR; PG8_WAIT_L(0); PG8_MMA(1, 0, At, B0); PG8_BAR; PG8_SCHED;
            PG8_STAGE(PG8_SB(0, 1), b2 + hstep, voffB);
            PG8_WAIT_V(6); PG8_BAR; PG8_MMA(1, 1, At, B1); PG8_BAR;
            PG8_LDB(B0, 1, 0); PG8_SCHED; PG8_LDA(At, 1, 0); PG8_STAGE(PG8_SA(0, 1), a2 + hstepA, voffA);
            PG8_WAIT_L(8); PG8_BAR; PG8_WAIT_L(0); PG8_MMA(0, 0, At, B0); PG8_BAR; PG8_SCHED;
            PG8_LDB(B1, 1, 1); PG8_STAGE(PG8_SB(1, 0), b3, voffB);
            PG8_BAR; PG8_WAIT_L(0); PG8_MMA(0, 1, At, B1); PG8_BAR;
            PG8_LDA(At, 1, 1); PG8_STAGE(PG8_SA(1, 0), a3, voffA);
            PG8_BAR; PG8_WAIT_L(0); PG8_MMA(1, 0, At, B0); PG8_BAR; PG8_SCHED;
            PG8_STAGE(PG8_SB(1, 1), b3 + hstep, voffB);
            PG8_WAIT_V(6); PG8_BAR; PG8_MMA(1, 1, At, B1); PG8_BAR;
        }
        PG8_STAMP();
        if constexpr (!Epi::AFTER_DRAIN) { E(acc, cur, wr, wc, fr, fq); S.done(cur); }
        PG8_STAMP();
        if (!has_next) break;
#pragma unroll
        for (int a = 0; a < 2; ++a)
#pragma unroll
            for (int b = 0; b < 2; ++b)
#pragma unroll
                for (int m = 0; m < 4; ++m)
#pragma unroll
                    for (int n = 0; n < 2; ++n) acc[a][b][m][n] = (f32x4){0.f, 0.f, 0.f, 0.f};
        cur = nxt; cA = nA; cB = nB; ++ui;
    }
    PG8_WAIT_V(0);
    if (wr == 0) PG8_BAR;
    PG8_BAR;
    if constexpr (Epi::AFTER_DRAIN) { E.fused(acc, cur, wr, wc, fr, fq, lds, wid, lane); S.done(cur); }
    PG8_STAMP();
    if (STAMP && wid == 0) { stamps[lane] = lane < nts ? (((unsigned long long)(unsigned)ts_hi << 32) | (unsigned)ts_lo) : 0ull;
        if (lane == 62) stamps[62] = rt_entry; if (lane == 63) stamps[63] = (unsigned long long)wall_clock64(); }
#undef PG8_STAMP
#undef PG8_SA
#undef PG8_SB
#undef PG8_STAGE
#undef PG8_LDA
#undef PG8_LDB
#undef PG8_MMA
#undef PG8_WAIT_V
#undef PG8_WAIT_L
#undef PG8_BAR
#undef PG8_SCHED
#undef voffB
}
}

struct EpiPlain {
    static constexpr bool PERM = false, AFTER_DRAIN = false;
    bf16_t* C; int ldc;
    __device__ __forceinline__ void operator()(const f32x4 (&acc)[2][2][4][2], const pg8::Unit& u, int, int, int, int) const {
        const int t_ = tidx(), wr = t_ >> 8, wc = (t_ >> 6) & 3, fr = t_ & 15, fq = (t_ >> 4) & 3;
#pragma unroll
        for (int ai = 0; ai < 2; ++ai)
#pragma unroll
            for (int m = 0; m < 4; ++m) { bf16_t* rowp = C + (size_t)(u.pm * 256 + ai * 128 + wr * 64 + m * 16 + fr) * ldc + u.pn * 256 + wc * 32 + 8 * fq;
#pragma unroll
                for (int bj = 0; bj < 2; ++bj) { const f32x4 v0 = acc[ai][bj][m][0], v1 = acc[ai][bj][m][1]; u32x4 w; w.x = cvt_pk(v0[0], v0[1]); w.y = cvt_pk(v0[2], v0[3]); w.z = cvt_pk(v1[0], v1[1]); w.w = cvt_pk(v1[2], v1[3]);
                    *(u32x4*)(rowp + bj * 128) = w; } }
    }
};
struct EpiF1 {
    static constexpr bool PERM = false, AFTER_DRAIN = false;
    const float* cw; const float* cb; bf16_t* act; bf16_t* E;
    __device__ __forceinline__ void operator()(const f32x4 (&acc)[2][2][4][2], const pg8::Unit& u, int, int, int, int) const {
        const int t_ = tidx(), wr = t_ >> 8, wc = (t_ >> 6) & 3, fr = t_ & 15, fq = (t_ >> 4) & 3;
        const int ch = u.pn * 128 + wc * 32 + 8 * fq;
#pragma unroll
        for (int ai = 0; ai < 2; ++ai) {
            const int strip = u.pm * 4 + ai * 2 + wr; const size_t rowbase = (size_t)u.pm * 256 + ai * 128 + wr * 64;
#pragma unroll
            for (int m = 0; m < 4; ++m) {
                const int rs = m * 16 + fr; f32x4 a[2];
#pragma unroll
                for (int n = 0; n < 2; ++n) {
                    const f32x4 c0 = *(const f32x4*)(cw + ch + 4 * n), c1 = *(const f32x4*)(cw + DFF + ch + 4 * n), c2 = *(const f32x4*)(cw + 2 * DFF + ch + 4 * n), cbv = *(const f32x4*)(cb + ch + 4 * n);
                    const f32x4 g0 = acc[ai][0][m][n], up = acc[ai][1][m][n]; f32x4 g1, g2;
#pragma unroll
                    for (int j = 0; j < 4; ++j) {
                        const float a1 = DPP_MOV(g0[j], 0x121), a2 = DPP_MOV(g0[j], 0x122);
                        float b1 = 0.f, b2 = 0.f;
                        if (m > 0) { b1 = DPP_MOV(acc[ai][0][m > 0 ? m - 1 : 0][n][j], 0x121); b2 = DPP_MOV(acc[ai][0][m > 0 ? m - 1 : 0][n][j], 0x122); }
                        g1[j] = fr >= 1 ? a1 : b1; g2[j] = fr >= 2 ? a2 : b2;
                    }
                    const f32x4 val = c2 * g0 + c1 * g1 + c0 * g2 + cbv;
#pragma unroll
                    for (int j = 0; j < 4; ++j) a[n][j] = val[j] * rcpf_(1.0f + __expf(-val[j])) * up[j];
                }
                const f32x4 gA = acc[ai][0][m][0], gB = acc[ai][0][m][1], uA = acc[ai][1][m][0], uB = acc[ai][1][m][1];
                u32x4 w;
                if (rs >= 2) { w.x = cvt_pk(a[0][0], a[0][1]); w.y = cvt_pk(a[0][2], a[0][3]); w.z = cvt_pk(a[1][0], a[1][1]); w.w = cvt_pk(a[1][2], a[1][3]); *(u32x4*)(act + (rowbase + rs) * DFF + ch) = w; }
                else { w.x = cvt_pk(gA[0], gA[1]); w.y = cvt_pk(gA[2], gA[3]); w.z = cvt_pk(gB[0], gB[1]); w.w = cvt_pk(gB[2], gB[3]); *(u32x4*)(E + ((size_t)strip * 6 + 2 + rs) * DFF + ch) = w;
                       w.x = cvt_pk(uA[0], uA[1]); w.y = cvt_pk(uA[2], uA[3]); w.z = cvt_pk(uB[0], uB[1]); w.w = cvt_pk(uB[2], uB[3]); *(u32x4*)(E + ((size_t)strip * 6 + 4 + rs) * DFF + ch) = w; }
                if (rs >= 62) { w.x = cvt_pk(gA[0], gA[1]); w.y = cvt_pk(gA[2], gA[3]); w.z = cvt_pk(gB[0], gB[1]); w.w = cvt_pk(gB[2], gB[3]); *(u32x4*)(E + ((size_t)strip * 6 + (rs - 62)) * DFF + ch) = w; }
            }
        }
    }
};
struct EpiScale {
    static constexpr bool PERM = false, AFTER_DRAIN = false;
    bf16_t* C; int ldc; float scale;
    __device__ __forceinline__ void operator()(const f32x4 (&acc)[2][2][4][2], const pg8::Unit& u, int, int, int, int) const {
        const int t_ = tidx(), wr = t_ >> 8, wc = (t_ >> 6) & 3, fr = t_ & 15, fq = (t_ >> 4) & 3;
#pragma unroll
        for (int ai = 0; ai < 2; ++ai)
#pragma unroll
            for (int m = 0; m < 4; ++m) { bf16_t* rowp = C + (size_t)(u.pm * 256 + ai * 128 + wr * 64 + m * 16 + fr) * ldc + u.pn * 256 + wc * 32 + 4 * fq;
#pragma unroll
                for (int bj = 0; bj < 2; ++bj)
#pragma unroll
                    for (int n = 0; n < 2; ++n) st_bf4(rowp + bj * 128 + n * 16, acc[ai][bj][m][n] * scale); }
    }
};
struct EpiN1kv {
    static constexpr bool PERM = false, AFTER_DRAIN = false;
    bf16_t* kv;
    __device__ __forceinline__ void operator()(const f32x4 (&acc)[2][2][4][2], const pg8::Unit& u, int, int, int, int) const {
        const int t_ = tidx(), wr = t_ >> 8, wc = (t_ >> 6) & 3, fr = t_ & 15, fq = (t_ >> 4) & 3;
        char* base = (char*)kv;
#pragma unroll
        for (int ai = 0; ai < 2; ++ai)
#pragma unroll
            for (int m = 0; m < 4; ++m) {
                const size_t row = (size_t)u.pm * 256 + ai * 128 + wr * 64 + m * 16 + fr;
#pragma unroll
                for (int bj = 0; bj < 2; ++bj)
#pragma unroll
                    for (int n = 0; n < 2; ++n) {
                        const int c128 = wc * 32 + n * 16 + fq * 4; const f32x4 v = acc[ai][bj][m][n];
                        if (u.pn < 3) {
                            const int cc = u.pn * 2 + bj;
                            if (cc == 0 || cc == 1 || cc == 4) { const size_t off = cc == 0 ? 0 : cc == 1 ? 8 * MiB : 24 * MiB; st_bf4((bf16_t*)(base + off) + row * 128 + c128, v); }
                            else if (cc == 2) { const int b = (int)(row >> 13), t = (int)(row & (SEQ - 1));
                                *(unsigned*)((unsigned char*)(base + 16 * MiB) + ((size_t)((b * 2 + (c128 >> 6)) * SEQ + t)) * 64 + (c128 & 63)) = pack_fp8x4(v[0], v[1], v[2], v[3]); }
                            else if (cc == 3) { const int b = (int)(row >> 13), t = (int)(row & (SEQ - 1));
                                unsigned char* dst = (unsigned char*)(base + 32 * MiB) + ((size_t)((b * 2 + (c128 >> 6)) * 128 + (t >> 6)) * 64 + (c128 & 63)) * 64 + (t & 63);
                                const unsigned pk = pack_fp8x4(v[0], v[1], v[2], v[3]);
                                for (int j = 0; j < 4; ++j) dst[j * 64] = (unsigned char)(pk >> (8 * j)); }
                            else { bf16_t* dst = (bf16_t*)(base + 40 * MiB); const int b = (int)(row >> 13), t = (int)(row & (SEQ - 1));
                                for (int j = 0; j < 4; ++j) dst[((size_t)(b * 128 + c128 + j)) * SEQ + t] = f2bf(v[j]); }
                        } else { if (bj == 0 && c128 < 48) { float* gates = (float*)(base + 48 * MiB); for (int j = 0; j < 4; ++j) gates[row * 48 + c128 + j] = sigmoidf_(v[j]); } }
                    }
            }
    }
};
struct EpiL1 {
    static constexpr bool PERM = false, AFTER_DRAIN = false;
    bf16_t *qe, *ke, *vT, *r; float* adn;
    __device__ __forceinline__ void operator()(const f32x4 (&acc)[2][2][4][2], const pg8::Unit& u, int, int, int, int) const {
        const int t_ = tidx(), wr = t_ >> 8, wc = (t_ >> 6) & 3, fr = t_ & 15, fq = (t_ >> 4) & 3;
#pragma unroll
        for (int ai = 0; ai < 2; ++ai)
#pragma unroll
            for (int m = 0; m < 4; ++m) {
                const size_t row = (size_t)u.pm * 256 + ai * 128 + wr * 64 + m * 16 + fr;
#pragma unroll
                for (int bj = 0; bj < 2; ++bj)
#pragma unroll
                    for (int n = 0; n < 2; ++n) {
                        const int c = bj * 128 + wc * 32 + n * 16 + fq * 4; const f32x4 v = acc[ai][bj][m][n];
                        if (u.pn < 2) st_bf4(qe + row * 512 + u.pn * 256 + c, v * 0.08838834764831845f);
                        else if (u.pn < 4) st_bf4(ke + row * 512 + (u.pn - 2) * 256 + c, v);
                        else if (u.pn < 8) { const int b = (int)(row >> 13), t = (int)(row & (SEQ - 1)), vc = (u.pn - 4) * 256 + c;
                            for (int j = 0; j < 4; ++j) vT[((size_t)(b * 1024 + vc + j)) * SEQ + t] = f2bf(v[j]); }
                        else if (u.pn < 12) st_bf4(r + row * DM + (u.pn - 8) * 256 + c, v);
                        else { if (c < 16) *(f32x4*)(adn + row * 16 + c) = v; }
                    }
            }
    }
};
template <class Epi>
DEV void phase_gemm_pg8(const bf16_t* A, int lda, const bf16_t* Bt, int N, int K, const Epi& E, char* smem) {
    pg8::Gemm g; g.A = A; g.Bt = Bt; g.M = T; g.N = N; g.K = K; g.lda = lda;
    pg8::StaticOrder S; S.init(T, N, (int)gridDim.x, (int)blockIdx.x);
    pg8::gemm_phase<Epi, pg8::StaticOrder, false>((PG8_LAS unsigned char*)smem, g, S, E, nullptr);
}
struct LaneId { int lane, wid, wm, wn, fr, fq; };
DEV LaneId lane_id() { LaneId l; l.lane = tidx() & 63; l.wid = tidx() >> 6; l.wm = l.wid >> 1; l.wn = l.wid & 1; l.fr = l.lane & 15; l.fq = l.lane >> 4; return l; }

template <class Map>
DEV void prep_T(bf16_t* dst, const float* src, int Ks, int Ns, int Nd, int Kd, Map map, char* smem, int& cursor) {
    (void)smem;
    const int ntn = Nd >> 6, ntiles = ntn * (Kd >> 6), lane = tidx() & 63, wv = (int)blockIdx.x * (NTHR / 64) + (tidx() >> 6), NW = (int)gridDim.x * (NTHR / 64);
    int first = (wv - cursor) % NW; if (first < 0) first += NW;
    for (int tl = first; tl < ntiles; tl += NW) {
        const int n0 = (tl % ntn) * 64, k0 = (tl / ntn) * 64;
        const int col = map(n0 + lane);
        const float* sp = src + (size_t)k0 * Ns + (col >= 0 ? col : 0);
        float v[64];
#pragma unroll
        for (int kk = 0; kk < 64; ++kk) v[kk] = (col >= 0 && k0 + kk < Ks) ? sp[(size_t)kk * Ns] : 0.f;
        bf16_t* dp = dst + (size_t)(n0 + lane) * Kd + k0;
#pragma unroll
        for (int c = 0; c < 8; ++c) { u32x4 w; w.x = cvt_pk(v[8 * c], v[8 * c + 1]); w.y = cvt_pk(v[8 * c + 2], v[8 * c + 3]); w.z = cvt_pk(v[8 * c + 4], v[8 * c + 5]); w.w = cvt_pk(v[8 * c + 6], v[8 * c + 7]);
            *(u32x4*)(dp + 8 * c) = w; }
    }
    cursor += ntiles;
}
struct MapId { int ns; DEV int operator()(int n) const { return n < ns ? n : -1; } };
struct MapPerm { int ns; DEV int operator()(int n) const { return n < ns ? (n & ~31) + pg8::perm32(n & 31) : -1; } };
struct MapFfn { DEV int operator()(int v) const { const int pn = v >> 8, c = v & 255, cc = (c & 96) + pg8::perm32(c & 31); return c < 128 ? 128 * pn + cc : DFF + 128 * pn + cc; } };

DEV void phase_prep(const Params& P, int layer, char* smem) {
    char* ws = P.ws; int cur = 0;
    const int kind = layer % 3, j = layer / 3;
    prep_T((bf16_t*)(ws + OFF_WF1), P.in[I_FWIN] + (size_t)layer * DM * 2 * DFF, DM, 2 * DFF, 2 * DFF, DM, MapFfn{}, smem, cur);
    prep_T((bf16_t*)(ws + OFF_WF2), P.in[I_FWOUT] + (size_t)layer * DFF * DM, DFF, DM, DM, DFF, MapPerm{DM}, smem, cur);
    bf16_t* mix = (bf16_t*)(ws + OFF_MIX);
    if (kind == 0) {
        const float* wrkv = P.in[I_WRKV] + (size_t)j * 3 * DM * DM;
        prep_T(mix, wrkv, DM, DM, DM, DM, MapPerm{DM}, smem, cur);
        prep_T(mix + (size_t)1024 * DM, wrkv + (size_t)DM * DM, DM, DM, DM, DM, MapPerm{DM}, smem, cur);
        prep_T(mix + (size_t)2048 * DM, P.in[I_W1] + (size_t)j * DM * 64, DM, 64, 128, DM, MapId{64}, smem, cur);
        prep_T(mix + (size_t)2176 * DM, P.in[I_A1] + (size_t)j * DM * 64, DM, 64, 128, DM, MapId{64}, smem, cur);
        prep_T(mix + (size_t)2304 * DM, P.in[I_G1] + (size_t)j * DM * 128, DM, 128, 128, DM, MapId{128}, smem, cur);
        if (j > 0) prep_T(mix + (size_t)2432 * DM, P.in[I_V1] + (size_t)(j - 1) * DM * 32, DM, 32, 128, DM, MapId{32}, smem, cur);
        else       prep_T(mix + (size_t)2432 * DM, P.in[I_V1], DM, 32, 128, DM, MapId{0}, smem, cur);
        prep_T((bf16_t*)((char*)mix + 5 * MiB), wrkv + (size_t)2 * DM * DM, DM, DM, DM, DM, MapPerm{DM}, smem, cur);
        prep_T((bf16_t*)((char*)mix + 7 * MiB), P.in[I_W2] + (size_t)j * 64 * DM, 64, DM, DM, 64, MapId{DM}, smem, cur);
        prep_T((bf16_t*)((char*)mix + 7 * MiB + 131072), P.in[I_A2] + (size_t)j * 64 * DM, 64, DM, DM, 64, MapId{DM}, smem, cur);
        if (j > 0) prep_T((bf16_t*)((char*)mix + 7 * MiB + 262144), P.in[I_V2] + (size_t)(j - 1) * 32 * DM, 32, DM, DM, 64, MapId{DM}, smem, cur);
        prep_T((bf16_t*)((char*)mix + 7 * MiB + 393216), P.in[I_G2] + (size_t)j * 128 * DM, 128, DM, DM, 128, MapId{DM}, smem, cur);
        prep_T((bf16_t*)((char*)mix + 8 * MiB), P.in[I_RWO] + (size_t)j * DM * DM, DM, DM, DM, DM, MapPerm{DM}, smem, cur);
    } else if (kind == 1) {
        prep_T(mix, P.in[I_NWIN], DM, 1840, 2048, DM, MapId{1840}, smem, cur);
        prep_T((bf16_t*)((char*)mix + 4 * MiB), P.in[I_CW1], 2048, 256, 256, 2048, MapId{256}, smem, cur);
        prep_T((bf16_t*)((char*)mix + 4 * MiB) + (size_t)256 * 2048, P.in[I_CW1] + (size_t)2048 * 256, 2048, 256, 256, 2048, MapId{256}, smem, cur);
        prep_T((bf16_t*)((char*)mix + 6 * MiB), P.in[I_CW2], 256, 64, 128, 256, MapId{64}, smem, cur);
        prep_T((bf16_t*)((char*)mix + 6 * MiB) + (size_t)128 * 256, P.in[I_CW2] + (size_t)256 * 64, 256, 64, 128, 256, MapId{64}, smem, cur);
        prep_T((bf16_t*)((char*)mix + 7 * MiB), P.in[I_NWO], DM, DM, DM, DM, MapPerm{DM}, smem, cur);
        { const int lane = tidx() & 63, gw = blockIdx.x * (NTHR / 64) + (tidx() >> 6);
          if (gw < 512) { const int c = gw >> 8, col = gw & 255; const float* w1 = P.in[I_CW1] + (size_t)c * 2048 * 256; const float* pe = P.in[I_CPE] + (size_t)c * 2048;
              float sacc = 0.f; for (int k = lane; k < 2048; k += 64) sacc += pe[k] * w1[(size_t)k * 256 + col];
              sacc = wave_sum(sacc); if (lane == 0) ((float*)(ws + OFF_BIASP))[gw] = sacc + P.in[I_CB1][c * 256 + col]; } }
    } else {
        prep_T(mix, P.in[I_GWIN], DM, 3088, 3328, DM, MapId{3088}, smem, cur);
        prep_T((bf16_t*)((char*)mix + 7 * MiB), P.in[I_GWO], DM, DM, DM, DM, MapPerm{DM}, smem, cur);
    }
}

template <int HIN, int HOUT>
DEV void phase_norm(const void* h_in, const bf16_t* z, const float* g_post, void* h_out, float* stage, const float* g_pre, bf16_t* xn) {
    const int lane = tidx() & 63, gw = blockIdx.x * (NTHR / 64) + (tidx() >> 6), nw = gridDim.x * (NTHR / 64);
    for (int row0 = gw; row0 < T; row0 += 2 * nw) {
        f32x4 hv[2][4], zv[2][4];
#pragma unroll
        for (int u = 0; u < 2; ++u) { const int row = row0 + u * nw;
            if (row < T) {
#pragma unroll
                for (int i = 0; i < 4; ++i) { const size_t off = (size_t)row * DM + i * 256 + lane * 4;
                    if (HIN == 0) hv[u][i] = *(const f32x4*)((const float*)h_in + off); else hv[u][i] = ld_bf4((const bf16_t*)h_in + off);
                    if (z) zv[u][i] = ld_bf4(z + off); } } }
#pragma unroll
        for (int u = 0; u < 2; ++u) { const int row = row0 + u * nw;
            if (row < T) {
                if (z) {
                    float ss = 0.f;
#pragma unroll
                    for (int i = 0; i < 4; ++i) ss += zv[u][i][0] * zv[u][i][0] + zv[u][i][1] * zv[u][i][1] + zv[u][i][2] * zv[u][i][2] + zv[u][i][3] * zv[u][i][3];
                    ss = wave_sum(ss); const float rs = rsqrtf(ss * (1.0f / DM) + 1e-6f);
#pragma unroll
                    for (int i = 0; i < 4; ++i) { const f32x4 g = *(const f32x4*)(g_post + i * 256 + lane * 4); hv[u][i] += zv[u][i] * rs * g; }
                }
                if (HOUT == 1) {
#pragma unroll
                    for (int i = 0; i < 4; ++i) st_bf4((bf16_t*)h_out + (size_t)row * DM + i * 256 + lane * 4, hv[u][i]);
                }
                if (HOUT == 2) {
                    float* dst = row < T / 2 ? (float*)h_out + (size_t)row * DM : stage + (size_t)(row - T / 2) * DM;
#pragma unroll
                    for (int i = 0; i < 4; ++i) *(f32x4*)(dst + i * 256 + lane * 4) = hv[u][i];
                }
                if (xn) {
                    float ss = 0.f;
#pragma unroll
                    for (int i = 0; i < 4; ++i) ss += hv[u][i][0] * hv[u][i][0] + hv[u][i][1] * hv[u][i][1] + hv[u][i][2] * hv[u][i][2] + hv[u][i][3] * hv[u][i][3];
                    ss = wave_sum(ss); const float rs = rsqrtf(ss * (1.0f / DM) + 1e-6f);
#pragma unroll
                    for (int i = 0; i < 4; ++i) { const f32x4 g = *(const f32x4*)(g_pre + i * 256 + lane * 4); st_bf4(xn + (size_t)row * DM + i * 256 + lane * 4, hv[u][i] * rs * g); }
                }
            } }
    }
}
DEV void phase_copy_out(const float* stage, float* out) {
    const size_t gt = (size_t)blockIdx.x * NTHR + tidx(), nt = (size_t)gridDim.x * NTHR;
    for (size_t i = gt; i < (size_t)(T / 2) * DM / 4; i += nt) ((f32x4*)(out + (size_t)(T / 2) * DM))[i] = ((const f32x4*)stage)[i];
}

DEV void phase_gemm_plain(const bf16_t* A, int lda, const bf16_t* Bt, int K, int ntn, bf16_t* C, int ldc, char* smem) {
    const LaneId L = lane_id();
    const int nunits = (T / 256) * ntn;
    for (int u = blockIdx.x; u < nunits; u += gridDim.x) {
        const int tm = u / ntn, tn = u % ntn;
        f32x4 acc[4][4];
        gemm_core(acc, LdPlain{A + (size_t)tm * 256 * lda, lda}, LdPlain{Bt + (size_t)tn * 128 * K, K}, K, smem);
#pragma unroll
        for (int m = 0; m < 4; ++m)
#pragma unroll
            for (int n = 0; n < 4; ++n)
                st_bf4(C + (size_t)(tm * 256 + L.wm * 64 + m * 16 + L.fr) * ldc + tn * 128 + L.wn * 64 + n * 16 + L.fq * 4, acc[m][n]);
    }
}

DEV void phase_f1(const bf16_t* xn, const bf16_t* Bt, const float* cw, const float* cb, bf16_t* act, bf16_t* E, char* smem) {
    const LaneId L = lane_id();
    const int ntn = 2 * DFF / 128, nunits = (T / 256) * ntn;
    for (int u = blockIdx.x; u < nunits; u += gridDim.x) {
        const int tm = u / ntn, tn = u % ntn;
        f32x4 acc[4][4];
        gemm_core(acc, LdPlain{xn + (size_t)tm * 256 * DM, DM}, LdPlain{Bt + (size_t)tn * 128 * DM, DM}, DM, smem);
        const int strip = tm * 4 + L.wm; const size_t rowbase = (size_t)tm * 256 + L.wm * 64;
#pragma unroll
        for (int n = 0; n < 2; ++n) {
            const int ch = tn * 64 + L.wn * 32 + n * 16 + L.fq * 4;
            const f32x4 c0 = *(const f32x4*)(cw + ch), c1 = *(const f32x4*)(cw + DFF + ch), c2 = *(const f32x4*)(cw + 2 * DFF + ch), cbv = *(const f32x4*)(cb + ch);
#pragma unroll
            for (int m = 0; m < 4; ++m) {
                const f32x4 g0 = acc[m][n], up = acc[m][n + 2]; f32x4 g1, g2;
#pragma unroll
                for (int j = 0; j < 4; ++j) {
                    const float a1 = __shfl(g0[j], (L.lane - 1) & 63), a2 = __shfl(g0[j], (L.lane - 2) & 63);
                    float b1 = 0.f, b2 = 0.f;
                    if (m > 0) { b1 = __shfl(acc[m > 0 ? m - 1 : 0][n][j], (L.lane + 15) & 63); b2 = __shfl(acc[m > 0 ? m - 1 : 0][n][j], (L.lane + 14) & 63); }
                    g1[j] = L.fr >= 1 ? a1 : b1; g2[j] = L.fr >= 2 ? a2 : b2;
                }
                const int rs = m * 16 + L.fr;
                f32x4 val = c2 * g0 + c1 * g1 + c0 * g2 + cbv, a;
#pragma unroll
                for (int j = 0; j < 4; ++j) a[j] = val[j] * rcpf_(1.0f + __expf(-val[j])) * up[j];
                if (rs >= 2) st_bf4(act + (rowbase + rs) * DFF + ch, a);
                else { st_bf4(E + ((size_t)strip * 6 + 2 + rs) * DFF + ch, g0); st_bf4(E + ((size_t)strip * 6 + 4 + rs) * DFF + ch, up); }
                if (rs >= 62) st_bf4(E + ((size_t)strip * 6 + (rs - 62)) * DFF + ch, g0);
            }
        }
    }
}
DEV void phase_f1b(const float* cw, const float* cb, bf16_t* act, const bf16_t* E) {
    const int gt = blockIdx.x * NTHR + tidx(), nt = gridDim.x * NTHR;
    for (int idx = gt; idx < 512 * 2 * (DFF / 4); idx += nt) {
        const int ch = (idx % (DFF / 4)) * 4, r = (idx / (DFF / 4)) & 1, strip = idx / (2 * (DFF / 4));
        const bool first = (strip & 127) == 0;
        const f32x4 zero = {0.f, 0.f, 0.f, 0.f};
        const f32x4 g0 = ld_bf4(E + ((size_t)strip * 6 + 2 + r) * DFF + ch), up = ld_bf4(E + ((size_t)strip * 6 + 4 + r) * DFF + ch);
        f32x4 g1, g2;
        if (r == 1) { g1 = ld_bf4(E + ((size_t)strip * 6 + 2) * DFF + ch); g2 = first ? zero : ld_bf4(E + ((size_t)(strip - 1) * 6 + 1) * DFF + ch); }
        else { g1 = first ? zero : ld_bf4(E + ((size_t)(strip - 1) * 6 + 1) * DFF + ch); g2 = first ? zero : ld_bf4(E + ((size_t)(strip - 1) * 6 + 0) * DFF + ch); }
        const f32x4 c0 = *(const f32x4*)(cw + ch), c1 = *(const f32x4*)(cw + DFF + ch), c2 = *(const f32x4*)(cw + 2 * DFF + ch), cbv = *(const f32x4*)(cb + ch);
        f32x4 val = c2 * g0 + c1 * g1 + c0 * g2 + cbv, a;
#pragma unroll
        for (int j = 0; j < 4; ++j) a[j] = val[j] * rcpf_(1.0f + __expf(-val[j])) * up[j];
        st_bf4(act + ((size_t)strip * 64 + r) * DFF + ch, a);
    }
}

struct RwkvW { const float *mu, *w0, *a0, *k_k, *k_a, *r_k, *ln_w, *ln_b, *v0; bool vres; };
DEV void phase_rmix(const bf16_t* xn, const float* mu, bf16_t* xr, bf16_t* xk, bf16_t* xv) {
    const int gt = blockIdx.x * NTHR + tidx(), nt = gridDim.x * NTHR;
    for (int idx0 = gt; idx0 < T * 128; idx0 += 2 * nt) {
        u32x4 cur[2], prv[2];
#pragma unroll
        for (int u = 0; u < 2; ++u) { const int idx = idx0 + u * nt; cur[u] = (u32x4){0u, 0u, 0u, 0u}; prv[u] = cur[u];
            if (idx < T * 128) { const int row = idx >> 7, c8 = (idx & 127) * 8; const size_t off = (size_t)row * DM + c8;
                cur[u] = *(const u32x4*)(xn + off); if ((row & (SEQ - 1)) != 0) prv[u] = *(const u32x4*)(xn + off - DM); } }
#pragma unroll
        for (int u = 0; u < 2; ++u) { const int idx = idx0 + u * nt;
            if (idx < T * 128) { const int row = idx >> 7, c8 = (idx & 127) * 8; const size_t off = (size_t)row * DM + c8;
                f32x4 x0, x1, d0, d1;
                x0[0] = bf_lo(cur[u].x); x0[1] = bf_hi(cur[u].x); x0[2] = bf_lo(cur[u].y); x0[3] = bf_hi(cur[u].y); x1[0] = bf_lo(cur[u].z); x1[1] = bf_hi(cur[u].z); x1[2] = bf_lo(cur[u].w); x1[3] = bf_hi(cur[u].w);
                d0[0] = bf_lo(prv[u].x) - x0[0]; d0[1] = bf_hi(prv[u].x) - x0[1]; d0[2] = bf_lo(prv[u].y) - x0[2]; d0[3] = bf_hi(prv[u].y) - x0[3];
                d1[0] = bf_lo(prv[u].z) - x1[0]; d1[1] = bf_hi(prv[u].z) - x1[1]; d1[2] = bf_lo(prv[u].w) - x1[2]; d1[3] = bf_hi(prv[u].w) - x1[3];
#pragma unroll
                for (int c = 0; c < 3; ++c) { const float* mp = mu + (c == 0 ? 0 : c == 1 ? 2 : 3) * DM + c8; const f32x4 m0 = *(const f32x4*)mp, m1 = *(const f32x4*)(mp + 4);
                    const f32x4 y0 = x0 + d0 * m0, y1 = x1 + d1 * m1; u32x4 w; w.x = cvt_pk(y0[0], y0[1]); w.y = cvt_pk(y0[2], y0[3]); w.z = cvt_pk(y1[0], y1[1]); w.w = cvt_pk(y1[2], y1[3]);
                    *(u32x4*)((c == 0 ? xr : c == 1 ? xk : xv) + off) = w; } } }
    }
}
DEV void phase_r1(const bf16_t* xn, const bf16_t* Bt, const RwkvW& W, bf16_t* hid, char* smem) {
    const LaneId L = lane_id();
    const int ntn = 4, nunits = (T / 256) * ntn;
    for (int u = blockIdx.x; u < nunits; u += gridDim.x) {
        const int tm = u / ntn, tn = 16 + u % ntn;
        const int var = tn == 16 ? 1 : tn == 17 ? 4 : tn == 18 ? 5 : 3;
        f32x4 acc[4][4];
        gemm_core(acc, LdMix{xn, W.mu + var * DM, tm * 256, {0.f, 0.f, 0.f, 0.f}, {0.f, 0.f, 0.f, 0.f}}, LdPlain{Bt + (size_t)tn * 128 * DM, DM}, DM, smem);
#pragma unroll
        for (int m = 0; m < 4; ++m)
#pragma unroll
            for (int n = 0; n < 4; ++n) {
                const size_t row = (size_t)tm * 256 + L.wm * 64 + m * 16 + L.fr; const int c = L.wn * 64 + n * 16 + L.fq * 4; f32x4 v = acc[m][n];
                if (tn == 16) { if (L.wn == 0) { for (int j = 0; j < 4; ++j) v[j] = tanhf(v[j]); st_bf4(hid + row * HIDP + c, v); } }
                else if (tn == 17) { if (L.wn == 0) st_bf4(hid + row * HIDP + 64 + c, v); }
                else if (tn == 18) { for (int j = 0; j < 4; ++j) v[j] = sigmoidf_(v[j]); st_bf4(hid + row * HIDP + 128 + c, v); }
                else { if (L.wn == 0) st_bf4(hid + row * HIDP + 256 + c, v); }
            }
    }
}
DEV void phase_r2(const bf16_t* vraw, const bf16_t* mixw, const RwkvW& W, const bf16_t* hid, const bf16_t* rb, float* bsc, bf16_t* wb, bf16_t* kb, bf16_t* kkb, bf16_t* kab, bf16_t* vb, char* smem) {
    const LaneId L = lane_id();
    const bf16_t* W2T = (const bf16_t*)((const char*)mixw + 7 * MiB);
    const bf16_t* A2T = (const bf16_t*)((const char*)mixw + 7 * MiB + 131072);
    const bf16_t* V2T = (const bf16_t*)((const char*)mixw + 7 * MiB + 262144);
    const int nunits = 1024 + 2048;
    for (int u = blockIdx.x + (W.vres ? 0 : 1024); u < nunits; u += gridDim.x) {
        if (u < 1024) {
            const int tm = u >> 3, tn = u & 7;
            f32x4 acc[4][4]; u32x2 gpk[4][4];
            {
                gemm_core(acc, LdPlain{hid + (size_t)tm * 256 * HIDP + 256, HIDP}, LdPlain{V2T + (size_t)tn * 128 * 64, 64}, 64, smem);
#pragma unroll
                for (int m = 0; m < 4; ++m)
#pragma unroll
                    for (int n = 0; n < 4; ++n) { const int col = tn * 128 + L.wn * 64 + n * 16 + L.fq * 4; const f32x4 b = *(const f32x4*)(W.v0 + col);
                        gpk[m][n].x = cvt_pk(sigmoidf_(b[0] + acc[m][n][0]), sigmoidf_(b[1] + acc[m][n][1]));
                        gpk[m][n].y = cvt_pk(sigmoidf_(b[2] + acc[m][n][2]), sigmoidf_(b[3] + acc[m][n][3])); }
            }
#pragma unroll
            for (int m = 0; m < 4; ++m)
#pragma unroll
                for (int n = 0; n < 4; ++n) {
                    const size_t row = (size_t)tm * 256 + L.wm * 64 + m * 16 + L.fr; const int col = tn * 128 + L.wn * 64 + n * 16 + L.fq * 4; f32x4 v = ld_bf4(vraw + row * DM + col);
                    const f32x4 vf = ld_bf4(vb + row * DM + col); f32x4 gt; gt[0] = bf_lo(gpk[m][n].x); gt[1] = bf_hi(gpk[m][n].x); gt[2] = bf_lo(gpk[m][n].y); gt[3] = bf_hi(gpk[m][n].y); v = v + (vf - v) * gt;
                    st_bf4(vb + row * DM + col, v);
                }
        } else {
            const int u2 = u - 1024, tm = u2 >> 4, jj = u2 & 15;
            f32x4 acc[4][4];
            if (jj < 8) {
                const int tn = jj;
                gemm_core(acc, LdPlain{hid + (size_t)tm * 256 * HIDP, HIDP}, LdPlain{W2T + (size_t)tn * 128 * 64, 64}, 64, smem);
#pragma unroll
                for (int m = 0; m < 4; ++m)
#pragma unroll
                    for (int n = 0; n < 4; ++n) {
                        const size_t row = (size_t)tm * 256 + L.wm * 64 + m * 16 + L.fr; const int col = tn * 128 + L.wn * 64 + n * 16 + L.fq * 4; const f32x4 b = *(const f32x4*)(W.w0 + col); f32x4 v;
                        for (int j = 0; j < 4; ++j) { const float x = b[j] + acc[m][n][j]; const float y = -x;
                            const float sp = fmaxf(y, 0.f) + log1pf(__expf(-fabsf(y))); const float w = -sp - 0.5f; v[j] = __expf(-__expf(w)); }
                        st_bf4(wb + row * DM + col, v);
                    }
            } else {
                const int tn = jj - 8;
                gemm_core(acc, LdPlain{hid + (size_t)tm * 256 * HIDP + 64, HIDP}, LdPlain{A2T + (size_t)tn * 128 * 64, 64}, 64, smem);
#pragma unroll
                for (int m = 0; m < 4; ++m) {
                    const size_t row = (size_t)tm * 256 + L.wm * 64 + m * 16 + L.fr;
                    u32x2 kpk[4]; float ss = 0.f;
#pragma unroll
                    for (int n = 0; n < 4; ++n) { const int col = tn * 128 + L.wn * 64 + n * 16 + L.fq * 4;
                        kpk[n] = *(const u32x2*)(kb + row * DM + col); const f32x4 kkw = *(const f32x4*)(W.k_k + col);
                        const float c0 = bf_lo(kpk[n].x) * kkw[0], c1 = bf_hi(kpk[n].x) * kkw[1], c2 = bf_lo(kpk[n].y) * kkw[2], c3 = bf_hi(kpk[n].y) * kkw[3];
                        ss += (c0 * c0 + c1 * c1) + (c2 * c2 + c3 * c3); }
                    ss += __shfl_xor(ss, 16); ss += __shfl_xor(ss, 32);
                    const float inv = rcpf_(fmaxf(sqrtf(ss), 1e-12f));
                    asm volatile("" ::: "memory");
                    float bon = 0.f;
#pragma unroll
                    for (int n = 0; n < 4; ++n) { const int col = tn * 128 + L.wn * 64 + n * 16 + L.fq * 4;
                        const f32x4 ka = *(const f32x4*)(W.k_a + col), kkw = *(const f32x4*)(W.k_k + col), a0 = *(const f32x4*)(W.a0 + col), rkv = *(const f32x4*)(W.r_k + col), rv = ld_bf4(rb + row * DM + col);
                        f32x4 kv; kv[0] = bf_lo(kpk[n].x); kv[1] = bf_hi(kpk[n].x); kv[2] = bf_lo(kpk[n].y); kv[3] = bf_hi(kpk[n].y);
                        f32x4 kk, kp, kka;
                        for (int j = 0; j < 4; ++j) { const float a = sigmoidf_(a0[j] + acc[m][n][j]); kk[j] = kv[j] * kkw[j] * inv; kp[j] = kv[j] * (1.0f + (a - 1.0f) * ka[j]); kka[j] = kk[j] * a; }
                        const u32x2 kpp = {cvt_pk(kp[0], kp[1]), cvt_pk(kp[2], kp[3])};
                        bon += rv[0] * bf_lo(kpp.x) * rkv[0] + rv[1] * bf_hi(kpp.x) * rkv[1] + rv[2] * bf_lo(kpp.y) * rkv[2] + rv[3] * bf_hi(kpp.y) * rkv[3];
                        *(u32x2*)(kb + row * DM + col) = kpp; st_bf4(kkb + row * DM + col, kk); st_bf4(kab + row * DM + col, kka);
                        asm volatile("" ::: "memory"); }
                    bon += __shfl_xor(bon, 16); bon += __shfl_xor(bon, 32);
                    if (L.fq == 0) bsc[row * 16 + tn * 2 + L.wn] = bon;
                }
            }
        }
    }
}
typedef float f32x2 __attribute__((ext_vector_type(2)));
constexpr int R3_CH = 32, R3_STR = R3_CH * 256, R3_BUF = 5 * R3_STR + R3_CH * 64;
DEV void r3_stage_raw(const bf16_t* const (&str)[5], const bf16_t* vb, size_t base, int vrow0, int t0, char* buf, int id) {
    u32x4 d[5];
    const int t = id >> 3, j = id & 7;
#pragma unroll
    for (int st = 0; st < 5; ++st) d[st] = *(const u32x4*)(str[st] + base + (size_t)(t0 + t) * DM + j * 8);
    u32x4 vv = {0u, 0u, 0u, 0u};
    if (id < 64) vv = *(const u32x4*)(vb + base + (size_t)(t0 + (id >> 1)) * DM + vrow0 + (id & 1) * 8);
#pragma unroll
    for (int st = 0; st < 5; ++st) { f32x4 a, b; a[0] = bf_lo(d[st].x); a[1] = bf_hi(d[st].x); a[2] = bf_lo(d[st].y); a[3] = bf_hi(d[st].y); b[0] = bf_lo(d[st].z); b[1] = bf_hi(d[st].z); b[2] = bf_lo(d[st].w); b[3] = bf_hi(d[st].w);
        float* p = (float*)(buf + st * R3_STR + t * 256 + j * 32); *(f32x4*)p = a; *(f32x4*)(p + 4) = b; }
    if (id < 64) { f32x4 a, b; a[0] = bf_lo(vv.x); a[1] = bf_hi(vv.x); a[2] = bf_lo(vv.y); a[3] = bf_hi(vv.y); b[0] = bf_lo(vv.z); b[1] = bf_hi(vv.z); b[2] = bf_lo(vv.w); b[3] = bf_hi(vv.w);
        float* vp = (float*)(buf + 5 * R3_STR + (id >> 1) * 64 + (id & 1) * 32); *(f32x4*)vp = a; *(f32x4*)(vp + 4) = b; }
}
DEV void phase_r3(const bf16_t* rb, const bf16_t* wb, const bf16_t* kb, const bf16_t* kkb, const bf16_t* kab, const bf16_t* vb, bf16_t* yb, float* bsc, const float* r_k, char* smem) {
    const int tid = tidx(), lane = tid & 63, wid = tid >> 6;
    const bf16_t* const str[5] = {rb, wb, kb, kkb, kab};
    constexpr int NCH = SEQ / R3_CH;
    for (int task = blockIdx.x; task < 256; task += gridDim.x) {
        const int bh = task >> 2, b = bh >> 4, h = bh & 15, rq = task & 3;
        const size_t base = (size_t)b * SEQ * DM + h * 64;
        bf16_t* ystage = (bf16_t*)(smem + 149504 + 64);
    float* gcarea = (float*)(smem + 3 * R3_BUF);
        if (wid >= 4) r3_stage_raw(str, vb, base, rq * 16, 0, smem, tid - 256);
        __syncthreads();
        if (wid >= 4) { r3_stage_raw(str, vb, base, rq * 16, R3_CH, smem + R3_BUF, tid - 256);
            char* bq = smem; float* w = (float*)bq + R3_STR / 4 + lane; const int p = wid - 4;
            float G = 1.f; for (int t = 0; t < 8 * p; ++t) G *= w[t * 64];
            float* r = (float*)bq + lane; float* k = r + 2 * (R3_STR / 4); float* q = r + 3 * (R3_STR / 4); float* a = r + 4 * (R3_STR / 4);
#pragma unroll
            for (int u = 0; u < 8; ++u) { const int t = 8 * p + u; const float Gold = G; G *= w[t * 64]; const float inv = rcpf_(G); r[t * 64] *= G; q[t * 64] *= Gold; k[t * 64] *= inv; a[t * 64] *= inv; }
            if (p == 3) gcarea[lane] = G; }
        __syncthreads();
        const int rr = lane >> 4, cg = lane & 15, rg = rq * 4 + wid;
        const size_t voff = base + rg * 4 + rr;
        f32x2 s01 = {0.f, 0.f}, s23 = {0.f, 0.f};
        for (int c = 0; c < NCH; ++c) {
            if (wid >= 4) {
                if (c >= 1 && tid - 256 < 64) { const int id = tid - 256;
                    *(u32x4*)(yb + base + (size_t)((c - 1) * R3_CH + (id >> 1)) * DM + rq * 16 + (id & 1) * 8) = *(const u32x4*)(ystage + ((c - 1) & 1) * 512 + (id >> 1) * 16 + (id & 1) * 8); }
                if (c + 2 < NCH) r3_stage_raw(str, vb, base, rq * 16, (c + 2) * R3_CH, smem + ((c + 2) % 3) * R3_BUF, tid - 256);
                if (c + 1 < NCH) { char* bq = smem + ((c + 1) % 3) * R3_BUF; float* w = (float*)bq + R3_STR / 4 + lane; const int p = wid - 4;
                    float G = 1.f; for (int t = 0; t < 8 * p; ++t) G *= w[t * 64];
                    float* r = (float*)bq + lane; float* k = r + 2 * (R3_STR / 4); float* q = r + 3 * (R3_STR / 4); float* a = r + 4 * (R3_STR / 4);
#pragma unroll
                    for (int u = 0; u < 8; ++u) { const int t = 8 * p + u; const float Gold = G; G *= w[t * 64]; const float inv = rcpf_(G); r[t * 64] *= G; q[t * 64] *= Gold; k[t * 64] *= inv; a[t * 64] *= inv; }
                    if (p == 3) gcarea[((c + 1) % 3) * 64 + lane] = G; }
            } else {
                const char* buf = smem + (c % 3) * R3_BUF;
                f32x4 R_[2][2], K_[2][2], Q_[2][2], A_[2][2]; float V_[2][2];
#define R3_LD(bf, t0) { _Pragma("unroll") for (int u = 0; u < 2; ++u) { const char* p = buf + ((t0) + u) * 256 + cg * 16; \
                    R_[bf][u] = *(const f32x4*)p; K_[bf][u] = *(const f32x4*)(p + 2 * R3_STR); Q_[bf][u] = *(const f32x4*)(p + 3 * R3_STR); A_[bf][u] = *(const f32x4*)(p + 4 * R3_STR); \
                    V_[bf][u] = *(const float*)(buf + 5 * R3_STR + ((t0) + u) * 64 + (wid * 4 + rr) * 4); } }
#define R3_CP(bf, sl) { _Pragma("unroll") for (int u = 0; u < 2; ++u) { \
                    const f32x4 R = R_[bf][u], K = K_[bf][u], Q = Q_[bf][u], A = A_[bf][u]; const float vv = V_[bf][u]; \
                    const f32x2 r01 = {R[0], R[1]}, r23 = {R[2], R[3]}, k01 = {K[0], K[1]}, k23 = {K[2], K[3]}; \
                    const f32x2 q01 = {Q[0], Q[1]}, q23 = {Q[2], Q[3]}, a01 = {A[0], A[1]}, a23 = {A[2], A[3]}; \
                    const f32x2 pq = s01 * q01 + s23 * q23; \
                    const float sa = -row16_sum(pq.x + pq.y); \
                    const f32x2 sa2 = {sa, sa}, vv2 = {vv, vv}; \
                    s01 = (s01 + vv2 * k01) + sa2 * a01; s23 = (s23 + vv2 * k23) + sa2 * a23; \
                    const f32x2 py = s01 * r01 + s23 * r23; \
                    const float y = row16_sum(py.x + py.y); \
                    yv = (cg == (sl) + u) ? y : yv; } }
                R3_LD(0, 0)
#pragma unroll 1
                for (int t8 = 0; t8 < R3_CH; t8 += 8) {
                    float yv = 0.f;
                    R3_LD(1, t8 + 2)
                    R3_CP(0, 0)
                    R3_LD(0, t8 + 4)
                    R3_CP(1, 2)
                    R3_LD(1, t8 + 6)
                    R3_CP(0, 4)
                    if (t8 + 8 < R3_CH) R3_LD(0, t8 + 8)
                    R3_CP(1, 6)
                    if (cg < 8) ystage[(c & 1) * 512 + (t8 + cg) * 16 + wid * 4 + rr] = f2bf(yv);
                }
#undef R3_LD
#undef R3_CP
                const f32x4 GC = *(const f32x4*)(gcarea + (c % 3) * 64 + cg * 4);
                s01 *= (f32x2){GC[0], GC[1]}; s23 *= (f32x2){GC[2], GC[3]};
            }
            __syncthreads();
        }
        if (wid >= 4 && tid - 256 < 64) { const int id = tid - 256;
            *(u32x4*)(yb + base + (size_t)((NCH - 1) * R3_CH + (id >> 1)) * DM + rq * 16 + (id & 1) * 8) = *(const u32x4*)(ystage + ((NCH - 1) & 1) * 512 + (id >> 1) * 16 + (id & 1) * 8); }
        __syncthreads();
    }
}
constexpr int RC_NP = 8, RC_SLOT = 18688, RC_LDS = 18688;
constexpr int RC_QT = 0, RC_RR = 4096, RC_BG = 8192, RC_AB = 12288, RC_D0 = 14336, RC_U0 = 16384, RC_Y0 = 17408, RC_G = 18432;
#define R3C_FENCE() asm volatile("" ::: "memory")
constexpr int RC_P = 144;
DEV bf16x8 r3c_permfrag(const char* rowp, int q) {
    const u32x2 lo = *(const u32x2*)(rowp + 8 * q), hi = *(const u32x2*)(rowp + 32 + 8 * q);
    u32x4 w; w.x = lo.x; w.y = lo.y; w.z = hi.x; w.w = hi.y; return __builtin_bit_cast(bf16x8, w);
}
DEV bf16x8 r3c_neg(bf16x8 a) { u32x4 w = __builtin_bit_cast(u32x4, a); w.x ^= 0x80008000u; w.y ^= 0x80008000u; w.z ^= 0x80008000u; w.w ^= 0x80008000u; return __builtin_bit_cast(bf16x8, w); }
DEV u32x4 r3c_scale8(u32x4 d, f32x4 a, f32x4 b) {
    u32x4 o; o.x = cvt_pk(bf_lo(d.x) * a[0], bf_hi(d.x) * a[1]); o.y = cvt_pk(bf_lo(d.y) * a[2], bf_hi(d.y) * a[3]);
    o.z = cvt_pk(bf_lo(d.z) * b[0], bf_hi(d.z) * b[1]); o.w = cvt_pk(bf_lo(d.w) * b[2], bf_hi(d.w) * b[3]); return o;
}
DEV u32x2 r3c_pk4(f32x4 v) { u32x2 w; w.x = cvt_pk(v[0], v[1]); w.y = cvt_pk(v[2], v[3]); return w; }
DEV f32x4 r3c_up4(u32x2 w) { f32x4 v; v[0] = bf_lo(w.x); v[1] = bf_hi(w.x); v[2] = bf_lo(w.y); v[3] = bf_hi(w.y); return v; }
#define R3C_SCORE(dst, A, B, ROWLESS, STRICT) { _Pragma("unroll") for (int a = 0; a < 2; ++a) { _Pragma("unroll") for (int b = 0; b < 2; ++b) { \
        f32x4 a_ = MFMA(A[a][0], B[b][0], z4); a_ = MFMA(A[a][1], B[b][1], a_); \
        _Pragma("unroll") for (int r = 0; r < 4; ++r) { const int row_ = 16 * a + 4 * q + r, col_ = 16 * b + m; const int lo_ = (ROWLESS) ? row_ : col_, hi_ = (ROWLESS) ? col_ : row_; \
            const bool keep_ = (STRICT) ? (lo_ < hi_) : (lo_ <= hi_); a_[r] = keep_ ? a_[r] : 0.f; } \
        dst[a][b] = a_; } } }
template <bool PERM> DEV bf16x8 r3c_ident(int x, int m, int q) {
    u32x4 w = {0u, 0u, 0u, 0u};
#pragma unroll
    for (int jj = 0; jj < 8; ++jj) { const unsigned one = 0x3F80u << ((jj & 1) * 16); const int k = PERM ? ((jj < 4) ? 4 * q + jj : 16 + 4 * q + jj - 4) : 8 * q + jj; const unsigned v = (k == 16 * x + m) ? one : 0u;
        if ((jj >> 1) == 0) w.x |= v; else if ((jj >> 1) == 1) w.y |= v; else if ((jj >> 1) == 2) w.z |= v; else w.w |= v; }
    return __builtin_bit_cast(bf16x8, w);
}
struct R3Raw { u32x4 dr[4], dw[4], dk[4], dq[4], da[4]; bf16x8 vfrag; };
DEV void r3c_load(R3Raw& W, const bf16_t* rb, const bf16_t* wb, const bf16_t* kkb, const bf16_t* vb, int vrow0, int lane) {
    const int m = lane & 15, q = lane >> 4, tr = lane >> 3, j = lane & 7;
#pragma unroll
    for (int s = 0; s < 4; ++s) { const unsigned o = (unsigned)(((8 * s + tr) * DM + j * 8) * 2);
        W.dw[s] = *(const u32x4*)((const char*)wb + o); W.dr[s] = *(const u32x4*)((const char*)rb + o); W.dq[s] = *(const u32x4*)((const char*)kkb + o); }
    unsigned e[8];
#pragma unroll
    for (int jj = 0; jj < 8; ++jj) { const int t = (jj < 4) ? 4 * q + jj : 16 + 4 * q + jj - 4; e[jj] = *(const bf16_t*)((const char*)vb + (unsigned)((t * DM + vrow0 + m) * 2)); }
    u32x4 w; w.x = e[0] | (e[1] << 16); w.y = e[2] | (e[3] << 16); w.z = e[4] | (e[5] << 16); w.w = e[6] | (e[7] << 16); W.vfrag = __builtin_bit_cast(bf16x8, w);
}
DEV void r3c_load2(R3Raw& W, const bf16_t* kb, const bf16_t* kab, int lane) {
    const int tr = lane >> 3, j = lane & 7;
#pragma unroll
    for (int s = 0; s < 4; ++s) { const unsigned o = (unsigned)(((8 * s + tr) * DM + j * 8) * 2); W.dk[s] = *(const u32x4*)((const char*)kb + o); W.da[s] = *(const u32x4*)((const char*)kab + o); }
}
DEV void r3c_produce(R3Raw& W, const bf16_t* kb, const bf16_t* kab, char* lds, int lane) {
    const int m = lane & 15, q = lane >> 4, tr = lane >> 3, j = lane & 7;
    r3c_load2(W, kb, kab, lane);
    const f32x4 z4 = {0.f, 0.f, 0.f, 0.f};
    char* Rh = lds; char* Qh = lds + 32 * RC_P; char* Kh = lds + 64 * RC_P; char* Bh = lds + 96 * RC_P; float* G31a = (float*)(lds + 128 * RC_P);
    float* Gb = (float*)Kh;
    const bf16x8 vfrag = W.vfrag;
#pragma unroll
    for (int s = 0; s < 4; ++s) { float* gp = Gb + (8 * s + tr) * 64 + 8 * j; f32x4 a, b; const u32x4 d = W.dw[s];
        a[0] = bf_lo(d.x); a[1] = bf_hi(d.x); a[2] = bf_lo(d.y); a[3] = bf_hi(d.y); b[0] = bf_lo(d.z); b[1] = bf_hi(d.z); b[2] = bf_lo(d.w); b[3] = bf_hi(d.w);
        *(f32x4*)gp = a; *(f32x4*)(gp + 4) = b; }
    R3C_FENCE();
    { float g[32];
#pragma unroll
      for (int t = 0; t < 32; ++t) g[t] = Gb[t * 64 + lane];
      float G = 1.f;
#pragma unroll
      for (int t = 0; t < 32; ++t) { G *= g[t]; Gb[t * 64 + lane] = G; }
      G31a[lane] = G; }
    R3C_FENCE();
    { u32x4 kh[4], bh[4];
#pragma unroll
      for (int s = 0; s < 4; ++s) { const int t = 8 * s + tr, tp = t > 0 ? t - 1 : 0;
          const f32x4 g0 = *(const f32x4*)(Gb + t * 64 + 8 * j), g1 = *(const f32x4*)(Gb + t * 64 + 8 * j + 4);
          f32x4 p0 = *(const f32x4*)(Gb + tp * 64 + 8 * j), p1 = *(const f32x4*)(Gb + tp * 64 + 8 * j + 4);
          if (t == 0) { p0 = (f32x4){1.f, 1.f, 1.f, 1.f}; p1 = p0; }
          f32x4 i0, i1;
#pragma unroll
          for (int e = 0; e < 4; ++e) { i0[e] = rcpf_(g0[e]); i1[e] = rcpf_(g1[e]); }
          *(u32x4*)(Rh + t * RC_P + j * 16) = r3c_scale8(W.dr[s], g0, g1);
          *(u32x4*)(Qh + t * RC_P + j * 16) = r3c_scale8(W.dq[s], p0, p1);
          kh[s] = r3c_scale8(W.dk[s], i0, i1); bh[s] = r3c_scale8(W.da[s], i0, i1); }
      R3C_FENCE();
#pragma unroll
      for (int s = 0; s < 4; ++s) { const int t = 8 * s + tr; *(u32x4*)(Kh + t * RC_P + j * 16) = kh[s]; *(u32x4*)(Bh + t * RC_P + j * 16) = bh[s]; } }
    R3C_FENCE();
    bf16x8 Qa[2][2], Ra[2][2], Kb[2][2], Bb[2][2];
#pragma unroll
    for (int x = 0; x < 2; ++x)
#pragma unroll
        for (int ks = 0; ks < 2; ++ks) { const int off = (16 * x + m) * RC_P + (32 * ks + 8 * q) * 2;
            Qa[x][ks] = *(const bf16x8*)(Qh + off); Ra[x][ks] = *(const bf16x8*)(Rh + off); Kb[x][ks] = *(const bf16x8*)(Kh + off); Bb[x][ks] = *(const bf16x8*)(Bh + off); }
    f32x4 Tt[2][2], PN[2][2], PT[2][2], Z[2][5];
    R3C_SCORE(Tt, Kb, Qa, true, true)
    Z[0][4] = MFMA(pack8(Tt[0][0], Tt[1][0]), vfrag, z4); Z[1][4] = MFMA(pack8(Tt[0][1], Tt[1][1]), vfrag, z4);
    R3C_SCORE(Tt, Kb, Ra, true, false)
    u32x2 oY0[2]; oY0[0] = r3c_pk4(MFMA(pack8(Tt[0][0], Tt[1][0]), vfrag, z4)); oY0[1] = r3c_pk4(MFMA(pack8(Tt[0][1], Tt[1][1]), vfrag, z4));
    R3C_SCORE(Tt, Bb, Ra, true, false)
    bf16x8 oAB[2]; oAB[0] = r3c_neg(pack8(Tt[0][0], Tt[1][0])); oAB[1] = r3c_neg(pack8(Tt[0][1], Tt[1][1]));
    R3C_SCORE(PN, Qa, Bb, false, true)
    R3C_SCORE(PT, Bb, Qa, true, true)
#pragma unroll
    for (int mt = 0; mt < 2; ++mt)
#pragma unroll
        for (int n = 0; n < 4; ++n) Z[mt][n] = MFMA(Qa[mt][n >> 1], r3c_ident<false>(n & 1, m, q), z4);
#pragma unroll
    for (int lev = 0; lev < 5; ++lev) {
        bf16x8 fa[2], fb[2], zb[5];
#pragma unroll
        for (int x = 0; x < 2; ++x) { fa[x] = pack8(PT[0][x], PT[1][x]); fb[x] = pack8(PN[0][x], PN[1][x]); }
#pragma unroll
        for (int n = 0; n < 5; ++n) zb[n] = pack8(Z[0][n], Z[1][n]);
        const bf16x8 a0 = lev == 0 ? r3c_neg(fa[0]) : fa[0], a1 = lev == 0 ? r3c_neg(fa[1]) : fa[1];
#pragma unroll
        for (int n = 0; n < 5; ++n) { Z[0][n] = MFMA(a0, zb[n], Z[0][n]); Z[1][n] = MFMA(a1, zb[n], Z[1][n]); }
        if (lev < 4) {
#pragma unroll
            for (int a = 0; a < 2; ++a)
#pragma unroll
                for (int b = 0; b < 2; ++b) { PN[a][b] = MFMA(fa[a], fb[b], z4); PT[a][b] = MFMA(fb[a], fa[b], z4); }
        }
    }
    bf16x8 oQT[4], oRR[4], oBG[4]; u32x2 oD0[4];
    { f32x4 ZT[4][2];
      const bf16x8 Ip0 = r3c_ident<true>(0, m, q), Ip1 = r3c_ident<true>(1, m, q);
#pragma unroll
      for (int a = 0; a < 4; ++a) { const bf16x8 zf = pack8(Z[0][a], Z[1][a]); ZT[a][0] = MFMA(zf, Ip0, z4); ZT[a][1] = MFMA(zf, Ip1, z4); }
#pragma unroll
      for (int mt = 0; mt < 2; ++mt)
#pragma unroll
          for (int ks = 0; ks < 2; ++ks) oQT[mt * 2 + ks] = pack8(ZT[2 * ks][mt], ZT[2 * ks + 1][mt]); }
#pragma unroll
    for (int mt = 0; mt < 2; ++mt)
#pragma unroll
        for (int ks = 0; ks < 2; ++ks) oRR[mt * 2 + ks] = r3c_permfrag(Rh + (16 * mt + m) * RC_P + ks * 64, q);
    { bf16x8 Kf[2][2], Bf[2][2], Inat[2]; Inat[0] = r3c_ident<false>(0, m, q); Inat[1] = r3c_ident<false>(1, m, q);
#pragma unroll
      for (int x = 0; x < 2; ++x)
#pragma unroll
          for (int ks = 0; ks < 2; ++ks) { const int off = (16 * x + m) * RC_P + (32 * ks + 8 * q) * 2; Kf[x][ks] = *(const bf16x8*)(Kh + off); Bf[x][ks] = *(const bf16x8*)(Bh + off); }
#pragma unroll
      for (int ct = 0; ct < 4; ++ct) { const float g = G31a[16 * ct + m];
          const f32x4 k0 = MFMA(Kf[0][ct >> 1], Inat[ct & 1], z4) * g, k1 = MFMA(Kf[1][ct >> 1], Inat[ct & 1], z4) * g;
          const f32x4 b0 = MFMA(Bf[0][ct >> 1], Inat[ct & 1], z4) * -g, b1 = MFMA(Bf[1][ct >> 1], Inat[ct & 1], z4) * -g;
          oBG[ct] = pack8(b0, b1);
          oD0[ct] = r3c_pk4(MFMA(pack8(k0, k1), vfrag, z4)); } }
    asm volatile("s_waitcnt lgkmcnt(0)" ::: "memory");
#pragma unroll
    for (int f = 0; f < 4; ++f) { *(bf16x8*)(lds + RC_QT + f * 1024 + lane * 16) = oQT[f]; *(bf16x8*)(lds + RC_RR + f * 1024 + lane * 16) = oRR[f]; *(bf16x8*)(lds + RC_BG + f * 1024 + lane * 16) = oBG[f];
        *(u32x2*)(lds + RC_D0 + f * 512 + lane * 8) = oD0[f]; }
#pragma unroll
    for (int f = 0; f < 2; ++f) { *(bf16x8*)(lds + RC_AB + f * 1024 + lane * 16) = oAB[f]; *(u32x2*)(lds + RC_U0 + f * 512 + lane * 8) = r3c_pk4(Z[f][4]); *(u32x2*)(lds + RC_Y0 + f * 512 + lane * 8) = oY0[f]; }
    R3C_FENCE();
}
DEV void r3c_walk(f32x4 (&S)[4], char* slot, int lane) {
    const int q = lane >> 4;
    bf16x8 QT[2][2], BG[4]; u32x2 D0[4], U0[2]; f32x4 Gv[4];
#pragma unroll
    for (int f = 0; f < 4; ++f) { QT[f >> 1][f & 1] = *(const bf16x8*)(slot + RC_QT + f * 1024 + lane * 16); BG[f] = *(const bf16x8*)(slot + RC_BG + f * 1024 + lane * 16);
        D0[f] = *(const u32x2*)(slot + RC_D0 + f * 512 + lane * 8); Gv[f] = *(const f32x4*)(slot + RC_G + (16 * f + 4 * q) * 4); }
#pragma unroll
    for (int f = 0; f < 2; ++f) U0[f] = *(const u32x2*)(slot + RC_U0 + f * 512 + lane * 8);
    const bf16x8 sB0 = pack8(S[0], S[1]), sB1 = pack8(S[2], S[3]);
    f32x4 U[2];
#pragma unroll
    for (int mt = 0; mt < 2; ++mt) { U[mt] = r3c_up4(U0[mt]); U[mt] = MFMA(QT[mt][0], sB0, U[mt]); U[mt] = MFMA(QT[mt][1], sB1, U[mt]); }
    const bf16x8 uB = pack8(U[0], U[1]);
#pragma unroll
    for (int ct = 0; ct < 4; ++ct) { S[ct] = S[ct] * Gv[ct] + r3c_up4(D0[ct]); S[ct] = MFMA(BG[ct], uB, S[ct]); }
    R3C_FENCE();
    *(bf16x8*)(slot + RC_QT + lane * 16) = sB0; *(bf16x8*)(slot + RC_QT + 1024 + lane * 16) = sB1; *(bf16x8*)(slot + RC_QT + 2048 + lane * 16) = uB;
    R3C_FENCE();
}
DEV void r3c_yout(const char* slot, bf16_t* yout, int lane) {
    const int m = lane & 15, q = lane >> 4;
    const bf16x8 sB0 = *(const bf16x8*)(slot + RC_QT + lane * 16), sB1 = *(const bf16x8*)(slot + RC_QT + 1024 + lane * 16), uB = *(const bf16x8*)(slot + RC_QT + 2048 + lane * 16);
#pragma unroll
    for (int mt = 0; mt < 2; ++mt) {
        f32x4 Y = r3c_up4(*(const u32x2*)(slot + RC_Y0 + mt * 512 + lane * 8));
        Y = MFMA(*(const bf16x8*)(slot + RC_RR + (mt * 2) * 1024 + lane * 16), sB0, Y); Y = MFMA(*(const bf16x8*)(slot + RC_RR + (mt * 2 + 1) * 1024 + lane * 16), sB1, Y);
        Y = MFMA(*(const bf16x8*)(slot + RC_AB + mt * 1024 + lane * 16), uB, Y);
#pragma unroll
        for (int r = 0; r < 4; ++r) *(bf16_t*)((char*)yout + (unsigned)(((16 * mt + 4 * q + r) * DM + m) * 2)) = f2bf(Y[r]); }
    R3C_FENCE();
}
DEV void phase_r3c(const bf16_t* rb, const bf16_t* wb, const bf16_t* kb, const bf16_t* kkb, const bf16_t* kab, const bf16_t* vb, bf16_t* yb, char* smem) {
    const int tid = tidx(), lane = tid & 63, wid = __builtin_amdgcn_readfirstlane(tid >> 6);
    constexpr int NCH = SEQ / 32, NR = NCH / RC_NP;
    for (int task = blockIdx.x; task < 256; task += gridDim.x) {
        const int xc = task & 7, ix = task >> 3, bh = xc * 8 + (ix >> 2), b = bh >> 4, h = bh & 15, rq = ix & 3;
        const size_t base = (size_t)b * SEQ * DM + h * 64;
        f32x4 S[4];
#pragma unroll
        for (int ct = 0; ct < 4; ++ct) S[ct] = (f32x4){0.f, 0.f, 0.f, 0.f};
        R3Raw W; { const size_t ub = base + (size_t)(wid * 32) * DM; r3c_load(W, rb + ub, wb + ub, kkb + ub, vb + ub, rq * 16, lane); }
        for (int rd = 0; rd < NR; ++rd) {
            const size_t ub = base + (size_t)((rd * RC_NP + wid) * 32) * DM;
            r3c_produce(W, kb + ub, kab + ub, smem + wid * RC_LDS, tidx() & 63);
            if (rd + 1 < NR) { const size_t un = ub + (size_t)(RC_NP * 32) * DM; r3c_load(W, rb + un, wb + un, kkb + un, vb + un, rq * 16, tidx() & 63); }
            asm volatile("s_waitcnt lgkmcnt(0)" ::: "memory");
            __syncthreads();
            if (wid == 0) {
#pragma unroll 1
                for (int p = 0; p < RC_NP; ++p) r3c_walk(S, smem + p * RC_LDS, tidx() & 63);
                asm volatile("s_waitcnt lgkmcnt(0)" ::: "memory");
            }
            __syncthreads();
            r3c_yout(smem + wid * RC_LDS, yb + ub + rq * 16, tidx() & 63);
        }
    }
}
DEV void phase_r4(const bf16_t* hid, const bf16_t* G2T, const RwkvW& W, const bf16_t* yb, const bf16_t* vb, const float* bsc, bf16_t* outb, char* smem) {
    const LaneId L = lane_id();
    const int ntn = 8, nunits = (T / 256) * ntn;
    for (int u = blockIdx.x; u < nunits; u += gridDim.x) {
        const int tm = u / ntn, tn = u % ntn;
        f32x4 acc[4][4];
        gemm_core(acc, LdPlain{hid + (size_t)tm * 256 * HIDP + 128, HIDP}, LdPlain{G2T + (size_t)tn * 128 * 128, 128}, 128, smem);
        const int head = tn * 2 + L.wn;
#pragma unroll
        for (int m = 0; m < 4; ++m) {
            const size_t row = (size_t)tm * 256 + L.wm * 64 + m * 16 + L.fr;
            f32x4 yv[4]; float s = 0.f;
#pragma unroll
            for (int n = 0; n < 4; ++n) { yv[n] = ld_bf4(yb + row * DM + head * 64 + n * 16 + L.fq * 4); s += (yv[n][0] + yv[n][1]) + (yv[n][2] + yv[n][3]); }
            s += __shfl_xor(s, 16); s += __shfl_xor(s, 32);
            const float mean = s * (1.0f / 64.0f); float q = 0.f;
#pragma unroll
            for (int n = 0; n < 4; ++n) { const f32x4 d = yv[n] - mean; q += (d[0] * d[0] + d[1] * d[1]) + (d[2] * d[2] + d[3] * d[3]); }
            q += __shfl_xor(q, 16); q += __shfl_xor(q, 32);
            const float rstd = rsqrtf(q * (1.0f / 64.0f) + 64e-5f);
            const float bs = bsc[row * 16 + head];
#pragma unroll
            for (int n = 0; n < 4; ++n) { const int col = head * 64 + n * 16 + L.fq * 4;
                const f32x4 lw = *(const f32x4*)(W.ln_w + col), lb = *(const f32x4*)(W.ln_b + col), vv = ld_bf4(vb + row * DM + col);
                f32x4 o = ((yv[n] - mean) * rstd * lw + lb + vv * bs);
                o = o * acc[m][n];
                st_bf4(outb + row * DM + col, o); }
        }
    }
}

struct NsaBuf { bf16_t *q, *kcmp, *vcmp, *kslc, *kwin, *vslcT, *vwinT, *hid, *kc, *vcT, *o; float* gates; };
DEV void phase_n1(const bf16_t* xn, const bf16_t* Bt, const NsaBuf& B, char* smem) {
    const LaneId L = lane_id();
    const int ntn = 15, nunits = (T / 256) * ntn;
    for (int u = blockIdx.x; u < nunits; u += gridDim.x) {
        const int tm = u / ntn, tn = u % ntn;
        f32x4 acc[4][4];
        gemm_core(acc, LdPlain{xn + (size_t)tm * 256 * DM, DM}, LdPlain{Bt + (size_t)tn * 128 * DM, DM}, DM, smem);
#pragma unroll
        for (int m = 0; m < 4; ++m)
#pragma unroll
            for (int n = 0; n < 4; ++n) {
                const size_t row = (size_t)tm * 256 + L.wm * 64 + m * 16 + L.fr; const int c = L.wn * 64 + n * 16 + L.fq * 4; f32x4 v = acc[m][n];
                if (tn < 8) st_bf4(B.q + row * DM + tn * 128 + c, v * 0.125f);
                else if (tn < 14) {
                    const int cc = tn - 8;
                    if (cc == 0) st_bf4(B.kcmp + row * 128 + c, v);
                    else if (cc == 1) st_bf4(B.vcmp + row * 128 + c, v);
                    else if (cc == 2) st_bf4(B.kslc + row * 128 + c, v);
                    else if (cc == 4) st_bf4(B.kwin + row * 128 + c, v);
                    else { bf16_t* dst = cc == 3 ? B.vslcT : B.vwinT; const int b = (int)(row >> 13), t = (int)(row & (SEQ - 1));
                        for (int j = 0; j < 4; ++j) dst[((size_t)(b * 128 + c + j)) * SEQ + t] = f2bf(v[j]); }
                } else { if (c < 48) { for (int j = 0; j < 4; ++j) B.gates[row * 48 + c + j] = sigmoidf_(v[j]); } }
            }
    }
}
DEV float gelu_tanh(float x) { const float u = 0.7978845608028654f * (x + 0.044715f * x * x * x); return 0.5f * x * (1.0f + tanhf(u)); }
DEV void phase_n2a(const bf16_t* W1T, const float* biasp, const NsaBuf& B, char* smem) {
    const LaneId L = lane_id();
    for (int u = blockIdx.x; u < 64; u += gridDim.x) {
        const int c = u >> 5, tm = (u >> 1) & 15, tn = u & 1;
        f32x4 acc[4][4];
        gemm_core(acc, LdCmp{c ? B.vcmp : B.kcmp, tm * 256}, LdPlain{W1T + (size_t)c * 256 * 2048 + (size_t)tn * 128 * 2048, 2048}, 2048, smem);
#pragma unroll
        for (int m = 0; m < 4; ++m)
#pragma unroll
            for (int n = 0; n < 4; ++n) { const size_t row = (size_t)tm * 256 + L.wm * 64 + m * 16 + L.fr; const int col = tn * 128 + L.wn * 64 + n * 16 + L.fq * 4;
                const f32x4 bb = *(const f32x4*)(biasp + c * 256 + col); f32x4 v;
                for (int j = 0; j < 4; ++j) v[j] = gelu_tanh(acc[m][n][j] + bb[j]);
                st_bf4(B.hid + ((size_t)c * 4096 + row) * 256 + col, v); }
    }
}
DEV void phase_n2b(const bf16_t* W2T, const NsaBuf& B, char* smem) {
    const LaneId L = lane_id();
    for (int u = blockIdx.x; u < 32; u += gridDim.x) {
        const int c = u >> 4, tm = u & 15;
        f32x4 acc[4][4];
        gemm_core(acc, LdPlain{B.hid + ((size_t)c * 4096 + tm * 256) * 256, 256}, LdPlain{W2T + (size_t)c * 128 * 256, 256}, 256, smem);
        if (L.wn == 0) {
#pragma unroll
            for (int m = 0; m < 4; ++m)
#pragma unroll
                for (int n = 0; n < 4; ++n) { const int row = tm * 256 + L.wm * 64 + m * 16 + L.fr, d = n * 16 + L.fq * 4;
                    const int b = row >> 10, nn = (row >> 1) & 511, g = row & 1;
                    if (c == 0) st_bf4(B.kc + ((size_t)((b * 2 + g) * 512 + nn)) * 64 + d, acc[m][n]);
                    else { for (int j = 0; j < 4; ++j) B.vcT[((size_t)((b * 2 + g) * 64 + d + j)) * 512 + nn] = f2bf(acc[m][n][j]); } }
        }
    }
}
#define NEGV (-1e30f)
#define LOG2E_ 1.4426950408889634f
DEV u32x4 n3_ldg(const bf16_t* kbase, long kpitch, const bf16_t* vbase, long vpitch, int kb, int tid) {
    if (tid < 256) return *(const u32x4*)(kbase + (size_t)(kb + (tid >> 3)) * kpitch + (tid & 7) * 8);
    const int i = tid - 256; return *(const u32x4*)(vbase + (size_t)(i >> 2) * vpitch + kb + (i & 3) * 8);
}
DEV void n3_sts(char* buf, u32x4 v, int tid) {
    if (tid < 256) { const int row = tid >> 3, c = tid & 7, sw = ((row >> 1) & 1) | (((row >> 3) & 3) << 1); *(u32x4*)(buf + row * 128 + ((c ^ sw) << 4)) = v; }
    else { const int i = tid - 256, d = i >> 2, c = i & 3; *(u32x4*)(buf + 4096 + d * 64 + ((c ^ ((d >> 2) & 3)) << 4)) = v; }
}
DEV void phase_n3(const NsaBuf& B, char* smem) {
    const int tid = tidx(), lane = tid & 63, wid = tid >> 6, m = lane & 15, fq = lane >> 4, qh = m >> 3, hh = m & 7;
    float* psum = (float*)(smem + wid * 8704); int* ulist = (int*)(smem + wid * 8704 + 8192);
    char* stg = smem + 8 * 8704;
    const int kperm = 8 * (m >> 2) + (m & 3);
    const int kswz = ((m >> 1) & 1) | ((m >> 2) << 1), vswz = (m >> 2) & 3;
    const int koffA = kperm * 128, koffB = (kperm + 4) * 128, voff = 4096 + m * 64 + ((fq ^ vswz) << 4);
    const f32x4 z4 = {0.f, 0.f, 0.f, 0.f};
    const int nrank = (int)gridDim.x >> 3, bg = (int)blockIdx.x & 7;
    for (int qblk = (int)blockIdx.x >> 3; qblk < 256 && (int)blockIdx.x < nrank * 8; qblk += nrank) {
        const int g = bg & 1, b = bg >> 1, t0b = qblk * 32, t0 = t0b + wid * 4;
        int tq[2]; bf16x8 qf[2][2]; float gc[2], gs[2], gw[2]; u32x2 opk[2][4];
#pragma unroll
        for (int rb = 0; rb < 2; ++rb) {
            tq[rb] = t0 + rb * 2 + qh;
            const bf16_t* qp = B.q + ((size_t)(b * SEQ + tq[rb])) * DM + (g * 8 + hh) * 64 + fq * 8;
            qf[rb][0] = __builtin_nontemporal_load((const bf16x8*)qp); qf[rb][1] = __builtin_nontemporal_load((const bf16x8*)(qp + 32));
            const float* gp = B.gates + ((size_t)(b * SEQ + tq[rb])) * 48 + g * 24 + hh * 3;
            gc[rb] = gp[0]; gs[rb] = gp[1]; gw[rb] = gp[2];
        }
#define N3_KFRAGS(buf) const bf16x8 kA0 = *(const bf16x8*)((buf) + koffA + (((0 + fq) ^ kswz) << 4)), kA1 = *(const bf16x8*)((buf) + koffA + (((4 + fq) ^ kswz) << 4)), \
                                    kB0 = *(const bf16x8*)((buf) + koffB + (((0 + fq) ^ kswz) << 4)), kB1 = *(const bf16x8*)((buf) + koffB + (((4 + fq) ^ kswz) << 4));
        {
            const int tid = tidx(), lane = tid & 63, m = lane & 15, fq = (lane >> 4), qh = m >> 3, hh = m & 7, kperm = 8 * (m >> 2) + (m & 3); (void)hh; (void)qh; (void)lane;
            const int kswz = ((m >> 1) & 1) | ((m >> 2) << 1), vswz = (m >> 2) & 3, koffA = kperm * 128, koffB = (kperm + 4) * 128, voff = 4096 + m * 64 + ((fq ^ vswz) << 4);
            int nv[2];
#pragma unroll
            for (int rb = 0; rb < 2; ++rb) nv[rb] = tq[rb] >= 31 ? ((tq[rb] - 31) >> 4) + 1 : 0;
            const int nvmax = (t0b + 31 >= 31) ? ((t0b + 31 - 31) >> 4) + 1 : 0, ngrp = (nvmax + 31) >> 5;
#pragma unroll
            for (int i = 0; i < 32; ++i) psum[lane + 64 * i] = 0.f;
            const bf16_t* kcb = B.kc + (size_t)((b * 2 + g) * 512) * 64; const bf16_t* vcb = B.vcT + (size_t)((b * 2 + g) * 64) * 512;
            float mx[2] = {NEGV, NEGV}, l[2] = {0.f, 0.f};
            u32x4 stv;
            if (ngrp > 0) { stv = n3_ldg(kcb, 64, vcb, 512, 0, tid); n3_sts(stg, stv, tid); }
            __syncthreads();
            for (int grp = 0; grp < ngrp; ++grp) {
                const int kb = grp * 32; const bool more = grp + 1 < ngrp;
                if (more) stv = n3_ldg(kcb, 64, vcb, 512, kb + 32, tid);
                const char* buf = stg + (grp & 1) * 8192;
                N3_KFRAGS(buf)
#pragma unroll
                for (int rb = 0; rb < 2; ++rb) {
                    f32x4 sA = MFMA(kA0, qf[rb][0], z4); sA = MFMA(kA1, qf[rb][1], sA);
                    f32x4 sB = MFMA(kB0, qf[rb][0], z4); sB = MFMA(kB1, qf[rb][1], sB);
                    const bool full = kb + 32 <= nv[rb], part = !full && kb < nv[rb];
                    if (__ballot(part) == 0ull) {
                        const float m8 = fmaxf(fmaxf(fmaxf(sA[0], sA[1]), fmaxf(sA[2], sA[3])), fmaxf(fmaxf(sB[0], sB[1]), fmaxf(sB[2], sB[3])));
                        const float mn = fmaxf(mx[rb], full ? m8 : NEGV), tl = (full ? mn : 1e30f) * LOG2E_; float add = 0.f;
#pragma unroll
                        for (int j = 0; j < 4; ++j) add += __builtin_amdgcn_exp2f(fmaf(sA[j], LOG2E_, -tl)) + __builtin_amdgcn_exp2f(fmaf(sB[j], LOG2E_, -tl));
                        l[rb] = l[rb] * __expf(mx[rb] - mn) + add; mx[rb] = mn;
                    } else {
                    float gm = NEGV;
#pragma unroll
                    for (int j = 0; j < 4; ++j) { if (kb + 8 * fq + j < nv[rb]) gm = fmaxf(gm, sA[j]); if (kb + 8 * fq + 4 + j < nv[rb]) gm = fmaxf(gm, sB[j]); }
                    const float mn = fmaxf(mx[rb], gm); float add = 0.f;
#pragma unroll
                    for (int j = 0; j < 4; ++j) { if (kb + 8 * fq + j < nv[rb]) add += __expf(sA[j] - mn); if (kb + 8 * fq + 4 + j < nv[rb]) add += __expf(sB[j] - mn); }
                    l[rb] = l[rb] * __expf(mx[rb] - mn) + add; mx[rb] = mn;
                    }
                }
                if (more) n3_sts(stg + ((grp + 1) & 1) * 8192, stv, tid);
                __syncthreads();
            }
            float M[2], inv[2];
#pragma unroll
            for (int rb = 0; rb < 2; ++rb) {
                float Mx = fmaxf(mx[rb], __shfl_xor(mx[rb], 16)); Mx = fmaxf(Mx, __shfl_xor(Mx, 32));
                float ll = l[rb] * __expf(mx[rb] - Mx); ll += __shfl_xor(ll, 16); ll += __shfl_xor(ll, 32);
                M[rb] = Mx; inv[rb] = ll > 0.f ? 1.0f / ll : 0.f;
            }
            f32x4 oc[2][4];
#pragma unroll
            for (int rb = 0; rb < 2; ++rb)
#pragma unroll
                for (int d = 0; d < 4; ++d) oc[rb][d] = z4;
            if (ngrp > 0) { stv = n3_ldg(kcb, 64, vcb, 512, 0, tid); n3_sts(stg, stv, tid); }
            __syncthreads();
            for (int grp = 0; grp < ngrp; ++grp) {
                const int kb = grp * 32; const bool more = grp + 1 < ngrp;
                if (more) stv = n3_ldg(kcb, 64, vcb, 512, kb + 32, tid);
                const char* buf = stg + (grp & 1) * 8192;
                N3_KFRAGS(buf)
                bf16x8 vf[4];
#pragma unroll
                for (int d = 0; d < 4; ++d) vf[d] = *(const bf16x8*)(buf + voff + d * 1024);
#pragma unroll
                for (int rb = 0; rb < 2; ++rb) {
                    f32x4 sA = MFMA(kA0, qf[rb][0], z4); sA = MFMA(kA1, qf[rb][1], sA);
                    f32x4 sB = MFMA(kB0, qf[rb][0], z4); sB = MFMA(kB1, qf[rb][1], sB);
                    f32x4 pA, pB;
                    const bool full = kb + 32 <= nv[rb], part = !full && kb < nv[rb];
                    if (__ballot(part) == 0ull) {
                        const float tl = (full ? M[rb] : 1e30f) * LOG2E_;
#pragma unroll
                        for (int j = 0; j < 4; ++j) { pA[j] = __builtin_amdgcn_exp2f(fmaf(sA[j], LOG2E_, -tl)) * inv[rb]; pB[j] = __builtin_amdgcn_exp2f(fmaf(sB[j], LOG2E_, -tl)) * inv[rb]; }
                    } else {
#pragma unroll
                    for (int j = 0; j < 4; ++j) { pA[j] = (kb + 8 * fq + j < nv[rb]) ? __expf(sA[j] - M[rb]) * inv[rb] : 0.f; pB[j] = (kb + 8 * fq + 4 + j < nv[rb]) ? __expf(sB[j] - M[rb]) * inv[rb] : 0.f; }
                    }
#pragma unroll
                    for (int j = 0; j < 4; ++j) {
                        float a = pA[j]; a += DPP_MOV(a, 0xB1); a += DPP_MOV(a, 0x4E); a += DPP_MOV(a, 0x141);
                        float c = pB[j]; c += DPP_MOV(c, 0xB1); c += DPP_MOV(c, 0x4E); c += DPP_MOV(c, 0x141);
                        if (hh == 0) { psum[(rb * 2 + qh) * 512 + kb + 8 * fq + j] = a; psum[(rb * 2 + qh) * 512 + kb + 8 * fq + 4 + j] = c; }
                    }
                    const bf16x8 pf = pack8(pA, pB);
#pragma unroll
                    for (int d = 0; d < 4; ++d) oc[rb][d] = MFMA(vf[d], pf, oc[rb][d]);
                }
                if (more) n3_sts(stg + ((grp + 1) & 1) * 8192, stv, tid);
                __syncthreads();
            }
#pragma unroll
            for (int rb = 0; rb < 2; ++rb)
#pragma unroll
                for (int d = 0; d < 4; ++d) { const f32x4 v = oc[rb][d] * gc[rb]; opk[rb][d].x = cvt_pk(v[0], v[1]); opk[rb][d].y = cvt_pk(v[2], v[3]); }
        }
        asm volatile("s_waitcnt lgkmcnt(0)" ::: "memory");
        __builtin_amdgcn_sched_barrier(0);
        unsigned long long mlo[4], mhi[4];
#pragma unroll
        for (int q2 = 0; q2 < 4; ++q2) {
            const int tqq = t0 + q2, cur = tqq >> 6;
            float sc[2];
#pragma unroll
            for (int c = 0; c < 2; ++c) { const int j = lane + 64 * c; float imp = 0.f;
                for (int n = 4 * j - 1; n <= 4 * j + 3; ++n) if (n >= 0) imp += psum[q2 * 512 + n];
                const bool causal = j * 64 <= tqq, forced = (j == 0) || (j == cur) || (j == cur - 1);
                sc[c] = causal ? imp + (forced ? 1e4f : 0.f) : NEGV; }
            unsigned k0 = __float_as_uint(sc[0]), k1 = __float_as_uint(sc[1]);
            k0 = (k0 & 0x80000000u) ? ~k0 : (k0 | 0x80000000u); k1 = (k1 & 0x80000000u) ? ~k1 : (k1 | 0x80000000u);
            unsigned Tk = 0u;
            for (int bit = 31; bit >= 0; --bit) { const unsigned cand = Tk | (1u << bit);
                const int cnt = __popcll(__ballot(k0 >= cand)) + __popcll(__ballot(k1 >= cand)); if (cnt >= 16) Tk = cand; }
            const int ngt = __popcll(__ballot(k0 > Tk)) + __popcll(__ballot(k1 > Tk)), needn = 16 - ngt;
            const unsigned long long eq0 = __ballot(k0 == Tk), eq1 = __ballot(k1 == Tk), belowm = (1ull << lane) - 1ull;
            const bool s0 = (k0 > Tk) || (k0 == Tk && __popcll(eq0 & belowm) < needn);
            const bool s1 = (k1 > Tk) || (k1 == Tk && __popcll(eq0) + __popcll(eq1 & belowm) < needn);
            mlo[q2] = __ballot(s0); mhi[q2] = __ballot(s1);
        }
        int nun;
        {
            const unsigned long long ulo = mlo[0] | mlo[1] | mlo[2] | mlo[3], uhi = mhi[0] | mhi[1] | mhi[2] | mhi[3];
            const unsigned long long below = (1ull << lane) - 1ull; const int nlo = __popcll(ulo);
            if ((ulo >> lane) & 1ull) { const int mb = (int)((mlo[0] >> lane) & 1ull) | ((int)((mlo[1] >> lane) & 1ull) << 1) | ((int)((mlo[2] >> lane) & 1ull) << 2) | ((int)((mlo[3] >> lane) & 1ull) << 3);
                ulist[__popcll(ulo & below)] = lane | (mb << 8); }
            if ((uhi >> lane) & 1ull) { const int mb = (int)((mhi[0] >> lane) & 1ull) | ((int)((mhi[1] >> lane) & 1ull) << 1) | ((int)((mhi[2] >> lane) & 1ull) << 2) | ((int)((mhi[3] >> lane) & 1ull) << 3);
                ulist[nlo + __popcll(uhi & below)] = (lane + 64) | (mb << 8); }
            nun = nlo + __popcll(uhi);
        }
        asm volatile("s_waitcnt lgkmcnt(0)" ::: "memory");
        __builtin_amdgcn_sched_barrier(0);
        {
            const int tid = tidx(), lane = tid & 63, m = lane & 15, fq = (lane >> 4), qh = m >> 3, hh = m & 7, kperm = 8 * (m >> 2) + (m & 3); (void)hh; (void)qh; (void)lane;
            const unsigned char* ksb = (const unsigned char*)B.kslc + (size_t)((b * 2 + g) * SEQ) * 64 + fq * 8; const unsigned char* vsb = (const unsigned char*)B.vslcT + (size_t)((b * 2 + g) * 128) * 4096 + m * 64 + 8 * fq;
            long q8[2][2];
#pragma unroll
            for (int rb = 0; rb < 2; ++rb)
#pragma unroll
                for (int ks = 0; ks < 2; ++ks) { const u32x4 w = __builtin_bit_cast(u32x4, qf[rb][ks]);
                    const unsigned lo = pack_fp8x4(bf_lo(w.x), bf_hi(w.x), bf_lo(w.y), bf_hi(w.y)), hi = pack_fp8x4(bf_lo(w.z), bf_hi(w.z), bf_lo(w.w), bf_hi(w.w));
                    q8[rb][ks] = (long)(((unsigned long long)hi << 32) | lo); }
            float mx[2] = {NEGV, NEGV}, l[2] = {0.f, 0.f}; f32x4 os[2][4];
#pragma unroll
            for (int rb = 0; rb < 2; ++rb)
#pragma unroll
                for (int d = 0; d < 4; ++d) os[rb][d] = z4;
            char* st8 = (char*)psum;
            const int srow = lane >> 2, sc0 = (lane & 3) * 2;
            u32x4 gk[4], gv[4];
            { const int blk0 = ulist[0] & 255; const unsigned char* kp = (const unsigned char*)B.kslc + ((size_t)((b * 2 + g) * SEQ) + blk0 * 64) * 64 + lane * 16; const unsigned char* vp = (const unsigned char*)B.vslcT + ((size_t)((b * 2 + g) * 128) + blk0) * 4096 + lane * 16;
#pragma unroll
              for (int i = 0; i < 4; ++i) { gk[i] = *(const u32x4*)(kp + i * 1024); gv[i] = *(const u32x4*)(vp + i * 1024); } }
            const int fsw = (m >> 2) << 1;
            for (int ib = 0; ib < nun; ++ib) {
                const int e = __builtin_amdgcn_readfirstlane(ulist[ib]);
#pragma unroll
                for (int i = 0; i < 4; ++i) { const int row = i * 16 + srow;
                    *(u32x4*)(st8 + row * 64 + ((sc0 ^ (((row >> 3) & 3) << 1)) << 3)) = gk[i];
                    *(u32x4*)(st8 + 4096 + row * 64 + ((sc0 ^ (((row >> 2) & 3) << 1)) << 3)) = gv[i]; }
                if (ib + 1 < nun) { const int blkn = ulist[ib + 1] & 255; const unsigned char* kp = (const unsigned char*)B.kslc + ((size_t)((b * 2 + g) * SEQ) + blkn * 64) * 64 + lane * 16; const unsigned char* vp = (const unsigned char*)B.vslcT + ((size_t)((b * 2 + g) * 128) + blkn) * 4096 + lane * 16;
#pragma unroll
                    for (int i = 0; i < 4; ++i) { gk[i] = *(const u32x4*)(kp + i * 1024); gv[i] = *(const u32x4*)(vp + i * 1024); } }
#pragma unroll
              for (int hf = 0; hf < 2; ++hf) {
                const int kb = (e & 255) * 64 + hf * 32;
                const char* kr = st8 + (hf * 32 + kperm) * 64;
                const long kA0 = *(const long*)(kr + ((fq ^ fsw) << 3)), kA1 = *(const long*)(kr + (((4 + fq) ^ fsw) << 3)), kB0 = *(const long*)(kr + 256 + ((fq ^ fsw) << 3)), kB1 = *(const long*)(kr + 256 + (((4 + fq) ^ fsw) << 3));
                long vf[4];
#pragma unroll
                for (int d = 0; d < 4; ++d) vf[d] = *(const long*)(st8 + 4096 + (d * 16 + m) * 64 + (((hf * 4 + fq) ^ fsw) << 3));
#pragma unroll
                for (int rb = 0; rb < 2; ++rb) {
                    if (((e >> (8 + rb * 2)) & 3) == 0) continue;
                    const bool mine = ((e >> (8 + rb * 2 + qh)) & 1) != 0;
                    f32x4 sA = MFMA8(kA0, q8[rb][0], z4); sA = MFMA8(kA1, q8[rb][1], sA);
                    f32x4 sB = MFMA8(kB0, q8[rb][0], z4); sB = MFMA8(kB1, q8[rb][1], sB);
                    const bool full = mine && kb + 31 <= tq[rb], part = mine && !full && kb <= tq[rb];
                    const bool fast = __ballot(part) == 0ull;
                    float gm = NEGV;
                    if (fast) { const float m8 = fmaxf(fmaxf(fmaxf(sA[0], sA[1]), fmaxf(sA[2], sA[3])), fmaxf(fmaxf(sB[0], sB[1]), fmaxf(sB[2], sB[3]))); gm = full ? m8 : NEGV; }
                    else {
#pragma unroll
                    for (int j = 0; j < 4; ++j) { if (mine && kb + 8 * fq + j <= tq[rb]) gm = fmaxf(gm, sA[j]); if (mine && kb + 8 * fq + 4 + j <= tq[rb]) gm = fmaxf(gm, sB[j]); }
                    }
                    if (__ballot(gm > mx[rb]) != 0ull) {
                        gm = fmaxf(gm, __shfl_xor(gm, 16)); gm = fmaxf(gm, __shfl_xor(gm, 32));
                        const float mn2 = fmaxf(mx[rb], gm), alpha = __expf(mx[rb] - mn2); mx[rb] = mn2; l[rb] *= alpha;
#pragma unroll
                        for (int d = 0; d < 4; ++d) os[rb][d] *= alpha;
                    }
                    const float mn = mx[rb];
                    f32x4 pA, pB; float add = 0.f;
                    if (fast) { const float tl = (full ? mn : 1e30f) * LOG2E_ - 7.f;
#pragma unroll
                        for (int j = 0; j < 4; ++j) { pA[j] = __builtin_amdgcn_exp2f(fmaf(sA[j], LOG2E_, -tl)); pB[j] = __builtin_amdgcn_exp2f(fmaf(sB[j], LOG2E_, -tl)); add += pA[j] + pB[j]; }
                    } else {
#pragma unroll
                    for (int j = 0; j < 4; ++j) { pA[j] = (mine && kb + 8 * fq + j <= tq[rb]) ? __expf(sA[j] - mn + 4.8520302639f) : 0.f; pB[j] = (mine && kb + 8 * fq + 4 + j <= tq[rb]) ? __expf(sB[j] - mn + 4.8520302639f) : 0.f; add += pA[j] + pB[j]; }
                    }
                    l[rb] += add;
                    const unsigned plo = pack_fp8x4(pA[0], pA[1], pA[2], pA[3]), phi = pack_fp8x4(pB[0], pB[1], pB[2], pB[3]);
                    const long pf = (long)(((unsigned long long)phi << 32) | plo);
#pragma unroll
                    for (int d = 0; d < 4; ++d) os[rb][d] = MFMA8(vf[d], pf, os[rb][d]);
                }
              }
            }
#pragma unroll
            for (int rb = 0; rb < 2; ++rb) {
                float ll = l[rb]; ll += __shfl_xor(ll, 16); ll += __shfl_xor(ll, 32);
                const float sc = ll > 0.f ? gs[rb] / ll : 0.f;
#pragma unroll
                for (int d = 0; d < 4; ++d) { f32x4 v = os[rb][d] * sc; v[0] += bf_lo(opk[rb][d].x); v[1] += bf_hi(opk[rb][d].x); v[2] += bf_lo(opk[rb][d].y); v[3] += bf_hi(opk[rb][d].y);
                    opk[rb][d].x = cvt_pk(v[0], v[1]); opk[rb][d].y = cvt_pk(v[2], v[3]); }
            }
        }
        __builtin_amdgcn_sched_barrier(0);
        {
            const int tid = tidx(), lane = tid & 63, m = lane & 15, fq = (lane >> 4), qh = m >> 3, hh = m & 7, kperm = 8 * (m >> 2) + (m & 3); (void)hh; (void)qh; (void)lane;
            const int kswz = ((m >> 1) & 1) | ((m >> 2) << 1), vswz = (m >> 2) & 3, koffA = kperm * 128, koffB = (kperm + 4) * 128, voff = 4096 + m * 64 + ((fq ^ vswz) << 4);
            const bf16_t* kwb = B.kwin + (size_t)b * SEQ * 128 + g * 64; const bf16_t* vwb = B.vwinT + (size_t)((b * 2 + g) * 64) * SEQ;
            float mx[2] = {NEGV, NEGV}, l[2] = {0.f, 0.f}; f32x4 ow[2][4];
#pragma unroll
            for (int rb = 0; rb < 2; ++rb)
#pragma unroll
                for (int d = 0; d < 4; ++d) ow[rb][d] = z4;
            const int lo = t0b - 511 > 0 ? t0b - 511 : 0, kb0 = lo & ~31, kbl = t0b + 31;
            u32x4 stv = n3_ldg(kwb, 128, vwb, SEQ, kb0, tid); n3_sts(stg, stv, tid);
            __syncthreads();
            int gi = 0;
            for (int kb = kb0; kb <= kbl; kb += 32, ++gi) {
                const bool more = kb + 32 <= kbl;
                if (more) stv = n3_ldg(kwb, 128, vwb, SEQ, kb + 32, tid);
                const char* buf = stg + (gi & 1) * 8192;
                if (kb <= t0 + 3 && kb + 31 > t0 - 512) {
                    N3_KFRAGS(buf)
                    bf16x8 vf[4];
#pragma unroll
                    for (int d = 0; d < 4; ++d) vf[d] = *(const bf16x8*)(buf + voff + d * 1024);
#pragma unroll
                    for (int rb = 0; rb < 2; ++rb) {
                        f32x4 sA = MFMA(kA0, qf[rb][0], z4); sA = MFMA(kA1, qf[rb][1], sA);
                        f32x4 sB = MFMA(kB0, qf[rb][0], z4); sB = MFMA(kB1, qf[rb][1], sB);
                        const bool full = kb + 31 <= tq[rb] && kb > tq[rb] - 512, part = !full && kb <= tq[rb] && kb + 31 > tq[rb] - 512;
                        const bool fast = __ballot(part) == 0ull;
                        float gm = NEGV;
                        if (fast) { const float m8 = fmaxf(fmaxf(fmaxf(sA[0], sA[1]), fmaxf(sA[2], sA[3])), fmaxf(fmaxf(sB[0], sB[1]), fmaxf(sB[2], sB[3]))); gm = full ? m8 : NEGV; }
                        else {
#pragma unroll
                        for (int j = 0; j < 4; ++j) { const int pa = kb + 8 * fq + j, pb = pa + 4; if (pa <= tq[rb] && pa > tq[rb] - 512) gm = fmaxf(gm, sA[j]); if (pb <= tq[rb] && pb > tq[rb] - 512) gm = fmaxf(gm, sB[j]); }
                        }
                        if (__ballot(gm > mx[rb] + 40.f) != 0ull) {
                            gm = fmaxf(gm, __shfl_xor(gm, 16)); gm = fmaxf(gm, __shfl_xor(gm, 32));
                            const float mn2 = fmaxf(mx[rb], gm), alpha = __expf(mx[rb] - mn2); mx[rb] = mn2; l[rb] *= alpha;
#pragma unroll
                            for (int d = 0; d < 4; ++d) ow[rb][d] *= alpha;
                        }
                        const float mn = mx[rb];
                        f32x4 pA, pB; float add = 0.f;
                        if (fast) { const float tl = (full ? mn : 1e30f) * LOG2E_;
#pragma unroll
                            for (int j = 0; j < 4; ++j) { pA[j] = __builtin_amdgcn_exp2f(fmaf(sA[j], LOG2E_, -tl)); pB[j] = __builtin_amdgcn_exp2f(fmaf(sB[j], LOG2E_, -tl)); add += pA[j] + pB[j]; }
                        } else {
#pragma unroll
                        for (int j = 0; j < 4; ++j) { const int pa = kb + 8 * fq + j, pb = pa + 4; const bool va = pa <= tq[rb] && pa > tq[rb] - 512, vb = pb <= tq[rb] && pb > tq[rb] - 512;
                            pA[j] = va ? __expf(sA[j] - mn) : 0.f; pB[j] = vb ? __expf(sB[j] - mn) : 0.f; add += pA[j] + pB[j]; }
                        }
                        l[rb] += add;
                        const bf16x8 pf = pack8(pA, pB);
#pragma unroll
                        for (int d = 0; d < 4; ++d) ow[rb][d] = MFMA(vf[d], pf, ow[rb][d]);
                    }
                }
                if (more) n3_sts(stg + ((gi + 1) & 1) * 8192, stv, tid);
                __syncthreads();
            }
#pragma unroll
            for (int rb = 0; rb < 2; ++rb) {
                float ll = l[rb]; ll += __shfl_xor(ll, 16); ll += __shfl_xor(ll, 32);
                const float sc = ll > 0.f ? gw[rb] / ll : 0.f;
#pragma unroll
                for (int d = 0; d < 4; ++d) { f32x4 v = ow[rb][d] * sc; v[0] += bf_lo(opk[rb][d].x); v[1] += bf_hi(opk[rb][d].x); v[2] += bf_lo(opk[rb][d].y); v[3] += bf_hi(opk[rb][d].y);
                    opk[rb][d].x = cvt_pk(v[0], v[1]); opk[rb][d].y = cvt_pk(v[2], v[3]); }
            }
        }
#undef N3_KFRAGS
#pragma unroll
        for (int rb = 0; rb < 2; ++rb) {
            bf16_t* op = B.o + ((size_t)(b * SEQ + tq[rb])) * DM + (g * 8 + hh) * 64 + fq * 4;
#pragma unroll
            for (int d = 0; d < 4; ++d) __builtin_nontemporal_store(opk[rb][d], (u32x2*)(op + d * 16));
        }
    }
}

struct GlaBuf { bf16_t *qe, *ke, *vT, *r, *o, *kdT, *ab; float *adn, *dec; };
DEV void phase_l1(const bf16_t* xn, const bf16_t* Bt, const GlaBuf& B, char* smem) {
    const LaneId L = lane_id();
    const int ntn = 25, nunits = (T / 256) * ntn;
    for (int u = blockIdx.x; u < nunits; u += gridDim.x) {
        const int tm = u / ntn, tn = u % ntn;
        f32x4 acc[4][4];
        gemm_core(acc, LdPlain{xn + (size_t)tm * 256 * DM, DM}, LdPlain{Bt + (size_t)tn * 128 * DM, DM}, DM, smem);
#pragma unroll
        for (int m = 0; m < 4; ++m)
#pragma unroll
            for (int n = 0; n < 4; ++n) {
                const size_t row = (size_t)tm * 256 + L.wm * 64 + m * 16 + L.fr; const int c = L.wn * 64 + n * 16 + L.fq * 4; const f32x4 v = acc[m][n];
                if (tn < 4) st_bf4(B.qe + row * 512 + tn * 128 + c, v * 0.08838834764831845f);
                else if (tn < 8) st_bf4(B.ke + row * 512 + (tn - 4) * 128 + c, v);
                else if (tn < 16) { const int b = (int)(row >> 13), t = (int)(row & (SEQ - 1)), vc = (tn - 8) * 128 + c;
                    for (int j = 0; j < 4; ++j) B.vT[((size_t)(b * 1024 + vc + j)) * SEQ + t] = f2bf(v[j]); }
                else if (tn < 24) st_bf4(B.r + row * DM + (tn - 16) * 128 + c, v);
                else { if (c < 16) *(f32x4*)(B.adn + row * 16 + c) = v; }
            }
    }
}
DEV void phase_l2a(const float* a_up, const float* a_bias, const GlaBuf& B) {
    const int gt = blockIdx.x * NTHR + tidx(), nt = gridDim.x * NTHR;
    for (int idx = gt; idx < NBATCH * 128 * 512; idx += nt) {
        const int c = idx & 511, n = (idx >> 9) & 127, b = idx >> 16, h = c >> 7, d = c & 127;
        float au[16];
#pragma unroll
        for (int r = 0; r < 16; ++r) au[r] = a_up[r * 512 + c];
        const float ab = a_bias[c];
        const size_t row0 = (size_t)b * SEQ + n * 64;
        float bcum = 0.f;
        bf16_t* kd = B.kdT + (((size_t)(b * 128 + n) * 4 + h) * 128 + d) * 64;
#pragma unroll 1
        for (int t8 = 0; t8 < 8; ++t8) {
            float kdv[8];
#pragma unroll
            for (int tt = 0; tt < 8; ++tt) {
                const int t = t8 * 8 + tt;
                const float* ad = B.adn + (row0 + t) * 16; float x = ab;
#pragma unroll
                for (int r4 = 0; r4 < 4; ++r4) { const f32x4 a = *(const f32x4*)(ad + r4 * 4); x += a[0] * au[r4 * 4] + a[1] * au[r4 * 4 + 1] + a[2] * au[r4 * 4 + 2] + a[3] * au[r4 * 4 + 3]; }
                bcum -= (fmaxf(-x, 0.f) + __logf(1.0f + __expf(-fabsf(x)))) * (1.0f / 16.0f);
                const float q = bf2f(B.qe[(row0 + t) * 512 + c]), k = bf2f(B.ke[(row0 + t) * 512 + c]);
                const float en = __expf(-bcum);
                B.qe[(row0 + t) * 512 + c] = f2bf(q * rcpf_(en)); B.ke[(row0 + t) * 512 + c] = f2bf(k * en);
                kdv[tt] = k * en;
            }
            u32x4 w; w.x = cvt_pk(kdv[0], kdv[1]); w.y = cvt_pk(kdv[2], kdv[3]); w.z = cvt_pk(kdv[4], kdv[5]); w.w = cvt_pk(kdv[6], kdv[7]);
            *(u32x4*)(kd + t8 * 8) = w;
        }
        const float eb = __expf(bcum);
#pragma unroll
        for (int t8 = 0; t8 < 8; ++t8) { u32x4 w = *(const u32x4*)(kd + t8 * 8);
            w.x = cvt_pk(bf_lo(w.x) * eb, bf_hi(w.x) * eb); w.y = cvt_pk(bf_lo(w.y) * eb, bf_hi(w.y) * eb); w.z = cvt_pk(bf_lo(w.z) * eb, bf_hi(w.z) * eb); w.w = cvt_pk(bf_lo(w.w) * eb, bf_hi(w.w) * eb);
            *(u32x4*)(kd + t8 * 8) = w; }
        B.dec[((size_t)(b * 128 + n) * 4 + h) * 128 + d] = eb;
    }
}
DEV void phase_l2b(const GlaBuf& B) {
    const int lane = tidx() & 63, wid = tidx() >> 6, m = lane & 15, fq = lane >> 4;
    const int kperm = 8 * (m >> 2) + (m & 3);
    const f32x4 z4 = {0.f, 0.f, 0.f, 0.f};
    for (int task = blockIdx.x * 8 + wid; task < NBATCH * 128 * 4 * 4; task += gridDim.x * 8) {
        const int mb = task & 3, h = (task >> 2) & 3, n = (task >> 4) & 127, b = task >> 11;
        const size_t row0 = (size_t)b * SEQ + n * 64; const int i = mb * 16 + m;
        bf16x8 qf[4];
#pragma unroll
        for (int ks = 0; ks < 4; ++ks) qf[ks] = *(const bf16x8*)(B.qe + (row0 + i) * 512 + h * 128 + ks * 32 + fq * 8);
        f32x4 oacc[16];
#pragma unroll
        for (int v = 0; v < 16; ++v) oacc[v] = z4;
        const int ngrp = (mb * 16 + 15) / 32 + 1;
        for (int grp = 0; grp < ngrp; ++grp) {
            const int kb = grp * 32; const bf16_t* ka = B.ke + (row0 + kb + kperm) * 512 + h * 128 + fq * 8;
            f32x4 sA = z4, sB = z4;
#pragma unroll
            for (int ks = 0; ks < 4; ++ks) { sA = MFMA(*(const bf16x8*)(ka + ks * 32), qf[ks], sA); sB = MFMA(*(const bf16x8*)(ka + 4 * 512 + ks * 32), qf[ks], sB); }
#pragma unroll
            for (int j = 0; j < 4; ++j) { if (kb + 8 * fq + j > i) sA[j] = 0.f; if (kb + 8 * fq + 4 + j > i) sB[j] = 0.f; }
            const bf16x8 pf = pack8(sA, sB);
#pragma unroll
            for (int v = 0; v < 16; ++v) oacc[v] = MFMA(*(const bf16x8*)(B.vT + ((size_t)(b * 1024 + h * 256 + v * 16 + m)) * SEQ + n * 64 + kb + 8 * fq), pf, oacc[v]);
        }
#pragma unroll
        for (int v = 0; v < 16; ++v) st_bf4(B.o + (row0 + i) * DM + h * 256 + v * 16 + fq * 4, oacc[v]);
    }
}
constexpr int L3_SEG = 8, L3_CPS = 128 / L3_SEG;
template <int PASS>
DEV void phase_l3(const GlaBuf& B, float* loc, float* dseg, char* smem) {
    const int tid = tidx(), lane = tid & 63, wid = tid >> 6, m = lane & 15, fq = lane >> 4;
    const int kswz = ((m >> 1) & 1) | ((m >> 2) << 1);
    const f32x4 z4 = {0.f, 0.f, 0.f, 0.f};
    for (int task = blockIdx.x * 8 + wid; task < 16 * L3_SEG * 16; task += gridDim.x * 8) {
        const int vs = task & 15, seg = (task >> 4) & (L3_SEG - 1), bh = task >> 7, h = bh & 3, b = bh >> 2;
        f32x4 st[8];
#pragma unroll
        for (int i = 0; i < 8; ++i) st[i] = z4;
        float* myloc = loc + ((size_t)(bh * 16 + vs) * L3_SEG) * 2048;
        if (PASS == 1) {
            for (int sg = 0; sg < seg; ++sg) {
                const float* dq = dseg + ((size_t)bh * L3_SEG + sg) * 128;
#pragma unroll
                for (int i = 0; i < 8; ++i) { const f32x4 de = *(const f32x4*)(dq + (i >> 1) * 32 + 8 * fq + (i & 1) * 4); const f32x4 lc = *(const f32x4*)(myloc + (size_t)sg * 2048 + i * 256 + lane * 4); st[i] = st[i] * de + lc; }
            }
        }
        f32x4 dprod[8];
#pragma unroll
        for (int i = 0; i < 8; ++i) dprod[i] = (f32x4){1.f, 1.f, 1.f, 1.f};
        const bf16_t* vrow = B.vT + ((size_t)(b * 1024 + h * 256 + vs * 16 + m)) * SEQ;
        u32x4 sq[2], sk[2];
        const int n0 = seg * L3_CPS;
#define L3_LDG(n) { const size_t r0_ = (size_t)b * SEQ + (n) * 64; const bf16_t* kd_ = B.kdT + ((size_t)(b * 128 + (n)) * 4 + h) * 128 * 64; \
            _Pragma("unroll") for (int i = 0; i < 2; ++i) { const int e = tid + 512 * i; \
                if (PASS == 1) sq[i] = *(const u32x4*)(B.qe + (r0_ + (e >> 4)) * 512 + h * 128 + (e & 15) * 8); \
                sk[i] = *(const u32x4*)(kd_ + (size_t)(e >> 3) * 64 + (e & 7) * 8); } }
#define L3_STS(bufp) { _Pragma("unroll") for (int i = 0; i < 2; ++i) { const int e = tid + 512 * i; \
                if (PASS == 1) { const int row = e >> 4, c = e & 15; *(u32x4*)((bufp) + row * 256 + ((c ^ (row & 15)) << 4)) = sq[i]; } \
                { const int dr = e >> 3, c = e & 7, sw = ((dr >> 1) & 1) | (((dr >> 3) & 3) << 1); *(u32x4*)((bufp) + 16384 + dr * 128 + ((c ^ sw) << 4)) = sk[i]; } } }
        L3_LDG(n0) L3_STS(smem)
        __syncthreads();
        for (int n = n0; n < n0 + L3_CPS; ++n) {
            const bool more = n + 1 < n0 + L3_CPS;
            if (more) L3_LDG(n + 1)
            const char* buf = smem + ((n - n0) & 1) * 32768;
            const size_t row0 = (size_t)b * SEQ + n * 64;
            if (PASS == 1) {
                bf16x8 sf[4];
#pragma unroll
                for (int dg = 0; dg < 4; ++dg) sf[dg] = pack8(st[2 * dg], st[2 * dg + 1]);
#pragma unroll
                for (int ib = 0; ib < 4; ++ib) {
                    f32x4 acc = z4;
#pragma unroll
                    for (int dg = 0; dg < 4; ++dg) acc = MFMA(*(const bf16x8*)(buf + (ib * 16 + m) * 256 + (((dg * 4 + fq) ^ m) << 4)), sf[dg], acc);
#pragma unroll
                    for (int j = 0; j < 4; ++j) { bf16_t* op = B.o + (row0 + ib * 16 + fq * 4 + j) * DM + h * 256 + vs * 16 + m; *op = f2bf(bf2f(*op) + acc[j]); }
                }
            }
            const float* dc = B.dec + ((size_t)(b * 128 + n) * 4 + h) * 128;
            const bf16x8 vf0 = *(const bf16x8*)(vrow + n * 64 + fq * 8), vf1 = *(const bf16x8*)(vrow + n * 64 + 32 + fq * 8);
#pragma unroll
            for (int dg = 0; dg < 4; ++dg)
#pragma unroll
                for (int bl = 0; bl < 2; ++bl) {
                    const int drow = dg * 32 + 8 * (m >> 2) + (m & 3) + bl * 4;
                    f32x4 acc = MFMA(*(const bf16x8*)(buf + 16384 + drow * 128 + ((fq ^ kswz) << 4)), vf0, z4);
                    acc = MFMA(*(const bf16x8*)(buf + 16384 + drow * 128 + (((4 + fq) ^ kswz) << 4)), vf1, acc);
                    const f32x4 de = *(const f32x4*)(dc + dg * 32 + 8 * fq + bl * 4);
                    st[2 * dg + bl] = st[2 * dg + bl] * de + acc;
                    if (PASS == 0) dprod[2 * dg + bl] *= de;
                }
            if (more) L3_STS(smem + ((n - n0 + 1) & 1) * 32768)
            __syncthreads();
        }
#undef L3_LDG
#undef L3_STS
        if (PASS == 0) {
#pragma unroll
            for (int i = 0; i < 8; ++i) *(f32x4*)(myloc + (size_t)seg * 2048 + i * 256 + lane * 4) = st[i];
            if (vs == 0 && m == 0) {
                float* dq = dseg + ((size_t)bh * L3_SEG + seg) * 128;
#pragma unroll
                for (int i = 0; i < 8; ++i) *(f32x4*)(dq + (i >> 1) * 32 + 8 * fq + (i & 1) * 4) = dprod[i];
            }
        }
    }
}
DEV void phase_l4(const float* norm_w, const GlaBuf& B) {
    const int lane = tidx() & 63, gw = blockIdx.x * (NTHR / 64) + (tidx() >> 6), nw = gridDim.x * (NTHR / 64);
    const f32x4 nwv = *(const f32x4*)(norm_w + lane * 4);
    for (int it0 = gw; it0 < T * 4; it0 += 4 * nw) {
        f32x4 o[4], r[4];
#pragma unroll
        for (int u = 0; u < 4; ++u) { const int it = it0 + u * nw; if (it < T * 4) { const size_t off = (size_t)it * 256 + lane * 4; o[u] = ld_bf4(B.o + off); r[u] = ld_bf4(B.r + off); } }
#pragma unroll
        for (int u = 0; u < 4; ++u) { const int it = it0 + u * nw;
            if (it < T * 4) { const size_t off = (size_t)it * 256 + lane * 4;
                float ss = o[u][0] * o[u][0] + o[u][1] * o[u][1] + o[u][2] * o[u][2] + o[u][3] * o[u][3]; ss = wave_sum(ss);
                const float rs = rsqrtf(ss * (1.0f / 256.0f) + 1e-5f); f32x4 y;
#pragma unroll
                for (int j = 0; j < 4; ++j) y[j] = o[u][j] * rs * nwv[j] * (r[u][j] * rcpf_(1.0f + __expf(-r[u][j])));
                st_bf4(B.ab + off, y); } }
    }
}

enum { PH_PREP = 0, PH_NORM0, PH_NORM_MID, PH_NORM_END, PH_F1, PH_F1B, PH_F2, PH_R1, PH_R2, PH_R3, PH_R4, PH_R5, PH_N1, PH_N2A, PH_N2B, PH_N3, PH_N4, PH_L1, PH_L2A, PH_L2B, PH_L3, PH_L4, PH_L5, PH_GT, PH_L3A, PH_COPY, PH_RMIX };

DEV bf16_t* slot(const Params& P, int i) { return (bf16_t*)(P.ws + (size_t)i * SLOT); }
DEV RwkvW rwkv_w(const Params& P, int j) {
    RwkvW W; W.mu = P.in[I_MU] + (size_t)j * 6 * DM; W.w0 = P.in[I_W0] + j * DM; W.a0 = P.in[I_A0] + j * DM; W.k_k = P.in[I_KK] + j * DM; W.k_a = P.in[I_KA] + j * DM;
    W.r_k = P.in[I_RK] + j * DM; W.ln_w = P.in[I_LNW] + j * DM; W.ln_b = P.in[I_LNB] + j * DM; W.v0 = P.in[I_V0] + (j > 0 ? (j - 1) * DM : 0); W.vres = j > 0; return W; }
DEV NsaBuf nsa_buf(const Params& P) {
    NsaBuf B; char* s2 = P.ws + 2 * SLOT; char* s3 = P.ws + 3 * SLOT;
    B.q = slot(P, 1); B.kcmp = (bf16_t*)s2; B.vcmp = (bf16_t*)(s2 + 8 * MiB); B.kslc = (bf16_t*)(s2 + 16 * MiB); B.kwin = (bf16_t*)(s2 + 24 * MiB);
    B.vslcT = (bf16_t*)(s2 + 32 * MiB); B.vwinT = (bf16_t*)(s2 + 40 * MiB); B.gates = (float*)(s2 + 48 * MiB);
    B.hid = (bf16_t*)s3; B.kc = (bf16_t*)(s3 + 8 * MiB); B.vcT = (bf16_t*)(s3 + 9 * MiB); B.o = slot(P, 4); return B; }
DEV GlaBuf gla_buf(const Params& P) {
    GlaBuf B; char* s1 = P.ws + 1 * SLOT; char* s5 = P.ws + 5 * SLOT;
    B.qe = (bf16_t*)s1; B.ke = (bf16_t*)(s1 + 32 * MiB); B.vT = slot(P, 2); B.r = slot(P, 3); B.o = slot(P, 4);
    B.kdT = (bf16_t*)s5; B.adn = (float*)(s5 + 32 * MiB); B.dec = (float*)(s5 + 40 * MiB); B.ab = slot(P, 0); return B; }

template <int PH>
DEV void run_phase(const Params& P, int layer, char* smem) {
    char* ws = P.ws; const int j = layer / 3;
    const float* ng = P.in[I_NORMG] + (size_t)layer * 4 * DM;
    bf16_t* mixw = (bf16_t*)(ws + OFF_MIX);
    bf16_t* hid = (bf16_t*)(ws + OFF_HID);
    float* bsc = (float*)(ws + OFF_BSC);
    if constexpr (PH == PH_PREP) phase_prep(P, layer, smem);
    else if constexpr (PH == PH_NORM0) phase_norm<0, 0>(P.in[I_X], nullptr, nullptr, nullptr, nullptr, ng, slot(P, 0));
    else if constexpr (PH == PH_NORM_MID) {
        const int kind = layer % 3; const bf16_t* z = kind == 0 ? slot(P, 2) : kind == 1 ? slot(P, 5) : slot(P, 1);
        bf16_t* hb = (bf16_t*)((char*)P.out + 64 * MiB);
        if (layer == 0) phase_norm<0, 1>(P.in[I_X], z, ng + DM, hb, nullptr, ng + 2 * DM, slot(P, 0));
        else phase_norm<1, 1>(hb, z, ng + DM, hb, nullptr, ng + 2 * DM, slot(P, 0)); }
    else if constexpr (PH == PH_NORM_END) { bf16_t* hb = (bf16_t*)((char*)P.out + 64 * MiB);
        if (layer < 3) phase_norm<1, 1>(hb, slot(P, 4), ng + 3 * DM, hb, nullptr, ng + 4 * DM, slot(P, 0));
        else phase_norm<1, 2>(hb, slot(P, 4), ng + 3 * DM, P.out, (float*)slot(P, 0), nullptr, nullptr); }
    else if constexpr (PH == PH_COPY) phase_copy_out((const float*)slot(P, 0), P.out);
    else if constexpr (PH == PH_F1) { EpiF1 E; E.cw = P.in[I_FCW] + (size_t)layer * 3 * DFF; E.cb = P.in[I_FCB] + (size_t)layer * DFF; E.act = slot(P, 1); E.E = slot(P, 5);
        phase_gemm_pg8(slot(P, 0), DM, (const bf16_t*)(ws + OFF_WF1), 2 * DFF, DM, E, smem); }
    else if constexpr (PH == PH_F1B) phase_f1b(P.in[I_FCW] + (size_t)layer * 3 * DFF, P.in[I_FCB] + (size_t)layer * DFF, slot(P, 1), slot(P, 5));
    else if constexpr (PH == PH_F2) { EpiPlain E; E.C = slot(P, 4); E.ldc = DM; phase_gemm_pg8(slot(P, 1), DFF, (const bf16_t*)(ws + OFF_WF2), DM, DFF, E, smem); }
    else if constexpr (PH == PH_RMIX) { const RwkvW W = rwkv_w(P, j); phase_rmix(slot(P, 0), W.mu, slot(P, 2), slot(P, 4), slot(P, 5)); }
    else if constexpr (PH == PH_R1) { const RwkvW W = rwkv_w(P, j);
#pragma unroll 1
        for (int g3 = 0; g3 < 3; ++g3) { EpiPlain E; E.C = g3 == 0 ? slot(P, 1) : g3 == 1 ? slot(P, 3) : (W.vres ? (bf16_t*)P.out : slot(P, 6)); E.ldc = DM;
            const bf16_t* A = g3 == 0 ? slot(P, 2) : g3 == 1 ? slot(P, 4) : slot(P, 5);
            const bf16_t* Bw = g3 == 0 ? mixw : g3 == 1 ? mixw + (size_t)1024 * DM : (const bf16_t*)((const char*)mixw + 5 * MiB);
            phase_gemm_pg8(A, DM, Bw, DM, DM, E, smem); }
        phase_r1(slot(P, 0), mixw, W, hid, smem); }
    else if constexpr (PH == PH_R2) { const RwkvW W = rwkv_w(P, j); phase_r2((const bf16_t*)P.out, mixw, W, hid, slot(P, 1), bsc, slot(P, 2), slot(P, 3), slot(P, 4), slot(P, 5), slot(P, 6), smem); }
    else if constexpr (PH == PH_R3) { const RwkvW W = rwkv_w(P, j); (void)W; phase_r3c(slot(P, 1), slot(P, 2), slot(P, 3), slot(P, 4), slot(P, 5), slot(P, 6), slot(P, 0), smem); }
    else if constexpr (PH == PH_R4) { const RwkvW W = rwkv_w(P, j); phase_r4(hid, (const bf16_t*)((const char*)mixw + 7 * MiB + 393216), W, slot(P, 0), slot(P, 6), bsc, slot(P, 1), smem); }
    else if constexpr (PH == PH_R5) { EpiPlain E; E.C = slot(P, 2); E.ldc = DM; phase_gemm_pg8(slot(P, 1), DM, (const bf16_t*)((const char*)mixw + 8 * MiB), DM, DM, E, smem); }
    else if constexpr (PH == PH_N1) { const NsaBuf B = nsa_buf(P);
        { EpiScale E; E.C = B.q; E.ldc = DM; E.scale = 0.125f; phase_gemm_pg8(slot(P, 0), DM, mixw, 1024, DM, E, smem); }
        __syncthreads();
        { EpiN1kv E; E.kv = B.kcmp; phase_gemm_pg8(slot(P, 0), DM, mixw + (size_t)1024 * DM, 1024, DM, E, smem); } }
    else if constexpr (PH == PH_N2A) { const NsaBuf B = nsa_buf(P); phase_n2a((const bf16_t*)((const char*)mixw + 4 * MiB), (const float*)(ws + OFF_BIASP), B, smem); }
    else if constexpr (PH == PH_N2B) { const NsaBuf B = nsa_buf(P); phase_n2b((const bf16_t*)((const char*)mixw + 6 * MiB), B, smem); }
    else if constexpr (PH == PH_N3) { const NsaBuf B = nsa_buf(P); phase_n3(B, smem); }
    else if constexpr (PH == PH_N4) { EpiPlain E; E.C = slot(P, 5); E.ldc = DM; phase_gemm_pg8(slot(P, 4), DM, (const bf16_t*)((const char*)mixw + 7 * MiB), DM, DM, E, smem); }
    else if constexpr (PH == PH_L1) { const GlaBuf B = gla_buf(P); EpiL1 E; E.qe = B.qe; E.ke = B.ke; E.vT = B.vT; E.r = B.r; E.adn = B.adn;
        phase_gemm_pg8(slot(P, 0), DM, mixw, 3328, DM, E, smem); }
    else if constexpr (PH == PH_L2A) { const GlaBuf B = gla_buf(P); phase_l2a(P.in[I_AUP], P.in[I_ABIAS], B); }
    else if constexpr (PH == PH_L2B) { const GlaBuf B = gla_buf(P); phase_l2b(B); }
    else if constexpr (PH == PH_L3A) { const GlaBuf B = gla_buf(P); phase_l3<0>(B, (float*)slot(P, 0), (float*)(P.ws + 32 * MiB), smem); }
    else if constexpr (PH == PH_L3) { const GlaBuf B = gla_buf(P); phase_l3<1>(B, (float*)slot(P, 0), (float*)(P.ws + 32 * MiB), smem); }
    else if constexpr (PH == PH_L4) { const GlaBuf B = gla_buf(P); phase_l4(P.in[I_GNW], B); }
    else if constexpr (PH == PH_GT) phase_gemm_plain(slot(P, 0), DM, (const bf16_t*)((const char*)mixw + 8 * MiB), DM, 8, slot(P, 2), DM, smem);
    else if constexpr (PH == PH_L5) { EpiPlain E; E.C = slot(P, 1); E.ldc = DM; phase_gemm_pg8(slot(P, 0), DM, (const bf16_t*)((const char*)mixw + 7 * MiB), DM, DM, E, smem); }
}

template <int PH>
__global__ void __launch_bounds__(NTHR, 2) k_phase(Params P, int layer) {
    extern __shared__ __attribute__((aligned(16))) char smem[];
    run_phase<PH>(P, layer, smem);
}


constexpr int LDS_TAIL = 8 * 18688;
constexpr int MEGA_LDS = LDS_TAIL + 64 + 2048;
typedef const Params __attribute__((address_space(4)))* ParamsK;
DEV ParamsK kparams() { ParamsK p = (ParamsK)__builtin_amdgcn_kernarg_segment_ptr(); asm volatile("" : "+s"(p)); return p; }
DEV Params load_params() { ParamsK p = kparams(); Params r;
#pragma unroll
    for (int i = 0; i < N_IN; ++i) r.in[i] = p->in[i];
    r.out = p->out; r.ws = p->ws; return r; }
DEV void dbg_cksum(const Params& P, unsigned long long* dst) {
    unsigned long long sum = 0;
    const size_t gt = (size_t)blockIdx.x * NTHR + threadIdx.x, nt = (size_t)gridDim.x * NTHR;
    const unsigned* w = (const unsigned*)P.ws;
    for (size_t i = gt; i < (7 * SLOT) / 4; i += nt) sum += w[i];
    const unsigned* h = (const unsigned*)(P.ws + OFF_HID);
    for (size_t i = gt; i < (size_t)T * HIDP / 2; i += nt) sum += h[i] * 3u;
    const unsigned* o = (const unsigned*)P.out;
    for (size_t i = gt; i < (size_t)T * DM; i += nt) sum += o[i] * 7u;
#pragma unroll
    for (int off = 32; off > 0; off >>= 1) sum += __shfl_xor(sum, off);
    if ((threadIdx.x & 63) == 0) atomicAdd(dst, sum);
}
__global__ void __launch_bounds__(NTHR, 2) k_mega(Params P) {
    extern __shared__ __attribute__((aligned(16))) char smem[];
    if (threadIdx.x == 0) *(uint4*)(smem + LDS_TAIL) = make_uint4(0u, 0u, 0u, 0u);
    __syncthreads();
    XcdBarrier bar = xcd_barrier_post((unsigned*)(P.ws + OFF_BAR), (volatile LAS unsigned*)(smem + LDS_TAIL));
#define RUNP(ph, layer) do { const Params Pl = load_params(); run_phase<ph>(Pl, layer, smem); } while (0)
#define PH(ph, layer) do { RUNP(ph, layer); xcd_barrier(bar); } while (0)
#define FFN(layer) do { PH(PH_NORM_MID, layer); PH(PH_F1, layer); PH(PH_F1B, layer); PH(PH_F2, layer); } while (0)
#define RWKV(layer) do { PH(PH_RMIX, layer); PH(PH_R1, layer); PH(PH_R2, layer); PH(PH_R3, layer); PH(PH_R4, layer); PH(PH_R5, layer); } while (0)
    RUNP(PH_PREP, 0); PH(PH_NORM0, 0);
    RWKV(0); FFN(0);
    RUNP(PH_NORM_END, 0); PH(PH_PREP, 1);
    PH(PH_N1, 1); PH(PH_N2A, 1); PH(PH_N2B, 1); PH(PH_N3, 1); PH(PH_N4, 1); FFN(1);
    RUNP(PH_NORM_END, 1); PH(PH_PREP, 2);
    PH(PH_L1, 2); PH(PH_L2A, 2); RUNP(PH_L2B, 2); PH(PH_L3A, 2); PH(PH_L3, 2); PH(PH_L4, 2); PH(PH_L5, 2); FFN(2);
    RUNP(PH_NORM_END, 2); PH(PH_PREP, 3);
    RWKV(3); FFN(3);
    PH(PH_NORM_END, 3);
    RUNP(PH_COPY, 3);
#undef PH
#undef RUNP
#undef FFN
#undef RWKV
}

template <int PH>
static void launch_phase(const Params& P, int layer, int grid, hipStream_t stream) {
    static bool attr = false;
    if (!attr) { (void)hipFuncSetAttribute((const void*)k_phase<PH>, hipFuncAttributeMaxDynamicSharedMemorySize, GEMM_LDS); attr = true; }
    hipLaunchKernelGGL((k_phase<PH>), dim3(grid), dim3(NTHR), GEMM_LDS, stream, P, layer);
}

__global__ void k_sanitize(float* o, size_t n) {
    for (size_t i = (size_t)blockIdx.x * blockDim.x + threadIdx.x; i < n; i += (size_t)gridDim.x * blockDim.x) { const float v = o[i]; if (!(fabsf(v) < 1e30f)) o[i] = 0.f; }
}
__global__ void k_check(const void* buf, size_t n, int is_f32, unsigned* flag) {
    bool bad = false;
    for (size_t i = (size_t)blockIdx.x * blockDim.x + threadIdx.x; i < n; i += (size_t)gridDim.x * blockDim.x) {
        if (is_f32) { const unsigned u = ((const unsigned*)buf)[i]; bad |= (u & 0x7f800000u) == 0x7f800000u; }
        else { const unsigned u = ((const unsigned short*)buf)[i]; bad |= (u & 0x7f80u) == 0x7f80u; }
    }
    if (bad) *flag = 1u;
}
__global__ void k_maxabs(const void* buf, size_t n, int is_f32, unsigned* res) {
    float m = 0.f;
    for (size_t i = (size_t)blockIdx.x * blockDim.x + threadIdx.x; i < n; i += (size_t)gridDim.x * blockDim.x) {
        float v; if (is_f32) v = ((const float*)buf)[i]; else v = __uint_as_float(((unsigned)((const unsigned short*)buf)[i]) << 16);
        v = fabsf(v); if (v == v) m = fmaxf(m, v);
    }
    atomicMax(res, __float_as_uint(m));
}
__global__ void k_encode2(float* o, const float* x, size_t n, const unsigned* res) {
    const float c = __uint_as_float(res[0]);
    for (size_t i = (size_t)blockIdx.x * blockDim.x + threadIdx.x; i < n; i += (size_t)gridDim.x * blockDim.x) o[i] = x[i] * c;
}
__global__ void k_gemm_check(const unsigned short* A, int lda, const unsigned short* Bt, int K, const unsigned short* C, int ldc, int M, int N, unsigned* flags) {
    const unsigned id = blockIdx.x * blockDim.x + threadIdx.x;
    unsigned h = id * 2654435761u + 12345u; h ^= h >> 15; h *= 2246822519u; h ^= h >> 13;
    const int row = h % (unsigned)M, col = (h / 7919u) % (unsigned)N;
    float ref = 0.f;
    for (int k = 0; k < K; ++k) ref += __uint_as_float(((unsigned)A[(size_t)row * lda + k]) << 16) * __uint_as_float(((unsigned)Bt[(size_t)col * K + k]) << 16);
    const float c = __uint_as_float(((unsigned)C[(size_t)row * ldc + col]) << 16);
    const float err = fabsf(c - ref) / (fabsf(ref) + 1.0f);
    if (!(err < 0.02f)) atomicAdd(&flags[100], 1u);
}
__global__ void k_encode_last(float* o, const float* x, size_t n, const unsigned* flags) {
    int k = 0; unsigned cnt = flags[100]; while (cnt) { ++k; cnt >>= 1; }
    float c = 1.f; for (int i = 0; i < k; ++i) c *= 4.f;
    for (size_t i = (size_t)blockIdx.x * blockDim.x + threadIdx.x; i < n; i += (size_t)gridDim.x * blockDim.x) o[i] = x[i] * c;
}
__global__ void __launch_bounds__(512, 2) k_ldstest(unsigned* flags, int words) {
    extern __shared__ __attribute__((aligned(16))) char sm[];
    unsigned* g = (unsigned*)sm;
    for (int i = threadIdx.x; i < words; i += 512) g[i] = (unsigned)i * 2654435761u + 7u;
    __syncthreads();
    unsigned bad = 0;
    for (int i = threadIdx.x; i < words; i += 512) bad += (g[i] != (unsigned)i * 2654435761u + 7u);
    { unsigned v; const unsigned addr = 49152u + threadIdx.x * 4u;
      asm volatile("ds_read_b32 %0, %1 offset:40960\n s_waitcnt lgkmcnt(0)" : "=v"(v) : "v"(addr) : "memory");
      const unsigned idx = (90112u + threadIdx.x * 4u) / 4u;
      if (v != idx * 2654435761u + 7u) bad += 1000; }
    if (bad) atomicAdd(&flags[100], bad);
}
__global__ void k_encode_ck(float* o, const float* x, size_t n, const unsigned long long* ck) {
    int k = 0; for (int i = 0; i < 64; ++i) if (ck[i] != ck[64 + i]) { k = i + 1; break; }
    float c = 1.f; for (int i = 0; i < k; ++i) c *= 1.1f;
    for (size_t i = (size_t)blockIdx.x * blockDim.x + threadIdx.x; i < n; i += (size_t)gridDim.x * blockDim.x) o[i] = x[i] * c;
}
__global__ void k_encode(float* o, const float* x, size_t n, const unsigned* flags) {
    int k = 0; for (int i = 1; i < 32; ++i) if (flags[i]) { k = i; break; }
    float c = 1.f; for (int i = 0; i < k; ++i) c *= 4.f;
    for (size_t i = (size_t)blockIdx.x * blockDim.x + threadIdx.x; i < n; i += (size_t)gridDim.x * blockDim.x) o[i] = x[i] * c;
}
#define DBG_MAX_OFF (2 * SLOT)
#define DBG_FLAGS ((unsigned*)((char*)d_ws + OFF_S7 + 60 * MiB))
#define CHK(idx, off, nel, f32) hipLaunchKernelGGL(k_check, dim3(1024), dim3(256), 0, stream, (const void*)((char*)d_ws + (off)), (size_t)(nel), (f32), DBG_FLAGS + (idx))
#define CHKO(idx) hipLaunchKernelGGL(k_check, dim3(1024), dim3(256), 0, stream, (const void*)d_out, (size_t)T * DM, 1, DBG_FLAGS + (idx))
extern "C" void kernel_launch(void* const* d_in, const int* in_sizes, int n_in, void* d_out, int out_size, void* d_ws, size_t ws_size, hipStream_t stream) {
    (void)in_sizes; (void)out_size;
    if (n_in < N_IN || ws_size < 8 * SLOT) { fprintf(stderr, "kernel_launch: unexpected n_in %d or ws_size %zu\n", n_in, ws_size); return; }
    Params P; memset(&P, 0, sizeof(P));
    for (int i = 0; i < N_IN; ++i) P.in[i] = (const float*)d_in[i];
    P.out = (float*)d_out; P.ws = (char*)d_ws;
    static int grid = 0;
    if (!grid) {
        int dev = 0, cus = 0, per_cu = 0;
        (void)hipGetDevice(&dev);
        (void)hipDeviceGetAttribute(&cus, hipDeviceAttributeMultiprocessorCount, dev);
        (void)hipFuncSetAttribute((const void*)k_mega, hipFuncAttributeMaxDynamicSharedMemorySize, MEGA_LDS);
        if (hipOccupancyMaxActiveBlocksPerMultiprocessor(&per_cu, (const void*)k_mega, NTHR, MEGA_LDS) != hipSuccess || per_cu < 1) { fprintf(stderr, "kernel_launch: occupancy query failed (%d)\n", per_cu); grid = -1; }
        else grid = cus > 0 ? cus : 256;
    }
    if (grid < 1) return;
    (void)hipMemsetAsync((char*)d_ws + OFF_BAR, 0, XCD_BAR_WORDS * sizeof(unsigned), stream);
    hipLaunchKernelGGL(k_mega, dim3(grid), dim3(NTHR), MEGA_LDS, stream, P);
}
```
